# Optimizing an MI355X kernel written in HIP

```python
import math
import jax, jax.numpy as jnp
from jax import lax
import numpy as np

D_MODEL = 1024
BATCH = 8
SEQ = 2048
DEPTH = 1

PLE_DIM = 256
HEAD_DIM = 64
D_MIX = D_MODEL
SB_HEADS = D_MIX // 2 // HEAD_DIM
RET_HEADS = D_MIX // 2 // HEAD_DIM
SB_WIDTH = SB_HEADS * HEAD_DIM
RET_WIDTH = RET_HEADS * HEAD_DIM
D_IN = 3 * SB_WIDTH + 4 * RET_WIDTH
Q_BLOCK = 128
RET_CHUNK = 128
ROPE_BASE = 10000.0
N_EXPERTS = 32
TOP_K = 4
D_EXPERT = D_MODEL
SWIGLU_LIMIT = 7.0
SWIGLU_ALPHA = 1.702
MOE_BLOCK = 128
EPS = 1e-6

kernel_name = "hybrid_sbattn_retention_moe_ple"


def _rmsnorm(x, g):
    xf = x.astype(jnp.float32)
    y = xf * lax.rsqrt(jnp.mean(xf * xf, axis=-1, keepdims=True) + EPS)
    return (y * g.astype(jnp.float32)).astype(x.dtype)


def _heads(t, n_heads):
    b, s, _ = t.shape
    return t.reshape(b, s, n_heads, HEAD_DIM).transpose(0, 2, 1, 3)


def _rope(t, positions):
    half = HEAD_DIM // 2
    inv_freq = ROPE_BASE ** (-jnp.arange(half, dtype=jnp.float32) / half)
    ang = positions.astype(jnp.float32)[:, None, :, None] * inv_freq
    cos, sin = jnp.cos(ang), jnp.sin(ang)
    tf = t.astype(jnp.float32)
    t1, t2 = tf[..., :half], tf[..., half:]
    return jnp.concatenate([t1 * cos - t2 * sin, t2 * cos + t1 * sin], axis=-1).astype(t.dtype)


def _stick_breaking(q, k, v):
    b, h, s, d = q.shape
    nqb = s // Q_BLOCK
    scale = 1.0 / math.sqrt(d)
    qs = q.reshape(b, h, nqb, Q_BLOCK, d).transpose(2, 0, 1, 3, 4)
    t0s = jnp.arange(nqb, dtype=jnp.int32) * Q_BLOCK
    kpos = jnp.arange(s, dtype=jnp.int32)

    def block(args):
        qb, t0 = args
        z = jnp.einsum('bhqd,bhkd->bhqk', qb, k).astype(jnp.float32) * scale
        qpos = t0 + jnp.arange(Q_BLOCK, dtype=jnp.int32)
        mask = kpos[None, :] < qpos[:, None]
        lneg = jnp.where(mask, jax.nn.log_sigmoid(-z), 0.0)
        tail = lax.cumsum(lneg, axis=3, reverse=True) - lneg
        w = jnp.where(mask, jnp.exp(jax.nn.log_sigmoid(z) + tail), 0.0)
        return jnp.einsum('bhqk,bhkd->bhqd', w.astype(v.dtype), v)

    out = lax.map(block, (qs, t0s))
    return out.transpose(1, 2, 0, 3, 4).reshape(b, h, s, d)


def _retention(q, k, v):
    b, h, s, d = q.shape
    n = s // RET_CHUNK
    c = RET_CHUNK
    log_g = jnp.log(1.0 - 2.0 ** (-5.0 - jnp.arange(h, dtype=jnp.float32)))
    idx = jnp.arange(c, dtype=jnp.float32)
    diff = idx[:, None] - idx[None, :]
    dmat = jnp.where(diff >= 0, jnp.exp(log_g[:, None, None] * jnp.maximum(diff, 0.0)), 0.0)
    k_dec = jnp.exp(log_g[:, None] * (c - 1 - idx)[None, :])
    q_dec = jnp.exp(log_g[:, None] * (idx + 1.0)[None, :])
    g_chunk = jnp.exp(log_g * c)
    qc = q.reshape(b, h, n, c, d)
    kc = k.reshape(b, h, n, c, d)
    vc = v.reshape(b, h, n, c, d)
    dt = q.dtype
    scores = jnp.einsum('bhnid,bhnjd->bhnij', qc, kc) * dmat[None, :, None].astype(dt)
    inner = jnp.einsum('bhnij,bhnjd->bhnid', scores, vc)
    kv = jnp.einsum('bhnjd,bhnje->bhnde', kc * k_dec[None, :, None, :, None].astype(dt), vc)

    def step(state, kv_n):
        return g_chunk[:, None, None].astype(state.dtype) * state + kv_n, state

    init = jnp.zeros((b, h, d, d), dtype=kv.dtype)
    _, prev = lax.scan(step, init, jnp.moveaxis(kv, 2, 0))
    prev = jnp.moveaxis(prev, 0, 2)
    cross = jnp.einsum('bhnid,bhnde->bhnie', qc, prev) * q_dec[None, :, None, :, None].astype(dt)
    return (inner + cross).reshape(b, h, s, d)


def _group_norm(y, gain, bias):
    yf = y.astype(jnp.float32)
    mu = jnp.mean(yf, axis=-1, keepdims=True)
    var = jnp.mean((yf - mu) ** 2, axis=-1, keepdims=True)
    yn = (yf - mu) * lax.rsqrt(var + EPS)
    b, h, s, d = y.shape
    yn = yn.transpose(0, 2, 1, 3).reshape(b, s, h * d)
    return (yn * gain.astype(jnp.float32) + bias.astype(jnp.float32)).astype(y.dtype)


def _moe(xt, w_router, b_router, w_up_gate, b_up_gate, w_down, b_down):
    t, d = xt.shape
    logits = (xt @ w_router + b_router).astype(jnp.float32)
    top_vals, top_idx = lax.top_k(logits, TOP_K)
    gates = jax.nn.softmax(top_vals, axis=-1)
    a = t * TOP_K
    flat_e = top_idx.reshape(a).astype(jnp.int32)
    flat_tok = jnp.arange(a, dtype=jnp.int32) // TOP_K
    flat_gate = gates.reshape(a)
    order = jnp.argsort(flat_e)
    sorted_e = flat_e[order]
    counts = jnp.zeros((N_EXPERTS,), jnp.int32).at[flat_e].add(1)
    padded = ((counts + MOE_BLOCK - 1) // MOE_BLOCK) * MOE_BLOCK
    pad_end = jnp.cumsum(padded)
    pad_start = pad_end - padded
    start = jnp.cumsum(counts) - counts
    rank = jnp.arange(a, dtype=jnp.int32) - start[sorted_e]
    dest = pad_start[sorted_e] + rank
    n_slots = a + N_EXPERTS * MOE_BLOCK
    n_blocks = n_slots // MOE_BLOCK
    slot_tok = jnp.zeros((n_slots,), jnp.int32).at[dest].set(flat_tok[order])
    slot_gate = jnp.zeros((n_slots,), jnp.float32).at[dest].set(flat_gate[order])
    block_e = jnp.clip(jnp.searchsorted(pad_end, jnp.arange(n_blocks, dtype=jnp.int32) * MOE_BLOCK, side='right'), 0, N_EXPERTS - 1)
    xs = xt[slot_tok].reshape(n_blocks, MOE_BLOCK, d)

    def expert_block(args):
        xb, e = args
        hgu = xb @ w_up_gate[e] + b_up_gate[e]
        x_glu = jnp.minimum(hgu[:, :D_EXPERT], SWIGLU_LIMIT)
        x_lin = jnp.clip(hgu[:, D_EXPERT:], -SWIGLU_LIMIT, SWIGLU_LIMIT)
        hact = x_glu * jax.nn.sigmoid(SWIGLU_ALPHA * x_glu) * (x_lin + 1.0)
        return hact @ w_down[e] + b_down[e]

    ys = lax.map(expert_block, (xs, block_e)).reshape(n_slots, d)
    return jnp.zeros((t, d), xt.dtype).at[slot_tok].add(ys * slot_gate[:, None].astype(xt.dtype))


def setup_inputs(seed: int = 0) -> dict:
    key = jax.random.key(seed)
    ks = jax.random.split(key, 24)
    nrm = lambda k, shape, s: jax.random.normal(k, shape, jnp.float32) * s
    L = DEPTH
    return {
        "x": nrm(ks[0], (BATCH, SEQ, D_MODEL), 1.0),
        "p": nrm(ks[1], (DEPTH, BATCH, SEQ, PLE_DIM), 1.0),
        "positions": jnp.broadcast_to(jnp.arange(SEQ, dtype=jnp.int32), (BATCH, SEQ)),
        "g_mix_norm": 1.0 + nrm(ks[2], (L, D_MODEL), 0.02),
        "w_in": nrm(ks[3], (L, D_MODEL, D_IN), D_MODEL ** -0.5),
        "sb_q_gain": 1.0 + nrm(ks[4], (L, HEAD_DIM), 0.02),
        "sb_k_gain": 1.0 + nrm(ks[5], (L, HEAD_DIM), 0.02),
        "ret_q_gain": 1.0 + nrm(ks[6], (L, HEAD_DIM), 0.02),
        "ret_k_gain": 1.0 + nrm(ks[7], (L, HEAD_DIM), 0.02),
        "ret_gn_gain": 1.0 + nrm(ks[8], (L, RET_WIDTH), 0.02),
        "ret_gn_bias": nrm(ks[9], (L, RET_WIDTH), 0.02),
        "w_out": nrm(ks[10], (L, D_MIX, D_MODEL), D_MIX ** -0.5),
        "g_ffn_norm": 1.0 + nrm(ks[11], (L, D_MODEL), 0.02),
        "w_router": nrm(ks[12], (L, D_MODEL, N_EXPERTS), D_MODEL ** -0.5),
        "b_router": nrm(ks[13], (L, N_EXPERTS), 0.01),
        "w_up_gate": nrm(ks[14], (L, N_EXPERTS, D_MODEL, 2 * D_EXPERT), D_MODEL ** -0.5),
        "b_up_gate": nrm(ks[15], (L, N_EXPERTS, 2 * D_EXPERT), 0.02),
        "w_down": nrm(ks[16], (L, N_EXPERTS, D_EXPERT, D_MODEL), D_EXPERT ** -0.5),
        "b_down": nrm(ks[17], (L, N_EXPERTS, D_MODEL), 0.02),
        "g_ple_norm": 1.0 + nrm(ks[18], (L, D_MODEL), 0.02),
        "w_ple_gate": nrm(ks[19], (L, D_MODEL, D_MODEL), D_MODEL ** -0.5),
        "w_ple_proj": nrm(ks[20], (L, PLE_DIM, D_MODEL), PLE_DIM ** -0.5),
    }


def reference(x, p, positions, g_mix_norm, w_in, sb_q_gain, sb_k_gain, ret_q_gain, ret_k_gain,
              ret_gn_gain, ret_gn_bias, w_out, g_ffn_norm, w_router, b_router, w_up_gate, b_up_gate,
              w_down, b_down, g_ple_norm, w_ple_gate, w_ple_proj):
    b, s, d = x.shape
    for i in range(DEPTH):
        xn = _rmsnorm(x, g_mix_norm[i])
        proj = xn @ w_in[i]
        o = 0
        sb_q = proj[..., o:o + SB_WIDTH]; o += SB_WIDTH
        sb_k = proj[..., o:o + SB_WIDTH]; o += SB_WIDTH
        sb_v = proj[..., o:o + SB_WIDTH]; o += SB_WIDTH
        r_q = proj[..., o:o + RET_WIDTH]; o += RET_WIDTH
        r_k = proj[..., o:o + RET_WIDTH]; o += RET_WIDTH
        r_v = proj[..., o:o + RET_WIDTH]; o += RET_WIDTH
        r_g = proj[..., o:o + RET_WIDTH]
        q_a = _rmsnorm(_heads(sb_q, SB_HEADS), sb_q_gain[i])
        k_a = _rmsnorm(_heads(sb_k, SB_HEADS), sb_k_gain[i])
        y_a = _stick_breaking(q_a, k_a, _heads(sb_v, SB_HEADS))
        y_a = y_a.transpose(0, 2, 1, 3).reshape(b, s, SB_WIDTH)
        q_b = _rope(_rmsnorm(_heads(r_q, RET_HEADS), ret_q_gain[i]), positions)
        k_b = _rope(_rmsnorm(_heads(r_k, RET_HEADS), ret_k_gain[i]), positions) * (HEAD_DIM ** -0.5)
        y_b = _retention(q_b, k_b, _heads(r_v, RET_HEADS))
        y_b = _group_norm(y_b, ret_gn_gain[i], ret_gn_bias[i]) * jax.nn.silu(r_g)
        x = x + jnp.concatenate([y_a, y_b], axis=-1) @ w_out[i]
        hn = _rmsnorm(x, g_ffn_norm[i]).reshape(b * s, d)
        x = x + _moe(hn, w_router[i], b_router[i], w_up_gate[i], b_up_gate[i], w_down[i], b_down[i]).reshape(b, s, d)
        gate = jax.nn.sigmoid(_rmsnorm(x, g_ple_norm[i]) @ w_ple_gate[i])
        x = x + (p[i] @ w_ple_proj[i]) * gate
    return x
```

```cpp
#include <hip/hip_runtime.h>
#include <cstdint>
#include <cstdio>

namespace {
constexpr int BATCH = 8, SEQ = 2048, DM = 1024, T = BATCH * SEQ;
constexpr int DIN = 3584, NE = 32, TOPK = 4, DE = 1024, PLE = 256;
constexpr float EPS = 1e-6f;
constexpr size_t MiB = 1u << 20;
constexpr size_t WS_PROJ = 0;
constexpr size_t WS_XN = 224 * MiB;
constexpr size_t WS_YRAW = 288 * MiB;
constexpr size_t WS_Y = 320 * MiB;
constexpr size_t WS_HN = 384 * MiB;
constexpr size_t WS_TOKLIST = 448 * MiB;
constexpr size_t WS_TOKINFO = 450 * MiB;
constexpr size_t WS_CNT = 452 * MiB;
constexpr size_t WS_H = 512 * MiB;
constexpr size_t WS_YS = 768 * MiB;
constexpr size_t WS_X2N = 0;
constexpr size_t WS_GATE = 64 * MiB;

__device__ __forceinline__ float wave_sum(float v) {
#pragma unroll
  for (int o = 1; o < 64; o <<= 1) v += __shfl_xor(v, o);
  return v;
}

__global__ __launch_bounds__(256) void rmsnorm_rows(const float* __restrict__ x, const float* __restrict__ g, float* __restrict__ out) {
  const int row = blockIdx.x * 4 + (threadIdx.x >> 6), lane = threadIdx.x & 63;
  const float4* xr = (const float4*)(x + (size_t)row * DM);
  float4 v[4]; float s = 0.f;
#pragma unroll
  for (int j = 0; j < 4; ++j) { v[j] = xr[lane + 64 * j]; s += v[j].x * v[j].x + v[j].y * v[j].y + v[j].z * v[j].z + v[j].w * v[j].w; }
  const float rstd = rsqrtf(wave_sum(s) * (1.f / DM) + EPS);
  float4* orow = (float4*)(out + (size_t)row * DM);
#pragma unroll
  for (int j = 0; j < 4; ++j) { const float4 gg = ((const float4*)g)[lane + 64 * j];
    orow[lane + 64 * j] = make_float4(v[j].x * rstd * gg.x, v[j].y * rstd * gg.y, v[j].z * rstd * gg.z, v[j].w * rstd * gg.w); }
}

enum { EPI_STORE = 0, EPI_RESID = 1, EPI_SIGMOID = 2, EPI_PLE = 3, EPI_MOEUP = 4 };
struct GemmP {
  const float* A; int lda; const int* arow;
  const float* B; int ldb; long strideB;
  float* C; int ldc;
  const float* bias; long strideBias;
  const int* cnt; const int* off;
  int M, N, K;
  const float* R1; const float* R2;
};
template <int EPI> __global__ __launch_bounds__(256) void sgemm(GemmP p) {
  __shared__ float As[8][128 + 4];
  __shared__ float Bs[8][128 + 4];
  const int z = blockIdx.z;
  const int Mz = p.cnt ? p.cnt[z] : p.M;
  const int m0 = blockIdx.y * 128, pn = blockIdx.x;
  if (m0 >= Mz) return;
  const int roff = p.off ? p.off[z] : 0;
  const float* B = p.B + (size_t)z * p.strideB;
  const int tid = threadIdx.x, tx = tid & 15, ty = tid >> 4;
  const int ar = tid >> 1, ak = (tid & 1) * 4;
  int arow_g = m0 + ar; const bool avalid = arow_g < Mz; if (!avalid) arow_g = Mz - 1;
  const size_t arow_src = p.arow ? (size_t)p.arow[(size_t)z * T + arow_g] : (size_t)(roff + arow_g);
  const float* Ap = p.A + arow_src * p.lda + ak;
  const int bk = tid >> 5, bn = (tid & 31) * 4;
  int bcol;
  if (EPI == EPI_MOEUP) bcol = (bn < 64) ? pn * 64 + bn : 1024 + pn * 64 + (bn - 64);
  else bcol = pn * 128 + bn;
  const float* Bp = B + (size_t)bk * p.ldb + bcol;
  float acc[8][8];
#pragma unroll
  for (int i = 0; i < 8; ++i)
#pragma unroll
    for (int j = 0; j < 8; ++j) acc[i][j] = 0.f;
  for (int k0 = 0; k0 < p.K; k0 += 8) {
    const float4 av = *(const float4*)(Ap + k0);
    const float4 bv = *(const float4*)(Bp + (size_t)k0 * p.ldb);
    __syncthreads();
    As[ak + 0][ar] = av.x; As[ak + 1][ar] = av.y; As[ak + 2][ar] = av.z; As[ak + 3][ar] = av.w;
    *(float4*)&Bs[bk][bn] = bv;
    __syncthreads();
#pragma unroll
    for (int k = 0; k < 8; ++k) {
      const float4 a0 = *(const float4*)&As[k][ty * 4], a1 = *(const float4*)&As[k][64 + ty * 4];
      const float4 b0 = *(const float4*)&Bs[k][tx * 4], b1 = *(const float4*)&Bs[k][64 + tx * 4];
      const float a[8] = {a0.x, a0.y, a0.z, a0.w, a1.x, a1.y, a1.z, a1.w};
      const float b[8] = {b0.x, b0.y, b0.z, b0.w, b1.x, b1.y, b1.z, b1.w};
#pragma unroll
      for (int i = 0; i < 8; ++i)
#pragma unroll
        for (int j = 0; j < 8; ++j) acc[i][j] = fmaf(a[i], b[j], acc[i][j]);
    }
  }
#pragma unroll
  for (int i = 0; i < 8; ++i) {
    const int rl = m0 + (i < 4 ? ty * 4 + i : 64 + ty * 4 + (i - 4));
    if (rl >= Mz) continue;
    const size_t crow = (size_t)(roff + rl);
    if (EPI == EPI_MOEUP) {
      const float* bias = p.bias + (size_t)z * p.strideBias;
#pragma unroll
      for (int j = 0; j < 4; ++j) {
        const int c = pn * 64 + tx * 4 + j;
        float glu = acc[i][j] + bias[c], lin = acc[i][4 + j] + bias[1024 + c];
        glu = fminf(glu, 7.0f); lin = fminf(fmaxf(lin, -7.0f), 7.0f);
        const float sg = 1.f / (1.f + expf(-1.702f * glu));
        p.C[crow * p.ldc + c] = glu * sg * (lin + 1.0f);
      }
    } else {
#pragma unroll
      for (int j = 0; j < 8; ++j) {
        const int c = pn * 128 + (j < 4 ? tx * 4 + j : 64 + tx * 4 + (j - 4));
        float v = acc[i][j];
        if (p.bias) v += p.bias[(size_t)z * p.strideBias + c];
        const size_t idx = crow * p.ldc + c;
        if (EPI == EPI_RESID) v += p.R1[idx];
        if (EPI == EPI_SIGMOID) v = 1.f / (1.f + expf(-v));
        if (EPI == EPI_PLE) v = p.R1[idx] + v * p.R2[idx];
        p.C[idx] = v;
      }
    }
  }
}

__global__ __launch_bounds__(256) void headnorm_rope(float* proj, const int* __restrict__ positions, const float* __restrict__ gq, const float* __restrict__ gk,
                                                    const float* __restrict__ grq, const float* __restrict__ grk) {
  const int w = blockIdx.x * 4 + (threadIdx.x >> 6), lane = threadIdx.x & 63;
  const int row = w >> 5, slot = w & 31, region = slot >> 3, head = slot & 7;
  const int base = (region == 0 ? 0 : region == 1 ? 512 : region == 2 ? 1536 : 2048) + head * 64;
  const float* gain = region == 0 ? gq : region == 1 ? gk : region == 2 ? grq : grk;
  float* ptr = proj + (size_t)row * DIN + base + lane;
  const float v = *ptr;
  const float ss = wave_sum(v * v);
  float y = v * rsqrtf(ss * (1.f / 64.f) + EPS) * gain[lane];
  if (region >= 2) {
    const float partner = __shfl_xor(y, 32);
    const int i = lane & 31;
    const float inv_freq = powf(10000.0f, -(float)i / 32.0f);
    const float ang = (float)positions[row] * inv_freq;
    float sn, cs; sincosf(ang, &sn, &cs);
    y = (lane < 32) ? (y * cs - partner * sn) : (y * cs + partner * sn);
    if (region == 3) y *= 0.125f;
  }
  *ptr = y;
}

template <int MODE> __global__ __launch_bounds__(64) void attn_naive(const float* __restrict__ proj, float* __restrict__ out, int ldo, int ocol0) {
  const int bh = blockIdx.y, b = bh >> 3, h = bh & 7, q0 = blockIdx.x * 64, lane = threadIdx.x, q = q0 + lane;
  const int qoff = MODE == 0 ? 0 : 1536, koff = MODE == 0 ? 512 : 2048, voff = MODE == 0 ? 1024 : 2560;
  const float* base = proj + (size_t)b * SEQ * DIN + h * 64;
  float qv[64], o[64];
  const float qs = MODE == 0 ? 0.125f : 1.0f;
#pragma unroll
  for (int d = 0; d < 64; ++d) { qv[d] = base[(size_t)q * DIN + qoff + d] * qs; o[d] = 0.f; }
  const float gamma = 1.0f - exp2f(-5.0f - (float)h);
  float tail = 0.f;
  float coef = 1.f;
  const int kstart = MODE == 0 ? q0 + 62 : q0 + 63;
  for (int k = kstart; k >= 0; --k) {
    const float* kp = base + (size_t)k * DIN + koff;
    const float* vp = base + (size_t)k * DIN + voff;
    float z = 0.f;
#pragma unroll
    for (int d = 0; d < 64; ++d) z = fmaf(qv[d], kp[d], z);
    float w;
    if (MODE == 0) {
      const bool valid = k < q;
      const float sp = fmaxf(z, 0.f) + log1pf(expf(-fabsf(z)));
      w = valid ? expf(z - sp + tail) : 0.f;
      tail += valid ? -sp : 0.f;
    } else {
      const bool valid = k <= q;
      w = valid ? z * coef : 0.f;
      coef = valid ? coef * gamma : coef;
    }
#pragma unroll
    for (int d = 0; d < 64; ++d) o[d] = fmaf(w, vp[d], o[d]);
  }
  float* op = out + (size_t)(b * SEQ + q) * ldo + ocol0 + h * 64;
#pragma unroll
  for (int d = 0; d < 64; ++d) op[d] = o[d];
}

__global__ __launch_bounds__(256) void groupnorm_gate(const float* __restrict__ yraw, const float* __restrict__ proj, const float* __restrict__ gain, const float* __restrict__ bias, float* __restrict__ Y) {
  const int w = blockIdx.x * 4 + (threadIdx.x >> 6), lane = threadIdx.x & 63;
  const int row = w >> 3, h = w & 7;
  const float v = yraw[(size_t)row * 512 + h * 64 + lane];
  const float mu = wave_sum(v) * (1.f / 64.f);
  const float d = v - mu;
  const float var = wave_sum(d * d) * (1.f / 64.f);
  const float yn = d * rsqrtf(var + EPS) * gain[h * 64 + lane] + bias[h * 64 + lane];
  const float g = proj[(size_t)row * DIN + 3072 + h * 64 + lane];
  Y[(size_t)row * DM + 512 + h * 64 + lane] = yn * (g / (1.f + expf(-g)));
}

__global__ __launch_bounds__(256) void router(const float* __restrict__ x1, const float* __restrict__ g, const float* __restrict__ wr, const float* __restrict__ br,
                                             float* __restrict__ hn, int* cnt, int* toklist, int* tok_e, int* tok_slot, float* tok_gate) {
  const int row = blockIdx.x * 4 + (threadIdx.x >> 6), lane = threadIdx.x & 63;
  const float* xr = x1 + (size_t)row * DM;
  float v[16]; float s = 0.f;
#pragma unroll
  for (int i = 0; i < 16; ++i) { v[i] = xr[lane + 64 * i]; s += v[i] * v[i]; }
  const float rstd = rsqrtf(wave_sum(s) * (1.f / DM) + EPS);
  float lg[32];
#pragma unroll
  for (int e = 0; e < 32; ++e) lg[e] = 0.f;
#pragma unroll
  for (int i = 0; i < 16; ++i) {
    const int c = lane + 64 * i;
    v[i] = v[i] * rstd * g[c];
    hn[(size_t)row * DM + c] = v[i];
    const float4* wrow = (const float4*)(wr + (size_t)c * NE);
#pragma unroll
    for (int e4 = 0; e4 < 8; ++e4) { const float4 w4 = wrow[e4];
      lg[e4 * 4 + 0] = fmaf(v[i], w4.x, lg[e4 * 4 + 0]); lg[e4 * 4 + 1] = fmaf(v[i], w4.y, lg[e4 * 4 + 1]);
      lg[e4 * 4 + 2] = fmaf(v[i], w4.z, lg[e4 * 4 + 2]); lg[e4 * 4 + 3] = fmaf(v[i], w4.w, lg[e4 * 4 + 3]); }
  }
#pragma unroll
  for (int e = 0; e < 32; ++e) lg[e] = wave_sum(lg[e]) + br[e];
  int idx[4]; float val[4];
  unsigned taken = 0u;
#pragma unroll
  for (int k = 0; k < 4; ++k) {
    float best = -INFINITY; int bi = 0;
#pragma unroll
    for (int e = 0; e < 32; ++e) { const bool ok = !((taken >> e) & 1u) && lg[e] > best; best = ok ? lg[e] : best; bi = ok ? e : bi; }
    idx[k] = bi; val[k] = best; taken |= 1u << bi;
  }
  const float mx = val[0];
  float ex[4], sum = 0.f;
#pragma unroll
  for (int k = 0; k < 4; ++k) { ex[k] = expf(val[k] - mx); sum += ex[k]; }
  if (lane == 0) {
#pragma unroll
    for (int k = 0; k < 4; ++k) {
      const int e = idx[k];
      const int slot = atomicAdd(&cnt[e], 1);
      toklist[(size_t)e * T + slot] = row;
      tok_e[row * 4 + k] = e; tok_slot[row * 4 + k] = slot; tok_gate[row * 4 + k] = ex[k] / sum;
    }
  }
}
__global__ void offsets_kernel(const int* cnt, int* off) {
  if (threadIdx.x == 0) { int s = 0; for (int e = 0; e < 32; ++e) { off[e] = s; s += cnt[e]; } }
}
__global__ __launch_bounds__(256) void combine(float* x  , const float* __restrict__ ys, const int* __restrict__ off, const int* __restrict__ tok_e, const int* __restrict__ tok_slot,
                                              const float* __restrict__ tok_gate, const float* __restrict__ g, float* __restrict__ x2n) {
  const int row = blockIdx.x * 4 + (threadIdx.x >> 6), lane = threadIdx.x & 63;
  float4* xr = (float4*)(x + (size_t)row * DM);
  float4 v[4];
#pragma unroll
  for (int j = 0; j < 4; ++j) v[j] = xr[lane + 64 * j];
#pragma unroll
  for (int k = 0; k < 4; ++k) {
    const int e = tok_e[row * 4 + k], slot = tok_slot[row * 4 + k]; const float gt = tok_gate[row * 4 + k];
    const float4* yr = (const float4*)(ys + (size_t)(off[e] + slot) * DM);
#pragma unroll
    for (int j = 0; j < 4; ++j) { const float4 y = yr[lane + 64 * j]; v[j].x += gt * y.x; v[j].y += gt * y.y; v[j].z += gt * y.z; v[j].w += gt * y.w; }
  }
  float s = 0.f;
#pragma unroll
  for (int j = 0; j < 4; ++j) s += v[j].x * v[j].x + v[j].y * v[j].y + v[j].z * v[j].z + v[j].w * v[j].w;
  const float rstd = rsqrtf(wave_sum(s) * (1.f / DM) + EPS);
  float4* nr = (float4*)(x2n + (size_t)row * DM);
#pragma unroll
  for (int j = 0; j < 4; ++j) { xr[lane + 64 * j] = v[j]; const float4 gg = ((const float4*)g)[lane + 64 * j];
    nr[lane + 64 * j] = make_float4(v[j].x * rstd * gg.x, v[j].y * rstd * gg.y, v[j].z * rstd * gg.z, v[j].w * rstd * gg.w); }
}
}

extern "C" void kernel_launch(void* const* d_in, const int* in_sizes, int n_in, void* d_out, int out_size, void* d_ws, size_t ws_size, hipStream_t stream) {
  const float* x = (const float*)d_in[0]; const float* pin = (const float*)d_in[1]; const int* positions = (const int*)d_in[2];
  const float* g_mix = (const float*)d_in[3]; const float* w_in = (const float*)d_in[4];
  const float* sbq = (const float*)d_in[5]; const float* sbk = (const float*)d_in[6]; const float* rq = (const float*)d_in[7]; const float* rk = (const float*)d_in[8];
  const float* gn_g = (const float*)d_in[9]; const float* gn_b = (const float*)d_in[10]; const float* w_out = (const float*)d_in[11];
  const float* g_ffn = (const float*)d_in[12]; const float* w_r = (const float*)d_in[13]; const float* b_r = (const float*)d_in[14];
  const float* w_ug = (const float*)d_in[15]; const float* b_ug = (const float*)d_in[16]; const float* w_dn = (const float*)d_in[17]; const float* b_dn = (const float*)d_in[18];
  const float* g_ple = (const float*)d_in[19]; const float* w_pg = (const float*)d_in[20]; const float* w_pp = (const float*)d_in[21];
  float* out = (float*)d_out; char* ws = (char*)d_ws;
  float* proj = (float*)(ws + WS_PROJ); float* xn = (float*)(ws + WS_XN); float* yraw = (float*)(ws + WS_YRAW); float* Y = (float*)(ws + WS_Y);
  float* hn = (float*)(ws + WS_HN); int* toklist = (int*)(ws + WS_TOKLIST);
  int* tok_e = (int*)(ws + WS_TOKINFO); int* tok_slot = tok_e + T * 4; float* tok_gate = (float*)(tok_slot + T * 4);
  int* cnt = (int*)(ws + WS_CNT); int* off = cnt + 64;
  float* H = (float*)(ws + WS_H); float* YS = (float*)(ws + WS_YS); float* x2n = (float*)(ws + WS_X2N); float* gate = (float*)(ws + WS_GATE);
  if (ws_size < 1024 * MiB) { fprintf(stderr, "workspace too small: %zu\n", ws_size); return; }

  hipMemsetAsync(cnt, 0, 1024, stream);
  rmsnorm_rows<<<T / 4, 256, 0, stream>>>(x, g_mix, xn);
  { GemmP p{}; p.A = xn; p.lda = DM; p.B = w_in; p.ldb = DIN; p.C = proj; p.ldc = DIN; p.M = T; p.N = DIN; p.K = DM;
    sgemm<EPI_STORE><<<dim3(DIN / 128, T / 128, 1), 256, 0, stream>>>(p); }
  headnorm_rope<<<T * 32 / 4, 256, 0, stream>>>(proj, positions, sbq, sbk, rq, rk);
  attn_naive<0><<<dim3(SEQ / 64, 64), 64, 0, stream>>>(proj, Y, DM, 0);
  attn_naive<1><<<dim3(SEQ / 64, 64), 64, 0, stream>>>(proj, yraw, 512, 0);
  groupnorm_gate<<<T * 8 / 4, 256, 0, stream>>>(yraw, proj, gn_g, gn_b, Y);
  { GemmP p{}; p.A = Y; p.lda = DM; p.B = w_out; p.ldb = DM; p.C = out; p.ldc = DM; p.M = T; p.N = DM; p.K = DM; p.R1 = x;
    sgemm<EPI_RESID><<<dim3(DM / 128, T / 128, 1), 256, 0, stream>>>(p); }
  router<<<T / 4, 256, 0, stream>>>(out, g_ffn, w_r, b_r, hn, cnt, toklist, tok_e, tok_slot, tok_gate);
  offsets_kernel<<<1, 64, 0, stream>>>(cnt, off);
  { GemmP p{}; p.A = hn; p.lda = DM; p.arow = toklist; p.B = w_ug; p.ldb = 2 * DE; p.strideB = (long)DM * 2 * DE; p.C = H; p.ldc = DE;
    p.bias = b_ug; p.strideBias = 2 * DE; p.cnt = cnt; p.off = off; p.M = T; p.N = DE; p.K = DM;
    sgemm<EPI_MOEUP><<<dim3(DE / 64, T / 128, NE), 256, 0, stream>>>(p); }
  { GemmP p{}; p.A = H; p.lda = DE; p.B = w_dn; p.ldb = DM; p.strideB = (long)DE * DM; p.C = YS; p.ldc = DM;
    p.bias = b_dn; p.strideBias = DM; p.cnt = cnt; p.off = off; p.M = T; p.N = DM; p.K = DE;
    sgemm<EPI_STORE><<<dim3(DM / 128, T / 128, NE), 256, 0, stream>>>(p); }
  combine<<<T / 4, 256, 0, stream>>>(out, YS, off, tok_e, tok_slot, tok_gate, g_ple, x2n);
  { GemmP p{}; p.A = x2n; p.lda = DM; p.B = w_pg; p.ldb = DM; p.C = gate; p.ldc = DM; p.M = T; p.N = DM; p.K = DM;
    sgemm<EPI_SIGMOID><<<dim3(DM / 128, T / 128, 1), 256, 0, stream>>>(p); }
  { GemmP p{}; p.A = pin; p.lda = PLE; p.B = w_pp; p.ldb = DM; p.C = out; p.ldc = DM; p.M = T; p.N = DM; p.K = PLE; p.R1 = out; p.R2 = gate;
    sgemm<EPI_PLE><<<dim3(DM / 128, T / 128, 1), 256, 0, stream>>>(p); }
}
```

```cpp
#include <hip/hip_runtime.h>
#include <cstdint>
#include <cstdio>
#include <cmath>

namespace pg8 {
#define PG8_LAS __attribute__((address_space(3)))
typedef unsigned short bf16_t;
typedef short bf16x8 __attribute__((ext_vector_type(8)));
typedef float f32x4 __attribute__((ext_vector_type(4)));
typedef unsigned u32x4 __attribute__((ext_vector_type(4)));
typedef unsigned u32x2 __attribute__((ext_vector_type(2)));
constexpr int BM = 256, BK = 64, HALF = 128, HTB = HALF * BK * 2  , STAGE_BYTES = 8 * HTB, NXCD = 8, WGM = 8;

__host__ __device__ __forceinline__ int lds_byte(int r, int c) { const int st = (r >> 4) * 2 + (c >> 5), rr = r & 15, cc = c & 31, ob = rr * 64 + cc * 2; return st * 1024 + (ob ^ (((ob >> 9) & 1) << 5)); }
__host__ __device__ __forceinline__ void stage_rc(int b, int& R, int& C) { const int st = b / 1024, sb = b % 1024, swz = sb ^ (((sb >> 9) & 1) << 5); R = (st >> 1) * 16 + swz / 64; C = (st & 1) * 32 + (swz % 64) / 2; }
__host__ __device__ __forceinline__ int perm32(int rho) { const int n = rho >> 4, i = rho & 15; return 8 * (i >> 2) + 4 * n + (i & 3); }

struct Unit { int pm, pn, e; };
struct Gemm { const bf16_t* A; const bf16_t* Bt; int K; size_t strideBe; };

struct StaticOrder {
    int nM, nN, nwg, G, c;
    __host__ __device__ void init(int nM_, int nN_, int G_, int c_) { nM = nM_; nN = nN_; nwg = nM * nN; G = G_; c = c_; }
    __host__ __device__ bool next(int i, Unit& u) const {
        const long L = (long)i * G + c; if (L >= nwg) return false;
        int wgid = (int)L; { const int q = nwg / NXCD, r = nwg % NXCD, xcd = wgid % NXCD, off = wgid / NXCD; wgid = (xcd < r ? xcd * (q + 1) : r * (q + 1) + (xcd - r) * q) + off; }
        const int nig = WGM * nN, gid = wgid / nig, fm = gid * WGM, gsz = (nM - fm) < WGM ? (nM - fm) : WGM;
        u.pm = fm + ((wgid % nig) % gsz); u.pn = (wgid % nig) / gsz; u.e = 0; return true;
    }
    __device__ __forceinline__ void a_ready(const Unit&) const {}
    __device__ __forceinline__ void done(const Unit&) const {}
};

typedef float f32x2_t __attribute__((ext_vector_type(2))); typedef __bf16 bf16x2_t __attribute__((ext_vector_type(2)));
__device__ __forceinline__ unsigned cvt_pk_bf16(float lo, float hi) { f32x2_t v = {lo, hi}; bf16x2_t b = __builtin_convertvector(v, bf16x2_t); return __builtin_bit_cast(unsigned, b); }

constexpr int T = 16384, SEQ = 2048, DM = 1024, DIN = 3584;
constexpr float EPS = 1e-6f;
__device__ __forceinline__ u32x4 pack8(const f32x4 a, const f32x4 b) { u32x4 w; w.x = cvt_pk_bf16(a[0], a[1]); w.y = cvt_pk_bf16(a[2], a[3]); w.z = cvt_pk_bf16(b[0], b[1]); w.w = cvt_pk_bf16(b[2], b[3]); return w; }

struct EpiProj {
    static constexpr bool PERM = true, AFTER_DRAIN = false;
    bf16_t* hm;
    bf16_t* rg;
    const float* gains;
    const float *ropec, *ropes;
    __device__ __forceinline__ void operator()(const f32x4 (&acc)[2][2][4][2], const Unit& u, int wr, int wc, int fr, int fq) const {
        const int region = u.pn >> 1, hb = 4 * (u.pn & 1) + wc;
        const bool normed = (region == 0) || (region == 1) || (region == 3) || (region == 4);
        const bool rope = (region == 3) || (region == 4);
        const int gidx = region == 0 ? 0 : region == 1 ? 1 : region == 3 ? 2 : 3;
        const float* gp = gains + gidx * 64;
        f32x4 gv[2][2];
#pragma unroll
        for (int bj = 0; bj < 2; ++bj)
#pragma unroll
            for (int n = 0; n < 2; ++n) gv[bj][n] = normed ? *(const f32x4*)(gp + 32 * bj + 8 * fq + 4 * n) : (f32x4){1.f, 1.f, 1.f, 1.f};
        const float lg2g = __log2f(1.0f - __builtin_amdgcn_exp2f(-5.0f - (float)hb));
        const float scale = region == 0 ? 0.125f * 1.4426950408889634f : region == 4 ? 0.125f : 1.0f;
#pragma unroll
        for (int ai = 0; ai < 2; ++ai)
#pragma unroll
            for (int m = 0; m < 4; ++m) {
                const int row = u.pm * BM + ai * HALF + wr * 64 + m * 16 + fr;
                const int b = row >> 11, s = row & (SEQ - 1);
                f32x4 v[2][2];
#pragma unroll
                for (int bj = 0; bj < 2; ++bj)
#pragma unroll
                    for (int n = 0; n < 2; ++n) v[bj][n] = acc[ai][bj][m][n];
                if (normed) {
                    float ss = 0.f;
#pragma unroll
                    for (int bj = 0; bj < 2; ++bj)
#pragma unroll
                        for (int n = 0; n < 2; ++n) { const f32x4 x = v[bj][n]; ss += (x[0] * x[0] + x[1] * x[1]) + (x[2] * x[2] + x[3] * x[3]); }
                    ss += __shfl_xor(ss, 16); ss += __shfl_xor(ss, 32);
                    float rs = rsqrtf(ss * (1.0f / 64.0f) + EPS) * scale;
                    if (rope) rs *= (region == 3) ? __builtin_amdgcn_exp2f((float)(s & 31) * lg2g) : __builtin_amdgcn_exp2f(-(float)(s & 63) * lg2g);
#pragma unroll
                    for (int bj = 0; bj < 2; ++bj)
#pragma unroll
                        for (int n = 0; n < 2; ++n) v[bj][n] = v[bj][n] * rs * gv[bj][n];
                    if (rope) {
#pragma unroll
                        for (int n = 0; n < 2; ++n) {
                            const f32x4 c = *(const f32x4*)(ropec + (size_t)row * 32 + 8 * fq + 4 * n), sn = *(const f32x4*)(ropes + (size_t)row * 32 + 8 * fq + 4 * n);
                            const f32x4 lo = v[0][n], hi = v[1][n];
                            v[0][n] = lo * c - hi * sn; v[1][n] = hi * c + lo * sn;
                        }
                    }
                }
                bf16_t* dst = (region < 6) ? hm + (size_t)region * ((size_t)T * 512) + ((size_t)(b * 8 + hb) * SEQ + s) * 64 + 8 * fq
                                           : rg + (size_t)row * 512 + hb * 64 + 8 * fq;
#pragma unroll
                for (int bj = 0; bj < 2; ++bj) *(u32x4*)(dst + 32 * bj) = pack8(v[bj][0], v[bj][1]);
            }
    }
};

struct EpiBf16Plain {
    static constexpr bool PERM = true, AFTER_DRAIN = false;
    bf16_t* O; int ldc;
    __device__ __forceinline__ void operator()(const f32x4 (&acc)[2][2][4][2], const Unit& u, int wr, int wc, int fr, int fq) const {
        const int row0 = u.pm * BM + wr * 64 + fr, col0 = u.pn * BM + wc * 32 + 8 * fq;
#pragma unroll
        for (int ai = 0; ai < 2; ++ai)
#pragma unroll
            for (int m = 0; m < 4; ++m) { bf16_t* rowp = O + (size_t)(row0 + ai * HALF + m * 16) * ldc + col0;
#pragma unroll
                for (int bj = 0; bj < 2; ++bj) *(u32x4*)(rowp + bj * HALF) = pack8(acc[ai][bj][m][0], acc[ai][bj][m][1]); }
    }
};
struct EpiResid {
    static constexpr bool PERM = false, AFTER_DRAIN = false;
    const float* base; float* out;
    __device__ __forceinline__ void operator()(const f32x4 (&acc)[2][2][4][2], const Unit& u, int wr, int wc, int fr, int fq) const {
        const int col0 = u.pn * BM + wc * 32 + 4 * fq;
#pragma unroll
        for (int ai = 0; ai < 2; ++ai)
#pragma unroll
            for (int m = 0; m < 4; ++m) { const size_t off = (size_t)(u.pm * BM + ai * HALF + wr * 64 + m * 16 + fr) * DM + col0;
#pragma unroll
                for (int bj = 0; bj < 2; ++bj)
#pragma unroll
                    for (int n = 0; n < 2; ++n) { const f32x4 bs = *(const f32x4*)(base + off + bj * HALF + n * 16); *(f32x4*)(out + off + bj * HALF + n * 16) = bs + acc[ai][bj][m][n]; } }
    }
};
struct EpiMoeUp {
    static constexpr bool PERM = true, AFTER_DRAIN = false;
    bf16_t* H; const float* bias;
    __device__ __forceinline__ void operator()(const f32x4 (&acc)[2][2][4][2], const Unit& u, int wr, int wc, int fr, int fq) const {
        const int cc = 128 * u.pn + 32 * wc + 8 * fq;
        const float* bp = bias + (size_t)u.e * 2048 + cc;
        f32x4 bg[2], bl[2];
#pragma unroll
        for (int n = 0; n < 2; ++n) { bg[n] = *(const f32x4*)(bp + 4 * n); bl[n] = *(const f32x4*)(bp + 1024 + 4 * n); }
#pragma unroll
        for (int ai = 0; ai < 2; ++ai)
#pragma unroll
            for (int m = 0; m < 4; ++m) {
                f32x4 hv[2];
#pragma unroll
                for (int n = 0; n < 2; ++n) {
                    const f32x4 g0 = acc[ai][0][m][n] + bg[n], l0 = acc[ai][1][m][n] + bl[n];
#pragma unroll
                    for (int j = 0; j < 4; ++j) {
                        const float glu = __builtin_fminf(g0[j], 7.0f), lin = __builtin_fminf(__builtin_fmaxf(l0[j], -7.0f), 7.0f);
                        const float sg = __builtin_amdgcn_rcpf(1.0f + __builtin_amdgcn_exp2f(-1.702f * 1.4426950408889634f * glu));
                        hv[n][j] = glu * sg * (lin + 1.0f);
                    }
                }
                *(u32x4*)(H + (size_t)(u.pm * BM + ai * HALF + wr * 64 + m * 16 + fr) * 1024 + cc) = pack8(hv[0], hv[1]);
            }
    }
};
struct EpiMoeDown {
    static constexpr bool PERM = true, AFTER_DRAIN = false;
    bf16_t* YS; const float* bias;
    __device__ __forceinline__ void operator()(const f32x4 (&acc)[2][2][4][2], const Unit& u, int wr, int wc, int fr, int fq) const {
        const int col0 = u.pn * BM + wc * 32 + 8 * fq;
        f32x4 bv[2][2];
#pragma unroll
        for (int bj = 0; bj < 2; ++bj)
#pragma unroll
            for (int n = 0; n < 2; ++n) bv[bj][n] = *(const f32x4*)(bias + (size_t)u.e * 1024 + col0 + bj * HALF + 4 * n);
#pragma unroll
        for (int ai = 0; ai < 2; ++ai)
#pragma unroll
            for (int m = 0; m < 4; ++m) { bf16_t* rowp = YS + (size_t)(u.pm * BM + ai * HALF + wr * 64 + m * 16 + fr) * 1024 + col0;
#pragma unroll
                for (int bj = 0; bj < 2; ++bj) *(u32x4*)(rowp + bj * HALF) = pack8(acc[ai][bj][m][0] + bv[bj][0], acc[ai][bj][m][1] + bv[bj][1]); }
    }
};
struct EpiPle {
    static constexpr bool PERM = false, AFTER_DRAIN = false;
    float* out; const bf16_t* PJ;
    __device__ __forceinline__ void operator()(const f32x4 (&acc)[2][2][4][2], const Unit& u, int wr, int wc, int fr, int fq) const {
        const int col0 = u.pn * BM + wc * 32 + 4 * fq;
#pragma unroll
        for (int ai = 0; ai < 2; ++ai)
#pragma unroll
            for (int m = 0; m < 4; ++m) { const size_t off = (size_t)(u.pm * BM + ai * HALF + wr * 64 + m * 16 + fr) * DM + col0;
#pragma unroll
                for (int bj = 0; bj < 2; ++bj)
#pragma unroll
                    for (int n = 0; n < 2; ++n) {
                        const size_t o2 = off + bj * HALF + n * 16;
                        const f32x4 x2 = *(const f32x4*)(out + o2); const u32x2 pj = *(const u32x2*)(PJ + o2); const f32x4 a = acc[ai][bj][m][n];
                        f32x4 r;
                        r[0] = x2[0] + __uint_as_float(pj.x << 16) * __builtin_amdgcn_rcpf(1.0f + __builtin_amdgcn_exp2f(-1.4426950408889634f * a[0]));
                        r[1] = x2[1] + __uint_as_float(pj.x & 0xffff0000u) * __builtin_amdgcn_rcpf(1.0f + __builtin_amdgcn_exp2f(-1.4426950408889634f * a[1]));
                        r[2] = x2[2] + __uint_as_float(pj.y << 16) * __builtin_amdgcn_rcpf(1.0f + __builtin_amdgcn_exp2f(-1.4426950408889634f * a[2]));
                        r[3] = x2[3] + __uint_as_float(pj.y & 0xffff0000u) * __builtin_amdgcn_rcpf(1.0f + __builtin_amdgcn_exp2f(-1.4426950408889634f * a[3]));
                        *(f32x4*)(out + o2) = r;
                    } }
    }
};
struct MoeOrder {
    int nM, nN, nwg, G, c; const PG8_LAS int* tile_e;
    __device__ void init(int nM_, int nN_, int G_, int c_, const PG8_LAS int* te) { nM = nM_; nN = nN_; nwg = nM * nN; G = G_; c = c_; tile_e = te; }
    __device__ bool next(int i, Unit& u) const {
        const long L = (long)i * G + c; if (L >= nwg) return false;
        int wgid = (int)L; { const int q = nwg / NXCD, r = nwg % NXCD, xcd = wgid % NXCD, off = wgid / NXCD; wgid = (xcd < r ? xcd * (q + 1) : r * (q + 1) + (xcd - r) * q) + off; }
        const int nig = WGM * nN, gid = wgid / nig, fm = gid * WGM, gsz = (nM - fm) < WGM ? (nM - fm) : WGM;
        u.pm = fm + ((wgid % nig) % gsz); u.pn = (wgid % nig) / gsz; u.e = __builtin_amdgcn_readfirstlane(tile_e[u.pm]); return true;
    }
    __device__ __forceinline__ void a_ready(const Unit&) const {}
    __device__ __forceinline__ void done(const Unit&) const {}
};
template <class Epi, class Sched, bool ALIGN_EPI = false, bool SP2 = false>
__device__ __forceinline__ void gemm_phase(PG8_LAS unsigned char* lds, const Gemm g, const Sched& S, const Epi& E) {
    int tid_ = threadIdx.x; asm volatile("" : "+v"(tid_));
    const int tid = tid_, wid = __builtin_amdgcn_readfirstlane(tid >> 6), lane = tid & 63, wr = wid >> 2, wc = wid & 3, fr = lane & 15, fq = lane >> 4;
    const int K = g.K, nt = K / BK;
    unsigned voffA[2], voffB[2];
#pragma unroll
    for (int i = 0; i < 2; ++i) { int R, C; stage_rc(tid * 16 + i * 8192, R, C); const int Rb = Epi::PERM ? ((R & ~31) + perm32(R & 31)) : R;
        voffA[i] = (unsigned)(R * K + C) * 2u; voffB[i] = (unsigned)(Rb * K + C) * 2u; }
    const size_t kstep = (size_t)(BK * 2);
    const size_t hstep = (size_t)HALF * K * 2;
    const size_t tstep = 2 * hstep;
    const unsigned ldsw = (unsigned)wid * 1024u;
    const int aoff = lds_byte(wr * 64 + fr, fq * 8), boff = lds_byte(wc * 32 + fr, fq * 8);
#define PG8_SA(b, h) (((b) * 2 + (h)) * HTB)
#define PG8_SB(b, h) ((4 + (b) * 2 + (h)) * HTB)
#define PG8_STAGE(bufoff, gbase, voff) do { _Pragma("unroll") for (int _i = 0; _i < 2; ++_i) \
        __builtin_amdgcn_global_load_lds((const unsigned*)((const char*)(gbase) + (voff)[_i]), (PG8_LAS unsigned*)(lds + (bufoff) + ldsw + _i * 8192), 16, 0, 0); } while (0)
#define PG8_LDA(dst, b, h) do { _Pragma("unroll") for (int m = 0; m < 4; ++m) _Pragma("unroll") for (int k = 0; k < 2; ++k) dst[m][k] = *(const PG8_LAS bf16x8*)(lds + PG8_SA(b, h) + aoff + m * 2048 + k * 1024); } while (0)
#define PG8_LDB(dst, b, h) do { _Pragma("unroll") for (int n = 0; n < 2; ++n) _Pragma("unroll") for (int k = 0; k < 2; ++k) dst[n][k] = *(const PG8_LAS bf16x8*)(lds + PG8_SB(b, h) + boff + n * 2048 + k * 1024); } while (0)
#define PG8_MMA(ai, bj, At, Bt) do { __builtin_amdgcn_s_setprio(1); _Pragma("unroll") for (int m = 0; m < 4; ++m) _Pragma("unroll") for (int n = 0; n < 2; ++n) _Pragma("unroll") for (int k = 0; k < 2; ++k) \
        acc[ai][bj][m][n] = __builtin_amdgcn_mfma_f32_16x16x32_bf16(Bt[n][k], At[m][k], acc[ai][bj][m][n], 0, 0, 0); __builtin_amdgcn_s_setprio(0); } while (0)
#define PG8_WAIT_V(n) asm volatile("s_waitcnt vmcnt(" #n ")" ::: "memory")
#define PG8_WAIT_L(n) asm volatile("s_waitcnt lgkmcnt(" #n ")" ::: "memory")
#define PG8_BAR __builtin_amdgcn_s_barrier()
#define PG8_SCHED __builtin_amdgcn_sched_barrier(0)
    Unit cur, nxt; int ui = 0;
    if (!S.next(0, cur)) return;
    f32x4 acc[2][2][4][2];
#pragma unroll
    for (int a = 0; a < 2; ++a)
#pragma unroll
        for (int b = 0; b < 2; ++b)
#pragma unroll
            for (int m = 0; m < 4; ++m)
#pragma unroll
                for (int n = 0; n < 2; ++n) acc[a][b][m][n] = (f32x4){0.f, 0.f, 0.f, 0.f};
    bf16x8 At[4][2], B0[2][2], B1[2][2];
    const char* cA = (const char*)g.A + (size_t)cur.pm * tstep; const char* cB = (const char*)g.Bt + (size_t)cur.e * g.strideBe + (size_t)cur.pn * tstep;
    S.a_ready(cur);
    if constexpr (SP2) {
        PG8_STAGE(PG8_SB(0, 0), cB, voffB); PG8_STAGE(PG8_SB(0, 1), cB + hstep, voffB); PG8_STAGE(PG8_SA(0, 0), cA, voffA); PG8_STAGE(PG8_SA(0, 1), cA + hstep, voffA);
        if (wr == 1) PG8_BAR;
        PG8_WAIT_V(2); PG8_BAR;
        PG8_STAGE(PG8_SB(1, 0), cB + kstep, voffB); PG8_STAGE(PG8_SA(1, 0), cA + kstep, voffA); PG8_STAGE(PG8_SB(1, 1), cB + hstep + kstep, voffB);
        PG8_WAIT_V(6); PG8_BAR;
    } else {
        PG8_STAGE(PG8_SB(0, 0), cB, voffB); PG8_STAGE(PG8_SA(0, 0), cA, voffA); PG8_STAGE(PG8_SB(0, 1), cB + hstep, voffB); PG8_STAGE(PG8_SA(0, 1), cA + hstep, voffA);
        if (wr == 1) PG8_BAR;
        PG8_WAIT_V(4); PG8_BAR;
        PG8_STAGE(PG8_SB(1, 0), cB + kstep, voffB); PG8_STAGE(PG8_SA(1, 0), cA + kstep, voffA); PG8_STAGE(PG8_SB(1, 1), cB + hstep + kstep, voffB);
        PG8_WAIT_V(6); PG8_BAR;
    }
    for (;;) {
        const bool has_next = S.next(ui + 1, nxt);
        const char* nA = has_next ? (const char*)g.A + (size_t)nxt.pm * tstep : cA; const char* nB = has_next ? (const char*)g.Bt + (size_t)nxt.e * g.strideBe + (size_t)nxt.pn * tstep : cB;
#pragma unroll 1
        for (int t = 0; t < nt; t += 2) {
            const bool last = (t == nt - 2);
            const char* a1 = cA + (size_t)(t + 1) * kstep;
            const char* a2 = last ? nA : cA + (size_t)(t + 2) * kstep; const char* b2 = last ? nB : cB + (size_t)(t + 2) * kstep;
            const char* a3 = a2 + kstep; const char* b3 = b2 + kstep;
            if (last && has_next) S.a_ready(nxt);
            if constexpr (SP2) {
            PG8_LDB(B0, 0, 0); PG8_LDB(B1, 0, 1); PG8_SCHED; PG8_LDA(At, 0, 0); PG8_STAGE(PG8_SA(1, 1), a1 + hstep, voffA);
            PG8_WAIT_V(8); PG8_WAIT_L(0); PG8_BAR; PG8_MMA(0, 0, At, B0); PG8_MMA(0, 1, At, B1); PG8_BAR; PG8_SCHED;
            PG8_LDA(At, 0, 1); PG8_STAGE(PG8_SB(0, 0), b2, voffB); PG8_STAGE(PG8_SB(0, 1), b2 + hstep, voffB); PG8_STAGE(PG8_SA(0, 0), a2, voffA);
            PG8_WAIT_V(8); PG8_WAIT_L(0); PG8_BAR; PG8_MMA(1, 0, At, B0); PG8_MMA(1, 1, At, B1); PG8_BAR; PG8_SCHED;
            PG8_LDB(B0, 1, 0); PG8_LDB(B1, 1, 1); PG8_SCHED; PG8_LDA(At, 1, 0); PG8_STAGE(PG8_SA(0, 1), a2 + hstep, voffA);
            PG8_WAIT_V(8); PG8_WAIT_L(0); PG8_BAR; PG8_MMA(0, 0, At, B0); PG8_MMA(0, 1, At, B1); PG8_BAR; PG8_SCHED;
            PG8_LDA(At, 1, 1); PG8_STAGE(PG8_SB(1, 0), b3, voffB); PG8_STAGE(PG8_SB(1, 1), b3 + hstep, voffB); PG8_STAGE(PG8_SA(1, 0), a3, voffA);
            PG8_WAIT_V(8); PG8_WAIT_L(0); PG8_BAR; PG8_MMA(1, 0, At, B0); PG8_MMA(1, 1, At, B1); PG8_BAR; PG8_SCHED;
            } else {
            PG8_LDB(B0, 0, 0); PG8_SCHED; PG8_LDA(At, 0, 0); PG8_STAGE(PG8_SA(1, 1), a1 + hstep, voffA);
            PG8_WAIT_L(8); PG8_BAR; PG8_WAIT_L(0); PG8_MMA(0, 0, At, B0); PG8_BAR; PG8_SCHED;
            PG8_LDB(B1, 0, 1); PG8_STAGE(PG8_SB(0, 0), b2, voffB);
            PG8_BAR; PG8_WAIT_L(0); PG8_MMA(0, 1, At, B1); PG8_BAR;
            PG8_LDA(At, 0, 1); PG8_STAGE(PG8_SA(0, 0), a2, voffA);
            PG8_BAR; PG8_WAIT_L(0); PG8_MMA(1, 0, At, B0); PG8_BAR; PG8_SCHED;
            PG8_STAGE(PG8_SB(0, 1), b2 + hstep, voffB);
            PG8_WAIT_V(6); PG8_BAR; PG8_MMA(1, 1, At, B1); PG8_BAR;
            PG8_LDB(B0, 1, 0); PG8_SCHED; PG8_LDA(At, 1, 0); PG8_STAGE(PG8_SA(0, 1), a2 + hstep, voffA);
            PG8_WAIT_L(8); PG8_BAR; PG8_WAIT_L(0); PG8_MMA(0, 0, At, B0); PG8_BAR; PG8_SCHED;
            PG8_LDB(B1, 1, 1); PG8_STAGE(PG8_SB(1, 0), b3, voffB);
            PG8_BAR; PG8_WAIT_L(0); PG8_MMA(0, 1, At, B1); PG8_BAR;
            PG8_LDA(At, 1, 1); PG8_STAGE(PG8_SA(1, 0), a3, voffA);
            PG8_BAR; PG8_WAIT_L(0); PG8_MMA(1, 0, At, B0); PG8_BAR; PG8_SCHED;
            PG8_STAGE(PG8_SB(1, 1), b3 + hstep, voffB);
            PG8_WAIT_V(6); PG8_BAR; PG8_MMA(1, 1, At, B1); PG8_BAR;
            }
        }
        if constexpr (ALIGN_EPI) { if (wr == 0) PG8_BAR; }
        if constexpr (!Epi::AFTER_DRAIN) { E(acc, cur, wr, wc, fr, fq); S.done(cur); }
        if (!has_next) break;
#pragma unroll
        for (int a = 0; a < 2; ++a)
#pragma unroll
            for (int b = 0; b < 2; ++b)
#pragma unroll
                for (int m = 0; m < 4; ++m)
#pragma unroll
                    for (int n = 0; n < 2; ++n) acc[a][b][m][n] = (f32x4){0.f, 0.f, 0.f, 0.f};
        cur = nxt; cA = nA; cB = nB; ++ui;
        if constexpr (ALIGN_EPI) { if (wr == 1) PG8_BAR; }
    }
    PG8_WAIT_V(0);
    if constexpr (!ALIGN_EPI) { if (wr == 0) PG8_BAR; }
    PG8_BAR;
    if constexpr (Epi::AFTER_DRAIN) { E.fused(acc, cur, wr, wc, fr, fq, lds, wid, lane); S.done(cur); }
#undef PG8_SA
#undef PG8_SB
#undef PG8_STAGE
#undef PG8_LDA
#undef PG8_LDB
#undef PG8_MMA
#undef PG8_WAIT_V
#undef PG8_WAIT_L
#undef PG8_BAR
#undef PG8_SCHED
}
}

constexpr int NWAVES = 8;
constexpr int T = pg8::T, SEQ = pg8::SEQ, DM = pg8::DM, DIN = pg8::DIN, NE = 32, PLE = 256;
constexpr float EPS = pg8::EPS;
constexpr size_t MiB = 1u << 20;
constexpr size_t WS_CTL = 0, CTL_ZERO_BYTES = 1 * MiB;
constexpr size_t WS_WT_IN = 2 * MiB, WS_WT_OUT = 9 * MiB, WS_WT_PG = 11 * MiB, WS_WT_PP = 13 * MiB;
constexpr size_t WS_GAINS = 13 * MiB + 512 * 1024;
constexpr size_t WS_ROPEC = 14 * MiB, WS_ROPES = 16 * MiB, WS_PB = 18 * MiB, WS_ROUTE = 26 * MiB;
constexpr size_t WS_WT_UG = 32 * MiB, WS_WT_DN = 160 * MiB;
constexpr size_t WS_XN = 224 * MiB;
constexpr size_t WS_HM = 256 * MiB;
constexpr size_t WS_RG = 352 * MiB;
constexpr size_t WS_Y = 368 * MiB;
constexpr size_t WS_PJ = 400 * MiB;
constexpr size_t WS_XS = 432 * MiB, WS_H = 576 * MiB, WS_YS = 720 * MiB;
constexpr size_t WS_END = 864 * MiB;
constexpr int CW_TMO = 0, CW_CODE = 1;
constexpr int CW_BAR = 4096;
constexpr int RING_OFF = 0, RING_BYTES = 131072;
constexpr int LDSCTL_OFF = RING_BYTES, MISC_OFF = LDSCTL_OFF + 320;
constexpr int LDS_BYTES = 147456;
#define GAS __attribute__((address_space(1)))
#define LAS __attribute__((address_space(3)))
typedef unsigned short bf16;
typedef unsigned v4u __attribute__((ext_vector_type(4)));
typedef float f32x4 __attribute__((ext_vector_type(4)));
typedef short bf16x8 __attribute__((ext_vector_type(8)));
typedef unsigned u32x4_t __attribute__((ext_vector_type(4)));
typedef unsigned u32x2_t __attribute__((ext_vector_type(2)));
typedef GAS unsigned gu32;
typedef GAS unsigned long long gu64;
#define RLX_AGENT __ATOMIC_RELAXED, __HIP_MEMORY_SCOPE_AGENT
#define LDS_WAIT() asm volatile("s_waitcnt lgkmcnt(0)" ::: "memory")
#define VM_WAIT() asm volatile("s_waitcnt vmcnt(0)" ::: "memory")
__device__ __forceinline__ unsigned long long rt() { return __builtin_amdgcn_s_memrealtime(); }
__device__ __forceinline__ unsigned f2bf(float f) { unsigned u = __builtin_bit_cast(unsigned, f); return (u + 0x7fffu + ((u >> 16) & 1u)) >> 16; }
__device__ __forceinline__ unsigned pk2(float lo, float hi) { return f2bf(lo) | (f2bf(hi) << 16); }

#define XB_TMO      128
#define XB_XCNT(j)  (256  + 64 * (j))
#define XB_XSUB(j)  (1280 + 64 * (j))
#define XB_XGEN(j)  (2304 + 64 * (j))
#define XB_TOP      3328
#define XB_TOPGEN   3392
#define XCD_BAR_WORDS 3456
#define XB_SPIN_CAP (1u << 18)

__device__ __forceinline__ unsigned xb_ld(unsigned* p)              { return __hip_atomic_load(p, __ATOMIC_RELAXED, __HIP_MEMORY_SCOPE_AGENT); }
__device__ __forceinline__ unsigned xb_add(unsigned* p, unsigned v) { return __hip_atomic_fetch_add(p, v, __ATOMIC_RELAXED, __HIP_MEMORY_SCOPE_AGENT); }
__device__ __forceinline__ unsigned xb_xcc_id() { return (unsigned)__builtin_amdgcn_s_getreg((3 << 11) | 20) & 0xFu; }
#define XB_SPIN(cond, bar) do { unsigned _sp = 0; while (cond) { __builtin_amdgcn_s_sleep(1); \
    if ((++_sp & 255u) == 0u) { if (xb_ld(&(bar)[XB_TMO])) break; if (_sp > XB_SPIN_CAP) { atomicAdd(&(bar)[XB_TMO], 1u); break; } } } } while (0)

struct XcdBarrier {
    unsigned* bar; unsigned x;
    volatile LAS unsigned* st;
};

__device__ __forceinline__ XcdBarrier xcd_barrier_post(unsigned* bar, volatile LAS unsigned* st) {
    XcdBarrier b; b.bar = bar; b.x = xb_xcc_id(); b.st = st;
    if (threadIdx.x == 0) (void)xb_add(&bar[XB_XCNT(b.x)], 1u);
    return b;
}
__device__ __forceinline__ void xcd_barrier_complete(unsigned* bar, unsigned x, unsigned& nloc, unsigned& nx) {
    const unsigned G = gridDim.x * gridDim.y * gridDim.z;
    unsigned sum, cnt, mine, sp = 0u;
    for (;;) {
        sum = 0u; cnt = 0u; mine = 0u;
#pragma unroll
        for (unsigned j = 0; j < 16; ++j) { const unsigned c = xb_ld(&bar[XB_XCNT(j)]); sum += c; cnt += (c > 0u) ? 1u : 0u; mine = (j == x) ? c : mine; }
        if (sum == G) break;
        __builtin_amdgcn_s_sleep(1);
        if ((++sp & 255u) == 0u) { if (xb_ld(&bar[XB_TMO])) break; if (sp > XB_SPIN_CAP) { atomicAdd(&bar[XB_TMO], 1u); break; } }
    }
    nloc = mine > 0u ? mine : 1u; nx = cnt > 0u ? cnt : 1u;
}

__device__ __forceinline__ void xcd_barrier(const XcdBarrier& b) {
    asm volatile("s_waitcnt vmcnt(0)" ::: "memory");
    __syncthreads();
    if (threadIdx.x == 0) {
        unsigned* bar = b.bar;
        __builtin_amdgcn_s_waitcnt(0);
        unsigned nloc = b.st[0], nx = b.st[1];
        if (nloc == 0u) { xcd_barrier_complete(bar, b.x, nloc, nx); b.st[0] = nloc; b.st[1] = nx; }
        const unsigned old = xb_add(&bar[XB_XSUB(b.x)], 1u);
        const unsigned gen = old / nloc;
        if (old + 1u == (gen + 1u) * nloc) {
            __builtin_amdgcn_fence(__ATOMIC_RELEASE, "agent");
            asm volatile("s_waitcnt vmcnt(0)" ::: "memory");
            const unsigned og = xb_add(&bar[XB_TOP], 1u);
            const unsigned tg = og / nx;
            if (og + 1u == (tg + 1u) * nx) xb_add(&bar[XB_TOPGEN], 1u);
            else XB_SPIN(xb_ld(&bar[XB_TOPGEN]) == tg, bar);
            __builtin_amdgcn_fence(__ATOMIC_ACQUIRE, "agent");
            xb_add(&bar[XB_XGEN(b.x)], 1u);
            asm volatile("s_waitcnt vmcnt(0)" ::: "memory");
        } else {
            XB_SPIN(xb_ld(&bar[XB_XGEN(b.x)]) == gen, bar);
            __builtin_amdgcn_fence(__ATOMIC_ACQUIRE, "agent");
            asm volatile("s_waitcnt vmcnt(0)" ::: "memory");
        }
    }
    __syncthreads();
}

struct Args {
    const float* x; const float* p; const int* positions; const float* g_mix; const float* w_in;
    const float* sbq; const float* sbk; const float* rq; const float* rk; const float* gn_g; const float* gn_b; const float* w_out;
    const float* g_ffn; const float* w_r; const float* b_r; const float* w_ug; const float* b_ug; const float* w_dn; const float* b_dn;
    const float* g_ple; const float* w_pg; const float* w_pp;
    float* out; unsigned char* ws; int ph_lo, ph_hi;
};
struct Frame {
    LAS unsigned char* lds;
    volatile LAS unsigned* MISC;
    gu32* ctl;
    int wave;
    int vcu, G;
};
__device__ __forceinline__ int tid_now() { int t = threadIdx.x; asm volatile("" : "+v"(t)); return t; }
__device__ __forceinline__ float wave_sum(float v) {
#pragma unroll
    for (int o = 1; o < 64; o <<= 1) v += __shfl_xor(v, o);
    return v;
}
__device__ __forceinline__ unsigned cvtpk(float lo, float hi) { return pg8::cvt_pk_bf16(lo, hi); }

enum { MAP_NAT = 0, MAP_IN = 1, MAP_UG = 2 };
__device__ __forceinline__ void p0_item(const float* __restrict__ W, int N, int K, bf16* __restrict__ WT, int kb, int nb, int mapmode, LAS unsigned char* scr, int lane) {
    const int np = 64 * nb + 4 * (lane & 15);
    int src = np;
    if (mapmode == MAP_IN) { const int pn = np >> 8, L = np & 255, bj = L >> 7, wc = (L >> 5) & 3, e = L & 31; src = 256 * pn + 64 * wc + 32 * bj + e; }
    else if (mapmode == MAP_UG) { const int pn = np >> 8, L = np & 255, bj = L >> 7, i = L & 127; src = 1024 * bj + 128 * pn + i; }
    const float* gp = W + (size_t)(64 * kb + (lane >> 4)) * N + src;
    f32x4 v[16];
#pragma unroll
    for (int i = 0; i < 16; ++i) v[i] = *(const f32x4*)(gp + (size_t)(4 * i) * N);
#pragma unroll
    for (int i = 0; i < 16; ++i) {
        LAS unsigned* d = (LAS unsigned*)(scr + (4 * i + (lane >> 4)) * 132 + 8 * (lane & 15));
        d[0] = cvtpk(v[i][0], v[i][1]); d[1] = cvtpk(v[i][2], v[i][3]);
    }
    LDS_WAIT(); asm volatile("" ::: "memory");
    const int c = lane & 7;
#pragma unroll
    for (int it = 0; it < 4; ++it) {
        const int nl = 16 * it + 2 * (lane >> 3);
        unsigned d[8];
#pragma unroll
        for (int j = 0; j < 8; ++j) d[j] = *(const LAS unsigned*)(scr + (8 * c + j) * 132 + 2 * nl);
        v4u o0, o1;
        o0.x = (d[0] & 0xffffu) | (d[1] << 16); o0.y = (d[2] & 0xffffu) | (d[3] << 16); o0.z = (d[4] & 0xffffu) | (d[5] << 16); o0.w = (d[6] & 0xffffu) | (d[7] << 16);
        o1.x = (d[0] >> 16) | (d[1] & 0xffff0000u); o1.y = (d[2] >> 16) | (d[3] & 0xffff0000u); o1.z = (d[4] >> 16) | (d[5] & 0xffff0000u); o1.w = (d[6] >> 16) | (d[7] & 0xffff0000u);
        bf16* dst = WT + (size_t)(64 * nb + nl) * K + 64 * kb + 8 * c;
        *(v4u*)dst = o0; *(v4u*)(dst + K) = o1;
    }
    LDS_WAIT(); asm volatile("" ::: "memory");
}
__device__ __forceinline__ void rms_row_to_bf16(const float* xrow, const float* g, bf16* orow, int lane) {
    const f32x4* xr = (const f32x4*)xrow + lane;
    f32x4 v[4]; float s = 0.f;
#pragma unroll
    for (int j = 0; j < 4; ++j) { v[j] = xr[64 * j]; s += (v[j][0] * v[j][0] + v[j][1] * v[j][1]) + (v[j][2] * v[j][2] + v[j][3] * v[j][3]); }
    const float rstd = rsqrtf(wave_sum(s) * (1.f / DM) + EPS);
    unsigned long long* o8 = (unsigned long long*)orow + lane;
#pragma unroll
    for (int j = 0; j < 4; ++j) { const f32x4 gg = ((const f32x4*)g)[lane + 64 * j];
        o8[64 * j] = (unsigned long long)cvtpk(v[j][0] * rstd * gg[0], v[j][1] * rstd * gg[1]) | ((unsigned long long)cvtpk(v[j][2] * rstd * gg[2], v[j][3] * rstd * gg[3]) << 32); }
}
__device__ __forceinline__ void p0_prologue(Frame& F, const Args& a) {
    unsigned char* ws = a.ws; const int tid = tid_now(), lane = tid & 63;
    LAS unsigned char* scr = F.lds + RING_OFF + F.wave * 8448;
    const int gw = F.vcu * NWAVES + F.wave, NGW = F.G * NWAVES;
    constexpr int I_IN = 16 * 56, I_OUT = 256, I_PG = 256, I_PP = 4 * 16, I_UG = 16 * 32, I_DN = 256;
    constexpr int NITEMS = I_IN + I_OUT + I_PG + I_PP + NE * I_UG + NE * I_DN;
    for (int it = gw; it < NITEMS; it += NGW) {
        int r = it;
        if (r < I_IN) { p0_item(a.w_in, DIN, DM, (bf16*)(ws + WS_WT_IN), r / 56, r % 56, MAP_IN, scr, lane); continue; } r -= I_IN;
        if (r < I_OUT) { p0_item(a.w_out, DM, DM, (bf16*)(ws + WS_WT_OUT), r / 16, r % 16, MAP_NAT, scr, lane); continue; } r -= I_OUT;
        if (r < I_PG) { p0_item(a.w_pg, DM, DM, (bf16*)(ws + WS_WT_PG), r / 16, r % 16, MAP_NAT, scr, lane); continue; } r -= I_PG;
        if (r < I_PP) { p0_item(a.w_pp, DM, PLE, (bf16*)(ws + WS_WT_PP), r / 16, r % 16, MAP_NAT, scr, lane); continue; } r -= I_PP;
        if (r < NE * I_UG) { const int e = r / I_UG, q = r % I_UG; p0_item(a.w_ug + (size_t)e * DM * 2048, 2048, DM, (bf16*)(ws + WS_WT_UG) + (size_t)e * 2048 * DM, q / 32, q % 32, MAP_UG, scr, lane); continue; } r -= NE * I_UG;
        { const int e = r / I_DN, q = r % I_DN; p0_item(a.w_dn + (size_t)e * DM * DM, DM, DM, (bf16*)(ws + WS_WT_DN) + (size_t)e * DM * DM, q / 16, q % 16, MAP_NAT, scr, lane); }
    }
    if (blockIdx.x == 0 && tid < 256) { const int t = tid; const float* srcs = (t < 64) ? a.sbq : (t < 128) ? a.sbk : (t < 192) ? a.rq : a.rk; ((float*)(ws + WS_GAINS))[t] = srcs[t & 63]; }
    for (int m = gw; m < T; m += NGW) rms_row_to_bf16(a.x + (size_t)m * DM, a.g_mix, (bf16*)(ws + WS_XN) + (size_t)m * DM, lane);
    { const int gt = gw * 64 + lane, NGT = NGW * 64;
      for (int i = gt; i < T * PLE / 8; i += NGT) { const f32x4 a0 = ((const f32x4*)a.p)[2 * i], a1 = ((const f32x4*)a.p)[2 * i + 1];
          v4u o; o.x = cvtpk(a0[0], a0[1]); o.y = cvtpk(a0[2], a0[3]); o.z = cvtpk(a1[0], a1[1]); o.w = cvtpk(a1[2], a1[3]); ((v4u*)(ws + WS_PB))[i] = o; }
      float* rc = (float*)(ws + WS_ROPEC); float* rs = (float*)(ws + WS_ROPES);
      for (int i = gt; i < T * 32; i += NGT) { const int row = i >> 5, f = i & 31;
          const float inv_freq = powf(10000.0f, -(float)f / 32.0f); const float ang = (float)a.positions[row] * inv_freq;
          float sn, cs; sincosf(ang, &sn, &cs); rc[i] = cs; rs[i] = sn; } }
}

namespace att {
typedef short bf16x8 __attribute__((ext_vector_type(8)));
typedef short s16x4 __attribute__((ext_vector_type(4)));
typedef float f32x16 __attribute__((ext_vector_type(16)));
typedef short v4i16_t __attribute__((ext_vector_type(4)));
constexpr int LK = 0, LV = 16384, LFLAG = 32768;
__device__ __forceinline__ s16x4 vtr(LAS const unsigned char* p) { return __builtin_bit_cast(s16x4, __builtin_amdgcn_ds_read_tr16_b64_v4i16((LAS v4i16_t*)p)); }
__device__ __forceinline__ int crow(int r, int hi) { return (r & 3) + 8 * (r >> 2) + 4 * hi; }
struct AttnArgs { const bf16* hm; const bf16* rg; bf16* Y; const float* gn_g; const float* gn_b; };

template <int MODE> __device__ __forceinline__ void attn_unit(LAS unsigned char* lds, const AttnArgs& A, int b, int h, int qb) {
    int tid_ = threadIdx.x; asm volatile("" : "+v"(tid_));
    const int tid = tid_, lane = tid & 63, r32 = lane & 31, hh = lane >> 5;
    const int w = __builtin_amdgcn_readfirstlane(tid >> 6);
    const int q0 = qb * 256, qw = q0 + 32 * w;
    const size_t TS = (size_t)T * 512;
    const size_t hoff = (size_t)(b * 8 + h) * SEQ * 64;
    const bf16* Qp = A.hm + (MODE == 0 ? 0 : 3) * TS + hoff;
    const bf16* Kp = A.hm + (MODE == 0 ? 1 : 4) * TS + hoff;
    const bf16* Vp = A.hm + (MODE == 0 ? 2 : 5) * TS + hoff;
    bf16x8 qf[4];
#pragma unroll
    for (int ds = 0; ds < 4; ++ds) qf[ds] = *(const bf16x8*)(Qp + (size_t)(qw + r32) * 64 + 16 * ds + 8 * hh);
    f32x16 o[2];
#pragma unroll
    for (int r = 0; r < 16; ++r) { o[0][r] = 0.f; o[1][r] = 0.f; }
    float carry = 0.f;
    const int jmax = (q0 + 255) >> 6, jd = (qw + 31) >> 6;
    const float lg2g = __log2f(1.0f - __builtin_amdgcn_exp2f(-5.0f - (float)h));
    const bf16* Kt = Kp + (size_t)tid * 8; const bf16* Vt = Vp + (size_t)tid * 8;
    LAS unsigned char* kdst = lds + LK + (tid & 7) * 1024 + (tid >> 3) * 16;
    LAS unsigned char* vdst = lds + LV + (tid >> 3) * 128 + (tid & 7) * 16;
    volatile LAS unsigned* flags = (volatile LAS unsigned*)(lds + LFLAG);
    v4u kreg = *(const v4u*)(Kt + (size_t)jmax * 4096), vreg = *(const v4u*)(Vt + (size_t)jmax * 4096);
    *(LAS v4u*)kdst = kreg; *(LAS v4u*)vdst = vreg;
    __syncthreads();
    bool finished = false;
    for (int it = 0, j = jmax; j >= 0; ++it, --j) {
        const int cur = it & 1;
        const bool more = j > 0;
        if (more) { kreg = *(const v4u*)(Kt + (size_t)(j - 1) * 4096); vreg = *(const v4u*)(Vt + (size_t)(j - 1) * 4096); }
        if (j <= jd && !finished) {
            LAS const unsigned char* Kb = lds + LK + cur * 8192;
            LAS const unsigned char* Vb = lds + LV + cur * 8192;
            f32x16 p[2];
#pragma unroll
            for (int r = 0; r < 16; ++r) { p[0][r] = 0.f; p[1][r] = 0.f; }
#pragma unroll
            for (int ds = 0; ds < 4; ++ds) {
                const bf16x8 k0 = *(LAS const bf16x8*)(Kb + (2 * ds + hh) * 1024 + r32 * 16);
                const bf16x8 k1 = *(LAS const bf16x8*)(Kb + (2 * ds + hh) * 1024 + (32 + r32) * 16);
                p[0] = __builtin_amdgcn_mfma_f32_32x32x16_bf16(k0, qf[ds], p[0], 0, 0, 0);
                p[1] = __builtin_amdgcn_mfma_f32_32x32x16_bf16(k1, qf[ds], p[1], 0, 0, 0);
            }
            const bool diag = (j == jd);
            const int qg = qw + r32, kv0 = 64 * j + 4 * hh;
            if (MODE == 0) {
                float ln[2][16];
#pragma unroll
                for (int hf = 0; hf < 2; ++hf)
#pragma unroll
                    for (int r = 0; r < 16; ++r) {
                        const float Z = p[hf][r];
                        const float e = __builtin_amdgcn_exp2f(-__builtin_fabsf(Z));
                        const float sp = __builtin_fmaxf(Z, 0.f) + __log2f(1.0f + e);
                        const bool valid = !diag || (kv0 + 32 * hf + (r & 3) + 8 * (r >> 2) < qg);
                        ln[hf][r] = valid ? -sp : 0.f;
                        p[hf][r] = valid ? (Z - sp) : -INFINITY;
                    }
                float gs[8], ot[8];
#pragma unroll
                for (int m = 0; m < 8; ++m) { const int hf = m >> 2, g = m & 3; gs[m] = (ln[hf][4 * g] + ln[hf][4 * g + 1]) + (ln[hf][4 * g + 2] + ln[hf][4 * g + 3]); ot[m] = __shfl_xor(gs[m], 32); }
                float ps[8];
                ps[7] = 0.f;
#pragma unroll
                for (int m = 6; m >= 0; --m) ps[m] = ps[m + 1] + (gs[m + 1] + ot[m + 1]);
                const float total = ps[0] + (gs[0] + ot[0]);
                const float om = hh ? 0.f : 1.f;
#pragma unroll
                for (int m = 0; m < 8; ++m) {
                    const int hf = m >> 2, g = m & 3;
                    float tail = carry + __builtin_fmaf(ot[m], om, ps[m]);
#pragma unroll
                    for (int i = 3; i >= 0; --i) { const int r = 4 * g + i; const float l = ln[hf][r]; p[hf][r] = __builtin_amdgcn_exp2f(p[hf][r] + tail); tail += l; }
                }
                carry += total;
                finished = __all(carry <= -160.0f);
            } else {
                const float ct = __builtin_amdgcn_exp2f(lg2g * (float)(qw - 64 * j));
#pragma unroll
                for (int hf = 0; hf < 2; ++hf)
#pragma unroll
                    for (int r = 0; r < 16; ++r) {
                        const bool valid = !diag || (kv0 + 32 * hf + (r & 3) + 8 * (r >> 2) <= qg);
                        p[hf][r] = valid ? p[hf][r] * ct : 0.f;
                    }
            }
#pragma unroll
            for (int hf = 0; hf < 2; ++hf)
#pragma unroll
                for (int s = 0; s < 2; ++s) {
                    u32x4_t wq;
                    wq.x = pg8::cvt_pk_bf16(p[hf][8 * s + 0], p[hf][8 * s + 1]); wq.y = pg8::cvt_pk_bf16(p[hf][8 * s + 2], p[hf][8 * s + 3]);
                    wq.z = pg8::cvt_pk_bf16(p[hf][8 * s + 4], p[hf][8 * s + 5]); wq.w = pg8::cvt_pk_bf16(p[hf][8 * s + 6], p[hf][8 * s + 7]);
                    const bf16x8 wf = __builtin_bit_cast(bf16x8, wq);
#pragma unroll
                    for (int d0 = 0; d0 < 2; ++d0) {
                        LAS const unsigned char* va = Vb + (32 * hf + 16 * s + 4 * hh + ((lane & 15) >> 2)) * 128 + (32 * d0 + 16 * ((lane >> 4) & 1) + 4 * (lane & 3)) * 2;
                        const s16x4 lo = vtr(va), hi = vtr(va + 8 * 128);
                        const bf16x8 vf = (bf16x8){lo[0], lo[1], lo[2], lo[3], hi[0], hi[1], hi[2], hi[3]};
                        o[d0] = __builtin_amdgcn_mfma_f32_32x32x16_bf16(vf, wf, o[d0], 0, 0, 0);
                    }
                }
        }
        if (more) { *(LAS v4u*)(kdst + (cur ^ 1) * 8192) = kreg; *(LAS v4u*)(vdst + (cur ^ 1) * 8192) = vreg; }
        if (MODE == 0) { if (lane == 0) flags[cur * 8 + w] = finished ? 1u : 0u; }
        __syncthreads();
        if (MODE == 0) {
            unsigned all = 1u;
#pragma unroll
            for (int i = 0; i < 8; ++i) all &= flags[cur * 8 + i];
            if (all) break;
        }
    }
    const int row = b * SEQ + qw + r32;
    if (MODE == 0) {
        bf16* yp = A.Y + (size_t)row * DM + h * 64 + 4 * hh;
#pragma unroll
        for (int d0 = 0; d0 < 2; ++d0)
#pragma unroll
            for (int g = 0; g < 4; ++g) { u32x2_t v; v.x = pg8::cvt_pk_bf16(o[d0][4 * g], o[d0][4 * g + 1]); v.y = pg8::cvt_pk_bf16(o[d0][4 * g + 2], o[d0][4 * g + 3]); *(u32x2_t*)(yp + 32 * d0 + 8 * g) = v; }
    } else {
        float s1 = 0.f;
#pragma unroll
        for (int r = 0; r < 16; ++r) s1 += o[0][r] + o[1][r];
        s1 += __shfl_xor(s1, 32);
        const float mu = s1 * (1.0f / 64.0f);
        float s2 = 0.f;
#pragma unroll
        for (int r = 0; r < 16; ++r) { const float a0 = o[0][r] - mu, a1 = o[1][r] - mu; s2 += a0 * a0 + a1 * a1; }
        s2 += __shfl_xor(s2, 32);
        const float rstd = rsqrtf(s2 * (1.0f / 64.0f) + EPS);
        bf16* yp = A.Y + (size_t)row * DM + 512 + h * 64 + 4 * hh;
        const bf16* gp = A.rg + (size_t)row * 512 + h * 64 + 4 * hh;
        const float* gg = A.gn_g + h * 64 + 4 * hh; const float* gb = A.gn_b + h * 64 + 4 * hh;
#pragma unroll
        for (int d0 = 0; d0 < 2; ++d0)
#pragma unroll
            for (int g = 0; g < 4; ++g) {
                const f32x4 gn = *(const f32x4*)(gg + 32 * d0 + 8 * g), bs = *(const f32x4*)(gb + 32 * d0 + 8 * g);
                const u32x2_t gr = *(const u32x2_t*)(gp + 32 * d0 + 8 * g);
                float gate[4] = {__uint_as_float(gr.x << 16), __uint_as_float(gr.x & 0xffff0000u), __uint_as_float(gr.y << 16), __uint_as_float(gr.y & 0xffff0000u)};
                float ov[4];
#pragma unroll
                for (int i = 0; i < 4; ++i) { const float yn = (o[d0][4 * g + i] - mu) * rstd * gn[i] + bs[i]; const float sg = gate[i] / (1.0f + __expf(-gate[i])); ov[i] = yn * sg; }
                u32x2_t v; v.x = pg8::cvt_pk_bf16(ov[0], ov[1]); v.y = pg8::cvt_pk_bf16(ov[2], ov[3]); *(u32x2_t*)(yp + 32 * d0 + 8 * g) = v;
            }
    }
}
__device__ __forceinline__ void attn_phase(LAS unsigned char* lds, const AttnArgs& A, int vcu) {
    const int bh = vcu >> 2, x = vcu & 3, b = bh >> 3, h = bh & 7;
    attn_unit<1>(lds, A, b, h, 7 - x);
    attn_unit<1>(lds, A, b, h, x);
    attn_unit<0>(lds, A, b, h, 7 - x);
    attn_unit<0>(lds, A, b, h, x);
}
}

constexpr int CW_GCNT = 2048;
constexpr int LR_LCNT = LDSCTL_OFF + 1024, LR_GBASE = LDSCTL_OFF + 1152;
constexpr int LT_POFF = LDSCTL_OFF + 2048, LT_NT = LDSCTL_OFF + 2176, LT_TILE_E = LDSCTL_OFF + 2304;
struct RouteBufs { int* tok_e; int* tok_slot; float* tok_gate; };
__device__ __forceinline__ RouteBufs route_bufs(unsigned char* ws) { RouteBufs r; r.tok_e = (int*)(ws + WS_ROUTE); r.tok_slot = r.tok_e + T * 4; r.tok_gate = (float*)(r.tok_slot + T * 4); return r; }
typedef float f32x2v __attribute__((ext_vector_type(2)));
__device__ __forceinline__ unsigned opq_mask(bool c) { unsigned m = c ? 0xffffffffu : 0u; asm volatile("" : "+v"(m)); return m; }
__device__ __forceinline__ float blendf(unsigned m, float a, float b) { return __uint_as_float((__float_as_uint(a) & m) | (__float_as_uint(b) & ~m)); }
__device__ __forceinline__ int blendi(unsigned m, int a, int b) { return (int)(((unsigned)a & m) | ((unsigned)b & ~m)); }

__device__ __forceinline__ void router_phase(Frame& F, const Args& a) {
    unsigned char* ws = a.ws; const int tid = tid_now();
    LAS unsigned char* lds = F.lds;
    for (int q = tid; q < 8192; q += NWAVES * 64) { const int c = q >> 3, k = q & 7; const int rho = ((c >> 8) * 4 + (c & 3)) * 64 + ((c & 255) >> 2);
        *(LAS f32x4*)(lds + rho * 128 + ((k ^ ((rho >> 1) & 7)) << 4)) = *(const f32x4*)(a.w_r + (size_t)c * 32 + 4 * k); }
    volatile LAS unsigned* lcnt = (volatile LAS unsigned*)(lds + LR_LCNT);
    volatile LAS unsigned* gbase = (volatile LAS unsigned*)(lds + LR_GBASE);
    if (tid < 32) lcnt[tid] = 0u;
    __syncthreads();
    const RouteBufs R = route_bufs(ws);
    const int lane = tid & 63;
    int as_e[2], as_rank[2]; float as_gate[2];
#pragma unroll
    for (int ps = 0; ps < 2; ++ps) {
        const int rb = F.vcu * 64 + F.wave * 8 + ps * 4;
        float rstd[4];
#pragma unroll
        for (int r = 0; r < 4; ++r) {
            f32x4 xg[4]; float ss = 0.f;
#pragma unroll
            for (int i = 0; i < 4; ++i) { const f32x4 v = *(const f32x4*)(a.out + (size_t)(rb + r) * DM + 4 * lane + 256 * i); const f32x4 g = *(const f32x4*)(a.g_ffn + 4 * lane + 256 * i);
                ss += (v[0] * v[0] + v[1] * v[1]) + (v[2] * v[2] + v[3] * v[3]); xg[i] = v * g; }
            rstd[r] = rsqrtf(wave_sum(ss) * (1.f / DM) + EPS);
            bf16* hp = (bf16*)(ws + WS_XN) + (size_t)(rb + r) * DM + 4 * lane;
#pragma unroll
            for (int i = 0; i < 4; ++i) { const f32x4 h = xg[i] * rstd[r]; u32x2_t o; o.x = cvtpk(h[0], h[1]); o.y = cvtpk(h[2], h[3]); *(u32x2_t*)(hp + 256 * i) = o; }
        }
        float lg[2];
#pragma unroll
        for (int eh = 0; eh < 2; ++eh) {
            f32x2v acc[4][8];
#pragma unroll
            for (int r = 0; r < 4; ++r)
#pragma unroll
                for (int e = 0; e < 8; ++e) acc[r][e] = (f32x2v){0.f, 0.f};
#pragma unroll 1
            for (int i = 0; i < 4; ++i) {
                f32x4 xv[4];
#pragma unroll
                for (int r = 0; r < 4; ++r) xv[r] = *(const f32x4*)(a.out + (size_t)(rb + r) * DM + 4 * lane + 256 * i) * *(const f32x4*)(a.g_ffn + 4 * lane + 256 * i);
#pragma unroll
                for (int j = 0; j < 4; ++j) {
                    const int rho = (i * 4 + j) * 64 + lane;
                    LAS const unsigned char* wp = lds + rho * 128; const int sw = (rho >> 1) & 7;
#pragma unroll
                    for (int k = 0; k < 4; ++k) {
                        const f32x4 w4 = *(LAS const f32x4*)(wp + (((4 * eh + k) ^ sw) << 4));
#pragma unroll
                        for (int r = 0; r < 4; ++r) { const float xs_ = xv[r][j]; acc[r][2 * k] += (f32x2v){xs_, xs_} * (f32x2v){w4[0], w4[1]}; acc[r][2 * k + 1] += (f32x2v){xs_, xs_} * (f32x2v){w4[2], w4[3]}; }
                    }
                }
            }
            const unsigned m32 = opq_mask((lane & 32) != 0), m16 = opq_mask((lane & 16) != 0), m8 = opq_mask((lane & 8) != 0), m4 = opq_mask((lane & 4) != 0), m2 = opq_mask((lane & 2) != 0), m1 = opq_mask((lane & 1) != 0);
#define TRX(dst, lo_, hi_, mm, MASK) { const float s_ = blendf(mm, lo_, hi_), k_ = blendf(mm, hi_, lo_); dst = k_ + __shfl_xor(s_, MASK); }
            f32x2v a1[2][8];
#pragma unroll
            for (int r = 0; r < 2; ++r)
#pragma unroll
                for (int e = 0; e < 8; ++e) { TRX(a1[r][e][0], acc[r][e][0], acc[r + 2][e][0], m32, 32) TRX(a1[r][e][1], acc[r][e][1], acc[r + 2][e][1], m32, 32) }
            f32x2v a2[8];
#pragma unroll
            for (int e = 0; e < 8; ++e) { TRX(a2[e][0], a1[0][e][0], a1[1][e][0], m16, 16) TRX(a2[e][1], a1[0][e][1], a1[1][e][1], m16, 16) }
            f32x2v a3[4];
#pragma unroll
            for (int e = 0; e < 4; ++e) { TRX(a3[e][0], a2[e][0], a2[e + 4][0], m8, 8) TRX(a3[e][1], a2[e][1], a2[e + 4][1], m8, 8) }
            f32x2v a4[2];
#pragma unroll
            for (int e = 0; e < 2; ++e) { TRX(a4[e][0], a3[e][0], a3[e + 2][0], m4, 4) TRX(a4[e][1], a3[e][1], a3[e + 2][1], m4, 4) }
            f32x2v a5;
            TRX(a5[0], a4[0][0], a4[1][0], m2, 2) TRX(a5[1], a4[0][1], a4[1][1], m2, 2)
            float a6;
            TRX(a6, a5[0], a5[1], m1, 1)
#undef TRX
            lg[eh] = a6;
        }
        const int rr = lane >> 4, e0 = lane & 15, e1 = 16 + (lane & 15);
        const unsigned mr1 = opq_mask((rr & 1) != 0), mr2 = opq_mask((rr & 2) != 0);
        const float rs = blendf(mr2, blendf(mr1, rstd[3], rstd[2]), blendf(mr1, rstd[1], rstd[0]));
        const float l0 = lg[0] * rs + a.b_r[e0], l1 = lg[1] * rs + a.b_r[e1];
        bool t0 = false, t1 = false; float val[4]; int idx[4];
#pragma unroll
        for (int k = 0; k < 4; ++k) {
            const float c0 = t0 ? -INFINITY : l0, c1 = t1 ? -INFINITY : l1;
            float bv = (c0 >= c1) ? c0 : c1; int bi = (c0 >= c1) ? e0 : e1;
#pragma unroll
            for (int mk = 1; mk < 16; mk <<= 1) { const float ov = __shfl_xor(bv, mk); const int oi = __shfl_xor(bi, mk); const bool take = (ov > bv) || (ov == bv && oi < bi); bv = take ? ov : bv; bi = take ? oi : bi; }
            val[k] = bv; idx[k] = bi; t0 = t0 || (bi == e0); t1 = t1 || (bi == e1);
        }
        float ex[4], sum = 0.f;
#pragma unroll
        for (int k = 0; k < 4; ++k) { ex[k] = __expf(val[k] - val[0]); sum += ex[k]; }
        const int kk = lane & 15;
        const unsigned mk1 = opq_mask((kk & 1) != 0), mk2 = opq_mask((kk & 2) != 0);
        const int my_e = blendi(mk2, blendi(mk1, idx[3], idx[2]), blendi(mk1, idx[1], idx[0]));
        const float my_g = blendf(mk2, blendf(mk1, ex[3], ex[2]), blendf(mk1, ex[1], ex[0])) / sum;
        int rank = 0;
        if (kk < 4) rank = (int)__hip_atomic_fetch_add((LAS unsigned*)(lds + LR_LCNT) + my_e, 1u, __ATOMIC_RELAXED, __HIP_MEMORY_SCOPE_WORKGROUP);
        as_e[ps] = my_e; as_rank[ps] = rank; as_gate[ps] = my_g;
    }
    __syncthreads();
    if (tid < 32) gbase[tid] = __hip_atomic_fetch_add((unsigned*)(F.ctl + CW_GCNT) + tid, lcnt[tid], __ATOMIC_RELAXED, __HIP_MEMORY_SCOPE_AGENT);
    __syncthreads();
#pragma unroll
    for (int ps = 0; ps < 2; ++ps) {
        const int row = F.vcu * 64 + F.wave * 8 + ps * 4 + (lane >> 4), kk = lane & 15;
        if (kk < 4) { R.tok_e[row * 4 + kk] = as_e[ps]; R.tok_slot[row * 4 + kk] = (int)gbase[as_e[ps]] + as_rank[ps]; R.tok_gate[row * 4 + kk] = as_gate[ps]; }
    }
}

__device__ __forceinline__ void build_tables(Frame& F) {
    LAS int* poff = (LAS int*)(F.lds + LT_POFF); LAS int* ntp = (LAS int*)(F.lds + LT_NT); LAS int* tile_e = (LAS int*)(F.lds + LT_TILE_E);
    LAS int* cnts = (LAS int*)(F.lds + LR_LCNT); const int tid = tid_now();
    if (tid < NE) cnts[tid] = (int)__hip_atomic_load((unsigned*)(F.ctl + CW_GCNT) + tid, __ATOMIC_RELAXED, __HIP_MEMORY_SCOPE_AGENT);
    __syncthreads();
    if (tid == 0) {
        int t = 0;
        for (int e = 0; e < NE; ++e) { const int c = cnts[e]; const int nt = (c + 255) >> 8; poff[e] = t * 256; for (int i = 0; i < nt; ++i) tile_e[t + i] = e; t += nt; }
        *ntp = t;
    }
    __syncthreads();
}
__device__ __forceinline__ void gather_phase(Frame& F, const Args& a) {
    unsigned char* ws = a.ws; const int lane = tid_now() & 63; const RouteBufs R = route_bufs(ws);
    LAS const int* poff = (LAS const int*)(F.lds + LT_POFF);
    const int gw = F.vcu * NWAVES + F.wave, NGW = F.G * NWAVES;
    for (int m = gw; m < T; m += NGW) {
        const v4u* src = (const v4u*)((const bf16*)(ws + WS_XN) + (size_t)m * DM);
        const v4u h0 = src[lane], h1 = src[lane + 64];
#pragma unroll
        for (int k = 0; k < 4; ++k) { const int e = R.tok_e[m * 4 + k], slot = R.tok_slot[m * 4 + k];
            v4u* dst = (v4u*)((bf16*)(ws + WS_XS) + (size_t)(poff[e] + slot) * DM); dst[lane] = h0; dst[lane + 64] = h1; }
    }
}
__device__ __forceinline__ void combine_phase(Frame& F, const Args& a) {
    unsigned char* ws = a.ws; const RouteBufs R = route_bufs(ws);
    LAS const int* poff = (LAS const int*)(F.lds + LT_POFF);
    const int gw = F.vcu * NWAVES + F.wave, NGW = F.G * NWAVES, lane = tid_now() & 63;
    for (int m = gw; m < T; m += NGW) {
        f32x4 v[4];
#pragma unroll
        for (int i = 0; i < 4; ++i) v[i] = *(const f32x4*)(a.out + (size_t)m * DM + 4 * lane + 256 * i);
#pragma unroll
        for (int k = 0; k < 4; ++k) {
            const int e = R.tok_e[m * 4 + k], slot = R.tok_slot[m * 4 + k]; const float gt = R.tok_gate[m * 4 + k];
            const bf16* yr = (const bf16*)(ws + WS_YS) + (size_t)(poff[e] + slot) * DM + 4 * lane;
#pragma unroll
            for (int i = 0; i < 4; ++i) { const u32x2_t y = *(const u32x2_t*)(yr + 256 * i);
                v[i][0] += gt * __uint_as_float(y.x << 16); v[i][1] += gt * __uint_as_float(y.x & 0xffff0000u); v[i][2] += gt * __uint_as_float(y.y << 16); v[i][3] += gt * __uint_as_float(y.y & 0xffff0000u); }
        }
        float ss = 0.f;
#pragma unroll
        for (int i = 0; i < 4; ++i) ss += (v[i][0] * v[i][0] + v[i][1] * v[i][1]) + (v[i][2] * v[i][2] + v[i][3] * v[i][3]);
        const float rstd = rsqrtf(wave_sum(ss) * (1.f / DM) + EPS);
        bf16* np = (bf16*)(ws + WS_XN) + (size_t)m * DM + 4 * lane;
#pragma unroll
        for (int i = 0; i < 4; ++i) { *(f32x4*)(a.out + (size_t)m * DM + 4 * lane + 256 * i) = v[i]; const f32x4 g = *(const f32x4*)(a.g_ple + 4 * lane + 256 * i);
            u32x2_t o; o.x = cvtpk(v[i][0] * rstd * g[0], v[i][1] * rstd * g[1]); o.y = cvtpk(v[i][2] * rstd * g[2], v[i][3] * rstd * g[3]); *(u32x2_t*)(np + 256 * i) = o; }
    }
}

__global__ void __launch_bounds__(NWAVES * 64, 2) mega_fwd(Args args) {
    extern __shared__ __attribute__((aligned(16))) unsigned char lds[];
    Frame F;
    F.lds = (LAS unsigned char*)lds;
    F.MISC = (volatile LAS unsigned*)(F.lds + MISC_OFF);
    F.wave = __builtin_amdgcn_readfirstlane(threadIdx.x >> 6);
    F.G = gridDim.x; { const int bx = blockIdx.x; F.vcu = (F.G % 8 == 0) ? (bx % 8) * (F.G / 8) + bx / 8 : bx; }
    unsigned char* ws = args.ws;
    F.ctl = (gu32*)(ws + WS_CTL);
    for (int u = threadIdx.x; u < (LDS_BYTES - LDSCTL_OFF) / 4; u += NWAVES * 64) ((LAS unsigned*)(F.lds + LDSCTL_OFF))[u] = 0u;
    __syncthreads();
    XcdBarrier bar = xcd_barrier_post((unsigned*)(F.ctl + CW_BAR), F.MISC + 8);
    const int lo = args.ph_lo, hi = args.ph_hi;
#define IN(k) (lo <= (k) && (k) < hi)
#define GRID_BAR() xcd_barrier(bar)

    if (IN(0)) { p0_prologue(F, args); GRID_BAR(); }

    if (IN(1)) {
        pg8::Gemm g{(const pg8::bf16_t*)(ws + WS_XN), (const pg8::bf16_t*)(ws + WS_WT_IN), DM, 0};
        pg8::StaticOrder S; S.init(T / 256, DIN / 256, F.G, (int)blockIdx.x);
        pg8::EpiProj E{(pg8::bf16_t*)(ws + WS_HM), (pg8::bf16_t*)(ws + WS_RG), (const float*)(ws + WS_GAINS), (const float*)(ws + WS_ROPEC), (const float*)(ws + WS_ROPES)};
        pg8::gemm_phase<pg8::EpiProj, pg8::StaticOrder, true, true>(F.lds + RING_OFF, g, S, E);
        GRID_BAR();
    }
    if (IN(2)) {
        if (F.G == 256) {
            const att::AttnArgs AA{(const bf16*)(ws + WS_HM), (const bf16*)(ws + WS_RG), (bf16*)(ws + WS_Y), args.gn_g, args.gn_b};
            att::attn_phase(F.lds + RING_OFF, AA, F.vcu);
        }
        GRID_BAR();
    }
    if (IN(3)) {
        {
        pg8::Gemm g2{(const pg8::bf16_t*)(ws + WS_PB), (const pg8::bf16_t*)(ws + WS_WT_PP), PLE, 0};
        pg8::StaticOrder S2; S2.init(T / 256, DM / 256, F.G, (int)blockIdx.x);
        pg8::EpiBf16Plain E2{(pg8::bf16_t*)(ws + WS_PJ), DM};
        pg8::gemm_phase<pg8::EpiBf16Plain, pg8::StaticOrder, true, true>(F.lds + RING_OFF, g2, S2, E2); }
        pg8::Gemm g{(const pg8::bf16_t*)(ws + WS_Y), (const pg8::bf16_t*)(ws + WS_WT_OUT), DM, 0};
        pg8::StaticOrder S; S.init(T / 256, DM / 256, F.G, (int)blockIdx.x);
        pg8::EpiResid E{args.x, args.out};
        pg8::gemm_phase<pg8::EpiResid, pg8::StaticOrder, true, true>(F.lds + RING_OFF, g, S, E);
        GRID_BAR();
    }
    if (IN(4)) { if (F.G == 256) router_phase(F, args); GRID_BAR(); }
    if (IN(5) || (lo >= 6 && lo <= 8)) build_tables(F);
    if (IN(5)) { gather_phase(F, args); GRID_BAR(); }
    if (IN(6)) {
        const int NT = *(LAS const int*)(F.lds + LT_NT);
        pg8::Gemm g{(const pg8::bf16_t*)(ws + WS_XS), (const pg8::bf16_t*)(ws + WS_WT_UG), DM, (size_t)2048 * DM * 2};
        pg8::MoeOrder S; S.init(NT, 8, F.G, (int)blockIdx.x, (LAS const int*)(F.lds + LT_TILE_E));
        pg8::EpiMoeUp E{(pg8::bf16_t*)(ws + WS_H), args.b_ug};
        pg8::gemm_phase<pg8::EpiMoeUp, pg8::MoeOrder, true, true>(F.lds + RING_OFF, g, S, E);
        GRID_BAR();
    }
    if (IN(7)) {
        const int NT = *(LAS const int*)(F.lds + LT_NT);
        pg8::Gemm g{(const pg8::bf16_t*)(ws + WS_H), (const pg8::bf16_t*)(ws + WS_WT_DN), DM, (size_t)DM * DM * 2};
        pg8::MoeOrder S; S.init(NT, 4, F.G, (int)blockIdx.x, (LAS const int*)(F.lds + LT_TILE_E));
        pg8::EpiMoeDown E{(pg8::bf16_t*)(ws + WS_YS), args.b_dn};
        pg8::gemm_phase<pg8::EpiMoeDown, pg8::MoeOrder, true, true>(F.lds + RING_OFF, g, S, E);
        GRID_BAR();
    }
    if (IN(8)) { combine_phase(F, args); GRID_BAR(); }
    if (IN(9)) {
        pg8::Gemm g{(const pg8::bf16_t*)(ws + WS_XN), (const pg8::bf16_t*)(ws + WS_WT_PG), DM, 0};
        pg8::StaticOrder S; S.init(T / 256, DM / 256, F.G, (int)blockIdx.x);
        pg8::EpiPle E{args.out, (const pg8::bf16_t*)(ws + WS_PJ)};
        pg8::gemm_phase<pg8::EpiPle, pg8::StaticOrder, true, true>(F.lds + RING_OFF, g, S, E);
    }
#undef IN
}
extern "C" void kernel_launch(void* const* d_in, const int* in_sizes, int n_in, void* d_out, int out_size, void* d_ws, size_t ws_size, hipStream_t stream) {
    static int grid = 0;
    if (grid == 0) {
        if (n_in != 22 || ws_size < 1024 * MiB) { fprintf(stderr, "kernel_launch: unexpected n_in %d / ws %zu\n", n_in, ws_size); grid = -1; return; }
        int dev = 0, cus = 0, per_cu = 0;
        if (hipGetDevice(&dev) != hipSuccess || hipDeviceGetAttribute(&cus, hipDeviceAttributeMultiprocessorCount, dev) != hipSuccess) { grid = -1; return; }
        if (hipFuncSetAttribute((const void*)mega_fwd, hipFuncAttributeMaxDynamicSharedMemorySize, LDS_BYTES) != hipSuccess) { fprintf(stderr, "kernel_launch: hipFuncSetAttribute failed\n"); grid = -1; return; }
        if (hipOccupancyMaxActiveBlocksPerMultiprocessor(&per_cu, (const void*)mega_fwd, NWAVES * 64, LDS_BYTES) != hipSuccess || per_cu < 1) { fprintf(stderr, "kernel_launch: occupancy query says %d\n", per_cu); per_cu = 1; }
        (void)hipGetLastError();
        grid = cus;
    }
    if (grid < 0) return;
    (void)hipMemsetAsync((char*)d_ws + WS_CTL, 0, CTL_ZERO_BYTES, stream);
    Args a{};
    a.x = (const float*)d_in[0]; a.p = (const float*)d_in[1]; a.positions = (const int*)d_in[2]; a.g_mix = (const float*)d_in[3]; a.w_in = (const float*)d_in[4];
    a.sbq = (const float*)d_in[5]; a.sbk = (const float*)d_in[6]; a.rq = (const float*)d_in[7]; a.rk = (const float*)d_in[8]; a.gn_g = (const float*)d_in[9]; a.gn_b = (const float*)d_in[10];
    a.w_out = (const float*)d_in[11]; a.g_ffn = (const float*)d_in[12]; a.w_r = (const float*)d_in[13]; a.b_r = (const float*)d_in[14]; a.w_ug = (const float*)d_in[15]; a.b_ug = (const float*)d_in[16];
    a.w_dn = (const float*)d_in[17]; a.b_dn = (const float*)d_in[18]; a.g_ple = (const float*)d_in[19]; a.w_pg = (const float*)d_in[20]; a.w_pp = (const float*)d_in[21];
    a.out = (float*)d_out; a.ws = (unsigned char*)d_ws; a.ph_lo = 0; a.ph_hi = 10;
    hipLaunchKernelGGL(mega_fwd, dim3(grid), dim3(NWAVES * 64), LDS_BYTES, stream, a);

}
```

```cpp
#include <hip/hip_runtime.h>
#include <cstdint>
#include <cstdio>
#include <cmath>

namespace pg8 {
#define PG8_LAS __attribute__((address_space(3)))
typedef unsigned short bf16_t;
typedef short bf16x8 __attribute__((ext_vector_type(8)));
typedef float f32x4 __attribute__((ext_vector_type(4)));
typedef unsigned u32x4 __attribute__((ext_vector_type(4)));
typedef unsigned u32x2 __attribute__((ext_vector_type(2)));
typedef int v4i32 __attribute__((ext_vector_type(4)));
typedef int v8i32 __attribute__((ext_vector_type(8)));
constexpr int BM = 256, BK = 64, HALF = 128, HTB = HALF * BK * 2  , STAGE_BYTES = 8 * HTB, NXCD = 8, WGM = 8;

__host__ __device__ __forceinline__ int lds_byte(int r, int c) { const int st = (r >> 4) * 2 + (c >> 5), rr = r & 15, cc = c & 31, ob = rr * 64 + cc * 2; return st * 1024 + (ob ^ (((ob >> 9) & 1) << 5)); }
__host__ __device__ __forceinline__ void stage_rc(int b, int& R, int& C) { const int st = b / 1024, sb = b % 1024, swz = sb ^ (((sb >> 9) & 1) << 5); R = (st >> 1) * 16 + swz / 64; C = (st & 1) * 32 + (swz % 64) / 2; }
__host__ __device__ __forceinline__ int perm32(int rho) { const int n = rho >> 4, i = rho & 15; return 8 * (i >> 2) + 4 * n + (i & 3); }

struct Unit { int pm, pn, e; };
struct Gemm { const bf16_t* A; const bf16_t* Bt; int K; size_t strideBe; };

struct StaticOrder {
    int nM, nN, nwg, G, c;
    __host__ __device__ void init(int nM_, int nN_, int G_, int c_) { nM = nM_; nN = nN_; nwg = nM * nN; G = G_; c = c_; }
    __host__ __device__ bool next(int i, Unit& u) const {
        const long L = (long)i * G + c; if (L >= nwg) return false;
        int wgid = (int)L; { const int q = nwg / NXCD, r = nwg % NXCD, xcd = wgid % NXCD, off = wgid / NXCD; wgid = (xcd < r ? xcd * (q + 1) : r * (q + 1) + (xcd - r) * q) + off; }
        const int nig = WGM * nN, gid = wgid / nig, fm = gid * WGM, gsz = (nM - fm) < WGM ? (nM - fm) : WGM;
        u.pm = fm + ((wgid % nig) % gsz); u.pn = (wgid % nig) / gsz; u.e = 0; return true;
    }
    __device__ __forceinline__ void a_ready(const Unit&) const {}
    __device__ __forceinline__ void done(const Unit&) const {}
};

typedef float f32x2_t __attribute__((ext_vector_type(2))); typedef __bf16 bf16x2_t __attribute__((ext_vector_type(2)));
__device__ __forceinline__ unsigned cvt_pk_bf16(float lo, float hi) { f32x2_t v = {lo, hi}; bf16x2_t b = __builtin_convertvector(v, bf16x2_t); return __builtin_bit_cast(unsigned, b); }

constexpr int T = 16384, SEQ = 2048, DM = 1024, DIN = 3584;
constexpr float EPS = 1e-6f;
__device__ __forceinline__ u32x4 pack8(const f32x4 a, const f32x4 b) { u32x4 w; w.x = cvt_pk_bf16(a[0], a[1]); w.y = cvt_pk_bf16(a[2], a[3]); w.z = cvt_pk_bf16(b[0], b[1]); w.w = cvt_pk_bf16(b[2], b[3]); return w; }

struct EpiProj {
    static constexpr bool PERM = true, AFTER_DRAIN = false;
    bf16_t* hm;
    bf16_t* rg;
    const float* gains;
    const float *ropec, *ropes;
    __device__ __forceinline__ void operator()(const f32x4 (&acc)[2][2][4][2], const Unit& u, int wr, int wc, int fr, int fq) const {
        const int region = u.pn >> 1, hb = 4 * (u.pn & 1) + wc;
        const bool normed = (region == 0) || (region == 1) || (region == 3) || (region == 4);
        const bool rope = (region == 3) || (region == 4);
        const int gidx = region == 0 ? 0 : region == 1 ? 1 : region == 3 ? 2 : 3;
        const float* gp = gains + gidx * 64;
        f32x4 gv[2][2];
#pragma unroll
        for (int bj = 0; bj < 2; ++bj)
#pragma unroll
            for (int n = 0; n < 2; ++n) gv[bj][n] = normed ? *(const f32x4*)(gp + 32 * bj + 8 * fq + 4 * n) : (f32x4){1.f, 1.f, 1.f, 1.f};
        const float lg2g = __log2f(1.0f - __builtin_amdgcn_exp2f(-5.0f - (float)hb));
        const float scale = region == 0 ? 0.125f * 1.4426950408889634f : region == 4 ? 0.125f : 1.0f;
#pragma unroll
        for (int ai = 0; ai < 2; ++ai)
#pragma unroll
            for (int m = 0; m < 4; ++m) {
                const int row = u.pm * BM + ai * HALF + wr * 64 + m * 16 + fr;
                const int b = row >> 11, s = row & (SEQ - 1);
                f32x4 v[2][2];
#pragma unroll
                for (int bj = 0; bj < 2; ++bj)
#pragma unroll
                    for (int n = 0; n < 2; ++n) v[bj][n] = acc[ai][bj][m][n];
                if (normed) {
                    float ss = 0.f;
#pragma unroll
                    for (int bj = 0; bj < 2; ++bj)
#pragma unroll
                        for (int n = 0; n < 2; ++n) { const f32x4 x = v[bj][n]; ss += (x[0] * x[0] + x[1] * x[1]) + (x[2] * x[2] + x[3] * x[3]); }
                    ss += __shfl_xor(ss, 16); ss += __shfl_xor(ss, 32);
                    float rs = rsqrtf(ss * (1.0f / 64.0f) + EPS) * scale;
                    if (rope) rs *= (region == 3) ? __builtin_amdgcn_exp2f((float)(s & 31) * lg2g) : __builtin_amdgcn_exp2f(-(float)(s & 63) * lg2g);
#pragma unroll
                    for (int bj = 0; bj < 2; ++bj)
#pragma unroll
                        for (int n = 0; n < 2; ++n) v[bj][n] = v[bj][n] * rs * gv[bj][n];
                    if (rope) {
#pragma unroll
                        for (int n = 0; n < 2; ++n) {
                            const f32x4 c = *(const f32x4*)(ropec + (size_t)row * 32 + 8 * fq + 4 * n), sn = *(const f32x4*)(ropes + (size_t)row * 32 + 8 * fq + 4 * n);
                            const f32x4 lo = v[0][n], hi = v[1][n];
                            v[0][n] = lo * c - hi * sn; v[1][n] = hi * c + lo * sn;
                        }
                    }
                }
                bf16_t* dst = (region < 6) ? hm + (size_t)region * ((size_t)T * 512) + ((size_t)(b * 8 + hb) * SEQ + s) * 64 + 8 * fq
                                           : rg + (size_t)row * 512 + hb * 64 + 8 * fq;
#pragma unroll
                for (int bj = 0; bj < 2; ++bj) *(u32x4*)(dst + 32 * bj) = pack8(v[bj][0], v[bj][1]);
            }
    }
};

struct EpiBf16Plain {
    static constexpr bool PERM = true, AFTER_DRAIN = false;
    bf16_t* O; int ldc;
    __device__ __forceinline__ void operator()(const f32x4 (&acc)[2][2][4][2], const Unit& u, int wr, int wc, int fr, int fq) const {
        const int row0 = u.pm * BM + wr * 64 + fr, col0 = u.pn * BM + wc * 32 + 8 * fq;
#pragma unroll
        for (int ai = 0; ai < 2; ++ai)
#pragma unroll
            for (int m = 0; m < 4; ++m) { bf16_t* rowp = O + (size_t)(row0 + ai * HALF + m * 16) * ldc + col0;
#pragma unroll
                for (int bj = 0; bj < 2; ++bj) *(u32x4*)(rowp + bj * HALF) = pack8(acc[ai][bj][m][0], acc[ai][bj][m][1]); }
    }
};
struct EpiResid {
    static constexpr bool PERM = false, AFTER_DRAIN = false;
    const float* base; float* out;
    __device__ __forceinline__ void operator()(const f32x4 (&acc)[2][2][4][2], const Unit& u, int wr, int wc, int fr, int fq) const {
        const int col0 = u.pn * BM + wc * 32 + 4 * fq;
#pragma unroll
        for (int ai = 0; ai < 2; ++ai)
#pragma unroll
            for (int m = 0; m < 4; ++m) { const size_t off = (size_t)(u.pm * BM + ai * HALF + wr * 64 + m * 16 + fr) * DM + col0;
#pragma unroll
                for (int bj = 0; bj < 2; ++bj)
#pragma unroll
                    for (int n = 0; n < 2; ++n) { const f32x4 bs = *(const f32x4*)(base + off + bj * HALF + n * 16); *(f32x4*)(out + off + bj * HALF + n * 16) = bs + acc[ai][bj][m][n]; } }
    }
};
struct EpiMoeUp {
    static constexpr bool PERM = true, AFTER_DRAIN = false;
    unsigned char* H; const float* bias;
    __device__ __forceinline__ void operator()(const f32x4 (&acc)[2][2][4][2], const Unit& u, int wr, int wc, int fr, int fq) const {
        const int cc = 128 * u.pn + 32 * wc + 8 * fq;
        const float* bp = bias + (size_t)u.e * 2048 + cc;
        f32x4 bg[2], bl[2];
#pragma unroll
        for (int n = 0; n < 2; ++n) { bg[n] = *(const f32x4*)(bp + 4 * n); bl[n] = *(const f32x4*)(bp + 1024 + 4 * n); }
#pragma unroll
        for (int ai = 0; ai < 2; ++ai)
#pragma unroll
            for (int m = 0; m < 4; ++m) {
                f32x4 hv[2];
#pragma unroll
                for (int n = 0; n < 2; ++n) {
                    const f32x4 g0 = acc[ai][0][m][n] * 0.015625f + bg[n], l0 = acc[ai][1][m][n] * 0.015625f + bl[n];
#pragma unroll
                    for (int j = 0; j < 4; ++j) {
                        const float glu = __builtin_fminf(g0[j], 7.0f), lin = __builtin_fminf(__builtin_fmaxf(l0[j], -7.0f), 7.0f);
                        const float sg = __builtin_amdgcn_rcpf(1.0f + __builtin_amdgcn_exp2f(-1.702f * 1.4426950408889634f * glu));
                        hv[n][j] = glu * sg * (lin + 1.0f);
                    }
                }
                u32x2 hq; hq.x = (unsigned)__builtin_amdgcn_cvt_pk_fp8_f32(hv[0][0], hv[0][1], 0, false); hq.x = (unsigned)__builtin_amdgcn_cvt_pk_fp8_f32(hv[0][2], hv[0][3], (int)hq.x, true);
                hq.y = (unsigned)__builtin_amdgcn_cvt_pk_fp8_f32(hv[1][0], hv[1][1], 0, false); hq.y = (unsigned)__builtin_amdgcn_cvt_pk_fp8_f32(hv[1][2], hv[1][3], (int)hq.y, true);
                *(u32x2*)(H + (size_t)(u.pm * BM + ai * HALF + wr * 64 + m * 16 + fr) * 1024 + cc) = hq;
            }
    }
};
struct EpiMoeDown {
    static constexpr bool PERM = true, AFTER_DRAIN = false;
    bf16_t* YS; const float* bias;
    __device__ __forceinline__ void operator()(const f32x4 (&acc)[2][2][4][2], const Unit& u, int wr, int wc, int fr, int fq) const {
        const int col0 = u.pn * BM + wc * 32 + 8 * fq;
        f32x4 bv[2][2];
#pragma unroll
        for (int bj = 0; bj < 2; ++bj)
#pragma unroll
            for (int n = 0; n < 2; ++n) bv[bj][n] = *(const f32x4*)(bias + (size_t)u.e * 1024 + col0 + bj * HALF + 4 * n);
#pragma unroll
        for (int ai = 0; ai < 2; ++ai)
#pragma unroll
            for (int m = 0; m < 4; ++m) { bf16_t* rowp = YS + (size_t)(u.pm * BM + ai * HALF + wr * 64 + m * 16 + fr) * 1024 + col0;
#pragma unroll
                for (int bj = 0; bj < 2; ++bj) *(u32x4*)(rowp + bj * HALF) = pack8(acc[ai][bj][m][0] * 0.015625f + bv[bj][0], acc[ai][bj][m][1] * 0.015625f + bv[bj][1]); }
    }
};
struct EpiPle {
    static constexpr bool PERM = false, AFTER_DRAIN = false;
    float* out; const bf16_t* PJ;
    __device__ __forceinline__ void operator()(const f32x4 (&acc)[2][2][4][2], const Unit& u, int wr, int wc, int fr, int fq) const {
        const int col0 = u.pn * BM + wc * 32 + 4 * fq;
#pragma unroll
        for (int ai = 0; ai < 2; ++ai)
#pragma unroll
            for (int m = 0; m < 4; ++m) { const size_t off = (size_t)(u.pm * BM + ai * HALF + wr * 64 + m * 16 + fr) * DM + col0;
#pragma unroll
                for (int bj = 0; bj < 2; ++bj)
#pragma unroll
                    for (int n = 0; n < 2; ++n) {
                        const size_t o2 = off + bj * HALF + n * 16;
                        const f32x4 x2 = *(const f32x4*)(out + o2); const u32x2 pj = *(const u32x2*)(PJ + o2); const f32x4 a = acc[ai][bj][m][n];
                        f32x4 r;
                        r[0] = x2[0] + __uint_as_float(pj.x << 16) * __builtin_amdgcn_rcpf(1.0f + __builtin_amdgcn_exp2f(-1.4426950408889634f * a[0]));
                        r[1] = x2[1] + __uint_as_float(pj.x & 0xffff0000u) * __builtin_amdgcn_rcpf(1.0f + __builtin_amdgcn_exp2f(-1.4426950408889634f * a[1]));
                        r[2] = x2[2] + __uint_as_float(pj.y << 16) * __builtin_amdgcn_rcpf(1.0f + __builtin_amdgcn_exp2f(-1.4426950408889634f * a[2]));
                        r[3] = x2[3] + __uint_as_float(pj.y & 0xffff0000u) * __builtin_amdgcn_rcpf(1.0f + __builtin_amdgcn_exp2f(-1.4426950408889634f * a[3]));
                        *(f32x4*)(out + o2) = r;
                    } }
    }
};
struct MoeOrder {
    int nM, nN, nwg, G, c; const PG8_LAS int* tile_e;
    __device__ void init(int nM_, int nN_, int G_, int c_, const PG8_LAS int* te) { nM = nM_; nN = nN_; nwg = nM * nN; G = G_; c = c_; tile_e = te; }
    __device__ bool next(int i, Unit& u) const {
        const long L = (long)i * G + c; if (L >= nwg) return false;
        int wgid = (int)L; { const int q = nwg / NXCD, r = nwg % NXCD, xcd = wgid % NXCD, off = wgid / NXCD; wgid = (xcd < r ? xcd * (q + 1) : r * (q + 1) + (xcd - r) * q) + off; }
        const int nig = WGM * nN, gid = wgid / nig, fm = gid * WGM, gsz = (nM - fm) < WGM ? (nM - fm) : WGM;
        u.pm = fm + ((wgid % nig) % gsz); u.pn = (wgid % nig) / gsz; u.e = __builtin_amdgcn_readfirstlane(tile_e[u.pm]); return true;
    }
    __device__ __forceinline__ void a_ready(const Unit&) const {}
    __device__ __forceinline__ void done(const Unit&) const {}
};
template <class Epi, class Sched, bool ALIGN_EPI = false, bool SP2 = false, bool F8 = false>
__device__ __forceinline__ void gemm_phase(PG8_LAS unsigned char* lds, const Gemm g, const Sched& S, const Epi& E) {
    int tid_ = threadIdx.x; asm volatile("" : "+v"(tid_));
    const int tid = tid_, wid = __builtin_amdgcn_readfirstlane(tid >> 6), lane = tid & 63, wr = wid >> 2, wc = wid & 3, fr = lane & 15, fq = lane >> 4;
    const int K = g.K, nt = K / BK;
    unsigned voffA[2], voffB[2];
#pragma unroll
    for (int i = 0; i < 2; ++i) { int R, C; stage_rc(tid * 16 + i * 8192, R, C); const int Rb = Epi::PERM ? ((R & ~31) + perm32(R & 31)) : R;
        voffA[i] = (unsigned)(R * K + C) * 2u; voffB[i] = (unsigned)(Rb * K + C) * 2u; }
    const size_t kstep = (size_t)(BK * 2);
    const size_t hstep = (size_t)HALF * K * 2;
    const size_t tstep = 2 * hstep;
    const unsigned ldsw = (unsigned)wid * 1024u;
    const int aoff = lds_byte(wr * 64 + fr, fq * 8), boff = lds_byte(wc * 32 + fr, fq * 8);
#define PG8_SA(b, h) (((b) * 2 + (h)) * HTB)
#define PG8_SB(b, h) ((4 + (b) * 2 + (h)) * HTB)
#define PG8_STAGE(bufoff, gbase, voff) do { _Pragma("unroll") for (int _i = 0; _i < 2; ++_i) \
        __builtin_amdgcn_global_load_lds((const unsigned*)((const char*)(gbase) + (voff)[_i]), (PG8_LAS unsigned*)(lds + (bufoff) + ldsw + _i * 8192), 16, 0, 0); } while (0)
#define PG8_LD16(off) (*(const PG8_LAS v4i32*)(lds + (off)))
#define PG8_LDA(dst, b, h) do { if constexpr (F8) { _Pragma("unroll") for (int m = 0; m < 4; ++m) dst##8[m] = __builtin_shufflevector(PG8_LD16(PG8_SA(b, h) + aoff + m * 2048), PG8_LD16(PG8_SA(b, h) + aoff + m * 2048 + 1024), 0, 1, 2, 3, 4, 5, 6, 7); } \
        else { _Pragma("unroll") for (int m = 0; m < 4; ++m) _Pragma("unroll") for (int k = 0; k < 2; ++k) dst[m][k] = *(const PG8_LAS bf16x8*)(lds + PG8_SA(b, h) + aoff + m * 2048 + k * 1024); } } while (0)
#define PG8_LDB(dst, b, h) do { if constexpr (F8) { _Pragma("unroll") for (int n = 0; n < 2; ++n) dst##8[n] = __builtin_shufflevector(PG8_LD16(PG8_SB(b, h) + boff + n * 2048), PG8_LD16(PG8_SB(b, h) + boff + n * 2048 + 1024), 0, 1, 2, 3, 4, 5, 6, 7); } \
        else { _Pragma("unroll") for (int n = 0; n < 2; ++n) _Pragma("unroll") for (int k = 0; k < 2; ++k) dst[n][k] = *(const PG8_LAS bf16x8*)(lds + PG8_SB(b, h) + boff + n * 2048 + k * 1024); } } while (0)
#define PG8_MMA(ai, bj, At, Bt) do { __builtin_amdgcn_s_setprio(1); \
        if constexpr (F8) { _Pragma("unroll") for (int m = 0; m < 4; ++m) _Pragma("unroll") for (int n = 0; n < 2; ++n) \
            asm volatile("v_mfma_scale_f32_16x16x128_f8f6f4 %0, %1, %2, %0, %3, %3 op_sel_hi:[0,0,0]" : "+v"(acc[ai][bj][m][n]) : "v"(Bt##8[n]), "v"(At##8[m]), "v"(f8scale)); } \
        else { _Pragma("unroll") for (int m = 0; m < 4; ++m) _Pragma("unroll") for (int n = 0; n < 2; ++n) _Pragma("unroll") for (int k = 0; k < 2; ++k) \
            acc[ai][bj][m][n] = __builtin_amdgcn_mfma_f32_16x16x32_bf16(Bt[n][k], At[m][k], acc[ai][bj][m][n], 0, 0, 0); } \
        __builtin_amdgcn_s_setprio(0); } while (0)
#define PG8_WAIT_V(n) asm volatile("s_waitcnt vmcnt(" #n ")" ::: "memory")
#define PG8_WAIT_L(n) asm volatile("s_waitcnt lgkmcnt(" #n ")" ::: "memory")
#define PG8_BAR __builtin_amdgcn_s_barrier()
#define PG8_SCHED __builtin_amdgcn_sched_barrier(0)
    Unit cur, nxt; int ui = 0;
    if (!S.next(0, cur)) return;
    f32x4 acc[2][2][4][2];
#pragma unroll
    for (int a = 0; a < 2; ++a)
#pragma unroll
        for (int b = 0; b < 2; ++b)
#pragma unroll
            for (int m = 0; m < 4; ++m)
#pragma unroll
                for (int n = 0; n < 2; ++n) acc[a][b][m][n] = (f32x4){0.f, 0.f, 0.f, 0.f};
    bf16x8 At[4][2], B0[2][2], B1[2][2];
    v8i32 At8[4], B08[2], B18[2]; const int f8scale = 0x7f7f7f7f;
    const char* cA = (const char*)g.A + (size_t)cur.pm * tstep; const char* cB = (const char*)g.Bt + (size_t)cur.e * g.strideBe + (size_t)cur.pn * tstep;
    S.a_ready(cur);
    if constexpr (SP2) {
        PG8_STAGE(PG8_SB(0, 0), cB, voffB); PG8_STAGE(PG8_SB(0, 1), cB + hstep, voffB); PG8_STAGE(PG8_SA(0, 0), cA, voffA); PG8_STAGE(PG8_SA(0, 1), cA + hstep, voffA);
        if (wr == 1) PG8_BAR;
        PG8_WAIT_V(2); PG8_BAR;
        PG8_STAGE(PG8_SB(1, 0), cB + kstep, voffB); PG8_STAGE(PG8_SA(1, 0), cA + kstep, voffA); PG8_STAGE(PG8_SB(1, 1), cB + hstep + kstep, voffB);
        PG8_WAIT_V(6); PG8_BAR;
    } else {
        PG8_STAGE(PG8_SB(0, 0), cB, voffB); PG8_STAGE(PG8_SA(0, 0), cA, voffA); PG8_STAGE(PG8_SB(0, 1), cB + hstep, voffB); PG8_STAGE(PG8_SA(0, 1), cA + hstep, voffA);
        if (wr == 1) PG8_BAR;
        PG8_WAIT_V(4); PG8_BAR;
        PG8_STAGE(PG8_SB(1, 0), cB + kstep, voffB); PG8_STAGE(PG8_SA(1, 0), cA + kstep, voffA); PG8_STAGE(PG8_SB(1, 1), cB + hstep + kstep, voffB);
        PG8_WAIT_V(6); PG8_BAR;
    }
    for (;;) {
        const bool has_next = S.next(ui + 1, nxt);
        const char* nA = has_next ? (const char*)g.A + (size_t)nxt.pm * tstep : cA; const char* nB = has_next ? (const char*)g.Bt + (size_t)nxt.e * g.strideBe + (size_t)nxt.pn * tstep : cB;
#pragma unroll 1
        for (int t = 0; t < nt; t += 2) {
            const bool last = (t == nt - 2);
            const char* a1 = cA + (size_t)(t + 1) * kstep;
            const char* a2 = last ? nA : cA + (size_t)(t + 2) * kstep; const char* b2 = last ? nB : cB + (size_t)(t + 2) * kstep;
            const char* a3 = a2 + kstep; const char* b3 = b2 + kstep;
            if (last && has_next) S.a_ready(nxt);
            if constexpr (SP2) {
            PG8_LDB(B0, 0, 0); PG8_LDB(B1, 0, 1); PG8_SCHED; PG8_LDA(At, 0, 0); PG8_STAGE(PG8_SA(1, 1), a1 + hstep, voffA);
            PG8_WAIT_V(8); PG8_WAIT_L(0); PG8_BAR; PG8_MMA(0, 0, At, B0); PG8_MMA(0, 1, At, B1); PG8_BAR; PG8_SCHED;
            PG8_LDA(At, 0, 1); PG8_STAGE(PG8_SB(0, 0), b2, voffB); PG8_STAGE(PG8_SB(0, 1), b2 + hstep, voffB); PG8_STAGE(PG8_SA(0, 0), a2, voffA);
            PG8_WAIT_V(8); PG8_WAIT_L(0); PG8_BAR; PG8_MMA(1, 0, At, B0); PG8_MMA(1, 1, At, B1); PG8_BAR; PG8_SCHED;
            PG8_LDB(B0, 1, 0); PG8_LDB(B1, 1, 1); PG8_SCHED; PG8_LDA(At, 1, 0); PG8_STAGE(PG8_SA(0, 1), a2 + hstep, voffA);
            PG8_WAIT_V(8); PG8_WAIT_L(0); PG8_BAR; PG8_MMA(0, 0, At, B0); PG8_MMA(0, 1, At, B1); PG8_BAR; PG8_SCHED;
            PG8_LDA(At, 1, 1); PG8_STAGE(PG8_SB(1, 0), b3, voffB); PG8_STAGE(PG8_SB(1, 1), b3 + hstep, voffB); PG8_STAGE(PG8_SA(1, 0), a3, voffA);
            PG8_WAIT_V(8); PG8_WAIT_L(0); PG8_BAR; PG8_MMA(1, 0, At, B0); PG8_MMA(1, 1, At, B1); PG8_BAR; PG8_SCHED;
            } else {
            PG8_LDB(B0, 0, 0); PG8_SCHED; PG8_LDA(At, 0, 0); PG8_STAGE(PG8_SA(1, 1), a1 + hstep, voffA);
            PG8_WAIT_L(8); PG8_BAR; PG8_WAIT_L(0); PG8_MMA(0, 0, At, B0); PG8_BAR; PG8_SCHED;
            PG8_LDB(B1, 0, 1); PG8_STAGE(PG8_SB(0, 0), b2, voffB);
            PG8_BAR; PG8_WAIT_L(0); PG8_MMA(0, 1, At, B1); PG8_BAR;
            PG8_LDA(At, 0, 1); PG8_STAGE(PG8_SA(0, 0), a2, voffA);
            PG8_BAR; PG8_WAIT_L(0); PG8_MMA(1, 0, At, B0); PG8_BAR; PG8_SCHED;
            PG8_STAGE(PG8_SB(0, 1), b2 + hstep, voffB);
            PG8_WAIT_V(6); PG8_BAR; PG8_MMA(1, 1, At, B1); PG8_BAR;
            PG8_LDB(B0, 1, 0); PG8_SCHED; PG8_LDA(At, 1, 0); PG8_STAGE(PG8_SA(0, 1), a2 + hstep, voffA);
            PG8_WAIT_L(8); PG8_BAR; PG8_WAIT_L(0); PG8_MMA(0, 0, At, B0); PG8_BAR; PG8_SCHED;
            PG8_LDB(B1, 1, 1); PG8_STAGE(PG8_SB(1, 0), b3, voffB);
            PG8_BAR; PG8_WAIT_L(0); PG8_MMA(0, 1, At, B1); PG8_BAR;
            PG8_LDA(At, 1, 1); PG8_STAGE(PG8_SA(1, 0), a3, voffA);
            PG8_BAR; PG8_WAIT_L(0); PG8_MMA(1, 0, At, B0); PG8_BAR; PG8_SCHED;
            PG8_STAGE(PG8_SB(1, 1), b3 + hstep, voffB);
            PG8_WAIT_V(6); PG8_BAR; PG8_MMA(1, 1, At, B1); PG8_BAR;
            }
        }
        if constexpr (ALIGN_EPI) { if (wr == 0) PG8_BAR; }
        if constexpr (F8) asm volatile("s_nop 15\n\ts_nop 15\n\ts_nop 15" ::: "memory");
        if constexpr (!Epi::AFTER_DRAIN) { E(acc, cur, wr, wc, fr, fq); S.done(cur); }
        if (!has_next) break;
#pragma unroll
        for (int a = 0; a < 2; ++a)
#pragma unroll
            for (int b = 0; b < 2; ++b)
#pragma unroll
                for (int m = 0; m < 4; ++m)
#pragma unroll
                    for (int n = 0; n < 2; ++n) acc[a][b][m][n] = (f32x4){0.f, 0.f, 0.f, 0.f};
        cur = nxt; cA = nA; cB = nB; ++ui;
        if constexpr (ALIGN_EPI) { if (wr == 1) PG8_BAR; }
    }
    PG8_WAIT_V(0);
    if constexpr (!ALIGN_EPI) { if (wr == 0) PG8_BAR; }
    PG8_BAR;
    if constexpr (Epi::AFTER_DRAIN) { E.fused(acc, cur, wr, wc, fr, fq, lds, wid, lane); S.done(cur); }
#undef PG8_SA
#undef PG8_SB
#undef PG8_STAGE
#undef PG8_LD16
#undef PG8_LDA
#undef PG8_LDB
#undef PG8_MMA
#undef PG8_WAIT_V
#undef PG8_WAIT_L
#undef PG8_BAR
#undef PG8_SCHED
}
}

constexpr int NWAVES = 8;
constexpr int T = pg8::T, SEQ = pg8::SEQ, DM = pg8::DM, DIN = pg8::DIN, NE = 32, PLE = 256;
constexpr float EPS = pg8::EPS;
constexpr size_t MiB = 1u << 20;
constexpr size_t WS_CTL = 0, CTL_ZERO_BYTES = 1 * MiB;
constexpr size_t WS_WT_IN = 2 * MiB, WS_WT_OUT = 9 * MiB, WS_WT_PG = 11 * MiB, WS_WT_PP = 13 * MiB;
constexpr size_t WS_GAINS = 13 * MiB + 512 * 1024;
constexpr size_t WS_ROPEC = 14 * MiB, WS_ROPES = 16 * MiB, WS_PB = 18 * MiB, WS_ROUTE = 26 * MiB;
constexpr size_t WS_WT_UG = 32 * MiB, WS_WT_DN = 160 * MiB;
constexpr size_t WS_XN = 224 * MiB;
constexpr size_t WS_HM = 256 * MiB;
constexpr size_t WS_RG = 352 * MiB;
constexpr size_t WS_Y = 368 * MiB;
constexpr size_t WS_PJ = 400 * MiB;
constexpr size_t WS_XS = 432 * MiB, WS_H = 576 * MiB, WS_YS = 720 * MiB;
constexpr size_t WS_END = 864 * MiB;
constexpr int CW_TMO = 0, CW_CODE = 1;
constexpr int CW_BAR = 4096;
constexpr int RING_OFF = 0, RING_BYTES = 131072;
constexpr int LDSCTL_OFF = RING_BYTES, MISC_OFF = LDSCTL_OFF + 320;
constexpr int LDS_BYTES = 147456;
#define GAS __attribute__((address_space(1)))
#define LAS __attribute__((address_space(3)))
typedef unsigned short bf16;
typedef unsigned v4u __attribute__((ext_vector_type(4)));
typedef float f32x4 __attribute__((ext_vector_type(4)));
typedef short bf16x8 __attribute__((ext_vector_type(8)));
typedef unsigned u32x4_t __attribute__((ext_vector_type(4)));
typedef unsigned u32x2_t __attribute__((ext_vector_type(2)));
typedef GAS unsigned gu32;
typedef GAS unsigned long long gu64;
#define RLX_AGENT __ATOMIC_RELAXED, __HIP_MEMORY_SCOPE_AGENT
#define LDS_WAIT() asm volatile("s_waitcnt lgkmcnt(0)" ::: "memory")
#define VM_WAIT() asm volatile("s_waitcnt vmcnt(0)" ::: "memory")
__device__ __forceinline__ unsigned long long rt() { return __builtin_amdgcn_s_memrealtime(); }
__device__ __forceinline__ unsigned f2bf(float f) { unsigned u = __builtin_bit_cast(unsigned, f); return (u + 0x7fffu + ((u >> 16) & 1u)) >> 16; }
__device__ __forceinline__ unsigned pk2(float lo, float hi) { return f2bf(lo) | (f2bf(hi) << 16); }

#define XB_TMO      128
#define XB_XCNT(j)  (256  + 64 * (j))
#define XB_XSUB(j)  (1280 + 64 * (j))
#define XB_XGEN(j)  (2304 + 64 * (j))
#define XB_TOP      3328
#define XB_TOPGEN   3392
#define XCD_BAR_WORDS 3456
#define XB_SPIN_CAP (1u << 18)

__device__ __forceinline__ unsigned xb_ld(unsigned* p)              { return __hip_atomic_load(p, __ATOMIC_RELAXED, __HIP_MEMORY_SCOPE_AGENT); }
__device__ __forceinline__ unsigned xb_add(unsigned* p, unsigned v) { return __hip_atomic_fetch_add(p, v, __ATOMIC_RELAXED, __HIP_MEMORY_SCOPE_AGENT); }
__device__ __forceinline__ unsigned xb_xcc_id() { return (unsigned)__builtin_amdgcn_s_getreg((3 << 11) | 20) & 0xFu; }
#define XB_SPIN(cond, bar) do { unsigned _sp = 0; while (cond) { __builtin_amdgcn_s_sleep(1); \
    if ((++_sp & 255u) == 0u) { if (xb_ld(&(bar)[XB_TMO])) break; if (_sp > XB_SPIN_CAP) { atomicAdd(&(bar)[XB_TMO], 1u); break; } } } } while (0)

struct XcdBarrier {
    unsigned* bar; unsigned x;
    volatile LAS unsigned* st;
};

__device__ __forceinline__ XcdBarrier xcd_barrier_post(unsigned* bar, volatile LAS unsigned* st) {
    XcdBarrier b; b.bar = bar; b.x = xb_xcc_id(); b.st = st;
    if (threadIdx.x == 0) (void)xb_add(&bar[XB_XCNT(b.x)], 1u);
    return b;
}
__device__ __forceinline__ void xcd_barrier_complete(unsigned* bar, unsigned x, unsigned& nloc, unsigned& nx) {
    const unsigned G = gridDim.x * gridDim.y * gridDim.z;
    unsigned sum, cnt, mine, sp = 0u;
    for (;;) {
        sum = 0u; cnt = 0u; mine = 0u;
#pragma unroll
        for (unsigned j = 0; j < 16; ++j) { const unsigned c = xb_ld(&bar[XB_XCNT(j)]); sum += c; cnt += (c > 0u) ? 1u : 0u; mine = (j == x) ? c : mine; }
        if (sum == G) break;
        __builtin_amdgcn_s_sleep(1);
        if ((++sp & 255u) == 0u) { if (xb_ld(&bar[XB_TMO])) break; if (sp > XB_SPIN_CAP) { atomicAdd(&bar[XB_TMO], 1u); break; } }
    }
    nloc = mine > 0u ? mine : 1u; nx = cnt > 0u ? cnt : 1u;
}

__device__ __forceinline__ void xcd_barrier(const XcdBarrier& b) {
    asm volatile("s_waitcnt vmcnt(0)" ::: "memory");
    __syncthreads();
    if (threadIdx.x == 0) {
        unsigned* bar = b.bar;
        __builtin_amdgcn_s_waitcnt(0);
        unsigned nloc = b.st[0], nx = b.st[1];
        if (nloc == 0u) { xcd_barrier_complete(bar, b.x, nloc, nx); b.st[0] = nloc; b.st[1] = nx; }
        const unsigned old = xb_add(&bar[XB_XSUB(b.x)], 1u);
        const unsigned gen = old / nloc;
        if (old + 1u == (gen + 1u) * nloc) {
            __builtin_amdgcn_fence(__ATOMIC_RELEASE, "agent");
            asm volatile("s_waitcnt vmcnt(0)" ::: "memory");
            const unsigned og = xb_add(&bar[XB_TOP], 1u);
            const unsigned tg = og / nx;
            if (og + 1u == (tg + 1u) * nx) xb_add(&bar[XB_TOPGEN], 1u);
            else XB_SPIN(xb_ld(&bar[XB_TOPGEN]) == tg, bar);
            __builtin_amdgcn_fence(__ATOMIC_ACQUIRE, "agent");
            xb_add(&bar[XB_XGEN(b.x)], 1u);
            asm volatile("s_waitcnt vmcnt(0)" ::: "memory");
        } else {
            XB_SPIN(xb_ld(&bar[XB_XGEN(b.x)]) == gen, bar);
            __builtin_amdgcn_fence(__ATOMIC_ACQUIRE, "agent");
            asm volatile("s_waitcnt vmcnt(0)" ::: "memory");
        }
    }
    __syncthreads();
}

struct Args {
    const float* x; const float* p; const int* positions; const float* g_mix; const float* w_in;
    const float* sbq; const float* sbk; const float* rq; const float* rk; const float* gn_g; const float* gn_b; const float* w_out;
    const float* g_ffn; const float* w_r; const float* b_r; const float* w_ug; const float* b_ug; const float* w_dn; const float* b_dn;
    const float* g_ple; const float* w_pg; const float* w_pp;
    float* out; unsigned char* ws; int ph_lo, ph_hi;
};
struct Frame {
    LAS unsigned char* lds;
    volatile LAS unsigned* MISC;
    gu32* ctl;
    int wave;
    int vcu, G;
};
__device__ __forceinline__ int tid_now() { int t = threadIdx.x; asm volatile("" : "+v"(t)); return t; }
__device__ __forceinline__ float wave_sum(float v) {
#pragma unroll
    for (int o = 1; o < 64; o <<= 1) v += __shfl_xor(v, o);
    return v;
}
__device__ __forceinline__ unsigned cvtpk(float lo, float hi) { return pg8::cvt_pk_bf16(lo, hi); }

enum { MAP_NAT = 0, MAP_IN = 1, MAP_UG = 2 };
__device__ __forceinline__ void p0_item(const float* __restrict__ W, int N, int K, bf16* __restrict__ WT, int kb, int nb, int mapmode, LAS unsigned char* scr, int lane) {
    const int np = 64 * nb + 4 * (lane & 15);
    int src = np;
    if (mapmode == MAP_IN) { const int pn = np >> 8, L = np & 255, bj = L >> 7, wc = (L >> 5) & 3, e = L & 31; src = 256 * pn + 64 * wc + 32 * bj + e; }
    else if (mapmode == MAP_UG) { const int pn = np >> 8, L = np & 255, bj = L >> 7, i = L & 127; src = 1024 * bj + 128 * pn + i; }
    const float* gp = W + (size_t)(64 * kb + (lane >> 4)) * N + src;
    f32x4 v[16];
#pragma unroll
    for (int i = 0; i < 16; ++i) v[i] = *(const f32x4*)(gp + (size_t)(4 * i) * N);
#pragma unroll
    for (int i = 0; i < 16; ++i) {
        LAS unsigned* d = (LAS unsigned*)(scr + (4 * i + (lane >> 4)) * 132 + 8 * (lane & 15));
        d[0] = cvtpk(v[i][0], v[i][1]); d[1] = cvtpk(v[i][2], v[i][3]);
    }
    LDS_WAIT(); asm volatile("" ::: "memory");
    const int c = lane & 7;
#pragma unroll
    for (int it = 0; it < 4; ++it) {
        const int nl = 16 * it + 2 * (lane >> 3);
        unsigned d[8];
#pragma unroll
        for (int j = 0; j < 8; ++j) d[j] = *(const LAS unsigned*)(scr + (8 * c + j) * 132 + 2 * nl);
        v4u o0, o1;
        o0.x = (d[0] & 0xffffu) | (d[1] << 16); o0.y = (d[2] & 0xffffu) | (d[3] << 16); o0.z = (d[4] & 0xffffu) | (d[5] << 16); o0.w = (d[6] & 0xffffu) | (d[7] << 16);
        o1.x = (d[0] >> 16) | (d[1] & 0xffff0000u); o1.y = (d[2] >> 16) | (d[3] & 0xffff0000u); o1.z = (d[4] >> 16) | (d[5] & 0xffff0000u); o1.w = (d[6] >> 16) | (d[7] & 0xffff0000u);
        bf16* dst = WT + (size_t)(64 * nb + nl) * K + 64 * kb + 8 * c;
        *(v4u*)dst = o0; *(v4u*)(dst + K) = o1;
    }
    LDS_WAIT(); asm volatile("" ::: "memory");
}
__device__ __forceinline__ unsigned pk4_fp8(float a, float b, float c, float d) { int r = __builtin_amdgcn_cvt_pk_fp8_f32(a, b, 0, false); r = __builtin_amdgcn_cvt_pk_fp8_f32(c, d, r, true); return (unsigned)r; }
__device__ __forceinline__ void p0_item_f8(const float* __restrict__ W, int N, int K, unsigned char* __restrict__ WT, int kb, int nb, int mapmode, LAS unsigned char* scr, int lane) {
    const int np = 64 * nb + 4 * (lane & 15);
    int src = np;
    if (mapmode == MAP_UG) { const int pn = np >> 8, L = np & 255, bj = L >> 7, i = L & 127; src = 1024 * bj + 128 * pn + i; }
    const float* gp = W + (size_t)(64 * kb + (lane >> 4)) * N + src;
    f32x4 v[16];
#pragma unroll
    for (int i = 0; i < 16; ++i) v[i] = *(const f32x4*)(gp + (size_t)(4 * i) * N);
#pragma unroll
    for (int i = 0; i < 16; ++i) *(LAS unsigned*)(scr + (4 * i + (lane >> 4)) * 68 + 4 * (lane & 15)) = pk4_fp8(v[i][0] * 64.0f, v[i][1] * 64.0f, v[i][2] * 64.0f, v[i][3] * 64.0f);
    LDS_WAIT(); asm volatile("" ::: "memory");
    const int nq = lane & 15, kg = lane >> 4;
    unsigned d[16];
#pragma unroll
    for (int j = 0; j < 16; ++j) d[j] = *(const LAS unsigned*)(scr + (16 * kg + j) * 68 + 4 * nq);
#pragma unroll
    for (int t = 0; t < 4; ++t) {
        v4u o;
#pragma unroll
        for (int q = 0; q < 4; ++q) o[q] = ((d[4 * q] >> (8 * t)) & 0xffu) | (((d[4 * q + 1] >> (8 * t)) & 0xffu) << 8) | (((d[4 * q + 2] >> (8 * t)) & 0xffu) << 16) | (((d[4 * q + 3] >> (8 * t)) & 0xffu) << 24);
        *(v4u*)(WT + (size_t)(64 * nb + 4 * nq + t) * K + 64 * kb + 16 * kg) = o;
    }
    LDS_WAIT(); asm volatile("" ::: "memory");
}
__device__ __forceinline__ void rms_row_to_bf16(const float* xrow, const float* g, bf16* orow, int lane) {
    const f32x4* xr = (const f32x4*)xrow + lane;
    f32x4 v[4]; float s = 0.f;
#pragma unroll
    for (int j = 0; j < 4; ++j) { v[j] = xr[64 * j]; s += (v[j][0] * v[j][0] + v[j][1] * v[j][1]) + (v[j][2] * v[j][2] + v[j][3] * v[j][3]); }
    const float rstd = rsqrtf(wave_sum(s) * (1.f / DM) + EPS);
    unsigned long long* o8 = (unsigned long long*)orow + lane;
#pragma unroll
    for (int j = 0; j < 4; ++j) { const f32x4 gg = ((const f32x4*)g)[lane + 64 * j];
        o8[64 * j] = (unsigned long long)cvtpk(v[j][0] * rstd * gg[0], v[j][1] * rstd * gg[1]) | ((unsigned long long)cvtpk(v[j][2] * rstd * gg[2], v[j][3] * rstd * gg[3]) << 32); }
}
__device__ __forceinline__ void p0_prologue(Frame& F, const Args& a) {
    unsigned char* ws = a.ws; const int tid = tid_now(), lane = tid & 63;
    LAS unsigned char* scr = F.lds + RING_OFF + F.wave * 8448;
    const int gw = F.vcu * NWAVES + F.wave, NGW = F.G * NWAVES;
    constexpr int I_IN = 16 * 56, I_OUT = 256, I_PG = 256, I_PP = 4 * 16, I_UG = 16 * 32, I_DN = 256;
    constexpr int NITEMS = I_IN + I_OUT + I_PG + I_PP + NE * I_UG + NE * I_DN;
    for (int it = gw; it < NITEMS; it += NGW) {
        int r = it;
        if (r < I_IN) { p0_item(a.w_in, DIN, DM, (bf16*)(ws + WS_WT_IN), r / 56, r % 56, MAP_IN, scr, lane); continue; } r -= I_IN;
        if (r < I_OUT) { p0_item(a.w_out, DM, DM, (bf16*)(ws + WS_WT_OUT), r / 16, r % 16, MAP_NAT, scr, lane); continue; } r -= I_OUT;
        if (r < I_PG) { p0_item(a.w_pg, DM, DM, (bf16*)(ws + WS_WT_PG), r / 16, r % 16, MAP_NAT, scr, lane); continue; } r -= I_PG;
        if (r < I_PP) { p0_item(a.w_pp, DM, PLE, (bf16*)(ws + WS_WT_PP), r / 16, r % 16, MAP_NAT, scr, lane); continue; } r -= I_PP;
        if (r < NE * I_UG) { const int e = r / I_UG, q = r % I_UG; p0_item_f8(a.w_ug + (size_t)e * DM * 2048, 2048, DM, (unsigned char*)(ws + WS_WT_UG) + (size_t)e * 2048 * DM, q / 32, q % 32, MAP_UG, scr, lane); continue; } r -= NE * I_UG;
        { const int e = r / I_DN, q = r % I_DN; p0_item_f8(a.w_dn + (size_t)e * DM * DM, DM, DM, (unsigned char*)(ws + WS_WT_DN) + (size_t)e * DM * DM, q / 16, q % 16, MAP_NAT, scr, lane); }
    }
    if (blockIdx.x == 0 && tid < 256) { const int t = tid; const float* srcs = (t < 64) ? a.sbq : (t < 128) ? a.sbk : (t < 192) ? a.rq : a.rk; ((float*)(ws + WS_GAINS))[t] = srcs[t & 63]; }
    for (int m = gw; m < T; m += NGW) rms_row_to_bf16(a.x + (size_t)m * DM, a.g_mix, (bf16*)(ws + WS_XN) + (size_t)m * DM, lane);
    { const int gt = gw * 64 + lane, NGT = NGW * 64;
      for (int i = gt; i < T * PLE / 8; i += NGT) { const f32x4 a0 = ((const f32x4*)a.p)[2 * i], a1 = ((const f32x4*)a.p)[2 * i + 1];
          v4u o; o.x = cvtpk(a0[0], a0[1]); o.y = cvtpk(a0[2], a0[3]); o.z = cvtpk(a1[0], a1[1]); o.w = cvtpk(a1[2], a1[3]); ((v4u*)(ws + WS_PB))[i] = o; }
      float* rc = (float*)(ws + WS_ROPEC); float* rs = (float*)(ws + WS_ROPES);
      for (int i = gt; i < T * 32; i += NGT) { const int row = i >> 5, f = i & 31;
          const float inv_freq = powf(10000.0f, -(float)f / 32.0f); const float ang = (float)a.positions[row] * inv_freq;
          float sn, cs; sincosf(ang, &sn, &cs); rc[i] = cs; rs[i] = sn; } }
}

namespace att {
typedef short bf16x8 __attribute__((ext_vector_type(8)));
typedef short s16x4 __attribute__((ext_vector_type(4)));
typedef float f32x16 __attribute__((ext_vector_type(16)));
typedef short v4i16_t __attribute__((ext_vector_type(4)));
constexpr int LK = 0, LV = 16384, LFLAG = 32768;
__device__ __forceinline__ s16x4 vtr(LAS const unsigned char* p) { return __builtin_bit_cast(s16x4, __builtin_amdgcn_ds_read_tr16_b64_v4i16((LAS v4i16_t*)p)); }
__device__ __forceinline__ int crow(int r, int hi) { return (r & 3) + 8 * (r >> 2) + 4 * hi; }
struct AttnArgs { const bf16* hm; const bf16* rg; bf16* Y; const float* gn_g; const float* gn_b; };

template <int MODE> __device__ __forceinline__ void attn_unit(LAS unsigned char* lds, const AttnArgs& A, int b, int h, int qb) {
    int tid_ = threadIdx.x; asm volatile("" : "+v"(tid_));
    const int tid = tid_, lane = tid & 63, r32 = lane & 31, hh = lane >> 5;
    const int w = __builtin_amdgcn_readfirstlane(tid >> 6);
    const int q0 = qb * 256, qw = q0 + 32 * w;
    const size_t TS = (size_t)T * 512;
    const size_t hoff = (size_t)(b * 8 + h) * SEQ * 64;
    const bf16* Qp = A.hm + (MODE == 0 ? 0 : 3) * TS + hoff;
    const bf16* Kp = A.hm + (MODE == 0 ? 1 : 4) * TS + hoff;
    const bf16* Vp = A.hm + (MODE == 0 ? 2 : 5) * TS + hoff;
    bf16x8 qf[4];
#pragma unroll
    for (int ds = 0; ds < 4; ++ds) qf[ds] = *(const bf16x8*)(Qp + (size_t)(qw + r32) * 64 + 16 * ds + 8 * hh);
    f32x16 o[2];
#pragma unroll
    for (int r = 0; r < 16; ++r) { o[0][r] = 0.f; o[1][r] = 0.f; }
    float carry = 0.f;
    const int jmax = (q0 + 255) >> 6, jd = (qw + 31) >> 6;
    const float lg2g = __log2f(1.0f - __builtin_amdgcn_exp2f(-5.0f - (float)h));
    const bf16* Kt = Kp + (size_t)tid * 8; const bf16* Vt = Vp + (size_t)tid * 8;
    LAS unsigned char* kdst = lds + LK + (tid & 7) * 1024 + (tid >> 3) * 16;
    LAS unsigned char* vdst = lds + LV + (tid >> 3) * 128 + (tid & 7) * 16;
    volatile LAS unsigned* flags = (volatile LAS unsigned*)(lds + LFLAG);
    v4u kreg = *(const v4u*)(Kt + (size_t)jmax * 4096), vreg = *(const v4u*)(Vt + (size_t)jmax * 4096);
    *(LAS v4u*)kdst = kreg; *(LAS v4u*)vdst = vreg;
    __syncthreads();
    bool finished = false;
    for (int it = 0, j = jmax; j >= 0; ++it, --j) {
        const int cur = it & 1;
        const bool more = j > 0;
        if (more) { kreg = *(const v4u*)(Kt + (size_t)(j - 1) * 4096); vreg = *(const v4u*)(Vt + (size_t)(j - 1) * 4096); }
        if (j <= jd && !finished) {
            LAS const unsigned char* Kb = lds + LK + cur * 8192;
            LAS const unsigned char* Vb = lds + LV + cur * 8192;
            f32x16 p[2];
#pragma unroll
            for (int r = 0; r < 16; ++r) { p[0][r] = 0.f; p[1][r] = 0.f; }
#pragma unroll
            for (int ds = 0; ds < 4; ++ds) {
                const bf16x8 k0 = *(LAS const bf16x8*)(Kb + (2 * ds + hh) * 1024 + r32 * 16);
                const bf16x8 k1 = *(LAS const bf16x8*)(Kb + (2 * ds + hh) * 1024 + (32 + r32) * 16);
                p[0] = __builtin_amdgcn_mfma_f32_32x32x16_bf16(k0, qf[ds], p[0], 0, 0, 0);
                p[1] = __builtin_amdgcn_mfma_f32_32x32x16_bf16(k1, qf[ds], p[1], 0, 0, 0);
            }
            const bool diag = (j == jd);
            const int qg = qw + r32, kv0 = 64 * j + 4 * hh;
            if (MODE == 0) {
                float ln[2][16];
#pragma unroll
                for (int hf = 0; hf < 2; ++hf)
#pragma unroll
                    for (int r = 0; r < 16; ++r) {
                        const float Z = p[hf][r];
                        const float e = __builtin_amdgcn_exp2f(-__builtin_fabsf(Z));
                        const float sp = __builtin_fmaxf(Z, 0.f) + __log2f(1.0f + e);
                        const bool valid = !diag || (kv0 + 32 * hf + (r & 3) + 8 * (r >> 2) < qg);
                        ln[hf][r] = valid ? -sp : 0.f;
                        p[hf][r] = valid ? (Z - sp) : -INFINITY;
                    }
                float gs[8], ot[8];
#pragma unroll
                for (int m = 0; m < 8; ++m) { const int hf = m >> 2, g = m & 3; gs[m] = (ln[hf][4 * g] + ln[hf][4 * g + 1]) + (ln[hf][4 * g + 2] + ln[hf][4 * g + 3]); ot[m] = __shfl_xor(gs[m], 32); }
                float ps[8];
                ps[7] = 0.f;
#pragma unroll
                for (int m = 6; m >= 0; --m) ps[m] = ps[m + 1] + (gs[m + 1] + ot[m + 1]);
                const float total = ps[0] + (gs[0] + ot[0]);
                const float om = hh ? 0.f : 1.f;
#pragma unroll
                for (int m = 0; m < 8; ++m) {
                    const int hf = m >> 2, g = m & 3;
                    float tail = carry + __builtin_fmaf(ot[m], om, ps[m]);
#pragma unroll
                    for (int i = 3; i >= 0; --i) { const int r = 4 * g + i; const float l = ln[hf][r]; p[hf][r] = __builtin_amdgcn_exp2f(p[hf][r] + tail); tail += l; }
                }
                carry += total;
                finished = __all(carry <= -160.0f);
            } else {
                const float ct = __builtin_amdgcn_exp2f(lg2g * (float)(qw - 64 * j));
#pragma unroll
                for (int hf = 0; hf < 2; ++hf)
#pragma unroll
                    for (int r = 0; r < 16; ++r) {
                        const bool valid = !diag || (kv0 + 32 * hf + (r & 3) + 8 * (r >> 2) <= qg);
                        p[hf][r] = valid ? p[hf][r] * ct : 0.f;
                    }
            }
#pragma unroll
            for (int hf = 0; hf < 2; ++hf)
#pragma unroll
                for (int s = 0; s < 2; ++s) {
                    u32x4_t wq;
                    wq.x = pg8::cvt_pk_bf16(p[hf][8 * s + 0], p[hf][8 * s + 1]); wq.y = pg8::cvt_pk_bf16(p[hf][8 * s + 2], p[hf][8 * s + 3]);
                    wq.z = pg8::cvt_pk_bf16(p[hf][8 * s + 4], p[hf][8 * s + 5]); wq.w = pg8::cvt_pk_bf16(p[hf][8 * s + 6], p[hf][8 * s + 7]);
                    const bf16x8 wf = __builtin_bit_cast(bf16x8, wq);
#pragma unroll
                    for (int d0 = 0; d0 < 2; ++d0) {
                        LAS const unsigned char* va = Vb + (32 * hf + 16 * s + 4 * hh + ((lane & 15) >> 2)) * 128 + (32 * d0 + 16 * ((lane >> 4) & 1) + 4 * (lane & 3)) * 2;
                        const s16x4 lo = vtr(va), hi = vtr(va + 8 * 128);
                        const bf16x8 vf = (bf16x8){lo[0], lo[1], lo[2], lo[3], hi[0], hi[1], hi[2], hi[3]};
                        o[d0] = __builtin_amdgcn_mfma_f32_32x32x16_bf16(vf, wf, o[d0], 0, 0, 0);
                    }
                }
        }
        if (more) { *(LAS v4u*)(kdst + (cur ^ 1) * 8192) = kreg; *(LAS v4u*)(vdst + (cur ^ 1) * 8192) = vreg; }
        if (MODE == 0) { if (lane == 0) flags[cur * 8 + w] = finished ? 1u : 0u; }
        __syncthreads();
        if (MODE == 0) {
            unsigned all = 1u;
#pragma unroll
            for (int i = 0; i < 8; ++i) all &= flags[cur * 8 + i];
            if (all) break;
        }
    }
    const int row = b * SEQ + qw + r32;
    if (MODE == 0) {
        bf16* yp = A.Y + (size_t)row * DM + h * 64 + 4 * hh;
#pragma unroll
        for (int d0 = 0; d0 < 2; ++d0)
#pragma unroll
            for (int g = 0; g < 4; ++g) { u32x2_t v; v.x = pg8::cvt_pk_bf16(o[d0][4 * g], o[d0][4 * g + 1]); v.y = pg8::cvt_pk_bf16(o[d0][4 * g + 2], o[d0][4 * g + 3]); *(u32x2_t*)(yp + 32 * d0 + 8 * g) = v; }
    } else {
        float s1 = 0.f;
#pragma unroll
        for (int r = 0; r < 16; ++r) s1 += o[0][r] + o[1][r];
        s1 += __shfl_xor(s1, 32);
        const float mu = s1 * (1.0f / 64.0f);
        float s2 = 0.f;
#pragma unroll
        for (int r = 0; r < 16; ++r) { const float a0 = o[0][r] - mu, a1 = o[1][r] - mu; s2 += a0 * a0 + a1 * a1; }
        s2 += __shfl_xor(s2, 32);
        const float rstd = rsqrtf(s2 * (1.0f / 64.0f) + EPS);
        bf16* yp = A.Y + (size_t)row * DM + 512 + h * 64 + 4 * hh;
        const bf16* gp = A.rg + (size_t)row * 512 + h * 64 + 4 * hh;
        const float* gg = A.gn_g + h * 64 + 4 * hh; const float* gb = A.gn_b + h * 64 + 4 * hh;
#pragma unroll
        for (int d0 = 0; d0 < 2; ++d0)
#pragma unroll
            for (int g = 0; g < 4; ++g) {
                const f32x4 gn = *(const f32x4*)(gg + 32 * d0 + 8 * g), bs = *(const f32x4*)(gb + 32 * d0 + 8 * g);
                const u32x2_t gr = *(const u32x2_t*)(gp + 32 * d0 + 8 * g);
                float gate[4] = {__uint_as_float(gr.x << 16), __uint_as_float(gr.x & 0xffff0000u), __uint_as_float(gr.y << 16), __uint_as_float(gr.y & 0xffff0000u)};
                float ov[4];
#pragma unroll
                for (int i = 0; i < 4; ++i) { const float yn = (o[d0][4 * g + i] - mu) * rstd * gn[i] + bs[i]; const float sg = gate[i] / (1.0f + __expf(-gate[i])); ov[i] = yn * sg; }
                u32x2_t v; v.x = pg8::cvt_pk_bf16(ov[0], ov[1]); v.y = pg8::cvt_pk_bf16(ov[2], ov[3]); *(u32x2_t*)(yp + 32 * d0 + 8 * g) = v;
            }
    }
}
__device__ __forceinline__ void attn_phase(LAS unsigned char* lds, const AttnArgs& A, int vcu) {
    const int bh = vcu >> 2, x = vcu & 3, b = bh >> 3, h = bh & 7;
    attn_unit<1>(lds, A, b, h, 7 - x);
    attn_unit<1>(lds, A, b, h, x);
    attn_unit<0>(lds, A, b, h, 7 - x);
    attn_unit<0>(lds, A, b, h, x);
}
}

constexpr int CW_GCNT = 2048;
constexpr int LR_LCNT = LDSCTL_OFF + 1024, LR_GBASE = LDSCTL_OFF + 1152;
constexpr int LT_POFF = LDSCTL_OFF + 2048, LT_NT = LDSCTL_OFF + 2176, LT_TILE_E = LDSCTL_OFF + 2304;
struct RouteBufs { int* tok_e; int* tok_slot; float* tok_gate; };
__device__ __forceinline__ RouteBufs route_bufs(unsigned char* ws) { RouteBufs r; r.tok_e = (int*)(ws + WS_ROUTE); r.tok_slot = r.tok_e + T * 4; r.tok_gate = (float*)(r.tok_slot + T * 4); return r; }
typedef float f32x2v __attribute__((ext_vector_type(2)));
__device__ __forceinline__ unsigned opq_mask(bool c) { unsigned m = c ? 0xffffffffu : 0u; asm volatile("" : "+v"(m)); return m; }
__device__ __forceinline__ float blendf(unsigned m, float a, float b) { return __uint_as_float((__float_as_uint(a) & m) | (__float_as_uint(b) & ~m)); }
__device__ __forceinline__ int blendi(unsigned m, int a, int b) { return (int)(((unsigned)a & m) | ((unsigned)b & ~m)); }

__device__ __forceinline__ void router_phase(Frame& F, const Args& a) {
    unsigned char* ws = a.ws; const int tid = tid_now();
    LAS unsigned char* lds = F.lds;
    for (int q = tid; q < 8192; q += NWAVES * 64) { const int c = q >> 3, k = q & 7; const int rho = ((c >> 8) * 4 + (c & 3)) * 64 + ((c & 255) >> 2);
        *(LAS f32x4*)(lds + rho * 128 + ((k ^ ((rho >> 1) & 7)) << 4)) = *(const f32x4*)(a.w_r + (size_t)c * 32 + 4 * k); }
    volatile LAS unsigned* lcnt = (volatile LAS unsigned*)(lds + LR_LCNT);
    volatile LAS unsigned* gbase = (volatile LAS unsigned*)(lds + LR_GBASE);
    if (tid < 32) lcnt[tid] = 0u;
    __syncthreads();
    const RouteBufs R = route_bufs(ws);
    const int lane = tid & 63;
    int as_e[2], as_rank[2]; float as_gate[2];
#pragma unroll
    for (int ps = 0; ps < 2; ++ps) {
        const int rb = F.vcu * 64 + F.wave * 8 + ps * 4;
        float rstd[4];
#pragma unroll
        for (int r = 0; r < 4; ++r) {
            f32x4 xg[4]; float ss = 0.f;
#pragma unroll
            for (int i = 0; i < 4; ++i) { const f32x4 v = *(const f32x4*)(a.out + (size_t)(rb + r) * DM + 4 * lane + 256 * i); const f32x4 g = *(const f32x4*)(a.g_ffn + 4 * lane + 256 * i);
                ss += (v[0] * v[0] + v[1] * v[1]) + (v[2] * v[2] + v[3] * v[3]); xg[i] = v * g; }
            rstd[r] = rsqrtf(wave_sum(ss) * (1.f / DM) + EPS);
            unsigned char* hp = (unsigned char*)(ws + WS_XN) + (size_t)(rb + r) * DM + 4 * lane;
#pragma unroll
            for (int i = 0; i < 4; ++i) { const f32x4 h = xg[i] * rstd[r]; *(unsigned*)(hp + 256 * i) = pk4_fp8(h[0], h[1], h[2], h[3]); }
        }
        float lg[2];
#pragma unroll
        for (int eh = 0; eh < 2; ++eh) {
            f32x2v acc[4][8];
#pragma unroll
            for (int r = 0; r < 4; ++r)
#pragma unroll
                for (int e = 0; e < 8; ++e) acc[r][e] = (f32x2v){0.f, 0.f};
#pragma unroll 1
            for (int i = 0; i < 4; ++i) {
                f32x4 xv[4];
#pragma unroll
                for (int r = 0; r < 4; ++r) xv[r] = *(const f32x4*)(a.out + (size_t)(rb + r) * DM + 4 * lane + 256 * i) * *(const f32x4*)(a.g_ffn + 4 * lane + 256 * i);
#pragma unroll
                for (int j = 0; j < 4; ++j) {
                    const int rho = (i * 4 + j) * 64 + lane;
                    LAS const unsigned char* wp = lds + rho * 128; const int sw = (rho >> 1) & 7;
#pragma unroll
                    for (int k = 0; k < 4; ++k) {
                        const f32x4 w4 = *(LAS const f32x4*)(wp + (((4 * eh + k) ^ sw) << 4));
#pragma unroll
                        for (int r = 0; r < 4; ++r) { const float xs_ = xv[r][j]; acc[r][2 * k] += (f32x2v){xs_, xs_} * (f32x2v){w4[0], w4[1]}; acc[r][2 * k + 1] += (f32x2v){xs_, xs_} * (f32x2v){w4[2], w4[3]}; }
                    }
                }
            }
            const unsigned m32 = opq_mask((lane & 32) != 0), m16 = opq_mask((lane & 16) != 0), m8 = opq_mask((lane & 8) != 0), m4 = opq_mask((lane & 4) != 0), m2 = opq_mask((lane & 2) != 0), m1 = opq_mask((lane & 1) != 0);
#define TRX(dst, lo_, hi_, mm, MASK) { const float s_ = blendf(mm, lo_, hi_), k_ = blendf(mm, hi_, lo_); dst = k_ + __shfl_xor(s_, MASK); }
            f32x2v a1[2][8];
#pragma unroll
            for (int r = 0; r < 2; ++r)
#pragma unroll
                for (int e = 0; e < 8; ++e) { TRX(a1[r][e][0], acc[r][e][0], acc[r + 2][e][0], m32, 32) TRX(a1[r][e][1], acc[r][e][1], acc[r + 2][e][1], m32, 32) }
            f32x2v a2[8];
#pragma unroll
            for (int e = 0; e < 8; ++e) { TRX(a2[e][0], a1[0][e][0], a1[1][e][0], m16, 16) TRX(a2[e][1], a1[0][e][1], a1[1][e][1], m16, 16) }
            f32x2v a3[4];
#pragma unroll
            for (int e = 0; e < 4; ++e) { TRX(a3[e][0], a2[e][0], a2[e + 4][0], m8, 8) TRX(a3[e][1], a2[e][1], a2[e + 4][1], m8, 8) }
            f32x2v a4[2];
#pragma unroll
            for (int e = 0; e < 2; ++e) { TRX(a4[e][0], a3[e][0], a3[e + 2][0], m4, 4) TRX(a4[e][1], a3[e][1], a3[e + 2][1], m4, 4) }
            f32x2v a5;
            TRX(a5[0], a4[0][0], a4[1][0], m2, 2) TRX(a5[1], a4[0][1], a4[1][1], m2, 2)
            float a6;
            TRX(a6, a5[0], a5[1], m1, 1)
#undef TRX
            lg[eh] = a6;
        }
        const int rr = lane >> 4, e0 = lane & 15, e1 = 16 + (lane & 15);
        const unsigned mr1 = opq_mask((rr & 1) != 0), mr2 = opq_mask((rr & 2) != 0);
        const float rs = blendf(mr2, blendf(mr1, rstd[3], rstd[2]), blendf(mr1, rstd[1], rstd[0]));
        const float l0 = lg[0] * rs + a.b_r[e0], l1 = lg[1] * rs + a.b_r[e1];
        bool t0 = false, t1 = false; float val[4]; int idx[4];
#pragma unroll
        for (int k = 0; k < 4; ++k) {
            const float c0 = t0 ? -INFINITY : l0, c1 = t1 ? -INFINITY : l1;
            float bv = (c0 >= c1) ? c0 : c1; int bi = (c0 >= c1) ? e0 : e1;
#pragma unroll
            for (int mk = 1; mk < 16; mk <<= 1) { const float ov = __shfl_xor(bv, mk); const int oi = __shfl_xor(bi, mk); const bool take = (ov > bv) || (ov == bv && oi < bi); bv = take ? ov : bv; bi = take ? oi : bi; }
            val[k] = bv; idx[k] = bi; t0 = t0 || (bi == e0); t1 = t1 || (bi == e1);
        }
        float ex[4], sum = 0.f;
#pragma unroll
        for (int k = 0; k < 4; ++k) { ex[k] = __expf(val[k] - val[0]); sum += ex[k]; }
        const int kk = lane & 15;
        const unsigned mk1 = opq_mask((kk & 1) != 0), mk2 = opq_mask((kk & 2) != 0);
        const int my_e = blendi(mk2, blendi(mk1, idx[3], idx[2]), blendi(mk1, idx[1], idx[0]));
        const float my_g = blendf(mk2, blendf(mk1, ex[3], ex[2]), blendf(mk1, ex[1], ex[0])) / sum;
        int rank = 0;
        if (kk < 4) rank = (int)__hip_atomic_fetch_add((LAS unsigned*)(lds + LR_LCNT) + my_e, 1u, __ATOMIC_RELAXED, __HIP_MEMORY_SCOPE_WORKGROUP);
        as_e[ps] = my_e; as_rank[ps] = rank; as_gate[ps] = my_g;
    }
    __syncthreads();
    if (tid < 32) gbase[tid] = __hip_atomic_fetch_add((unsigned*)(F.ctl + CW_GCNT) + tid, lcnt[tid], __ATOMIC_RELAXED, __HIP_MEMORY_SCOPE_AGENT);
    __syncthreads();
#pragma unroll
    for (int ps = 0; ps < 2; ++ps) {
        const int row = F.vcu * 64 + F.wave * 8 + ps * 4 + (lane >> 4), kk = lane & 15;
        if (kk < 4) { R.tok_e[row * 4 + kk] = as_e[ps]; R.tok_slot[row * 4 + kk] = (int)gbase[as_e[ps]] + as_rank[ps]; R.tok_gate[row * 4 + kk] = as_gate[ps]; }
    }
}

__device__ __forceinline__ void build_tables(Frame& F) {
    LAS int* poff = (LAS int*)(F.lds + LT_POFF); LAS int* ntp = (LAS int*)(F.lds + LT_NT); LAS int* tile_e = (LAS int*)(F.lds + LT_TILE_E);
    LAS int* cnts = (LAS int*)(F.lds + LR_LCNT); const int tid = tid_now();
    if (tid < NE) cnts[tid] = (int)__hip_atomic_load((unsigned*)(F.ctl + CW_GCNT) + tid, __ATOMIC_RELAXED, __HIP_MEMORY_SCOPE_AGENT);
    __syncthreads();
    if (tid == 0) {
        int t = 0;
        for (int e = 0; e < NE; ++e) { const int c = cnts[e]; const int nt = (c + 255) >> 8; poff[e] = t * 256; for (int i = 0; i < nt; ++i) tile_e[t + i] = e; t += nt; }
        *ntp = t;
    }
    __syncthreads();
}
__device__ __forceinline__ void gather_phase(Frame& F, const Args& a) {
    unsigned char* ws = a.ws; const int lane = tid_now() & 63; const RouteBufs R = route_bufs(ws);
    LAS const int* poff = (LAS const int*)(F.lds + LT_POFF);
    const int gw = F.vcu * NWAVES + F.wave, NGW = F.G * NWAVES;
    for (int m = gw; m < T; m += NGW) {
        const v4u* src = (const v4u*)((const unsigned char*)(ws + WS_XN) + (size_t)m * DM);
        const v4u h0 = src[lane];
#pragma unroll
        for (int k = 0; k < 4; ++k) { const int e = R.tok_e[m * 4 + k], slot = R.tok_slot[m * 4 + k];
            v4u* dst = (v4u*)((unsigned char*)(ws + WS_XS) + (size_t)(poff[e] + slot) * DM); dst[lane] = h0; }
    }
}
__device__ __forceinline__ void combine_phase(Frame& F, const Args& a) {
    unsigned char* ws = a.ws; const RouteBufs R = route_bufs(ws);
    LAS const int* poff = (LAS const int*)(F.lds + LT_POFF);
    const int gw = F.vcu * NWAVES + F.wave, NGW = F.G * NWAVES, lane = tid_now() & 63;
    for (int m = gw; m < T; m += NGW) {
        f32x4 v[4];
#pragma unroll
        for (int i = 0; i < 4; ++i) v[i] = *(const f32x4*)(a.out + (size_t)m * DM + 4 * lane + 256 * i);
#pragma unroll
        for (int k = 0; k < 4; ++k) {
            const int e = R.tok_e[m * 4 + k], slot = R.tok_slot[m * 4 + k]; const float gt = R.tok_gate[m * 4 + k];
            const bf16* yr = (const bf16*)(ws + WS_YS) + (size_t)(poff[e] + slot) * DM + 4 * lane;
#pragma unroll
            for (int i = 0; i < 4; ++i) { const u32x2_t y = *(const u32x2_t*)(yr + 256 * i);
                v[i][0] += gt * __uint_as_float(y.x << 16); v[i][1] += gt * __uint_as_float(y.x & 0xffff0000u); v[i][2] += gt * __uint_as_float(y.y << 16); v[i][3] += gt * __uint_as_float(y.y & 0xffff0000u); }
        }
        float ss = 0.f;
#pragma unroll
        for (int i = 0; i < 4; ++i) ss += (v[i][0] * v[i][0] + v[i][1] * v[i][1]) + (v[i][2] * v[i][2] + v[i][3] * v[i][3]);
        const float rstd = rsqrtf(wave_sum(ss) * (1.f / DM) + EPS);
        bf16* np = (bf16*)(ws + WS_XN) + (size_t)m * DM + 4 * lane;
#pragma unroll
        for (int i = 0; i < 4; ++i) { *(f32x4*)(a.out + (size_t)m * DM + 4 * lane + 256 * i) = v[i]; const f32x4 g = *(const f32x4*)(a.g_ple + 4 * lane + 256 * i);
            u32x2_t o; o.x = cvtpk(v[i][0] * rstd * g[0], v[i][1] * rstd * g[1]); o.y = cvtpk(v[i][2] * rstd * g[2], v[i][3] * rstd * g[3]); *(u32x2_t*)(np + 256 * i) = o; }
    }
}

__global__ void __launch_bounds__(NWAVES * 64, 2) mega_fwd(Args args) {
    extern __shared__ __attribute__((aligned(16))) unsigned char lds[];
    Frame F;
    F.lds = (LAS unsigned char*)lds;
    F.MISC = (volatile LAS unsigned*)(F.lds + MISC_OFF);
    F.wave = __builtin_amdgcn_readfirstlane(threadIdx.x >> 6);
    F.G = gridDim.x; { const int bx = blockIdx.x; F.vcu = (F.G % 8 == 0) ? (bx % 8) * (F.G / 8) + bx / 8 : bx; }
    unsigned char* ws = args.ws;
    F.ctl = (gu32*)(ws + WS_CTL);
    for (int u = threadIdx.x; u < (LDS_BYTES - LDSCTL_OFF) / 4; u += NWAVES * 64) ((LAS unsigned*)(F.lds + LDSCTL_OFF))[u] = 0u;
    __syncthreads();
    XcdBarrier bar = xcd_barrier_post((unsigned*)(F.ctl + CW_BAR), F.MISC + 8);
    const int lo = args.ph_lo, hi = args.ph_hi;
#define IN(k) (lo <= (k) && (k) < hi)
#define GRID_BAR() xcd_barrier(bar)
#ifndef DUP_PHASE
#define DUP_PHASE -1
#endif
#define REP(k) for (int rep_ = 0; rep_ < ((DUP_PHASE) == (k) ? 2 : 1); ++rep_)

    if (IN(0)) REP(0) { p0_prologue(F, args); GRID_BAR(); }

    if (IN(1)) REP(1) {
        pg8::Gemm g{(const pg8::bf16_t*)(ws + WS_XN), (const pg8::bf16_t*)(ws + WS_WT_IN), DM, 0};
        pg8::StaticOrder S; S.init(T / 256, DIN / 256, F.G, (int)blockIdx.x);
        pg8::EpiProj E{(pg8::bf16_t*)(ws + WS_HM), (pg8::bf16_t*)(ws + WS_RG), (const float*)(ws + WS_GAINS), (const float*)(ws + WS_ROPEC), (const float*)(ws + WS_ROPES)};
        pg8::gemm_phase<pg8::EpiProj, pg8::StaticOrder, true, true>(F.lds + RING_OFF, g, S, E);
        GRID_BAR();
    }
    if (IN(2)) REP(2) {
        if (F.G == 256) {
            const att::AttnArgs AA{(const bf16*)(ws + WS_HM), (const bf16*)(ws + WS_RG), (bf16*)(ws + WS_Y), args.gn_g, args.gn_b};
            att::attn_phase(F.lds + RING_OFF, AA, F.vcu);
        }
        GRID_BAR();
    }
    if (IN(3)) REP(3) {
        {
        pg8::Gemm g2{(const pg8::bf16_t*)(ws + WS_PB), (const pg8::bf16_t*)(ws + WS_WT_PP), PLE, 0};
        pg8::StaticOrder S2; S2.init(T / 256, DM / 256, F.G, (int)blockIdx.x);
        pg8::EpiBf16Plain E2{(pg8::bf16_t*)(ws + WS_PJ), DM};
        pg8::gemm_phase<pg8::EpiBf16Plain, pg8::StaticOrder, true, true>(F.lds + RING_OFF, g2, S2, E2); }
        pg8::Gemm g{(const pg8::bf16_t*)(ws + WS_Y), (const pg8::bf16_t*)(ws + WS_WT_OUT), DM, 0};
        pg8::StaticOrder S; S.init(T / 256, DM / 256, F.G, (int)blockIdx.x);
        pg8::EpiResid E{args.x, args.out};
        pg8::gemm_phase<pg8::EpiResid, pg8::StaticOrder, true, true>(F.lds + RING_OFF, g, S, E);
        GRID_BAR();
    }
    if (IN(4)) { if (F.G == 256) router_phase(F, args); GRID_BAR(); }
    if (IN(5) || (lo >= 6 && lo <= 8)) build_tables(F);
    if (IN(5)) REP(5) { gather_phase(F, args); GRID_BAR(); }
    if (IN(6)) REP(6) {
        const int NT = *(LAS const int*)(F.lds + LT_NT);
        pg8::Gemm g{(const pg8::bf16_t*)(ws + WS_XS), (const pg8::bf16_t*)(ws + WS_WT_UG), DM / 2, (size_t)2048 * DM};
        pg8::MoeOrder S; S.init(NT, 8, F.G, (int)blockIdx.x, (LAS const int*)(F.lds + LT_TILE_E));
        pg8::EpiMoeUp E{(unsigned char*)(ws + WS_H), args.b_ug};
        pg8::gemm_phase<pg8::EpiMoeUp, pg8::MoeOrder, true, false, true>(F.lds + RING_OFF, g, S, E);
        GRID_BAR();
    }
    if (IN(7)) REP(7) {
        const int NT = *(LAS const int*)(F.lds + LT_NT);
        pg8::Gemm g{(const pg8::bf16_t*)(ws + WS_H), (const pg8::bf16_t*)(ws + WS_WT_DN), DM / 2, (size_t)DM * DM};
        pg8::MoeOrder S; S.init(NT, 4, F.G, (int)blockIdx.x, (LAS const int*)(F.lds + LT_TILE_E));
        pg8::EpiMoeDown E{(pg8::bf16_t*)(ws + WS_YS), args.b_dn};
        pg8::gemm_phase<pg8::EpiMoeDown, pg8::MoeOrder, true, false, true>(F.lds + RING_OFF, g, S, E);
        GRID_BAR();
    }
    if (IN(8)) { combine_phase(F, args); GRID_BAR(); }
    if (IN(9)) {
        pg8::Gemm g{(const pg8::bf16_t*)(ws + WS_XN), (const pg8::bf16_t*)(ws + WS_WT_PG), DM, 0};
        pg8::StaticOrder S; S.init(T / 256, DM / 256, F.G, (int)blockIdx.x);
        pg8::EpiPle E{args.out, (const pg8::bf16_t*)(ws + WS_PJ)};
        pg8::gemm_phase<pg8::EpiPle, pg8::StaticOrder, true, true>(F.lds + RING_OFF, g, S, E);
    }
#undef IN
}
extern "C" void kernel_launch(void* const* d_in, const int* in_sizes, int n_in, void* d_out, int out_size, void* d_ws, size_t ws_size, hipStream_t stream) {
    static int grid = 0;
    if (grid == 0) {
        if (n_in != 22 || ws_size < 1024 * MiB) { fprintf(stderr, "kernel_launch: unexpected n_in %d / ws %zu\n", n_in, ws_size); grid = -1; return; }
        int dev = 0, cus = 0, per_cu = 0;
        if (hipGetDevice(&dev) != hipSuccess || hipDeviceGetAttribute(&cus, hipDeviceAttributeMultiprocessorCount, dev) != hipSuccess) { grid = -1; return; }
        if (hipFuncSetAttribute((const void*)mega_fwd, hipFuncAttributeMaxDynamicSharedMemorySize, LDS_BYTES) != hipSuccess) { fprintf(stderr, "kernel_launch: hipFuncSetAttribute failed\n"); grid = -1; return; }
        if (hipOccupancyMaxActiveBlocksPerMultiprocessor(&per_cu, (const void*)mega_fwd, NWAVES * 64, LDS_BYTES) != hipSuccess || per_cu < 1) { fprintf(stderr, "kernel_launch: occupancy query says %d\n", per_cu); per_cu = 1; }
        (void)hipGetLastError();
        grid = cus;
    }
    if (grid < 0) return;
    (void)hipMemsetAsync((char*)d_ws + WS_CTL, 0, CTL_ZERO_BYTES, stream);
    Args a{};
    a.x = (const float*)d_in[0]; a.p = (const float*)d_in[1]; a.positions = (const int*)d_in[2]; a.g_mix = (const float*)d_in[3]; a.w_in = (const float*)d_in[4];
    a.sbq = (const float*)d_in[5]; a.sbk = (const float*)d_in[6]; a.rq = (const float*)d_in[7]; a.rk = (const float*)d_in[8]; a.gn_g = (const float*)d_in[9]; a.gn_b = (const float*)d_in[10];
    a.w_out = (const float*)d_in[11]; a.g_ffn = (const float*)d_in[12]; a.w_r = (const float*)d_in[13]; a.b_r = (const float*)d_in[14]; a.w_ug = (const float*)d_in[15]; a.b_ug = (const float*)d_in[16];
    a.w_dn = (const float*)d_in[17]; a.b_dn = (const float*)d_in[18]; a.g_ple = (const float*)d_in[19]; a.w_pg = (const float*)d_in[20]; a.w_pp = (const float*)d_in[21];
    a.out = (float*)d_out; a.ws = (unsigned char*)d_ws; a.ph_lo = 0; a.ph_hi = 10;
    hipLaunchKernelGGL(mega_fwd, dim3(grid), dim3(NWAVES * 64), LDS_BYTES, stream, a);

}
```

```cpp
#include <hip/hip_runtime.h>
#include <cstdint>
#include <cstdio>
#include <cmath>

namespace pg8 {
#define PG8_LAS __attribute__((address_space(3)))
typedef unsigned short bf16_t;
typedef short bf16x8 __attribute__((ext_vector_type(8)));
typedef float f32x4 __attribute__((ext_vector_type(4)));
typedef unsigned u32x4 __attribute__((ext_vector_type(4)));
typedef unsigned u32x2 __attribute__((ext_vector_type(2)));
typedef int v4i32 __attribute__((ext_vector_type(4)));
typedef int v8i32 __attribute__((ext_vector_type(8)));
constexpr int BM = 256, BK = 64, HALF = 128, HTB = HALF * BK * 2  , STAGE_BYTES = 8 * HTB, NXCD = 8, WGM = 8;

__host__ __device__ __forceinline__ int lds_byte(int r, int c) { const int st = (r >> 4) * 2 + (c >> 5), rr = r & 15, cc = c & 31, ob = rr * 64 + cc * 2; return st * 1024 + (ob ^ (((ob >> 9) & 1) << 5)); }
__host__ __device__ __forceinline__ void stage_rc(int b, int& R, int& C) { const int st = b / 1024, sb = b % 1024, swz = sb ^ (((sb >> 9) & 1) << 5); R = (st >> 1) * 16 + swz / 64; C = (st & 1) * 32 + (swz % 64) / 2; }
__host__ __device__ __forceinline__ int perm32(int rho) { const int n = rho >> 4, i = rho & 15; return 8 * (i >> 2) + 4 * n + (i & 3); }

struct Unit { int pm, pn, e; };
struct Gemm { const bf16_t* A; const bf16_t* Bt; int K; size_t strideBe; };

struct StaticOrder {
    int nM, nN, nwg, G, c;
    __host__ __device__ void init(int nM_, int nN_, int G_, int c_) { nM = nM_; nN = nN_; nwg = nM * nN; G = G_; c = c_; }
    __host__ __device__ bool next(int i, Unit& u) const {
        const long L = (long)i * G + c; if (L >= nwg) return false;
        int wgid = (int)L; { const int q = nwg / NXCD, r = nwg % NXCD, xcd = wgid % NXCD, off = wgid / NXCD; wgid = (xcd < r ? xcd * (q + 1) : r * (q + 1) + (xcd - r) * q) + off; }
        const int nig = WGM * nN, gid = wgid / nig, fm = gid * WGM, gsz = (nM - fm) < WGM ? (nM - fm) : WGM;
        u.pm = fm + ((wgid % nig) % gsz); u.pn = (wgid % nig) / gsz; u.e = 0; return true;
    }
    __device__ __forceinline__ void a_ready(const Unit&) const {}
    __device__ __forceinline__ void done(const Unit&) const {}
};

typedef float f32x2_t __attribute__((ext_vector_type(2))); typedef __bf16 bf16x2_t __attribute__((ext_vector_type(2)));
__device__ __forceinline__ unsigned cvt_pk_bf16(float lo, float hi) { f32x2_t v = {lo, hi}; bf16x2_t b = __builtin_convertvector(v, bf16x2_t); return __builtin_bit_cast(unsigned, b); }

constexpr int T = 16384, SEQ = 2048, DM = 1024, DIN = 3584;
constexpr float EPS = 1e-6f;
__device__ __forceinline__ u32x4 pack8(const f32x4 a, const f32x4 b) { u32x4 w; w.x = cvt_pk_bf16(a[0], a[1]); w.y = cvt_pk_bf16(a[2], a[3]); w.z = cvt_pk_bf16(b[0], b[1]); w.w = cvt_pk_bf16(b[2], b[3]); return w; }

struct EpiProj {
    static constexpr bool PERM = true, AFTER_DRAIN = false;
    bf16_t* hm;
    bf16_t* rg;
    const float* gains;
    const float *ropec, *ropes;
    __device__ __forceinline__ void operator()(const f32x4 (&acc)[2][2][4][2], const Unit& u, int wr, int wc, int fr, int fq) const {
        const int region = u.pn >> 1, hb = 4 * (u.pn & 1) + wc;
        const bool normed = (region == 0) || (region == 1) || (region == 3) || (region == 4);
        const bool rope = (region == 3) || (region == 4);
        const int gidx = region == 0 ? 0 : region == 1 ? 1 : region == 3 ? 2 : 3;
        const float* gp = gains + gidx * 64;
        f32x4 gv[2][2];
#pragma unroll
        for (int bj = 0; bj < 2; ++bj)
#pragma unroll
            for (int n = 0; n < 2; ++n) gv[bj][n] = normed ? *(const f32x4*)(gp + 32 * bj + 8 * fq + 4 * n) : (f32x4){1.f, 1.f, 1.f, 1.f};
        const float lg2g = __log2f(1.0f - __builtin_amdgcn_exp2f(-5.0f - (float)hb));
        const float scale = region == 0 ? 0.125f * 1.4426950408889634f : region == 4 ? 0.125f : 1.0f;
#pragma unroll
        for (int ai = 0; ai < 2; ++ai)
#pragma unroll
            for (int m = 0; m < 4; ++m) {
                const int row = u.pm * BM + ai * HALF + wr * 64 + m * 16 + fr;
                const int b = row >> 11, s = row & (SEQ - 1);
                f32x4 v[2][2];
#pragma unroll
                for (int bj = 0; bj < 2; ++bj)
#pragma unroll
                    for (int n = 0; n < 2; ++n) v[bj][n] = acc[ai][bj][m][n];
                if (normed) {
                    float ss = 0.f;
#pragma unroll
                    for (int bj = 0; bj < 2; ++bj)
#pragma unroll
                        for (int n = 0; n < 2; ++n) { const f32x4 x = v[bj][n]; ss += (x[0] * x[0] + x[1] * x[1]) + (x[2] * x[2] + x[3] * x[3]); }
                    ss += __shfl_xor(ss, 16); ss += __shfl_xor(ss, 32);
                    float rs = rsqrtf(ss * (1.0f / 64.0f) + EPS) * scale;
                    if (rope) rs *= (region == 3) ? __builtin_amdgcn_exp2f((float)(s & 31) * lg2g) : __builtin_amdgcn_exp2f(-(float)(s & 63) * lg2g);
#pragma unroll
                    for (int bj = 0; bj < 2; ++bj)
#pragma unroll
                        for (int n = 0; n < 2; ++n) v[bj][n] = v[bj][n] * rs * gv[bj][n];
                    if (rope) {
#pragma unroll
                        for (int n = 0; n < 2; ++n) {
                            const f32x4 c = *(const f32x4*)(ropec + (size_t)row * 32 + 8 * fq + 4 * n), sn = *(const f32x4*)(ropes + (size_t)row * 32 + 8 * fq + 4 * n);
                            const f32x4 lo = v[0][n], hi = v[1][n];
                            v[0][n] = lo * c - hi * sn; v[1][n] = hi * c + lo * sn;
                        }
                    }
                }
                bf16_t* dst = (region < 6) ? hm + (size_t)region * ((size_t)T * 512) + ((size_t)(b * 8 + hb) * SEQ + s) * 64 + 8 * fq
                                           : rg + (size_t)row * 512 + hb * 64 + 8 * fq;
#pragma unroll
                for (int bj = 0; bj < 2; ++bj) *(u32x4*)(dst + 32 * bj) = pack8(v[bj][0], v[bj][1]);
            }
    }
};

struct EpiBf16Plain {
    static constexpr bool PERM = true, AFTER_DRAIN = false;
    bf16_t* O; int ldc;
    __device__ __forceinline__ void operator()(const f32x4 (&acc)[2][2][4][2], const Unit& u, int wr, int wc, int fr, int fq) const {
        const int row0 = u.pm * BM + wr * 64 + fr, col0 = u.pn * BM + wc * 32 + 8 * fq;
#pragma unroll
        for (int ai = 0; ai < 2; ++ai)
#pragma unroll
            for (int m = 0; m < 4; ++m) { bf16_t* rowp = O + (size_t)(row0 + ai * HALF + m * 16) * ldc + col0;
#pragma unroll
                for (int bj = 0; bj < 2; ++bj) *(u32x4*)(rowp + bj * HALF) = pack8(acc[ai][bj][m][0], acc[ai][bj][m][1]); }
    }
};
struct EpiResid {
    static constexpr bool PERM = false, AFTER_DRAIN = false;
    const float* base; float* out;
    __device__ __forceinline__ void operator()(const f32x4 (&acc)[2][2][4][2], const Unit& u, int wr, int wc, int fr, int fq) const {
        const int col0 = u.pn * BM + wc * 32 + 4 * fq;
#pragma unroll
        for (int ai = 0; ai < 2; ++ai)
#pragma unroll
            for (int m = 0; m < 4; ++m) { const size_t off = (size_t)(u.pm * BM + ai * HALF + wr * 64 + m * 16 + fr) * DM + col0;
#pragma unroll
                for (int bj = 0; bj < 2; ++bj)
#pragma unroll
                    for (int n = 0; n < 2; ++n) { const f32x4 bs = *(const f32x4*)(base + off + bj * HALF + n * 16); *(f32x4*)(out + off + bj * HALF + n * 16) = bs + acc[ai][bj][m][n]; } }
    }
};
struct EpiMoeUp {
    static constexpr bool PERM = true, AFTER_DRAIN = false;
    unsigned char* H; const float* bias; const float* srstd;
    __device__ __forceinline__ void operator()(const f32x4 (&acc)[2][2][4][2], const Unit& u, int wr, int wc, int fr, int fq) const {
        const int cc = 128 * u.pn + 32 * wc + 8 * fq;
        const float* bp = bias + (size_t)u.e * 2048 + cc;
        f32x4 bg[2], bl[2];
#pragma unroll
        for (int n = 0; n < 2; ++n) { bg[n] = *(const f32x4*)(bp + 4 * n); bl[n] = *(const f32x4*)(bp + 1024 + 4 * n); }
#pragma unroll
        for (int ai = 0; ai < 2; ++ai)
#pragma unroll
            for (int m = 0; m < 4; ++m) {
                f32x4 hv[2]; const float sc = srstd[u.pm * BM + ai * HALF + wr * 64 + m * 16 + fr] * 0.015625f;
#pragma unroll
                for (int n = 0; n < 2; ++n) {
                    const f32x4 g0 = acc[ai][0][m][n] * sc + bg[n], l0 = acc[ai][1][m][n] * sc + bl[n];
#pragma unroll
                    for (int j = 0; j < 4; ++j) {
                        const float glu = __builtin_fminf(g0[j], 7.0f), lin = __builtin_fminf(__builtin_fmaxf(l0[j], -7.0f), 7.0f);
                        const float sg = __builtin_amdgcn_rcpf(1.0f + __builtin_amdgcn_exp2f(-1.702f * 1.4426950408889634f * glu));
                        hv[n][j] = glu * sg * (lin + 1.0f);
                    }
                }
                u32x2 hq; hq.x = (unsigned)__builtin_amdgcn_cvt_pk_fp8_f32(hv[0][0], hv[0][1], 0, false); hq.x = (unsigned)__builtin_amdgcn_cvt_pk_fp8_f32(hv[0][2], hv[0][3], (int)hq.x, true);
                hq.y = (unsigned)__builtin_amdgcn_cvt_pk_fp8_f32(hv[1][0], hv[1][1], 0, false); hq.y = (unsigned)__builtin_amdgcn_cvt_pk_fp8_f32(hv[1][2], hv[1][3], (int)hq.y, true);
                *(u32x2*)(H + (size_t)(u.pm * BM + ai * HALF + wr * 64 + m * 16 + fr) * 1024 + cc) = hq;
            }
    }
};
struct EpiMoeDown {
    static constexpr bool PERM = true, AFTER_DRAIN = false;
    bf16_t* YS; const float* bias;
    __device__ __forceinline__ void operator()(const f32x4 (&acc)[2][2][4][2], const Unit& u, int wr, int wc, int fr, int fq) const {
        const int col0 = u.pn * BM + wc * 32 + 8 * fq;
        f32x4 bv[2][2];
#pragma unroll
        for (int bj = 0; bj < 2; ++bj)
#pragma unroll
            for (int n = 0; n < 2; ++n) bv[bj][n] = *(const f32x4*)(bias + (size_t)u.e * 1024 + col0 + bj * HALF + 4 * n);
#pragma unroll
        for (int ai = 0; ai < 2; ++ai)
#pragma unroll
            for (int m = 0; m < 4; ++m) { bf16_t* rowp = YS + (size_t)(u.pm * BM + ai * HALF + wr * 64 + m * 16 + fr) * 1024 + col0;
#pragma unroll
                for (int bj = 0; bj < 2; ++bj) *(u32x4*)(rowp + bj * HALF) = pack8(acc[ai][bj][m][0] * 0.015625f + bv[bj][0], acc[ai][bj][m][1] * 0.015625f + bv[bj][1]); }
    }
};
struct EpiPle {
    static constexpr bool PERM = false, AFTER_DRAIN = false;
    float* out; const bf16_t* PJ; float* outw;
    __device__ __forceinline__ void operator()(const f32x4 (&acc)[2][2][4][2], const Unit& u, int wr, int wc, int fr, int fq) const {
        const int col0 = u.pn * BM + wc * 32 + 4 * fq;
#pragma unroll
        for (int ai = 0; ai < 2; ++ai)
#pragma unroll
            for (int m = 0; m < 4; ++m) { const size_t off = (size_t)(u.pm * BM + ai * HALF + wr * 64 + m * 16 + fr) * DM + col0;
#pragma unroll
                for (int bj = 0; bj < 2; ++bj)
#pragma unroll
                    for (int n = 0; n < 2; ++n) {
                        const size_t o2 = off + bj * HALF + n * 16;
                        const f32x4 x2 = *(const f32x4*)(out + o2); const u32x2 pj = *(const u32x2*)(PJ + o2); const f32x4 a = acc[ai][bj][m][n] * 0.015625f;
                        f32x4 r;
                        r[0] = x2[0] + __uint_as_float(pj.x << 16) * __builtin_amdgcn_rcpf(1.0f + __builtin_amdgcn_exp2f(-1.4426950408889634f * a[0]));
                        r[1] = x2[1] + __uint_as_float(pj.x & 0xffff0000u) * __builtin_amdgcn_rcpf(1.0f + __builtin_amdgcn_exp2f(-1.4426950408889634f * a[1]));
                        r[2] = x2[2] + __uint_as_float(pj.y << 16) * __builtin_amdgcn_rcpf(1.0f + __builtin_amdgcn_exp2f(-1.4426950408889634f * a[2]));
                        r[3] = x2[3] + __uint_as_float(pj.y & 0xffff0000u) * __builtin_amdgcn_rcpf(1.0f + __builtin_amdgcn_exp2f(-1.4426950408889634f * a[3]));
                        *(f32x4*)(outw + o2) = r;
                    } }
    }
};
struct MoeOrder {
    int nM, nN, nwg, G, c; const PG8_LAS int* tile_e;
    __device__ void init(int nM_, int nN_, int G_, int c_, const PG8_LAS int* te) { nM = nM_; nN = nN_; nwg = nM * nN; G = G_; c = c_; tile_e = te; }
    __device__ bool next(int i, Unit& u) const {
        const long L = (long)i * G + c; if (L >= nwg) return false;
        int wgid = (int)L; { const int q = nwg / NXCD, r = nwg % NXCD, xcd = wgid % NXCD, off = wgid / NXCD; wgid = (xcd < r ? xcd * (q + 1) : r * (q + 1) + (xcd - r) * q) + off; }
        const int nig = WGM * nN, gid = wgid / nig, fm = gid * WGM, gsz = (nM - fm) < WGM ? (nM - fm) : WGM;
        u.pm = fm + ((wgid % nig) % gsz); u.pn = (wgid % nig) / gsz; u.e = __builtin_amdgcn_readfirstlane(tile_e[u.pm]); return true;
    }
    __device__ __forceinline__ void a_ready(const Unit&) const {}
    __device__ __forceinline__ void done(const Unit&) const {}
};
template <class Epi, class Sched, bool ALIGN_EPI = false, bool SP2 = false, bool F8 = false>
__device__ __forceinline__ void gemm_phase(PG8_LAS unsigned char* lds, const Gemm g, const Sched& S, const Epi& E) {
    int tid_ = threadIdx.x; asm volatile("" : "+v"(tid_));
    const int tid = tid_, wid = __builtin_amdgcn_readfirstlane(tid >> 6), lane = tid & 63, wr = wid >> 2, wc = wid & 3, fr = lane & 15, fq = lane >> 4;
    const int K = g.K, nt = K / BK;
    unsigned voffA[2], voffB[2];
#pragma unroll
    for (int i = 0; i < 2; ++i) { int R, C; stage_rc(tid * 16 + i * 8192, R, C); const int Rb = Epi::PERM ? ((R & ~31) + perm32(R & 31)) : R;
        voffA[i] = (unsigned)(R * K + C) * 2u; voffB[i] = (unsigned)(Rb * K + C) * 2u; }
    const size_t kstep = (size_t)(BK * 2);
    const size_t hstep = (size_t)HALF * K * 2;
    const size_t tstep = 2 * hstep;
    const unsigned ldsw = (unsigned)wid * 1024u;
    const int aoff = lds_byte(wr * 64 + fr, fq * 8), boff = lds_byte(wc * 32 + fr, fq * 8);
#define PG8_SA(b, h) (((b) * 2 + (h)) * HTB)
#define PG8_SB(b, h) ((4 + (b) * 2 + (h)) * HTB)
#define PG8_STAGE(bufoff, gbase, voff) do { _Pragma("unroll") for (int _i = 0; _i < 2; ++_i) \
        __builtin_amdgcn_global_load_lds((const unsigned*)((const char*)(gbase) + (voff)[_i]), (PG8_LAS unsigned*)(lds + (bufoff) + ldsw + _i * 8192), 16, 0, 0); } while (0)
#define PG8_LD16(off) (*(const PG8_LAS v4i32*)(lds + (off)))
#define PG8_LDA(dst, b, h) do { if constexpr (F8) { _Pragma("unroll") for (int m = 0; m < 4; ++m) dst##8[m] = __builtin_shufflevector(PG8_LD16(PG8_SA(b, h) + aoff + m * 2048), PG8_LD16(PG8_SA(b, h) + aoff + m * 2048 + 1024), 0, 1, 2, 3, 4, 5, 6, 7); } \
        else { _Pragma("unroll") for (int m = 0; m < 4; ++m) _Pragma("unroll") for (int k = 0; k < 2; ++k) dst[m][k] = *(const PG8_LAS bf16x8*)(lds + PG8_SA(b, h) + aoff + m * 2048 + k * 1024); } } while (0)
#define PG8_LDB(dst, b, h) do { if constexpr (F8) { _Pragma("unroll") for (int n = 0; n < 2; ++n) dst##8[n] = __builtin_shufflevector(PG8_LD16(PG8_SB(b, h) + boff + n * 2048), PG8_LD16(PG8_SB(b, h) + boff + n * 2048 + 1024), 0, 1, 2, 3, 4, 5, 6, 7); } \
        else { _Pragma("unroll") for (int n = 0; n < 2; ++n) _Pragma("unroll") for (int k = 0; k < 2; ++k) dst[n][k] = *(const PG8_LAS bf16x8*)(lds + PG8_SB(b, h) + boff + n * 2048 + k * 1024); } } while (0)
#define PG8_MMA(ai, bj, At, Bt) do { __builtin_amdgcn_s_setprio(1); \
        if constexpr (F8) { _Pragma("unroll") for (int m = 0; m < 4; ++m) _Pragma("unroll") for (int n = 0; n < 2; ++n) \
            asm volatile("v_mfma_scale_f32_16x16x128_f8f6f4 %0, %1, %2, %0, %3, %3 op_sel_hi:[0,0,0]" : "+v"(acc[ai][bj][m][n]) : "v"(Bt##8[n]), "v"(At##8[m]), "v"(f8scale)); } \
        else { _Pragma("unroll") for (int m = 0; m < 4; ++m) _Pragma("unroll") for (int n = 0; n < 2; ++n) _Pragma("unroll") for (int k = 0; k < 2; ++k) \
            acc[ai][bj][m][n] = __builtin_amdgcn_mfma_f32_16x16x32_bf16(Bt[n][k], At[m][k], acc[ai][bj][m][n], 0, 0, 0); } \
        __builtin_amdgcn_s_setprio(0); } while (0)
#define PG8_WAIT_V(n) asm volatile("s_waitcnt vmcnt(" #n ")" ::: "memory")
#define PG8_WAIT_L(n) asm volatile("s_waitcnt lgkmcnt(" #n ")" ::: "memory")
#define PG8_BAR __builtin_amdgcn_s_barrier()
#define PG8_SCHED __builtin_amdgcn_sched_barrier(0)
    Unit cur, nxt; int ui = 0;
    if (!S.next(0, cur)) return;
    f32x4 acc[2][2][4][2];
#pragma unroll
    for (int a = 0; a < 2; ++a)
#pragma unroll
        for (int b = 0; b < 2; ++b)
#pragma unroll
            for (int m = 0; m < 4; ++m)
#pragma unroll
                for (int n = 0; n < 2; ++n) acc[a][b][m][n] = (f32x4){0.f, 0.f, 0.f, 0.f};
    bf16x8 At[4][2], B0[2][2], B1[2][2];
    v8i32 At8[4], B08[2], B18[2]; const int f8scale = 0x7f7f7f7f;
    const char* cA = (const char*)g.A + (size_t)cur.pm * tstep; const char* cB = (const char*)g.Bt + (size_t)cur.e * g.strideBe + (size_t)cur.pn * tstep;
    S.a_ready(cur);
    if constexpr (SP2) {
        PG8_STAGE(PG8_SB(0, 0), cB, voffB); PG8_STAGE(PG8_SB(0, 1), cB + hstep, voffB); PG8_STAGE(PG8_SA(0, 0), cA, voffA); PG8_STAGE(PG8_SA(0, 1), cA + hstep, voffA);
        if (wr == 1) PG8_BAR;
        PG8_WAIT_V(2); PG8_BAR;
        PG8_STAGE(PG8_SB(1, 0), cB + kstep, voffB); PG8_STAGE(PG8_SA(1, 0), cA + kstep, voffA); PG8_STAGE(PG8_SB(1, 1), cB + hstep + kstep, voffB);
        PG8_WAIT_V(6); PG8_BAR;
    } else {
        PG8_STAGE(PG8_SB(0, 0), cB, voffB); PG8_STAGE(PG8_SA(0, 0), cA, voffA); PG8_STAGE(PG8_SB(0, 1), cB + hstep, voffB); PG8_STAGE(PG8_SA(0, 1), cA + hstep, voffA);
        if (wr == 1) PG8_BAR;
        PG8_WAIT_V(4); PG8_BAR;
        PG8_STAGE(PG8_SB(1, 0), cB + kstep, voffB); PG8_STAGE(PG8_SA(1, 0), cA + kstep, voffA); PG8_STAGE(PG8_SB(1, 1), cB + hstep + kstep, voffB);
        PG8_WAIT_V(6); PG8_BAR;
    }
    for (;;) {
        const bool has_next = S.next(ui + 1, nxt);
        const char* nA = has_next ? (const char*)g.A + (size_t)nxt.pm * tstep : cA; const char* nB = has_next ? (const char*)g.Bt + (size_t)nxt.e * g.strideBe + (size_t)nxt.pn * tstep : cB;
#pragma unroll 1
        for (int t = 0; t < nt; t += 2) {
            const bool last = (t == nt - 2);
            const char* a1 = cA + (size_t)(t + 1) * kstep;
            const char* a2 = last ? nA : cA + (size_t)(t + 2) * kstep; const char* b2 = last ? nB : cB + (size_t)(t + 2) * kstep;
            const char* a3 = a2 + kstep; const char* b3 = b2 + kstep;
            if (last && has_next) S.a_ready(nxt);
            if constexpr (SP2) {
            PG8_LDB(B0, 0, 0); PG8_LDB(B1, 0, 1); PG8_SCHED; PG8_LDA(At, 0, 0); PG8_STAGE(PG8_SA(1, 1), a1 + hstep, voffA);
            PG8_WAIT_V(8); PG8_WAIT_L(0); PG8_BAR; PG8_MMA(0, 0, At, B0); PG8_MMA(0, 1, At, B1); PG8_BAR; PG8_SCHED;
            PG8_LDA(At, 0, 1); PG8_STAGE(PG8_SB(0, 0), b2, voffB); PG8_STAGE(PG8_SB(0, 1), b2 + hstep, voffB); PG8_STAGE(PG8_SA(0, 0), a2, voffA);
            PG8_WAIT_V(8); PG8_WAIT_L(0); PG8_BAR; PG8_MMA(1, 0, At, B0); PG8_MMA(1, 1, At, B1); PG8_BAR; PG8_SCHED;
            PG8_LDB(B0, 1, 0); PG8_LDB(B1, 1, 1); PG8_SCHED; PG8_LDA(At, 1, 0); PG8_STAGE(PG8_SA(0, 1), a2 + hstep, voffA);
            PG8_WAIT_V(8); PG8_WAIT_L(0); PG8_BAR; PG8_MMA(0, 0, At, B0); PG8_MMA(0, 1, At, B1); PG8_BAR; PG8_SCHED;
            PG8_LDA(At, 1, 1); PG8_STAGE(PG8_SB(1, 0), b3, voffB); PG8_STAGE(PG8_SB(1, 1), b3 + hstep, voffB); PG8_STAGE(PG8_SA(1, 0), a3, voffA);
            PG8_WAIT_V(8); PG8_WAIT_L(0); PG8_BAR; PG8_MMA(1, 0, At, B0); PG8_MMA(1, 1, At, B1); PG8_BAR; PG8_SCHED;
            } else {
            PG8_LDB(B0, 0, 0); PG8_SCHED; PG8_LDA(At, 0, 0); PG8_STAGE(PG8_SA(1, 1), a1 + hstep, voffA);
            PG8_WAIT_L(8); PG8_BAR; PG8_WAIT_L(0); PG8_MMA(0, 0, At, B0); PG8_BAR; PG8_SCHED;
            PG8_LDB(B1, 0, 1); PG8_STAGE(PG8_SB(0, 0), b2, voffB);
            PG8_BAR; PG8_WAIT_L(0); PG8_MMA(0, 1, At, B1); PG8_BAR;
            PG8_LDA(At, 0, 1); PG8_STAGE(PG8_SA(0, 0), a2, voffA);
            PG8_BAR; PG8_WAIT_L(0); PG8_MMA(1, 0, At, B0); PG8_BAR; PG8_SCHED;
            PG8_STAGE(PG8_SB(0, 1), b2 + hstep, voffB);
            PG8_WAIT_V(6); PG8_BAR; PG8_MMA(1, 1, At, B1); PG8_BAR;
            PG8_LDB(B0, 1, 0); PG8_SCHED; PG8_LDA(At, 1, 0); PG8_STAGE(PG8_SA(0, 1), a2 + hstep, voffA);
            PG8_WAIT_L(8); PG8_BAR; PG8_WAIT_L(0); PG8_MMA(0, 0, At, B0); PG8_BAR; PG8_SCHED;
            PG8_LDB(B1, 1, 1); PG8_STAGE(PG8_SB(1, 0), b3, voffB);
            PG8_BAR; PG8_WAIT_L(0); PG8_MMA(0, 1, At, B1); PG8_BAR;
            PG8_LDA(At, 1, 1); PG8_STAGE(PG8_SA(1, 0), a3, voffA);
            PG8_BAR; PG8_WAIT_L(0); PG8_MMA(1, 0, At, B0); PG8_BAR; PG8_SCHED;
            PG8_STAGE(PG8_SB(1, 1), b3 + hstep, voffB);
            PG8_WAIT_V(6); PG8_BAR; PG8_MMA(1, 1, At, B1); PG8_BAR;
            }
        }
        if constexpr (ALIGN_EPI) { if (wr == 0) PG8_BAR; }
        if constexpr (F8) asm volatile("s_nop 15\n\ts_nop 15\n\ts_nop 15" ::: "memory");
        if constexpr (!Epi::AFTER_DRAIN) { E(acc, cur, wr, wc, fr, fq); S.done(cur); }
        if (!has_next) break;
#pragma unroll
        for (int a = 0; a < 2; ++a)
#pragma unroll
            for (int b = 0; b < 2; ++b)
#pragma unroll
                for (int m = 0; m < 4; ++m)
#pragma unroll
                    for (int n = 0; n < 2; ++n) acc[a][b][m][n] = (f32x4){0.f, 0.f, 0.f, 0.f};
        cur = nxt; cA = nA; cB = nB; ++ui;
        if constexpr (ALIGN_EPI) { if (wr == 1) PG8_BAR; }
    }
    PG8_WAIT_V(0);
    if constexpr (!ALIGN_EPI) { if (wr == 0) PG8_BAR; }
    PG8_BAR;
    if constexpr (Epi::AFTER_DRAIN) { E.fused(acc, cur, wr, wc, fr, fq, lds, wid, lane); S.done(cur); }
#undef PG8_SA
#undef PG8_SB
#undef PG8_STAGE
#undef PG8_LD16
#undef PG8_LDA
#undef PG8_LDB
#undef PG8_MMA
#undef PG8_WAIT_V
#undef PG8_WAIT_L
#undef PG8_BAR
#undef PG8_SCHED
}
}

constexpr int NWAVES = 8;
constexpr int T = pg8::T, SEQ = pg8::SEQ, DM = pg8::DM, DIN = pg8::DIN, NE = 32, PLE = 256;
constexpr float EPS = pg8::EPS;
constexpr size_t MiB = 1u << 20;
constexpr size_t WS_CTL = 0, CTL_ZERO_BYTES = 1 * MiB;
constexpr size_t WS_WT_IN = 2 * MiB, WS_WT_OUT = 9 * MiB, WS_WT_PG = 11 * MiB, WS_WT_PP = 13 * MiB;
constexpr size_t WS_GAINS = 13 * MiB + 512 * 1024;
constexpr size_t WS_WRT = 13 * MiB + 576 * 1024;
constexpr size_t WS_ROPEC = 14 * MiB, WS_ROPES = 16 * MiB, WS_PB = 18 * MiB, WS_ROUTE = 26 * MiB;
constexpr size_t WS_WT_UG = 32 * MiB, WS_WT_DN = 160 * MiB;
constexpr size_t WS_XN = 224 * MiB;
constexpr size_t WS_HM = 256 * MiB;
constexpr size_t WS_RG = 352 * MiB;
constexpr size_t WS_Y = 368 * MiB;
constexpr size_t WS_PJ = 400 * MiB;
constexpr size_t WS_XS = 432 * MiB, WS_H = 576 * MiB, WS_YS = 720 * MiB;
constexpr size_t WS_END = 864 * MiB;
constexpr int CW_TMO = 0, CW_CODE = 1;
constexpr int CW_BAR = 4096;
constexpr int RING_OFF = 0, RING_BYTES = 131072;
constexpr int LDSCTL_OFF = RING_BYTES, MISC_OFF = LDSCTL_OFF + 320;
constexpr int LDS_BYTES = 147456;
#define GAS __attribute__((address_space(1)))
#define LAS __attribute__((address_space(3)))
typedef unsigned short bf16;
typedef unsigned v4u __attribute__((ext_vector_type(4)));
typedef float f32x4 __attribute__((ext_vector_type(4)));
typedef short bf16x8 __attribute__((ext_vector_type(8)));
typedef unsigned u32x4_t __attribute__((ext_vector_type(4)));
typedef unsigned u32x2_t __attribute__((ext_vector_type(2)));
typedef GAS unsigned gu32;
typedef GAS unsigned long long gu64;
#define RLX_AGENT __ATOMIC_RELAXED, __HIP_MEMORY_SCOPE_AGENT
#define LDS_WAIT() asm volatile("s_waitcnt lgkmcnt(0)" ::: "memory")
#define VM_WAIT() asm volatile("s_waitcnt vmcnt(0)" ::: "memory")
__device__ __forceinline__ unsigned long long rt() { return __builtin_amdgcn_s_memrealtime(); }
__device__ __forceinline__ unsigned f2bf(float f) { unsigned u = __builtin_bit_cast(unsigned, f); return (u + 0x7fffu + ((u >> 16) & 1u)) >> 16; }
__device__ __forceinline__ unsigned pk2(float lo, float hi) { return f2bf(lo) | (f2bf(hi) << 16); }

#define XB_TMO      128
#define XB_XCNT(j)  (256  + 64 * (j))
#define XB_XSUB(j)  (1280 + 64 * (j))
#define XB_XGEN(j)  (2304 + 64 * (j))
#define XB_TOP      3328
#define XB_TOPGEN   3392
#define XCD_BAR_WORDS 3456
#define XB_SPIN_CAP (1u << 18)

__device__ __forceinline__ unsigned xb_ld(unsigned* p)              { return __hip_atomic_load(p, __ATOMIC_RELAXED, __HIP_MEMORY_SCOPE_AGENT); }
__device__ __forceinline__ unsigned xb_add(unsigned* p, unsigned v) { return __hip_atomic_fetch_add(p, v, __ATOMIC_RELAXED, __HIP_MEMORY_SCOPE_AGENT); }
__device__ __forceinline__ unsigned xb_xcc_id() { return (unsigned)__builtin_amdgcn_s_getreg((3 << 11) | 20) & 0xFu; }
#define XB_SPIN(cond, bar) do { unsigned _sp = 0; while (cond) { __builtin_amdgcn_s_sleep(1); \
    if ((++_sp & 255u) == 0u) { if (xb_ld(&(bar)[XB_TMO])) break; if (_sp > XB_SPIN_CAP) { atomicAdd(&(bar)[XB_TMO], 1u); break; } } } } while (0)

struct XcdBarrier {
    unsigned* bar; unsigned x;
    volatile LAS unsigned* st;
};

__device__ __forceinline__ XcdBarrier xcd_barrier_post(unsigned* bar, volatile LAS unsigned* st) {
    XcdBarrier b; b.bar = bar; b.x = xb_xcc_id(); b.st = st;
    if (threadIdx.x == 0) (void)xb_add(&bar[XB_XCNT(b.x)], 1u);
    return b;
}
__device__ __forceinline__ void xcd_barrier_complete(unsigned* bar, unsigned x, unsigned& nloc, unsigned& nx) {
    const unsigned G = gridDim.x * gridDim.y * gridDim.z;
    unsigned sum, cnt, mine, sp = 0u;
    for (;;) {
        sum = 0u; cnt = 0u; mine = 0u;
#pragma unroll
        for (unsigned j = 0; j < 16; ++j) { const unsigned c = xb_ld(&bar[XB_XCNT(j)]); sum += c; cnt += (c > 0u) ? 1u : 0u; mine = (j == x) ? c : mine; }
        if (sum == G) break;
        __builtin_amdgcn_s_sleep(1);
        if ((++sp & 255u) == 0u) { if (xb_ld(&bar[XB_TMO])) break; if (sp > XB_SPIN_CAP) { atomicAdd(&bar[XB_TMO], 1u); break; } }
    }
    nloc = mine > 0u ? mine : 1u; nx = cnt > 0u ? cnt : 1u;
}

__device__ __forceinline__ void xcd_barrier(const XcdBarrier& b) {
    asm volatile("s_waitcnt vmcnt(0)" ::: "memory");
    __syncthreads();
    if (threadIdx.x == 0) {
        unsigned* bar = b.bar;
        __builtin_amdgcn_s_waitcnt(0);
        unsigned nloc = b.st[0], nx = b.st[1];
        if (nloc == 0u) { xcd_barrier_complete(bar, b.x, nloc, nx); b.st[0] = nloc; b.st[1] = nx; }
        const unsigned old = xb_add(&bar[XB_XSUB(b.x)], 1u);
        const unsigned gen = old / nloc;
        if (old + 1u == (gen + 1u) * nloc) {
            __builtin_amdgcn_fence(__ATOMIC_RELEASE, "agent");
            asm volatile("s_waitcnt vmcnt(0)" ::: "memory");
            const unsigned og = xb_add(&bar[XB_TOP], 1u);
            const unsigned tg = og / nx;
            if (og + 1u == (tg + 1u) * nx) xb_add(&bar[XB_TOPGEN], 1u);
            else XB_SPIN(xb_ld(&bar[XB_TOPGEN]) == tg, bar);
            __builtin_amdgcn_fence(__ATOMIC_ACQUIRE, "agent");
            xb_add(&bar[XB_XGEN(b.x)], 1u);
            asm volatile("s_waitcnt vmcnt(0)" ::: "memory");
        } else {
            XB_SPIN(xb_ld(&bar[XB_XGEN(b.x)]) == gen, bar);
            __builtin_amdgcn_fence(__ATOMIC_ACQUIRE, "agent");
            asm volatile("s_waitcnt vmcnt(0)" ::: "memory");
        }
    }
    __syncthreads();
}

struct Args {
    const float* x; const float* p; const int* positions; const float* g_mix; const float* w_in;
    const float* sbq; const float* sbk; const float* rq; const float* rk; const float* gn_g; const float* gn_b; const float* w_out;
    const float* g_ffn; const float* w_r; const float* b_r; const float* w_ug; const float* b_ug; const float* w_dn; const float* b_dn;
    const float* g_ple; const float* w_pg; const float* w_pp;
    float* out; unsigned char* ws; int ph_lo, ph_hi;
};
struct Frame {
    LAS unsigned char* lds;
    volatile LAS unsigned* MISC;
    gu32* ctl;
    int wave;
    int vcu, G;
};
__device__ __forceinline__ int tid_now() { int t = threadIdx.x; asm volatile("" : "+v"(t)); return t; }
__device__ __forceinline__ float wave_sum(float v) {
#pragma unroll
    for (int o = 1; o < 64; o <<= 1) v += __shfl_xor(v, o);
    return v;
}
__device__ __forceinline__ unsigned cvtpk(float lo, float hi) { return pg8::cvt_pk_bf16(lo, hi); }

enum { MAP_NAT = 0, MAP_IN = 1, MAP_UG = 2 };
__device__ __forceinline__ void p0_item(const float* __restrict__ W, int N, int K, bf16* __restrict__ WT, int kb, int nb, int mapmode, LAS unsigned char* scr, int lane) {
    const int np = 64 * nb + 4 * (lane & 15);
    int src = np;
    if (mapmode == MAP_IN) { const int pn = np >> 8, L = np & 255, bj = L >> 7, wc = (L >> 5) & 3, e = L & 31; src = 256 * pn + 64 * wc + 32 * bj + e; }
    else if (mapmode == MAP_UG) { const int pn = np >> 8, L = np & 255, bj = L >> 7, i = L & 127; src = 1024 * bj + 128 * pn + i; }
    const float* gp = W + (size_t)(64 * kb + (lane >> 4)) * N + src;
    f32x4 v[16];
#pragma unroll
    for (int i = 0; i < 16; ++i) v[i] = *(const f32x4*)(gp + (size_t)(4 * i) * N);
#pragma unroll
    for (int i = 0; i < 16; ++i) {
        LAS unsigned* d = (LAS unsigned*)(scr + (4 * i + (lane >> 4)) * 132 + 8 * (lane & 15));
        d[0] = cvtpk(v[i][0], v[i][1]); d[1] = cvtpk(v[i][2], v[i][3]);
    }
    LDS_WAIT(); asm volatile("" ::: "memory");
    const int c = lane & 7;
#pragma unroll
    for (int it = 0; it < 4; ++it) {
        const int nl = 16 * it + 2 * (lane >> 3);
        unsigned d[8];
#pragma unroll
        for (int j = 0; j < 8; ++j) d[j] = *(const LAS unsigned*)(scr + (8 * c + j) * 132 + 2 * nl);
        v4u o0, o1;
        o0.x = (d[0] & 0xffffu) | (d[1] << 16); o0.y = (d[2] & 0xffffu) | (d[3] << 16); o0.z = (d[4] & 0xffffu) | (d[5] << 16); o0.w = (d[6] & 0xffffu) | (d[7] << 16);
        o1.x = (d[0] >> 16) | (d[1] & 0xffff0000u); o1.y = (d[2] >> 16) | (d[3] & 0xffff0000u); o1.z = (d[4] >> 16) | (d[5] & 0xffff0000u); o1.w = (d[6] >> 16) | (d[7] & 0xffff0000u);
        bf16* dst = WT + (size_t)(64 * nb + nl) * K + 64 * kb + 8 * c;
        *(v4u*)dst = o0; *(v4u*)(dst + K) = o1;
    }
    LDS_WAIT(); asm volatile("" ::: "memory");
}
__device__ __forceinline__ unsigned pk4_fp8(float a, float b, float c, float d) { int r = __builtin_amdgcn_cvt_pk_fp8_f32(a, b, 0, false); r = __builtin_amdgcn_cvt_pk_fp8_f32(c, d, r, true); return (unsigned)r; }
__device__ __forceinline__ void p0_item_f8(const float* __restrict__ W, int N, int K, unsigned char* __restrict__ WT, int kb, int nb, int mapmode, LAS unsigned char* scr, int lane) {
    const int np = 64 * nb + 4 * (lane & 15);
    int src = np;
    if (mapmode == MAP_UG) { const int pn = np >> 8, L = np & 255, bj = L >> 7, i = L & 127; src = 1024 * bj + 128 * pn + i; }
    const float* gp = W + (size_t)(64 * kb + (lane >> 4)) * N + src;
    f32x4 v[16];
#pragma unroll
    for (int i = 0; i < 16; ++i) v[i] = *(const f32x4*)(gp + (size_t)(4 * i) * N);
#pragma unroll
    for (int i = 0; i < 16; ++i) *(LAS unsigned*)(scr + (4 * i + (lane >> 4)) * 68 + 4 * (lane & 15)) = pk4_fp8(v[i][0] * 64.0f, v[i][1] * 64.0f, v[i][2] * 64.0f, v[i][3] * 64.0f);
    LDS_WAIT(); asm volatile("" ::: "memory");
    const int nq = lane & 15, kg = lane >> 4;
    unsigned d[16];
#pragma unroll
    for (int j = 0; j < 16; ++j) d[j] = *(const LAS unsigned*)(scr + (16 * kg + j) * 68 + 4 * nq);
#pragma unroll
    for (int t = 0; t < 4; ++t) {
        v4u o;
#pragma unroll
        for (int q = 0; q < 4; ++q) o[q] = ((d[4 * q] >> (8 * t)) & 0xffu) | (((d[4 * q + 1] >> (8 * t)) & 0xffu) << 8) | (((d[4 * q + 2] >> (8 * t)) & 0xffu) << 16) | (((d[4 * q + 3] >> (8 * t)) & 0xffu) << 24);
        *(v4u*)(WT + (size_t)(64 * nb + 4 * nq + t) * K + 64 * kb + 16 * kg) = o;
    }
    LDS_WAIT(); asm volatile("" ::: "memory");
}
__device__ __forceinline__ void rms_row_to_bf16(const float* xrow, const float* g, bf16* orow, int lane) {
    const f32x4* xr = (const f32x4*)xrow + lane;
    f32x4 v[4]; float s = 0.f;
#pragma unroll
    for (int j = 0; j < 4; ++j) { v[j] = xr[64 * j]; s += (v[j][0] * v[j][0] + v[j][1] * v[j][1]) + (v[j][2] * v[j][2] + v[j][3] * v[j][3]); }
    const float rstd = rsqrtf(wave_sum(s) * (1.f / DM) + EPS);
    unsigned long long* o8 = (unsigned long long*)orow + lane;
#pragma unroll
    for (int j = 0; j < 4; ++j) { const f32x4 gg = ((const f32x4*)g)[lane + 64 * j];
        o8[64 * j] = (unsigned long long)cvtpk(v[j][0] * rstd * gg[0], v[j][1] * rstd * gg[1]) | ((unsigned long long)cvtpk(v[j][2] * rstd * gg[2], v[j][3] * rstd * gg[3]) << 32); }
}
__device__ __forceinline__ void p0_prologue(Frame& F, const Args& a) {
    unsigned char* ws = a.ws; const int tid = tid_now(), lane = tid & 63;
    LAS unsigned char* scr = F.lds + RING_OFF + F.wave * 8448;
    const int gw = F.vcu * NWAVES + F.wave, NGW = F.G * NWAVES;
    constexpr int I_IN = 16 * 56, I_OUT = 256, I_PG = 256, I_PP = 4 * 16, I_UG = 16 * 32, I_DN = 256;
    constexpr int NITEMS = I_IN + I_OUT + I_PG + I_PP + NE * I_UG + NE * I_DN;
    for (int it = gw; it < NITEMS; it += NGW) {
        int r = it;
        if (r < I_IN) { p0_item(a.w_in, DIN, DM, (bf16*)(ws + WS_WT_IN), r / 56, r % 56, MAP_IN, scr, lane); continue; } r -= I_IN;
        if (r < I_OUT) { p0_item(a.w_out, DM, DM, (bf16*)(ws + WS_WT_OUT), r / 16, r % 16, MAP_NAT, scr, lane); continue; } r -= I_OUT;
        if (r < I_PG) { p0_item_f8(a.w_pg, DM, DM, (unsigned char*)(ws + WS_WT_PG), r / 16, r % 16, MAP_NAT, scr, lane); continue; } r -= I_PG;
        if (r < I_PP) { p0_item(a.w_pp, DM, PLE, (bf16*)(ws + WS_WT_PP), r / 16, r % 16, MAP_NAT, scr, lane); continue; } r -= I_PP;
        if (r < NE * I_UG) { const int e = r / I_UG, q = r % I_UG; p0_item_f8(a.w_ug + (size_t)e * DM * 2048, 2048, DM, (unsigned char*)(ws + WS_WT_UG) + (size_t)e * 2048 * DM, q / 32, q % 32, MAP_UG, scr, lane); continue; } r -= NE * I_UG;
        { const int e = r / I_DN, q = r % I_DN; p0_item_f8(a.w_dn + (size_t)e * DM * DM, DM, DM, (unsigned char*)(ws + WS_WT_DN) + (size_t)e * DM * DM, q / 16, q % 16, MAP_NAT, scr, lane); }
    }
    if (blockIdx.x == 0 && tid < 256) { const int t = tid; const float* srcs = (t < 64) ? a.sbq : (t < 128) ? a.sbk : (t < 192) ? a.rq : a.rk; ((float*)(ws + WS_GAINS))[t] = srcs[t & 63]; }
    for (int m = gw; m < T; m += NGW) rms_row_to_bf16(a.x + (size_t)m * DM, a.g_mix, (bf16*)(ws + WS_XN) + (size_t)m * DM, lane);
    { const int gt = gw * 64 + lane, NGT = NGW * 64;
      for (int i = gt; i < T * PLE / 8; i += NGT) { const f32x4 a0 = ((const f32x4*)a.p)[2 * i], a1 = ((const f32x4*)a.p)[2 * i + 1];
          v4u o; o.x = cvtpk(a0[0], a0[1]); o.y = cvtpk(a0[2], a0[3]); o.z = cvtpk(a1[0], a1[1]); o.w = cvtpk(a1[2], a1[3]); ((v4u*)(ws + WS_PB))[i] = o; }
      for (int i = gt; i < NE * DM; i += NGT) { const int e = i >> 10, k = i & (DM - 1); const float wv = a.w_r[(size_t)k * NE + e];
          const unsigned hi = cvtpk(wv, 0.f) & 0xffffu; const unsigned lo = cvtpk(wv - __uint_as_float(hi << 16), 0.f) & 0xffffu;
          ((bf16*)(ws + WS_WRT))[i] = (bf16)hi; ((bf16*)(ws + WS_WRT))[NE * DM + i] = (bf16)lo; }
      float* rc = (float*)(ws + WS_ROPEC); float* rs = (float*)(ws + WS_ROPES);
      for (int i = gt; i < T * 32; i += NGT) { const int row = i >> 5, f = i & 31;
          const float inv_freq = powf(10000.0f, -(float)f / 32.0f); const float ang = (float)a.positions[row] * inv_freq;
          float sn, cs; sincosf(ang, &sn, &cs); rc[i] = cs; rs[i] = sn; } }
}

namespace att {
typedef short bf16x8 __attribute__((ext_vector_type(8)));
typedef short s16x4 __attribute__((ext_vector_type(4)));
typedef float f32x16 __attribute__((ext_vector_type(16)));
typedef short v4i16_t __attribute__((ext_vector_type(4)));
constexpr int LK = 0, LV = 16384, LFLAG = 32768;
__device__ __forceinline__ s16x4 vtr(LAS const unsigned char* p) { return __builtin_bit_cast(s16x4, __builtin_amdgcn_ds_read_tr16_b64_v4i16((LAS v4i16_t*)p)); }
__device__ __forceinline__ int crow(int r, int hi) { return (r & 3) + 8 * (r >> 2) + 4 * hi; }
struct AttnArgs { const bf16* hm; const bf16* rg; bf16* Y; const float* gn_g; const float* gn_b; };

template <int MODE> __device__ __forceinline__ void attn_unit(LAS unsigned char* lds, const AttnArgs& A, int b, int h, int qb) {
    int tid_ = threadIdx.x; asm volatile("" : "+v"(tid_));
    const int tid = tid_, lane = tid & 63, r32 = lane & 31, hh = lane >> 5;
    const int w = __builtin_amdgcn_readfirstlane(tid >> 6);
    const int q0 = qb * 256, qw = q0 + 32 * w;
    const size_t TS = (size_t)T * 512;
    const size_t hoff = (size_t)(b * 8 + h) * SEQ * 64;
    const bf16* Qp = A.hm + (MODE == 0 ? 0 : 3) * TS + hoff;
    const bf16* Kp = A.hm + (MODE == 0 ? 1 : 4) * TS + hoff;
    const bf16* Vp = A.hm + (MODE == 0 ? 2 : 5) * TS + hoff;
    bf16x8 qf[4];
#pragma unroll
    for (int ds = 0; ds < 4; ++ds) qf[ds] = *(const bf16x8*)(Qp + (size_t)(qw + r32) * 64 + 16 * ds + 8 * hh);
    f32x16 o[2];
#pragma unroll
    for (int r = 0; r < 16; ++r) { o[0][r] = 0.f; o[1][r] = 0.f; }
    float carry = 0.f;
    const int jmax = (q0 + 255) >> 6, jd = (qw + 31) >> 6;
    const float lg2g = __log2f(1.0f - __builtin_amdgcn_exp2f(-5.0f - (float)h));
    const bf16* Kt = Kp + (size_t)tid * 8; const bf16* Vt = Vp + (size_t)tid * 8;
    LAS unsigned char* kdst = lds + LK + (tid & 7) * 1024 + (tid >> 3) * 16;
    LAS unsigned char* vdst = lds + LV + (tid >> 3) * 128 + (tid & 7) * 16;
    volatile LAS unsigned* flags = (volatile LAS unsigned*)(lds + LFLAG);
    v4u kreg = *(const v4u*)(Kt + (size_t)jmax * 4096), vreg = *(const v4u*)(Vt + (size_t)jmax * 4096);
    *(LAS v4u*)kdst = kreg; *(LAS v4u*)vdst = vreg;
    __syncthreads();
    bool finished = false;
    for (int it = 0, j = jmax; j >= 0; ++it, --j) {
        const int cur = it & 1;
        const bool more = j > 0;
        if (more) { kreg = *(const v4u*)(Kt + (size_t)(j - 1) * 4096); vreg = *(const v4u*)(Vt + (size_t)(j - 1) * 4096); }
        if (j <= jd && !finished) {
            LAS const unsigned char* Kb = lds + LK + cur * 8192;
            LAS const unsigned char* Vb = lds + LV + cur * 8192;
            f32x16 p[2];
#pragma unroll
            for (int r = 0; r < 16; ++r) { p[0][r] = 0.f; p[1][r] = 0.f; }
#pragma unroll
            for (int ds = 0; ds < 4; ++ds) {
                const bf16x8 k0 = *(LAS const bf16x8*)(Kb + (2 * ds + hh) * 1024 + r32 * 16);
                const bf16x8 k1 = *(LAS const bf16x8*)(Kb + (2 * ds + hh) * 1024 + (32 + r32) * 16);
                p[0] = __builtin_amdgcn_mfma_f32_32x32x16_bf16(k0, qf[ds], p[0], 0, 0, 0);
                p[1] = __builtin_amdgcn_mfma_f32_32x32x16_bf16(k1, qf[ds], p[1], 0, 0, 0);
            }
            const bool diag = (j == jd);
            const int qg = qw + r32, kv0 = 64 * j + 4 * hh;
            if (MODE == 0) {
                float ln[2][16];
#pragma unroll
                for (int hf = 0; hf < 2; ++hf)
#pragma unroll
                    for (int r = 0; r < 16; ++r) {
                        const float Z = p[hf][r];
                        const float e = __builtin_amdgcn_exp2f(-__builtin_fabsf(Z));
                        const float sp = __builtin_fmaxf(Z, 0.f) + __log2f(1.0f + e);
                        const bool valid = !diag || (kv0 + 32 * hf + (r & 3) + 8 * (r >> 2) < qg);
                        ln[hf][r] = valid ? -sp : 0.f;
                        p[hf][r] = valid ? (Z - sp) : -INFINITY;
                    }
                float gs[8], ot[8];
#pragma unroll
                for (int m = 0; m < 8; ++m) { const int hf = m >> 2, g = m & 3; gs[m] = (ln[hf][4 * g] + ln[hf][4 * g + 1]) + (ln[hf][4 * g + 2] + ln[hf][4 * g + 3]); ot[m] = __shfl_xor(gs[m], 32); }
                float ps[8];
                ps[7] = 0.f;
#pragma unroll
                for (int m = 6; m >= 0; --m) ps[m] = ps[m + 1] + (gs[m + 1] + ot[m + 1]);
                const float total = ps[0] + (gs[0] + ot[0]);
                const float om = hh ? 0.f : 1.f;
#pragma unroll
                for (int m = 0; m < 8; ++m) {
                    const int hf = m >> 2, g = m & 3;
                    float tail = carry + __builtin_fmaf(ot[m], om, ps[m]);
#pragma unroll
                    for (int i = 3; i >= 0; --i) { const int r = 4 * g + i; const float l = ln[hf][r]; p[hf][r] = __builtin_amdgcn_exp2f(p[hf][r] + tail); tail += l; }
                }
                carry += total;
                finished = __all(carry <= -160.0f);
            } else {
                const float ct = __builtin_amdgcn_exp2f(lg2g * (float)(qw - 64 * j));
#pragma unroll
                for (int hf = 0; hf < 2; ++hf)
#pragma unroll
                    for (int r = 0; r < 16; ++r) {
                        const bool valid = !diag || (kv0 + 32 * hf + (r & 3) + 8 * (r >> 2) <= qg);
                        p[hf][r] = valid ? p[hf][r] * ct : 0.f;
                    }
            }
#pragma unroll
            for (int hf = 0; hf < 2; ++hf)
#pragma unroll
                for (int s = 0; s < 2; ++s) {
                    u32x4_t wq;
                    wq.x = pg8::cvt_pk_bf16(p[hf][8 * s + 0], p[hf][8 * s + 1]); wq.y = pg8::cvt_pk_bf16(p[hf][8 * s + 2], p[hf][8 * s + 3]);
                    wq.z = pg8::cvt_pk_bf16(p[hf][8 * s + 4], p[hf][8 * s + 5]); wq.w = pg8::cvt_pk_bf16(p[hf][8 * s + 6], p[hf][8 * s + 7]);
                    const bf16x8 wf = __builtin_bit_cast(bf16x8, wq);
#pragma unroll
                    for (int d0 = 0; d0 < 2; ++d0) {
                        LAS const unsigned char* va = Vb + (32 * hf + 16 * s + 4 * hh + ((lane & 15) >> 2)) * 128 + (32 * d0 + 16 * ((lane >> 4) & 1) + 4 * (lane & 3)) * 2;
                        const s16x4 lo = vtr(va), hi = vtr(va + 8 * 128);
                        const bf16x8 vf = (bf16x8){lo[0], lo[1], lo[2], lo[3], hi[0], hi[1], hi[2], hi[3]};
                        o[d0] = __builtin_amdgcn_mfma_f32_32x32x16_bf16(vf, wf, o[d0], 0, 0, 0);
                    }
                }
        }
        if (more) { *(LAS v4u*)(kdst + (cur ^ 1) * 8192) = kreg; *(LAS v4u*)(vdst + (cur ^ 1) * 8192) = vreg; }
        if (MODE == 0) { if (lane == 0) flags[cur * 8 + w] = finished ? 1u : 0u; }
        __syncthreads();
        if (MODE == 0) {
            unsigned all = 1u;
#pragma unroll
            for (int i = 0; i < 8; ++i) all &= flags[cur * 8 + i];
            if (all) break;
        }
    }
    const int row = b * SEQ + qw + r32;
    if (MODE == 0) {
        bf16* yp = A.Y + (size_t)row * DM + h * 64 + 4 * hh;
#pragma unroll
        for (int d0 = 0; d0 < 2; ++d0)
#pragma unroll
            for (int g = 0; g < 4; ++g) { u32x2_t v; v.x = pg8::cvt_pk_bf16(o[d0][4 * g], o[d0][4 * g + 1]); v.y = pg8::cvt_pk_bf16(o[d0][4 * g + 2], o[d0][4 * g + 3]); *(u32x2_t*)(yp + 32 * d0 + 8 * g) = v; }
    } else {
        float s1 = 0.f;
#pragma unroll
        for (int r = 0; r < 16; ++r) s1 += o[0][r] + o[1][r];
        s1 += __shfl_xor(s1, 32);
        const float mu = s1 * (1.0f / 64.0f);
        float s2 = 0.f;
#pragma unroll
        for (int r = 0; r < 16; ++r) { const float a0 = o[0][r] - mu, a1 = o[1][r] - mu; s2 += a0 * a0 + a1 * a1; }
        s2 += __shfl_xor(s2, 32);
        const float rstd = rsqrtf(s2 * (1.0f / 64.0f) + EPS);
        bf16* yp = A.Y + (size_t)row * DM + 512 + h * 64 + 4 * hh;
        const bf16* gp = A.rg + (size_t)row * 512 + h * 64 + 4 * hh;
        const float* gg = A.gn_g + h * 64 + 4 * hh; const float* gb = A.gn_b + h * 64 + 4 * hh;
#pragma unroll
        for (int d0 = 0; d0 < 2; ++d0)
#pragma unroll
            for (int g = 0; g < 4; ++g) {
                const f32x4 gn = *(const f32x4*)(gg + 32 * d0 + 8 * g), bs = *(const f32x4*)(gb + 32 * d0 + 8 * g);
                const u32x2_t gr = *(const u32x2_t*)(gp + 32 * d0 + 8 * g);
                float gate[4] = {__uint_as_float(gr.x << 16), __uint_as_float(gr.x & 0xffff0000u), __uint_as_float(gr.y << 16), __uint_as_float(gr.y & 0xffff0000u)};
                float ov[4];
#pragma unroll
                for (int i = 0; i < 4; ++i) { const float yn = (o[d0][4 * g + i] - mu) * rstd * gn[i] + bs[i]; const float sg = gate[i] / (1.0f + __expf(-gate[i])); ov[i] = yn * sg; }
                u32x2_t v; v.x = pg8::cvt_pk_bf16(ov[0], ov[1]); v.y = pg8::cvt_pk_bf16(ov[2], ov[3]); *(u32x2_t*)(yp + 32 * d0 + 8 * g) = v;
            }
    }
}
__device__ __forceinline__ void attn_phase(LAS unsigned char* lds, const AttnArgs& A, int vcu) {
    const int bh = vcu >> 2, x = vcu & 3, b = bh >> 3, h = bh & 7;
    attn_unit<1>(lds, A, b, h, 7 - x);
    attn_unit<1>(lds, A, b, h, x);
    attn_unit<0>(lds, A, b, h, 7 - x);
    attn_unit<0>(lds, A, b, h, x);
}
}

constexpr int CW_GCNT = 2048;
constexpr int LR_LCNT = LDSCTL_OFF + 1024, LR_GBASE = LDSCTL_OFF + 1152;
constexpr int LT_POFF = LDSCTL_OFF + 2048, LT_NT = LDSCTL_OFF + 2176, LT_TILE_E = LDSCTL_OFF + 2304;
struct RouteBufs { int* tok_e; int* tok_slot; float* tok_gate; float* rstd; float* slot_rstd; };
__device__ __forceinline__ RouteBufs route_bufs(unsigned char* ws) { RouteBufs r; r.tok_e = (int*)(ws + WS_ROUTE); r.tok_slot = r.tok_e + T * 4; r.tok_gate = (float*)(r.tok_slot + T * 4); r.rstd = (float*)(ws + WS_ROUTE + 1 * MiB); r.slot_rstd = (float*)(ws + WS_ROUTE + 2 * MiB); return r; }
typedef float f32x2v __attribute__((ext_vector_type(2)));
__device__ __forceinline__ unsigned opq_mask(bool c) { unsigned m = c ? 0xffffffffu : 0u; asm volatile("" : "+v"(m)); return m; }
__device__ __forceinline__ float blendf(unsigned m, float a, float b) { return __uint_as_float((__float_as_uint(a) & m) | (__float_as_uint(b) & ~m)); }
__device__ __forceinline__ int blendi(unsigned m, int a, int b) { return (int)(((unsigned)a & m) | ((unsigned)b & ~m)); }

#define SW2(c, a, b) { const float ta_ = (c) ? (b) : (a), tb_ = (c) ? (a) : (b); a = ta_; b = tb_; }
#define SW2I(c, a, b) { const int ta_ = (c) ? (b) : (a), tb_ = (c) ? (a) : (b); a = ta_; b = tb_; }
#define TOP4_INSERT(x, e) { const float x_ = (x); const int e_ = (e); const bool c3_ = (x_ > v3) || (x_ == v3 && e_ < i3); v3 = c3_ ? x_ : v3; i3 = c3_ ? e_ : i3; \
    const bool c2_ = (v3 > v2) || (v3 == v2 && i3 < i2); SW2(c2_, v2, v3) SW2I(c2_, i2, i3) const bool c1_ = (v2 > v1) || (v2 == v1 && i2 < i1); SW2(c1_, v1, v2) SW2I(c1_, i1, i2) \
    const bool c0_ = (v1 > v0) || (v1 == v0 && i1 < i0); SW2(c0_, v0, v1) SW2I(c0_, i0, i1) }
__device__ __forceinline__ void router_phase(Frame& F, const Args& a, const bool dry = false) {
    unsigned char* ws = a.ws; const int tid = tid_now();
    LAS unsigned char* lds = F.lds;
    const int lane = tid & 63, r32 = lane & 31, hh = lane >> 5, w = F.wave, rg = w >> 2, kq = w & 3;
    volatile LAS unsigned* lcnt = (volatile LAS unsigned*)(lds + LR_LCNT);
    volatile LAS unsigned* gbase = (volatile LAS unsigned*)(lds + LR_GBASE);
    if (tid < 32) lcnt[tid] = 0u;
    const RouteBufs R = route_bufs(dry ? ws + 3 * MiB : ws);
    const int row = F.vcu * 64 + 32 * rg + r32;
    const float* xr = a.out + (size_t)row * DM + 256 * kq + 8 * hh;
    const float* gr = a.g_ffn + 256 * kq + 8 * hh;
    const bf16* wt = (const bf16*)(ws + WS_WRT) + (size_t)r32 * DM + 256 * kq + 8 * hh;
    unsigned char* hp = (unsigned char*)(ws + (dry ? WS_H : WS_XN)) + (size_t)row * DM + 256 * kq + 8 * hh;
    att::f32x16 D;
#pragma unroll
    for (int r = 0; r < 16; ++r) D[r] = 0.f;
    float ss = 0.f;
#pragma unroll 4
    for (int ks = 0; ks < 16; ++ks) {
        const f32x4 x0 = *(const f32x4*)(xr + 16 * ks), x1 = *(const f32x4*)(xr + 16 * ks + 4);
        const f32x4 g0 = *(const f32x4*)(gr + 16 * ks), g1 = *(const f32x4*)(gr + 16 * ks + 4);
        ss += ((x0[0] * x0[0] + x0[1] * x0[1]) + (x0[2] * x0[2] + x0[3] * x0[3])) + ((x1[0] * x1[0] + x1[1] * x1[1]) + (x1[2] * x1[2] + x1[3] * x1[3]));
        const f32x4 v0 = x0 * g0, v1 = x1 * g1;
        u32x2_t h8; h8.x = pk4_fp8(v0[0], v0[1], v0[2], v0[3]); h8.y = pk4_fp8(v1[0], v1[1], v1[2], v1[3]); *(u32x2_t*)(hp + 16 * ks) = h8;
        u32x4_t xh, xl;
        xh.x = cvtpk(v0[0], v0[1]); xh.y = cvtpk(v0[2], v0[3]); xh.z = cvtpk(v1[0], v1[1]); xh.w = cvtpk(v1[2], v1[3]);
        xl.x = cvtpk(v0[0] - __uint_as_float(xh.x << 16), v0[1] - __uint_as_float(xh.x & 0xffff0000u)); xl.y = cvtpk(v0[2] - __uint_as_float(xh.y << 16), v0[3] - __uint_as_float(xh.y & 0xffff0000u));
        xl.z = cvtpk(v1[0] - __uint_as_float(xh.z << 16), v1[1] - __uint_as_float(xh.z & 0xffff0000u)); xl.w = cvtpk(v1[2] - __uint_as_float(xh.w << 16), v1[3] - __uint_as_float(xh.w & 0xffff0000u));
        const att::bf16x8 whi = *(const att::bf16x8*)(wt + 16 * ks), wlo = *(const att::bf16x8*)(wt + 32 * DM + 16 * ks);
        const att::bf16x8 bxh = __builtin_bit_cast(att::bf16x8, xh), bxl = __builtin_bit_cast(att::bf16x8, xl);
        D = __builtin_amdgcn_mfma_f32_32x32x16_bf16(whi, bxh, D, 0, 0, 0);
        D = __builtin_amdgcn_mfma_f32_32x32x16_bf16(wlo, bxh, D, 0, 0, 0);
        D = __builtin_amdgcn_mfma_f32_32x32x16_bf16(whi, bxl, D, 0, 0, 0);
    }
    { LAS f32x4* dp = (LAS f32x4*)(lds + (w * 64 + lane) * 64);
#pragma unroll
      for (int q = 0; q < 4; ++q) dp[q] = (f32x4){D[4 * q], D[4 * q + 1], D[4 * q + 2], D[4 * q + 3]};
      *(LAS float*)(lds + 32768 + (w * 64 + lane) * 4) = ss; }
    __syncthreads();
    int my_e0 = 0, my_e1 = 0, rk0 = 0, rk1 = 0; float my_g0 = 0.f, my_g1 = 0.f;
    if (kq == 0) {
#pragma unroll
        for (int o = 1; o < 4; ++o) { LAS const f32x4* dp = (LAS const f32x4*)(lds + ((w + o) * 64 + lane) * 64);
#pragma unroll
            for (int q = 0; q < 4; ++q) { const f32x4 t = dp[q]; D[4 * q] += t[0]; D[4 * q + 1] += t[1]; D[4 * q + 2] += t[2]; D[4 * q + 3] += t[3]; }
            ss += *(LAS const float*)(lds + 32768 + ((w + o) * 64 + lane) * 4); }
        ss += __shfl_xor(ss, 32);
        const float rstd = rsqrtf(ss * (1.f / DM) + EPS);
        if (hh == 0) R.rstd[row] = rstd;
        float l[16];
#pragma unroll
        for (int r = 0; r < 16; ++r) l[r] = D[r] * rstd + a.b_r[(r & 3) + 8 * (r >> 2) + 4 * hh];
        float c[8]; int ci[8];
#pragma unroll
        for (int k = 0; k < 4; ++k) {
            float bv = -INFINITY; int bi = 99;
#pragma unroll
            for (int r = 0; r < 16; ++r) { const int e = (r & 3) + 8 * (r >> 2) + 4 * hh; const bool bt = l[r] > bv; bv = bt ? l[r] : bv; bi = bt ? e : bi; }
            c[k] = bv; ci[k] = bi;
#pragma unroll
            for (int r = 0; r < 16; ++r) { const int e = (r & 3) + 8 * (r >> 2) + 4 * hh; l[r] = (e == bi) ? -INFINITY : l[r]; }
        }
#pragma unroll
        for (int k = 0; k < 4; ++k) { c[4 + k] = __shfl_xor(c[k], 32); ci[4 + k] = __shfl_xor(ci[k], 32); }
        float tv[4]; int ti[4];
#pragma unroll
        for (int k = 0; k < 4; ++k) {
            float bv = -INFINITY; int bi = 99;
#pragma unroll
            for (int j = 0; j < 8; ++j) { const bool bt = (c[j] > bv) || (c[j] == bv && ci[j] < bi); bv = bt ? c[j] : bv; bi = bt ? ci[j] : bi; }
            tv[k] = bv; ti[k] = bi;
#pragma unroll
            for (int j = 0; j < 8; ++j) c[j] = (ci[j] == bi) ? -INFINITY : c[j];
        }
        const float v0 = tv[0], v1 = tv[1], v2 = tv[2], v3 = tv[3]; const int i0 = ti[0], i1 = ti[1], i2 = ti[2], i3 = ti[3];
        const float e1 = __expf(v1 - v0), e2 = __expf(v2 - v0), e3 = __expf(v3 - v0), inv = 1.0f / (1.0f + e1 + e2 + e3);
        my_e0 = hh ? i2 : i0; my_e1 = hh ? i3 : i1; my_g0 = (hh ? e2 : 1.0f) * inv; my_g1 = (hh ? e3 : e1) * inv;
        rk0 = (int)__hip_atomic_fetch_add((LAS unsigned*)(lds + LR_LCNT) + my_e0, 1u, __ATOMIC_RELAXED, __HIP_MEMORY_SCOPE_WORKGROUP);
        rk1 = (int)__hip_atomic_fetch_add((LAS unsigned*)(lds + LR_LCNT) + my_e1, 1u, __ATOMIC_RELAXED, __HIP_MEMORY_SCOPE_WORKGROUP);
    }
    __syncthreads();
    if (tid < 32) gbase[tid] = __hip_atomic_fetch_add((unsigned*)(F.ctl + CW_GCNT + (dry ? 64 : 0)) + tid, lcnt[tid], __ATOMIC_RELAXED, __HIP_MEMORY_SCOPE_AGENT);
    __syncthreads();
    if (kq == 0) {
        const int k0 = 2 * hh;
        R.tok_e[row * 4 + k0] = my_e0; R.tok_slot[row * 4 + k0] = (int)gbase[my_e0] + rk0; R.tok_gate[row * 4 + k0] = my_g0;
        R.tok_e[row * 4 + k0 + 1] = my_e1; R.tok_slot[row * 4 + k0 + 1] = (int)gbase[my_e1] + rk1; R.tok_gate[row * 4 + k0 + 1] = my_g1;
    }
}
#undef SW2
#undef SW2I
#undef TOP4_INSERT

__device__ __forceinline__ void build_tables(Frame& F) {
    LAS int* poff = (LAS int*)(F.lds + LT_POFF); LAS int* ntp = (LAS int*)(F.lds + LT_NT); LAS int* tile_e = (LAS int*)(F.lds + LT_TILE_E);
    LAS int* cnts = (LAS int*)(F.lds + LR_LCNT); const int tid = tid_now();
    if (tid < NE) cnts[tid] = (int)__hip_atomic_load((unsigned*)(F.ctl + CW_GCNT) + tid, __ATOMIC_RELAXED, __HIP_MEMORY_SCOPE_AGENT);
    __syncthreads();
    if (tid == 0) {
        int t = 0;
        for (int e = 0; e < NE; ++e) { const int c = cnts[e]; const int nt = (c + 255) >> 8; poff[e] = t * 256; for (int i = 0; i < nt; ++i) tile_e[t + i] = e; t += nt; }
        *ntp = t;
    }
    __syncthreads();
}
__device__ __forceinline__ void gather_phase(Frame& F, const Args& a) {
    unsigned char* ws = a.ws; const int lane = tid_now() & 63; const RouteBufs R = route_bufs(ws);
    LAS const int* poff = (LAS const int*)(F.lds + LT_POFF);
    const int gw = F.vcu * NWAVES + F.wave, NGW = F.G * NWAVES;
    for (int m = gw; m < T; m += NGW) {
        const v4u* src = (const v4u*)((const unsigned char*)(ws + WS_XN) + (size_t)m * DM);
        const v4u h0 = src[lane]; const float rs = R.rstd[m];
#pragma unroll
        for (int k = 0; k < 4; ++k) { const int e = R.tok_e[m * 4 + k], slot = R.tok_slot[m * 4 + k];
            v4u* dst = (v4u*)((unsigned char*)(ws + WS_XS) + (size_t)(poff[e] + slot) * DM); dst[lane] = h0; if (lane == 0) R.slot_rstd[poff[e] + slot] = rs; }
    }
}
__device__ __forceinline__ void combine_phase(Frame& F, const Args& a, const bool dry = false) {
    unsigned char* ws = a.ws; const RouteBufs R = route_bufs(ws);
    LAS const int* poff = (LAS const int*)(F.lds + LT_POFF);
    const int gw = F.vcu * NWAVES + F.wave, NGW = F.G * NWAVES, lane = tid_now() & 63;
    for (int m0 = 2 * gw; m0 < T; m0 += 2 * NGW) {
        f32x4 v[2][2][2]; v4u y[2][4][2]; float gt[2][4];
#pragma unroll
        for (int rr = 0; rr < 2; ++rr) { const int m = m0 + rr;
#pragma unroll
            for (int i = 0; i < 2; ++i) { v[rr][i][0] = *(const f32x4*)(a.out + (size_t)m * DM + 8 * lane + 512 * i); v[rr][i][1] = *(const f32x4*)(a.out + (size_t)m * DM + 8 * lane + 512 * i + 4); }
#pragma unroll
            for (int k = 0; k < 4; ++k) { const int e = R.tok_e[m * 4 + k], slot = R.tok_slot[m * 4 + k]; gt[rr][k] = R.tok_gate[m * 4 + k];
                const bf16* yr = (const bf16*)(ws + WS_YS) + (size_t)(poff[e] + slot) * DM + 8 * lane;
                y[rr][k][0] = *(const v4u*)yr; y[rr][k][1] = *(const v4u*)(yr + 512); } }
#pragma unroll
        for (int rr = 0; rr < 2; ++rr) { const int m = m0 + rr;
#pragma unroll
            for (int k = 0; k < 4; ++k)
#pragma unroll
                for (int i = 0; i < 2; ++i) { const v4u yy = y[rr][k][i]; const float g = gt[rr][k];
                    v[rr][i][0][0] += g * __uint_as_float(yy[0] << 16); v[rr][i][0][1] += g * __uint_as_float(yy[0] & 0xffff0000u); v[rr][i][0][2] += g * __uint_as_float(yy[1] << 16); v[rr][i][0][3] += g * __uint_as_float(yy[1] & 0xffff0000u);
                    v[rr][i][1][0] += g * __uint_as_float(yy[2] << 16); v[rr][i][1][1] += g * __uint_as_float(yy[2] & 0xffff0000u); v[rr][i][1][2] += g * __uint_as_float(yy[3] << 16); v[rr][i][1][3] += g * __uint_as_float(yy[3] & 0xffff0000u); }
            float ss = 0.f;
#pragma unroll
            for (int i = 0; i < 2; ++i)
#pragma unroll
                for (int q = 0; q < 2; ++q) { const f32x4 t = v[rr][i][q]; ss += (t[0] * t[0] + t[1] * t[1]) + (t[2] * t[2] + t[3] * t[3]); }
            const float rstd = rsqrtf(wave_sum(ss) * (1.f / DM) + EPS);
            unsigned char* np = (unsigned char*)(ws + (dry ? WS_H : WS_XN)) + (size_t)m * DM + 8 * lane; float* ow = dry ? (float*)(ws + WS_XS) : a.out;
#pragma unroll
            for (int i = 0; i < 2; ++i) { *(f32x4*)(ow + (size_t)m * DM + 8 * lane + 512 * i) = v[rr][i][0]; *(f32x4*)(ow + (size_t)m * DM + 8 * lane + 512 * i + 4) = v[rr][i][1];
                const f32x4 g0 = *(const f32x4*)(a.g_ple + 8 * lane + 512 * i), g1 = *(const f32x4*)(a.g_ple + 8 * lane + 512 * i + 4);
                u32x2_t o; o.x = pk4_fp8(v[rr][i][0][0] * rstd * g0[0], v[rr][i][0][1] * rstd * g0[1], v[rr][i][0][2] * rstd * g0[2], v[rr][i][0][3] * rstd * g0[3]);
                o.y = pk4_fp8(v[rr][i][1][0] * rstd * g1[0], v[rr][i][1][1] * rstd * g1[1], v[rr][i][1][2] * rstd * g1[2], v[rr][i][1][3] * rstd * g1[3]);
                *(u32x2_t*)(np + 512 * i) = o; } }
    }
}

__global__ void __launch_bounds__(NWAVES * 64, 2) mega_fwd(Args args) {
    extern __shared__ __attribute__((aligned(16))) unsigned char lds[];
    Frame F;
    F.lds = (LAS unsigned char*)lds;
    F.MISC = (volatile LAS unsigned*)(F.lds + MISC_OFF);
    F.wave = __builtin_amdgcn_readfirstlane(threadIdx.x >> 6);
    F.G = gridDim.x; { const int bx = blockIdx.x; F.vcu = (F.G % 8 == 0) ? (bx % 8) * (F.G / 8) + bx / 8 : bx; }
    unsigned char* ws = args.ws;
    F.ctl = (gu32*)(ws + WS_CTL);
    for (int u = threadIdx.x; u < (LDS_BYTES - LDSCTL_OFF) / 4; u += NWAVES * 64) ((LAS unsigned*)(F.lds + LDSCTL_OFF))[u] = 0u;
    __syncthreads();
    XcdBarrier bar = xcd_barrier_post((unsigned*)(F.ctl + CW_BAR), F.MISC + 8);
    const int lo = args.ph_lo, hi = args.ph_hi;
#define IN(k) (lo <= (k) && (k) < hi)
#define GRID_BAR() xcd_barrier(bar)
#ifndef DUP_PHASE
#define DUP_PHASE -1
#endif
#define REP(k) for (int rep_ = 0; rep_ < ((DUP_PHASE) == (k) ? 2 : 1); ++rep_)

    if (IN(0)) REP(0) { p0_prologue(F, args); GRID_BAR(); }

    if (IN(1)) REP(1) {
        pg8::Gemm g{(const pg8::bf16_t*)(ws + WS_XN), (const pg8::bf16_t*)(ws + WS_WT_IN), DM, 0};
        pg8::StaticOrder S; S.init(T / 256, DIN / 256, F.G, (int)blockIdx.x);
        pg8::EpiProj E{(pg8::bf16_t*)(ws + WS_HM), (pg8::bf16_t*)(ws + WS_RG), (const float*)(ws + WS_GAINS), (const float*)(ws + WS_ROPEC), (const float*)(ws + WS_ROPES)};
        pg8::gemm_phase<pg8::EpiProj, pg8::StaticOrder, true, true>(F.lds + RING_OFF, g, S, E);
        if (F.G == 256 && blockIdx.x >= 128) {
            pg8::Gemm g2{(const pg8::bf16_t*)(ws + WS_PB), (const pg8::bf16_t*)(ws + WS_WT_PP), PLE, 0};
            pg8::StaticOrder S2; S2.init(T / 256, DM / 256, 128, (int)blockIdx.x - 128);
            pg8::EpiBf16Plain E2{(pg8::bf16_t*)(ws + WS_PJ), DM};
            pg8::gemm_phase<pg8::EpiBf16Plain, pg8::StaticOrder, true, true>(F.lds + RING_OFF, g2, S2, E2);
        } else if (F.G != 256) {
            pg8::Gemm g2{(const pg8::bf16_t*)(ws + WS_PB), (const pg8::bf16_t*)(ws + WS_WT_PP), PLE, 0};
            pg8::StaticOrder S2; S2.init(T / 256, DM / 256, F.G, (int)blockIdx.x);
            pg8::EpiBf16Plain E2{(pg8::bf16_t*)(ws + WS_PJ), DM};
            pg8::gemm_phase<pg8::EpiBf16Plain, pg8::StaticOrder, true, true>(F.lds + RING_OFF, g2, S2, E2);
        }
        GRID_BAR();
    }
    if (IN(2)) REP(2) {
        if (F.G == 256) {
            const att::AttnArgs AA{(const bf16*)(ws + WS_HM), (const bf16*)(ws + WS_RG), (bf16*)(ws + WS_Y), args.gn_g, args.gn_b};
            att::attn_phase(F.lds + RING_OFF, AA, F.vcu);
        }
        GRID_BAR();
    }
    if (IN(3)) REP(3) {
        pg8::Gemm g{(const pg8::bf16_t*)(ws + WS_Y), (const pg8::bf16_t*)(ws + WS_WT_OUT), DM, 0};
        pg8::StaticOrder S; S.init(T / 256, DM / 256, F.G, (int)blockIdx.x);
        pg8::EpiResid E{args.x, args.out};
        pg8::gemm_phase<pg8::EpiResid, pg8::StaticOrder, true, true>(F.lds + RING_OFF, g, S, E);
        GRID_BAR();
    }
    if (IN(4)) { if (DUP_PHASE == 4) { if (F.G == 256) router_phase(F, args, true); GRID_BAR(); } if (F.G == 256) router_phase(F, args); GRID_BAR(); }
    if (IN(5) || (lo >= 6 && lo <= 8)) build_tables(F);
    if (IN(5)) REP(5) { gather_phase(F, args); GRID_BAR(); }
    if (IN(6)) REP(6) {
        const int NT = *(LAS const int*)(F.lds + LT_NT);
        pg8::Gemm g{(const pg8::bf16_t*)(ws + WS_XS), (const pg8::bf16_t*)(ws + WS_WT_UG), DM / 2, (size_t)2048 * DM};
        pg8::MoeOrder S; S.init(NT, 8, F.G, (int)blockIdx.x, (LAS const int*)(F.lds + LT_TILE_E));
        pg8::EpiMoeUp E{(unsigned char*)(ws + WS_H), args.b_ug, route_bufs(ws).slot_rstd};
        pg8::gemm_phase<pg8::EpiMoeUp, pg8::MoeOrder, true, true, true>(F.lds + RING_OFF, g, S, E);
        GRID_BAR();
    }
    if (IN(7)) REP(7) {
        const int NT = *(LAS const int*)(F.lds + LT_NT);
        pg8::Gemm g{(const pg8::bf16_t*)(ws + WS_H), (const pg8::bf16_t*)(ws + WS_WT_DN), DM / 2, (size_t)DM * DM};
        pg8::MoeOrder S; S.init(NT, 4, F.G, (int)blockIdx.x, (LAS const int*)(F.lds + LT_TILE_E));
        pg8::EpiMoeDown E{(pg8::bf16_t*)(ws + WS_YS), args.b_dn};
        pg8::gemm_phase<pg8::EpiMoeDown, pg8::MoeOrder, true, true, true>(F.lds + RING_OFF, g, S, E);
        GRID_BAR();
    }
    if (IN(8)) { if (DUP_PHASE == 8) { combine_phase(F, args, true); GRID_BAR(); } combine_phase(F, args); GRID_BAR(); }
    if (IN(9)) {
        pg8::Gemm g{(const pg8::bf16_t*)(ws + WS_XN), (const pg8::bf16_t*)(ws + WS_WT_PG), DM / 2, 0};
        pg8::StaticOrder S; S.init(T / 256, DM / 256, F.G, (int)blockIdx.x);
        if (DUP_PHASE == 9) { pg8::EpiPle E0{args.out, (const pg8::bf16_t*)(ws + WS_PJ), (float*)(ws + WS_XS)}; pg8::gemm_phase<pg8::EpiPle, pg8::StaticOrder, true, true, true>(F.lds + RING_OFF, g, S, E0); }
        pg8::EpiPle E{args.out, (const pg8::bf16_t*)(ws + WS_PJ), args.out};
        pg8::gemm_phase<pg8::EpiPle, pg8::StaticOrder, true, true, true>(F.lds + RING_OFF, g, S, E);
    }
#undef IN
}
extern "C" void kernel_launch(void* const* d_in, const int* in_sizes, int n_in, void* d_out, int out_size, void* d_ws, size_t ws_size, hipStream_t stream) {
    static int grid = 0;
    if (grid == 0) {
        if (n_in != 22 || ws_size < 1024 * MiB) { fprintf(stderr, "kernel_launch: unexpected n_in %d / ws %zu\n", n_in, ws_size); grid = -1; return; }
        int dev = 0, cus = 0, per_cu = 0;
        if (hipGetDevice(&dev) != hipSuccess || hipDeviceGetAttribute(&cus, hipDeviceAttributeMultiprocessorCount, dev) != hipSuccess) { grid = -1; return; }
        if (hipFuncSetAttribute((const void*)mega_fwd, hipFuncAttributeMaxDynamicSharedMemorySize, LDS_BYTES) != hipSuccess) { fprintf(stderr, "kernel_launch: hipFuncSetAttribute failed\n"); grid = -1; return; }
        if (hipOccupancyMaxActiveBlocksPerMultiprocessor(&per_cu, (const void*)mega_fwd, NWAVES * 64, LDS_BYTES) != hipSuccess || per_cu < 1) { fprintf(stderr, "kernel_launch: occupancy query says %d\n", per_cu); per_cu = 1; }
        (void)hipGetLastError();
        grid = cus;
    }
    if (grid < 0) return;
    (void)hipMemsetAsync((char*)d_ws + WS_CTL, 0, CTL_ZERO_BYTES, stream);
    Args a{};
    a.x = (const float*)d_in[0]; a.p = (const float*)d_in[1]; a.positions = (const int*)d_in[2]; a.g_mix = (const float*)d_in[3]; a.w_in = (const float*)d_in[4];
    a.sbq = (const float*)d_in[5]; a.sbk = (const float*)d_in[6]; a.rq = (const float*)d_in[7]; a.rk = (const float*)d_in[8]; a.gn_g = (const float*)d_in[9]; a.gn_b = (const float*)d_in[10];
    a.w_out = (const float*)d_in[11]; a.g_ffn = (const float*)d_in[12]; a.w_r = (const float*)d_in[13]; a.b_r = (const float*)d_in[14]; a.w_ug = (const float*)d_in[15]; a.b_ug = (const float*)d_in[16];
    a.w_dn = (const float*)d_in[17]; a.b_dn = (const float*)d_in[18]; a.g_ple = (const float*)d_in[19]; a.w_pg = (const float*)d_in[20]; a.w_pp = (const float*)d_in[21];
    a.out = (float*)d_out; a.ws = (unsigned char*)d_ws; a.ph_lo = 0; a.ph_hi = 10;
    hipLaunchKernelGGL(mega_fwd, dim3(grid), dim3(NWAVES * 64), LDS_BYTES, stream, a);

}
```

```cpp
#include <hip/hip_runtime.h>
#include <cstdint>
#include <cstdio>
#include <cmath>

namespace pg8 {
#define PG8_LAS __attribute__((address_space(3)))
typedef unsigned short bf16_t;
typedef short bf16x8 __attribute__((ext_vector_type(8)));
typedef float f32x4 __attribute__((ext_vector_type(4)));
typedef unsigned u32x4 __attribute__((ext_vector_type(4)));
typedef unsigned u32x2 __attribute__((ext_vector_type(2)));
typedef int v4i32 __attribute__((ext_vector_type(4)));
typedef int v8i32 __attribute__((ext_vector_type(8)));
constexpr int BM = 256, BK = 64, HALF = 128, HTB = HALF * BK * 2  , STAGE_BYTES = 8 * HTB, NXCD = 8, WGM = 8;

__host__ __device__ __forceinline__ int lds_byte(int r, int c) { const int st = (r >> 4) * 2 + (c >> 5), rr = r & 15, cc = c & 31, ob = rr * 64 + cc * 2; return st * 1024 + (ob ^ (((ob >> 9) & 1) << 5)); }
__host__ __device__ __forceinline__ void stage_rc(int b, int& R, int& C) { const int st = b / 1024, sb = b % 1024, swz = sb ^ (((sb >> 9) & 1) << 5); R = (st >> 1) * 16 + swz / 64; C = (st & 1) * 32 + (swz % 64) / 2; }
__host__ __device__ __forceinline__ int perm32(int rho) { const int n = rho >> 4, i = rho & 15; return 8 * (i >> 2) + 4 * n + (i & 3); }

struct Unit { int pm, pn, e; };
struct Gemm { const bf16_t* A; const bf16_t* Bt; int K; size_t strideBe; };

struct StaticOrder {
    int nM, nN, nwg, G, c;
    __host__ __device__ void init(int nM_, int nN_, int G_, int c_) { nM = nM_; nN = nN_; nwg = nM * nN; G = G_; c = c_; }
    __host__ __device__ bool next(int i, Unit& u) const {
        const long L = (long)i * G + c; if (L >= nwg) return false;
        int wgid = (int)L; { const int q = nwg / NXCD, r = nwg % NXCD, xcd = wgid % NXCD, off = wgid / NXCD; wgid = (xcd < r ? xcd * (q + 1) : r * (q + 1) + (xcd - r) * q) + off; }
        const int nig = WGM * nN, gid = wgid / nig, fm = gid * WGM, gsz = (nM - fm) < WGM ? (nM - fm) : WGM;
        u.pm = fm + ((wgid % nig) % gsz); u.pn = (wgid % nig) / gsz; u.e = 0; return true;
    }
    __device__ __forceinline__ void a_ready(const Unit&) const {}
    __device__ __forceinline__ void done(const Unit&) const {}
};

typedef float f32x2_t __attribute__((ext_vector_type(2))); typedef __bf16 bf16x2_t __attribute__((ext_vector_type(2)));
__device__ __forceinline__ unsigned cvt_pk_bf16(float lo, float hi) { f32x2_t v = {lo, hi}; bf16x2_t b = __builtin_convertvector(v, bf16x2_t); return __builtin_bit_cast(unsigned, b); }

constexpr int T = 16384, SEQ = 2048, DM = 1024, DIN = 3584;
constexpr float EPS = 1e-6f;
__device__ __forceinline__ u32x4 pack8(const f32x4 a, const f32x4 b) { u32x4 w; w.x = cvt_pk_bf16(a[0], a[1]); w.y = cvt_pk_bf16(a[2], a[3]); w.z = cvt_pk_bf16(b[0], b[1]); w.w = cvt_pk_bf16(b[2], b[3]); return w; }

struct EpiProj {
    static constexpr bool PERM = true, AFTER_DRAIN = false;
    bf16_t* hm;
    bf16_t* rg;
    const float* gains;
    const float *ropec, *ropes;
    __device__ __forceinline__ void operator()(const f32x4 (&acc)[2][2][4][2], const Unit& u, int wr, int wc, int fr, int fq) const {
        const int region = u.pn >> 1, hb = 4 * (u.pn & 1) + wc;
        const bool normed = (region == 0) || (region == 1) || (region == 3) || (region == 4);
        const bool rope = (region == 3) || (region == 4);
        const int gidx = region == 0 ? 0 : region == 1 ? 1 : region == 3 ? 2 : 3;
        const float* gp = gains + gidx * 64;
        f32x4 gv[2][2];
#pragma unroll
        for (int bj = 0; bj < 2; ++bj)
#pragma unroll
            for (int n = 0; n < 2; ++n) gv[bj][n] = normed ? *(const f32x4*)(gp + 32 * bj + 8 * fq + 4 * n) : (f32x4){1.f, 1.f, 1.f, 1.f};
        const float lg2g = __log2f(1.0f - __builtin_amdgcn_exp2f(-5.0f - (float)hb));
        const float scale = region == 0 ? 0.125f * 1.4426950408889634f : region == 4 ? 0.125f : 1.0f;
#pragma unroll
        for (int ai = 0; ai < 2; ++ai)
#pragma unroll
            for (int m = 0; m < 4; ++m) {
                const int row = u.pm * BM + ai * HALF + wr * 64 + m * 16 + fr;
                const int b = row >> 11, s = row & (SEQ - 1);
                f32x4 v[2][2];
#pragma unroll
                for (int bj = 0; bj < 2; ++bj)
#pragma unroll
                    for (int n = 0; n < 2; ++n) v[bj][n] = acc[ai][bj][m][n];
                if (normed) {
                    float ss = 0.f;
#pragma unroll
                    for (int bj = 0; bj < 2; ++bj)
#pragma unroll
                        for (int n = 0; n < 2; ++n) { const f32x4 x = v[bj][n]; ss += (x[0] * x[0] + x[1] * x[1]) + (x[2] * x[2] + x[3] * x[3]); }
                    ss += __shfl_xor(ss, 16); ss += __shfl_xor(ss, 32);
                    float rs = rsqrtf(ss * (1.0f / 64.0f) + EPS) * scale;
                    if (rope) rs *= (region == 3) ? __builtin_amdgcn_exp2f((float)(s & 31) * lg2g) : __builtin_amdgcn_exp2f(-(float)(s & 63) * lg2g);
#pragma unroll
                    for (int bj = 0; bj < 2; ++bj)
#pragma unroll
                        for (int n = 0; n < 2; ++n) v[bj][n] = v[bj][n] * rs * gv[bj][n];
                    if (rope) {
#pragma unroll
                        for (int n = 0; n < 2; ++n) {
                            const f32x4 c = *(const f32x4*)(ropec + (size_t)row * 32 + 8 * fq + 4 * n), sn = *(const f32x4*)(ropes + (size_t)row * 32 + 8 * fq + 4 * n);
                            const f32x4 lo = v[0][n], hi = v[1][n];
                            v[0][n] = lo * c - hi * sn; v[1][n] = hi * c + lo * sn;
                        }
                    }
                }
                bf16_t* dst = (region < 6) ? hm + (size_t)region * ((size_t)T * 512) + ((size_t)(b * 8 + hb) * SEQ + s) * 64 + 8 * fq
                                           : rg + (size_t)row * 512 + hb * 64 + 8 * fq;
#pragma unroll
                for (int bj = 0; bj < 2; ++bj) *(u32x4*)(dst + 32 * bj) = pack8(v[bj][0], v[bj][1]);
            }
    }
};

struct EpiBf16Plain {
    static constexpr bool PERM = true, AFTER_DRAIN = false;
    bf16_t* O; int ldc;
    __device__ __forceinline__ void operator()(const f32x4 (&acc)[2][2][4][2], const Unit& u, int wr, int wc, int fr, int fq) const {
        const int row0 = u.pm * BM + wr * 64 + fr, col0 = u.pn * BM + wc * 32 + 8 * fq;
#pragma unroll
        for (int ai = 0; ai < 2; ++ai)
#pragma unroll
            for (int m = 0; m < 4; ++m) { bf16_t* rowp = O + (size_t)(row0 + ai * HALF + m * 16) * ldc + col0;
#pragma unroll
                for (int bj = 0; bj < 2; ++bj) *(u32x4*)(rowp + bj * HALF) = pack8(acc[ai][bj][m][0], acc[ai][bj][m][1]); }
    }
};
struct EpiResid {
    static constexpr bool PERM = false, AFTER_DRAIN = false;
    const float* base; float* out;
    __device__ __forceinline__ void operator()(const f32x4 (&acc)[2][2][4][2], const Unit& u, int wr, int wc, int fr, int fq) const {
        const int col0 = u.pn * BM + wc * 32 + 4 * fq;
#pragma unroll
        for (int ai = 0; ai < 2; ++ai)
#pragma unroll
            for (int m = 0; m < 4; ++m) { const size_t off = (size_t)(u.pm * BM + ai * HALF + wr * 64 + m * 16 + fr) * DM + col0;
#pragma unroll
                for (int bj = 0; bj < 2; ++bj)
#pragma unroll
                    for (int n = 0; n < 2; ++n) { const f32x4 bs = *(const f32x4*)(base + off + bj * HALF + n * 16); *(f32x4*)(out + off + bj * HALF + n * 16) = bs + acc[ai][bj][m][n]; } }
    }
};
struct EpiMoeUp {
    static constexpr bool PERM = true, AFTER_DRAIN = false;
    unsigned char* H; const float* bias; const float* srstd;
    __device__ __forceinline__ void operator()(const f32x4 (&acc)[2][2][4][2], const Unit& u, int wr, int wc, int fr, int fq) const {
        const int cc = 128 * u.pn + 32 * wc + 8 * fq;
        const float* bp = bias + (size_t)u.e * 2048 + cc;
        f32x4 bg[2], bl[2];
#pragma unroll
        for (int n = 0; n < 2; ++n) { bg[n] = *(const f32x4*)(bp + 4 * n); bl[n] = *(const f32x4*)(bp + 1024 + 4 * n); }
#pragma unroll
        for (int ai = 0; ai < 2; ++ai)
#pragma unroll
            for (int m = 0; m < 4; ++m) {
                f32x4 hv[2]; const float sc = srstd[u.pm * BM + ai * HALF + wr * 64 + m * 16 + fr] * 0.015625f;
#pragma unroll
                for (int n = 0; n < 2; ++n) {
                    const f32x4 g0 = acc[ai][0][m][n] * sc + bg[n], l0 = acc[ai][1][m][n] * sc + bl[n];
#pragma unroll
                    for (int j = 0; j < 4; ++j) {
                        const float glu = __builtin_fminf(g0[j], 7.0f), lin = __builtin_fminf(__builtin_fmaxf(l0[j], -7.0f), 7.0f);
                        const float sg = __builtin_amdgcn_rcpf(1.0f + __builtin_amdgcn_exp2f(-1.702f * 1.4426950408889634f * glu));
                        hv[n][j] = glu * sg * (lin + 1.0f);
                    }
                }
                u32x2 hq; hq.x = (unsigned)__builtin_amdgcn_cvt_pk_fp8_f32(hv[0][0], hv[0][1], 0, false); hq.x = (unsigned)__builtin_amdgcn_cvt_pk_fp8_f32(hv[0][2], hv[0][3], (int)hq.x, true);
                hq.y = (unsigned)__builtin_amdgcn_cvt_pk_fp8_f32(hv[1][0], hv[1][1], 0, false); hq.y = (unsigned)__builtin_amdgcn_cvt_pk_fp8_f32(hv[1][2], hv[1][3], (int)hq.y, true);
                *(u32x2*)(H + (size_t)(u.pm * BM + ai * HALF + wr * 64 + m * 16 + fr) * 1024 + cc) = hq;
            }
    }
};
struct EpiMoeDown {
    static constexpr bool PERM = true, AFTER_DRAIN = false;
    bf16_t* YS; const float* bias;
    __device__ __forceinline__ void operator()(const f32x4 (&acc)[2][2][4][2], const Unit& u, int wr, int wc, int fr, int fq) const {
        const int col0 = u.pn * BM + wc * 32 + 8 * fq;
        f32x4 bv[2][2];
#pragma unroll
        for (int bj = 0; bj < 2; ++bj)
#pragma unroll
            for (int n = 0; n < 2; ++n) bv[bj][n] = *(const f32x4*)(bias + (size_t)u.e * 1024 + col0 + bj * HALF + 4 * n);
#pragma unroll
        for (int ai = 0; ai < 2; ++ai)
#pragma unroll
            for (int m = 0; m < 4; ++m) { bf16_t* rowp = YS + (size_t)(u.pm * BM + ai * HALF + wr * 64 + m * 16 + fr) * 1024 + col0;
#pragma unroll
                for (int bj = 0; bj < 2; ++bj) *(u32x4*)(rowp + bj * HALF) = pack8(acc[ai][bj][m][0] * 0.015625f + bv[bj][0], acc[ai][bj][m][1] * 0.015625f + bv[bj][1]); }
    }
};
struct EpiPle {
    static constexpr bool PERM = false, AFTER_DRAIN = false;
    float* out; const bf16_t* PJ; float* outw;
    __device__ __forceinline__ void operator()(const f32x4 (&acc)[2][2][4][2], const Unit& u, int wr, int wc, int fr, int fq) const {
        const int col0 = u.pn * BM + wc * 32 + 4 * fq;
#pragma unroll
        for (int ai = 0; ai < 2; ++ai)
#pragma unroll
            for (int m = 0; m < 4; ++m) { const size_t off = (size_t)(u.pm * BM + ai * HALF + wr * 64 + m * 16 + fr) * DM + col0;
#pragma unroll
                for (int bj = 0; bj < 2; ++bj)
#pragma unroll
                    for (int n = 0; n < 2; ++n) {
                        const size_t o2 = off + bj * HALF + n * 16;
                        const f32x4 x2 = *(const f32x4*)(out + o2); const u32x2 pj = *(const u32x2*)(PJ + o2); const f32x4 a = acc[ai][bj][m][n] * 0.015625f;
                        f32x4 r;
                        r[0] = x2[0] + __uint_as_float(pj.x << 16) * __builtin_amdgcn_rcpf(1.0f + __builtin_amdgcn_exp2f(-1.4426950408889634f * a[0]));
                        r[1] = x2[1] + __uint_as_float(pj.x & 0xffff0000u) * __builtin_amdgcn_rcpf(1.0f + __builtin_amdgcn_exp2f(-1.4426950408889634f * a[1]));
                        r[2] = x2[2] + __uint_as_float(pj.y << 16) * __builtin_amdgcn_rcpf(1.0f + __builtin_amdgcn_exp2f(-1.4426950408889634f * a[2]));
                        r[3] = x2[3] + __uint_as_float(pj.y & 0xffff0000u) * __builtin_amdgcn_rcpf(1.0f + __builtin_amdgcn_exp2f(-1.4426950408889634f * a[3]));
                        *(f32x4*)(outw + o2) = r;
                    } }
    }
};
struct MoeOrder {
    int nM, nN, nwg, G, c; const PG8_LAS int* tile_e;
    __device__ void init(int nM_, int nN_, int G_, int c_, const PG8_LAS int* te) { nM = nM_; nN = nN_; nwg = nM * nN; G = G_; c = c_; tile_e = te; }
    __device__ bool next(int i, Unit& u) const {
        const long L = (long)i * G + c; if (L >= nwg) return false;
        int wgid = (int)L; { const int q = nwg / NXCD, r = nwg % NXCD, xcd = wgid % NXCD, off = wgid / NXCD; wgid = (xcd < r ? xcd * (q + 1) : r * (q + 1) + (xcd - r) * q) + off; }
        const int nig = WGM * nN, gid = wgid / nig, fm = gid * WGM, gsz = (nM - fm) < WGM ? (nM - fm) : WGM;
        u.pm = fm + ((wgid % nig) % gsz); u.pn = (wgid % nig) / gsz; u.e = __builtin_amdgcn_readfirstlane(tile_e[u.pm]); return true;
    }
    __device__ __forceinline__ void a_ready(const Unit&) const {}
    __device__ __forceinline__ void done(const Unit&) const {}
};
template <class Epi, class Sched, bool ALIGN_EPI = false, bool SP2 = false, bool F8 = false>
__device__ __forceinline__ void gemm_phase(PG8_LAS unsigned char* lds, const Gemm g, const Sched& S, const Epi& E) {
    int tid_ = threadIdx.x; asm volatile("" : "+v"(tid_));
    const int tid = tid_, wid = __builtin_amdgcn_readfirstlane(tid >> 6), lane = tid & 63, wr = wid >> 2, wc = wid & 3, fr = lane & 15, fq = lane >> 4;
    const int K = g.K, nt = K / BK;
    unsigned voffA[2], voffB[2];
#pragma unroll
    for (int i = 0; i < 2; ++i) { int R, C; stage_rc(tid * 16 + i * 8192, R, C); const int Rb = Epi::PERM ? ((R & ~31) + perm32(R & 31)) : R;
        voffA[i] = (unsigned)(R * K + C) * 2u; voffB[i] = (unsigned)(Rb * K + C) * 2u; }
    const size_t kstep = (size_t)(BK * 2);
    const size_t hstep = (size_t)HALF * K * 2;
    const size_t tstep = 2 * hstep;
    const unsigned ldsw = (unsigned)wid * 1024u;
    const int aoff = lds_byte(wr * 64 + fr, fq * 8), boff = lds_byte(wc * 32 + fr, fq * 8);
#define PG8_SA(b, h) (((b) * 2 + (h)) * HTB)
#define PG8_SB(b, h) ((4 + (b) * 2 + (h)) * HTB)
#define PG8_STAGE(bufoff, gbase, voff) do { _Pragma("unroll") for (int _i = 0; _i < 2; ++_i) \
        __builtin_amdgcn_global_load_lds((const unsigned*)((const char*)(gbase) + (voff)[_i]), (PG8_LAS unsigned*)(lds + (bufoff) + ldsw + _i * 8192), 16, 0, 0); } while (0)
#define PG8_LD16(off) (*(const PG8_LAS v4i32*)(lds + (off)))
#define PG8_LDA(dst, b, h) do { if constexpr (F8) { _Pragma("unroll") for (int m = 0; m < 4; ++m) dst##8[m] = __builtin_shufflevector(PG8_LD16(PG8_SA(b, h) + aoff + m * 2048), PG8_LD16(PG8_SA(b, h) + aoff + m * 2048 + 1024), 0, 1, 2, 3, 4, 5, 6, 7); } \
        else { _Pragma("unroll") for (int m = 0; m < 4; ++m) _Pragma("unroll") for (int k = 0; k < 2; ++k) dst[m][k] = *(const PG8_LAS bf16x8*)(lds + PG8_SA(b, h) + aoff + m * 2048 + k * 1024); } } while (0)
#define PG8_LDB(dst, b, h) do { if constexpr (F8) { _Pragma("unroll") for (int n = 0; n < 2; ++n) dst##8[n] = __builtin_shufflevector(PG8_LD16(PG8_SB(b, h) + boff + n * 2048), PG8_LD16(PG8_SB(b, h) + boff + n * 2048 + 1024), 0, 1, 2, 3, 4, 5, 6, 7); } \
        else { _Pragma("unroll") for (int n = 0; n < 2; ++n) _Pragma("unroll") for (int k = 0; k < 2; ++k) dst[n][k] = *(const PG8_LAS bf16x8*)(lds + PG8_SB(b, h) + boff + n * 2048 + k * 1024); } } while (0)
#define PG8_MMA(ai, bj, At, Bt) do { __builtin_amdgcn_s_setprio(1); \
        if constexpr (F8) { _Pragma("unroll") for (int m = 0; m < 4; ++m) _Pragma("unroll") for (int n = 0; n < 2; ++n) \
            asm volatile("v_mfma_scale_f32_16x16x128_f8f6f4 %0, %1, %2, %0, %3, %3 op_sel_hi:[0,0,0]" : "+v"(acc[ai][bj][m][n]) : "v"(Bt##8[n]), "v"(At##8[m]), "v"(f8scale)); } \
        else { _Pragma("unroll") for (int m = 0; m < 4; ++m) _Pragma("unroll") for (int n = 0; n < 2; ++n) _Pragma("unroll") for (int k = 0; k < 2; ++k) \
            acc[ai][bj][m][n] = __builtin_amdgcn_mfma_f32_16x16x32_bf16(Bt[n][k], At[m][k], acc[ai][bj][m][n], 0, 0, 0); } \
        __builtin_amdgcn_s_setprio(0); } while (0)
#define PG8_WAIT_V(n) asm volatile("s_waitcnt vmcnt(" #n ")" ::: "memory")
#define PG8_WAIT_L(n) asm volatile("s_waitcnt lgkmcnt(" #n ")" ::: "memory")
#define PG8_BAR __builtin_amdgcn_s_barrier()
#define PG8_SCHED __builtin_amdgcn_sched_barrier(0)
    Unit cur, nxt; int ui = 0;
    if (!S.next(0, cur)) return;
    f32x4 acc[2][2][4][2];
#pragma unroll
    for (int a = 0; a < 2; ++a)
#pragma unroll
        for (int b = 0; b < 2; ++b)
#pragma unroll
            for (int m = 0; m < 4; ++m)
#pragma unroll
                for (int n = 0; n < 2; ++n) acc[a][b][m][n] = (f32x4){0.f, 0.f, 0.f, 0.f};
    bf16x8 At[4][2], B0[2][2], B1[2][2];
    v8i32 At8[4], B08[2], B18[2]; const int f8scale = 0x7f7f7f7f;
    const char* cA = (const char*)g.A + (size_t)cur.pm * tstep; const char* cB = (const char*)g.Bt + (size_t)cur.e * g.strideBe + (size_t)cur.pn * tstep;
    S.a_ready(cur);
    if constexpr (SP2) {
        PG8_STAGE(PG8_SB(0, 0), cB, voffB); PG8_STAGE(PG8_SB(0, 1), cB + hstep, voffB); PG8_STAGE(PG8_SA(0, 0), cA, voffA); PG8_STAGE(PG8_SA(0, 1), cA + hstep, voffA);
        if (wr == 1) PG8_BAR;
        PG8_WAIT_V(2); PG8_BAR;
        PG8_STAGE(PG8_SB(1, 0), cB + kstep, voffB); PG8_STAGE(PG8_SA(1, 0), cA + kstep, voffA); PG8_STAGE(PG8_SB(1, 1), cB + hstep + kstep, voffB);
        PG8_WAIT_V(6); PG8_BAR;
    } else {
        PG8_STAGE(PG8_SB(0, 0), cB, voffB); PG8_STAGE(PG8_SA(0, 0), cA, voffA); PG8_STAGE(PG8_SB(0, 1), cB + hstep, voffB); PG8_STAGE(PG8_SA(0, 1), cA + hstep, voffA);
        if (wr == 1) PG8_BAR;
        PG8_WAIT_V(4); PG8_BAR;
        PG8_STAGE(PG8_SB(1, 0), cB + kstep, voffB); PG8_STAGE(PG8_SA(1, 0), cA + kstep, voffA); PG8_STAGE(PG8_SB(1, 1), cB + hstep + kstep, voffB);
        PG8_WAIT_V(6); PG8_BAR;
    }
    for (;;) {
        const bool has_next = S.next(ui + 1, nxt);
        const char* nA = has_next ? (const char*)g.A + (size_t)nxt.pm * tstep : cA; const char* nB = has_next ? (const char*)g.Bt + (size_t)nxt.e * g.strideBe + (size_t)nxt.pn * tstep : cB;
#pragma unroll 1
        for (int t = 0; t < nt; t += 2) {
            const bool last = (t == nt - 2);
            const char* a1 = cA + (size_t)(t + 1) * kstep;
            const char* a2 = last ? nA : cA + (size_t)(t + 2) * kstep; const char* b2 = last ? nB : cB + (size_t)(t + 2) * kstep;
            const char* a3 = a2 + kstep; const char* b3 = b2 + kstep;
            if (last && has_next) S.a_ready(nxt);
            if constexpr (SP2) {
            PG8_LDB(B0, 0, 0); PG8_LDB(B1, 0, 1); PG8_SCHED; PG8_LDA(At, 0, 0); PG8_STAGE(PG8_SA(1, 1), a1 + hstep, voffA);
            PG8_WAIT_V(8); PG8_WAIT_L(0); PG8_BAR; PG8_MMA(0, 0, At, B0); PG8_MMA(0, 1, At, B1); PG8_BAR; PG8_SCHED;
            PG8_LDA(At, 0, 1); PG8_STAGE(PG8_SB(0, 0), b2, voffB); PG8_STAGE(PG8_SB(0, 1), b2 + hstep, voffB); PG8_STAGE(PG8_SA(0, 0), a2, voffA);
            PG8_WAIT_V(8); PG8_WAIT_L(0); PG8_BAR; PG8_MMA(1, 0, At, B0); PG8_MMA(1, 1, At, B1); PG8_BAR; PG8_SCHED;
            PG8_LDB(B0, 1, 0); PG8_LDB(B1, 1, 1); PG8_SCHED; PG8_LDA(At, 1, 0); PG8_STAGE(PG8_SA(0, 1), a2 + hstep, voffA);
            PG8_WAIT_V(8); PG8_WAIT_L(0); PG8_BAR; PG8_MMA(0, 0, At, B0); PG8_MMA(0, 1, At, B1); PG8_BAR; PG8_SCHED;
            PG8_LDA(At, 1, 1); PG8_STAGE(PG8_SB(1, 0), b3, voffB); PG8_STAGE(PG8_SB(1, 1), b3 + hstep, voffB); PG8_STAGE(PG8_SA(1, 0), a3, voffA);
            PG8_WAIT_V(8); PG8_WAIT_L(0); PG8_BAR; PG8_MMA(1, 0, At, B0); PG8_MMA(1, 1, At, B1); PG8_BAR; PG8_SCHED;
            } else {
            PG8_LDB(B0, 0, 0); PG8_SCHED; PG8_LDA(At, 0, 0); PG8_STAGE(PG8_SA(1, 1), a1 + hstep, voffA);
            PG8_WAIT_L(8); PG8_BAR; PG8_WAIT_L(0); PG8_MMA(0, 0, At, B0); PG8_BAR; PG8_SCHED;
            PG8_LDB(B1, 0, 1); PG8_STAGE(PG8_SB(0, 0), b2, voffB);
            PG8_BAR; PG8_WAIT_L(0); PG8_MMA(0, 1, At, B1); PG8_BAR;
            PG8_LDA(At, 0, 1); PG8_STAGE(PG8_SA(0, 0), a2, voffA);
            PG8_BAR; PG8_WAIT_L(0); PG8_MMA(1, 0, At, B0); PG8_BAR; PG8_SCHED;
            PG8_STAGE(PG8_SB(0, 1), b2 + hstep, voffB);
            PG8_WAIT_V(6); PG8_BAR; PG8_MMA(1, 1, At, B1); PG8_BAR;
            PG8_LDB(B0, 1, 0); PG8_SCHED; PG8_LDA(At, 1, 0); PG8_STAGE(PG8_SA(0, 1), a2 + hstep, voffA);
            PG8_WAIT_L(8); PG8_BAR; PG8_WAIT_L(0); PG8_MMA(0, 0, At, B0); PG8_BAR; PG8_SCHED;
            PG8_LDB(B1, 1, 1); PG8_STAGE(PG8_SB(1, 0), b3, voffB);
            PG8_BAR; PG8_WAIT_L(0); PG8_MMA(0, 1, At, B1); PG8_BAR;
            PG8_LDA(At, 1, 1); PG8_STAGE(PG8_SA(1, 0), a3, voffA);
            PG8_BAR; PG8_WAIT_L(0); PG8_MMA(1, 0, At, B0); PG8_BAR; PG8_SCHED;
            PG8_STAGE(PG8_SB(1, 1), b3 + hstep, voffB);
            PG8_WAIT_V(6); PG8_BAR; PG8_MMA(1, 1, At, B1); PG8_BAR;
            }
        }
        if constexpr (ALIGN_EPI) { if (wr == 0) PG8_BAR; }
        if constexpr (F8) asm volatile("s_nop 15\n\ts_nop 15\n\ts_nop 15" ::: "memory");
        if constexpr (!Epi::AFTER_DRAIN) { E(acc, cur, wr, wc, fr, fq); S.done(cur); }
        if (!has_next) break;
#pragma unroll
        for (int a = 0; a < 2; ++a)
#pragma unroll
            for (int b = 0; b < 2; ++b)
#pragma unroll
                for (int m = 0; m < 4; ++m)
#pragma unroll
                    for (int n = 0; n < 2; ++n) acc[a][b][m][n] = (f32x4){0.f, 0.f, 0.f, 0.f};
        cur = nxt; cA = nA; cB = nB; ++ui;
        if constexpr (ALIGN_EPI) { if (wr == 1) PG8_BAR; }
    }
    PG8_WAIT_V(0);
    if constexpr (!ALIGN_EPI) { if (wr == 0) PG8_BAR; }
    PG8_BAR;
    if constexpr (Epi::AFTER_DRAIN) { E.fused(acc, cur, wr, wc, fr, fq, lds, wid, lane); S.done(cur); }
#undef PG8_SA
#undef PG8_SB
#undef PG8_STAGE
#undef PG8_LD16
#undef PG8_LDA
#undef PG8_LDB
#undef PG8_MMA
#undef PG8_WAIT_V
#undef PG8_WAIT_L
#undef PG8_BAR
#undef PG8_SCHED
}
}

constexpr int NWAVES = 8;
constexpr int T = pg8::T, SEQ = pg8::SEQ, DM = pg8::DM, DIN = pg8::DIN, NE = 32, PLE = 256;
constexpr float EPS = pg8::EPS;
constexpr size_t MiB = 1u << 20;
constexpr size_t WS_CTL = 0, CTL_ZERO_BYTES = 1 * MiB;
constexpr size_t WS_WT_IN = 2 * MiB, WS_WT_OUT = 9 * MiB, WS_WT_PG = 11 * MiB, WS_WT_PP = 13 * MiB;
constexpr size_t WS_GAINS = 13 * MiB + 512 * 1024;
constexpr size_t WS_WRT = 13 * MiB + 576 * 1024;
constexpr size_t WS_ROPEC = 14 * MiB, WS_ROPES = 16 * MiB, WS_PB = 18 * MiB, WS_ROUTE = 26 * MiB;
constexpr size_t WS_WT_UG = 32 * MiB, WS_WT_DN = 160 * MiB;
constexpr size_t WS_XN = 224 * MiB;
constexpr size_t WS_HM = 256 * MiB;
constexpr size_t WS_RG = 352 * MiB;
constexpr size_t WS_Y = 368 * MiB;
constexpr size_t WS_PJ = 400 * MiB;
constexpr size_t WS_XS = 432 * MiB, WS_H = 576 * MiB, WS_YS = 720 * MiB;
constexpr size_t WS_END = 864 * MiB;
constexpr int CW_TMO = 0, CW_CODE = 1;
constexpr int CW_BAR = 4096;
constexpr int RING_OFF = 0, RING_BYTES = 131072;
constexpr int LDSCTL_OFF = RING_BYTES, MISC_OFF = LDSCTL_OFF + 320;
constexpr int LDS_BYTES = 147456;
#define GAS __attribute__((address_space(1)))
#define LAS __attribute__((address_space(3)))
typedef unsigned short bf16;
typedef unsigned v4u __attribute__((ext_vector_type(4)));
typedef float f32x4 __attribute__((ext_vector_type(4)));
typedef short bf16x8 __attribute__((ext_vector_type(8)));
typedef unsigned u32x4_t __attribute__((ext_vector_type(4)));
typedef unsigned u32x2_t __attribute__((ext_vector_type(2)));
typedef GAS unsigned gu32;
typedef GAS unsigned long long gu64;
#define RLX_AGENT __ATOMIC_RELAXED, __HIP_MEMORY_SCOPE_AGENT
#define LDS_WAIT() asm volatile("s_waitcnt lgkmcnt(0)" ::: "memory")
#define VM_WAIT() asm volatile("s_waitcnt vmcnt(0)" ::: "memory")
__device__ __forceinline__ unsigned long long rt() { return __builtin_amdgcn_s_memrealtime(); }
__device__ __forceinline__ unsigned f2bf(float f) { unsigned u = __builtin_bit_cast(unsigned, f); return (u + 0x7fffu + ((u >> 16) & 1u)) >> 16; }
__device__ __forceinline__ unsigned pk2(float lo, float hi) { return f2bf(lo) | (f2bf(hi) << 16); }

#define XB_TMO      128
#define XB_XCNT(j)  (256  + 64 * (j))
#define XB_XSUB(j)  (1280 + 64 * (j))
#define XB_XGEN(j)  (2304 + 64 * (j))
#define XB_TOP      3328
#define XB_TOPGEN   3392
#define XCD_BAR_WORDS 3456
#define XB_SPIN_CAP (1u << 18)

__device__ __forceinline__ unsigned xb_ld(unsigned* p)              { return __hip_atomic_load(p, __ATOMIC_RELAXED, __HIP_MEMORY_SCOPE_AGENT); }
__device__ __forceinline__ unsigned xb_add(unsigned* p, unsigned v) { return __hip_atomic_fetch_add(p, v, __ATOMIC_RELAXED, __HIP_MEMORY_SCOPE_AGENT); }
__device__ __forceinline__ unsigned xb_xcc_id() { return (unsigned)__builtin_amdgcn_s_getreg((3 << 11) | 20) & 0xFu; }
#define XB_SPIN(cond, bar) do { unsigned _sp = 0; while (cond) { __builtin_amdgcn_s_sleep(1); \
    if ((++_sp & 255u) == 0u) { if (xb_ld(&(bar)[XB_TMO])) break; if (_sp > XB_SPIN_CAP) { atomicAdd(&(bar)[XB_TMO], 1u); break; } } } } while (0)

struct XcdBarrier {
    unsigned* bar; unsigned x;
    volatile LAS unsigned* st;
};

__device__ __forceinline__ XcdBarrier xcd_barrier_post(unsigned* bar, volatile LAS unsigned* st) {
    XcdBarrier b; b.bar = bar; b.x = xb_xcc_id(); b.st = st;
    if (threadIdx.x == 0) (void)xb_add(&bar[XB_XCNT(b.x)], 1u);
    return b;
}
__device__ __forceinline__ void xcd_barrier_complete(unsigned* bar, unsigned x, unsigned& nloc, unsigned& nx) {
    const unsigned G = gridDim.x * gridDim.y * gridDim.z;
    unsigned sum, cnt, mine, sp = 0u;
    for (;;) {
        sum = 0u; cnt = 0u; mine = 0u;
#pragma unroll
        for (unsigned j = 0; j < 16; ++j) { const unsigned c = xb_ld(&bar[XB_XCNT(j)]); sum += c; cnt += (c > 0u) ? 1u : 0u; mine = (j == x) ? c : mine; }
        if (sum == G) break;
        __builtin_amdgcn_s_sleep(1);
        if ((++sp & 255u) == 0u) { if (xb_ld(&bar[XB_TMO])) break; if (sp > XB_SPIN_CAP) { atomicAdd(&bar[XB_TMO], 1u); break; } }
    }
    nloc = mine > 0u ? mine : 1u; nx = cnt > 0u ? cnt : 1u;
}

__device__ __forceinline__ void xcd_barrier(const XcdBarrier& b) {
    asm volatile("s_waitcnt vmcnt(0)" ::: "memory");
    __syncthreads();
    if (threadIdx.x == 0) {
        unsigned* bar = b.bar;
        __builtin_amdgcn_s_waitcnt(0);
        unsigned nloc = b.st[0], nx = b.st[1];
        if (nloc == 0u) { xcd_barrier_complete(bar, b.x, nloc, nx); b.st[0] = nloc; b.st[1] = nx; }
        const unsigned old = xb_add(&bar[XB_XSUB(b.x)], 1u);
        const unsigned gen = old / nloc;
        if (old + 1u == (gen + 1u) * nloc) {
            __builtin_amdgcn_fence(__ATOMIC_RELEASE, "agent");
            asm volatile("s_waitcnt vmcnt(0)" ::: "memory");
            const unsigned og = xb_add(&bar[XB_TOP], 1u);
            const unsigned tg = og / nx;
            if (og + 1u == (tg + 1u) * nx) xb_add(&bar[XB_TOPGEN], 1u);
            else XB_SPIN(xb_ld(&bar[XB_TOPGEN]) == tg, bar);
            __builtin_amdgcn_fence(__ATOMIC_ACQUIRE, "agent");
            xb_add(&bar[XB_XGEN(b.x)], 1u);
            asm volatile("s_waitcnt vmcnt(0)" ::: "memory");
        } else {
            XB_SPIN(xb_ld(&bar[XB_XGEN(b.x)]) == gen, bar);
            __builtin_amdgcn_fence(__ATOMIC_ACQUIRE, "agent");
            asm volatile("s_waitcnt vmcnt(0)" ::: "memory");
        }
    }
    __syncthreads();
}

struct Args {
    const float* x; const float* p; const int* positions; const float* g_mix; const float* w_in;
    const float* sbq; const float* sbk; const float* rq; const float* rk; const float* gn_g; const float* gn_b; const float* w_out;
    const float* g_ffn; const float* w_r; const float* b_r; const float* w_ug; const float* b_ug; const float* w_dn; const float* b_dn;
    const float* g_ple; const float* w_pg; const float* w_pp;
    float* out; unsigned char* ws; int ph_lo, ph_hi;
};
struct Frame {
    LAS unsigned char* lds;
    volatile LAS unsigned* MISC;
    gu32* ctl;
    int wave;
    int vcu, G;
};
__device__ __forceinline__ int tid_now() { int t = threadIdx.x; asm volatile("" : "+v"(t)); return t; }
__device__ __forceinline__ float wave_sum(float v) {
#pragma unroll
    for (int o = 1; o < 64; o <<= 1) v += __shfl_xor(v, o);
    return v;
}
__device__ __forceinline__ unsigned cvtpk(float lo, float hi) { return pg8::cvt_pk_bf16(lo, hi); }

enum { MAP_NAT = 0, MAP_IN = 1, MAP_UG = 2 };
__device__ __forceinline__ void p0_item(const float* __restrict__ W, int N, int K, bf16* __restrict__ WT, int kb, int nb, int mapmode, LAS unsigned char* scr, int lane) {
    const int np = 64 * nb + 4 * (lane & 15);
    int src = np;
    if (mapmode == MAP_IN) { const int pn = np >> 8, L = np & 255, bj = L >> 7, wc = (L >> 5) & 3, e = L & 31; src = 256 * pn + 64 * wc + 32 * bj + e; }
    else if (mapmode == MAP_UG) { const int pn = np >> 8, L = np & 255, bj = L >> 7, i = L & 127; src = 1024 * bj + 128 * pn + i; }
    const float* gp = W + (size_t)(64 * kb + (lane >> 4)) * N + src;
    f32x4 v[16];
#pragma unroll
    for (int i = 0; i < 16; ++i) v[i] = *(const f32x4*)(gp + (size_t)(4 * i) * N);
#pragma unroll
    for (int i = 0; i < 16; ++i) {
        LAS unsigned* d = (LAS unsigned*)(scr + (4 * i + (lane >> 4)) * 132 + 8 * (lane & 15));
        d[0] = cvtpk(v[i][0], v[i][1]); d[1] = cvtpk(v[i][2], v[i][3]);
    }
    LDS_WAIT(); asm volatile("" ::: "memory");
    const int c = lane & 7;
#pragma unroll
    for (int it = 0; it < 4; ++it) {
        const int nl = 16 * it + 2 * (lane >> 3);
        unsigned d[8];
#pragma unroll
        for (int j = 0; j < 8; ++j) d[j] = *(const LAS unsigned*)(scr + (8 * c + j) * 132 + 2 * nl);
        v4u o0, o1;
        o0.x = (d[0] & 0xffffu) | (d[1] << 16); o0.y = (d[2] & 0xffffu) | (d[3] << 16); o0.z = (d[4] & 0xffffu) | (d[5] << 16); o0.w = (d[6] & 0xffffu) | (d[7] << 16);
        o1.x = (d[0] >> 16) | (d[1] & 0xffff0000u); o1.y = (d[2] >> 16) | (d[3] & 0xffff0000u); o1.z = (d[4] >> 16) | (d[5] & 0xffff0000u); o1.w = (d[6] >> 16) | (d[7] & 0xffff0000u);
        bf16* dst = WT + (size_t)(64 * nb + nl) * K + 64 * kb + 8 * c;
        *(v4u*)dst = o0; *(v4u*)(dst + K) = o1;
    }
    LDS_WAIT(); asm volatile("" ::: "memory");
}
__device__ __forceinline__ unsigned pk4_fp8(float a, float b, float c, float d) { int r = __builtin_amdgcn_cvt_pk_fp8_f32(a, b, 0, false); r = __builtin_amdgcn_cvt_pk_fp8_f32(c, d, r, true); return (unsigned)r; }
__device__ __forceinline__ void p0_item_f8(const float* __restrict__ W, int N, int K, unsigned char* __restrict__ WT, int kb, int nb, int mapmode, LAS unsigned char* scr, int lane) {
    const int np = 64 * nb + 4 * (lane & 15);
    int src = np;
    if (mapmode == MAP_UG) { const int pn = np >> 8, L = np & 255, bj = L >> 7, i = L & 127; src = 1024 * bj + 128 * pn + i; }
    const float* gp = W + (size_t)(64 * kb + (lane >> 4)) * N + src;
    f32x4 v[16];
#pragma unroll
    for (int i = 0; i < 16; ++i) v[i] = *(const f32x4*)(gp + (size_t)(4 * i) * N);
#pragma unroll
    for (int i = 0; i < 16; ++i) *(LAS unsigned*)(scr + (4 * i + (lane >> 4)) * 68 + 4 * (lane & 15)) = pk4_fp8(v[i][0] * 64.0f, v[i][1] * 64.0f, v[i][2] * 64.0f, v[i][3] * 64.0f);
    LDS_WAIT(); asm volatile("" ::: "memory");
    const int nq = lane & 15, kg = lane >> 4;
    unsigned d[16];
#pragma unroll
    for (int j = 0; j < 16; ++j) d[j] = *(const LAS unsigned*)(scr + (16 * kg + j) * 68 + 4 * nq);
#pragma unroll
    for (int t = 0; t < 4; ++t) {
        v4u o;
#pragma unroll
        for (int q = 0; q < 4; ++q) o[q] = ((d[4 * q] >> (8 * t)) & 0xffu) | (((d[4 * q + 1] >> (8 * t)) & 0xffu) << 8) | (((d[4 * q + 2] >> (8 * t)) & 0xffu) << 16) | (((d[4 * q + 3] >> (8 * t)) & 0xffu) << 24);
        *(v4u*)(WT + (size_t)(64 * nb + 4 * nq + t) * K + 64 * kb + 16 * kg) = o;
    }
    LDS_WAIT(); asm volatile("" ::: "memory");
}
struct P0D { const float* gp; int N, K, kb, nb; bf16* W16; unsigned char* W8; };
__device__ __forceinline__ int p0_src_col(int np, int mapmode) {
    int src = np;
    if (mapmode == MAP_IN) { const int pn = np >> 8, L = np & 255, bj = L >> 7, wc = (L >> 5) & 3, e = L & 31; src = 256 * pn + 64 * wc + 32 * bj + e; }
    else if (mapmode == MAP_UG) { const int pn = np >> 8, L = np & 255, bj = L >> 7, i = L & 127; src = 1024 * bj + 128 * pn + i; }
    return src;
}
__device__ __forceinline__ P0D p0_mk(const float* W, int N, int K, bf16* W16, unsigned char* W8, int kb, int nb, int mapmode, int lane) {
    P0D d; d.N = N; d.K = K; d.kb = kb; d.nb = nb; d.W16 = W16; d.W8 = W8;
    d.gp = W + (size_t)(64 * kb + (lane >> 4)) * N + p0_src_col(64 * nb + 4 * (lane & 15), mapmode); return d;
}
__device__ __forceinline__ void p0_load(const P0D& d, f32x4 (&v)[16]) {
#pragma unroll
    for (int i = 0; i < 16; ++i) v[i] = *(const f32x4*)(d.gp + (size_t)(4 * i) * d.N);
}
__device__ __forceinline__ void p0_finish(const P0D& d, const f32x4 (&v)[16], LAS unsigned char* scr, int lane) {
    if (d.W16) {
#pragma unroll
        for (int i = 0; i < 16; ++i) { LAS unsigned* q = (LAS unsigned*)(scr + (4 * i + (lane >> 4)) * 132 + 8 * (lane & 15)); q[0] = cvtpk(v[i][0], v[i][1]); q[1] = cvtpk(v[i][2], v[i][3]); }
        LDS_WAIT(); asm volatile("" ::: "memory");
        const int c = lane & 7;
#pragma unroll
        for (int it = 0; it < 4; ++it) {
            const int nl = 16 * it + 2 * (lane >> 3);
            unsigned x[8];
#pragma unroll
            for (int j = 0; j < 8; ++j) x[j] = *(const LAS unsigned*)(scr + (8 * c + j) * 132 + 2 * nl);
            v4u o0, o1;
            o0.x = (x[0] & 0xffffu) | (x[1] << 16); o0.y = (x[2] & 0xffffu) | (x[3] << 16); o0.z = (x[4] & 0xffffu) | (x[5] << 16); o0.w = (x[6] & 0xffffu) | (x[7] << 16);
            o1.x = (x[0] >> 16) | (x[1] & 0xffff0000u); o1.y = (x[2] >> 16) | (x[3] & 0xffff0000u); o1.z = (x[4] >> 16) | (x[5] & 0xffff0000u); o1.w = (x[6] >> 16) | (x[7] & 0xffff0000u);
            bf16* dst = d.W16 + (size_t)(64 * d.nb + nl) * d.K + 64 * d.kb + 8 * c;
            *(v4u*)dst = o0; *(v4u*)(dst + d.K) = o1;
        }
    } else {
#pragma unroll
        for (int i = 0; i < 16; ++i) *(LAS unsigned*)(scr + (4 * i + (lane >> 4)) * 68 + 4 * (lane & 15)) = pk4_fp8(v[i][0] * 64.0f, v[i][1] * 64.0f, v[i][2] * 64.0f, v[i][3] * 64.0f);
        LDS_WAIT(); asm volatile("" ::: "memory");
        const int nq = lane & 15, kg = lane >> 4;
        unsigned x[16];
#pragma unroll
        for (int j = 0; j < 16; ++j) x[j] = *(const LAS unsigned*)(scr + (16 * kg + j) * 68 + 4 * nq);
#pragma unroll
        for (int t = 0; t < 4; ++t) {
            v4u o;
#pragma unroll
            for (int q = 0; q < 4; ++q) o[q] = ((x[4 * q] >> (8 * t)) & 0xffu) | (((x[4 * q + 1] >> (8 * t)) & 0xffu) << 8) | (((x[4 * q + 2] >> (8 * t)) & 0xffu) << 16) | (((x[4 * q + 3] >> (8 * t)) & 0xffu) << 24);
            *(v4u*)(d.W8 + (size_t)(64 * d.nb + 4 * nq + t) * d.K + 64 * d.kb + 16 * kg) = o;
        }
    }
    LDS_WAIT(); asm volatile("" ::: "memory");
}
__device__ __forceinline__ P0D p0_decode(const Args& a, unsigned char* ws, int it, int lane) {
    constexpr int I_IN = 16 * 56, I_OUT = 256, I_PG = 256, I_PP = 4 * 16, I_UG = 16 * 32, I_DN = 256;
    int r = it;
    if (r < I_IN) return p0_mk(a.w_in, DIN, DM, (bf16*)(ws + WS_WT_IN), nullptr, r / 56, r % 56, MAP_IN, lane); r -= I_IN;
    if (r < I_OUT) return p0_mk(a.w_out, DM, DM, (bf16*)(ws + WS_WT_OUT), nullptr, r / 16, r % 16, MAP_NAT, lane); r -= I_OUT;
    if (r < I_PG) return p0_mk(a.w_pg, DM, DM, nullptr, (unsigned char*)(ws + WS_WT_PG), r / 16, r % 16, MAP_NAT, lane); r -= I_PG;
    if (r < I_PP) return p0_mk(a.w_pp, DM, PLE, (bf16*)(ws + WS_WT_PP), nullptr, r / 16, r % 16, MAP_NAT, lane); r -= I_PP;
    if (r < NE * I_UG) { const int e = r / I_UG, q = r % I_UG; return p0_mk(a.w_ug + (size_t)e * DM * 2048, 2048, DM, nullptr, (unsigned char*)(ws + WS_WT_UG) + (size_t)e * 2048 * DM, q / 32, q % 32, MAP_UG, lane); } r -= NE * I_UG;
    { const int e = r / I_DN, q = r % I_DN; return p0_mk(a.w_dn + (size_t)e * DM * DM, DM, DM, nullptr, (unsigned char*)(ws + WS_WT_DN) + (size_t)e * DM * DM, q / 16, q % 16, MAP_NAT, lane); }
}
__device__ __forceinline__ void rms_row_to_bf16(const float* xrow, const float* g, bf16* orow, int lane) {
    const f32x4* xr = (const f32x4*)xrow + lane;
    f32x4 v[4]; float s = 0.f;
#pragma unroll
    for (int j = 0; j < 4; ++j) { v[j] = xr[64 * j]; s += (v[j][0] * v[j][0] + v[j][1] * v[j][1]) + (v[j][2] * v[j][2] + v[j][3] * v[j][3]); }
    const float rstd = rsqrtf(wave_sum(s) * (1.f / DM) + EPS);
    unsigned long long* o8 = (unsigned long long*)orow + lane;
#pragma unroll
    for (int j = 0; j < 4; ++j) { const f32x4 gg = ((const f32x4*)g)[lane + 64 * j];
        o8[64 * j] = (unsigned long long)cvtpk(v[j][0] * rstd * gg[0], v[j][1] * rstd * gg[1]) | ((unsigned long long)cvtpk(v[j][2] * rstd * gg[2], v[j][3] * rstd * gg[3]) << 32); }
}
__device__ __forceinline__ void p0_prologue(Frame& F, const Args& a) {
    unsigned char* ws = a.ws; const int tid = tid_now(), lane = tid & 63;
    LAS unsigned char* scr = F.lds + RING_OFF + F.wave * 8448;
    const int gw = F.vcu * NWAVES + F.wave, NGW = F.G * NWAVES;
    constexpr int I_IN = 16 * 56, I_OUT = 256, I_PG = 256, I_PP = 4 * 16, I_UG = 16 * 32, I_DN = 256;
    constexpr int NITEMS = I_IN + I_OUT + I_PG + I_PP + NE * I_UG + NE * I_DN;
    if (gw < NITEMS) {
        int it = gw; P0D d0 = p0_decode(a, ws, it, lane), d1 = d0; f32x4 va[16], vb[16]; p0_load(d0, va);
        for (;;) {
            const int it1 = it + NGW; const bool h1 = it1 < NITEMS;
            if (h1) { d1 = p0_decode(a, ws, it1, lane); p0_load(d1, vb); }
            p0_finish(d0, va, scr, lane);
            if (!h1) break;
            const int it2 = it1 + NGW; const bool h2 = it2 < NITEMS;
            if (h2) { d0 = p0_decode(a, ws, it2, lane); p0_load(d0, va); }
            p0_finish(d1, vb, scr, lane);
            if (!h2) break;
            it = it2;
        }
    }
    if (blockIdx.x == 0 && tid < 256) { const int t = tid; const float* srcs = (t < 64) ? a.sbq : (t < 128) ? a.sbk : (t < 192) ? a.rq : a.rk; ((float*)(ws + WS_GAINS))[t] = srcs[t & 63]; }
    for (int m = gw; m < T; m += NGW) rms_row_to_bf16(a.x + (size_t)m * DM, a.g_mix, (bf16*)(ws + WS_XN) + (size_t)m * DM, lane);
    { const int gt = gw * 64 + lane, NGT = NGW * 64;
      for (int i = gt; i < T * PLE / 8; i += NGT) { const f32x4 a0 = ((const f32x4*)a.p)[2 * i], a1 = ((const f32x4*)a.p)[2 * i + 1];
          v4u o; o.x = cvtpk(a0[0], a0[1]); o.y = cvtpk(a0[2], a0[3]); o.z = cvtpk(a1[0], a1[1]); o.w = cvtpk(a1[2], a1[3]); ((v4u*)(ws + WS_PB))[i] = o; }
      for (int i = gt; i < NE * DM; i += NGT) { const int e = i >> 10, k = i & (DM - 1); const float wv = a.w_r[(size_t)k * NE + e];
          const unsigned hi = cvtpk(wv, 0.f) & 0xffffu; const unsigned lo = cvtpk(wv - __uint_as_float(hi << 16), 0.f) & 0xffffu;
          ((bf16*)(ws + WS_WRT))[i] = (bf16)hi; ((bf16*)(ws + WS_WRT))[NE * DM + i] = (bf16)lo; }
      float* rc = (float*)(ws + WS_ROPEC); float* rs = (float*)(ws + WS_ROPES);
      for (int i = gt; i < T * 32; i += NGT) { const int row = i >> 5, f = i & 31;
          const float inv_freq = powf(10000.0f, -(float)f / 32.0f); const float ang = (float)a.positions[row] * inv_freq;
          float sn, cs; sincosf(ang, &sn, &cs); rc[i] = cs; rs[i] = sn; } }
}

namespace att {
typedef short bf16x8 __attribute__((ext_vector_type(8)));
typedef short s16x4 __attribute__((ext_vector_type(4)));
typedef float f32x16 __attribute__((ext_vector_type(16)));
typedef short v4i16_t __attribute__((ext_vector_type(4)));
constexpr int LK = 0, LV = 24576, LFLAG = 49152;
__device__ __forceinline__ s16x4 vtr(LAS const unsigned char* p) { return __builtin_bit_cast(s16x4, __builtin_amdgcn_ds_read_tr16_b64_v4i16((LAS v4i16_t*)p)); }
__device__ __forceinline__ int crow(int r, int hi) { return (r & 3) + 8 * (r >> 2) + 4 * hi; }
struct AttnArgs { const bf16* hm; const bf16* rg; bf16* Y; const float* gn_g; const float* gn_b; };

template <int MODE> __device__ __forceinline__ void attn_unit(LAS unsigned char* lds, const AttnArgs& A, int b, int h, int qb) {
    int tid_ = threadIdx.x; asm volatile("" : "+v"(tid_));
    const int tid = tid_, lane = tid & 63, r32 = lane & 31, hh = lane >> 5;
    const int w = __builtin_amdgcn_readfirstlane(tid >> 6);
    const int q0 = qb * 256, qw = q0 + 32 * w;
    const size_t TS = (size_t)T * 512;
    const size_t hoff = (size_t)(b * 8 + h) * SEQ * 64;
    const bf16* Qp = A.hm + (MODE == 0 ? 0 : 3) * TS + hoff;
    const bf16* Kp = A.hm + (MODE == 0 ? 1 : 4) * TS + hoff;
    const bf16* Vp = A.hm + (MODE == 0 ? 2 : 5) * TS + hoff;
    bf16x8 qf[4];
#pragma unroll
    for (int ds = 0; ds < 4; ++ds) qf[ds] = *(const bf16x8*)(Qp + (size_t)(qw + r32) * 64 + 16 * ds + 8 * hh);
    f32x16 o[2];
#pragma unroll
    for (int r = 0; r < 16; ++r) { o[0][r] = 0.f; o[1][r] = 0.f; }
    float carry = 1.0f;
    const int jmax = (q0 + 255) >> 6, jd = (qw + 31) >> 6;
    const float lg2g = __log2f(1.0f - __builtin_amdgcn_exp2f(-5.0f - (float)h));
    const bf16* Kt = Kp + (size_t)lane * 64 + w * 8; const bf16* Vt = Vp + (size_t)w * 512 + lane * 8;
    volatile LAS unsigned* flags = (volatile LAS unsigned*)(lds + LFLAG);
#define ATT_DMA(t, so) do { __builtin_amdgcn_global_load_lds((const unsigned*)(Kt + (size_t)(t) * 4096), (LAS unsigned*)(lds + LK + (so) + w * 1024), 16, 0, 0); \
                            __builtin_amdgcn_global_load_lds((const unsigned*)(Vt + (size_t)(t) * 4096), (LAS unsigned*)(lds + LV + (so) + w * 1024), 16, 0, 0); } while (0)
    ATT_DMA(jmax, 0);
    if (jmax >= 1) { ATT_DMA(jmax - 1, 8192); asm volatile("s_waitcnt vmcnt(2)\n\ts_barrier" ::: "memory"); }
    else asm volatile("s_waitcnt vmcnt(0)\n\ts_barrier" ::: "memory");
    bool finished = false;
    int so_cur = 0, so_new = 16384;
    for (int j = jmax; j >= 0; --j) {
        const int cur = j & 1;
        if (j >= 2) ATT_DMA(j - 2, so_new);
        if (j <= jd && !finished) {
            LAS const unsigned char* Kb = lds + LK + so_cur;
            LAS const unsigned char* Vb = lds + LV + so_cur;
            f32x16 p[2];
#pragma unroll
            for (int r = 0; r < 16; ++r) { p[0][r] = 0.f; p[1][r] = 0.f; }
#pragma unroll
            for (int ds = 0; ds < 4; ++ds) {
                const bf16x8 k0 = *(LAS const bf16x8*)(Kb + (2 * ds + hh) * 1024 + r32 * 16);
                const bf16x8 k1 = *(LAS const bf16x8*)(Kb + (2 * ds + hh) * 1024 + (32 + r32) * 16);
                p[0] = __builtin_amdgcn_mfma_f32_32x32x16_bf16(k0, qf[ds], p[0], 0, 0, 0);
                p[1] = __builtin_amdgcn_mfma_f32_32x32x16_bf16(k1, qf[ds], p[1], 0, 0, 0);
            }
            const bool diag = (j == jd);
            const int qg = qw + r32, kv0 = 64 * j + 4 * hh;
            if (MODE == 0) {
                float om[2][16];
#pragma unroll
                for (int hf = 0; hf < 2; ++hf)
#pragma unroll
                    for (int r = 0; r < 16; ++r) {
                        const float Z = p[hf][r];
                        const float a = __builtin_amdgcn_exp2f(-__builtin_fabsf(Z));
                        const float rc = __builtin_amdgcn_rcpf(1.0f + a), ar = a * rc;
                        const bool pos = Z >= 0.f;
                        const bool valid = !diag || (kv0 + 32 * hf + (r & 3) + 8 * (r >> 2) < qg);
                        const float beta = pos ? rc : ar, omb = pos ? ar : rc;
                        p[hf][r] = valid ? beta : 0.f;
                        om[hf][r] = valid ? omb : 1.0f;
                    }
                float gs[8], ot[8];
#pragma unroll
                for (int m = 0; m < 8; ++m) { const int hf = m >> 2, g = m & 3; gs[m] = (om[hf][4 * g] * om[hf][4 * g + 1]) * (om[hf][4 * g + 2] * om[hf][4 * g + 3]); ot[m] = __shfl_xor(gs[m], 32); }
                float ps[8];
                ps[7] = 1.0f;
#pragma unroll
                for (int m = 6; m >= 0; --m) ps[m] = ps[m + 1] * (gs[m + 1] * ot[m + 1]);
                const float total = ps[0] * (gs[0] * ot[0]);
#pragma unroll
                for (int m = 0; m < 8; ++m) {
                    const int hf = m >> 2, g = m & 3;
                    float tail = carry * (hh ? ps[m] : ps[m] * ot[m]);
#pragma unroll
                    for (int i = 3; i >= 0; --i) { const int r = 4 * g + i; const float o1 = om[hf][r]; p[hf][r] *= tail; tail *= o1; }
                }
                carry *= total;
                finished = __all(carry < 1.0e-37f);
            } else {
                const float ct = __builtin_amdgcn_exp2f(lg2g * (float)(qw - 64 * j));
#pragma unroll
                for (int hf = 0; hf < 2; ++hf)
#pragma unroll
                    for (int r = 0; r < 16; ++r) {
                        const bool valid = !diag || (kv0 + 32 * hf + (r & 3) + 8 * (r >> 2) <= qg);
                        p[hf][r] = valid ? p[hf][r] * ct : 0.f;
                    }
            }
#pragma unroll
            for (int hf = 0; hf < 2; ++hf)
#pragma unroll
                for (int s = 0; s < 2; ++s) {
                    u32x4_t wq;
                    wq.x = pg8::cvt_pk_bf16(p[hf][8 * s + 0], p[hf][8 * s + 1]); wq.y = pg8::cvt_pk_bf16(p[hf][8 * s + 2], p[hf][8 * s + 3]);
                    wq.z = pg8::cvt_pk_bf16(p[hf][8 * s + 4], p[hf][8 * s + 5]); wq.w = pg8::cvt_pk_bf16(p[hf][8 * s + 6], p[hf][8 * s + 7]);
                    const bf16x8 wf = __builtin_bit_cast(bf16x8, wq);
#pragma unroll
                    for (int d0 = 0; d0 < 2; ++d0) {
                        LAS const unsigned char* va = Vb + (32 * hf + 16 * s + 4 * hh + ((lane & 15) >> 2)) * 128 + (32 * d0 + 16 * ((lane >> 4) & 1) + 4 * (lane & 3)) * 2;
                        const s16x4 lo = vtr(va), hi = vtr(va + 8 * 128);
                        const bf16x8 vf = (bf16x8){lo[0], lo[1], lo[2], lo[3], hi[0], hi[1], hi[2], hi[3]};
                        o[d0] = __builtin_amdgcn_mfma_f32_32x32x16_bf16(vf, wf, o[d0], 0, 0, 0);
                    }
                }
        }
        if (MODE == 0) { if (lane == 0) flags[cur * 8 + w] = finished ? 1u : 0u; }
        if (j >= 2) asm volatile("s_waitcnt vmcnt(2) lgkmcnt(0)\n\ts_barrier" ::: "memory"); else asm volatile("s_waitcnt vmcnt(0) lgkmcnt(0)\n\ts_barrier" ::: "memory");
        so_cur = (so_cur == 16384) ? 0 : so_cur + 8192; so_new = (so_new == 16384) ? 0 : so_new + 8192;
        if (MODE == 0) {
            unsigned all = 1u;
#pragma unroll
            for (int i = 0; i < 8; ++i) all &= flags[cur * 8 + i];
            if (all) break;
        }
    }
    asm volatile("s_waitcnt vmcnt(0)\n\ts_barrier" ::: "memory");
#undef ATT_DMA
    const int row = b * SEQ + qw + r32;
    if (MODE == 0) {
        bf16* yp = A.Y + (size_t)row * DM + h * 64 + 4 * hh;
#pragma unroll
        for (int d0 = 0; d0 < 2; ++d0)
#pragma unroll
            for (int g = 0; g < 4; ++g) { u32x2_t v; v.x = pg8::cvt_pk_bf16(o[d0][4 * g], o[d0][4 * g + 1]); v.y = pg8::cvt_pk_bf16(o[d0][4 * g + 2], o[d0][4 * g + 3]); *(u32x2_t*)(yp + 32 * d0 + 8 * g) = v; }
    } else {
        float s1 = 0.f;
#pragma unroll
        for (int r = 0; r < 16; ++r) s1 += o[0][r] + o[1][r];
        s1 += __shfl_xor(s1, 32);
        const float mu = s1 * (1.0f / 64.0f);
        float s2 = 0.f;
#pragma unroll
        for (int r = 0; r < 16; ++r) { const float a0 = o[0][r] - mu, a1 = o[1][r] - mu; s2 += a0 * a0 + a1 * a1; }
        s2 += __shfl_xor(s2, 32);
        const float rstd = rsqrtf(s2 * (1.0f / 64.0f) + EPS);
        bf16* yp = A.Y + (size_t)row * DM + 512 + h * 64 + 4 * hh;
        const bf16* gp = A.rg + (size_t)row * 512 + h * 64 + 4 * hh;
        const float* gg = A.gn_g + h * 64 + 4 * hh; const float* gb = A.gn_b + h * 64 + 4 * hh;
#pragma unroll
        for (int d0 = 0; d0 < 2; ++d0)
#pragma unroll
            for (int g = 0; g < 4; ++g) {
                const f32x4 gn = *(const f32x4*)(gg + 32 * d0 + 8 * g), bs = *(const f32x4*)(gb + 32 * d0 + 8 * g);
                const u32x2_t gr = *(const u32x2_t*)(gp + 32 * d0 + 8 * g);
                float gate[4] = {__uint_as_float(gr.x << 16), __uint_as_float(gr.x & 0xffff0000u), __uint_as_float(gr.y << 16), __uint_as_float(gr.y & 0xffff0000u)};
                float ov[4];
#pragma unroll
                for (int i = 0; i < 4; ++i) { const float yn = (o[d0][4 * g + i] - mu) * rstd * gn[i] + bs[i]; const float sg = gate[i] / (1.0f + __expf(-gate[i])); ov[i] = yn * sg; }
                u32x2_t v; v.x = pg8::cvt_pk_bf16(ov[0], ov[1]); v.y = pg8::cvt_pk_bf16(ov[2], ov[3]); *(u32x2_t*)(yp + 32 * d0 + 8 * g) = v;
            }
    }
}
__device__ __forceinline__ void attn_phase(LAS unsigned char* lds, const AttnArgs& A, int vcu, int dup) {
    const int bh = vcu >> 2, x = vcu & 3, b = bh >> 3, h = bh & 7;
#pragma unroll 1
    for (int u = 0; u < ((dup == 20) ? 4 : 2); ++u) attn_unit<1>(lds, A, b, h, (u & 1) ? x : 7 - x);
#pragma unroll 1
    for (int u = 0; u < ((dup == 21) ? 4 : 2); ++u) attn_unit<0>(lds, A, b, h, (u & 1) ? x : 7 - x);
}
}

constexpr int CW_GCNT = 2048;
constexpr int LR_LCNT = LDSCTL_OFF + 1024, LR_GBASE = LDSCTL_OFF + 1152;
constexpr int LT_POFF = LDSCTL_OFF + 2048, LT_NT = LDSCTL_OFF + 2176, LT_TILE_E = LDSCTL_OFF + 2304;
struct RouteBufs { int* tok_e; int* tok_slot; float* tok_gate; float* rstd; float* slot_rstd; };
__device__ __forceinline__ RouteBufs route_bufs(unsigned char* ws) { RouteBufs r; r.tok_e = (int*)(ws + WS_ROUTE); r.tok_slot = r.tok_e + T * 4; r.tok_gate = (float*)(r.tok_slot + T * 4); r.rstd = (float*)(ws + WS_ROUTE + 1 * MiB); r.slot_rstd = (float*)(ws + WS_ROUTE + 2 * MiB); return r; }
typedef float f32x2v __attribute__((ext_vector_type(2)));
__device__ __forceinline__ unsigned opq_mask(bool c) { unsigned m = c ? 0xffffffffu : 0u; asm volatile("" : "+v"(m)); return m; }
__device__ __forceinline__ float blendf(unsigned m, float a, float b) { return __uint_as_float((__float_as_uint(a) & m) | (__float_as_uint(b) & ~m)); }
__device__ __forceinline__ int blendi(unsigned m, int a, int b) { return (int)(((unsigned)a & m) | ((unsigned)b & ~m)); }

#define SW2(c, a, b) { const float ta_ = (c) ? (b) : (a), tb_ = (c) ? (a) : (b); a = ta_; b = tb_; }
#define SW2I(c, a, b) { const int ta_ = (c) ? (b) : (a), tb_ = (c) ? (a) : (b); a = ta_; b = tb_; }
#define TOP4_INSERT(x, e) { const float x_ = (x); const int e_ = (e); const bool c3_ = (x_ > v3) || (x_ == v3 && e_ < i3); v3 = c3_ ? x_ : v3; i3 = c3_ ? e_ : i3; \
    const bool c2_ = (v3 > v2) || (v3 == v2 && i3 < i2); SW2(c2_, v2, v3) SW2I(c2_, i2, i3) const bool c1_ = (v2 > v1) || (v2 == v1 && i2 < i1); SW2(c1_, v1, v2) SW2I(c1_, i1, i2) \
    const bool c0_ = (v1 > v0) || (v1 == v0 && i1 < i0); SW2(c0_, v0, v1) SW2I(c0_, i0, i1) }
__device__ __forceinline__ void router_phase(Frame& F, const Args& a, const bool dry = false) {
    unsigned char* ws = a.ws; const int tid = tid_now();
    LAS unsigned char* lds = F.lds;
    const int lane = tid & 63, r32 = lane & 31, hh = lane >> 5, w = F.wave, rg = w >> 2, kq = w & 3;
    volatile LAS unsigned* lcnt = (volatile LAS unsigned*)(lds + LR_LCNT);
    volatile LAS unsigned* gbase = (volatile LAS unsigned*)(lds + LR_GBASE);
    if (tid < 32) lcnt[tid] = 0u;
    const RouteBufs R = route_bufs(dry ? ws + 3 * MiB : ws);
    const int row = F.vcu * 64 + 32 * rg + r32;
    const float* xr = a.out + (size_t)row * DM + 256 * kq + 8 * hh;
    const float* gr = a.g_ffn + 256 * kq + 8 * hh;
    const bf16* wt = (const bf16*)(ws + WS_WRT) + (size_t)r32 * DM + 256 * kq + 8 * hh;
    unsigned char* hp = (unsigned char*)(ws + (dry ? WS_H : WS_XN)) + (size_t)row * DM + 256 * kq + 8 * hh;
    att::f32x16 D;
#pragma unroll
    for (int r = 0; r < 16; ++r) D[r] = 0.f;
    float ss = 0.f;
#pragma unroll 4
    for (int ks = 0; ks < 16; ++ks) {
        const f32x4 x0 = *(const f32x4*)(xr + 16 * ks), x1 = *(const f32x4*)(xr + 16 * ks + 4);
        const f32x4 g0 = *(const f32x4*)(gr + 16 * ks), g1 = *(const f32x4*)(gr + 16 * ks + 4);
        ss += ((x0[0] * x0[0] + x0[1] * x0[1]) + (x0[2] * x0[2] + x0[3] * x0[3])) + ((x1[0] * x1[0] + x1[1] * x1[1]) + (x1[2] * x1[2] + x1[3] * x1[3]));
        const f32x4 v0 = x0 * g0, v1 = x1 * g1;
        u32x2_t h8; h8.x = pk4_fp8(v0[0], v0[1], v0[2], v0[3]); h8.y = pk4_fp8(v1[0], v1[1], v1[2], v1[3]); *(u32x2_t*)(hp + 16 * ks) = h8;
        u32x4_t xh, xl;
        xh.x = cvtpk(v0[0], v0[1]); xh.y = cvtpk(v0[2], v0[3]); xh.z = cvtpk(v1[0], v1[1]); xh.w = cvtpk(v1[2], v1[3]);
        xl.x = cvtpk(v0[0] - __uint_as_float(xh.x << 16), v0[1] - __uint_as_float(xh.x & 0xffff0000u)); xl.y = cvtpk(v0[2] - __uint_as_float(xh.y << 16), v0[3] - __uint_as_float(xh.y & 0xffff0000u));
        xl.z = cvtpk(v1[0] - __uint_as_float(xh.z << 16), v1[1] - __uint_as_float(xh.z & 0xffff0000u)); xl.w = cvtpk(v1[2] - __uint_as_float(xh.w << 16), v1[3] - __uint_as_float(xh.w & 0xffff0000u));
        const att::bf16x8 whi = *(const att::bf16x8*)(wt + 16 * ks), wlo = *(const att::bf16x8*)(wt + 32 * DM + 16 * ks);
        const att::bf16x8 bxh = __builtin_bit_cast(att::bf16x8, xh), bxl = __builtin_bit_cast(att::bf16x8, xl);
        D = __builtin_amdgcn_mfma_f32_32x32x16_bf16(whi, bxh, D, 0, 0, 0);
        D = __builtin_amdgcn_mfma_f32_32x32x16_bf16(wlo, bxh, D, 0, 0, 0);
        D = __builtin_amdgcn_mfma_f32_32x32x16_bf16(whi, bxl, D, 0, 0, 0);
    }
    { LAS f32x4* dp = (LAS f32x4*)(lds + (w * 64 + lane) * 64);
#pragma unroll
      for (int q = 0; q < 4; ++q) dp[q] = (f32x4){D[4 * q], D[4 * q + 1], D[4 * q + 2], D[4 * q + 3]};
      *(LAS float*)(lds + 32768 + (w * 64 + lane) * 4) = ss; }
    __syncthreads();
    int my_e0 = 0, my_e1 = 0, rk0 = 0, rk1 = 0; float my_g0 = 0.f, my_g1 = 0.f;
    if (kq == 0) {
#pragma unroll
        for (int o = 1; o < 4; ++o) { LAS const f32x4* dp = (LAS const f32x4*)(lds + ((w + o) * 64 + lane) * 64);
#pragma unroll
            for (int q = 0; q < 4; ++q) { const f32x4 t = dp[q]; D[4 * q] += t[0]; D[4 * q + 1] += t[1]; D[4 * q + 2] += t[2]; D[4 * q + 3] += t[3]; }
            ss += *(LAS const float*)(lds + 32768 + ((w + o) * 64 + lane) * 4); }
        ss += __shfl_xor(ss, 32);
        const float rstd = rsqrtf(ss * (1.f / DM) + EPS);
        if (hh == 0) R.rstd[row] = rstd;
        float l[16];
#pragma unroll
        for (int r = 0; r < 16; ++r) l[r] = D[r] * rstd + a.b_r[(r & 3) + 8 * (r >> 2) + 4 * hh];
        float c[8]; int ci[8];
#pragma unroll
        for (int k = 0; k < 4; ++k) {
            float bv = -INFINITY; int bi = 99;
#pragma unroll
            for (int r = 0; r < 16; ++r) { const int e = (r & 3) + 8 * (r >> 2) + 4 * hh; const bool bt = l[r] > bv; bv = bt ? l[r] : bv; bi = bt ? e : bi; }
            c[k] = bv; ci[k] = bi;
#pragma unroll
            for (int r = 0; r < 16; ++r) { const int e = (r & 3) + 8 * (r >> 2) + 4 * hh; l[r] = (e == bi) ? -INFINITY : l[r]; }
        }
#pragma unroll
        for (int k = 0; k < 4; ++k) { c[4 + k] = __shfl_xor(c[k], 32); ci[4 + k] = __shfl_xor(ci[k], 32); }
        float tv[4]; int ti[4];
#pragma unroll
        for (int k = 0; k < 4; ++k) {
            float bv = -INFINITY; int bi = 99;
#pragma unroll
            for (int j = 0; j < 8; ++j) { const bool bt = (c[j] > bv) || (c[j] == bv && ci[j] < bi); bv = bt ? c[j] : bv; bi = bt ? ci[j] : bi; }
            tv[k] = bv; ti[k] = bi;
#pragma unroll
            for (int j = 0; j < 8; ++j) c[j] = (ci[j] == bi) ? -INFINITY : c[j];
        }
        const float v0 = tv[0], v1 = tv[1], v2 = tv[2], v3 = tv[3]; const int i0 = ti[0], i1 = ti[1], i2 = ti[2], i3 = ti[3];
        const float e1 = __expf(v1 - v0), e2 = __expf(v2 - v0), e3 = __expf(v3 - v0), inv = 1.0f / (1.0f + e1 + e2 + e3);
        my_e0 = hh ? i2 : i0; my_e1 = hh ? i3 : i1; my_g0 = (hh ? e2 : 1.0f) * inv; my_g1 = (hh ? e3 : e1) * inv;
        rk0 = (int)__hip_atomic_fetch_add((LAS unsigned*)(lds + LR_LCNT) + my_e0, 1u, __ATOMIC_RELAXED, __HIP_MEMORY_SCOPE_WORKGROUP);
        rk1 = (int)__hip_atomic_fetch_add((LAS unsigned*)(lds + LR_LCNT) + my_e1, 1u, __ATOMIC_RELAXED, __HIP_MEMORY_SCOPE_WORKGROUP);
    }
    __syncthreads();
    if (tid < 32) gbase[tid] = __hip_atomic_fetch_add((unsigned*)(F.ctl + CW_GCNT + (dry ? 64 : 0)) + tid, lcnt[tid], __ATOMIC_RELAXED, __HIP_MEMORY_SCOPE_AGENT);
    __syncthreads();
    if (kq == 0) {
        const int k0 = 2 * hh;
        R.tok_e[row * 4 + k0] = my_e0; R.tok_slot[row * 4 + k0] = (int)gbase[my_e0] + rk0; R.tok_gate[row * 4 + k0] = my_g0;
        R.tok_e[row * 4 + k0 + 1] = my_e1; R.tok_slot[row * 4 + k0 + 1] = (int)gbase[my_e1] + rk1; R.tok_gate[row * 4 + k0 + 1] = my_g1;
    }
}
#undef SW2
#undef SW2I
#undef TOP4_INSERT

__device__ __forceinline__ void build_tables(Frame& F) {
    LAS int* poff = (LAS int*)(F.lds + LT_POFF); LAS int* ntp = (LAS int*)(F.lds + LT_NT); LAS int* tile_e = (LAS int*)(F.lds + LT_TILE_E);
    LAS int* cnts = (LAS int*)(F.lds + LR_LCNT); const int tid = tid_now();
    if (tid < NE) cnts[tid] = (int)__hip_atomic_load((unsigned*)(F.ctl + CW_GCNT) + tid, __ATOMIC_RELAXED, __HIP_MEMORY_SCOPE_AGENT);
    __syncthreads();
    if (tid == 0) {
        int t = 0;
        for (int e = 0; e < NE; ++e) { const int c = cnts[e]; const int nt = (c + 255) >> 8; poff[e] = t * 256; for (int i = 0; i < nt; ++i) tile_e[t + i] = e; t += nt; }
        *ntp = t;
    }
    __syncthreads();
}
__device__ __forceinline__ void gather_phase(Frame& F, const Args& a) {
    unsigned char* ws = a.ws; const int lane = tid_now() & 63; const RouteBufs R = route_bufs(ws);
    LAS const int* poff = (LAS const int*)(F.lds + LT_POFF);
    const int gw = F.vcu * NWAVES + F.wave, NGW = F.G * NWAVES;
    for (int m = gw; m < T; m += NGW) {
        const v4u* src = (const v4u*)((const unsigned char*)(ws + WS_XN) + (size_t)m * DM);
        const v4u h0 = src[lane]; const float rs = R.rstd[m];
#pragma unroll
        for (int k = 0; k < 4; ++k) { const int e = R.tok_e[m * 4 + k], slot = R.tok_slot[m * 4 + k];
            v4u* dst = (v4u*)((unsigned char*)(ws + WS_XS) + (size_t)(poff[e] + slot) * DM); dst[lane] = h0; if (lane == 0) R.slot_rstd[poff[e] + slot] = rs; }
    }
}
__device__ __forceinline__ void combine_phase(Frame& F, const Args& a, const bool dry = false) {
    unsigned char* ws = a.ws; const RouteBufs R = route_bufs(ws);
    LAS const int* poff = (LAS const int*)(F.lds + LT_POFF);
    const int gw = F.vcu * NWAVES + F.wave, NGW = F.G * NWAVES, lane = tid_now() & 63;
    for (int m0 = 2 * gw; m0 < T; m0 += 2 * NGW) {
        f32x4 v[2][2][2]; v4u y[2][4][2]; float gt[2][4];
#pragma unroll
        for (int rr = 0; rr < 2; ++rr) { const int m = m0 + rr;
#pragma unroll
            for (int i = 0; i < 2; ++i) { v[rr][i][0] = *(const f32x4*)(a.out + (size_t)m * DM + 8 * lane + 512 * i); v[rr][i][1] = *(const f32x4*)(a.out + (size_t)m * DM + 8 * lane + 512 * i + 4); }
#pragma unroll
            for (int k = 0; k < 4; ++k) { const int e = R.tok_e[m * 4 + k], slot = R.tok_slot[m * 4 + k]; gt[rr][k] = R.tok_gate[m * 4 + k];
                const bf16* yr = (const bf16*)(ws + WS_YS) + (size_t)(poff[e] + slot) * DM + 8 * lane;
                y[rr][k][0] = *(const v4u*)yr; y[rr][k][1] = *(const v4u*)(yr + 512); } }
#pragma unroll
        for (int rr = 0; rr < 2; ++rr) { const int m = m0 + rr;
#pragma unroll
            for (int k = 0; k < 4; ++k)
#pragma unroll
                for (int i = 0; i < 2; ++i) { const v4u yy = y[rr][k][i]; const float g = gt[rr][k];
                    v[rr][i][0][0] += g * __uint_as_float(yy[0] << 16); v[rr][i][0][1] += g * __uint_as_float(yy[0] & 0xffff0000u); v[rr][i][0][2] += g * __uint_as_float(yy[1] << 16); v[rr][i][0][3] += g * __uint_as_float(yy[1] & 0xffff0000u);
                    v[rr][i][1][0] += g * __uint_as_float(yy[2] << 16); v[rr][i][1][1] += g * __uint_as_float(yy[2] & 0xffff0000u); v[rr][i][1][2] += g * __uint_as_float(yy[3] << 16); v[rr][i][1][3] += g * __uint_as_float(yy[3] & 0xffff0000u); }
            float ss = 0.f;
#pragma unroll
            for (int i = 0; i < 2; ++i)
#pragma unroll
                for (int q = 0; q < 2; ++q) { const f32x4 t = v[rr][i][q]; ss += (t[0] * t[0] + t[1] * t[1]) + (t[2] * t[2] + t[3] * t[3]); }
            const float rstd = rsqrtf(wave_sum(ss) * (1.f / DM) + EPS);
            unsigned char* np = (unsigned char*)(ws + (dry ? WS_H : WS_XN)) + (size_t)m * DM + 8 * lane; float* ow = dry ? (float*)(ws + WS_XS) : a.out;
#pragma unroll
            for (int i = 0; i < 2; ++i) { *(f32x4*)(ow + (size_t)m * DM + 8 * lane + 512 * i) = v[rr][i][0]; *(f32x4*)(ow + (size_t)m * DM + 8 * lane + 512 * i + 4) = v[rr][i][1];
                const f32x4 g0 = *(const f32x4*)(a.g_ple + 8 * lane + 512 * i), g1 = *(const f32x4*)(a.g_ple + 8 * lane + 512 * i + 4);
                u32x2_t o; o.x = pk4_fp8(v[rr][i][0][0] * rstd * g0[0], v[rr][i][0][1] * rstd * g0[1], v[rr][i][0][2] * rstd * g0[2], v[rr][i][0][3] * rstd * g0[3]);
                o.y = pk4_fp8(v[rr][i][1][0] * rstd * g1[0], v[rr][i][1][1] * rstd * g1[1], v[rr][i][1][2] * rstd * g1[2], v[rr][i][1][3] * rstd * g1[3]);
                *(u32x2_t*)(np + 512 * i) = o; } }
    }
}

__global__ void __launch_bounds__(NWAVES * 64, 2) mega_fwd(Args args) {
    extern __shared__ __attribute__((aligned(16))) unsigned char lds[];
    Frame F;
    F.lds = (LAS unsigned char*)lds;
    F.MISC = (volatile LAS unsigned*)(F.lds + MISC_OFF);
    F.wave = __builtin_amdgcn_readfirstlane(threadIdx.x >> 6);
    F.G = gridDim.x; { const int bx = blockIdx.x; F.vcu = (F.G % 8 == 0) ? (bx % 8) * (F.G / 8) + bx / 8 : bx; }
    unsigned char* ws = args.ws;
    F.ctl = (gu32*)(ws + WS_CTL);
    for (int u = threadIdx.x; u < (LDS_BYTES - LDSCTL_OFF) / 4; u += NWAVES * 64) ((LAS unsigned*)(F.lds + LDSCTL_OFF))[u] = 0u;
    __syncthreads();
    XcdBarrier bar = xcd_barrier_post((unsigned*)(F.ctl + CW_BAR), F.MISC + 8);
    const int lo = args.ph_lo, hi = args.ph_hi;
#define IN(k) (lo <= (k) && (k) < hi)
#define GRID_BAR() xcd_barrier(bar)
#ifndef DUP_PHASE
#define DUP_PHASE -1
#endif
#define REP(k) for (int rep_ = 0; rep_ < ((DUP_PHASE) == (k) ? 2 : 1); ++rep_)

    if (IN(0)) REP(0) { p0_prologue(F, args); GRID_BAR(); }

    if (IN(1)) REP(1) {
        pg8::Gemm g{(const pg8::bf16_t*)(ws + WS_XN), (const pg8::bf16_t*)(ws + WS_WT_IN), DM, 0};
        pg8::StaticOrder S; S.init(T / 256, DIN / 256, F.G, (int)blockIdx.x);
        pg8::EpiProj E{(pg8::bf16_t*)(ws + WS_HM), (pg8::bf16_t*)(ws + WS_RG), (const float*)(ws + WS_GAINS), (const float*)(ws + WS_ROPEC), (const float*)(ws + WS_ROPES)};
        pg8::gemm_phase<pg8::EpiProj, pg8::StaticOrder, true, true>(F.lds + RING_OFF, g, S, E);
        {
            const int G2 = (F.G == 256) ? 128 : F.G, c2 = (F.G == 256) ? (int)blockIdx.x - 128 : (int)blockIdx.x;
            if (c2 >= 0) {
                pg8::Gemm g2{(const pg8::bf16_t*)(ws + WS_PB), (const pg8::bf16_t*)(ws + WS_WT_PP), PLE, 0};
                pg8::StaticOrder S2; S2.init(T / 256, DM / 256, G2, c2);
                pg8::EpiBf16Plain E2{(pg8::bf16_t*)(ws + WS_PJ), DM};
                pg8::gemm_phase<pg8::EpiBf16Plain, pg8::StaticOrder, true, true>(F.lds + RING_OFF, g2, S2, E2);
            }
        }
        GRID_BAR();
    }
    if (IN(2)) REP(2) {
        if (F.G == 256) {
            const att::AttnArgs AA{(const bf16*)(ws + WS_HM), (const bf16*)(ws + WS_RG), (bf16*)(ws + WS_Y), args.gn_g, args.gn_b};
            att::attn_phase(F.lds + RING_OFF, AA, F.vcu, DUP_PHASE);
        }
        GRID_BAR();
    }
    if (IN(3)) REP(3) {
        pg8::Gemm g{(const pg8::bf16_t*)(ws + WS_Y), (const pg8::bf16_t*)(ws + WS_WT_OUT), DM, 0};
        pg8::StaticOrder S; S.init(T / 256, DM / 256, F.G, (int)blockIdx.x);
        pg8::EpiResid E{args.x, args.out};
        pg8::gemm_phase<pg8::EpiResid, pg8::StaticOrder, true, true>(F.lds + RING_OFF, g, S, E);
        GRID_BAR();
    }
    if (IN(4)) { if (DUP_PHASE == 4) { if (F.G == 256) router_phase(F, args, true); GRID_BAR(); } if (F.G == 256) router_phase(F, args); GRID_BAR(); }
    if (IN(5) || (lo >= 6 && lo <= 8)) build_tables(F);
    if (IN(5)) REP(5) { gather_phase(F, args); GRID_BAR(); }
    if (IN(6)) REP(6) {
        const int NT = *(LAS const int*)(F.lds + LT_NT);
        pg8::Gemm g{(const pg8::bf16_t*)(ws + WS_XS), (const pg8::bf16_t*)(ws + WS_WT_UG), DM / 2, (size_t)2048 * DM};
        pg8::MoeOrder S; S.init(NT, 8, F.G, (int)blockIdx.x, (LAS const int*)(F.lds + LT_TILE_E));
        pg8::EpiMoeUp E{(unsigned char*)(ws + WS_H), args.b_ug, route_bufs(ws).slot_rstd};
        pg8::gemm_phase<pg8::EpiMoeUp, pg8::MoeOrder, true, true, true>(F.lds + RING_OFF, g, S, E);
        GRID_BAR();
    }
    if (IN(7)) REP(7) {
        const int NT = *(LAS const int*)(F.lds + LT_NT);
        pg8::Gemm g{(const pg8::bf16_t*)(ws + WS_H), (const pg8::bf16_t*)(ws + WS_WT_DN), DM / 2, (size_t)DM * DM};
        pg8::MoeOrder S; S.init(NT, 4, F.G, (int)blockIdx.x, (LAS const int*)(F.lds + LT_TILE_E));
        pg8::EpiMoeDown E{(pg8::bf16_t*)(ws + WS_YS), args.b_dn};
        pg8::gemm_phase<pg8::EpiMoeDown, pg8::MoeOrder, true, true, true>(F.lds + RING_OFF, g, S, E);
        GRID_BAR();
    }
    if (IN(8)) { if (DUP_PHASE == 8) { combine_phase(F, args, true); GRID_BAR(); } combine_phase(F, args); GRID_BAR(); }
    if (IN(9)) {
        pg8::Gemm g{(const pg8::bf16_t*)(ws + WS_XN), (const pg8::bf16_t*)(ws + WS_WT_PG), DM / 2, 0};
        pg8::StaticOrder S; S.init(T / 256, DM / 256, F.G, (int)blockIdx.x);
        if (DUP_PHASE == 9) { pg8::EpiPle E0{args.out, (const pg8::bf16_t*)(ws + WS_PJ), (float*)(ws + WS_XS)}; pg8::gemm_phase<pg8::EpiPle, pg8::StaticOrder, true, true, true>(F.lds + RING_OFF, g, S, E0); }
        pg8::EpiPle E{args.out, (const pg8::bf16_t*)(ws + WS_PJ), args.out};
        pg8::gemm_phase<pg8::EpiPle, pg8::StaticOrder, true, true, true>(F.lds + RING_OFF, g, S, E);
    }
#undef IN
}
extern "C" void kernel_launch(void* const* d_in, const int* in_sizes, int n_in, void* d_out, int out_size, void* d_ws, size_t ws_size, hipStream_t stream) {
    static int grid = 0;
    if (grid == 0) {
        if (n_in != 22 || ws_size < 1024 * MiB) { fprintf(stderr, "kernel_launch: unexpected n_in %d / ws %zu\n", n_in, ws_size); grid = -1; return; }
        int dev = 0, cus = 0, per_cu = 0;
        if (hipGetDevice(&dev) != hipSuccess || hipDeviceGetAttribute(&cus, hipDeviceAttributeMultiprocessorCount, dev) != hipSuccess) { grid = -1; return; }
        if (hipFuncSetAttribute((const void*)mega_fwd, hipFuncAttributeMaxDynamicSharedMemorySize, LDS_BYTES) != hipSuccess) { fprintf(stderr, "kernel_launch: hipFuncSetAttribute failed\n"); grid = -1; return; }
        if (hipOccupancyMaxActiveBlocksPerMultiprocessor(&per_cu, (const void*)mega_fwd, NWAVES * 64, LDS_BYTES) != hipSuccess || per_cu < 1) { fprintf(stderr, "kernel_launch: occupancy query says %d\n", per_cu); per_cu = 1; }
        (void)hipGetLastError();
        grid = cus;
    }
    if (grid < 0) return;
    (void)hipMemsetAsync((char*)d_ws + WS_CTL, 0, CTL_ZERO_BYTES, stream);
    Args a{};
    a.x = (const float*)d_in[0]; a.p = (const float*)d_in[1]; a.positions = (const int*)d_in[2]; a.g_mix = (const float*)d_in[3]; a.w_in = (const float*)d_in[4];
    a.sbq = (const float*)d_in[5]; a.sbk = (const float*)d_in[6]; a.rq = (const float*)d_in[7]; a.rk = (const float*)d_in[8]; a.gn_g = (const float*)d_in[9]; a.gn_b = (const float*)d_in[10];
    a.w_out = (const float*)d_in[11]; a.g_ffn = (const float*)d_in[12]; a.w_r = (const float*)d_in[13]; a.b_r = (const float*)d_in[14]; a.w_ug = (const float*)d_in[15]; a.b_ug = (const float*)d_in[16];
    a.w_dn = (const float*)d_in[17]; a.b_dn = (const float*)d_in[18]; a.g_ple = (const float*)d_in[19]; a.w_pg = (const float*)d_in[20]; a.w_pp = (const float*)d_in[21];
    a.out = (float*)d_out; a.ws = (unsigned char*)d_ws; a.ph_lo = 0; a.ph_hi = 10;
    hipLaunchKernelGGL(mega_fwd, dim3(grid), dim3(NWAVES * 64), LDS_BYTES, stream, a);

}
```

```cpp
#include <hip/hip_runtime.h>
#include <cstdint>
#include <cstdio>
#include <cmath>

namespace pg8 {
#define PG8_LAS __attribute__((address_space(3)))
typedef unsigned short bf16_t;
typedef short bf16x8 __attribute__((ext_vector_type(8)));
typedef float f32x4 __attribute__((ext_vector_type(4)));
typedef unsigned u32x4 __attribute__((ext_vector_type(4)));
typedef unsigned u32x2 __attribute__((ext_vector_type(2)));
typedef int v4i32 __attribute__((ext_vector_type(4)));
typedef int v8i32 __attribute__((ext_vector_type(8)));
constexpr int BM = 256, BK = 64, HALF = 128, HTB = HALF * BK * 2  , STAGE_BYTES = 8 * HTB, NXCD = 8, WGM = 8;

__host__ __device__ __forceinline__ int lds_byte(int r, int c) { const int st = (r >> 4) * 2 + (c >> 5), rr = r & 15, cc = c & 31, ob = rr * 64 + cc * 2; return st * 1024 + (ob ^ (((ob >> 9) & 1) << 5)); }
__host__ __device__ __forceinline__ void stage_rc(int b, int& R, int& C) { const int st = b / 1024, sb = b % 1024, swz = sb ^ (((sb >> 9) & 1) << 5); R = (st >> 1) * 16 + swz / 64; C = (st & 1) * 32 + (swz % 64) / 2; }
__host__ __device__ __forceinline__ int perm32(int rho) { const int n = rho >> 4, i = rho & 15; return 8 * (i >> 2) + 4 * n + (i & 3); }

struct Unit { int pm, pn, e; };
struct Gemm { const bf16_t* A; const bf16_t* Bt; int K; size_t strideBe; };

struct StaticOrder {
    int nM, nN, nwg, G, c;
    __host__ __device__ void init(int nM_, int nN_, int G_, int c_) { nM = nM_; nN = nN_; nwg = nM * nN; G = G_; c = c_; }
    __host__ __device__ bool next(int i, Unit& u) const {
        const long L = (long)i * G + c; if (L >= nwg) return false;
        int wgid = (int)L; { const int q = nwg / NXCD, r = nwg % NXCD, xcd = wgid % NXCD, off = wgid / NXCD; wgid = (xcd < r ? xcd * (q + 1) : r * (q + 1) + (xcd - r) * q) + off; }
        const int nig = WGM * nN, gid = wgid / nig, fm = gid * WGM, gsz = (nM - fm) < WGM ? (nM - fm) : WGM;
        u.pm = fm + ((wgid % nig) % gsz); u.pn = (wgid % nig) / gsz; u.e = 0; return true;
    }
    __device__ __forceinline__ void a_ready(const Unit&) const {}
    __device__ __forceinline__ void done(const Unit&) const {}
};

typedef float f32x2_t __attribute__((ext_vector_type(2))); typedef __bf16 bf16x2_t __attribute__((ext_vector_type(2)));
__device__ __forceinline__ unsigned cvt_pk_bf16(float lo, float hi) { f32x2_t v = {lo, hi}; bf16x2_t b = __builtin_convertvector(v, bf16x2_t); return __builtin_bit_cast(unsigned, b); }

constexpr int T = 16384, SEQ = 2048, DM = 1024, DIN = 3584;
constexpr float EPS = 1e-6f;
__device__ __forceinline__ u32x4 pack8(const f32x4 a, const f32x4 b) { u32x4 w; w.x = cvt_pk_bf16(a[0], a[1]); w.y = cvt_pk_bf16(a[2], a[3]); w.z = cvt_pk_bf16(b[0], b[1]); w.w = cvt_pk_bf16(b[2], b[3]); return w; }

struct EpiProj {
    static constexpr bool PERM = true, AFTER_DRAIN = false;
    bf16_t* hm;
    bf16_t* rg;
    const float* gains;
    const float *ropec, *ropes;
    __device__ __forceinline__ void operator()(const f32x4 (&acc)[2][2][4][2], const Unit& u, int wr, int wc, int fr, int fq) const {
        const int region = u.pn >> 1, hb = 4 * (u.pn & 1) + wc;
        const bool normed = (region == 0) || (region == 1) || (region == 3) || (region == 4);
        const bool rope = (region == 3) || (region == 4);
        const int gidx = region == 0 ? 0 : region == 1 ? 1 : region == 3 ? 2 : 3;
        const float* gp = gains + gidx * 64;
        f32x4 gv[2][2];
#pragma unroll
        for (int bj = 0; bj < 2; ++bj)
#pragma unroll
            for (int n = 0; n < 2; ++n) gv[bj][n] = normed ? *(const f32x4*)(gp + 32 * bj + 8 * fq + 4 * n) : (f32x4){1.f, 1.f, 1.f, 1.f};
        const float lg2g = __log2f(1.0f - __builtin_amdgcn_exp2f(-5.0f - (float)hb));
        const float scale = region == 0 ? 0.125f * 1.4426950408889634f : region == 4 ? 0.125f : 1.0f;
#pragma unroll
        for (int ai = 0; ai < 2; ++ai)
#pragma unroll
            for (int m = 0; m < 4; ++m) {
                const int row = u.pm * BM + ai * HALF + wr * 64 + m * 16 + fr;
                const int b = row >> 11, s = row & (SEQ - 1);
                f32x4 v[2][2];
#pragma unroll
                for (int bj = 0; bj < 2; ++bj)
#pragma unroll
                    for (int n = 0; n < 2; ++n) v[bj][n] = acc[ai][bj][m][n];
                if (normed) {
                    float ss = 0.f;
#pragma unroll
                    for (int bj = 0; bj < 2; ++bj)
#pragma unroll
                        for (int n = 0; n < 2; ++n) { const f32x4 x = v[bj][n]; ss += (x[0] * x[0] + x[1] * x[1]) + (x[2] * x[2] + x[3] * x[3]); }
                    ss += __shfl_xor(ss, 16); ss += __shfl_xor(ss, 32);
                    float rs = rsqrtf(ss * (1.0f / 64.0f) + EPS) * scale;
                    if (rope) rs *= (region == 3) ? __builtin_amdgcn_exp2f((float)(s & 31) * lg2g) : __builtin_amdgcn_exp2f(-(float)(s & 63) * lg2g);
#pragma unroll
                    for (int bj = 0; bj < 2; ++bj)
#pragma unroll
                        for (int n = 0; n < 2; ++n) v[bj][n] = v[bj][n] * rs * gv[bj][n];
                    if (rope) {
#pragma unroll
                        for (int n = 0; n < 2; ++n) {
                            const f32x4 c = *(const f32x4*)(ropec + (size_t)row * 32 + 8 * fq + 4 * n), sn = *(const f32x4*)(ropes + (size_t)row * 32 + 8 * fq + 4 * n);
                            const f32x4 lo = v[0][n], hi = v[1][n];
                            v[0][n] = lo * c - hi * sn; v[1][n] = hi * c + lo * sn;
                        }
                    }
                }
                bf16_t* dst = (region < 6) ? hm + (size_t)region * ((size_t)T * 512) + ((size_t)(b * 8 + hb) * SEQ + s) * 64 + 8 * fq
                                           : rg + (size_t)row * 512 + hb * 64 + 8 * fq;
#pragma unroll
                for (int bj = 0; bj < 2; ++bj) *(u32x4*)(dst + 32 * bj) = pack8(v[bj][0], v[bj][1]);
            }
    }
};

struct EpiBf16Plain {
    static constexpr bool PERM = true, AFTER_DRAIN = false;
    bf16_t* O; int ldc;
    __device__ __forceinline__ void operator()(const f32x4 (&acc)[2][2][4][2], const Unit& u, int wr, int wc, int fr, int fq) const {
        const int row0 = u.pm * BM + wr * 64 + fr, col0 = u.pn * BM + wc * 32 + 8 * fq;
#pragma unroll
        for (int ai = 0; ai < 2; ++ai)
#pragma unroll
            for (int m = 0; m < 4; ++m) { bf16_t* rowp = O + (size_t)(row0 + ai * HALF + m * 16) * ldc + col0;
#pragma unroll
                for (int bj = 0; bj < 2; ++bj) *(u32x4*)(rowp + bj * HALF) = pack8(acc[ai][bj][m][0], acc[ai][bj][m][1]); }
    }
};
struct EpiResid {
    static constexpr bool PERM = false, AFTER_DRAIN = false;
    const float* base; float* out;
    __device__ __forceinline__ void operator()(const f32x4 (&acc)[2][2][4][2], const Unit& u, int wr, int wc, int fr, int fq) const {
        const int col0 = u.pn * BM + wc * 32 + 4 * fq;
#pragma unroll
        for (int ai = 0; ai < 2; ++ai)
#pragma unroll
            for (int m = 0; m < 4; ++m) { const size_t off = (size_t)(u.pm * BM + ai * HALF + wr * 64 + m * 16 + fr) * DM + col0;
#pragma unroll
                for (int bj = 0; bj < 2; ++bj)
#pragma unroll
                    for (int n = 0; n < 2; ++n) { const f32x4 bs = *(const f32x4*)(base + off + bj * HALF + n * 16); *(f32x4*)(out + off + bj * HALF + n * 16) = bs + acc[ai][bj][m][n]; } }
    }
};
struct EpiMoeUp {
    static constexpr bool PERM = true, AFTER_DRAIN = false;
    unsigned char* H; const float* bias; const float* srstd;
    __device__ __forceinline__ void operator()(const f32x4 (&acc)[2][2][4][2], const Unit& u, int wr, int wc, int fr, int fq) const {
        const int cc = 128 * u.pn + 32 * wc + 8 * fq;
        const float* bp = bias + (size_t)u.e * 2048 + cc;
        f32x4 bg[2], bl[2];
#pragma unroll
        for (int n = 0; n < 2; ++n) { bg[n] = *(const f32x4*)(bp + 4 * n); bl[n] = *(const f32x4*)(bp + 1024 + 4 * n); }
#pragma unroll
        for (int ai = 0; ai < 2; ++ai)
#pragma unroll
            for (int m = 0; m < 4; ++m) {
                f32x4 hv[2]; const float sc = srstd[u.pm * BM + ai * HALF + wr * 64 + m * 16 + fr] * 0.015625f;
#pragma unroll
                for (int n = 0; n < 2; ++n) {
                    const f32x4 g0 = acc[ai][0][m][n] * sc + bg[n], l0 = acc[ai][1][m][n] * sc + bl[n];
#pragma unroll
                    for (int j = 0; j < 4; ++j) {
                        const float glu = __builtin_fminf(g0[j], 7.0f), lin = __builtin_fminf(__builtin_fmaxf(l0[j], -7.0f), 7.0f);
                        const float sg = __builtin_amdgcn_rcpf(1.0f + __builtin_amdgcn_exp2f(-1.702f * 1.4426950408889634f * glu));
                        hv[n][j] = glu * sg * (lin + 1.0f);
                    }
                }
                u32x2 hq; hq.x = (unsigned)__builtin_amdgcn_cvt_pk_fp8_f32(hv[0][0], hv[0][1], 0, false); hq.x = (unsigned)__builtin_amdgcn_cvt_pk_fp8_f32(hv[0][2], hv[0][3], (int)hq.x, true);
                hq.y = (unsigned)__builtin_amdgcn_cvt_pk_fp8_f32(hv[1][0], hv[1][1], 0, false); hq.y = (unsigned)__builtin_amdgcn_cvt_pk_fp8_f32(hv[1][2], hv[1][3], (int)hq.y, true);
                *(u32x2*)(H + (size_t)(u.pm * BM + ai * HALF + wr * 64 + m * 16 + fr) * 1024 + cc) = hq;
            }
    }
};
struct EpiMoeDown {
    static constexpr bool PERM = true, AFTER_DRAIN = false;
    unsigned char* YS; const float* bias;
    __device__ __forceinline__ void operator()(const f32x4 (&acc)[2][2][4][2], const Unit& u, int wr, int wc, int fr, int fq) const {
        const int col0 = u.pn * BM + wc * 32 + 8 * fq;
        f32x4 bv[2][2];
#pragma unroll
        for (int bj = 0; bj < 2; ++bj)
#pragma unroll
            for (int n = 0; n < 2; ++n) bv[bj][n] = *(const f32x4*)(bias + (size_t)u.e * 1024 + col0 + bj * HALF + 4 * n);
#pragma unroll
        for (int ai = 0; ai < 2; ++ai)
#pragma unroll
            for (int m = 0; m < 4; ++m) { unsigned char* rowp = YS + (size_t)(u.pm * BM + ai * HALF + wr * 64 + m * 16 + fr) * 1024 + col0;
#pragma unroll
                for (int bj = 0; bj < 2; ++bj) { const f32x4 y0 = acc[ai][bj][m][0] * 0.015625f + bv[bj][0], y1 = acc[ai][bj][m][1] * 0.015625f + bv[bj][1];
                    u32x2 q; q.x = (unsigned)__builtin_amdgcn_cvt_pk_fp8_f32(y0[0], y0[1], 0, false); q.x = (unsigned)__builtin_amdgcn_cvt_pk_fp8_f32(y0[2], y0[3], (int)q.x, true);
                    q.y = (unsigned)__builtin_amdgcn_cvt_pk_fp8_f32(y1[0], y1[1], 0, false); q.y = (unsigned)__builtin_amdgcn_cvt_pk_fp8_f32(y1[2], y1[3], (int)q.y, true);
                    *(u32x2*)(rowp + bj * HALF) = q; } }
    }
};
struct EpiPle {
    static constexpr bool PERM = false, AFTER_DRAIN = false;
    float* out; const bf16_t* PJ; float* outw;
    __device__ __forceinline__ void operator()(const f32x4 (&acc)[2][2][4][2], const Unit& u, int wr, int wc, int fr, int fq) const {
        const int col0 = u.pn * BM + wc * 32 + 4 * fq;
#pragma unroll
        for (int ai = 0; ai < 2; ++ai)
#pragma unroll
            for (int m = 0; m < 4; ++m) { const size_t off = (size_t)(u.pm * BM + ai * HALF + wr * 64 + m * 16 + fr) * DM + col0;
#pragma unroll
                for (int bj = 0; bj < 2; ++bj)
#pragma unroll
                    for (int n = 0; n < 2; ++n) {
                        const size_t o2 = off + bj * HALF + n * 16;
                        const f32x4 x2 = *(const f32x4*)(out + o2); const u32x2 pj = *(const u32x2*)(PJ + o2); const f32x4 a = acc[ai][bj][m][n] * 0.015625f;
                        f32x4 r;
                        r[0] = x2[0] + __uint_as_float(pj.x << 16) * __builtin_amdgcn_rcpf(1.0f + __builtin_amdgcn_exp2f(-1.4426950408889634f * a[0]));
                        r[1] = x2[1] + __uint_as_float(pj.x & 0xffff0000u) * __builtin_amdgcn_rcpf(1.0f + __builtin_amdgcn_exp2f(-1.4426950408889634f * a[1]));
                        r[2] = x2[2] + __uint_as_float(pj.y << 16) * __builtin_amdgcn_rcpf(1.0f + __builtin_amdgcn_exp2f(-1.4426950408889634f * a[2]));
                        r[3] = x2[3] + __uint_as_float(pj.y & 0xffff0000u) * __builtin_amdgcn_rcpf(1.0f + __builtin_amdgcn_exp2f(-1.4426950408889634f * a[3]));
                        *(f32x4*)(outw + o2) = r;
                    } }
    }
};
struct MoeOrder {
    int nM, nN, nwg, G, c; const PG8_LAS int* tile_e;
    __device__ void init(int nM_, int nN_, int G_, int c_, const PG8_LAS int* te) { nM = nM_; nN = nN_; nwg = nM * nN; G = G_; c = c_; tile_e = te; }
    __device__ bool next(int i, Unit& u) const {
        const long L = (long)i * G + c; if (L >= nwg) return false;
        int wgid = (int)L; { const int q = nwg / NXCD, r = nwg % NXCD, xcd = wgid % NXCD, off = wgid / NXCD; wgid = (xcd < r ? xcd * (q + 1) : r * (q + 1) + (xcd - r) * q) + off; }
        const int nig = WGM * nN, gid = wgid / nig, fm = gid * WGM, gsz = (nM - fm) < WGM ? (nM - fm) : WGM;
        u.pm = fm + ((wgid % nig) % gsz); u.pn = (wgid % nig) / gsz; u.e = __builtin_amdgcn_readfirstlane(tile_e[u.pm]); return true;
    }
    __device__ __forceinline__ void a_ready(const Unit&) const {}
    __device__ __forceinline__ void done(const Unit&) const {}
};
template <class Epi, class Sched, bool ALIGN_EPI = false, bool SP2 = false, bool F8 = false>
__device__ __forceinline__ void gemm_phase(PG8_LAS unsigned char* lds, const Gemm g, const Sched& S, const Epi& E) {
    int tid_ = threadIdx.x; asm volatile("" : "+v"(tid_));
    const int tid = tid_, wid = __builtin_amdgcn_readfirstlane(tid >> 6), lane = tid & 63, wr = wid >> 2, wc = wid & 3, fr = lane & 15, fq = lane >> 4;
    const int K = g.K, nt = K / BK;
    unsigned voffA[2], voffB[2];
#pragma unroll
    for (int i = 0; i < 2; ++i) { int R, C; stage_rc(tid * 16 + i * 8192, R, C); const int Rb = Epi::PERM ? ((R & ~31) + perm32(R & 31)) : R;
        voffA[i] = (unsigned)(R * K + C) * 2u; voffB[i] = (unsigned)(Rb * K + C) * 2u; }
    const size_t kstep = (size_t)(BK * 2);
    const size_t hstep = (size_t)HALF * K * 2;
    const size_t tstep = 2 * hstep;
    const unsigned ldsw = (unsigned)wid * 1024u;
    const int aoff = lds_byte(wr * 64 + fr, fq * 8), boff = lds_byte(wc * 32 + fr, fq * 8);
#define PG8_SA(b, h) (((b) * 2 + (h)) * HTB)
#define PG8_SB(b, h) ((4 + (b) * 2 + (h)) * HTB)
#define PG8_STAGE(bufoff, gbase, voff) do { _Pragma("unroll") for (int _i = 0; _i < 2; ++_i) \
        __builtin_amdgcn_global_load_lds((const unsigned*)((const char*)(gbase) + (voff)[_i]), (PG8_LAS unsigned*)(lds + (bufoff) + ldsw + _i * 8192), 16, 0, 0); } while (0)
#define PG8_LD16(off) (*(const PG8_LAS v4i32*)(lds + (off)))
#define PG8_LDA(dst, b, h) do { if constexpr (F8) { _Pragma("unroll") for (int m = 0; m < 4; ++m) dst##8[m] = __builtin_shufflevector(PG8_LD16(PG8_SA(b, h) + aoff + m * 2048), PG8_LD16(PG8_SA(b, h) + aoff + m * 2048 + 1024), 0, 1, 2, 3, 4, 5, 6, 7); } \
        else { _Pragma("unroll") for (int m = 0; m < 4; ++m) _Pragma("unroll") for (int k = 0; k < 2; ++k) dst[m][k] = *(const PG8_LAS bf16x8*)(lds + PG8_SA(b, h) + aoff + m * 2048 + k * 1024); } } while (0)
#define PG8_LDB(dst, b, h) do { if constexpr (F8) { _Pragma("unroll") for (int n = 0; n < 2; ++n) dst##8[n] = __builtin_shufflevector(PG8_LD16(PG8_SB(b, h) + boff + n * 2048), PG8_LD16(PG8_SB(b, h) + boff + n * 2048 + 1024), 0, 1, 2, 3, 4, 5, 6, 7); } \
        else { _Pragma("unroll") for (int n = 0; n < 2; ++n) _Pragma("unroll") for (int k = 0; k < 2; ++k) dst[n][k] = *(const PG8_LAS bf16x8*)(lds + PG8_SB(b, h) + boff + n * 2048 + k * 1024); } } while (0)
#define PG8_MMA(ai, bj, At, Bt) do { __builtin_amdgcn_s_setprio(1); \
        if constexpr (F8) { _Pragma("unroll") for (int m = 0; m < 4; ++m) _Pragma("unroll") for (int n = 0; n < 2; ++n) \
            asm volatile("v_mfma_scale_f32_16x16x128_f8f6f4 %0, %1, %2, %0, %3, %3 op_sel_hi:[0,0,0]" : "+v"(acc[ai][bj][m][n]) : "v"(Bt##8[n]), "v"(At##8[m]), "v"(f8scale)); } \
        else { _Pragma("unroll") for (int m = 0; m < 4; ++m) _Pragma("unroll") for (int n = 0; n < 2; ++n) _Pragma("unroll") for (int k = 0; k < 2; ++k) \
            acc[ai][bj][m][n] = __builtin_amdgcn_mfma_f32_16x16x32_bf16(Bt[n][k], At[m][k], acc[ai][bj][m][n], 0, 0, 0); } \
        __builtin_amdgcn_s_setprio(0); } while (0)
#define PG8_WAIT_V(n) asm volatile("s_waitcnt vmcnt(" #n ")" ::: "memory")
#define PG8_WAIT_L(n) asm volatile("s_waitcnt lgkmcnt(" #n ")" ::: "memory")
#define PG8_BAR __builtin_amdgcn_s_barrier()
#define PG8_SCHED __builtin_amdgcn_sched_barrier(0)
    Unit cur, nxt; int ui = 0;
    if (!S.next(0, cur)) return;
    f32x4 acc[2][2][4][2];
#pragma unroll
    for (int a = 0; a < 2; ++a)
#pragma unroll
        for (int b = 0; b < 2; ++b)
#pragma unroll
            for (int m = 0; m < 4; ++m)
#pragma unroll
                for (int n = 0; n < 2; ++n) acc[a][b][m][n] = (f32x4){0.f, 0.f, 0.f, 0.f};
    bf16x8 At[4][2], B0[2][2], B1[2][2];
    v8i32 At8[4], B08[2], B18[2]; const int f8scale = 0x7f7f7f7f;
    const char* cA = (const char*)g.A + (size_t)cur.pm * tstep; const char* cB = (const char*)g.Bt + (size_t)cur.e * g.strideBe + (size_t)cur.pn * tstep;
    S.a_ready(cur);
    if constexpr (SP2) {
        PG8_STAGE(PG8_SB(0, 0), cB, voffB); PG8_STAGE(PG8_SB(0, 1), cB + hstep, voffB); PG8_STAGE(PG8_SA(0, 0), cA, voffA); PG8_STAGE(PG8_SA(0, 1), cA + hstep, voffA);
        if (wr == 1) PG8_BAR;
        PG8_WAIT_V(2); PG8_BAR;
        PG8_STAGE(PG8_SB(1, 0), cB + kstep, voffB); PG8_STAGE(PG8_SA(1, 0), cA + kstep, voffA); PG8_STAGE(PG8_SB(1, 1), cB + hstep + kstep, voffB);
        PG8_WAIT_V(6); PG8_BAR;
    } else {
        PG8_STAGE(PG8_SB(0, 0), cB, voffB); PG8_STAGE(PG8_SA(0, 0), cA, voffA); PG8_STAGE(PG8_SB(0, 1), cB + hstep, voffB); PG8_STAGE(PG8_SA(0, 1), cA + hstep, voffA);
        if (wr == 1) PG8_BAR;
        PG8_WAIT_V(4); PG8_BAR;
        PG8_STAGE(PG8_SB(1, 0), cB + kstep, voffB); PG8_STAGE(PG8_SA(1, 0), cA + kstep, voffA); PG8_STAGE(PG8_SB(1, 1), cB + hstep + kstep, voffB);
        PG8_WAIT_V(6); PG8_BAR;
    }
    for (;;) {
        const bool has_next = S.next(ui + 1, nxt);
        const char* nA = has_next ? (const char*)g.A + (size_t)nxt.pm * tstep : cA; const char* nB = has_next ? (const char*)g.Bt + (size_t)nxt.e * g.strideBe + (size_t)nxt.pn * tstep : cB;
#pragma unroll 1
        for (int t = 0; t < nt; t += 2) {
            const bool last = (t == nt - 2);
            const char* a1 = cA + (size_t)(t + 1) * kstep;
            const char* a2 = last ? nA : cA + (size_t)(t + 2) * kstep; const char* b2 = last ? nB : cB + (size_t)(t + 2) * kstep;
            const char* a3 = a2 + kstep; const char* b3 = b2 + kstep;
            if (last && has_next) S.a_ready(nxt);
            if constexpr (SP2) {
            PG8_LDB(B0, 0, 0); PG8_LDB(B1, 0, 1); PG8_SCHED; PG8_LDA(At, 0, 0); PG8_STAGE(PG8_SA(1, 1), a1 + hstep, voffA);
            PG8_WAIT_V(8); PG8_WAIT_L(0); PG8_BAR; PG8_MMA(0, 0, At, B0); PG8_MMA(0, 1, At, B1); PG8_BAR; PG8_SCHED;
            PG8_LDA(At, 0, 1); PG8_STAGE(PG8_SB(0, 0), b2, voffB); PG8_STAGE(PG8_SB(0, 1), b2 + hstep, voffB); PG8_STAGE(PG8_SA(0, 0), a2, voffA);
            PG8_WAIT_V(8); PG8_WAIT_L(0); PG8_BAR; PG8_MMA(1, 0, At, B0); PG8_MMA(1, 1, At, B1); PG8_BAR; PG8_SCHED;
            PG8_LDB(B0, 1, 0); PG8_LDB(B1, 1, 1); PG8_SCHED; PG8_LDA(At, 1, 0); PG8_STAGE(PG8_SA(0, 1), a2 + hstep, voffA);
            PG8_WAIT_V(8); PG8_WAIT_L(0); PG8_BAR; PG8_MMA(0, 0, At, B0); PG8_MMA(0, 1, At, B1); PG8_BAR; PG8_SCHED;
            PG8_LDA(At, 1, 1); PG8_STAGE(PG8_SB(1, 0), b3, voffB); PG8_STAGE(PG8_SB(1, 1), b3 + hstep, voffB); PG8_STAGE(PG8_SA(1, 0), a3, voffA);
            PG8_WAIT_V(8); PG8_WAIT_L(0); PG8_BAR; PG8_MMA(1, 0, At, B0); PG8_MMA(1, 1, At, B1); PG8_BAR; PG8_SCHED;
            } else {
            PG8_LDB(B0, 0, 0); PG8_SCHED; PG8_LDA(At, 0, 0); PG8_STAGE(PG8_SA(1, 1), a1 + hstep, voffA);
            PG8_WAIT_L(8); PG8_BAR; PG8_WAIT_L(0); PG8_MMA(0, 0, At, B0); PG8_BAR; PG8_SCHED;
            PG8_LDB(B1, 0, 1); PG8_STAGE(PG8_SB(0, 0), b2, voffB);
            PG8_BAR; PG8_WAIT_L(0); PG8_MMA(0, 1, At, B1); PG8_BAR;
            PG8_LDA(At, 0, 1); PG8_STAGE(PG8_SA(0, 0), a2, voffA);
            PG8_BAR; PG8_WAIT_L(0); PG8_MMA(1, 0, At, B0); PG8_BAR; PG8_SCHED;
            PG8_STAGE(PG8_SB(0, 1), b2 + hstep, voffB);
            PG8_WAIT_V(6); PG8_BAR; PG8_MMA(1, 1, At, B1); PG8_BAR;
            PG8_LDB(B0, 1, 0); PG8_SCHED; PG8_LDA(At, 1, 0); PG8_STAGE(PG8_SA(0, 1), a2 + hstep, voffA);
            PG8_WAIT_L(8); PG8_BAR; PG8_WAIT_L(0); PG8_MMA(0, 0, At, B0); PG8_BAR; PG8_SCHED;
            PG8_LDB(B1, 1, 1); PG8_STAGE(PG8_SB(1, 0), b3, voffB);
            PG8_BAR; PG8_WAIT_L(0); PG8_MMA(0, 1, At, B1); PG8_BAR;
            PG8_LDA(At, 1, 1); PG8_STAGE(PG8_SA(1, 0), a3, voffA);
            PG8_BAR; PG8_WAIT_L(0); PG8_MMA(1, 0, At, B0); PG8_BAR; PG8_SCHED;
            PG8_STAGE(PG8_SB(1, 1), b3 + hstep, voffB);
            PG8_WAIT_V(6); PG8_BAR; PG8_MMA(1, 1, At, B1); PG8_BAR;
            }
        }
        if constexpr (ALIGN_EPI) { if (wr == 0) PG8_BAR; }
        if constexpr (F8) asm volatile("s_nop 15\n\ts_nop 15\n\ts_nop 15" ::: "memory");
        if constexpr (!Epi::AFTER_DRAIN) { E(acc, cur, wr, wc, fr, fq); S.done(cur); }
        if (!has_next) break;
#pragma unroll
        for (int a = 0; a < 2; ++a)
#pragma unroll
            for (int b = 0; b < 2; ++b)
#pragma unroll
                for (int m = 0; m < 4; ++m)
#pragma unroll
                    for (int n = 0; n < 2; ++n) acc[a][b][m][n] = (f32x4){0.f, 0.f, 0.f, 0.f};
        cur = nxt; cA = nA; cB = nB; ++ui;
        if constexpr (ALIGN_EPI) { if (wr == 1) PG8_BAR; }
    }
    PG8_WAIT_V(0);
    if constexpr (!ALIGN_EPI) { if (wr == 0) PG8_BAR; }
    PG8_BAR;
    if constexpr (Epi::AFTER_DRAIN) { E.fused(acc, cur, wr, wc, fr, fq, lds, wid, lane); S.done(cur); }
#undef PG8_SA
#undef PG8_SB
#undef PG8_STAGE
#undef PG8_LD16
#undef PG8_LDA
#undef PG8_LDB
#undef PG8_MMA
#undef PG8_WAIT_V
#undef PG8_WAIT_L
#undef PG8_BAR
#undef PG8_SCHED
}
}

constexpr int NWAVES = 8;
constexpr int T = pg8::T, SEQ = pg8::SEQ, DM = pg8::DM, DIN = pg8::DIN, NE = 32, PLE = 256;
constexpr float EPS = pg8::EPS;
constexpr size_t MiB = 1u << 20;
constexpr size_t WS_CTL = 0, CTL_ZERO_BYTES = 1 * MiB;
constexpr size_t WS_WT_IN = 2 * MiB, WS_WT_OUT = 9 * MiB, WS_WT_PG = 11 * MiB, WS_WT_PP = 13 * MiB;
constexpr size_t WS_GAINS = 13 * MiB + 512 * 1024;
constexpr size_t WS_WRT = 13 * MiB + 576 * 1024;
constexpr size_t WS_ROPEC = 14 * MiB, WS_ROPES = 16 * MiB, WS_PB = 18 * MiB, WS_ROUTE = 26 * MiB;
constexpr size_t WS_WT_UG = 32 * MiB, WS_WT_DN = 160 * MiB;
constexpr size_t WS_XN = 224 * MiB;
constexpr size_t WS_HM = 256 * MiB;
constexpr size_t WS_RG = 352 * MiB;
constexpr size_t WS_Y = 368 * MiB;
constexpr size_t WS_PJ = 400 * MiB;
constexpr size_t WS_XS = 432 * MiB, WS_H = 576 * MiB, WS_YS = 720 * MiB;
constexpr size_t WS_END = 864 * MiB;
constexpr int CW_TMO = 0, CW_CODE = 1;
constexpr int CW_BAR = 4096;
constexpr int RING_OFF = 0, RING_BYTES = 131072;
constexpr int LDSCTL_OFF = RING_BYTES, MISC_OFF = LDSCTL_OFF + 320;
constexpr int LDS_BYTES = 147456;
#define GAS __attribute__((address_space(1)))
#define LAS __attribute__((address_space(3)))
typedef unsigned short bf16;
typedef unsigned v4u __attribute__((ext_vector_type(4)));
typedef float f32x4 __attribute__((ext_vector_type(4)));
typedef short bf16x8 __attribute__((ext_vector_type(8)));
typedef unsigned u32x4_t __attribute__((ext_vector_type(4)));
typedef unsigned u32x2_t __attribute__((ext_vector_type(2)));
typedef GAS unsigned gu32;
typedef GAS unsigned long long gu64;
#define RLX_AGENT __ATOMIC_RELAXED, __HIP_MEMORY_SCOPE_AGENT
#define LDS_WAIT() asm volatile("s_waitcnt lgkmcnt(0)" ::: "memory")
#define VM_WAIT() asm volatile("s_waitcnt vmcnt(0)" ::: "memory")
__device__ __forceinline__ unsigned long long rt() { return __builtin_amdgcn_s_memrealtime(); }
__device__ __forceinline__ unsigned f2bf(float f) { unsigned u = __builtin_bit_cast(unsigned, f); return (u + 0x7fffu + ((u >> 16) & 1u)) >> 16; }
__device__ __forceinline__ unsigned pk2(float lo, float hi) { return f2bf(lo) | (f2bf(hi) << 16); }

#define XB_TMO      128
#define XB_XCNT(j)  (256  + 64 * (j))
#define XB_XSUB(j)  (1280 + 64 * (j))
#define XB_XGEN(j)  (2304 + 64 * (j))
#define XB_TOP      3328
#define XB_TOPGEN   3392
#define XCD_BAR_WORDS 3456
#define XB_SPIN_CAP (1u << 18)

__device__ __forceinline__ unsigned xb_ld(unsigned* p)              { return __hip_atomic_load(p, __ATOMIC_RELAXED, __HIP_MEMORY_SCOPE_AGENT); }
__device__ __forceinline__ unsigned xb_add(unsigned* p, unsigned v) { return __hip_atomic_fetch_add(p, v, __ATOMIC_RELAXED, __HIP_MEMORY_SCOPE_AGENT); }
__device__ __forceinline__ unsigned xb_xcc_id() { return (unsigned)__builtin_amdgcn_s_getreg((3 << 11) | 20) & 0xFu; }
#define XB_SPIN(cond, bar) do { unsigned _sp = 0; while (cond) { __builtin_amdgcn_s_sleep(1); \
    if ((++_sp & 255u) == 0u) { if (xb_ld(&(bar)[XB_TMO])) break; if (_sp > XB_SPIN_CAP) { atomicAdd(&(bar)[XB_TMO], 1u); break; } } } } while (0)

struct XcdBarrier {
    unsigned* bar; unsigned x;
    volatile LAS unsigned* st;
};

__device__ __forceinline__ XcdBarrier xcd_barrier_post(unsigned* bar, volatile LAS unsigned* st) {
    XcdBarrier b; b.bar = bar; b.x = xb_xcc_id(); b.st = st;
    if (threadIdx.x == 0) (void)xb_add(&bar[XB_XCNT(b.x)], 1u);
    return b;
}
__device__ __forceinline__ void xcd_barrier_complete(unsigned* bar, unsigned x, unsigned& nloc, unsigned& nx) {
    const unsigned G = gridDim.x * gridDim.y * gridDim.z;
    unsigned sum, cnt, mine, sp = 0u;
    for (;;) {
        sum = 0u; cnt = 0u; mine = 0u;
#pragma unroll
        for (unsigned j = 0; j < 16; ++j) { const unsigned c = xb_ld(&bar[XB_XCNT(j)]); sum += c; cnt += (c > 0u) ? 1u : 0u; mine = (j == x) ? c : mine; }
        if (sum == G) break;
        __builtin_amdgcn_s_sleep(1);
        if ((++sp & 255u) == 0u) { if (xb_ld(&bar[XB_TMO])) break; if (sp > XB_SPIN_CAP) { atomicAdd(&bar[XB_TMO], 1u); break; } }
    }
    nloc = mine > 0u ? mine : 1u; nx = cnt > 0u ? cnt : 1u;
}

__device__ __forceinline__ void xcd_barrier(const XcdBarrier& b) {
    asm volatile("s_waitcnt vmcnt(0)" ::: "memory");
    __syncthreads();
    if (threadIdx.x == 0) {
        unsigned* bar = b.bar;
        __builtin_amdgcn_s_waitcnt(0);
        unsigned nloc = b.st[0], nx = b.st[1];
        if (nloc == 0u) { xcd_barrier_complete(bar, b.x, nloc, nx); b.st[0] = nloc; b.st[1] = nx; }
        const unsigned old = xb_add(&bar[XB_XSUB(b.x)], 1u);
        const unsigned gen = old / nloc;
        const unsigned tgen = gen;
        if (old + 1u == (gen + 1u) * nloc) {
            __builtin_amdgcn_fence(__ATOMIC_RELEASE, "agent");
            asm volatile("s_waitcnt vmcnt(0)" ::: "memory");
            const unsigned og = xb_add(&bar[XB_TOP], 1u);
            const unsigned tg = og / nx;
            if (og + 1u == (tg + 1u) * nx) xb_add(&bar[XB_TOPGEN], 1u);
            else XB_SPIN(xb_ld(&bar[XB_TOPGEN]) == tg, bar);
        } else {
            XB_SPIN(xb_ld(&bar[XB_TOPGEN]) == tgen, bar);
        }
        __builtin_amdgcn_fence(__ATOMIC_ACQUIRE, "agent");
        asm volatile("s_waitcnt vmcnt(0)" ::: "memory");
    }
    __syncthreads();
}

struct Args {
    const float* x; const float* p; const int* positions; const float* g_mix; const float* w_in;
    const float* sbq; const float* sbk; const float* rq; const float* rk; const float* gn_g; const float* gn_b; const float* w_out;
    const float* g_ffn; const float* w_r; const float* b_r; const float* w_ug; const float* b_ug; const float* w_dn; const float* b_dn;
    const float* g_ple; const float* w_pg; const float* w_pp;
    float* out; unsigned char* ws; int ph_lo, ph_hi;
};
struct Frame {
    LAS unsigned char* lds;
    volatile LAS unsigned* MISC;
    gu32* ctl;
    int wave;
    int vcu, G;
};
__device__ __forceinline__ int tid_now() { int t = threadIdx.x; asm volatile("" : "+v"(t)); return t; }
__device__ __forceinline__ float wave_sum(float v) {
#pragma unroll
    for (int o = 1; o < 64; o <<= 1) v += __shfl_xor(v, o);
    return v;
}
__device__ __forceinline__ unsigned cvtpk(float lo, float hi) { return pg8::cvt_pk_bf16(lo, hi); }

enum { MAP_NAT = 0, MAP_IN = 1, MAP_UG = 2 };
__device__ __forceinline__ void p0_item(const float* __restrict__ W, int N, int K, bf16* __restrict__ WT, int kb, int nb, int mapmode, LAS unsigned char* scr, int lane) {
    const int np = 64 * nb + 4 * (lane & 15);
    int src = np;
    if (mapmode == MAP_IN) { const int pn = np >> 8, L = np & 255, bj = L >> 7, wc = (L >> 5) & 3, e = L & 31; src = 256 * pn + 64 * wc + 32 * bj + e; }
    else if (mapmode == MAP_UG) { const int pn = np >> 8, L = np & 255, bj = L >> 7, i = L & 127; src = 1024 * bj + 128 * pn + i; }
    const float* gp = W + (size_t)(64 * kb + (lane >> 4)) * N + src;
    f32x4 v[16];
#pragma unroll
    for (int i = 0; i < 16; ++i) v[i] = *(const f32x4*)(gp + (size_t)(4 * i) * N);
#pragma unroll
    for (int i = 0; i < 16; ++i) {
        LAS unsigned* d = (LAS unsigned*)(scr + (4 * i + (lane >> 4)) * 132 + 8 * (lane & 15));
        d[0] = cvtpk(v[i][0], v[i][1]); d[1] = cvtpk(v[i][2], v[i][3]);
    }
    LDS_WAIT(); asm volatile("" ::: "memory");
    const int c = lane & 7;
#pragma unroll
    for (int it = 0; it < 4; ++it) {
        const int nl = 16 * it + 2 * (lane >> 3);
        unsigned d[8];
#pragma unroll
        for (int j = 0; j < 8; ++j) d[j] = *(const LAS unsigned*)(scr + (8 * c + j) * 132 + 2 * nl);
        v4u o0, o1;
        o0.x = (d[0] & 0xffffu) | (d[1] << 16); o0.y = (d[2] & 0xffffu) | (d[3] << 16); o0.z = (d[4] & 0xffffu) | (d[5] << 16); o0.w = (d[6] & 0xffffu) | (d[7] << 16);
        o1.x = (d[0] >> 16) | (d[1] & 0xffff0000u); o1.y = (d[2] >> 16) | (d[3] & 0xffff0000u); o1.z = (d[4] >> 16) | (d[5] & 0xffff0000u); o1.w = (d[6] >> 16) | (d[7] & 0xffff0000u);
        bf16* dst = WT + (size_t)(64 * nb + nl) * K + 64 * kb + 8 * c;
        *(v4u*)dst = o0; *(v4u*)(dst + K) = o1;
    }
    LDS_WAIT(); asm volatile("" ::: "memory");
}
__device__ __forceinline__ unsigned pk4_fp8(float a, float b, float c, float d) { int r = __builtin_amdgcn_cvt_pk_fp8_f32(a, b, 0, false); r = __builtin_amdgcn_cvt_pk_fp8_f32(c, d, r, true); return (unsigned)r; }
__device__ __forceinline__ void p0_item_f8(const float* __restrict__ W, int N, int K, unsigned char* __restrict__ WT, int kb, int nb, int mapmode, LAS unsigned char* scr, int lane) {
    const int np = 64 * nb + 4 * (lane & 15);
    int src = np;
    if (mapmode == MAP_UG) { const int pn = np >> 8, L = np & 255, bj = L >> 7, i = L & 127; src = 1024 * bj + 128 * pn + i; }
    const float* gp = W + (size_t)(64 * kb + (lane >> 4)) * N + src;
    f32x4 v[16];
#pragma unroll
    for (int i = 0; i < 16; ++i) v[i] = *(const f32x4*)(gp + (size_t)(4 * i) * N);
#pragma unroll
    for (int i = 0; i < 16; ++i) *(LAS unsigned*)(scr + (4 * i + (lane >> 4)) * 68 + 4 * (lane & 15)) = pk4_fp8(v[i][0] * 64.0f, v[i][1] * 64.0f, v[i][2] * 64.0f, v[i][3] * 64.0f);
    LDS_WAIT(); asm volatile("" ::: "memory");
    const int nq = lane & 15, kg = lane >> 4;
    unsigned d[16];
#pragma unroll
    for (int j = 0; j < 16; ++j) d[j] = *(const LAS unsigned*)(scr + (16 * kg + j) * 68 + 4 * nq);
#pragma unroll
    for (int t = 0; t < 4; ++t) {
        v4u o;
#pragma unroll
        for (int q = 0; q < 4; ++q) o[q] = ((d[4 * q] >> (8 * t)) & 0xffu) | (((d[4 * q + 1] >> (8 * t)) & 0xffu) << 8) | (((d[4 * q + 2] >> (8 * t)) & 0xffu) << 16) | (((d[4 * q + 3] >> (8 * t)) & 0xffu) << 24);
        *(v4u*)(WT + (size_t)(64 * nb + 4 * nq + t) * K + 64 * kb + 16 * kg) = o;
    }
    LDS_WAIT(); asm volatile("" ::: "memory");
}
struct P0D { const float* gp; int N, K, kb, nb; bf16* W16; unsigned char* W8; };
__device__ __forceinline__ int p0_src_col(int np, int mapmode) {
    int src = np;
    if (mapmode == MAP_IN) { const int pn = np >> 8, L = np & 255, bj = L >> 7, wc = (L >> 5) & 3, e = L & 31; src = 256 * pn + 64 * wc + 32 * bj + e; }
    else if (mapmode == MAP_UG) { const int pn = np >> 8, L = np & 255, bj = L >> 7, i = L & 127; src = 1024 * bj + 128 * pn + i; }
    return src;
}
__device__ __forceinline__ P0D p0_mk(const float* W, int N, int K, bf16* W16, unsigned char* W8, int kb, int nb, int mapmode, int lane) {
    P0D d; d.N = N; d.K = K; d.kb = kb; d.nb = nb; d.W16 = W16; d.W8 = W8;
    d.gp = W + (size_t)(64 * kb + (lane >> 4)) * N + p0_src_col(64 * nb + 4 * (lane & 15), mapmode); return d;
}
__device__ __forceinline__ void p0_load(const P0D& d, f32x4 (&v)[16]) {
#pragma unroll
    for (int i = 0; i < 16; ++i) v[i] = *(const f32x4*)(d.gp + (size_t)(4 * i) * d.N);
}
__device__ __forceinline__ void p0_finish(const P0D& d, const f32x4 (&v)[16], LAS unsigned char* scr, int lane, const int pm = 0) {
    if (pm == 1) { _Pragma("unroll") for (int i = 0; i < 16; ++i) asm volatile("" :: "v"(v[i])); return; }
    if (d.W16) {
#pragma unroll
        for (int i = 0; i < 16; ++i) { LAS unsigned* q = (LAS unsigned*)(scr + (4 * i + (lane >> 4)) * 132 + 8 * (lane & 15)); q[0] = cvtpk(v[i][0], v[i][1]); q[1] = cvtpk(v[i][2], v[i][3]); }
        LDS_WAIT(); asm volatile("" ::: "memory");
        const int c = lane & 7;
#pragma unroll
        for (int it = 0; it < 4; ++it) {
            const int nl = 16 * it + 2 * (lane >> 3);
            unsigned x[8];
#pragma unroll
            for (int j = 0; j < 8; ++j) x[j] = *(const LAS unsigned*)(scr + (8 * c + j) * 132 + 2 * nl);
            v4u o0, o1;
            o0.x = (x[0] & 0xffffu) | (x[1] << 16); o0.y = (x[2] & 0xffffu) | (x[3] << 16); o0.z = (x[4] & 0xffffu) | (x[5] << 16); o0.w = (x[6] & 0xffffu) | (x[7] << 16);
            o1.x = (x[0] >> 16) | (x[1] & 0xffff0000u); o1.y = (x[2] >> 16) | (x[3] & 0xffff0000u); o1.z = (x[4] >> 16) | (x[5] & 0xffff0000u); o1.w = (x[6] >> 16) | (x[7] & 0xffff0000u);
            bf16* dst = d.W16 + (size_t)(64 * d.nb + nl) * d.K + 64 * d.kb + 8 * c;
            if (pm == 0) { *(v4u*)dst = o0; *(v4u*)(dst + d.K) = o1; } else asm volatile("" :: "v"(o0), "v"(o1));
        }
    } else {
#pragma unroll
        for (int i = 0; i < 16; ++i) *(LAS unsigned*)(scr + (4 * i + (lane >> 4)) * 68 + 4 * (lane & 15)) = pk4_fp8(v[i][0] * 64.0f, v[i][1] * 64.0f, v[i][2] * 64.0f, v[i][3] * 64.0f);
        LDS_WAIT(); asm volatile("" ::: "memory");
        const int nq = lane & 15, kg = lane >> 4;
        unsigned x[16];
#pragma unroll
        for (int j = 0; j < 16; ++j) x[j] = *(const LAS unsigned*)(scr + (16 * kg + j) * 68 + 4 * nq);
#pragma unroll
        for (int t = 0; t < 4; ++t) {
            v4u o;
#pragma unroll
            for (int q = 0; q < 4; ++q) o[q] = ((x[4 * q] >> (8 * t)) & 0xffu) | (((x[4 * q + 1] >> (8 * t)) & 0xffu) << 8) | (((x[4 * q + 2] >> (8 * t)) & 0xffu) << 16) | (((x[4 * q + 3] >> (8 * t)) & 0xffu) << 24);
            if (pm == 0) *(v4u*)(d.W8 + (size_t)(64 * d.nb + 4 * nq + t) * d.K + 64 * d.kb + 16 * kg) = o; else asm volatile("" :: "v"(o));
        }
    }
    LDS_WAIT(); asm volatile("" ::: "memory");
}
__device__ __forceinline__ P0D p0_decode(const Args& a, unsigned char* ws, int it, int lane) {
    constexpr int I_IN = 16 * 56, I_OUT = 256, I_PG = 256, I_PP = 4 * 16, I_UG = 16 * 32, I_DN = 256;
    int r = it;
    if (r < I_IN) return p0_mk(a.w_in, DIN, DM, (bf16*)(ws + WS_WT_IN), nullptr, r / 56, r % 56, MAP_IN, lane); r -= I_IN;
    if (r < I_OUT) return p0_mk(a.w_out, DM, DM, (bf16*)(ws + WS_WT_OUT), nullptr, r / 16, r % 16, MAP_NAT, lane); r -= I_OUT;
    if (r < I_PG) return p0_mk(a.w_pg, DM, DM, nullptr, (unsigned char*)(ws + WS_WT_PG), r / 16, r % 16, MAP_NAT, lane); r -= I_PG;
    if (r < I_PP) return p0_mk(a.w_pp, DM, PLE, (bf16*)(ws + WS_WT_PP), nullptr, r / 16, r % 16, MAP_NAT, lane); r -= I_PP;
    if (r < NE * I_UG) { const int e = r / I_UG, q = r % I_UG; return p0_mk(a.w_ug + (size_t)e * DM * 2048, 2048, DM, nullptr, (unsigned char*)(ws + WS_WT_UG) + (size_t)e * 2048 * DM, q / 32, q % 32, MAP_UG, lane); } r -= NE * I_UG;
    { const int e = r / I_DN, q = r % I_DN; return p0_mk(a.w_dn + (size_t)e * DM * DM, DM, DM, nullptr, (unsigned char*)(ws + WS_WT_DN) + (size_t)e * DM * DM, q / 16, q % 16, MAP_NAT, lane); }
}
__device__ __forceinline__ void rms_row_to_bf16(const float* xrow, const float* g, bf16* orow, int lane) {
    const f32x4* xr = (const f32x4*)xrow + lane;
    f32x4 v[4]; float s = 0.f;
#pragma unroll
    for (int j = 0; j < 4; ++j) { v[j] = xr[64 * j]; s += (v[j][0] * v[j][0] + v[j][1] * v[j][1]) + (v[j][2] * v[j][2] + v[j][3] * v[j][3]); }
    const float rstd = rsqrtf(wave_sum(s) * (1.f / DM) + EPS);
    unsigned long long* o8 = (unsigned long long*)orow + lane;
#pragma unroll
    for (int j = 0; j < 4; ++j) { const f32x4 gg = ((const f32x4*)g)[lane + 64 * j];
        o8[64 * j] = (unsigned long long)cvtpk(v[j][0] * rstd * gg[0], v[j][1] * rstd * gg[1]) | ((unsigned long long)cvtpk(v[j][2] * rstd * gg[2], v[j][3] * rstd * gg[3]) << 32); }
}
__device__ __forceinline__ void p0_prologue(Frame& F, const Args& a, const int pm = 0) {
    unsigned char* ws = a.ws; const int tid = tid_now(), lane = tid & 63;
    LAS unsigned char* scr = F.lds + RING_OFF + F.wave * 8448;
    const int gw = F.vcu * NWAVES + F.wave, NGW = F.G * NWAVES;
    constexpr int I_IN = 16 * 56, I_OUT = 256, I_PG = 256, I_PP = 4 * 16, I_UG = 16 * 32, I_DN = 256;
    constexpr int NITEMS = I_IN + I_OUT + I_PG + I_PP + NE * I_UG + NE * I_DN;
    if (gw < NITEMS) {
        int it = gw; P0D d0 = p0_decode(a, ws, it, lane), d1 = d0; f32x4 va[16], vb[16]; p0_load(d0, va);
        for (;;) {
            const int it1 = it + NGW; const bool h1 = it1 < NITEMS;
            if (h1) { d1 = p0_decode(a, ws, it1, lane); p0_load(d1, vb); }
            p0_finish(d0, va, scr, lane, pm);
            if (!h1) break;
            const int it2 = it1 + NGW; const bool h2 = it2 < NITEMS;
            if (h2) { d0 = p0_decode(a, ws, it2, lane); p0_load(d0, va); }
            p0_finish(d1, vb, scr, lane, pm);
            if (!h2) break;
            it = it2;
        }
    }
    if (pm != 0) return;
    if (blockIdx.x == 0 && tid < 256) { const int t = tid; const float* srcs = (t < 64) ? a.sbq : (t < 128) ? a.sbk : (t < 192) ? a.rq : a.rk; ((float*)(ws + WS_GAINS))[t] = srcs[t & 63]; }
    for (int m = gw; m < T; m += NGW) rms_row_to_bf16(a.x + (size_t)m * DM, a.g_mix, (bf16*)(ws + WS_XN) + (size_t)m * DM, lane);
    { const int gt = gw * 64 + lane, NGT = NGW * 64;
      for (int i = gt; i < T * PLE / 8; i += NGT) { const f32x4 a0 = ((const f32x4*)a.p)[2 * i], a1 = ((const f32x4*)a.p)[2 * i + 1];
          v4u o; o.x = cvtpk(a0[0], a0[1]); o.y = cvtpk(a0[2], a0[3]); o.z = cvtpk(a1[0], a1[1]); o.w = cvtpk(a1[2], a1[3]); ((v4u*)(ws + WS_PB))[i] = o; }
      for (int i = gt; i < NE * DM; i += NGT) { const int e = i >> 10, k = i & (DM - 1); const float wv = a.w_r[(size_t)k * NE + e];
          const unsigned hi = cvtpk(wv, 0.f) & 0xffffu; const unsigned lo = cvtpk(wv - __uint_as_float(hi << 16), 0.f) & 0xffffu;
          ((bf16*)(ws + WS_WRT))[i] = (bf16)hi; ((bf16*)(ws + WS_WRT))[NE * DM + i] = (bf16)lo; }
      float* rc = (float*)(ws + WS_ROPEC); float* rs = (float*)(ws + WS_ROPES);
      for (int i = gt; i < T * 32; i += NGT) { const int row = i >> 5, f = i & 31;
          const float inv_freq = powf(10000.0f, -(float)f / 32.0f); const float ang = (float)a.positions[row] * inv_freq;
          float sn, cs; sincosf(ang, &sn, &cs); rc[i] = cs; rs[i] = sn; } }
}

namespace att {
typedef short bf16x8 __attribute__((ext_vector_type(8)));
typedef short s16x4 __attribute__((ext_vector_type(4)));
typedef float f32x16 __attribute__((ext_vector_type(16)));
typedef short v4i16_t __attribute__((ext_vector_type(4)));
constexpr int LK = 0, LV = 24576, LFLAG = 49152;
__device__ __forceinline__ s16x4 vtr(LAS const unsigned char* p) { return __builtin_bit_cast(s16x4, __builtin_amdgcn_ds_read_tr16_b64_v4i16((LAS v4i16_t*)p)); }
__device__ __forceinline__ int crow(int r, int hi) { return (r & 3) + 8 * (r >> 2) + 4 * hi; }
struct AttnArgs { const bf16* hm; const bf16* rg; bf16* Y; const float* gn_g; const float* gn_b; };

template <int MODE> __device__ __forceinline__ void attn_unit(LAS unsigned char* lds, const AttnArgs& A, int b, int h, int qb) {
    int tid_ = threadIdx.x; asm volatile("" : "+v"(tid_));
    const int tid = tid_, lane = tid & 63, r32 = lane & 31, hh = lane >> 5;
    const int w = __builtin_amdgcn_readfirstlane(tid >> 6);
    const int q0 = qb * 256, qw = q0 + 32 * w;
    const size_t TS = (size_t)T * 512;
    const size_t hoff = (size_t)(b * 8 + h) * SEQ * 64;
    const bf16* Qp = A.hm + (MODE == 0 ? 0 : 3) * TS + hoff;
    const bf16* Kp = A.hm + (MODE == 0 ? 1 : 4) * TS + hoff;
    const bf16* Vp = A.hm + (MODE == 0 ? 2 : 5) * TS + hoff;
    bf16x8 qf[4];
#pragma unroll
    for (int ds = 0; ds < 4; ++ds) qf[ds] = *(const bf16x8*)(Qp + (size_t)(qw + r32) * 64 + 16 * ds + 8 * hh);
    f32x16 o[2];
#pragma unroll
    for (int r = 0; r < 16; ++r) { o[0][r] = 0.f; o[1][r] = 0.f; }
    float carry = 1.0f;
    const int jmax = (q0 + 255) >> 6, jd = (qw + 31) >> 6;
    const float lg2g = __log2f(1.0f - __builtin_amdgcn_exp2f(-5.0f - (float)h));
    const bf16* Kt = Kp + (size_t)lane * 64 + w * 8; const bf16* Vt = Vp + (size_t)w * 512 + lane * 8;
    volatile LAS unsigned* flags = (volatile LAS unsigned*)(lds + LFLAG);
#define ATT_DMA(t, so) do { __builtin_amdgcn_global_load_lds((const unsigned*)(Kt + (size_t)(t) * 4096), (LAS unsigned*)(lds + LK + (so) + w * 1024), 16, 0, 0); \
                            __builtin_amdgcn_global_load_lds((const unsigned*)(Vt + (size_t)(t) * 4096), (LAS unsigned*)(lds + LV + (so) + w * 1024), 16, 0, 0); } while (0)
    ATT_DMA(jmax, 0);
    if (jmax >= 1) { ATT_DMA(jmax - 1, 8192); asm volatile("s_waitcnt vmcnt(2)\n\ts_barrier" ::: "memory"); }
    else asm volatile("s_waitcnt vmcnt(0)\n\ts_barrier" ::: "memory");
    bool finished = false;
    int so_cur = 0, so_new = 16384;
    for (int j = jmax; j >= 0; --j) {
        const int cur = j & 1;
        if (j >= 2) ATT_DMA(j - 2, so_new);
        if (j <= jd && !finished) {
            LAS const unsigned char* Kb = lds + LK + so_cur;
            LAS const unsigned char* Vb = lds + LV + so_cur;
            f32x16 p[2];
#pragma unroll
            for (int r = 0; r < 16; ++r) { p[0][r] = 0.f; p[1][r] = 0.f; }
#pragma unroll
            for (int ds = 0; ds < 4; ++ds) {
                const bf16x8 k0 = *(LAS const bf16x8*)(Kb + (2 * ds + hh) * 1024 + r32 * 16);
                const bf16x8 k1 = *(LAS const bf16x8*)(Kb + (2 * ds + hh) * 1024 + (32 + r32) * 16);
                p[0] = __builtin_amdgcn_mfma_f32_32x32x16_bf16(k0, qf[ds], p[0], 0, 0, 0);
                p[1] = __builtin_amdgcn_mfma_f32_32x32x16_bf16(k1, qf[ds], p[1], 0, 0, 0);
            }
            const bool diag = (j == jd);
            const int qg = qw + r32, kv0 = 64 * j + 4 * hh;
            if (MODE == 0) {
                float om[2][16];
#pragma unroll
                for (int hf = 0; hf < 2; ++hf)
#pragma unroll
                    for (int r = 0; r < 16; ++r) {
                        const float Z = p[hf][r];
                        const float a = __builtin_amdgcn_exp2f(-__builtin_fabsf(Z));
                        const float rc = __builtin_amdgcn_rcpf(1.0f + a), ar = a * rc;
                        const bool pos = Z >= 0.f;
                        const bool valid = !diag || (kv0 + 32 * hf + (r & 3) + 8 * (r >> 2) < qg);
                        const float beta = pos ? rc : ar, omb = pos ? ar : rc;
                        p[hf][r] = valid ? beta : 0.f;
                        om[hf][r] = valid ? omb : 1.0f;
                    }
                float gs[8], ot[8];
#pragma unroll
                for (int m = 0; m < 8; ++m) { const int hf = m >> 2, g = m & 3; gs[m] = (om[hf][4 * g] * om[hf][4 * g + 1]) * (om[hf][4 * g + 2] * om[hf][4 * g + 3]); ot[m] = __shfl_xor(gs[m], 32); }
                float ps[8];
                ps[7] = 1.0f;
#pragma unroll
                for (int m = 6; m >= 0; --m) ps[m] = ps[m + 1] * (gs[m + 1] * ot[m + 1]);
                const float total = ps[0] * (gs[0] * ot[0]);
#pragma unroll
                for (int m = 0; m < 8; ++m) {
                    const int hf = m >> 2, g = m & 3;
                    float tail = carry * (hh ? ps[m] : ps[m] * ot[m]);
#pragma unroll
                    for (int i = 3; i >= 0; --i) { const int r = 4 * g + i; const float o1 = om[hf][r]; p[hf][r] *= tail; tail *= o1; }
                }
                carry *= total;
                finished = __all(carry < 1.0e-37f);
            } else {
                const float ct = __builtin_amdgcn_exp2f(lg2g * (float)(qw - 64 * j));
#pragma unroll
                for (int hf = 0; hf < 2; ++hf)
#pragma unroll
                    for (int r = 0; r < 16; ++r) {
                        const bool valid = !diag || (kv0 + 32 * hf + (r & 3) + 8 * (r >> 2) <= qg);
                        p[hf][r] = valid ? p[hf][r] * ct : 0.f;
                    }
            }
#pragma unroll
            for (int hf = 0; hf < 2; ++hf)
#pragma unroll
                for (int s = 0; s < 2; ++s) {
                    u32x4_t wq;
                    wq.x = pg8::cvt_pk_bf16(p[hf][8 * s + 0], p[hf][8 * s + 1]); wq.y = pg8::cvt_pk_bf16(p[hf][8 * s + 2], p[hf][8 * s + 3]);
                    wq.z = pg8::cvt_pk_bf16(p[hf][8 * s + 4], p[hf][8 * s + 5]); wq.w = pg8::cvt_pk_bf16(p[hf][8 * s + 6], p[hf][8 * s + 7]);
                    const bf16x8 wf = __builtin_bit_cast(bf16x8, wq);
#pragma unroll
                    for (int d0 = 0; d0 < 2; ++d0) {
                        LAS const unsigned char* va = Vb + (32 * hf + 16 * s + 4 * hh + ((lane & 15) >> 2)) * 128 + (32 * d0 + 16 * ((lane >> 4) & 1) + 4 * (lane & 3)) * 2;
                        const s16x4 lo = vtr(va), hi = vtr(va + 8 * 128);
                        const bf16x8 vf = (bf16x8){lo[0], lo[1], lo[2], lo[3], hi[0], hi[1], hi[2], hi[3]};
                        o[d0] = __builtin_amdgcn_mfma_f32_32x32x16_bf16(vf, wf, o[d0], 0, 0, 0);
                    }
                }
        }
        if (MODE == 0) { if (lane == 0) flags[cur * 8 + w] = finished ? 1u : 0u; }
        if (j >= 2) asm volatile("s_waitcnt vmcnt(2) lgkmcnt(0)\n\ts_barrier" ::: "memory"); else asm volatile("s_waitcnt vmcnt(0) lgkmcnt(0)\n\ts_barrier" ::: "memory");
        so_cur = (so_cur == 16384) ? 0 : so_cur + 8192; so_new = (so_new == 16384) ? 0 : so_new + 8192;
        if (MODE == 0) {
            unsigned all = 1u;
#pragma unroll
            for (int i = 0; i < 8; ++i) all &= flags[cur * 8 + i];
            if (all) break;
        }
    }
    asm volatile("s_waitcnt vmcnt(0)\n\ts_barrier" ::: "memory");
#undef ATT_DMA
    const int row = b * SEQ + qw + r32;
    if (MODE == 0) {
        bf16* yp = A.Y + (size_t)row * DM + h * 64 + 4 * hh;
#pragma unroll
        for (int d0 = 0; d0 < 2; ++d0)
#pragma unroll
            for (int g = 0; g < 4; ++g) { u32x2_t v; v.x = pg8::cvt_pk_bf16(o[d0][4 * g], o[d0][4 * g + 1]); v.y = pg8::cvt_pk_bf16(o[d0][4 * g + 2], o[d0][4 * g + 3]); *(u32x2_t*)(yp + 32 * d0 + 8 * g) = v; }
    } else {
        float s1 = 0.f;
#pragma unroll
        for (int r = 0; r < 16; ++r) s1 += o[0][r] + o[1][r];
        s1 += __shfl_xor(s1, 32);
        const float mu = s1 * (1.0f / 64.0f);
        float s2 = 0.f;
#pragma unroll
        for (int r = 0; r < 16; ++r) { const float a0 = o[0][r] - mu, a1 = o[1][r] - mu; s2 += a0 * a0 + a1 * a1; }
        s2 += __shfl_xor(s2, 32);
        const float rstd = rsqrtf(s2 * (1.0f / 64.0f) + EPS);
        bf16* yp = A.Y + (size_t)row * DM + 512 + h * 64 + 4 * hh;
        const bf16* gp = A.rg + (size_t)row * 512 + h * 64 + 4 * hh;
        const float* gg = A.gn_g + h * 64 + 4 * hh; const float* gb = A.gn_b + h * 64 + 4 * hh;
#pragma unroll
        for (int d0 = 0; d0 < 2; ++d0)
#pragma unroll
            for (int g = 0; g < 4; ++g) {
                const f32x4 gn = *(const f32x4*)(gg + 32 * d0 + 8 * g), bs = *(const f32x4*)(gb + 32 * d0 + 8 * g);
                const u32x2_t gr = *(const u32x2_t*)(gp + 32 * d0 + 8 * g);
                float gate[4] = {__uint_as_float(gr.x << 16), __uint_as_float(gr.x & 0xffff0000u), __uint_as_float(gr.y << 16), __uint_as_float(gr.y & 0xffff0000u)};
                float ov[4];
#pragma unroll
                for (int i = 0; i < 4; ++i) { const float yn = (o[d0][4 * g + i] - mu) * rstd * gn[i] + bs[i]; const float sg = gate[i] / (1.0f + __expf(-gate[i])); ov[i] = yn * sg; }
                u32x2_t v; v.x = pg8::cvt_pk_bf16(ov[0], ov[1]); v.y = pg8::cvt_pk_bf16(ov[2], ov[3]); *(u32x2_t*)(yp + 32 * d0 + 8 * g) = v;
            }
    }
}
__device__ __forceinline__ void attn_phase(LAS unsigned char* lds, const AttnArgs& A, int vcu, int dup) {
    const int bh = vcu >> 2, x = vcu & 3, b = bh >> 3, h = bh & 7;
#pragma unroll 1
    for (int u = 0; u < ((dup == 20) ? 4 : 2); ++u) attn_unit<1>(lds, A, b, h, (u & 1) ? x : 7 - x);
#pragma unroll 1
    for (int u = 0; u < ((dup == 21) ? 4 : 2); ++u) attn_unit<0>(lds, A, b, h, (u & 1) ? x : 7 - x);
}
}

constexpr int CW_GCNT = 2048;
constexpr int LR_LCNT = LDSCTL_OFF + 1024, LR_GBASE = LDSCTL_OFF + 1152;
constexpr int LT_POFF = LDSCTL_OFF + 2048, LT_NT = LDSCTL_OFF + 2176, LT_TILE_E = LDSCTL_OFF + 2304;
struct RouteBufs { int* tok_e; int* tok_slot; float* tok_gate; float* rstd; float* slot_rstd; };
__device__ __forceinline__ RouteBufs route_bufs(unsigned char* ws) { RouteBufs r; r.tok_e = (int*)(ws + WS_ROUTE); r.tok_slot = r.tok_e + T * 4; r.tok_gate = (float*)(r.tok_slot + T * 4); r.rstd = (float*)(ws + WS_ROUTE + 1 * MiB); r.slot_rstd = (float*)(ws + WS_ROUTE + 2 * MiB); return r; }
typedef float f32x2v __attribute__((ext_vector_type(2)));
__device__ __forceinline__ unsigned opq_mask(bool c) { unsigned m = c ? 0xffffffffu : 0u; asm volatile("" : "+v"(m)); return m; }
__device__ __forceinline__ float blendf(unsigned m, float a, float b) { return __uint_as_float((__float_as_uint(a) & m) | (__float_as_uint(b) & ~m)); }
__device__ __forceinline__ int blendi(unsigned m, int a, int b) { return (int)(((unsigned)a & m) | ((unsigned)b & ~m)); }

#define SW2(c, a, b) { const float ta_ = (c) ? (b) : (a), tb_ = (c) ? (a) : (b); a = ta_; b = tb_; }
#define SW2I(c, a, b) { const int ta_ = (c) ? (b) : (a), tb_ = (c) ? (a) : (b); a = ta_; b = tb_; }
#define TOP4_INSERT(x, e) { const float x_ = (x); const int e_ = (e); const bool c3_ = (x_ > v3) || (x_ == v3 && e_ < i3); v3 = c3_ ? x_ : v3; i3 = c3_ ? e_ : i3; \
    const bool c2_ = (v3 > v2) || (v3 == v2 && i3 < i2); SW2(c2_, v2, v3) SW2I(c2_, i2, i3) const bool c1_ = (v2 > v1) || (v2 == v1 && i2 < i1); SW2(c1_, v1, v2) SW2I(c1_, i1, i2) \
    const bool c0_ = (v1 > v0) || (v1 == v0 && i1 < i0); SW2(c0_, v0, v1) SW2I(c0_, i0, i1) }
__device__ __forceinline__ void router_phase(Frame& F, const Args& a, const bool dry = false) {
    unsigned char* ws = a.ws; const int tid = tid_now();
    LAS unsigned char* lds = F.lds;
    const int lane = tid & 63, r32 = lane & 31, hh = lane >> 5, w = F.wave, rg = w >> 2, kq = w & 3;
    volatile LAS unsigned* lcnt = (volatile LAS unsigned*)(lds + LR_LCNT);
    volatile LAS unsigned* gbase = (volatile LAS unsigned*)(lds + LR_GBASE);
    if (tid < 32) lcnt[tid] = 0u;
    const RouteBufs R = route_bufs(dry ? ws + 3 * MiB : ws);
    const int row = F.vcu * 64 + 32 * rg + r32;
    const float* xr = a.out + (size_t)row * DM + 256 * kq + 8 * hh;
    const float* gr = a.g_ffn + 256 * kq + 8 * hh;
    const bf16* wt = (const bf16*)(ws + WS_WRT) + (size_t)r32 * DM + 256 * kq + 8 * hh;
    unsigned char* hp = (unsigned char*)(ws + (dry ? WS_H : WS_XN)) + (size_t)row * DM + 256 * kq + 8 * hh;
    att::f32x16 D;
#pragma unroll
    for (int r = 0; r < 16; ++r) D[r] = 0.f;
    float ss = 0.f;
#pragma unroll 4
    for (int ks = 0; ks < 16; ++ks) {
        const f32x4 x0 = *(const f32x4*)(xr + 16 * ks), x1 = *(const f32x4*)(xr + 16 * ks + 4);
        const f32x4 g0 = *(const f32x4*)(gr + 16 * ks), g1 = *(const f32x4*)(gr + 16 * ks + 4);
        ss += ((x0[0] * x0[0] + x0[1] * x0[1]) + (x0[2] * x0[2] + x0[3] * x0[3])) + ((x1[0] * x1[0] + x1[1] * x1[1]) + (x1[2] * x1[2] + x1[3] * x1[3]));
        const f32x4 v0 = x0 * g0, v1 = x1 * g1;
        u32x2_t h8; h8.x = pk4_fp8(v0[0], v0[1], v0[2], v0[3]); h8.y = pk4_fp8(v1[0], v1[1], v1[2], v1[3]); *(u32x2_t*)(hp + 16 * ks) = h8;
        u32x4_t xh, xl;
        xh.x = cvtpk(v0[0], v0[1]); xh.y = cvtpk(v0[2], v0[3]); xh.z = cvtpk(v1[0], v1[1]); xh.w = cvtpk(v1[2], v1[3]);
        xl.x = cvtpk(v0[0] - __uint_as_float(xh.x << 16), v0[1] - __uint_as_float(xh.x & 0xffff0000u)); xl.y = cvtpk(v0[2] - __uint_as_float(xh.y << 16), v0[3] - __uint_as_float(xh.y & 0xffff0000u));
        xl.z = cvtpk(v1[0] - __uint_as_float(xh.z << 16), v1[1] - __uint_as_float(xh.z & 0xffff0000u)); xl.w = cvtpk(v1[2] - __uint_as_float(xh.w << 16), v1[3] - __uint_as_float(xh.w & 0xffff0000u));
        const att::bf16x8 whi = *(const att::bf16x8*)(wt + 16 * ks), wlo = *(const att::bf16x8*)(wt + 32 * DM + 16 * ks);
        const att::bf16x8 bxh = __builtin_bit_cast(att::bf16x8, xh), bxl = __builtin_bit_cast(att::bf16x8, xl);
        D = __builtin_amdgcn_mfma_f32_32x32x16_bf16(whi, bxh, D, 0, 0, 0);
        D = __builtin_amdgcn_mfma_f32_32x32x16_bf16(wlo, bxh, D, 0, 0, 0);
        D = __builtin_amdgcn_mfma_f32_32x32x16_bf16(whi, bxl, D, 0, 0, 0);
    }
    { LAS f32x4* dp = (LAS f32x4*)(lds + (w * 64 + lane) * 64);
#pragma unroll
      for (int q = 0; q < 4; ++q) dp[q] = (f32x4){D[4 * q], D[4 * q + 1], D[4 * q + 2], D[4 * q + 3]};
      *(LAS float*)(lds + 32768 + (w * 64 + lane) * 4) = ss; }
    __syncthreads();
    int my_e0 = 0, my_e1 = 0, rk0 = 0, rk1 = 0; float my_g0 = 0.f, my_g1 = 0.f;
    if (kq == 0) {
#pragma unroll
        for (int o = 1; o < 4; ++o) { LAS const f32x4* dp = (LAS const f32x4*)(lds + ((w + o) * 64 + lane) * 64);
#pragma unroll
            for (int q = 0; q < 4; ++q) { const f32x4 t = dp[q]; D[4 * q] += t[0]; D[4 * q + 1] += t[1]; D[4 * q + 2] += t[2]; D[4 * q + 3] += t[3]; }
            ss += *(LAS const float*)(lds + 32768 + ((w + o) * 64 + lane) * 4); }
        ss += __shfl_xor(ss, 32);
        const float rstd = rsqrtf(ss * (1.f / DM) + EPS);
        if (hh == 0) R.rstd[row] = rstd;
        float l[16];
#pragma unroll
        for (int r = 0; r < 16; ++r) l[r] = D[r] * rstd + a.b_r[(r & 3) + 8 * (r >> 2) + 4 * hh];
        float c[8]; int ci[8];
#pragma unroll
        for (int k = 0; k < 4; ++k) {
            float bv = -INFINITY; int bi = 99;
#pragma unroll
            for (int r = 0; r < 16; ++r) { const int e = (r & 3) + 8 * (r >> 2) + 4 * hh; const bool bt = l[r] > bv; bv = bt ? l[r] : bv; bi = bt ? e : bi; }
            c[k] = bv; ci[k] = bi;
#pragma unroll
            for (int r = 0; r < 16; ++r) { const int e = (r & 3) + 8 * (r >> 2) + 4 * hh; l[r] = (e == bi) ? -INFINITY : l[r]; }
        }
#pragma unroll
        for (int k = 0; k < 4; ++k) { c[4 + k] = __shfl_xor(c[k], 32); ci[4 + k] = __shfl_xor(ci[k], 32); }
        float tv[4]; int ti[4];
#pragma unroll
        for (int k = 0; k < 4; ++k) {
            float bv = -INFINITY; int bi = 99;
#pragma unroll
            for (int j = 0; j < 8; ++j) { const bool bt = (c[j] > bv) || (c[j] == bv && ci[j] < bi); bv = bt ? c[j] : bv; bi = bt ? ci[j] : bi; }
            tv[k] = bv; ti[k] = bi;
#pragma unroll
            for (int j = 0; j < 8; ++j) c[j] = (ci[j] == bi) ? -INFINITY : c[j];
        }
        const float v0 = tv[0], v1 = tv[1], v2 = tv[2], v3 = tv[3]; const int i0 = ti[0], i1 = ti[1], i2 = ti[2], i3 = ti[3];
        const float e1 = __expf(v1 - v0), e2 = __expf(v2 - v0), e3 = __expf(v3 - v0), inv = 1.0f / (1.0f + e1 + e2 + e3);
        my_e0 = hh ? i2 : i0; my_e1 = hh ? i3 : i1; my_g0 = (hh ? e2 : 1.0f) * inv; my_g1 = (hh ? e3 : e1) * inv;
        rk0 = (int)__hip_atomic_fetch_add((LAS unsigned*)(lds + LR_LCNT) + my_e0, 1u, __ATOMIC_RELAXED, __HIP_MEMORY_SCOPE_WORKGROUP);
        rk1 = (int)__hip_atomic_fetch_add((LAS unsigned*)(lds + LR_LCNT) + my_e1, 1u, __ATOMIC_RELAXED, __HIP_MEMORY_SCOPE_WORKGROUP);
    }
    __syncthreads();
    if (tid < 32) gbase[tid] = __hip_atomic_fetch_add((unsigned*)(F.ctl + CW_GCNT + (dry ? 64 : 0)) + tid, lcnt[tid], __ATOMIC_RELAXED, __HIP_MEMORY_SCOPE_AGENT);
    __syncthreads();
    if (kq == 0) {
        const int k0 = 2 * hh;
        R.tok_e[row * 4 + k0] = my_e0; R.tok_slot[row * 4 + k0] = (int)gbase[my_e0] + rk0; R.tok_gate[row * 4 + k0] = my_g0;
        R.tok_e[row * 4 + k0 + 1] = my_e1; R.tok_slot[row * 4 + k0 + 1] = (int)gbase[my_e1] + rk1; R.tok_gate[row * 4 + k0 + 1] = my_g1;
    }
}
#undef SW2
#undef SW2I
#undef TOP4_INSERT

__device__ __forceinline__ void build_tables(Frame& F) {
    LAS int* poff = (LAS int*)(F.lds + LT_POFF); LAS int* ntp = (LAS int*)(F.lds + LT_NT); LAS int* tile_e = (LAS int*)(F.lds + LT_TILE_E);
    LAS int* cnts = (LAS int*)(F.lds + LR_LCNT); const int tid = tid_now();
    if (tid < NE) cnts[tid] = (int)__hip_atomic_load((unsigned*)(F.ctl + CW_GCNT) + tid, __ATOMIC_RELAXED, __HIP_MEMORY_SCOPE_AGENT);
    __syncthreads();
    if (tid == 0) {
        int t = 0;
        for (int e = 0; e < NE; ++e) { const int c = cnts[e]; const int nt = (c + 255) >> 8; poff[e] = t * 256; for (int i = 0; i < nt; ++i) tile_e[t + i] = e; t += nt; }
        *ntp = t;
    }
    __syncthreads();
}
__device__ __forceinline__ void gather_phase(Frame& F, const Args& a) {
    unsigned char* ws = a.ws; const int lane = tid_now() & 63; const RouteBufs R = route_bufs(ws);
    LAS const int* poff = (LAS const int*)(F.lds + LT_POFF);
    const int gw = F.vcu * NWAVES + F.wave, NGW = F.G * NWAVES;
    for (int m = gw; m < T; m += NGW) {
        const v4u* src = (const v4u*)((const unsigned char*)(ws + WS_XN) + (size_t)m * DM);
        const v4u h0 = src[lane]; const float rs = R.rstd[m];
#pragma unroll
        for (int k = 0; k < 4; ++k) { const int e = R.tok_e[m * 4 + k], slot = R.tok_slot[m * 4 + k];
            v4u* dst = (v4u*)((unsigned char*)(ws + WS_XS) + (size_t)(poff[e] + slot) * DM); dst[lane] = h0; if (lane == 0) R.slot_rstd[poff[e] + slot] = rs; }
    }
}
__device__ __forceinline__ void combine_phase(Frame& F, const Args& a, const bool dry = false) {
    unsigned char* ws = a.ws; const RouteBufs R = route_bufs(ws);
    LAS const int* poff = (LAS const int*)(F.lds + LT_POFF);
    const int gw = F.vcu * NWAVES + F.wave, NGW = F.G * NWAVES, lane = tid_now() & 63;
    for (int m0 = 2 * gw; m0 < T; m0 += 2 * NGW) {
        f32x4 v[2][2][2]; u32x2_t y[2][4][2]; float gt[2][4];
#pragma unroll
        for (int rr = 0; rr < 2; ++rr) { const int m = m0 + rr;
#pragma unroll
            for (int i = 0; i < 2; ++i) { v[rr][i][0] = *(const f32x4*)(a.out + (size_t)m * DM + 8 * lane + 512 * i); v[rr][i][1] = *(const f32x4*)(a.out + (size_t)m * DM + 8 * lane + 512 * i + 4); }
#pragma unroll
            for (int k = 0; k < 4; ++k) { const int e = R.tok_e[m * 4 + k], slot = R.tok_slot[m * 4 + k]; gt[rr][k] = R.tok_gate[m * 4 + k];
                const unsigned char* yr = (const unsigned char*)(ws + WS_YS) + (size_t)(poff[e] + slot) * DM + 8 * lane;
                y[rr][k][0] = *(const u32x2_t*)yr; y[rr][k][1] = *(const u32x2_t*)(yr + 512); } }
#pragma unroll
        for (int rr = 0; rr < 2; ++rr) { const int m = m0 + rr;
#pragma unroll
            for (int k = 0; k < 4; ++k)
#pragma unroll
                for (int i = 0; i < 2; ++i) { const u32x2_t yy = y[rr][k][i]; const float g = gt[rr][k];
                    const f32x2v a0 = __builtin_amdgcn_cvt_pk_f32_fp8((int)yy.x, false), a1 = __builtin_amdgcn_cvt_pk_f32_fp8((int)yy.x, true), a2 = __builtin_amdgcn_cvt_pk_f32_fp8((int)yy.y, false), a3 = __builtin_amdgcn_cvt_pk_f32_fp8((int)yy.y, true);
                    v[rr][i][0][0] += g * a0[0]; v[rr][i][0][1] += g * a0[1]; v[rr][i][0][2] += g * a1[0]; v[rr][i][0][3] += g * a1[1];
                    v[rr][i][1][0] += g * a2[0]; v[rr][i][1][1] += g * a2[1]; v[rr][i][1][2] += g * a3[0]; v[rr][i][1][3] += g * a3[1]; }
            float ss = 0.f;
#pragma unroll
            for (int i = 0; i < 2; ++i)
#pragma unroll
                for (int q = 0; q < 2; ++q) { const f32x4 t = v[rr][i][q]; ss += (t[0] * t[0] + t[1] * t[1]) + (t[2] * t[2] + t[3] * t[3]); }
            const float rstd = rsqrtf(wave_sum(ss) * (1.f / DM) + EPS);
            unsigned char* np = (unsigned char*)(ws + (dry ? WS_H : WS_XN)) + (size_t)m * DM + 8 * lane; float* ow = dry ? (float*)(ws + WS_XS) : a.out;
#pragma unroll
            for (int i = 0; i < 2; ++i) { *(f32x4*)(ow + (size_t)m * DM + 8 * lane + 512 * i) = v[rr][i][0]; *(f32x4*)(ow + (size_t)m * DM + 8 * lane + 512 * i + 4) = v[rr][i][1];
                const f32x4 g0 = *(const f32x4*)(a.g_ple + 8 * lane + 512 * i), g1 = *(const f32x4*)(a.g_ple + 8 * lane + 512 * i + 4);
                u32x2_t o; o.x = pk4_fp8(v[rr][i][0][0] * rstd * g0[0], v[rr][i][0][1] * rstd * g0[1], v[rr][i][0][2] * rstd * g0[2], v[rr][i][0][3] * rstd * g0[3]);
                o.y = pk4_fp8(v[rr][i][1][0] * rstd * g1[0], v[rr][i][1][1] * rstd * g1[1], v[rr][i][1][2] * rstd * g1[2], v[rr][i][1][3] * rstd * g1[3]);
                *(u32x2_t*)(np + 512 * i) = o; } }
    }
}

__global__ void __launch_bounds__(NWAVES * 64, 2) mega_fwd(Args args) {
    extern __shared__ __attribute__((aligned(16))) unsigned char lds[];
    Frame F;
    F.lds = (LAS unsigned char*)lds;
    F.MISC = (volatile LAS unsigned*)(F.lds + MISC_OFF);
    F.wave = __builtin_amdgcn_readfirstlane(threadIdx.x >> 6);
    F.G = gridDim.x; { const int bx = blockIdx.x; F.vcu = (F.G % 8 == 0) ? (bx % 8) * (F.G / 8) + bx / 8 : bx; }
    unsigned char* ws = args.ws;
    F.ctl = (gu32*)(ws + WS_CTL);
    for (int u = threadIdx.x; u < (LDS_BYTES - LDSCTL_OFF) / 4; u += NWAVES * 64) ((LAS unsigned*)(F.lds + LDSCTL_OFF))[u] = 0u;
    __syncthreads();
    XcdBarrier bar = xcd_barrier_post((unsigned*)(F.ctl + CW_BAR), F.MISC + 8);
    const int lo = args.ph_lo, hi = args.ph_hi;
#define IN(k) (lo <= (k) && (k) < hi)
#define GRID_BAR() xcd_barrier(bar)
#ifndef DUP_PHASE
#define DUP_PHASE -1
#endif
#define REP(k) for (int rep_ = 0; rep_ < ((DUP_PHASE) == (k) ? 2 : 1); ++rep_)

    if (IN(0)) { if (DUP_PHASE == 40) { p0_prologue(F, args, 1); GRID_BAR(); } if (DUP_PHASE == 41) { p0_prologue(F, args, 2); GRID_BAR(); } REP(0) { p0_prologue(F, args); GRID_BAR(); } }

    if (IN(1)) REP(1) {
        pg8::Gemm g{(const pg8::bf16_t*)(ws + WS_XN), (const pg8::bf16_t*)(ws + WS_WT_IN), DM, 0};
        pg8::StaticOrder S; S.init(T / 256, DIN / 256, F.G, (int)blockIdx.x);
        pg8::EpiProj E{(pg8::bf16_t*)(ws + WS_HM), (pg8::bf16_t*)(ws + WS_RG), (const float*)(ws + WS_GAINS), (const float*)(ws + WS_ROPEC), (const float*)(ws + WS_ROPES)};
        pg8::gemm_phase<pg8::EpiProj, pg8::StaticOrder, true, true>(F.lds + RING_OFF, g, S, E);
        {
            const int G2 = (F.G == 256) ? 128 : F.G, c2 = (F.G == 256) ? (int)blockIdx.x - 128 : (int)blockIdx.x;
            if (c2 >= 0) {
                pg8::Gemm g2{(const pg8::bf16_t*)(ws + WS_PB), (const pg8::bf16_t*)(ws + WS_WT_PP), PLE, 0};
                pg8::StaticOrder S2; S2.init(T / 256, DM / 256, G2, c2);
                pg8::EpiBf16Plain E2{(pg8::bf16_t*)(ws + WS_PJ), DM};
                pg8::gemm_phase<pg8::EpiBf16Plain, pg8::StaticOrder, true, true>(F.lds + RING_OFF, g2, S2, E2);
            }
        }
        GRID_BAR();
    }
    if (IN(2)) REP(2) {
        if (F.G == 256) {
            const att::AttnArgs AA{(const bf16*)(ws + WS_HM), (const bf16*)(ws + WS_RG), (bf16*)(ws + WS_Y), args.gn_g, args.gn_b};
            att::attn_phase(F.lds + RING_OFF, AA, F.vcu, DUP_PHASE);
        }
        GRID_BAR();
    }
    if (IN(3)) REP(3) {
        pg8::Gemm g{(const pg8::bf16_t*)(ws + WS_Y), (const pg8::bf16_t*)(ws + WS_WT_OUT), DM, 0};
        pg8::StaticOrder S; S.init(T / 256, DM / 256, F.G, (int)blockIdx.x);
        pg8::EpiResid E{args.x, args.out};
        pg8::gemm_phase<pg8::EpiResid, pg8::StaticOrder, true, true>(F.lds + RING_OFF, g, S, E);
        GRID_BAR();
    }
    if (DUP_PHASE == 30 && IN(3)) { GRID_BAR(); GRID_BAR(); GRID_BAR(); GRID_BAR(); }
    if (IN(4)) { if (DUP_PHASE == 4) { if (F.G == 256) router_phase(F, args, true); GRID_BAR(); } if (F.G == 256) router_phase(F, args); GRID_BAR(); }
    if (IN(5) || (lo >= 6 && lo <= 8)) build_tables(F);
    if (IN(5)) REP(5) { gather_phase(F, args); GRID_BAR(); }
    if (IN(6)) REP(6) {
        const int NT = *(LAS const int*)(F.lds + LT_NT);
        pg8::Gemm g{(const pg8::bf16_t*)(ws + WS_XS), (const pg8::bf16_t*)(ws + WS_WT_UG), DM / 2, (size_t)2048 * DM};
        pg8::MoeOrder S; S.init(NT, 8, F.G, (int)blockIdx.x, (LAS const int*)(F.lds + LT_TILE_E));
        pg8::EpiMoeUp E{(unsigned char*)(ws + WS_H), args.b_ug, route_bufs(ws).slot_rstd};
        pg8::gemm_phase<pg8::EpiMoeUp, pg8::MoeOrder, true, true, true>(F.lds + RING_OFF, g, S, E);
        GRID_BAR();
    }
    if (IN(7)) REP(7) {
        const int NT = *(LAS const int*)(F.lds + LT_NT);
        pg8::Gemm g{(const pg8::bf16_t*)(ws + WS_H), (const pg8::bf16_t*)(ws + WS_WT_DN), DM / 2, (size_t)DM * DM};
        pg8::MoeOrder S; S.init(NT, 4, F.G, (int)blockIdx.x, (LAS const int*)(F.lds + LT_TILE_E));
        pg8::EpiMoeDown E{(unsigned char*)(ws + WS_YS), args.b_dn};
        pg8::gemm_phase<pg8::EpiMoeDown, pg8::MoeOrder, true, true, true>(F.lds + RING_OFF, g, S, E);
        GRID_BAR();
    }
    if (IN(8)) { if (DUP_PHASE == 8) { combine_phase(F, args, true); GRID_BAR(); } combine_phase(F, args); GRID_BAR(); }
    if (IN(9)) {
        pg8::Gemm g{(const pg8::bf16_t*)(ws + WS_XN), (const pg8::bf16_t*)(ws + WS_WT_PG), DM / 2, 0};
        pg8::StaticOrder S; S.init(T / 256, DM / 256, F.G, (int)blockIdx.x);
        if (DUP_PHASE == 9) { pg8::EpiPle E0{args.out, (const pg8::bf16_t*)(ws + WS_PJ), (float*)(ws + WS_XS)}; pg8::gemm_phase<pg8::EpiPle, pg8::StaticOrder, true, true, true>(F.lds + RING_OFF, g, S, E0); }
        pg8::EpiPle E{args.out, (const pg8::bf16_t*)(ws + WS_PJ), args.out};
        pg8::gemm_phase<pg8::EpiPle, pg8::StaticOrder, true, true, true>(F.lds + RING_OFF, g, S, E);
    }
#undef IN
}
extern "C" void kernel_launch(void* const* d_in, const int* in_sizes, int n_in, void* d_out, int out_size, void* d_ws, size_t ws_size, hipStream_t stream) {
    static int grid = 0;
    if (grid == 0) {
        if (n_in != 22 || ws_size < 1024 * MiB) { fprintf(stderr, "kernel_launch: unexpected n_in %d / ws %zu\n", n_in, ws_size); grid = -1; return; }
        int dev = 0, cus = 0, per_cu = 0;
        if (hipGetDevice(&dev) != hipSuccess || hipDeviceGetAttribute(&cus, hipDeviceAttributeMultiprocessorCount, dev) != hipSuccess) { grid = -1; return; }
        if (hipFuncSetAttribute((const void*)mega_fwd, hipFuncAttributeMaxDynamicSharedMemorySize, LDS_BYTES) != hipSuccess) { fprintf(stderr, "kernel_launch: hipFuncSetAttribute failed\n"); grid = -1; return; }
        if (hipOccupancyMaxActiveBlocksPerMultiprocessor(&per_cu, (const void*)mega_fwd, NWAVES * 64, LDS_BYTES) != hipSuccess || per_cu < 1) { fprintf(stderr, "kernel_launch: occupancy query says %d\n", per_cu); per_cu = 1; }
        (void)hipGetLastError();
        grid = cus;
    }
    if (grid < 0) return;
    (void)hipMemsetAsync((char*)d_ws + WS_CTL, 0, CTL_ZERO_BYTES, stream);
    Args a{};
    a.x = (const float*)d_in[0]; a.p = (const float*)d_in[1]; a.positions = (const int*)d_in[2]; a.g_mix = (const float*)d_in[3]; a.w_in = (const float*)d_in[4];
    a.sbq = (const float*)d_in[5]; a.sbk = (const float*)d_in[6]; a.rq = (const float*)d_in[7]; a.rk = (const float*)d_in[8]; a.gn_g = (const float*)d_in[9]; a.gn_b = (const float*)d_in[10];
    a.w_out = (const float*)d_in[11]; a.g_ffn = (const float*)d_in[12]; a.w_r = (const float*)d_in[13]; a.b_r = (const float*)d_in[14]; a.w_ug = (const float*)d_in[15]; a.b_ug = (const float*)d_in[16];
    a.w_dn = (const float*)d_in[17]; a.b_dn = (const float*)d_in[18]; a.g_ple = (const float*)d_in[19]; a.w_pg = (const float*)d_in[20]; a.w_pp = (const float*)d_in[21];
    a.out = (float*)d_out; a.ws = (unsigned char*)d_ws; a.ph_lo = 0; a.ph_hi = 10;
    hipLaunchKernelGGL(mega_fwd, dim3(grid), dim3(NWAVES * 64), LDS_BYTES, stream, a);

}
```

```cpp
#include <hip/hip_runtime.h>
#include <cstdint>
#include <cstdio>
#include <cmath>

namespace pg8 {
#define PG8_LAS __attribute__((address_space(3)))
typedef unsigned short bf16_t;
typedef short bf16x8 __attribute__((ext_vector_type(8)));
typedef float f32x4 __attribute__((ext_vector_type(4)));
typedef unsigned u32x4 __attribute__((ext_vector_type(4)));
typedef unsigned u32x2 __attribute__((ext_vector_type(2)));
typedef int v4i32 __attribute__((ext_vector_type(4)));
typedef int v8i32 __attribute__((ext_vector_type(8)));
constexpr int BM = 256, BK = 64, HALF = 128, HTB = HALF * BK * 2  , STAGE_BYTES = 8 * HTB, NXCD = 8, WGM = 8;

__host__ __device__ __forceinline__ int lds_byte(int r, int c) { const int st = (r >> 4) * 2 + (c >> 5), rr = r & 15, cc = c & 31, ob = rr * 64 + cc * 2; return st * 1024 + (ob ^ (((ob >> 9) & 1) << 5)); }
__host__ __device__ __forceinline__ void stage_rc(int b, int& R, int& C) { const int st = b / 1024, sb = b % 1024, swz = sb ^ (((sb >> 9) & 1) << 5); R = (st >> 1) * 16 + swz / 64; C = (st & 1) * 32 + (swz % 64) / 2; }
__host__ __device__ __forceinline__ int perm32(int rho) { const int n = rho >> 4, i = rho & 15; return 8 * (i >> 2) + 4 * n + (i & 3); }

struct Unit { int pm, pn, e; };
struct Gemm { const bf16_t* A; const bf16_t* Bt; int K; size_t strideBe; };

struct StaticOrder {
    int nM, nN, nwg, G, c;
    __host__ __device__ void init(int nM_, int nN_, int G_, int c_) { nM = nM_; nN = nN_; nwg = nM * nN; G = G_; c = c_; }
    __host__ __device__ bool next(int i, Unit& u) const {
        const long L = (long)i * G + c; if (L >= nwg) return false;
        int wgid = (int)L; { const int q = nwg / NXCD, r = nwg % NXCD, xcd = wgid % NXCD, off = wgid / NXCD; wgid = (xcd < r ? xcd * (q + 1) : r * (q + 1) + (xcd - r) * q) + off; }
        const int nig = WGM * nN, gid = wgid / nig, fm = gid * WGM, gsz = (nM - fm) < WGM ? (nM - fm) : WGM;
        u.pm = fm + ((wgid % nig) % gsz); u.pn = (wgid % nig) / gsz; u.e = 0; return true;
    }
    __device__ __forceinline__ void a_ready(const Unit&) const {}
    __device__ __forceinline__ void done(const Unit&) const {}
};

typedef float f32x2_t __attribute__((ext_vector_type(2))); typedef __bf16 bf16x2_t __attribute__((ext_vector_type(2)));
__device__ __forceinline__ unsigned cvt_pk_bf16(float lo, float hi) { f32x2_t v = {lo, hi}; bf16x2_t b = __builtin_convertvector(v, bf16x2_t); return __builtin_bit_cast(unsigned, b); }

constexpr int T = 16384, SEQ = 2048, DM = 1024, DIN = 3584;
constexpr float EPS = 1e-6f;
__device__ __forceinline__ u32x4 pack8(const f32x4 a, const f32x4 b) { u32x4 w; w.x = cvt_pk_bf16(a[0], a[1]); w.y = cvt_pk_bf16(a[2], a[3]); w.z = cvt_pk_bf16(b[0], b[1]); w.w = cvt_pk_bf16(b[2], b[3]); return w; }

struct EpiProj {
    static constexpr bool PERM = true, AFTER_DRAIN = false;
    bf16_t* hm;
    bf16_t* rg;
    const float* gains;
    const float *ropec, *ropes;
    __device__ __forceinline__ void operator()(const f32x4 (&acc)[2][2][4][2], const Unit& u, int wr, int wc, int fr, int fq) const {
        const int region = u.pn >> 1, hb = 4 * (u.pn & 1) + wc;
        const bool normed = (region == 0) || (region == 1) || (region == 3) || (region == 4);
        const bool rope = (region == 3) || (region == 4);
        const int gidx = region == 0 ? 0 : region == 1 ? 1 : region == 3 ? 2 : 3;
        const float* gp = gains + gidx * 64;
        f32x4 gv[2][2];
#pragma unroll
        for (int bj = 0; bj < 2; ++bj)
#pragma unroll
            for (int n = 0; n < 2; ++n) gv[bj][n] = normed ? *(const f32x4*)(gp + 32 * bj + 8 * fq + 4 * n) : (f32x4){1.f, 1.f, 1.f, 1.f};
        const float lg2g = __log2f(1.0f - __builtin_amdgcn_exp2f(-5.0f - (float)hb));
        const float scale = region == 0 ? 0.125f * 1.4426950408889634f : region == 4 ? 0.125f : 1.0f;
#pragma unroll
        for (int ai = 0; ai < 2; ++ai)
#pragma unroll
            for (int m = 0; m < 4; ++m) {
                const int row = u.pm * BM + ai * HALF + wr * 64 + m * 16 + fr;
                const int b = row >> 11, s = row & (SEQ - 1);
                f32x4 v[2][2];
#pragma unroll
                for (int bj = 0; bj < 2; ++bj)
#pragma unroll
                    for (int n = 0; n < 2; ++n) v[bj][n] = acc[ai][bj][m][n];
                if (normed) {
                    float ss = 0.f;
#pragma unroll
                    for (int bj = 0; bj < 2; ++bj)
#pragma unroll
                        for (int n = 0; n < 2; ++n) { const f32x4 x = v[bj][n]; ss += (x[0] * x[0] + x[1] * x[1]) + (x[2] * x[2] + x[3] * x[3]); }
                    ss += __shfl_xor(ss, 16); ss += __shfl_xor(ss, 32);
                    float rs = rsqrtf(ss * (1.0f / 64.0f) + EPS) * scale;
                    if (rope) rs *= (region == 3) ? __builtin_amdgcn_exp2f((float)(s & 31) * lg2g) : __builtin_amdgcn_exp2f(-(float)(s & 63) * lg2g);
#pragma unroll
                    for (int bj = 0; bj < 2; ++bj)
#pragma unroll
                        for (int n = 0; n < 2; ++n) v[bj][n] = v[bj][n] * rs * gv[bj][n];
                    if (rope) {
#pragma unroll
                        for (int n = 0; n < 2; ++n) {
                            const f32x4 c = *(const f32x4*)(ropec + (size_t)row * 32 + 8 * fq + 4 * n), sn = *(const f32x4*)(ropes + (size_t)row * 32 + 8 * fq + 4 * n);
                            const f32x4 lo = v[0][n], hi = v[1][n];
                            v[0][n] = lo * c - hi * sn; v[1][n] = hi * c + lo * sn;
                        }
                    }
                }
                bf16_t* dst = (region < 6) ? hm + (size_t)region * ((size_t)T * 512) + ((size_t)(b * 8 + hb) * SEQ + s) * 64 + 8 * fq
                                           : rg + (size_t)row * 512 + hb * 64 + 8 * fq;
#pragma unroll
                for (int bj = 0; bj < 2; ++bj) *(u32x4*)(dst + 32 * bj) = pack8(v[bj][0], v[bj][1]);
            }
    }
};

struct EpiBf16Plain {
    static constexpr bool PERM = true, AFTER_DRAIN = false;
    bf16_t* O; int ldc;
    __device__ __forceinline__ void operator()(const f32x4 (&acc)[2][2][4][2], const Unit& u, int wr, int wc, int fr, int fq) const {
        const int row0 = u.pm * BM + wr * 64 + fr, col0 = u.pn * BM + wc * 32 + 8 * fq;
#pragma unroll
        for (int ai = 0; ai < 2; ++ai)
#pragma unroll
            for (int m = 0; m < 4; ++m) { bf16_t* rowp = O + (size_t)(row0 + ai * HALF + m * 16) * ldc + col0;
#pragma unroll
                for (int bj = 0; bj < 2; ++bj) *(u32x4*)(rowp + bj * HALF) = pack8(acc[ai][bj][m][0], acc[ai][bj][m][1]); }
    }
};
struct EpiResid {
    static constexpr bool PERM = false, AFTER_DRAIN = false;
    const float* base; float* out;
    __device__ __forceinline__ void operator()(const f32x4 (&acc)[2][2][4][2], const Unit& u, int wr, int wc, int fr, int fq) const {
        const int col0 = u.pn * BM + wc * 32 + 4 * fq;
#pragma unroll
        for (int ai = 0; ai < 2; ++ai)
#pragma unroll
            for (int m = 0; m < 4; ++m) { const size_t off = (size_t)(u.pm * BM + ai * HALF + wr * 64 + m * 16 + fr) * DM + col0;
#pragma unroll
                for (int bj = 0; bj < 2; ++bj)
#pragma unroll
                    for (int n = 0; n < 2; ++n) { const f32x4 bs = *(const f32x4*)(base + off + bj * HALF + n * 16); *(f32x4*)(out + off + bj * HALF + n * 16) = bs + acc[ai][bj][m][n]; } }
    }
};
struct EpiMoeUp {
    static constexpr bool PERM = true, AFTER_DRAIN = false;
    unsigned char* H; const float* bias; const float* srstd;
    __device__ __forceinline__ void operator()(const f32x4 (&acc)[2][2][4][2], const Unit& u, int wr, int wc, int fr, int fq) const {
        const int cc = 128 * u.pn + 32 * wc + 8 * fq;
        const float* bp = bias + (size_t)u.e * 2048 + cc;
        f32x4 bg[2], bl[2];
#pragma unroll
        for (int n = 0; n < 2; ++n) { bg[n] = *(const f32x4*)(bp + 4 * n); bl[n] = *(const f32x4*)(bp + 1024 + 4 * n); }
#pragma unroll
        for (int ai = 0; ai < 2; ++ai)
#pragma unroll
            for (int m = 0; m < 4; ++m) {
                f32x4 hv[2]; const float sc = srstd[u.pm * BM + ai * HALF + wr * 64 + m * 16 + fr] * 0.015625f;
#pragma unroll
                for (int n = 0; n < 2; ++n) {
                    const f32x4 g0 = acc[ai][0][m][n] * sc + bg[n], l0 = acc[ai][1][m][n] * sc + bl[n];
#pragma unroll
                    for (int j = 0; j < 4; ++j) {
                        const float glu = __builtin_fminf(g0[j], 7.0f), lin = __builtin_fminf(__builtin_fmaxf(l0[j], -7.0f), 7.0f);
                        const float sg = __builtin_amdgcn_rcpf(1.0f + __builtin_amdgcn_exp2f(-1.702f * 1.4426950408889634f * glu));
                        hv[n][j] = glu * sg * (lin + 1.0f);
                    }
                }
                u32x2 hq; hq.x = (unsigned)__builtin_amdgcn_cvt_pk_fp8_f32(hv[0][0], hv[0][1], 0, false); hq.x = (unsigned)__builtin_amdgcn_cvt_pk_fp8_f32(hv[0][2], hv[0][3], (int)hq.x, true);
                hq.y = (unsigned)__builtin_amdgcn_cvt_pk_fp8_f32(hv[1][0], hv[1][1], 0, false); hq.y = (unsigned)__builtin_amdgcn_cvt_pk_fp8_f32(hv[1][2], hv[1][3], (int)hq.y, true);
                *(u32x2*)(H + (size_t)(u.pm * BM + ai * HALF + wr * 64 + m * 16 + fr) * 1024 + cc) = hq;
            }
    }
};
struct EpiMoeDown {
    static constexpr bool PERM = true, AFTER_DRAIN = false;
    unsigned char* YS; const float* bias;
    __device__ __forceinline__ void operator()(const f32x4 (&acc)[2][2][4][2], const Unit& u, int wr, int wc, int fr, int fq) const {
        const int col0 = u.pn * BM + wc * 32 + 8 * fq;
        f32x4 bv[2][2];
#pragma unroll
        for (int bj = 0; bj < 2; ++bj)
#pragma unroll
            for (int n = 0; n < 2; ++n) bv[bj][n] = *(const f32x4*)(bias + (size_t)u.e * 1024 + col0 + bj * HALF + 4 * n);
#pragma unroll
        for (int ai = 0; ai < 2; ++ai)
#pragma unroll
            for (int m = 0; m < 4; ++m) { unsigned char* rowp = YS + (size_t)(u.pm * BM + ai * HALF + wr * 64 + m * 16 + fr) * 1024 + col0;
#pragma unroll
                for (int bj = 0; bj < 2; ++bj) { const f32x4 y0 = acc[ai][bj][m][0] * 0.015625f + bv[bj][0], y1 = acc[ai][bj][m][1] * 0.015625f + bv[bj][1];
                    u32x2 q; q.x = (unsigned)__builtin_amdgcn_cvt_pk_fp8_f32(y0[0], y0[1], 0, false); q.x = (unsigned)__builtin_amdgcn_cvt_pk_fp8_f32(y0[2], y0[3], (int)q.x, true);
                    q.y = (unsigned)__builtin_amdgcn_cvt_pk_fp8_f32(y1[0], y1[1], 0, false); q.y = (unsigned)__builtin_amdgcn_cvt_pk_fp8_f32(y1[2], y1[3], (int)q.y, true);
                    *(u32x2*)(rowp + bj * HALF) = q; } }
    }
};
struct EpiPle {
    static constexpr bool PERM = false, AFTER_DRAIN = false;
    float* out; const bf16_t* PJ; float* outw;
    __device__ __forceinline__ void operator()(const f32x4 (&acc)[2][2][4][2], const Unit& u, int wr, int wc, int fr, int fq) const {
        const int col0 = u.pn * BM + wc * 32 + 4 * fq;
#pragma unroll
        for (int ai = 0; ai < 2; ++ai)
#pragma unroll
            for (int m = 0; m < 4; ++m) { const size_t off = (size_t)(u.pm * BM + ai * HALF + wr * 64 + m * 16 + fr) * DM + col0;
#pragma unroll
                for (int bj = 0; bj < 2; ++bj)
#pragma unroll
                    for (int n = 0; n < 2; ++n) {
                        const size_t o2 = off + bj * HALF + n * 16;
                        const f32x4 x2 = *(const f32x4*)(out + o2); const u32x2 pj = *(const u32x2*)(PJ + o2); const f32x4 a = acc[ai][bj][m][n] * 0.015625f;
                        f32x4 r;
                        r[0] = x2[0] + __uint_as_float(pj.x << 16) * __builtin_amdgcn_rcpf(1.0f + __builtin_amdgcn_exp2f(-1.4426950408889634f * a[0]));
                        r[1] = x2[1] + __uint_as_float(pj.x & 0xffff0000u) * __builtin_amdgcn_rcpf(1.0f + __builtin_amdgcn_exp2f(-1.4426950408889634f * a[1]));
                        r[2] = x2[2] + __uint_as_float(pj.y << 16) * __builtin_amdgcn_rcpf(1.0f + __builtin_amdgcn_exp2f(-1.4426950408889634f * a[2]));
                        r[3] = x2[3] + __uint_as_float(pj.y & 0xffff0000u) * __builtin_amdgcn_rcpf(1.0f + __builtin_amdgcn_exp2f(-1.4426950408889634f * a[3]));
                        *(f32x4*)(outw + o2) = r;
                    } }
    }
};
struct MoeOrder {
    int nM, nN, nwg, G, c; const PG8_LAS int* tile_e;
    __device__ void init(int nM_, int nN_, int G_, int c_, const PG8_LAS int* te) { nM = nM_; nN = nN_; nwg = nM * nN; G = G_; c = c_; tile_e = te; }
    __device__ bool next(int i, Unit& u) const {
        const long L = (long)i * G + c; if (L >= nwg) return false;
        int wgid = (int)L; { const int q = nwg / NXCD, r = nwg % NXCD, xcd = wgid % NXCD, off = wgid / NXCD; wgid = (xcd < r ? xcd * (q + 1) : r * (q + 1) + (xcd - r) * q) + off; }
        const int nig = WGM * nN, gid = wgid / nig, fm = gid * WGM, gsz = (nM - fm) < WGM ? (nM - fm) : WGM;
        u.pm = fm + ((wgid % nig) % gsz); u.pn = (wgid % nig) / gsz; u.e = __builtin_amdgcn_readfirstlane(tile_e[u.pm]); return true;
    }
    __device__ __forceinline__ void a_ready(const Unit&) const {}
    __device__ __forceinline__ void done(const Unit&) const {}
};
template <class Epi, class Sched, bool ALIGN_EPI = false, bool SP2 = false, bool F8 = false>
__device__ __forceinline__ void gemm_phase(PG8_LAS unsigned char* lds, const Gemm g, const Sched& S, const Epi& E) {
    int tid_ = threadIdx.x; asm volatile("" : "+v"(tid_));
    const int tid = tid_, wid = __builtin_amdgcn_readfirstlane(tid >> 6), lane = tid & 63, wr = wid >> 2, wc = wid & 3, fr = lane & 15, fq = lane >> 4;
    const int K = g.K, nt = K / BK;
    unsigned voffA[2], voffB[2];
#pragma unroll
    for (int i = 0; i < 2; ++i) { int R, C; stage_rc(tid * 16 + i * 8192, R, C); const int Rb = Epi::PERM ? ((R & ~31) + perm32(R & 31)) : R;
        voffA[i] = (unsigned)(R * K + C) * 2u; voffB[i] = (unsigned)(Rb * K + C) * 2u; }
    const size_t kstep = (size_t)(BK * 2);
    const size_t hstep = (size_t)HALF * K * 2;
    const size_t tstep = 2 * hstep;
    const unsigned ldsw = (unsigned)wid * 1024u;
    const int aoff = lds_byte(wr * 64 + fr, fq * 8), boff = lds_byte(wc * 32 + fr, fq * 8);
#define PG8_SA(b, h) (((b) * 2 + (h)) * HTB)
#define PG8_SB(b, h) ((4 + (b) * 2 + (h)) * HTB)
#define PG8_STAGE(bufoff, gbase, voff) do { _Pragma("unroll") for (int _i = 0; _i < 2; ++_i) \
        __builtin_amdgcn_global_load_lds((const unsigned*)((const char*)(gbase) + (voff)[_i]), (PG8_LAS unsigned*)(lds + (bufoff) + ldsw + _i * 8192), 16, 0, 0); } while (0)
#define PG8_LD16(off) (*(const PG8_LAS v4i32*)(lds + (off)))
#define PG8_LDA(dst, b, h) do { if constexpr (F8) { _Pragma("unroll") for (int m = 0; m < 4; ++m) dst##8[m] = __builtin_shufflevector(PG8_LD16(PG8_SA(b, h) + aoff + m * 2048), PG8_LD16(PG8_SA(b, h) + aoff + m * 2048 + 1024), 0, 1, 2, 3, 4, 5, 6, 7); } \
        else { _Pragma("unroll") for (int m = 0; m < 4; ++m) _Pragma("unroll") for (int k = 0; k < 2; ++k) dst[m][k] = *(const PG8_LAS bf16x8*)(lds + PG8_SA(b, h) + aoff + m * 2048 + k * 1024); } } while (0)
#define PG8_LDB(dst, b, h) do { if constexpr (F8) { _Pragma("unroll") for (int n = 0; n < 2; ++n) dst##8[n] = __builtin_shufflevector(PG8_LD16(PG8_SB(b, h) + boff + n * 2048), PG8_LD16(PG8_SB(b, h) + boff + n * 2048 + 1024), 0, 1, 2, 3, 4, 5, 6, 7); } \
        else { _Pragma("unroll") for (int n = 0; n < 2; ++n) _Pragma("unroll") for (int k = 0; k < 2; ++k) dst[n][k] = *(const PG8_LAS bf16x8*)(lds + PG8_SB(b, h) + boff + n * 2048 + k * 1024); } } while (0)
#define PG8_MMA(ai, bj, At, Bt) do { __builtin_amdgcn_s_setprio(1); \
        if constexpr (F8) { _Pragma("unroll") for (int m = 0; m < 4; ++m) _Pragma("unroll") for (int n = 0; n < 2; ++n) \
            asm volatile("v_mfma_scale_f32_16x16x128_f8f6f4 %0, %1, %2, %0, %3, %3 op_sel_hi:[0,0,0]" : "+v"(acc[ai][bj][m][n]) : "v"(Bt##8[n]), "v"(At##8[m]), "v"(f8scale)); } \
        else { _Pragma("unroll") for (int m = 0; m < 4; ++m) _Pragma("unroll") for (int n = 0; n < 2; ++n) _Pragma("unroll") for (int k = 0; k < 2; ++k) \
            acc[ai][bj][m][n] = __builtin_amdgcn_mfma_f32_16x16x32_bf16(Bt[n][k], At[m][k], acc[ai][bj][m][n], 0, 0, 0); } \
        __builtin_amdgcn_s_setprio(0); } while (0)
#define PG8_WAIT_V(n) asm volatile("s_waitcnt vmcnt(" #n ")" ::: "memory")
#define PG8_WAIT_L(n) asm volatile("s_waitcnt lgkmcnt(" #n ")" ::: "memory")
#define PG8_BAR __builtin_amdgcn_s_barrier()
#define PG8_SCHED __builtin_amdgcn_sched_barrier(0)
    Unit cur, nxt; int ui = 0;
    if (!S.next(0, cur)) return;
    f32x4 acc[2][2][4][2];
#pragma unroll
    for (int a = 0; a < 2; ++a)
#pragma unroll
        for (int b = 0; b < 2; ++b)
#pragma unroll
            for (int m = 0; m < 4; ++m)
#pragma unroll
                for (int n = 0; n < 2; ++n) acc[a][b][m][n] = (f32x4){0.f, 0.f, 0.f, 0.f};
    bf16x8 At[4][2], B0[2][2], B1[2][2];
    v8i32 At8[4], B08[2], B18[2]; const int f8scale = 0x7f7f7f7f;
    const char* cA = (const char*)g.A + (size_t)cur.pm * tstep; const char* cB = (const char*)g.Bt + (size_t)cur.e * g.strideBe + (size_t)cur.pn * tstep;
    S.a_ready(cur);
    if constexpr (SP2) {
        PG8_STAGE(PG8_SB(0, 0), cB, voffB); PG8_STAGE(PG8_SB(0, 1), cB + hstep, voffB); PG8_STAGE(PG8_SA(0, 0), cA, voffA); PG8_STAGE(PG8_SA(0, 1), cA + hstep, voffA);
        if (wr == 1) PG8_BAR;
        PG8_WAIT_V(2); PG8_BAR;
        PG8_STAGE(PG8_SB(1, 0), cB + kstep, voffB); PG8_STAGE(PG8_SA(1, 0), cA + kstep, voffA); PG8_STAGE(PG8_SB(1, 1), cB + hstep + kstep, voffB);
        PG8_WAIT_V(6); PG8_BAR;
    } else {
        PG8_STAGE(PG8_SB(0, 0), cB, voffB); PG8_STAGE(PG8_SA(0, 0), cA, voffA); PG8_STAGE(PG8_SB(0, 1), cB + hstep, voffB); PG8_STAGE(PG8_SA(0, 1), cA + hstep, voffA);
        if (wr == 1) PG8_BAR;
        PG8_WAIT_V(4); PG8_BAR;
        PG8_STAGE(PG8_SB(1, 0), cB + kstep, voffB); PG8_STAGE(PG8_SA(1, 0), cA + kstep, voffA); PG8_STAGE(PG8_SB(1, 1), cB + hstep + kstep, voffB);
        PG8_WAIT_V(6); PG8_BAR;
    }
    for (;;) {
        const bool has_next = S.next(ui + 1, nxt);
        const char* nA = has_next ? (const char*)g.A + (size_t)nxt.pm * tstep : cA; const char* nB = has_next ? (const char*)g.Bt + (size_t)nxt.e * g.strideBe + (size_t)nxt.pn * tstep : cB;
#pragma unroll 1
        for (int t = 0; t < nt; t += 2) {
            const bool last = (t == nt - 2);
            const char* a1 = cA + (size_t)(t + 1) * kstep;
            const char* a2 = last ? nA : cA + (size_t)(t + 2) * kstep; const char* b2 = last ? nB : cB + (size_t)(t + 2) * kstep;
            const char* a3 = a2 + kstep; const char* b3 = b2 + kstep;
            if (last && has_next) S.a_ready(nxt);
            if constexpr (SP2) {
            PG8_LDB(B0, 0, 0); PG8_LDB(B1, 0, 1); PG8_SCHED; PG8_LDA(At, 0, 0); PG8_STAGE(PG8_SA(1, 1), a1 + hstep, voffA);
            PG8_WAIT_V(8); PG8_WAIT_L(0); PG8_BAR; PG8_MMA(0, 0, At, B0); PG8_MMA(0, 1, At, B1); PG8_BAR; PG8_SCHED;
            PG8_LDA(At, 0, 1); PG8_STAGE(PG8_SB(0, 0), b2, voffB); PG8_STAGE(PG8_SB(0, 1), b2 + hstep, voffB); PG8_STAGE(PG8_SA(0, 0), a2, voffA);
            PG8_WAIT_V(8); PG8_WAIT_L(0); PG8_BAR; PG8_MMA(1, 0, At, B0); PG8_MMA(1, 1, At, B1); PG8_BAR; PG8_SCHED;
            PG8_LDB(B0, 1, 0); PG8_LDB(B1, 1, 1); PG8_SCHED; PG8_LDA(At, 1, 0); PG8_STAGE(PG8_SA(0, 1), a2 + hstep, voffA);
            PG8_WAIT_V(8); PG8_WAIT_L(0); PG8_BAR; PG8_MMA(0, 0, At, B0); PG8_MMA(0, 1, At, B1); PG8_BAR; PG8_SCHED;
            PG8_LDA(At, 1, 1); PG8_STAGE(PG8_SB(1, 0), b3, voffB); PG8_STAGE(PG8_SB(1, 1), b3 + hstep, voffB); PG8_STAGE(PG8_SA(1, 0), a3, voffA);
            PG8_WAIT_V(8); PG8_WAIT_L(0); PG8_BAR; PG8_MMA(1, 0, At, B0); PG8_MMA(1, 1, At, B1); PG8_BAR; PG8_SCHED;
            } else {
            PG8_LDB(B0, 0, 0); PG8_SCHED; PG8_LDA(At, 0, 0); PG8_STAGE(PG8_SA(1, 1), a1 + hstep, voffA);
            PG8_WAIT_L(8); PG8_BAR; PG8_WAIT_L(0); PG8_MMA(0, 0, At, B0); PG8_BAR; PG8_SCHED;
            PG8_LDB(B1, 0, 1); PG8_STAGE(PG8_SB(0, 0), b2, voffB);
            PG8_BAR; PG8_WAIT_L(0); PG8_MMA(0, 1, At, B1); PG8_BAR;
            PG8_LDA(At, 0, 1); PG8_STAGE(PG8_SA(0, 0), a2, voffA);
            PG8_BAR; PG8_WAIT_L(0); PG8_MMA(1, 0, At, B0); PG8_BAR; PG8_SCHED;
            PG8_STAGE(PG8_SB(0, 1), b2 + hstep, voffB);
            PG8_WAIT_V(6); PG8_BAR; PG8_MMA(1, 1, At, B1); PG8_BAR;
            PG8_LDB(B0, 1, 0); PG8_SCHED; PG8_LDA(At, 1, 0); PG8_STAGE(PG8_SA(0, 1), a2 + hstep, voffA);
            PG8_WAIT_L(8); PG8_BAR; PG8_WAIT_L(0); PG8_MMA(0, 0, At, B0); PG8_BAR; PG8_SCHED;
            PG8_LDB(B1, 1, 1); PG8_STAGE(PG8_SB(1, 0), b3, voffB);
            PG8_BAR; PG8_WAIT_L(0); PG8_MMA(0, 1, At, B1); PG8_BAR;
            PG8_LDA(At, 1, 1); PG8_STAGE(PG8_SA(1, 0), a3, voffA);
            PG8_BAR; PG8_WAIT_L(0); PG8_MMA(1, 0, At, B0); PG8_BAR; PG8_SCHED;
            PG8_STAGE(PG8_SB(1, 1), b3 + hstep, voffB);
            PG8_WAIT_V(6); PG8_BAR; PG8_MMA(1, 1, At, B1); PG8_BAR;
            }
        }
        if constexpr (ALIGN_EPI) { if (wr == 0) PG8_BAR; }
        if constexpr (F8) asm volatile("s_nop 15\n\ts_nop 15\n\ts_nop 15" ::: "memory");
        if constexpr (!Epi::AFTER_DRAIN) { E(acc, cur, wr, wc, fr, fq); S.done(cur); }
        if (!has_next) break;
#pragma unroll
        for (int a = 0; a < 2; ++a)
#pragma unroll
            for (int b = 0; b < 2; ++b)
#pragma unroll
                for (int m = 0; m < 4; ++m)
#pragma unroll
                    for (int n = 0; n < 2; ++n) acc[a][b][m][n] = (f32x4){0.f, 0.f, 0.f, 0.f};
        cur = nxt; cA = nA; cB = nB; ++ui;
        if constexpr (ALIGN_EPI) { if (wr == 1) PG8_BAR; }
    }
    PG8_WAIT_V(0);
    if constexpr (!ALIGN_EPI) { if (wr == 0) PG8_BAR; }
    PG8_BAR;
    if constexpr (Epi::AFTER_DRAIN) { E.fused(acc, cur, wr, wc, fr, fq, lds, wid, lane); S.done(cur); }
#undef PG8_SA
#undef PG8_SB
#undef PG8_STAGE
#undef PG8_LD16
#undef PG8_LDA
#undef PG8_LDB
#undef PG8_MMA
#undef PG8_WAIT_V
#undef PG8_WAIT_L
#undef PG8_BAR
#undef PG8_SCHED
}
}

constexpr int NWAVES = 8;
constexpr int T = pg8::T, SEQ = pg8::SEQ, DM = pg8::DM, DIN = pg8::DIN, NE = 32, PLE = 256;
constexpr float EPS = pg8::EPS;
constexpr size_t MiB = 1u << 20;
constexpr size_t WS_CTL = 0, CTL_ZERO_BYTES = 1 * MiB;
constexpr size_t WS_WT_IN = 2 * MiB, WS_WT_OUT = 9 * MiB, WS_WT_PG = 11 * MiB, WS_WT_PP = 13 * MiB;
constexpr size_t WS_GAINS = 13 * MiB + 512 * 1024;
constexpr size_t WS_WRT = 13 * MiB + 576 * 1024;
constexpr size_t WS_ROPEC = 14 * MiB, WS_ROPES = 16 * MiB, WS_PB = 18 * MiB, WS_ROUTE = 26 * MiB;
constexpr size_t WS_WT_UG = 32 * MiB, WS_WT_DN = 160 * MiB;
constexpr size_t WS_XN = 224 * MiB;
constexpr size_t WS_HM = 256 * MiB;
constexpr size_t WS_RG = 352 * MiB;
constexpr size_t WS_Y = 368 * MiB;
constexpr size_t WS_PJ = 400 * MiB;
constexpr size_t WS_XS = 432 * MiB, WS_H = 576 * MiB, WS_YS = 720 * MiB;
constexpr size_t WS_END = 864 * MiB;
constexpr int CW_TMO = 0, CW_CODE = 1;
constexpr int CW_BAR = 4096;
constexpr int RING_OFF = 0, RING_BYTES = 131072;
constexpr int LDSCTL_OFF = RING_BYTES, MISC_OFF = LDSCTL_OFF + 320;
constexpr int LDS_BYTES = 147456;
#define GAS __attribute__((address_space(1)))
#define LAS __attribute__((address_space(3)))
typedef unsigned short bf16;
typedef unsigned v4u __attribute__((ext_vector_type(4)));
typedef float f32x4 __attribute__((ext_vector_type(4)));
typedef short bf16x8 __attribute__((ext_vector_type(8)));
typedef unsigned u32x4_t __attribute__((ext_vector_type(4)));
typedef unsigned u32x2_t __attribute__((ext_vector_type(2)));
typedef GAS unsigned gu32;
typedef GAS unsigned long long gu64;
#define RLX_AGENT __ATOMIC_RELAXED, __HIP_MEMORY_SCOPE_AGENT
#define LDS_WAIT() asm volatile("s_waitcnt lgkmcnt(0)" ::: "memory")
#define VM_WAIT() asm volatile("s_waitcnt vmcnt(0)" ::: "memory")
__device__ __forceinline__ unsigned long long rt() { return __builtin_amdgcn_s_memrealtime(); }
__device__ __forceinline__ unsigned f2bf(float f) { unsigned u = __builtin_bit_cast(unsigned, f); return (u + 0x7fffu + ((u >> 16) & 1u)) >> 16; }
__device__ __forceinline__ unsigned pk2(float lo, float hi) { return f2bf(lo) | (f2bf(hi) << 16); }

#define XB_TMO      128
#define XB_XCNT(j)  (256  + 64 * (j))
#define XB_XSUB(j)  (1280 + 64 * (j))
#define XB_XGEN(j)  (2304 + 64 * (j))
#define XB_TOP      3328
#define XB_TOPGEN   3392
#define XCD_BAR_WORDS 3456
#define XB_SPIN_CAP (1u << 18)

__device__ __forceinline__ unsigned xb_ld(unsigned* p)              { return __hip_atomic_load(p, __ATOMIC_RELAXED, __HIP_MEMORY_SCOPE_AGENT); }
__device__ __forceinline__ unsigned xb_add(unsigned* p, unsigned v) { return __hip_atomic_fetch_add(p, v, __ATOMIC_RELAXED, __HIP_MEMORY_SCOPE_AGENT); }
__device__ __forceinline__ unsigned xb_xcc_id() { return (unsigned)__builtin_amdgcn_s_getreg((3 << 11) | 20) & 0xFu; }
#define XB_SPIN(cond, bar) do { unsigned _sp = 0; while (cond) { __builtin_amdgcn_s_sleep(1); \
    if ((++_sp & 255u) == 0u) { if (xb_ld(&(bar)[XB_TMO])) break; if (_sp > XB_SPIN_CAP) { atomicAdd(&(bar)[XB_TMO], 1u); break; } } } } while (0)

struct XcdBarrier {
    unsigned* bar; unsigned x;
    volatile LAS unsigned* st;
};

__device__ __forceinline__ XcdBarrier xcd_barrier_post(unsigned* bar, volatile LAS unsigned* st) {
    XcdBarrier b; b.bar = bar; b.x = xb_xcc_id(); b.st = st;
    if (threadIdx.x == 0) (void)xb_add(&bar[XB_XCNT(b.x)], 1u);
    return b;
}
__device__ __forceinline__ void xcd_barrier_complete(unsigned* bar, unsigned x, unsigned& nloc, unsigned& nx) {
    const unsigned G = gridDim.x * gridDim.y * gridDim.z;
    unsigned sum, cnt, mine, sp = 0u;
    for (;;) {
        sum = 0u; cnt = 0u; mine = 0u;
#pragma unroll
        for (unsigned j = 0; j < 16; ++j) { const unsigned c = xb_ld(&bar[XB_XCNT(j)]); sum += c; cnt += (c > 0u) ? 1u : 0u; mine = (j == x) ? c : mine; }
        if (sum == G) break;
        __builtin_amdgcn_s_sleep(1);
        if ((++sp & 255u) == 0u) { if (xb_ld(&bar[XB_TMO])) break; if (sp > XB_SPIN_CAP) { atomicAdd(&bar[XB_TMO], 1u); break; } }
    }
    nloc = mine > 0u ? mine : 1u; nx = cnt > 0u ? cnt : 1u;
}

__device__ __forceinline__ void xcd_barrier(const XcdBarrier& b) {
    asm volatile("s_waitcnt vmcnt(0)" ::: "memory");
    __syncthreads();
    if (threadIdx.x == 0) {
        unsigned* bar = b.bar;
        __builtin_amdgcn_s_waitcnt(0);
        unsigned nloc = b.st[0], nx = b.st[1];
        if (nloc == 0u) { xcd_barrier_complete(bar, b.x, nloc, nx); b.st[0] = nloc; b.st[1] = nx; }
        const unsigned old = xb_add(&bar[XB_XSUB(b.x)], 1u);
        const unsigned gen = old / nloc;
        const unsigned tgen = gen;
        if (old + 1u == (gen + 1u) * nloc) {
            __builtin_amdgcn_fence(__ATOMIC_RELEASE, "agent");
            asm volatile("s_waitcnt vmcnt(0)" ::: "memory");
            const unsigned og = xb_add(&bar[XB_TOP], 1u);
            const unsigned tg = og / nx;
            if (og + 1u == (tg + 1u) * nx) xb_add(&bar[XB_TOPGEN], 1u);
            else XB_SPIN(xb_ld(&bar[XB_TOPGEN]) == tg, bar);
        } else {
            XB_SPIN(xb_ld(&bar[XB_TOPGEN]) == tgen, bar);
        }
        __builtin_amdgcn_fence(__ATOMIC_ACQUIRE, "agent");
        asm volatile("s_waitcnt vmcnt(0)" ::: "memory");
    }
    __syncthreads();
}

struct Args {
    const float* x; const float* p; const int* positions; const float* g_mix; const float* w_in;
    const float* sbq; const float* sbk; const float* rq; const float* rk; const float* gn_g; const float* gn_b; const float* w_out;
    const float* g_ffn; const float* w_r; const float* b_r; const float* w_ug; const float* b_ug; const float* w_dn; const float* b_dn;
    const float* g_ple; const float* w_pg; const float* w_pp;
    float* out; unsigned char* ws; int ph_lo, ph_hi;
};
struct Frame {
    LAS unsigned char* lds;
    volatile LAS unsigned* MISC;
    gu32* ctl;
    int wave;
    int vcu, G;
};
__device__ __forceinline__ int tid_now() { int t = threadIdx.x; asm volatile("" : "+v"(t)); return t; }
__device__ __forceinline__ float wave_sum(float v) {
#pragma unroll
    for (int o = 1; o < 64; o <<= 1) v += __shfl_xor(v, o);
    return v;
}
__device__ __forceinline__ unsigned cvtpk(float lo, float hi) { return pg8::cvt_pk_bf16(lo, hi); }

enum { MAP_NAT = 0, MAP_IN = 1, MAP_UG = 2 };
__device__ __forceinline__ void p0_item(const float* __restrict__ W, int N, int K, bf16* __restrict__ WT, int kb, int nb, int mapmode, LAS unsigned char* scr, int lane) {
    const int np = 64 * nb + 4 * (lane & 15);
    int src = np;
    if (mapmode == MAP_IN) { const int pn = np >> 8, L = np & 255, bj = L >> 7, wc = (L >> 5) & 3, e = L & 31; src = 256 * pn + 64 * wc + 32 * bj + e; }
    else if (mapmode == MAP_UG) { const int pn = np >> 8, L = np & 255, bj = L >> 7, i = L & 127; src = 1024 * bj + 128 * pn + i; }
    const float* gp = W + (size_t)(64 * kb + (lane >> 4)) * N + src;
    f32x4 v[16];
#pragma unroll
    for (int i = 0; i < 16; ++i) v[i] = *(const f32x4*)(gp + (size_t)(4 * i) * N);
#pragma unroll
    for (int i = 0; i < 16; ++i) {
        LAS unsigned* d = (LAS unsigned*)(scr + (4 * i + (lane >> 4)) * 132 + 8 * (lane & 15));
        d[0] = cvtpk(v[i][0], v[i][1]); d[1] = cvtpk(v[i][2], v[i][3]);
    }
    LDS_WAIT(); asm volatile("" ::: "memory");
    const int c = lane & 7;
#pragma unroll
    for (int it = 0; it < 4; ++it) {
        const int nl = 16 * it + 2 * (lane >> 3);
        unsigned d[8];
#pragma unroll
        for (int j = 0; j < 8; ++j) d[j] = *(const LAS unsigned*)(scr + (8 * c + j) * 132 + 2 * nl);
        v4u o0, o1;
        o0.x = (d[0] & 0xffffu) | (d[1] << 16); o0.y = (d[2] & 0xffffu) | (d[3] << 16); o0.z = (d[4] & 0xffffu) | (d[5] << 16); o0.w = (d[6] & 0xffffu) | (d[7] << 16);
        o1.x = (d[0] >> 16) | (d[1] & 0xffff0000u); o1.y = (d[2] >> 16) | (d[3] & 0xffff0000u); o1.z = (d[4] >> 16) | (d[5] & 0xffff0000u); o1.w = (d[6] >> 16) | (d[7] & 0xffff0000u);
        bf16* dst = WT + (size_t)(64 * nb + nl) * K + 64 * kb + 8 * c;
        *(v4u*)dst = o0; *(v4u*)(dst + K) = o1;
    }
    LDS_WAIT(); asm volatile("" ::: "memory");
}
__device__ __forceinline__ unsigned pk4_fp8(float a, float b, float c, float d) { int r = __builtin_amdgcn_cvt_pk_fp8_f32(a, b, 0, false); r = __builtin_amdgcn_cvt_pk_fp8_f32(c, d, r, true); return (unsigned)r; }
__device__ __forceinline__ void p0_item_f8(const float* __restrict__ W, int N, int K, unsigned char* __restrict__ WT, int kb, int nb, int mapmode, LAS unsigned char* scr, int lane) {
    const int np = 64 * nb + 4 * (lane & 15);
    int src = np;
    if (mapmode == MAP_UG) { const int pn = np >> 8, L = np & 255, bj = L >> 7, i = L & 127; src = 1024 * bj + 128 * pn + i; }
    const float* gp = W + (size_t)(64 * kb + (lane >> 4)) * N + src;
    f32x4 v[16];
#pragma unroll
    for (int i = 0; i < 16; ++i) v[i] = *(const f32x4*)(gp + (size_t)(4 * i) * N);
#pragma unroll
    for (int i = 0; i < 16; ++i) *(LAS unsigned*)(scr + (4 * i + (lane >> 4)) * 68 + 4 * (lane & 15)) = pk4_fp8(v[i][0] * 64.0f, v[i][1] * 64.0f, v[i][2] * 64.0f, v[i][3] * 64.0f);
    LDS_WAIT(); asm volatile("" ::: "memory");
    const int nq = lane & 15, kg = lane >> 4;
    unsigned d[16];
#pragma unroll
    for (int j = 0; j < 16; ++j) d[j] = *(const LAS unsigned*)(scr + (16 * kg + j) * 68 + 4 * nq);
#pragma unroll
    for (int t = 0; t < 4; ++t) {
        v4u o;
#pragma unroll
        for (int q = 0; q < 4; ++q) o[q] = ((d[4 * q] >> (8 * t)) & 0xffu) | (((d[4 * q + 1] >> (8 * t)) & 0xffu) << 8) | (((d[4 * q + 2] >> (8 * t)) & 0xffu) << 16) | (((d[4 * q + 3] >> (8 * t)) & 0xffu) << 24);
        *(v4u*)(WT + (size_t)(64 * nb + 4 * nq + t) * K + 64 * kb + 16 * kg) = o;
    }
    LDS_WAIT(); asm volatile("" ::: "memory");
}
struct P0D { const float* gp; int N, K, kb, nb; bf16* W16; unsigned char* W8; };
__device__ __forceinline__ int p0_src_col(int np, int mapmode) {
    int src = np;
    if (mapmode == MAP_IN) { const int pn = np >> 8, L = np & 255, bj = L >> 7, wc = (L >> 5) & 3, e = L & 31; src = 256 * pn + 64 * wc + 32 * bj + e; }
    else if (mapmode == MAP_UG) { const int pn = np >> 8, L = np & 255, bj = L >> 7, i = L & 127; src = 1024 * bj + 128 * pn + i; }
    return src;
}
__device__ __forceinline__ P0D p0_mk(const float* W, int N, int K, bf16* W16, unsigned char* W8, int kb, int nb, int mapmode, int lane) {
    P0D d; d.N = N; d.K = K; d.kb = kb; d.nb = nb; d.W16 = W16; d.W8 = W8;
    d.gp = W + (size_t)(64 * kb + (lane >> 4)) * N + p0_src_col(64 * nb + 4 * (lane & 15), mapmode); return d;
}
__device__ __forceinline__ void p0_load(const P0D& d, f32x4 (&v)[16]) {
#pragma unroll
    for (int i = 0; i < 16; ++i) v[i] = *(const f32x4*)(d.gp + (size_t)(4 * i) * d.N);
}
__device__ __forceinline__ void p0_finish(const P0D& d, const f32x4 (&v)[16], LAS unsigned char* scr, int lane, const int pm = 0) {
    if (pm == 1) { _Pragma("unroll") for (int i = 0; i < 16; ++i) asm volatile("" :: "v"(v[i])); return; }
    if (d.W16) {
#pragma unroll
        for (int i = 0; i < 16; ++i) { LAS unsigned* q = (LAS unsigned*)(scr + (4 * i + (lane >> 4)) * 132 + 8 * (lane & 15)); q[0] = cvtpk(v[i][0], v[i][1]); q[1] = cvtpk(v[i][2], v[i][3]); }
        LDS_WAIT(); asm volatile("" ::: "memory");
        const int c = lane & 7;
#pragma unroll
        for (int it = 0; it < 4; ++it) {
            const int nl = 16 * it + 2 * (lane >> 3);
            unsigned x[8];
#pragma unroll
            for (int j = 0; j < 8; ++j) x[j] = *(const LAS unsigned*)(scr + (8 * c + j) * 132 + 2 * nl);
            v4u o0, o1;
            o0.x = (x[0] & 0xffffu) | (x[1] << 16); o0.y = (x[2] & 0xffffu) | (x[3] << 16); o0.z = (x[4] & 0xffffu) | (x[5] << 16); o0.w = (x[6] & 0xffffu) | (x[7] << 16);
            o1.x = (x[0] >> 16) | (x[1] & 0xffff0000u); o1.y = (x[2] >> 16) | (x[3] & 0xffff0000u); o1.z = (x[4] >> 16) | (x[5] & 0xffff0000u); o1.w = (x[6] >> 16) | (x[7] & 0xffff0000u);
            bf16* dst = d.W16 + (size_t)(64 * d.nb + nl) * d.K + 64 * d.kb + 8 * c;
            if (pm == 0 || pm == 3) { *(v4u*)dst = o0; *(v4u*)(dst + d.K) = o1; } else asm volatile("" :: "v"(o0), "v"(o1));
        }
    } else {
#pragma unroll
        for (int i = 0; i < 16; ++i) *(LAS unsigned*)(scr + (4 * i + (lane >> 4)) * 68 + 4 * (lane & 15)) = pk4_fp8(v[i][0] * 64.0f, v[i][1] * 64.0f, v[i][2] * 64.0f, v[i][3] * 64.0f);
        LDS_WAIT(); asm volatile("" ::: "memory");
        const int nq = lane & 15, kg = lane >> 4;
        unsigned x[16];
#pragma unroll
        for (int j = 0; j < 16; ++j) x[j] = *(const LAS unsigned*)(scr + (16 * kg + j) * 68 + 4 * nq);
#pragma unroll
        for (int t = 0; t < 4; ++t) {
            v4u o;
#pragma unroll
            for (int q = 0; q < 4; ++q) o[q] = ((x[4 * q] >> (8 * t)) & 0xffu) | (((x[4 * q + 1] >> (8 * t)) & 0xffu) << 8) | (((x[4 * q + 2] >> (8 * t)) & 0xffu) << 16) | (((x[4 * q + 3] >> (8 * t)) & 0xffu) << 24);
            if (pm == 0 || pm == 3) *(v4u*)(d.W8 + (size_t)(64 * d.nb + 4 * nq + t) * d.K + 64 * d.kb + 16 * kg) = o; else asm volatile("" :: "v"(o));
        }
    }
    LDS_WAIT(); asm volatile("" ::: "memory");
}
__device__ __forceinline__ P0D p0_decode(const Args& a, unsigned char* ws, int it, int lane) {
    constexpr int I_IN = 16 * 56, I_OUT = 256, I_PG = 256, I_PP = 4 * 16, I_UG = 16 * 32, I_DN = 256;
    int r = it;
    if (r < I_IN) return p0_mk(a.w_in, DIN, DM, (bf16*)(ws + WS_WT_IN), nullptr, r / 56, r % 56, MAP_IN, lane); r -= I_IN;
    if (r < I_OUT) return p0_mk(a.w_out, DM, DM, (bf16*)(ws + WS_WT_OUT), nullptr, r / 16, r % 16, MAP_NAT, lane); r -= I_OUT;
    if (r < I_PG) return p0_mk(a.w_pg, DM, DM, nullptr, (unsigned char*)(ws + WS_WT_PG), r / 16, r % 16, MAP_NAT, lane); r -= I_PG;
    if (r < I_PP) return p0_mk(a.w_pp, DM, PLE, (bf16*)(ws + WS_WT_PP), nullptr, r / 16, r % 16, MAP_NAT, lane); r -= I_PP;
    if (r < NE * I_UG) { const int e = r / I_UG, q = r % I_UG; return p0_mk(a.w_ug + (size_t)e * DM * 2048, 2048, DM, nullptr, (unsigned char*)(ws + WS_WT_UG) + (size_t)e * 2048 * DM, q / 32, q % 32, MAP_UG, lane); } r -= NE * I_UG;
    { const int e = r / I_DN, q = r % I_DN; return p0_mk(a.w_dn + (size_t)e * DM * DM, DM, DM, nullptr, (unsigned char*)(ws + WS_WT_DN) + (size_t)e * DM * DM, q / 16, q % 16, MAP_NAT, lane); }
}
__device__ __forceinline__ void rms_row_to_bf16(const float* xrow, const float* g, bf16* orow, int lane) {
    const f32x4* xr = (const f32x4*)xrow + lane;
    f32x4 v[4]; float s = 0.f;
#pragma unroll
    for (int j = 0; j < 4; ++j) { v[j] = xr[64 * j]; s += (v[j][0] * v[j][0] + v[j][1] * v[j][1]) + (v[j][2] * v[j][2] + v[j][3] * v[j][3]); }
    const float rstd = rsqrtf(wave_sum(s) * (1.f / DM) + EPS);
    unsigned long long* o8 = (unsigned long long*)orow + lane;
#pragma unroll
    for (int j = 0; j < 4; ++j) { const f32x4 gg = ((const f32x4*)g)[lane + 64 * j];
        o8[64 * j] = (unsigned long long)cvtpk(v[j][0] * rstd * gg[0], v[j][1] * rstd * gg[1]) | ((unsigned long long)cvtpk(v[j][2] * rstd * gg[2], v[j][3] * rstd * gg[3]) << 32); }
}
__device__ __forceinline__ void p0_prologue(Frame& F, const Args& a, const int pm = 0) {
    unsigned char* ws = a.ws; const int tid = tid_now(), lane = tid & 63;
    LAS unsigned char* scr = F.lds + RING_OFF + F.wave * 8448;
    const int gw = F.vcu * NWAVES + F.wave, NGW = F.G * NWAVES;
    constexpr int I_IN = 16 * 56, I_OUT = 256, I_PG = 256, I_PP = 4 * 16, I_UG = 16 * 32, I_DN = 256;
    constexpr int NITEMS = I_IN + I_OUT + I_PG + I_PP + NE * I_UG + NE * I_DN;
    if (gw < NITEMS) {
        int it = gw; P0D d0 = p0_decode(a, ws, it, lane), d1 = d0; f32x4 va[16], vb[16]; p0_load(d0, va);
        for (;;) {
            const int it1 = it + NGW; const bool h1 = it1 < NITEMS;
            if (h1) { d1 = p0_decode(a, ws, it1, lane); p0_load(d1, vb); }
            p0_finish(d0, va, scr, lane, pm);
            if (!h1) break;
            const int it2 = it1 + NGW; const bool h2 = it2 < NITEMS;
            if (h2) { d0 = p0_decode(a, ws, it2, lane); p0_load(d0, va); }
            p0_finish(d1, vb, scr, lane, pm);
            if (!h2) break;
            it = it2;
        }
    }
    if (pm != 0) return;
    if (blockIdx.x == 0 && tid < 256) { const int t = tid; const float* srcs = (t < 64) ? a.sbq : (t < 128) ? a.sbk : (t < 192) ? a.rq : a.rk; ((float*)(ws + WS_GAINS))[t] = srcs[t & 63]; }
    {
        f32x4 gg[4];
#pragma unroll
        for (int j = 0; j < 4; ++j) gg[j] = ((const f32x4*)a.g_mix)[lane + 64 * j];
        for (int m0 = 4 * gw; m0 < T; m0 += 4 * NGW) {
            f32x4 v[4][4];
#pragma unroll
            for (int r = 0; r < 4; ++r)
#pragma unroll
                for (int j = 0; j < 4; ++j) v[r][j] = ((const f32x4*)(a.x + (size_t)(m0 + r) * DM))[lane + 64 * j];
#pragma unroll
            for (int r = 0; r < 4; ++r) {
                float ss = 0.f;
#pragma unroll
                for (int j = 0; j < 4; ++j) ss += (v[r][j][0] * v[r][j][0] + v[r][j][1] * v[r][j][1]) + (v[r][j][2] * v[r][j][2] + v[r][j][3] * v[r][j][3]);
                const float rstd = rsqrtf(wave_sum(ss) * (1.f / DM) + EPS);
                unsigned long long* o8 = (unsigned long long*)((bf16*)(ws + WS_XN) + (size_t)(m0 + r) * DM) + lane;
#pragma unroll
                for (int j = 0; j < 4; ++j) o8[64 * j] = (unsigned long long)cvtpk(v[r][j][0] * rstd * gg[j][0], v[r][j][1] * rstd * gg[j][1]) | ((unsigned long long)cvtpk(v[r][j][2] * rstd * gg[j][2], v[r][j][3] * rstd * gg[j][3]) << 32);
            }
        }
    }
    { const int gt = gw * 64 + lane, NGT = NGW * 64;
      for (int i0 = gt; i0 < T * PLE / 8; i0 += 4 * NGT) {
          f32x4 a0[4], a1[4];
#pragma unroll
          for (int q = 0; q < 4; ++q) { const int i = i0 + q * NGT; if (i < T * PLE / 8) { a0[q] = ((const f32x4*)a.p)[2 * i]; a1[q] = ((const f32x4*)a.p)[2 * i + 1]; } }
#pragma unroll
          for (int q = 0; q < 4; ++q) { const int i = i0 + q * NGT; if (i < T * PLE / 8) { v4u o; o.x = cvtpk(a0[q][0], a0[q][1]); o.y = cvtpk(a0[q][2], a0[q][3]); o.z = cvtpk(a1[q][0], a1[q][1]); o.w = cvtpk(a1[q][2], a1[q][3]); ((v4u*)(ws + WS_PB))[i] = o; } }
      }
      for (int i = gt; i < NE * DM; i += NGT) { const int e = i >> 10, k = i & (DM - 1); const float wv = a.w_r[(size_t)k * NE + e];
          const unsigned hi = cvtpk(wv, 0.f) & 0xffffu; const unsigned lo = cvtpk(wv - __uint_as_float(hi << 16), 0.f) & 0xffffu;
          ((bf16*)(ws + WS_WRT))[i] = (bf16)hi; ((bf16*)(ws + WS_WRT))[NE * DM + i] = (bf16)lo; }
      float* rc = (float*)(ws + WS_ROPEC); float* rs = (float*)(ws + WS_ROPES);
      for (int i = gt; i < T * 32; i += NGT) { const int row = i >> 5, f = i & 31;
          const float inv_freq = exp2f(-(float)f * (13.287712379549449f / 32.0f));   const float ang = (float)a.positions[row] * inv_freq;
          float sn, cs; sincosf(ang, &sn, &cs); rc[i] = cs; rs[i] = sn; } }
}

namespace att {
typedef short bf16x8 __attribute__((ext_vector_type(8)));
typedef short s16x4 __attribute__((ext_vector_type(4)));
typedef float f32x16 __attribute__((ext_vector_type(16)));
typedef short v4i16_t __attribute__((ext_vector_type(4)));
constexpr int LK = 0, LV = 24576, LFLAG = 49152;
__device__ __forceinline__ s16x4 vtr(LAS const unsigned char* p) { return __builtin_bit_cast(s16x4, __builtin_amdgcn_ds_read_tr16_b64_v4i16((LAS v4i16_t*)p)); }
__device__ __forceinline__ int crow(int r, int hi) { return (r & 3) + 8 * (r >> 2) + 4 * hi; }
struct AttnArgs { const bf16* hm; const bf16* rg; bf16* Y; const float* gn_g; const float* gn_b; };

template <int MODE> __device__ __forceinline__ void attn_unit(LAS unsigned char* lds, const AttnArgs& A, int b, int h, int qb) {
    int tid_ = threadIdx.x; asm volatile("" : "+v"(tid_));
    const int tid = tid_, lane = tid & 63, r32 = lane & 31, hh = lane >> 5;
    const int w = __builtin_amdgcn_readfirstlane(tid >> 6);
    const int q0 = qb * 256, qw = q0 + 32 * w;
    const size_t TS = (size_t)T * 512;
    const size_t hoff = (size_t)(b * 8 + h) * SEQ * 64;
    const bf16* Qp = A.hm + (MODE == 0 ? 0 : 3) * TS + hoff;
    const bf16* Kp = A.hm + (MODE == 0 ? 1 : 4) * TS + hoff;
    const bf16* Vp = A.hm + (MODE == 0 ? 2 : 5) * TS + hoff;
    bf16x8 qf[4];
#pragma unroll
    for (int ds = 0; ds < 4; ++ds) qf[ds] = *(const bf16x8*)(Qp + (size_t)(qw + r32) * 64 + 16 * ds + 8 * hh);
    f32x16 o[2];
#pragma unroll
    for (int r = 0; r < 16; ++r) { o[0][r] = 0.f; o[1][r] = 0.f; }
    float carry = 1.0f;
    const int jmax = (q0 + 255) >> 6, jd = (qw + 31) >> 6;
    const float lg2g = __log2f(1.0f - __builtin_amdgcn_exp2f(-5.0f - (float)h));
    const bf16* Kt = Kp + (size_t)lane * 64 + w * 8; const bf16* Vt = Vp + (size_t)w * 512 + lane * 8;
    volatile LAS unsigned* flags = (volatile LAS unsigned*)(lds + LFLAG);
#define ATT_DMA(t, so) do { __builtin_amdgcn_global_load_lds((const unsigned*)(Kt + (size_t)(t) * 4096), (LAS unsigned*)(lds + LK + (so) + w * 1024), 16, 0, 0); \
                            __builtin_amdgcn_global_load_lds((const unsigned*)(Vt + (size_t)(t) * 4096), (LAS unsigned*)(lds + LV + (so) + w * 1024), 16, 0, 0); } while (0)
    ATT_DMA(jmax, 0);
    if (jmax >= 1) { ATT_DMA(jmax - 1, 8192); asm volatile("s_waitcnt vmcnt(2)\n\ts_barrier" ::: "memory"); }
    else asm volatile("s_waitcnt vmcnt(0)\n\ts_barrier" ::: "memory");
    bool finished = false;
    int so_cur = 0, so_new = 16384;
    for (int j = jmax; j >= 0; --j) {
        const int cur = j & 1;
        if (j >= 2) ATT_DMA(j - 2, so_new);
        if (j <= jd && !finished) {
            LAS const unsigned char* Kb = lds + LK + so_cur;
            LAS const unsigned char* Vb = lds + LV + so_cur;
            f32x16 p[2];
#pragma unroll
            for (int r = 0; r < 16; ++r) { p[0][r] = 0.f; p[1][r] = 0.f; }
#pragma unroll
            for (int ds = 0; ds < 4; ++ds) {
                const bf16x8 k0 = *(LAS const bf16x8*)(Kb + (2 * ds + hh) * 1024 + r32 * 16);
                const bf16x8 k1 = *(LAS const bf16x8*)(Kb + (2 * ds + hh) * 1024 + (32 + r32) * 16);
                p[0] = __builtin_amdgcn_mfma_f32_32x32x16_bf16(k0, qf[ds], p[0], 0, 0, 0);
                p[1] = __builtin_amdgcn_mfma_f32_32x32x16_bf16(k1, qf[ds], p[1], 0, 0, 0);
            }
            const bool diag = (j == jd);
            const int qg = qw + r32, kv0 = 64 * j + 4 * hh;
            if (MODE == 0) {
                float om[2][16];
#pragma unroll
                for (int hf = 0; hf < 2; ++hf)
#pragma unroll
                    for (int r = 0; r < 16; ++r) {
                        const float Z = p[hf][r];
                        const float a = __builtin_amdgcn_exp2f(-__builtin_fabsf(Z));
                        const float rc = __builtin_amdgcn_rcpf(1.0f + a), ar = a * rc;
                        const bool pos = Z >= 0.f;
                        const bool valid = !diag || (kv0 + 32 * hf + (r & 3) + 8 * (r >> 2) < qg);
                        const float beta = pos ? rc : ar, omb = pos ? ar : rc;
                        p[hf][r] = valid ? beta : 0.f;
                        om[hf][r] = valid ? omb : 1.0f;
                    }
                float gs[8], ot[8];
#pragma unroll
                for (int m = 0; m < 8; ++m) { const int hf = m >> 2, g = m & 3; gs[m] = (om[hf][4 * g] * om[hf][4 * g + 1]) * (om[hf][4 * g + 2] * om[hf][4 * g + 3]); ot[m] = __shfl_xor(gs[m], 32); }
                float ps[8];
                ps[7] = 1.0f;
#pragma unroll
                for (int m = 6; m >= 0; --m) ps[m] = ps[m + 1] * (gs[m + 1] * ot[m + 1]);
                const float total = ps[0] * (gs[0] * ot[0]);
#pragma unroll
                for (int m = 0; m < 8; ++m) {
                    const int hf = m >> 2, g = m & 3;
                    float tail = carry * (hh ? ps[m] : ps[m] * ot[m]);
#pragma unroll
                    for (int i = 3; i >= 0; --i) { const int r = 4 * g + i; const float o1 = om[hf][r]; p[hf][r] *= tail; tail *= o1; }
                }
                carry *= total;
                finished = __all(carry < 1.0e-37f);
            } else {
                const float ct = __builtin_amdgcn_exp2f(lg2g * (float)(qw - 64 * j));
#pragma unroll
                for (int hf = 0; hf < 2; ++hf)
#pragma unroll
                    for (int r = 0; r < 16; ++r) {
                        const bool valid = !diag || (kv0 + 32 * hf + (r & 3) + 8 * (r >> 2) <= qg);
                        p[hf][r] = valid ? p[hf][r] * ct : 0.f;
                    }
            }
#pragma unroll
            for (int hf = 0; hf < 2; ++hf)
#pragma unroll
                for (int s = 0; s < 2; ++s) {
                    u32x4_t wq;
                    wq.x = pg8::cvt_pk_bf16(p[hf][8 * s + 0], p[hf][8 * s + 1]); wq.y = pg8::cvt_pk_bf16(p[hf][8 * s + 2], p[hf][8 * s + 3]);
                    wq.z = pg8::cvt_pk_bf16(p[hf][8 * s + 4], p[hf][8 * s + 5]); wq.w = pg8::cvt_pk_bf16(p[hf][8 * s + 6], p[hf][8 * s + 7]);
                    const bf16x8 wf = __builtin_bit_cast(bf16x8, wq);
#pragma unroll
                    for (int d0 = 0; d0 < 2; ++d0) {
                        LAS const unsigned char* va = Vb + (32 * hf + 16 * s + 4 * hh + ((lane & 15) >> 2)) * 128 + (32 * d0 + 16 * ((lane >> 4) & 1) + 4 * (lane & 3)) * 2;
                        const s16x4 lo = vtr(va), hi = vtr(va + 8 * 128);
                        const bf16x8 vf = (bf16x8){lo[0], lo[1], lo[2], lo[3], hi[0], hi[1], hi[2], hi[3]};
                        o[d0] = __builtin_amdgcn_mfma_f32_32x32x16_bf16(vf, wf, o[d0], 0, 0, 0);
                    }
                }
        }
        if (MODE == 0) { if (lane == 0) flags[cur * 8 + w] = finished ? 1u : 0u; }
        if (j >= 2) asm volatile("s_waitcnt vmcnt(2) lgkmcnt(0)\n\ts_barrier" ::: "memory"); else asm volatile("s_waitcnt vmcnt(0) lgkmcnt(0)\n\ts_barrier" ::: "memory");
        so_cur = (so_cur == 16384) ? 0 : so_cur + 8192; so_new = (so_new == 16384) ? 0 : so_new + 8192;
        if (MODE == 0) {
            unsigned all = 1u;
#pragma unroll
            for (int i = 0; i < 8; ++i) all &= flags[cur * 8 + i];
            if (all) break;
        }
    }
    asm volatile("s_waitcnt vmcnt(0)\n\ts_barrier" ::: "memory");
#undef ATT_DMA
    const int row = b * SEQ + qw + r32;
    if (MODE == 0) {
        bf16* yp = A.Y + (size_t)row * DM + h * 64 + 4 * hh;
#pragma unroll
        for (int d0 = 0; d0 < 2; ++d0)
#pragma unroll
            for (int g = 0; g < 4; ++g) { u32x2_t v; v.x = pg8::cvt_pk_bf16(o[d0][4 * g], o[d0][4 * g + 1]); v.y = pg8::cvt_pk_bf16(o[d0][4 * g + 2], o[d0][4 * g + 3]); *(u32x2_t*)(yp + 32 * d0 + 8 * g) = v; }
    } else {
        float s1 = 0.f;
#pragma unroll
        for (int r = 0; r < 16; ++r) s1 += o[0][r] + o[1][r];
        s1 += __shfl_xor(s1, 32);
        const float mu = s1 * (1.0f / 64.0f);
        float s2 = 0.f;
#pragma unroll
        for (int r = 0; r < 16; ++r) { const float a0 = o[0][r] - mu, a1 = o[1][r] - mu; s2 += a0 * a0 + a1 * a1; }
        s2 += __shfl_xor(s2, 32);
        const float rstd = rsqrtf(s2 * (1.0f / 64.0f) + EPS);
        bf16* yp = A.Y + (size_t)row * DM + 512 + h * 64 + 4 * hh;
        const bf16* gp = A.rg + (size_t)row * 512 + h * 64 + 4 * hh;
        const float* gg = A.gn_g + h * 64 + 4 * hh; const float* gb = A.gn_b + h * 64 + 4 * hh;
#pragma unroll
        for (int d0 = 0; d0 < 2; ++d0)
#pragma unroll
            for (int g = 0; g < 4; ++g) {
                const f32x4 gn = *(const f32x4*)(gg + 32 * d0 + 8 * g), bs = *(const f32x4*)(gb + 32 * d0 + 8 * g);
                const u32x2_t gr = *(const u32x2_t*)(gp + 32 * d0 + 8 * g);
                float gate[4] = {__uint_as_float(gr.x << 16), __uint_as_float(gr.x & 0xffff0000u), __uint_as_float(gr.y << 16), __uint_as_float(gr.y & 0xffff0000u)};
                float ov[4];
#pragma unroll
                for (int i = 0; i < 4; ++i) { const float yn = (o[d0][4 * g + i] - mu) * rstd * gn[i] + bs[i]; const float sg = gate[i] / (1.0f + __expf(-gate[i])); ov[i] = yn * sg; }
                u32x2_t v; v.x = pg8::cvt_pk_bf16(ov[0], ov[1]); v.y = pg8::cvt_pk_bf16(ov[2], ov[3]); *(u32x2_t*)(yp + 32 * d0 + 8 * g) = v;
            }
    }
}
__device__ __forceinline__ void attn_phase(LAS unsigned char* lds, const AttnArgs& A, int vcu, int dup) {
    const int bh = vcu >> 2, x = vcu & 3, b = bh >> 3, h = bh & 7;
#pragma unroll 1
    for (int u = 0; u < ((dup == 20) ? 4 : 2); ++u) attn_unit<1>(lds, A, b, h, (u & 1) ? x : 7 - x);
#pragma unroll 1
    for (int u = 0; u < ((dup == 21) ? 4 : 2); ++u) attn_unit<0>(lds, A, b, h, (u & 1) ? x : 7 - x);
}
}

constexpr int CW_GCNT = 2048;
constexpr int LR_LCNT = LDSCTL_OFF + 1024, LR_GBASE = LDSCTL_OFF + 1152;
constexpr int LT_POFF = LDSCTL_OFF + 2048, LT_NT = LDSCTL_OFF + 2176, LT_TILE_E = LDSCTL_OFF + 2304;
struct RouteBufs { int* tok_e; int* tok_slot; float* tok_gate; float* rstd; float* slot_rstd; };
__device__ __forceinline__ RouteBufs route_bufs(unsigned char* ws) { RouteBufs r; r.tok_e = (int*)(ws + WS_ROUTE); r.tok_slot = r.tok_e + T * 4; r.tok_gate = (float*)(r.tok_slot + T * 4); r.rstd = (float*)(ws + WS_ROUTE + 1 * MiB); r.slot_rstd = (float*)(ws + WS_ROUTE + 2 * MiB); return r; }
typedef float f32x2v __attribute__((ext_vector_type(2)));
__device__ __forceinline__ unsigned opq_mask(bool c) { unsigned m = c ? 0xffffffffu : 0u; asm volatile("" : "+v"(m)); return m; }
__device__ __forceinline__ float blendf(unsigned m, float a, float b) { return __uint_as_float((__float_as_uint(a) & m) | (__float_as_uint(b) & ~m)); }
__device__ __forceinline__ int blendi(unsigned m, int a, int b) { return (int)(((unsigned)a & m) | ((unsigned)b & ~m)); }

#define SW2(c, a, b) { const float ta_ = (c) ? (b) : (a), tb_ = (c) ? (a) : (b); a = ta_; b = tb_; }
#define SW2I(c, a, b) { const int ta_ = (c) ? (b) : (a), tb_ = (c) ? (a) : (b); a = ta_; b = tb_; }
#define TOP4_INSERT(x, e) { const float x_ = (x); const int e_ = (e); const bool c3_ = (x_ > v3) || (x_ == v3 && e_ < i3); v3 = c3_ ? x_ : v3; i3 = c3_ ? e_ : i3; \
    const bool c2_ = (v3 > v2) || (v3 == v2 && i3 < i2); SW2(c2_, v2, v3) SW2I(c2_, i2, i3) const bool c1_ = (v2 > v1) || (v2 == v1 && i2 < i1); SW2(c1_, v1, v2) SW2I(c1_, i1, i2) \
    const bool c0_ = (v1 > v0) || (v1 == v0 && i1 < i0); SW2(c0_, v0, v1) SW2I(c0_, i0, i1) }
__device__ __forceinline__ void router_phase(Frame& F, const Args& a, const bool dry = false) {
    unsigned char* ws = a.ws; const int tid = tid_now();
    LAS unsigned char* lds = F.lds;
    const int lane = tid & 63, r32 = lane & 31, hh = lane >> 5, w = F.wave, rg = w >> 2, kq = w & 3;
    volatile LAS unsigned* lcnt = (volatile LAS unsigned*)(lds + LR_LCNT);
    volatile LAS unsigned* gbase = (volatile LAS unsigned*)(lds + LR_GBASE);
    if (tid < 32) lcnt[tid] = 0u;
    const RouteBufs R = route_bufs(dry ? ws + 3 * MiB : ws);
    const int row = F.vcu * 64 + 32 * rg + r32;
    const float* xr = a.out + (size_t)row * DM + 256 * kq + 8 * hh;
    const float* gr = a.g_ffn + 256 * kq + 8 * hh;
    const bf16* wt = (const bf16*)(ws + WS_WRT) + (size_t)r32 * DM + 256 * kq + 8 * hh;
    unsigned char* hp = (unsigned char*)(ws + (dry ? WS_H : WS_XN)) + (size_t)row * DM + 256 * kq + 8 * hh;
    att::f32x16 D;
#pragma unroll
    for (int r = 0; r < 16; ++r) D[r] = 0.f;
    float ss = 0.f;
#pragma unroll 4
    for (int ks = 0; ks < 16; ++ks) {
        const f32x4 x0 = *(const f32x4*)(xr + 16 * ks), x1 = *(const f32x4*)(xr + 16 * ks + 4);
        const f32x4 g0 = *(const f32x4*)(gr + 16 * ks), g1 = *(const f32x4*)(gr + 16 * ks + 4);
        ss += ((x0[0] * x0[0] + x0[1] * x0[1]) + (x0[2] * x0[2] + x0[3] * x0[3])) + ((x1[0] * x1[0] + x1[1] * x1[1]) + (x1[2] * x1[2] + x1[3] * x1[3]));
        const f32x4 v0 = x0 * g0, v1 = x1 * g1;
        u32x2_t h8; h8.x = pk4_fp8(v0[0], v0[1], v0[2], v0[3]); h8.y = pk4_fp8(v1[0], v1[1], v1[2], v1[3]); *(u32x2_t*)(hp + 16 * ks) = h8;
        u32x4_t xh, xl;
        xh.x = cvtpk(v0[0], v0[1]); xh.y = cvtpk(v0[2], v0[3]); xh.z = cvtpk(v1[0], v1[1]); xh.w = cvtpk(v1[2], v1[3]);
        xl.x = cvtpk(v0[0] - __uint_as_float(xh.x << 16), v0[1] - __uint_as_float(xh.x & 0xffff0000u)); xl.y = cvtpk(v0[2] - __uint_as_float(xh.y << 16), v0[3] - __uint_as_float(xh.y & 0xffff0000u));
        xl.z = cvtpk(v1[0] - __uint_as_float(xh.z << 16), v1[1] - __uint_as_float(xh.z & 0xffff0000u)); xl.w = cvtpk(v1[2] - __uint_as_float(xh.w << 16), v1[3] - __uint_as_float(xh.w & 0xffff0000u));
        const att::bf16x8 whi = *(const att::bf16x8*)(wt + 16 * ks), wlo = *(const att::bf16x8*)(wt + 32 * DM + 16 * ks);
        const att::bf16x8 bxh = __builtin_bit_cast(att::bf16x8, xh), bxl = __builtin_bit_cast(att::bf16x8, xl);
        D = __builtin_amdgcn_mfma_f32_32x32x16_bf16(whi, bxh, D, 0, 0, 0);
        D = __builtin_amdgcn_mfma_f32_32x32x16_bf16(wlo, bxh, D, 0, 0, 0);
        D = __builtin_amdgcn_mfma_f32_32x32x16_bf16(whi, bxl, D, 0, 0, 0);
    }
    { LAS f32x4* dp = (LAS f32x4*)(lds + (w * 64 + lane) * 64);
#pragma unroll
      for (int q = 0; q < 4; ++q) dp[q] = (f32x4){D[4 * q], D[4 * q + 1], D[4 * q + 2], D[4 * q + 3]};
      *(LAS float*)(lds + 32768 + (w * 64 + lane) * 4) = ss; }
    __syncthreads();
    int my_e0 = 0, my_e1 = 0, rk0 = 0, rk1 = 0; float my_g0 = 0.f, my_g1 = 0.f;
    if (kq == 0) {
#pragma unroll
        for (int o = 1; o < 4; ++o) { LAS const f32x4* dp = (LAS const f32x4*)(lds + ((w + o) * 64 + lane) * 64);
#pragma unroll
            for (int q = 0; q < 4; ++q) { const f32x4 t = dp[q]; D[4 * q] += t[0]; D[4 * q + 1] += t[1]; D[4 * q + 2] += t[2]; D[4 * q + 3] += t[3]; }
            ss += *(LAS const float*)(lds + 32768 + ((w + o) * 64 + lane) * 4); }
        ss += __shfl_xor(ss, 32);
        const float rstd = rsqrtf(ss * (1.f / DM) + EPS);
        if (hh == 0) R.rstd[row] = rstd;
        float l[16];
#pragma unroll
        for (int r = 0; r < 16; ++r) l[r] = D[r] * rstd + a.b_r[(r & 3) + 8 * (r >> 2) + 4 * hh];
        float c[8]; int ci[8];
#pragma unroll
        for (int k = 0; k < 4; ++k) {
            float bv = -INFINITY; int bi = 99;
#pragma unroll
            for (int r = 0; r < 16; ++r) { const int e = (r & 3) + 8 * (r >> 2) + 4 * hh; const bool bt = l[r] > bv; bv = bt ? l[r] : bv; bi = bt ? e : bi; }
            c[k] = bv; ci[k] = bi;
#pragma unroll
            for (int r = 0; r < 16; ++r) { const int e = (r & 3) + 8 * (r >> 2) + 4 * hh; l[r] = (e == bi) ? -INFINITY : l[r]; }
        }
#pragma unroll
        for (int k = 0; k < 4; ++k) { c[4 + k] = __shfl_xor(c[k], 32); ci[4 + k] = __shfl_xor(ci[k], 32); }
        float tv[4]; int ti[4];
#pragma unroll
        for (int k = 0; k < 4; ++k) {
            float bv = -INFINITY; int bi = 99;
#pragma unroll
            for (int j = 0; j < 8; ++j) { const bool bt = (c[j] > bv) || (c[j] == bv && ci[j] < bi); bv = bt ? c[j] : bv; bi = bt ? ci[j] : bi; }
            tv[k] = bv; ti[k] = bi;
#pragma unroll
            for (int j = 0; j < 8; ++j) c[j] = (ci[j] == bi) ? -INFINITY : c[j];
        }
        const float v0 = tv[0], v1 = tv[1], v2 = tv[2], v3 = tv[3]; const int i0 = ti[0], i1 = ti[1], i2 = ti[2], i3 = ti[3];
        const float e1 = __expf(v1 - v0), e2 = __expf(v2 - v0), e3 = __expf(v3 - v0), inv = 1.0f / (1.0f + e1 + e2 + e3);
        my_e0 = hh ? i2 : i0; my_e1 = hh ? i3 : i1; my_g0 = (hh ? e2 : 1.0f) * inv; my_g1 = (hh ? e3 : e1) * inv;
        rk0 = (int)__hip_atomic_fetch_add((LAS unsigned*)(lds + LR_LCNT) + my_e0, 1u, __ATOMIC_RELAXED, __HIP_MEMORY_SCOPE_WORKGROUP);
        rk1 = (int)__hip_atomic_fetch_add((LAS unsigned*)(lds + LR_LCNT) + my_e1, 1u, __ATOMIC_RELAXED, __HIP_MEMORY_SCOPE_WORKGROUP);
    }
    __syncthreads();
    if (tid < 32) gbase[tid] = __hip_atomic_fetch_add((unsigned*)(F.ctl + CW_GCNT + (dry ? 64 : 0)) + tid, lcnt[tid], __ATOMIC_RELAXED, __HIP_MEMORY_SCOPE_AGENT);
    __syncthreads();
    if (kq == 0) {
        const int k0 = 2 * hh;
        R.tok_e[row * 4 + k0] = my_e0; R.tok_slot[row * 4 + k0] = (int)gbase[my_e0] + rk0; R.tok_gate[row * 4 + k0] = my_g0;
        R.tok_e[row * 4 + k0 + 1] = my_e1; R.tok_slot[row * 4 + k0 + 1] = (int)gbase[my_e1] + rk1; R.tok_gate[row * 4 + k0 + 1] = my_g1;
    }
}
#undef SW2
#undef SW2I
#undef TOP4_INSERT

__device__ __forceinline__ void build_tables(Frame& F) {
    LAS int* poff = (LAS int*)(F.lds + LT_POFF); LAS int* ntp = (LAS int*)(F.lds + LT_NT); LAS int* tile_e = (LAS int*)(F.lds + LT_TILE_E);
    LAS int* cnts = (LAS int*)(F.lds + LR_LCNT); const int tid = tid_now();
    if (tid < NE) cnts[tid] = (int)__hip_atomic_load((unsigned*)(F.ctl + CW_GCNT) + tid, __ATOMIC_RELAXED, __HIP_MEMORY_SCOPE_AGENT);
    __syncthreads();
    if (tid == 0) {
        int t = 0;
        for (int e = 0; e < NE; ++e) { const int c = cnts[e]; const int nt = (c + 255) >> 8; poff[e] = t * 256; for (int i = 0; i < nt; ++i) tile_e[t + i] = e; t += nt; }
        *ntp = t;
    }
    __syncthreads();
}
__device__ __forceinline__ void gather_phase(Frame& F, const Args& a) {
    unsigned char* ws = a.ws; const int lane = tid_now() & 63; const RouteBufs R = route_bufs(ws);
    LAS const int* poff = (LAS const int*)(F.lds + LT_POFF);
    const int gw = F.vcu * NWAVES + F.wave, NGW = F.G * NWAVES;
    for (int m = gw; m < T; m += NGW) {
        const v4u* src = (const v4u*)((const unsigned char*)(ws + WS_XN) + (size_t)m * DM);
        const v4u h0 = src[lane]; const float rs = R.rstd[m];
#pragma unroll
        for (int k = 0; k < 4; ++k) { const int e = R.tok_e[m * 4 + k], slot = R.tok_slot[m * 4 + k];
            v4u* dst = (v4u*)((unsigned char*)(ws + WS_XS) + (size_t)(poff[e] + slot) * DM); dst[lane] = h0; if (lane == 0) R.slot_rstd[poff[e] + slot] = rs; }
    }
}
__device__ __forceinline__ void combine_phase(Frame& F, const Args& a, const bool dry = false) {
    unsigned char* ws = a.ws; const RouteBufs R = route_bufs(ws);
    LAS const int* poff = (LAS const int*)(F.lds + LT_POFF);
    const int gw = F.vcu * NWAVES + F.wave, NGW = F.G * NWAVES, lane = tid_now() & 63;
    for (int m0 = 2 * gw; m0 < T; m0 += 2 * NGW) {
        f32x4 v[2][2][2]; u32x2_t y[2][4][2]; float gt[2][4];
#pragma unroll
        for (int rr = 0; rr < 2; ++rr) { const int m = m0 + rr;
#pragma unroll
            for (int i = 0; i < 2; ++i) { v[rr][i][0] = *(const f32x4*)(a.out + (size_t)m * DM + 8 * lane + 512 * i); v[rr][i][1] = *(const f32x4*)(a.out + (size_t)m * DM + 8 * lane + 512 * i + 4); }
#pragma unroll
            for (int k = 0; k < 4; ++k) { const int e = R.tok_e[m * 4 + k], slot = R.tok_slot[m * 4 + k]; gt[rr][k] = R.tok_gate[m * 4 + k];
                const unsigned char* yr = (const unsigned char*)(ws + WS_YS) + (size_t)(poff[e] + slot) * DM + 8 * lane;
                y[rr][k][0] = *(const u32x2_t*)yr; y[rr][k][1] = *(const u32x2_t*)(yr + 512); } }
#pragma unroll
        for (int rr = 0; rr < 2; ++rr) { const int m = m0 + rr;
#pragma unroll
            for (int k = 0; k < 4; ++k)
#pragma unroll
                for (int i = 0; i < 2; ++i) { const u32x2_t yy = y[rr][k][i]; const float g = gt[rr][k];
                    const f32x2v a0 = __builtin_amdgcn_cvt_pk_f32_fp8((int)yy.x, false), a1 = __builtin_amdgcn_cvt_pk_f32_fp8((int)yy.x, true), a2 = __builtin_amdgcn_cvt_pk_f32_fp8((int)yy.y, false), a3 = __builtin_amdgcn_cvt_pk_f32_fp8((int)yy.y, true);
                    v[rr][i][0][0] += g * a0[0]; v[rr][i][0][1] += g * a0[1]; v[rr][i][0][2] += g * a1[0]; v[rr][i][0][3] += g * a1[1];
                    v[rr][i][1][0] += g * a2[0]; v[rr][i][1][1] += g * a2[1]; v[rr][i][1][2] += g * a3[0]; v[rr][i][1][3] += g * a3[1]; }
            float ss = 0.f;
#pragma unroll
            for (int i = 0; i < 2; ++i)
#pragma unroll
                for (int q = 0; q < 2; ++q) { const f32x4 t = v[rr][i][q]; ss += (t[0] * t[0] + t[1] * t[1]) + (t[2] * t[2] + t[3] * t[3]); }
            const float rstd = rsqrtf(wave_sum(ss) * (1.f / DM) + EPS);
            unsigned char* np = (unsigned char*)(ws + (dry ? WS_H : WS_XN)) + (size_t)m * DM + 8 * lane; float* ow = dry ? (float*)(ws + WS_XS) : a.out;
#pragma unroll
            for (int i = 0; i < 2; ++i) { *(f32x4*)(ow + (size_t)m * DM + 8 * lane + 512 * i) = v[rr][i][0]; *(f32x4*)(ow + (size_t)m * DM + 8 * lane + 512 * i + 4) = v[rr][i][1];
                const f32x4 g0 = *(const f32x4*)(a.g_ple + 8 * lane + 512 * i), g1 = *(const f32x4*)(a.g_ple + 8 * lane + 512 * i + 4);
                u32x2_t o; o.x = pk4_fp8(v[rr][i][0][0] * rstd * g0[0], v[rr][i][0][1] * rstd * g0[1], v[rr][i][0][2] * rstd * g0[2], v[rr][i][0][3] * rstd * g0[3]);
                o.y = pk4_fp8(v[rr][i][1][0] * rstd * g1[0], v[rr][i][1][1] * rstd * g1[1], v[rr][i][1][2] * rstd * g1[2], v[rr][i][1][3] * rstd * g1[3]);
                *(u32x2_t*)(np + 512 * i) = o; } }
    }
}

__global__ void __launch_bounds__(NWAVES * 64, 2) mega_fwd(Args args) {
    extern __shared__ __attribute__((aligned(16))) unsigned char lds[];
    Frame F;
    F.lds = (LAS unsigned char*)lds;
    F.MISC = (volatile LAS unsigned*)(F.lds + MISC_OFF);
    F.wave = __builtin_amdgcn_readfirstlane(threadIdx.x >> 6);
    F.G = gridDim.x; { const int bx = blockIdx.x; F.vcu = (F.G % 8 == 0) ? (bx % 8) * (F.G / 8) + bx / 8 : bx; }
    unsigned char* ws = args.ws;
    F.ctl = (gu32*)(ws + WS_CTL);
    for (int u = threadIdx.x; u < (LDS_BYTES - LDSCTL_OFF) / 4; u += NWAVES * 64) ((LAS unsigned*)(F.lds + LDSCTL_OFF))[u] = 0u;
    __syncthreads();
    XcdBarrier bar = xcd_barrier_post((unsigned*)(F.ctl + CW_BAR), F.MISC + 8);
    const int lo = args.ph_lo, hi = args.ph_hi;
#define IN(k) (lo <= (k) && (k) < hi)
#define GRID_BAR() xcd_barrier(bar)
#ifndef DUP_PHASE
#define DUP_PHASE -1
#endif
#define REP(k) for (int rep_ = 0; rep_ < ((DUP_PHASE) == (k) ? 2 : 1); ++rep_)

    if (IN(0)) { if (DUP_PHASE == 40) { p0_prologue(F, args, 1); GRID_BAR(); } if (DUP_PHASE == 41) { p0_prologue(F, args, 2); GRID_BAR(); } if (DUP_PHASE == 42) { p0_prologue(F, args, 3); GRID_BAR(); } REP(0) { p0_prologue(F, args); GRID_BAR(); } }

    if (IN(1)) REP(1) {
        pg8::Gemm g{(const pg8::bf16_t*)(ws + WS_XN), (const pg8::bf16_t*)(ws + WS_WT_IN), DM, 0};
        pg8::StaticOrder S; S.init(T / 256, DIN / 256, F.G, (int)blockIdx.x);
        pg8::EpiProj E{(pg8::bf16_t*)(ws + WS_HM), (pg8::bf16_t*)(ws + WS_RG), (const float*)(ws + WS_GAINS), (const float*)(ws + WS_ROPEC), (const float*)(ws + WS_ROPES)};
        pg8::gemm_phase<pg8::EpiProj, pg8::StaticOrder, true, true>(F.lds + RING_OFF, g, S, E);
        {
            const int G2 = (F.G == 256) ? 128 : F.G, c2 = (F.G == 256) ? (int)blockIdx.x - 128 : (int)blockIdx.x;
            if (c2 >= 0) {
                pg8::Gemm g2{(const pg8::bf16_t*)(ws + WS_PB), (const pg8::bf16_t*)(ws + WS_WT_PP), PLE, 0};
                pg8::StaticOrder S2; S2.init(T / 256, DM / 256, G2, c2);
                pg8::EpiBf16Plain E2{(pg8::bf16_t*)(ws + WS_PJ), DM};
                pg8::gemm_phase<pg8::EpiBf16Plain, pg8::StaticOrder, true, true>(F.lds + RING_OFF, g2, S2, E2);
            }
        }
        GRID_BAR();
    }
    if (IN(2)) REP(2) {
        if (F.G == 256) {
            const att::AttnArgs AA{(const bf16*)(ws + WS_HM), (const bf16*)(ws + WS_RG), (bf16*)(ws + WS_Y), args.gn_g, args.gn_b};
            att::attn_phase(F.lds + RING_OFF, AA, F.vcu, DUP_PHASE);
        }
        GRID_BAR();
    }
    if (IN(3)) REP(3) {
        pg8::Gemm g{(const pg8::bf16_t*)(ws + WS_Y), (const pg8::bf16_t*)(ws + WS_WT_OUT), DM, 0};
        pg8::StaticOrder S; S.init(T / 256, DM / 256, F.G, (int)blockIdx.x);
        pg8::EpiResid E{args.x, args.out};
        pg8::gemm_phase<pg8::EpiResid, pg8::StaticOrder, true, true>(F.lds + RING_OFF, g, S, E);
        GRID_BAR();
    }
    if (DUP_PHASE == 30 && IN(3)) { GRID_BAR(); GRID_BAR(); GRID_BAR(); GRID_BAR(); }
    if (IN(4)) { if (DUP_PHASE == 4) { if (F.G == 256) router_phase(F, args, true); GRID_BAR(); } if (F.G == 256) router_phase(F, args); GRID_BAR(); }
    if (IN(5) || (lo >= 6 && lo <= 8)) build_tables(F);
    if (IN(5)) REP(5) { gather_phase(F, args); GRID_BAR(); }
    if (IN(6)) REP(6) {
        const int NT = *(LAS const int*)(F.lds + LT_NT);
        pg8::Gemm g{(const pg8::bf16_t*)(ws + WS_XS), (const pg8::bf16_t*)(ws + WS_WT_UG), DM / 2, (size_t)2048 * DM};
        pg8::MoeOrder S; S.init(NT, 8, F.G, (int)blockIdx.x, (LAS const int*)(F.lds + LT_TILE_E));
        pg8::EpiMoeUp E{(unsigned char*)(ws + WS_H), args.b_ug, route_bufs(ws).slot_rstd};
        pg8::gemm_phase<pg8::EpiMoeUp, pg8::MoeOrder, true, true, true>(F.lds + RING_OFF, g, S, E);
        GRID_BAR();
    }
    if (IN(7)) REP(7) {
        const int NT = *(LAS const int*)(F.lds + LT_NT);
        pg8::Gemm g{(const pg8::bf16_t*)(ws + WS_H), (const pg8::bf16_t*)(ws + WS_WT_DN), DM / 2, (size_t)DM * DM};
        pg8::MoeOrder S; S.init(NT, 4, F.G, (int)blockIdx.x, (LAS const int*)(F.lds + LT_TILE_E));
        pg8::EpiMoeDown E{(unsigned char*)(ws + WS_YS), args.b_dn};
        pg8::gemm_phase<pg8::EpiMoeDown, pg8::MoeOrder, true, true, true>(F.lds + RING_OFF, g, S, E);
        GRID_BAR();
    }
    if (IN(8)) { if (DUP_PHASE == 8) { combine_phase(F, args, true); GRID_BAR(); } combine_phase(F, args); GRID_BAR(); }
    if (IN(9)) {
        pg8::Gemm g{(const pg8::bf16_t*)(ws + WS_XN), (const pg8::bf16_t*)(ws + WS_WT_PG), DM / 2, 0};
        pg8::StaticOrder S; S.init(T / 256, DM / 256, F.G, (int)blockIdx.x);
        if (DUP_PHASE == 9) { pg8::EpiPle E0{args.out, (const pg8::bf16_t*)(ws + WS_PJ), (float*)(ws + WS_XS)}; pg8::gemm_phase<pg8::EpiPle, pg8::StaticOrder, true, true, true>(F.lds + RING_OFF, g, S, E0); }
        pg8::EpiPle E{args.out, (const pg8::bf16_t*)(ws + WS_PJ), args.out};
        pg8::gemm_phase<pg8::EpiPle, pg8::StaticOrder, true, true, true>(F.lds + RING_OFF, g, S, E);
    }
#undef IN
}
extern "C" void kernel_launch(void* const* d_in, const int* in_sizes, int n_in, void* d_out, int out_size, void* d_ws, size_t ws_size, hipStream_t stream) {
    static int grid = 0;
    if (grid == 0) {
        if (n_in != 22 || ws_size < 1024 * MiB) { fprintf(stderr, "kernel_launch: unexpected n_in %d / ws %zu\n", n_in, ws_size); grid = -1; return; }
        int dev = 0, cus = 0, per_cu = 0;
        if (hipGetDevice(&dev) != hipSuccess || hipDeviceGetAttribute(&cus, hipDeviceAttributeMultiprocessorCount, dev) != hipSuccess) { grid = -1; return; }
        if (hipFuncSetAttribute((const void*)mega_fwd, hipFuncAttributeMaxDynamicSharedMemorySize, LDS_BYTES) != hipSuccess) { fprintf(stderr, "kernel_launch: hipFuncSetAttribute failed\n"); grid = -1; return; }
        if (hipOccupancyMaxActiveBlocksPerMultiprocessor(&per_cu, (const void*)mega_fwd, NWAVES * 64, LDS_BYTES) != hipSuccess || per_cu < 1) { fprintf(stderr, "kernel_launch: occupancy query says %d\n", per_cu); per_cu = 1; }
        (void)hipGetLastError();
        grid = cus;
    }
    if (grid < 0) return;
    (void)hipMemsetAsync((char*)d_ws + WS_CTL, 0, CTL_ZERO_BYTES, stream);
    Args a{};
    a.x = (const float*)d_in[0]; a.p = (const float*)d_in[1]; a.positions = (const int*)d_in[2]; a.g_mix = (const float*)d_in[3]; a.w_in = (const float*)d_in[4];
    a.sbq = (const float*)d_in[5]; a.sbk = (const float*)d_in[6]; a.rq = (const float*)d_in[7]; a.rk = (const float*)d_in[8]; a.gn_g = (const float*)d_in[9]; a.gn_b = (const float*)d_in[10];
    a.w_out = (const float*)d_in[11]; a.g_ffn = (const float*)d_in[12]; a.w_r = (const float*)d_in[13]; a.b_r = (const float*)d_in[14]; a.w_ug = (const float*)d_in[15]; a.b_ug = (const float*)d_in[16];
    a.w_dn = (const float*)d_in[17]; a.b_dn = (const float*)d_in[18]; a.g_ple = (const float*)d_in[19]; a.w_pg = (const float*)d_in[20]; a.w_pp = (const float*)d_in[21];
    a.out = (float*)d_out; a.ws = (unsigned char*)d_ws; a.ph_lo = 0; a.ph_hi = 10;
    hipLaunchKernelGGL(mega_fwd, dim3(grid), dim3(NWAVES * 64), LDS_BYTES, stream, a);

}
```

```cpp
#include <hip/hip_runtime.h>
#include <cstdint>
#include <cstdio>
#include <cmath>

namespace pg8 {
#define PG8_LAS __attribute__((address_space(3)))
typedef unsigned short bf16_t;
typedef short bf16x8 __attribute__((ext_vector_type(8)));
typedef float f32x4 __attribute__((ext_vector_type(4)));
typedef unsigned u32x4 __attribute__((ext_vector_type(4)));
typedef unsigned u32x2 __attribute__((ext_vector_type(2)));
typedef int v4i32 __attribute__((ext_vector_type(4)));
typedef int v8i32 __attribute__((ext_vector_type(8)));
constexpr int BM = 256, BK = 64, HALF = 128, HTB = HALF * BK * 2  , STAGE_BYTES = 8 * HTB, NXCD = 8, WGM = 8;

__host__ __device__ __forceinline__ int lds_byte(int r, int c) { const int st = (r >> 4) * 2 + (c >> 5), rr = r & 15, cc = c & 31, ob = rr * 64 + cc * 2; return st * 1024 + (ob ^ (((ob >> 9) & 1) << 5)); }
__host__ __device__ __forceinline__ void stage_rc(int b, int& R, int& C) { const int st = b / 1024, sb = b % 1024, swz = sb ^ (((sb >> 9) & 1) << 5); R = (st >> 1) * 16 + swz / 64; C = (st & 1) * 32 + (swz % 64) / 2; }
__host__ __device__ __forceinline__ int perm32(int rho) { const int n = rho >> 4, i = rho & 15; return 8 * (i >> 2) + 4 * n + (i & 3); }

struct Unit { int pm, pn, e; };
struct Gemm { const bf16_t* A; const bf16_t* Bt; int K; size_t strideBe; };

struct StaticOrder {
    int nM, nN, nwg, G, c;
    __host__ __device__ void init(int nM_, int nN_, int G_, int c_) { nM = nM_; nN = nN_; nwg = nM * nN; G = G_; c = c_; }
    __host__ __device__ bool next(int i, Unit& u) const {
        const long L = (long)i * G + c; if (L >= nwg) return false;
        int wgid = (int)L; { const int q = nwg / NXCD, r = nwg % NXCD, xcd = wgid % NXCD, off = wgid / NXCD; wgid = (xcd < r ? xcd * (q + 1) : r * (q + 1) + (xcd - r) * q) + off; }
        const int nig = WGM * nN, gid = wgid / nig, fm = gid * WGM, gsz = (nM - fm) < WGM ? (nM - fm) : WGM;
        u.pm = fm + ((wgid % nig) % gsz); u.pn = (wgid % nig) / gsz; u.e = 0; return true;
    }
    __device__ __forceinline__ void a_ready(const Unit&) const {}
    __device__ __forceinline__ void done(const Unit&) const {}
};

typedef float f32x2_t __attribute__((ext_vector_type(2))); typedef __bf16 bf16x2_t __attribute__((ext_vector_type(2)));
__device__ __forceinline__ unsigned cvt_pk_bf16(float lo, float hi) { f32x2_t v = {lo, hi}; bf16x2_t b = __builtin_convertvector(v, bf16x2_t); return __builtin_bit_cast(unsigned, b); }

constexpr int T = 16384, SEQ = 2048, DM = 1024, DIN = 3584;
constexpr float EPS = 1e-6f;
__device__ __forceinline__ u32x4 pack8(const f32x4 a, const f32x4 b) { u32x4 w; w.x = cvt_pk_bf16(a[0], a[1]); w.y = cvt_pk_bf16(a[2], a[3]); w.z = cvt_pk_bf16(b[0], b[1]); w.w = cvt_pk_bf16(b[2], b[3]); return w; }

struct EpiProj {
    static constexpr bool PERM = true, AFTER_DRAIN = false;
    bf16_t* hm;
    bf16_t* rg;
    const float* gains;
    const float *ropec, *ropes;
    __device__ __forceinline__ void operator()(const f32x4 (&acc)[2][2][4][2], const Unit& u, int wr, int wc, int fr, int fq) const {
        const int region = u.pn >> 1, hb = 4 * (u.pn & 1) + wc;
        const bool normed = (region == 0) || (region == 1) || (region == 3) || (region == 4);
        const bool rope = (region == 3) || (region == 4);
        const int gidx = region == 0 ? 0 : region == 1 ? 1 : region == 3 ? 2 : 3;
        const float* gp = gains + gidx * 64;
        f32x4 gv[2][2];
#pragma unroll
        for (int bj = 0; bj < 2; ++bj)
#pragma unroll
            for (int n = 0; n < 2; ++n) gv[bj][n] = normed ? *(const f32x4*)(gp + 32 * bj + 8 * fq + 4 * n) : (f32x4){1.f, 1.f, 1.f, 1.f};
        const float lg2g = __log2f(1.0f - __builtin_amdgcn_exp2f(-5.0f - (float)hb));
        const float scale = region == 0 ? 0.125f * 1.4426950408889634f : region == 4 ? 0.125f : 1.0f;
#pragma unroll
        for (int ai = 0; ai < 2; ++ai)
#pragma unroll
            for (int m = 0; m < 4; ++m) {
                const int row = u.pm * BM + ai * HALF + wr * 64 + m * 16 + fr;
                const int b = row >> 11, s = row & (SEQ - 1);
                f32x4 v[2][2];
#pragma unroll
                for (int bj = 0; bj < 2; ++bj)
#pragma unroll
                    for (int n = 0; n < 2; ++n) v[bj][n] = acc[ai][bj][m][n];
                if (normed) {
                    float ss = 0.f;
#pragma unroll
                    for (int bj = 0; bj < 2; ++bj)
#pragma unroll
                        for (int n = 0; n < 2; ++n) { const f32x4 x = v[bj][n]; ss += (x[0] * x[0] + x[1] * x[1]) + (x[2] * x[2] + x[3] * x[3]); }
                    ss += __shfl_xor(ss, 16); ss += __shfl_xor(ss, 32);
                    float rs = rsqrtf(ss * (1.0f / 64.0f) + EPS) * scale;
                    if (rope) rs *= (region == 3) ? __builtin_amdgcn_exp2f((float)(s & 31) * lg2g) : __builtin_amdgcn_exp2f(-(float)(s & 63) * lg2g);
#pragma unroll
                    for (int bj = 0; bj < 2; ++bj)
#pragma unroll
                        for (int n = 0; n < 2; ++n) v[bj][n] = v[bj][n] * rs * gv[bj][n];
                    if (rope) {
#pragma unroll
                        for (int n = 0; n < 2; ++n) {
                            const f32x4 c = *(const f32x4*)(ropec + (size_t)row * 32 + 8 * fq + 4 * n), sn = *(const f32x4*)(ropes + (size_t)row * 32 + 8 * fq + 4 * n);
                            const f32x4 lo = v[0][n], hi = v[1][n];
                            v[0][n] = lo * c - hi * sn; v[1][n] = hi * c + lo * sn;
                        }
                    }
                }
                bf16_t* dst = (region < 6) ? hm + (size_t)region * ((size_t)T * 512) + ((size_t)(b * 8 + hb) * SEQ + s) * 64 + 8 * fq
                                           : rg + (size_t)row * 512 + hb * 64 + 8 * fq;
#pragma unroll
                for (int bj = 0; bj < 2; ++bj) *(u32x4*)(dst + 32 * bj) = pack8(v[bj][0], v[bj][1]);
            }
    }
};

struct EpiBf16Plain {
    static constexpr bool PERM = true, AFTER_DRAIN = false;
    bf16_t* O; int ldc;
    __device__ __forceinline__ void operator()(const f32x4 (&acc)[2][2][4][2], const Unit& u, int wr, int wc, int fr, int fq) const {
        const int row0 = u.pm * BM + wr * 64 + fr, col0 = u.pn * BM + wc * 32 + 8 * fq;
#pragma unroll
        for (int ai = 0; ai < 2; ++ai)
#pragma unroll
            for (int m = 0; m < 4; ++m) { bf16_t* rowp = O + (size_t)(row0 + ai * HALF + m * 16) * ldc + col0;
#pragma unroll
                for (int bj = 0; bj < 2; ++bj) *(u32x4*)(rowp + bj * HALF) = pack8(acc[ai][bj][m][0], acc[ai][bj][m][1]); }
    }
};
struct EpiResid {
    static constexpr bool PERM = false, AFTER_DRAIN = false;
    const float* base; float* out;
    __device__ __forceinline__ void operator()(const f32x4 (&acc)[2][2][4][2], const Unit& u, int wr, int wc, int fr, int fq) const {
        const int col0 = u.pn * BM + wc * 32 + 4 * fq;
#pragma unroll
        for (int ai = 0; ai < 2; ++ai)
#pragma unroll
            for (int m = 0; m < 4; ++m) { const size_t off = (size_t)(u.pm * BM + ai * HALF + wr * 64 + m * 16 + fr) * DM + col0;
#pragma unroll
                for (int bj = 0; bj < 2; ++bj)
#pragma unroll
                    for (int n = 0; n < 2; ++n) { const f32x4 bs = *(const f32x4*)(base + off + bj * HALF + n * 16); *(f32x4*)(out + off + bj * HALF + n * 16) = bs + acc[ai][bj][m][n]; } }
    }
};
struct EpiMoeUp {
    static constexpr bool PERM = true, AFTER_DRAIN = false;
    unsigned char* H; const float* bias; const float* srstd;
    __device__ __forceinline__ void operator()(const f32x4 (&acc)[2][2][4][2], const Unit& u, int wr, int wc, int fr, int fq) const {
        const int cc = 128 * u.pn + 32 * wc + 8 * fq;
        const float* bp = bias + (size_t)u.e * 2048 + cc;
        f32x4 bg[2], bl[2];
#pragma unroll
        for (int n = 0; n < 2; ++n) { bg[n] = *(const f32x4*)(bp + 4 * n); bl[n] = *(const f32x4*)(bp + 1024 + 4 * n); }
#pragma unroll
        for (int ai = 0; ai < 2; ++ai)
#pragma unroll
            for (int m = 0; m < 4; ++m) {
                f32x4 hv[2]; const float sc = srstd[u.pm * BM + ai * HALF + wr * 64 + m * 16 + fr] * 0.015625f;
#pragma unroll
                for (int n = 0; n < 2; ++n) {
                    const f32x4 g0 = acc[ai][0][m][n] * sc + bg[n], l0 = acc[ai][1][m][n] * sc + bl[n];
#pragma unroll
                    for (int j = 0; j < 4; ++j) {
                        const float glu = __builtin_fminf(g0[j], 7.0f), lin = __builtin_fminf(__builtin_fmaxf(l0[j], -7.0f), 7.0f);
                        const float sg = __builtin_amdgcn_rcpf(1.0f + __builtin_amdgcn_exp2f(-1.702f * 1.4426950408889634f * glu));
                        hv[n][j] = glu * sg * (lin + 1.0f);
                    }
                }
                u32x2 hq; hq.x = (unsigned)__builtin_amdgcn_cvt_pk_fp8_f32(hv[0][0], hv[0][1], 0, false); hq.x = (unsigned)__builtin_amdgcn_cvt_pk_fp8_f32(hv[0][2], hv[0][3], (int)hq.x, true);
                hq.y = (unsigned)__builtin_amdgcn_cvt_pk_fp8_f32(hv[1][0], hv[1][1], 0, false); hq.y = (unsigned)__builtin_amdgcn_cvt_pk_fp8_f32(hv[1][2], hv[1][3], (int)hq.y, true);
                *(u32x2*)(H + (size_t)(u.pm * BM + ai * HALF + wr * 64 + m * 16 + fr) * 1024 + cc) = hq;
            }
    }
};
struct EpiMoeDown {
    static constexpr bool PERM = true, AFTER_DRAIN = false;
    unsigned char* YS; const float* bias;
    __device__ __forceinline__ void operator()(const f32x4 (&acc)[2][2][4][2], const Unit& u, int wr, int wc, int fr, int fq) const {
        const int col0 = u.pn * BM + wc * 32 + 8 * fq;
        f32x4 bv[2][2];
#pragma unroll
        for (int bj = 0; bj < 2; ++bj)
#pragma unroll
            for (int n = 0; n < 2; ++n) bv[bj][n] = *(const f32x4*)(bias + (size_t)u.e * 1024 + col0 + bj * HALF + 4 * n);
#pragma unroll
        for (int ai = 0; ai < 2; ++ai)
#pragma unroll
            for (int m = 0; m < 4; ++m) { unsigned char* rowp = YS + (size_t)(u.pm * BM + ai * HALF + wr * 64 + m * 16 + fr) * 1024 + col0;
#pragma unroll
                for (int bj = 0; bj < 2; ++bj) { const f32x4 y0 = acc[ai][bj][m][0] * 0.015625f + bv[bj][0], y1 = acc[ai][bj][m][1] * 0.015625f + bv[bj][1];
                    u32x2 q; q.x = (unsigned)__builtin_amdgcn_cvt_pk_fp8_f32(y0[0], y0[1], 0, false); q.x = (unsigned)__builtin_amdgcn_cvt_pk_fp8_f32(y0[2], y0[3], (int)q.x, true);
                    q.y = (unsigned)__builtin_amdgcn_cvt_pk_fp8_f32(y1[0], y1[1], 0, false); q.y = (unsigned)__builtin_amdgcn_cvt_pk_fp8_f32(y1[2], y1[3], (int)q.y, true);
                    *(u32x2*)(rowp + bj * HALF) = q; } }
    }
};
struct EpiPle {
    static constexpr bool PERM = false, AFTER_DRAIN = false;
    float* out; const bf16_t* PJ; float* outw;
    __device__ __forceinline__ void operator()(const f32x4 (&acc)[2][2][4][2], const Unit& u, int wr, int wc, int fr, int fq) const {
        const int col0 = u.pn * BM + wc * 32 + 4 * fq;
#pragma unroll
        for (int ai = 0; ai < 2; ++ai)
#pragma unroll
            for (int m = 0; m < 4; ++m) { const size_t off = (size_t)(u.pm * BM + ai * HALF + wr * 64 + m * 16 + fr) * DM + col0;
#pragma unroll
                for (int bj = 0; bj < 2; ++bj)
#pragma unroll
                    for (int n = 0; n < 2; ++n) {
                        const size_t o2 = off + bj * HALF + n * 16;
                        const f32x4 x2 = *(const f32x4*)(out + o2); const u32x2 pj = *(const u32x2*)(PJ + o2); const f32x4 a = acc[ai][bj][m][n] * 0.015625f;
                        f32x4 r;
                        r[0] = x2[0] + __uint_as_float(pj.x << 16) * __builtin_amdgcn_rcpf(1.0f + __builtin_amdgcn_exp2f(-1.4426950408889634f * a[0]));
                        r[1] = x2[1] + __uint_as_float(pj.x & 0xffff0000u) * __builtin_amdgcn_rcpf(1.0f + __builtin_amdgcn_exp2f(-1.4426950408889634f * a[1]));
                        r[2] = x2[2] + __uint_as_float(pj.y << 16) * __builtin_amdgcn_rcpf(1.0f + __builtin_amdgcn_exp2f(-1.4426950408889634f * a[2]));
                        r[3] = x2[3] + __uint_as_float(pj.y & 0xffff0000u) * __builtin_amdgcn_rcpf(1.0f + __builtin_amdgcn_exp2f(-1.4426950408889634f * a[3]));
                        *(f32x4*)(outw + o2) = r;
                    } }
    }
};
struct MoeOrder {
    int nM, nN, nwg, G, c; const PG8_LAS int* tile_e;
    __device__ void init(int nM_, int nN_, int G_, int c_, const PG8_LAS int* te) { nM = nM_; nN = nN_; nwg = nM * nN; G = G_; c = c_; tile_e = te; }
    __device__ bool next(int i, Unit& u) const {
        const long L = (long)i * G + c; if (L >= nwg) return false;
        int wgid = (int)L; { const int q = nwg / NXCD, r = nwg % NXCD, xcd = wgid % NXCD, off = wgid / NXCD; wgid = (xcd < r ? xcd * (q + 1) : r * (q + 1) + (xcd - r) * q) + off; }
        const int nig = WGM * nN, gid = wgid / nig, fm = gid * WGM, gsz = (nM - fm) < WGM ? (nM - fm) : WGM;
        u.pm = fm + ((wgid % nig) % gsz); u.pn = (wgid % nig) / gsz; u.e = __builtin_amdgcn_readfirstlane(tile_e[u.pm]); return true;
    }
    __device__ __forceinline__ void a_ready(const Unit&) const {}
    __device__ __forceinline__ void done(const Unit&) const {}
};
template <class Epi, class Sched, bool ALIGN_EPI = false, bool SP2 = false, bool F8 = false>
__device__ __forceinline__ void gemm_phase(PG8_LAS unsigned char* lds, const Gemm g, const Sched& S, const Epi& E) {
    int tid_ = threadIdx.x; asm volatile("" : "+v"(tid_));
    const int tid = tid_, wid = __builtin_amdgcn_readfirstlane(tid >> 6), lane = tid & 63, wr = wid >> 2, wc = wid & 3, fr = lane & 15, fq = lane >> 4;
    const int K = g.K, nt = K / BK;
    unsigned voffA[2], voffB[2];
#pragma unroll
    for (int i = 0; i < 2; ++i) { int R, C; stage_rc(tid * 16 + i * 8192, R, C); const int Rb = Epi::PERM ? ((R & ~31) + perm32(R & 31)) : R;
        voffA[i] = (unsigned)(R * K + C) * 2u; voffB[i] = (unsigned)(Rb * K + C) * 2u; }
    const size_t kstep = (size_t)(BK * 2);
    const size_t hstep = (size_t)HALF * K * 2;
    const size_t tstep = 2 * hstep;
    const unsigned ldsw = (unsigned)wid * 1024u;
    const int aoff = lds_byte(wr * 64 + fr, fq * 8), boff = lds_byte(wc * 32 + fr, fq * 8);
#define PG8_SA(b, h) (((b) * 2 + (h)) * HTB)
#define PG8_SB(b, h) ((4 + (b) * 2 + (h)) * HTB)
#define PG8_STAGE(bufoff, gbase, voff) do { _Pragma("unroll") for (int _i = 0; _i < 2; ++_i) \
        __builtin_amdgcn_global_load_lds((const unsigned*)((const char*)(gbase) + (voff)[_i]), (PG8_LAS unsigned*)(lds + (bufoff) + ldsw + _i * 8192), 16, 0, 0); } while (0)
#define PG8_LD16(off) (*(const PG8_LAS v4i32*)(lds + (off)))
#define PG8_LDA(dst, b, h) do { if constexpr (F8) { _Pragma("unroll") for (int m = 0; m < 4; ++m) dst##8[m] = __builtin_shufflevector(PG8_LD16(PG8_SA(b, h) + aoff + m * 2048), PG8_LD16(PG8_SA(b, h) + aoff + m * 2048 + 1024), 0, 1, 2, 3, 4, 5, 6, 7); } \
        else { _Pragma("unroll") for (int m = 0; m < 4; ++m) _Pragma("unroll") for (int k = 0; k < 2; ++k) dst[m][k] = *(const PG8_LAS bf16x8*)(lds + PG8_SA(b, h) + aoff + m * 2048 + k * 1024); } } while (0)
#define PG8_LDB(dst, b, h) do { if constexpr (F8) { _Pragma("unroll") for (int n = 0; n < 2; ++n) dst##8[n] = __builtin_shufflevector(PG8_LD16(PG8_SB(b, h) + boff + n * 2048), PG8_LD16(PG8_SB(b, h) + boff + n * 2048 + 1024), 0, 1, 2, 3, 4, 5, 6, 7); } \
        else { _Pragma("unroll") for (int n = 0; n < 2; ++n) _Pragma("unroll") for (int k = 0; k < 2; ++k) dst[n][k] = *(const PG8_LAS bf16x8*)(lds + PG8_SB(b, h) + boff + n * 2048 + k * 1024); } } while (0)
#define PG8_MMA(ai, bj, At, Bt) do { __builtin_amdgcn_s_setprio(1); \
        if constexpr (F8) { _Pragma("unroll") for (int m = 0; m < 4; ++m) _Pragma("unroll") for (int n = 0; n < 2; ++n) \
            asm volatile("v_mfma_scale_f32_16x16x128_f8f6f4 %0, %1, %2, %0, %3, %3 op_sel_hi:[0,0,0]" : "+v"(acc[ai][bj][m][n]) : "v"(Bt##8[n]), "v"(At##8[m]), "v"(f8scale)); } \
        else { _Pragma("unroll") for (int m = 0; m < 4; ++m) _Pragma("unroll") for (int n = 0; n < 2; ++n) _Pragma("unroll") for (int k = 0; k < 2; ++k) \
            acc[ai][bj][m][n] = __builtin_amdgcn_mfma_f32_16x16x32_bf16(Bt[n][k], At[m][k], acc[ai][bj][m][n], 0, 0, 0); } \
        __builtin_amdgcn_s_setprio(0); } while (0)
#define PG8_WAIT_V(n) asm volatile("s_waitcnt vmcnt(" #n ")" ::: "memory")
#define PG8_WAIT_L(n) asm volatile("s_waitcnt lgkmcnt(" #n ")" ::: "memory")
#define PG8_BAR __builtin_amdgcn_s_barrier()
#define PG8_SCHED __builtin_amdgcn_sched_barrier(0)
    Unit cur, nxt; int ui = 0;
    if (!S.next(0, cur)) return;
    f32x4 acc[2][2][4][2];
#pragma unroll
    for (int a = 0; a < 2; ++a)
#pragma unroll
        for (int b = 0; b < 2; ++b)
#pragma unroll
            for (int m = 0; m < 4; ++m)
#pragma unroll
                for (int n = 0; n < 2; ++n) acc[a][b][m][n] = (f32x4){0.f, 0.f, 0.f, 0.f};
    bf16x8 At[4][2], B0[2][2], B1[2][2];
    v8i32 At8[4], B08[2], B18[2]; const int f8scale = 0x7f7f7f7f;
    const char* cA = (const char*)g.A + (size_t)cur.pm * tstep; const char* cB = (const char*)g.Bt + (size_t)cur.e * g.strideBe + (size_t)cur.pn * tstep;
    S.a_ready(cur);
    if constexpr (SP2) {
        PG8_STAGE(PG8_SB(0, 0), cB, voffB); PG8_STAGE(PG8_SB(0, 1), cB + hstep, voffB); PG8_STAGE(PG8_SA(0, 0), cA, voffA); PG8_STAGE(PG8_SA(0, 1), cA + hstep, voffA);
        if (wr == 1) PG8_BAR;
        PG8_WAIT_V(2); PG8_BAR;
        PG8_STAGE(PG8_SB(1, 0), cB + kstep, voffB); PG8_STAGE(PG8_SA(1, 0), cA + kstep, voffA); PG8_STAGE(PG8_SB(1, 1), cB + hstep + kstep, voffB);
        PG8_WAIT_V(6); PG8_BAR;
    } else {
        PG8_STAGE(PG8_SB(0, 0), cB, voffB); PG8_STAGE(PG8_SA(0, 0), cA, voffA); PG8_STAGE(PG8_SB(0, 1), cB + hstep, voffB); PG8_STAGE(PG8_SA(0, 1), cA + hstep, voffA);
        if (wr == 1) PG8_BAR;
        PG8_WAIT_V(4); PG8_BAR;
        PG8_STAGE(PG8_SB(1, 0), cB + kstep, voffB); PG8_STAGE(PG8_SA(1, 0), cA + kstep, voffA); PG8_STAGE(PG8_SB(1, 1), cB + hstep + kstep, voffB);
        PG8_WAIT_V(6); PG8_BAR;
    }
    for (;;) {
        const bool has_next = S.next(ui + 1, nxt);
        const char* nA = has_next ? (const char*)g.A + (size_t)nxt.pm * tstep : cA; const char* nB = has_next ? (const char*)g.Bt + (size_t)nxt.e * g.strideBe + (size_t)nxt.pn * tstep : cB;
#pragma unroll 1
        for (int t = 0; t < nt; t += 2) {
            const bool last = (t == nt - 2);
            const char* a1 = cA + (size_t)(t + 1) * kstep;
            const char* a2 = last ? nA : cA + (size_t)(t + 2) * kstep; const char* b2 = last ? nB : cB + (size_t)(t + 2) * kstep;
            const char* a3 = a2 + kstep; const char* b3 = b2 + kstep;
            if (last && has_next) S.a_ready(nxt);
            if constexpr (SP2) {
            PG8_LDB(B0, 0, 0); PG8_LDB(B1, 0, 1); PG8_SCHED; PG8_LDA(At, 0, 0); PG8_STAGE(PG8_SA(1, 1), a1 + hstep, voffA);
            PG8_WAIT_V(8); PG8_WAIT_L(0); PG8_BAR; PG8_MMA(0, 0, At, B0); PG8_MMA(0, 1, At, B1); PG8_BAR; PG8_SCHED;
            PG8_LDA(At, 0, 1); PG8_STAGE(PG8_SB(0, 0), b2, voffB); PG8_STAGE(PG8_SB(0, 1), b2 + hstep, voffB); PG8_STAGE(PG8_SA(0, 0), a2, voffA);
            PG8_WAIT_V(8); PG8_WAIT_L(0); PG8_BAR; PG8_MMA(1, 0, At, B0); PG8_MMA(1, 1, At, B1); PG8_BAR; PG8_SCHED;
            PG8_LDB(B0, 1, 0); PG8_LDB(B1, 1, 1); PG8_SCHED; PG8_LDA(At, 1, 0); PG8_STAGE(PG8_SA(0, 1), a2 + hstep, voffA);
            PG8_WAIT_V(8); PG8_WAIT_L(0); PG8_BAR; PG8_MMA(0, 0, At, B0); PG8_MMA(0, 1, At, B1); PG8_BAR; PG8_SCHED;
            PG8_LDA(At, 1, 1); PG8_STAGE(PG8_SB(1, 0), b3, voffB); PG8_STAGE(PG8_SB(1, 1), b3 + hstep, voffB); PG8_STAGE(PG8_SA(1, 0), a3, voffA);
            PG8_WAIT_V(8); PG8_WAIT_L(0); PG8_BAR; PG8_MMA(1, 0, At, B0); PG8_MMA(1, 1, At, B1); PG8_BAR; PG8_SCHED;
            } else {
            PG8_LDB(B0, 0, 0); PG8_SCHED; PG8_LDA(At, 0, 0); PG8_STAGE(PG8_SA(1, 1), a1 + hstep, voffA);
            PG8_WAIT_L(8); PG8_BAR; PG8_WAIT_L(0); PG8_MMA(0, 0, At, B0); PG8_BAR; PG8_SCHED;
            PG8_LDB(B1, 0, 1); PG8_STAGE(PG8_SB(0, 0), b2, voffB);
            PG8_BAR; PG8_WAIT_L(0); PG8_MMA(0, 1, At, B1); PG8_BAR;
            PG8_LDA(At, 0, 1); PG8_STAGE(PG8_SA(0, 0), a2, voffA);
            PG8_BAR; PG8_WAIT_L(0); PG8_MMA(1, 0, At, B0); PG8_BAR; PG8_SCHED;
            PG8_STAGE(PG8_SB(0, 1), b2 + hstep, voffB);
            PG8_WAIT_V(6); PG8_BAR; PG8_MMA(1, 1, At, B1); PG8_BAR;
            PG8_LDB(B0, 1, 0); PG8_SCHED; PG8_LDA(At, 1, 0); PG8_STAGE(PG8_SA(0, 1), a2 + hstep, voffA);
            PG8_WAIT_L(8); PG8_BAR; PG8_WAIT_L(0); PG8_MMA(0, 0, At, B0); PG8_BAR; PG8_SCHED;
            PG8_LDB(B1, 1, 1); PG8_STAGE(PG8_SB(1, 0), b3, voffB);
            PG8_BAR; PG8_WAIT_L(0); PG8_MMA(0, 1, At, B1); PG8_BAR;
            PG8_LDA(At, 1, 1); PG8_STAGE(PG8_SA(1, 0), a3, voffA);
            PG8_BAR; PG8_WAIT_L(0); PG8_MMA(1, 0, At, B0); PG8_BAR; PG8_SCHED;
            PG8_STAGE(PG8_SB(1, 1), b3 + hstep, voffB);
            PG8_WAIT_V(6); PG8_BAR; PG8_MMA(1, 1, At, B1); PG8_BAR;
            }
        }
        if constexpr (ALIGN_EPI) { if (wr == 0) PG8_BAR; }
        if constexpr (F8) asm volatile("s_nop 15\n\ts_nop 15\n\ts_nop 15" ::: "memory");
        if constexpr (!Epi::AFTER_DRAIN) { E(acc, cur, wr, wc, fr, fq); S.done(cur); }
        if (!has_next) break;
#pragma unroll
        for (int a = 0; a < 2; ++a)
#pragma unroll
            for (int b = 0; b < 2; ++b)
#pragma unroll
                for (int m = 0; m < 4; ++m)
#pragma unroll
                    for (int n = 0; n < 2; ++n) acc[a][b][m][n] = (f32x4){0.f, 0.f, 0.f, 0.f};
        cur = nxt; cA = nA; cB = nB; ++ui;
        if constexpr (ALIGN_EPI) { if (wr == 1) PG8_BAR; }
    }
    PG8_WAIT_V(0);
    if constexpr (!ALIGN_EPI) { if (wr == 0) PG8_BAR; }
    PG8_BAR;
    if constexpr (Epi::AFTER_DRAIN) { E.fused(acc, cur, wr, wc, fr, fq, lds, wid, lane); S.done(cur); }
#undef PG8_SA
#undef PG8_SB
#undef PG8_STAGE
#undef PG8_LD16
#undef PG8_LDA
#undef PG8_LDB
#undef PG8_MMA
#undef PG8_WAIT_V
#undef PG8_WAIT_L
#undef PG8_BAR
#undef PG8_SCHED
}
}

constexpr int NWAVES = 8;
constexpr int T = pg8::T, SEQ = pg8::SEQ, DM = pg8::DM, DIN = pg8::DIN, NE = 32, PLE = 256;
constexpr float EPS = pg8::EPS;
constexpr size_t MiB = 1u << 20;
constexpr size_t WS_CTL = 0, CTL_ZERO_BYTES = 1 * MiB;
constexpr size_t WS_WT_IN = 2 * MiB, WS_WT_OUT = 9 * MiB, WS_WT_PG = 11 * MiB, WS_WT_PP = 13 * MiB;
constexpr size_t WS_GAINS = 13 * MiB + 512 * 1024;
constexpr size_t WS_WRT = 13 * MiB + 576 * 1024;
constexpr size_t WS_ROPEC = 14 * MiB, WS_ROPES = 16 * MiB, WS_PB = 18 * MiB, WS_ROUTE = 26 * MiB;
constexpr size_t WS_WT_UG = 32 * MiB, WS_WT_DN = 160 * MiB;
constexpr size_t WS_XN = 224 * MiB;
constexpr size_t WS_HM = 256 * MiB;
constexpr size_t WS_RG = 352 * MiB;
constexpr size_t WS_Y = 368 * MiB;
constexpr size_t WS_PJ = 400 * MiB;
constexpr size_t WS_XS = 432 * MiB, WS_H = 576 * MiB, WS_YS = 720 * MiB;
constexpr size_t WS_END = 864 * MiB;
constexpr int CW_TMO = 0, CW_CODE = 1;
constexpr int CW_BAR = 4096;
constexpr int RING_OFF = 0, RING_BYTES = 131072;
constexpr int LDSCTL_OFF = RING_BYTES, MISC_OFF = LDSCTL_OFF + 320;
constexpr int LDS_BYTES = 147456;
#define GAS __attribute__((address_space(1)))
#define LAS __attribute__((address_space(3)))
typedef unsigned short bf16;
typedef unsigned v4u __attribute__((ext_vector_type(4)));
typedef float f32x4 __attribute__((ext_vector_type(4)));
typedef short bf16x8 __attribute__((ext_vector_type(8)));
typedef unsigned u32x4_t __attribute__((ext_vector_type(4)));
typedef unsigned u32x2_t __attribute__((ext_vector_type(2)));
typedef GAS unsigned gu32;
typedef GAS unsigned long long gu64;
#define RLX_AGENT __ATOMIC_RELAXED, __HIP_MEMORY_SCOPE_AGENT
#define LDS_WAIT() asm volatile("s_waitcnt lgkmcnt(0)" ::: "memory")
#define VM_WAIT() asm volatile("s_waitcnt vmcnt(0)" ::: "memory")
__device__ __forceinline__ unsigned long long rt() { return __builtin_amdgcn_s_memrealtime(); }
__device__ __forceinline__ unsigned f2bf(float f) { unsigned u = __builtin_bit_cast(unsigned, f); return (u + 0x7fffu + ((u >> 16) & 1u)) >> 16; }
__device__ __forceinline__ unsigned pk2(float lo, float hi) { return f2bf(lo) | (f2bf(hi) << 16); }

#define XB_TMO      128
#define XB_XCNT(j)  (256  + 64 * (j))
#define XB_XSUB(j)  (1280 + 64 * (j))
#define XB_XGEN(j)  (2304 + 64 * (j))
#define XB_TOP      3328
#define XB_TOPGEN   3392
#define XCD_BAR_WORDS 3456
#define XB_SPIN_CAP (1u << 18)

__device__ __forceinline__ unsigned xb_ld(unsigned* p)              { return __hip_atomic_load(p, __ATOMIC_RELAXED, __HIP_MEMORY_SCOPE_AGENT); }
__device__ __forceinline__ unsigned xb_add(unsigned* p, unsigned v) { return __hip_atomic_fetch_add(p, v, __ATOMIC_RELAXED, __HIP_MEMORY_SCOPE_AGENT); }
__device__ __forceinline__ unsigned xb_xcc_id() { return (unsigned)__builtin_amdgcn_s_getreg((3 << 11) | 20) & 0xFu; }
#define XB_SPIN(cond, bar) do { unsigned _sp = 0; while (cond) { __builtin_amdgcn_s_sleep(1); \
    if ((++_sp & 255u) == 0u) { if (xb_ld(&(bar)[XB_TMO])) break; if (_sp > XB_SPIN_CAP) { atomicAdd(&(bar)[XB_TMO], 1u); break; } } } } while (0)

struct XcdBarrier {
    unsigned* bar; unsigned x;
    volatile LAS unsigned* st;
};

__device__ __forceinline__ XcdBarrier xcd_barrier_post(unsigned* bar, volatile LAS unsigned* st) {
    XcdBarrier b; b.bar = bar; b.x = xb_xcc_id(); b.st = st;
    if (threadIdx.x == 0) (void)xb_add(&bar[XB_XCNT(b.x)], 1u);
    return b;
}
__device__ __forceinline__ void xcd_barrier_complete(unsigned* bar, unsigned x, unsigned& nloc, unsigned& nx) {
    const unsigned G = gridDim.x * gridDim.y * gridDim.z;
    unsigned sum, cnt, mine, sp = 0u;
    for (;;) {
        sum = 0u; cnt = 0u; mine = 0u;
#pragma unroll
        for (unsigned j = 0; j < 16; ++j) { const unsigned c = xb_ld(&bar[XB_XCNT(j)]); sum += c; cnt += (c > 0u) ? 1u : 0u; mine = (j == x) ? c : mine; }
        if (sum == G) break;
        __builtin_amdgcn_s_sleep(1);
        if ((++sp & 255u) == 0u) { if (xb_ld(&bar[XB_TMO])) break; if (sp > XB_SPIN_CAP) { atomicAdd(&bar[XB_TMO], 1u); break; } }
    }
    nloc = mine > 0u ? mine : 1u; nx = cnt > 0u ? cnt : 1u;
}

__device__ __forceinline__ void xcd_barrier(const XcdBarrier& b) {
    asm volatile("s_waitcnt vmcnt(0)" ::: "memory");
    __syncthreads();
    if (threadIdx.x == 0) {
        unsigned* bar = b.bar;
        __builtin_amdgcn_s_waitcnt(0);
        unsigned nloc = b.st[0], nx = b.st[1];
        if (nloc == 0u) { xcd_barrier_complete(bar, b.x, nloc, nx); b.st[0] = nloc; b.st[1] = nx; }
        const unsigned old = xb_add(&bar[XB_XSUB(b.x)], 1u);
        const unsigned gen = old / nloc;
        const unsigned tgen = gen;
        if (old + 1u == (gen + 1u) * nloc) {
            __builtin_amdgcn_fence(__ATOMIC_RELEASE, "agent");
            asm volatile("s_waitcnt vmcnt(0)" ::: "memory");
            const unsigned og = xb_add(&bar[XB_TOP], 1u);
            const unsigned tg = og / nx;
            if (og + 1u == (tg + 1u) * nx) xb_add(&bar[XB_TOPGEN], 1u);
            else XB_SPIN(xb_ld(&bar[XB_TOPGEN]) == tg, bar);
        } else {
            XB_SPIN(xb_ld(&bar[XB_TOPGEN]) == tgen, bar);
        }
        __builtin_amdgcn_fence(__ATOMIC_ACQUIRE, "agent");
        asm volatile("s_waitcnt vmcnt(0)" ::: "memory");
    }
    __syncthreads();
}

struct Args {
    const float* x; const float* p; const int* positions; const float* g_mix; const float* w_in;
    const float* sbq; const float* sbk; const float* rq; const float* rk; const float* gn_g; const float* gn_b; const float* w_out;
    const float* g_ffn; const float* w_r; const float* b_r; const float* w_ug; const float* b_ug; const float* w_dn; const float* b_dn;
    const float* g_ple; const float* w_pg; const float* w_pp;
    float* out; unsigned char* ws; int ph_lo, ph_hi;
};
struct Frame {
    LAS unsigned char* lds;
    volatile LAS unsigned* MISC;
    gu32* ctl;
    int wave;
    int vcu, G;
};
__device__ __forceinline__ int tid_now() { int t = threadIdx.x; asm volatile("" : "+v"(t)); return t; }
__device__ __forceinline__ float wave_sum(float v) {
#pragma unroll
    for (int o = 1; o < 64; o <<= 1) v += __shfl_xor(v, o);
    return v;
}
__device__ __forceinline__ unsigned cvtpk(float lo, float hi) { return pg8::cvt_pk_bf16(lo, hi); }

enum { MAP_NAT = 0, MAP_IN = 1, MAP_UG = 2 };
__device__ __forceinline__ void p0_item(const float* __restrict__ W, int N, int K, bf16* __restrict__ WT, int kb, int nb, int mapmode, LAS unsigned char* scr, int lane) {
    const int np = 64 * nb + 4 * (lane & 15);
    int src = np;
    if (mapmode == MAP_IN) { const int pn = np >> 8, L = np & 255, bj = L >> 7, wc = (L >> 5) & 3, e = L & 31; src = 256 * pn + 64 * wc + 32 * bj + e; }
    else if (mapmode == MAP_UG) { const int pn = np >> 8, L = np & 255, bj = L >> 7, i = L & 127; src = 1024 * bj + 128 * pn + i; }
    const float* gp = W + (size_t)(64 * kb + (lane >> 4)) * N + src;
    f32x4 v[16];
#pragma unroll
    for (int i = 0; i < 16; ++i) v[i] = *(const f32x4*)(gp + (size_t)(4 * i) * N);
#pragma unroll
    for (int i = 0; i < 16; ++i) {
        LAS unsigned* d = (LAS unsigned*)(scr + (4 * i + (lane >> 4)) * 132 + 8 * (lane & 15));
        d[0] = cvtpk(v[i][0], v[i][1]); d[1] = cvtpk(v[i][2], v[i][3]);
    }
    LDS_WAIT(); asm volatile("" ::: "memory");
    const int c = lane & 7;
#pragma unroll
    for (int it = 0; it < 4; ++it) {
        const int nl = 16 * it + 2 * (lane >> 3);
        unsigned d[8];
#pragma unroll
        for (int j = 0; j < 8; ++j) d[j] = *(const LAS unsigned*)(scr + (8 * c + j) * 132 + 2 * nl);
        v4u o0, o1;
        o0.x = (d[0] & 0xffffu) | (d[1] << 16); o0.y = (d[2] & 0xffffu) | (d[3] << 16); o0.z = (d[4] & 0xffffu) | (d[5] << 16); o0.w = (d[6] & 0xffffu) | (d[7] << 16);
        o1.x = (d[0] >> 16) | (d[1] & 0xffff0000u); o1.y = (d[2] >> 16) | (d[3] & 0xffff0000u); o1.z = (d[4] >> 16) | (d[5] & 0xffff0000u); o1.w = (d[6] >> 16) | (d[7] & 0xffff0000u);
        bf16* dst = WT + (size_t)(64 * nb + nl) * K + 64 * kb + 8 * c;
        *(v4u*)dst = o0; *(v4u*)(dst + K) = o1;
    }
    LDS_WAIT(); asm volatile("" ::: "memory");
}
__device__ __forceinline__ unsigned pk4_fp8(float a, float b, float c, float d) { int r = __builtin_amdgcn_cvt_pk_fp8_f32(a, b, 0, false); r = __builtin_amdgcn_cvt_pk_fp8_f32(c, d, r, true); return (unsigned)r; }
__device__ __forceinline__ void p0_item_f8(const float* __restrict__ W, int N, int K, unsigned char* __restrict__ WT, int kb, int nb, int mapmode, LAS unsigned char* scr, int lane) {
    const int np = 64 * nb + 4 * (lane & 15);
    int src = np;
    if (mapmode == MAP_UG) { const int pn = np >> 8, L = np & 255, bj = L >> 7, i = L & 127; src = 1024 * bj + 128 * pn + i; }
    const float* gp = W + (size_t)(64 * kb + (lane >> 4)) * N + src;
    f32x4 v[16];
#pragma unroll
    for (int i = 0; i < 16; ++i) v[i] = *(const f32x4*)(gp + (size_t)(4 * i) * N);
#pragma unroll
    for (int i = 0; i < 16; ++i) *(LAS unsigned*)(scr + (4 * i + (lane >> 4)) * 68 + 4 * (lane & 15)) = pk4_fp8(v[i][0] * 64.0f, v[i][1] * 64.0f, v[i][2] * 64.0f, v[i][3] * 64.0f);
    LDS_WAIT(); asm volatile("" ::: "memory");
    const int nq = lane & 15, kg = lane >> 4;
    unsigned d[16];
#pragma unroll
    for (int j = 0; j < 16; ++j) d[j] = *(const LAS unsigned*)(scr + (16 * kg + j) * 68 + 4 * nq);
#pragma unroll
    for (int t = 0; t < 4; ++t) {
        v4u o;
#pragma unroll
        for (int q = 0; q < 4; ++q) o[q] = ((d[4 * q] >> (8 * t)) & 0xffu) | (((d[4 * q + 1] >> (8 * t)) & 0xffu) << 8) | (((d[4 * q + 2] >> (8 * t)) & 0xffu) << 16) | (((d[4 * q + 3] >> (8 * t)) & 0xffu) << 24);
        *(v4u*)(WT + (size_t)(64 * nb + 4 * nq + t) * K + 64 * kb + 16 * kg) = o;
    }
    LDS_WAIT(); asm volatile("" ::: "memory");
}
struct P0D { const float* gp; int N, K, kb, nb; bf16* W16; unsigned char* W8; const float* rsc; };
__device__ __forceinline__ int p0_src_col(int np, int mapmode) {
    int src = np;
    if (mapmode == MAP_IN) { const int pn = np >> 8, L = np & 255, bj = L >> 7, wc = (L >> 5) & 3, e = L & 31; src = 256 * pn + 64 * wc + 32 * bj + e; }
    else if (mapmode == MAP_UG) { const int pn = np >> 8, L = np & 255, bj = L >> 7, i = L & 127; src = 1024 * bj + 128 * pn + i; }
    return src;
}
__device__ __forceinline__ P0D p0_mk(const float* W, int N, int K, bf16* W16, unsigned char* W8, int kb, int nb, int mapmode, int lane, const float* rsc = nullptr) {
    P0D d; d.N = N; d.K = K; d.kb = kb; d.nb = nb; d.W16 = W16; d.W8 = W8;
    if (W8) {
        d.rsc = rsc ? rsc + 128 * kb + (lane >> 3) : nullptr;
        d.gp = W + (size_t)(128 * kb + (lane >> 3)) * N + p0_src_col(32 * nb + 4 * (lane & 7), mapmode);
    } else {
        d.rsc = nullptr;
        d.gp = W + (size_t)(64 * kb + (lane >> 4)) * N + p0_src_col(64 * nb + 4 * (lane & 15), mapmode);
    }
    return d;
}
__device__ __forceinline__ void p0_load(const P0D& d, f32x4 (&v)[16]) {
#pragma unroll
    for (int i = 0; i < 16; ++i) v[i] = *(const f32x4*)(d.gp + (size_t)((d.W8 ? 8 : 4) * i) * d.N);
}
__device__ __forceinline__ void p0_finish(const P0D& d, const f32x4 (&v)[16], LAS unsigned char* scr, int lane, const int pm = 0) {
    if (pm == 1) { _Pragma("unroll") for (int i = 0; i < 16; ++i) asm volatile("" :: "v"(v[i])); return; }
    if (d.W16) {
#pragma unroll
        for (int i = 0; i < 16; ++i) { LAS unsigned* q = (LAS unsigned*)(scr + (4 * i + (lane >> 4)) * 132 + 8 * (lane & 15)); q[0] = cvtpk(v[i][0], v[i][1]); q[1] = cvtpk(v[i][2], v[i][3]); }
        LDS_WAIT(); asm volatile("" ::: "memory");
        const int c = lane & 7;
#pragma unroll
        for (int it = 0; it < 4; ++it) {
            const int nl = 16 * it + 2 * (lane >> 3);
            unsigned x[8];
#pragma unroll
            for (int j = 0; j < 8; ++j) x[j] = *(const LAS unsigned*)(scr + (8 * c + j) * 132 + 2 * nl);
            v4u o0, o1;
            o0.x = (x[0] & 0xffffu) | (x[1] << 16); o0.y = (x[2] & 0xffffu) | (x[3] << 16); o0.z = (x[4] & 0xffffu) | (x[5] << 16); o0.w = (x[6] & 0xffffu) | (x[7] << 16);
            o1.x = (x[0] >> 16) | (x[1] & 0xffff0000u); o1.y = (x[2] >> 16) | (x[3] & 0xffff0000u); o1.z = (x[4] >> 16) | (x[5] & 0xffff0000u); o1.w = (x[6] >> 16) | (x[7] & 0xffff0000u);
            bf16* dst = d.W16 + (size_t)(64 * d.nb + nl) * d.K + 64 * d.kb + 8 * c;
            if (pm == 0 || pm == 3) { *(v4u*)dst = o0; *(v4u*)(dst + d.K) = o1; } else asm volatile("" :: "v"(o0), "v"(o1));
        }
    } else {
#pragma unroll
        for (int i = 0; i < 16; ++i) { const float sc = d.rsc ? d.rsc[8 * i] * 64.0f : 64.0f; *(LAS unsigned*)(scr + (8 * i + (lane >> 3)) * 36 + 4 * (lane & 7)) = pk4_fp8(v[i][0] * sc, v[i][1] * sc, v[i][2] * sc, v[i][3] * sc); }
        LDS_WAIT(); asm volatile("" ::: "memory");
        const int nq = lane & 7, kg = lane >> 3;
        unsigned x[16];
#pragma unroll
        for (int j = 0; j < 16; ++j) x[j] = *(const LAS unsigned*)(scr + (16 * kg + j) * 36 + 4 * nq);
#pragma unroll
        for (int t = 0; t < 4; ++t) {
            v4u o;
#pragma unroll
            for (int q = 0; q < 4; ++q) o[q] = ((x[4 * q] >> (8 * t)) & 0xffu) | (((x[4 * q + 1] >> (8 * t)) & 0xffu) << 8) | (((x[4 * q + 2] >> (8 * t)) & 0xffu) << 16) | (((x[4 * q + 3] >> (8 * t)) & 0xffu) << 24);
            if (pm == 0 || pm == 3) *(v4u*)(d.W8 + (size_t)(32 * d.nb + 4 * nq + t) * d.K + 128 * d.kb + 16 * kg) = o; else asm volatile("" :: "v"(o));
        }
    }
    LDS_WAIT(); asm volatile("" ::: "memory");
}
__device__ __forceinline__ P0D p0_decode(const Args& a, unsigned char* ws, int it, int lane) {
    constexpr int I_IN = 16 * 56, I_OUT = 256, I_PG = 256, I_PP = 4 * 16, I_UG = 16 * 32, I_DN = 256;
    int r = it;
    if (r < I_IN) return p0_mk(a.w_in, DIN, DM, (bf16*)(ws + WS_WT_IN), nullptr, r / 56, r % 56, MAP_IN, lane); r -= I_IN;
    if (r < I_OUT) return p0_mk(a.w_out, DM, DM, (bf16*)(ws + WS_WT_OUT), nullptr, r / 16, r % 16, MAP_NAT, lane); r -= I_OUT;
    if (r < I_PG) return p0_mk(a.w_pg, DM, DM, nullptr, (unsigned char*)(ws + WS_WT_PG), r / 32, r % 32, MAP_NAT, lane); r -= I_PG;
    if (r < I_PP) return p0_mk(a.w_pp, DM, PLE, (bf16*)(ws + WS_WT_PP), nullptr, r / 16, r % 16, MAP_NAT, lane); r -= I_PP;
    if (r < NE * I_UG) { const int e = r / I_UG, q = r % I_UG; return p0_mk(a.w_ug + (size_t)e * DM * 2048, 2048, DM, nullptr, (unsigned char*)(ws + WS_WT_UG) + (size_t)e * 2048 * DM, q / 64, q % 64, MAP_UG, lane, a.g_ffn); } r -= NE * I_UG;
    { const int e = r / I_DN, q = r % I_DN; return p0_mk(a.w_dn + (size_t)e * DM * DM, DM, DM, nullptr, (unsigned char*)(ws + WS_WT_DN) + (size_t)e * DM * DM, q / 32, q % 32, MAP_NAT, lane); }
}
__device__ __forceinline__ void rms_row_to_bf16(const float* xrow, const float* g, bf16* orow, int lane) {
    const f32x4* xr = (const f32x4*)xrow + lane;
    f32x4 v[4]; float s = 0.f;
#pragma unroll
    for (int j = 0; j < 4; ++j) { v[j] = xr[64 * j]; s += (v[j][0] * v[j][0] + v[j][1] * v[j][1]) + (v[j][2] * v[j][2] + v[j][3] * v[j][3]); }
    const float rstd = rsqrtf(wave_sum(s) * (1.f / DM) + EPS);
    unsigned long long* o8 = (unsigned long long*)orow + lane;
#pragma unroll
    for (int j = 0; j < 4; ++j) { const f32x4 gg = ((const f32x4*)g)[lane + 64 * j];
        o8[64 * j] = (unsigned long long)cvtpk(v[j][0] * rstd * gg[0], v[j][1] * rstd * gg[1]) | ((unsigned long long)cvtpk(v[j][2] * rstd * gg[2], v[j][3] * rstd * gg[3]) << 32); }
}
__device__ __forceinline__ void p0_prologue(Frame& F, const Args& a, const int pm = 0) {
    unsigned char* ws = a.ws; const int tid = tid_now(), lane = tid & 63;
    LAS unsigned char* scr = F.lds + RING_OFF + F.wave * 8448;
    const int gw = F.vcu * NWAVES + F.wave, NGW = F.G * NWAVES;
    constexpr int I_IN = 16 * 56, I_OUT = 256, I_PG = 256, I_PP = 4 * 16, I_UG = 16 * 32, I_DN = 256;
    constexpr int NITEMS = I_IN + I_OUT + I_PG + I_PP + NE * I_UG + NE * I_DN;
    if (gw < NITEMS) {
        int it = gw; P0D d0 = p0_decode(a, ws, it, lane), d1 = d0; f32x4 va[16], vb[16]; p0_load(d0, va);
        for (;;) {
            const int it1 = it + NGW; const bool h1 = it1 < NITEMS;
            if (h1) { d1 = p0_decode(a, ws, it1, lane); p0_load(d1, vb); }
            p0_finish(d0, va, scr, lane, pm);
            if (!h1) break;
            const int it2 = it1 + NGW; const bool h2 = it2 < NITEMS;
            if (h2) { d0 = p0_decode(a, ws, it2, lane); p0_load(d0, va); }
            p0_finish(d1, vb, scr, lane, pm);
            if (!h2) break;
            it = it2;
        }
    }
    if (pm != 0) return;
    if (blockIdx.x == 0 && tid < 256) { const int t = tid; const float* srcs = (t < 64) ? a.sbq : (t < 128) ? a.sbk : (t < 192) ? a.rq : a.rk; ((float*)(ws + WS_GAINS))[t] = srcs[t & 63]; }
    {
        f32x4 gg[4];
#pragma unroll
        for (int j = 0; j < 4; ++j) gg[j] = ((const f32x4*)a.g_mix)[lane + 64 * j];
        for (int m0 = 4 * gw; m0 < T; m0 += 4 * NGW) {
            f32x4 v[4][4];
#pragma unroll
            for (int r = 0; r < 4; ++r)
#pragma unroll
                for (int j = 0; j < 4; ++j) v[r][j] = ((const f32x4*)(a.x + (size_t)(m0 + r) * DM))[lane + 64 * j];
#pragma unroll
            for (int r = 0; r < 4; ++r) {
                float ss = 0.f;
#pragma unroll
                for (int j = 0; j < 4; ++j) ss += (v[r][j][0] * v[r][j][0] + v[r][j][1] * v[r][j][1]) + (v[r][j][2] * v[r][j][2] + v[r][j][3] * v[r][j][3]);
                const float rstd = rsqrtf(wave_sum(ss) * (1.f / DM) + EPS);
                unsigned long long* o8 = (unsigned long long*)((bf16*)(ws + WS_XN) + (size_t)(m0 + r) * DM) + lane;
#pragma unroll
                for (int j = 0; j < 4; ++j) o8[64 * j] = (unsigned long long)cvtpk(v[r][j][0] * rstd * gg[j][0], v[r][j][1] * rstd * gg[j][1]) | ((unsigned long long)cvtpk(v[r][j][2] * rstd * gg[j][2], v[r][j][3] * rstd * gg[j][3]) << 32);
            }
        }
    }
    { const int gt = gw * 64 + lane, NGT = NGW * 64;
      for (int i0 = gt; i0 < T * PLE / 8; i0 += 4 * NGT) {
          f32x4 a0[4], a1[4];
#pragma unroll
          for (int q = 0; q < 4; ++q) { const int i = i0 + q * NGT; if (i < T * PLE / 8) { a0[q] = ((const f32x4*)a.p)[2 * i]; a1[q] = ((const f32x4*)a.p)[2 * i + 1]; } }
#pragma unroll
          for (int q = 0; q < 4; ++q) { const int i = i0 + q * NGT; if (i < T * PLE / 8) { v4u o; o.x = cvtpk(a0[q][0], a0[q][1]); o.y = cvtpk(a0[q][2], a0[q][3]); o.z = cvtpk(a1[q][0], a1[q][1]); o.w = cvtpk(a1[q][2], a1[q][3]); ((v4u*)(ws + WS_PB))[i] = o; } }
      }
      for (int i = gt; i < NE * DM; i += NGT) { const int e = i >> 10, k = i & (DM - 1); const float wv = a.w_r[(size_t)k * NE + e] * a.g_ffn[k];
          const unsigned hi = cvtpk(wv, 0.f) & 0xffffu; const unsigned lo = cvtpk(wv - __uint_as_float(hi << 16), 0.f) & 0xffffu;
          ((bf16*)(ws + WS_WRT))[i] = (bf16)hi; ((bf16*)(ws + WS_WRT))[NE * DM + i] = (bf16)lo; }
      float* rc = (float*)(ws + WS_ROPEC); float* rs = (float*)(ws + WS_ROPES);
      for (int i = gt; i < T * 32; i += NGT) { const int row = i >> 5, f = i & 31;
          const float inv_freq = exp2f(-(float)f * (13.287712379549449f / 32.0f));   const float ang = (float)a.positions[row] * inv_freq;
          float sn, cs; sincosf(ang, &sn, &cs); rc[i] = cs; rs[i] = sn; } }
}

namespace att {
typedef short bf16x8 __attribute__((ext_vector_type(8)));
typedef short s16x4 __attribute__((ext_vector_type(4)));
typedef float f32x16 __attribute__((ext_vector_type(16)));
typedef short v4i16_t __attribute__((ext_vector_type(4)));
constexpr int LK = 0, LV = 24576, LFLAG = 49152;
__device__ __forceinline__ s16x4 vtr(LAS const unsigned char* p) { return __builtin_bit_cast(s16x4, __builtin_amdgcn_ds_read_tr16_b64_v4i16((LAS v4i16_t*)p)); }
__device__ __forceinline__ int crow(int r, int hi) { return (r & 3) + 8 * (r >> 2) + 4 * hi; }
struct AttnArgs { const bf16* hm; const bf16* rg; bf16* Y; const float* gn_g; const float* gn_b; };

template <int MODE> __device__ __forceinline__ void attn_unit(LAS unsigned char* lds, const AttnArgs& A, int b, int h, int qb) {
    int tid_ = threadIdx.x; asm volatile("" : "+v"(tid_));
    const int tid = tid_, lane = tid & 63, r32 = lane & 31, hh = lane >> 5;
    const int w = __builtin_amdgcn_readfirstlane(tid >> 6);
    const int q0 = qb * 256, qw = q0 + 32 * w;
    const size_t TS = (size_t)T * 512;
    const size_t hoff = (size_t)(b * 8 + h) * SEQ * 64;
    const bf16* Qp = A.hm + (MODE == 0 ? 0 : 3) * TS + hoff;
    const bf16* Kp = A.hm + (MODE == 0 ? 1 : 4) * TS + hoff;
    const bf16* Vp = A.hm + (MODE == 0 ? 2 : 5) * TS + hoff;
    bf16x8 qf[4];
#pragma unroll
    for (int ds = 0; ds < 4; ++ds) qf[ds] = *(const bf16x8*)(Qp + (size_t)(qw + r32) * 64 + 16 * ds + 8 * hh);
    f32x16 o[2];
#pragma unroll
    for (int r = 0; r < 16; ++r) { o[0][r] = 0.f; o[1][r] = 0.f; }
    float carry = 1.0f;
    const int jmax = (q0 + 255) >> 6, jd = (qw + 31) >> 6;
    const float lg2g = __log2f(1.0f - __builtin_amdgcn_exp2f(-5.0f - (float)h));
    const bf16* Kt = Kp + (size_t)lane * 64 + w * 8; const bf16* Vt = Vp + (size_t)w * 512 + lane * 8;
    volatile LAS unsigned* flags = (volatile LAS unsigned*)(lds + LFLAG);
#define ATT_DMA(t, so) do { __builtin_amdgcn_global_load_lds((const unsigned*)(Kt + (size_t)(t) * 4096), (LAS unsigned*)(lds + LK + (so) + w * 1024), 16, 0, 0); \
                            __builtin_amdgcn_global_load_lds((const unsigned*)(Vt + (size_t)(t) * 4096), (LAS unsigned*)(lds + LV + (so) + w * 1024), 16, 0, 0); } while (0)
    ATT_DMA(jmax, 0);
    if (jmax >= 1) { ATT_DMA(jmax - 1, 8192); asm volatile("s_waitcnt vmcnt(2)\n\ts_barrier" ::: "memory"); }
    else asm volatile("s_waitcnt vmcnt(0)\n\ts_barrier" ::: "memory");
    bool finished = false;
    int so_cur = 0, so_new = 16384;
    for (int j = jmax; j >= 0; --j) {
        const int cur = j & 1;
        if (j >= 2) ATT_DMA(j - 2, so_new);
        if (j <= jd && !finished) {
            LAS const unsigned char* Kb = lds + LK + so_cur;
            LAS const unsigned char* Vb = lds + LV + so_cur;
            f32x16 p[2];
#pragma unroll
            for (int r = 0; r < 16; ++r) { p[0][r] = 0.f; p[1][r] = 0.f; }
#pragma unroll
            for (int ds = 0; ds < 4; ++ds) {
                const bf16x8 k0 = *(LAS const bf16x8*)(Kb + (2 * ds + hh) * 1024 + r32 * 16);
                const bf16x8 k1 = *(LAS const bf16x8*)(Kb + (2 * ds + hh) * 1024 + (32 + r32) * 16);
                p[0] = __builtin_amdgcn_mfma_f32_32x32x16_bf16(k0, qf[ds], p[0], 0, 0, 0);
                p[1] = __builtin_amdgcn_mfma_f32_32x32x16_bf16(k1, qf[ds], p[1], 0, 0, 0);
            }
            const bool diag = (j == jd);
            const int qg = qw + r32, kv0 = 64 * j + 4 * hh;
            if (MODE == 0) {
                float om[2][16];
#pragma unroll
                for (int hf = 0; hf < 2; ++hf)
#pragma unroll
                    for (int r = 0; r < 16; ++r) {
                        const float Z = p[hf][r];
                        const float a = __builtin_amdgcn_exp2f(-__builtin_fabsf(Z));
                        const float rc = __builtin_amdgcn_rcpf(1.0f + a), ar = a * rc;
                        const bool pos = Z >= 0.f;
                        const bool valid = !diag || (kv0 + 32 * hf + (r & 3) + 8 * (r >> 2) < qg);
                        const float beta = pos ? rc : ar, omb = pos ? ar : rc;
                        p[hf][r] = valid ? beta : 0.f;
                        om[hf][r] = valid ? omb : 1.0f;
                    }
                float gs[8], ot[8];
#pragma unroll
                for (int m = 0; m < 8; ++m) { const int hf = m >> 2, g = m & 3; gs[m] = (om[hf][4 * g] * om[hf][4 * g + 1]) * (om[hf][4 * g + 2] * om[hf][4 * g + 3]); ot[m] = __shfl_xor(gs[m], 32); }
                float ps[8];
                ps[7] = 1.0f;
#pragma unroll
                for (int m = 6; m >= 0; --m) ps[m] = ps[m + 1] * (gs[m + 1] * ot[m + 1]);
                const float total = ps[0] * (gs[0] * ot[0]);
#pragma unroll
                for (int m = 0; m < 8; ++m) {
                    const int hf = m >> 2, g = m & 3;
                    float tail = carry * (hh ? ps[m] : ps[m] * ot[m]);
#pragma unroll
                    for (int i = 3; i >= 0; --i) { const int r = 4 * g + i; const float o1 = om[hf][r]; p[hf][r] *= tail; tail *= o1; }
                }
                carry *= total;
                finished = __all(carry < 1.0e-37f);
            } else {
                const float ct = __builtin_amdgcn_exp2f(lg2g * (float)(qw - 64 * j));
#pragma unroll
                for (int hf = 0; hf < 2; ++hf)
#pragma unroll
                    for (int r = 0; r < 16; ++r) {
                        const bool valid = !diag || (kv0 + 32 * hf + (r & 3) + 8 * (r >> 2) <= qg);
                        p[hf][r] = valid ? p[hf][r] * ct : 0.f;
                    }
            }
#pragma unroll
            for (int hf = 0; hf < 2; ++hf)
#pragma unroll
                for (int s = 0; s < 2; ++s) {
                    u32x4_t wq;
                    wq.x = pg8::cvt_pk_bf16(p[hf][8 * s + 0], p[hf][8 * s + 1]); wq.y = pg8::cvt_pk_bf16(p[hf][8 * s + 2], p[hf][8 * s + 3]);
                    wq.z = pg8::cvt_pk_bf16(p[hf][8 * s + 4], p[hf][8 * s + 5]); wq.w = pg8::cvt_pk_bf16(p[hf][8 * s + 6], p[hf][8 * s + 7]);
                    const bf16x8 wf = __builtin_bit_cast(bf16x8, wq);
#pragma unroll
                    for (int d0 = 0; d0 < 2; ++d0) {
                        LAS const unsigned char* va = Vb + (32 * hf + 16 * s + 4 * hh + ((lane & 15) >> 2)) * 128 + (32 * d0 + 16 * ((lane >> 4) & 1) + 4 * (lane & 3)) * 2;
                        const s16x4 lo = vtr(va), hi = vtr(va + 8 * 128);
                        const bf16x8 vf = (bf16x8){lo[0], lo[1], lo[2], lo[3], hi[0], hi[1], hi[2], hi[3]};
                        o[d0] = __builtin_amdgcn_mfma_f32_32x32x16_bf16(vf, wf, o[d0], 0, 0, 0);
                    }
                }
        }
        if (MODE == 0) { if (lane == 0) flags[cur * 8 + w] = finished ? 1u : 0u; }
        if (j >= 2) asm volatile("s_waitcnt vmcnt(2) lgkmcnt(0)\n\ts_barrier" ::: "memory"); else asm volatile("s_waitcnt vmcnt(0) lgkmcnt(0)\n\ts_barrier" ::: "memory");
        so_cur = (so_cur == 16384) ? 0 : so_cur + 8192; so_new = (so_new == 16384) ? 0 : so_new + 8192;
        if (MODE == 0) {
            unsigned all = 1u;
#pragma unroll
            for (int i = 0; i < 8; ++i) all &= flags[cur * 8 + i];
            if (all) break;
        }
    }
    asm volatile("s_waitcnt vmcnt(0)\n\ts_barrier" ::: "memory");
#undef ATT_DMA
    const int row = b * SEQ + qw + r32;
    if (MODE == 0) {
        bf16* yp = A.Y + (size_t)row * DM + h * 64 + 4 * hh;
#pragma unroll
        for (int d0 = 0; d0 < 2; ++d0)
#pragma unroll
            for (int g = 0; g < 4; ++g) { u32x2_t v; v.x = pg8::cvt_pk_bf16(o[d0][4 * g], o[d0][4 * g + 1]); v.y = pg8::cvt_pk_bf16(o[d0][4 * g + 2], o[d0][4 * g + 3]); *(u32x2_t*)(yp + 32 * d0 + 8 * g) = v; }
    } else {
        float s1 = 0.f;
#pragma unroll
        for (int r = 0; r < 16; ++r) s1 += o[0][r] + o[1][r];
        s1 += __shfl_xor(s1, 32);
        const float mu = s1 * (1.0f / 64.0f);
        float s2 = 0.f;
#pragma unroll
        for (int r = 0; r < 16; ++r) { const float a0 = o[0][r] - mu, a1 = o[1][r] - mu; s2 += a0 * a0 + a1 * a1; }
        s2 += __shfl_xor(s2, 32);
        const float rstd = rsqrtf(s2 * (1.0f / 64.0f) + EPS);
        bf16* yp = A.Y + (size_t)row * DM + 512 + h * 64 + 4 * hh;
        const bf16* gp = A.rg + (size_t)row * 512 + h * 64 + 4 * hh;
        const float* gg = A.gn_g + h * 64 + 4 * hh; const float* gb = A.gn_b + h * 64 + 4 * hh;
#pragma unroll
        for (int d0 = 0; d0 < 2; ++d0)
#pragma unroll
            for (int g = 0; g < 4; ++g) {
                const f32x4 gn = *(const f32x4*)(gg + 32 * d0 + 8 * g), bs = *(const f32x4*)(gb + 32 * d0 + 8 * g);
                const u32x2_t gr = *(const u32x2_t*)(gp + 32 * d0 + 8 * g);
                float gate[4] = {__uint_as_float(gr.x << 16), __uint_as_float(gr.x & 0xffff0000u), __uint_as_float(gr.y << 16), __uint_as_float(gr.y & 0xffff0000u)};
                float ov[4];
#pragma unroll
                for (int i = 0; i < 4; ++i) { const float yn = (o[d0][4 * g + i] - mu) * rstd * gn[i] + bs[i]; const float sg = gate[i] / (1.0f + __expf(-gate[i])); ov[i] = yn * sg; }
                u32x2_t v; v.x = pg8::cvt_pk_bf16(ov[0], ov[1]); v.y = pg8::cvt_pk_bf16(ov[2], ov[3]); *(u32x2_t*)(yp + 32 * d0 + 8 * g) = v;
            }
    }
}
__device__ __forceinline__ void attn_phase(LAS unsigned char* lds, const AttnArgs& A, int vcu, int dup) {
    const int bh = vcu >> 2, x = vcu & 3, b = bh >> 3, h = bh & 7;
#pragma unroll 1
    for (int u = 0; u < ((dup == 20) ? 4 : 2); ++u) attn_unit<1>(lds, A, b, h, (u & 1) ? x : 7 - x);
#pragma unroll 1
    for (int u = 0; u < ((dup == 21) ? 4 : 2); ++u) attn_unit<0>(lds, A, b, h, (u & 1) ? x : 7 - x);
}
}

constexpr int CW_GCNT = 2048;
constexpr int LR_LCNT = LDSCTL_OFF + 1024, LR_GBASE = LDSCTL_OFF + 1152;
constexpr int LT_POFF = LDSCTL_OFF + 2048, LT_NT = LDSCTL_OFF + 2176, LT_TILE_E = LDSCTL_OFF + 2304;
struct RouteBufs { int* tok_e; int* tok_slot; float* tok_gate; float* rstd; float* slot_rstd; };
__device__ __forceinline__ RouteBufs route_bufs(unsigned char* ws) { RouteBufs r; r.tok_e = (int*)(ws + WS_ROUTE); r.tok_slot = r.tok_e + T * 4; r.tok_gate = (float*)(r.tok_slot + T * 4); r.rstd = (float*)(ws + WS_ROUTE + 1 * MiB); r.slot_rstd = (float*)(ws + WS_ROUTE + 2 * MiB); return r; }
typedef float f32x2v __attribute__((ext_vector_type(2)));
__device__ __forceinline__ unsigned opq_mask(bool c) { unsigned m = c ? 0xffffffffu : 0u; asm volatile("" : "+v"(m)); return m; }
__device__ __forceinline__ float blendf(unsigned m, float a, float b) { return __uint_as_float((__float_as_uint(a) & m) | (__float_as_uint(b) & ~m)); }
__device__ __forceinline__ int blendi(unsigned m, int a, int b) { return (int)(((unsigned)a & m) | ((unsigned)b & ~m)); }

#define SW2(c, a, b) { const float ta_ = (c) ? (b) : (a), tb_ = (c) ? (a) : (b); a = ta_; b = tb_; }
#define SW2I(c, a, b) { const int ta_ = (c) ? (b) : (a), tb_ = (c) ? (a) : (b); a = ta_; b = tb_; }
#define TOP4_INSERT(x, e) { const float x_ = (x); const int e_ = (e); const bool c3_ = (x_ > v3) || (x_ == v3 && e_ < i3); v3 = c3_ ? x_ : v3; i3 = c3_ ? e_ : i3; \
    const bool c2_ = (v3 > v2) || (v3 == v2 && i3 < i2); SW2(c2_, v2, v3) SW2I(c2_, i2, i3) const bool c1_ = (v2 > v1) || (v2 == v1 && i2 < i1); SW2(c1_, v1, v2) SW2I(c1_, i1, i2) \
    const bool c0_ = (v1 > v0) || (v1 == v0 && i1 < i0); SW2(c0_, v0, v1) SW2I(c0_, i0, i1) }
__device__ __forceinline__ void router_phase(Frame& F, const Args& a, const bool dry = false) {
    unsigned char* ws = a.ws; const int tid = tid_now();
    LAS unsigned char* lds = F.lds;
    const int lane = tid & 63, r32 = lane & 31, hh = lane >> 5, w = F.wave, rg = w >> 2, kq = w & 3;
    volatile LAS unsigned* lcnt = (volatile LAS unsigned*)(lds + LR_LCNT);
    volatile LAS unsigned* gbase = (volatile LAS unsigned*)(lds + LR_GBASE);
    if (tid < 32) lcnt[tid] = 0u;
    const RouteBufs R = route_bufs(dry ? ws + 3 * MiB : ws);
    const int row = F.vcu * 64 + 32 * rg + r32;
    const float* xr = a.out + (size_t)row * DM + 256 * kq + 8 * hh;
    const bf16* wt = (const bf16*)(ws + WS_WRT) + (size_t)r32 * DM + 256 * kq + 8 * hh;
    unsigned char* hp = (unsigned char*)(ws + (dry ? WS_H : WS_XN)) + (size_t)row * DM + 256 * kq + 8 * hh;
    att::f32x16 D;
#pragma unroll
    for (int r = 0; r < 16; ++r) D[r] = 0.f;
    float ss = 0.f;
#pragma unroll 8
    for (int ks = 0; ks < 16; ++ks) {
        const f32x4 v0 = *(const f32x4*)(xr + 16 * ks), v1 = *(const f32x4*)(xr + 16 * ks + 4);
        ss += ((v0[0] * v0[0] + v0[1] * v0[1]) + (v0[2] * v0[2] + v0[3] * v0[3])) + ((v1[0] * v1[0] + v1[1] * v1[1]) + (v1[2] * v1[2] + v1[3] * v1[3]));
        u32x2_t h8; h8.x = pk4_fp8(v0[0], v0[1], v0[2], v0[3]); h8.y = pk4_fp8(v1[0], v1[1], v1[2], v1[3]); *(u32x2_t*)(hp + 16 * ks) = h8;
        u32x4_t xh, xl;
        xh.x = cvtpk(v0[0], v0[1]); xh.y = cvtpk(v0[2], v0[3]); xh.z = cvtpk(v1[0], v1[1]); xh.w = cvtpk(v1[2], v1[3]);
        xl.x = cvtpk(v0[0] - __uint_as_float(xh.x << 16), v0[1] - __uint_as_float(xh.x & 0xffff0000u)); xl.y = cvtpk(v0[2] - __uint_as_float(xh.y << 16), v0[3] - __uint_as_float(xh.y & 0xffff0000u));
        xl.z = cvtpk(v1[0] - __uint_as_float(xh.z << 16), v1[1] - __uint_as_float(xh.z & 0xffff0000u)); xl.w = cvtpk(v1[2] - __uint_as_float(xh.w << 16), v1[3] - __uint_as_float(xh.w & 0xffff0000u));
        const att::bf16x8 whi = *(const att::bf16x8*)(wt + 16 * ks), wlo = *(const att::bf16x8*)(wt + 32 * DM + 16 * ks);
        const att::bf16x8 bxh = __builtin_bit_cast(att::bf16x8, xh), bxl = __builtin_bit_cast(att::bf16x8, xl);
        D = __builtin_amdgcn_mfma_f32_32x32x16_bf16(whi, bxh, D, 0, 0, 0);
        D = __builtin_amdgcn_mfma_f32_32x32x16_bf16(wlo, bxh, D, 0, 0, 0);
        D = __builtin_amdgcn_mfma_f32_32x32x16_bf16(whi, bxl, D, 0, 0, 0);
    }
    { LAS f32x4* dp = (LAS f32x4*)(lds + (w * 64 + lane) * 64);
#pragma unroll
      for (int q = 0; q < 4; ++q) dp[q] = (f32x4){D[4 * q], D[4 * q + 1], D[4 * q + 2], D[4 * q + 3]};
      *(LAS float*)(lds + 32768 + (w * 64 + lane) * 4) = ss; }
    __syncthreads();
    int my_e0 = 0, my_e1 = 0, rk0 = 0, rk1 = 0; float my_g0 = 0.f, my_g1 = 0.f;
    if (kq == 0) {
#pragma unroll
        for (int o = 1; o < 4; ++o) { LAS const f32x4* dp = (LAS const f32x4*)(lds + ((w + o) * 64 + lane) * 64);
#pragma unroll
            for (int q = 0; q < 4; ++q) { const f32x4 t = dp[q]; D[4 * q] += t[0]; D[4 * q + 1] += t[1]; D[4 * q + 2] += t[2]; D[4 * q + 3] += t[3]; }
            ss += *(LAS const float*)(lds + 32768 + ((w + o) * 64 + lane) * 4); }
        ss += __shfl_xor(ss, 32);
        const float rstd = rsqrtf(ss * (1.f / DM) + EPS);
        if (hh == 0) R.rstd[row] = rstd;
        float l[16];
#pragma unroll
        for (int r = 0; r < 16; ++r) l[r] = D[r] * rstd + a.b_r[(r & 3) + 8 * (r >> 2) + 4 * hh];
        float c[8]; int ci[8];
#pragma unroll
        for (int k = 0; k < 4; ++k) {
            float bv = -INFINITY; int bi = 99;
#pragma unroll
            for (int r = 0; r < 16; ++r) { const int e = (r & 3) + 8 * (r >> 2) + 4 * hh; const bool bt = l[r] > bv; bv = bt ? l[r] : bv; bi = bt ? e : bi; }
            c[k] = bv; ci[k] = bi;
#pragma unroll
            for (int r = 0; r < 16; ++r) { const int e = (r & 3) + 8 * (r >> 2) + 4 * hh; l[r] = (e == bi) ? -INFINITY : l[r]; }
        }
#pragma unroll
        for (int k = 0; k < 4; ++k) { c[4 + k] = __shfl_xor(c[k], 32); ci[4 + k] = __shfl_xor(ci[k], 32); }
        float tv[4]; int ti[4];
#pragma unroll
        for (int k = 0; k < 4; ++k) {
            float bv = -INFINITY; int bi = 99;
#pragma unroll
            for (int j = 0; j < 8; ++j) { const bool bt = (c[j] > bv) || (c[j] == bv && ci[j] < bi); bv = bt ? c[j] : bv; bi = bt ? ci[j] : bi; }
            tv[k] = bv; ti[k] = bi;
#pragma unroll
            for (int j = 0; j < 8; ++j) c[j] = (ci[j] == bi) ? -INFINITY : c[j];
        }
        const float v0 = tv[0], v1 = tv[1], v2 = tv[2], v3 = tv[3]; const int i0 = ti[0], i1 = ti[1], i2 = ti[2], i3 = ti[3];
        const float e1 = __expf(v1 - v0), e2 = __expf(v2 - v0), e3 = __expf(v3 - v0), inv = 1.0f / (1.0f + e1 + e2 + e3);
        my_e0 = hh ? i2 : i0; my_e1 = hh ? i3 : i1; my_g0 = (hh ? e2 : 1.0f) * inv; my_g1 = (hh ? e3 : e1) * inv;
        rk0 = (int)__hip_atomic_fetch_add((LAS unsigned*)(lds + LR_LCNT) + my_e0, 1u, __ATOMIC_RELAXED, __HIP_MEMORY_SCOPE_WORKGROUP);
        rk1 = (int)__hip_atomic_fetch_add((LAS unsigned*)(lds + LR_LCNT) + my_e1, 1u, __ATOMIC_RELAXED, __HIP_MEMORY_SCOPE_WORKGROUP);
    }
    __syncthreads();
    if (tid < 32) gbase[tid] = __hip_atomic_fetch_add((unsigned*)(F.ctl + CW_GCNT + (dry ? 64 : 0)) + tid, lcnt[tid], __ATOMIC_RELAXED, __HIP_MEMORY_SCOPE_AGENT);
    __syncthreads();
    if (kq == 0) {
        const int k0 = 2 * hh;
        R.tok_e[row * 4 + k0] = my_e0; R.tok_slot[row * 4 + k0] = (int)gbase[my_e0] + rk0; R.tok_gate[row * 4 + k0] = my_g0;
        R.tok_e[row * 4 + k0 + 1] = my_e1; R.tok_slot[row * 4 + k0 + 1] = (int)gbase[my_e1] + rk1; R.tok_gate[row * 4 + k0 + 1] = my_g1;
    }
}
#undef SW2
#undef SW2I
#undef TOP4_INSERT

__device__ __forceinline__ void build_tables(Frame& F) {
    LAS int* poff = (LAS int*)(F.lds + LT_POFF); LAS int* ntp = (LAS int*)(F.lds + LT_NT); LAS int* tile_e = (LAS int*)(F.lds + LT_TILE_E);
    LAS int* cnts = (LAS int*)(F.lds + LR_LCNT); const int tid = tid_now();
    if (tid < NE) cnts[tid] = (int)__hip_atomic_load((unsigned*)(F.ctl + CW_GCNT) + tid, __ATOMIC_RELAXED, __HIP_MEMORY_SCOPE_AGENT);
    __syncthreads();
    if (tid == 0) {
        int t = 0;
        for (int e = 0; e < NE; ++e) { const int c = cnts[e]; const int nt = (c + 255) >> 8; poff[e] = t * 256; for (int i = 0; i < nt; ++i) tile_e[t + i] = e; t += nt; }
        *ntp = t;
    }
    __syncthreads();
}
__device__ __forceinline__ void gather_phase(Frame& F, const Args& a) {
    unsigned char* ws = a.ws; const int lane = tid_now() & 63; const RouteBufs R = route_bufs(ws);
    LAS const int* poff = (LAS const int*)(F.lds + LT_POFF);
    const int gw = F.vcu * NWAVES + F.wave, NGW = F.G * NWAVES;
    for (int m0 = 4 * gw; m0 < T; m0 += 4 * NGW) {
        v4u h0[4]; float rs[4]; int dsts[4][4];
#pragma unroll
        for (int r = 0; r < 4; ++r) { const int m = m0 + r; h0[r] = ((const v4u*)((const unsigned char*)(ws + WS_XN) + (size_t)m * DM))[lane]; rs[r] = R.rstd[m];
#pragma unroll
            for (int k = 0; k < 4; ++k) dsts[r][k] = poff[R.tok_e[m * 4 + k]] + R.tok_slot[m * 4 + k]; }
#pragma unroll
        for (int r = 0; r < 4; ++r)
#pragma unroll
            for (int k = 0; k < 4; ++k) { ((v4u*)((unsigned char*)(ws + WS_XS) + (size_t)dsts[r][k] * DM))[lane] = h0[r]; if (lane == 0) R.slot_rstd[dsts[r][k]] = rs[r]; }
    }
}
__device__ __forceinline__ void combine_phase(Frame& F, const Args& a, const bool dry = false) {
    unsigned char* ws = a.ws; const RouteBufs R = route_bufs(ws);
    LAS const int* poff = (LAS const int*)(F.lds + LT_POFF);
    const int gw = F.vcu * NWAVES + F.wave, NGW = F.G * NWAVES, lane = tid_now() & 63;
    for (int m0 = 2 * gw; m0 < T; m0 += 2 * NGW) {
        f32x4 v[2][2][2]; u32x2_t y[2][4][2]; float gt[2][4];
#pragma unroll
        for (int rr = 0; rr < 2; ++rr) { const int m = m0 + rr;
#pragma unroll
            for (int i = 0; i < 2; ++i) { v[rr][i][0] = *(const f32x4*)(a.out + (size_t)m * DM + 8 * lane + 512 * i); v[rr][i][1] = *(const f32x4*)(a.out + (size_t)m * DM + 8 * lane + 512 * i + 4); }
#pragma unroll
            for (int k = 0; k < 4; ++k) { const int e = R.tok_e[m * 4 + k], slot = R.tok_slot[m * 4 + k]; gt[rr][k] = R.tok_gate[m * 4 + k];
                const unsigned char* yr = (const unsigned char*)(ws + WS_YS) + (size_t)(poff[e] + slot) * DM + 8 * lane;
                y[rr][k][0] = *(const u32x2_t*)yr; y[rr][k][1] = *(const u32x2_t*)(yr + 512); } }
#pragma unroll
        for (int rr = 0; rr < 2; ++rr) { const int m = m0 + rr;
#pragma unroll
            for (int k = 0; k < 4; ++k)
#pragma unroll
                for (int i = 0; i < 2; ++i) { const u32x2_t yy = y[rr][k][i]; const float g = gt[rr][k];
                    const f32x2v a0 = __builtin_amdgcn_cvt_pk_f32_fp8((int)yy.x, false), a1 = __builtin_amdgcn_cvt_pk_f32_fp8((int)yy.x, true), a2 = __builtin_amdgcn_cvt_pk_f32_fp8((int)yy.y, false), a3 = __builtin_amdgcn_cvt_pk_f32_fp8((int)yy.y, true);
                    v[rr][i][0][0] += g * a0[0]; v[rr][i][0][1] += g * a0[1]; v[rr][i][0][2] += g * a1[0]; v[rr][i][0][3] += g * a1[1];
                    v[rr][i][1][0] += g * a2[0]; v[rr][i][1][1] += g * a2[1]; v[rr][i][1][2] += g * a3[0]; v[rr][i][1][3] += g * a3[1]; }
            float ss = 0.f;
#pragma unroll
            for (int i = 0; i < 2; ++i)
#pragma unroll
                for (int q = 0; q < 2; ++q) { const f32x4 t = v[rr][i][q]; ss += (t[0] * t[0] + t[1] * t[1]) + (t[2] * t[2] + t[3] * t[3]); }
            const float rstd = rsqrtf(wave_sum(ss) * (1.f / DM) + EPS);
            unsigned char* np = (unsigned char*)(ws + (dry ? WS_H : WS_XN)) + (size_t)m * DM + 8 * lane; float* ow = dry ? (float*)(ws + WS_XS) : a.out;
#pragma unroll
            for (int i = 0; i < 2; ++i) { *(f32x4*)(ow + (size_t)m * DM + 8 * lane + 512 * i) = v[rr][i][0]; *(f32x4*)(ow + (size_t)m * DM + 8 * lane + 512 * i + 4) = v[rr][i][1];
                const f32x4 g0 = *(const f32x4*)(a.g_ple + 8 * lane + 512 * i), g1 = *(const f32x4*)(a.g_ple + 8 * lane + 512 * i + 4);
                u32x2_t o; o.x = pk4_fp8(v[rr][i][0][0] * rstd * g0[0], v[rr][i][0][1] * rstd * g0[1], v[rr][i][0][2] * rstd * g0[2], v[rr][i][0][3] * rstd * g0[3]);
                o.y = pk4_fp8(v[rr][i][1][0] * rstd * g1[0], v[rr][i][1][1] * rstd * g1[1], v[rr][i][1][2] * rstd * g1[2], v[rr][i][1][3] * rstd * g1[3]);
                *(u32x2_t*)(np + 512 * i) = o; } }
    }
}

__global__ void __launch_bounds__(NWAVES * 64, 2) mega_fwd(Args args) {
    extern __shared__ __attribute__((aligned(16))) unsigned char lds[];
    Frame F;
    F.lds = (LAS unsigned char*)lds;
    F.MISC = (volatile LAS unsigned*)(F.lds + MISC_OFF);
    F.wave = __builtin_amdgcn_readfirstlane(threadIdx.x >> 6);
    F.G = gridDim.x; { const int bx = blockIdx.x; F.vcu = (F.G % 8 == 0) ? (bx % 8) * (F.G / 8) + bx / 8 : bx; }
    unsigned char* ws = args.ws;
    F.ctl = (gu32*)(ws + WS_CTL);
    for (int u = threadIdx.x; u < (LDS_BYTES - LDSCTL_OFF) / 4; u += NWAVES * 64) ((LAS unsigned*)(F.lds + LDSCTL_OFF))[u] = 0u;
    __syncthreads();
    XcdBarrier bar = xcd_barrier_post((unsigned*)(F.ctl + CW_BAR), F.MISC + 8);
    const int lo = args.ph_lo, hi = args.ph_hi;
#define IN(k) (lo <= (k) && (k) < hi)
#define GRID_BAR() xcd_barrier(bar)
#ifndef DUP_PHASE
#define DUP_PHASE -1
#endif
#define REP(k) for (int rep_ = 0; rep_ < ((DUP_PHASE) == (k) ? 2 : 1); ++rep_)

    if (IN(0)) { if (DUP_PHASE == 40) { p0_prologue(F, args, 1); GRID_BAR(); } if (DUP_PHASE == 41) { p0_prologue(F, args, 2); GRID_BAR(); } if (DUP_PHASE == 42) { p0_prologue(F, args, 3); GRID_BAR(); } REP(0) { p0_prologue(F, args); GRID_BAR(); } }

    if (IN(1)) REP(1) {
        pg8::Gemm g{(const pg8::bf16_t*)(ws + WS_XN), (const pg8::bf16_t*)(ws + WS_WT_IN), DM, 0};
        pg8::StaticOrder S; S.init(T / 256, DIN / 256, F.G, (int)blockIdx.x);
        pg8::EpiProj E{(pg8::bf16_t*)(ws + WS_HM), (pg8::bf16_t*)(ws + WS_RG), (const float*)(ws + WS_GAINS), (const float*)(ws + WS_ROPEC), (const float*)(ws + WS_ROPES)};
        pg8::gemm_phase<pg8::EpiProj, pg8::StaticOrder, true, true>(F.lds + RING_OFF, g, S, E);
        {
            const int G2 = (F.G == 256) ? 128 : F.G, c2 = (F.G == 256) ? (int)blockIdx.x - 128 : (int)blockIdx.x;
            if (c2 >= 0) {
                pg8::Gemm g2{(const pg8::bf16_t*)(ws + WS_PB), (const pg8::bf16_t*)(ws + WS_WT_PP), PLE, 0};
                pg8::StaticOrder S2; S2.init(T / 256, DM / 256, G2, c2);
                pg8::EpiBf16Plain E2{(pg8::bf16_t*)(ws + WS_PJ), DM};
                pg8::gemm_phase<pg8::EpiBf16Plain, pg8::StaticOrder, true, true>(F.lds + RING_OFF, g2, S2, E2);
            }
        }
        GRID_BAR();
    }
    if (IN(2)) REP(2) {
        if (F.G == 256) {
            const att::AttnArgs AA{(const bf16*)(ws + WS_HM), (const bf16*)(ws + WS_RG), (bf16*)(ws + WS_Y), args.gn_g, args.gn_b};
            att::attn_phase(F.lds + RING_OFF, AA, F.vcu, DUP_PHASE);
        }
        GRID_BAR();
    }
    if (IN(3)) REP(3) {
        pg8::Gemm g{(const pg8::bf16_t*)(ws + WS_Y), (const pg8::bf16_t*)(ws + WS_WT_OUT), DM, 0};
        pg8::StaticOrder S; S.init(T / 256, DM / 256, F.G, (int)blockIdx.x);
        pg8::EpiResid E{args.x, args.out};
        pg8::gemm_phase<pg8::EpiResid, pg8::StaticOrder, true, true>(F.lds + RING_OFF, g, S, E);
        GRID_BAR();
    }
    if (DUP_PHASE == 30 && IN(3)) { GRID_BAR(); GRID_BAR(); GRID_BAR(); GRID_BAR(); }
    if (IN(4)) { if (DUP_PHASE == 4) { if (F.G == 256) router_phase(F, args, true); GRID_BAR(); } if (F.G == 256) router_phase(F, args); GRID_BAR(); }
    if (IN(5) || (lo >= 6 && lo <= 8)) build_tables(F);
    if (IN(5)) REP(5) { gather_phase(F, args); GRID_BAR(); }
    if (IN(6)) REP(6) {
        const int NT = *(LAS const int*)(F.lds + LT_NT);
        pg8::Gemm g{(const pg8::bf16_t*)(ws + WS_XS), (const pg8::bf16_t*)(ws + WS_WT_UG), DM / 2, (size_t)2048 * DM};
        pg8::MoeOrder S; S.init(NT, 8, F.G, (int)blockIdx.x, (LAS const int*)(F.lds + LT_TILE_E));
        pg8::EpiMoeUp E{(unsigned char*)(ws + WS_H), args.b_ug, route_bufs(ws).slot_rstd};
        pg8::gemm_phase<pg8::EpiMoeUp, pg8::MoeOrder, true, true, true>(F.lds + RING_OFF, g, S, E);
        GRID_BAR();
    }
    if (IN(7)) REP(7) {
        const int NT = *(LAS const int*)(F.lds + LT_NT);
        pg8::Gemm g{(const pg8::bf16_t*)(ws + WS_H), (const pg8::bf16_t*)(ws + WS_WT_DN), DM / 2, (size_t)DM * DM};
        pg8::MoeOrder S; S.init(NT, 4, F.G, (int)blockIdx.x, (LAS const int*)(F.lds + LT_TILE_E));
        pg8::EpiMoeDown E{(unsigned char*)(ws + WS_YS), args.b_dn};
        pg8::gemm_phase<pg8::EpiMoeDown, pg8::MoeOrder, true, true, true>(F.lds + RING_OFF, g, S, E);
        GRID_BAR();
    }
    if (IN(8)) { if (DUP_PHASE == 8) { combine_phase(F, args, true); GRID_BAR(); } combine_phase(F, args); GRID_BAR(); }
    if (IN(9)) {
        pg8::Gemm g{(const pg8::bf16_t*)(ws + WS_XN), (const pg8::bf16_t*)(ws + WS_WT_PG), DM / 2, 0};
        pg8::StaticOrder S; S.init(T / 256, DM / 256, F.G, (int)blockIdx.x);
        if (DUP_PHASE == 9) { pg8::EpiPle E0{args.out, (const pg8::bf16_t*)(ws + WS_PJ), (float*)(ws + WS_XS)}; pg8::gemm_phase<pg8::EpiPle, pg8::StaticOrder, true, true, true>(F.lds + RING_OFF, g, S, E0); }
        pg8::EpiPle E{args.out, (const pg8::bf16_t*)(ws + WS_PJ), args.out};
        pg8::gemm_phase<pg8::EpiPle, pg8::StaticOrder, true, true, true>(F.lds + RING_OFF, g, S, E);
    }
#undef IN
}
extern "C" void kernel_launch(void* const* d_in, const int* in_sizes, int n_in, void* d_out, int out_size, void* d_ws, size_t ws_size, hipStream_t stream) {
    static int grid = 0;
    if (grid == 0) {
        if (n_in != 22 || ws_size < 1024 * MiB) { fprintf(stderr, "kernel_launch: unexpected n_in %d / ws %zu\n", n_in, ws_size); grid = -1; return; }
        int dev = 0, cus = 0, per_cu = 0;
        if (hipGetDevice(&dev) != hipSuccess || hipDeviceGetAttribute(&cus, hipDeviceAttributeMultiprocessorCount, dev) != hipSuccess) { grid = -1; return; }
        if (hipFuncSetAttribute((const void*)mega_fwd, hipFuncAttributeMaxDynamicSharedMemorySize, LDS_BYTES) != hipSuccess) { fprintf(stderr, "kernel_launch: hipFuncSetAttribute failed\n"); grid = -1; return; }
        if (hipOccupancyMaxActiveBlocksPerMultiprocessor(&per_cu, (const void*)mega_fwd, NWAVES * 64, LDS_BYTES) != hipSuccess || per_cu < 1) { fprintf(stderr, "kernel_launch: occupancy query says %d\n", per_cu); per_cu = 1; }
        (void)hipGetLastError();
        grid = cus;
    }
    if (grid < 0) return;
    (void)hipMemsetAsync((char*)d_ws + WS_CTL, 0, CTL_ZERO_BYTES, stream);
    Args a{};
    a.x = (const float*)d_in[0]; a.p = (const float*)d_in[1]; a.positions = (const int*)d_in[2]; a.g_mix = (const float*)d_in[3]; a.w_in = (const float*)d_in[4];
    a.sbq = (const float*)d_in[5]; a.sbk = (const float*)d_in[6]; a.rq = (const float*)d_in[7]; a.rk = (const float*)d_in[8]; a.gn_g = (const float*)d_in[9]; a.gn_b = (const float*)d_in[10];
    a.w_out = (const float*)d_in[11]; a.g_ffn = (const float*)d_in[12]; a.w_r = (const float*)d_in[13]; a.b_r = (const float*)d_in[14]; a.w_ug = (const float*)d_in[15]; a.b_ug = (const float*)d_in[16];
    a.w_dn = (const float*)d_in[17]; a.b_dn = (const float*)d_in[18]; a.g_ple = (const float*)d_in[19]; a.w_pg = (const float*)d_in[20]; a.w_pp = (const float*)d_in[21];
    a.out = (float*)d_out; a.ws = (unsigned char*)d_ws; a.ph_lo = 0; a.ph_hi = 10;
    hipLaunchKernelGGL(mega_fwd, dim3(grid), dim3(NWAVES * 64), LDS_BYTES, stream, a);

}
```

```cpp
#include <hip/hip_runtime.h>
#include <cstdint>
#include <cstdio>
#include <cmath>

namespace pg8 {
#define PG8_LAS __attribute__((address_space(3)))
typedef unsigned short bf16_t;
typedef short bf16x8 __attribute__((ext_vector_type(8)));
typedef float f32x4 __attribute__((ext_vector_type(4)));
typedef unsigned u32x4 __attribute__((ext_vector_type(4)));
typedef unsigned u32x2 __attribute__((ext_vector_type(2)));
typedef int v4i32 __attribute__((ext_vector_type(4)));
typedef int v8i32 __attribute__((ext_vector_type(8)));
constexpr int BM = 256, BK = 64, HALF = 128, HTB = HALF * BK * 2  , STAGE_BYTES = 8 * HTB, NXCD = 8, WGM = 8;

__host__ __device__ __forceinline__ int lds_byte(int r, int c) { const int st = (r >> 4) * 2 + (c >> 5), rr = r & 15, cc = c & 31, ob = rr * 64 + cc * 2; return st * 1024 + (ob ^ (((ob >> 9) & 1) << 5)); }
__host__ __device__ __forceinline__ void stage_rc(int b, int& R, int& C) { const int st = b / 1024, sb = b % 1024, swz = sb ^ (((sb >> 9) & 1) << 5); R = (st >> 1) * 16 + swz / 64; C = (st & 1) * 32 + (swz % 64) / 2; }
__host__ __device__ __forceinline__ int perm32(int rho) { const int n = rho >> 4, i = rho & 15; return 8 * (i >> 2) + 4 * n + (i & 3); }

struct Unit { int pm, pn, e; };
struct Gemm { const bf16_t* A; const bf16_t* Bt; int K; size_t strideBe; };

struct StaticOrder {
    int nM, nN, nwg, G, c;
    __host__ __device__ void init(int nM_, int nN_, int G_, int c_) { nM = nM_; nN = nN_; nwg = nM * nN; G = G_; c = c_; }
    __host__ __device__ bool next(int i, Unit& u) const {
        const long L = (long)i * G + c; if (L >= nwg) return false;
        int wgid = (int)L; { const int q = nwg / NXCD, r = nwg % NXCD, xcd = wgid % NXCD, off = wgid / NXCD; wgid = (xcd < r ? xcd * (q + 1) : r * (q + 1) + (xcd - r) * q) + off; }
        const int nig = WGM * nN, gid = wgid / nig, fm = gid * WGM, gsz = (nM - fm) < WGM ? (nM - fm) : WGM;
        u.pm = fm + ((wgid % nig) % gsz); u.pn = (wgid % nig) / gsz; u.e = 0; return true;
    }
    __device__ __forceinline__ void a_ready(const Unit&) const {}
    __device__ __forceinline__ void done(const Unit&) const {}
};

typedef float f32x2_t __attribute__((ext_vector_type(2))); typedef __bf16 bf16x2_t __attribute__((ext_vector_type(2)));
__device__ __forceinline__ unsigned cvt_pk_bf16(float lo, float hi) { f32x2_t v = {lo, hi}; bf16x2_t b = __builtin_convertvector(v, bf16x2_t); return __builtin_bit_cast(unsigned, b); }

constexpr int T = 16384, SEQ = 2048, DM = 1024, DIN = 3584;
constexpr float EPS = 1e-6f;
__device__ __forceinline__ u32x4 pack8(const f32x4 a, const f32x4 b) { u32x4 w; w.x = cvt_pk_bf16(a[0], a[1]); w.y = cvt_pk_bf16(a[2], a[3]); w.z = cvt_pk_bf16(b[0], b[1]); w.w = cvt_pk_bf16(b[2], b[3]); return w; }

struct EpiProj {
    static constexpr bool PERM = true, AFTER_DRAIN = false;
    bf16_t* hm;
    bf16_t* rg;
    const float* gains;
    const float *ropec, *ropes;
    __device__ __forceinline__ void operator()(const f32x4 (&acc)[2][2][4][2], const Unit& u, int wr, int wc, int fr, int fq) const {
        const int region = u.pn >> 1, hb = 4 * (u.pn & 1) + wc;
        const bool normed = (region == 0) || (region == 1) || (region == 3) || (region == 4);
        const bool rope = (region == 3) || (region == 4);
        const int gidx = region == 0 ? 0 : region == 1 ? 1 : region == 3 ? 2 : 3;
        const float* gp = gains + gidx * 64;
        f32x4 gv[2][2];
#pragma unroll
        for (int bj = 0; bj < 2; ++bj)
#pragma unroll
            for (int n = 0; n < 2; ++n) gv[bj][n] = normed ? *(const f32x4*)(gp + 32 * bj + 8 * fq + 4 * n) : (f32x4){1.f, 1.f, 1.f, 1.f};
        const float lg2g = __log2f(1.0f - __builtin_amdgcn_exp2f(-5.0f - (float)hb));
        const float scale = region == 0 ? 0.125f * 1.4426950408889634f : region == 4 ? 0.125f : 1.0f;
#pragma unroll
        for (int ai = 0; ai < 2; ++ai)
#pragma unroll
            for (int m = 0; m < 4; ++m) {
                const int row = u.pm * BM + ai * HALF + wr * 64 + m * 16 + fr;
                const int b = row >> 11, s = row & (SEQ - 1);
                f32x4 v[2][2];
#pragma unroll
                for (int bj = 0; bj < 2; ++bj)
#pragma unroll
                    for (int n = 0; n < 2; ++n) v[bj][n] = acc[ai][bj][m][n];
                if (normed) {
                    float ss = 0.f;
#pragma unroll
                    for (int bj = 0; bj < 2; ++bj)
#pragma unroll
                        for (int n = 0; n < 2; ++n) { const f32x4 x = v[bj][n]; ss += (x[0] * x[0] + x[1] * x[1]) + (x[2] * x[2] + x[3] * x[3]); }
                    ss += __shfl_xor(ss, 16); ss += __shfl_xor(ss, 32);
                    float rs = rsqrtf(ss * (1.0f / 64.0f) + EPS) * scale;
                    if (rope) rs *= (region == 3) ? __builtin_amdgcn_exp2f((float)(s & 31) * lg2g) : __builtin_amdgcn_exp2f(-(float)(s & 63) * lg2g);
#pragma unroll
                    for (int bj = 0; bj < 2; ++bj)
#pragma unroll
                        for (int n = 0; n < 2; ++n) v[bj][n] = v[bj][n] * rs * gv[bj][n];
                    if (rope) {
#pragma unroll
                        for (int n = 0; n < 2; ++n) {
                            const f32x4 c = *(const f32x4*)(ropec + (size_t)row * 32 + 8 * fq + 4 * n), sn = *(const f32x4*)(ropes + (size_t)row * 32 + 8 * fq + 4 * n);
                            const f32x4 lo = v[0][n], hi = v[1][n];
                            v[0][n] = lo * c - hi * sn; v[1][n] = hi * c + lo * sn;
                        }
                    }
                }
                bf16_t* dst = (region < 6) ? hm + (size_t)region * ((size_t)T * 512) + ((size_t)(b * 8 + hb) * SEQ + s) * 64 + 8 * fq
                                           : rg + (size_t)row * 512 + hb * 64 + 8 * fq;
#pragma unroll
                for (int bj = 0; bj < 2; ++bj) *(u32x4*)(dst + 32 * bj) = pack8(v[bj][0], v[bj][1]);
            }
    }
};

struct EpiBf16Plain {
    static constexpr bool PERM = true, AFTER_DRAIN = false;
    bf16_t* O; int ldc;
    __device__ __forceinline__ void operator()(const f32x4 (&acc)[2][2][4][2], const Unit& u, int wr, int wc, int fr, int fq) const {
        const int row0 = u.pm * BM + wr * 64 + fr, col0 = u.pn * BM + wc * 32 + 8 * fq;
#pragma unroll
        for (int ai = 0; ai < 2; ++ai)
#pragma unroll
            for (int m = 0; m < 4; ++m) { bf16_t* rowp = O + (size_t)(row0 + ai * HALF + m * 16) * ldc + col0;
#pragma unroll
                for (int bj = 0; bj < 2; ++bj) *(u32x4*)(rowp + bj * HALF) = pack8(acc[ai][bj][m][0], acc[ai][bj][m][1]); }
    }
};
struct EpiResid {
    static constexpr bool PERM = false, AFTER_DRAIN = false;
    const float* base; float* out;
    __device__ __forceinline__ void operator()(const f32x4 (&acc)[2][2][4][2], const Unit& u, int wr, int wc, int fr, int fq) const {
        const int col0 = u.pn * BM + wc * 32 + 4 * fq;
#pragma unroll
        for (int ai = 0; ai < 2; ++ai)
#pragma unroll
            for (int m = 0; m < 4; ++m) { const size_t off = (size_t)(u.pm * BM + ai * HALF + wr * 64 + m * 16 + fr) * DM + col0;
#pragma unroll
                for (int bj = 0; bj < 2; ++bj)
#pragma unroll
                    for (int n = 0; n < 2; ++n) { const f32x4 bs = *(const f32x4*)(base + off + bj * HALF + n * 16); *(f32x4*)(out + off + bj * HALF + n * 16) = bs + acc[ai][bj][m][n]; } }
    }
};
struct EpiMoeUp {
    static constexpr bool PERM = true, AFTER_DRAIN = false;
    unsigned char* H; const float* bias; const float* srstd;
    __device__ __forceinline__ void operator()(const f32x4 (&acc)[2][2][4][2], const Unit& u, int wr, int wc, int fr, int fq) const {
        const int cc = 128 * u.pn + 32 * wc + 8 * fq;
        const float* bp = bias + (size_t)u.e * 2048 + cc;
        f32x4 bg[2], bl[2];
#pragma unroll
        for (int n = 0; n < 2; ++n) { bg[n] = *(const f32x4*)(bp + 4 * n); bl[n] = *(const f32x4*)(bp + 1024 + 4 * n); }
#pragma unroll
        for (int ai = 0; ai < 2; ++ai)
#pragma unroll
            for (int m = 0; m < 4; ++m) {
                f32x4 hv[2]; const float sc = srstd[u.pm * BM + ai * HALF + wr * 64 + m * 16 + fr] * 0.015625f;
#pragma unroll
                for (int n = 0; n < 2; ++n) {
                    const f32x4 g0 = acc[ai][0][m][n] * sc + bg[n], l0 = acc[ai][1][m][n] * sc + bl[n];
#pragma unroll
                    for (int j = 0; j < 4; ++j) {
                        const float glu = __builtin_fminf(g0[j], 7.0f), lin = __builtin_fminf(__builtin_fmaxf(l0[j], -7.0f), 7.0f);
                        const float sg = __builtin_amdgcn_rcpf(1.0f + __builtin_amdgcn_exp2f(-1.702f * 1.4426950408889634f * glu));
                        hv[n][j] = glu * sg * (lin + 1.0f);
                    }
                }
                u32x2 hq; hq.x = (unsigned)__builtin_amdgcn_cvt_pk_fp8_f32(hv[0][0], hv[0][1], 0, false); hq.x = (unsigned)__builtin_amdgcn_cvt_pk_fp8_f32(hv[0][2], hv[0][3], (int)hq.x, true);
                hq.y = (unsigned)__builtin_amdgcn_cvt_pk_fp8_f32(hv[1][0], hv[1][1], 0, false); hq.y = (unsigned)__builtin_amdgcn_cvt_pk_fp8_f32(hv[1][2], hv[1][3], (int)hq.y, true);
                *(u32x2*)(H + (size_t)(u.pm * BM + ai * HALF + wr * 64 + m * 16 + fr) * 1024 + cc) = hq;
            }
    }
};
struct EpiMoeDown {
    static constexpr bool PERM = true, AFTER_DRAIN = false;
    unsigned char* YS; const float* bias;
    __device__ __forceinline__ void operator()(const f32x4 (&acc)[2][2][4][2], const Unit& u, int wr, int wc, int fr, int fq) const {
        const int col0 = u.pn * BM + wc * 32 + 8 * fq;
        f32x4 bv[2][2];
#pragma unroll
        for (int bj = 0; bj < 2; ++bj)
#pragma unroll
            for (int n = 0; n < 2; ++n) bv[bj][n] = *(const f32x4*)(bias + (size_t)u.e * 1024 + col0 + bj * HALF + 4 * n);
#pragma unroll
        for (int ai = 0; ai < 2; ++ai)
#pragma unroll
            for (int m = 0; m < 4; ++m) { unsigned char* rowp = YS + (size_t)(u.pm * BM + ai * HALF + wr * 64 + m * 16 + fr) * 1024 + col0;
#pragma unroll
                for (int bj = 0; bj < 2; ++bj) { const f32x4 y0 = acc[ai][bj][m][0] * 0.015625f + bv[bj][0], y1 = acc[ai][bj][m][1] * 0.015625f + bv[bj][1];
                    u32x2 q; q.x = (unsigned)__builtin_amdgcn_cvt_pk_fp8_f32(y0[0], y0[1], 0, false); q.x = (unsigned)__builtin_amdgcn_cvt_pk_fp8_f32(y0[2], y0[3], (int)q.x, true);
                    q.y = (unsigned)__builtin_amdgcn_cvt_pk_fp8_f32(y1[0], y1[1], 0, false); q.y = (unsigned)__builtin_amdgcn_cvt_pk_fp8_f32(y1[2], y1[3], (int)q.y, true);
                    *(u32x2*)(rowp + bj * HALF) = q; } }
    }
};
struct EpiPle {
    static constexpr bool PERM = false, AFTER_DRAIN = false;
    float* out; const bf16_t* PJ; float* outw;
    __device__ __forceinline__ void operator()(const f32x4 (&acc)[2][2][4][2], const Unit& u, int wr, int wc, int fr, int fq) const {
        const int col0 = u.pn * BM + wc * 32 + 4 * fq;
#pragma unroll
        for (int ai = 0; ai < 2; ++ai)
#pragma unroll
            for (int m = 0; m < 4; ++m) { const size_t off = (size_t)(u.pm * BM + ai * HALF + wr * 64 + m * 16 + fr) * DM + col0;
#pragma unroll
                for (int bj = 0; bj < 2; ++bj)
#pragma unroll
                    for (int n = 0; n < 2; ++n) {
                        const size_t o2 = off + bj * HALF + n * 16;
                        const f32x4 x2 = *(const f32x4*)(out + o2); const u32x2 pj = *(const u32x2*)(PJ + o2); const f32x4 a = acc[ai][bj][m][n] * 0.015625f;
                        f32x4 r;
                        r[0] = x2[0] + __uint_as_float(pj.x << 16) * __builtin_amdgcn_rcpf(1.0f + __builtin_amdgcn_exp2f(-1.4426950408889634f * a[0]));
                        r[1] = x2[1] + __uint_as_float(pj.x & 0xffff0000u) * __builtin_amdgcn_rcpf(1.0f + __builtin_amdgcn_exp2f(-1.4426950408889634f * a[1]));
                        r[2] = x2[2] + __uint_as_float(pj.y << 16) * __builtin_amdgcn_rcpf(1.0f + __builtin_amdgcn_exp2f(-1.4426950408889634f * a[2]));
                        r[3] = x2[3] + __uint_as_float(pj.y & 0xffff0000u) * __builtin_amdgcn_rcpf(1.0f + __builtin_amdgcn_exp2f(-1.4426950408889634f * a[3]));
                        *(f32x4*)(outw + o2) = r;
                    } }
    }
};
struct MoeOrder {
    int nM, nN, nwg, G, c; const PG8_LAS int* tile_e;
    __device__ void init(int nM_, int nN_, int G_, int c_, const PG8_LAS int* te) { nM = nM_; nN = nN_; nwg = nM * nN; G = G_; c = c_; tile_e = te; }
    __device__ bool next(int i, Unit& u) const {
        const long L = (long)i * G + c; if (L >= nwg) return false;
        int wgid = (int)L; { const int q = nwg / NXCD, r = nwg % NXCD, xcd = wgid % NXCD, off = wgid / NXCD; wgid = (xcd < r ? xcd * (q + 1) : r * (q + 1) + (xcd - r) * q) + off; }
        const int nig = WGM * nN, gid = wgid / nig, fm = gid * WGM, gsz = (nM - fm) < WGM ? (nM - fm) : WGM;
        u.pm = fm + ((wgid % nig) % gsz); u.pn = (wgid % nig) / gsz; u.e = __builtin_amdgcn_readfirstlane(tile_e[u.pm]); return true;
    }
    __device__ __forceinline__ void a_ready(const Unit&) const {}
    __device__ __forceinline__ void done(const Unit&) const {}
};
template <class Epi, class Sched, bool ALIGN_EPI = false, bool SP2 = false, bool F8 = false>
__device__ __forceinline__ void gemm_phase(PG8_LAS unsigned char* lds, const Gemm g, const Sched& S, const Epi& E) {
    int tid_ = threadIdx.x; asm volatile("" : "+v"(tid_));
    const int tid = tid_, wid = __builtin_amdgcn_readfirstlane(tid >> 6), lane = tid & 63, wr = wid >> 2, wc = wid & 3, fr = lane & 15, fq = lane >> 4;
    const int K = g.K, nt = K / BK;
    unsigned voffA[2], voffB[2];
#pragma unroll
    for (int i = 0; i < 2; ++i) { int R, C; stage_rc(tid * 16 + i * 8192, R, C); const int Rb = Epi::PERM ? ((R & ~31) + perm32(R & 31)) : R;
        voffA[i] = (unsigned)(R * K + C) * 2u; voffB[i] = (unsigned)(Rb * K + C) * 2u; }
    const size_t kstep = (size_t)(BK * 2);
    const size_t hstep = (size_t)HALF * K * 2;
    const size_t tstep = 2 * hstep;
    const unsigned ldsw = (unsigned)wid * 1024u;
    const int aoff = lds_byte(wr * 64 + fr, fq * 8), boff = lds_byte(wc * 32 + fr, fq * 8);
#define PG8_SA(b, h) (((b) * 2 + (h)) * HTB)
#define PG8_SB(b, h) ((4 + (b) * 2 + (h)) * HTB)
#define PG8_STAGE(bufoff, gbase, voff) do { _Pragma("unroll") for (int _i = 0; _i < 2; ++_i) \
        __builtin_amdgcn_global_load_lds((const unsigned*)((const char*)(gbase) + (voff)[_i]), (PG8_LAS unsigned*)(lds + (bufoff) + ldsw + _i * 8192), 16, 0, 0); } while (0)
#define PG8_LD16(off) (*(const PG8_LAS v4i32*)(lds + (off)))
#define PG8_LDA(dst, b, h) do { if constexpr (F8) { _Pragma("unroll") for (int m = 0; m < 4; ++m) dst##8[m] = __builtin_shufflevector(PG8_LD16(PG8_SA(b, h) + aoff + m * 2048), PG8_LD16(PG8_SA(b, h) + aoff + m * 2048 + 1024), 0, 1, 2, 3, 4, 5, 6, 7); } \
        else { _Pragma("unroll") for (int m = 0; m < 4; ++m) _Pragma("unroll") for (int k = 0; k < 2; ++k) dst[m][k] = *(const PG8_LAS bf16x8*)(lds + PG8_SA(b, h) + aoff + m * 2048 + k * 1024); } } while (0)
#define PG8_LDB(dst, b, h) do { if constexpr (F8) { _Pragma("unroll") for (int n = 0; n < 2; ++n) dst##8[n] = __builtin_shufflevector(PG8_LD16(PG8_SB(b, h) + boff + n * 2048), PG8_LD16(PG8_SB(b, h) + boff + n * 2048 + 1024), 0, 1, 2, 3, 4, 5, 6, 7); } \
        else { _Pragma("unroll") for (int n = 0; n < 2; ++n) _Pragma("unroll") for (int k = 0; k < 2; ++k) dst[n][k] = *(const PG8_LAS bf16x8*)(lds + PG8_SB(b, h) + boff + n * 2048 + k * 1024); } } while (0)
#define PG8_MMA(ai, bj, At, Bt) do { __builtin_amdgcn_s_setprio(1); \
        if constexpr (F8) { _Pragma("unroll") for (int m = 0; m < 4; ++m) _Pragma("unroll") for (int n = 0; n < 2; ++n) \
            asm volatile("v_mfma_scale_f32_16x16x128_f8f6f4 %0, %1, %2, %0, %3, %3 op_sel_hi:[0,0,0]" : "+v"(acc[ai][bj][m][n]) : "v"(Bt##8[n]), "v"(At##8[m]), "v"(f8scale)); } \
        else { _Pragma("unroll") for (int m = 0; m < 4; ++m) _Pragma("unroll") for (int n = 0; n < 2; ++n) _Pragma("unroll") for (int k = 0; k < 2; ++k) \
            acc[ai][bj][m][n] = __builtin_amdgcn_mfma_f32_16x16x32_bf16(Bt[n][k], At[m][k], acc[ai][bj][m][n], 0, 0, 0); } \
        __builtin_amdgcn_s_setprio(0); } while (0)
#define PG8_WAIT_V(n) asm volatile("s_waitcnt vmcnt(" #n ")" ::: "memory")
#define PG8_WAIT_L(n) asm volatile("s_waitcnt lgkmcnt(" #n ")" ::: "memory")
#define PG8_BAR __builtin_amdgcn_s_barrier()
#define PG8_SCHED __builtin_amdgcn_sched_barrier(0)
    Unit cur, nxt; int ui = 0;
    if (!S.next(0, cur)) return;
    f32x4 acc[2][2][4][2];
#pragma unroll
    for (int a = 0; a < 2; ++a)
#pragma unroll
        for (int b = 0; b < 2; ++b)
#pragma unroll
            for (int m = 0; m < 4; ++m)
#pragma unroll
                for (int n = 0; n < 2; ++n) acc[a][b][m][n] = (f32x4){0.f, 0.f, 0.f, 0.f};
    bf16x8 At[4][2], B0[2][2], B1[2][2];
    v8i32 At8[4], B08[2], B18[2]; const int f8scale = 0x7f7f7f7f;
    const char* cA = (const char*)g.A + (size_t)cur.pm * tstep; const char* cB = (const char*)g.Bt + (size_t)cur.e * g.strideBe + (size_t)cur.pn * tstep;
    S.a_ready(cur);
    if constexpr (SP2) {
        PG8_STAGE(PG8_SB(0, 0), cB, voffB); PG8_STAGE(PG8_SB(0, 1), cB + hstep, voffB); PG8_STAGE(PG8_SA(0, 0), cA, voffA); PG8_STAGE(PG8_SA(0, 1), cA + hstep, voffA);
        if (wr == 1) PG8_BAR;
        PG8_WAIT_V(2); PG8_BAR;
        PG8_STAGE(PG8_SB(1, 0), cB + kstep, voffB); PG8_STAGE(PG8_SA(1, 0), cA + kstep, voffA); PG8_STAGE(PG8_SB(1, 1), cB + hstep + kstep, voffB);
        PG8_WAIT_V(6); PG8_BAR;
    } else {
        PG8_STAGE(PG8_SB(0, 0), cB, voffB); PG8_STAGE(PG8_SA(0, 0), cA, voffA); PG8_STAGE(PG8_SB(0, 1), cB + hstep, voffB); PG8_STAGE(PG8_SA(0, 1), cA + hstep, voffA);
        if (wr == 1) PG8_BAR;
        PG8_WAIT_V(4); PG8_BAR;
        PG8_STAGE(PG8_SB(1, 0), cB + kstep, voffB); PG8_STAGE(PG8_SA(1, 0), cA + kstep, voffA); PG8_STAGE(PG8_SB(1, 1), cB + hstep + kstep, voffB);
        PG8_WAIT_V(6); PG8_BAR;
    }
    for (;;) {
        const bool has_next = S.next(ui + 1, nxt);
        const char* nA = has_next ? (const char*)g.A + (size_t)nxt.pm * tstep : cA; const char* nB = has_next ? (const char*)g.Bt + (size_t)nxt.e * g.strideBe + (size_t)nxt.pn * tstep : cB;
#pragma unroll 1
        for (int t = 0; t < nt; t += 2) {
            const bool last = (t == nt - 2);
            const char* a1 = cA + (size_t)(t + 1) * kstep;
            const char* a2 = last ? nA : cA + (size_t)(t + 2) * kstep; const char* b2 = last ? nB : cB + (size_t)(t + 2) * kstep;
            const char* a3 = a2 + kstep; const char* b3 = b2 + kstep;
            if (last && has_next) S.a_ready(nxt);
            if constexpr (SP2) {
            PG8_LDB(B0, 0, 0); PG8_LDB(B1, 0, 1); PG8_SCHED; PG8_LDA(At, 0, 0); PG8_STAGE(PG8_SA(1, 1), a1 + hstep, voffA);
            PG8_WAIT_V(8); PG8_WAIT_L(0); PG8_BAR; PG8_MMA(0, 0, At, B0); PG8_MMA(0, 1, At, B1); PG8_BAR; PG8_SCHED;
            PG8_LDA(At, 0, 1); PG8_STAGE(PG8_SB(0, 0), b2, voffB); PG8_STAGE(PG8_SB(0, 1), b2 + hstep, voffB); PG8_STAGE(PG8_SA(0, 0), a2, voffA);
            PG8_WAIT_V(8); PG8_WAIT_L(0); PG8_BAR; PG8_MMA(1, 0, At, B0); PG8_MMA(1, 1, At, B1); PG8_BAR; PG8_SCHED;
            PG8_LDB(B0, 1, 0); PG8_LDB(B1, 1, 1); PG8_SCHED; PG8_LDA(At, 1, 0); PG8_STAGE(PG8_SA(0, 1), a2 + hstep, voffA);
            PG8_WAIT_V(8); PG8_WAIT_L(0); PG8_BAR; PG8_MMA(0, 0, At, B0); PG8_MMA(0, 1, At, B1); PG8_BAR; PG8_SCHED;
            PG8_LDA(At, 1, 1); PG8_STAGE(PG8_SB(1, 0), b3, voffB); PG8_STAGE(PG8_SB(1, 1), b3 + hstep, voffB); PG8_STAGE(PG8_SA(1, 0), a3, voffA);
            PG8_WAIT_V(8); PG8_WAIT_L(0); PG8_BAR; PG8_MMA(1, 0, At, B0); PG8_MMA(1, 1, At, B1); PG8_BAR; PG8_SCHED;
            } else {
            PG8_LDB(B0, 0, 0); PG8_SCHED; PG8_LDA(At, 0, 0); PG8_STAGE(PG8_SA(1, 1), a1 + hstep, voffA);
            PG8_WAIT_L(8); PG8_BAR; PG8_WAIT_L(0); PG8_MMA(0, 0, At, B0); PG8_BAR; PG8_SCHED;
            PG8_LDB(B1, 0, 1); PG8_STAGE(PG8_SB(0, 0), b2, voffB);
            PG8_BAR; PG8_WAIT_L(0); PG8_MMA(0, 1, At, B1); PG8_BAR;
            PG8_LDA(At, 0, 1); PG8_STAGE(PG8_SA(0, 0), a2, voffA);
            PG8_BAR; PG8_WAIT_L(0); PG8_MMA(1, 0, At, B0); PG8_BAR; PG8_SCHED;
            PG8_STAGE(PG8_SB(0, 1), b2 + hstep, voffB);
            PG8_WAIT_V(6); PG8_BAR; PG8_MMA(1, 1, At, B1); PG8_BAR;
            PG8_LDB(B0, 1, 0); PG8_SCHED; PG8_LDA(At, 1, 0); PG8_STAGE(PG8_SA(0, 1), a2 + hstep, voffA);
            PG8_WAIT_L(8); PG8_BAR; PG8_WAIT_L(0); PG8_MMA(0, 0, At, B0); PG8_BAR; PG8_SCHED;
            PG8_LDB(B1, 1, 1); PG8_STAGE(PG8_SB(1, 0), b3, voffB);
            PG8_BAR; PG8_WAIT_L(0); PG8_MMA(0, 1, At, B1); PG8_BAR;
            PG8_LDA(At, 1, 1); PG8_STAGE(PG8_SA(1, 0), a3, voffA);
            PG8_BAR; PG8_WAIT_L(0); PG8_MMA(1, 0, At, B0); PG8_BAR; PG8_SCHED;
            PG8_STAGE(PG8_SB(1, 1), b3 + hstep, voffB);
            PG8_WAIT_V(6); PG8_BAR; PG8_MMA(1, 1, At, B1); PG8_BAR;
            }
        }
        if constexpr (ALIGN_EPI) { if (wr == 0) PG8_BAR; }
        if constexpr (F8) asm volatile("s_nop 15\n\ts_nop 15\n\ts_nop 15" ::: "memory");
        if constexpr (!Epi::AFTER_DRAIN) { E(acc, cur, wr, wc, fr, fq); S.done(cur); }
        if (!has_next) break;
#pragma unroll
        for (int a = 0; a < 2; ++a)
#pragma unroll
            for (int b = 0; b < 2; ++b)
#pragma unroll
                for (int m = 0; m < 4; ++m)
#pragma unroll
                    for (int n = 0; n < 2; ++n) acc[a][b][m][n] = (f32x4){0.f, 0.f, 0.f, 0.f};
        cur = nxt; cA = nA; cB = nB; ++ui;
        if constexpr (ALIGN_EPI) { if (wr == 1) PG8_BAR; }
    }
    PG8_WAIT_V(0);
    if constexpr (!ALIGN_EPI) { if (wr == 0) PG8_BAR; }
    PG8_BAR;
    if constexpr (Epi::AFTER_DRAIN) { E.fused(acc, cur, wr, wc, fr, fq, lds, wid, lane); S.done(cur); }
#undef PG8_SA
#undef PG8_SB
#undef PG8_STAGE
#undef PG8_LD16
#undef PG8_LDA
#undef PG8_LDB
#undef PG8_MMA
#undef PG8_WAIT_V
#undef PG8_WAIT_L
#undef PG8_BAR
#undef PG8_SCHED
}
}

constexpr int NWAVES = 8;
constexpr int T = pg8::T, SEQ = pg8::SEQ, DM = pg8::DM, DIN = pg8::DIN, NE = 32, PLE = 256;
constexpr float EPS = pg8::EPS;
constexpr size_t MiB = 1u << 20;
constexpr size_t WS_CTL = 0, CTL_ZERO_BYTES = 1 * MiB;
constexpr size_t WS_WT_IN = 2 * MiB, WS_WT_OUT = 9 * MiB, WS_WT_PG = 11 * MiB, WS_WT_PP = 13 * MiB;
constexpr size_t WS_GAINS = 13 * MiB + 512 * 1024;
constexpr size_t WS_WRT = 13 * MiB + 576 * 1024;
constexpr size_t WS_ROPEC = 14 * MiB, WS_ROPES = 16 * MiB, WS_PB = 18 * MiB, WS_ROUTE = 26 * MiB;
constexpr size_t WS_WT_UG = 32 * MiB, WS_WT_DN = 160 * MiB;
constexpr size_t WS_XN = 224 * MiB;
constexpr size_t WS_HM = 256 * MiB;
constexpr size_t WS_RG = 352 * MiB;
constexpr size_t WS_Y = 368 * MiB;
constexpr size_t WS_PJ = 400 * MiB;
constexpr size_t WS_XS = 432 * MiB, WS_H = 576 * MiB, WS_YS = 720 * MiB;
constexpr size_t WS_END = 864 * MiB;
constexpr int CW_TMO = 0, CW_CODE = 1;
constexpr int CW_BAR = 4096;
constexpr int RING_OFF = 0, RING_BYTES = 131072;
constexpr int LDSCTL_OFF = RING_BYTES, MISC_OFF = LDSCTL_OFF + 320;
constexpr int LDS_BYTES = 147456;
#define GAS __attribute__((address_space(1)))
#define LAS __attribute__((address_space(3)))
typedef unsigned short bf16;
typedef unsigned v4u __attribute__((ext_vector_type(4)));
typedef float f32x4 __attribute__((ext_vector_type(4)));
typedef short bf16x8 __attribute__((ext_vector_type(8)));
typedef unsigned u32x4_t __attribute__((ext_vector_type(4)));
typedef unsigned u32x2_t __attribute__((ext_vector_type(2)));
typedef GAS unsigned gu32;
typedef GAS unsigned long long gu64;
#define RLX_AGENT __ATOMIC_RELAXED, __HIP_MEMORY_SCOPE_AGENT
#define LDS_WAIT() asm volatile("s_waitcnt lgkmcnt(0)" ::: "memory")
#define VM_WAIT() asm volatile("s_waitcnt vmcnt(0)" ::: "memory")
__device__ __forceinline__ unsigned long long rt() { return __builtin_amdgcn_s_memrealtime(); }
__device__ __forceinline__ unsigned f2bf(float f) { unsigned u = __builtin_bit_cast(unsigned, f); return (u + 0x7fffu + ((u >> 16) & 1u)) >> 16; }
__device__ __forceinline__ unsigned pk2(float lo, float hi) { return f2bf(lo) | (f2bf(hi) << 16); }

#define XB_TMO      128
#define XB_XCNT(j)  (256  + 64 * (j))
#define XB_XSUB(j)  (1280 + 64 * (j))
#define XB_XGEN(j)  (2304 + 64 * (j))
#define XB_TOP      3328
#define XB_TOPGEN   3392
#define XCD_BAR_WORDS 3456
#define XB_SPIN_CAP (1u << 18)

__device__ __forceinline__ unsigned xb_ld(unsigned* p)              { return __hip_atomic_load(p, __ATOMIC_RELAXED, __HIP_MEMORY_SCOPE_AGENT); }
__device__ __forceinline__ unsigned xb_add(unsigned* p, unsigned v) { return __hip_atomic_fetch_add(p, v, __ATOMIC_RELAXED, __HIP_MEMORY_SCOPE_AGENT); }
__device__ __forceinline__ unsigned xb_xcc_id() { return (unsigned)__builtin_amdgcn_s_getreg((3 << 11) | 20) & 0xFu; }
#define XB_SPIN(cond, bar) do { unsigned _sp = 0; while (cond) { __builtin_amdgcn_s_sleep(1); \
    if ((++_sp & 255u) == 0u) { if (xb_ld(&(bar)[XB_TMO])) break; if (_sp > XB_SPIN_CAP) { atomicAdd(&(bar)[XB_TMO], 1u); break; } } } } while (0)

struct XcdBarrier {
    unsigned* bar; unsigned x;
    volatile LAS unsigned* st;
};

__device__ __forceinline__ XcdBarrier xcd_barrier_post(unsigned* bar, volatile LAS unsigned* st) {
    XcdBarrier b; b.bar = bar; b.x = xb_xcc_id(); b.st = st;
    if (threadIdx.x == 0) (void)xb_add(&bar[XB_XCNT(b.x)], 1u);
    return b;
}
__device__ __forceinline__ void xcd_barrier_complete(unsigned* bar, unsigned x, unsigned& nloc, unsigned& nx) {
    const unsigned G = gridDim.x * gridDim.y * gridDim.z;
    unsigned sum, cnt, mine, sp = 0u;
    for (;;) {
        sum = 0u; cnt = 0u; mine = 0u;
#pragma unroll
        for (unsigned j = 0; j < 16; ++j) { const unsigned c = xb_ld(&bar[XB_XCNT(j)]); sum += c; cnt += (c > 0u) ? 1u : 0u; mine = (j == x) ? c : mine; }
        if (sum == G) break;
        __builtin_amdgcn_s_sleep(1);
        if ((++sp & 255u) == 0u) { if (xb_ld(&bar[XB_TMO])) break; if (sp > XB_SPIN_CAP) { atomicAdd(&bar[XB_TMO], 1u); break; } }
    }
    nloc = mine > 0u ? mine : 1u; nx = cnt > 0u ? cnt : 1u;
}

__device__ __forceinline__ void xcd_barrier(const XcdBarrier& b) {
    asm volatile("s_waitcnt vmcnt(0)" ::: "memory");
    __syncthreads();
    if (threadIdx.x == 0) {
        unsigned* bar = b.bar;
        __builtin_amdgcn_s_waitcnt(0);
        unsigned nloc = b.st[0], nx = b.st[1];
        if (nloc == 0u) { xcd_barrier_complete(bar, b.x, nloc, nx); b.st[0] = nloc; b.st[1] = nx; }
        const unsigned old = xb_add(&bar[XB_XSUB(b.x)], 1u);
        const unsigned gen = old / nloc;
        const unsigned tgen = gen;
        if (old + 1u == (gen + 1u) * nloc) {
            __builtin_amdgcn_fence(__ATOMIC_RELEASE, "agent");
            asm volatile("s_waitcnt vmcnt(0)" ::: "memory");
            const unsigned og = xb_add(&bar[XB_TOP], 1u);
            const unsigned tg = og / nx;
            if (og + 1u == (tg + 1u) * nx) xb_add(&bar[XB_TOPGEN], 1u);
            else XB_SPIN(xb_ld(&bar[XB_TOPGEN]) == tg, bar);
        } else {
            XB_SPIN(xb_ld(&bar[XB_TOPGEN]) == tgen, bar);
        }
        __builtin_amdgcn_fence(__ATOMIC_ACQUIRE, "agent");
        asm volatile("s_waitcnt vmcnt(0)" ::: "memory");
    }
    __syncthreads();
}

struct Args {
    const float* x; const float* p; const int* positions; const float* g_mix; const float* w_in;
    const float* sbq; const float* sbk; const float* rq; const float* rk; const float* gn_g; const float* gn_b; const float* w_out;
    const float* g_ffn; const float* w_r; const float* b_r; const float* w_ug; const float* b_ug; const float* w_dn; const float* b_dn;
    const float* g_ple; const float* w_pg; const float* w_pp;
    float* out; unsigned char* ws; int ph_lo, ph_hi;
};
struct Frame {
    LAS unsigned char* lds;
    volatile LAS unsigned* MISC;
    gu32* ctl;
    int wave;
    int vcu, G;
};
__device__ __forceinline__ int tid_now() { int t = threadIdx.x; asm volatile("" : "+v"(t)); return t; }
__device__ __forceinline__ float wave_sum(float v) {
#pragma unroll
    for (int o = 1; o < 64; o <<= 1) v += __shfl_xor(v, o);
    return v;
}
__device__ __forceinline__ unsigned cvtpk(float lo, float hi) { return pg8::cvt_pk_bf16(lo, hi); }

enum { MAP_NAT = 0, MAP_IN = 1, MAP_UG = 2 };
__device__ __forceinline__ void p0_item(const float* __restrict__ W, int N, int K, bf16* __restrict__ WT, int kb, int nb, int mapmode, LAS unsigned char* scr, int lane) {
    const int np = 64 * nb + 4 * (lane & 15);
    int src = np;
    if (mapmode == MAP_IN) { const int pn = np >> 8, L = np & 255, bj = L >> 7, wc = (L >> 5) & 3, e = L & 31; src = 256 * pn + 64 * wc + 32 * bj + e; }
    else if (mapmode == MAP_UG) { const int pn = np >> 8, L = np & 255, bj = L >> 7, i = L & 127; src = 1024 * bj + 128 * pn + i; }
    const float* gp = W + (size_t)(64 * kb + (lane >> 4)) * N + src;
    f32x4 v[16];
#pragma unroll
    for (int i = 0; i < 16; ++i) v[i] = *(const f32x4*)(gp + (size_t)(4 * i) * N);
#pragma unroll
    for (int i = 0; i < 16; ++i) {
        LAS unsigned* d = (LAS unsigned*)(scr + (4 * i + (lane >> 4)) * 132 + 8 * (lane & 15));
        d[0] = cvtpk(v[i][0], v[i][1]); d[1] = cvtpk(v[i][2], v[i][3]);
    }
    LDS_WAIT(); asm volatile("" ::: "memory");
    const int c = lane & 7;
#pragma unroll
    for (int it = 0; it < 4; ++it) {
        const int nl = 16 * it + 2 * (lane >> 3);
        unsigned d[8];
#pragma unroll
        for (int j = 0; j < 8; ++j) d[j] = *(const LAS unsigned*)(scr + (8 * c + j) * 132 + 2 * nl);
        v4u o0, o1;
        o0.x = (d[0] & 0xffffu) | (d[1] << 16); o0.y = (d[2] & 0xffffu) | (d[3] << 16); o0.z = (d[4] & 0xffffu) | (d[5] << 16); o0.w = (d[6] & 0xffffu) | (d[7] << 16);
        o1.x = (d[0] >> 16) | (d[1] & 0xffff0000u); o1.y = (d[2] >> 16) | (d[3] & 0xffff0000u); o1.z = (d[4] >> 16) | (d[5] & 0xffff0000u); o1.w = (d[6] >> 16) | (d[7] & 0xffff0000u);
        bf16* dst = WT + (size_t)(64 * nb + nl) * K + 64 * kb + 8 * c;
        *(v4u*)dst = o0; *(v4u*)(dst + K) = o1;
    }
    LDS_WAIT(); asm volatile("" ::: "memory");
}
__device__ __forceinline__ unsigned pk4_fp8(float a, float b, float c, float d) { int r = __builtin_amdgcn_cvt_pk_fp8_f32(a, b, 0, false); r = __builtin_amdgcn_cvt_pk_fp8_f32(c, d, r, true); return (unsigned)r; }
__device__ __forceinline__ void p0_item_f8(const float* __restrict__ W, int N, int K, unsigned char* __restrict__ WT, int kb, int nb, int mapmode, LAS unsigned char* scr, int lane) {
    const int np = 64 * nb + 4 * (lane & 15);
    int src = np;
    if (mapmode == MAP_UG) { const int pn = np >> 8, L = np & 255, bj = L >> 7, i = L & 127; src = 1024 * bj + 128 * pn + i; }
    const float* gp = W + (size_t)(64 * kb + (lane >> 4)) * N + src;
    f32x4 v[16];
#pragma unroll
    for (int i = 0; i < 16; ++i) v[i] = *(const f32x4*)(gp + (size_t)(4 * i) * N);
#pragma unroll
    for (int i = 0; i < 16; ++i) *(LAS unsigned*)(scr + (4 * i + (lane >> 4)) * 68 + 4 * (lane & 15)) = pk4_fp8(v[i][0] * 64.0f, v[i][1] * 64.0f, v[i][2] * 64.0f, v[i][3] * 64.0f);
    LDS_WAIT(); asm volatile("" ::: "memory");
    const int nq = lane & 15, kg = lane >> 4;
    unsigned d[16];
#pragma unroll
    for (int j = 0; j < 16; ++j) d[j] = *(const LAS unsigned*)(scr + (16 * kg + j) * 68 + 4 * nq);
#pragma unroll
    for (int t = 0; t < 4; ++t) {
        v4u o;
#pragma unroll
        for (int q = 0; q < 4; ++q) o[q] = ((d[4 * q] >> (8 * t)) & 0xffu) | (((d[4 * q + 1] >> (8 * t)) & 0xffu) << 8) | (((d[4 * q + 2] >> (8 * t)) & 0xffu) << 16) | (((d[4 * q + 3] >> (8 * t)) & 0xffu) << 24);
        *(v4u*)(WT + (size_t)(64 * nb + 4 * nq + t) * K + 64 * kb + 16 * kg) = o;
    }
    LDS_WAIT(); asm volatile("" ::: "memory");
}
struct P0D { const float* gp; int N, K, kb, nb; bf16* W16; unsigned char* W8; const float* rsc; };
__device__ __forceinline__ int p0_src_col(int np, int mapmode) {
    int src = np;
    if (mapmode == MAP_IN) { const int pn = np >> 8, L = np & 255, bj = L >> 7, wc = (L >> 5) & 3, e = L & 31; src = 256 * pn + 64 * wc + 32 * bj + e; }
    else if (mapmode == MAP_UG) { const int pn = np >> 8, L = np & 255, bj = L >> 7, i = L & 127; src = 1024 * bj + 128 * pn + i; }
    return src;
}
__device__ __forceinline__ P0D p0_mk(const float* W, int N, int K, bf16* W16, unsigned char* W8, int kb, int nb, int mapmode, int lane, const float* rsc = nullptr) {
    P0D d; d.N = N; d.K = K; d.kb = kb; d.nb = nb; d.W16 = W16; d.W8 = W8;
    if (W8) {
        d.rsc = rsc ? rsc + 128 * kb + (lane >> 3) : nullptr;
        d.gp = W + (size_t)(128 * kb + (lane >> 3)) * N + p0_src_col(32 * nb + 4 * (lane & 7), mapmode);
    } else {
        d.rsc = nullptr;
        d.gp = W + (size_t)(64 * kb + (lane >> 4)) * N + p0_src_col(64 * nb + 4 * (lane & 15), mapmode);
    }
    return d;
}
__device__ __forceinline__ void p0_load(const P0D& d, f32x4 (&v)[16]) {
#pragma unroll
    for (int i = 0; i < 16; ++i) v[i] = *(const f32x4*)(d.gp + (size_t)((d.W8 ? 8 : 4) * i) * d.N);
}
__device__ __forceinline__ void p0_finish(const P0D& d, const f32x4 (&v)[16], LAS unsigned char* scr, int lane, const int pm = 0) {
    if (pm == 1) { _Pragma("unroll") for (int i = 0; i < 16; ++i) asm volatile("" :: "v"(v[i])); return; }
    if (d.W16) {
#pragma unroll
        for (int i = 0; i < 16; ++i) { LAS unsigned* q = (LAS unsigned*)(scr + (4 * i + (lane >> 4)) * 132 + 8 * (lane & 15)); q[0] = cvtpk(v[i][0], v[i][1]); q[1] = cvtpk(v[i][2], v[i][3]); }
        LDS_WAIT(); asm volatile("" ::: "memory");
        const int c = lane & 7;
#pragma unroll
        for (int it = 0; it < 4; ++it) {
            const int nl = 16 * it + 2 * (lane >> 3);
            unsigned x[8];
#pragma unroll
            for (int j = 0; j < 8; ++j) x[j] = *(const LAS unsigned*)(scr + (8 * c + j) * 132 + 2 * nl);
            v4u o0, o1;
            o0.x = (x[0] & 0xffffu) | (x[1] << 16); o0.y = (x[2] & 0xffffu) | (x[3] << 16); o0.z = (x[4] & 0xffffu) | (x[5] << 16); o0.w = (x[6] & 0xffffu) | (x[7] << 16);
            o1.x = (x[0] >> 16) | (x[1] & 0xffff0000u); o1.y = (x[2] >> 16) | (x[3] & 0xffff0000u); o1.z = (x[4] >> 16) | (x[5] & 0xffff0000u); o1.w = (x[6] >> 16) | (x[7] & 0xffff0000u);
            bf16* dst = d.W16 + (size_t)(64 * d.nb + nl) * d.K + 64 * d.kb + 8 * c;
            if (pm == 0 || pm == 3) { *(v4u*)dst = o0; *(v4u*)(dst + d.K) = o1; } else asm volatile("" :: "v"(o0), "v"(o1));
        }
    } else {
#pragma unroll
        for (int i = 0; i < 16; ++i) { const float sc = d.rsc ? d.rsc[8 * i] * 64.0f : 64.0f; *(LAS unsigned*)(scr + (8 * i + (lane >> 3)) * 36 + 4 * (lane & 7)) = pk4_fp8(v[i][0] * sc, v[i][1] * sc, v[i][2] * sc, v[i][3] * sc); }
        LDS_WAIT(); asm volatile("" ::: "memory");
        const int nq = lane & 7, kg = lane >> 3;
        unsigned x[16];
#pragma unroll
        for (int j = 0; j < 16; ++j) x[j] = *(const LAS unsigned*)(scr + (16 * kg + j) * 36 + 4 * nq);
#pragma unroll
        for (int t = 0; t < 4; ++t) {
            v4u o;
#pragma unroll
            for (int q = 0; q < 4; ++q) o[q] = ((x[4 * q] >> (8 * t)) & 0xffu) | (((x[4 * q + 1] >> (8 * t)) & 0xffu) << 8) | (((x[4 * q + 2] >> (8 * t)) & 0xffu) << 16) | (((x[4 * q + 3] >> (8 * t)) & 0xffu) << 24);
            if (pm == 0 || pm == 3) *(v4u*)(d.W8 + (size_t)(32 * d.nb + 4 * nq + t) * d.K + 128 * d.kb + 16 * kg) = o; else asm volatile("" :: "v"(o));
        }
    }
    LDS_WAIT(); asm volatile("" ::: "memory");
}
__device__ __forceinline__ P0D p0_decode(const Args& a, unsigned char* ws, int it, int lane) {
    constexpr int I_IN = 16 * 56, I_OUT = 256, I_PG = 256, I_PP = 4 * 16, I_UG = 16 * 32, I_DN = 256;
    int r = it;
    if (r < I_IN) return p0_mk(a.w_in, DIN, DM, (bf16*)(ws + WS_WT_IN), nullptr, r / 56, r % 56, MAP_IN, lane); r -= I_IN;
    if (r < I_OUT) return p0_mk(a.w_out, DM, DM, (bf16*)(ws + WS_WT_OUT), nullptr, r / 16, r % 16, MAP_NAT, lane); r -= I_OUT;
    if (r < I_PG) return p0_mk(a.w_pg, DM, DM, nullptr, (unsigned char*)(ws + WS_WT_PG), r / 32, r % 32, MAP_NAT, lane); r -= I_PG;
    if (r < I_PP) return p0_mk(a.w_pp, DM, PLE, (bf16*)(ws + WS_WT_PP), nullptr, r / 16, r % 16, MAP_NAT, lane); r -= I_PP;
    if (r < NE * I_UG) { const int e = r / I_UG, q = r % I_UG; return p0_mk(a.w_ug + (size_t)e * DM * 2048, 2048, DM, nullptr, (unsigned char*)(ws + WS_WT_UG) + (size_t)e * 2048 * DM, q / 64, q % 64, MAP_UG, lane, a.g_ffn); } r -= NE * I_UG;
    { const int e = r / I_DN, q = r % I_DN; return p0_mk(a.w_dn + (size_t)e * DM * DM, DM, DM, nullptr, (unsigned char*)(ws + WS_WT_DN) + (size_t)e * DM * DM, q / 32, q % 32, MAP_NAT, lane); }
}
__device__ __forceinline__ void rms_row_to_bf16(const float* xrow, const float* g, bf16* orow, int lane) {
    const f32x4* xr = (const f32x4*)xrow + lane;
    f32x4 v[4]; float s = 0.f;
#pragma unroll
    for (int j = 0; j < 4; ++j) { v[j] = xr[64 * j]; s += (v[j][0] * v[j][0] + v[j][1] * v[j][1]) + (v[j][2] * v[j][2] + v[j][3] * v[j][3]); }
    const float rstd = rsqrtf(wave_sum(s) * (1.f / DM) + EPS);
    unsigned long long* o8 = (unsigned long long*)orow + lane;
#pragma unroll
    for (int j = 0; j < 4; ++j) { const f32x4 gg = ((const f32x4*)g)[lane + 64 * j];
        o8[64 * j] = (unsigned long long)cvtpk(v[j][0] * rstd * gg[0], v[j][1] * rstd * gg[1]) | ((unsigned long long)cvtpk(v[j][2] * rstd * gg[2], v[j][3] * rstd * gg[3]) << 32); }
}
__device__ __forceinline__ void p0_prologue(Frame& F, const Args& a, const int pm = 0) {
    unsigned char* ws = a.ws; const int tid = tid_now(), lane = tid & 63;
    LAS unsigned char* scr = F.lds + RING_OFF + F.wave * 8448;
    const int gw = F.vcu * NWAVES + F.wave, NGW = F.G * NWAVES;
    constexpr int I_IN = 16 * 56, I_OUT = 256, I_PG = 256, I_PP = 4 * 16, I_UG = 16 * 32, I_DN = 256;
    constexpr int NITEMS = I_IN + I_OUT + I_PG + I_PP + NE * I_UG + NE * I_DN;
    if (gw < NITEMS) {
        int it = gw; P0D d0 = p0_decode(a, ws, it, lane), d1 = d0; f32x4 va[16], vb[16]; p0_load(d0, va);
        for (;;) {
            const int it1 = it + NGW; const bool h1 = it1 < NITEMS;
            if (h1) { d1 = p0_decode(a, ws, it1, lane); p0_load(d1, vb); }
            p0_finish(d0, va, scr, lane, pm);
            if (!h1) break;
            const int it2 = it1 + NGW; const bool h2 = it2 < NITEMS;
            if (h2) { d0 = p0_decode(a, ws, it2, lane); p0_load(d0, va); }
            p0_finish(d1, vb, scr, lane, pm);
            if (!h2) break;
            it = it2;
        }
    }
    if (pm != 0) return;
    if (blockIdx.x == 0 && tid < 256) { const int t = tid; const float* srcs = (t < 64) ? a.sbq : (t < 128) ? a.sbk : (t < 192) ? a.rq : a.rk; ((float*)(ws + WS_GAINS))[t] = srcs[t & 63]; }
    {
        f32x4 gg[4];
#pragma unroll
        for (int j = 0; j < 4; ++j) gg[j] = ((const f32x4*)a.g_mix)[lane + 64 * j];
        for (int m0 = 4 * gw; m0 < T; m0 += 4 * NGW) {
            f32x4 v[4][4];
#pragma unroll
            for (int r = 0; r < 4; ++r)
#pragma unroll
                for (int j = 0; j < 4; ++j) v[r][j] = ((const f32x4*)(a.x + (size_t)(m0 + r) * DM))[lane + 64 * j];
#pragma unroll
            for (int r = 0; r < 4; ++r) {
                float ss = 0.f;
#pragma unroll
                for (int j = 0; j < 4; ++j) ss += (v[r][j][0] * v[r][j][0] + v[r][j][1] * v[r][j][1]) + (v[r][j][2] * v[r][j][2] + v[r][j][3] * v[r][j][3]);
                const float rstd = rsqrtf(wave_sum(ss) * (1.f / DM) + EPS);
                unsigned long long* o8 = (unsigned long long*)((bf16*)(ws + WS_XN) + (size_t)(m0 + r) * DM) + lane;
#pragma unroll
                for (int j = 0; j < 4; ++j) o8[64 * j] = (unsigned long long)cvtpk(v[r][j][0] * rstd * gg[j][0], v[r][j][1] * rstd * gg[j][1]) | ((unsigned long long)cvtpk(v[r][j][2] * rstd * gg[j][2], v[r][j][3] * rstd * gg[j][3]) << 32);
            }
        }
    }
    { const int gt = gw * 64 + lane, NGT = NGW * 64;
      for (int i0 = gt; i0 < T * PLE / 8; i0 += 4 * NGT) {
          f32x4 a0[4], a1[4];
#pragma unroll
          for (int q = 0; q < 4; ++q) { const int i = i0 + q * NGT; if (i < T * PLE / 8) { a0[q] = ((const f32x4*)a.p)[2 * i]; a1[q] = ((const f32x4*)a.p)[2 * i + 1]; } }
#pragma unroll
          for (int q = 0; q < 4; ++q) { const int i = i0 + q * NGT; if (i < T * PLE / 8) { v4u o; o.x = cvtpk(a0[q][0], a0[q][1]); o.y = cvtpk(a0[q][2], a0[q][3]); o.z = cvtpk(a1[q][0], a1[q][1]); o.w = cvtpk(a1[q][2], a1[q][3]); ((v4u*)(ws + WS_PB))[i] = o; } }
      }
      for (int i = gt; i < NE * DM; i += NGT) { const int e = i >> 10, k = i & (DM - 1); const float wv = a.w_r[(size_t)k * NE + e] * a.g_ffn[k];
          const unsigned hi = cvtpk(wv, 0.f) & 0xffffu; const unsigned lo = cvtpk(wv - __uint_as_float(hi << 16), 0.f) & 0xffffu;
          ((bf16*)(ws + WS_WRT))[i] = (bf16)hi; ((bf16*)(ws + WS_WRT))[NE * DM + i] = (bf16)lo; }
      float* rc = (float*)(ws + WS_ROPEC); float* rs = (float*)(ws + WS_ROPES);
      for (int i = gt; i < T * 32; i += NGT) { const int row = i >> 5, f = i & 31;
          const float inv_freq = exp2f(-(float)f * (13.287712379549449f / 32.0f));   const float ang = (float)a.positions[row] * inv_freq;
          float sn, cs; sincosf(ang, &sn, &cs); rc[i] = cs; rs[i] = sn; } }
}

namespace att {
typedef short bf16x8 __attribute__((ext_vector_type(8)));
typedef short s16x4 __attribute__((ext_vector_type(4)));
typedef float f32x16 __attribute__((ext_vector_type(16)));
typedef short v4i16_t __attribute__((ext_vector_type(4)));
constexpr int LK = 0, LV = 24576, LFLAG = 49152;
__device__ __forceinline__ s16x4 vtr(LAS const unsigned char* p) { return __builtin_bit_cast(s16x4, __builtin_amdgcn_ds_read_tr16_b64_v4i16((LAS v4i16_t*)p)); }
__device__ __forceinline__ int crow(int r, int hi) { return (r & 3) + 8 * (r >> 2) + 4 * hi; }
struct AttnArgs { const bf16* hm; const bf16* rg; bf16* Y; const float* gn_g; const float* gn_b; };

template <int MODE> __device__ __forceinline__ void attn_unit(LAS unsigned char* lds, const AttnArgs& A, int b, int h, int qb) {
    int tid_ = threadIdx.x; asm volatile("" : "+v"(tid_));
    const int tid = tid_, lane = tid & 63, r32 = lane & 31, hh = lane >> 5;
    const int w = __builtin_amdgcn_readfirstlane(tid >> 6);
    const int q0 = qb * 256, qw = q0 + 32 * w;
    const size_t TS = (size_t)T * 512;
    const size_t hoff = (size_t)(b * 8 + h) * SEQ * 64;
    const bf16* Qp = A.hm + (MODE == 0 ? 0 : 3) * TS + hoff;
    const bf16* Kp = A.hm + (MODE == 0 ? 1 : 4) * TS + hoff;
    const bf16* Vp = A.hm + (MODE == 0 ? 2 : 5) * TS + hoff;
    bf16x8 qf[4];
#pragma unroll
    for (int ds = 0; ds < 4; ++ds) qf[ds] = *(const bf16x8*)(Qp + (size_t)(qw + r32) * 64 + 16 * ds + 8 * hh);
    f32x16 o[2];
#pragma unroll
    for (int r = 0; r < 16; ++r) { o[0][r] = 0.f; o[1][r] = 0.f; }
    float carry = 1.0f;
    const int jmax = (q0 + 255) >> 6, jd = (qw + 31) >> 6;
    const float lg2g = __log2f(1.0f - __builtin_amdgcn_exp2f(-5.0f - (float)h));
    const int krow = 8 * w + (lane >> 3);
    const bf16* Kt = Kp + (size_t)krow * 64 + (((lane & 7) ^ ((krow >> 1) & 7)) << 3); const bf16* Vt = Vp + (size_t)w * 512 + lane * 8;
    volatile LAS unsigned* flags = (volatile LAS unsigned*)(lds + LFLAG);
#define ATT_DMA(t, so) do { __builtin_amdgcn_global_load_lds((const unsigned*)(Kt + (size_t)(t) * 4096), (LAS unsigned*)(lds + LK + (so) + w * 1024), 16, 0, 0); \
                            __builtin_amdgcn_global_load_lds((const unsigned*)(Vt + (size_t)(t) * 4096), (LAS unsigned*)(lds + LV + (so) + w * 1024), 16, 0, 0); } while (0)
    ATT_DMA(jmax, 0);
    if (jmax >= 1) { ATT_DMA(jmax - 1, 8192); asm volatile("s_waitcnt vmcnt(2)\n\ts_barrier" ::: "memory"); }
    else asm volatile("s_waitcnt vmcnt(0)\n\ts_barrier" ::: "memory");
    bool finished = false;
    int so_cur = 0, so_new = 16384;
    for (int j = jmax; j >= 0; --j) {
        const int cur = j & 1;
        if (j >= 2) ATT_DMA(j - 2, so_new);
        if (j <= jd && !finished) {
            LAS const unsigned char* Kb = lds + LK + so_cur;
            LAS const unsigned char* Vb = lds + LV + so_cur;
            f32x16 p[2];
#pragma unroll
            for (int r = 0; r < 16; ++r) { p[0][r] = 0.f; p[1][r] = 0.f; }
            bf16x8 kf[4][2];
            const int ksw = (r32 >> 1) & 7;
#pragma unroll
            for (int ds = 0; ds < 4; ++ds) { kf[ds][0] = *(LAS const bf16x8*)(Kb + r32 * 128 + (((2 * ds + hh) ^ ksw) << 4)); kf[ds][1] = *(LAS const bf16x8*)(Kb + 4096 + r32 * 128 + (((2 * ds + hh) ^ ksw) << 4)); }
#pragma unroll
            for (int ds = 0; ds < 4; ++ds) {
                p[0] = __builtin_amdgcn_mfma_f32_32x32x16_bf16(kf[ds][0], qf[ds], p[0], 0, 0, 0);
                p[1] = __builtin_amdgcn_mfma_f32_32x32x16_bf16(kf[ds][1], qf[ds], p[1], 0, 0, 0);
            }
            const bool diag = (j == jd);
            const int qg = qw + r32, kv0 = 64 * j + 4 * hh;
            if (MODE == 0) {
                float om[2][16];
#pragma unroll
                for (int hf = 0; hf < 2; ++hf)
#pragma unroll
                    for (int r = 0; r < 16; ++r) {
                        const float Z = p[hf][r];
                        const float a = __builtin_amdgcn_exp2f(-__builtin_fabsf(Z));
                        const float rc = __builtin_amdgcn_rcpf(1.0f + a), ar = a * rc;
                        const bool pos = Z >= 0.f;
                        p[hf][r] = pos ? rc : ar;
                        om[hf][r] = pos ? ar : rc;
                    }
                if (diag) {
#pragma unroll
                    for (int hf = 0; hf < 2; ++hf)
#pragma unroll
                        for (int r = 0; r < 16; ++r) { const bool valid = kv0 + 32 * hf + (r & 3) + 8 * (r >> 2) < qg; p[hf][r] = valid ? p[hf][r] : 0.f; om[hf][r] = valid ? om[hf][r] : 1.0f; }
                }
                float gs[8], ot[8];
#pragma unroll
                for (int m = 0; m < 8; ++m) { const int hf = m >> 2, g = m & 3; gs[m] = (om[hf][4 * g] * om[hf][4 * g + 1]) * (om[hf][4 * g + 2] * om[hf][4 * g + 3]); ot[m] = __shfl_xor(gs[m], 32); }
                float ps[8];
                ps[7] = 1.0f;
#pragma unroll
                for (int m = 6; m >= 0; --m) ps[m] = ps[m + 1] * (gs[m + 1] * ot[m + 1]);
                const float total = ps[0] * (gs[0] * ot[0]);
#pragma unroll
                for (int m = 0; m < 8; ++m) {
                    const int hf = m >> 2, g = m & 3;
                    float tail = carry * (hh ? ps[m] : ps[m] * ot[m]);
#pragma unroll
                    for (int i = 3; i >= 0; --i) { const int r = 4 * g + i; const float o1 = om[hf][r]; p[hf][r] *= tail; tail *= o1; }
                }
                carry *= total;
                finished = __all(carry < 1.0e-37f);
            } else {
                const float ct = __builtin_amdgcn_exp2f(lg2g * (float)(qw - 64 * j));
#pragma unroll
                for (int hf = 0; hf < 2; ++hf)
#pragma unroll
                    for (int r = 0; r < 16; ++r) p[hf][r] *= ct;
                if (diag) {
#pragma unroll
                    for (int hf = 0; hf < 2; ++hf)
#pragma unroll
                        for (int r = 0; r < 16; ++r) { const bool valid = kv0 + 32 * hf + (r & 3) + 8 * (r >> 2) <= qg; p[hf][r] = valid ? p[hf][r] : 0.f; }
                }
            }
            {
                const unsigned vbase = (unsigned)(uintptr_t)(Vb + (4 * hh + ((lane & 15) >> 2)) * 128 + (16 * ((lane >> 4) & 1) + 4 * (lane & 3)) * 2);
                s16x4 vl[2][2][2], vh[2][2][2];
#pragma unroll
                for (int hf = 0; hf < 2; ++hf)
#pragma unroll
                    for (int s = 0; s < 2; ++s)
#pragma unroll
                        for (int d0 = 0; d0 < 2; ++d0) {
                            asm volatile("ds_read_b64_tr_b16 %0, %1 offset:%c2" : "=&v"(vl[hf][s][d0]) : "v"(vbase), "i"(hf * 4096 + s * 2048 + d0 * 64) : "memory");
                            asm volatile("ds_read_b64_tr_b16 %0, %1 offset:%c2" : "=&v"(vh[hf][s][d0]) : "v"(vbase), "i"(hf * 4096 + s * 2048 + d0 * 64 + 1024) : "memory");
                        }
                bf16x8 wfr[2][2];
#pragma unroll
                for (int hf = 0; hf < 2; ++hf)
#pragma unroll
                    for (int s = 0; s < 2; ++s) {
                        u32x4_t wq;
                        wq.x = pg8::cvt_pk_bf16(p[hf][8 * s + 0], p[hf][8 * s + 1]); wq.y = pg8::cvt_pk_bf16(p[hf][8 * s + 2], p[hf][8 * s + 3]);
                        wq.z = pg8::cvt_pk_bf16(p[hf][8 * s + 4], p[hf][8 * s + 5]); wq.w = pg8::cvt_pk_bf16(p[hf][8 * s + 6], p[hf][8 * s + 7]);
                        wfr[hf][s] = __builtin_bit_cast(bf16x8, wq);
                    }
                asm volatile("s_waitcnt lgkmcnt(0)" ::: "memory"); __builtin_amdgcn_sched_barrier(0);
#pragma unroll
                for (int hf = 0; hf < 2; ++hf)
#pragma unroll
                    for (int s = 0; s < 2; ++s)
#pragma unroll
                        for (int d0 = 0; d0 < 2; ++d0) {
                            const s16x4 lo = vl[hf][s][d0], hi = vh[hf][s][d0];
                            const bf16x8 vf = (bf16x8){lo[0], lo[1], lo[2], lo[3], hi[0], hi[1], hi[2], hi[3]};
                            o[d0] = __builtin_amdgcn_mfma_f32_32x32x16_bf16(vf, wfr[hf][s], o[d0], 0, 0, 0);
                        }
            }
        }
        if (MODE == 0) { if (lane == 0) flags[cur * 8 + w] = finished ? 1u : 0u; }
        if (j >= 2) asm volatile("s_waitcnt vmcnt(2) lgkmcnt(0)\n\ts_barrier" ::: "memory"); else asm volatile("s_waitcnt vmcnt(0) lgkmcnt(0)\n\ts_barrier" ::: "memory");
        so_cur = (so_cur == 16384) ? 0 : so_cur + 8192; so_new = (so_new == 16384) ? 0 : so_new + 8192;
        if (MODE == 0) {
            unsigned all = 1u;
#pragma unroll
            for (int i = 0; i < 8; ++i) all &= flags[cur * 8 + i];
            if (all) break;
        }
    }
    asm volatile("s_waitcnt vmcnt(0)\n\ts_barrier" ::: "memory");
#undef ATT_DMA
    const int row = b * SEQ + qw + r32;
    if (MODE == 0) {
        bf16* yp = A.Y + (size_t)row * DM + h * 64 + 4 * hh;
#pragma unroll
        for (int d0 = 0; d0 < 2; ++d0)
#pragma unroll
            for (int g = 0; g < 4; ++g) { u32x2_t v; v.x = pg8::cvt_pk_bf16(o[d0][4 * g], o[d0][4 * g + 1]); v.y = pg8::cvt_pk_bf16(o[d0][4 * g + 2], o[d0][4 * g + 3]); *(u32x2_t*)(yp + 32 * d0 + 8 * g) = v; }
    } else {
        float s1 = 0.f;
#pragma unroll
        for (int r = 0; r < 16; ++r) s1 += o[0][r] + o[1][r];
        s1 += __shfl_xor(s1, 32);
        const float mu = s1 * (1.0f / 64.0f);
        float s2 = 0.f;
#pragma unroll
        for (int r = 0; r < 16; ++r) { const float a0 = o[0][r] - mu, a1 = o[1][r] - mu; s2 += a0 * a0 + a1 * a1; }
        s2 += __shfl_xor(s2, 32);
        const float rstd = rsqrtf(s2 * (1.0f / 64.0f) + EPS);
        bf16* yp = A.Y + (size_t)row * DM + 512 + h * 64 + 4 * hh;
        const bf16* gp = A.rg + (size_t)row * 512 + h * 64 + 4 * hh;
        const float* gg = A.gn_g + h * 64 + 4 * hh; const float* gb = A.gn_b + h * 64 + 4 * hh;
#pragma unroll
        for (int d0 = 0; d0 < 2; ++d0)
#pragma unroll
            for (int g = 0; g < 4; ++g) {
                const f32x4 gn = *(const f32x4*)(gg + 32 * d0 + 8 * g), bs = *(const f32x4*)(gb + 32 * d0 + 8 * g);
                const u32x2_t gr = *(const u32x2_t*)(gp + 32 * d0 + 8 * g);
                float gate[4] = {__uint_as_float(gr.x << 16), __uint_as_float(gr.x & 0xffff0000u), __uint_as_float(gr.y << 16), __uint_as_float(gr.y & 0xffff0000u)};
                float ov[4];
#pragma unroll
                for (int i = 0; i < 4; ++i) { const float yn = (o[d0][4 * g + i] - mu) * rstd * gn[i] + bs[i]; const float sg = gate[i] / (1.0f + __expf(-gate[i])); ov[i] = yn * sg; }
                u32x2_t v; v.x = pg8::cvt_pk_bf16(ov[0], ov[1]); v.y = pg8::cvt_pk_bf16(ov[2], ov[3]); *(u32x2_t*)(yp + 32 * d0 + 8 * g) = v;
            }
    }
}
__device__ __forceinline__ void attn_phase(LAS unsigned char* lds, const AttnArgs& A, int vcu, int dup) {
    const int bh = vcu >> 2, x = vcu & 3, b = bh >> 3, h = bh & 7;
#pragma unroll 1
    for (int u = 0; u < ((dup == 20) ? 4 : 2); ++u) attn_unit<1>(lds, A, b, h, (u & 1) ? x : 7 - x);
#pragma unroll 1
    for (int u = 0; u < ((dup == 21) ? 4 : 2); ++u) attn_unit<0>(lds, A, b, h, (u & 1) ? x : 7 - x);
}
}

constexpr int CW_GCNT = 2048;
constexpr int LR_LCNT = LDSCTL_OFF + 1024, LR_GBASE = LDSCTL_OFF + 1152;
constexpr int LT_POFF = LDSCTL_OFF + 2048, LT_NT = LDSCTL_OFF + 2176, LT_TILE_E = LDSCTL_OFF + 2304;
struct RouteBufs { int* tok_e; int* tok_slot; float* tok_gate; float* rstd; float* slot_rstd; };
__device__ __forceinline__ RouteBufs route_bufs(unsigned char* ws) { RouteBufs r; r.tok_e = (int*)(ws + WS_ROUTE); r.tok_slot = r.tok_e + T * 4; r.tok_gate = (float*)(r.tok_slot + T * 4); r.rstd = (float*)(ws + WS_ROUTE + 1 * MiB); r.slot_rstd = (float*)(ws + WS_ROUTE + 2 * MiB); return r; }
typedef float f32x2v __attribute__((ext_vector_type(2)));
__device__ __forceinline__ unsigned opq_mask(bool c) { unsigned m = c ? 0xffffffffu : 0u; asm volatile("" : "+v"(m)); return m; }
__device__ __forceinline__ float blendf(unsigned m, float a, float b) { return __uint_as_float((__float_as_uint(a) & m) | (__float_as_uint(b) & ~m)); }
__device__ __forceinline__ int blendi(unsigned m, int a, int b) { return (int)(((unsigned)a & m) | ((unsigned)b & ~m)); }

#define SW2(c, a, b) { const float ta_ = (c) ? (b) : (a), tb_ = (c) ? (a) : (b); a = ta_; b = tb_; }
#define SW2I(c, a, b) { const int ta_ = (c) ? (b) : (a), tb_ = (c) ? (a) : (b); a = ta_; b = tb_; }
#define TOP4_INSERT(x, e) { const float x_ = (x); const int e_ = (e); const bool c3_ = (x_ > v3) || (x_ == v3 && e_ < i3); v3 = c3_ ? x_ : v3; i3 = c3_ ? e_ : i3; \
    const bool c2_ = (v3 > v2) || (v3 == v2 && i3 < i2); SW2(c2_, v2, v3) SW2I(c2_, i2, i3) const bool c1_ = (v2 > v1) || (v2 == v1 && i2 < i1); SW2(c1_, v1, v2) SW2I(c1_, i1, i2) \
    const bool c0_ = (v1 > v0) || (v1 == v0 && i1 < i0); SW2(c0_, v0, v1) SW2I(c0_, i0, i1) }
__device__ __forceinline__ void router_phase(Frame& F, const Args& a, const bool dry = false) {
    unsigned char* ws = a.ws; const int tid = tid_now();
    LAS unsigned char* lds = F.lds;
    const int lane = tid & 63, r32 = lane & 31, hh = lane >> 5, w = F.wave, rg = w >> 2, kq = w & 3;
    volatile LAS unsigned* lcnt = (volatile LAS unsigned*)(lds + LR_LCNT);
    volatile LAS unsigned* gbase = (volatile LAS unsigned*)(lds + LR_GBASE);
    if (tid < 32) lcnt[tid] = 0u;
    const RouteBufs R = route_bufs(dry ? ws + 3 * MiB : ws);
    const int row = F.vcu * 64 + 32 * rg + r32;
    const float* xr = a.out + (size_t)row * DM + 256 * kq + 8 * hh;
    const bf16* wt = (const bf16*)(ws + WS_WRT) + (size_t)r32 * DM + 256 * kq + 8 * hh;
    unsigned char* hp = (unsigned char*)(ws + (dry ? WS_H : WS_XN)) + (size_t)row * DM + 256 * kq + 8 * hh;
    att::f32x16 D;
#pragma unroll
    for (int r = 0; r < 16; ++r) D[r] = 0.f;
    float ss = 0.f;
#pragma unroll 8
    for (int ks = 0; ks < 16; ++ks) {
        const f32x4 v0 = *(const f32x4*)(xr + 16 * ks), v1 = *(const f32x4*)(xr + 16 * ks + 4);
        ss += ((v0[0] * v0[0] + v0[1] * v0[1]) + (v0[2] * v0[2] + v0[3] * v0[3])) + ((v1[0] * v1[0] + v1[1] * v1[1]) + (v1[2] * v1[2] + v1[3] * v1[3]));
        u32x2_t h8; h8.x = pk4_fp8(v0[0], v0[1], v0[2], v0[3]); h8.y = pk4_fp8(v1[0], v1[1], v1[2], v1[3]); *(u32x2_t*)(hp + 16 * ks) = h8;
        u32x4_t xh, xl;
        xh.x = cvtpk(v0[0], v0[1]); xh.y = cvtpk(v0[2], v0[3]); xh.z = cvtpk(v1[0], v1[1]); xh.w = cvtpk(v1[2], v1[3]);
        xl.x = cvtpk(v0[0] - __uint_as_float(xh.x << 16), v0[1] - __uint_as_float(xh.x & 0xffff0000u)); xl.y = cvtpk(v0[2] - __uint_as_float(xh.y << 16), v0[3] - __uint_as_float(xh.y & 0xffff0000u));
        xl.z = cvtpk(v1[0] - __uint_as_float(xh.z << 16), v1[1] - __uint_as_float(xh.z & 0xffff0000u)); xl.w = cvtpk(v1[2] - __uint_as_float(xh.w << 16), v1[3] - __uint_as_float(xh.w & 0xffff0000u));
        const att::bf16x8 whi = *(const att::bf16x8*)(wt + 16 * ks), wlo = *(const att::bf16x8*)(wt + 32 * DM + 16 * ks);
        const att::bf16x8 bxh = __builtin_bit_cast(att::bf16x8, xh), bxl = __builtin_bit_cast(att::bf16x8, xl);
        D = __builtin_amdgcn_mfma_f32_32x32x16_bf16(whi, bxh, D, 0, 0, 0);
        D = __builtin_amdgcn_mfma_f32_32x32x16_bf16(wlo, bxh, D, 0, 0, 0);
        D = __builtin_amdgcn_mfma_f32_32x32x16_bf16(whi, bxl, D, 0, 0, 0);
    }
    { LAS f32x4* dp = (LAS f32x4*)(lds + (w * 64 + lane) * 64);
#pragma unroll
      for (int q = 0; q < 4; ++q) dp[q] = (f32x4){D[4 * q], D[4 * q + 1], D[4 * q + 2], D[4 * q + 3]};
      *(LAS float*)(lds + 32768 + (w * 64 + lane) * 4) = ss; }
    __syncthreads();
    int my_e0 = 0, my_e1 = 0, rk0 = 0, rk1 = 0; float my_g0 = 0.f, my_g1 = 0.f;
    if (kq == 0) {
#pragma unroll
        for (int o = 1; o < 4; ++o) { LAS const f32x4* dp = (LAS const f32x4*)(lds + ((w + o) * 64 + lane) * 64);
#pragma unroll
            for (int q = 0; q < 4; ++q) { const f32x4 t = dp[q]; D[4 * q] += t[0]; D[4 * q + 1] += t[1]; D[4 * q + 2] += t[2]; D[4 * q + 3] += t[3]; }
            ss += *(LAS const float*)(lds + 32768 + ((w + o) * 64 + lane) * 4); }
        ss += __shfl_xor(ss, 32);
        const float rstd = rsqrtf(ss * (1.f / DM) + EPS);
        if (hh == 0) R.rstd[row] = rstd;
        float l[16];
#pragma unroll
        for (int r = 0; r < 16; ++r) l[r] = D[r] * rstd + a.b_r[(r & 3) + 8 * (r >> 2) + 4 * hh];
        float c[8]; int ci[8];
#pragma unroll
        for (int k = 0; k < 4; ++k) {
            float bv = -INFINITY; int bi = 99;
#pragma unroll
            for (int r = 0; r < 16; ++r) { const int e = (r & 3) + 8 * (r >> 2) + 4 * hh; const bool bt = l[r] > bv; bv = bt ? l[r] : bv; bi = bt ? e : bi; }
            c[k] = bv; ci[k] = bi;
#pragma unroll
            for (int r = 0; r < 16; ++r) { const int e = (r & 3) + 8 * (r >> 2) + 4 * hh; l[r] = (e == bi) ? -INFINITY : l[r]; }
        }
#pragma unroll
        for (int k = 0; k < 4; ++k) { c[4 + k] = __shfl_xor(c[k], 32); ci[4 + k] = __shfl_xor(ci[k], 32); }
        float tv[4]; int ti[4];
#pragma unroll
        for (int k = 0; k < 4; ++k) {
            float bv = -INFINITY; int bi = 99;
#pragma unroll
            for (int j = 0; j < 8; ++j) { const bool bt = (c[j] > bv) || (c[j] == bv && ci[j] < bi); bv = bt ? c[j] : bv; bi = bt ? ci[j] : bi; }
            tv[k] = bv; ti[k] = bi;
#pragma unroll
            for (int j = 0; j < 8; ++j) c[j] = (ci[j] == bi) ? -INFINITY : c[j];
        }
        const float v0 = tv[0], v1 = tv[1], v2 = tv[2], v3 = tv[3]; const int i0 = ti[0], i1 = ti[1], i2 = ti[2], i3 = ti[3];
        const float e1 = __expf(v1 - v0), e2 = __expf(v2 - v0), e3 = __expf(v3 - v0), inv = 1.0f / (1.0f + e1 + e2 + e3);
        my_e0 = hh ? i2 : i0; my_e1 = hh ? i3 : i1; my_g0 = (hh ? e2 : 1.0f) * inv; my_g1 = (hh ? e3 : e1) * inv;
        rk0 = (int)__hip_atomic_fetch_add((LAS unsigned*)(lds + LR_LCNT) + my_e0, 1u, __ATOMIC_RELAXED, __HIP_MEMORY_SCOPE_WORKGROUP);
        rk1 = (int)__hip_atomic_fetch_add((LAS unsigned*)(lds + LR_LCNT) + my_e1, 1u, __ATOMIC_RELAXED, __HIP_MEMORY_SCOPE_WORKGROUP);
    }
    __syncthreads();
    if (tid < 32) gbase[tid] = __hip_atomic_fetch_add((unsigned*)(F.ctl + CW_GCNT + (dry ? 64 : 0)) + tid, lcnt[tid], __ATOMIC_RELAXED, __HIP_MEMORY_SCOPE_AGENT);
    __syncthreads();
    if (kq == 0) {
        const int k0 = 2 * hh;
        R.tok_e[row * 4 + k0] = my_e0; R.tok_slot[row * 4 + k0] = (int)gbase[my_e0] + rk0; R.tok_gate[row * 4 + k0] = my_g0;
        R.tok_e[row * 4 + k0 + 1] = my_e1; R.tok_slot[row * 4 + k0 + 1] = (int)gbase[my_e1] + rk1; R.tok_gate[row * 4 + k0 + 1] = my_g1;
    }
}
#undef SW2
#undef SW2I
#undef TOP4_INSERT

__device__ __forceinline__ void build_tables(Frame& F) {
    LAS int* poff = (LAS int*)(F.lds + LT_POFF); LAS int* ntp = (LAS int*)(F.lds + LT_NT); LAS int* tile_e = (LAS int*)(F.lds + LT_TILE_E);
    LAS int* cnts = (LAS int*)(F.lds + LR_LCNT); const int tid = tid_now();
    if (tid < NE) cnts[tid] = (int)__hip_atomic_load((unsigned*)(F.ctl + CW_GCNT) + tid, __ATOMIC_RELAXED, __HIP_MEMORY_SCOPE_AGENT);
    __syncthreads();
    if (tid == 0) {
        int t = 0;
        for (int e = 0; e < NE; ++e) { const int c = cnts[e]; const int nt = (c + 255) >> 8; poff[e] = t * 256; for (int i = 0; i < nt; ++i) tile_e[t + i] = e; t += nt; }
        *ntp = t;
    }
    __syncthreads();
}
__device__ __forceinline__ void gather_phase(Frame& F, const Args& a) {
    unsigned char* ws = a.ws; const int lane = tid_now() & 63; const RouteBufs R = route_bufs(ws);
    LAS const int* poff = (LAS const int*)(F.lds + LT_POFF);
    const int gw = F.vcu * NWAVES + F.wave, NGW = F.G * NWAVES;
    for (int m0 = 4 * gw; m0 < T; m0 += 4 * NGW) {
        v4u h0[4]; float rs[4]; int dsts[4][4];
#pragma unroll
        for (int r = 0; r < 4; ++r) { const int m = m0 + r; h0[r] = ((const v4u*)((const unsigned char*)(ws + WS_XN) + (size_t)m * DM))[lane]; rs[r] = R.rstd[m];
#pragma unroll
            for (int k = 0; k < 4; ++k) dsts[r][k] = poff[R.tok_e[m * 4 + k]] + R.tok_slot[m * 4 + k]; }
#pragma unroll
        for (int r = 0; r < 4; ++r)
#pragma unroll
            for (int k = 0; k < 4; ++k) { ((v4u*)((unsigned char*)(ws + WS_XS) + (size_t)dsts[r][k] * DM))[lane] = h0[r]; if (lane == 0) R.slot_rstd[dsts[r][k]] = rs[r]; }
    }
}
__device__ __forceinline__ void combine_phase(Frame& F, const Args& a, const bool dry = false) {
    unsigned char* ws = a.ws; const RouteBufs R = route_bufs(ws);
    LAS const int* poff = (LAS const int*)(F.lds + LT_POFF);
    const int gw = F.vcu * NWAVES + F.wave, NGW = F.G * NWAVES, lane = tid_now() & 63;
    for (int m0 = 2 * gw; m0 < T; m0 += 2 * NGW) {
        f32x4 v[2][2][2]; u32x2_t y[2][4][2]; float gt[2][4];
#pragma unroll
        for (int rr = 0; rr < 2; ++rr) { const int m = m0 + rr;
#pragma unroll
            for (int i = 0; i < 2; ++i) { v[rr][i][0] = *(const f32x4*)(a.out + (size_t)m * DM + 8 * lane + 512 * i); v[rr][i][1] = *(const f32x4*)(a.out + (size_t)m * DM + 8 * lane + 512 * i + 4); }
#pragma unroll
            for (int k = 0; k < 4; ++k) { const int e = R.tok_e[m * 4 + k], slot = R.tok_slot[m * 4 + k]; gt[rr][k] = R.tok_gate[m * 4 + k];
                const unsigned char* yr = (const unsigned char*)(ws + WS_YS) + (size_t)(poff[e] + slot) * DM + 8 * lane;
                y[rr][k][0] = *(const u32x2_t*)yr; y[rr][k][1] = *(const u32x2_t*)(yr + 512); } }
#pragma unroll
        for (int rr = 0; rr < 2; ++rr) { const int m = m0 + rr;
#pragma unroll
            for (int k = 0; k < 4; ++k)
#pragma unroll
                for (int i = 0; i < 2; ++i) { const u32x2_t yy = y[rr][k][i]; const float g = gt[rr][k];
                    const f32x2v a0 = __builtin_amdgcn_cvt_pk_f32_fp8((int)yy.x, false), a1 = __builtin_amdgcn_cvt_pk_f32_fp8((int)yy.x, true), a2 = __builtin_amdgcn_cvt_pk_f32_fp8((int)yy.y, false), a3 = __builtin_amdgcn_cvt_pk_f32_fp8((int)yy.y, true);
                    v[rr][i][0][0] += g * a0[0]; v[rr][i][0][1] += g * a0[1]; v[rr][i][0][2] += g * a1[0]; v[rr][i][0][3] += g * a1[1];
                    v[rr][i][1][0] += g * a2[0]; v[rr][i][1][1] += g * a2[1]; v[rr][i][1][2] += g * a3[0]; v[rr][i][1][3] += g * a3[1]; }
            float ss = 0.f;
#pragma unroll
            for (int i = 0; i < 2; ++i)
#pragma unroll
                for (int q = 0; q < 2; ++q) { const f32x4 t = v[rr][i][q]; ss += (t[0] * t[0] + t[1] * t[1]) + (t[2] * t[2] + t[3] * t[3]); }
            const float rstd = rsqrtf(wave_sum(ss) * (1.f / DM) + EPS);
            unsigned char* np = (unsigned char*)(ws + (dry ? WS_H : WS_XN)) + (size_t)m * DM + 8 * lane; float* ow = dry ? (float*)(ws + WS_XS) : a.out;
#pragma unroll
            for (int i = 0; i < 2; ++i) { *(f32x4*)(ow + (size_t)m * DM + 8 * lane + 512 * i) = v[rr][i][0]; *(f32x4*)(ow + (size_t)m * DM + 8 * lane + 512 * i + 4) = v[rr][i][1];
                const f32x4 g0 = *(const f32x4*)(a.g_ple + 8 * lane + 512 * i), g1 = *(const f32x4*)(a.g_ple + 8 * lane + 512 * i + 4);
                u32x2_t o; o.x = pk4_fp8(v[rr][i][0][0] * rstd * g0[0], v[rr][i][0][1] * rstd * g0[1], v[rr][i][0][2] * rstd * g0[2], v[rr][i][0][3] * rstd * g0[3]);
                o.y = pk4_fp8(v[rr][i][1][0] * rstd * g1[0], v[rr][i][1][1] * rstd * g1[1], v[rr][i][1][2] * rstd * g1[2], v[rr][i][1][3] * rstd * g1[3]);
                *(u32x2_t*)(np + 512 * i) = o; } }
    }
}

__global__ void __launch_bounds__(NWAVES * 64, 2) mega_fwd(Args args) {
    extern __shared__ __attribute__((aligned(16))) unsigned char lds[];
    Frame F;
    F.lds = (LAS unsigned char*)lds;
    F.MISC = (volatile LAS unsigned*)(F.lds + MISC_OFF);
    F.wave = __builtin_amdgcn_readfirstlane(threadIdx.x >> 6);
    F.G = gridDim.x; { const int bx = blockIdx.x; F.vcu = (F.G % 8 == 0) ? (bx % 8) * (F.G / 8) + bx / 8 : bx; }
    unsigned char* ws = args.ws;
    F.ctl = (gu32*)(ws + WS_CTL);
    for (int u = threadIdx.x; u < (LDS_BYTES - LDSCTL_OFF) / 4; u += NWAVES * 64) ((LAS unsigned*)(F.lds + LDSCTL_OFF))[u] = 0u;
    __syncthreads();
    XcdBarrier bar = xcd_barrier_post((unsigned*)(F.ctl + CW_BAR), F.MISC + 8);
    const int lo = args.ph_lo, hi = args.ph_hi;
#define IN(k) (lo <= (k) && (k) < hi)
#define GRID_BAR() xcd_barrier(bar)
#ifndef DUP_PHASE
#define DUP_PHASE -1
#endif
#define REP(k) for (int rep_ = 0; rep_ < ((DUP_PHASE) == (k) ? 2 : 1); ++rep_)

    if (IN(0)) { if (DUP_PHASE == 40) { p0_prologue(F, args, 1); GRID_BAR(); } if (DUP_PHASE == 41) { p0_prologue(F, args, 2); GRID_BAR(); } if (DUP_PHASE == 42) { p0_prologue(F, args, 3); GRID_BAR(); } REP(0) { p0_prologue(F, args); GRID_BAR(); } }

    if (IN(1)) REP(1) {
        pg8::Gemm g{(const pg8::bf16_t*)(ws + WS_XN), (const pg8::bf16_t*)(ws + WS_WT_IN), DM, 0};
        pg8::StaticOrder S; S.init(T / 256, DIN / 256, F.G, (int)blockIdx.x);
        pg8::EpiProj E{(pg8::bf16_t*)(ws + WS_HM), (pg8::bf16_t*)(ws + WS_RG), (const float*)(ws + WS_GAINS), (const float*)(ws + WS_ROPEC), (const float*)(ws + WS_ROPES)};
        pg8::gemm_phase<pg8::EpiProj, pg8::StaticOrder, true, true>(F.lds + RING_OFF, g, S, E);
        {
            const int G2 = (F.G == 256) ? 128 : F.G, c2 = (F.G == 256) ? (int)blockIdx.x - 128 : (int)blockIdx.x;
            if (c2 >= 0) {
                pg8::Gemm g2{(const pg8::bf16_t*)(ws + WS_PB), (const pg8::bf16_t*)(ws + WS_WT_PP), PLE, 0};
                pg8::StaticOrder S2; S2.init(T / 256, DM / 256, G2, c2);
                pg8::EpiBf16Plain E2{(pg8::bf16_t*)(ws + WS_PJ), DM};
                pg8::gemm_phase<pg8::EpiBf16Plain, pg8::StaticOrder, true, true>(F.lds + RING_OFF, g2, S2, E2);
            }
        }
        GRID_BAR();
    }
    if (IN(2)) REP(2) {
        if (F.G == 256) {
            const att::AttnArgs AA{(const bf16*)(ws + WS_HM), (const bf16*)(ws + WS_RG), (bf16*)(ws + WS_Y), args.gn_g, args.gn_b};
            att::attn_phase(F.lds + RING_OFF, AA, F.vcu, DUP_PHASE);
        }
        GRID_BAR();
    }
    if (IN(3)) REP(3) {
        pg8::Gemm g{(const pg8::bf16_t*)(ws + WS_Y), (const pg8::bf16_t*)(ws + WS_WT_OUT), DM, 0};
        pg8::StaticOrder S; S.init(T / 256, DM / 256, F.G, (int)blockIdx.x);
        pg8::EpiResid E{args.x, args.out};
        pg8::gemm_phase<pg8::EpiResid, pg8::StaticOrder, true, true>(F.lds + RING_OFF, g, S, E);
        GRID_BAR();
    }
    if (DUP_PHASE == 30 && IN(3)) { GRID_BAR(); GRID_BAR(); GRID_BAR(); GRID_BAR(); }
    if (IN(4)) { if (DUP_PHASE == 4) { if (F.G == 256) router_phase(F, args, true); GRID_BAR(); } if (F.G == 256) router_phase(F, args); GRID_BAR(); }
    if (IN(5) || (lo >= 6 && lo <= 8)) build_tables(F);
    if (IN(5)) REP(5) { gather_phase(F, args); GRID_BAR(); }
    if (IN(6)) REP(6) {
        const int NT = *(LAS const int*)(F.lds + LT_NT);
        pg8::Gemm g{(const pg8::bf16_t*)(ws + WS_XS), (const pg8::bf16_t*)(ws + WS_WT_UG), DM / 2, (size_t)2048 * DM};
        pg8::MoeOrder S; S.init(NT, 8, F.G, (int)blockIdx.x, (LAS const int*)(F.lds + LT_TILE_E));
        pg8::EpiMoeUp E{(unsigned char*)(ws + WS_H), args.b_ug, route_bufs(ws).slot_rstd};
        pg8::gemm_phase<pg8::EpiMoeUp, pg8::MoeOrder, true, true, true>(F.lds + RING_OFF, g, S, E);
        GRID_BAR();
    }
    if (IN(7)) REP(7) {
        const int NT = *(LAS const int*)(F.lds + LT_NT);
        pg8::Gemm g{(const pg8::bf16_t*)(ws + WS_H), (const pg8::bf16_t*)(ws + WS_WT_DN), DM / 2, (size_t)DM * DM};
        pg8::MoeOrder S; S.init(NT, 4, F.G, (int)blockIdx.x, (LAS const int*)(F.lds + LT_TILE_E));
        pg8::EpiMoeDown E{(unsigned char*)(ws + WS_YS), args.b_dn};
        pg8::gemm_phase<pg8::EpiMoeDown, pg8::MoeOrder, true, true, true>(F.lds + RING_OFF, g, S, E);
        GRID_BAR();
    }
    if (IN(8)) { if (DUP_PHASE == 8) { combine_phase(F, args, true); GRID_BAR(); } combine_phase(F, args); GRID_BAR(); }
    if (IN(9)) {
        pg8::Gemm g{(const pg8::bf16_t*)(ws + WS_XN), (const pg8::bf16_t*)(ws + WS_WT_PG), DM / 2, 0};
        pg8::StaticOrder S; S.init(T / 256, DM / 256, F.G, (int)blockIdx.x);
        if (DUP_PHASE == 9) { pg8::EpiPle E0{args.out, (const pg8::bf16_t*)(ws + WS_PJ), (float*)(ws + WS_XS)}; pg8::gemm_phase<pg8::EpiPle, pg8::StaticOrder, true, true, true>(F.lds + RING_OFF, g, S, E0); }
        pg8::EpiPle E{args.out, (const pg8::bf16_t*)(ws + WS_PJ), args.out};
        pg8::gemm_phase<pg8::EpiPle, pg8::StaticOrder, true, true, true>(F.lds + RING_OFF, g, S, E);
    }
#undef IN
}
extern "C" void kernel_launch(void* const* d_in, const int* in_sizes, int n_in, void* d_out, int out_size, void* d_ws, size_t ws_size, hipStream_t stream) {
    static int grid = 0;
    if (grid == 0) {
        if (n_in != 22 || ws_size < 1024 * MiB) { fprintf(stderr, "kernel_launch: unexpected n_in %d / ws %zu\n", n_in, ws_size); grid = -1; return; }
        int dev = 0, cus = 0, per_cu = 0;
        if (hipGetDevice(&dev) != hipSuccess || hipDeviceGetAttribute(&cus, hipDeviceAttributeMultiprocessorCount, dev) != hipSuccess) { grid = -1; return; }
        if (hipFuncSetAttribute((const void*)mega_fwd, hipFuncAttributeMaxDynamicSharedMemorySize, LDS_BYTES) != hipSuccess) { fprintf(stderr, "kernel_launch: hipFuncSetAttribute failed\n"); grid = -1; return; }
        if (hipOccupancyMaxActiveBlocksPerMultiprocessor(&per_cu, (const void*)mega_fwd, NWAVES * 64, LDS_BYTES) != hipSuccess || per_cu < 1) { fprintf(stderr, "kernel_launch: occupancy query says %d\n", per_cu); per_cu = 1; }
        (void)hipGetLastError();
        grid = cus;
    }
    if (grid < 0) return;
    (void)hipMemsetAsync((char*)d_ws + WS_CTL, 0, CTL_ZERO_BYTES, stream);
    Args a{};
    a.x = (const float*)d_in[0]; a.p = (const float*)d_in[1]; a.positions = (const int*)d_in[2]; a.g_mix = (const float*)d_in[3]; a.w_in = (const float*)d_in[4];
    a.sbq = (const float*)d_in[5]; a.sbk = (const float*)d_in[6]; a.rq = (const float*)d_in[7]; a.rk = (const float*)d_in[8]; a.gn_g = (const float*)d_in[9]; a.gn_b = (const float*)d_in[10];
    a.w_out = (const float*)d_in[11]; a.g_ffn = (const float*)d_in[12]; a.w_r = (const float*)d_in[13]; a.b_r = (const float*)d_in[14]; a.w_ug = (const float*)d_in[15]; a.b_ug = (const float*)d_in[16];
    a.w_dn = (const float*)d_in[17]; a.b_dn = (const float*)d_in[18]; a.g_ple = (const float*)d_in[19]; a.w_pg = (const float*)d_in[20]; a.w_pp = (const float*)d_in[21];
    a.out = (float*)d_out; a.ws = (unsigned char*)d_ws; a.ph_lo = 0; a.ph_hi = 10;
    hipLaunchKernelGGL(mega_fwd, dim3(grid), dim3(NWAVES * 64), LDS_BYTES, stream, a);

}
```

```cpp
#include <hip/hip_runtime.h>
#include <cstdint>
#include <cstdio>
#include <cmath>

namespace pg8 {
#define PG8_LAS __attribute__((address_space(3)))
typedef unsigned short bf16_t;
typedef short bf16x8 __attribute__((ext_vector_type(8)));
typedef float f32x4 __attribute__((ext_vector_type(4)));
typedef unsigned u32x4 __attribute__((ext_vector_type(4)));
typedef unsigned u32x2 __attribute__((ext_vector_type(2)));
typedef int v4i32 __attribute__((ext_vector_type(4)));
typedef int v8i32 __attribute__((ext_vector_type(8)));
constexpr int BM = 256, BK = 64, HALF = 128, HTB = HALF * BK * 2  , STAGE_BYTES = 8 * HTB, NXCD = 8, WGM = 8;

__host__ __device__ __forceinline__ int lds_byte(int r, int c) { const int st = (r >> 4) * 2 + (c >> 5), rr = r & 15, cc = c & 31, ob = rr * 64 + cc * 2; return st * 1024 + (ob ^ (((ob >> 9) & 1) << 5)); }
__host__ __device__ __forceinline__ void stage_rc(int b, int& R, int& C) { const int st = b / 1024, sb = b % 1024, swz = sb ^ (((sb >> 9) & 1) << 5); R = (st >> 1) * 16 + swz / 64; C = (st & 1) * 32 + (swz % 64) / 2; }
__host__ __device__ __forceinline__ int perm32(int rho) { const int n = rho >> 4, i = rho & 15; return 8 * (i >> 2) + 4 * n + (i & 3); }

struct Unit { int pm, pn, e; };
struct Gemm { const bf16_t* A; const bf16_t* Bt; int K; size_t strideBe; };

struct StaticOrder {
    int nM, nN, nwg, G, c;
    __host__ __device__ void init(int nM_, int nN_, int G_, int c_) { nM = nM_; nN = nN_; nwg = nM * nN; G = G_; c = c_; }
    __host__ __device__ bool next(int i, Unit& u) const {
        const long L = (long)i * G + c; if (L >= nwg) return false;
        int wgid = (int)L; { const int q = nwg / NXCD, r = nwg % NXCD, xcd = wgid % NXCD, off = wgid / NXCD; wgid = (xcd < r ? xcd * (q + 1) : r * (q + 1) + (xcd - r) * q) + off; }
        const int nig = WGM * nN, gid = wgid / nig, fm = gid * WGM, gsz = (nM - fm) < WGM ? (nM - fm) : WGM;
        u.pm = fm + ((wgid % nig) % gsz); u.pn = (wgid % nig) / gsz; u.e = 0; return true;
    }
    __device__ __forceinline__ void a_ready(const Unit&) const {}
    __device__ __forceinline__ void done(const Unit&) const {}
};

typedef float f32x2_t __attribute__((ext_vector_type(2))); typedef __bf16 bf16x2_t __attribute__((ext_vector_type(2)));
__device__ __forceinline__ unsigned cvt_pk_bf16(float lo, float hi) { f32x2_t v = {lo, hi}; bf16x2_t b = __builtin_convertvector(v, bf16x2_t); return __builtin_bit_cast(unsigned, b); }

constexpr int T = 16384, SEQ = 2048, DM = 1024, DIN = 3584;
constexpr float EPS = 1e-6f;
__device__ __forceinline__ u32x4 pack8(const f32x4 a, const f32x4 b) { u32x4 w; w.x = cvt_pk_bf16(a[0], a[1]); w.y = cvt_pk_bf16(a[2], a[3]); w.z = cvt_pk_bf16(b[0], b[1]); w.w = cvt_pk_bf16(b[2], b[3]); return w; }

struct EpiProj {
    static constexpr bool PERM = true, AFTER_DRAIN = false;
    bf16_t* hm;
    bf16_t* rg;
    const float* gains;
    const float *ropec, *ropes;
    __device__ __forceinline__ void operator()(const f32x4 (&acc)[2][2][4][2], const Unit& u, int wr, int wc, int fr, int fq) const {
        const int region = u.pn >> 1, hb = 4 * (u.pn & 1) + wc;
        const bool normed = (region == 0) || (region == 1) || (region == 3) || (region == 4);
        const bool rope = (region == 3) || (region == 4);
        const int gidx = region == 0 ? 0 : region == 1 ? 1 : region == 3 ? 2 : 3;
        const float* gp = gains + gidx * 64;
        f32x4 gv[2][2];
#pragma unroll
        for (int bj = 0; bj < 2; ++bj)
#pragma unroll
            for (int n = 0; n < 2; ++n) gv[bj][n] = normed ? *(const f32x4*)(gp + 32 * bj + 8 * fq + 4 * n) : (f32x4){1.f, 1.f, 1.f, 1.f};
        const float lg2g = __log2f(1.0f - __builtin_amdgcn_exp2f(-5.0f - (float)hb));
        const float scale = region == 0 ? 0.125f * 1.4426950408889634f : region == 4 ? 0.125f : 1.0f;
#pragma unroll
        for (int ai = 0; ai < 2; ++ai)
#pragma unroll
            for (int m = 0; m < 4; ++m) {
                const int row = u.pm * BM + ai * HALF + wr * 64 + m * 16 + fr;
                const int b = row >> 11, s = row & (SEQ - 1);
                f32x4 v[2][2];
#pragma unroll
                for (int bj = 0; bj < 2; ++bj)
#pragma unroll
                    for (int n = 0; n < 2; ++n) v[bj][n] = acc[ai][bj][m][n];
                if (normed) {
                    float ss = 0.f;
#pragma unroll
                    for (int bj = 0; bj < 2; ++bj)
#pragma unroll
                        for (int n = 0; n < 2; ++n) { const f32x4 x = v[bj][n]; ss += (x[0] * x[0] + x[1] * x[1]) + (x[2] * x[2] + x[3] * x[3]); }
                    ss += __shfl_xor(ss, 16); ss += __shfl_xor(ss, 32);
                    float rs = rsqrtf(ss * (1.0f / 64.0f) + EPS) * scale;
                    if (rope) rs *= (region == 3) ? __builtin_amdgcn_exp2f((float)(s & 31) * lg2g) : __builtin_amdgcn_exp2f(-(float)(s & 63) * lg2g);
#pragma unroll
                    for (int bj = 0; bj < 2; ++bj)
#pragma unroll
                        for (int n = 0; n < 2; ++n) v[bj][n] = v[bj][n] * rs * gv[bj][n];
                    if (rope) {
#pragma unroll
                        for (int n = 0; n < 2; ++n) {
                            const f32x4 c = *(const f32x4*)(ropec + (size_t)row * 32 + 8 * fq + 4 * n), sn = *(const f32x4*)(ropes + (size_t)row * 32 + 8 * fq + 4 * n);
                            const f32x4 lo = v[0][n], hi = v[1][n];
                            v[0][n] = lo * c - hi * sn; v[1][n] = hi * c + lo * sn;
                        }
                    }
                }
                bf16_t* dst = (region < 6) ? hm + (size_t)region * ((size_t)T * 512) + ((size_t)(b * 8 + hb) * SEQ + s) * 64 + 8 * fq
                                           : rg + (size_t)row * 512 + hb * 64 + 8 * fq;
#pragma unroll
                for (int bj = 0; bj < 2; ++bj) *(u32x4*)(dst + 32 * bj) = pack8(v[bj][0], v[bj][1]);
            }
    }
};

struct EpiBf16Plain {
    static constexpr bool PERM = true, AFTER_DRAIN = false;
    bf16_t* O; int ldc;
    __device__ __forceinline__ void operator()(const f32x4 (&acc)[2][2][4][2], const Unit& u, int wr, int wc, int fr, int fq) const {
        const int row0 = u.pm * BM + wr * 64 + fr, col0 = u.pn * BM + wc * 32 + 8 * fq;
#pragma unroll
        for (int ai = 0; ai < 2; ++ai)
#pragma unroll
            for (int m = 0; m < 4; ++m) { bf16_t* rowp = O + (size_t)(row0 + ai * HALF + m * 16) * ldc + col0;
#pragma unroll
                for (int bj = 0; bj < 2; ++bj) *(u32x4*)(rowp + bj * HALF) = pack8(acc[ai][bj][m][0], acc[ai][bj][m][1]); }
    }
};
struct EpiResid {
    static constexpr bool PERM = false, AFTER_DRAIN = false;
    const float* base; float* out;
    __device__ __forceinline__ void operator()(const f32x4 (&acc)[2][2][4][2], const Unit& u, int wr, int wc, int fr, int fq) const {
        const int col0 = u.pn * BM + wc * 32 + 4 * fq;
#pragma unroll
        for (int ai = 0; ai < 2; ++ai)
#pragma unroll
            for (int m = 0; m < 4; ++m) { const size_t off = (size_t)(u.pm * BM + ai * HALF + wr * 64 + m * 16 + fr) * DM + col0;
#pragma unroll
                for (int bj = 0; bj < 2; ++bj)
#pragma unroll
                    for (int n = 0; n < 2; ++n) { const f32x4 bs = __builtin_nontemporal_load((const f32x4*)(base + off + bj * HALF + n * 16)); *(f32x4*)(out + off + bj * HALF + n * 16) = bs + acc[ai][bj][m][n]; } }
    }
};
struct EpiMoeUp {
    static constexpr bool PERM = true, AFTER_DRAIN = false;
    unsigned char* H; const float* bias; const float* srstd;
    __device__ __forceinline__ void operator()(const f32x4 (&acc)[2][2][4][2], const Unit& u, int wr, int wc, int fr, int fq) const {
        const int cc = 128 * u.pn + 32 * wc + 8 * fq;
        const float* bp = bias + (size_t)u.e * 2048 + cc;
        f32x4 bg[2], bl[2];
#pragma unroll
        for (int n = 0; n < 2; ++n) { bg[n] = *(const f32x4*)(bp + 4 * n); bl[n] = *(const f32x4*)(bp + 1024 + 4 * n); }
#pragma unroll
        for (int ai = 0; ai < 2; ++ai)
#pragma unroll
            for (int m = 0; m < 4; ++m) {
                f32x4 hv[2]; const float sc = srstd[u.pm * BM + ai * HALF + wr * 64 + m * 16 + fr] * 0.015625f;
#pragma unroll
                for (int n = 0; n < 2; ++n) {
                    const f32x4 g0 = acc[ai][0][m][n] * sc + bg[n], l0 = acc[ai][1][m][n] * sc + bl[n];
#pragma unroll
                    for (int j = 0; j < 4; ++j) {
                        const float glu = __builtin_fminf(g0[j], 7.0f), lin = __builtin_fminf(__builtin_fmaxf(l0[j], -7.0f), 7.0f);
                        const float sg = __builtin_amdgcn_rcpf(1.0f + __builtin_amdgcn_exp2f(-1.702f * 1.4426950408889634f * glu));
                        hv[n][j] = glu * sg * (lin + 1.0f);
                    }
                }
                u32x2 hq; hq.x = (unsigned)__builtin_amdgcn_cvt_pk_fp8_f32(hv[0][0], hv[0][1], 0, false); hq.x = (unsigned)__builtin_amdgcn_cvt_pk_fp8_f32(hv[0][2], hv[0][3], (int)hq.x, true);
                hq.y = (unsigned)__builtin_amdgcn_cvt_pk_fp8_f32(hv[1][0], hv[1][1], 0, false); hq.y = (unsigned)__builtin_amdgcn_cvt_pk_fp8_f32(hv[1][2], hv[1][3], (int)hq.y, true);
                *(u32x2*)(H + (size_t)(u.pm * BM + ai * HALF + wr * 64 + m * 16 + fr) * 1024 + cc) = hq;
            }
    }
};
struct EpiMoeDown {
    static constexpr bool PERM = true, AFTER_DRAIN = false;
    unsigned char* YS; const float* bias;
    __device__ __forceinline__ void operator()(const f32x4 (&acc)[2][2][4][2], const Unit& u, int wr, int wc, int fr, int fq) const {
        const int col0 = u.pn * BM + wc * 32 + 8 * fq;
        f32x4 bv[2][2];
#pragma unroll
        for (int bj = 0; bj < 2; ++bj)
#pragma unroll
            for (int n = 0; n < 2; ++n) bv[bj][n] = *(const f32x4*)(bias + (size_t)u.e * 1024 + col0 + bj * HALF + 4 * n);
#pragma unroll
        for (int ai = 0; ai < 2; ++ai)
#pragma unroll
            for (int m = 0; m < 4; ++m) { unsigned char* rowp = YS + (size_t)(u.pm * BM + ai * HALF + wr * 64 + m * 16 + fr) * 1024 + col0;
#pragma unroll
                for (int bj = 0; bj < 2; ++bj) { const f32x4 y0 = acc[ai][bj][m][0] * 0.015625f + bv[bj][0], y1 = acc[ai][bj][m][1] * 0.015625f + bv[bj][1];
                    u32x2 q; q.x = (unsigned)__builtin_amdgcn_cvt_pk_fp8_f32(y0[0], y0[1], 0, false); q.x = (unsigned)__builtin_amdgcn_cvt_pk_fp8_f32(y0[2], y0[3], (int)q.x, true);
                    q.y = (unsigned)__builtin_amdgcn_cvt_pk_fp8_f32(y1[0], y1[1], 0, false); q.y = (unsigned)__builtin_amdgcn_cvt_pk_fp8_f32(y1[2], y1[3], (int)q.y, true);
                    *(u32x2*)(rowp + bj * HALF) = q; } }
    }
};
struct EpiPle {
    static constexpr bool PERM = false, AFTER_DRAIN = false;
    float* out; const bf16_t* PJ; float* outw;
    __device__ __forceinline__ void operator()(const f32x4 (&acc)[2][2][4][2], const Unit& u, int wr, int wc, int fr, int fq) const {
        const int col0 = u.pn * BM + wc * 32 + 4 * fq;
#pragma unroll
        for (int ai = 0; ai < 2; ++ai)
#pragma unroll
            for (int m = 0; m < 4; ++m) { const size_t off = (size_t)(u.pm * BM + ai * HALF + wr * 64 + m * 16 + fr) * DM + col0;
#pragma unroll
                for (int bj = 0; bj < 2; ++bj)
#pragma unroll
                    for (int n = 0; n < 2; ++n) {
                        const size_t o2 = off + bj * HALF + n * 16;
                        const f32x4 x2 = __builtin_nontemporal_load((const f32x4*)(out + o2)); const u32x2 pj = __builtin_nontemporal_load((const u32x2*)(PJ + o2)); const f32x4 a = acc[ai][bj][m][n] * 0.015625f;
                        f32x4 r;
                        r[0] = x2[0] + __uint_as_float(pj.x << 16) * __builtin_amdgcn_rcpf(1.0f + __builtin_amdgcn_exp2f(-1.4426950408889634f * a[0]));
                        r[1] = x2[1] + __uint_as_float(pj.x & 0xffff0000u) * __builtin_amdgcn_rcpf(1.0f + __builtin_amdgcn_exp2f(-1.4426950408889634f * a[1]));
                        r[2] = x2[2] + __uint_as_float(pj.y << 16) * __builtin_amdgcn_rcpf(1.0f + __builtin_amdgcn_exp2f(-1.4426950408889634f * a[2]));
                        r[3] = x2[3] + __uint_as_float(pj.y & 0xffff0000u) * __builtin_amdgcn_rcpf(1.0f + __builtin_amdgcn_exp2f(-1.4426950408889634f * a[3]));
                        __builtin_nontemporal_store(r, (f32x4*)(outw + o2));
                    } }
    }
};
struct MoeOrder {
    int nM, nN, nwg, G, c; const PG8_LAS int* tile_e;
    __device__ void init(int nM_, int nN_, int G_, int c_, const PG8_LAS int* te) { nM = nM_; nN = nN_; nwg = nM * nN; G = G_; c = c_; tile_e = te; }
    __device__ bool next(int i, Unit& u) const {
        const long L = (long)i * G + c; if (L >= nwg) return false;
        int wgid = (int)L; { const int q = nwg / NXCD, r = nwg % NXCD, xcd = wgid % NXCD, off = wgid / NXCD; wgid = (xcd < r ? xcd * (q + 1) : r * (q + 1) + (xcd - r) * q) + off; }
        const int nig = WGM * nN, gid = wgid / nig, fm = gid * WGM, gsz = (nM - fm) < WGM ? (nM - fm) : WGM;
        u.pm = fm + ((wgid % nig) % gsz); u.pn = (wgid % nig) / gsz; u.e = __builtin_amdgcn_readfirstlane(tile_e[u.pm]); return true;
    }
    __device__ __forceinline__ void a_ready(const Unit&) const {}
    __device__ __forceinline__ void done(const Unit&) const {}
};
template <class Epi, class Sched, bool ALIGN_EPI = false, bool SP2 = false, bool F8 = false>
__device__ __forceinline__ void gemm_phase(PG8_LAS unsigned char* lds, const Gemm g, const Sched& S, const Epi& E) {
    int tid_ = threadIdx.x; asm volatile("" : "+v"(tid_));
    const int tid = tid_, wid = __builtin_amdgcn_readfirstlane(tid >> 6), lane = tid & 63, wr = wid >> 2, wc = wid & 3, fr = lane & 15, fq = lane >> 4;
    const int K = g.K, nt = K / BK;
    unsigned voffA[2], voffB[2];
#pragma unroll
    for (int i = 0; i < 2; ++i) { int R, C; stage_rc(tid * 16 + i * 8192, R, C); const int Rb = Epi::PERM ? ((R & ~31) + perm32(R & 31)) : R;
        voffA[i] = (unsigned)(R * K + C) * 2u; voffB[i] = (unsigned)(Rb * K + C) * 2u; }
    const size_t kstep = (size_t)(BK * 2);
    const size_t hstep = (size_t)HALF * K * 2;
    const size_t tstep = 2 * hstep;
    const unsigned ldsw = (unsigned)wid * 1024u;
    const int aoff = lds_byte(wr * 64 + fr, fq * 8), boff = lds_byte(wc * 32 + fr, fq * 8);
#define PG8_SA(b, h) (((b) * 2 + (h)) * HTB)
#define PG8_SB(b, h) ((4 + (b) * 2 + (h)) * HTB)
#define PG8_STAGE(bufoff, gbase, voff) do { _Pragma("unroll") for (int _i = 0; _i < 2; ++_i) \
        __builtin_amdgcn_global_load_lds((const unsigned*)((const char*)(gbase) + (voff)[_i]), (PG8_LAS unsigned*)(lds + (bufoff) + ldsw + _i * 8192), 16, 0, 0); } while (0)
#define PG8_LD16(off) (*(const PG8_LAS v4i32*)(lds + (off)))
#define PG8_LDA(dst, b, h) do { if constexpr (F8) { _Pragma("unroll") for (int m = 0; m < 4; ++m) dst##8[m] = __builtin_shufflevector(PG8_LD16(PG8_SA(b, h) + aoff + m * 2048), PG8_LD16(PG8_SA(b, h) + aoff + m * 2048 + 1024), 0, 1, 2, 3, 4, 5, 6, 7); } \
        else { _Pragma("unroll") for (int m = 0; m < 4; ++m) _Pragma("unroll") for (int k = 0; k < 2; ++k) dst[m][k] = *(const PG8_LAS bf16x8*)(lds + PG8_SA(b, h) + aoff + m * 2048 + k * 1024); } } while (0)
#define PG8_LDB(dst, b, h) do { if constexpr (F8) { _Pragma("unroll") for (int n = 0; n < 2; ++n) dst##8[n] = __builtin_shufflevector(PG8_LD16(PG8_SB(b, h) + boff + n * 2048), PG8_LD16(PG8_SB(b, h) + boff + n * 2048 + 1024), 0, 1, 2, 3, 4, 5, 6, 7); } \
        else { _Pragma("unroll") for (int n = 0; n < 2; ++n) _Pragma("unroll") for (int k = 0; k < 2; ++k) dst[n][k] = *(const PG8_LAS bf16x8*)(lds + PG8_SB(b, h) + boff + n * 2048 + k * 1024); } } while (0)
#define PG8_MMA(ai, bj, At, Bt) do { __builtin_amdgcn_s_setprio(1); \
        if constexpr (F8) { _Pragma("unroll") for (int m = 0; m < 4; ++m) _Pragma("unroll") for (int n = 0; n < 2; ++n) \
            asm volatile("v_mfma_scale_f32_16x16x128_f8f6f4 %0, %1, %2, %0, %3, %3 op_sel_hi:[0,0,0]" : "+v"(acc[ai][bj][m][n]) : "v"(Bt##8[n]), "v"(At##8[m]), "v"(f8scale)); } \
        else { _Pragma("unroll") for (int m = 0; m < 4; ++m) _Pragma("unroll") for (int n = 0; n < 2; ++n) _Pragma("unroll") for (int k = 0; k < 2; ++k) \
            acc[ai][bj][m][n] = __builtin_amdgcn_mfma_f32_16x16x32_bf16(Bt[n][k], At[m][k], acc[ai][bj][m][n], 0, 0, 0); } \
        __builtin_amdgcn_s_setprio(0); } while (0)
#define PG8_WAIT_V(n) asm volatile("s_waitcnt vmcnt(" #n ")" ::: "memory")
#define PG8_WAIT_L(n) asm volatile("s_waitcnt lgkmcnt(" #n ")" ::: "memory")
#define PG8_BAR __builtin_amdgcn_s_barrier()
#define PG8_SCHED __builtin_amdgcn_sched_barrier(0)
    Unit cur, nxt; int ui = 0;
    if (!S.next(0, cur)) return;
    f32x4 acc[2][2][4][2];
#pragma unroll
    for (int a = 0; a < 2; ++a)
#pragma unroll
        for (int b = 0; b < 2; ++b)
#pragma unroll
            for (int m = 0; m < 4; ++m)
#pragma unroll
                for (int n = 0; n < 2; ++n) acc[a][b][m][n] = (f32x4){0.f, 0.f, 0.f, 0.f};
    bf16x8 At[4][2], B0[2][2], B1[2][2];
    v8i32 At8[4], B08[2], B18[2]; const int f8scale = 0x7f7f7f7f;
    const char* cA = (const char*)g.A + (size_t)cur.pm * tstep; const char* cB = (const char*)g.Bt + (size_t)cur.e * g.strideBe + (size_t)cur.pn * tstep;
    S.a_ready(cur);
    if constexpr (SP2) {
        PG8_STAGE(PG8_SB(0, 0), cB, voffB); PG8_STAGE(PG8_SB(0, 1), cB + hstep, voffB); PG8_STAGE(PG8_SA(0, 0), cA, voffA); PG8_STAGE(PG8_SA(0, 1), cA + hstep, voffA);
        if (wr == 1) PG8_BAR;
        PG8_WAIT_V(2); PG8_BAR;
        PG8_STAGE(PG8_SB(1, 0), cB + kstep, voffB); PG8_STAGE(PG8_SA(1, 0), cA + kstep, voffA); PG8_STAGE(PG8_SB(1, 1), cB + hstep + kstep, voffB);
        PG8_WAIT_V(6); PG8_BAR;
    } else {
        PG8_STAGE(PG8_SB(0, 0), cB, voffB); PG8_STAGE(PG8_SA(0, 0), cA, voffA); PG8_STAGE(PG8_SB(0, 1), cB + hstep, voffB); PG8_STAGE(PG8_SA(0, 1), cA + hstep, voffA);
        if (wr == 1) PG8_BAR;
        PG8_WAIT_V(4); PG8_BAR;
        PG8_STAGE(PG8_SB(1, 0), cB + kstep, voffB); PG8_STAGE(PG8_SA(1, 0), cA + kstep, voffA); PG8_STAGE(PG8_SB(1, 1), cB + hstep + kstep, voffB);
        PG8_WAIT_V(6); PG8_BAR;
    }
    for (;;) {
        const bool has_next = S.next(ui + 1, nxt);
        const char* nA = has_next ? (const char*)g.A + (size_t)nxt.pm * tstep : cA; const char* nB = has_next ? (const char*)g.Bt + (size_t)nxt.e * g.strideBe + (size_t)nxt.pn * tstep : cB;
#pragma unroll 1
        for (int t = 0; t < nt; t += 2) {
            const bool last = (t == nt - 2);
            const char* a1 = cA + (size_t)(t + 1) * kstep;
            const char* a2 = last ? nA : cA + (size_t)(t + 2) * kstep; const char* b2 = last ? nB : cB + (size_t)(t + 2) * kstep;
            const char* a3 = a2 + kstep; const char* b3 = b2 + kstep;
            if (last && has_next) S.a_ready(nxt);
            if constexpr (SP2) {
            PG8_LDB(B0, 0, 0); PG8_LDB(B1, 0, 1); PG8_SCHED; PG8_LDA(At, 0, 0); PG8_STAGE(PG8_SA(1, 1), a1 + hstep, voffA);
            PG8_WAIT_V(8); PG8_WAIT_L(0); PG8_BAR; PG8_MMA(0, 0, At, B0); PG8_MMA(0, 1, At, B1); PG8_BAR; PG8_SCHED;
            PG8_LDA(At, 0, 1); PG8_STAGE(PG8_SB(0, 0), b2, voffB); PG8_STAGE(PG8_SB(0, 1), b2 + hstep, voffB); PG8_STAGE(PG8_SA(0, 0), a2, voffA);
            PG8_WAIT_V(8); PG8_WAIT_L(0); PG8_BAR; PG8_MMA(1, 0, At, B0); PG8_MMA(1, 1, At, B1); PG8_BAR; PG8_SCHED;
            PG8_LDB(B0, 1, 0); PG8_LDB(B1, 1, 1); PG8_SCHED; PG8_LDA(At, 1, 0); PG8_STAGE(PG8_SA(0, 1), a2 + hstep, voffA);
            PG8_WAIT_V(8); PG8_WAIT_L(0); PG8_BAR; PG8_MMA(0, 0, At, B0); PG8_MMA(0, 1, At, B1); PG8_BAR; PG8_SCHED;
            PG8_LDA(At, 1, 1); PG8_STAGE(PG8_SB(1, 0), b3, voffB); PG8_STAGE(PG8_SB(1, 1), b3 + hstep, voffB); PG8_STAGE(PG8_SA(1, 0), a3, voffA);
            PG8_WAIT_V(8); PG8_WAIT_L(0); PG8_BAR; PG8_MMA(1, 0, At, B0); PG8_MMA(1, 1, At, B1); PG8_BAR; PG8_SCHED;
            } else {
            PG8_LDB(B0, 0, 0); PG8_SCHED; PG8_LDA(At, 0, 0); PG8_STAGE(PG8_SA(1, 1), a1 + hstep, voffA);
            PG8_WAIT_L(8); PG8_BAR; PG8_WAIT_L(0); PG8_MMA(0, 0, At, B0); PG8_BAR; PG8_SCHED;
            PG8_LDB(B1, 0, 1); PG8_STAGE(PG8_SB(0, 0), b2, voffB);
            PG8_BAR; PG8_WAIT_L(0); PG8_MMA(0, 1, At, B1); PG8_BAR;
            PG8_LDA(At, 0, 1); PG8_STAGE(PG8_SA(0, 0), a2, voffA);
            PG8_BAR; PG8_WAIT_L(0); PG8_MMA(1, 0, At, B0); PG8_BAR; PG8_SCHED;
            PG8_STAGE(PG8_SB(0, 1), b2 + hstep, voffB);
            PG8_WAIT_V(6); PG8_BAR; PG8_MMA(1, 1, At, B1); PG8_BAR;
            PG8_LDB(B0, 1, 0); PG8_SCHED; PG8_LDA(At, 1, 0); PG8_STAGE(PG8_SA(0, 1), a2 + hstep, voffA);
            PG8_WAIT_L(8); PG8_BAR; PG8_WAIT_L(0); PG8_MMA(0, 0, At, B0); PG8_BAR; PG8_SCHED;
            PG8_LDB(B1, 1, 1); PG8_STAGE(PG8_SB(1, 0), b3, voffB);
            PG8_BAR; PG8_WAIT_L(0); PG8_MMA(0, 1, At, B1); PG8_BAR;
            PG8_LDA(At, 1, 1); PG8_STAGE(PG8_SA(1, 0), a3, voffA);
            PG8_BAR; PG8_WAIT_L(0); PG8_MMA(1, 0, At, B0); PG8_BAR; PG8_SCHED;
            PG8_STAGE(PG8_SB(1, 1), b3 + hstep, voffB);
            PG8_WAIT_V(6); PG8_BAR; PG8_MMA(1, 1, At, B1); PG8_BAR;
            }
        }
        if constexpr (ALIGN_EPI) { if (wr == 0) PG8_BAR; }
        if constexpr (F8) asm volatile("s_nop 15\n\ts_nop 15\n\ts_nop 15" ::: "memory");
        if constexpr (!Epi::AFTER_DRAIN) { E(acc, cur, wr, wc, fr, fq); S.done(cur); }
        if (!has_next) break;
#pragma unroll
        for (int a = 0; a < 2; ++a)
#pragma unroll
            for (int b = 0; b < 2; ++b)
#pragma unroll
                for (int m = 0; m < 4; ++m)
#pragma unroll
                    for (int n = 0; n < 2; ++n) acc[a][b][m][n] = (f32x4){0.f, 0.f, 0.f, 0.f};
        cur = nxt; cA = nA; cB = nB; ++ui;
        if constexpr (ALIGN_EPI) { if (wr == 1) PG8_BAR; }
    }
    PG8_WAIT_V(0);
    if constexpr (!ALIGN_EPI) { if (wr == 0) PG8_BAR; }
    PG8_BAR;
    if constexpr (Epi::AFTER_DRAIN) { E.fused(acc, cur, wr, wc, fr, fq, lds, wid, lane); S.done(cur); }
#undef PG8_SA
#undef PG8_SB
#undef PG8_STAGE
#undef PG8_LD16
#undef PG8_LDA
#undef PG8_LDB
#undef PG8_MMA
#undef PG8_WAIT_V
#undef PG8_WAIT_L
#undef PG8_BAR
#undef PG8_SCHED
}
}

constexpr int NWAVES = 8;
constexpr int T = pg8::T, SEQ = pg8::SEQ, DM = pg8::DM, DIN = pg8::DIN, NE = 32, PLE = 256;
constexpr float EPS = pg8::EPS;
constexpr size_t MiB = 1u << 20;
constexpr size_t WS_CTL = 0, CTL_ZERO_BYTES = 1 * MiB;
constexpr size_t WS_WT_IN = 2 * MiB, WS_WT_OUT = 9 * MiB, WS_WT_PG = 11 * MiB, WS_WT_PP = 13 * MiB;
constexpr size_t WS_GAINS = 13 * MiB + 512 * 1024;
constexpr size_t WS_WRT = 13 * MiB + 576 * 1024;
constexpr size_t WS_ROPEC = 14 * MiB, WS_ROPES = 16 * MiB, WS_PB = 18 * MiB, WS_ROUTE = 26 * MiB;
constexpr size_t WS_WT_UG = 32 * MiB, WS_WT_DN = 160 * MiB;
constexpr size_t WS_XN = 224 * MiB;
constexpr size_t WS_HM = 256 * MiB;
constexpr size_t WS_RG = 352 * MiB;
constexpr size_t WS_Y = 368 * MiB;
constexpr size_t WS_PJ = 400 * MiB;
constexpr size_t WS_XS = 432 * MiB, WS_H = 576 * MiB, WS_YS = 720 * MiB;
constexpr size_t WS_END = 864 * MiB;
constexpr int CW_TMO = 0, CW_CODE = 1;
constexpr int CW_BAR = 4096;
constexpr int RING_OFF = 0, RING_BYTES = 131072;
constexpr int LDSCTL_OFF = RING_BYTES, MISC_OFF = LDSCTL_OFF + 320;
constexpr int LDS_BYTES = 147456;
#define GAS __attribute__((address_space(1)))
#define LAS __attribute__((address_space(3)))
typedef unsigned short bf16;
typedef unsigned v4u __attribute__((ext_vector_type(4)));
typedef float f32x4 __attribute__((ext_vector_type(4)));
typedef short bf16x8 __attribute__((ext_vector_type(8)));
typedef unsigned u32x4_t __attribute__((ext_vector_type(4)));
typedef unsigned u32x2_t __attribute__((ext_vector_type(2)));
typedef GAS unsigned gu32;
typedef GAS unsigned long long gu64;
#define RLX_AGENT __ATOMIC_RELAXED, __HIP_MEMORY_SCOPE_AGENT
#define LDS_WAIT() asm volatile("s_waitcnt lgkmcnt(0)" ::: "memory")
#define VM_WAIT() asm volatile("s_waitcnt vmcnt(0)" ::: "memory")
__device__ __forceinline__ unsigned long long rt() { return __builtin_amdgcn_s_memrealtime(); }
__device__ __forceinline__ unsigned f2bf(float f) { unsigned u = __builtin_bit_cast(unsigned, f); return (u + 0x7fffu + ((u >> 16) & 1u)) >> 16; }
__device__ __forceinline__ unsigned pk2(float lo, float hi) { return f2bf(lo) | (f2bf(hi) << 16); }

#define XB_TMO      128
#define XB_XCNT(j)  (256  + 64 * (j))
#define XB_XSUB(j)  (1280 + 64 * (j))
#define XB_XGEN(j)  (2304 + 64 * (j))
#define XB_TOP      3328
#define XB_TOPGEN   3392
#define XCD_BAR_WORDS 3456
#define XB_SPIN_CAP (1u << 18)

__device__ __forceinline__ unsigned xb_ld(unsigned* p)              { return __hip_atomic_load(p, __ATOMIC_RELAXED, __HIP_MEMORY_SCOPE_AGENT); }
__device__ __forceinline__ unsigned xb_add(unsigned* p, unsigned v) { return __hip_atomic_fetch_add(p, v, __ATOMIC_RELAXED, __HIP_MEMORY_SCOPE_AGENT); }
__device__ __forceinline__ unsigned xb_xcc_id() { return (unsigned)__builtin_amdgcn_s_getreg((3 << 11) | 20) & 0xFu; }
#define XB_SPIN(cond, bar) do { unsigned _sp = 0; while (cond) { __builtin_amdgcn_s_sleep(1); \
    if ((++_sp & 255u) == 0u) { if (xb_ld(&(bar)[XB_TMO])) break; if (_sp > XB_SPIN_CAP) { atomicAdd(&(bar)[XB_TMO], 1u); break; } } } } while (0)

struct XcdBarrier {
    unsigned* bar; unsigned x;
    volatile LAS unsigned* st;
};

__device__ __forceinline__ XcdBarrier xcd_barrier_post(unsigned* bar, volatile LAS unsigned* st) {
    XcdBarrier b; b.bar = bar; b.x = xb_xcc_id(); b.st = st;
    if (threadIdx.x == 0) (void)xb_add(&bar[XB_XCNT(b.x)], 1u);
    return b;
}
__device__ __forceinline__ void xcd_barrier_complete(unsigned* bar, unsigned x, unsigned& nloc, unsigned& nx) {
    const unsigned G = gridDim.x * gridDim.y * gridDim.z;
    unsigned sum, cnt, mine, sp = 0u;
    for (;;) {
        sum = 0u; cnt = 0u; mine = 0u;
#pragma unroll
        for (unsigned j = 0; j < 16; ++j) { const unsigned c = xb_ld(&bar[XB_XCNT(j)]); sum += c; cnt += (c > 0u) ? 1u : 0u; mine = (j == x) ? c : mine; }
        if (sum == G) break;
        __builtin_amdgcn_s_sleep(1);
        if ((++sp & 255u) == 0u) { if (xb_ld(&bar[XB_TMO])) break; if (sp > XB_SPIN_CAP) { atomicAdd(&bar[XB_TMO], 1u); break; } }
    }
    nloc = mine > 0u ? mine : 1u; nx = cnt > 0u ? cnt : 1u;
}

__device__ __forceinline__ void xcd_barrier(const XcdBarrier& b) {
    asm volatile("s_waitcnt vmcnt(0)" ::: "memory");
    __syncthreads();
    if (threadIdx.x == 0) {
        unsigned* bar = b.bar;
        __builtin_amdgcn_s_waitcnt(0);
        unsigned nloc = b.st[0], nx = b.st[1];
        if (nloc == 0u) { xcd_barrier_complete(bar, b.x, nloc, nx); b.st[0] = nloc; b.st[1] = nx; }
        const unsigned old = xb_add(&bar[XB_XSUB(b.x)], 1u);
        const unsigned gen = old / nloc;
        const unsigned tgen = gen;
        if (old + 1u == (gen + 1u) * nloc) {
            __builtin_amdgcn_fence(__ATOMIC_RELEASE, "agent");
            asm volatile("s_waitcnt vmcnt(0)" ::: "memory");
            const unsigned og = xb_add(&bar[XB_TOP], 1u);
            const unsigned tg = og / nx;
            if (og + 1u == (tg + 1u) * nx) xb_add(&bar[XB_TOPGEN], 1u);
            else XB_SPIN(xb_ld(&bar[XB_TOPGEN]) == tg, bar);
        } else {
            XB_SPIN(xb_ld(&bar[XB_TOPGEN]) == tgen, bar);
        }
        __builtin_amdgcn_fence(__ATOMIC_ACQUIRE, "agent");
        asm volatile("s_waitcnt vmcnt(0)" ::: "memory");
    }
    __syncthreads();
}

struct Args {
    const float* x; const float* p; const int* positions; const float* g_mix; const float* w_in;
    const float* sbq; const float* sbk; const float* rq; const float* rk; const float* gn_g; const float* gn_b; const float* w_out;
    const float* g_ffn; const float* w_r; const float* b_r; const float* w_ug; const float* b_ug; const float* w_dn; const float* b_dn;
    const float* g_ple; const float* w_pg; const float* w_pp;
    float* out; unsigned char* ws; int ph_lo, ph_hi;
};
struct Frame {
    LAS unsigned char* lds;
    volatile LAS unsigned* MISC;
    gu32* ctl;
    int wave;
    int vcu, G;
};
__device__ __forceinline__ int tid_now() { int t = threadIdx.x; asm volatile("" : "+v"(t)); return t; }
__device__ __forceinline__ float wave_sum(float v) {
#pragma unroll
    for (int o = 1; o < 64; o <<= 1) v += __shfl_xor(v, o);
    return v;
}
__device__ __forceinline__ unsigned cvtpk(float lo, float hi) { return pg8::cvt_pk_bf16(lo, hi); }

enum { MAP_NAT = 0, MAP_IN = 1, MAP_UG = 2 };
__device__ __forceinline__ void p0_item(const float* __restrict__ W, int N, int K, bf16* __restrict__ WT, int kb, int nb, int mapmode, LAS unsigned char* scr, int lane) {
    const int np = 64 * nb + 4 * (lane & 15);
    int src = np;
    if (mapmode == MAP_IN) { const int pn = np >> 8, L = np & 255, bj = L >> 7, wc = (L >> 5) & 3, e = L & 31; src = 256 * pn + 64 * wc + 32 * bj + e; }
    else if (mapmode == MAP_UG) { const int pn = np >> 8, L = np & 255, bj = L >> 7, i = L & 127; src = 1024 * bj + 128 * pn + i; }
    const float* gp = W + (size_t)(64 * kb + (lane >> 4)) * N + src;
    f32x4 v[16];
#pragma unroll
    for (int i = 0; i < 16; ++i) v[i] = *(const f32x4*)(gp + (size_t)(4 * i) * N);
#pragma unroll
    for (int i = 0; i < 16; ++i) {
        LAS unsigned* d = (LAS unsigned*)(scr + (4 * i + (lane >> 4)) * 132 + 8 * (lane & 15));
        d[0] = cvtpk(v[i][0], v[i][1]); d[1] = cvtpk(v[i][2], v[i][3]);
    }
    LDS_WAIT(); asm volatile("" ::: "memory");
    const int c = lane & 7;
#pragma unroll
    for (int it = 0; it < 4; ++it) {
        const int nl = 16 * it + 2 * (lane >> 3);
        unsigned d[8];
#pragma unroll
        for (int j = 0; j < 8; ++j) d[j] = *(const LAS unsigned*)(scr + (8 * c + j) * 132 + 2 * nl);
        v4u o0, o1;
        o0.x = (d[0] & 0xffffu) | (d[1] << 16); o0.y = (d[2] & 0xffffu) | (d[3] << 16); o0.z = (d[4] & 0xffffu) | (d[5] << 16); o0.w = (d[6] & 0xffffu) | (d[7] << 16);
        o1.x = (d[0] >> 16) | (d[1] & 0xffff0000u); o1.y = (d[2] >> 16) | (d[3] & 0xffff0000u); o1.z = (d[4] >> 16) | (d[5] & 0xffff0000u); o1.w = (d[6] >> 16) | (d[7] & 0xffff0000u);
        bf16* dst = WT + (size_t)(64 * nb + nl) * K + 64 * kb + 8 * c;
        *(v4u*)dst = o0; *(v4u*)(dst + K) = o1;
    }
    LDS_WAIT(); asm volatile("" ::: "memory");
}
__device__ __forceinline__ unsigned pk4_fp8(float a, float b, float c, float d) { int r = __builtin_amdgcn_cvt_pk_fp8_f32(a, b, 0, false); r = __builtin_amdgcn_cvt_pk_fp8_f32(c, d, r, true); return (unsigned)r; }
__device__ __forceinline__ void p0_item_f8(const float* __restrict__ W, int N, int K, unsigned char* __restrict__ WT, int kb, int nb, int mapmode, LAS unsigned char* scr, int lane) {
    const int np = 64 * nb + 4 * (lane & 15);
    int src = np;
    if (mapmode == MAP_UG) { const int pn = np >> 8, L = np & 255, bj = L >> 7, i = L & 127; src = 1024 * bj + 128 * pn + i; }
    const float* gp = W + (size_t)(64 * kb + (lane >> 4)) * N + src;
    f32x4 v[16];
#pragma unroll
    for (int i = 0; i < 16; ++i) v[i] = *(const f32x4*)(gp + (size_t)(4 * i) * N);
#pragma unroll
    for (int i = 0; i < 16; ++i) *(LAS unsigned*)(scr + (4 * i + (lane >> 4)) * 68 + 4 * (lane & 15)) = pk4_fp8(v[i][0] * 64.0f, v[i][1] * 64.0f, v[i][2] * 64.0f, v[i][3] * 64.0f);
    LDS_WAIT(); asm volatile("" ::: "memory");
    const int nq = lane & 15, kg = lane >> 4;
    unsigned d[16];
#pragma unroll
    for (int j = 0; j < 16; ++j) d[j] = *(const LAS unsigned*)(scr + (16 * kg + j) * 68 + 4 * nq);
#pragma unroll
    for (int t = 0; t < 4; ++t) {
        v4u o;
#pragma unroll
        for (int q = 0; q < 4; ++q) o[q] = ((d[4 * q] >> (8 * t)) & 0xffu) | (((d[4 * q + 1] >> (8 * t)) & 0xffu) << 8) | (((d[4 * q + 2] >> (8 * t)) & 0xffu) << 16) | (((d[4 * q + 3] >> (8 * t)) & 0xffu) << 24);
        *(v4u*)(WT + (size_t)(64 * nb + 4 * nq + t) * K + 64 * kb + 16 * kg) = o;
    }
    LDS_WAIT(); asm volatile("" ::: "memory");
}
struct P0D { const float* gp; int N, K, kb, nb; bf16* W16; unsigned char* W8; const float* rsc; };
__device__ __forceinline__ int p0_src_col(int np, int mapmode) {
    int src = np;
    if (mapmode == MAP_IN) { const int pn = np >> 8, L = np & 255, bj = L >> 7, wc = (L >> 5) & 3, e = L & 31; src = 256 * pn + 64 * wc + 32 * bj + e; }
    else if (mapmode == MAP_UG) { const int pn = np >> 8, L = np & 255, bj = L >> 7, i = L & 127; src = 1024 * bj + 128 * pn + i; }
    return src;
}
__device__ __forceinline__ P0D p0_mk(const float* W, int N, int K, bf16* W16, unsigned char* W8, int kb, int nb, int mapmode, int lane, const float* rsc = nullptr) {
    P0D d; d.N = N; d.K = K; d.kb = kb; d.nb = nb; d.W16 = W16; d.W8 = W8;
    if (W8) {
        d.rsc = rsc ? rsc + 128 * kb + (lane >> 3) : nullptr;
        d.gp = W + (size_t)(128 * kb + (lane >> 3)) * N + p0_src_col(32 * nb + 4 * (lane & 7), mapmode);
    } else {
        d.rsc = nullptr;
        d.gp = W + (size_t)(64 * kb + (lane >> 4)) * N + p0_src_col(64 * nb + 4 * (lane & 15), mapmode);
    }
    return d;
}
__device__ __forceinline__ void p0_load(const P0D& d, f32x4 (&v)[16]) {
#pragma unroll
    for (int i = 0; i < 16; ++i) v[i] = __builtin_nontemporal_load((const f32x4*)(d.gp + (size_t)((d.W8 ? 8 : 4) * i) * d.N));
}
__device__ __forceinline__ void p0_finish(const P0D& d, const f32x4 (&v)[16], LAS unsigned char* scr, int lane, const int pm = 0) {
    if (pm == 1) { _Pragma("unroll") for (int i = 0; i < 16; ++i) asm volatile("" :: "v"(v[i])); return; }
    if (d.W16) {
#pragma unroll
        for (int i = 0; i < 16; ++i) { LAS unsigned* q = (LAS unsigned*)(scr + (4 * i + (lane >> 4)) * 132 + 8 * (lane & 15)); q[0] = cvtpk(v[i][0], v[i][1]); q[1] = cvtpk(v[i][2], v[i][3]); }
        LDS_WAIT(); asm volatile("" ::: "memory");
        const int c = lane & 7;
#pragma unroll
        for (int it = 0; it < 4; ++it) {
            const int nl = 16 * it + 2 * (lane >> 3);
            unsigned x[8];
#pragma unroll
            for (int j = 0; j < 8; ++j) x[j] = *(const LAS unsigned*)(scr + (8 * c + j) * 132 + 2 * nl);
            v4u o0, o1;
            o0.x = (x[0] & 0xffffu) | (x[1] << 16); o0.y = (x[2] & 0xffffu) | (x[3] << 16); o0.z = (x[4] & 0xffffu) | (x[5] << 16); o0.w = (x[6] & 0xffffu) | (x[7] << 16);
            o1.x = (x[0] >> 16) | (x[1] & 0xffff0000u); o1.y = (x[2] >> 16) | (x[3] & 0xffff0000u); o1.z = (x[4] >> 16) | (x[5] & 0xffff0000u); o1.w = (x[6] >> 16) | (x[7] & 0xffff0000u);
            bf16* dst = d.W16 + (size_t)(64 * d.nb + nl) * d.K + 64 * d.kb + 8 * c;
            if (pm == 0 || pm == 3) { *(v4u*)dst = o0; *(v4u*)(dst + d.K) = o1; } else asm volatile("" :: "v"(o0), "v"(o1));
        }
    } else {
#pragma unroll
        for (int i = 0; i < 16; ++i) { const float sc = d.rsc ? d.rsc[8 * i] * 64.0f : 64.0f; *(LAS unsigned*)(scr + (8 * i + (lane >> 3)) * 36 + 4 * (lane & 7)) = pk4_fp8(v[i][0] * sc, v[i][1] * sc, v[i][2] * sc, v[i][3] * sc); }
        LDS_WAIT(); asm volatile("" ::: "memory");
        const int nq = lane & 7, kg = lane >> 3;
        unsigned x[16];
#pragma unroll
        for (int j = 0; j < 16; ++j) x[j] = *(const LAS unsigned*)(scr + (16 * kg + j) * 36 + 4 * nq);
#pragma unroll
        for (int t = 0; t < 4; ++t) {
            v4u o;
#pragma unroll
            for (int q = 0; q < 4; ++q) o[q] = ((x[4 * q] >> (8 * t)) & 0xffu) | (((x[4 * q + 1] >> (8 * t)) & 0xffu) << 8) | (((x[4 * q + 2] >> (8 * t)) & 0xffu) << 16) | (((x[4 * q + 3] >> (8 * t)) & 0xffu) << 24);
            if (pm == 0 || pm == 3) __builtin_nontemporal_store(o, (v4u*)(d.W8 + (size_t)(32 * d.nb + 4 * nq + t) * d.K + 128 * d.kb + 16 * kg)); else asm volatile("" :: "v"(o));
        }
    }
    LDS_WAIT(); asm volatile("" ::: "memory");
}
__device__ __forceinline__ P0D p0_decode(const Args& a, unsigned char* ws, int it, int lane) {
    constexpr int I_IN = 16 * 56, I_OUT = 256, I_PG = 256, I_PP = 4 * 16, I_UG = 16 * 32, I_DN = 256;
    int r = it;
    if (r < I_IN) return p0_mk(a.w_in, DIN, DM, (bf16*)(ws + WS_WT_IN), nullptr, r / 56, r % 56, MAP_IN, lane); r -= I_IN;
    if (r < I_OUT) return p0_mk(a.w_out, DM, DM, (bf16*)(ws + WS_WT_OUT), nullptr, r / 16, r % 16, MAP_NAT, lane); r -= I_OUT;
    if (r < I_PG) return p0_mk(a.w_pg, DM, DM, nullptr, (unsigned char*)(ws + WS_WT_PG), r / 32, r % 32, MAP_NAT, lane); r -= I_PG;
    if (r < I_PP) return p0_mk(a.w_pp, DM, PLE, (bf16*)(ws + WS_WT_PP), nullptr, r / 16, r % 16, MAP_NAT, lane); r -= I_PP;
    if (r < NE * I_UG) { const int e = r / I_UG, q = r % I_UG; return p0_mk(a.w_ug + (size_t)e * DM * 2048, 2048, DM, nullptr, (unsigned char*)(ws + WS_WT_UG) + (size_t)e * 2048 * DM, q / 64, q % 64, MAP_UG, lane, a.g_ffn); } r -= NE * I_UG;
    { const int e = r / I_DN, q = r % I_DN; return p0_mk(a.w_dn + (size_t)e * DM * DM, DM, DM, nullptr, (unsigned char*)(ws + WS_WT_DN) + (size_t)e * DM * DM, q / 32, q % 32, MAP_NAT, lane); }
}
__device__ __forceinline__ void rms_row_to_bf16(const float* xrow, const float* g, bf16* orow, int lane) {
    const f32x4* xr = (const f32x4*)xrow + lane;
    f32x4 v[4]; float s = 0.f;
#pragma unroll
    for (int j = 0; j < 4; ++j) { v[j] = xr[64 * j]; s += (v[j][0] * v[j][0] + v[j][1] * v[j][1]) + (v[j][2] * v[j][2] + v[j][3] * v[j][3]); }
    const float rstd = rsqrtf(wave_sum(s) * (1.f / DM) + EPS);
    unsigned long long* o8 = (unsigned long long*)orow + lane;
#pragma unroll
    for (int j = 0; j < 4; ++j) { const f32x4 gg = ((const f32x4*)g)[lane + 64 * j];
        o8[64 * j] = (unsigned long long)cvtpk(v[j][0] * rstd * gg[0], v[j][1] * rstd * gg[1]) | ((unsigned long long)cvtpk(v[j][2] * rstd * gg[2], v[j][3] * rstd * gg[3]) << 32); }
}
__device__ __forceinline__ void p0_prologue(Frame& F, const Args& a, const int pm = 0) {
    unsigned char* ws = a.ws; const int tid = tid_now(), lane = tid & 63;
    LAS unsigned char* scr = F.lds + RING_OFF + F.wave * 8448;
    const int gw = F.vcu * NWAVES + F.wave, NGW = F.G * NWAVES;
    constexpr int I_IN = 16 * 56, I_OUT = 256, I_PG = 256, I_PP = 4 * 16, I_UG = 16 * 32, I_DN = 256;
    constexpr int NITEMS = I_IN + I_OUT + I_PG + I_PP + NE * I_UG + NE * I_DN;
    if (gw < NITEMS) {
        int it = gw; P0D d0 = p0_decode(a, ws, it, lane), d1 = d0; f32x4 va[16], vb[16]; p0_load(d0, va);
        for (;;) {
            const int it1 = it + NGW; const bool h1 = it1 < NITEMS;
            if (h1) { d1 = p0_decode(a, ws, it1, lane); p0_load(d1, vb); }
            p0_finish(d0, va, scr, lane, pm);
            if (!h1) break;
            const int it2 = it1 + NGW; const bool h2 = it2 < NITEMS;
            if (h2) { d0 = p0_decode(a, ws, it2, lane); p0_load(d0, va); }
            p0_finish(d1, vb, scr, lane, pm);
            if (!h2) break;
            it = it2;
        }
    }
    if (pm != 0) return;
    if (blockIdx.x == 0 && tid < 256) { const int t = tid; const float* srcs = (t < 64) ? a.sbq : (t < 128) ? a.sbk : (t < 192) ? a.rq : a.rk; ((float*)(ws + WS_GAINS))[t] = srcs[t & 63]; }
    {
        f32x4 gg[4];
#pragma unroll
        for (int j = 0; j < 4; ++j) gg[j] = ((const f32x4*)a.g_mix)[lane + 64 * j];
        for (int m0 = 4 * gw; m0 < T; m0 += 4 * NGW) {
            f32x4 v[4][4];
#pragma unroll
            for (int r = 0; r < 4; ++r)
#pragma unroll
                for (int j = 0; j < 4; ++j) v[r][j] = __builtin_nontemporal_load((const f32x4*)(a.x + (size_t)(m0 + r) * DM) + lane + 64 * j);
#pragma unroll
            for (int r = 0; r < 4; ++r) {
                float ss = 0.f;
#pragma unroll
                for (int j = 0; j < 4; ++j) ss += (v[r][j][0] * v[r][j][0] + v[r][j][1] * v[r][j][1]) + (v[r][j][2] * v[r][j][2] + v[r][j][3] * v[r][j][3]);
                const float rstd = rsqrtf(wave_sum(ss) * (1.f / DM) + EPS);
                unsigned long long* o8 = (unsigned long long*)((bf16*)(ws + WS_XN) + (size_t)(m0 + r) * DM) + lane;
#pragma unroll
                for (int j = 0; j < 4; ++j) o8[64 * j] = (unsigned long long)cvtpk(v[r][j][0] * rstd * gg[j][0], v[r][j][1] * rstd * gg[j][1]) | ((unsigned long long)cvtpk(v[r][j][2] * rstd * gg[j][2], v[r][j][3] * rstd * gg[j][3]) << 32);
            }
        }
    }
    { const int gt = gw * 64 + lane, NGT = NGW * 64;
      for (int i0 = gt; i0 < T * PLE / 8; i0 += 4 * NGT) {
          f32x4 a0[4], a1[4];
#pragma unroll
          for (int q = 0; q < 4; ++q) { const int i = i0 + q * NGT; if (i < T * PLE / 8) { a0[q] = __builtin_nontemporal_load((const f32x4*)a.p + 2 * i); a1[q] = __builtin_nontemporal_load((const f32x4*)a.p + 2 * i + 1); } }
#pragma unroll
          for (int q = 0; q < 4; ++q) { const int i = i0 + q * NGT; if (i < T * PLE / 8) { v4u o; o.x = cvtpk(a0[q][0], a0[q][1]); o.y = cvtpk(a0[q][2], a0[q][3]); o.z = cvtpk(a1[q][0], a1[q][1]); o.w = cvtpk(a1[q][2], a1[q][3]); ((v4u*)(ws + WS_PB))[i] = o; } }
      }
      for (int i = gt; i < NE * DM; i += NGT) { const int e = i >> 10, k = i & (DM - 1); const float wv = a.w_r[(size_t)k * NE + e] * a.g_ffn[k];
          const unsigned hi = cvtpk(wv, 0.f) & 0xffffu; const unsigned lo = cvtpk(wv - __uint_as_float(hi << 16), 0.f) & 0xffffu;
          ((bf16*)(ws + WS_WRT))[i] = (bf16)hi; ((bf16*)(ws + WS_WRT))[NE * DM + i] = (bf16)lo; }
      float* rc = (float*)(ws + WS_ROPEC); float* rs = (float*)(ws + WS_ROPES);
      for (int i = gt; i < T * 32; i += NGT) { const int row = i >> 5, f = i & 31;
          const float inv_freq = exp2f(-(float)f * (13.287712379549449f / 32.0f));   const float ang = (float)a.positions[row] * inv_freq;
          float sn, cs; sincosf(ang, &sn, &cs); rc[i] = cs; rs[i] = sn; } }
}

namespace att {
typedef short bf16x8 __attribute__((ext_vector_type(8)));
typedef short s16x4 __attribute__((ext_vector_type(4)));
typedef float f32x16 __attribute__((ext_vector_type(16)));
typedef short v4i16_t __attribute__((ext_vector_type(4)));
constexpr int LK = 0, LV = 24576, LFLAG = 49152;
__device__ __forceinline__ s16x4 vtr(LAS const unsigned char* p) { return __builtin_bit_cast(s16x4, __builtin_amdgcn_ds_read_tr16_b64_v4i16((LAS v4i16_t*)p)); }
__device__ __forceinline__ int crow(int r, int hi) { return (r & 3) + 8 * (r >> 2) + 4 * hi; }
struct AttnArgs { const bf16* hm; const bf16* rg; bf16* Y; const float* gn_g; const float* gn_b; };

template <int MODE, int ABL = 0> __device__ __forceinline__ void attn_unit(LAS unsigned char* lds, const AttnArgs& A, int b, int h, int qb) {
    int tid_ = threadIdx.x; asm volatile("" : "+v"(tid_));
    const int tid = tid_, lane = tid & 63, r32 = lane & 31, hh = lane >> 5;
    const int w = __builtin_amdgcn_readfirstlane(tid >> 6);
    const int q0 = qb * 256, qw = q0 + 32 * w;
    const size_t TS = (size_t)T * 512;
    const size_t hoff = (size_t)(b * 8 + h) * SEQ * 64;
    const bf16* Qp = A.hm + (MODE == 0 ? 0 : 3) * TS + hoff;
    const bf16* Kp = A.hm + (MODE == 0 ? 1 : 4) * TS + hoff;
    const bf16* Vp = A.hm + (MODE == 0 ? 2 : 5) * TS + hoff;
    bf16x8 qf[4];
#pragma unroll
    for (int ds = 0; ds < 4; ++ds) qf[ds] = *(const bf16x8*)(Qp + (size_t)(qw + r32) * 64 + 16 * ds + 8 * hh);
    f32x16 o[2];
#pragma unroll
    for (int r = 0; r < 16; ++r) { o[0][r] = 0.f; o[1][r] = 0.f; }
    float carry = 1.0f;
    const int jmax = (q0 + 255) >> 6, jd = (qw + 31) >> 6;
    const float lg2g = __log2f(1.0f - __builtin_amdgcn_exp2f(-5.0f - (float)h));
    const int krow = 8 * w + (lane >> 3);
    const bf16* Kt = Kp + (size_t)krow * 64 + (((lane & 7) ^ ((krow >> 1) & 7)) << 3); const bf16* Vt = Vp + (size_t)w * 512 + lane * 8;
    volatile LAS unsigned* flags = (volatile LAS unsigned*)(lds + LFLAG);
#define ATT_DMA(t, so) do { __builtin_amdgcn_global_load_lds((const unsigned*)(Kt + (size_t)(t) * 4096), (LAS unsigned*)(lds + LK + (so) + w * 1024), 16, 0, 0); \
                            __builtin_amdgcn_global_load_lds((const unsigned*)(Vt + (size_t)(t) * 4096), (LAS unsigned*)(lds + LV + (so) + w * 1024), 16, 0, 0); } while (0)
    ATT_DMA(jmax, 0);
    if (jmax >= 1) { ATT_DMA(jmax - 1, 8192); asm volatile("s_waitcnt vmcnt(2)\n\ts_barrier" ::: "memory"); }
    else asm volatile("s_waitcnt vmcnt(0)\n\ts_barrier" ::: "memory");
    bool finished = false;
    int so_cur = 0, so_new = 16384;
    for (int j = jmax; j >= 0; --j) {
        const int cur = j & 1;
        if (j >= 2 && ABL != 4) ATT_DMA(j - 2, so_new);
        if (j <= jd && !finished && ABL == 0) {
            LAS const unsigned char* Kb = lds + LK + so_cur;
            LAS const unsigned char* Vb = lds + LV + so_cur;
            f32x16 p[2];
#pragma unroll
            for (int r = 0; r < 16; ++r) { p[0][r] = 0.f; p[1][r] = 0.f; }
            bf16x8 kf[4][2];
            const int ksw = (r32 >> 1) & 7;
#pragma unroll
            for (int ds = 0; ds < 4; ++ds) { kf[ds][0] = *(LAS const bf16x8*)(Kb + r32 * 128 + (((2 * ds + hh) ^ ksw) << 4)); kf[ds][1] = *(LAS const bf16x8*)(Kb + 4096 + r32 * 128 + (((2 * ds + hh) ^ ksw) << 4)); }
#pragma unroll
            for (int ds = 0; ds < 4; ++ds) {
                p[0] = __builtin_amdgcn_mfma_f32_32x32x16_bf16(kf[ds][0], qf[ds], p[0], 0, 0, 0);
                p[1] = __builtin_amdgcn_mfma_f32_32x32x16_bf16(kf[ds][1], qf[ds], p[1], 0, 0, 0);
            }
            const bool diag = (j == jd);
            const int qg = qw + r32, kv0 = 64 * j + 4 * hh;
            if (MODE == 0) {
                float om[2][16];
#pragma unroll
                for (int hf = 0; hf < 2; ++hf)
#pragma unroll
                    for (int r = 0; r < 16; ++r) {
                        const float Z = p[hf][r];
                        const float a = __builtin_amdgcn_exp2f(-__builtin_fabsf(Z));
                        const float rc = __builtin_amdgcn_rcpf(1.0f + a), ar = a * rc;
                        const bool pos = Z >= 0.f;
                        p[hf][r] = pos ? rc : ar;
                        om[hf][r] = pos ? ar : rc;
                    }
                if (diag) {
#pragma unroll
                    for (int hf = 0; hf < 2; ++hf)
#pragma unroll
                        for (int r = 0; r < 16; ++r) { const bool valid = kv0 + 32 * hf + (r & 3) + 8 * (r >> 2) < qg; p[hf][r] = valid ? p[hf][r] : 0.f; om[hf][r] = valid ? om[hf][r] : 1.0f; }
                }
                float gs[8], ot[8];
#pragma unroll
                for (int m = 0; m < 8; ++m) { const int hf = m >> 2, g = m & 3; gs[m] = (om[hf][4 * g] * om[hf][4 * g + 1]) * (om[hf][4 * g + 2] * om[hf][4 * g + 3]); ot[m] = __shfl_xor(gs[m], 32); }
                float ps[8];
                ps[7] = 1.0f;
#pragma unroll
                for (int m = 6; m >= 0; --m) ps[m] = ps[m + 1] * (gs[m + 1] * ot[m + 1]);
                const float total = ps[0] * (gs[0] * ot[0]);
#pragma unroll
                for (int m = 0; m < 8; ++m) {
                    const int hf = m >> 2, g = m & 3;
                    float tail = carry * (hh ? ps[m] : ps[m] * ot[m]);
#pragma unroll
                    for (int i = 3; i >= 0; --i) { const int r = 4 * g + i; const float o1 = om[hf][r]; p[hf][r] *= tail; tail *= o1; }
                }
                carry *= total;
                finished = __all(carry < 1.0e-37f);
            } else {
                const float ct = __builtin_amdgcn_exp2f(lg2g * (float)(qw - 64 * j));
#pragma unroll
                for (int hf = 0; hf < 2; ++hf)
#pragma unroll
                    for (int r = 0; r < 16; ++r) p[hf][r] *= ct;
                if (diag) {
#pragma unroll
                    for (int hf = 0; hf < 2; ++hf)
#pragma unroll
                        for (int r = 0; r < 16; ++r) { const bool valid = kv0 + 32 * hf + (r & 3) + 8 * (r >> 2) <= qg; p[hf][r] = valid ? p[hf][r] : 0.f; }
                }
            }
            {
                const unsigned vbase = (unsigned)(uintptr_t)(Vb + (4 * hh + ((lane & 15) >> 2)) * 128 + (16 * ((lane >> 4) & 1) + 4 * (lane & 3)) * 2);
                s16x4 vl[2][2][2], vh[2][2][2];
#pragma unroll
                for (int hf = 0; hf < 2; ++hf)
#pragma unroll
                    for (int s = 0; s < 2; ++s)
#pragma unroll
                        for (int d0 = 0; d0 < 2; ++d0) {
                            asm volatile("ds_read_b64_tr_b16 %0, %1 offset:%c2" : "=&v"(vl[hf][s][d0]) : "v"(vbase), "i"(hf * 4096 + s * 2048 + d0 * 64) : "memory");
                            asm volatile("ds_read_b64_tr_b16 %0, %1 offset:%c2" : "=&v"(vh[hf][s][d0]) : "v"(vbase), "i"(hf * 4096 + s * 2048 + d0 * 64 + 1024) : "memory");
                        }
                bf16x8 wfr[2][2];
#pragma unroll
                for (int hf = 0; hf < 2; ++hf)
#pragma unroll
                    for (int s = 0; s < 2; ++s) {
                        u32x4_t wq;
                        wq.x = pg8::cvt_pk_bf16(p[hf][8 * s + 0], p[hf][8 * s + 1]); wq.y = pg8::cvt_pk_bf16(p[hf][8 * s + 2], p[hf][8 * s + 3]);
                        wq.z = pg8::cvt_pk_bf16(p[hf][8 * s + 4], p[hf][8 * s + 5]); wq.w = pg8::cvt_pk_bf16(p[hf][8 * s + 6], p[hf][8 * s + 7]);
                        wfr[hf][s] = __builtin_bit_cast(bf16x8, wq);
                    }
                asm volatile("s_waitcnt lgkmcnt(0)" ::: "memory"); __builtin_amdgcn_sched_barrier(0);
#pragma unroll
                for (int hf = 0; hf < 2; ++hf)
#pragma unroll
                    for (int s = 0; s < 2; ++s)
#pragma unroll
                        for (int d0 = 0; d0 < 2; ++d0) {
                            const s16x4 lo = vl[hf][s][d0], hi = vh[hf][s][d0];
                            const bf16x8 vf = (bf16x8){lo[0], lo[1], lo[2], lo[3], hi[0], hi[1], hi[2], hi[3]};
                            o[d0] = __builtin_amdgcn_mfma_f32_32x32x16_bf16(vf, wfr[hf][s], o[d0], 0, 0, 0);
                        }
            }
        }
        if (MODE == 0) { if (lane == 0) flags[cur * 8 + w] = finished ? 1u : 0u; }
        if (j >= 2) asm volatile("s_waitcnt vmcnt(2) lgkmcnt(0)\n\ts_barrier" ::: "memory"); else asm volatile("s_waitcnt vmcnt(0) lgkmcnt(0)\n\ts_barrier" ::: "memory");
        so_cur = (so_cur == 16384) ? 0 : so_cur + 8192; so_new = (so_new == 16384) ? 0 : so_new + 8192;
        if (MODE == 0) {
            unsigned all = 1u;
#pragma unroll
            for (int i = 0; i < 8; ++i) all &= flags[cur * 8 + i];
            if (all) break;
        }
    }
    asm volatile("s_waitcnt vmcnt(0)\n\ts_barrier" ::: "memory");
#undef ATT_DMA
    const int row = b * SEQ + qw + r32;
    if (MODE == 0) {
        bf16* yp = A.Y + (size_t)row * DM + h * 64 + 4 * hh;
#pragma unroll
        for (int d0 = 0; d0 < 2; ++d0)
#pragma unroll
            for (int g = 0; g < 4; ++g) { u32x2_t v; v.x = pg8::cvt_pk_bf16(o[d0][4 * g], o[d0][4 * g + 1]); v.y = pg8::cvt_pk_bf16(o[d0][4 * g + 2], o[d0][4 * g + 3]); *(u32x2_t*)(yp + 32 * d0 + 8 * g) = v; }
    } else {
        float s1 = 0.f;
#pragma unroll
        for (int r = 0; r < 16; ++r) s1 += o[0][r] + o[1][r];
        s1 += __shfl_xor(s1, 32);
        const float mu = s1 * (1.0f / 64.0f);
        float s2 = 0.f;
#pragma unroll
        for (int r = 0; r < 16; ++r) { const float a0 = o[0][r] - mu, a1 = o[1][r] - mu; s2 += a0 * a0 + a1 * a1; }
        s2 += __shfl_xor(s2, 32);
        const float rstd = rsqrtf(s2 * (1.0f / 64.0f) + EPS);
        bf16* yp = A.Y + (size_t)row * DM + 512 + h * 64 + 4 * hh;
        const bf16* gp = A.rg + (size_t)row * 512 + h * 64 + 4 * hh;
        const float* gg = A.gn_g + h * 64 + 4 * hh; const float* gb = A.gn_b + h * 64 + 4 * hh;
#pragma unroll
        for (int d0 = 0; d0 < 2; ++d0)
#pragma unroll
            for (int g = 0; g < 4; ++g) {
                const f32x4 gn = *(const f32x4*)(gg + 32 * d0 + 8 * g), bs = *(const f32x4*)(gb + 32 * d0 + 8 * g);
                const u32x2_t gr = *(const u32x2_t*)(gp + 32 * d0 + 8 * g);
                float gate[4] = {__uint_as_float(gr.x << 16), __uint_as_float(gr.x & 0xffff0000u), __uint_as_float(gr.y << 16), __uint_as_float(gr.y & 0xffff0000u)};
                float ov[4];
#pragma unroll
                for (int i = 0; i < 4; ++i) { const float yn = (o[d0][4 * g + i] - mu) * rstd * gn[i] + bs[i]; const float sg = gate[i] / (1.0f + __expf(-gate[i])); ov[i] = yn * sg; }
                u32x2_t v; v.x = pg8::cvt_pk_bf16(ov[0], ov[1]); v.y = pg8::cvt_pk_bf16(ov[2], ov[3]); *(u32x2_t*)(yp + 32 * d0 + 8 * g) = v;
            }
    }
}
__device__ __forceinline__ void attn_phase(LAS unsigned char* lds, const AttnArgs& A, int vcu, int dup, bf16* dummyY) {
    const int g = vcu >> 5, local = vcu & 31;
    if (dup == 24 || dup == 25) { AttnArgs A2 = A; A2.Y = dummyY;
#pragma unroll 1
        for (int u = 0; u < 2; ++u) { const int bh = 8 * g + 4 * (u & 1) + (local >> 3), qb = (u & 1) ? 7 - (local & 7) : (local & 7); if (dup == 24) attn_unit<1, 3>(lds, A2, bh >> 3, bh & 7, qb); else attn_unit<1, 4>(lds, A2, bh >> 3, bh & 7, qb); } }
#pragma unroll 1
    for (int u = 0; u < ((dup == 20) ? 4 : 2); ++u) { const int bh = 8 * g + 4 * (u & 1) + (local >> 3), qb = (u & 1) ? 7 - (local & 7) : (local & 7); attn_unit<1>(lds, A, bh >> 3, bh & 7, qb); }
#pragma unroll 1
    for (int u = 0; u < ((dup == 21) ? 4 : 2); ++u) { const int bh = 8 * g + 4 * (u & 1) + (local >> 3), qb = (u & 1) ? 7 - (local & 7) : (local & 7); attn_unit<0>(lds, A, bh >> 3, bh & 7, qb); }
}
}

constexpr int CW_GCNT = 2048;
constexpr int LR_LCNT = LDSCTL_OFF + 1024, LR_GBASE = LDSCTL_OFF + 1152;
constexpr int LT_POFF = LDSCTL_OFF + 2048, LT_NT = LDSCTL_OFF + 2176, LT_TILE_E = LDSCTL_OFF + 2304;
struct RouteBufs { int* tok_e; int* tok_slot; float* tok_gate; float* rstd; float* slot_rstd; };
__device__ __forceinline__ RouteBufs route_bufs(unsigned char* ws) { RouteBufs r; r.tok_e = (int*)(ws + WS_ROUTE); r.tok_slot = r.tok_e + T * 4; r.tok_gate = (float*)(r.tok_slot + T * 4); r.rstd = (float*)(ws + WS_ROUTE + 1 * MiB); r.slot_rstd = (float*)(ws + WS_ROUTE + 2 * MiB); return r; }
typedef float f32x2v __attribute__((ext_vector_type(2)));
__device__ __forceinline__ unsigned opq_mask(bool c) { unsigned m = c ? 0xffffffffu : 0u; asm volatile("" : "+v"(m)); return m; }
__device__ __forceinline__ float blendf(unsigned m, float a, float b) { return __uint_as_float((__float_as_uint(a) & m) | (__float_as_uint(b) & ~m)); }
__device__ __forceinline__ int blendi(unsigned m, int a, int b) { return (int)(((unsigned)a & m) | ((unsigned)b & ~m)); }

#define SW2(c, a, b) { const float ta_ = (c) ? (b) : (a), tb_ = (c) ? (a) : (b); a = ta_; b = tb_; }
#define SW2I(c, a, b) { const int ta_ = (c) ? (b) : (a), tb_ = (c) ? (a) : (b); a = ta_; b = tb_; }
#define TOP4_INSERT(x, e) { const float x_ = (x); const int e_ = (e); const bool c3_ = (x_ > v3) || (x_ == v3 && e_ < i3); v3 = c3_ ? x_ : v3; i3 = c3_ ? e_ : i3; \
    const bool c2_ = (v3 > v2) || (v3 == v2 && i3 < i2); SW2(c2_, v2, v3) SW2I(c2_, i2, i3) const bool c1_ = (v2 > v1) || (v2 == v1 && i2 < i1); SW2(c1_, v1, v2) SW2I(c1_, i1, i2) \
    const bool c0_ = (v1 > v0) || (v1 == v0 && i1 < i0); SW2(c0_, v0, v1) SW2I(c0_, i0, i1) }
__device__ __forceinline__ void router_phase(Frame& F, const Args& a, const bool dry = false) {
    unsigned char* ws = a.ws; const int tid = tid_now();
    LAS unsigned char* lds = F.lds;
    const int lane = tid & 63, r32 = lane & 31, hh = lane >> 5, w = F.wave, rg = w >> 2, kq = w & 3;
    volatile LAS unsigned* lcnt = (volatile LAS unsigned*)(lds + LR_LCNT);
    volatile LAS unsigned* gbase = (volatile LAS unsigned*)(lds + LR_GBASE);
    if (tid < 32) lcnt[tid] = 0u;
    const RouteBufs R = route_bufs(dry ? ws + 3 * MiB : ws);
    const int row = F.vcu * 64 + 32 * rg + r32;
    const float* xr = a.out + (size_t)row * DM + 256 * kq + 8 * hh;
    const bf16* wt = (const bf16*)(ws + WS_WRT) + (size_t)r32 * DM + 256 * kq + 8 * hh;
    unsigned char* hp = (unsigned char*)(ws + (dry ? WS_H : WS_XN)) + (size_t)row * DM + 256 * kq + 8 * hh;
    att::f32x16 D;
#pragma unroll
    for (int r = 0; r < 16; ++r) D[r] = 0.f;
    float ss = 0.f;
#pragma unroll 8
    for (int ks = 0; ks < 16; ++ks) {
        const f32x4 v0 = *(const f32x4*)(xr + 16 * ks), v1 = *(const f32x4*)(xr + 16 * ks + 4);
        ss += ((v0[0] * v0[0] + v0[1] * v0[1]) + (v0[2] * v0[2] + v0[3] * v0[3])) + ((v1[0] * v1[0] + v1[1] * v1[1]) + (v1[2] * v1[2] + v1[3] * v1[3]));
        u32x2_t h8; h8.x = pk4_fp8(v0[0], v0[1], v0[2], v0[3]); h8.y = pk4_fp8(v1[0], v1[1], v1[2], v1[3]); *(u32x2_t*)(hp + 16 * ks) = h8;
        u32x4_t xh, xl;
        xh.x = cvtpk(v0[0], v0[1]); xh.y = cvtpk(v0[2], v0[3]); xh.z = cvtpk(v1[0], v1[1]); xh.w = cvtpk(v1[2], v1[3]);
        xl.x = cvtpk(v0[0] - __uint_as_float(xh.x << 16), v0[1] - __uint_as_float(xh.x & 0xffff0000u)); xl.y = cvtpk(v0[2] - __uint_as_float(xh.y << 16), v0[3] - __uint_as_float(xh.y & 0xffff0000u));
        xl.z = cvtpk(v1[0] - __uint_as_float(xh.z << 16), v1[1] - __uint_as_float(xh.z & 0xffff0000u)); xl.w = cvtpk(v1[2] - __uint_as_float(xh.w << 16), v1[3] - __uint_as_float(xh.w & 0xffff0000u));
        const att::bf16x8 whi = *(const att::bf16x8*)(wt + 16 * ks), wlo = *(const att::bf16x8*)(wt + 32 * DM + 16 * ks);
        const att::bf16x8 bxh = __builtin_bit_cast(att::bf16x8, xh), bxl = __builtin_bit_cast(att::bf16x8, xl);
        D = __builtin_amdgcn_mfma_f32_32x32x16_bf16(whi, bxh, D, 0, 0, 0);
        D = __builtin_amdgcn_mfma_f32_32x32x16_bf16(wlo, bxh, D, 0, 0, 0);
        D = __builtin_amdgcn_mfma_f32_32x32x16_bf16(whi, bxl, D, 0, 0, 0);
    }
    { LAS f32x4* dp = (LAS f32x4*)(lds + (w * 64 + lane) * 64);
#pragma unroll
      for (int q = 0; q < 4; ++q) dp[q] = (f32x4){D[4 * q], D[4 * q + 1], D[4 * q + 2], D[4 * q + 3]};
      *(LAS float*)(lds + 32768 + (w * 64 + lane) * 4) = ss; }
    __syncthreads();
    int my_e0 = 0, my_e1 = 0, rk0 = 0, rk1 = 0; float my_g0 = 0.f, my_g1 = 0.f;
    if (kq == 0) {
#pragma unroll
        for (int o = 1; o < 4; ++o) { LAS const f32x4* dp = (LAS const f32x4*)(lds + ((w + o) * 64 + lane) * 64);
#pragma unroll
            for (int q = 0; q < 4; ++q) { const f32x4 t = dp[q]; D[4 * q] += t[0]; D[4 * q + 1] += t[1]; D[4 * q + 2] += t[2]; D[4 * q + 3] += t[3]; }
            ss += *(LAS const float*)(lds + 32768 + ((w + o) * 64 + lane) * 4); }
        ss += __shfl_xor(ss, 32);
        const float rstd = rsqrtf(ss * (1.f / DM) + EPS);
        if (hh == 0) R.rstd[row] = rstd;
        float l[16];
#pragma unroll
        for (int r = 0; r < 16; ++r) l[r] = D[r] * rstd + a.b_r[(r & 3) + 8 * (r >> 2) + 4 * hh];
        float c[8]; int ci[8];
#pragma unroll
        for (int k = 0; k < 4; ++k) {
            float bv = -INFINITY; int bi = 99;
#pragma unroll
            for (int r = 0; r < 16; ++r) { const int e = (r & 3) + 8 * (r >> 2) + 4 * hh; const bool bt = l[r] > bv; bv = bt ? l[r] : bv; bi = bt ? e : bi; }
            c[k] = bv; ci[k] = bi;
#pragma unroll
            for (int r = 0; r < 16; ++r) { const int e = (r & 3) + 8 * (r >> 2) + 4 * hh; l[r] = (e == bi) ? -INFINITY : l[r]; }
        }
#pragma unroll
        for (int k = 0; k < 4; ++k) { c[4 + k] = __shfl_xor(c[k], 32); ci[4 + k] = __shfl_xor(ci[k], 32); }
        float tv[4]; int ti[4];
#pragma unroll
        for (int k = 0; k < 4; ++k) {
            float bv = -INFINITY; int bi = 99;
#pragma unroll
            for (int j = 0; j < 8; ++j) { const bool bt = (c[j] > bv) || (c[j] == bv && ci[j] < bi); bv = bt ? c[j] : bv; bi = bt ? ci[j] : bi; }
            tv[k] = bv; ti[k] = bi;
#pragma unroll
            for (int j = 0; j < 8; ++j) c[j] = (ci[j] == bi) ? -INFINITY : c[j];
        }
        const float v0 = tv[0], v1 = tv[1], v2 = tv[2], v3 = tv[3]; const int i0 = ti[0], i1 = ti[1], i2 = ti[2], i3 = ti[3];
        const float e1 = __expf(v1 - v0), e2 = __expf(v2 - v0), e3 = __expf(v3 - v0), inv = 1.0f / (1.0f + e1 + e2 + e3);
        my_e0 = hh ? i2 : i0; my_e1 = hh ? i3 : i1; my_g0 = (hh ? e2 : 1.0f) * inv; my_g1 = (hh ? e3 : e1) * inv;
        rk0 = (int)__hip_atomic_fetch_add((LAS unsigned*)(lds + LR_LCNT) + my_e0, 1u, __ATOMIC_RELAXED, __HIP_MEMORY_SCOPE_WORKGROUP);
        rk1 = (int)__hip_atomic_fetch_add((LAS unsigned*)(lds + LR_LCNT) + my_e1, 1u, __ATOMIC_RELAXED, __HIP_MEMORY_SCOPE_WORKGROUP);
    }
    __syncthreads();
    if (tid < 32) gbase[tid] = __hip_atomic_fetch_add((unsigned*)(F.ctl + CW_GCNT + (dry ? 64 : 0)) + tid, lcnt[tid], __ATOMIC_RELAXED, __HIP_MEMORY_SCOPE_AGENT);
    __syncthreads();
    if (kq == 0) {
        const int k0 = 2 * hh;
        R.tok_e[row * 4 + k0] = my_e0; R.tok_slot[row * 4 + k0] = (int)gbase[my_e0] + rk0; R.tok_gate[row * 4 + k0] = my_g0;
        R.tok_e[row * 4 + k0 + 1] = my_e1; R.tok_slot[row * 4 + k0 + 1] = (int)gbase[my_e1] + rk1; R.tok_gate[row * 4 + k0 + 1] = my_g1;
    }
}
#undef SW2
#undef SW2I
#undef TOP4_INSERT

__device__ __forceinline__ void build_tables(Frame& F) {
    LAS int* poff = (LAS int*)(F.lds + LT_POFF); LAS int* ntp = (LAS int*)(F.lds + LT_NT); LAS int* tile_e = (LAS int*)(F.lds + LT_TILE_E);
    LAS int* cnts = (LAS int*)(F.lds + LR_LCNT); const int tid = tid_now();
    if (tid < NE) cnts[tid] = (int)__hip_atomic_load((unsigned*)(F.ctl + CW_GCNT) + tid, __ATOMIC_RELAXED, __HIP_MEMORY_SCOPE_AGENT);
    __syncthreads();
    if (tid == 0) {
        int t = 0;
        for (int e = 0; e < NE; ++e) { const int c = cnts[e]; const int nt = (c + 255) >> 8; poff[e] = t * 256; for (int i = 0; i < nt; ++i) tile_e[t + i] = e; t += nt; }
        *ntp = t;
    }
    __syncthreads();
}
__device__ __forceinline__ void gather_phase(Frame& F, const Args& a) {
    unsigned char* ws = a.ws; const int lane = tid_now() & 63; const RouteBufs R = route_bufs(ws);
    LAS const int* poff = (LAS const int*)(F.lds + LT_POFF);
    const int gw = F.vcu * NWAVES + F.wave, NGW = F.G * NWAVES;
    for (int m0 = 4 * gw; m0 < T; m0 += 4 * NGW) {
        v4u h0[4]; float rs[4]; int dsts[4][4];
#pragma unroll
        for (int r = 0; r < 4; ++r) { const int m = m0 + r; h0[r] = __builtin_nontemporal_load((const v4u*)((const unsigned char*)(ws + WS_XN) + (size_t)m * DM) + lane); rs[r] = R.rstd[m];
#pragma unroll
            for (int k = 0; k < 4; ++k) dsts[r][k] = poff[R.tok_e[m * 4 + k]] + R.tok_slot[m * 4 + k]; }
#pragma unroll
        for (int r = 0; r < 4; ++r)
#pragma unroll
            for (int k = 0; k < 4; ++k) { ((v4u*)((unsigned char*)(ws + WS_XS) + (size_t)dsts[r][k] * DM))[lane] = h0[r]; if (lane == 0) R.slot_rstd[dsts[r][k]] = rs[r]; }
    }
}
__device__ __forceinline__ void combine_phase(Frame& F, const Args& a, const bool dry = false) {
    unsigned char* ws = a.ws; const RouteBufs R = route_bufs(ws);
    LAS const int* poff = (LAS const int*)(F.lds + LT_POFF);
    const int gw = F.vcu * NWAVES + F.wave, NGW = F.G * NWAVES, lane = tid_now() & 63;
    for (int m0 = 2 * gw; m0 < T; m0 += 2 * NGW) {
        f32x4 v[2][2][2]; u32x2_t y[2][4][2]; float gt[2][4];
#pragma unroll
        for (int rr = 0; rr < 2; ++rr) { const int m = m0 + rr;
#pragma unroll
            for (int i = 0; i < 2; ++i) { v[rr][i][0] = __builtin_nontemporal_load((const f32x4*)(a.out + (size_t)m * DM + 8 * lane + 512 * i)); v[rr][i][1] = __builtin_nontemporal_load((const f32x4*)(a.out + (size_t)m * DM + 8 * lane + 512 * i + 4)); }
#pragma unroll
            for (int k = 0; k < 4; ++k) { const int e = R.tok_e[m * 4 + k], slot = R.tok_slot[m * 4 + k]; gt[rr][k] = R.tok_gate[m * 4 + k];
                const unsigned char* yr = (const unsigned char*)(ws + WS_YS) + (size_t)(poff[e] + slot) * DM + 8 * lane;
                y[rr][k][0] = __builtin_nontemporal_load((const u32x2_t*)yr); y[rr][k][1] = __builtin_nontemporal_load((const u32x2_t*)(yr + 512)); } }
#pragma unroll
        for (int rr = 0; rr < 2; ++rr) { const int m = m0 + rr;
#pragma unroll
            for (int k = 0; k < 4; ++k)
#pragma unroll
                for (int i = 0; i < 2; ++i) { const u32x2_t yy = y[rr][k][i]; const float g = gt[rr][k];
                    const f32x2v a0 = __builtin_amdgcn_cvt_pk_f32_fp8((int)yy.x, false), a1 = __builtin_amdgcn_cvt_pk_f32_fp8((int)yy.x, true), a2 = __builtin_amdgcn_cvt_pk_f32_fp8((int)yy.y, false), a3 = __builtin_amdgcn_cvt_pk_f32_fp8((int)yy.y, true);
                    v[rr][i][0][0] += g * a0[0]; v[rr][i][0][1] += g * a0[1]; v[rr][i][0][2] += g * a1[0]; v[rr][i][0][3] += g * a1[1];
                    v[rr][i][1][0] += g * a2[0]; v[rr][i][1][1] += g * a2[1]; v[rr][i][1][2] += g * a3[0]; v[rr][i][1][3] += g * a3[1]; }
            float ss = 0.f;
#pragma unroll
            for (int i = 0; i < 2; ++i)
#pragma unroll
                for (int q = 0; q < 2; ++q) { const f32x4 t = v[rr][i][q]; ss += (t[0] * t[0] + t[1] * t[1]) + (t[2] * t[2] + t[3] * t[3]); }
            const float rstd = rsqrtf(wave_sum(ss) * (1.f / DM) + EPS);
            unsigned char* np = (unsigned char*)(ws + (dry ? WS_H : WS_XN)) + (size_t)m * DM + 8 * lane; float* ow = dry ? (float*)(ws + WS_XS) : a.out;
#pragma unroll
            for (int i = 0; i < 2; ++i) { *(f32x4*)(ow + (size_t)m * DM + 8 * lane + 512 * i) = v[rr][i][0]; *(f32x4*)(ow + (size_t)m * DM + 8 * lane + 512 * i + 4) = v[rr][i][1];
                const f32x4 g0 = *(const f32x4*)(a.g_ple + 8 * lane + 512 * i), g1 = *(const f32x4*)(a.g_ple + 8 * lane + 512 * i + 4);
                u32x2_t o; o.x = pk4_fp8(v[rr][i][0][0] * rstd * g0[0], v[rr][i][0][1] * rstd * g0[1], v[rr][i][0][2] * rstd * g0[2], v[rr][i][0][3] * rstd * g0[3]);
                o.y = pk4_fp8(v[rr][i][1][0] * rstd * g1[0], v[rr][i][1][1] * rstd * g1[1], v[rr][i][1][2] * rstd * g1[2], v[rr][i][1][3] * rstd * g1[3]);
                *(u32x2_t*)(np + 512 * i) = o; } }
    }
}

__global__ void __launch_bounds__(NWAVES * 64, 2) mega_fwd(Args args) {
    extern __shared__ __attribute__((aligned(16))) unsigned char lds[];
    Frame F;
    F.lds = (LAS unsigned char*)lds;
    F.MISC = (volatile LAS unsigned*)(F.lds + MISC_OFF);
    F.wave = __builtin_amdgcn_readfirstlane(threadIdx.x >> 6);
    F.G = gridDim.x; { const int bx = blockIdx.x; F.vcu = (F.G % 8 == 0) ? (bx % 8) * (F.G / 8) + bx / 8 : bx; }
    unsigned char* ws = args.ws;
    F.ctl = (gu32*)(ws + WS_CTL);
    for (int u = threadIdx.x; u < (LDS_BYTES - LDSCTL_OFF) / 4; u += NWAVES * 64) ((LAS unsigned*)(F.lds + LDSCTL_OFF))[u] = 0u;
    __syncthreads();
    XcdBarrier bar = xcd_barrier_post((unsigned*)(F.ctl + CW_BAR), F.MISC + 8);
    const int lo = args.ph_lo, hi = args.ph_hi;
#define IN(k) (lo <= (k) && (k) < hi)
#define GRID_BAR() xcd_barrier(bar)
#ifndef DUP_PHASE
#define DUP_PHASE -1
#endif
#define REP(k) for (int rep_ = 0; rep_ < ((DUP_PHASE) == (k) ? 2 : 1); ++rep_)

    if (IN(0)) { if (DUP_PHASE == 40) { p0_prologue(F, args, 1); GRID_BAR(); } if (DUP_PHASE == 41) { p0_prologue(F, args, 2); GRID_BAR(); } if (DUP_PHASE == 42) { p0_prologue(F, args, 3); GRID_BAR(); } REP(0) { p0_prologue(F, args); GRID_BAR(); } }

    if (IN(1)) REP(1) {
        pg8::Gemm g{(const pg8::bf16_t*)(ws + WS_XN), (const pg8::bf16_t*)(ws + WS_WT_IN), DM, 0};
        pg8::StaticOrder S; S.init(T / 256, DIN / 256, F.G, (int)blockIdx.x);
        pg8::EpiProj E{(pg8::bf16_t*)(ws + WS_HM), (pg8::bf16_t*)(ws + WS_RG), (const float*)(ws + WS_GAINS), (const float*)(ws + WS_ROPEC), (const float*)(ws + WS_ROPES)};
        pg8::gemm_phase<pg8::EpiProj, pg8::StaticOrder, true, true>(F.lds + RING_OFF, g, S, E);
        {
            const int G2 = (F.G == 256) ? 128 : F.G, c2 = (F.G == 256) ? (int)blockIdx.x - 128 : (int)blockIdx.x;
            if (c2 >= 0) {
                pg8::Gemm g2{(const pg8::bf16_t*)(ws + WS_PB), (const pg8::bf16_t*)(ws + WS_WT_PP), PLE, 0};
                pg8::StaticOrder S2; S2.init(T / 256, DM / 256, G2, c2);
                pg8::EpiBf16Plain E2{(pg8::bf16_t*)(ws + WS_PJ), DM};
                pg8::gemm_phase<pg8::EpiBf16Plain, pg8::StaticOrder, true, true>(F.lds + RING_OFF, g2, S2, E2);
            }
        }
        GRID_BAR();
    }
    if (IN(2)) REP(2) {
        if (F.G == 256) {
            const att::AttnArgs AA{(const bf16*)(ws + WS_HM), (const bf16*)(ws + WS_RG), (bf16*)(ws + WS_Y), args.gn_g, args.gn_b};
            att::attn_phase(F.lds + RING_OFF, AA, F.vcu, DUP_PHASE, (bf16*)(ws + WS_XS));
        }
        GRID_BAR();
    }
    if (IN(3)) REP(3) {
        pg8::Gemm g{(const pg8::bf16_t*)(ws + WS_Y), (const pg8::bf16_t*)(ws + WS_WT_OUT), DM, 0};
        pg8::StaticOrder S; S.init(T / 256, DM / 256, F.G, (int)blockIdx.x);
        pg8::EpiResid E{args.x, args.out};
        pg8::gemm_phase<pg8::EpiResid, pg8::StaticOrder, true, true>(F.lds + RING_OFF, g, S, E);
        GRID_BAR();
    }
    if (DUP_PHASE == 30 && IN(3)) { GRID_BAR(); GRID_BAR(); GRID_BAR(); GRID_BAR(); }
    if (IN(4)) { if (DUP_PHASE == 4) { if (F.G == 256) router_phase(F, args, true); GRID_BAR(); } if (F.G == 256) router_phase(F, args); GRID_BAR(); }
    if (IN(5) || (lo >= 6 && lo <= 8)) build_tables(F);
    if (IN(5)) REP(5) { gather_phase(F, args); GRID_BAR(); }
    if (IN(6)) REP(6) {
        const int NT = *(LAS const int*)(F.lds + LT_NT);
        pg8::Gemm g{(const pg8::bf16_t*)(ws + WS_XS), (const pg8::bf16_t*)(ws + WS_WT_UG), DM / 2, (size_t)2048 * DM};
        pg8::MoeOrder S; S.init(NT, 8, F.G, (int)blockIdx.x, (LAS const int*)(F.lds + LT_TILE_E));
        pg8::EpiMoeUp E{(unsigned char*)(ws + WS_H), args.b_ug, route_bufs(ws).slot_rstd};
        pg8::gemm_phase<pg8::EpiMoeUp, pg8::MoeOrder, true, true, true>(F.lds + RING_OFF, g, S, E);
        GRID_BAR();
    }
    if (IN(7)) REP(7) {
        const int NT = *(LAS const int*)(F.lds + LT_NT);
        pg8::Gemm g{(const pg8::bf16_t*)(ws + WS_H), (const pg8::bf16_t*)(ws + WS_WT_DN), DM / 2, (size_t)DM * DM};
        pg8::MoeOrder S; S.init(NT, 4, F.G, (int)blockIdx.x, (LAS const int*)(F.lds + LT_TILE_E));
        pg8::EpiMoeDown E{(unsigned char*)(ws + WS_YS), args.b_dn};
        pg8::gemm_phase<pg8::EpiMoeDown, pg8::MoeOrder, true, true, true>(F.lds + RING_OFF, g, S, E);
        GRID_BAR();
    }
    if (IN(8)) { if (DUP_PHASE == 8) { combine_phase(F, args, true); GRID_BAR(); } combine_phase(F, args); GRID_BAR(); }
    if (IN(9)) {
        pg8::Gemm g{(const pg8::bf16_t*)(ws + WS_XN), (const pg8::bf16_t*)(ws + WS_WT_PG), DM / 2, 0};
        pg8::StaticOrder S; S.init(T / 256, DM / 256, F.G, (int)blockIdx.x);
        if (DUP_PHASE == 9) { pg8::EpiPle E0{args.out, (const pg8::bf16_t*)(ws + WS_PJ), (float*)(ws + WS_XS)}; pg8::gemm_phase<pg8::EpiPle, pg8::StaticOrder, true, true, true>(F.lds + RING_OFF, g, S, E0); }
        pg8::EpiPle E{args.out, (const pg8::bf16_t*)(ws + WS_PJ), args.out};
        pg8::gemm_phase<pg8::EpiPle, pg8::StaticOrder, true, true, true>(F.lds + RING_OFF, g, S, E);
    }
#undef IN
}
extern "C" void kernel_launch(void* const* d_in, const int* in_sizes, int n_in, void* d_out, int out_size, void* d_ws, size_t ws_size, hipStream_t stream) {
    static int grid = 0;
    if (grid == 0) {
        if (n_in != 22 || ws_size < 1024 * MiB) { fprintf(stderr, "kernel_launch: unexpected n_in %d / ws %zu\n", n_in, ws_size); grid = -1; return; }
        int dev = 0, cus = 0, per_cu = 0;
        if (hipGetDevice(&dev) != hipSuccess || hipDeviceGetAttribute(&cus, hipDeviceAttributeMultiprocessorCount, dev) != hipSuccess) { grid = -1; return; }
        if (hipFuncSetAttribute((const void*)mega_fwd, hipFuncAttributeMaxDynamicSharedMemorySize, LDS_BYTES) != hipSuccess) { fprintf(stderr, "kernel_launch: hipFuncSetAttribute failed\n"); grid = -1; return; }
        if (hipOccupancyMaxActiveBlocksPerMultiprocessor(&per_cu, (const void*)mega_fwd, NWAVES * 64, LDS_BYTES) != hipSuccess || per_cu < 1) { fprintf(stderr, "kernel_launch: occupancy query says %d\n", per_cu); per_cu = 1; }
        (void)hipGetLastError();
        grid = cus;
    }
    if (grid < 0) return;
    (void)hipMemsetAsync((char*)d_ws + WS_CTL, 0, CTL_ZERO_BYTES, stream);
    Args a{};
    a.x = (const float*)d_in[0]; a.p = (const float*)d_in[1]; a.positions = (const int*)d_in[2]; a.g_mix = (const float*)d_in[3]; a.w_in = (const float*)d_in[4];
    a.sbq = (const float*)d_in[5]; a.sbk = (const float*)d_in[6]; a.rq = (const float*)d_in[7]; a.rk = (const float*)d_in[8]; a.gn_g = (const float*)d_in[9]; a.gn_b = (const float*)d_in[10];
    a.w_out = (const float*)d_in[11]; a.g_ffn = (const float*)d_in[12]; a.w_r = (const float*)d_in[13]; a.b_r = (const float*)d_in[14]; a.w_ug = (const float*)d_in[15]; a.b_ug = (const float*)d_in[16];
    a.w_dn = (const float*)d_in[17]; a.b_dn = (const float*)d_in[18]; a.g_ple = (const float*)d_in[19]; a.w_pg = (const float*)d_in[20]; a.w_pp = (const float*)d_in[21];
    a.out = (float*)d_out; a.ws = (unsigned char*)d_ws; a.ph_lo = 0; a.ph_hi = 10;
    hipLaunchKernelGGL(mega_fwd, dim3(grid), dim3(NWAVES * 64), LDS_BYTES, stream, a);

}
```

```cpp
#include <hip/hip_runtime.h>
#include <cstdint>
#include <cstdio>
#include <cmath>

namespace pg8 {
#define PG8_LAS __attribute__((address_space(3)))
typedef unsigned short bf16_t;
typedef short bf16x8 __attribute__((ext_vector_type(8)));
typedef float f32x4 __attribute__((ext_vector_type(4)));
typedef unsigned u32x4 __attribute__((ext_vector_type(4)));
typedef unsigned u32x2 __attribute__((ext_vector_type(2)));
typedef int v4i32 __attribute__((ext_vector_type(4)));
typedef int v8i32 __attribute__((ext_vector_type(8)));
constexpr int BM = 256, BK = 64, HALF = 128, HTB = HALF * BK * 2  , STAGE_BYTES = 8 * HTB, NXCD = 8, WGM = 8;

__host__ __device__ __forceinline__ int lds_byte(int r, int c) { const int st = (r >> 4) * 2 + (c >> 5), rr = r & 15, cc = c & 31, ob = rr * 64 + cc * 2; return st * 1024 + (ob ^ (((ob >> 9) & 1) << 5)); }
__host__ __device__ __forceinline__ void stage_rc(int b, int& R, int& C) { const int st = b / 1024, sb = b % 1024, swz = sb ^ (((sb >> 9) & 1) << 5); R = (st >> 1) * 16 + swz / 64; C = (st & 1) * 32 + (swz % 64) / 2; }
__host__ __device__ __forceinline__ int perm32(int rho) { const int n = rho >> 4, i = rho & 15; return 8 * (i >> 2) + 4 * n + (i & 3); }

struct Unit { int pm, pn, e; };
struct Gemm { const bf16_t* A; const bf16_t* Bt; int K; size_t strideBe; };

struct StaticOrder {
    int nM, nN, nwg, G, c;
    __host__ __device__ void init(int nM_, int nN_, int G_, int c_) { nM = nM_; nN = nN_; nwg = nM * nN; G = G_; c = c_; }
    __host__ __device__ bool next(int i, Unit& u) const {
        const long L = (long)i * G + c; if (L >= nwg) return false;
        int wgid = (int)L; { const int q = nwg / NXCD, r = nwg % NXCD, xcd = wgid % NXCD, off = wgid / NXCD; wgid = (xcd < r ? xcd * (q + 1) : r * (q + 1) + (xcd - r) * q) + off; }
        const int nig = WGM * nN, gid = wgid / nig, fm = gid * WGM, gsz = (nM - fm) < WGM ? (nM - fm) : WGM;
        u.pm = fm + ((wgid % nig) % gsz); u.pn = (wgid % nig) / gsz; u.e = 0; return true;
    }
    __device__ __forceinline__ void a_ready(const Unit&) const {}
    __device__ __forceinline__ void done(const Unit&) const {}
};

typedef float f32x2_t __attribute__((ext_vector_type(2))); typedef __bf16 bf16x2_t __attribute__((ext_vector_type(2)));
__device__ __forceinline__ unsigned cvt_pk_bf16(float lo, float hi) { f32x2_t v = {lo, hi}; bf16x2_t b = __builtin_convertvector(v, bf16x2_t); return __builtin_bit_cast(unsigned, b); }

constexpr int T = 16384, SEQ = 2048, DM = 1024, DIN = 3584;
constexpr float EPS = 1e-6f;
__device__ __forceinline__ u32x4 pack8(const f32x4 a, const f32x4 b) { u32x4 w; w.x = cvt_pk_bf16(a[0], a[1]); w.y = cvt_pk_bf16(a[2], a[3]); w.z = cvt_pk_bf16(b[0], b[1]); w.w = cvt_pk_bf16(b[2], b[3]); return w; }

struct EpiProj {
    static constexpr bool PERM = true, AFTER_DRAIN = false;
    bf16_t* hm;
    bf16_t* rg;
    const float* gains;
    const float *ropec, *ropes;
    __device__ __forceinline__ void operator()(const f32x4 (&acc)[2][2][4][2], const Unit& u, int wr, int wc, int fr, int fq) const {
        const int region = u.pn >> 1, hb = 4 * (u.pn & 1) + wc;
        const bool normed = (region == 0) || (region == 1) || (region == 3) || (region == 4);
        const bool rope = (region == 3) || (region == 4);
        const int gidx = region == 0 ? 0 : region == 1 ? 1 : region == 3 ? 2 : 3;
        const float* gp = gains + gidx * 64;
        f32x4 gv[2][2];
#pragma unroll
        for (int bj = 0; bj < 2; ++bj)
#pragma unroll
            for (int n = 0; n < 2; ++n) gv[bj][n] = normed ? *(const f32x4*)(gp + 32 * bj + 8 * fq + 4 * n) : (f32x4){1.f, 1.f, 1.f, 1.f};
        const float lg2g = __log2f(1.0f - __builtin_amdgcn_exp2f(-5.0f - (float)hb));
        const float scale = region == 0 ? 0.125f * 1.4426950408889634f : region == 4 ? 0.125f : 1.0f;
#pragma unroll
        for (int ai = 0; ai < 2; ++ai)
#pragma unroll
            for (int m = 0; m < 4; ++m) {
                const int row = u.pm * BM + ai * HALF + wr * 64 + m * 16 + fr;
                const int b = row >> 11, s = row & (SEQ - 1);
                f32x4 v[2][2];
#pragma unroll
                for (int bj = 0; bj < 2; ++bj)
#pragma unroll
                    for (int n = 0; n < 2; ++n) v[bj][n] = acc[ai][bj][m][n];
                if (normed) {
                    float ss = 0.f;
#pragma unroll
                    for (int bj = 0; bj < 2; ++bj)
#pragma unroll
                        for (int n = 0; n < 2; ++n) { const f32x4 x = v[bj][n]; ss += (x[0] * x[0] + x[1] * x[1]) + (x[2] * x[2] + x[3] * x[3]); }
                    ss += __shfl_xor(ss, 16); ss += __shfl_xor(ss, 32);
                    float rs = rsqrtf(ss * (1.0f / 64.0f) + EPS) * scale;
                    if (rope) rs *= (region == 3) ? __builtin_amdgcn_exp2f((float)(s & 31) * lg2g) : __builtin_amdgcn_exp2f(-(float)(s & 63) * lg2g);
#pragma unroll
                    for (int bj = 0; bj < 2; ++bj)
#pragma unroll
                        for (int n = 0; n < 2; ++n) v[bj][n] = v[bj][n] * rs * gv[bj][n];
                    if (rope) {
#pragma unroll
                        for (int n = 0; n < 2; ++n) {
                            const f32x4 c = *(const f32x4*)(ropec + (size_t)row * 32 + 8 * fq + 4 * n), sn = *(const f32x4*)(ropes + (size_t)row * 32 + 8 * fq + 4 * n);
                            const f32x4 lo = v[0][n], hi = v[1][n];
                            v[0][n] = lo * c - hi * sn; v[1][n] = hi * c + lo * sn;
                        }
                    }
                }
                bf16_t* dst = (region < 6) ? hm + (size_t)region * ((size_t)T * 512) + ((size_t)(b * 8 + hb) * SEQ + s) * 64 + 8 * fq
                                           : rg + (size_t)row * 512 + hb * 64 + 8 * fq;
#pragma unroll
                for (int bj = 0; bj < 2; ++bj) *(u32x4*)(dst + 32 * bj) = pack8(v[bj][0], v[bj][1]);
            }
    }
};

struct EpiBf16Plain {
    static constexpr bool PERM = true, AFTER_DRAIN = false;
    bf16_t* O; int ldc;
    __device__ __forceinline__ void operator()(const f32x4 (&acc)[2][2][4][2], const Unit& u, int wr, int wc, int fr, int fq) const {
        const int row0 = u.pm * BM + wr * 64 + fr, col0 = u.pn * BM + wc * 32 + 8 * fq;
#pragma unroll
        for (int ai = 0; ai < 2; ++ai)
#pragma unroll
            for (int m = 0; m < 4; ++m) { bf16_t* rowp = O + (size_t)(row0 + ai * HALF + m * 16) * ldc + col0;
#pragma unroll
                for (int bj = 0; bj < 2; ++bj) *(u32x4*)(rowp + bj * HALF) = pack8(acc[ai][bj][m][0], acc[ai][bj][m][1]); }
    }
};
struct EpiResid {
    static constexpr bool PERM = false, AFTER_DRAIN = false;
    const float* base; float* out;
    __device__ __forceinline__ void operator()(const f32x4 (&acc)[2][2][4][2], const Unit& u, int wr, int wc, int fr, int fq) const {
        const int col0 = u.pn * BM + wc * 32 + 4 * fq;
#pragma unroll
        for (int ai = 0; ai < 2; ++ai)
#pragma unroll
            for (int m = 0; m < 4; ++m) { const size_t off = (size_t)(u.pm * BM + ai * HALF + wr * 64 + m * 16 + fr) * DM + col0;
#pragma unroll
                for (int bj = 0; bj < 2; ++bj)
#pragma unroll
                    for (int n = 0; n < 2; ++n) { const f32x4 bs = __builtin_nontemporal_load((const f32x4*)(base + off + bj * HALF + n * 16)); *(f32x4*)(out + off + bj * HALF + n * 16) = bs + acc[ai][bj][m][n]; } }
    }
};
struct EpiMoeUp {
    static constexpr bool PERM = true, AFTER_DRAIN = false;
    unsigned char* H; const float* bias; const float* srstd;
    __device__ __forceinline__ void operator()(const f32x4 (&acc)[2][2][4][2], const Unit& u, int wr, int wc, int fr, int fq) const {
        const int cc = 128 * u.pn + 32 * wc + 8 * fq;
        const float* bp = bias + (size_t)u.e * 2048 + cc;
        f32x4 bg[2], bl[2];
#pragma unroll
        for (int n = 0; n < 2; ++n) { bg[n] = *(const f32x4*)(bp + 4 * n); bl[n] = *(const f32x4*)(bp + 1024 + 4 * n); }
#pragma unroll
        for (int ai = 0; ai < 2; ++ai)
#pragma unroll
            for (int m = 0; m < 4; ++m) {
                f32x4 hv[2]; const float sc = srstd[u.pm * BM + ai * HALF + wr * 64 + m * 16 + fr] * 0.015625f;
#pragma unroll
                for (int n = 0; n < 2; ++n) {
                    const f32x4 g0 = acc[ai][0][m][n] * sc + bg[n], l0 = acc[ai][1][m][n] * sc + bl[n];
#pragma unroll
                    for (int j = 0; j < 4; ++j) {
                        const float glu = __builtin_fminf(g0[j], 7.0f), lin = __builtin_fminf(__builtin_fmaxf(l0[j], -7.0f), 7.0f);
                        const float sg = __builtin_amdgcn_rcpf(1.0f + __builtin_amdgcn_exp2f(-1.702f * 1.4426950408889634f * glu));
                        hv[n][j] = glu * sg * (lin + 1.0f);
                    }
                }
                u32x2 hq; hq.x = (unsigned)__builtin_amdgcn_cvt_pk_fp8_f32(hv[0][0], hv[0][1], 0, false); hq.x = (unsigned)__builtin_amdgcn_cvt_pk_fp8_f32(hv[0][2], hv[0][3], (int)hq.x, true);
                hq.y = (unsigned)__builtin_amdgcn_cvt_pk_fp8_f32(hv[1][0], hv[1][1], 0, false); hq.y = (unsigned)__builtin_amdgcn_cvt_pk_fp8_f32(hv[1][2], hv[1][3], (int)hq.y, true);
                *(u32x2*)(H + (size_t)(u.pm * BM + ai * HALF + wr * 64 + m * 16 + fr) * 1024 + cc) = hq;
            }
    }
};
struct EpiMoeDown {
    static constexpr bool PERM = true, AFTER_DRAIN = false;
    unsigned char* YS; const float* bias;
    __device__ __forceinline__ void operator()(const f32x4 (&acc)[2][2][4][2], const Unit& u, int wr, int wc, int fr, int fq) const {
        const int col0 = u.pn * BM + wc * 32 + 8 * fq;
        f32x4 bv[2][2];
#pragma unroll
        for (int bj = 0; bj < 2; ++bj)
#pragma unroll
            for (int n = 0; n < 2; ++n) bv[bj][n] = *(const f32x4*)(bias + (size_t)u.e * 1024 + col0 + bj * HALF + 4 * n);
#pragma unroll
        for (int ai = 0; ai < 2; ++ai)
#pragma unroll
            for (int m = 0; m < 4; ++m) { unsigned char* rowp = YS + (size_t)(u.pm * BM + ai * HALF + wr * 64 + m * 16 + fr) * 1024 + col0;
#pragma unroll
                for (int bj = 0; bj < 2; ++bj) { const f32x4 y0 = acc[ai][bj][m][0] * 0.015625f + bv[bj][0], y1 = acc[ai][bj][m][1] * 0.015625f + bv[bj][1];
                    u32x2 q; q.x = (unsigned)__builtin_amdgcn_cvt_pk_fp8_f32(y0[0], y0[1], 0, false); q.x = (unsigned)__builtin_amdgcn_cvt_pk_fp8_f32(y0[2], y0[3], (int)q.x, true);
                    q.y = (unsigned)__builtin_amdgcn_cvt_pk_fp8_f32(y1[0], y1[1], 0, false); q.y = (unsigned)__builtin_amdgcn_cvt_pk_fp8_f32(y1[2], y1[3], (int)q.y, true);
                    *(u32x2*)(rowp + bj * HALF) = q; } }
    }
};
struct EpiPle {
    static constexpr bool PERM = false, AFTER_DRAIN = false;
    const bf16_t* X2; const bf16_t* PJ; float* outw;
    __device__ __forceinline__ void operator()(const f32x4 (&acc)[2][2][4][2], const Unit& u, int wr, int wc, int fr, int fq) const {
        const int col0 = u.pn * BM + wc * 32 + 4 * fq;
#pragma unroll
        for (int ai = 0; ai < 2; ++ai)
#pragma unroll
            for (int m = 0; m < 4; ++m) { const size_t off = (size_t)(u.pm * BM + ai * HALF + wr * 64 + m * 16 + fr) * DM + col0;
#pragma unroll
                for (int bj = 0; bj < 2; ++bj)
#pragma unroll
                    for (int n = 0; n < 2; ++n) {
                        const size_t o2 = off + bj * HALF + n * 16;
                        const u32x2 xq = __builtin_nontemporal_load((const u32x2*)(X2 + o2)); const f32x4 x2 = (f32x4){__uint_as_float(xq.x << 16), __uint_as_float(xq.x & 0xffff0000u), __uint_as_float(xq.y << 16), __uint_as_float(xq.y & 0xffff0000u)}; const u32x2 pj = __builtin_nontemporal_load((const u32x2*)(PJ + o2)); const f32x4 a = acc[ai][bj][m][n] * 0.015625f;
                        f32x4 r;
                        r[0] = x2[0] + __uint_as_float(pj.x << 16) * __builtin_amdgcn_rcpf(1.0f + __builtin_amdgcn_exp2f(-1.4426950408889634f * a[0]));
                        r[1] = x2[1] + __uint_as_float(pj.x & 0xffff0000u) * __builtin_amdgcn_rcpf(1.0f + __builtin_amdgcn_exp2f(-1.4426950408889634f * a[1]));
                        r[2] = x2[2] + __uint_as_float(pj.y << 16) * __builtin_amdgcn_rcpf(1.0f + __builtin_amdgcn_exp2f(-1.4426950408889634f * a[2]));
                        r[3] = x2[3] + __uint_as_float(pj.y & 0xffff0000u) * __builtin_amdgcn_rcpf(1.0f + __builtin_amdgcn_exp2f(-1.4426950408889634f * a[3]));
                        __builtin_nontemporal_store(r, (f32x4*)(outw + o2));
                    } }
    }
};
struct MoeOrder {
    int nM, nN, nwg, G, c; const PG8_LAS int* tile_e;
    __device__ void init(int nM_, int nN_, int G_, int c_, const PG8_LAS int* te) { nM = nM_; nN = nN_; nwg = nM * nN; G = G_; c = c_; tile_e = te; }
    __device__ bool next(int i, Unit& u) const {
        const long L = (long)i * G + c; if (L >= nwg) return false;
        int wgid = (int)L; { const int q = nwg / NXCD, r = nwg % NXCD, xcd = wgid % NXCD, off = wgid / NXCD; wgid = (xcd < r ? xcd * (q + 1) : r * (q + 1) + (xcd - r) * q) + off; }
        const int nig = WGM * nN, gid = wgid / nig, fm = gid * WGM, gsz = (nM - fm) < WGM ? (nM - fm) : WGM;
        u.pm = fm + ((wgid % nig) % gsz); u.pn = (wgid % nig) / gsz; u.e = __builtin_amdgcn_readfirstlane(tile_e[u.pm]); return true;
    }
    __device__ __forceinline__ void a_ready(const Unit&) const {}
    __device__ __forceinline__ void done(const Unit&) const {}
};
template <class Epi, class Sched, bool ALIGN_EPI = false, bool SP2 = false, bool F8 = false>
__device__ __forceinline__ void gemm_phase(PG8_LAS unsigned char* lds, const Gemm g, const Sched& S, const Epi& E) {
    int tid_ = threadIdx.x; asm volatile("" : "+v"(tid_));
    const int tid = tid_, wid = __builtin_amdgcn_readfirstlane(tid >> 6), lane = tid & 63, wr = wid >> 2, wc = wid & 3, fr = lane & 15, fq = lane >> 4;
    const int K = g.K, nt = K / BK;
    unsigned voffA[2], voffB[2];
#pragma unroll
    for (int i = 0; i < 2; ++i) { int R, C; stage_rc(tid * 16 + i * 8192, R, C); const int Rb = Epi::PERM ? ((R & ~31) + perm32(R & 31)) : R;
        voffA[i] = (unsigned)(R * K + C) * 2u; voffB[i] = (unsigned)(Rb * K + C) * 2u; }
    const size_t kstep = (size_t)(BK * 2);
    const size_t hstep = (size_t)HALF * K * 2;
    const size_t tstep = 2 * hstep;
    const unsigned ldsw = (unsigned)wid * 1024u;
    const int aoff = lds_byte(wr * 64 + fr, fq * 8), boff = lds_byte(wc * 32 + fr, fq * 8);
#define PG8_SA(b, h) (((b) * 2 + (h)) * HTB)
#define PG8_SB(b, h) ((4 + (b) * 2 + (h)) * HTB)
#define PG8_STAGE(bufoff, gbase, voff) do { _Pragma("unroll") for (int _i = 0; _i < 2; ++_i) \
        __builtin_amdgcn_global_load_lds((const unsigned*)((const char*)(gbase) + (voff)[_i]), (PG8_LAS unsigned*)(lds + (bufoff) + ldsw + _i * 8192), 16, 0, 0); } while (0)
#define PG8_LD16(off) (*(const PG8_LAS v4i32*)(lds + (off)))
#define PG8_LDA(dst, b, h) do { if constexpr (F8) { _Pragma("unroll") for (int m = 0; m < 4; ++m) dst##8[m] = __builtin_shufflevector(PG8_LD16(PG8_SA(b, h) + aoff + m * 2048), PG8_LD16(PG8_SA(b, h) + aoff + m * 2048 + 1024), 0, 1, 2, 3, 4, 5, 6, 7); } \
        else { _Pragma("unroll") for (int m = 0; m < 4; ++m) _Pragma("unroll") for (int k = 0; k < 2; ++k) dst[m][k] = *(const PG8_LAS bf16x8*)(lds + PG8_SA(b, h) + aoff + m * 2048 + k * 1024); } } while (0)
#define PG8_LDB(dst, b, h) do { if constexpr (F8) { _Pragma("unroll") for (int n = 0; n < 2; ++n) dst##8[n] = __builtin_shufflevector(PG8_LD16(PG8_SB(b, h) + boff + n * 2048), PG8_LD16(PG8_SB(b, h) + boff + n * 2048 + 1024), 0, 1, 2, 3, 4, 5, 6, 7); } \
        else { _Pragma("unroll") for (int n = 0; n < 2; ++n) _Pragma("unroll") for (int k = 0; k < 2; ++k) dst[n][k] = *(const PG8_LAS bf16x8*)(lds + PG8_SB(b, h) + boff + n * 2048 + k * 1024); } } while (0)
#define PG8_MMA(ai, bj, At, Bt) do { __builtin_amdgcn_s_setprio(1); \
        if constexpr (F8) { _Pragma("unroll") for (int m = 0; m < 4; ++m) _Pragma("unroll") for (int n = 0; n < 2; ++n) \
            asm volatile("v_mfma_scale_f32_16x16x128_f8f6f4 %0, %1, %2, %0, %3, %3 op_sel_hi:[0,0,0]" : "+v"(acc[ai][bj][m][n]) : "v"(Bt##8[n]), "v"(At##8[m]), "v"(f8scale)); } \
        else { _Pragma("unroll") for (int m = 0; m < 4; ++m) _Pragma("unroll") for (int n = 0; n < 2; ++n) _Pragma("unroll") for (int k = 0; k < 2; ++k) \
            acc[ai][bj][m][n] = __builtin_amdgcn_mfma_f32_16x16x32_bf16(Bt[n][k], At[m][k], acc[ai][bj][m][n], 0, 0, 0); } \
        __builtin_amdgcn_s_setprio(0); } while (0)
#define PG8_WAIT_V(n) asm volatile("s_waitcnt vmcnt(" #n ")" ::: "memory")
#define PG8_WAIT_L(n) asm volatile("s_waitcnt lgkmcnt(" #n ")" ::: "memory")
#define PG8_BAR __builtin_amdgcn_s_barrier()
#define PG8_SCHED __builtin_amdgcn_sched_barrier(0)
    Unit cur, nxt; int ui = 0;
    if (!S.next(0, cur)) return;
    f32x4 acc[2][2][4][2];
#pragma unroll
    for (int a = 0; a < 2; ++a)
#pragma unroll
        for (int b = 0; b < 2; ++b)
#pragma unroll
            for (int m = 0; m < 4; ++m)
#pragma unroll
                for (int n = 0; n < 2; ++n) acc[a][b][m][n] = (f32x4){0.f, 0.f, 0.f, 0.f};
    bf16x8 At[4][2], B0[2][2], B1[2][2];
    v8i32 At8[4], B08[2], B18[2]; const int f8scale = 0x7f7f7f7f;
    const char* cA = (const char*)g.A + (size_t)cur.pm * tstep; const char* cB = (const char*)g.Bt + (size_t)cur.e * g.strideBe + (size_t)cur.pn * tstep;
    S.a_ready(cur);
    if constexpr (SP2) {
        PG8_STAGE(PG8_SB(0, 0), cB, voffB); PG8_STAGE(PG8_SB(0, 1), cB + hstep, voffB); PG8_STAGE(PG8_SA(0, 0), cA, voffA); PG8_STAGE(PG8_SA(0, 1), cA + hstep, voffA);
        if (wr == 1) PG8_BAR;
        PG8_WAIT_V(2); PG8_BAR;
        PG8_STAGE(PG8_SB(1, 0), cB + kstep, voffB); PG8_STAGE(PG8_SA(1, 0), cA + kstep, voffA); PG8_STAGE(PG8_SB(1, 1), cB + hstep + kstep, voffB);
        PG8_WAIT_V(6); PG8_BAR;
    } else {
        PG8_STAGE(PG8_SB(0, 0), cB, voffB); PG8_STAGE(PG8_SA(0, 0), cA, voffA); PG8_STAGE(PG8_SB(0, 1), cB + hstep, voffB); PG8_STAGE(PG8_SA(0, 1), cA + hstep, voffA);
        if (wr == 1) PG8_BAR;
        PG8_WAIT_V(4); PG8_BAR;
        PG8_STAGE(PG8_SB(1, 0), cB + kstep, voffB); PG8_STAGE(PG8_SA(1, 0), cA + kstep, voffA); PG8_STAGE(PG8_SB(1, 1), cB + hstep + kstep, voffB);
        PG8_WAIT_V(6); PG8_BAR;
    }
    for (;;) {
        const bool has_next = S.next(ui + 1, nxt);
        const char* nA = has_next ? (const char*)g.A + (size_t)nxt.pm * tstep : cA; const char* nB = has_next ? (const char*)g.Bt + (size_t)nxt.e * g.strideBe + (size_t)nxt.pn * tstep : cB;
#pragma unroll 1
        for (int t = 0; t < nt; t += 2) {
            const bool last = (t == nt - 2);
            const char* a1 = cA + (size_t)(t + 1) * kstep;
            const char* a2 = last ? nA : cA + (size_t)(t + 2) * kstep; const char* b2 = last ? nB : cB + (size_t)(t + 2) * kstep;
            const char* a3 = a2 + kstep; const char* b3 = b2 + kstep;
            if (last && has_next) S.a_ready(nxt);
            if constexpr (SP2) {
            PG8_LDB(B0, 0, 0); PG8_LDB(B1, 0, 1); PG8_SCHED; PG8_LDA(At, 0, 0); PG8_STAGE(PG8_SA(1, 1), a1 + hstep, voffA);
            PG8_WAIT_V(8); PG8_WAIT_L(0); PG8_BAR; PG8_MMA(0, 0, At, B0); PG8_MMA(0, 1, At, B1); PG8_BAR; PG8_SCHED;
            PG8_LDA(At, 0, 1); PG8_STAGE(PG8_SB(0, 0), b2, voffB); PG8_STAGE(PG8_SB(0, 1), b2 + hstep, voffB); PG8_STAGE(PG8_SA(0, 0), a2, voffA);
            PG8_WAIT_V(8); PG8_WAIT_L(0); PG8_BAR; PG8_MMA(1, 0, At, B0); PG8_MMA(1, 1, At, B1); PG8_BAR; PG8_SCHED;
            PG8_LDB(B0, 1, 0); PG8_LDB(B1, 1, 1); PG8_SCHED; PG8_LDA(At, 1, 0); PG8_STAGE(PG8_SA(0, 1), a2 + hstep, voffA);
            PG8_WAIT_V(8); PG8_WAIT_L(0); PG8_BAR; PG8_MMA(0, 0, At, B0); PG8_MMA(0, 1, At, B1); PG8_BAR; PG8_SCHED;
            PG8_LDA(At, 1, 1); PG8_STAGE(PG8_SB(1, 0), b3, voffB); PG8_STAGE(PG8_SB(1, 1), b3 + hstep, voffB); PG8_STAGE(PG8_SA(1, 0), a3, voffA);
            PG8_WAIT_V(8); PG8_WAIT_L(0); PG8_BAR; PG8_MMA(1, 0, At, B0); PG8_MMA(1, 1, At, B1); PG8_BAR; PG8_SCHED;
            } else {
            PG8_LDB(B0, 0, 0); PG8_SCHED; PG8_LDA(At, 0, 0); PG8_STAGE(PG8_SA(1, 1), a1 + hstep, voffA);
            PG8_WAIT_L(8); PG8_BAR; PG8_WAIT_L(0); PG8_MMA(0, 0, At, B0); PG8_BAR; PG8_SCHED;
            PG8_LDB(B1, 0, 1); PG8_STAGE(PG8_SB(0, 0), b2, voffB);
            PG8_BAR; PG8_WAIT_L(0); PG8_MMA(0, 1, At, B1); PG8_BAR;
            PG8_LDA(At, 0, 1); PG8_STAGE(PG8_SA(0, 0), a2, voffA);
            PG8_BAR; PG8_WAIT_L(0); PG8_MMA(1, 0, At, B0); PG8_BAR; PG8_SCHED;
            PG8_STAGE(PG8_SB(0, 1), b2 + hstep, voffB);
            PG8_WAIT_V(6); PG8_BAR; PG8_MMA(1, 1, At, B1); PG8_BAR;
            PG8_LDB(B0, 1, 0); PG8_SCHED; PG8_LDA(At, 1, 0); PG8_STAGE(PG8_SA(0, 1), a2 + hstep, voffA);
            PG8_WAIT_L(8); PG8_BAR; PG8_WAIT_L(0); PG8_MMA(0, 0, At, B0); PG8_BAR; PG8_SCHED;
            PG8_LDB(B1, 1, 1); PG8_STAGE(PG8_SB(1, 0), b3, voffB);
            PG8_BAR; PG8_WAIT_L(0); PG8_MMA(0, 1, At, B1); PG8_BAR;
            PG8_LDA(At, 1, 1); PG8_STAGE(PG8_SA(1, 0), a3, voffA);
            PG8_BAR; PG8_WAIT_L(0); PG8_MMA(1, 0, At, B0); PG8_BAR; PG8_SCHED;
            PG8_STAGE(PG8_SB(1, 1), b3 + hstep, voffB);
            PG8_WAIT_V(6); PG8_BAR; PG8_MMA(1, 1, At, B1); PG8_BAR;
            }
        }
        if constexpr (ALIGN_EPI) { if (wr == 0) PG8_BAR; }
        if constexpr (F8) asm volatile("s_nop 15\n\ts_nop 15\n\ts_nop 15" ::: "memory");
        if constexpr (!Epi::AFTER_DRAIN) { E(acc, cur, wr, wc, fr, fq); S.done(cur); }
        if (!has_next) break;
#pragma unroll
        for (int a = 0; a < 2; ++a)
#pragma unroll
            for (int b = 0; b < 2; ++b)
#pragma unroll
                for (int m = 0; m < 4; ++m)
#pragma unroll
                    for (int n = 0; n < 2; ++n) acc[a][b][m][n] = (f32x4){0.f, 0.f, 0.f, 0.f};
        cur = nxt; cA = nA; cB = nB; ++ui;
        if constexpr (ALIGN_EPI) { if (wr == 1) PG8_BAR; }
    }
    PG8_WAIT_V(0);
    if constexpr (!ALIGN_EPI) { if (wr == 0) PG8_BAR; }
    PG8_BAR;
    if constexpr (Epi::AFTER_DRAIN) { E.fused(acc, cur, wr, wc, fr, fq, lds, wid, lane); S.done(cur); }
#undef PG8_SA
#undef PG8_SB
#undef PG8_STAGE
#undef PG8_LD16
#undef PG8_LDA
#undef PG8_LDB
#undef PG8_MMA
#undef PG8_WAIT_V
#undef PG8_WAIT_L
#undef PG8_BAR
#undef PG8_SCHED
}
}

constexpr int NWAVES = 8;
constexpr int T = pg8::T, SEQ = pg8::SEQ, DM = pg8::DM, DIN = pg8::DIN, NE = 32, PLE = 256;
constexpr float EPS = pg8::EPS;
constexpr size_t MiB = 1u << 20;
constexpr size_t WS_CTL = 0, CTL_ZERO_BYTES = 1 * MiB;
constexpr size_t WS_WT_IN = 2 * MiB, WS_WT_OUT = 9 * MiB, WS_WT_PG = 11 * MiB, WS_WT_PP = 13 * MiB;
constexpr size_t WS_GAINS = 13 * MiB + 512 * 1024;
constexpr size_t WS_WRT = 13 * MiB + 576 * 1024;
constexpr size_t WS_ROPEC = 14 * MiB, WS_ROPES = 16 * MiB, WS_PB = 18 * MiB, WS_ROUTE = 26 * MiB;
constexpr size_t WS_WT_UG = 32 * MiB, WS_WT_DN = 160 * MiB;
constexpr size_t WS_XN = 224 * MiB;
constexpr size_t WS_HM = 256 * MiB;
constexpr size_t WS_RG = 352 * MiB;
constexpr size_t WS_Y = 368 * MiB;
constexpr size_t WS_PJ = 400 * MiB;
constexpr size_t WS_XS = 432 * MiB, WS_H = 576 * MiB, WS_YS = 720 * MiB;
constexpr size_t WS_END = 864 * MiB;
constexpr int CW_TMO = 0, CW_CODE = 1;
constexpr int CW_BAR = 4096;
constexpr int RING_OFF = 0, RING_BYTES = 131072;
constexpr int LDSCTL_OFF = RING_BYTES, MISC_OFF = LDSCTL_OFF + 320;
constexpr int LDS_BYTES = 147456;
#define GAS __attribute__((address_space(1)))
#define LAS __attribute__((address_space(3)))
typedef unsigned short bf16;
typedef unsigned v4u __attribute__((ext_vector_type(4)));
typedef float f32x4 __attribute__((ext_vector_type(4)));
typedef short bf16x8 __attribute__((ext_vector_type(8)));
typedef unsigned u32x4_t __attribute__((ext_vector_type(4)));
typedef unsigned u32x2_t __attribute__((ext_vector_type(2)));
typedef GAS unsigned gu32;
typedef GAS unsigned long long gu64;
#define RLX_AGENT __ATOMIC_RELAXED, __HIP_MEMORY_SCOPE_AGENT
#define LDS_WAIT() asm volatile("s_waitcnt lgkmcnt(0)" ::: "memory")
#define VM_WAIT() asm volatile("s_waitcnt vmcnt(0)" ::: "memory")
__device__ __forceinline__ unsigned long long rt() { return __builtin_amdgcn_s_memrealtime(); }
__device__ __forceinline__ unsigned f2bf(float f) { unsigned u = __builtin_bit_cast(unsigned, f); return (u + 0x7fffu + ((u >> 16) & 1u)) >> 16; }
__device__ __forceinline__ unsigned pk2(float lo, float hi) { return f2bf(lo) | (f2bf(hi) << 16); }

#define XB_TMO      128
#define XB_XCNT(j)  (256  + 64 * (j))
#define XB_XSUB(j)  (1280 + 64 * (j))
#define XB_XGEN(j)  (2304 + 64 * (j))
#define XB_TOP      3328
#define XB_TOPGEN   3392
#define XCD_BAR_WORDS 3456
#define XB_SPIN_CAP (1u << 18)

__device__ __forceinline__ unsigned xb_ld(unsigned* p)              { return __hip_atomic_load(p, __ATOMIC_RELAXED, __HIP_MEMORY_SCOPE_AGENT); }
__device__ __forceinline__ unsigned xb_add(unsigned* p, unsigned v) { return __hip_atomic_fetch_add(p, v, __ATOMIC_RELAXED, __HIP_MEMORY_SCOPE_AGENT); }
__device__ __forceinline__ unsigned xb_xcc_id() { return (unsigned)__builtin_amdgcn_s_getreg((3 << 11) | 20) & 0xFu; }
#define XB_SPIN(cond, bar) do { unsigned _sp = 0; while (cond) { __builtin_amdgcn_s_sleep(1); \
    if ((++_sp & 255u) == 0u) { if (xb_ld(&(bar)[XB_TMO])) break; if (_sp > XB_SPIN_CAP) { atomicAdd(&(bar)[XB_TMO], 1u); break; } } } } while (0)

struct XcdBarrier {
    unsigned* bar; unsigned x;
    volatile LAS unsigned* st;
};

__device__ __forceinline__ XcdBarrier xcd_barrier_post(unsigned* bar, volatile LAS unsigned* st) {
    XcdBarrier b; b.bar = bar; b.x = xb_xcc_id(); b.st = st;
    if (threadIdx.x == 0) (void)xb_add(&bar[XB_XCNT(b.x)], 1u);
    return b;
}
__device__ __forceinline__ void xcd_barrier_complete(unsigned* bar, unsigned x, unsigned& nloc, unsigned& nx) {
    const unsigned G = gridDim.x * gridDim.y * gridDim.z;
    unsigned sum, cnt, mine, sp = 0u;
    for (;;) {
        sum = 0u; cnt = 0u; mine = 0u;
#pragma unroll
        for (unsigned j = 0; j < 16; ++j) { const unsigned c = xb_ld(&bar[XB_XCNT(j)]); sum += c; cnt += (c > 0u) ? 1u : 0u; mine = (j == x) ? c : mine; }
        if (sum == G) break;
        __builtin_amdgcn_s_sleep(1);
        if ((++sp & 255u) == 0u) { if (xb_ld(&bar[XB_TMO])) break; if (sp > XB_SPIN_CAP) { atomicAdd(&bar[XB_TMO], 1u); break; } }
    }
    nloc = mine > 0u ? mine : 1u; nx = cnt > 0u ? cnt : 1u;
}

__device__ __forceinline__ void xcd_barrier(const XcdBarrier& b) {
    asm volatile("s_waitcnt vmcnt(0)" ::: "memory");
    __syncthreads();
    if (threadIdx.x == 0) {
        unsigned* bar = b.bar;
        __builtin_amdgcn_s_waitcnt(0);
        unsigned nloc = b.st[0], nx = b.st[1];
        if (nloc == 0u) { xcd_barrier_complete(bar, b.x, nloc, nx); b.st[0] = nloc; b.st[1] = nx; }
        const unsigned old = xb_add(&bar[XB_XSUB(b.x)], 1u);
        const unsigned gen = old / nloc;
        const unsigned tgen = gen;
        if (old + 1u == (gen + 1u) * nloc) {
            __builtin_amdgcn_fence(__ATOMIC_RELEASE, "agent");
            asm volatile("s_waitcnt vmcnt(0)" ::: "memory");
            const unsigned og = xb_add(&bar[XB_TOP], 1u);
            const unsigned tg = og / nx;
            if (og + 1u == (tg + 1u) * nx) xb_add(&bar[XB_TOPGEN], 1u);
            else XB_SPIN(xb_ld(&bar[XB_TOPGEN]) == tg, bar);
        } else {
            XB_SPIN(xb_ld(&bar[XB_TOPGEN]) == tgen, bar);
        }
        __builtin_amdgcn_fence(__ATOMIC_ACQUIRE, "agent");
        asm volatile("s_waitcnt vmcnt(0)" ::: "memory");
    }
    __syncthreads();
}

struct Args {
    const float* x; const float* p; const int* positions; const float* g_mix; const float* w_in;
    const float* sbq; const float* sbk; const float* rq; const float* rk; const float* gn_g; const float* gn_b; const float* w_out;
    const float* g_ffn; const float* w_r; const float* b_r; const float* w_ug; const float* b_ug; const float* w_dn; const float* b_dn;
    const float* g_ple; const float* w_pg; const float* w_pp;
    float* out; unsigned char* ws; int ph_lo, ph_hi;
};
struct Frame {
    LAS unsigned char* lds;
    volatile LAS unsigned* MISC;
    gu32* ctl;
    int wave;
    int vcu, G;
};
__device__ __forceinline__ int tid_now() { int t = threadIdx.x; asm volatile("" : "+v"(t)); return t; }
__device__ __forceinline__ float wave_sum(float v) {
#pragma unroll
    for (int o = 1; o < 64; o <<= 1) v += __shfl_xor(v, o);
    return v;
}
__device__ __forceinline__ unsigned cvtpk(float lo, float hi) { return pg8::cvt_pk_bf16(lo, hi); }

enum { MAP_NAT = 0, MAP_IN = 1, MAP_UG = 2 };
__device__ __forceinline__ void p0_item(const float* __restrict__ W, int N, int K, bf16* __restrict__ WT, int kb, int nb, int mapmode, LAS unsigned char* scr, int lane) {
    const int np = 64 * nb + 4 * (lane & 15);
    int src = np;
    if (mapmode == MAP_IN) { const int pn = np >> 8, L = np & 255, bj = L >> 7, wc = (L >> 5) & 3, e = L & 31; src = 256 * pn + 64 * wc + 32 * bj + e; }
    else if (mapmode == MAP_UG) { const int pn = np >> 8, L = np & 255, bj = L >> 7, i = L & 127; src = 1024 * bj + 128 * pn + i; }
    const float* gp = W + (size_t)(64 * kb + (lane >> 4)) * N + src;
    f32x4 v[16];
#pragma unroll
    for (int i = 0; i < 16; ++i) v[i] = *(const f32x4*)(gp + (size_t)(4 * i) * N);
#pragma unroll
    for (int i = 0; i < 16; ++i) {
        LAS unsigned* d = (LAS unsigned*)(scr + (4 * i + (lane >> 4)) * 132 + 8 * (lane & 15));
        d[0] = cvtpk(v[i][0], v[i][1]); d[1] = cvtpk(v[i][2], v[i][3]);
    }
    LDS_WAIT(); asm volatile("" ::: "memory");
    const int c = lane & 7;
#pragma unroll
    for (int it = 0; it < 4; ++it) {
        const int nl = 16 * it + 2 * (lane >> 3);
        unsigned d[8];
#pragma unroll
        for (int j = 0; j < 8; ++j) d[j] = *(const LAS unsigned*)(scr + (8 * c + j) * 132 + 2 * nl);
        v4u o0, o1;
        o0.x = (d[0] & 0xffffu) | (d[1] << 16); o0.y = (d[2] & 0xffffu) | (d[3] << 16); o0.z = (d[4] & 0xffffu) | (d[5] << 16); o0.w = (d[6] & 0xffffu) | (d[7] << 16);
        o1.x = (d[0] >> 16) | (d[1] & 0xffff0000u); o1.y = (d[2] >> 16) | (d[3] & 0xffff0000u); o1.z = (d[4] >> 16) | (d[5] & 0xffff0000u); o1.w = (d[6] >> 16) | (d[7] & 0xffff0000u);
        bf16* dst = WT + (size_t)(64 * nb + nl) * K + 64 * kb + 8 * c;
        *(v4u*)dst = o0; *(v4u*)(dst + K) = o1;
    }
    LDS_WAIT(); asm volatile("" ::: "memory");
}
__device__ __forceinline__ unsigned pk4_fp8(float a, float b, float c, float d) { int r = __builtin_amdgcn_cvt_pk_fp8_f32(a, b, 0, false); r = __builtin_amdgcn_cvt_pk_fp8_f32(c, d, r, true); return (unsigned)r; }
__device__ __forceinline__ void p0_item_f8(const float* __restrict__ W, int N, int K, unsigned char* __restrict__ WT, int kb, int nb, int mapmode, LAS unsigned char* scr, int lane) {
    const int np = 64 * nb + 4 * (lane & 15);
    int src = np;
    if (mapmode == MAP_UG) { const int pn = np >> 8, L = np & 255, bj = L >> 7, i = L & 127; src = 1024 * bj + 128 * pn + i; }
    const float* gp = W + (size_t)(64 * kb + (lane >> 4)) * N + src;
    f32x4 v[16];
#pragma unroll
    for (int i = 0; i < 16; ++i) v[i] = *(const f32x4*)(gp + (size_t)(4 * i) * N);
#pragma unroll
    for (int i = 0; i < 16; ++i) *(LAS unsigned*)(scr + (4 * i + (lane >> 4)) * 68 + 4 * (lane & 15)) = pk4_fp8(v[i][0] * 64.0f, v[i][1] * 64.0f, v[i][2] * 64.0f, v[i][3] * 64.0f);
    LDS_WAIT(); asm volatile("" ::: "memory");
    const int nq = lane & 15, kg = lane >> 4;
    unsigned d[16];
#pragma unroll
    for (int j = 0; j < 16; ++j) d[j] = *(const LAS unsigned*)(scr + (16 * kg + j) * 68 + 4 * nq);
#pragma unroll
    for (int t = 0; t < 4; ++t) {
        v4u o;
#pragma unroll
        for (int q = 0; q < 4; ++q) o[q] = ((d[4 * q] >> (8 * t)) & 0xffu) | (((d[4 * q + 1] >> (8 * t)) & 0xffu) << 8) | (((d[4 * q + 2] >> (8 * t)) & 0xffu) << 16) | (((d[4 * q + 3] >> (8 * t)) & 0xffu) << 24);
        *(v4u*)(WT + (size_t)(64 * nb + 4 * nq + t) * K + 64 * kb + 16 * kg) = o;
    }
    LDS_WAIT(); asm volatile("" ::: "memory");
}
struct P0D { const float* gp; int N, K, kb, nb; bf16* W16; unsigned char* W8; const float* rsc; };
__device__ __forceinline__ int p0_src_col(int np, int mapmode) {
    int src = np;
    if (mapmode == MAP_IN) { const int pn = np >> 8, L = np & 255, bj = L >> 7, wc = (L >> 5) & 3, e = L & 31; src = 256 * pn + 64 * wc + 32 * bj + e; }
    else if (mapmode == MAP_UG) { const int pn = np >> 8, L = np & 255, bj = L >> 7, i = L & 127; src = 1024 * bj + 128 * pn + i; }
    return src;
}
__device__ __forceinline__ P0D p0_mk(const float* W, int N, int K, bf16* W16, unsigned char* W8, int kb, int nb, int mapmode, int lane, const float* rsc = nullptr) {
    P0D d; d.N = N; d.K = K; d.kb = kb; d.nb = nb; d.W16 = W16; d.W8 = W8;
    if (W8) {
        d.rsc = rsc ? rsc + 128 * kb + (lane >> 3) : nullptr;
        d.gp = W + (size_t)(128 * kb + (lane >> 3)) * N + p0_src_col(32 * nb + 4 * (lane & 7), mapmode);
    } else {
        d.rsc = nullptr;
        d.gp = W + (size_t)(64 * kb + (lane >> 4)) * N + p0_src_col(64 * nb + 4 * (lane & 15), mapmode);
    }
    return d;
}
__device__ __forceinline__ void p0_load(const P0D& d, f32x4 (&v)[16]) {
#pragma unroll
    for (int i = 0; i < 16; ++i) v[i] = __builtin_nontemporal_load((const f32x4*)(d.gp + (size_t)((d.W8 ? 8 : 4) * i) * d.N));
}
__device__ __forceinline__ void p0_finish(const P0D& d, const f32x4 (&v)[16], LAS unsigned char* scr, int lane, const int pm = 0) {
    if (pm == 1) { _Pragma("unroll") for (int i = 0; i < 16; ++i) asm volatile("" :: "v"(v[i])); return; }
    if (d.W16) {
#pragma unroll
        for (int i = 0; i < 16; ++i) { LAS unsigned* q = (LAS unsigned*)(scr + (4 * i + (lane >> 4)) * 132 + 8 * (lane & 15)); q[0] = cvtpk(v[i][0], v[i][1]); q[1] = cvtpk(v[i][2], v[i][3]); }
        LDS_WAIT(); asm volatile("" ::: "memory");
        const int c = lane & 7;
#pragma unroll
        for (int it = 0; it < 4; ++it) {
            const int nl = 16 * it + 2 * (lane >> 3);
            unsigned x[8];
#pragma unroll
            for (int j = 0; j < 8; ++j) x[j] = *(const LAS unsigned*)(scr + (8 * c + j) * 132 + 2 * nl);
            v4u o0, o1;
            o0.x = (x[0] & 0xffffu) | (x[1] << 16); o0.y = (x[2] & 0xffffu) | (x[3] << 16); o0.z = (x[4] & 0xffffu) | (x[5] << 16); o0.w = (x[6] & 0xffffu) | (x[7] << 16);
            o1.x = (x[0] >> 16) | (x[1] & 0xffff0000u); o1.y = (x[2] >> 16) | (x[3] & 0xffff0000u); o1.z = (x[4] >> 16) | (x[5] & 0xffff0000u); o1.w = (x[6] >> 16) | (x[7] & 0xffff0000u);
            bf16* dst = d.W16 + (size_t)(64 * d.nb + nl) * d.K + 64 * d.kb + 8 * c;
            if (pm == 0 || pm == 3) { *(v4u*)dst = o0; *(v4u*)(dst + d.K) = o1; } else asm volatile("" :: "v"(o0), "v"(o1));
        }
    } else {
#pragma unroll
        for (int i = 0; i < 16; ++i) { const float sc = d.rsc ? d.rsc[8 * i] * 64.0f : 64.0f; *(LAS unsigned*)(scr + (8 * i + (lane >> 3)) * 36 + 4 * (lane & 7)) = pk4_fp8(v[i][0] * sc, v[i][1] * sc, v[i][2] * sc, v[i][3] * sc); }
        LDS_WAIT(); asm volatile("" ::: "memory");
        const int nq = lane & 7, kg = lane >> 3;
        unsigned x[16];
#pragma unroll
        for (int j = 0; j < 16; ++j) x[j] = *(const LAS unsigned*)(scr + (16 * kg + j) * 36 + 4 * nq);
#pragma unroll
        for (int t = 0; t < 4; ++t) {
            v4u o;
#pragma unroll
            for (int q = 0; q < 4; ++q) o[q] = ((x[4 * q] >> (8 * t)) & 0xffu) | (((x[4 * q + 1] >> (8 * t)) & 0xffu) << 8) | (((x[4 * q + 2] >> (8 * t)) & 0xffu) << 16) | (((x[4 * q + 3] >> (8 * t)) & 0xffu) << 24);
            if (pm == 0 || pm == 3) __builtin_nontemporal_store(o, (v4u*)(d.W8 + (size_t)(32 * d.nb + 4 * nq + t) * d.K + 128 * d.kb + 16 * kg)); else asm volatile("" :: "v"(o));
        }
    }
    LDS_WAIT(); asm volatile("" ::: "memory");
}
__device__ __forceinline__ P0D p0_decode(const Args& a, unsigned char* ws, int it, int lane) {
    constexpr int I_IN = 16 * 56, I_OUT = 256, I_PG = 256, I_PP = 4 * 16, I_UG = 16 * 32, I_DN = 256;
    int r = it;
    if (r < I_IN) return p0_mk(a.w_in, DIN, DM, (bf16*)(ws + WS_WT_IN), nullptr, r / 56, r % 56, MAP_IN, lane); r -= I_IN;
    if (r < I_OUT) return p0_mk(a.w_out, DM, DM, (bf16*)(ws + WS_WT_OUT), nullptr, r / 16, r % 16, MAP_NAT, lane); r -= I_OUT;
    if (r < I_PG) return p0_mk(a.w_pg, DM, DM, nullptr, (unsigned char*)(ws + WS_WT_PG), r / 32, r % 32, MAP_NAT, lane); r -= I_PG;
    if (r < I_PP) return p0_mk(a.w_pp, DM, PLE, (bf16*)(ws + WS_WT_PP), nullptr, r / 16, r % 16, MAP_NAT, lane); r -= I_PP;
    if (r < NE * I_UG) { const int e = r / I_UG, q = r % I_UG; return p0_mk(a.w_ug + (size_t)e * DM * 2048, 2048, DM, nullptr, (unsigned char*)(ws + WS_WT_UG) + (size_t)e * 2048 * DM, q / 64, q % 64, MAP_UG, lane, a.g_ffn); } r -= NE * I_UG;
    { const int e = r / I_DN, q = r % I_DN; return p0_mk(a.w_dn + (size_t)e * DM * DM, DM, DM, nullptr, (unsigned char*)(ws + WS_WT_DN) + (size_t)e * DM * DM, q / 32, q % 32, MAP_NAT, lane); }
}
__device__ __forceinline__ void rms_row_to_bf16(const float* xrow, const float* g, bf16* orow, int lane) {
    const f32x4* xr = (const f32x4*)xrow + lane;
    f32x4 v[4]; float s = 0.f;
#pragma unroll
    for (int j = 0; j < 4; ++j) { v[j] = xr[64 * j]; s += (v[j][0] * v[j][0] + v[j][1] * v[j][1]) + (v[j][2] * v[j][2] + v[j][3] * v[j][3]); }
    const float rstd = rsqrtf(wave_sum(s) * (1.f / DM) + EPS);
    unsigned long long* o8 = (unsigned long long*)orow + lane;
#pragma unroll
    for (int j = 0; j < 4; ++j) { const f32x4 gg = ((const f32x4*)g)[lane + 64 * j];
        o8[64 * j] = (unsigned long long)cvtpk(v[j][0] * rstd * gg[0], v[j][1] * rstd * gg[1]) | ((unsigned long long)cvtpk(v[j][2] * rstd * gg[2], v[j][3] * rstd * gg[3]) << 32); }
}
__device__ __forceinline__ void p0_prologue(Frame& F, const Args& a, const int pm = 0) {
    unsigned char* ws = a.ws; const int tid = tid_now(), lane = tid & 63;
    LAS unsigned char* scr = F.lds + RING_OFF + F.wave * 8448;
    const int gw = F.vcu * NWAVES + F.wave, NGW = F.G * NWAVES;
    constexpr int I_IN = 16 * 56, I_OUT = 256, I_PG = 256, I_PP = 4 * 16, I_UG = 16 * 32, I_DN = 256;
    constexpr int NITEMS = I_IN + I_OUT + I_PG + I_PP + NE * I_UG + NE * I_DN;
    if (gw < NITEMS) {
        int it = gw; P0D d0 = p0_decode(a, ws, it, lane), d1 = d0; f32x4 va[16], vb[16]; p0_load(d0, va);
        for (;;) {
            const int it1 = it + NGW; const bool h1 = it1 < NITEMS;
            if (h1) { d1 = p0_decode(a, ws, it1, lane); p0_load(d1, vb); }
            p0_finish(d0, va, scr, lane, pm);
            if (!h1) break;
            const int it2 = it1 + NGW; const bool h2 = it2 < NITEMS;
            if (h2) { d0 = p0_decode(a, ws, it2, lane); p0_load(d0, va); }
            p0_finish(d1, vb, scr, lane, pm);
            if (!h2) break;
            it = it2;
        }
    }
    if (pm != 0) return;
    if (blockIdx.x == 0 && tid < 256) { const int t = tid; const float* srcs = (t < 64) ? a.sbq : (t < 128) ? a.sbk : (t < 192) ? a.rq : a.rk; ((float*)(ws + WS_GAINS))[t] = srcs[t & 63]; }
    {
        f32x4 gg[4];
#pragma unroll
        for (int j = 0; j < 4; ++j) gg[j] = ((const f32x4*)a.g_mix)[lane + 64 * j];
        for (int m0 = 4 * gw; m0 < T; m0 += 4 * NGW) {
            f32x4 v[4][4];
#pragma unroll
            for (int r = 0; r < 4; ++r)
#pragma unroll
                for (int j = 0; j < 4; ++j) v[r][j] = __builtin_nontemporal_load((const f32x4*)(a.x + (size_t)(m0 + r) * DM) + lane + 64 * j);
#pragma unroll
            for (int r = 0; r < 4; ++r) {
                float ss = 0.f;
#pragma unroll
                for (int j = 0; j < 4; ++j) ss += (v[r][j][0] * v[r][j][0] + v[r][j][1] * v[r][j][1]) + (v[r][j][2] * v[r][j][2] + v[r][j][3] * v[r][j][3]);
                const float rstd = rsqrtf(wave_sum(ss) * (1.f / DM) + EPS);
                unsigned long long* o8 = (unsigned long long*)((bf16*)(ws + WS_XN) + (size_t)(m0 + r) * DM) + lane;
#pragma unroll
                for (int j = 0; j < 4; ++j) o8[64 * j] = (unsigned long long)cvtpk(v[r][j][0] * rstd * gg[j][0], v[r][j][1] * rstd * gg[j][1]) | ((unsigned long long)cvtpk(v[r][j][2] * rstd * gg[j][2], v[r][j][3] * rstd * gg[j][3]) << 32);
            }
        }
    }
    { const int gt = gw * 64 + lane, NGT = NGW * 64;
      for (int i0 = gt; i0 < T * PLE / 8; i0 += 4 * NGT) {
          f32x4 a0[4], a1[4];
#pragma unroll
          for (int q = 0; q < 4; ++q) { const int i = i0 + q * NGT; if (i < T * PLE / 8) { a0[q] = __builtin_nontemporal_load((const f32x4*)a.p + 2 * i); a1[q] = __builtin_nontemporal_load((const f32x4*)a.p + 2 * i + 1); } }
#pragma unroll
          for (int q = 0; q < 4; ++q) { const int i = i0 + q * NGT; if (i < T * PLE / 8) { v4u o; o.x = cvtpk(a0[q][0], a0[q][1]); o.y = cvtpk(a0[q][2], a0[q][3]); o.z = cvtpk(a1[q][0], a1[q][1]); o.w = cvtpk(a1[q][2], a1[q][3]); ((v4u*)(ws + WS_PB))[i] = o; } }
      }
      for (int i = gt; i < NE * DM; i += NGT) { const int e = i >> 10, k = i & (DM - 1); const float wv = a.w_r[(size_t)k * NE + e] * a.g_ffn[k];
          const unsigned hi = cvtpk(wv, 0.f) & 0xffffu; const unsigned lo = cvtpk(wv - __uint_as_float(hi << 16), 0.f) & 0xffffu;
          ((bf16*)(ws + WS_WRT))[i] = (bf16)hi; ((bf16*)(ws + WS_WRT))[NE * DM + i] = (bf16)lo; }
      float* rc = (float*)(ws + WS_ROPEC); float* rs = (float*)(ws + WS_ROPES);
      for (int i = gt; i < T * 32; i += NGT) { const int row = i >> 5, f = i & 31;
          const float inv_freq = exp2f(-(float)f * (13.287712379549449f / 32.0f));   const float ang = (float)a.positions[row] * inv_freq;
          float sn, cs; sincosf(ang, &sn, &cs); rc[i] = cs; rs[i] = sn; } }
}

namespace att {
typedef short bf16x8 __attribute__((ext_vector_type(8)));
typedef short s16x4 __attribute__((ext_vector_type(4)));
typedef float f32x16 __attribute__((ext_vector_type(16)));
typedef short v4i16_t __attribute__((ext_vector_type(4)));
constexpr int LK = 0, LV = 24576, LFLAG = 49152;
__device__ __forceinline__ s16x4 vtr(LAS const unsigned char* p) { return __builtin_bit_cast(s16x4, __builtin_amdgcn_ds_read_tr16_b64_v4i16((LAS v4i16_t*)p)); }
__device__ __forceinline__ int crow(int r, int hi) { return (r & 3) + 8 * (r >> 2) + 4 * hi; }
struct AttnArgs { const bf16* hm; const bf16* rg; bf16* Y; const float* gn_g; const float* gn_b; };

template <int MODE, int ABL = 0> __device__ __forceinline__ void attn_unit(LAS unsigned char* lds, const AttnArgs& A, int b, int h, int qb) {
    int tid_ = threadIdx.x; asm volatile("" : "+v"(tid_));
    const int tid = tid_, lane = tid & 63, r32 = lane & 31, hh = lane >> 5;
    const int w = __builtin_amdgcn_readfirstlane(tid >> 6);
    const int q0 = qb * 256, qw = q0 + 32 * w;
    const size_t TS = (size_t)T * 512;
    const size_t hoff = (size_t)(b * 8 + h) * SEQ * 64;
    const bf16* Qp = A.hm + (MODE == 0 ? 0 : 3) * TS + hoff;
    const bf16* Kp = A.hm + (MODE == 0 ? 1 : 4) * TS + hoff;
    const bf16* Vp = A.hm + (MODE == 0 ? 2 : 5) * TS + hoff;
    bf16x8 qf[4];
#pragma unroll
    for (int ds = 0; ds < 4; ++ds) qf[ds] = *(const bf16x8*)(Qp + (size_t)(qw + r32) * 64 + 16 * ds + 8 * hh);
    f32x16 o[2];
#pragma unroll
    for (int r = 0; r < 16; ++r) { o[0][r] = 0.f; o[1][r] = 0.f; }
    float carry = 1.0f;
    const int jmax = (q0 + 255) >> 6, jd = (qw + 31) >> 6;
    const float lg2g = __log2f(1.0f - __builtin_amdgcn_exp2f(-5.0f - (float)h));
    const int krow = 8 * w + (lane >> 3);
    const bf16* Kt = Kp + (size_t)krow * 64 + (((lane & 7) ^ ((krow >> 1) & 7)) << 3); const bf16* Vt = Vp + (size_t)w * 512 + lane * 8;
    volatile LAS unsigned* flags = (volatile LAS unsigned*)(lds + LFLAG);
#define ATT_DMA(t, so) do { __builtin_amdgcn_global_load_lds((const unsigned*)(Kt + (size_t)(t) * 4096), (LAS unsigned*)(lds + LK + (so) + w * 1024), 16, 0, 0); \
                            __builtin_amdgcn_global_load_lds((const unsigned*)(Vt + (size_t)(t) * 4096), (LAS unsigned*)(lds + LV + (so) + w * 1024), 16, 0, 0); } while (0)
    ATT_DMA(jmax, 0);
    if (jmax >= 1) { ATT_DMA(jmax - 1, 8192); asm volatile("s_waitcnt vmcnt(2)\n\ts_barrier" ::: "memory"); }
    else asm volatile("s_waitcnt vmcnt(0)\n\ts_barrier" ::: "memory");
    bool finished = false;
    int so_cur = 0, so_new = 16384;
    for (int j = jmax; j >= 0; --j) {
        const int cur = j & 1;
        if (j >= 2 && ABL != 4) ATT_DMA(j - 2, so_new);
        if (j <= jd && !finished && ABL == 0) {
            LAS const unsigned char* Kb = lds + LK + so_cur;
            LAS const unsigned char* Vb = lds + LV + so_cur;
            f32x16 p[2];
#pragma unroll
            for (int r = 0; r < 16; ++r) { p[0][r] = 0.f; p[1][r] = 0.f; }
            bf16x8 kf[4][2];
            const int ksw = (r32 >> 1) & 7;
#pragma unroll
            for (int ds = 0; ds < 4; ++ds) { kf[ds][0] = *(LAS const bf16x8*)(Kb + r32 * 128 + (((2 * ds + hh) ^ ksw) << 4)); kf[ds][1] = *(LAS const bf16x8*)(Kb + 4096 + r32 * 128 + (((2 * ds + hh) ^ ksw) << 4)); }
#pragma unroll
            for (int ds = 0; ds < 4; ++ds) {
                p[0] = __builtin_amdgcn_mfma_f32_32x32x16_bf16(kf[ds][0], qf[ds], p[0], 0, 0, 0);
                p[1] = __builtin_amdgcn_mfma_f32_32x32x16_bf16(kf[ds][1], qf[ds], p[1], 0, 0, 0);
            }
            const bool diag = (j == jd);
            const int qg = qw + r32, kv0 = 64 * j + 4 * hh;
            if (MODE == 0) {
                float om[2][16];
#pragma unroll
                for (int hf = 0; hf < 2; ++hf)
#pragma unroll
                    for (int r = 0; r < 16; ++r) {
                        const float Z = p[hf][r];
                        const float a = __builtin_amdgcn_exp2f(-__builtin_fabsf(Z));
                        const float rc = __builtin_amdgcn_rcpf(1.0f + a), ar = a * rc;
                        const bool pos = Z >= 0.f;
                        p[hf][r] = pos ? rc : ar;
                        om[hf][r] = pos ? ar : rc;
                    }
                if (diag) {
#pragma unroll
                    for (int hf = 0; hf < 2; ++hf)
#pragma unroll
                        for (int r = 0; r < 16; ++r) { const bool valid = kv0 + 32 * hf + (r & 3) + 8 * (r >> 2) < qg; p[hf][r] = valid ? p[hf][r] : 0.f; om[hf][r] = valid ? om[hf][r] : 1.0f; }
                }
                float gs[8], ot[8];
#pragma unroll
                for (int m = 0; m < 8; ++m) { const int hf = m >> 2, g = m & 3; gs[m] = (om[hf][4 * g] * om[hf][4 * g + 1]) * (om[hf][4 * g + 2] * om[hf][4 * g + 3]); ot[m] = __shfl_xor(gs[m], 32); }
                float ps[8];
                ps[7] = 1.0f;
#pragma unroll
                for (int m = 6; m >= 0; --m) ps[m] = ps[m + 1] * (gs[m + 1] * ot[m + 1]);
                const float total = ps[0] * (gs[0] * ot[0]);
#pragma unroll
                for (int m = 0; m < 8; ++m) {
                    const int hf = m >> 2, g = m & 3;
                    float tail = carry * (hh ? ps[m] : ps[m] * ot[m]);
#pragma unroll
                    for (int i = 3; i >= 0; --i) { const int r = 4 * g + i; const float o1 = om[hf][r]; p[hf][r] *= tail; tail *= o1; }
                }
                carry *= total;
                finished = __all(carry < 1.0e-37f);
            } else {
                const float ct = __builtin_amdgcn_exp2f(lg2g * (float)(qw - 64 * j));
#pragma unroll
                for (int hf = 0; hf < 2; ++hf)
#pragma unroll
                    for (int r = 0; r < 16; ++r) p[hf][r] *= ct;
                if (diag) {
#pragma unroll
                    for (int hf = 0; hf < 2; ++hf)
#pragma unroll
                        for (int r = 0; r < 16; ++r) { const bool valid = kv0 + 32 * hf + (r & 3) + 8 * (r >> 2) <= qg; p[hf][r] = valid ? p[hf][r] : 0.f; }
                }
            }
            {
                const unsigned vbase = (unsigned)(uintptr_t)(Vb + (4 * hh + ((lane & 15) >> 2)) * 128 + (16 * ((lane >> 4) & 1) + 4 * (lane & 3)) * 2);
                s16x4 vl[2][2][2], vh[2][2][2];
#pragma unroll
                for (int hf = 0; hf < 2; ++hf)
#pragma unroll
                    for (int s = 0; s < 2; ++s)
#pragma unroll
                        for (int d0 = 0; d0 < 2; ++d0) {
                            asm volatile("ds_read_b64_tr_b16 %0, %1 offset:%c2" : "=&v"(vl[hf][s][d0]) : "v"(vbase), "i"(hf * 4096 + s * 2048 + d0 * 64) : "memory");
                            asm volatile("ds_read_b64_tr_b16 %0, %1 offset:%c2" : "=&v"(vh[hf][s][d0]) : "v"(vbase), "i"(hf * 4096 + s * 2048 + d0 * 64 + 1024) : "memory");
                        }
                bf16x8 wfr[2][2];
#pragma unroll
                for (int hf = 0; hf < 2; ++hf)
#pragma unroll
                    for (int s = 0; s < 2; ++s) {
                        u32x4_t wq;
                        wq.x = pg8::cvt_pk_bf16(p[hf][8 * s + 0], p[hf][8 * s + 1]); wq.y = pg8::cvt_pk_bf16(p[hf][8 * s + 2], p[hf][8 * s + 3]);
                        wq.z = pg8::cvt_pk_bf16(p[hf][8 * s + 4], p[hf][8 * s + 5]); wq.w = pg8::cvt_pk_bf16(p[hf][8 * s + 6], p[hf][8 * s + 7]);
                        wfr[hf][s] = __builtin_bit_cast(bf16x8, wq);
                    }
                asm volatile("s_waitcnt lgkmcnt(0)" ::: "memory"); __builtin_amdgcn_sched_barrier(0);
#pragma unroll
                for (int hf = 0; hf < 2; ++hf)
#pragma unroll
                    for (int s = 0; s < 2; ++s)
#pragma unroll
                        for (int d0 = 0; d0 < 2; ++d0) {
                            const s16x4 lo = vl[hf][s][d0], hi = vh[hf][s][d0];
                            const bf16x8 vf = (bf16x8){lo[0], lo[1], lo[2], lo[3], hi[0], hi[1], hi[2], hi[3]};
                            o[d0] = __builtin_amdgcn_mfma_f32_32x32x16_bf16(vf, wfr[hf][s], o[d0], 0, 0, 0);
                        }
            }
        }
        if (MODE == 0) { if (lane == 0) flags[cur * 8 + w] = finished ? 1u : 0u; }
        if (j >= 2) asm volatile("s_waitcnt vmcnt(2) lgkmcnt(0)\n\ts_barrier" ::: "memory"); else asm volatile("s_waitcnt vmcnt(0) lgkmcnt(0)\n\ts_barrier" ::: "memory");
        so_cur = (so_cur == 16384) ? 0 : so_cur + 8192; so_new = (so_new == 16384) ? 0 : so_new + 8192;
        if (MODE == 0) {
            unsigned all = 1u;
#pragma unroll
            for (int i = 0; i < 8; ++i) all &= flags[cur * 8 + i];
            if (all) break;
        }
    }
    asm volatile("s_waitcnt vmcnt(0)\n\ts_barrier" ::: "memory");
#undef ATT_DMA
    const int row = b * SEQ + qw + r32;
    if (MODE == 0) {
        bf16* yp = A.Y + (size_t)row * DM + h * 64 + 4 * hh;
#pragma unroll
        for (int d0 = 0; d0 < 2; ++d0)
#pragma unroll
            for (int g = 0; g < 4; ++g) { u32x2_t v; v.x = pg8::cvt_pk_bf16(o[d0][4 * g], o[d0][4 * g + 1]); v.y = pg8::cvt_pk_bf16(o[d0][4 * g + 2], o[d0][4 * g + 3]); *(u32x2_t*)(yp + 32 * d0 + 8 * g) = v; }
    } else {
        float s1 = 0.f;
#pragma unroll
        for (int r = 0; r < 16; ++r) s1 += o[0][r] + o[1][r];
        s1 += __shfl_xor(s1, 32);
        const float mu = s1 * (1.0f / 64.0f);
        float s2 = 0.f;
#pragma unroll
        for (int r = 0; r < 16; ++r) { const float a0 = o[0][r] - mu, a1 = o[1][r] - mu; s2 += a0 * a0 + a1 * a1; }
        s2 += __shfl_xor(s2, 32);
        const float rstd = rsqrtf(s2 * (1.0f / 64.0f) + EPS);
        bf16* yp = A.Y + (size_t)row * DM + 512 + h * 64 + 4 * hh;
        const bf16* gp = A.rg + (size_t)row * 512 + h * 64 + 4 * hh;
        const float* gg = A.gn_g + h * 64 + 4 * hh; const float* gb = A.gn_b + h * 64 + 4 * hh;
#pragma unroll
        for (int d0 = 0; d0 < 2; ++d0)
#pragma unroll
            for (int g = 0; g < 4; ++g) {
                const f32x4 gn = *(const f32x4*)(gg + 32 * d0 + 8 * g), bs = *(const f32x4*)(gb + 32 * d0 + 8 * g);
                const u32x2_t gr = *(const u32x2_t*)(gp + 32 * d0 + 8 * g);
                float gate[4] = {__uint_as_float(gr.x << 16), __uint_as_float(gr.x & 0xffff0000u), __uint_as_float(gr.y << 16), __uint_as_float(gr.y & 0xffff0000u)};
                float ov[4];
#pragma unroll
                for (int i = 0; i < 4; ++i) { const float yn = (o[d0][4 * g + i] - mu) * rstd * gn[i] + bs[i]; const float sg = gate[i] / (1.0f + __expf(-gate[i])); ov[i] = yn * sg; }
                u32x2_t v; v.x = pg8::cvt_pk_bf16(ov[0], ov[1]); v.y = pg8::cvt_pk_bf16(ov[2], ov[3]); *(u32x2_t*)(yp + 32 * d0 + 8 * g) = v;
            }
    }
}
__device__ __forceinline__ void attn_phase(LAS unsigned char* lds, const AttnArgs& A, int vcu, int dup, bf16* dummyY) {
    const int g = vcu >> 5, local = vcu & 31;
    if (dup == 24 || dup == 25) { AttnArgs A2 = A; A2.Y = dummyY;
#pragma unroll 1
        for (int u = 0; u < 2; ++u) { const int bh = 8 * g + 4 * (u & 1) + (local >> 3), qb = (u & 1) ? 7 - (local & 7) : (local & 7); if (dup == 24) attn_unit<1, 3>(lds, A2, bh >> 3, bh & 7, qb); else attn_unit<1, 4>(lds, A2, bh >> 3, bh & 7, qb); } }
#pragma unroll 1
    for (int u = 0; u < ((dup == 20) ? 4 : 2); ++u) { const int bh = 8 * g + 4 * (u & 1) + (local >> 3), qb = (u & 1) ? 7 - (local & 7) : (local & 7); attn_unit<1>(lds, A, bh >> 3, bh & 7, qb); }
#pragma unroll 1
    for (int u = 0; u < ((dup == 21) ? 4 : 2); ++u) { const int bh = 8 * g + 4 * (u & 1) + (local >> 3), qb = (u & 1) ? 7 - (local & 7) : (local & 7); attn_unit<0>(lds, A, bh >> 3, bh & 7, qb); }
}
}

constexpr int CW_GCNT = 2048;
constexpr int LR_LCNT = LDSCTL_OFF + 1024, LR_GBASE = LDSCTL_OFF + 1152;
constexpr int LT_POFF = LDSCTL_OFF + 2048, LT_NT = LDSCTL_OFF + 2176, LT_TILE_E = LDSCTL_OFF + 2304;
struct RouteBufs { int* tok_e; int* tok_slot; float* tok_gate; float* rstd; float* slot_rstd; };
__device__ __forceinline__ RouteBufs route_bufs(unsigned char* ws) { RouteBufs r; r.tok_e = (int*)(ws + WS_ROUTE); r.tok_slot = r.tok_e + T * 4; r.tok_gate = (float*)(r.tok_slot + T * 4); r.rstd = (float*)(ws + WS_ROUTE + 1 * MiB); r.slot_rstd = (float*)(ws + WS_ROUTE + 2 * MiB); return r; }
typedef float f32x2v __attribute__((ext_vector_type(2)));
__device__ __forceinline__ unsigned opq_mask(bool c) { unsigned m = c ? 0xffffffffu : 0u; asm volatile("" : "+v"(m)); return m; }
__device__ __forceinline__ float blendf(unsigned m, float a, float b) { return __uint_as_float((__float_as_uint(a) & m) | (__float_as_uint(b) & ~m)); }
__device__ __forceinline__ int blendi(unsigned m, int a, int b) { return (int)(((unsigned)a & m) | ((unsigned)b & ~m)); }

#define SW2(c, a, b) { const float ta_ = (c) ? (b) : (a), tb_ = (c) ? (a) : (b); a = ta_; b = tb_; }
#define SW2I(c, a, b) { const int ta_ = (c) ? (b) : (a), tb_ = (c) ? (a) : (b); a = ta_; b = tb_; }
#define TOP4_INSERT(x, e) { const float x_ = (x); const int e_ = (e); const bool c3_ = (x_ > v3) || (x_ == v3 && e_ < i3); v3 = c3_ ? x_ : v3; i3 = c3_ ? e_ : i3; \
    const bool c2_ = (v3 > v2) || (v3 == v2 && i3 < i2); SW2(c2_, v2, v3) SW2I(c2_, i2, i3) const bool c1_ = (v2 > v1) || (v2 == v1 && i2 < i1); SW2(c1_, v1, v2) SW2I(c1_, i1, i2) \
    const bool c0_ = (v1 > v0) || (v1 == v0 && i1 < i0); SW2(c0_, v0, v1) SW2I(c0_, i0, i1) }
__device__ __forceinline__ void router_phase(Frame& F, const Args& a, const bool dry = false) {
    unsigned char* ws = a.ws; const int tid = tid_now();
    LAS unsigned char* lds = F.lds;
    const int lane = tid & 63, r32 = lane & 31, hh = lane >> 5, w = F.wave, rg = w >> 2, kq = w & 3;
    volatile LAS unsigned* lcnt = (volatile LAS unsigned*)(lds + LR_LCNT);
    volatile LAS unsigned* gbase = (volatile LAS unsigned*)(lds + LR_GBASE);
    if (tid < 32) lcnt[tid] = 0u;
    const RouteBufs R = route_bufs(dry ? ws + 3 * MiB : ws);
    const int row = F.vcu * 64 + 32 * rg + r32;
    const float* xr = a.out + (size_t)row * DM + 256 * kq + 8 * hh;
    const bf16* wt = (const bf16*)(ws + WS_WRT) + (size_t)r32 * DM + 256 * kq + 8 * hh;
    unsigned char* hp = (unsigned char*)(ws + (dry ? WS_H : WS_XN)) + (size_t)row * DM + 256 * kq + 8 * hh;
    att::f32x16 D;
#pragma unroll
    for (int r = 0; r < 16; ++r) D[r] = 0.f;
    float ss = 0.f;
#pragma unroll 8
    for (int ks = 0; ks < 16; ++ks) {
        const f32x4 v0 = *(const f32x4*)(xr + 16 * ks), v1 = *(const f32x4*)(xr + 16 * ks + 4);
        ss += ((v0[0] * v0[0] + v0[1] * v0[1]) + (v0[2] * v0[2] + v0[3] * v0[3])) + ((v1[0] * v1[0] + v1[1] * v1[1]) + (v1[2] * v1[2] + v1[3] * v1[3]));
        u32x2_t h8; h8.x = pk4_fp8(v0[0], v0[1], v0[2], v0[3]); h8.y = pk4_fp8(v1[0], v1[1], v1[2], v1[3]); *(u32x2_t*)(hp + 16 * ks) = h8;
        u32x4_t xh, xl;
        xh.x = cvtpk(v0[0], v0[1]); xh.y = cvtpk(v0[2], v0[3]); xh.z = cvtpk(v1[0], v1[1]); xh.w = cvtpk(v1[2], v1[3]);
        xl.x = cvtpk(v0[0] - __uint_as_float(xh.x << 16), v0[1] - __uint_as_float(xh.x & 0xffff0000u)); xl.y = cvtpk(v0[2] - __uint_as_float(xh.y << 16), v0[3] - __uint_as_float(xh.y & 0xffff0000u));
        xl.z = cvtpk(v1[0] - __uint_as_float(xh.z << 16), v1[1] - __uint_as_float(xh.z & 0xffff0000u)); xl.w = cvtpk(v1[2] - __uint_as_float(xh.w << 16), v1[3] - __uint_as_float(xh.w & 0xffff0000u));
        const att::bf16x8 whi = *(const att::bf16x8*)(wt + 16 * ks), wlo = *(const att::bf16x8*)(wt + 32 * DM + 16 * ks);
        const att::bf16x8 bxh = __builtin_bit_cast(att::bf16x8, xh), bxl = __builtin_bit_cast(att::bf16x8, xl);
        D = __builtin_amdgcn_mfma_f32_32x32x16_bf16(whi, bxh, D, 0, 0, 0);
        D = __builtin_amdgcn_mfma_f32_32x32x16_bf16(wlo, bxh, D, 0, 0, 0);
        D = __builtin_amdgcn_mfma_f32_32x32x16_bf16(whi, bxl, D, 0, 0, 0);
    }
    { LAS f32x4* dp = (LAS f32x4*)(lds + (w * 64 + lane) * 64);
#pragma unroll
      for (int q = 0; q < 4; ++q) dp[q] = (f32x4){D[4 * q], D[4 * q + 1], D[4 * q + 2], D[4 * q + 3]};
      *(LAS float*)(lds + 32768 + (w * 64 + lane) * 4) = ss; }
    __syncthreads();
    int my_e0 = 0, my_e1 = 0, rk0 = 0, rk1 = 0; float my_g0 = 0.f, my_g1 = 0.f;
    if (kq == 0) {
#pragma unroll
        for (int o = 1; o < 4; ++o) { LAS const f32x4* dp = (LAS const f32x4*)(lds + ((w + o) * 64 + lane) * 64);
#pragma unroll
            for (int q = 0; q < 4; ++q) { const f32x4 t = dp[q]; D[4 * q] += t[0]; D[4 * q + 1] += t[1]; D[4 * q + 2] += t[2]; D[4 * q + 3] += t[3]; }
            ss += *(LAS const float*)(lds + 32768 + ((w + o) * 64 + lane) * 4); }
        ss += __shfl_xor(ss, 32);
        const float rstd = rsqrtf(ss * (1.f / DM) + EPS);
        if (hh == 0) R.rstd[row] = rstd;
        float l[16];
#pragma unroll
        for (int r = 0; r < 16; ++r) l[r] = D[r] * rstd + a.b_r[(r & 3) + 8 * (r >> 2) + 4 * hh];
        float c[8]; int ci[8];
#pragma unroll
        for (int k = 0; k < 4; ++k) {
            float bv = -INFINITY; int bi = 99;
#pragma unroll
            for (int r = 0; r < 16; ++r) { const int e = (r & 3) + 8 * (r >> 2) + 4 * hh; const bool bt = l[r] > bv; bv = bt ? l[r] : bv; bi = bt ? e : bi; }
            c[k] = bv; ci[k] = bi;
#pragma unroll
            for (int r = 0; r < 16; ++r) { const int e = (r & 3) + 8 * (r >> 2) + 4 * hh; l[r] = (e == bi) ? -INFINITY : l[r]; }
        }
#pragma unroll
        for (int k = 0; k < 4; ++k) { c[4 + k] = __shfl_xor(c[k], 32); ci[4 + k] = __shfl_xor(ci[k], 32); }
        float tv[4]; int ti[4];
#pragma unroll
        for (int k = 0; k < 4; ++k) {
            float bv = -INFINITY; int bi = 99;
#pragma unroll
            for (int j = 0; j < 8; ++j) { const bool bt = (c[j] > bv) || (c[j] == bv && ci[j] < bi); bv = bt ? c[j] : bv; bi = bt ? ci[j] : bi; }
            tv[k] = bv; ti[k] = bi;
#pragma unroll
            for (int j = 0; j < 8; ++j) c[j] = (ci[j] == bi) ? -INFINITY : c[j];
        }
        const float v0 = tv[0], v1 = tv[1], v2 = tv[2], v3 = tv[3]; const int i0 = ti[0], i1 = ti[1], i2 = ti[2], i3 = ti[3];
        const float e1 = __expf(v1 - v0), e2 = __expf(v2 - v0), e3 = __expf(v3 - v0), inv = 1.0f / (1.0f + e1 + e2 + e3);
        my_e0 = hh ? i2 : i0; my_e1 = hh ? i3 : i1; my_g0 = (hh ? e2 : 1.0f) * inv; my_g1 = (hh ? e3 : e1) * inv;
        rk0 = (int)__hip_atomic_fetch_add((LAS unsigned*)(lds + LR_LCNT) + my_e0, 1u, __ATOMIC_RELAXED, __HIP_MEMORY_SCOPE_WORKGROUP);
        rk1 = (int)__hip_atomic_fetch_add((LAS unsigned*)(lds + LR_LCNT) + my_e1, 1u, __ATOMIC_RELAXED, __HIP_MEMORY_SCOPE_WORKGROUP);
    }
    __syncthreads();
    if (tid < 32) gbase[tid] = __hip_atomic_fetch_add((unsigned*)(F.ctl + CW_GCNT + (dry ? 64 : 0)) + tid, lcnt[tid], __ATOMIC_RELAXED, __HIP_MEMORY_SCOPE_AGENT);
    __syncthreads();
    if (kq == 0) {
        const int k0 = 2 * hh;
        R.tok_e[row * 4 + k0] = my_e0; R.tok_slot[row * 4 + k0] = (int)gbase[my_e0] + rk0; R.tok_gate[row * 4 + k0] = my_g0;
        R.tok_e[row * 4 + k0 + 1] = my_e1; R.tok_slot[row * 4 + k0 + 1] = (int)gbase[my_e1] + rk1; R.tok_gate[row * 4 + k0 + 1] = my_g1;
    }
}
#undef SW2
#undef SW2I
#undef TOP4_INSERT

__device__ __forceinline__ void build_tables(Frame& F) {
    LAS int* poff = (LAS int*)(F.lds + LT_POFF); LAS int* ntp = (LAS int*)(F.lds + LT_NT); LAS int* tile_e = (LAS int*)(F.lds + LT_TILE_E);
    LAS int* cnts = (LAS int*)(F.lds + LR_LCNT); const int tid = tid_now();
    if (tid < NE) cnts[tid] = (int)__hip_atomic_load((unsigned*)(F.ctl + CW_GCNT) + tid, __ATOMIC_RELAXED, __HIP_MEMORY_SCOPE_AGENT);
    __syncthreads();
    if (tid == 0) {
        int t = 0;
        for (int e = 0; e < NE; ++e) { const int c = cnts[e]; const int nt = (c + 255) >> 8; poff[e] = t * 256; for (int i = 0; i < nt; ++i) tile_e[t + i] = e; t += nt; }
        *ntp = t;
    }
    __syncthreads();
}
__device__ __forceinline__ void gather_phase(Frame& F, const Args& a) {
    unsigned char* ws = a.ws; const int lane = tid_now() & 63; const RouteBufs R = route_bufs(ws);
    LAS const int* poff = (LAS const int*)(F.lds + LT_POFF);
    const int gw = F.vcu * NWAVES + F.wave, NGW = F.G * NWAVES;
    for (int m0 = 4 * gw; m0 < T; m0 += 4 * NGW) {
        v4u h0[4]; float rs[4]; int dsts[4][4];
#pragma unroll
        for (int r = 0; r < 4; ++r) { const int m = m0 + r; h0[r] = __builtin_nontemporal_load((const v4u*)((const unsigned char*)(ws + WS_XN) + (size_t)m * DM) + lane); rs[r] = R.rstd[m];
#pragma unroll
            for (int k = 0; k < 4; ++k) dsts[r][k] = poff[R.tok_e[m * 4 + k]] + R.tok_slot[m * 4 + k]; }
#pragma unroll
        for (int r = 0; r < 4; ++r)
#pragma unroll
            for (int k = 0; k < 4; ++k) { ((v4u*)((unsigned char*)(ws + WS_XS) + (size_t)dsts[r][k] * DM))[lane] = h0[r]; if (lane == 0) R.slot_rstd[dsts[r][k]] = rs[r]; }
    }
}
__device__ __forceinline__ void combine_phase(Frame& F, const Args& a, const bool dry = false) {
    unsigned char* ws = a.ws; const RouteBufs R = route_bufs(ws);
    LAS const int* poff = (LAS const int*)(F.lds + LT_POFF);
    const int gw = F.vcu * NWAVES + F.wave, NGW = F.G * NWAVES, lane = tid_now() & 63;
    for (int m0 = 2 * gw; m0 < T; m0 += 2 * NGW) {
        f32x4 v[2][2][2]; u32x2_t y[2][4][2]; float gt[2][4];
#pragma unroll
        for (int rr = 0; rr < 2; ++rr) { const int m = m0 + rr;
#pragma unroll
            for (int i = 0; i < 2; ++i) { v[rr][i][0] = __builtin_nontemporal_load((const f32x4*)(a.out + (size_t)m * DM + 8 * lane + 512 * i)); v[rr][i][1] = __builtin_nontemporal_load((const f32x4*)(a.out + (size_t)m * DM + 8 * lane + 512 * i + 4)); }
#pragma unroll
            for (int k = 0; k < 4; ++k) { const int e = R.tok_e[m * 4 + k], slot = R.tok_slot[m * 4 + k]; gt[rr][k] = R.tok_gate[m * 4 + k];
                const unsigned char* yr = (const unsigned char*)(ws + WS_YS) + (size_t)(poff[e] + slot) * DM + 8 * lane;
                y[rr][k][0] = __builtin_nontemporal_load((const u32x2_t*)yr); y[rr][k][1] = __builtin_nontemporal_load((const u32x2_t*)(yr + 512)); } }
#pragma unroll
        for (int rr = 0; rr < 2; ++rr) { const int m = m0 + rr;
#pragma unroll
            for (int k = 0; k < 4; ++k)
#pragma unroll
                for (int i = 0; i < 2; ++i) { const u32x2_t yy = y[rr][k][i]; const float g = gt[rr][k];
                    const f32x2v a0 = __builtin_amdgcn_cvt_pk_f32_fp8((int)yy.x, false), a1 = __builtin_amdgcn_cvt_pk_f32_fp8((int)yy.x, true), a2 = __builtin_amdgcn_cvt_pk_f32_fp8((int)yy.y, false), a3 = __builtin_amdgcn_cvt_pk_f32_fp8((int)yy.y, true);
                    v[rr][i][0][0] += g * a0[0]; v[rr][i][0][1] += g * a0[1]; v[rr][i][0][2] += g * a1[0]; v[rr][i][0][3] += g * a1[1];
                    v[rr][i][1][0] += g * a2[0]; v[rr][i][1][1] += g * a2[1]; v[rr][i][1][2] += g * a3[0]; v[rr][i][1][3] += g * a3[1]; }
            float ss = 0.f;
#pragma unroll
            for (int i = 0; i < 2; ++i)
#pragma unroll
                for (int q = 0; q < 2; ++q) { const f32x4 t = v[rr][i][q]; ss += (t[0] * t[0] + t[1] * t[1]) + (t[2] * t[2] + t[3] * t[3]); }
            const float rstd = rsqrtf(wave_sum(ss) * (1.f / DM) + EPS);
            unsigned char* np = (unsigned char*)(ws + (dry ? WS_H : WS_XN)) + (size_t)m * DM + 8 * lane; bf16* ow = (bf16*)(ws + (dry ? WS_XS : WS_Y));
#pragma unroll
            for (int i = 0; i < 2; ++i) { { v4u xb; xb[0] = cvtpk(v[rr][i][0][0], v[rr][i][0][1]); xb[1] = cvtpk(v[rr][i][0][2], v[rr][i][0][3]); xb[2] = cvtpk(v[rr][i][1][0], v[rr][i][1][1]); xb[3] = cvtpk(v[rr][i][1][2], v[rr][i][1][3]); *(v4u*)(ow + (size_t)m * DM + 8 * lane + 512 * i) = xb; }
                const f32x4 g0 = *(const f32x4*)(a.g_ple + 8 * lane + 512 * i), g1 = *(const f32x4*)(a.g_ple + 8 * lane + 512 * i + 4);
                u32x2_t o; o.x = pk4_fp8(v[rr][i][0][0] * rstd * g0[0], v[rr][i][0][1] * rstd * g0[1], v[rr][i][0][2] * rstd * g0[2], v[rr][i][0][3] * rstd * g0[3]);
                o.y = pk4_fp8(v[rr][i][1][0] * rstd * g1[0], v[rr][i][1][1] * rstd * g1[1], v[rr][i][1][2] * rstd * g1[2], v[rr][i][1][3] * rstd * g1[3]);
                *(u32x2_t*)(np + 512 * i) = o; } }
    }
}

__global__ void __launch_bounds__(NWAVES * 64, 2) mega_fwd(Args args) {
    extern __shared__ __attribute__((aligned(16))) unsigned char lds[];
    Frame F;
    F.lds = (LAS unsigned char*)lds;
    F.MISC = (volatile LAS unsigned*)(F.lds + MISC_OFF);
    F.wave = __builtin_amdgcn_readfirstlane(threadIdx.x >> 6);
    F.G = gridDim.x; { const int bx = blockIdx.x; F.vcu = (F.G % 8 == 0) ? (bx % 8) * (F.G / 8) + bx / 8 : bx; }
    unsigned char* ws = args.ws;
    F.ctl = (gu32*)(ws + WS_CTL);
    for (int u = threadIdx.x; u < (LDS_BYTES - LDSCTL_OFF) / 4; u += NWAVES * 64) ((LAS unsigned*)(F.lds + LDSCTL_OFF))[u] = 0u;
    __syncthreads();
    XcdBarrier bar = xcd_barrier_post((unsigned*)(F.ctl + CW_BAR), F.MISC + 8);
    const int lo = args.ph_lo, hi = args.ph_hi;
#define IN(k) (lo <= (k) && (k) < hi)
#define GRID_BAR() xcd_barrier(bar)
#ifndef DUP_PHASE
#define DUP_PHASE -1
#endif
#define REP(k) for (int rep_ = 0; rep_ < ((DUP_PHASE) == (k) ? 2 : 1); ++rep_)

    if (IN(0)) { if (DUP_PHASE == 40) { p0_prologue(F, args, 1); GRID_BAR(); } if (DUP_PHASE == 41) { p0_prologue(F, args, 2); GRID_BAR(); } if (DUP_PHASE == 42) { p0_prologue(F, args, 3); GRID_BAR(); } REP(0) { p0_prologue(F, args); GRID_BAR(); } }

    if (IN(1)) REP(1) {
        pg8::Gemm g{(const pg8::bf16_t*)(ws + WS_XN), (const pg8::bf16_t*)(ws + WS_WT_IN), DM, 0};
        pg8::StaticOrder S; S.init(T / 256, DIN / 256, F.G, (int)blockIdx.x);
        pg8::EpiProj E{(pg8::bf16_t*)(ws + WS_HM), (pg8::bf16_t*)(ws + WS_RG), (const float*)(ws + WS_GAINS), (const float*)(ws + WS_ROPEC), (const float*)(ws + WS_ROPES)};
        pg8::gemm_phase<pg8::EpiProj, pg8::StaticOrder, true, true>(F.lds + RING_OFF, g, S, E);
        {
            const int G2 = (F.G == 256) ? 128 : F.G, c2 = (F.G == 256) ? (int)blockIdx.x - 128 : (int)blockIdx.x;
            if (c2 >= 0) {
                pg8::Gemm g2{(const pg8::bf16_t*)(ws + WS_PB), (const pg8::bf16_t*)(ws + WS_WT_PP), PLE, 0};
                pg8::StaticOrder S2; S2.init(T / 256, DM / 256, G2, c2);
                pg8::EpiBf16Plain E2{(pg8::bf16_t*)(ws + WS_PJ), DM};
                pg8::gemm_phase<pg8::EpiBf16Plain, pg8::StaticOrder, true, true>(F.lds + RING_OFF, g2, S2, E2);
            }
        }
        GRID_BAR();
    }
    if (IN(2)) REP(2) {
        if (F.G == 256) {
            const att::AttnArgs AA{(const bf16*)(ws + WS_HM), (const bf16*)(ws + WS_RG), (bf16*)(ws + WS_Y), args.gn_g, args.gn_b};
            att::attn_phase(F.lds + RING_OFF, AA, F.vcu, DUP_PHASE, (bf16*)(ws + WS_XS));
        }
        GRID_BAR();
    }
    if (IN(3)) REP(3) {
        pg8::Gemm g{(const pg8::bf16_t*)(ws + WS_Y), (const pg8::bf16_t*)(ws + WS_WT_OUT), DM, 0};
        pg8::StaticOrder S; S.init(T / 256, DM / 256, F.G, (int)blockIdx.x);
        pg8::EpiResid E{args.x, args.out};
        pg8::gemm_phase<pg8::EpiResid, pg8::StaticOrder, true, true>(F.lds + RING_OFF, g, S, E);
        GRID_BAR();
    }
    if (DUP_PHASE == 30 && IN(3)) { GRID_BAR(); GRID_BAR(); GRID_BAR(); GRID_BAR(); }
    if (IN(4)) { if (DUP_PHASE == 4) { if (F.G == 256) router_phase(F, args, true); GRID_BAR(); } if (F.G == 256) router_phase(F, args); GRID_BAR(); }
    if (IN(5) || (lo >= 6 && lo <= 8)) build_tables(F);
    if (IN(5)) REP(5) { gather_phase(F, args); GRID_BAR(); }
    if (IN(6)) REP(6) {
        const int NT = *(LAS const int*)(F.lds + LT_NT);
        pg8::Gemm g{(const pg8::bf16_t*)(ws + WS_XS), (const pg8::bf16_t*)(ws + WS_WT_UG), DM / 2, (size_t)2048 * DM};
        pg8::MoeOrder S; S.init(NT, 8, F.G, (int)blockIdx.x, (LAS const int*)(F.lds + LT_TILE_E));
        pg8::EpiMoeUp E{(unsigned char*)(ws + WS_H), args.b_ug, route_bufs(ws).slot_rstd};
        pg8::gemm_phase<pg8::EpiMoeUp, pg8::MoeOrder, true, true, true>(F.lds + RING_OFF, g, S, E);
        GRID_BAR();
    }
    if (IN(7)) REP(7) {
        const int NT = *(LAS const int*)(F.lds + LT_NT);
        pg8::Gemm g{(const pg8::bf16_t*)(ws + WS_H), (const pg8::bf16_t*)(ws + WS_WT_DN), DM / 2, (size_t)DM * DM};
        pg8::MoeOrder S; S.init(NT, 4, F.G, (int)blockIdx.x, (LAS const int*)(F.lds + LT_TILE_E));
        pg8::EpiMoeDown E{(unsigned char*)(ws + WS_YS), args.b_dn};
        pg8::gemm_phase<pg8::EpiMoeDown, pg8::MoeOrder, true, true, true>(F.lds + RING_OFF, g, S, E);
        GRID_BAR();
    }
    if (IN(8)) { if (DUP_PHASE == 8) { combine_phase(F, args, true); GRID_BAR(); } combine_phase(F, args); GRID_BAR(); }
    if (IN(9)) {
        pg8::Gemm g{(const pg8::bf16_t*)(ws + WS_XN), (const pg8::bf16_t*)(ws + WS_WT_PG), DM / 2, 0};
        pg8::StaticOrder S; S.init(T / 256, DM / 256, F.G, (int)blockIdx.x);
        if (DUP_PHASE == 9) { pg8::EpiPle E0{(const pg8::bf16_t*)(ws + WS_Y), (const pg8::bf16_t*)(ws + WS_PJ), (float*)(ws + WS_XS)}; pg8::gemm_phase<pg8::EpiPle, pg8::StaticOrder, true, true, true>(F.lds + RING_OFF, g, S, E0); }
        pg8::EpiPle E{(const pg8::bf16_t*)(ws + WS_Y), (const pg8::bf16_t*)(ws + WS_PJ), args.out};
        pg8::gemm_phase<pg8::EpiPle, pg8::StaticOrder, true, true, true>(F.lds + RING_OFF, g, S, E);
    }
#undef IN
}
extern "C" void kernel_launch(void* const* d_in, const int* in_sizes, int n_in, void* d_out, int out_size, void* d_ws, size_t ws_size, hipStream_t stream) {
    static int grid = 0;
    if (grid == 0) {
        if (n_in != 22 || ws_size < 1024 * MiB) { fprintf(stderr, "kernel_launch: unexpected n_in %d / ws %zu\n", n_in, ws_size); grid = -1; return; }
        int dev = 0, cus = 0, per_cu = 0;
        if (hipGetDevice(&dev) != hipSuccess || hipDeviceGetAttribute(&cus, hipDeviceAttributeMultiprocessorCount, dev) != hipSuccess) { grid = -1; return; }
        if (hipFuncSetAttribute((const void*)mega_fwd, hipFuncAttributeMaxDynamicSharedMemorySize, LDS_BYTES) != hipSuccess) { fprintf(stderr, "kernel_launch: hipFuncSetAttribute failed\n"); grid = -1; return; }
        if (hipOccupancyMaxActiveBlocksPerMultiprocessor(&per_cu, (const void*)mega_fwd, NWAVES * 64, LDS_BYTES) != hipSuccess || per_cu < 1) { fprintf(stderr, "kernel_launch: occupancy query says %d\n", per_cu); per_cu = 1; }
        (void)hipGetLastError();
        grid = cus;
    }
    if (grid < 0) return;
    (void)hipMemsetAsync((char*)d_ws + WS_CTL, 0, CTL_ZERO_BYTES, stream);
    Args a{};
    a.x = (const float*)d_in[0]; a.p = (const float*)d_in[1]; a.positions = (const int*)d_in[2]; a.g_mix = (const float*)d_in[3]; a.w_in = (const float*)d_in[4];
    a.sbq = (const float*)d_in[5]; a.sbk = (const float*)d_in[6]; a.rq = (const float*)d_in[7]; a.rk = (const float*)d_in[8]; a.gn_g = (const float*)d_in[9]; a.gn_b = (const float*)d_in[10];
    a.w_out = (const float*)d_in[11]; a.g_ffn = (const float*)d_in[12]; a.w_r = (const float*)d_in[13]; a.b_r = (const float*)d_in[14]; a.w_ug = (const float*)d_in[15]; a.b_ug = (const float*)d_in[16];
    a.w_dn = (const float*)d_in[17]; a.b_dn = (const float*)d_in[18]; a.g_ple = (const float*)d_in[19]; a.w_pg = (const float*)d_in[20]; a.w_pp = (const float*)d_in[21];
    a.out = (float*)d_out; a.ws = (unsigned char*)d_ws; a.ph_lo = 0; a.ph_hi = 10;
    hipLaunchKernelGGL(mega_fwd, dim3(grid), dim3(NWAVES * 64), LDS_BYTES, stream, a);

}
```

```cpp
#include <hip/hip_runtime.h>
#include <cstdint>
#include <cstdio>
#include <cmath>

namespace pg8 {
#define PG8_LAS __attribute__((address_space(3)))
typedef unsigned short bf16_t;
typedef short bf16x8 __attribute__((ext_vector_type(8)));
typedef float f32x4 __attribute__((ext_vector_type(4)));
typedef unsigned u32x4 __attribute__((ext_vector_type(4)));
typedef unsigned u32x2 __attribute__((ext_vector_type(2)));
typedef int v4i32 __attribute__((ext_vector_type(4)));
typedef int v8i32 __attribute__((ext_vector_type(8)));
constexpr int BM = 256, BK = 64, HALF = 128, HTB = HALF * BK * 2  , STAGE_BYTES = 8 * HTB, NXCD = 8, WGM = 8;

__host__ __device__ __forceinline__ int lds_byte(int r, int c) { const int st = (r >> 4) * 2 + (c >> 5), rr = r & 15, cc = c & 31, ob = rr * 64 + cc * 2; return st * 1024 + (ob ^ (((ob >> 9) & 1) << 5)); }
__host__ __device__ __forceinline__ void stage_rc(int b, int& R, int& C) { const int st = b / 1024, sb = b % 1024, swz = sb ^ (((sb >> 9) & 1) << 5); R = (st >> 1) * 16 + swz / 64; C = (st & 1) * 32 + (swz % 64) / 2; }
__host__ __device__ __forceinline__ int perm32(int rho) { const int n = rho >> 4, i = rho & 15; return 8 * (i >> 2) + 4 * n + (i & 3); }

struct Unit { int pm, pn, e, seq; };
struct Gemm { const bf16_t* A; const bf16_t* Bt; int K; size_t strideBe; };

struct StaticOrder {
    int nM, nN, nwg, G, c;
    __host__ __device__ void init(int nM_, int nN_, int G_, int c_) { nM = nM_; nN = nN_; nwg = nM * nN; G = G_; c = c_; }
    __host__ __device__ bool next(int i, Unit& u) const {
        const long L = (long)i * G + c; if (L >= nwg) return false;
        int wgid = (int)L; { const int q = nwg / NXCD, r = nwg % NXCD, xcd = wgid % NXCD, off = wgid / NXCD; wgid = (xcd < r ? xcd * (q + 1) : r * (q + 1) + (xcd - r) * q) + off; }
        const int nig = WGM * nN, gid = wgid / nig, fm = gid * WGM, gsz = (nM - fm) < WGM ? (nM - fm) : WGM;
        u.pm = fm + ((wgid % nig) % gsz); u.pn = (wgid % nig) / gsz; u.e = 0; u.seq = i; return true;
    }
    __device__ __forceinline__ void a_ready(const Unit&) const {}
    __device__ __forceinline__ void done(const Unit&) const {}
};

typedef float f32x2_t __attribute__((ext_vector_type(2))); typedef __bf16 bf16x2_t __attribute__((ext_vector_type(2)));
__device__ __forceinline__ unsigned cvt_pk_bf16(float lo, float hi) { f32x2_t v = {lo, hi}; bf16x2_t b = __builtin_convertvector(v, bf16x2_t); return __builtin_bit_cast(unsigned, b); }

constexpr int T = 16384, SEQ = 2048, DM = 1024, DIN = 3584;
constexpr float EPS = 1e-6f;
__device__ __forceinline__ u32x4 pack8(const f32x4 a, const f32x4 b) { u32x4 w; w.x = cvt_pk_bf16(a[0], a[1]); w.y = cvt_pk_bf16(a[2], a[3]); w.z = cvt_pk_bf16(b[0], b[1]); w.w = cvt_pk_bf16(b[2], b[3]); return w; }

struct EpiProj {
    static constexpr bool PERM = true, AFTER_DRAIN = false;
    bf16_t* hm;
    bf16_t* rg;
    const float* gains;
    const float *ropec, *ropes;
    __device__ __forceinline__ void operator()(const f32x4 (&acc)[2][2][4][2], const Unit& u, int wr, int wc, int fr, int fq) const {
        const int region = u.pn >> 1, hb = 4 * (u.pn & 1) + wc;
        const bool normed = (region == 0) || (region == 1) || (region == 3) || (region == 4);
        const bool rope = (region == 3) || (region == 4);
        const int gidx = region == 0 ? 0 : region == 1 ? 1 : region == 3 ? 2 : 3;
        const float* gp = gains + gidx * 64;
        f32x4 gv[2][2];
#pragma unroll
        for (int bj = 0; bj < 2; ++bj)
#pragma unroll
            for (int n = 0; n < 2; ++n) gv[bj][n] = normed ? *(const f32x4*)(gp + 32 * bj + 8 * fq + 4 * n) : (f32x4){1.f, 1.f, 1.f, 1.f};
        const float lg2g = __log2f(1.0f - __builtin_amdgcn_exp2f(-5.0f - (float)hb));
        const float scale = region == 0 ? 0.125f * 1.4426950408889634f : region == 4 ? 0.125f : 1.0f;
#pragma unroll
        for (int ai = 0; ai < 2; ++ai)
#pragma unroll
            for (int m = 0; m < 4; ++m) {
                const int row = u.pm * BM + ai * HALF + wr * 64 + m * 16 + fr;
                const int b = row >> 11, s = row & (SEQ - 1);
                f32x4 v[2][2];
#pragma unroll
                for (int bj = 0; bj < 2; ++bj)
#pragma unroll
                    for (int n = 0; n < 2; ++n) v[bj][n] = acc[ai][bj][m][n];
                if (normed) {
                    float ss = 0.f;
#pragma unroll
                    for (int bj = 0; bj < 2; ++bj)
#pragma unroll
                        for (int n = 0; n < 2; ++n) { const f32x4 x = v[bj][n]; ss += (x[0] * x[0] + x[1] * x[1]) + (x[2] * x[2] + x[3] * x[3]); }
                    ss += __shfl_xor(ss, 16); ss += __shfl_xor(ss, 32);
                    float rs = rsqrtf(ss * (1.0f / 64.0f) + EPS) * scale;
                    if (rope) rs *= (region == 3) ? __builtin_amdgcn_exp2f((float)(s & 31) * lg2g) : __builtin_amdgcn_exp2f(-(float)(s & 63) * lg2g);
#pragma unroll
                    for (int bj = 0; bj < 2; ++bj)
#pragma unroll
                        for (int n = 0; n < 2; ++n) v[bj][n] = v[bj][n] * rs * gv[bj][n];
                    if (rope) {
#pragma unroll
                        for (int n = 0; n < 2; ++n) {
                            const f32x4 c = *(const f32x4*)(ropec + (size_t)row * 32 + 8 * fq + 4 * n), sn = *(const f32x4*)(ropes + (size_t)row * 32 + 8 * fq + 4 * n);
                            const f32x4 lo = v[0][n], hi = v[1][n];
                            v[0][n] = lo * c - hi * sn; v[1][n] = hi * c + lo * sn;
                        }
                    }
                }
                bf16_t* dst = (region < 6) ? hm + (size_t)region * ((size_t)T * 512) + ((size_t)(b * 8 + hb) * SEQ + s) * 64 + 8 * fq
                                           : rg + (size_t)row * 512 + hb * 64 + 8 * fq;
#pragma unroll
                for (int bj = 0; bj < 2; ++bj) *(u32x4*)(dst + 32 * bj) = pack8(v[bj][0], v[bj][1]);
            }
    }
};

constexpr int PF_WAVE_BYTES = 768, PF_BUF_BYTES = 8 * PF_WAVE_BYTES;
struct EpiBf16Plain {
    static constexpr bool PERM = true, AFTER_DRAIN = false;
    bf16_t* O; int ldc;
    __device__ __forceinline__ void operator()(const f32x4 (&acc)[2][2][4][2], const Unit& u, int wr, int wc, int fr, int fq) const {
        const int row0 = u.pm * BM + wr * 64 + fr, col0 = u.pn * BM + wc * 32 + 8 * fq;
#pragma unroll
        for (int ai = 0; ai < 2; ++ai)
#pragma unroll
            for (int m = 0; m < 4; ++m) { bf16_t* rowp = O + (size_t)(row0 + ai * HALF + m * 16) * ldc + col0;
#pragma unroll
                for (int bj = 0; bj < 2; ++bj) *(u32x4*)(rowp + bj * HALF) = pack8(acc[ai][bj][m][0], acc[ai][bj][m][1]); }
    }
};
struct EpiResid {
    static constexpr bool PERM = false, AFTER_DRAIN = false;
    const float* base; float* out;
    __device__ __forceinline__ void operator()(const f32x4 (&acc)[2][2][4][2], const Unit& u, int wr, int wc, int fr, int fq) const {
        const int col0 = u.pn * BM + wc * 32 + 4 * fq;
#pragma unroll
        for (int ai = 0; ai < 2; ++ai)
#pragma unroll
            for (int m = 0; m < 4; ++m) { const size_t off = (size_t)(u.pm * BM + ai * HALF + wr * 64 + m * 16 + fr) * DM + col0;
#pragma unroll
                for (int bj = 0; bj < 2; ++bj)
#pragma unroll
                    for (int n = 0; n < 2; ++n) { const f32x4 bs = __builtin_nontemporal_load((const f32x4*)(base + off + bj * HALF + n * 16)); *(f32x4*)(out + off + bj * HALF + n * 16) = bs + acc[ai][bj][m][n]; } }
    }
};
struct EpiMoeUp {
    static constexpr bool PERM = true, AFTER_DRAIN = false;
    unsigned char* H; const PG8_LAS unsigned char* pf_lds;
    __device__ __forceinline__ void operator()(const f32x4 (&acc)[2][2][4][2], const Unit& u, int wr, int wc, int fr, int fq) const {
        const int cc = 128 * u.pn + 32 * wc + 8 * fq;
        f32x4 bg[2], bl[2]; float scs[2][4];
        const PG8_LAS unsigned char* buf = pf_lds + (u.seq & 1) * PF_BUF_BYTES + (wr * 4 + wc) * PF_WAVE_BYTES;
#pragma unroll
        for (int n = 0; n < 2; ++n) { bg[n] = *(const PG8_LAS f32x4*)(buf + (8 * fq + 4 * n) * 4); bl[n] = *(const PG8_LAS f32x4*)(buf + 128 + (8 * fq + 4 * n) * 4); }
#pragma unroll
        for (int ai = 0; ai < 2; ++ai)
#pragma unroll
            for (int m = 0; m < 4; ++m) scs[ai][m] = *(const PG8_LAS float*)(buf + 256 + ai * 256 + (m * 16 + fr) * 4);
#pragma unroll
        for (int n = 0; n < 2; ++n) bl[n] = bl[n] + 1.0f;
#pragma unroll
        for (int ai = 0; ai < 2; ++ai)
#pragma unroll
            for (int m = 0; m < 4; ++m) {
                const float sc = scs[ai][m] * 0.015625f;
                f32x4 hv[2];
#pragma unroll
                for (int n = 0; n < 2; ++n) {
                    const f32x4 g0 = acc[ai][0][m][n] * sc + bg[n], l1 = acc[ai][1][m][n] * sc + bl[n];
                    f32x4 glu, lin1;
#pragma unroll
                    for (int j = 0; j < 4; ++j) { glu[j] = __builtin_fminf(g0[j], 7.0f); lin1[j] = __builtin_amdgcn_fmed3f(l1[j], -6.0f, 8.0f); }
                    const f32x4 t = glu * (-1.702f * 1.4426950408889634f);
                    f32x4 e;
#pragma unroll
                    for (int j = 0; j < 4; ++j) e[j] = __builtin_amdgcn_exp2f(t[j]);
                    const f32x4 d = e + 1.0f;
                    f32x4 r;
#pragma unroll
                    for (int j = 0; j < 4; ++j) r[j] = __builtin_amdgcn_rcpf(d[j]);
                    hv[n] = (glu * r) * lin1;
                }
                u32x2 hq; hq.x = (unsigned)__builtin_amdgcn_cvt_pk_fp8_f32(hv[0][0], hv[0][1], 0, false); hq.x = (unsigned)__builtin_amdgcn_cvt_pk_fp8_f32(hv[0][2], hv[0][3], (int)hq.x, true);
                hq.y = (unsigned)__builtin_amdgcn_cvt_pk_fp8_f32(hv[1][0], hv[1][1], 0, false); hq.y = (unsigned)__builtin_amdgcn_cvt_pk_fp8_f32(hv[1][2], hv[1][3], (int)hq.y, true);
                *(u32x2*)(H + (size_t)(u.pm * BM + ai * HALF + wr * 64 + m * 16 + fr) * 1024 + cc) = hq;
            }
    }
};
struct EpiMoeDown {
    static constexpr bool PERM = true, AFTER_DRAIN = false;
    unsigned char* YS; const PG8_LAS unsigned char* pf_lds;
    __device__ __forceinline__ void operator()(const f32x4 (&acc)[2][2][4][2], const Unit& u, int wr, int wc, int fr, int fq) const {
        const int col0 = u.pn * BM + wc * 32 + 8 * fq;
        const PG8_LAS unsigned char* buf = pf_lds + (u.seq & 1) * PF_BUF_BYTES + (wr * 4 + wc) * PF_WAVE_BYTES;
        f32x4 bv[2][2];
#pragma unroll
        for (int bj = 0; bj < 2; ++bj)
#pragma unroll
            for (int n = 0; n < 2; ++n) bv[bj][n] = *(const PG8_LAS f32x4*)(buf + bj * 128 + (8 * fq + 4 * n) * 4);
#pragma unroll
        for (int ai = 0; ai < 2; ++ai)
#pragma unroll
            for (int m = 0; m < 4; ++m) { unsigned char* rowp = YS + (size_t)(u.pm * BM + ai * HALF + wr * 64 + m * 16 + fr) * 1024 + col0;
#pragma unroll
                for (int bj = 0; bj < 2; ++bj) { const f32x4 y0 = acc[ai][bj][m][0] * 0.015625f + bv[bj][0], y1 = acc[ai][bj][m][1] * 0.015625f + bv[bj][1];
                    u32x2 q; q.x = (unsigned)__builtin_amdgcn_cvt_pk_fp8_f32(y0[0], y0[1], 0, false); q.x = (unsigned)__builtin_amdgcn_cvt_pk_fp8_f32(y0[2], y0[3], (int)q.x, true);
                    q.y = (unsigned)__builtin_amdgcn_cvt_pk_fp8_f32(y1[0], y1[1], 0, false); q.y = (unsigned)__builtin_amdgcn_cvt_pk_fp8_f32(y1[2], y1[3], (int)q.y, true);
                    *(u32x2*)(rowp + bj * HALF) = q; } }
    }
};
struct EpiPle {
    static constexpr bool PERM = false, AFTER_DRAIN = false;
    const bf16_t* X2; const bf16_t* PJ; float* outw;
    __device__ __forceinline__ void operator()(const f32x4 (&acc)[2][2][4][2], const Unit& u, int wr, int wc, int fr, int fq) const {
        const int col0 = u.pn * BM + wc * 32 + 4 * fq;
#pragma unroll
        for (int ai = 0; ai < 2; ++ai)
#pragma unroll
            for (int m = 0; m < 4; ++m) { const size_t off = (size_t)(u.pm * BM + ai * HALF + wr * 64 + m * 16 + fr) * DM + col0;
#pragma unroll
                for (int bj = 0; bj < 2; ++bj)
#pragma unroll
                    for (int n = 0; n < 2; ++n) {
                        const size_t o2 = off + bj * HALF + n * 16;
                        const u32x2 xq = __builtin_nontemporal_load((const u32x2*)(X2 + o2)); const f32x4 x2 = (f32x4){__uint_as_float(xq.x << 16), __uint_as_float(xq.x & 0xffff0000u), __uint_as_float(xq.y << 16), __uint_as_float(xq.y & 0xffff0000u)}; const u32x2 pj = __builtin_nontemporal_load((const u32x2*)(PJ + o2)); const f32x4 a = acc[ai][bj][m][n] * 0.015625f;
                        f32x4 r;
                        r[0] = x2[0] + __uint_as_float(pj.x << 16) * __builtin_amdgcn_rcpf(1.0f + __builtin_amdgcn_exp2f(-1.4426950408889634f * a[0]));
                        r[1] = x2[1] + __uint_as_float(pj.x & 0xffff0000u) * __builtin_amdgcn_rcpf(1.0f + __builtin_amdgcn_exp2f(-1.4426950408889634f * a[1]));
                        r[2] = x2[2] + __uint_as_float(pj.y << 16) * __builtin_amdgcn_rcpf(1.0f + __builtin_amdgcn_exp2f(-1.4426950408889634f * a[2]));
                        r[3] = x2[3] + __uint_as_float(pj.y & 0xffff0000u) * __builtin_amdgcn_rcpf(1.0f + __builtin_amdgcn_exp2f(-1.4426950408889634f * a[3]));
                        __builtin_nontemporal_store(r, (f32x4*)(outw + o2));
                    } }
    }
};
struct MoeOrder {
    int nM, nN, nwg, G, c, wid, mode; const PG8_LAS int* tile_e; const float* pf_bias; const float* pf_rstd; PG8_LAS unsigned char* pf_lds;
    __device__ void init(int nM_, int nN_, int G_, int c_, const PG8_LAS int* te, int wid_, int mode_, const float* pb, const float* pr, PG8_LAS unsigned char* pl) { nM = nM_; nN = nN_; nwg = nM * nN; G = G_; c = c_; tile_e = te; wid = wid_; mode = mode_; pf_bias = pb; pf_rstd = pr; pf_lds = pl; }
    __device__ bool next(int i, Unit& u) const {
        const long L = (long)i * G + c; if (L >= nwg) return false;
        int wgid = (int)L; { const int q = nwg / NXCD, r = nwg % NXCD, xcd = wgid % NXCD, off = wgid / NXCD; wgid = (xcd < r ? xcd * (q + 1) : r * (q + 1) + (xcd - r) * q) + off; }
        const int nig = WGM * nN, gid = wgid / nig, fm = gid * WGM, gsz = (nM - fm) < WGM ? (nM - fm) : WGM;
        u.pm = fm + ((wgid % nig) % gsz); u.pn = (wgid % nig) / gsz; u.e = __builtin_amdgcn_readfirstlane(tile_e[u.pm]); u.seq = i; return true;
    }
    __device__ __forceinline__ void a_ready(const Unit& u) const {
        const int lane = (int)__builtin_amdgcn_mbcnt_hi(~0u, __builtin_amdgcn_mbcnt_lo(~0u, 0u)), wr = wid >> 2, wc = wid & 3;
        PG8_LAS unsigned char* buf = pf_lds + (u.seq & 1) * PF_BUF_BYTES + wid * PF_WAVE_BYTES;
        if (mode == 1) {
            const float* bsrc = pf_bias + (size_t)u.e * 2048 + 128 * u.pn + 32 * wc + (lane & 31) + ((lane >> 5) ? 1024 : 0);
            __builtin_amdgcn_global_load_lds((const unsigned*)bsrc, (PG8_LAS unsigned*)buf, 4, 0, 0);
            const float* rsrc = pf_rstd + u.pm * BM + wr * 64 + lane;
            __builtin_amdgcn_global_load_lds((const unsigned*)rsrc, (PG8_LAS unsigned*)(buf + 256), 4, 0, 0);
            __builtin_amdgcn_global_load_lds((const unsigned*)(rsrc + HALF), (PG8_LAS unsigned*)(buf + 512), 4, 0, 0);
        } else if (mode == 2) {
            const float* bsrc = pf_bias + (size_t)u.e * 1024 + u.pn * BM + 32 * wc + (lane & 31) + ((lane >> 5) ? HALF : 0);
            __builtin_amdgcn_global_load_lds((const unsigned*)bsrc, (PG8_LAS unsigned*)buf, 4, 0, 0);
        }
    }
    __device__ __forceinline__ void done(const Unit&) const {}
};
struct EpiNull {
    static constexpr bool PERM = true, AFTER_DRAIN = false;
    __device__ __forceinline__ void operator()(const f32x4 (&acc)[2][2][4][2], const Unit& u, int wr, int wc, int fr, int fq) const {
#pragma unroll
        for (int ai = 0; ai < 2; ++ai)
#pragma unroll
            for (int bj = 0; bj < 2; ++bj)
#pragma unroll
                for (int m = 0; m < 4; ++m)
#pragma unroll
                    for (int n = 0; n < 2; ++n) asm volatile("" :: "v"(acc[ai][bj][m][n]));
    }
};
template <class Epi, class Sched, bool ALIGN_EPI = false, bool SP2 = false, bool F8 = false>
__device__ __forceinline__ void gemm_phase(PG8_LAS unsigned char* lds, const Gemm g, const Sched& S, const Epi& E) {
    int tid_ = threadIdx.x; asm volatile("" : "+v"(tid_));
    const int tid = tid_, wid = __builtin_amdgcn_readfirstlane(tid >> 6), lane = tid & 63, wr = wid >> 2, wc = wid & 3, fr = lane & 15, fq = lane >> 4;
    const int K = g.K, nt = K / BK;
    unsigned voffA[2], voffB[2];
#pragma unroll
    for (int i = 0; i < 2; ++i) { int R, C; stage_rc(tid * 16 + i * 8192, R, C); const int Rb = Epi::PERM ? ((R & ~31) + perm32(R & 31)) : R;
        voffA[i] = (unsigned)(R * K + C) * 2u; voffB[i] = (unsigned)(Rb * K + C) * 2u; }
    const size_t kstep = (size_t)(BK * 2);
    const size_t hstep = (size_t)HALF * K * 2;
    const size_t tstep = 2 * hstep;
    const unsigned ldsw = (unsigned)wid * 1024u;
    const int aoff = lds_byte(wr * 64 + fr, fq * 8), boff = lds_byte(wc * 32 + fr, fq * 8);
#define PG8_SA(b, h) (((b) * 2 + (h)) * HTB)
#define PG8_SB(b, h) ((4 + (b) * 2 + (h)) * HTB)
#define PG8_STAGE(bufoff, gbase, voff) do { _Pragma("unroll") for (int _i = 0; _i < 2; ++_i) \
        __builtin_amdgcn_global_load_lds((const unsigned*)((const char*)(gbase) + (voff)[_i]), (PG8_LAS unsigned*)(lds + (bufoff) + ldsw + _i * 8192), 16, 0, 0); } while (0)
#define PG8_LD16(off) (*(const PG8_LAS v4i32*)(lds + (off)))
#define PG8_LDA(dst, b, h) do { if constexpr (F8) { _Pragma("unroll") for (int m = 0; m < 4; ++m) dst##8[m] = __builtin_shufflevector(PG8_LD16(PG8_SA(b, h) + aoff + m * 2048), PG8_LD16(PG8_SA(b, h) + aoff + m * 2048 + 1024), 0, 1, 2, 3, 4, 5, 6, 7); } \
        else { _Pragma("unroll") for (int m = 0; m < 4; ++m) _Pragma("unroll") for (int k = 0; k < 2; ++k) dst[m][k] = *(const PG8_LAS bf16x8*)(lds + PG8_SA(b, h) + aoff + m * 2048 + k * 1024); } } while (0)
#define PG8_LDB(dst, b, h) do { if constexpr (F8) { _Pragma("unroll") for (int n = 0; n < 2; ++n) dst##8[n] = __builtin_shufflevector(PG8_LD16(PG8_SB(b, h) + boff + n * 2048), PG8_LD16(PG8_SB(b, h) + boff + n * 2048 + 1024), 0, 1, 2, 3, 4, 5, 6, 7); } \
        else { _Pragma("unroll") for (int n = 0; n < 2; ++n) _Pragma("unroll") for (int k = 0; k < 2; ++k) dst[n][k] = *(const PG8_LAS bf16x8*)(lds + PG8_SB(b, h) + boff + n * 2048 + k * 1024); } } while (0)
#define PG8_MMA(ai, bj, At, Bt) do { __builtin_amdgcn_s_setprio(1); \
        if constexpr (F8) { _Pragma("unroll") for (int m = 0; m < 4; ++m) _Pragma("unroll") for (int n = 0; n < 2; ++n) \
            asm volatile("v_mfma_scale_f32_16x16x128_f8f6f4 %0, %1, %2, %0, %3, %3 op_sel_hi:[0,0,0]" : "+v"(acc[ai][bj][m][n]) : "v"(Bt##8[n]), "v"(At##8[m]), "v"(f8scale)); } \
        else { _Pragma("unroll") for (int m = 0; m < 4; ++m) _Pragma("unroll") for (int n = 0; n < 2; ++n) _Pragma("unroll") for (int k = 0; k < 2; ++k) \
            acc[ai][bj][m][n] = __builtin_amdgcn_mfma_f32_16x16x32_bf16(Bt[n][k], At[m][k], acc[ai][bj][m][n], 0, 0, 0); } \
        __builtin_amdgcn_s_setprio(0); } while (0)
#define PG8_WAIT_V(n) asm volatile("s_waitcnt vmcnt(" #n ")" ::: "memory")
#define PG8_WAIT_L(n) asm volatile("s_waitcnt lgkmcnt(" #n ")" ::: "memory")
#define PG8_BAR __builtin_amdgcn_s_barrier()
#define PG8_SCHED __builtin_amdgcn_sched_barrier(0)
    Unit cur, nxt; int ui = 0;
    if (!S.next(0, cur)) return;
    f32x4 acc[2][2][4][2];
#pragma unroll
    for (int a = 0; a < 2; ++a)
#pragma unroll
        for (int b = 0; b < 2; ++b)
#pragma unroll
            for (int m = 0; m < 4; ++m)
#pragma unroll
                for (int n = 0; n < 2; ++n) acc[a][b][m][n] = (f32x4){0.f, 0.f, 0.f, 0.f};
    bf16x8 At[4][2], B0[2][2], B1[2][2];
    v8i32 At8[4], B08[2], B18[2]; const int f8scale = 0x7f7f7f7f;
    const char* cA = (const char*)g.A + (size_t)cur.pm * tstep; const char* cB = (const char*)g.Bt + (size_t)cur.e * g.strideBe + (size_t)cur.pn * tstep;
    S.a_ready(cur);
    if constexpr (SP2) {
        PG8_STAGE(PG8_SB(0, 0), cB, voffB); PG8_STAGE(PG8_SB(0, 1), cB + hstep, voffB); PG8_STAGE(PG8_SA(0, 0), cA, voffA); PG8_STAGE(PG8_SA(0, 1), cA + hstep, voffA);
        if (wr == 1) PG8_BAR;
        PG8_WAIT_V(2); PG8_BAR;
        PG8_STAGE(PG8_SB(1, 0), cB + kstep, voffB); PG8_STAGE(PG8_SA(1, 0), cA + kstep, voffA); PG8_STAGE(PG8_SB(1, 1), cB + hstep + kstep, voffB);
        PG8_WAIT_V(6); PG8_BAR;
    } else {
        PG8_STAGE(PG8_SB(0, 0), cB, voffB); PG8_STAGE(PG8_SA(0, 0), cA, voffA); PG8_STAGE(PG8_SB(0, 1), cB + hstep, voffB); PG8_STAGE(PG8_SA(0, 1), cA + hstep, voffA);
        if (wr == 1) PG8_BAR;
        PG8_WAIT_V(4); PG8_BAR;
        PG8_STAGE(PG8_SB(1, 0), cB + kstep, voffB); PG8_STAGE(PG8_SA(1, 0), cA + kstep, voffA); PG8_STAGE(PG8_SB(1, 1), cB + hstep + kstep, voffB);
        PG8_WAIT_V(6); PG8_BAR;
    }
    for (;;) {
        const bool has_next = S.next(ui + 1, nxt);
        const char* nA = has_next ? (const char*)g.A + (size_t)nxt.pm * tstep : cA; const char* nB = has_next ? (const char*)g.Bt + (size_t)nxt.e * g.strideBe + (size_t)nxt.pn * tstep : cB;
#pragma unroll 1
        for (int t = 0; t < nt; t += 2) {
            const bool last = (t == nt - 2);
            const char* a1 = cA + (size_t)(t + 1) * kstep;
            const char* a2 = last ? nA : cA + (size_t)(t + 2) * kstep; const char* b2 = last ? nB : cB + (size_t)(t + 2) * kstep;
            const char* a3 = a2 + kstep; const char* b3 = b2 + kstep;
            if (last && has_next) S.a_ready(nxt);
            if constexpr (SP2) {
            PG8_LDB(B0, 0, 0); PG8_LDB(B1, 0, 1); PG8_SCHED; PG8_LDA(At, 0, 0); PG8_STAGE(PG8_SA(1, 1), a1 + hstep, voffA);
            PG8_WAIT_V(8); PG8_WAIT_L(0); PG8_BAR; PG8_MMA(0, 0, At, B0); PG8_MMA(0, 1, At, B1); PG8_BAR; PG8_SCHED;
            PG8_LDA(At, 0, 1); PG8_STAGE(PG8_SB(0, 0), b2, voffB); PG8_STAGE(PG8_SB(0, 1), b2 + hstep, voffB); PG8_STAGE(PG8_SA(0, 0), a2, voffA);
            PG8_WAIT_V(8); PG8_WAIT_L(0); PG8_BAR; PG8_MMA(1, 0, At, B0); PG8_MMA(1, 1, At, B1); PG8_BAR; PG8_SCHED;
            PG8_LDB(B0, 1, 0); PG8_LDB(B1, 1, 1); PG8_SCHED; PG8_LDA(At, 1, 0); PG8_STAGE(PG8_SA(0, 1), a2 + hstep, voffA);
            PG8_WAIT_V(8); PG8_WAIT_L(0); PG8_BAR; PG8_MMA(0, 0, At, B0); PG8_MMA(0, 1, At, B1); PG8_BAR; PG8_SCHED;
            PG8_LDA(At, 1, 1); PG8_STAGE(PG8_SB(1, 0), b3, voffB); PG8_STAGE(PG8_SB(1, 1), b3 + hstep, voffB); PG8_STAGE(PG8_SA(1, 0), a3, voffA);
            PG8_WAIT_V(8); PG8_WAIT_L(0); PG8_BAR; PG8_MMA(1, 0, At, B0); PG8_MMA(1, 1, At, B1); PG8_BAR; PG8_SCHED;
            } else {
            PG8_LDB(B0, 0, 0); PG8_SCHED; PG8_LDA(At, 0, 0); PG8_STAGE(PG8_SA(1, 1), a1 + hstep, voffA);
            PG8_WAIT_L(8); PG8_BAR; PG8_WAIT_L(0); PG8_MMA(0, 0, At, B0); PG8_BAR; PG8_SCHED;
            PG8_LDB(B1, 0, 1); PG8_STAGE(PG8_SB(0, 0), b2, voffB);
            PG8_BAR; PG8_WAIT_L(0); PG8_MMA(0, 1, At, B1); PG8_BAR;
            PG8_LDA(At, 0, 1); PG8_STAGE(PG8_SA(0, 0), a2, voffA);
            PG8_BAR; PG8_WAIT_L(0); PG8_MMA(1, 0, At, B0); PG8_BAR; PG8_SCHED;
            PG8_STAGE(PG8_SB(0, 1), b2 + hstep, voffB);
            PG8_WAIT_V(6); PG8_BAR; PG8_MMA(1, 1, At, B1); PG8_BAR;
            PG8_LDB(B0, 1, 0); PG8_SCHED; PG8_LDA(At, 1, 0); PG8_STAGE(PG8_SA(0, 1), a2 + hstep, voffA);
            PG8_WAIT_L(8); PG8_BAR; PG8_WAIT_L(0); PG8_MMA(0, 0, At, B0); PG8_BAR; PG8_SCHED;
            PG8_LDB(B1, 1, 1); PG8_STAGE(PG8_SB(1, 0), b3, voffB);
            PG8_BAR; PG8_WAIT_L(0); PG8_MMA(0, 1, At, B1); PG8_BAR;
            PG8_LDA(At, 1, 1); PG8_STAGE(PG8_SA(1, 0), a3, voffA);
            PG8_BAR; PG8_WAIT_L(0); PG8_MMA(1, 0, At, B0); PG8_BAR; PG8_SCHED;
            PG8_STAGE(PG8_SB(1, 1), b3 + hstep, voffB);
            PG8_WAIT_V(6); PG8_BAR; PG8_MMA(1, 1, At, B1); PG8_BAR;
            }
        }
        if constexpr (ALIGN_EPI) { if (wr == 0) PG8_BAR; }
        if constexpr (F8) asm volatile("s_nop 15\n\ts_nop 15\n\ts_nop 15" ::: "memory");
        if constexpr (!Epi::AFTER_DRAIN) { E(acc, cur, wr, wc, fr, fq); S.done(cur); }
        if (!has_next) break;
#pragma unroll
        for (int a = 0; a < 2; ++a)
#pragma unroll
            for (int b = 0; b < 2; ++b)
#pragma unroll
                for (int m = 0; m < 4; ++m)
#pragma unroll
                    for (int n = 0; n < 2; ++n) acc[a][b][m][n] = (f32x4){0.f, 0.f, 0.f, 0.f};
        cur = nxt; cA = nA; cB = nB; ++ui;
        if constexpr (ALIGN_EPI) { if (wr == 1) PG8_BAR; }
    }
    PG8_WAIT_V(0);
    if constexpr (!ALIGN_EPI) { if (wr == 0) PG8_BAR; }
    PG8_BAR;
    if constexpr (Epi::AFTER_DRAIN) { E.fused(acc, cur, wr, wc, fr, fq, lds, wid, lane); S.done(cur); }
#undef PG8_SA
#undef PG8_SB
#undef PG8_STAGE
#undef PG8_LD16
#undef PG8_LDA
#undef PG8_LDB
#undef PG8_MMA
#undef PG8_WAIT_V
#undef PG8_WAIT_L
#undef PG8_BAR
#undef PG8_SCHED
}
}

constexpr int NWAVES = 8;
constexpr int T = pg8::T, SEQ = pg8::SEQ, DM = pg8::DM, DIN = pg8::DIN, NE = 32, PLE = 256;
constexpr float EPS = pg8::EPS;
constexpr size_t MiB = 1u << 20;
constexpr size_t WS_CTL = 0, CTL_ZERO_BYTES = 1 * MiB;
constexpr size_t WS_WT_IN = 2 * MiB, WS_WT_OUT = 9 * MiB, WS_WT_PG = 11 * MiB, WS_WT_PP = 13 * MiB;
constexpr size_t WS_GAINS = 13 * MiB + 512 * 1024;
constexpr size_t WS_WRT = 13 * MiB + 576 * 1024;
constexpr size_t WS_ROPEC = 14 * MiB, WS_ROPES = 16 * MiB, WS_PB = 18 * MiB, WS_ROUTE = 26 * MiB;
constexpr size_t WS_WT_UG = 32 * MiB, WS_WT_DN = 160 * MiB;
constexpr size_t WS_XN = 224 * MiB;
constexpr size_t WS_HM = 256 * MiB;
constexpr size_t WS_RG = 352 * MiB;
constexpr size_t WS_Y = 368 * MiB;
constexpr size_t WS_PJ = 400 * MiB;
constexpr size_t WS_XS = 432 * MiB, WS_H = 576 * MiB, WS_YS = 720 * MiB;
constexpr size_t WS_END = 864 * MiB;
constexpr int CW_TMO = 0, CW_CODE = 1;
constexpr int CW_BAR = 4096;
constexpr int RING_OFF = 0, RING_BYTES = 131072;
constexpr int LDSCTL_OFF = RING_BYTES, MISC_OFF = LDSCTL_OFF + 320;
constexpr int PF_OFF = LDSCTL_OFF + 4096;
constexpr int LDS_BYTES = 147456;
#define GAS __attribute__((address_space(1)))
#define LAS __attribute__((address_space(3)))
typedef unsigned short bf16;
typedef unsigned v4u __attribute__((ext_vector_type(4)));
typedef float f32x4 __attribute__((ext_vector_type(4)));
typedef short bf16x8 __attribute__((ext_vector_type(8)));
typedef unsigned u32x4_t __attribute__((ext_vector_type(4)));
typedef unsigned u32x2_t __attribute__((ext_vector_type(2)));
typedef GAS unsigned gu32;
typedef GAS unsigned long long gu64;
#define RLX_AGENT __ATOMIC_RELAXED, __HIP_MEMORY_SCOPE_AGENT
#define LDS_WAIT() asm volatile("s_waitcnt lgkmcnt(0)" ::: "memory")
#define VM_WAIT() asm volatile("s_waitcnt vmcnt(0)" ::: "memory")
__device__ __forceinline__ unsigned long long rt() { return __builtin_amdgcn_s_memrealtime(); }
__device__ __forceinline__ unsigned f2bf(float f) { unsigned u = __builtin_bit_cast(unsigned, f); return (u + 0x7fffu + ((u >> 16) & 1u)) >> 16; }
__device__ __forceinline__ unsigned pk2(float lo, float hi) { return f2bf(lo) | (f2bf(hi) << 16); }

#define XB_TMO      128
#define XB_XCNT(j)  (256  + 64 * (j))
#define XB_XSUB(j)  (1280 + 64 * (j))
#define XB_XGEN(j)  (2304 + 64 * (j))
#define XB_TOP      3328
#define XB_TOPGEN   3392
#define XCD_BAR_WORDS 3456
#define XB_SPIN_CAP (1u << 18)

__device__ __forceinline__ unsigned xb_ld(unsigned* p)              { return __hip_atomic_load(p, __ATOMIC_RELAXED, __HIP_MEMORY_SCOPE_AGENT); }
__device__ __forceinline__ unsigned xb_add(unsigned* p, unsigned v) { return __hip_atomic_fetch_add(p, v, __ATOMIC_RELAXED, __HIP_MEMORY_SCOPE_AGENT); }
__device__ __forceinline__ unsigned xb_xcc_id() { return (unsigned)__builtin_amdgcn_s_getreg((3 << 11) | 20) & 0xFu; }
#define XB_SPIN(cond, bar) do { unsigned _sp = 0; while (cond) { __builtin_amdgcn_s_sleep(1); \
    if ((++_sp & 255u) == 0u) { if (xb_ld(&(bar)[XB_TMO])) break; if (_sp > XB_SPIN_CAP) { atomicAdd(&(bar)[XB_TMO], 1u); break; } } } } while (0)

struct XcdBarrier {
    unsigned* bar; unsigned x;
    volatile LAS unsigned* st;
};

__device__ __forceinline__ XcdBarrier xcd_barrier_post(unsigned* bar, volatile LAS unsigned* st) {
    XcdBarrier b; b.bar = bar; b.x = xb_xcc_id(); b.st = st;
    if (threadIdx.x == 0) (void)xb_add(&bar[XB_XCNT(b.x)], 1u);
    return b;
}
__device__ __forceinline__ void xcd_barrier_complete(unsigned* bar, unsigned x, unsigned& nloc, unsigned& nx) {
    const unsigned G = gridDim.x * gridDim.y * gridDim.z;
    unsigned sum, cnt, mine, sp = 0u;
    for (;;) {
        sum = 0u; cnt = 0u; mine = 0u;
#pragma unroll
        for (unsigned j = 0; j < 16; ++j) { const unsigned c = xb_ld(&bar[XB_XCNT(j)]); sum += c; cnt += (c > 0u) ? 1u : 0u; mine = (j == x) ? c : mine; }
        if (sum == G) break;
        __builtin_amdgcn_s_sleep(1);
        if ((++sp & 255u) == 0u) { if (xb_ld(&bar[XB_TMO])) break; if (sp > XB_SPIN_CAP) { atomicAdd(&bar[XB_TMO], 1u); break; } }
    }
    nloc = mine > 0u ? mine : 1u; nx = cnt > 0u ? cnt : 1u;
}

__device__ __forceinline__ void xcd_barrier(const XcdBarrier& b) {
    asm volatile("s_waitcnt vmcnt(0)" ::: "memory");
    __syncthreads();
    if (threadIdx.x == 0) {
        unsigned* bar = b.bar;
        __builtin_amdgcn_s_waitcnt(0);
        unsigned nloc = b.st[0], nx = b.st[1];
        if (nloc == 0u) { xcd_barrier_complete(bar, b.x, nloc, nx); b.st[0] = nloc; b.st[1] = nx; }
        const unsigned old = xb_add(&bar[XB_XSUB(b.x)], 1u);
        const unsigned gen = old / nloc;
        const unsigned tgen = gen;
        if (old + 1u == (gen + 1u) * nloc) {
            __builtin_amdgcn_fence(__ATOMIC_RELEASE, "agent");
            asm volatile("s_waitcnt vmcnt(0)" ::: "memory");
            const unsigned og = xb_add(&bar[XB_TOP], 1u);
            const unsigned tg = og / nx;
            if (og + 1u == (tg + 1u) * nx) xb_add(&bar[XB_TOPGEN], 1u);
            else XB_SPIN(xb_ld(&bar[XB_TOPGEN]) == tg, bar);
        } else {
            XB_SPIN(xb_ld(&bar[XB_TOPGEN]) == tgen, bar);
        }
        __builtin_amdgcn_fence(__ATOMIC_ACQUIRE, "agent");
        asm volatile("s_waitcnt vmcnt(0)" ::: "memory");
    }
    __syncthreads();
}

struct Args {
    const float* x; const float* p; const int* positions; const float* g_mix; const float* w_in;
    const float* sbq; const float* sbk; const float* rq; const float* rk; const float* gn_g; const float* gn_b; const float* w_out;
    const float* g_ffn; const float* w_r; const float* b_r; const float* w_ug; const float* b_ug; const float* w_dn; const float* b_dn;
    const float* g_ple; const float* w_pg; const float* w_pp;
    float* out; unsigned char* ws; int ph_lo, ph_hi;
};
struct Frame {
    LAS unsigned char* lds;
    volatile LAS unsigned* MISC;
    gu32* ctl;
    int wave;
    int vcu, G;
};
__device__ __forceinline__ int tid_now() { int t = threadIdx.x; asm volatile("" : "+v"(t)); return t; }
__device__ __forceinline__ float wave_sum(float v) {
#pragma unroll
    for (int o = 1; o < 64; o <<= 1) v += __shfl_xor(v, o);
    return v;
}
__device__ __forceinline__ unsigned cvtpk(float lo, float hi) { return pg8::cvt_pk_bf16(lo, hi); }

enum { MAP_NAT = 0, MAP_IN = 1, MAP_UG = 2 };
__device__ __forceinline__ void p0_item(const float* __restrict__ W, int N, int K, bf16* __restrict__ WT, int kb, int nb, int mapmode, LAS unsigned char* scr, int lane) {
    const int np = 64 * nb + 4 * (lane & 15);
    int src = np;
    if (mapmode == MAP_IN) { const int pn = np >> 8, L = np & 255, bj = L >> 7, wc = (L >> 5) & 3, e = L & 31; src = 256 * pn + 64 * wc + 32 * bj + e; }
    else if (mapmode == MAP_UG) { const int pn = np >> 8, L = np & 255, bj = L >> 7, i = L & 127; src = 1024 * bj + 128 * pn + i; }
    const float* gp = W + (size_t)(64 * kb + (lane >> 4)) * N + src;
    f32x4 v[16];
#pragma unroll
    for (int i = 0; i < 16; ++i) v[i] = *(const f32x4*)(gp + (size_t)(4 * i) * N);
#pragma unroll
    for (int i = 0; i < 16; ++i) {
        LAS unsigned* d = (LAS unsigned*)(scr + (4 * i + (lane >> 4)) * 132 + 8 * (lane & 15));
        d[0] = cvtpk(v[i][0], v[i][1]); d[1] = cvtpk(v[i][2], v[i][3]);
    }
    LDS_WAIT(); asm volatile("" ::: "memory");
    const int c = lane & 7;
#pragma unroll
    for (int it = 0; it < 4; ++it) {
        const int nl = 16 * it + 2 * (lane >> 3);
        unsigned d[8];
#pragma unroll
        for (int j = 0; j < 8; ++j) d[j] = *(const LAS unsigned*)(scr + (8 * c + j) * 132 + 2 * nl);
        v4u o0, o1;
        o0.x = (d[0] & 0xffffu) | (d[1] << 16); o0.y = (d[2] & 0xffffu) | (d[3] << 16); o0.z = (d[4] & 0xffffu) | (d[5] << 16); o0.w = (d[6] & 0xffffu) | (d[7] << 16);
        o1.x = (d[0] >> 16) | (d[1] & 0xffff0000u); o1.y = (d[2] >> 16) | (d[3] & 0xffff0000u); o1.z = (d[4] >> 16) | (d[5] & 0xffff0000u); o1.w = (d[6] >> 16) | (d[7] & 0xffff0000u);
        bf16* dst = WT + (size_t)(64 * nb + nl) * K + 64 * kb + 8 * c;
        *(v4u*)dst = o0; *(v4u*)(dst + K) = o1;
    }
    LDS_WAIT(); asm volatile("" ::: "memory");
}
__device__ __forceinline__ unsigned pk4_fp8(float a, float b, float c, float d) { int r = __builtin_amdgcn_cvt_pk_fp8_f32(a, b, 0, false); r = __builtin_amdgcn_cvt_pk_fp8_f32(c, d, r, true); return (unsigned)r; }
__device__ __forceinline__ void p0_item_f8(const float* __restrict__ W, int N, int K, unsigned char* __restrict__ WT, int kb, int nb, int mapmode, LAS unsigned char* scr, int lane) {
    const int np = 64 * nb + 4 * (lane & 15);
    int src = np;
    if (mapmode == MAP_UG) { const int pn = np >> 8, L = np & 255, bj = L >> 7, i = L & 127; src = 1024 * bj + 128 * pn + i; }
    const float* gp = W + (size_t)(64 * kb + (lane >> 4)) * N + src;
    f32x4 v[16];
#pragma unroll
    for (int i = 0; i < 16; ++i) v[i] = *(const f32x4*)(gp + (size_t)(4 * i) * N);
#pragma unroll
    for (int i = 0; i < 16; ++i) *(LAS unsigned*)(scr + (4 * i + (lane >> 4)) * 68 + 4 * (lane & 15)) = pk4_fp8(v[i][0] * 64.0f, v[i][1] * 64.0f, v[i][2] * 64.0f, v[i][3] * 64.0f);
    LDS_WAIT(); asm volatile("" ::: "memory");
    const int nq = lane & 15, kg = lane >> 4;
    unsigned d[16];
#pragma unroll
    for (int j = 0; j < 16; ++j) d[j] = *(const LAS unsigned*)(scr + (16 * kg + j) * 68 + 4 * nq);
#pragma unroll
    for (int t = 0; t < 4; ++t) {
        v4u o;
#pragma unroll
        for (int q = 0; q < 4; ++q) o[q] = ((d[4 * q] >> (8 * t)) & 0xffu) | (((d[4 * q + 1] >> (8 * t)) & 0xffu) << 8) | (((d[4 * q + 2] >> (8 * t)) & 0xffu) << 16) | (((d[4 * q + 3] >> (8 * t)) & 0xffu) << 24);
        *(v4u*)(WT + (size_t)(64 * nb + 4 * nq + t) * K + 64 * kb + 16 * kg) = o;
    }
    LDS_WAIT(); asm volatile("" ::: "memory");
}
struct P0D { const float* gp; int N, K, kb, nb; bf16* W16; unsigned char* W8; const float* rsc; };
__device__ __forceinline__ int p0_src_col(int np, int mapmode) {
    int src = np;
    if (mapmode == MAP_IN) { const int pn = np >> 8, L = np & 255, bj = L >> 7, wc = (L >> 5) & 3, e = L & 31; src = 256 * pn + 64 * wc + 32 * bj + e; }
    else if (mapmode == MAP_UG) { const int pn = np >> 8, L = np & 255, bj = L >> 7, i = L & 127; src = 1024 * bj + 128 * pn + i; }
    return src;
}
__device__ __forceinline__ P0D p0_mk(const float* W, int N, int K, bf16* W16, unsigned char* W8, int kb, int nb, int mapmode, int lane, const float* rsc = nullptr) {
    P0D d; d.N = N; d.K = K; d.kb = kb; d.nb = nb; d.W16 = W16; d.W8 = W8;
    if (W8) {
        d.rsc = rsc ? rsc + 128 * kb + (lane >> 3) : nullptr;
        d.gp = W + (size_t)(128 * kb + (lane >> 3)) * N + p0_src_col(32 * nb + 4 * (lane & 7), mapmode);
    } else {
        d.rsc = nullptr;
        d.gp = W + (size_t)(64 * kb + (lane >> 4)) * N + p0_src_col(64 * nb + 4 * (lane & 15), mapmode);
    }
    return d;
}
__device__ __forceinline__ void p0_load(const P0D& d, f32x4 (&v)[16]) {
#pragma unroll
    for (int i = 0; i < 16; ++i) v[i] = __builtin_nontemporal_load((const f32x4*)(d.gp + (size_t)((d.W8 ? 8 : 4) * i) * d.N));
}
__device__ __forceinline__ void p0_finish(const P0D& d, const f32x4 (&v)[16], LAS unsigned char* scr, int lane, const int pm = 0) {
    if (pm == 1) { _Pragma("unroll") for (int i = 0; i < 16; ++i) asm volatile("" :: "v"(v[i])); return; }
    if (d.W16) {
#pragma unroll
        for (int i = 0; i < 16; ++i) { LAS unsigned* q = (LAS unsigned*)(scr + (4 * i + (lane >> 4)) * 132 + 8 * (lane & 15)); q[0] = cvtpk(v[i][0], v[i][1]); q[1] = cvtpk(v[i][2], v[i][3]); }
        LDS_WAIT(); asm volatile("" ::: "memory");
        const int c = lane & 7;
#pragma unroll
        for (int it = 0; it < 4; ++it) {
            const int nl = 16 * it + 2 * (lane >> 3);
            unsigned x[8];
#pragma unroll
            for (int j = 0; j < 8; ++j) x[j] = *(const LAS unsigned*)(scr + (8 * c + j) * 132 + 2 * nl);
            v4u o0, o1;
            o0.x = (x[0] & 0xffffu) | (x[1] << 16); o0.y = (x[2] & 0xffffu) | (x[3] << 16); o0.z = (x[4] & 0xffffu) | (x[5] << 16); o0.w = (x[6] & 0xffffu) | (x[7] << 16);
            o1.x = (x[0] >> 16) | (x[1] & 0xffff0000u); o1.y = (x[2] >> 16) | (x[3] & 0xffff0000u); o1.z = (x[4] >> 16) | (x[5] & 0xffff0000u); o1.w = (x[6] >> 16) | (x[7] & 0xffff0000u);
            bf16* dst = d.W16 + (size_t)(64 * d.nb + nl) * d.K + 64 * d.kb + 8 * c;
            if (pm == 0 || pm == 3) { *(v4u*)dst = o0; *(v4u*)(dst + d.K) = o1; } else asm volatile("" :: "v"(o0), "v"(o1));
        }
    } else {
#pragma unroll
        for (int i = 0; i < 16; ++i) { const float sc = d.rsc ? d.rsc[8 * i] * 64.0f : 64.0f; *(LAS unsigned*)(scr + (8 * i + (lane >> 3)) * 36 + 4 * (lane & 7)) = pk4_fp8(v[i][0] * sc, v[i][1] * sc, v[i][2] * sc, v[i][3] * sc); }
        LDS_WAIT(); asm volatile("" ::: "memory");
        const int nq = lane & 7, kg = lane >> 3;
        unsigned x[16];
#pragma unroll
        for (int j = 0; j < 16; ++j) x[j] = *(const LAS unsigned*)(scr + (16 * kg + j) * 36 + 4 * nq);
#pragma unroll
        for (int t = 0; t < 4; ++t) {
            v4u o;
#pragma unroll
            for (int q = 0; q < 4; ++q) o[q] = ((x[4 * q] >> (8 * t)) & 0xffu) | (((x[4 * q + 1] >> (8 * t)) & 0xffu) << 8) | (((x[4 * q + 2] >> (8 * t)) & 0xffu) << 16) | (((x[4 * q + 3] >> (8 * t)) & 0xffu) << 24);
            if (pm == 0 || pm == 3) __builtin_nontemporal_store(o, (v4u*)(d.W8 + (size_t)(32 * d.nb + 4 * nq + t) * d.K + 128 * d.kb + 16 * kg)); else asm volatile("" :: "v"(o));
        }
    }
    LDS_WAIT(); asm volatile("" ::: "memory");
}
__device__ __forceinline__ P0D p0_decode(const Args& a, unsigned char* ws, int it, int lane) {
    constexpr int I_IN = 16 * 56, I_OUT = 256, I_PG = 256, I_PP = 4 * 16, I_UG = 16 * 32, I_DN = 256;
    int r = it;
    if (r < I_IN) return p0_mk(a.w_in, DIN, DM, (bf16*)(ws + WS_WT_IN), nullptr, r / 56, r % 56, MAP_IN, lane); r -= I_IN;
    if (r < I_OUT) return p0_mk(a.w_out, DM, DM, (bf16*)(ws + WS_WT_OUT), nullptr, r / 16, r % 16, MAP_NAT, lane); r -= I_OUT;
    if (r < I_PG) return p0_mk(a.w_pg, DM, DM, nullptr, (unsigned char*)(ws + WS_WT_PG), r / 32, r % 32, MAP_NAT, lane); r -= I_PG;
    if (r < I_PP) return p0_mk(a.w_pp, DM, PLE, (bf16*)(ws + WS_WT_PP), nullptr, r / 16, r % 16, MAP_NAT, lane); r -= I_PP;
    if (r < NE * I_UG) { const int e = r / I_UG, q = r % I_UG; return p0_mk(a.w_ug + (size_t)e * DM * 2048, 2048, DM, nullptr, (unsigned char*)(ws + WS_WT_UG) + (size_t)e * 2048 * DM, q / 64, q % 64, MAP_UG, lane, a.g_ffn); } r -= NE * I_UG;
    { const int e = r / I_DN, q = r % I_DN; return p0_mk(a.w_dn + (size_t)e * DM * DM, DM, DM, nullptr, (unsigned char*)(ws + WS_WT_DN) + (size_t)e * DM * DM, q / 32, q % 32, MAP_NAT, lane); }
}
__device__ __forceinline__ void rms_row_to_bf16(const float* xrow, const float* g, bf16* orow, int lane) {
    const f32x4* xr = (const f32x4*)xrow + lane;
    f32x4 v[4]; float s = 0.f;
#pragma unroll
    for (int j = 0; j < 4; ++j) { v[j] = xr[64 * j]; s += (v[j][0] * v[j][0] + v[j][1] * v[j][1]) + (v[j][2] * v[j][2] + v[j][3] * v[j][3]); }
    const float rstd = rsqrtf(wave_sum(s) * (1.f / DM) + EPS);
    unsigned long long* o8 = (unsigned long long*)orow + lane;
#pragma unroll
    for (int j = 0; j < 4; ++j) { const f32x4 gg = ((const f32x4*)g)[lane + 64 * j];
        o8[64 * j] = (unsigned long long)cvtpk(v[j][0] * rstd * gg[0], v[j][1] * rstd * gg[1]) | ((unsigned long long)cvtpk(v[j][2] * rstd * gg[2], v[j][3] * rstd * gg[3]) << 32); }
}
__device__ __forceinline__ void p0_prologue(Frame& F, const Args& a, const int pm = 0) {
    unsigned char* ws = a.ws; const int tid = tid_now(), lane = tid & 63;
    LAS unsigned char* scr = F.lds + RING_OFF + F.wave * 8448;
    const int gw = F.vcu * NWAVES + F.wave, NGW = F.G * NWAVES;
    constexpr int I_IN = 16 * 56, I_OUT = 256, I_PG = 256, I_PP = 4 * 16, I_UG = 16 * 32, I_DN = 256;
    constexpr int NITEMS = I_IN + I_OUT + I_PG + I_PP + NE * I_UG + NE * I_DN;
    if (gw < NITEMS) {
        int it = gw; P0D d0 = p0_decode(a, ws, it, lane), d1 = d0; f32x4 va[16], vb[16]; p0_load(d0, va);
        for (;;) {
            const int it1 = it + NGW; const bool h1 = it1 < NITEMS;
            if (h1) { d1 = p0_decode(a, ws, it1, lane); p0_load(d1, vb); }
            p0_finish(d0, va, scr, lane, pm);
            if (!h1) break;
            const int it2 = it1 + NGW; const bool h2 = it2 < NITEMS;
            if (h2) { d0 = p0_decode(a, ws, it2, lane); p0_load(d0, va); }
            p0_finish(d1, vb, scr, lane, pm);
            if (!h2) break;
            it = it2;
        }
    }
    if (pm != 0) return;
    if (blockIdx.x == 0 && tid < 256) { const int t = tid; const float* srcs = (t < 64) ? a.sbq : (t < 128) ? a.sbk : (t < 192) ? a.rq : a.rk; ((float*)(ws + WS_GAINS))[t] = srcs[t & 63]; }
    {
        f32x4 gg[4];
#pragma unroll
        for (int j = 0; j < 4; ++j) gg[j] = ((const f32x4*)a.g_mix)[lane + 64 * j];
        for (int m0 = 4 * gw; m0 < T; m0 += 4 * NGW) {
            f32x4 v[4][4];
#pragma unroll
            for (int r = 0; r < 4; ++r)
#pragma unroll
                for (int j = 0; j < 4; ++j) v[r][j] = __builtin_nontemporal_load((const f32x4*)(a.x + (size_t)(m0 + r) * DM) + lane + 64 * j);
#pragma unroll
            for (int r = 0; r < 4; ++r) {
                float ss = 0.f;
#pragma unroll
                for (int j = 0; j < 4; ++j) ss += (v[r][j][0] * v[r][j][0] + v[r][j][1] * v[r][j][1]) + (v[r][j][2] * v[r][j][2] + v[r][j][3] * v[r][j][3]);
                const float rstd = rsqrtf(wave_sum(ss) * (1.f / DM) + EPS);
                unsigned long long* o8 = (unsigned long long*)((bf16*)(ws + WS_XN) + (size_t)(m0 + r) * DM) + lane;
#pragma unroll
                for (int j = 0; j < 4; ++j) o8[64 * j] = (unsigned long long)cvtpk(v[r][j][0] * rstd * gg[j][0], v[r][j][1] * rstd * gg[j][1]) | ((unsigned long long)cvtpk(v[r][j][2] * rstd * gg[j][2], v[r][j][3] * rstd * gg[j][3]) << 32);
            }
        }
    }
    { const int gt = gw * 64 + lane, NGT = NGW * 64;
      for (int i0 = gt; i0 < T * PLE / 8; i0 += 4 * NGT) {
          f32x4 a0[4], a1[4];
#pragma unroll
          for (int q = 0; q < 4; ++q) { const int i = i0 + q * NGT; if (i < T * PLE / 8) { a0[q] = __builtin_nontemporal_load((const f32x4*)a.p + 2 * i); a1[q] = __builtin_nontemporal_load((const f32x4*)a.p + 2 * i + 1); } }
#pragma unroll
          for (int q = 0; q < 4; ++q) { const int i = i0 + q * NGT; if (i < T * PLE / 8) { v4u o; o.x = cvtpk(a0[q][0], a0[q][1]); o.y = cvtpk(a0[q][2], a0[q][3]); o.z = cvtpk(a1[q][0], a1[q][1]); o.w = cvtpk(a1[q][2], a1[q][3]); ((v4u*)(ws + WS_PB))[i] = o; } }
      }
      for (int i = gt; i < NE * DM; i += NGT) { const int e = i >> 10, k = i & (DM - 1); const float wv = a.w_r[(size_t)k * NE + e] * a.g_ffn[k];
          const unsigned hi = cvtpk(wv, 0.f) & 0xffffu; const unsigned lo = cvtpk(wv - __uint_as_float(hi << 16), 0.f) & 0xffffu;
          ((bf16*)(ws + WS_WRT))[i] = (bf16)hi; ((bf16*)(ws + WS_WRT))[NE * DM + i] = (bf16)lo; }
      float* rc = (float*)(ws + WS_ROPEC); float* rs = (float*)(ws + WS_ROPES);
      for (int i = gt; i < T * 32; i += NGT) { const int row = i >> 5, f = i & 31;
          const float inv_freq = exp2f(-(float)f * (13.287712379549449f / 32.0f));   const float ang = (float)a.positions[row] * inv_freq;
          float sn, cs; sincosf(ang, &sn, &cs); rc[i] = cs; rs[i] = sn; } }
}

namespace att {
typedef short bf16x8 __attribute__((ext_vector_type(8)));
typedef short s16x4 __attribute__((ext_vector_type(4)));
typedef float f32x16 __attribute__((ext_vector_type(16)));
typedef short v4i16_t __attribute__((ext_vector_type(4)));
constexpr int LK = 0, LV = 24576, LFLAG = 49152;
__device__ __forceinline__ s16x4 vtr(LAS const unsigned char* p) { return __builtin_bit_cast(s16x4, __builtin_amdgcn_ds_read_tr16_b64_v4i16((LAS v4i16_t*)p)); }
__device__ __forceinline__ int crow(int r, int hi) { return (r & 3) + 8 * (r >> 2) + 4 * hi; }
struct AttnArgs { const bf16* hm; const bf16* rg; bf16* Y; const float* gn_g; const float* gn_b; };

template <int MODE, int ABL = 0> __device__ __forceinline__ void attn_unit(LAS unsigned char* lds, const AttnArgs& A, int b, int h, int qb) {
    int tid_ = threadIdx.x; asm volatile("" : "+v"(tid_));
    const int tid = tid_, lane = tid & 63, r32 = lane & 31, hh = lane >> 5;
    const int w = __builtin_amdgcn_readfirstlane(tid >> 6);
    const int q0 = qb * 256, qw = q0 + 32 * w;
    const size_t TS = (size_t)T * 512;
    const size_t hoff = (size_t)(b * 8 + h) * SEQ * 64;
    const bf16* Qp = A.hm + (MODE == 0 ? 0 : 3) * TS + hoff;
    const bf16* Kp = A.hm + (MODE == 0 ? 1 : 4) * TS + hoff;
    const bf16* Vp = A.hm + (MODE == 0 ? 2 : 5) * TS + hoff;
    bf16x8 qf[4];
#pragma unroll
    for (int ds = 0; ds < 4; ++ds) qf[ds] = *(const bf16x8*)(Qp + (size_t)(qw + r32) * 64 + 16 * ds + 8 * hh);
    f32x16 o[2];
#pragma unroll
    for (int r = 0; r < 16; ++r) { o[0][r] = 0.f; o[1][r] = 0.f; }
    float carry = 1.0f;
    const int jmax = (q0 + 255) >> 6, jd = (qw + 31) >> 6;
    const float lg2g = __log2f(1.0f - __builtin_amdgcn_exp2f(-5.0f - (float)h));
    const int krow = 8 * w + (lane >> 3);
    const bf16* Kt = Kp + (size_t)krow * 64 + (((lane & 7) ^ ((krow >> 1) & 7)) << 3); const bf16* Vt = Vp + (size_t)w * 512 + lane * 8;
    volatile LAS unsigned* flags = (volatile LAS unsigned*)(lds + LFLAG);
#define ATT_DMA(t, so) do { __builtin_amdgcn_global_load_lds((const unsigned*)(Kt + (size_t)(t) * 4096), (LAS unsigned*)(lds + LK + (so) + w * 1024), 16, 0, 0); \
                            __builtin_amdgcn_global_load_lds((const unsigned*)(Vt + (size_t)(t) * 4096), (LAS unsigned*)(lds + LV + (so) + w * 1024), 16, 0, 0); } while (0)
    ATT_DMA(jmax, 0);
    if (jmax >= 1) { ATT_DMA(jmax - 1, 8192); asm volatile("s_waitcnt vmcnt(2)\n\ts_barrier" ::: "memory"); }
    else asm volatile("s_waitcnt vmcnt(0)\n\ts_barrier" ::: "memory");
    bool finished = false;
    int so_cur = 0, so_new = 16384;
    for (int j = jmax; j >= 0; --j) {
        const int cur = j & 1;
        if (j >= 2 && ABL != 4) ATT_DMA(j - 2, so_new);
        if (j <= jd && !finished && ABL == 0) {
            LAS const unsigned char* Kb = lds + LK + so_cur;
            LAS const unsigned char* Vb = lds + LV + so_cur;
            f32x16 p[2];
#pragma unroll
            for (int r = 0; r < 16; ++r) { p[0][r] = 0.f; p[1][r] = 0.f; }
            bf16x8 kf[4][2];
            const int ksw = (r32 >> 1) & 7;
#pragma unroll
            for (int ds = 0; ds < 4; ++ds) { kf[ds][0] = *(LAS const bf16x8*)(Kb + r32 * 128 + (((2 * ds + hh) ^ ksw) << 4)); kf[ds][1] = *(LAS const bf16x8*)(Kb + 4096 + r32 * 128 + (((2 * ds + hh) ^ ksw) << 4)); }
#pragma unroll
            for (int ds = 0; ds < 4; ++ds) {
                p[0] = __builtin_amdgcn_mfma_f32_32x32x16_bf16(kf[ds][0], qf[ds], p[0], 0, 0, 0);
                p[1] = __builtin_amdgcn_mfma_f32_32x32x16_bf16(kf[ds][1], qf[ds], p[1], 0, 0, 0);
            }
            const bool diag = (j == jd);
            const int qg = qw + r32, kv0 = 64 * j + 4 * hh;
            if (MODE == 0) {
                float om[2][16];
#pragma unroll
                for (int hf = 0; hf < 2; ++hf)
#pragma unroll
                    for (int r = 0; r < 16; ++r) {
                        const float Z = p[hf][r];
                        const float a = __builtin_amdgcn_exp2f(-__builtin_fabsf(Z));
                        const float rc = __builtin_amdgcn_rcpf(1.0f + a), ar = a * rc;
                        const bool pos = Z >= 0.f;
                        p[hf][r] = pos ? rc : ar;
                        om[hf][r] = pos ? ar : rc;
                    }
                if (diag) {
#pragma unroll
                    for (int hf = 0; hf < 2; ++hf)
#pragma unroll
                        for (int r = 0; r < 16; ++r) { const bool valid = kv0 + 32 * hf + (r & 3) + 8 * (r >> 2) < qg; p[hf][r] = valid ? p[hf][r] : 0.f; om[hf][r] = valid ? om[hf][r] : 1.0f; }
                }
                float gs[8], ot[8];
#pragma unroll
                for (int m = 0; m < 8; ++m) { const int hf = m >> 2, g = m & 3; gs[m] = (om[hf][4 * g] * om[hf][4 * g + 1]) * (om[hf][4 * g + 2] * om[hf][4 * g + 3]); ot[m] = __shfl_xor(gs[m], 32); }
                float ps[8];
                ps[7] = 1.0f;
#pragma unroll
                for (int m = 6; m >= 0; --m) ps[m] = ps[m + 1] * (gs[m + 1] * ot[m + 1]);
                const float total = ps[0] * (gs[0] * ot[0]);
#pragma unroll
                for (int m = 0; m < 8; ++m) {
                    const int hf = m >> 2, g = m & 3;
                    float tail = carry * (hh ? ps[m] : ps[m] * ot[m]);
#pragma unroll
                    for (int i = 3; i >= 0; --i) { const int r = 4 * g + i; const float o1 = om[hf][r]; p[hf][r] *= tail; tail *= o1; }
                }
                carry *= total;
                finished = __all(carry < 1.0e-37f);
            } else {
                const float ct = __builtin_amdgcn_exp2f(lg2g * (float)(qw - 64 * j));
#pragma unroll
                for (int hf = 0; hf < 2; ++hf)
#pragma unroll
                    for (int r = 0; r < 16; ++r) p[hf][r] *= ct;
                if (diag) {
#pragma unroll
                    for (int hf = 0; hf < 2; ++hf)
#pragma unroll
                        for (int r = 0; r < 16; ++r) { const bool valid = kv0 + 32 * hf + (r & 3) + 8 * (r >> 2) <= qg; p[hf][r] = valid ? p[hf][r] : 0.f; }
                }
            }
            {
                const unsigned vbase = (unsigned)(uintptr_t)(Vb + (4 * hh + ((lane & 15) >> 2)) * 128 + (16 * ((lane >> 4) & 1) + 4 * (lane & 3)) * 2);
                s16x4 vl[2][2][2], vh[2][2][2];
#pragma unroll
                for (int hf = 0; hf < 2; ++hf)
#pragma unroll
                    for (int s = 0; s < 2; ++s)
#pragma unroll
                        for (int d0 = 0; d0 < 2; ++d0) {
                            asm volatile("ds_read_b64_tr_b16 %0, %1 offset:%c2" : "=&v"(vl[hf][s][d0]) : "v"(vbase), "i"(hf * 4096 + s * 2048 + d0 * 64) : "memory");
                            asm volatile("ds_read_b64_tr_b16 %0, %1 offset:%c2" : "=&v"(vh[hf][s][d0]) : "v"(vbase), "i"(hf * 4096 + s * 2048 + d0 * 64 + 1024) : "memory");
                        }
                bf16x8 wfr[2][2];
#pragma unroll
                for (int hf = 0; hf < 2; ++hf)
#pragma unroll
                    for (int s = 0; s < 2; ++s) {
                        u32x4_t wq;
                        wq.x = pg8::cvt_pk_bf16(p[hf][8 * s + 0], p[hf][8 * s + 1]); wq.y = pg8::cvt_pk_bf16(p[hf][8 * s + 2], p[hf][8 * s + 3]);
                        wq.z = pg8::cvt_pk_bf16(p[hf][8 * s + 4], p[hf][8 * s + 5]); wq.w = pg8::cvt_pk_bf16(p[hf][8 * s + 6], p[hf][8 * s + 7]);
                        wfr[hf][s] = __builtin_bit_cast(bf16x8, wq);
                    }
                asm volatile("s_waitcnt lgkmcnt(0)" ::: "memory"); __builtin_amdgcn_sched_barrier(0);
#pragma unroll
                for (int hf = 0; hf < 2; ++hf)
#pragma unroll
                    for (int s = 0; s < 2; ++s)
#pragma unroll
                        for (int d0 = 0; d0 < 2; ++d0) {
                            const s16x4 lo = vl[hf][s][d0], hi = vh[hf][s][d0];
                            const bf16x8 vf = (bf16x8){lo[0], lo[1], lo[2], lo[3], hi[0], hi[1], hi[2], hi[3]};
                            o[d0] = __builtin_amdgcn_mfma_f32_32x32x16_bf16(vf, wfr[hf][s], o[d0], 0, 0, 0);
                        }
            }
        }
        if (MODE == 0) { if (lane == 0) flags[cur * 8 + w] = finished ? 1u : 0u; }
        if (j >= 2) asm volatile("s_waitcnt vmcnt(2) lgkmcnt(0)\n\ts_barrier" ::: "memory"); else asm volatile("s_waitcnt vmcnt(0) lgkmcnt(0)\n\ts_barrier" ::: "memory");
        so_cur = (so_cur == 16384) ? 0 : so_cur + 8192; so_new = (so_new == 16384) ? 0 : so_new + 8192;
        if (MODE == 0) {
            unsigned all = 1u;
#pragma unroll
            for (int i = 0; i < 8; ++i) all &= flags[cur * 8 + i];
            if (all) break;
        }
    }
    asm volatile("s_waitcnt vmcnt(0)\n\ts_barrier" ::: "memory");
#undef ATT_DMA
    const int row = b * SEQ + qw + r32;
    if (MODE == 0) {
        bf16* yp = A.Y + (size_t)row * DM + h * 64 + 4 * hh;
#pragma unroll
        for (int d0 = 0; d0 < 2; ++d0)
#pragma unroll
            for (int g = 0; g < 4; ++g) { u32x2_t v; v.x = pg8::cvt_pk_bf16(o[d0][4 * g], o[d0][4 * g + 1]); v.y = pg8::cvt_pk_bf16(o[d0][4 * g + 2], o[d0][4 * g + 3]); *(u32x2_t*)(yp + 32 * d0 + 8 * g) = v; }
    } else {
        float s1 = 0.f;
#pragma unroll
        for (int r = 0; r < 16; ++r) s1 += o[0][r] + o[1][r];
        s1 += __shfl_xor(s1, 32);
        const float mu = s1 * (1.0f / 64.0f);
        float s2 = 0.f;
#pragma unroll
        for (int r = 0; r < 16; ++r) { const float a0 = o[0][r] - mu, a1 = o[1][r] - mu; s2 += a0 * a0 + a1 * a1; }
        s2 += __shfl_xor(s2, 32);
        const float rstd = rsqrtf(s2 * (1.0f / 64.0f) + EPS);
        bf16* yp = A.Y + (size_t)row * DM + 512 + h * 64 + 4 * hh;
        const bf16* gp = A.rg + (size_t)row * 512 + h * 64 + 4 * hh;
        const float* gg = A.gn_g + h * 64 + 4 * hh; const float* gb = A.gn_b + h * 64 + 4 * hh;
#pragma unroll
        for (int d0 = 0; d0 < 2; ++d0)
#pragma unroll
            for (int g = 0; g < 4; ++g) {
                const f32x4 gn = *(const f32x4*)(gg + 32 * d0 + 8 * g), bs = *(const f32x4*)(gb + 32 * d0 + 8 * g);
                const u32x2_t gr = *(const u32x2_t*)(gp + 32 * d0 + 8 * g);
                float gate[4] = {__uint_as_float(gr.x << 16), __uint_as_float(gr.x & 0xffff0000u), __uint_as_float(gr.y << 16), __uint_as_float(gr.y & 0xffff0000u)};
                float ov[4];
#pragma unroll
                for (int i = 0; i < 4; ++i) { const float yn = (o[d0][4 * g + i] - mu) * rstd * gn[i] + bs[i]; const float sg = gate[i] / (1.0f + __expf(-gate[i])); ov[i] = yn * sg; }
                u32x2_t v; v.x = pg8::cvt_pk_bf16(ov[0], ov[1]); v.y = pg8::cvt_pk_bf16(ov[2], ov[3]); *(u32x2_t*)(yp + 32 * d0 + 8 * g) = v;
            }
    }
}
__device__ __forceinline__ void attn_phase(LAS unsigned char* lds, const AttnArgs& A, int vcu, int dup, bf16* dummyY) {
    const int g = vcu >> 5, local = vcu & 31;
    if (dup == 24 || dup == 25) { AttnArgs A2 = A; A2.Y = dummyY;
#pragma unroll 1
        for (int u = 0; u < 2; ++u) { const int bh = 8 * g + 4 * (u & 1) + (local >> 3), qb = (u & 1) ? 7 - (local & 7) : (local & 7); if (dup == 24) attn_unit<1, 3>(lds, A2, bh >> 3, bh & 7, qb); else attn_unit<1, 4>(lds, A2, bh >> 3, bh & 7, qb); } }
#pragma unroll 1
    for (int u = 0; u < ((dup == 20) ? 4 : 2); ++u) { const int bh = 8 * g + 4 * (u & 1) + (local >> 3), qb = (u & 1) ? 7 - (local & 7) : (local & 7); attn_unit<1>(lds, A, bh >> 3, bh & 7, qb); }
#pragma unroll 1
    for (int u = 0; u < ((dup == 21) ? 4 : 2); ++u) { const int bh = 8 * g + 4 * (u & 1) + (local >> 3), qb = (u & 1) ? 7 - (local & 7) : (local & 7); attn_unit<0>(lds, A, bh >> 3, bh & 7, qb); }
}
}

constexpr int CW_GCNT = 2048;
constexpr int LR_LCNT = LDSCTL_OFF + 1024, LR_GBASE = LDSCTL_OFF + 1152;
constexpr int LT_POFF = LDSCTL_OFF + 2048, LT_NT = LDSCTL_OFF + 2176, LT_TILE_E = LDSCTL_OFF + 2304;
struct RouteBufs { int* tok_e; int* tok_slot; float* tok_gate; float* rstd; float* slot_rstd; };
__device__ __forceinline__ RouteBufs route_bufs(unsigned char* ws) { RouteBufs r; r.tok_e = (int*)(ws + WS_ROUTE); r.tok_slot = r.tok_e + T * 4; r.tok_gate = (float*)(r.tok_slot + T * 4); r.rstd = (float*)(ws + WS_ROUTE + 1 * MiB); r.slot_rstd = (float*)(ws + WS_ROUTE + 2 * MiB); return r; }
typedef float f32x2v __attribute__((ext_vector_type(2)));
__device__ __forceinline__ unsigned opq_mask(bool c) { unsigned m = c ? 0xffffffffu : 0u; asm volatile("" : "+v"(m)); return m; }
__device__ __forceinline__ float blendf(unsigned m, float a, float b) { return __uint_as_float((__float_as_uint(a) & m) | (__float_as_uint(b) & ~m)); }
__device__ __forceinline__ int blendi(unsigned m, int a, int b) { return (int)(((unsigned)a & m) | ((unsigned)b & ~m)); }

#define SW2(c, a, b) { const float ta_ = (c) ? (b) : (a), tb_ = (c) ? (a) : (b); a = ta_; b = tb_; }
#define SW2I(c, a, b) { const int ta_ = (c) ? (b) : (a), tb_ = (c) ? (a) : (b); a = ta_; b = tb_; }
#define TOP4_INSERT(x, e) { const float x_ = (x); const int e_ = (e); const bool c3_ = (x_ > v3) || (x_ == v3 && e_ < i3); v3 = c3_ ? x_ : v3; i3 = c3_ ? e_ : i3; \
    const bool c2_ = (v3 > v2) || (v3 == v2 && i3 < i2); SW2(c2_, v2, v3) SW2I(c2_, i2, i3) const bool c1_ = (v2 > v1) || (v2 == v1 && i2 < i1); SW2(c1_, v1, v2) SW2I(c1_, i1, i2) \
    const bool c0_ = (v1 > v0) || (v1 == v0 && i1 < i0); SW2(c0_, v0, v1) SW2I(c0_, i0, i1) }
__device__ __forceinline__ void router_phase(Frame& F, const Args& a, const bool dry = false) {
    unsigned char* ws = a.ws; const int tid = tid_now();
    LAS unsigned char* lds = F.lds;
    const int lane = tid & 63, r32 = lane & 31, hh = lane >> 5, w = F.wave, rg = w >> 2, kq = w & 3;
    volatile LAS unsigned* lcnt = (volatile LAS unsigned*)(lds + LR_LCNT);
    volatile LAS unsigned* gbase = (volatile LAS unsigned*)(lds + LR_GBASE);
    if (tid < 32) lcnt[tid] = 0u;
    const RouteBufs R = route_bufs(dry ? ws + 3 * MiB : ws);
    const int row = F.vcu * 64 + 32 * rg + r32;
    const float* xr = a.out + (size_t)row * DM + 256 * kq + 8 * hh;
    const bf16* wt = (const bf16*)(ws + WS_WRT) + (size_t)r32 * DM + 256 * kq + 8 * hh;
    unsigned char* hp = (unsigned char*)(ws + (dry ? WS_H : WS_XN)) + (size_t)row * DM + 256 * kq + 8 * hh;
    att::f32x16 D;
#pragma unroll
    for (int r = 0; r < 16; ++r) D[r] = 0.f;
    float ss = 0.f;
#pragma unroll 8
    for (int ks = 0; ks < 16; ++ks) {
        const f32x4 v0 = *(const f32x4*)(xr + 16 * ks), v1 = *(const f32x4*)(xr + 16 * ks + 4);
        ss += ((v0[0] * v0[0] + v0[1] * v0[1]) + (v0[2] * v0[2] + v0[3] * v0[3])) + ((v1[0] * v1[0] + v1[1] * v1[1]) + (v1[2] * v1[2] + v1[3] * v1[3]));
        u32x2_t h8; h8.x = pk4_fp8(v0[0], v0[1], v0[2], v0[3]); h8.y = pk4_fp8(v1[0], v1[1], v1[2], v1[3]); *(u32x2_t*)(hp + 16 * ks) = h8;
        u32x4_t xh, xl;
        xh.x = cvtpk(v0[0], v0[1]); xh.y = cvtpk(v0[2], v0[3]); xh.z = cvtpk(v1[0], v1[1]); xh.w = cvtpk(v1[2], v1[3]);
        xl.x = cvtpk(v0[0] - __uint_as_float(xh.x << 16), v0[1] - __uint_as_float(xh.x & 0xffff0000u)); xl.y = cvtpk(v0[2] - __uint_as_float(xh.y << 16), v0[3] - __uint_as_float(xh.y & 0xffff0000u));
        xl.z = cvtpk(v1[0] - __uint_as_float(xh.z << 16), v1[1] - __uint_as_float(xh.z & 0xffff0000u)); xl.w = cvtpk(v1[2] - __uint_as_float(xh.w << 16), v1[3] - __uint_as_float(xh.w & 0xffff0000u));
        const att::bf16x8 whi = *(const att::bf16x8*)(wt + 16 * ks), wlo = *(const att::bf16x8*)(wt + 32 * DM + 16 * ks);
        const att::bf16x8 bxh = __builtin_bit_cast(att::bf16x8, xh), bxl = __builtin_bit_cast(att::bf16x8, xl);
        D = __builtin_amdgcn_mfma_f32_32x32x16_bf16(whi, bxh, D, 0, 0, 0);
        D = __builtin_amdgcn_mfma_f32_32x32x16_bf16(wlo, bxh, D, 0, 0, 0);
        D = __builtin_amdgcn_mfma_f32_32x32x16_bf16(whi, bxl, D, 0, 0, 0);
    }
    { LAS f32x4* dp = (LAS f32x4*)(lds + (w * 64 + lane) * 64);
#pragma unroll
      for (int q = 0; q < 4; ++q) dp[q] = (f32x4){D[4 * q], D[4 * q + 1], D[4 * q + 2], D[4 * q + 3]};
      *(LAS float*)(lds + 32768 + (w * 64 + lane) * 4) = ss; }
    __syncthreads();
    int my_e0 = 0, my_e1 = 0, rk0 = 0, rk1 = 0; float my_g0 = 0.f, my_g1 = 0.f;
    if (kq == 0) {
#pragma unroll
        for (int o = 1; o < 4; ++o) { LAS const f32x4* dp = (LAS const f32x4*)(lds + ((w + o) * 64 + lane) * 64);
#pragma unroll
            for (int q = 0; q < 4; ++q) { const f32x4 t = dp[q]; D[4 * q] += t[0]; D[4 * q + 1] += t[1]; D[4 * q + 2] += t[2]; D[4 * q + 3] += t[3]; }
            ss += *(LAS const float*)(lds + 32768 + ((w + o) * 64 + lane) * 4); }
        ss += __shfl_xor(ss, 32);
        const float rstd = rsqrtf(ss * (1.f / DM) + EPS);
        if (hh == 0) R.rstd[row] = rstd;
        float l[16];
#pragma unroll
        for (int r = 0; r < 16; ++r) l[r] = D[r] * rstd + a.b_r[(r & 3) + 8 * (r >> 2) + 4 * hh];
        float c[8]; int ci[8];
#pragma unroll
        for (int k = 0; k < 4; ++k) {
            float bv = -INFINITY; int bi = 99;
#pragma unroll
            for (int r = 0; r < 16; ++r) { const int e = (r & 3) + 8 * (r >> 2) + 4 * hh; const bool bt = l[r] > bv; bv = bt ? l[r] : bv; bi = bt ? e : bi; }
            c[k] = bv; ci[k] = bi;
#pragma unroll
            for (int r = 0; r < 16; ++r) { const int e = (r & 3) + 8 * (r >> 2) + 4 * hh; l[r] = (e == bi) ? -INFINITY : l[r]; }
        }
#pragma unroll
        for (int k = 0; k < 4; ++k) { c[4 + k] = __shfl_xor(c[k], 32); ci[4 + k] = __shfl_xor(ci[k], 32); }
        float tv[4]; int ti[4];
#pragma unroll
        for (int k = 0; k < 4; ++k) {
            float bv = -INFINITY; int bi = 99;
#pragma unroll
            for (int j = 0; j < 8; ++j) { const bool bt = (c[j] > bv) || (c[j] == bv && ci[j] < bi); bv = bt ? c[j] : bv; bi = bt ? ci[j] : bi; }
            tv[k] = bv; ti[k] = bi;
#pragma unroll
            for (int j = 0; j < 8; ++j) c[j] = (ci[j] == bi) ? -INFINITY : c[j];
        }
        const float v0 = tv[0], v1 = tv[1], v2 = tv[2], v3 = tv[3]; const int i0 = ti[0], i1 = ti[1], i2 = ti[2], i3 = ti[3];
        const float e1 = __expf(v1 - v0), e2 = __expf(v2 - v0), e3 = __expf(v3 - v0), inv = 1.0f / (1.0f + e1 + e2 + e3);
        my_e0 = hh ? i2 : i0; my_e1 = hh ? i3 : i1; my_g0 = (hh ? e2 : 1.0f) * inv; my_g1 = (hh ? e3 : e1) * inv;
        rk0 = (int)__hip_atomic_fetch_add((LAS unsigned*)(lds + LR_LCNT) + my_e0, 1u, __ATOMIC_RELAXED, __HIP_MEMORY_SCOPE_WORKGROUP);
        rk1 = (int)__hip_atomic_fetch_add((LAS unsigned*)(lds + LR_LCNT) + my_e1, 1u, __ATOMIC_RELAXED, __HIP_MEMORY_SCOPE_WORKGROUP);
    }
    __syncthreads();
    if (tid < 32) gbase[tid] = __hip_atomic_fetch_add((unsigned*)(F.ctl + CW_GCNT + (dry ? 64 : 0)) + tid, lcnt[tid], __ATOMIC_RELAXED, __HIP_MEMORY_SCOPE_AGENT);
    __syncthreads();
    if (kq == 0) {
        const int k0 = 2 * hh;
        R.tok_e[row * 4 + k0] = my_e0; R.tok_slot[row * 4 + k0] = (int)gbase[my_e0] + rk0; R.tok_gate[row * 4 + k0] = my_g0;
        R.tok_e[row * 4 + k0 + 1] = my_e1; R.tok_slot[row * 4 + k0 + 1] = (int)gbase[my_e1] + rk1; R.tok_gate[row * 4 + k0 + 1] = my_g1;
    }
}
#undef SW2
#undef SW2I
#undef TOP4_INSERT

__device__ __forceinline__ void build_tables(Frame& F) {
    LAS int* poff = (LAS int*)(F.lds + LT_POFF); LAS int* ntp = (LAS int*)(F.lds + LT_NT); LAS int* tile_e = (LAS int*)(F.lds + LT_TILE_E);
    LAS int* cnts = (LAS int*)(F.lds + LR_LCNT); const int tid = tid_now();
    if (tid < NE) cnts[tid] = (int)__hip_atomic_load((unsigned*)(F.ctl + CW_GCNT) + tid, __ATOMIC_RELAXED, __HIP_MEMORY_SCOPE_AGENT);
    __syncthreads();
    if (tid == 0) {
        int t = 0;
        for (int e = 0; e < NE; ++e) { const int c = cnts[e]; const int nt = (c + 255) >> 8; poff[e] = t * 256; for (int i = 0; i < nt; ++i) tile_e[t + i] = e; t += nt; }
        *ntp = t;
    }
    __syncthreads();
}
__device__ __forceinline__ void gather_phase(Frame& F, const Args& a) {
    unsigned char* ws = a.ws; const int lane = tid_now() & 63; const RouteBufs R = route_bufs(ws);
    LAS const int* poff = (LAS const int*)(F.lds + LT_POFF);
    const int gw = F.vcu * NWAVES + F.wave, NGW = F.G * NWAVES;
    for (int m0 = 4 * gw; m0 < T; m0 += 4 * NGW) {
        v4u h0[4]; float rs[4]; int dsts[4][4];
#pragma unroll
        for (int r = 0; r < 4; ++r) { const int m = m0 + r; h0[r] = __builtin_nontemporal_load((const v4u*)((const unsigned char*)(ws + WS_XN) + (size_t)m * DM) + lane); rs[r] = R.rstd[m];
#pragma unroll
            for (int k = 0; k < 4; ++k) dsts[r][k] = poff[R.tok_e[m * 4 + k]] + R.tok_slot[m * 4 + k]; }
#pragma unroll
        for (int r = 0; r < 4; ++r)
#pragma unroll
            for (int k = 0; k < 4; ++k) { ((v4u*)((unsigned char*)(ws + WS_XS) + (size_t)dsts[r][k] * DM))[lane] = h0[r]; if (lane == 0) R.slot_rstd[dsts[r][k]] = rs[r]; }
    }
}
__device__ __forceinline__ void combine_phase(Frame& F, const Args& a, const bool dry = false) {
    unsigned char* ws = a.ws; const RouteBufs R = route_bufs(ws);
    LAS const int* poff = (LAS const int*)(F.lds + LT_POFF);
    const int gw = F.vcu * NWAVES + F.wave, NGW = F.G * NWAVES, lane = tid_now() & 63;
    for (int m0 = 2 * gw; m0 < T; m0 += 2 * NGW) {
        f32x4 v[2][2][2]; u32x2_t y[2][4][2]; float gt[2][4];
#pragma unroll
        for (int rr = 0; rr < 2; ++rr) { const int m = m0 + rr;
#pragma unroll
            for (int i = 0; i < 2; ++i) { v[rr][i][0] = __builtin_nontemporal_load((const f32x4*)(a.out + (size_t)m * DM + 8 * lane + 512 * i)); v[rr][i][1] = __builtin_nontemporal_load((const f32x4*)(a.out + (size_t)m * DM + 8 * lane + 512 * i + 4)); }
#pragma unroll
            for (int k = 0; k < 4; ++k) { const int e = R.tok_e[m * 4 + k], slot = R.tok_slot[m * 4 + k]; gt[rr][k] = R.tok_gate[m * 4 + k];
                const unsigned char* yr = (const unsigned char*)(ws + WS_YS) + (size_t)(poff[e] + slot) * DM + 8 * lane;
                y[rr][k][0] = __builtin_nontemporal_load((const u32x2_t*)yr); y[rr][k][1] = __builtin_nontemporal_load((const u32x2_t*)(yr + 512)); } }
#pragma unroll
        for (int rr = 0; rr < 2; ++rr) { const int m = m0 + rr;
#pragma unroll
            for (int k = 0; k < 4; ++k)
#pragma unroll
                for (int i = 0; i < 2; ++i) { const u32x2_t yy = y[rr][k][i]; const float g = gt[rr][k];
                    const f32x2v a0 = __builtin_amdgcn_cvt_pk_f32_fp8((int)yy.x, false), a1 = __builtin_amdgcn_cvt_pk_f32_fp8((int)yy.x, true), a2 = __builtin_amdgcn_cvt_pk_f32_fp8((int)yy.y, false), a3 = __builtin_amdgcn_cvt_pk_f32_fp8((int)yy.y, true);
                    v[rr][i][0][0] += g * a0[0]; v[rr][i][0][1] += g * a0[1]; v[rr][i][0][2] += g * a1[0]; v[rr][i][0][3] += g * a1[1];
                    v[rr][i][1][0] += g * a2[0]; v[rr][i][1][1] += g * a2[1]; v[rr][i][1][2] += g * a3[0]; v[rr][i][1][3] += g * a3[1]; }
            float ss = 0.f;
#pragma unroll
            for (int i = 0; i < 2; ++i)
#pragma unroll
                for (int q = 0; q < 2; ++q) { const f32x4 t = v[rr][i][q]; ss += (t[0] * t[0] + t[1] * t[1]) + (t[2] * t[2] + t[3] * t[3]); }
            const float rstd = rsqrtf(wave_sum(ss) * (1.f / DM) + EPS);
            unsigned char* np = (unsigned char*)(ws + (dry ? WS_H : WS_XN)) + (size_t)m * DM + 8 * lane; bf16* ow = (bf16*)(ws + (dry ? WS_XS : WS_Y));
#pragma unroll
            for (int i = 0; i < 2; ++i) { { v4u xb; xb[0] = cvtpk(v[rr][i][0][0], v[rr][i][0][1]); xb[1] = cvtpk(v[rr][i][0][2], v[rr][i][0][3]); xb[2] = cvtpk(v[rr][i][1][0], v[rr][i][1][1]); xb[3] = cvtpk(v[rr][i][1][2], v[rr][i][1][3]); *(v4u*)(ow + (size_t)m * DM + 8 * lane + 512 * i) = xb; }
                const f32x4 g0 = *(const f32x4*)(a.g_ple + 8 * lane + 512 * i), g1 = *(const f32x4*)(a.g_ple + 8 * lane + 512 * i + 4);
                u32x2_t o; o.x = pk4_fp8(v[rr][i][0][0] * rstd * g0[0], v[rr][i][0][1] * rstd * g0[1], v[rr][i][0][2] * rstd * g0[2], v[rr][i][0][3] * rstd * g0[3]);
                o.y = pk4_fp8(v[rr][i][1][0] * rstd * g1[0], v[rr][i][1][1] * rstd * g1[1], v[rr][i][1][2] * rstd * g1[2], v[rr][i][1][3] * rstd * g1[3]);
                *(u32x2_t*)(np + 512 * i) = o; } }
    }
}

__global__ void __launch_bounds__(NWAVES * 64, 2) mega_fwd(Args args) {
    extern __shared__ __attribute__((aligned(16))) unsigned char lds[];
    Frame F;
    F.lds = (LAS unsigned char*)lds;
    F.MISC = (volatile LAS unsigned*)(F.lds + MISC_OFF);
    F.wave = __builtin_amdgcn_readfirstlane(threadIdx.x >> 6);
    F.G = gridDim.x; { const int bx = blockIdx.x; F.vcu = (F.G % 8 == 0) ? (bx % 8) * (F.G / 8) + bx / 8 : bx; }
    unsigned char* ws = args.ws;
    F.ctl = (gu32*)(ws + WS_CTL);
    for (int u = threadIdx.x; u < (LDS_BYTES - LDSCTL_OFF) / 4; u += NWAVES * 64) ((LAS unsigned*)(F.lds + LDSCTL_OFF))[u] = 0u;
    __syncthreads();
    XcdBarrier bar = xcd_barrier_post((unsigned*)(F.ctl + CW_BAR), F.MISC + 8);
    const int lo = args.ph_lo, hi = args.ph_hi;
#define IN(k) (lo <= (k) && (k) < hi)
#define GRID_BAR() xcd_barrier(bar)
#ifndef DUP_PHASE
#define DUP_PHASE -1
#endif
#define REP(k) for (int rep_ = 0; rep_ < ((DUP_PHASE) == (k) ? 2 : 1); ++rep_)

    if (IN(0)) { if (DUP_PHASE == 40) { p0_prologue(F, args, 1); GRID_BAR(); } if (DUP_PHASE == 41) { p0_prologue(F, args, 2); GRID_BAR(); } if (DUP_PHASE == 42) { p0_prologue(F, args, 3); GRID_BAR(); } REP(0) { p0_prologue(F, args); GRID_BAR(); } }

    if (IN(1)) REP(1) {
        pg8::Gemm g{(const pg8::bf16_t*)(ws + WS_XN), (const pg8::bf16_t*)(ws + WS_WT_IN), DM, 0};
        pg8::StaticOrder S; S.init(T / 256, DIN / 256, F.G, (int)blockIdx.x);
        pg8::EpiProj E{(pg8::bf16_t*)(ws + WS_HM), (pg8::bf16_t*)(ws + WS_RG), (const float*)(ws + WS_GAINS), (const float*)(ws + WS_ROPEC), (const float*)(ws + WS_ROPES)};
        pg8::gemm_phase<pg8::EpiProj, pg8::StaticOrder, true, true>(F.lds + RING_OFF, g, S, E);
        {
            const int G2 = (F.G == 256) ? 128 : F.G, c2 = (F.G == 256) ? (int)blockIdx.x - 128 : (int)blockIdx.x;
            if (c2 >= 0) {
                pg8::Gemm g2{(const pg8::bf16_t*)(ws + WS_PB), (const pg8::bf16_t*)(ws + WS_WT_PP), PLE, 0};
                pg8::StaticOrder S2; S2.init(T / 256, DM / 256, G2, c2);
                pg8::EpiBf16Plain E2{(pg8::bf16_t*)(ws + WS_PJ), DM};
                pg8::gemm_phase<pg8::EpiBf16Plain, pg8::StaticOrder, true, true>(F.lds + RING_OFF, g2, S2, E2);
            }
        }
        GRID_BAR();
    }
    if (DUP_PHASE == 51 && IN(1)) {
        pg8::Gemm g{(const pg8::bf16_t*)(ws + WS_XN), (const pg8::bf16_t*)(ws + WS_WT_IN), DM, 0};
        pg8::StaticOrder S; S.init(T / 256, DIN / 256, F.G, (int)blockIdx.x);
        pg8::EpiNull E;
        pg8::gemm_phase<pg8::EpiNull, pg8::StaticOrder, true, true>(F.lds + RING_OFF, g, S, E);
        GRID_BAR();
    }
    if (IN(2)) REP(2) {
        if (F.G == 256) {
            const att::AttnArgs AA{(const bf16*)(ws + WS_HM), (const bf16*)(ws + WS_RG), (bf16*)(ws + WS_Y), args.gn_g, args.gn_b};
            att::attn_phase(F.lds + RING_OFF, AA, F.vcu, DUP_PHASE, (bf16*)(ws + WS_XS));
        }
        GRID_BAR();
    }
    if (IN(3)) REP(3) {
        pg8::Gemm g{(const pg8::bf16_t*)(ws + WS_Y), (const pg8::bf16_t*)(ws + WS_WT_OUT), DM, 0};
        pg8::StaticOrder S; S.init(T / 256, DM / 256, F.G, (int)blockIdx.x);
        pg8::EpiResid E{args.x, args.out};
        pg8::gemm_phase<pg8::EpiResid, pg8::StaticOrder, true, true>(F.lds + RING_OFF, g, S, E);
        GRID_BAR();
    }
    if (DUP_PHASE == 30 && IN(3)) { GRID_BAR(); GRID_BAR(); GRID_BAR(); GRID_BAR(); }
    if (IN(4)) { if (DUP_PHASE == 4) { if (F.G == 256) router_phase(F, args, true); GRID_BAR(); } if (F.G == 256) router_phase(F, args); GRID_BAR(); }
    if (IN(5) || (lo >= 6 && lo <= 8)) build_tables(F);
    if (IN(5)) REP(5) { gather_phase(F, args); GRID_BAR(); }
    if (IN(6)) REP(6) {
        const int NT = *(LAS const int*)(F.lds + LT_NT);
        pg8::Gemm g{(const pg8::bf16_t*)(ws + WS_XS), (const pg8::bf16_t*)(ws + WS_WT_UG), DM / 2, (size_t)2048 * DM};
        pg8::MoeOrder S; S.init(NT, 8, F.G, (int)blockIdx.x, (LAS const int*)(F.lds + LT_TILE_E), F.wave, 1, args.b_ug, route_bufs(ws).slot_rstd, F.lds + PF_OFF);
        pg8::EpiMoeUp E{(unsigned char*)(ws + WS_H), F.lds + PF_OFF};
        pg8::gemm_phase<pg8::EpiMoeUp, pg8::MoeOrder, true, true, true>(F.lds + RING_OFF, g, S, E);
        GRID_BAR();
    }
    if (DUP_PHASE == 50 && IN(6)) {
        const int NT = *(LAS const int*)(F.lds + LT_NT);
        pg8::Gemm g{(const pg8::bf16_t*)(ws + WS_XS), (const pg8::bf16_t*)(ws + WS_WT_UG), DM / 2, (size_t)2048 * DM};
        pg8::MoeOrder S; S.init(NT, 8, F.G, (int)blockIdx.x, (LAS const int*)(F.lds + LT_TILE_E), F.wave, 0, nullptr, nullptr, F.lds + PF_OFF);
        pg8::EpiNull E;
        pg8::gemm_phase<pg8::EpiNull, pg8::MoeOrder, true, true, true>(F.lds + RING_OFF, g, S, E);
        GRID_BAR();
    }
    if (IN(7)) REP(7) {
        const int NT = *(LAS const int*)(F.lds + LT_NT);
        pg8::Gemm g{(const pg8::bf16_t*)(ws + WS_H), (const pg8::bf16_t*)(ws + WS_WT_DN), DM / 2, (size_t)DM * DM};
        pg8::MoeOrder S; S.init(NT, 4, F.G, (int)blockIdx.x, (LAS const int*)(F.lds + LT_TILE_E), F.wave, 2, args.b_dn, nullptr, F.lds + PF_OFF);
        pg8::EpiMoeDown E{(unsigned char*)(ws + WS_YS), F.lds + PF_OFF};
        pg8::gemm_phase<pg8::EpiMoeDown, pg8::MoeOrder, true, true, true>(F.lds + RING_OFF, g, S, E);
        GRID_BAR();
    }
    if (IN(8)) { if (DUP_PHASE == 8) { combine_phase(F, args, true); GRID_BAR(); } combine_phase(F, args); GRID_BAR(); }
    if (IN(9)) {
        pg8::Gemm g{(const pg8::bf16_t*)(ws + WS_XN), (const pg8::bf16_t*)(ws + WS_WT_PG), DM / 2, 0};
        pg8::StaticOrder S; S.init(T / 256, DM / 256, F.G, (int)blockIdx.x);
        if (DUP_PHASE == 9) { pg8::EpiPle E0{(const pg8::bf16_t*)(ws + WS_Y), (const pg8::bf16_t*)(ws + WS_PJ), (float*)(ws + WS_XS)}; pg8::gemm_phase<pg8::EpiPle, pg8::StaticOrder, true, true, true>(F.lds + RING_OFF, g, S, E0); }
        pg8::EpiPle E{(const pg8::bf16_t*)(ws + WS_Y), (const pg8::bf16_t*)(ws + WS_PJ), args.out};
        pg8::gemm_phase<pg8::EpiPle, pg8::StaticOrder, true, true, true>(F.lds + RING_OFF, g, S, E);
    }
#undef IN
}
extern "C" void kernel_launch(void* const* d_in, const int* in_sizes, int n_in, void* d_out, int out_size, void* d_ws, size_t ws_size, hipStream_t stream) {
    static int grid = 0;
    if (grid == 0) {
        if (n_in != 22 || ws_size < 1024 * MiB) { fprintf(stderr, "kernel_launch: unexpected n_in %d / ws %zu\n", n_in, ws_size); grid = -1; return; }
        int dev = 0, cus = 0, per_cu = 0;
        if (hipGetDevice(&dev) != hipSuccess || hipDeviceGetAttribute(&cus, hipDeviceAttributeMultiprocessorCount, dev) != hipSuccess) { grid = -1; return; }
        if (hipFuncSetAttribute((const void*)mega_fwd, hipFuncAttributeMaxDynamicSharedMemorySize, LDS_BYTES) != hipSuccess) { fprintf(stderr, "kernel_launch: hipFuncSetAttribute failed\n"); grid = -1; return; }
        if (hipOccupancyMaxActiveBlocksPerMultiprocessor(&per_cu, (const void*)mega_fwd, NWAVES * 64, LDS_BYTES) != hipSuccess || per_cu < 1) { fprintf(stderr, "kernel_launch: occupancy query says %d\n", per_cu); per_cu = 1; }
        (void)hipGetLastError();
        grid = cus;
    }
    if (grid < 0) return;
    (void)hipMemsetAsync((char*)d_ws + WS_CTL, 0, CTL_ZERO_BYTES, stream);
    Args a{};
    a.x = (const float*)d_in[0]; a.p = (const float*)d_in[1]; a.positions = (const int*)d_in[2]; a.g_mix = (const float*)d_in[3]; a.w_in = (const float*)d_in[4];
    a.sbq = (const float*)d_in[5]; a.sbk = (const float*)d_in[6]; a.rq = (const float*)d_in[7]; a.rk = (const float*)d_in[8]; a.gn_g = (const float*)d_in[9]; a.gn_b = (const float*)d_in[10];
    a.w_out = (const float*)d_in[11]; a.g_ffn = (const float*)d_in[12]; a.w_r = (const float*)d_in[13]; a.b_r = (const float*)d_in[14]; a.w_ug = (const float*)d_in[15]; a.b_ug = (const float*)d_in[16];
    a.w_dn = (const float*)d_in[17]; a.b_dn = (const float*)d_in[18]; a.g_ple = (const float*)d_in[19]; a.w_pg = (const float*)d_in[20]; a.w_pp = (const float*)d_in[21];
    a.out = (float*)d_out; a.ws = (unsigned char*)d_ws; a.ph_lo = 0; a.ph_hi = 10;
    hipLaunchKernelGGL(mega_fwd, dim3(grid), dim3(NWAVES * 64), LDS_BYTES, stream, a);

}
```

```cpp
#include <hip/hip_runtime.h>
#include <cstdint>
#include <cstdio>
#include <cmath>

namespace pg8 {
#define PG8_LAS __attribute__((address_space(3)))
typedef unsigned short bf16_t;
typedef short bf16x8 __attribute__((ext_vector_type(8)));
typedef float f32x4 __attribute__((ext_vector_type(4)));
typedef unsigned u32x4 __attribute__((ext_vector_type(4)));
typedef unsigned u32x2 __attribute__((ext_vector_type(2)));
typedef int v4i32 __attribute__((ext_vector_type(4)));
typedef int v8i32 __attribute__((ext_vector_type(8)));
constexpr int BM = 256, BK = 64, HALF = 128, HTB = HALF * BK * 2  , STAGE_BYTES = 8 * HTB, NXCD = 8, WGM = 8;

__host__ __device__ __forceinline__ int lds_byte(int r, int c) { const int st = (r >> 4) * 2 + (c >> 5), rr = r & 15, cc = c & 31, ob = rr * 64 + cc * 2; return st * 1024 + (ob ^ (((ob >> 9) & 1) << 5)); }
__host__ __device__ __forceinline__ void stage_rc(int b, int& R, int& C) { const int st = b / 1024, sb = b % 1024, swz = sb ^ (((sb >> 9) & 1) << 5); R = (st >> 1) * 16 + swz / 64; C = (st & 1) * 32 + (swz % 64) / 2; }
__host__ __device__ __forceinline__ int perm32(int rho) { const int n = rho >> 4, i = rho & 15; return 8 * (i >> 2) + 4 * n + (i & 3); }

struct Unit { int pm, pn, e, seq; };
struct Gemm { const bf16_t* A; const bf16_t* Bt; int K; size_t strideBe; };

struct StaticOrder {
    int nM, nN, nwg, G, c;
    __host__ __device__ void init(int nM_, int nN_, int G_, int c_) { nM = nM_; nN = nN_; nwg = nM * nN; G = G_; c = c_; }
    __host__ __device__ bool next(int i, Unit& u) const {
        const long L = (long)i * G + c; if (L >= nwg) return false;
        int wgid = (int)L; { const int q = nwg / NXCD, r = nwg % NXCD, xcd = wgid % NXCD, off = wgid / NXCD; wgid = (xcd < r ? xcd * (q + 1) : r * (q + 1) + (xcd - r) * q) + off; }
        const int nig = WGM * nN, gid = wgid / nig, fm = gid * WGM, gsz = (nM - fm) < WGM ? (nM - fm) : WGM;
        u.pm = fm + ((wgid % nig) % gsz); u.pn = (wgid % nig) / gsz; u.e = 0; u.seq = i; return true;
    }
    __device__ __forceinline__ void a_ready(const Unit&) const {}
    __device__ __forceinline__ void done(const Unit&) const {}
};

typedef float f32x2_t __attribute__((ext_vector_type(2))); typedef __bf16 bf16x2_t __attribute__((ext_vector_type(2)));
__device__ __forceinline__ unsigned cvt_pk_bf16(float lo, float hi) { f32x2_t v = {lo, hi}; bf16x2_t b = __builtin_convertvector(v, bf16x2_t); return __builtin_bit_cast(unsigned, b); }

constexpr int T = 16384, SEQ = 2048, DM = 1024, DIN = 3584;
constexpr float EPS = 1e-6f;
__device__ __forceinline__ u32x4 pack8(const f32x4 a, const f32x4 b) { u32x4 w; w.x = cvt_pk_bf16(a[0], a[1]); w.y = cvt_pk_bf16(a[2], a[3]); w.z = cvt_pk_bf16(b[0], b[1]); w.w = cvt_pk_bf16(b[2], b[3]); return w; }

struct EpiProj {
    static constexpr bool PERM = true, AFTER_DRAIN = false;
    bf16_t* hm;
    bf16_t* rg;
    const float* gains;
    const float *ropec, *ropes;
    __device__ __forceinline__ void operator()(const f32x4 (&acc)[2][2][4][2], const Unit& u, int wr, int wc, int fr, int fq) const {
        const int region = u.pn >> 1, hb = 4 * (u.pn & 1) + wc;
        const bool normed = (region == 0) || (region == 1) || (region == 3) || (region == 4);
        const bool rope = (region == 3) || (region == 4);
        const int gidx = region == 0 ? 0 : region == 1 ? 1 : region == 3 ? 2 : 3;
        const float* gp = gains + gidx * 64;
        f32x4 gv[2][2];
#pragma unroll
        for (int bj = 0; bj < 2; ++bj)
#pragma unroll
            for (int n = 0; n < 2; ++n) gv[bj][n] = normed ? *(const f32x4*)(gp + 32 * bj + 8 * fq + 4 * n) : (f32x4){1.f, 1.f, 1.f, 1.f};
        const float lg2g = __log2f(1.0f - __builtin_amdgcn_exp2f(-5.0f - (float)hb));
        const float scale = region == 0 ? 0.125f * 1.4426950408889634f : region == 4 ? 0.125f : 1.0f;
#pragma unroll
        for (int ai = 0; ai < 2; ++ai)
#pragma unroll
            for (int m = 0; m < 4; ++m) {
                const int row = u.pm * BM + ai * HALF + wr * 64 + m * 16 + fr;
                const int b = row >> 11, s = row & (SEQ - 1);
                f32x4 v[2][2];
#pragma unroll
                for (int bj = 0; bj < 2; ++bj)
#pragma unroll
                    for (int n = 0; n < 2; ++n) v[bj][n] = acc[ai][bj][m][n];
                if (normed) {
                    float ss = 0.f;
#pragma unroll
                    for (int bj = 0; bj < 2; ++bj)
#pragma unroll
                        for (int n = 0; n < 2; ++n) { const f32x4 x = v[bj][n]; ss += (x[0] * x[0] + x[1] * x[1]) + (x[2] * x[2] + x[3] * x[3]); }
                    ss += __shfl_xor(ss, 16); ss += __shfl_xor(ss, 32);
                    float rs = rsqrtf(ss * (1.0f / 64.0f) + EPS) * scale;
                    if (rope) rs *= (region == 3) ? __builtin_amdgcn_exp2f((float)(s & 31) * lg2g) : __builtin_amdgcn_exp2f(-(float)(s & 63) * lg2g);
#pragma unroll
                    for (int bj = 0; bj < 2; ++bj)
#pragma unroll
                        for (int n = 0; n < 2; ++n) v[bj][n] = v[bj][n] * rs * gv[bj][n];
                    if (rope) {
#pragma unroll
                        for (int n = 0; n < 2; ++n) {
                            const f32x4 c = *(const f32x4*)(ropec + (size_t)row * 32 + 8 * fq + 4 * n), sn = *(const f32x4*)(ropes + (size_t)row * 32 + 8 * fq + 4 * n);
                            const f32x4 lo = v[0][n], hi = v[1][n];
                            v[0][n] = lo * c - hi * sn; v[1][n] = hi * c + lo * sn;
                        }
                    }
                }
                bf16_t* dst = (region < 6) ? hm + (size_t)region * ((size_t)T * 512) + ((size_t)(b * 8 + hb) * SEQ + s) * 64 + 8 * fq
                                           : rg + (size_t)row * 512 + hb * 64 + 8 * fq;
#pragma unroll
                for (int bj = 0; bj < 2; ++bj) *(u32x4*)(dst + 32 * bj) = pack8(v[bj][0], v[bj][1]);
            }
    }
};

constexpr int PF_WAVE_BYTES = 768, PF_BUF_BYTES = 8 * PF_WAVE_BYTES;
struct EpiBf16Plain {
    static constexpr bool PERM = true, AFTER_DRAIN = false;
    bf16_t* O; int ldc;
    __device__ __forceinline__ void operator()(const f32x4 (&acc)[2][2][4][2], const Unit& u, int wr, int wc, int fr, int fq) const {
        const int row0 = u.pm * BM + wr * 64 + fr, col0 = u.pn * BM + wc * 32 + 8 * fq;
#pragma unroll
        for (int ai = 0; ai < 2; ++ai)
#pragma unroll
            for (int m = 0; m < 4; ++m) { bf16_t* rowp = O + (size_t)(row0 + ai * HALF + m * 16) * ldc + col0;
#pragma unroll
                for (int bj = 0; bj < 2; ++bj) *(u32x4*)(rowp + bj * HALF) = pack8(acc[ai][bj][m][0], acc[ai][bj][m][1]); }
    }
};
struct EpiResid {
    static constexpr bool PERM = true, AFTER_DRAIN = false;
    const float* base; bf16_t* X1;
    __device__ __forceinline__ void operator()(const f32x4 (&acc)[2][2][4][2], const Unit& u, int wr, int wc, int fr, int fq) const {
        const int col0 = u.pn * BM + wc * 32 + 8 * fq;
#pragma unroll
        for (int ai = 0; ai < 2; ++ai)
#pragma unroll
            for (int m = 0; m < 4; ++m) { const size_t off = (size_t)(u.pm * BM + ai * HALF + wr * 64 + m * 16 + fr) * DM + col0;
#pragma unroll
                for (int bj = 0; bj < 2; ++bj) { const f32x4 b0 = __builtin_nontemporal_load((const f32x4*)(base + off + bj * HALF)), b1 = __builtin_nontemporal_load((const f32x4*)(base + off + bj * HALF + 4));
                    *(u32x4*)(X1 + off + bj * HALF) = pack8(b0 + acc[ai][bj][m][0], b1 + acc[ai][bj][m][1]); } }
    }
};
struct EpiMoeUp {
    static constexpr bool PERM = true, AFTER_DRAIN = false;
    unsigned char* H; const PG8_LAS unsigned char* pf_lds;
    __device__ __forceinline__ void operator()(const f32x4 (&acc)[2][2][4][2], const Unit& u, int wr, int wc, int fr, int fq) const {
        const int cc = 128 * u.pn + 32 * wc + 8 * fq;
        f32x4 bg[2], bl[2]; float scs[2][4];
        const PG8_LAS unsigned char* buf = pf_lds + (u.seq & 1) * PF_BUF_BYTES + (wr * 4 + wc) * PF_WAVE_BYTES;
#pragma unroll
        for (int n = 0; n < 2; ++n) { bg[n] = *(const PG8_LAS f32x4*)(buf + (8 * fq + 4 * n) * 4); bl[n] = *(const PG8_LAS f32x4*)(buf + 128 + (8 * fq + 4 * n) * 4); }
#pragma unroll
        for (int ai = 0; ai < 2; ++ai)
#pragma unroll
            for (int m = 0; m < 4; ++m) scs[ai][m] = *(const PG8_LAS float*)(buf + 256 + ai * 256 + (m * 16 + fr) * 4);
#pragma unroll
        for (int n = 0; n < 2; ++n) bl[n] = bl[n] + 1.0f;
#pragma unroll
        for (int ai = 0; ai < 2; ++ai)
#pragma unroll
            for (int m = 0; m < 4; ++m) {
                const float sc = scs[ai][m] * 0.015625f;
                f32x4 hv[2];
#pragma unroll
                for (int n = 0; n < 2; ++n) {
                    const f32x4 g0 = acc[ai][0][m][n] * sc + bg[n], l1 = acc[ai][1][m][n] * sc + bl[n];
                    f32x4 glu, lin1;
#pragma unroll
                    for (int j = 0; j < 4; ++j) { glu[j] = __builtin_fminf(g0[j], 7.0f); lin1[j] = __builtin_amdgcn_fmed3f(l1[j], -6.0f, 8.0f); }
                    const f32x4 t = glu * (-1.702f * 1.4426950408889634f);
                    f32x4 e;
#pragma unroll
                    for (int j = 0; j < 4; ++j) e[j] = __builtin_amdgcn_exp2f(t[j]);
                    const f32x4 d = e + 1.0f;
                    f32x4 r;
#pragma unroll
                    for (int j = 0; j < 4; ++j) r[j] = __builtin_amdgcn_rcpf(d[j]);
                    hv[n] = (glu * r) * lin1;
                }
                u32x2 hq; hq.x = (unsigned)__builtin_amdgcn_cvt_pk_fp8_f32(hv[0][0], hv[0][1], 0, false); hq.x = (unsigned)__builtin_amdgcn_cvt_pk_fp8_f32(hv[0][2], hv[0][3], (int)hq.x, true);
                hq.y = (unsigned)__builtin_amdgcn_cvt_pk_fp8_f32(hv[1][0], hv[1][1], 0, false); hq.y = (unsigned)__builtin_amdgcn_cvt_pk_fp8_f32(hv[1][2], hv[1][3], (int)hq.y, true);
                *(u32x2*)(H + (size_t)(u.pm * BM + ai * HALF + wr * 64 + m * 16 + fr) * 1024 + cc) = hq;
            }
    }
};
struct EpiMoeDown {
    static constexpr bool PERM = true, AFTER_DRAIN = false;
    unsigned char* YS; const PG8_LAS unsigned char* pf_lds;
    __device__ __forceinline__ void operator()(const f32x4 (&acc)[2][2][4][2], const Unit& u, int wr, int wc, int fr, int fq) const {
        const int col0 = u.pn * BM + wc * 32 + 8 * fq;
        const PG8_LAS unsigned char* buf = pf_lds + (u.seq & 1) * PF_BUF_BYTES + (wr * 4 + wc) * PF_WAVE_BYTES;
        f32x4 bv[2][2];
#pragma unroll
        for (int bj = 0; bj < 2; ++bj)
#pragma unroll
            for (int n = 0; n < 2; ++n) bv[bj][n] = *(const PG8_LAS f32x4*)(buf + bj * 128 + (8 * fq + 4 * n) * 4);
#pragma unroll
        for (int ai = 0; ai < 2; ++ai)
#pragma unroll
            for (int m = 0; m < 4; ++m) { unsigned char* rowp = YS + (size_t)(u.pm * BM + ai * HALF + wr * 64 + m * 16 + fr) * 1024 + col0;
#pragma unroll
                for (int bj = 0; bj < 2; ++bj) { const f32x4 y0 = acc[ai][bj][m][0] * 0.015625f + bv[bj][0], y1 = acc[ai][bj][m][1] * 0.015625f + bv[bj][1];
                    u32x2 q; q.x = (unsigned)__builtin_amdgcn_cvt_pk_fp8_f32(y0[0], y0[1], 0, false); q.x = (unsigned)__builtin_amdgcn_cvt_pk_fp8_f32(y0[2], y0[3], (int)q.x, true);
                    q.y = (unsigned)__builtin_amdgcn_cvt_pk_fp8_f32(y1[0], y1[1], 0, false); q.y = (unsigned)__builtin_amdgcn_cvt_pk_fp8_f32(y1[2], y1[3], (int)q.y, true);
                    *(u32x2*)(rowp + bj * HALF) = q; } }
    }
};
struct EpiPle {
    static constexpr bool PERM = false, AFTER_DRAIN = false;
    const bf16_t* X2; const bf16_t* PJ; float* outw;
    __device__ __forceinline__ void operator()(const f32x4 (&acc)[2][2][4][2], const Unit& u, int wr, int wc, int fr, int fq) const {
        const int col0 = u.pn * BM + wc * 32 + 4 * fq;
#pragma unroll
        for (int ai = 0; ai < 2; ++ai)
#pragma unroll
            for (int m = 0; m < 4; ++m) { const size_t off = (size_t)(u.pm * BM + ai * HALF + wr * 64 + m * 16 + fr) * DM + col0;
#pragma unroll
                for (int bj = 0; bj < 2; ++bj)
#pragma unroll
                    for (int n = 0; n < 2; ++n) {
                        const size_t o2 = off + bj * HALF + n * 16;
                        const u32x2 xq = __builtin_nontemporal_load((const u32x2*)(X2 + o2)); const f32x4 x2 = (f32x4){__uint_as_float(xq.x << 16), __uint_as_float(xq.x & 0xffff0000u), __uint_as_float(xq.y << 16), __uint_as_float(xq.y & 0xffff0000u)}; const u32x2 pj = __builtin_nontemporal_load((const u32x2*)(PJ + o2)); const f32x4 a = acc[ai][bj][m][n] * 0.015625f;
                        f32x4 r;
                        r[0] = x2[0] + __uint_as_float(pj.x << 16) * __builtin_amdgcn_rcpf(1.0f + __builtin_amdgcn_exp2f(-1.4426950408889634f * a[0]));
                        r[1] = x2[1] + __uint_as_float(pj.x & 0xffff0000u) * __builtin_amdgcn_rcpf(1.0f + __builtin_amdgcn_exp2f(-1.4426950408889634f * a[1]));
                        r[2] = x2[2] + __uint_as_float(pj.y << 16) * __builtin_amdgcn_rcpf(1.0f + __builtin_amdgcn_exp2f(-1.4426950408889634f * a[2]));
                        r[3] = x2[3] + __uint_as_float(pj.y & 0xffff0000u) * __builtin_amdgcn_rcpf(1.0f + __builtin_amdgcn_exp2f(-1.4426950408889634f * a[3]));
                        __builtin_nontemporal_store(r, (f32x4*)(outw + o2));
                    } }
    }
};
struct MoeOrder {
    int nM, nN, nwg, G, c, wid, mode; const PG8_LAS int* tile_e; const float* pf_bias; const float* pf_rstd; PG8_LAS unsigned char* pf_lds;
    __device__ void init(int nM_, int nN_, int G_, int c_, const PG8_LAS int* te, int wid_, int mode_, const float* pb, const float* pr, PG8_LAS unsigned char* pl) { nM = nM_; nN = nN_; nwg = nM * nN; G = G_; c = c_; tile_e = te; wid = wid_; mode = mode_; pf_bias = pb; pf_rstd = pr; pf_lds = pl; }
    __device__ bool next(int i, Unit& u) const {
        const long L = (long)i * G + c; if (L >= nwg) return false;
        int wgid = (int)L; { const int q = nwg / NXCD, r = nwg % NXCD, xcd = wgid % NXCD, off = wgid / NXCD; wgid = (xcd < r ? xcd * (q + 1) : r * (q + 1) + (xcd - r) * q) + off; }
        const int nig = WGM * nN, gid = wgid / nig, fm = gid * WGM, gsz = (nM - fm) < WGM ? (nM - fm) : WGM;
        u.pm = fm + ((wgid % nig) % gsz); u.pn = (wgid % nig) / gsz; u.e = __builtin_amdgcn_readfirstlane(tile_e[u.pm]); u.seq = i; return true;
    }
    __device__ __forceinline__ void a_ready(const Unit& u) const {
        const int lane = (int)__builtin_amdgcn_mbcnt_hi(~0u, __builtin_amdgcn_mbcnt_lo(~0u, 0u)), wr = wid >> 2, wc = wid & 3;
        PG8_LAS unsigned char* buf = pf_lds + (u.seq & 1) * PF_BUF_BYTES + wid * PF_WAVE_BYTES;
        if (mode == 1) {
            const float* bsrc = pf_bias + (size_t)u.e * 2048 + 128 * u.pn + 32 * wc + (lane & 31) + ((lane >> 5) ? 1024 : 0);
            __builtin_amdgcn_global_load_lds((const unsigned*)bsrc, (PG8_LAS unsigned*)buf, 4, 0, 0);
            const float* rsrc = pf_rstd + u.pm * BM + wr * 64 + lane;
            __builtin_amdgcn_global_load_lds((const unsigned*)rsrc, (PG8_LAS unsigned*)(buf + 256), 4, 0, 0);
            __builtin_amdgcn_global_load_lds((const unsigned*)(rsrc + HALF), (PG8_LAS unsigned*)(buf + 512), 4, 0, 0);
        } else if (mode == 2) {
            const float* bsrc = pf_bias + (size_t)u.e * 1024 + u.pn * BM + 32 * wc + (lane & 31) + ((lane >> 5) ? HALF : 0);
            __builtin_amdgcn_global_load_lds((const unsigned*)bsrc, (PG8_LAS unsigned*)buf, 4, 0, 0);
        }
    }
    __device__ __forceinline__ void done(const Unit&) const {}
};
struct EpiNull {
    static constexpr bool PERM = true, AFTER_DRAIN = false;
    __device__ __forceinline__ void operator()(const f32x4 (&acc)[2][2][4][2], const Unit& u, int wr, int wc, int fr, int fq) const {
#pragma unroll
        for (int ai = 0; ai < 2; ++ai)
#pragma unroll
            for (int bj = 0; bj < 2; ++bj)
#pragma unroll
                for (int m = 0; m < 4; ++m)
#pragma unroll
                    for (int n = 0; n < 2; ++n) asm volatile("" :: "v"(acc[ai][bj][m][n]));
    }
};
template <class Epi, class Sched, bool ALIGN_EPI = false, bool SP2 = false, bool F8 = false>
__device__ __forceinline__ void gemm_phase(PG8_LAS unsigned char* lds, const Gemm g, const Sched& S, const Epi& E) {
    int tid_ = threadIdx.x; asm volatile("" : "+v"(tid_));
    const int tid = tid_, wid = __builtin_amdgcn_readfirstlane(tid >> 6), lane = tid & 63, wr = wid >> 2, wc = wid & 3, fr = lane & 15, fq = lane >> 4;
    const int K = g.K, nt = K / BK;
    unsigned voffA[2], voffB[2];
#pragma unroll
    for (int i = 0; i < 2; ++i) { int R, C; stage_rc(tid * 16 + i * 8192, R, C); const int Rb = Epi::PERM ? ((R & ~31) + perm32(R & 31)) : R;
        voffA[i] = (unsigned)(R * K + C) * 2u; voffB[i] = (unsigned)(Rb * K + C) * 2u; }
    const size_t kstep = (size_t)(BK * 2);
    const size_t hstep = (size_t)HALF * K * 2;
    const size_t tstep = 2 * hstep;
    const unsigned ldsw = (unsigned)wid * 1024u;
    const int aoff = lds_byte(wr * 64 + fr, fq * 8), boff = lds_byte(wc * 32 + fr, fq * 8);
#define PG8_SA(b, h) (((b) * 2 + (h)) * HTB)
#define PG8_SB(b, h) ((4 + (b) * 2 + (h)) * HTB)
#define PG8_STAGE(bufoff, gbase, voff) do { _Pragma("unroll") for (int _i = 0; _i < 2; ++_i) \
        __builtin_amdgcn_global_load_lds((const unsigned*)((const char*)(gbase) + (voff)[_i]), (PG8_LAS unsigned*)(lds + (bufoff) + ldsw + _i * 8192), 16, 0, 0); } while (0)
#define PG8_LD16(off) (*(const PG8_LAS v4i32*)(lds + (off)))
#define PG8_LDA(dst, b, h) do { if constexpr (F8) { _Pragma("unroll") for (int m = 0; m < 4; ++m) dst##8[m] = __builtin_shufflevector(PG8_LD16(PG8_SA(b, h) + aoff + m * 2048), PG8_LD16(PG8_SA(b, h) + aoff + m * 2048 + 1024), 0, 1, 2, 3, 4, 5, 6, 7); } \
        else { _Pragma("unroll") for (int m = 0; m < 4; ++m) _Pragma("unroll") for (int k = 0; k < 2; ++k) dst[m][k] = *(const PG8_LAS bf16x8*)(lds + PG8_SA(b, h) + aoff + m * 2048 + k * 1024); } } while (0)
#define PG8_LDB(dst, b, h) do { if constexpr (F8) { _Pragma("unroll") for (int n = 0; n < 2; ++n) dst##8[n] = __builtin_shufflevector(PG8_LD16(PG8_SB(b, h) + boff + n * 2048), PG8_LD16(PG8_SB(b, h) + boff + n * 2048 + 1024), 0, 1, 2, 3, 4, 5, 6, 7); } \
        else { _Pragma("unroll") for (int n = 0; n < 2; ++n) _Pragma("unroll") for (int k = 0; k < 2; ++k) dst[n][k] = *(const PG8_LAS bf16x8*)(lds + PG8_SB(b, h) + boff + n * 2048 + k * 1024); } } while (0)
#define PG8_MMA(ai, bj, At, Bt) do { __builtin_amdgcn_s_setprio(1); \
        if constexpr (F8) { _Pragma("unroll") for (int m = 0; m < 4; ++m) _Pragma("unroll") for (int n = 0; n < 2; ++n) \
            asm volatile("v_mfma_scale_f32_16x16x128_f8f6f4 %0, %1, %2, %0, %3, %3 op_sel_hi:[0,0,0]" : "+v"(acc[ai][bj][m][n]) : "v"(Bt##8[n]), "v"(At##8[m]), "v"(f8scale)); } \
        else { _Pragma("unroll") for (int m = 0; m < 4; ++m) _Pragma("unroll") for (int n = 0; n < 2; ++n) _Pragma("unroll") for (int k = 0; k < 2; ++k) \
            acc[ai][bj][m][n] = __builtin_amdgcn_mfma_f32_16x16x32_bf16(Bt[n][k], At[m][k], acc[ai][bj][m][n], 0, 0, 0); } \
        __builtin_amdgcn_s_setprio(0); } while (0)
#define PG8_WAIT_V(n) asm volatile("s_waitcnt vmcnt(" #n ")" ::: "memory")
#define PG8_WAIT_L(n) asm volatile("s_waitcnt lgkmcnt(" #n ")" ::: "memory")
#define PG8_BAR __builtin_amdgcn_s_barrier()
#define PG8_SCHED __builtin_amdgcn_sched_barrier(0)
    Unit cur, nxt; int ui = 0;
    if (!S.next(0, cur)) return;
    f32x4 acc[2][2][4][2];
#pragma unroll
    for (int a = 0; a < 2; ++a)
#pragma unroll
        for (int b = 0; b < 2; ++b)
#pragma unroll
            for (int m = 0; m < 4; ++m)
#pragma unroll
                for (int n = 0; n < 2; ++n) acc[a][b][m][n] = (f32x4){0.f, 0.f, 0.f, 0.f};
    bf16x8 At[4][2], B0[2][2], B1[2][2];
    v8i32 At8[4], B08[2], B18[2]; const int f8scale = 0x7f7f7f7f;
    const char* cA = (const char*)g.A + (size_t)cur.pm * tstep; const char* cB = (const char*)g.Bt + (size_t)cur.e * g.strideBe + (size_t)cur.pn * tstep;
    S.a_ready(cur);
    if constexpr (SP2) {
        PG8_STAGE(PG8_SB(0, 0), cB, voffB); PG8_STAGE(PG8_SB(0, 1), cB + hstep, voffB); PG8_STAGE(PG8_SA(0, 0), cA, voffA); PG8_STAGE(PG8_SA(0, 1), cA + hstep, voffA);
        if (wr == 1) PG8_BAR;
        PG8_WAIT_V(2); PG8_BAR;
        PG8_STAGE(PG8_SB(1, 0), cB + kstep, voffB); PG8_STAGE(PG8_SA(1, 0), cA + kstep, voffA); PG8_STAGE(PG8_SB(1, 1), cB + hstep + kstep, voffB);
        PG8_WAIT_V(6); PG8_BAR;
    } else {
        PG8_STAGE(PG8_SB(0, 0), cB, voffB); PG8_STAGE(PG8_SA(0, 0), cA, voffA); PG8_STAGE(PG8_SB(0, 1), cB + hstep, voffB); PG8_STAGE(PG8_SA(0, 1), cA + hstep, voffA);
        if (wr == 1) PG8_BAR;
        PG8_WAIT_V(4); PG8_BAR;
        PG8_STAGE(PG8_SB(1, 0), cB + kstep, voffB); PG8_STAGE(PG8_SA(1, 0), cA + kstep, voffA); PG8_STAGE(PG8_SB(1, 1), cB + hstep + kstep, voffB);
        PG8_WAIT_V(6); PG8_BAR;
    }
    for (;;) {
        const bool has_next = S.next(ui + 1, nxt);
        const char* nA = has_next ? (const char*)g.A + (size_t)nxt.pm * tstep : cA; const char* nB = has_next ? (const char*)g.Bt + (size_t)nxt.e * g.strideBe + (size_t)nxt.pn * tstep : cB;
#pragma unroll 1
        for (int t = 0; t < nt; t += 2) {
            const bool last = (t == nt - 2);
            const char* a1 = cA + (size_t)(t + 1) * kstep;
            const char* a2 = last ? nA : cA + (size_t)(t + 2) * kstep; const char* b2 = last ? nB : cB + (size_t)(t + 2) * kstep;
            const char* a3 = a2 + kstep; const char* b3 = b2 + kstep;
            if (last && has_next) S.a_ready(nxt);
            if constexpr (SP2) {
            PG8_LDB(B0, 0, 0); PG8_LDB(B1, 0, 1); PG8_SCHED; PG8_LDA(At, 0, 0); PG8_STAGE(PG8_SA(1, 1), a1 + hstep, voffA);
            PG8_WAIT_V(8); PG8_WAIT_L(0); PG8_BAR; PG8_MMA(0, 0, At, B0); PG8_MMA(0, 1, At, B1); PG8_BAR; PG8_SCHED;
            PG8_LDA(At, 0, 1); PG8_STAGE(PG8_SB(0, 0), b2, voffB); PG8_STAGE(PG8_SB(0, 1), b2 + hstep, voffB); PG8_STAGE(PG8_SA(0, 0), a2, voffA);
            PG8_WAIT_V(8); PG8_WAIT_L(0); PG8_BAR; PG8_MMA(1, 0, At, B0); PG8_MMA(1, 1, At, B1); PG8_BAR; PG8_SCHED;
            PG8_LDB(B0, 1, 0); PG8_LDB(B1, 1, 1); PG8_SCHED; PG8_LDA(At, 1, 0); PG8_STAGE(PG8_SA(0, 1), a2 + hstep, voffA);
            PG8_WAIT_V(8); PG8_WAIT_L(0); PG8_BAR; PG8_MMA(0, 0, At, B0); PG8_MMA(0, 1, At, B1); PG8_BAR; PG8_SCHED;
            PG8_LDA(At, 1, 1); PG8_STAGE(PG8_SB(1, 0), b3, voffB); PG8_STAGE(PG8_SB(1, 1), b3 + hstep, voffB); PG8_STAGE(PG8_SA(1, 0), a3, voffA);
            PG8_WAIT_V(8); PG8_WAIT_L(0); PG8_BAR; PG8_MMA(1, 0, At, B0); PG8_MMA(1, 1, At, B1); PG8_BAR; PG8_SCHED;
            } else {
            PG8_LDB(B0, 0, 0); PG8_SCHED; PG8_LDA(At, 0, 0); PG8_STAGE(PG8_SA(1, 1), a1 + hstep, voffA);
            PG8_WAIT_L(8); PG8_BAR; PG8_WAIT_L(0); PG8_MMA(0, 0, At, B0); PG8_BAR; PG8_SCHED;
            PG8_LDB(B1, 0, 1); PG8_STAGE(PG8_SB(0, 0), b2, voffB);
            PG8_BAR; PG8_WAIT_L(0); PG8_MMA(0, 1, At, B1); PG8_BAR;
            PG8_LDA(At, 0, 1); PG8_STAGE(PG8_SA(0, 0), a2, voffA);
            PG8_BAR; PG8_WAIT_L(0); PG8_MMA(1, 0, At, B0); PG8_BAR; PG8_SCHED;
            PG8_STAGE(PG8_SB(0, 1), b2 + hstep, voffB);
            PG8_WAIT_V(6); PG8_BAR; PG8_MMA(1, 1, At, B1); PG8_BAR;
            PG8_LDB(B0, 1, 0); PG8_SCHED; PG8_LDA(At, 1, 0); PG8_STAGE(PG8_SA(0, 1), a2 + hstep, voffA);
            PG8_WAIT_L(8); PG8_BAR; PG8_WAIT_L(0); PG8_MMA(0, 0, At, B0); PG8_BAR; PG8_SCHED;
            PG8_LDB(B1, 1, 1); PG8_STAGE(PG8_SB(1, 0), b3, voffB);
            PG8_BAR; PG8_WAIT_L(0); PG8_MMA(0, 1, At, B1); PG8_BAR;
            PG8_LDA(At, 1, 1); PG8_STAGE(PG8_SA(1, 0), a3, voffA);
            PG8_BAR; PG8_WAIT_L(0); PG8_MMA(1, 0, At, B0); PG8_BAR; PG8_SCHED;
            PG8_STAGE(PG8_SB(1, 1), b3 + hstep, voffB);
            PG8_WAIT_V(6); PG8_BAR; PG8_MMA(1, 1, At, B1); PG8_BAR;
            }
        }
        if constexpr (ALIGN_EPI) { if (wr == 0) PG8_BAR; }
        if constexpr (F8) asm volatile("s_nop 15\n\ts_nop 15\n\ts_nop 15" ::: "memory");
        if constexpr (!Epi::AFTER_DRAIN) { E(acc, cur, wr, wc, fr, fq); S.done(cur); }
        if (!has_next) break;
#pragma unroll
        for (int a = 0; a < 2; ++a)
#pragma unroll
            for (int b = 0; b < 2; ++b)
#pragma unroll
                for (int m = 0; m < 4; ++m)
#pragma unroll
                    for (int n = 0; n < 2; ++n) acc[a][b][m][n] = (f32x4){0.f, 0.f, 0.f, 0.f};
        cur = nxt; cA = nA; cB = nB; ++ui;
        if constexpr (ALIGN_EPI) { if (wr == 1) PG8_BAR; }
    }
    PG8_WAIT_V(0);
    if constexpr (!ALIGN_EPI) { if (wr == 0) PG8_BAR; }
    PG8_BAR;
    if constexpr (Epi::AFTER_DRAIN) { E.fused(acc, cur, wr, wc, fr, fq, lds, wid, lane); S.done(cur); }
#undef PG8_SA
#undef PG8_SB
#undef PG8_STAGE
#undef PG8_LD16
#undef PG8_LDA
#undef PG8_LDB
#undef PG8_MMA
#undef PG8_WAIT_V
#undef PG8_WAIT_L
#undef PG8_BAR
#undef PG8_SCHED
}
}

constexpr int NWAVES = 8;
constexpr int T = pg8::T, SEQ = pg8::SEQ, DM = pg8::DM, DIN = pg8::DIN, NE = 32, PLE = 256;
constexpr float EPS = pg8::EPS;
constexpr size_t MiB = 1u << 20;
constexpr size_t WS_CTL = 0, CTL_ZERO_BYTES = 1 * MiB;
constexpr size_t WS_WT_IN = 2 * MiB, WS_WT_OUT = 9 * MiB, WS_WT_PG = 11 * MiB, WS_WT_PP = 13 * MiB;
constexpr size_t WS_GAINS = 13 * MiB + 512 * 1024;
constexpr size_t WS_WRT = 13 * MiB + 576 * 1024;
constexpr size_t WS_ROPEC = 14 * MiB, WS_ROPES = 16 * MiB, WS_PB = 18 * MiB, WS_ROUTE = 26 * MiB;
constexpr size_t WS_WT_UG = 32 * MiB, WS_WT_DN = 160 * MiB;
constexpr size_t WS_XN = 224 * MiB;
constexpr size_t WS_HM = 256 * MiB;
constexpr size_t WS_X1 = 256 * MiB;
constexpr size_t WS_RG = 352 * MiB;
constexpr size_t WS_Y = 368 * MiB;
constexpr size_t WS_PJ = 400 * MiB;
constexpr size_t WS_XS = 432 * MiB, WS_H = 576 * MiB, WS_YS = 720 * MiB;
constexpr size_t WS_END = 864 * MiB;
constexpr int CW_TMO = 0, CW_CODE = 1;
constexpr int CW_BAR = 4096;
constexpr int RING_OFF = 0, RING_BYTES = 131072;
constexpr int LDSCTL_OFF = RING_BYTES, MISC_OFF = LDSCTL_OFF + 320;
constexpr int PF_OFF = LDSCTL_OFF + 4096;
constexpr int LDS_BYTES = 147456;
#define GAS __attribute__((address_space(1)))
#define LAS __attribute__((address_space(3)))
typedef unsigned short bf16;
typedef unsigned v4u __attribute__((ext_vector_type(4)));
typedef float f32x4 __attribute__((ext_vector_type(4)));
typedef short bf16x8 __attribute__((ext_vector_type(8)));
typedef unsigned u32x4_t __attribute__((ext_vector_type(4)));
typedef unsigned u32x2_t __attribute__((ext_vector_type(2)));
typedef GAS unsigned gu32;
typedef GAS unsigned long long gu64;
#define RLX_AGENT __ATOMIC_RELAXED, __HIP_MEMORY_SCOPE_AGENT
#define LDS_WAIT() asm volatile("s_waitcnt lgkmcnt(0)" ::: "memory")
#define VM_WAIT() asm volatile("s_waitcnt vmcnt(0)" ::: "memory")
__device__ __forceinline__ unsigned long long rt() { return __builtin_amdgcn_s_memrealtime(); }
__device__ __forceinline__ unsigned f2bf(float f) { unsigned u = __builtin_bit_cast(unsigned, f); return (u + 0x7fffu + ((u >> 16) & 1u)) >> 16; }
__device__ __forceinline__ unsigned pk2(float lo, float hi) { return f2bf(lo) | (f2bf(hi) << 16); }

#define XB_TMO      128
#define XB_XCNT(j)  (256  + 64 * (j))
#define XB_XSUB(j)  (1280 + 64 * (j))
#define XB_XGEN(j)  (2304 + 64 * (j))
#define XB_TOP      3328
#define XB_TOPGEN   3392
#define XCD_BAR_WORDS 3456
#define XB_SPIN_CAP (1u << 18)

__device__ __forceinline__ unsigned xb_ld(unsigned* p)              { return __hip_atomic_load(p, __ATOMIC_RELAXED, __HIP_MEMORY_SCOPE_AGENT); }
__device__ __forceinline__ unsigned xb_add(unsigned* p, unsigned v) { return __hip_atomic_fetch_add(p, v, __ATOMIC_RELAXED, __HIP_MEMORY_SCOPE_AGENT); }
__device__ __forceinline__ unsigned xb_xcc_id() { return (unsigned)__builtin_amdgcn_s_getreg((3 << 11) | 20) & 0xFu; }
#define XB_SPIN(cond, bar) do { unsigned _sp = 0; while (cond) { __builtin_amdgcn_s_sleep(1); \
    if ((++_sp & 255u) == 0u) { if (xb_ld(&(bar)[XB_TMO])) break; if (_sp > XB_SPIN_CAP) { atomicAdd(&(bar)[XB_TMO], 1u); break; } } } } while (0)

struct XcdBarrier {
    unsigned* bar; unsigned x;
    volatile LAS unsigned* st;
};

__device__ __forceinline__ XcdBarrier xcd_barrier_post(unsigned* bar, volatile LAS unsigned* st) {
    XcdBarrier b; b.bar = bar; b.x = xb_xcc_id(); b.st = st;
    if (threadIdx.x == 0) (void)xb_add(&bar[XB_XCNT(b.x)], 1u);
    return b;
}
__device__ __forceinline__ void xcd_barrier_complete(unsigned* bar, unsigned x, unsigned& nloc, unsigned& nx) {
    const unsigned G = gridDim.x * gridDim.y * gridDim.z;
    unsigned sum, cnt, mine, sp = 0u;
    for (;;) {
        sum = 0u; cnt = 0u; mine = 0u;
#pragma unroll
        for (unsigned j = 0; j < 16; ++j) { const unsigned c = xb_ld(&bar[XB_XCNT(j)]); sum += c; cnt += (c > 0u) ? 1u : 0u; mine = (j == x) ? c : mine; }
        if (sum == G) break;
        __builtin_amdgcn_s_sleep(1);
        if ((++sp & 255u) == 0u) { if (xb_ld(&bar[XB_TMO])) break; if (sp > XB_SPIN_CAP) { atomicAdd(&bar[XB_TMO], 1u); break; } }
    }
    nloc = mine > 0u ? mine : 1u; nx = cnt > 0u ? cnt : 1u;
}

__device__ __forceinline__ void xcd_barrier(const XcdBarrier& b) {
    asm volatile("s_waitcnt vmcnt(0)" ::: "memory");
    __syncthreads();
    if (threadIdx.x == 0) {
        unsigned* bar = b.bar;
        __builtin_amdgcn_s_waitcnt(0);
        unsigned nloc = b.st[0], nx = b.st[1];
        if (nloc == 0u) { xcd_barrier_complete(bar, b.x, nloc, nx); b.st[0] = nloc; b.st[1] = nx; }
        const unsigned old = xb_add(&bar[XB_XSUB(b.x)], 1u);
        const unsigned gen = old / nloc;
        const unsigned tgen = gen;
        if (old + 1u == (gen + 1u) * nloc) {
            __builtin_amdgcn_fence(__ATOMIC_RELEASE, "agent");
            asm volatile("s_waitcnt vmcnt(0)" ::: "memory");
            const unsigned og = xb_add(&bar[XB_TOP], 1u);
            const unsigned tg = og / nx;
            if (og + 1u == (tg + 1u) * nx) xb_add(&bar[XB_TOPGEN], 1u);
            else XB_SPIN(xb_ld(&bar[XB_TOPGEN]) == tg, bar);
        } else {
            XB_SPIN(xb_ld(&bar[XB_TOPGEN]) == tgen, bar);
        }
        __builtin_amdgcn_fence(__ATOMIC_ACQUIRE, "agent");
        asm volatile("s_waitcnt vmcnt(0)" ::: "memory");
    }
    __syncthreads();
}

struct Args {
    const float* x; const float* p; const int* positions; const float* g_mix; const float* w_in;
    const float* sbq; const float* sbk; const float* rq; const float* rk; const float* gn_g; const float* gn_b; const float* w_out;
    const float* g_ffn; const float* w_r; const float* b_r; const float* w_ug; const float* b_ug; const float* w_dn; const float* b_dn;
    const float* g_ple; const float* w_pg; const float* w_pp;
    float* out; unsigned char* ws; int ph_lo, ph_hi;
};
struct Frame {
    LAS unsigned char* lds;
    volatile LAS unsigned* MISC;
    gu32* ctl;
    int wave;
    int vcu, G;
};
__device__ __forceinline__ int tid_now() { int t = threadIdx.x; asm volatile("" : "+v"(t)); return t; }
__device__ __forceinline__ float wave_sum(float v) {
#pragma unroll
    for (int o = 1; o < 64; o <<= 1) v += __shfl_xor(v, o);
    return v;
}
__device__ __forceinline__ unsigned cvtpk(float lo, float hi) { return pg8::cvt_pk_bf16(lo, hi); }

enum { MAP_NAT = 0, MAP_IN = 1, MAP_UG = 2 };
__device__ __forceinline__ void p0_item(const float* __restrict__ W, int N, int K, bf16* __restrict__ WT, int kb, int nb, int mapmode, LAS unsigned char* scr, int lane) {
    const int np = 64 * nb + 4 * (lane & 15);
    int src = np;
    if (mapmode == MAP_IN) { const int pn = np >> 8, L = np & 255, bj = L >> 7, wc = (L >> 5) & 3, e = L & 31; src = 256 * pn + 64 * wc + 32 * bj + e; }
    else if (mapmode == MAP_UG) { const int pn = np >> 8, L = np & 255, bj = L >> 7, i = L & 127; src = 1024 * bj + 128 * pn + i; }
    const float* gp = W + (size_t)(64 * kb + (lane >> 4)) * N + src;
    f32x4 v[16];
#pragma unroll
    for (int i = 0; i < 16; ++i) v[i] = *(const f32x4*)(gp + (size_t)(4 * i) * N);
#pragma unroll
    for (int i = 0; i < 16; ++i) {
        LAS unsigned* d = (LAS unsigned*)(scr + (4 * i + (lane >> 4)) * 132 + 8 * (lane & 15));
        d[0] = cvtpk(v[i][0], v[i][1]); d[1] = cvtpk(v[i][2], v[i][3]);
    }
    LDS_WAIT(); asm volatile("" ::: "memory");
    const int c = lane & 7;
#pragma unroll
    for (int it = 0; it < 4; ++it) {
        const int nl = 16 * it + 2 * (lane >> 3);
        unsigned d[8];
#pragma unroll
        for (int j = 0; j < 8; ++j) d[j] = *(const LAS unsigned*)(scr + (8 * c + j) * 132 + 2 * nl);
        v4u o0, o1;
        o0.x = (d[0] & 0xffffu) | (d[1] << 16); o0.y = (d[2] & 0xffffu) | (d[3] << 16); o0.z = (d[4] & 0xffffu) | (d[5] << 16); o0.w = (d[6] & 0xffffu) | (d[7] << 16);
        o1.x = (d[0] >> 16) | (d[1] & 0xffff0000u); o1.y = (d[2] >> 16) | (d[3] & 0xffff0000u); o1.z = (d[4] >> 16) | (d[5] & 0xffff0000u); o1.w = (d[6] >> 16) | (d[7] & 0xffff0000u);
        bf16* dst = WT + (size_t)(64 * nb + nl) * K + 64 * kb + 8 * c;
        *(v4u*)dst = o0; *(v4u*)(dst + K) = o1;
    }
    LDS_WAIT(); asm volatile("" ::: "memory");
}
__device__ __forceinline__ unsigned pk4_fp8(float a, float b, float c, float d) { int r = __builtin_amdgcn_cvt_pk_fp8_f32(a, b, 0, false); r = __builtin_amdgcn_cvt_pk_fp8_f32(c, d, r, true); return (unsigned)r; }
__device__ __forceinline__ void p0_item_f8(const float* __restrict__ W, int N, int K, unsigned char* __restrict__ WT, int kb, int nb, int mapmode, LAS unsigned char* scr, int lane) {
    const int np = 64 * nb + 4 * (lane & 15);
    int src = np;
    if (mapmode == MAP_UG) { const int pn = np >> 8, L = np & 255, bj = L >> 7, i = L & 127; src = 1024 * bj + 128 * pn + i; }
    const float* gp = W + (size_t)(64 * kb + (lane >> 4)) * N + src;
    f32x4 v[16];
#pragma unroll
    for (int i = 0; i < 16; ++i) v[i] = *(const f32x4*)(gp + (size_t)(4 * i) * N);
#pragma unroll
    for (int i = 0; i < 16; ++i) *(LAS unsigned*)(scr + (4 * i + (lane >> 4)) * 68 + 4 * (lane & 15)) = pk4_fp8(v[i][0] * 64.0f, v[i][1] * 64.0f, v[i][2] * 64.0f, v[i][3] * 64.0f);
    LDS_WAIT(); asm volatile("" ::: "memory");
    const int nq = lane & 15, kg = lane >> 4;
    unsigned d[16];
#pragma unroll
    for (int j = 0; j < 16; ++j) d[j] = *(const LAS unsigned*)(scr + (16 * kg + j) * 68 + 4 * nq);
#pragma unroll
    for (int t = 0; t < 4; ++t) {
        v4u o;
#pragma unroll
        for (int q = 0; q < 4; ++q) o[q] = ((d[4 * q] >> (8 * t)) & 0xffu) | (((d[4 * q + 1] >> (8 * t)) & 0xffu) << 8) | (((d[4 * q + 2] >> (8 * t)) & 0xffu) << 16) | (((d[4 * q + 3] >> (8 * t)) & 0xffu) << 24);
        *(v4u*)(WT + (size_t)(64 * nb + 4 * nq + t) * K + 64 * kb + 16 * kg) = o;
    }
    LDS_WAIT(); asm volatile("" ::: "memory");
}
struct P0D { const float* gp; int N, K, kb, nb; bf16* W16; unsigned char* W8; const float* rsc; };
__device__ __forceinline__ int p0_src_col(int np, int mapmode) {
    int src = np;
    if (mapmode == MAP_IN) { const int pn = np >> 8, L = np & 255, bj = L >> 7, wc = (L >> 5) & 3, e = L & 31; src = 256 * pn + 64 * wc + 32 * bj + e; }
    else if (mapmode == MAP_UG) { const int pn = np >> 8, L = np & 255, bj = L >> 7, i = L & 127; src = 1024 * bj + 128 * pn + i; }
    return src;
}
__device__ __forceinline__ P0D p0_mk(const float* W, int N, int K, bf16* W16, unsigned char* W8, int kb, int nb, int mapmode, int lane, const float* rsc = nullptr) {
    P0D d; d.N = N; d.K = K; d.kb = kb; d.nb = nb; d.W16 = W16; d.W8 = W8;
    if (W8) {
        d.rsc = rsc ? rsc + 128 * kb + (lane >> 3) : nullptr;
        d.gp = W + (size_t)(128 * kb + (lane >> 3)) * N + p0_src_col(32 * nb + 4 * (lane & 7), mapmode);
    } else {
        d.rsc = nullptr;
        d.gp = W + (size_t)(64 * kb + (lane >> 4)) * N + p0_src_col(64 * nb + 4 * (lane & 15), mapmode);
    }
    return d;
}
__device__ __forceinline__ void p0_load(const P0D& d, f32x4 (&v)[16]) {
#pragma unroll
    for (int i = 0; i < 16; ++i) v[i] = __builtin_nontemporal_load((const f32x4*)(d.gp + (size_t)((d.W8 ? 8 : 4) * i) * d.N));
}
__device__ __forceinline__ void p0_finish(const P0D& d, const f32x4 (&v)[16], LAS unsigned char* scr, int lane, const int pm = 0) {
    if (pm == 1) { _Pragma("unroll") for (int i = 0; i < 16; ++i) asm volatile("" :: "v"(v[i])); return; }
    if (d.W16) {
#pragma unroll
        for (int i = 0; i < 16; ++i) { LAS unsigned* q = (LAS unsigned*)(scr + (4 * i + (lane >> 4)) * 132 + 8 * (lane & 15)); q[0] = cvtpk(v[i][0], v[i][1]); q[1] = cvtpk(v[i][2], v[i][3]); }
        LDS_WAIT(); asm volatile("" ::: "memory");
        const int c = lane & 7;
#pragma unroll
        for (int it = 0; it < 4; ++it) {
            const int nl = 16 * it + 2 * (lane >> 3);
            unsigned x[8];
#pragma unroll
            for (int j = 0; j < 8; ++j) x[j] = *(const LAS unsigned*)(scr + (8 * c + j) * 132 + 2 * nl);
            v4u o0, o1;
            o0.x = (x[0] & 0xffffu) | (x[1] << 16); o0.y = (x[2] & 0xffffu) | (x[3] << 16); o0.z = (x[4] & 0xffffu) | (x[5] << 16); o0.w = (x[6] & 0xffffu) | (x[7] << 16);
            o1.x = (x[0] >> 16) | (x[1] & 0xffff0000u); o1.y = (x[2] >> 16) | (x[3] & 0xffff0000u); o1.z = (x[4] >> 16) | (x[5] & 0xffff0000u); o1.w = (x[6] >> 16) | (x[7] & 0xffff0000u);
            bf16* dst = d.W16 + (size_t)(64 * d.nb + nl) * d.K + 64 * d.kb + 8 * c;
            if (pm == 0 || pm == 3) { *(v4u*)dst = o0; *(v4u*)(dst + d.K) = o1; } else asm volatile("" :: "v"(o0), "v"(o1));
        }
    } else {
#pragma unroll
        for (int i = 0; i < 16; ++i) { const float sc = d.rsc ? d.rsc[8 * i] * 64.0f : 64.0f; *(LAS unsigned*)(scr + (8 * i + (lane >> 3)) * 36 + 4 * (lane & 7)) = pk4_fp8(v[i][0] * sc, v[i][1] * sc, v[i][2] * sc, v[i][3] * sc); }
        LDS_WAIT(); asm volatile("" ::: "memory");
        const int nq = lane & 7, kg = lane >> 3;
        unsigned x[16];
#pragma unroll
        for (int j = 0; j < 16; ++j) x[j] = *(const LAS unsigned*)(scr + (16 * kg + j) * 36 + 4 * nq);
#pragma unroll
        for (int t = 0; t < 4; ++t) {
            v4u o;
#pragma unroll
            for (int q = 0; q < 4; ++q) o[q] = ((x[4 * q] >> (8 * t)) & 0xffu) | (((x[4 * q + 1] >> (8 * t)) & 0xffu) << 8) | (((x[4 * q + 2] >> (8 * t)) & 0xffu) << 16) | (((x[4 * q + 3] >> (8 * t)) & 0xffu) << 24);
            if (pm == 0 || pm == 3) __builtin_nontemporal_store(o, (v4u*)(d.W8 + (size_t)(32 * d.nb + 4 * nq + t) * d.K + 128 * d.kb + 16 * kg)); else asm volatile("" :: "v"(o));
        }
    }
    LDS_WAIT(); asm volatile("" ::: "memory");
}
__device__ __forceinline__ P0D p0_decode(const Args& a, unsigned char* ws, int it, int lane) {
    constexpr int I_IN = 16 * 56, I_OUT = 256, I_PG = 256, I_PP = 4 * 16, I_UG = 16 * 32, I_DN = 256;
    int r = it;
    if (r < I_IN) return p0_mk(a.w_in, DIN, DM, (bf16*)(ws + WS_WT_IN), nullptr, r / 56, r % 56, MAP_IN, lane); r -= I_IN;
    if (r < I_OUT) return p0_mk(a.w_out, DM, DM, (bf16*)(ws + WS_WT_OUT), nullptr, r / 16, r % 16, MAP_NAT, lane); r -= I_OUT;
    if (r < I_PG) return p0_mk(a.w_pg, DM, DM, nullptr, (unsigned char*)(ws + WS_WT_PG), r / 32, r % 32, MAP_NAT, lane); r -= I_PG;
    if (r < I_PP) return p0_mk(a.w_pp, DM, PLE, (bf16*)(ws + WS_WT_PP), nullptr, r / 16, r % 16, MAP_NAT, lane); r -= I_PP;
    if (r < NE * I_UG) { const int e = r / I_UG, q = r % I_UG; return p0_mk(a.w_ug + (size_t)e * DM * 2048, 2048, DM, nullptr, (unsigned char*)(ws + WS_WT_UG) + (size_t)e * 2048 * DM, q / 64, q % 64, MAP_UG, lane, a.g_ffn); } r -= NE * I_UG;
    { const int e = r / I_DN, q = r % I_DN; return p0_mk(a.w_dn + (size_t)e * DM * DM, DM, DM, nullptr, (unsigned char*)(ws + WS_WT_DN) + (size_t)e * DM * DM, q / 32, q % 32, MAP_NAT, lane); }
}
__device__ __forceinline__ void rms_row_to_bf16(const float* xrow, const float* g, bf16* orow, int lane) {
    const f32x4* xr = (const f32x4*)xrow + lane;
    f32x4 v[4]; float s = 0.f;
#pragma unroll
    for (int j = 0; j < 4; ++j) { v[j] = xr[64 * j]; s += (v[j][0] * v[j][0] + v[j][1] * v[j][1]) + (v[j][2] * v[j][2] + v[j][3] * v[j][3]); }
    const float rstd = rsqrtf(wave_sum(s) * (1.f / DM) + EPS);
    unsigned long long* o8 = (unsigned long long*)orow + lane;
#pragma unroll
    for (int j = 0; j < 4; ++j) { const f32x4 gg = ((const f32x4*)g)[lane + 64 * j];
        o8[64 * j] = (unsigned long long)cvtpk(v[j][0] * rstd * gg[0], v[j][1] * rstd * gg[1]) | ((unsigned long long)cvtpk(v[j][2] * rstd * gg[2], v[j][3] * rstd * gg[3]) << 32); }
}
__device__ __forceinline__ void p0_prologue(Frame& F, const Args& a, const int pm = 0) {
    unsigned char* ws = a.ws; const int tid = tid_now(), lane = tid & 63;
    LAS unsigned char* scr = F.lds + RING_OFF + F.wave * 8448;
    const int gw = F.vcu * NWAVES + F.wave, NGW = F.G * NWAVES;
    constexpr int I_IN = 16 * 56, I_OUT = 256, I_PG = 256, I_PP = 4 * 16, I_UG = 16 * 32, I_DN = 256;
    constexpr int NITEMS = I_IN + I_OUT + I_PG + I_PP + NE * I_UG + NE * I_DN;
    if (gw < NITEMS) {
        int it = gw; P0D d0 = p0_decode(a, ws, it, lane), d1 = d0; f32x4 va[16], vb[16]; p0_load(d0, va);
        for (;;) {
            const int it1 = it + NGW; const bool h1 = it1 < NITEMS;
            if (h1) { d1 = p0_decode(a, ws, it1, lane); p0_load(d1, vb); }
            p0_finish(d0, va, scr, lane, pm);
            if (!h1) break;
            const int it2 = it1 + NGW; const bool h2 = it2 < NITEMS;
            if (h2) { d0 = p0_decode(a, ws, it2, lane); p0_load(d0, va); }
            p0_finish(d1, vb, scr, lane, pm);
            if (!h2) break;
            it = it2;
        }
    }
    if (pm != 0) return;
    if (blockIdx.x == 0 && tid < 256) { const int t = tid; const float* srcs = (t < 64) ? a.sbq : (t < 128) ? a.sbk : (t < 192) ? a.rq : a.rk; ((float*)(ws + WS_GAINS))[t] = srcs[t & 63]; }
    {
        f32x4 gg[4];
#pragma unroll
        for (int j = 0; j < 4; ++j) gg[j] = ((const f32x4*)a.g_mix)[lane + 64 * j];
        for (int m0 = 4 * gw; m0 < T; m0 += 4 * NGW) {
            f32x4 v[4][4];
#pragma unroll
            for (int r = 0; r < 4; ++r)
#pragma unroll
                for (int j = 0; j < 4; ++j) v[r][j] = __builtin_nontemporal_load((const f32x4*)(a.x + (size_t)(m0 + r) * DM) + lane + 64 * j);
#pragma unroll
            for (int r = 0; r < 4; ++r) {
                float ss = 0.f;
#pragma unroll
                for (int j = 0; j < 4; ++j) ss += (v[r][j][0] * v[r][j][0] + v[r][j][1] * v[r][j][1]) + (v[r][j][2] * v[r][j][2] + v[r][j][3] * v[r][j][3]);
                const float rstd = rsqrtf(wave_sum(ss) * (1.f / DM) + EPS);
                unsigned long long* o8 = (unsigned long long*)((bf16*)(ws + WS_XN) + (size_t)(m0 + r) * DM) + lane;
#pragma unroll
                for (int j = 0; j < 4; ++j) o8[64 * j] = (unsigned long long)cvtpk(v[r][j][0] * rstd * gg[j][0], v[r][j][1] * rstd * gg[j][1]) | ((unsigned long long)cvtpk(v[r][j][2] * rstd * gg[j][2], v[r][j][3] * rstd * gg[j][3]) << 32);
            }
        }
    }
    { const int gt = gw * 64 + lane, NGT = NGW * 64;
      for (int i0 = gt; i0 < T * PLE / 8; i0 += 4 * NGT) {
          f32x4 a0[4], a1[4];
#pragma unroll
          for (int q = 0; q < 4; ++q) { const int i = i0 + q * NGT; if (i < T * PLE / 8) { a0[q] = __builtin_nontemporal_load((const f32x4*)a.p + 2 * i); a1[q] = __builtin_nontemporal_load((const f32x4*)a.p + 2 * i + 1); } }
#pragma unroll
          for (int q = 0; q < 4; ++q) { const int i = i0 + q * NGT; if (i < T * PLE / 8) { v4u o; o.x = cvtpk(a0[q][0], a0[q][1]); o.y = cvtpk(a0[q][2], a0[q][3]); o.z = cvtpk(a1[q][0], a1[q][1]); o.w = cvtpk(a1[q][2], a1[q][3]); ((v4u*)(ws + WS_PB))[i] = o; } }
      }
      for (int i = gt; i < NE * DM; i += NGT) { const int e = i >> 10, k = i & (DM - 1); const float wv = a.w_r[(size_t)k * NE + e] * a.g_ffn[k];
          const unsigned hi = cvtpk(wv, 0.f) & 0xffffu; const unsigned lo = cvtpk(wv - __uint_as_float(hi << 16), 0.f) & 0xffffu;
          ((bf16*)(ws + WS_WRT))[i] = (bf16)hi; ((bf16*)(ws + WS_WRT))[NE * DM + i] = (bf16)lo; }
      float* rc = (float*)(ws + WS_ROPEC); float* rs = (float*)(ws + WS_ROPES);
      for (int i = gt; i < T * 32; i += NGT) { const int row = i >> 5, f = i & 31;
          const float inv_freq = exp2f(-(float)f * (13.287712379549449f / 32.0f));   const float ang = (float)a.positions[row] * inv_freq;
          float sn, cs; sincosf(ang, &sn, &cs); rc[i] = cs; rs[i] = sn; } }
}

namespace att {
typedef short bf16x8 __attribute__((ext_vector_type(8)));
typedef short s16x4 __attribute__((ext_vector_type(4)));
typedef float f32x16 __attribute__((ext_vector_type(16)));
typedef short v4i16_t __attribute__((ext_vector_type(4)));
constexpr int LK = 0, LV = 24576, LFLAG = 49152;
__device__ __forceinline__ s16x4 vtr(LAS const unsigned char* p) { return __builtin_bit_cast(s16x4, __builtin_amdgcn_ds_read_tr16_b64_v4i16((LAS v4i16_t*)p)); }
__device__ __forceinline__ int crow(int r, int hi) { return (r & 3) + 8 * (r >> 2) + 4 * hi; }
struct AttnArgs { const bf16* hm; const bf16* rg; bf16* Y; const float* gn_g; const float* gn_b; };

template <int MODE, int ABL = 0> __device__ __forceinline__ void attn_unit(LAS unsigned char* lds, const AttnArgs& A, int b, int h, int qb) {
    int tid_ = threadIdx.x; asm volatile("" : "+v"(tid_));
    const int tid = tid_, lane = tid & 63, r32 = lane & 31, hh = lane >> 5;
    const int w = __builtin_amdgcn_readfirstlane(tid >> 6);
    const int q0 = qb * 256, qw = q0 + 32 * w;
    const size_t TS = (size_t)T * 512;
    const size_t hoff = (size_t)(b * 8 + h) * SEQ * 64;
    const bf16* Qp = A.hm + (MODE == 0 ? 0 : 3) * TS + hoff;
    const bf16* Kp = A.hm + (MODE == 0 ? 1 : 4) * TS + hoff;
    const bf16* Vp = A.hm + (MODE == 0 ? 2 : 5) * TS + hoff;
    bf16x8 qf[4];
#pragma unroll
    for (int ds = 0; ds < 4; ++ds) qf[ds] = *(const bf16x8*)(Qp + (size_t)(qw + r32) * 64 + 16 * ds + 8 * hh);
    f32x16 o[2];
#pragma unroll
    for (int r = 0; r < 16; ++r) { o[0][r] = 0.f; o[1][r] = 0.f; }
    float carry = 1.0f;
    const int jmax = (q0 + 255) >> 6, jd = (qw + 31) >> 6;
    const float lg2g = __log2f(1.0f - __builtin_amdgcn_exp2f(-5.0f - (float)h));
    const int krow = 8 * w + (lane >> 3);
    const bf16* Kt = Kp + (size_t)krow * 64 + (((lane & 7) ^ ((krow >> 1) & 7)) << 3); const bf16* Vt = Vp + (size_t)w * 512 + lane * 8;
    volatile LAS unsigned* flags = (volatile LAS unsigned*)(lds + LFLAG);
#define ATT_DMA(t, so) do { __builtin_amdgcn_global_load_lds((const unsigned*)(Kt + (size_t)(t) * 4096), (LAS unsigned*)(lds + LK + (so) + w * 1024), 16, 0, 0); \
                            __builtin_amdgcn_global_load_lds((const unsigned*)(Vt + (size_t)(t) * 4096), (LAS unsigned*)(lds + LV + (so) + w * 1024), 16, 0, 0); } while (0)
    ATT_DMA(jmax, 0);
    if (jmax >= 1) { ATT_DMA(jmax - 1, 8192); asm volatile("s_waitcnt vmcnt(2)\n\ts_barrier" ::: "memory"); }
    else asm volatile("s_waitcnt vmcnt(0)\n\ts_barrier" ::: "memory");
    bool finished = false;
    int so_cur = 0, so_new = 16384;
    for (int j = jmax; j >= 0; --j) {
        const int cur = j & 1;
        if (j >= 2 && ABL != 4) ATT_DMA(j - 2, so_new);
        if (j <= jd && !finished && ABL == 0) {
            LAS const unsigned char* Kb = lds + LK + so_cur;
            LAS const unsigned char* Vb = lds + LV + so_cur;
            f32x16 p[2];
#pragma unroll
            for (int r = 0; r < 16; ++r) { p[0][r] = 0.f; p[1][r] = 0.f; }
            bf16x8 kf[4][2];
            const int ksw = (r32 >> 1) & 7;
#pragma unroll
            for (int ds = 0; ds < 4; ++ds) { kf[ds][0] = *(LAS const bf16x8*)(Kb + r32 * 128 + (((2 * ds + hh) ^ ksw) << 4)); kf[ds][1] = *(LAS const bf16x8*)(Kb + 4096 + r32 * 128 + (((2 * ds + hh) ^ ksw) << 4)); }
#pragma unroll
            for (int ds = 0; ds < 4; ++ds) {
                p[0] = __builtin_amdgcn_mfma_f32_32x32x16_bf16(kf[ds][0], qf[ds], p[0], 0, 0, 0);
                p[1] = __builtin_amdgcn_mfma_f32_32x32x16_bf16(kf[ds][1], qf[ds], p[1], 0, 0, 0);
            }
            const bool diag = (j == jd);
            const int qg = qw + r32, kv0 = 64 * j + 4 * hh;
            if (MODE == 0) {
                float om[2][16];
#pragma unroll
                for (int hf = 0; hf < 2; ++hf)
#pragma unroll
                    for (int r = 0; r < 16; ++r) {
                        const float Z = p[hf][r];
                        const float a = __builtin_amdgcn_exp2f(-__builtin_fabsf(Z));
                        const float rc = __builtin_amdgcn_rcpf(1.0f + a), ar = a * rc;
                        const bool pos = Z >= 0.f;
                        p[hf][r] = pos ? rc : ar;
                        om[hf][r] = pos ? ar : rc;
                    }
                if (diag) {
#pragma unroll
                    for (int hf = 0; hf < 2; ++hf)
#pragma unroll
                        for (int r = 0; r < 16; ++r) { const bool valid = kv0 + 32 * hf + (r & 3) + 8 * (r >> 2) < qg; p[hf][r] = valid ? p[hf][r] : 0.f; om[hf][r] = valid ? om[hf][r] : 1.0f; }
                }
                float gs[8], ot[8];
#pragma unroll
                for (int m = 0; m < 8; ++m) { const int hf = m >> 2, g = m & 3; gs[m] = (om[hf][4 * g] * om[hf][4 * g + 1]) * (om[hf][4 * g + 2] * om[hf][4 * g + 3]); ot[m] = __shfl_xor(gs[m], 32); }
                float ps[8];
                ps[7] = 1.0f;
#pragma unroll
                for (int m = 6; m >= 0; --m) ps[m] = ps[m + 1] * (gs[m + 1] * ot[m + 1]);
                const float total = ps[0] * (gs[0] * ot[0]);
#pragma unroll
                for (int m = 0; m < 8; ++m) {
                    const int hf = m >> 2, g = m & 3;
                    float tail = carry * (hh ? ps[m] : ps[m] * ot[m]);
#pragma unroll
                    for (int i = 3; i >= 0; --i) { const int r = 4 * g + i; const float o1 = om[hf][r]; p[hf][r] *= tail; tail *= o1; }
                }
                carry *= total;
                finished = __all(carry < 1.0e-37f);
            } else {
                const float ct = __builtin_amdgcn_exp2f(lg2g * (float)(qw - 64 * j));
#pragma unroll
                for (int hf = 0; hf < 2; ++hf)
#pragma unroll
                    for (int r = 0; r < 16; ++r) p[hf][r] *= ct;
                if (diag) {
#pragma unroll
                    for (int hf = 0; hf < 2; ++hf)
#pragma unroll
                        for (int r = 0; r < 16; ++r) { const bool valid = kv0 + 32 * hf + (r & 3) + 8 * (r >> 2) <= qg; p[hf][r] = valid ? p[hf][r] : 0.f; }
                }
            }
            {
                const unsigned vbase = (unsigned)(uintptr_t)(Vb + (4 * hh + ((lane & 15) >> 2)) * 128 + (16 * ((lane >> 4) & 1) + 4 * (lane & 3)) * 2);
                s16x4 vl[2][2][2], vh[2][2][2];
#pragma unroll
                for (int hf = 0; hf < 2; ++hf)
#pragma unroll
                    for (int s = 0; s < 2; ++s)
#pragma unroll
                        for (int d0 = 0; d0 < 2; ++d0) {
                            asm volatile("ds_read_b64_tr_b16 %0, %1 offset:%c2" : "=&v"(vl[hf][s][d0]) : "v"(vbase), "i"(hf * 4096 + s * 2048 + d0 * 64) : "memory");
                            asm volatile("ds_read_b64_tr_b16 %0, %1 offset:%c2" : "=&v"(vh[hf][s][d0]) : "v"(vbase), "i"(hf * 4096 + s * 2048 + d0 * 64 + 1024) : "memory");
                        }
                bf16x8 wfr[2][2];
#pragma unroll
                for (int hf = 0; hf < 2; ++hf)
#pragma unroll
                    for (int s = 0; s < 2; ++s) {
                        u32x4_t wq;
                        wq.x = pg8::cvt_pk_bf16(p[hf][8 * s + 0], p[hf][8 * s + 1]); wq.y = pg8::cvt_pk_bf16(p[hf][8 * s + 2], p[hf][8 * s + 3]);
                        wq.z = pg8::cvt_pk_bf16(p[hf][8 * s + 4], p[hf][8 * s + 5]); wq.w = pg8::cvt_pk_bf16(p[hf][8 * s + 6], p[hf][8 * s + 7]);
                        wfr[hf][s] = __builtin_bit_cast(bf16x8, wq);
                    }
                asm volatile("s_waitcnt lgkmcnt(0)" ::: "memory"); __builtin_amdgcn_sched_barrier(0);
#pragma unroll
                for (int hf = 0; hf < 2; ++hf)
#pragma unroll
                    for (int s = 0; s < 2; ++s)
#pragma unroll
                        for (int d0 = 0; d0 < 2; ++d0) {
                            const s16x4 lo = vl[hf][s][d0], hi = vh[hf][s][d0];
                            const bf16x8 vf = (bf16x8){lo[0], lo[1], lo[2], lo[3], hi[0], hi[1], hi[2], hi[3]};
                            o[d0] = __builtin_amdgcn_mfma_f32_32x32x16_bf16(vf, wfr[hf][s], o[d0], 0, 0, 0);
                        }
            }
        }
        if (MODE == 0) { if (lane == 0) flags[cur * 8 + w] = finished ? 1u : 0u; }
        if (j >= 2) asm volatile("s_waitcnt vmcnt(2) lgkmcnt(0)\n\ts_barrier" ::: "memory"); else asm volatile("s_waitcnt vmcnt(0) lgkmcnt(0)\n\ts_barrier" ::: "memory");
        so_cur = (so_cur == 16384) ? 0 : so_cur + 8192; so_new = (so_new == 16384) ? 0 : so_new + 8192;
        if (MODE == 0) {
            unsigned all = 1u;
#pragma unroll
            for (int i = 0; i < 8; ++i) all &= flags[cur * 8 + i];
            if (all) break;
        }
    }
    asm volatile("s_waitcnt vmcnt(0)\n\ts_barrier" ::: "memory");
#undef ATT_DMA
    const int row = b * SEQ + qw + r32;
    if (MODE == 0) {
        bf16* yp = A.Y + (size_t)row * DM + h * 64 + 4 * hh;
#pragma unroll
        for (int d0 = 0; d0 < 2; ++d0)
#pragma unroll
            for (int g = 0; g < 4; ++g) { u32x2_t v; v.x = pg8::cvt_pk_bf16(o[d0][4 * g], o[d0][4 * g + 1]); v.y = pg8::cvt_pk_bf16(o[d0][4 * g + 2], o[d0][4 * g + 3]); *(u32x2_t*)(yp + 32 * d0 + 8 * g) = v; }
    } else {
        float s1 = 0.f;
#pragma unroll
        for (int r = 0; r < 16; ++r) s1 += o[0][r] + o[1][r];
        s1 += __shfl_xor(s1, 32);
        const float mu = s1 * (1.0f / 64.0f);
        float s2 = 0.f;
#pragma unroll
        for (int r = 0; r < 16; ++r) { const float a0 = o[0][r] - mu, a1 = o[1][r] - mu; s2 += a0 * a0 + a1 * a1; }
        s2 += __shfl_xor(s2, 32);
        const float rstd = rsqrtf(s2 * (1.0f / 64.0f) + EPS);
        bf16* yp = A.Y + (size_t)row * DM + 512 + h * 64 + 4 * hh;
        const bf16* gp = A.rg + (size_t)row * 512 + h * 64 + 4 * hh;
        const float* gg = A.gn_g + h * 64 + 4 * hh; const float* gb = A.gn_b + h * 64 + 4 * hh;
#pragma unroll
        for (int d0 = 0; d0 < 2; ++d0)
#pragma unroll
            for (int g = 0; g < 4; ++g) {
                const f32x4 gn = *(const f32x4*)(gg + 32 * d0 + 8 * g), bs = *(const f32x4*)(gb + 32 * d0 + 8 * g);
                const u32x2_t gr = *(const u32x2_t*)(gp + 32 * d0 + 8 * g);
                float gate[4] = {__uint_as_float(gr.x << 16), __uint_as_float(gr.x & 0xffff0000u), __uint_as_float(gr.y << 16), __uint_as_float(gr.y & 0xffff0000u)};
                float ov[4];
#pragma unroll
                for (int i = 0; i < 4; ++i) { const float yn = (o[d0][4 * g + i] - mu) * rstd * gn[i] + bs[i]; const float sg = gate[i] / (1.0f + __expf(-gate[i])); ov[i] = yn * sg; }
                u32x2_t v; v.x = pg8::cvt_pk_bf16(ov[0], ov[1]); v.y = pg8::cvt_pk_bf16(ov[2], ov[3]); *(u32x2_t*)(yp + 32 * d0 + 8 * g) = v;
            }
    }
}
__device__ __forceinline__ void attn_phase(LAS unsigned char* lds, const AttnArgs& A, int vcu, int dup, bf16* dummyY) {
    const int g = vcu >> 5, local = vcu & 31;
    if (dup == 24 || dup == 25) { AttnArgs A2 = A; A2.Y = dummyY;
#pragma unroll 1
        for (int u = 0; u < 2; ++u) { const int bh = 8 * g + 4 * (u & 1) + (local >> 3), qb = (u & 1) ? 7 - (local & 7) : (local & 7); if (dup == 24) attn_unit<1, 3>(lds, A2, bh >> 3, bh & 7, qb); else attn_unit<1, 4>(lds, A2, bh >> 3, bh & 7, qb); } }
#pragma unroll 1
    for (int u = 0; u < ((dup == 20) ? 4 : 2); ++u) { const int bh = 8 * g + 4 * (u & 1) + (local >> 3), qb = (u & 1) ? 7 - (local & 7) : (local & 7); attn_unit<1>(lds, A, bh >> 3, bh & 7, qb); }
#pragma unroll 1
    for (int u = 0; u < ((dup == 21) ? 4 : 2); ++u) { const int bh = 8 * g + 4 * (u & 1) + (local >> 3), qb = (u & 1) ? 7 - (local & 7) : (local & 7); attn_unit<0>(lds, A, bh >> 3, bh & 7, qb); }
}
}

constexpr int CW_GCNT = 2048;
constexpr int LR_LCNT = LDSCTL_OFF + 1024, LR_GBASE = LDSCTL_OFF + 1152;
constexpr int LT_POFF = LDSCTL_OFF + 2048, LT_NT = LDSCTL_OFF + 2176, LT_TILE_E = LDSCTL_OFF + 2304;
struct RouteBufs { int* tok_e; int* tok_slot; float* tok_gate; float* rstd; float* slot_rstd; };
__device__ __forceinline__ RouteBufs route_bufs(unsigned char* ws) { RouteBufs r; r.tok_e = (int*)(ws + WS_ROUTE); r.tok_slot = r.tok_e + T * 4; r.tok_gate = (float*)(r.tok_slot + T * 4); r.rstd = (float*)(ws + WS_ROUTE + 1 * MiB); r.slot_rstd = (float*)(ws + WS_ROUTE + 2 * MiB); return r; }
typedef float f32x2v __attribute__((ext_vector_type(2)));
__device__ __forceinline__ unsigned opq_mask(bool c) { unsigned m = c ? 0xffffffffu : 0u; asm volatile("" : "+v"(m)); return m; }
__device__ __forceinline__ float blendf(unsigned m, float a, float b) { return __uint_as_float((__float_as_uint(a) & m) | (__float_as_uint(b) & ~m)); }
__device__ __forceinline__ int blendi(unsigned m, int a, int b) { return (int)(((unsigned)a & m) | ((unsigned)b & ~m)); }

#define SW2(c, a, b) { const float ta_ = (c) ? (b) : (a), tb_ = (c) ? (a) : (b); a = ta_; b = tb_; }
#define SW2I(c, a, b) { const int ta_ = (c) ? (b) : (a), tb_ = (c) ? (a) : (b); a = ta_; b = tb_; }
#define TOP4_INSERT(x, e) { const float x_ = (x); const int e_ = (e); const bool c3_ = (x_ > v3) || (x_ == v3 && e_ < i3); v3 = c3_ ? x_ : v3; i3 = c3_ ? e_ : i3; \
    const bool c2_ = (v3 > v2) || (v3 == v2 && i3 < i2); SW2(c2_, v2, v3) SW2I(c2_, i2, i3) const bool c1_ = (v2 > v1) || (v2 == v1 && i2 < i1); SW2(c1_, v1, v2) SW2I(c1_, i1, i2) \
    const bool c0_ = (v1 > v0) || (v1 == v0 && i1 < i0); SW2(c0_, v0, v1) SW2I(c0_, i0, i1) }
__device__ __forceinline__ void router_phase(Frame& F, const Args& a, const bool dry = false) {
    unsigned char* ws = a.ws; const int tid = tid_now();
    LAS unsigned char* lds = F.lds;
    const int lane = tid & 63, r32 = lane & 31, hh = lane >> 5, w = F.wave, rg = w >> 2, kq = w & 3;
    volatile LAS unsigned* lcnt = (volatile LAS unsigned*)(lds + LR_LCNT);
    volatile LAS unsigned* gbase = (volatile LAS unsigned*)(lds + LR_GBASE);
    if (tid < 32) lcnt[tid] = 0u;
    const RouteBufs R = route_bufs(dry ? ws + 3 * MiB : ws);
    const int row = F.vcu * 64 + 32 * rg + r32;
    const bf16* xr = (const bf16*)(ws + WS_X1) + (size_t)row * DM + 256 * kq + 8 * hh;
    const bf16* wt = (const bf16*)(ws + WS_WRT) + (size_t)r32 * DM + 256 * kq + 8 * hh;
    unsigned char* hp = (unsigned char*)(ws + (dry ? WS_H : WS_XN)) + (size_t)row * DM + 256 * kq + 8 * hh;
    att::f32x16 D;
#pragma unroll
    for (int r = 0; r < 16; ++r) D[r] = 0.f;
    float ss = 0.f;
#pragma unroll 8
    for (int ks = 0; ks < 16; ++ks) {
        const u32x4_t xh = *(const u32x4_t*)(xr + 16 * ks);
        const f32x4 v0 = (f32x4){__uint_as_float(xh.x << 16), __uint_as_float(xh.x & 0xffff0000u), __uint_as_float(xh.y << 16), __uint_as_float(xh.y & 0xffff0000u)};
        const f32x4 v1 = (f32x4){__uint_as_float(xh.z << 16), __uint_as_float(xh.z & 0xffff0000u), __uint_as_float(xh.w << 16), __uint_as_float(xh.w & 0xffff0000u)};
        ss += ((v0[0] * v0[0] + v0[1] * v0[1]) + (v0[2] * v0[2] + v0[3] * v0[3])) + ((v1[0] * v1[0] + v1[1] * v1[1]) + (v1[2] * v1[2] + v1[3] * v1[3]));
        u32x2_t h8; h8.x = pk4_fp8(v0[0], v0[1], v0[2], v0[3]); h8.y = pk4_fp8(v1[0], v1[1], v1[2], v1[3]); *(u32x2_t*)(hp + 16 * ks) = h8;
        const att::bf16x8 whi = *(const att::bf16x8*)(wt + 16 * ks), wlo = *(const att::bf16x8*)(wt + 32 * DM + 16 * ks);
        const att::bf16x8 bxh = __builtin_bit_cast(att::bf16x8, xh);
        D = __builtin_amdgcn_mfma_f32_32x32x16_bf16(whi, bxh, D, 0, 0, 0);
        D = __builtin_amdgcn_mfma_f32_32x32x16_bf16(wlo, bxh, D, 0, 0, 0);
    }
    { LAS f32x4* dp = (LAS f32x4*)(lds + (w * 64 + lane) * 64);
#pragma unroll
      for (int q = 0; q < 4; ++q) dp[q] = (f32x4){D[4 * q], D[4 * q + 1], D[4 * q + 2], D[4 * q + 3]};
      *(LAS float*)(lds + 32768 + (w * 64 + lane) * 4) = ss; }
    __syncthreads();
    int my_e0 = 0, my_e1 = 0, rk0 = 0, rk1 = 0; float my_g0 = 0.f, my_g1 = 0.f;
    if (kq == 0) {
#pragma unroll
        for (int o = 1; o < 4; ++o) { LAS const f32x4* dp = (LAS const f32x4*)(lds + ((w + o) * 64 + lane) * 64);
#pragma unroll
            for (int q = 0; q < 4; ++q) { const f32x4 t = dp[q]; D[4 * q] += t[0]; D[4 * q + 1] += t[1]; D[4 * q + 2] += t[2]; D[4 * q + 3] += t[3]; }
            ss += *(LAS const float*)(lds + 32768 + ((w + o) * 64 + lane) * 4); }
        ss += __shfl_xor(ss, 32);
        const float rstd = rsqrtf(ss * (1.f / DM) + EPS);
        if (hh == 0) R.rstd[row] = rstd;
        float l[16];
#pragma unroll
        for (int r = 0; r < 16; ++r) l[r] = D[r] * rstd + a.b_r[(r & 3) + 8 * (r >> 2) + 4 * hh];
        float c[8]; int ci[8];
#pragma unroll
        for (int k = 0; k < 4; ++k) {
            float bv = -INFINITY; int bi = 99;
#pragma unroll
            for (int r = 0; r < 16; ++r) { const int e = (r & 3) + 8 * (r >> 2) + 4 * hh; const bool bt = l[r] > bv; bv = bt ? l[r] : bv; bi = bt ? e : bi; }
            c[k] = bv; ci[k] = bi;
#pragma unroll
            for (int r = 0; r < 16; ++r) { const int e = (r & 3) + 8 * (r >> 2) + 4 * hh; l[r] = (e == bi) ? -INFINITY : l[r]; }
        }
#pragma unroll
        for (int k = 0; k < 4; ++k) { c[4 + k] = __shfl_xor(c[k], 32); ci[4 + k] = __shfl_xor(ci[k], 32); }
        float tv[4]; int ti[4];
#pragma unroll
        for (int k = 0; k < 4; ++k) {
            float bv = -INFINITY; int bi = 99;
#pragma unroll
            for (int j = 0; j < 8; ++j) { const bool bt = (c[j] > bv) || (c[j] == bv && ci[j] < bi); bv = bt ? c[j] : bv; bi = bt ? ci[j] : bi; }
            tv[k] = bv; ti[k] = bi;
#pragma unroll
            for (int j = 0; j < 8; ++j) c[j] = (ci[j] == bi) ? -INFINITY : c[j];
        }
        const float v0 = tv[0], v1 = tv[1], v2 = tv[2], v3 = tv[3]; const int i0 = ti[0], i1 = ti[1], i2 = ti[2], i3 = ti[3];
        const float e1 = __expf(v1 - v0), e2 = __expf(v2 - v0), e3 = __expf(v3 - v0), inv = 1.0f / (1.0f + e1 + e2 + e3);
        my_e0 = hh ? i2 : i0; my_e1 = hh ? i3 : i1; my_g0 = (hh ? e2 : 1.0f) * inv; my_g1 = (hh ? e3 : e1) * inv;
        rk0 = (int)__hip_atomic_fetch_add((LAS unsigned*)(lds + LR_LCNT) + my_e0, 1u, __ATOMIC_RELAXED, __HIP_MEMORY_SCOPE_WORKGROUP);
        rk1 = (int)__hip_atomic_fetch_add((LAS unsigned*)(lds + LR_LCNT) + my_e1, 1u, __ATOMIC_RELAXED, __HIP_MEMORY_SCOPE_WORKGROUP);
    }
    __syncthreads();
    if (tid < 32) gbase[tid] = __hip_atomic_fetch_add((unsigned*)(F.ctl + CW_GCNT + (dry ? 64 : 0)) + tid, lcnt[tid], __ATOMIC_RELAXED, __HIP_MEMORY_SCOPE_AGENT);
    __syncthreads();
    if (kq == 0) {
        const int k0 = 2 * hh;
        R.tok_e[row * 4 + k0] = my_e0; R.tok_slot[row * 4 + k0] = (int)gbase[my_e0] + rk0; R.tok_gate[row * 4 + k0] = my_g0;
        R.tok_e[row * 4 + k0 + 1] = my_e1; R.tok_slot[row * 4 + k0 + 1] = (int)gbase[my_e1] + rk1; R.tok_gate[row * 4 + k0 + 1] = my_g1;
    }
}
#undef SW2
#undef SW2I
#undef TOP4_INSERT

__device__ __forceinline__ void build_tables(Frame& F) {
    LAS int* poff = (LAS int*)(F.lds + LT_POFF); LAS int* ntp = (LAS int*)(F.lds + LT_NT); LAS int* tile_e = (LAS int*)(F.lds + LT_TILE_E);
    LAS int* cnts = (LAS int*)(F.lds + LR_LCNT); const int tid = tid_now();
    if (tid < NE) cnts[tid] = (int)__hip_atomic_load((unsigned*)(F.ctl + CW_GCNT) + tid, __ATOMIC_RELAXED, __HIP_MEMORY_SCOPE_AGENT);
    __syncthreads();
    if (tid == 0) {
        int t = 0;
        for (int e = 0; e < NE; ++e) { const int c = cnts[e]; const int nt = (c + 255) >> 8; poff[e] = t * 256; for (int i = 0; i < nt; ++i) tile_e[t + i] = e; t += nt; }
        *ntp = t;
    }
    __syncthreads();
}
__device__ __forceinline__ void gather_phase(Frame& F, const Args& a) {
    unsigned char* ws = a.ws; const int lane = tid_now() & 63; const RouteBufs R = route_bufs(ws);
    LAS const int* poff = (LAS const int*)(F.lds + LT_POFF);
    const int gw = F.vcu * NWAVES + F.wave, NGW = F.G * NWAVES;
    for (int m0 = 4 * gw; m0 < T; m0 += 4 * NGW) {
        v4u h0[4]; float rs[4]; int dsts[4][4];
#pragma unroll
        for (int r = 0; r < 4; ++r) { const int m = m0 + r; h0[r] = __builtin_nontemporal_load((const v4u*)((const unsigned char*)(ws + WS_XN) + (size_t)m * DM) + lane); rs[r] = R.rstd[m];
#pragma unroll
            for (int k = 0; k < 4; ++k) dsts[r][k] = poff[R.tok_e[m * 4 + k]] + R.tok_slot[m * 4 + k]; }
#pragma unroll
        for (int r = 0; r < 4; ++r)
#pragma unroll
            for (int k = 0; k < 4; ++k) { ((v4u*)((unsigned char*)(ws + WS_XS) + (size_t)dsts[r][k] * DM))[lane] = h0[r]; if (lane == 0) R.slot_rstd[dsts[r][k]] = rs[r]; }
    }
}
__device__ __forceinline__ void combine_phase(Frame& F, const Args& a, const bool dry = false) {
    unsigned char* ws = a.ws; const RouteBufs R = route_bufs(ws);
    LAS const int* poff = (LAS const int*)(F.lds + LT_POFF);
    const int gw = F.vcu * NWAVES + F.wave, NGW = F.G * NWAVES, lane = tid_now() & 63;
    for (int m0 = 2 * gw; m0 < T; m0 += 2 * NGW) {
        f32x4 v[2][2][2]; u32x2_t y[2][4][2]; float gt[2][4];
#pragma unroll
        for (int rr = 0; rr < 2; ++rr) { const int m = m0 + rr;
#pragma unroll
            for (int i = 0; i < 2; ++i) { { const v4u xq = __builtin_nontemporal_load((const v4u*)((const bf16*)(ws + WS_X1) + (size_t)m * DM + 8 * lane + 512 * i)); v[rr][i][0] = (f32x4){__uint_as_float(xq[0] << 16), __uint_as_float(xq[0] & 0xffff0000u), __uint_as_float(xq[1] << 16), __uint_as_float(xq[1] & 0xffff0000u)}; v[rr][i][1] = (f32x4){__uint_as_float(xq[2] << 16), __uint_as_float(xq[2] & 0xffff0000u), __uint_as_float(xq[3] << 16), __uint_as_float(xq[3] & 0xffff0000u)}; } }
#pragma unroll
            for (int k = 0; k < 4; ++k) { const int e = R.tok_e[m * 4 + k], slot = R.tok_slot[m * 4 + k]; gt[rr][k] = R.tok_gate[m * 4 + k];
                const unsigned char* yr = (const unsigned char*)(ws + WS_YS) + (size_t)(poff[e] + slot) * DM + 8 * lane;
                y[rr][k][0] = __builtin_nontemporal_load((const u32x2_t*)yr); y[rr][k][1] = __builtin_nontemporal_load((const u32x2_t*)(yr + 512)); } }
#pragma unroll
        for (int rr = 0; rr < 2; ++rr) { const int m = m0 + rr;
#pragma unroll
            for (int k = 0; k < 4; ++k)
#pragma unroll
                for (int i = 0; i < 2; ++i) { const u32x2_t yy = y[rr][k][i]; const float g = gt[rr][k];
                    const f32x2v a0 = __builtin_amdgcn_cvt_pk_f32_fp8((int)yy.x, false), a1 = __builtin_amdgcn_cvt_pk_f32_fp8((int)yy.x, true), a2 = __builtin_amdgcn_cvt_pk_f32_fp8((int)yy.y, false), a3 = __builtin_amdgcn_cvt_pk_f32_fp8((int)yy.y, true);
                    v[rr][i][0][0] += g * a0[0]; v[rr][i][0][1] += g * a0[1]; v[rr][i][0][2] += g * a1[0]; v[rr][i][0][3] += g * a1[1];
                    v[rr][i][1][0] += g * a2[0]; v[rr][i][1][1] += g * a2[1]; v[rr][i][1][2] += g * a3[0]; v[rr][i][1][3] += g * a3[1]; }
            float ss = 0.f;
#pragma unroll
            for (int i = 0; i < 2; ++i)
#pragma unroll
                for (int q = 0; q < 2; ++q) { const f32x4 t = v[rr][i][q]; ss += (t[0] * t[0] + t[1] * t[1]) + (t[2] * t[2] + t[3] * t[3]); }
            const float rstd = rsqrtf(wave_sum(ss) * (1.f / DM) + EPS);
            unsigned char* np = (unsigned char*)(ws + (dry ? WS_H : WS_XN)) + (size_t)m * DM + 8 * lane; bf16* ow = (bf16*)(ws + (dry ? WS_XS : WS_Y));
#pragma unroll
            for (int i = 0; i < 2; ++i) { { v4u xb; xb[0] = cvtpk(v[rr][i][0][0], v[rr][i][0][1]); xb[1] = cvtpk(v[rr][i][0][2], v[rr][i][0][3]); xb[2] = cvtpk(v[rr][i][1][0], v[rr][i][1][1]); xb[3] = cvtpk(v[rr][i][1][2], v[rr][i][1][3]); *(v4u*)(ow + (size_t)m * DM + 8 * lane + 512 * i) = xb; }
                const f32x4 g0 = *(const f32x4*)(a.g_ple + 8 * lane + 512 * i), g1 = *(const f32x4*)(a.g_ple + 8 * lane + 512 * i + 4);
                u32x2_t o; o.x = pk4_fp8(v[rr][i][0][0] * rstd * g0[0], v[rr][i][0][1] * rstd * g0[1], v[rr][i][0][2] * rstd * g0[2], v[rr][i][0][3] * rstd * g0[3]);
                o.y = pk4_fp8(v[rr][i][1][0] * rstd * g1[0], v[rr][i][1][1] * rstd * g1[1], v[rr][i][1][2] * rstd * g1[2], v[rr][i][1][3] * rstd * g1[3]);
                *(u32x2_t*)(np + 512 * i) = o; } }
    }
}

__global__ void __launch_bounds__(NWAVES * 64, 2) mega_fwd(Args args) {
    extern __shared__ __attribute__((aligned(16))) unsigned char lds[];
    Frame F;
    F.lds = (LAS unsigned char*)lds;
    F.MISC = (volatile LAS unsigned*)(F.lds + MISC_OFF);
    F.wave = __builtin_amdgcn_readfirstlane(threadIdx.x >> 6);
    F.G = gridDim.x; { const int bx = blockIdx.x; F.vcu = (F.G % 8 == 0) ? (bx % 8) * (F.G / 8) + bx / 8 : bx; }
    unsigned char* ws = args.ws;
    F.ctl = (gu32*)(ws + WS_CTL);
    for (int u = threadIdx.x; u < (LDS_BYTES - LDSCTL_OFF) / 4; u += NWAVES * 64) ((LAS unsigned*)(F.lds + LDSCTL_OFF))[u] = 0u;
    __syncthreads();
    XcdBarrier bar = xcd_barrier_post((unsigned*)(F.ctl + CW_BAR), F.MISC + 8);
    const int lo = args.ph_lo, hi = args.ph_hi;
#define IN(k) (lo <= (k) && (k) < hi)
#define GRID_BAR() xcd_barrier(bar)
#ifndef DUP_PHASE
#define DUP_PHASE -1
#endif
#define REP(k) for (int rep_ = 0; rep_ < ((DUP_PHASE) == (k) ? 2 : 1); ++rep_)

    if (IN(0)) { if (DUP_PHASE == 40) { p0_prologue(F, args, 1); GRID_BAR(); } if (DUP_PHASE == 41) { p0_prologue(F, args, 2); GRID_BAR(); } if (DUP_PHASE == 42) { p0_prologue(F, args, 3); GRID_BAR(); } REP(0) { p0_prologue(F, args); GRID_BAR(); } }

    if (IN(1)) REP(1) {
        pg8::Gemm g{(const pg8::bf16_t*)(ws + WS_XN), (const pg8::bf16_t*)(ws + WS_WT_IN), DM, 0};
        pg8::StaticOrder S; S.init(T / 256, DIN / 256, F.G, (int)blockIdx.x);
        pg8::EpiProj E{(pg8::bf16_t*)(ws + WS_HM), (pg8::bf16_t*)(ws + WS_RG), (const float*)(ws + WS_GAINS), (const float*)(ws + WS_ROPEC), (const float*)(ws + WS_ROPES)};
        pg8::gemm_phase<pg8::EpiProj, pg8::StaticOrder, true, true>(F.lds + RING_OFF, g, S, E);
        {
            const int G2 = (F.G == 256) ? 128 : F.G, c2 = (F.G == 256) ? (int)blockIdx.x - 128 : (int)blockIdx.x;
            if (c2 >= 0) {
                pg8::Gemm g2{(const pg8::bf16_t*)(ws + WS_PB), (const pg8::bf16_t*)(ws + WS_WT_PP), PLE, 0};
                pg8::StaticOrder S2; S2.init(T / 256, DM / 256, G2, c2);
                pg8::EpiBf16Plain E2{(pg8::bf16_t*)(ws + WS_PJ), DM};
                pg8::gemm_phase<pg8::EpiBf16Plain, pg8::StaticOrder, true, true>(F.lds + RING_OFF, g2, S2, E2);
            }
        }
        GRID_BAR();
    }
    if (DUP_PHASE == 51 && IN(1)) {
        pg8::Gemm g{(const pg8::bf16_t*)(ws + WS_XN), (const pg8::bf16_t*)(ws + WS_WT_IN), DM, 0};
        pg8::StaticOrder S; S.init(T / 256, DIN / 256, F.G, (int)blockIdx.x);
        pg8::EpiNull E;
        pg8::gemm_phase<pg8::EpiNull, pg8::StaticOrder, true, true>(F.lds + RING_OFF, g, S, E);
        GRID_BAR();
    }
    if (IN(2)) REP(2) {
        if (F.G == 256) {
            const att::AttnArgs AA{(const bf16*)(ws + WS_HM), (const bf16*)(ws + WS_RG), (bf16*)(ws + WS_Y), args.gn_g, args.gn_b};
            att::attn_phase(F.lds + RING_OFF, AA, F.vcu, DUP_PHASE, (bf16*)(ws + WS_XS));
        }
        GRID_BAR();
    }
    if (IN(3)) REP(3) {
        pg8::Gemm g{(const pg8::bf16_t*)(ws + WS_Y), (const pg8::bf16_t*)(ws + WS_WT_OUT), DM, 0};
        pg8::StaticOrder S; S.init(T / 256, DM / 256, F.G, (int)blockIdx.x);
        pg8::EpiResid E{args.x, (pg8::bf16_t*)(ws + WS_X1)};
        pg8::gemm_phase<pg8::EpiResid, pg8::StaticOrder, true, true>(F.lds + RING_OFF, g, S, E);
        GRID_BAR();
    }
    if (DUP_PHASE == 30 && IN(3)) { GRID_BAR(); GRID_BAR(); GRID_BAR(); GRID_BAR(); }
    if (IN(4)) { if (DUP_PHASE == 4) { if (F.G == 256) router_phase(F, args, true); GRID_BAR(); } if (F.G == 256) router_phase(F, args); GRID_BAR(); }
    if (IN(5) || (lo >= 6 && lo <= 8)) build_tables(F);
    if (IN(5)) REP(5) { gather_phase(F, args); GRID_BAR(); }
    if (IN(6)) REP(6) {
        const int NT = *(LAS const int*)(F.lds + LT_NT);
        pg8::Gemm g{(const pg8::bf16_t*)(ws + WS_XS), (const pg8::bf16_t*)(ws + WS_WT_UG), DM / 2, (size_t)2048 * DM};
        pg8::MoeOrder S; S.init(NT, 8, F.G, (int)blockIdx.x, (LAS const int*)(F.lds + LT_TILE_E), F.wave, 1, args.b_ug, route_bufs(ws).slot_rstd, F.lds + PF_OFF);
        pg8::EpiMoeUp E{(unsigned char*)(ws + WS_H), F.lds + PF_OFF};
        pg8::gemm_phase<pg8::EpiMoeUp, pg8::MoeOrder, true, true, true>(F.lds + RING_OFF, g, S, E);
        GRID_BAR();
    }
    if ((DUP_PHASE == 50 || DUP_PHASE == 52) && IN(6)) {
        const int NT = *(LAS const int*)(F.lds + LT_NT);
        pg8::Gemm g{(const pg8::bf16_t*)(ws + WS_XS), (const pg8::bf16_t*)(ws + WS_WT_UG), (DUP_PHASE == 52) ? DM / 4 : DM / 2, (size_t)2048 * DM};
        pg8::MoeOrder S; S.init(NT, 8, F.G, (int)blockIdx.x, (LAS const int*)(F.lds + LT_TILE_E), F.wave, 0, nullptr, nullptr, F.lds + PF_OFF);
        pg8::EpiNull E;
        pg8::gemm_phase<pg8::EpiNull, pg8::MoeOrder, true, true, true>(F.lds + RING_OFF, g, S, E);
        GRID_BAR();
    }
    if (IN(7)) REP(7) {
        const int NT = *(LAS const int*)(F.lds + LT_NT);
        pg8::Gemm g{(const pg8::bf16_t*)(ws + WS_H), (const pg8::bf16_t*)(ws + WS_WT_DN), DM / 2, (size_t)DM * DM};
        pg8::MoeOrder S; S.init(NT, 4, F.G, (int)blockIdx.x, (LAS const int*)(F.lds + LT_TILE_E), F.wave, 2, args.b_dn, nullptr, F.lds + PF_OFF);
        pg8::EpiMoeDown E{(unsigned char*)(ws + WS_YS), F.lds + PF_OFF};
        pg8::gemm_phase<pg8::EpiMoeDown, pg8::MoeOrder, true, true, true>(F.lds + RING_OFF, g, S, E);
        GRID_BAR();
    }
    if (IN(8)) { if (DUP_PHASE == 8) { combine_phase(F, args, true); GRID_BAR(); } combine_phase(F, args); GRID_BAR(); }
    if (IN(9)) {
        pg8::Gemm g{(const pg8::bf16_t*)(ws + WS_XN), (const pg8::bf16_t*)(ws + WS_WT_PG), DM / 2, 0};
        pg8::StaticOrder S; S.init(T / 256, DM / 256, F.G, (int)blockIdx.x);
        if (DUP_PHASE == 9) { pg8::EpiPle E0{(const pg8::bf16_t*)(ws + WS_Y), (const pg8::bf16_t*)(ws + WS_PJ), (float*)(ws + WS_XS)}; pg8::gemm_phase<pg8::EpiPle, pg8::StaticOrder, true, true, true>(F.lds + RING_OFF, g, S, E0); }
        pg8::EpiPle E{(const pg8::bf16_t*)(ws + WS_Y), (const pg8::bf16_t*)(ws + WS_PJ), args.out};
        pg8::gemm_phase<pg8::EpiPle, pg8::StaticOrder, true, true, true>(F.lds + RING_OFF, g, S, E);
    }
#undef IN
}
extern "C" void kernel_launch(void* const* d_in, const int* in_sizes, int n_in, void* d_out, int out_size, void* d_ws, size_t ws_size, hipStream_t stream) {
    static int grid = 0;
    if (grid == 0) {
        if (n_in != 22 || ws_size < 1024 * MiB) { fprintf(stderr, "kernel_launch: unexpected n_in %d / ws %zu\n", n_in, ws_size); grid = -1; return; }
        int dev = 0, cus = 0, per_cu = 0;
        if (hipGetDevice(&dev) != hipSuccess || hipDeviceGetAttribute(&cus, hipDeviceAttributeMultiprocessorCount, dev) != hipSuccess) { grid = -1; return; }
        if (hipFuncSetAttribute((const void*)mega_fwd, hipFuncAttributeMaxDynamicSharedMemorySize, LDS_BYTES) != hipSuccess) { fprintf(stderr, "kernel_launch: hipFuncSetAttribute failed\n"); grid = -1; return; }
        if (hipOccupancyMaxActiveBlocksPerMultiprocessor(&per_cu, (const void*)mega_fwd, NWAVES * 64, LDS_BYTES) != hipSuccess || per_cu < 1) { fprintf(stderr, "kernel_launch: occupancy query says %d\n", per_cu); per_cu = 1; }
        (void)hipGetLastError();
        grid = cus;
    }
    if (grid < 0) return;
    (void)hipMemsetAsync((char*)d_ws + WS_CTL, 0, CTL_ZERO_BYTES, stream);
    Args a{};
    a.x = (const float*)d_in[0]; a.p = (const float*)d_in[1]; a.positions = (const int*)d_in[2]; a.g_mix = (const float*)d_in[3]; a.w_in = (const float*)d_in[4];
    a.sbq = (const float*)d_in[5]; a.sbk = (const float*)d_in[6]; a.rq = (const float*)d_in[7]; a.rk = (const float*)d_in[8]; a.gn_g = (const float*)d_in[9]; a.gn_b = (const float*)d_in[10];
    a.w_out = (const float*)d_in[11]; a.g_ffn = (const float*)d_in[12]; a.w_r = (const float*)d_in[13]; a.b_r = (const float*)d_in[14]; a.w_ug = (const float*)d_in[15]; a.b_ug = (const float*)d_in[16];
    a.w_dn = (const float*)d_in[17]; a.b_dn = (const float*)d_in[18]; a.g_ple = (const float*)d_in[19]; a.w_pg = (const float*)d_in[20]; a.w_pp = (const float*)d_in[21];
    a.out = (float*)d_out; a.ws = (unsigned char*)d_ws; a.ph_lo = 0; a.ph_hi = 10;
    hipLaunchKernelGGL(mega_fwd, dim3(grid), dim3(NWAVES * 64), LDS_BYTES, stream, a);

}
```

```cpp
#include <hip/hip_runtime.h>
#include <cstdint>
#include <cstdio>
#include <cmath>

__device__ __forceinline__ int lane_id_hw() { return (int)__builtin_amdgcn_mbcnt_hi(~0u, __builtin_amdgcn_mbcnt_lo(~0u, 0u)); }
namespace pg8 {
#define PG8_LAS __attribute__((address_space(3)))
typedef unsigned short bf16_t;
typedef short bf16x8 __attribute__((ext_vector_type(8)));
typedef float f32x4 __attribute__((ext_vector_type(4)));
typedef unsigned u32x4 __attribute__((ext_vector_type(4)));
typedef unsigned u32x2 __attribute__((ext_vector_type(2)));
typedef int v4i32 __attribute__((ext_vector_type(4)));
typedef int v8i32 __attribute__((ext_vector_type(8)));
constexpr int BM = 256, BK = 64, HALF = 128, HTB = HALF * BK * 2  , STAGE_BYTES = 8 * HTB, NXCD = 8, WGM = 8;

__host__ __device__ __forceinline__ int lds_byte(int r, int c) { const int st = (r >> 4) * 2 + (c >> 5), rr = r & 15, cc = c & 31, ob = rr * 64 + cc * 2; return st * 1024 + (ob ^ (((ob >> 9) & 1) << 5)); }
__host__ __device__ __forceinline__ void stage_rc(int b, int& R, int& C) { const int st = b / 1024, sb = b % 1024, swz = sb ^ (((sb >> 9) & 1) << 5); R = (st >> 1) * 16 + swz / 64; C = (st & 1) * 32 + (swz % 64) / 2; }
__host__ __device__ __forceinline__ int perm32(int rho) { const int n = rho >> 4, i = rho & 15; return 8 * (i >> 2) + 4 * n + (i & 3); }

struct Unit { int pm, pn, e, seq; };
struct Gemm { const bf16_t* A; const bf16_t* Bt; int K; size_t strideBe; };

struct StaticOrder {
    int nM, nN, nwg, G, c;
    __host__ __device__ void init(int nM_, int nN_, int G_, int c_) { nM = nM_; nN = nN_; nwg = nM * nN; G = G_; c = c_; }
    __host__ __device__ bool next(int i, Unit& u) const {
        const long L = (long)i * G + c; if (L >= nwg) return false;
        int wgid = (int)L; { const int q = nwg / NXCD, r = nwg % NXCD, xcd = wgid % NXCD, off = wgid / NXCD; wgid = (xcd < r ? xcd * (q + 1) : r * (q + 1) + (xcd - r) * q) + off; }
        const int nig = WGM * nN, gid = wgid / nig, fm = gid * WGM, gsz = (nM - fm) < WGM ? (nM - fm) : WGM;
        u.pm = fm + ((wgid % nig) % gsz); u.pn = (wgid % nig) / gsz; u.e = 0; u.seq = i; return true;
    }
    __device__ __forceinline__ void a_ready(const Unit&) const {}
    __device__ __forceinline__ void done(const Unit&) const {}
};

typedef float f32x2_t __attribute__((ext_vector_type(2))); typedef __bf16 bf16x2_t __attribute__((ext_vector_type(2)));
__device__ __forceinline__ unsigned cvt_pk_bf16(float lo, float hi) { f32x2_t v = {lo, hi}; bf16x2_t b = __builtin_convertvector(v, bf16x2_t); return __builtin_bit_cast(unsigned, b); }

constexpr int T = 16384, SEQ = 2048, DM = 1024, DIN = 3584;
constexpr float EPS = 1e-6f;
__device__ __forceinline__ u32x4 pack8(const f32x4 a, const f32x4 b) { u32x4 w; w.x = cvt_pk_bf16(a[0], a[1]); w.y = cvt_pk_bf16(a[2], a[3]); w.z = cvt_pk_bf16(b[0], b[1]); w.w = cvt_pk_bf16(b[2], b[3]); return w; }

struct EpiProj {
    static constexpr bool PERM = true, AFTER_DRAIN = false;
    bf16_t* hm;
    bf16_t* rg;
    const float* gains;
    const float *ropec, *ropes;
    __device__ __forceinline__ void operator()(const f32x4 (&acc)[2][2][4][2], const Unit& u, int wr, int wc, int fr, int fq) const {
        const int region = u.pn >> 1, hb = 4 * (u.pn & 1) + wc;
        const bool normed = (region == 0) || (region == 1) || (region == 3) || (region == 4);
        const bool rope = (region == 3) || (region == 4);
        const int gidx = region == 0 ? 0 : region == 1 ? 1 : region == 3 ? 2 : 3;
        const float* gp = gains + gidx * 64;
        f32x4 gv[2][2];
#pragma unroll
        for (int bj = 0; bj < 2; ++bj)
#pragma unroll
            for (int n = 0; n < 2; ++n) gv[bj][n] = normed ? *(const f32x4*)(gp + 32 * bj + 8 * fq + 4 * n) : (f32x4){1.f, 1.f, 1.f, 1.f};
        const float lg2g = __log2f(1.0f - __builtin_amdgcn_exp2f(-5.0f - (float)hb));
        const float scale = region == 0 ? 0.125f * 1.4426950408889634f : region == 4 ? 0.125f : 1.0f;
#pragma unroll
        for (int ai = 0; ai < 2; ++ai)
#pragma unroll
            for (int m = 0; m < 4; ++m) {
                const int row = u.pm * BM + ai * HALF + wr * 64 + m * 16 + fr;
                const int b = row >> 11, s = row & (SEQ - 1);
                f32x4 v[2][2];
#pragma unroll
                for (int bj = 0; bj < 2; ++bj)
#pragma unroll
                    for (int n = 0; n < 2; ++n) v[bj][n] = acc[ai][bj][m][n];
                if (normed) {
                    float ss = 0.f;
#pragma unroll
                    for (int bj = 0; bj < 2; ++bj)
#pragma unroll
                        for (int n = 0; n < 2; ++n) { const f32x4 x = v[bj][n]; ss += (x[0] * x[0] + x[1] * x[1]) + (x[2] * x[2] + x[3] * x[3]); }
                    ss += __shfl_xor(ss, 16); ss += __shfl_xor(ss, 32);
                    float rs = rsqrtf(ss * (1.0f / 64.0f) + EPS) * scale;
                    if (rope) rs *= (region == 3) ? __builtin_amdgcn_exp2f((float)(s & 31) * lg2g) : __builtin_amdgcn_exp2f(-(float)(s & 63) * lg2g);
#pragma unroll
                    for (int bj = 0; bj < 2; ++bj)
#pragma unroll
                        for (int n = 0; n < 2; ++n) v[bj][n] = v[bj][n] * rs * gv[bj][n];
                    if (rope) {
#pragma unroll
                        for (int n = 0; n < 2; ++n) {
                            const f32x4 c = *(const f32x4*)(ropec + (size_t)row * 32 + 8 * fq + 4 * n), sn = *(const f32x4*)(ropes + (size_t)row * 32 + 8 * fq + 4 * n);
                            const f32x4 lo = v[0][n], hi = v[1][n];
                            v[0][n] = lo * c - hi * sn; v[1][n] = hi * c + lo * sn;
                        }
                    }
                }
                bf16_t* dst = (region < 6) ? hm + (size_t)region * ((size_t)T * 512) + ((size_t)(b * 8 + hb) * SEQ + s) * 64 + 8 * fq
                                           : rg + (size_t)row * 512 + hb * 64 + 8 * fq;
#pragma unroll
                for (int bj = 0; bj < 2; ++bj) *(u32x4*)(dst + 32 * bj) = pack8(v[bj][0], v[bj][1]);
            }
    }
};

constexpr int PF_WAVE_BYTES = 768, PF_BUF_BYTES = 8 * PF_WAVE_BYTES;
struct EpiBf16Plain {
    static constexpr bool PERM = true, AFTER_DRAIN = false;
    bf16_t* O; int ldc;
    __device__ __forceinline__ void operator()(const f32x4 (&acc)[2][2][4][2], const Unit& u, int wr, int wc, int fr, int fq) const {
        const int row0 = u.pm * BM + wr * 64 + fr, col0 = u.pn * BM + wc * 32 + 8 * fq;
#pragma unroll
        for (int ai = 0; ai < 2; ++ai)
#pragma unroll
            for (int m = 0; m < 4; ++m) { bf16_t* rowp = O + (size_t)(row0 + ai * HALF + m * 16) * ldc + col0;
#pragma unroll
                for (int bj = 0; bj < 2; ++bj) *(u32x4*)(rowp + bj * HALF) = pack8(acc[ai][bj][m][0], acc[ai][bj][m][1]); }
    }
};
struct EpiResid {
    static constexpr bool PERM = true, AFTER_DRAIN = false;
    const float* base; bf16_t* X1;
    __device__ __forceinline__ void operator()(const f32x4 (&acc)[2][2][4][2], const Unit& u, int wr, int wc, int fr, int fq) const {
        const int col0 = u.pn * BM + wc * 32 + 8 * fq;
#pragma unroll
        for (int ai = 0; ai < 2; ++ai)
#pragma unroll
            for (int m = 0; m < 4; ++m) { const size_t off = (size_t)(u.pm * BM + ai * HALF + wr * 64 + m * 16 + fr) * DM + col0;
#pragma unroll
                for (int bj = 0; bj < 2; ++bj) { const f32x4 b0 = __builtin_nontemporal_load((const f32x4*)(base + off + bj * HALF)), b1 = __builtin_nontemporal_load((const f32x4*)(base + off + bj * HALF + 4));
                    *(u32x4*)(X1 + off + bj * HALF) = pack8(b0 + acc[ai][bj][m][0], b1 + acc[ai][bj][m][1]); } }
    }
};
struct EpiMoeUp {
    static constexpr bool PERM = true, AFTER_DRAIN = false;
    unsigned char* H; const PG8_LAS unsigned char* pf_lds;
    __device__ __forceinline__ void operator()(const f32x4 (&acc)[2][2][4][2], const Unit& u, int wr, int wc, int fr, int fq) const {
        const int cc = 128 * u.pn + 32 * wc + 8 * fq;
        f32x4 bg[2], bl[2]; float scs[2][4];
        const PG8_LAS unsigned char* buf = pf_lds + (u.seq & 1) * PF_BUF_BYTES + (wr * 4 + wc) * PF_WAVE_BYTES;
#pragma unroll
        for (int n = 0; n < 2; ++n) { bg[n] = *(const PG8_LAS f32x4*)(buf + (8 * fq + 4 * n) * 4); bl[n] = *(const PG8_LAS f32x4*)(buf + 128 + (8 * fq + 4 * n) * 4); }
#pragma unroll
        for (int ai = 0; ai < 2; ++ai)
#pragma unroll
            for (int m = 0; m < 4; ++m) scs[ai][m] = *(const PG8_LAS float*)(buf + 256 + ai * 256 + (m * 16 + fr) * 4);
#pragma unroll
        for (int n = 0; n < 2; ++n) bl[n] = bl[n] + 1.0f;
#pragma unroll
        for (int ai = 0; ai < 2; ++ai)
#pragma unroll
            for (int m = 0; m < 4; ++m) {
                const float sc = scs[ai][m] * 0.015625f;
                f32x4 hv[2];
#pragma unroll
                for (int n = 0; n < 2; ++n) {
                    const f32x4 g0 = acc[ai][0][m][n] * sc + bg[n], l1 = acc[ai][1][m][n] * sc + bl[n];
                    f32x4 glu, lin1;
#pragma unroll
                    for (int j = 0; j < 4; ++j) { glu[j] = __builtin_fminf(g0[j], 7.0f); lin1[j] = __builtin_amdgcn_fmed3f(l1[j], -6.0f, 8.0f); }
                    const f32x4 t = glu * (-1.702f * 1.4426950408889634f);
                    f32x4 e;
#pragma unroll
                    for (int j = 0; j < 4; ++j) e[j] = __builtin_amdgcn_exp2f(t[j]);
                    const f32x4 d = e + 1.0f;
                    f32x4 r;
#pragma unroll
                    for (int j = 0; j < 4; ++j) r[j] = __builtin_amdgcn_rcpf(d[j]);
                    hv[n] = (glu * r) * lin1;
                }
                u32x2 hq; hq.x = (unsigned)__builtin_amdgcn_cvt_pk_fp8_f32(hv[0][0], hv[0][1], 0, false); hq.x = (unsigned)__builtin_amdgcn_cvt_pk_fp8_f32(hv[0][2], hv[0][3], (int)hq.x, true);
                hq.y = (unsigned)__builtin_amdgcn_cvt_pk_fp8_f32(hv[1][0], hv[1][1], 0, false); hq.y = (unsigned)__builtin_amdgcn_cvt_pk_fp8_f32(hv[1][2], hv[1][3], (int)hq.y, true);
                *(u32x2*)(H + (size_t)(u.pm * BM + ai * HALF + wr * 64 + m * 16 + fr) * 1024 + cc) = hq;
            }
    }
};
struct EpiMoeDown {
    static constexpr bool PERM = true, AFTER_DRAIN = false;
    unsigned char* YS; const PG8_LAS unsigned char* pf_lds;
    __device__ __forceinline__ void operator()(const f32x4 (&acc)[2][2][4][2], const Unit& u, int wr, int wc, int fr, int fq) const {
        const int col0 = u.pn * BM + wc * 32 + 8 * fq;
        const PG8_LAS unsigned char* buf = pf_lds + (u.seq & 1) * PF_BUF_BYTES + (wr * 4 + wc) * PF_WAVE_BYTES;
        f32x4 bv[2][2];
#pragma unroll
        for (int bj = 0; bj < 2; ++bj)
#pragma unroll
            for (int n = 0; n < 2; ++n) bv[bj][n] = *(const PG8_LAS f32x4*)(buf + bj * 128 + (8 * fq + 4 * n) * 4);
#pragma unroll
        for (int ai = 0; ai < 2; ++ai)
#pragma unroll
            for (int m = 0; m < 4; ++m) { unsigned char* rowp = YS + (size_t)(u.pm * BM + ai * HALF + wr * 64 + m * 16 + fr) * 1024 + col0;
#pragma unroll
                for (int bj = 0; bj < 2; ++bj) { const f32x4 y0 = acc[ai][bj][m][0] * 0.015625f + bv[bj][0], y1 = acc[ai][bj][m][1] * 0.015625f + bv[bj][1];
                    u32x2 q; q.x = (unsigned)__builtin_amdgcn_cvt_pk_fp8_f32(y0[0], y0[1], 0, false); q.x = (unsigned)__builtin_amdgcn_cvt_pk_fp8_f32(y0[2], y0[3], (int)q.x, true);
                    q.y = (unsigned)__builtin_amdgcn_cvt_pk_fp8_f32(y1[0], y1[1], 0, false); q.y = (unsigned)__builtin_amdgcn_cvt_pk_fp8_f32(y1[2], y1[3], (int)q.y, true);
                    *(u32x2*)(rowp + bj * HALF) = q; } }
    }
};
struct EpiPle {
    static constexpr bool PERM = false, AFTER_DRAIN = false;
    const bf16_t* X2; const bf16_t* PJ; float* outw;
    __device__ __forceinline__ void operator()(const f32x4 (&acc)[2][2][4][2], const Unit& u, int wr, int wc, int fr, int fq) const {
        const int col0 = u.pn * BM + wc * 32 + 4 * fq;
#pragma unroll
        for (int ai = 0; ai < 2; ++ai)
#pragma unroll
            for (int m = 0; m < 4; ++m) { const size_t off = (size_t)(u.pm * BM + ai * HALF + wr * 64 + m * 16 + fr) * DM + col0;
#pragma unroll
                for (int bj = 0; bj < 2; ++bj)
#pragma unroll
                    for (int n = 0; n < 2; ++n) {
                        const size_t o2 = off + bj * HALF + n * 16;
                        const u32x2 xq = __builtin_nontemporal_load((const u32x2*)(X2 + o2)); const f32x4 x2 = (f32x4){__uint_as_float(xq.x << 16), __uint_as_float(xq.x & 0xffff0000u), __uint_as_float(xq.y << 16), __uint_as_float(xq.y & 0xffff0000u)}; const u32x2 pj = __builtin_nontemporal_load((const u32x2*)(PJ + o2)); const f32x4 a = acc[ai][bj][m][n] * 0.015625f;
                        f32x4 r;
                        r[0] = x2[0] + __uint_as_float(pj.x << 16) * __builtin_amdgcn_rcpf(1.0f + __builtin_amdgcn_exp2f(-1.4426950408889634f * a[0]));
                        r[1] = x2[1] + __uint_as_float(pj.x & 0xffff0000u) * __builtin_amdgcn_rcpf(1.0f + __builtin_amdgcn_exp2f(-1.4426950408889634f * a[1]));
                        r[2] = x2[2] + __uint_as_float(pj.y << 16) * __builtin_amdgcn_rcpf(1.0f + __builtin_amdgcn_exp2f(-1.4426950408889634f * a[2]));
                        r[3] = x2[3] + __uint_as_float(pj.y & 0xffff0000u) * __builtin_amdgcn_rcpf(1.0f + __builtin_amdgcn_exp2f(-1.4426950408889634f * a[3]));
                        __builtin_nontemporal_store(r, (f32x4*)(outw + o2));
                    } }
    }
};
struct MoeOrder {
    int nM, nN, nwg, G, c, wid, mode; const PG8_LAS int* tile_e; const float* pf_bias; const float* pf_rstd; PG8_LAS unsigned char* pf_lds;
    const int* toklist; const PG8_LAS int* first_tile; PG8_LAS unsigned char* tokl;
    __device__ __forceinline__ const int* tok_src(const Unit& u) const { return toklist + (size_t)u.e * T + 256 * (u.pm - first_tile[u.e]); }
    __device__ __forceinline__ PG8_LAS unsigned char* tok_lds() const { return tokl; }
    __device__ void init(int nM_, int nN_, int G_, int c_, const PG8_LAS int* te, int wid_, int mode_, const float* pb, const float* pr, PG8_LAS unsigned char* pl) { nM = nM_; nN = nN_; nwg = nM * nN; G = G_; c = c_; tile_e = te; wid = wid_; mode = mode_; pf_bias = pb; pf_rstd = pr; pf_lds = pl; }
    __device__ bool next(int i, Unit& u) const {
        const long L = (long)i * G + c; if (L >= nwg) return false;
        int wgid = (int)L; { const int q = nwg / NXCD, r = nwg % NXCD, xcd = wgid % NXCD, off = wgid / NXCD; wgid = (xcd < r ? xcd * (q + 1) : r * (q + 1) + (xcd - r) * q) + off; }
        const int nig = WGM * nN, gid = wgid / nig, fm = gid * WGM, gsz = (nM - fm) < WGM ? (nM - fm) : WGM;
        u.pm = fm + ((wgid % nig) % gsz); u.pn = (wgid % nig) / gsz; u.e = __builtin_amdgcn_readfirstlane(tile_e[u.pm]); u.seq = i; return true;
    }
    __device__ __forceinline__ void a_ready(const Unit& u) const {
        const int lane = (int)__builtin_amdgcn_mbcnt_hi(~0u, __builtin_amdgcn_mbcnt_lo(~0u, 0u)), wr = wid >> 2, wc = wid & 3;
        PG8_LAS unsigned char* buf = pf_lds + (u.seq & 1) * PF_BUF_BYTES + wid * PF_WAVE_BYTES;
        if (mode == 1) {
            const float* bsrc = pf_bias + (size_t)u.e * 2048 + 128 * u.pn + 32 * wc + (lane & 31) + ((lane >> 5) ? 1024 : 0);
            __builtin_amdgcn_global_load_lds((const unsigned*)bsrc, (PG8_LAS unsigned*)buf, 4, 0, 0);
            const PG8_LAS int* tl = (const PG8_LAS int*)(tokl + 1024 * (u.seq & 1)) + wr * 64 + lane;
            __builtin_amdgcn_global_load_lds((const unsigned*)(pf_rstd + tl[0]), (PG8_LAS unsigned*)(buf + 256), 4, 0, 0);
            __builtin_amdgcn_global_load_lds((const unsigned*)(pf_rstd + tl[HALF]), (PG8_LAS unsigned*)(buf + 512), 4, 0, 0);
        } else if (mode == 2) {
            const float* bsrc = pf_bias + (size_t)u.e * 1024 + u.pn * BM + 32 * wc + (lane & 31) + ((lane >> 5) ? HALF : 0);
            __builtin_amdgcn_global_load_lds((const unsigned*)bsrc, (PG8_LAS unsigned*)buf, 4, 0, 0);
        }
    }
    __device__ __forceinline__ void done(const Unit&) const {}
};
struct EpiNull {
    static constexpr bool PERM = true, AFTER_DRAIN = false;
    __device__ __forceinline__ void operator()(const f32x4 (&acc)[2][2][4][2], const Unit& u, int wr, int wc, int fr, int fq) const {
#pragma unroll
        for (int ai = 0; ai < 2; ++ai)
#pragma unroll
            for (int bj = 0; bj < 2; ++bj)
#pragma unroll
                for (int m = 0; m < 4; ++m)
#pragma unroll
                    for (int n = 0; n < 2; ++n) asm volatile("" :: "v"(acc[ai][bj][m][n]));
    }
};
template <class Epi, class Sched, bool ALIGN_EPI = false, bool SP2 = false, bool F8 = false, bool GATHER = false>
__device__ __forceinline__ void gemm_phase(PG8_LAS unsigned char* lds, const Gemm g, const Sched& S, const Epi& E, const int wave_id) {
    int tid_ = wave_id * 64 + lane_id_hw(); asm volatile("" : "+v"(tid_));
    const int tid = tid_, wid = __builtin_amdgcn_readfirstlane(tid >> 6), lane = tid & 63, wr = wid >> 2, wc = wid & 3, fr = lane & 15, fq = lane >> 4;
    const int K = g.K, nt = K / BK;
    unsigned voffA[2], voffB[2];
#pragma unroll
    for (int i = 0; i < 2; ++i) { int R, C; stage_rc(tid * 16 + i * 8192, R, C); const int Rb = Epi::PERM ? ((R & ~31) + perm32(R & 31)) : R;
        voffA[i] = (unsigned)(R * K + C) * 2u; voffB[i] = (unsigned)(Rb * K + C) * 2u; }
    const size_t kstep = (size_t)(BK * 2);
    const size_t hstep = (size_t)HALF * K * 2;
    const size_t tstep = 2 * hstep;
    const size_t hstepA = GATHER ? 0 : hstep;
    unsigned gC[2][2];
#pragma unroll
    for (int h = 0; h < 2; ++h)
#pragma unroll
        for (int i = 0; i < 2; ++i) gC[h][i] = voffA[i];
#define PG8_TOK_DMA(U, par) do { if constexpr (GATHER) { if (wid < 4) __builtin_amdgcn_global_load_lds((const unsigned*)(S.tok_src(U) + 64 * wid + (int)__builtin_amdgcn_mbcnt_hi(~0u, __builtin_amdgcn_mbcnt_lo(~0u, 0u))), (PG8_LAS unsigned*)(S.tok_lds() + 1024 * (par) + 256 * wid), 4, 0, 0); } } while (0)
#define PG8_TOK_READ(dst, par) do { if constexpr (GATHER) { _Pragma("unroll") for (int i = 0; i < 2; ++i) { int R_, C_; stage_rc((wid * 64 + (int)__builtin_amdgcn_mbcnt_hi(~0u, __builtin_amdgcn_mbcnt_lo(~0u, 0u))) * 16 + i * 8192, R_, C_); _Pragma("unroll") for (int h = 0; h < 2; ++h) \
        dst[h][i] = (unsigned)(*(const PG8_LAS int*)(S.tok_lds() + 1024 * (par) + 4 * (h * HALF + R_))) * (unsigned)(K * 2) + (unsigned)C_ * 2u; } } } while (0)
    const unsigned ldsw = (unsigned)wid * 1024u;
    const int aoff = lds_byte(wr * 64 + fr, fq * 8), boff = lds_byte(wc * 32 + fr, fq * 8);
#define PG8_SA(b, h) (((b) * 2 + (h)) * HTB)
#define PG8_SB(b, h) ((4 + (b) * 2 + (h)) * HTB)
#define PG8_STAGE(bufoff, gbase, voff) do { _Pragma("unroll") for (int _i = 0; _i < 2; ++_i) \
        __builtin_amdgcn_global_load_lds((const unsigned*)((const char*)(gbase) + (voff)[_i]), (PG8_LAS unsigned*)(lds + (bufoff) + ldsw + _i * 8192), 16, 0, 0); } while (0)
#define PG8_LD16(off) (*(const PG8_LAS v4i32*)(lds + (off)))
#define PG8_LDA(dst, b, h) do { if constexpr (F8) { _Pragma("unroll") for (int m = 0; m < 4; ++m) dst##8[m] = __builtin_shufflevector(PG8_LD16(PG8_SA(b, h) + aoff + m * 2048), PG8_LD16(PG8_SA(b, h) + aoff + m * 2048 + 1024), 0, 1, 2, 3, 4, 5, 6, 7); } \
        else { _Pragma("unroll") for (int m = 0; m < 4; ++m) _Pragma("unroll") for (int k = 0; k < 2; ++k) dst[m][k] = *(const PG8_LAS bf16x8*)(lds + PG8_SA(b, h) + aoff + m * 2048 + k * 1024); } } while (0)
#define PG8_LDB(dst, b, h) do { if constexpr (F8) { _Pragma("unroll") for (int n = 0; n < 2; ++n) dst##8[n] = __builtin_shufflevector(PG8_LD16(PG8_SB(b, h) + boff + n * 2048), PG8_LD16(PG8_SB(b, h) + boff + n * 2048 + 1024), 0, 1, 2, 3, 4, 5, 6, 7); } \
        else { _Pragma("unroll") for (int n = 0; n < 2; ++n) _Pragma("unroll") for (int k = 0; k < 2; ++k) dst[n][k] = *(const PG8_LAS bf16x8*)(lds + PG8_SB(b, h) + boff + n * 2048 + k * 1024); } } while (0)
#define PG8_MMA(ai, bj, At, Bt) do { __builtin_amdgcn_s_setprio(1); \
        if constexpr (F8) { _Pragma("unroll") for (int m = 0; m < 4; ++m) _Pragma("unroll") for (int n = 0; n < 2; ++n) \
            asm volatile("v_mfma_scale_f32_16x16x128_f8f6f4 %0, %1, %2, %0, %3, %3 op_sel_hi:[0,0,0]" : "+v"(acc[ai][bj][m][n]) : "v"(Bt##8[n]), "v"(At##8[m]), "v"(f8scale)); } \
        else { _Pragma("unroll") for (int m = 0; m < 4; ++m) _Pragma("unroll") for (int n = 0; n < 2; ++n) _Pragma("unroll") for (int k = 0; k < 2; ++k) \
            acc[ai][bj][m][n] = __builtin_amdgcn_mfma_f32_16x16x32_bf16(Bt[n][k], At[m][k], acc[ai][bj][m][n], 0, 0, 0); } \
        __builtin_amdgcn_s_setprio(0); } while (0)
#define PG8_WAIT_V(n) asm volatile("s_waitcnt vmcnt(" #n ")" ::: "memory")
#define PG8_WAIT_L(n) asm volatile("s_waitcnt lgkmcnt(" #n ")" ::: "memory")
#define PG8_BAR __builtin_amdgcn_s_barrier()
#define PG8_SCHED __builtin_amdgcn_sched_barrier(0)
    Unit cur, nxt; int ui = 0;
    if (!S.next(0, cur)) return;
    f32x4 acc[2][2][4][2];
#pragma unroll
    for (int a = 0; a < 2; ++a)
#pragma unroll
        for (int b = 0; b < 2; ++b)
#pragma unroll
            for (int m = 0; m < 4; ++m)
#pragma unroll
                for (int n = 0; n < 2; ++n) acc[a][b][m][n] = (f32x4){0.f, 0.f, 0.f, 0.f};
    bf16x8 At[4][2], B0[2][2], B1[2][2];
    v8i32 At8[4], B08[2], B18[2]; const int f8scale = 0x7f7f7f7f;
    const char* cA = (const char*)g.A + (GATHER ? (size_t)0 : (size_t)cur.pm * tstep); const char* cB = (const char*)g.Bt + (size_t)cur.e * g.strideBe + (size_t)cur.pn * tstep;
    if constexpr (GATHER) { PG8_TOK_DMA(cur, 0); asm volatile("s_waitcnt vmcnt(0)" ::: "memory"); PG8_BAR; PG8_TOK_READ(gC, 0); }
    S.a_ready(cur);
    if constexpr (SP2) {
        PG8_STAGE(PG8_SB(0, 0), cB, voffB); PG8_STAGE(PG8_SB(0, 1), cB + hstep, voffB); PG8_STAGE(PG8_SA(0, 0), cA, gC[0]); PG8_STAGE(PG8_SA(0, 1), cA + hstepA, gC[1]);
        if (wr == 1) PG8_BAR;
        PG8_WAIT_V(2); PG8_BAR;
        PG8_STAGE(PG8_SB(1, 0), cB + kstep, voffB); PG8_STAGE(PG8_SA(1, 0), cA + kstep, gC[0]); PG8_STAGE(PG8_SB(1, 1), cB + hstep + kstep, voffB);
        PG8_WAIT_V(6); PG8_BAR;
    } else {
        PG8_STAGE(PG8_SB(0, 0), cB, voffB); PG8_STAGE(PG8_SA(0, 0), cA, voffA); PG8_STAGE(PG8_SB(0, 1), cB + hstep, voffB); PG8_STAGE(PG8_SA(0, 1), cA + hstep, voffA);
        if (wr == 1) PG8_BAR;
        PG8_WAIT_V(4); PG8_BAR;
        PG8_STAGE(PG8_SB(1, 0), cB + kstep, voffB); PG8_STAGE(PG8_SA(1, 0), cA + kstep, voffA); PG8_STAGE(PG8_SB(1, 1), cB + hstep + kstep, voffB);
        PG8_WAIT_V(6); PG8_BAR;
    }
    for (;;) {
        const bool has_next = S.next(ui + 1, nxt);
        const char* nA = (has_next && !GATHER) ? (const char*)g.A + (size_t)nxt.pm * tstep : cA;
        const char* nB = has_next ? (const char*)g.Bt + (size_t)nxt.e * g.strideBe + (size_t)nxt.pn * tstep : cB;
        if (has_next) PG8_TOK_DMA(nxt, (ui + 1) & 1);
#pragma unroll 1
        for (int t = 0; t < nt; t += 2) {
            const bool last = (t == nt - 2);
            const char* a1 = cA + (size_t)(t + 1) * kstep;
            const char* a2 = last ? nA : cA + (size_t)(t + 2) * kstep; const char* b2 = last ? nB : cB + (size_t)(t + 2) * kstep;
            const char* a3 = a2 + kstep; const char* b3 = b2 + kstep;
            if (last && has_next) S.a_ready(nxt);
            if constexpr (SP2) {
            PG8_LDB(B0, 0, 0); PG8_LDB(B1, 0, 1); PG8_SCHED; PG8_LDA(At, 0, 0); PG8_STAGE(PG8_SA(1, 1), a1 + hstepA, gC[1]);
            if constexpr (GATHER) { if (last && has_next) PG8_TOK_READ(gC, (ui + 1) & 1); }
            PG8_WAIT_V(8); PG8_WAIT_L(0); PG8_BAR; PG8_MMA(0, 0, At, B0); PG8_MMA(0, 1, At, B1); PG8_BAR; PG8_SCHED;
            PG8_LDA(At, 0, 1); PG8_STAGE(PG8_SB(0, 0), b2, voffB); PG8_STAGE(PG8_SB(0, 1), b2 + hstep, voffB); PG8_STAGE(PG8_SA(0, 0), a2, gC[0]);
            PG8_WAIT_V(8); PG8_WAIT_L(0); PG8_BAR; PG8_MMA(1, 0, At, B0); PG8_MMA(1, 1, At, B1); PG8_BAR; PG8_SCHED;
            PG8_LDB(B0, 1, 0); PG8_LDB(B1, 1, 1); PG8_SCHED; PG8_LDA(At, 1, 0); PG8_STAGE(PG8_SA(0, 1), a2 + hstepA, gC[1]);
            PG8_WAIT_V(8); PG8_WAIT_L(0); PG8_BAR; PG8_MMA(0, 0, At, B0); PG8_MMA(0, 1, At, B1); PG8_BAR; PG8_SCHED;
            PG8_LDA(At, 1, 1); PG8_STAGE(PG8_SB(1, 0), b3, voffB); PG8_STAGE(PG8_SB(1, 1), b3 + hstep, voffB); PG8_STAGE(PG8_SA(1, 0), a3, gC[0]);
            PG8_WAIT_V(8); PG8_WAIT_L(0); PG8_BAR; PG8_MMA(1, 0, At, B0); PG8_MMA(1, 1, At, B1); PG8_BAR; PG8_SCHED;
            } else {
            PG8_LDB(B0, 0, 0); PG8_SCHED; PG8_LDA(At, 0, 0); PG8_STAGE(PG8_SA(1, 1), a1 + hstep, voffA);
            PG8_WAIT_L(8); PG8_BAR; PG8_WAIT_L(0); PG8_MMA(0, 0, At, B0); PG8_BAR; PG8_SCHED;
            PG8_LDB(B1, 0, 1); PG8_STAGE(PG8_SB(0, 0), b2, voffB);
            PG8_BAR; PG8_WAIT_L(0); PG8_MMA(0, 1, At, B1); PG8_BAR;
            PG8_LDA(At, 0, 1); PG8_STAGE(PG8_SA(0, 0), a2, voffA);
            PG8_BAR; PG8_WAIT_L(0); PG8_MMA(1, 0, At, B0); PG8_BAR; PG8_SCHED;
            PG8_STAGE(PG8_SB(0, 1), b2 + hstep, voffB);
            PG8_WAIT_V(6); PG8_BAR; PG8_MMA(1, 1, At, B1); PG8_BAR;
            PG8_LDB(B0, 1, 0); PG8_SCHED; PG8_LDA(At, 1, 0); PG8_STAGE(PG8_SA(0, 1), a2 + hstep, voffA);
            PG8_WAIT_L(8); PG8_BAR; PG8_WAIT_L(0); PG8_MMA(0, 0, At, B0); PG8_BAR; PG8_SCHED;
            PG8_LDB(B1, 1, 1); PG8_STAGE(PG8_SB(1, 0), b3, voffB);
            PG8_BAR; PG8_WAIT_L(0); PG8_MMA(0, 1, At, B1); PG8_BAR;
            PG8_LDA(At, 1, 1); PG8_STAGE(PG8_SA(1, 0), a3, voffA);
            PG8_BAR; PG8_WAIT_L(0); PG8_MMA(1, 0, At, B0); PG8_BAR; PG8_SCHED;
            PG8_STAGE(PG8_SB(1, 1), b3 + hstep, voffB);
            PG8_WAIT_V(6); PG8_BAR; PG8_MMA(1, 1, At, B1); PG8_BAR;
            }
        }
        if constexpr (ALIGN_EPI) { if (wr == 0) PG8_BAR; }
        if constexpr (F8) asm volatile("s_nop 15\n\ts_nop 15\n\ts_nop 15" ::: "memory");
        if constexpr (!Epi::AFTER_DRAIN) { E(acc, cur, wr, wc, fr, fq); S.done(cur); }
        if (!has_next) break;
#pragma unroll
        for (int a = 0; a < 2; ++a)
#pragma unroll
            for (int b = 0; b < 2; ++b)
#pragma unroll
                for (int m = 0; m < 4; ++m)
#pragma unroll
                    for (int n = 0; n < 2; ++n) acc[a][b][m][n] = (f32x4){0.f, 0.f, 0.f, 0.f};
        cur = nxt; cA = nA; cB = nB; ++ui;
        if constexpr (ALIGN_EPI) { if (wr == 1) PG8_BAR; }
    }
    PG8_WAIT_V(0);
    if constexpr (!ALIGN_EPI) { if (wr == 0) PG8_BAR; }
    PG8_BAR;
    if constexpr (Epi::AFTER_DRAIN) { E.fused(acc, cur, wr, wc, fr, fq, lds, wid, lane); S.done(cur); }
#undef PG8_TOK_DMA
#undef PG8_TOK_READ
#undef PG8_SA
#undef PG8_SB
#undef PG8_STAGE
#undef PG8_LD16
#undef PG8_LDA
#undef PG8_LDB
#undef PG8_MMA
#undef PG8_WAIT_V
#undef PG8_WAIT_L
#undef PG8_BAR
#undef PG8_SCHED
}
}

constexpr int NWAVES = 8;
constexpr int T = pg8::T, SEQ = pg8::SEQ, DM = pg8::DM, DIN = pg8::DIN, NE = 32, PLE = 256;
constexpr float EPS = pg8::EPS;
constexpr size_t MiB = 1u << 20;
constexpr size_t WS_CTL = 0, CTL_ZERO_BYTES = 1 * MiB;
constexpr size_t WS_WT_IN = 2 * MiB, WS_WT_OUT = 9 * MiB, WS_WT_PG = 11 * MiB, WS_WT_PP = 13 * MiB;
constexpr size_t WS_GAINS = 13 * MiB + 512 * 1024;
constexpr size_t WS_WRT = 13 * MiB + 576 * 1024;
constexpr size_t WS_ROPEC = 14 * MiB, WS_ROPES = 16 * MiB, WS_PB = 18 * MiB, WS_ROUTE = 26 * MiB;
constexpr size_t WS_TOKLIST = 29 * MiB;
constexpr size_t WS_WT_UG = 32 * MiB, WS_WT_DN = 160 * MiB;
constexpr size_t WS_XN = 224 * MiB;
constexpr size_t WS_HM = 256 * MiB;
constexpr size_t WS_X1 = 256 * MiB;
constexpr size_t WS_RG = 352 * MiB;
constexpr size_t WS_Y = 368 * MiB;
constexpr size_t WS_PJ = 400 * MiB;
constexpr size_t WS_XS = 432 * MiB, WS_H = 576 * MiB, WS_YS = 720 * MiB;
constexpr size_t WS_END = 864 * MiB;
constexpr int CW_TMO = 0, CW_CODE = 1;
constexpr int CW_BAR = 4096;
constexpr int RING_OFF = 0, RING_BYTES = 131072;
constexpr int LDSCTL_OFF = RING_BYTES, MISC_OFF = LDSCTL_OFF + 320;
constexpr int PF_OFF = LDSCTL_OFF + 4096;
constexpr int TOKL_OFF = LDSCTL_OFF + 16384;
constexpr int LDS_BYTES = 151552;
#define GAS __attribute__((address_space(1)))
#define LAS __attribute__((address_space(3)))
typedef unsigned short bf16;
typedef unsigned v4u __attribute__((ext_vector_type(4)));
typedef float f32x4 __attribute__((ext_vector_type(4)));
typedef short bf16x8 __attribute__((ext_vector_type(8)));
typedef unsigned u32x4_t __attribute__((ext_vector_type(4)));
typedef unsigned u32x2_t __attribute__((ext_vector_type(2)));
typedef GAS unsigned gu32;
typedef GAS unsigned long long gu64;
#define RLX_AGENT __ATOMIC_RELAXED, __HIP_MEMORY_SCOPE_AGENT
#define LDS_WAIT() asm volatile("s_waitcnt lgkmcnt(0)" ::: "memory")
#define VM_WAIT() asm volatile("s_waitcnt vmcnt(0)" ::: "memory")
__device__ __forceinline__ unsigned long long rt() { return __builtin_amdgcn_s_memrealtime(); }
__device__ __forceinline__ unsigned f2bf(float f) { unsigned u = __builtin_bit_cast(unsigned, f); return (u + 0x7fffu + ((u >> 16) & 1u)) >> 16; }
__device__ __forceinline__ unsigned pk2(float lo, float hi) { return f2bf(lo) | (f2bf(hi) << 16); }

#define XB_TMO      128
#define XB_XCNT(j)  (256  + 64 * (j))
#define XB_XSUB(j)  (1280 + 64 * (j))
#define XB_XGEN(j)  (2304 + 64 * (j))
#define XB_TOP      3328
#define XB_TOPGEN   3392
#define XCD_BAR_WORDS 3456
#define XB_SPIN_CAP (1u << 18)

__device__ __forceinline__ unsigned xb_ld(unsigned* p)              { return __hip_atomic_load(p, __ATOMIC_RELAXED, __HIP_MEMORY_SCOPE_AGENT); }
__device__ __forceinline__ unsigned xb_add(unsigned* p, unsigned v) { return __hip_atomic_fetch_add(p, v, __ATOMIC_RELAXED, __HIP_MEMORY_SCOPE_AGENT); }
__device__ __forceinline__ unsigned xb_xcc_id() { return (unsigned)__builtin_amdgcn_s_getreg((3 << 11) | 20) & 0xFu; }
#define XB_SPIN(cond, bar) do { unsigned _sp = 0; while (cond) { __builtin_amdgcn_s_sleep(1); \
    if ((++_sp & 255u) == 0u) { if (xb_ld(&(bar)[XB_TMO])) break; if (_sp > XB_SPIN_CAP) { atomicAdd(&(bar)[XB_TMO], 1u); break; } } } } while (0)

struct XcdBarrier {
    unsigned* bar; unsigned x; int wave;
    volatile LAS unsigned* st;
};

__device__ __forceinline__ XcdBarrier xcd_barrier_post(unsigned* bar, volatile LAS unsigned* st) {
    XcdBarrier b; b.bar = bar; b.x = xb_xcc_id(); b.st = st;
    if (threadIdx.x == 0) (void)xb_add(&bar[XB_XCNT(b.x)], 1u);
    return b;
}
__device__ __forceinline__ void xcd_barrier_complete(unsigned* bar, unsigned x, unsigned& nloc, unsigned& nx) {
    const unsigned G = gridDim.x * gridDim.y * gridDim.z;
    unsigned sum, cnt, mine, sp = 0u;
    for (;;) {
        sum = 0u; cnt = 0u; mine = 0u;
#pragma unroll
        for (unsigned j = 0; j < 16; ++j) { const unsigned c = xb_ld(&bar[XB_XCNT(j)]); sum += c; cnt += (c > 0u) ? 1u : 0u; mine = (j == x) ? c : mine; }
        if (sum == G) break;
        __builtin_amdgcn_s_sleep(1);
        if ((++sp & 255u) == 0u) { if (xb_ld(&bar[XB_TMO])) break; if (sp > XB_SPIN_CAP) { atomicAdd(&bar[XB_TMO], 1u); break; } }
    }
    nloc = mine > 0u ? mine : 1u; nx = cnt > 0u ? cnt : 1u;
}

__device__ __forceinline__ void xcd_barrier(const XcdBarrier& b) {
    asm volatile("s_waitcnt vmcnt(0)" ::: "memory");
    __syncthreads();
    if (b.wave == 0 && lane_id_hw() == 0) {
        unsigned* bar = b.bar;
        __builtin_amdgcn_s_waitcnt(0);
        unsigned nloc = b.st[0], nx = b.st[1];
        if (nloc == 0u) { xcd_barrier_complete(bar, b.x, nloc, nx); b.st[0] = nloc; b.st[1] = nx; }
        const unsigned old = xb_add(&bar[XB_XSUB(b.x)], 1u);
        const unsigned gen = old / nloc;
        const unsigned tgen = gen;
        if (old + 1u == (gen + 1u) * nloc) {
            __builtin_amdgcn_fence(__ATOMIC_RELEASE, "agent");
            asm volatile("s_waitcnt vmcnt(0)" ::: "memory");
            const unsigned og = xb_add(&bar[XB_TOP], 1u);
            const unsigned tg = og / nx;
            if (og + 1u == (tg + 1u) * nx) xb_add(&bar[XB_TOPGEN], 1u);
            else XB_SPIN(xb_ld(&bar[XB_TOPGEN]) == tg, bar);
        } else {
            XB_SPIN(xb_ld(&bar[XB_TOPGEN]) == tgen, bar);
        }
        __builtin_amdgcn_fence(__ATOMIC_ACQUIRE, "agent");
        asm volatile("s_waitcnt vmcnt(0)" ::: "memory");
    }
    __syncthreads();
}

struct Args {
    const float* x; const float* p; const int* positions; const float* g_mix; const float* w_in;
    const float* sbq; const float* sbk; const float* rq; const float* rk; const float* gn_g; const float* gn_b; const float* w_out;
    const float* g_ffn; const float* w_r; const float* b_r; const float* w_ug; const float* b_ug; const float* w_dn; const float* b_dn;
    const float* g_ple; const float* w_pg; const float* w_pp;
    float* out; unsigned char* ws; int ph_lo, ph_hi;
};
struct Frame {
    LAS unsigned char* lds;
    volatile LAS unsigned* MISC;
    gu32* ctl;
    int wave;
    int vcu, G;
};
__device__ __forceinline__ int tid_now(int wave_id) { int t = wave_id * 64 + lane_id_hw(); asm volatile("" : "+v"(t)); return t; }
__device__ __forceinline__ float wave_sum(float v) {
#pragma unroll
    for (int o = 1; o < 64; o <<= 1) v += __shfl_xor(v, o);
    return v;
}
__device__ __forceinline__ unsigned cvtpk(float lo, float hi) { return pg8::cvt_pk_bf16(lo, hi); }

enum { MAP_NAT = 0, MAP_IN = 1, MAP_UG = 2 };
__device__ __forceinline__ void p0_item(const float* __restrict__ W, int N, int K, bf16* __restrict__ WT, int kb, int nb, int mapmode, LAS unsigned char* scr, int lane) {
    const int np = 64 * nb + 4 * (lane & 15);
    int src = np;
    if (mapmode == MAP_IN) { const int pn = np >> 8, L = np & 255, bj = L >> 7, wc = (L >> 5) & 3, e = L & 31; src = 256 * pn + 64 * wc + 32 * bj + e; }
    else if (mapmode == MAP_UG) { const int pn = np >> 8, L = np & 255, bj = L >> 7, i = L & 127; src = 1024 * bj + 128 * pn + i; }
    const float* gp = W + (size_t)(64 * kb + (lane >> 4)) * N + src;
    f32x4 v[16];
#pragma unroll
    for (int i = 0; i < 16; ++i) v[i] = *(const f32x4*)(gp + (size_t)(4 * i) * N);
#pragma unroll
    for (int i = 0; i < 16; ++i) {
        LAS unsigned* d = (LAS unsigned*)(scr + (4 * i + (lane >> 4)) * 132 + 8 * (lane & 15));
        d[0] = cvtpk(v[i][0], v[i][1]); d[1] = cvtpk(v[i][2], v[i][3]);
    }
    LDS_WAIT(); asm volatile("" ::: "memory");
    const int c = lane & 7;
#pragma unroll
    for (int it = 0; it < 4; ++it) {
        const int nl = 16 * it + 2 * (lane >> 3);
        unsigned d[8];
#pragma unroll
        for (int j = 0; j < 8; ++j) d[j] = *(const LAS unsigned*)(scr + (8 * c + j) * 132 + 2 * nl);
        v4u o0, o1;
        o0.x = (d[0] & 0xffffu) | (d[1] << 16); o0.y = (d[2] & 0xffffu) | (d[3] << 16); o0.z = (d[4] & 0xffffu) | (d[5] << 16); o0.w = (d[6] & 0xffffu) | (d[7] << 16);
        o1.x = (d[0] >> 16) | (d[1] & 0xffff0000u); o1.y = (d[2] >> 16) | (d[3] & 0xffff0000u); o1.z = (d[4] >> 16) | (d[5] & 0xffff0000u); o1.w = (d[6] >> 16) | (d[7] & 0xffff0000u);
        bf16* dst = WT + (size_t)(64 * nb + nl) * K + 64 * kb + 8 * c;
        *(v4u*)dst = o0; *(v4u*)(dst + K) = o1;
    }
    LDS_WAIT(); asm volatile("" ::: "memory");
}
__device__ __forceinline__ unsigned pk4_fp8(float a, float b, float c, float d) { int r = __builtin_amdgcn_cvt_pk_fp8_f32(a, b, 0, false); r = __builtin_amdgcn_cvt_pk_fp8_f32(c, d, r, true); return (unsigned)r; }
__device__ __forceinline__ void p0_item_f8(const float* __restrict__ W, int N, int K, unsigned char* __restrict__ WT, int kb, int nb, int mapmode, LAS unsigned char* scr, int lane) {
    const int np = 64 * nb + 4 * (lane & 15);
    int src = np;
    if (mapmode == MAP_UG) { const int pn = np >> 8, L = np & 255, bj = L >> 7, i = L & 127; src = 1024 * bj + 128 * pn + i; }
    const float* gp = W + (size_t)(64 * kb + (lane >> 4)) * N + src;
    f32x4 v[16];
#pragma unroll
    for (int i = 0; i < 16; ++i) v[i] = *(const f32x4*)(gp + (size_t)(4 * i) * N);
#pragma unroll
    for (int i = 0; i < 16; ++i) *(LAS unsigned*)(scr + (4 * i + (lane >> 4)) * 68 + 4 * (lane & 15)) = pk4_fp8(v[i][0] * 64.0f, v[i][1] * 64.0f, v[i][2] * 64.0f, v[i][3] * 64.0f);
    LDS_WAIT(); asm volatile("" ::: "memory");
    const int nq = lane & 15, kg = lane >> 4;
    unsigned d[16];
#pragma unroll
    for (int j = 0; j < 16; ++j) d[j] = *(const LAS unsigned*)(scr + (16 * kg + j) * 68 + 4 * nq);
#pragma unroll
    for (int t = 0; t < 4; ++t) {
        v4u o;
#pragma unroll
        for (int q = 0; q < 4; ++q) o[q] = ((d[4 * q] >> (8 * t)) & 0xffu) | (((d[4 * q + 1] >> (8 * t)) & 0xffu) << 8) | (((d[4 * q + 2] >> (8 * t)) & 0xffu) << 16) | (((d[4 * q + 3] >> (8 * t)) & 0xffu) << 24);
        *(v4u*)(WT + (size_t)(64 * nb + 4 * nq + t) * K + 64 * kb + 16 * kg) = o;
    }
    LDS_WAIT(); asm volatile("" ::: "memory");
}
struct P0D { const float* gp; int N, K, kb, nb; bf16* W16; unsigned char* W8; const float* rsc; };
__device__ __forceinline__ int p0_src_col(int np, int mapmode) {
    int src = np;
    if (mapmode == MAP_IN) { const int pn = np >> 8, L = np & 255, bj = L >> 7, wc = (L >> 5) & 3, e = L & 31; src = 256 * pn + 64 * wc + 32 * bj + e; }
    else if (mapmode == MAP_UG) { const int pn = np >> 8, L = np & 255, bj = L >> 7, i = L & 127; src = 1024 * bj + 128 * pn + i; }
    return src;
}
__device__ __forceinline__ P0D p0_mk(const float* W, int N, int K, bf16* W16, unsigned char* W8, int kb, int nb, int mapmode, int lane, const float* rsc = nullptr) {
    P0D d; d.N = N; d.K = K; d.kb = kb; d.nb = nb; d.W16 = W16; d.W8 = W8;
    if (W8) {
        d.rsc = rsc ? rsc + 128 * kb + (lane >> 3) : nullptr;
        d.gp = W + (size_t)(128 * kb + (lane >> 3)) * N + p0_src_col(32 * nb + 4 * (lane & 7), mapmode);
    } else {
        d.rsc = nullptr;
        d.gp = W + (size_t)(64 * kb + (lane >> 4)) * N + p0_src_col(64 * nb + 4 * (lane & 15), mapmode);
    }
    return d;
}
__device__ __forceinline__ void p0_load(const P0D& d, f32x4 (&v)[16]) {
#pragma unroll
    for (int i = 0; i < 16; ++i) v[i] = __builtin_nontemporal_load((const f32x4*)(d.gp + (size_t)((d.W8 ? 8 : 4) * i) * d.N));
}
__device__ __forceinline__ void p0_finish(const P0D& d, const f32x4 (&v)[16], LAS unsigned char* scr, int lane, const int pm = 0) {
    if (pm == 1) { _Pragma("unroll") for (int i = 0; i < 16; ++i) asm volatile("" :: "v"(v[i])); return; }
    if (d.W16) {
#pragma unroll
        for (int i = 0; i < 16; ++i) { LAS unsigned* q = (LAS unsigned*)(scr + (4 * i + (lane >> 4)) * 132 + 8 * (lane & 15)); q[0] = cvtpk(v[i][0], v[i][1]); q[1] = cvtpk(v[i][2], v[i][3]); }
        LDS_WAIT(); asm volatile("" ::: "memory");
        const int c = lane & 7;
#pragma unroll
        for (int it = 0; it < 4; ++it) {
            const int nl = 16 * it + 2 * (lane >> 3);
            unsigned x[8];
#pragma unroll
            for (int j = 0; j < 8; ++j) x[j] = *(const LAS unsigned*)(scr + (8 * c + j) * 132 + 2 * nl);
            v4u o0, o1;
            o0.x = (x[0] & 0xffffu) | (x[1] << 16); o0.y = (x[2] & 0xffffu) | (x[3] << 16); o0.z = (x[4] & 0xffffu) | (x[5] << 16); o0.w = (x[6] & 0xffffu) | (x[7] << 16);
            o1.x = (x[0] >> 16) | (x[1] & 0xffff0000u); o1.y = (x[2] >> 16) | (x[3] & 0xffff0000u); o1.z = (x[4] >> 16) | (x[5] & 0xffff0000u); o1.w = (x[6] >> 16) | (x[7] & 0xffff0000u);
            bf16* dst = d.W16 + (size_t)(64 * d.nb + nl) * d.K + 64 * d.kb + 8 * c;
            if (pm == 0 || pm == 3) { *(v4u*)dst = o0; *(v4u*)(dst + d.K) = o1; } else asm volatile("" :: "v"(o0), "v"(o1));
        }
    } else {
#pragma unroll
        for (int i = 0; i < 16; ++i) { const float sc = d.rsc ? d.rsc[8 * i] * 64.0f : 64.0f; *(LAS unsigned*)(scr + (8 * i + (lane >> 3)) * 36 + 4 * (lane & 7)) = pk4_fp8(v[i][0] * sc, v[i][1] * sc, v[i][2] * sc, v[i][3] * sc); }
        LDS_WAIT(); asm volatile("" ::: "memory");
        const int nq = lane & 7, kg = lane >> 3;
        unsigned x[16];
#pragma unroll
        for (int j = 0; j < 16; ++j) x[j] = *(const LAS unsigned*)(scr + (16 * kg + j) * 36 + 4 * nq);
#pragma unroll
        for (int t = 0; t < 4; ++t) {
            v4u o;
#pragma unroll
            for (int q = 0; q < 4; ++q) o[q] = ((x[4 * q] >> (8 * t)) & 0xffu) | (((x[4 * q + 1] >> (8 * t)) & 0xffu) << 8) | (((x[4 * q + 2] >> (8 * t)) & 0xffu) << 16) | (((x[4 * q + 3] >> (8 * t)) & 0xffu) << 24);
            if (pm == 0 || pm == 3) __builtin_nontemporal_store(o, (v4u*)(d.W8 + (size_t)(32 * d.nb + 4 * nq + t) * d.K + 128 * d.kb + 16 * kg)); else asm volatile("" :: "v"(o));
        }
    }
    LDS_WAIT(); asm volatile("" ::: "memory");
}
__device__ __forceinline__ P0D p0_decode(const Args& a, unsigned char* ws, int it, int lane) {
    constexpr int I_IN = 16 * 56, I_OUT = 256, I_PG = 256, I_PP = 4 * 16, I_UG = 16 * 32, I_DN = 256;
    int r = it;
    if (r < I_IN) return p0_mk(a.w_in, DIN, DM, (bf16*)(ws + WS_WT_IN), nullptr, r / 56, r % 56, MAP_IN, lane); r -= I_IN;
    if (r < I_OUT) return p0_mk(a.w_out, DM, DM, (bf16*)(ws + WS_WT_OUT), nullptr, r / 16, r % 16, MAP_NAT, lane); r -= I_OUT;
    if (r < I_PG) return p0_mk(a.w_pg, DM, DM, nullptr, (unsigned char*)(ws + WS_WT_PG), r / 32, r % 32, MAP_NAT, lane); r -= I_PG;
    if (r < I_PP) return p0_mk(a.w_pp, DM, PLE, (bf16*)(ws + WS_WT_PP), nullptr, r / 16, r % 16, MAP_NAT, lane); r -= I_PP;
    if (r < NE * I_UG) { const int e = r / I_UG, q = r % I_UG; return p0_mk(a.w_ug + (size_t)e * DM * 2048, 2048, DM, nullptr, (unsigned char*)(ws + WS_WT_UG) + (size_t)e * 2048 * DM, q / 64, q % 64, MAP_UG, lane, a.g_ffn); } r -= NE * I_UG;
    { const int e = r / I_DN, q = r % I_DN; return p0_mk(a.w_dn + (size_t)e * DM * DM, DM, DM, nullptr, (unsigned char*)(ws + WS_WT_DN) + (size_t)e * DM * DM, q / 32, q % 32, MAP_NAT, lane); }
}
__device__ __forceinline__ void rms_row_to_bf16(const float* xrow, const float* g, bf16* orow, int lane) {
    const f32x4* xr = (const f32x4*)xrow + lane;
    f32x4 v[4]; float s = 0.f;
#pragma unroll
    for (int j = 0; j < 4; ++j) { v[j] = xr[64 * j]; s += (v[j][0] * v[j][0] + v[j][1] * v[j][1]) + (v[j][2] * v[j][2] + v[j][3] * v[j][3]); }
    const float rstd = rsqrtf(wave_sum(s) * (1.f / DM) + EPS);
    unsigned long long* o8 = (unsigned long long*)orow + lane;
#pragma unroll
    for (int j = 0; j < 4; ++j) { const f32x4 gg = ((const f32x4*)g)[lane + 64 * j];
        o8[64 * j] = (unsigned long long)cvtpk(v[j][0] * rstd * gg[0], v[j][1] * rstd * gg[1]) | ((unsigned long long)cvtpk(v[j][2] * rstd * gg[2], v[j][3] * rstd * gg[3]) << 32); }
}
__device__ __forceinline__ void p0_prologue(Frame& F, const Args& a, const int pm = 0) {
    unsigned char* ws = a.ws; const int tid = tid_now(F.wave), lane = tid & 63;
    LAS unsigned char* scr = F.lds + RING_OFF + F.wave * 8448;
    const int gw = F.vcu * NWAVES + F.wave, NGW = F.G * NWAVES;
    constexpr int I_IN = 16 * 56, I_OUT = 256, I_PG = 256, I_PP = 4 * 16, I_UG = 16 * 32, I_DN = 256;
    constexpr int NITEMS = I_IN + I_OUT + I_PG + I_PP + NE * I_UG + NE * I_DN;
    if (gw < NITEMS) {
        int it = gw; P0D d0 = p0_decode(a, ws, it, lane), d1 = d0; f32x4 va[16], vb[16]; p0_load(d0, va);
        for (;;) {
            const int it1 = it + NGW; const bool h1 = it1 < NITEMS;
            if (h1) { d1 = p0_decode(a, ws, it1, lane); p0_load(d1, vb); }
            p0_finish(d0, va, scr, lane, pm);
            if (!h1) break;
            const int it2 = it1 + NGW; const bool h2 = it2 < NITEMS;
            if (h2) { d0 = p0_decode(a, ws, it2, lane); p0_load(d0, va); }
            p0_finish(d1, vb, scr, lane, pm);
            if (!h2) break;
            it = it2;
        }
    }
    if (pm != 0) return;
    if (blockIdx.x == 0 && tid < 256) { const int t = tid; const float* srcs = (t < 64) ? a.sbq : (t < 128) ? a.sbk : (t < 192) ? a.rq : a.rk; ((float*)(ws + WS_GAINS))[t] = srcs[t & 63]; }
    {
        f32x4 gg[4];
#pragma unroll
        for (int j = 0; j < 4; ++j) gg[j] = ((const f32x4*)a.g_mix)[lane + 64 * j];
        for (int m0 = 4 * gw; m0 < T; m0 += 4 * NGW) {
            f32x4 v[4][4];
#pragma unroll
            for (int r = 0; r < 4; ++r)
#pragma unroll
                for (int j = 0; j < 4; ++j) v[r][j] = __builtin_nontemporal_load((const f32x4*)(a.x + (size_t)(m0 + r) * DM) + lane + 64 * j);
#pragma unroll
            for (int r = 0; r < 4; ++r) {
                float ss = 0.f;
#pragma unroll
                for (int j = 0; j < 4; ++j) ss += (v[r][j][0] * v[r][j][0] + v[r][j][1] * v[r][j][1]) + (v[r][j][2] * v[r][j][2] + v[r][j][3] * v[r][j][3]);
                const float rstd = rsqrtf(wave_sum(ss) * (1.f / DM) + EPS);
                unsigned long long* o8 = (unsigned long long*)((bf16*)(ws + WS_XN) + (size_t)(m0 + r) * DM) + lane;
#pragma unroll
                for (int j = 0; j < 4; ++j) o8[64 * j] = (unsigned long long)cvtpk(v[r][j][0] * rstd * gg[j][0], v[r][j][1] * rstd * gg[j][1]) | ((unsigned long long)cvtpk(v[r][j][2] * rstd * gg[j][2], v[r][j][3] * rstd * gg[j][3]) << 32);
            }
        }
    }
    { const int gt = gw * 64 + lane, NGT = NGW * 64;
      for (int i0 = gt; i0 < T * PLE / 8; i0 += 4 * NGT) {
          f32x4 a0[4], a1[4];
#pragma unroll
          for (int q = 0; q < 4; ++q) { const int i = i0 + q * NGT; if (i < T * PLE / 8) { a0[q] = __builtin_nontemporal_load((const f32x4*)a.p + 2 * i); a1[q] = __builtin_nontemporal_load((const f32x4*)a.p + 2 * i + 1); } }
#pragma unroll
          for (int q = 0; q < 4; ++q) { const int i = i0 + q * NGT; if (i < T * PLE / 8) { v4u o; o.x = cvtpk(a0[q][0], a0[q][1]); o.y = cvtpk(a0[q][2], a0[q][3]); o.z = cvtpk(a1[q][0], a1[q][1]); o.w = cvtpk(a1[q][2], a1[q][3]); ((v4u*)(ws + WS_PB))[i] = o; } }
      }
      for (int i = gt; i < NE * DM; i += NGT) { const int e = i >> 10, k = i & (DM - 1); const float wv = a.w_r[(size_t)k * NE + e] * a.g_ffn[k];
          const unsigned hi = cvtpk(wv, 0.f) & 0xffffu; const unsigned lo = cvtpk(wv - __uint_as_float(hi << 16), 0.f) & 0xffffu;
          ((bf16*)(ws + WS_WRT))[i] = (bf16)hi; ((bf16*)(ws + WS_WRT))[NE * DM + i] = (bf16)lo; }
      float* rc = (float*)(ws + WS_ROPEC); float* rs = (float*)(ws + WS_ROPES);
      for (int i = gt; i < T * 32; i += NGT) { const int row = i >> 5, f = i & 31;
          const float inv_freq = exp2f(-(float)f * (13.287712379549449f / 32.0f));   const float ang = (float)a.positions[row] * inv_freq;
          float sn, cs; sincosf(ang, &sn, &cs); rc[i] = cs; rs[i] = sn; } }
}

namespace att {
typedef short bf16x8 __attribute__((ext_vector_type(8)));
typedef short s16x4 __attribute__((ext_vector_type(4)));
typedef float f32x16 __attribute__((ext_vector_type(16)));
typedef short v4i16_t __attribute__((ext_vector_type(4)));
constexpr int LK = 0, LV = 24576, LFLAG = 49152;
__device__ __forceinline__ s16x4 vtr(LAS const unsigned char* p) { return __builtin_bit_cast(s16x4, __builtin_amdgcn_ds_read_tr16_b64_v4i16((LAS v4i16_t*)p)); }
__device__ __forceinline__ int crow(int r, int hi) { return (r & 3) + 8 * (r >> 2) + 4 * hi; }
struct AttnArgs { const bf16* hm; const bf16* rg; bf16* Y; const float* gn_g; const float* gn_b; };

template <int MODE, int ABL = 0> __device__ __forceinline__ void attn_unit(LAS unsigned char* lds, const AttnArgs& A, int b, int h, int qb, const int wave_id) {
    int tid_ = wave_id * 64 + lane_id_hw(); asm volatile("" : "+v"(tid_));
    const int tid = tid_, lane = tid & 63, r32 = lane & 31, hh = lane >> 5;
    const int w = __builtin_amdgcn_readfirstlane(tid >> 6);
    const int q0 = qb * 256, qw = q0 + 32 * w;
    const size_t TS = (size_t)T * 512;
    const size_t hoff = (size_t)(b * 8 + h) * SEQ * 64;
    const bf16* Qp = A.hm + (MODE == 0 ? 0 : 3) * TS + hoff;
    const bf16* Kp = A.hm + (MODE == 0 ? 1 : 4) * TS + hoff;
    const bf16* Vp = A.hm + (MODE == 0 ? 2 : 5) * TS + hoff;
    bf16x8 qf[4];
#pragma unroll
    for (int ds = 0; ds < 4; ++ds) qf[ds] = *(const bf16x8*)(Qp + (size_t)(qw + r32) * 64 + 16 * ds + 8 * hh);
    f32x16 o[2];
#pragma unroll
    for (int r = 0; r < 16; ++r) { o[0][r] = 0.f; o[1][r] = 0.f; }
    float carry = 1.0f;
    const int jmax = (q0 + 255) >> 6, jd = (qw + 31) >> 6;
    const float lg2g = __log2f(1.0f - __builtin_amdgcn_exp2f(-5.0f - (float)h));
    const int krow = 8 * w + (lane >> 3);
    const bf16* Kt = Kp + (size_t)krow * 64 + (((lane & 7) ^ ((krow >> 1) & 7)) << 3); const bf16* Vt = Vp + (size_t)w * 512 + lane * 8;
    volatile LAS unsigned* flags = (volatile LAS unsigned*)(lds + LFLAG);
#define ATT_DMA(t, so) do { __builtin_amdgcn_global_load_lds((const unsigned*)(Kt + (size_t)(t) * 4096), (LAS unsigned*)(lds + LK + (so) + w * 1024), 16, 0, 0); \
                            __builtin_amdgcn_global_load_lds((const unsigned*)(Vt + (size_t)(t) * 4096), (LAS unsigned*)(lds + LV + (so) + w * 1024), 16, 0, 0); } while (0)
    ATT_DMA(jmax, 0);
    if (jmax >= 1) { ATT_DMA(jmax - 1, 8192); asm volatile("s_waitcnt vmcnt(2)\n\ts_barrier" ::: "memory"); }
    else asm volatile("s_waitcnt vmcnt(0)\n\ts_barrier" ::: "memory");
    bool finished = false;
    int so_cur = 0, so_new = 16384;
    for (int j = jmax; j >= 0; --j) {
        const int cur = j & 1;
        if (j >= 2 && ABL != 4) ATT_DMA(j - 2, so_new);
        if (j <= jd && !finished && ABL == 0) {
            LAS const unsigned char* Kb = lds + LK + so_cur;
            LAS const unsigned char* Vb = lds + LV + so_cur;
            f32x16 p[2];
#pragma unroll
            for (int r = 0; r < 16; ++r) { p[0][r] = 0.f; p[1][r] = 0.f; }
            bf16x8 kf[4][2];
            const int ksw = (r32 >> 1) & 7;
#pragma unroll
            for (int ds = 0; ds < 4; ++ds) { kf[ds][0] = *(LAS const bf16x8*)(Kb + r32 * 128 + (((2 * ds + hh) ^ ksw) << 4)); kf[ds][1] = *(LAS const bf16x8*)(Kb + 4096 + r32 * 128 + (((2 * ds + hh) ^ ksw) << 4)); }
#pragma unroll
            for (int ds = 0; ds < 4; ++ds) {
                p[0] = __builtin_amdgcn_mfma_f32_32x32x16_bf16(kf[ds][0], qf[ds], p[0], 0, 0, 0);
                p[1] = __builtin_amdgcn_mfma_f32_32x32x16_bf16(kf[ds][1], qf[ds], p[1], 0, 0, 0);
            }
            const bool diag = (j == jd);
            const int qg = qw + r32, kv0 = 64 * j + 4 * hh;
            if (MODE == 0) {
                float om[2][16];
#pragma unroll
                for (int hf = 0; hf < 2; ++hf)
#pragma unroll
                    for (int r = 0; r < 16; ++r) {
                        const float Z = p[hf][r];
                        const float a = __builtin_amdgcn_exp2f(-__builtin_fabsf(Z));
                        const float rc = __builtin_amdgcn_rcpf(1.0f + a), ar = a * rc;
                        const bool pos = Z >= 0.f;
                        p[hf][r] = pos ? rc : ar;
                        om[hf][r] = pos ? ar : rc;
                    }
                if (diag) {
#pragma unroll
                    for (int hf = 0; hf < 2; ++hf)
#pragma unroll
                        for (int r = 0; r < 16; ++r) { const bool valid = kv0 + 32 * hf + (r & 3) + 8 * (r >> 2) < qg; p[hf][r] = valid ? p[hf][r] : 0.f; om[hf][r] = valid ? om[hf][r] : 1.0f; }
                }
                float gs[8], ot[8];
#pragma unroll
                for (int m = 0; m < 8; ++m) { const int hf = m >> 2, g = m & 3; gs[m] = (om[hf][4 * g] * om[hf][4 * g + 1]) * (om[hf][4 * g + 2] * om[hf][4 * g + 3]); ot[m] = __shfl_xor(gs[m], 32); }
                float ps[8];
                ps[7] = 1.0f;
#pragma unroll
                for (int m = 6; m >= 0; --m) ps[m] = ps[m + 1] * (gs[m + 1] * ot[m + 1]);
                const float total = ps[0] * (gs[0] * ot[0]);
#pragma unroll
                for (int m = 0; m < 8; ++m) {
                    const int hf = m >> 2, g = m & 3;
                    float tail = carry * (hh ? ps[m] : ps[m] * ot[m]);
#pragma unroll
                    for (int i = 3; i >= 0; --i) { const int r = 4 * g + i; const float o1 = om[hf][r]; p[hf][r] *= tail; tail *= o1; }
                }
                carry *= total;
                finished = __all(carry < 1.0e-37f);
            } else {
                const float ct = __builtin_amdgcn_exp2f(lg2g * (float)(qw - 64 * j));
#pragma unroll
                for (int hf = 0; hf < 2; ++hf)
#pragma unroll
                    for (int r = 0; r < 16; ++r) p[hf][r] *= ct;
                if (diag) {
#pragma unroll
                    for (int hf = 0; hf < 2; ++hf)
#pragma unroll
                        for (int r = 0; r < 16; ++r) { const bool valid = kv0 + 32 * hf + (r & 3) + 8 * (r >> 2) <= qg; p[hf][r] = valid ? p[hf][r] : 0.f; }
                }
            }
            {
                const unsigned vbase = (unsigned)(uintptr_t)(Vb + (4 * hh + ((lane & 15) >> 2)) * 128 + (16 * ((lane >> 4) & 1) + 4 * (lane & 3)) * 2);
                s16x4 vl[2][2][2], vh[2][2][2];
#pragma unroll
                for (int hf = 0; hf < 2; ++hf)
#pragma unroll
                    for (int s = 0; s < 2; ++s)
#pragma unroll
                        for (int d0 = 0; d0 < 2; ++d0) {
                            asm volatile("ds_read_b64_tr_b16 %0, %1 offset:%c2" : "=&v"(vl[hf][s][d0]) : "v"(vbase), "i"(hf * 4096 + s * 2048 + d0 * 64) : "memory");
                            asm volatile("ds_read_b64_tr_b16 %0, %1 offset:%c2" : "=&v"(vh[hf][s][d0]) : "v"(vbase), "i"(hf * 4096 + s * 2048 + d0 * 64 + 1024) : "memory");
                        }
                bf16x8 wfr[2][2];
#pragma unroll
                for (int hf = 0; hf < 2; ++hf)
#pragma unroll
                    for (int s = 0; s < 2; ++s) {
                        u32x4_t wq;
                        wq.x = pg8::cvt_pk_bf16(p[hf][8 * s + 0], p[hf][8 * s + 1]); wq.y = pg8::cvt_pk_bf16(p[hf][8 * s + 2], p[hf][8 * s + 3]);
                        wq.z = pg8::cvt_pk_bf16(p[hf][8 * s + 4], p[hf][8 * s + 5]); wq.w = pg8::cvt_pk_bf16(p[hf][8 * s + 6], p[hf][8 * s + 7]);
                        wfr[hf][s] = __builtin_bit_cast(bf16x8, wq);
                    }
                asm volatile("s_waitcnt lgkmcnt(0)" ::: "memory"); __builtin_amdgcn_sched_barrier(0);
#pragma unroll
                for (int hf = 0; hf < 2; ++hf)
#pragma unroll
                    for (int s = 0; s < 2; ++s)
#pragma unroll
                        for (int d0 = 0; d0 < 2; ++d0) {
                            const s16x4 lo = vl[hf][s][d0], hi = vh[hf][s][d0];
                            const bf16x8 vf = (bf16x8){lo[0], lo[1], lo[2], lo[3], hi[0], hi[1], hi[2], hi[3]};
                            o[d0] = __builtin_amdgcn_mfma_f32_32x32x16_bf16(vf, wfr[hf][s], o[d0], 0, 0, 0);
                        }
            }
        }
        if (MODE == 0) { if (lane == 0) flags[cur * 8 + w] = finished ? 1u : 0u; }
        if (j >= 2) asm volatile("s_waitcnt vmcnt(2) lgkmcnt(0)\n\ts_barrier" ::: "memory"); else asm volatile("s_waitcnt vmcnt(0) lgkmcnt(0)\n\ts_barrier" ::: "memory");
        so_cur = (so_cur == 16384) ? 0 : so_cur + 8192; so_new = (so_new == 16384) ? 0 : so_new + 8192;
        if (MODE == 0) {
            unsigned all = 1u;
#pragma unroll
            for (int i = 0; i < 8; ++i) all &= flags[cur * 8 + i];
            if (all) break;
        }
    }
    asm volatile("s_waitcnt vmcnt(0)\n\ts_barrier" ::: "memory");
#undef ATT_DMA
    const int row = b * SEQ + qw + r32;
    if (MODE == 0) {
        bf16* yp = A.Y + (size_t)row * DM + h * 64 + 4 * hh;
#pragma unroll
        for (int d0 = 0; d0 < 2; ++d0)
#pragma unroll
            for (int g = 0; g < 4; ++g) { u32x2_t v; v.x = pg8::cvt_pk_bf16(o[d0][4 * g], o[d0][4 * g + 1]); v.y = pg8::cvt_pk_bf16(o[d0][4 * g + 2], o[d0][4 * g + 3]); *(u32x2_t*)(yp + 32 * d0 + 8 * g) = v; }
    } else {
        float s1 = 0.f;
#pragma unroll
        for (int r = 0; r < 16; ++r) s1 += o[0][r] + o[1][r];
        s1 += __shfl_xor(s1, 32);
        const float mu = s1 * (1.0f / 64.0f);
        float s2 = 0.f;
#pragma unroll
        for (int r = 0; r < 16; ++r) { const float a0 = o[0][r] - mu, a1 = o[1][r] - mu; s2 += a0 * a0 + a1 * a1; }
        s2 += __shfl_xor(s2, 32);
        const float rstd = rsqrtf(s2 * (1.0f / 64.0f) + EPS);
        bf16* yp = A.Y + (size_t)row * DM + 512 + h * 64 + 4 * hh;
        const bf16* gp = A.rg + (size_t)row * 512 + h * 64 + 4 * hh;
        const float* gg = A.gn_g + h * 64 + 4 * hh; const float* gb = A.gn_b + h * 64 + 4 * hh;
#pragma unroll
        for (int d0 = 0; d0 < 2; ++d0)
#pragma unroll
            for (int g = 0; g < 4; ++g) {
                const f32x4 gn = *(const f32x4*)(gg + 32 * d0 + 8 * g), bs = *(const f32x4*)(gb + 32 * d0 + 8 * g);
                const u32x2_t gr = *(const u32x2_t*)(gp + 32 * d0 + 8 * g);
                float gate[4] = {__uint_as_float(gr.x << 16), __uint_as_float(gr.x & 0xffff0000u), __uint_as_float(gr.y << 16), __uint_as_float(gr.y & 0xffff0000u)};
                float ov[4];
#pragma unroll
                for (int i = 0; i < 4; ++i) { const float yn = (o[d0][4 * g + i] - mu) * rstd * gn[i] + bs[i]; const float sg = gate[i] / (1.0f + __expf(-gate[i])); ov[i] = yn * sg; }
                u32x2_t v; v.x = pg8::cvt_pk_bf16(ov[0], ov[1]); v.y = pg8::cvt_pk_bf16(ov[2], ov[3]); *(u32x2_t*)(yp + 32 * d0 + 8 * g) = v;
            }
    }
}
__device__ __forceinline__ void attn_phase(LAS unsigned char* lds, const AttnArgs& A, int vcu, int dup, bf16* dummyY, const int wave_id) {
    const int g = vcu >> 5, local = vcu & 31;
    if (dup == 24 || dup == 25) { AttnArgs A2 = A; A2.Y = dummyY;
#pragma unroll 1
        for (int u = 0; u < 2; ++u) { const int bh = 8 * g + 4 * (u & 1) + (local >> 3), qb = (u & 1) ? 7 - (local & 7) : (local & 7); if (dup == 24) attn_unit<1, 3>(lds, A2, bh >> 3, bh & 7, qb, wave_id); else attn_unit<1, 4>(lds, A2, bh >> 3, bh & 7, qb, wave_id); } }
#pragma unroll 1
    for (int u = 0; u < ((dup == 20) ? 4 : 2); ++u) { const int bh = 8 * g + 4 * (u & 1) + (local >> 3), qb = (u & 1) ? 7 - (local & 7) : (local & 7); attn_unit<1>(lds, A, bh >> 3, bh & 7, qb, wave_id); }
#pragma unroll 1
    for (int u = 0; u < ((dup == 21) ? 4 : 2); ++u) { const int bh = 8 * g + 4 * (u & 1) + (local >> 3), qb = (u & 1) ? 7 - (local & 7) : (local & 7); attn_unit<0>(lds, A, bh >> 3, bh & 7, qb, wave_id); }
}
}

constexpr int CW_GCNT = 2048;
constexpr int LR_LCNT = LDSCTL_OFF + 1024, LR_GBASE = LDSCTL_OFF + 1152;
constexpr int LT_POFF = LDSCTL_OFF + 2048, LT_NT = LDSCTL_OFF + 2176, LT_TILE_E = LDSCTL_OFF + 2304, LT_FIRST = LDSCTL_OFF + 3712;
struct RouteBufs { int* tok_e; int* tok_slot; float* tok_gate; float* rstd; int* toklist; };
__device__ __forceinline__ RouteBufs route_bufs(unsigned char* ws) { RouteBufs r; r.tok_e = (int*)(ws + WS_ROUTE); r.tok_slot = r.tok_e + T * 4; r.tok_gate = (float*)(r.tok_slot + T * 4); r.rstd = (float*)(ws + WS_ROUTE + 1 * MiB); r.toklist = (int*)(ws + WS_TOKLIST); return r; }
typedef float f32x2v __attribute__((ext_vector_type(2)));
__device__ __forceinline__ unsigned opq_mask(bool c) { unsigned m = c ? 0xffffffffu : 0u; asm volatile("" : "+v"(m)); return m; }
__device__ __forceinline__ float blendf(unsigned m, float a, float b) { return __uint_as_float((__float_as_uint(a) & m) | (__float_as_uint(b) & ~m)); }
__device__ __forceinline__ int blendi(unsigned m, int a, int b) { return (int)(((unsigned)a & m) | ((unsigned)b & ~m)); }

#define SW2(c, a, b) { const float ta_ = (c) ? (b) : (a), tb_ = (c) ? (a) : (b); a = ta_; b = tb_; }
#define SW2I(c, a, b) { const int ta_ = (c) ? (b) : (a), tb_ = (c) ? (a) : (b); a = ta_; b = tb_; }
#define TOP4_INSERT(x, e) { const float x_ = (x); const int e_ = (e); const bool c3_ = (x_ > v3) || (x_ == v3 && e_ < i3); v3 = c3_ ? x_ : v3; i3 = c3_ ? e_ : i3; \
    const bool c2_ = (v3 > v2) || (v3 == v2 && i3 < i2); SW2(c2_, v2, v3) SW2I(c2_, i2, i3) const bool c1_ = (v2 > v1) || (v2 == v1 && i2 < i1); SW2(c1_, v1, v2) SW2I(c1_, i1, i2) \
    const bool c0_ = (v1 > v0) || (v1 == v0 && i1 < i0); SW2(c0_, v0, v1) SW2I(c0_, i0, i1) }
__device__ __forceinline__ void router_phase(Frame& F, const Args& a, const bool dry = false) {
    unsigned char* ws = a.ws; const int tid = tid_now(F.wave);
    LAS unsigned char* lds = F.lds;
    const int lane = tid & 63, r32 = lane & 31, hh = lane >> 5, w = F.wave, rg = w >> 2, kq = w & 3;
    volatile LAS unsigned* lcnt = (volatile LAS unsigned*)(lds + LR_LCNT);
    volatile LAS unsigned* gbase = (volatile LAS unsigned*)(lds + LR_GBASE);
    if (tid < 32) lcnt[tid] = 0u;
    const RouteBufs R = route_bufs(ws);
    const int row = F.vcu * 64 + 32 * rg + r32;
    const bf16* xr = (const bf16*)(ws + WS_X1) + (size_t)row * DM + 256 * kq + 8 * hh;
    const bf16* wt = (const bf16*)(ws + WS_WRT) + (size_t)r32 * DM + 256 * kq + 8 * hh;
    unsigned char* hp = (unsigned char*)(ws + (dry ? WS_H : WS_XN)) + (size_t)row * DM + 256 * kq + 8 * hh;
    att::f32x16 D;
#pragma unroll
    for (int r = 0; r < 16; ++r) D[r] = 0.f;
    float ss = 0.f;
#pragma unroll 8
    for (int ks = 0; ks < 16; ++ks) {
        const u32x4_t xh = *(const u32x4_t*)(xr + 16 * ks);
        const f32x4 v0 = (f32x4){__uint_as_float(xh.x << 16), __uint_as_float(xh.x & 0xffff0000u), __uint_as_float(xh.y << 16), __uint_as_float(xh.y & 0xffff0000u)};
        const f32x4 v1 = (f32x4){__uint_as_float(xh.z << 16), __uint_as_float(xh.z & 0xffff0000u), __uint_as_float(xh.w << 16), __uint_as_float(xh.w & 0xffff0000u)};
        ss += ((v0[0] * v0[0] + v0[1] * v0[1]) + (v0[2] * v0[2] + v0[3] * v0[3])) + ((v1[0] * v1[0] + v1[1] * v1[1]) + (v1[2] * v1[2] + v1[3] * v1[3]));
        u32x2_t h8; h8.x = pk4_fp8(v0[0], v0[1], v0[2], v0[3]); h8.y = pk4_fp8(v1[0], v1[1], v1[2], v1[3]); *(u32x2_t*)(hp + 16 * ks) = h8;
        const att::bf16x8 whi = *(const att::bf16x8*)(wt + 16 * ks), wlo = *(const att::bf16x8*)(wt + 32 * DM + 16 * ks);
        const att::bf16x8 bxh = __builtin_bit_cast(att::bf16x8, xh);
        D = __builtin_amdgcn_mfma_f32_32x32x16_bf16(whi, bxh, D, 0, 0, 0);
        D = __builtin_amdgcn_mfma_f32_32x32x16_bf16(wlo, bxh, D, 0, 0, 0);
    }
    { LAS f32x4* dp = (LAS f32x4*)(lds + (w * 64 + lane) * 64);
#pragma unroll
      for (int q = 0; q < 4; ++q) dp[q] = (f32x4){D[4 * q], D[4 * q + 1], D[4 * q + 2], D[4 * q + 3]};
      *(LAS float*)(lds + 32768 + (w * 64 + lane) * 4) = ss; }
    __syncthreads();
    int my_e0 = 0, my_e1 = 0, rk0 = 0, rk1 = 0; float my_g0 = 0.f, my_g1 = 0.f;
    if (kq == 0) {
#pragma unroll
        for (int o = 1; o < 4; ++o) { LAS const f32x4* dp = (LAS const f32x4*)(lds + ((w + o) * 64 + lane) * 64);
#pragma unroll
            for (int q = 0; q < 4; ++q) { const f32x4 t = dp[q]; D[4 * q] += t[0]; D[4 * q + 1] += t[1]; D[4 * q + 2] += t[2]; D[4 * q + 3] += t[3]; }
            ss += *(LAS const float*)(lds + 32768 + ((w + o) * 64 + lane) * 4); }
        ss += __shfl_xor(ss, 32);
        const float rstd = rsqrtf(ss * (1.f / DM) + EPS);
        if (hh == 0) R.rstd[row] = rstd;
        float l[16];
#pragma unroll
        for (int r = 0; r < 16; ++r) l[r] = D[r] * rstd + a.b_r[(r & 3) + 8 * (r >> 2) + 4 * hh];
        float c[8]; int ci[8];
#pragma unroll
        for (int k = 0; k < 4; ++k) {
            float bv = -INFINITY; int bi = 99;
#pragma unroll
            for (int r = 0; r < 16; ++r) { const int e = (r & 3) + 8 * (r >> 2) + 4 * hh; const bool bt = l[r] > bv; bv = bt ? l[r] : bv; bi = bt ? e : bi; }
            c[k] = bv; ci[k] = bi;
#pragma unroll
            for (int r = 0; r < 16; ++r) { const int e = (r & 3) + 8 * (r >> 2) + 4 * hh; l[r] = (e == bi) ? -INFINITY : l[r]; }
        }
#pragma unroll
        for (int k = 0; k < 4; ++k) { c[4 + k] = __shfl_xor(c[k], 32); ci[4 + k] = __shfl_xor(ci[k], 32); }
        float tv[4]; int ti[4];
#pragma unroll
        for (int k = 0; k < 4; ++k) {
            float bv = -INFINITY; int bi = 99;
#pragma unroll
            for (int j = 0; j < 8; ++j) { const bool bt = (c[j] > bv) || (c[j] == bv && ci[j] < bi); bv = bt ? c[j] : bv; bi = bt ? ci[j] : bi; }
            tv[k] = bv; ti[k] = bi;
#pragma unroll
            for (int j = 0; j < 8; ++j) c[j] = (ci[j] == bi) ? -INFINITY : c[j];
        }
        const float v0 = tv[0], v1 = tv[1], v2 = tv[2], v3 = tv[3]; const int i0 = ti[0], i1 = ti[1], i2 = ti[2], i3 = ti[3];
        const float e1 = __expf(v1 - v0), e2 = __expf(v2 - v0), e3 = __expf(v3 - v0), inv = 1.0f / (1.0f + e1 + e2 + e3);
        my_e0 = hh ? i2 : i0; my_e1 = hh ? i3 : i1; my_g0 = (hh ? e2 : 1.0f) * inv; my_g1 = (hh ? e3 : e1) * inv;
        rk0 = (int)__hip_atomic_fetch_add((LAS unsigned*)(lds + LR_LCNT) + my_e0, 1u, __ATOMIC_RELAXED, __HIP_MEMORY_SCOPE_WORKGROUP);
        rk1 = (int)__hip_atomic_fetch_add((LAS unsigned*)(lds + LR_LCNT) + my_e1, 1u, __ATOMIC_RELAXED, __HIP_MEMORY_SCOPE_WORKGROUP);
    }
    __syncthreads();
    if (tid < 32) gbase[tid] = __hip_atomic_fetch_add((unsigned*)(F.ctl + CW_GCNT + (dry ? 64 : 0)) + tid, lcnt[tid], __ATOMIC_RELAXED, __HIP_MEMORY_SCOPE_AGENT);
    __syncthreads();
    if (kq == 0) {
        const int k0 = 2 * hh;
        const int s0 = (int)gbase[my_e0] + rk0, s1 = (int)gbase[my_e1] + rk1;
        R.tok_e[row * 4 + k0] = my_e0; R.tok_slot[row * 4 + k0] = s0; R.tok_gate[row * 4 + k0] = my_g0; R.toklist[(size_t)my_e0 * T + s0] = row;
        R.tok_e[row * 4 + k0 + 1] = my_e1; R.tok_slot[row * 4 + k0 + 1] = s1; R.tok_gate[row * 4 + k0 + 1] = my_g1; R.toklist[(size_t)my_e1 * T + s1] = row;
    }
}
#undef SW2
#undef SW2I
#undef TOP4_INSERT

__device__ __forceinline__ void build_tables(Frame& F) {
    LAS int* poff = (LAS int*)(F.lds + LT_POFF); LAS int* ntp = (LAS int*)(F.lds + LT_NT); LAS int* tile_e = (LAS int*)(F.lds + LT_TILE_E);
    LAS int* cnts = (LAS int*)(F.lds + LR_LCNT); const int tid = tid_now(F.wave);
    if (tid < NE) cnts[tid] = (int)__hip_atomic_load((unsigned*)(F.ctl + CW_GCNT) + tid, __ATOMIC_RELAXED, __HIP_MEMORY_SCOPE_AGENT);
    __syncthreads();
    if (tid == 0) {
        int t = 0;
        for (int e = 0; e < NE; ++e) { const int c = cnts[e]; const int nt = (c + 255) >> 8; poff[e] = t * 256; ((LAS int*)(F.lds + LT_FIRST))[e] = t; for (int i = 0; i < nt; ++i) tile_e[t + i] = e; t += nt; }
        *ntp = t;
    }
    __syncthreads();
}
__device__ __forceinline__ void combine_phase(Frame& F, const Args& a, const bool dry = false) {
    unsigned char* ws = a.ws; const RouteBufs R = route_bufs(ws);
    LAS const int* poff = (LAS const int*)(F.lds + LT_POFF);
    const int gw = F.vcu * NWAVES + F.wave, NGW = F.G * NWAVES, lane = tid_now(F.wave) & 63;
    for (int m0 = 2 * gw; m0 < T; m0 += 2 * NGW) {
        f32x4 v[2][2][2]; u32x2_t y[2][4][2]; float gt[2][4];
#pragma unroll
        for (int rr = 0; rr < 2; ++rr) { const int m = m0 + rr;
#pragma unroll
            for (int i = 0; i < 2; ++i) { { const v4u xq = __builtin_nontemporal_load((const v4u*)((const bf16*)(ws + WS_X1) + (size_t)m * DM + 8 * lane + 512 * i)); v[rr][i][0] = (f32x4){__uint_as_float(xq[0] << 16), __uint_as_float(xq[0] & 0xffff0000u), __uint_as_float(xq[1] << 16), __uint_as_float(xq[1] & 0xffff0000u)}; v[rr][i][1] = (f32x4){__uint_as_float(xq[2] << 16), __uint_as_float(xq[2] & 0xffff0000u), __uint_as_float(xq[3] << 16), __uint_as_float(xq[3] & 0xffff0000u)}; } }
#pragma unroll
            for (int k = 0; k < 4; ++k) { const int e = R.tok_e[m * 4 + k], slot = R.tok_slot[m * 4 + k]; gt[rr][k] = R.tok_gate[m * 4 + k];
                const unsigned char* yr = (const unsigned char*)(ws + WS_YS) + (size_t)(poff[e] + slot) * DM + 8 * lane;
                y[rr][k][0] = __builtin_nontemporal_load((const u32x2_t*)yr); y[rr][k][1] = __builtin_nontemporal_load((const u32x2_t*)(yr + 512)); } }
#pragma unroll
        for (int rr = 0; rr < 2; ++rr) { const int m = m0 + rr;
#pragma unroll
            for (int k = 0; k < 4; ++k)
#pragma unroll
                for (int i = 0; i < 2; ++i) { const u32x2_t yy = y[rr][k][i]; const float g = gt[rr][k];
                    const f32x2v a0 = __builtin_amdgcn_cvt_pk_f32_fp8((int)yy.x, false), a1 = __builtin_amdgcn_cvt_pk_f32_fp8((int)yy.x, true), a2 = __builtin_amdgcn_cvt_pk_f32_fp8((int)yy.y, false), a3 = __builtin_amdgcn_cvt_pk_f32_fp8((int)yy.y, true);
                    v[rr][i][0][0] += g * a0[0]; v[rr][i][0][1] += g * a0[1]; v[rr][i][0][2] += g * a1[0]; v[rr][i][0][3] += g * a1[1];
                    v[rr][i][1][0] += g * a2[0]; v[rr][i][1][1] += g * a2[1]; v[rr][i][1][2] += g * a3[0]; v[rr][i][1][3] += g * a3[1]; }
            float ss = 0.f;
#pragma unroll
            for (int i = 0; i < 2; ++i)
#pragma unroll
                for (int q = 0; q < 2; ++q) { const f32x4 t = v[rr][i][q]; ss += (t[0] * t[0] + t[1] * t[1]) + (t[2] * t[2] + t[3] * t[3]); }
            const float rstd = rsqrtf(wave_sum(ss) * (1.f / DM) + EPS);
            unsigned char* np = (unsigned char*)(ws + (dry ? WS_H : WS_XN)) + (size_t)m * DM + 8 * lane; bf16* ow = (bf16*)(ws + (dry ? WS_XS : WS_Y));
#pragma unroll
            for (int i = 0; i < 2; ++i) { { v4u xb; xb[0] = cvtpk(v[rr][i][0][0], v[rr][i][0][1]); xb[1] = cvtpk(v[rr][i][0][2], v[rr][i][0][3]); xb[2] = cvtpk(v[rr][i][1][0], v[rr][i][1][1]); xb[3] = cvtpk(v[rr][i][1][2], v[rr][i][1][3]); *(v4u*)(ow + (size_t)m * DM + 8 * lane + 512 * i) = xb; }
                const f32x4 g0 = *(const f32x4*)(a.g_ple + 8 * lane + 512 * i), g1 = *(const f32x4*)(a.g_ple + 8 * lane + 512 * i + 4);
                u32x2_t o; o.x = pk4_fp8(v[rr][i][0][0] * rstd * g0[0], v[rr][i][0][1] * rstd * g0[1], v[rr][i][0][2] * rstd * g0[2], v[rr][i][0][3] * rstd * g0[3]);
                o.y = pk4_fp8(v[rr][i][1][0] * rstd * g1[0], v[rr][i][1][1] * rstd * g1[1], v[rr][i][1][2] * rstd * g1[2], v[rr][i][1][3] * rstd * g1[3]);
                *(u32x2_t*)(np + 512 * i) = o; } }
    }
}

__global__ void __launch_bounds__(NWAVES * 64, 2) mega_fwd(Args args) {
    extern __shared__ __attribute__((aligned(16))) unsigned char lds[];
    Frame F;
    F.lds = (LAS unsigned char*)lds;
    F.MISC = (volatile LAS unsigned*)(F.lds + MISC_OFF);
    F.wave = __builtin_amdgcn_readfirstlane(threadIdx.x >> 6);
    F.G = gridDim.x; { const int bx = blockIdx.x; F.vcu = (F.G % 8 == 0) ? (bx % 8) * (F.G / 8) + bx / 8 : bx; }
    unsigned char* ws = args.ws;
    F.ctl = (gu32*)(ws + WS_CTL);
    for (int u = threadIdx.x; u < (LDS_BYTES - LDSCTL_OFF) / 4; u += NWAVES * 64) ((LAS unsigned*)(F.lds + LDSCTL_OFF))[u] = 0u;
    __syncthreads();
    XcdBarrier bar = xcd_barrier_post((unsigned*)(F.ctl + CW_BAR), F.MISC + 8); bar.wave = F.wave;
    const int lo = args.ph_lo, hi = args.ph_hi;
#define IN(k) (lo <= (k) && (k) < hi)
#define GRID_BAR() xcd_barrier(bar)
#ifndef DUP_PHASE
#define DUP_PHASE -1
#endif
#define REP(k) for (int rep_ = 0; rep_ < ((DUP_PHASE) == (k) ? 2 : 1); ++rep_)

    if (IN(0)) { if (DUP_PHASE == 40) { p0_prologue(F, args, 1); GRID_BAR(); } if (DUP_PHASE == 41) { p0_prologue(F, args, 2); GRID_BAR(); } if (DUP_PHASE == 42) { p0_prologue(F, args, 3); GRID_BAR(); } REP(0) { p0_prologue(F, args); GRID_BAR(); } }

    if (IN(1)) REP(1) {
        pg8::Gemm g{(const pg8::bf16_t*)(ws + WS_XN), (const pg8::bf16_t*)(ws + WS_WT_IN), DM, 0};
        pg8::StaticOrder S; S.init(T / 256, DIN / 256, F.G, (int)blockIdx.x);
        pg8::EpiProj E{(pg8::bf16_t*)(ws + WS_HM), (pg8::bf16_t*)(ws + WS_RG), (const float*)(ws + WS_GAINS), (const float*)(ws + WS_ROPEC), (const float*)(ws + WS_ROPES)};
        pg8::gemm_phase<pg8::EpiProj, pg8::StaticOrder, true, true>(F.lds + RING_OFF, g, S, E, F.wave);
        {
            const int G2 = (F.G == 256) ? 128 : F.G, c2 = (F.G == 256) ? (int)blockIdx.x - 128 : (int)blockIdx.x;
            if (c2 >= 0) {
                pg8::Gemm g2{(const pg8::bf16_t*)(ws + WS_PB), (const pg8::bf16_t*)(ws + WS_WT_PP), PLE, 0};
                pg8::StaticOrder S2; S2.init(T / 256, DM / 256, G2, c2);
                pg8::EpiBf16Plain E2{(pg8::bf16_t*)(ws + WS_PJ), DM};
                pg8::gemm_phase<pg8::EpiBf16Plain, pg8::StaticOrder, true, true>(F.lds + RING_OFF, g2, S2, E2, F.wave);
            }
        }
        GRID_BAR();
    }
    if (DUP_PHASE == 51 && IN(1)) {
        pg8::Gemm g{(const pg8::bf16_t*)(ws + WS_XN), (const pg8::bf16_t*)(ws + WS_WT_IN), DM, 0};
        pg8::StaticOrder S; S.init(T / 256, DIN / 256, F.G, (int)blockIdx.x);
        pg8::EpiNull E;
        pg8::gemm_phase<pg8::EpiNull, pg8::StaticOrder, true, true>(F.lds + RING_OFF, g, S, E, F.wave);
        GRID_BAR();
    }
    if (IN(2)) REP(2) {
        if (F.G == 256) {
            const att::AttnArgs AA{(const bf16*)(ws + WS_HM), (const bf16*)(ws + WS_RG), (bf16*)(ws + WS_Y), args.gn_g, args.gn_b};
            att::attn_phase(F.lds + RING_OFF, AA, F.vcu, DUP_PHASE, (bf16*)(ws + WS_XS), F.wave);
        }
        GRID_BAR();
    }
    if (IN(3)) REP(3) {
        pg8::Gemm g{(const pg8::bf16_t*)(ws + WS_Y), (const pg8::bf16_t*)(ws + WS_WT_OUT), DM, 0};
        pg8::StaticOrder S; S.init(T / 256, DM / 256, F.G, (int)blockIdx.x);
        pg8::EpiResid E{args.x, (pg8::bf16_t*)(ws + WS_X1)};
        pg8::gemm_phase<pg8::EpiResid, pg8::StaticOrder, true, true>(F.lds + RING_OFF, g, S, E, F.wave);
        GRID_BAR();
    }
    if (DUP_PHASE == 30 && IN(3)) { GRID_BAR(); GRID_BAR(); GRID_BAR(); GRID_BAR(); }
    if (IN(4)) { if (DUP_PHASE == 4) { if (F.G == 256) router_phase(F, args, true); GRID_BAR(); } if (F.G == 256) router_phase(F, args); GRID_BAR(); }
    if (IN(5) || (lo >= 6 && lo <= 8)) build_tables(F);
    if (IN(6)) REP(6) {
        const int NT = *(LAS const int*)(F.lds + LT_NT);
        pg8::Gemm g{(const pg8::bf16_t*)(ws + WS_XN), (const pg8::bf16_t*)(ws + WS_WT_UG), DM / 2, (size_t)2048 * DM};
        pg8::MoeOrder S; S.init(NT, 8, F.G, (int)blockIdx.x, (LAS const int*)(F.lds + LT_TILE_E), F.wave, 1, args.b_ug, route_bufs(ws).rstd, F.lds + PF_OFF);
        S.toklist = route_bufs(ws).toklist; S.first_tile = (LAS const int*)(F.lds + LT_FIRST); S.tokl = F.lds + TOKL_OFF;
        pg8::EpiMoeUp E{(unsigned char*)(ws + WS_H), F.lds + PF_OFF};
        pg8::gemm_phase<pg8::EpiMoeUp, pg8::MoeOrder, true, true, true, true>(F.lds + RING_OFF, g, S, E, F.wave);
        GRID_BAR();
    }
    if (IN(7)) REP(7) {
        const int NT = *(LAS const int*)(F.lds + LT_NT);
        pg8::Gemm g{(const pg8::bf16_t*)(ws + WS_H), (const pg8::bf16_t*)(ws + WS_WT_DN), DM / 2, (size_t)DM * DM};
        pg8::MoeOrder S; S.init(NT, 4, F.G, (int)blockIdx.x, (LAS const int*)(F.lds + LT_TILE_E), F.wave, 2, args.b_dn, nullptr, F.lds + PF_OFF);
        pg8::EpiMoeDown E{(unsigned char*)(ws + WS_YS), F.lds + PF_OFF};
        pg8::gemm_phase<pg8::EpiMoeDown, pg8::MoeOrder, true, true, true>(F.lds + RING_OFF, g, S, E, F.wave);
        GRID_BAR();
    }
    if (IN(8)) { if (DUP_PHASE == 8) { combine_phase(F, args, true); GRID_BAR(); } combine_phase(F, args); GRID_BAR(); }
    if (IN(9)) {
        pg8::Gemm g{(const pg8::bf16_t*)(ws + WS_XN), (const pg8::bf16_t*)(ws + WS_WT_PG), DM / 2, 0};
        pg8::StaticOrder S; S.init(T / 256, DM / 256, F.G, (int)blockIdx.x);
        if (DUP_PHASE == 9) { pg8::EpiPle E0{(const pg8::bf16_t*)(ws + WS_Y), (const pg8::bf16_t*)(ws + WS_PJ), (float*)(ws + WS_XS)}; pg8::gemm_phase<pg8::EpiPle, pg8::StaticOrder, true, true, true>(F.lds + RING_OFF, g, S, E0, F.wave); }
        pg8::EpiPle E{(const pg8::bf16_t*)(ws + WS_Y), (const pg8::bf16_t*)(ws + WS_PJ), args.out};
        pg8::gemm_phase<pg8::EpiPle, pg8::StaticOrder, true, true, true>(F.lds + RING_OFF, g, S, E, F.wave);
    }
#undef IN
}
extern "C" void kernel_launch(void* const* d_in, const int* in_sizes, int n_in, void* d_out, int out_size, void* d_ws, size_t ws_size, hipStream_t stream) {
    static int grid = 0;
    if (grid == 0) {
        if (n_in != 22 || ws_size < 1024 * MiB) { fprintf(stderr, "kernel_launch: unexpected n_in %d / ws %zu\n", n_in, ws_size); grid = -1; return; }
        int dev = 0, cus = 0, per_cu = 0;
        if (hipGetDevice(&dev) != hipSuccess || hipDeviceGetAttribute(&cus, hipDeviceAttributeMultiprocessorCount, dev) != hipSuccess) { grid = -1; return; }
        if (hipFuncSetAttribute((const void*)mega_fwd, hipFuncAttributeMaxDynamicSharedMemorySize, LDS_BYTES) != hipSuccess) { fprintf(stderr, "kernel_launch: hipFuncSetAttribute failed\n"); grid = -1; return; }
        if (hipOccupancyMaxActiveBlocksPerMultiprocessor(&per_cu, (const void*)mega_fwd, NWAVES * 64, LDS_BYTES) != hipSuccess || per_cu < 1) { fprintf(stderr, "kernel_launch: occupancy query says %d\n", per_cu); per_cu = 1; }
        (void)hipGetLastError();
        grid = cus;
    }
    if (grid < 0) return;
    (void)hipMemsetAsync((char*)d_ws + WS_CTL, 0, CTL_ZERO_BYTES, stream);
    (void)hipMemsetAsync((char*)d_ws + WS_TOKLIST, 0, (size_t)NE * T * 4, stream);
    Args a{};
    a.x = (const float*)d_in[0]; a.p = (const float*)d_in[1]; a.positions = (const int*)d_in[2]; a.g_mix = (const float*)d_in[3]; a.w_in = (const float*)d_in[4];
    a.sbq = (const float*)d_in[5]; a.sbk = (const float*)d_in[6]; a.rq = (const float*)d_in[7]; a.rk = (const float*)d_in[8]; a.gn_g = (const float*)d_in[9]; a.gn_b = (const float*)d_in[10];
    a.w_out = (const float*)d_in[11]; a.g_ffn = (const float*)d_in[12]; a.w_r = (const float*)d_in[13]; a.b_r = (const float*)d_in[14]; a.w_ug = (const float*)d_in[15]; a.b_ug = (const float*)d_in[16];
    a.w_dn = (const float*)d_in[17]; a.b_dn = (const float*)d_in[18]; a.g_ple = (const float*)d_in[19]; a.w_pg = (const float*)d_in[20]; a.w_pp = (const float*)d_in[21];
    a.out = (float*)d_out; a.ws = (unsigned char*)d_ws; a.ph_lo = 0; a.ph_hi = 10;
    hipLaunchKernelGGL(mega_fwd, dim3(grid), dim3(NWAVES * 64), LDS_BYTES, stream, a);

}
```

```cpp
#include <hip/hip_runtime.h>
#include <cstdint>
#include <cstdio>
#include <cmath>

__device__ __forceinline__ int lane_id_hw() { return (int)__builtin_amdgcn_mbcnt_hi(~0u, __builtin_amdgcn_mbcnt_lo(~0u, 0u)); }
namespace pg8 {
#define PG8_LAS __attribute__((address_space(3)))
typedef unsigned short bf16_t;
typedef short bf16x8 __attribute__((ext_vector_type(8)));
typedef float f32x4 __attribute__((ext_vector_type(4)));
typedef unsigned u32x4 __attribute__((ext_vector_type(4)));
typedef unsigned u32x2 __attribute__((ext_vector_type(2)));
typedef int v4i32 __attribute__((ext_vector_type(4)));
typedef int v8i32 __attribute__((ext_vector_type(8)));
constexpr int BM = 256, BK = 64, HALF = 128, HTB = HALF * BK * 2  , STAGE_BYTES = 8 * HTB, NXCD = 8, WGM = 8;

__host__ __device__ __forceinline__ int lds_byte(int r, int c) { const int st = (r >> 4) * 2 + (c >> 5), rr = r & 15, cc = c & 31, ob = rr * 64 + cc * 2; return st * 1024 + (ob ^ (((ob >> 9) & 1) << 5)); }
__host__ __device__ __forceinline__ void stage_rc(int b, int& R, int& C) { const int st = b / 1024, sb = b % 1024, swz = sb ^ (((sb >> 9) & 1) << 5); R = (st >> 1) * 16 + swz / 64; C = (st & 1) * 32 + (swz % 64) / 2; }
__host__ __device__ __forceinline__ int perm32(int rho) { const int n = rho >> 4, i = rho & 15; return 8 * (i >> 2) + 4 * n + (i & 3); }

struct Unit { int pm, pn, e, seq; };
struct Gemm { const bf16_t* A; const bf16_t* Bt; int K; size_t strideBe; };

struct StaticOrder {
    int nM, nN, nwg, G, c;
    __host__ __device__ void init(int nM_, int nN_, int G_, int c_) { nM = nM_; nN = nN_; nwg = nM * nN; G = G_; c = c_; }
    __host__ __device__ bool next(int i, Unit& u) const {
        const long L = (long)i * G + c; if (L >= nwg) return false;
        int wgid = (int)L; { const int q = nwg / NXCD, r = nwg % NXCD, xcd = wgid % NXCD, off = wgid / NXCD; wgid = (xcd < r ? xcd * (q + 1) : r * (q + 1) + (xcd - r) * q) + off; }
        const int nig = WGM * nN, gid = wgid / nig, fm = gid * WGM, gsz = (nM - fm) < WGM ? (nM - fm) : WGM;
        u.pm = fm + ((wgid % nig) % gsz); u.pn = (wgid % nig) / gsz; u.e = 0; u.seq = i; return true;
    }
    __device__ __forceinline__ void a_ready(const Unit&) const {}
    __device__ __forceinline__ void done(const Unit&) const {}
};

typedef float f32x2_t __attribute__((ext_vector_type(2))); typedef __bf16 bf16x2_t __attribute__((ext_vector_type(2)));
__device__ __forceinline__ unsigned cvt_pk_bf16(float lo, float hi) { f32x2_t v = {lo, hi}; bf16x2_t b = __builtin_convertvector(v, bf16x2_t); return __builtin_bit_cast(unsigned, b); }

constexpr int T = 16384, SEQ = 2048, DM = 1024, DIN = 3584;
constexpr float EPS = 1e-6f;
__device__ __forceinline__ u32x4 pack8(const f32x4 a, const f32x4 b) { u32x4 w; w.x = cvt_pk_bf16(a[0], a[1]); w.y = cvt_pk_bf16(a[2], a[3]); w.z = cvt_pk_bf16(b[0], b[1]); w.w = cvt_pk_bf16(b[2], b[3]); return w; }

struct EpiProj {
    static constexpr bool PERM = true, AFTER_DRAIN = false;
    bf16_t* hm;
    bf16_t* rg;
    const float* gains;
    const float *ropec, *ropes;
    __device__ __forceinline__ void operator()(const f32x4 (&acc)[2][2][4][2], const Unit& u, int wr, int wc, int fr, int fq) const {
        const int region = u.pn >> 1, hb = 4 * (u.pn & 1) + wc;
        const bool normed = (region == 0) || (region == 1) || (region == 3) || (region == 4);
        const bool rope = (region == 3) || (region == 4);
        const int gidx = region == 0 ? 0 : region == 1 ? 1 : region == 3 ? 2 : 3;
        const float* gp = gains + gidx * 64;
        f32x4 gv[2][2];
#pragma unroll
        for (int bj = 0; bj < 2; ++bj)
#pragma unroll
            for (int n = 0; n < 2; ++n) gv[bj][n] = normed ? *(const f32x4*)(gp + 32 * bj + 8 * fq + 4 * n) : (f32x4){1.f, 1.f, 1.f, 1.f};
        const float lg2g = __log2f(1.0f - __builtin_amdgcn_exp2f(-5.0f - (float)hb));
        const float scale = region == 0 ? 0.125f * 1.4426950408889634f : region == 4 ? 0.125f : 1.0f;
#pragma unroll
        for (int ai = 0; ai < 2; ++ai)
#pragma unroll
            for (int m = 0; m < 4; ++m) {
                const int row = u.pm * BM + ai * HALF + wr * 64 + m * 16 + fr;
                const int b = row >> 11, s = row & (SEQ - 1);
                f32x4 v[2][2];
#pragma unroll
                for (int bj = 0; bj < 2; ++bj)
#pragma unroll
                    for (int n = 0; n < 2; ++n) v[bj][n] = acc[ai][bj][m][n];
                if (normed) {
                    float ss = 0.f;
#pragma unroll
                    for (int bj = 0; bj < 2; ++bj)
#pragma unroll
                        for (int n = 0; n < 2; ++n) { const f32x4 x = v[bj][n]; ss += (x[0] * x[0] + x[1] * x[1]) + (x[2] * x[2] + x[3] * x[3]); }
                    ss += __shfl_xor(ss, 16); ss += __shfl_xor(ss, 32);
                    float rs = rsqrtf(ss * (1.0f / 64.0f) + EPS) * scale;
                    if (rope) rs *= (region == 3) ? __builtin_amdgcn_exp2f((float)(s & 31) * lg2g) : __builtin_amdgcn_exp2f(-(float)(s & 63) * lg2g);
#pragma unroll
                    for (int bj = 0; bj < 2; ++bj)
#pragma unroll
                        for (int n = 0; n < 2; ++n) v[bj][n] = v[bj][n] * rs * gv[bj][n];
                    if (rope) {
#pragma unroll
                        for (int n = 0; n < 2; ++n) {
                            const f32x4 c = *(const f32x4*)(ropec + (size_t)row * 32 + 8 * fq + 4 * n), sn = *(const f32x4*)(ropes + (size_t)row * 32 + 8 * fq + 4 * n);
                            const f32x4 lo = v[0][n], hi = v[1][n];
                            v[0][n] = lo * c - hi * sn; v[1][n] = hi * c + lo * sn;
                        }
                    }
                }
                bf16_t* dst = (region < 6) ? hm + (size_t)region * ((size_t)T * 512) + ((size_t)(b * 8 + hb) * SEQ + s) * 64 + 8 * fq
                                           : rg + (size_t)row * 512 + hb * 64 + 8 * fq;
#pragma unroll
                for (int bj = 0; bj < 2; ++bj) *(u32x4*)(dst + 32 * bj) = pack8(v[bj][0], v[bj][1]);
            }
    }
};

constexpr int PF_WAVE_BYTES = 768, PF_BUF_BYTES = 8 * PF_WAVE_BYTES;
struct EpiBf16Plain {
    static constexpr bool PERM = true, AFTER_DRAIN = false;
    bf16_t* O; int ldc;
    __device__ __forceinline__ void operator()(const f32x4 (&acc)[2][2][4][2], const Unit& u, int wr, int wc, int fr, int fq) const {
        const int row0 = u.pm * BM + wr * 64 + fr, col0 = u.pn * BM + wc * 32 + 8 * fq;
#pragma unroll
        for (int ai = 0; ai < 2; ++ai)
#pragma unroll
            for (int m = 0; m < 4; ++m) { bf16_t* rowp = O + (size_t)(row0 + ai * HALF + m * 16) * ldc + col0;
#pragma unroll
                for (int bj = 0; bj < 2; ++bj) *(u32x4*)(rowp + bj * HALF) = pack8(acc[ai][bj][m][0], acc[ai][bj][m][1]); }
    }
};
struct EpiResid {
    static constexpr bool PERM = true, AFTER_DRAIN = false;
    const float* base; bf16_t* X1;
    __device__ __forceinline__ void operator()(const f32x4 (&acc)[2][2][4][2], const Unit& u, int wr, int wc, int fr, int fq) const {
        const int col0 = u.pn * BM + wc * 32 + 8 * fq;
#pragma unroll
        for (int ai = 0; ai < 2; ++ai)
#pragma unroll
            for (int m = 0; m < 4; ++m) { const size_t off = (size_t)(u.pm * BM + ai * HALF + wr * 64 + m * 16 + fr) * DM + col0;
#pragma unroll
                for (int bj = 0; bj < 2; ++bj) { const f32x4 b0 = __builtin_nontemporal_load((const f32x4*)(base + off + bj * HALF)), b1 = __builtin_nontemporal_load((const f32x4*)(base + off + bj * HALF + 4));
                    *(u32x4*)(X1 + off + bj * HALF) = pack8(b0 + acc[ai][bj][m][0], b1 + acc[ai][bj][m][1]); } }
    }
};
struct EpiMoeUp {
    static constexpr bool PERM = true, AFTER_DRAIN = false;
    unsigned char* H; const PG8_LAS unsigned char* pf_lds;
    __device__ __forceinline__ void operator()(const f32x4 (&acc)[2][2][4][2], const Unit& u, int wr, int wc, int fr, int fq) const {
        const int cc = 128 * u.pn + 32 * wc + 8 * fq;
        f32x4 bg[2], bl[2]; float scs[2][4];
        const PG8_LAS unsigned char* buf = pf_lds + (u.seq & 1) * PF_BUF_BYTES + (wr * 4 + wc) * PF_WAVE_BYTES;
#pragma unroll
        for (int n = 0; n < 2; ++n) { bg[n] = *(const PG8_LAS f32x4*)(buf + (8 * fq + 4 * n) * 4); bl[n] = *(const PG8_LAS f32x4*)(buf + 128 + (8 * fq + 4 * n) * 4); }
#pragma unroll
        for (int ai = 0; ai < 2; ++ai)
#pragma unroll
            for (int m = 0; m < 4; ++m) scs[ai][m] = *(const PG8_LAS float*)(buf + 256 + ai * 256 + (m * 16 + fr) * 4);
#pragma unroll
        for (int n = 0; n < 2; ++n) bl[n] = bl[n] + 1.0f;
#pragma unroll
        for (int ai = 0; ai < 2; ++ai)
#pragma unroll
            for (int m = 0; m < 4; ++m) {
                const float sc = scs[ai][m] * 0.015625f;
                f32x4 hv[2];
#pragma unroll
                for (int n = 0; n < 2; ++n) {
                    const f32x4 g0 = acc[ai][0][m][n] * sc + bg[n], l1 = acc[ai][1][m][n] * sc + bl[n];
                    f32x4 glu, lin1;
#pragma unroll
                    for (int j = 0; j < 4; ++j) { glu[j] = __builtin_fminf(g0[j], 7.0f); lin1[j] = __builtin_amdgcn_fmed3f(l1[j], -6.0f, 8.0f); }
                    const f32x4 t = glu * (-1.702f * 1.4426950408889634f);
                    f32x4 e;
#pragma unroll
                    for (int j = 0; j < 4; ++j) e[j] = __builtin_amdgcn_exp2f(t[j]);
                    const f32x4 d = e + 1.0f;
                    f32x4 r;
#pragma unroll
                    for (int j = 0; j < 4; ++j) r[j] = __builtin_amdgcn_rcpf(d[j]);
                    hv[n] = (glu * r) * lin1;
                }
                u32x2 hq; hq.x = (unsigned)__builtin_amdgcn_cvt_pk_fp8_f32(hv[0][0], hv[0][1], 0, false); hq.x = (unsigned)__builtin_amdgcn_cvt_pk_fp8_f32(hv[0][2], hv[0][3], (int)hq.x, true);
                hq.y = (unsigned)__builtin_amdgcn_cvt_pk_fp8_f32(hv[1][0], hv[1][1], 0, false); hq.y = (unsigned)__builtin_amdgcn_cvt_pk_fp8_f32(hv[1][2], hv[1][3], (int)hq.y, true);
                *(u32x2*)(H + (size_t)(u.pm * BM + ai * HALF + wr * 64 + m * 16 + fr) * 1024 + cc) = hq;
            }
    }
};
struct EpiMoeDown {
    static constexpr bool PERM = true, AFTER_DRAIN = false;
    unsigned char* YS; const PG8_LAS unsigned char* pf_lds;
    __device__ __forceinline__ void operator()(const f32x4 (&acc)[2][2][4][2], const Unit& u, int wr, int wc, int fr, int fq) const {
        const int col0 = u.pn * BM + wc * 32 + 8 * fq;
        const PG8_LAS unsigned char* buf = pf_lds + (u.seq & 1) * PF_BUF_BYTES + (wr * 4 + wc) * PF_WAVE_BYTES;
        f32x4 bv[2][2];
#pragma unroll
        for (int bj = 0; bj < 2; ++bj)
#pragma unroll
            for (int n = 0; n < 2; ++n) bv[bj][n] = *(const PG8_LAS f32x4*)(buf + bj * 128 + (8 * fq + 4 * n) * 4);
#pragma unroll
        for (int ai = 0; ai < 2; ++ai)
#pragma unroll
            for (int m = 0; m < 4; ++m) { unsigned char* rowp = YS + (size_t)(u.pm * BM + ai * HALF + wr * 64 + m * 16 + fr) * 1024 + col0;
#pragma unroll
                for (int bj = 0; bj < 2; ++bj) { const f32x4 y0 = acc[ai][bj][m][0] * 0.015625f + bv[bj][0], y1 = acc[ai][bj][m][1] * 0.015625f + bv[bj][1];
                    u32x2 q; q.x = (unsigned)__builtin_amdgcn_cvt_pk_fp8_f32(y0[0], y0[1], 0, false); q.x = (unsigned)__builtin_amdgcn_cvt_pk_fp8_f32(y0[2], y0[3], (int)q.x, true);
                    q.y = (unsigned)__builtin_amdgcn_cvt_pk_fp8_f32(y1[0], y1[1], 0, false); q.y = (unsigned)__builtin_amdgcn_cvt_pk_fp8_f32(y1[2], y1[3], (int)q.y, true);
                    *(u32x2*)(rowp + bj * HALF) = q; } }
    }
};
struct EpiPle {
    static constexpr bool PERM = false, AFTER_DRAIN = false;
    const bf16_t* X2; const bf16_t* PJ; float* outw;
    __device__ __forceinline__ void operator()(const f32x4 (&acc)[2][2][4][2], const Unit& u, int wr, int wc, int fr, int fq) const {
        const int col0 = u.pn * BM + wc * 32 + 4 * fq;
#pragma unroll
        for (int ai = 0; ai < 2; ++ai)
#pragma unroll
            for (int m = 0; m < 4; ++m) { const size_t off = (size_t)(u.pm * BM + ai * HALF + wr * 64 + m * 16 + fr) * DM + col0;
#pragma unroll
                for (int bj = 0; bj < 2; ++bj)
#pragma unroll
                    for (int n = 0; n < 2; ++n) {
                        const size_t o2 = off + bj * HALF + n * 16;
                        const u32x2 xq = __builtin_nontemporal_load((const u32x2*)(X2 + o2)); const f32x4 x2 = (f32x4){__uint_as_float(xq.x << 16), __uint_as_float(xq.x & 0xffff0000u), __uint_as_float(xq.y << 16), __uint_as_float(xq.y & 0xffff0000u)}; const u32x2 pj = __builtin_nontemporal_load((const u32x2*)(PJ + o2)); const f32x4 a = acc[ai][bj][m][n] * 0.015625f;
                        f32x4 r;
                        r[0] = x2[0] + __uint_as_float(pj.x << 16) * __builtin_amdgcn_rcpf(1.0f + __builtin_amdgcn_exp2f(-1.4426950408889634f * a[0]));
                        r[1] = x2[1] + __uint_as_float(pj.x & 0xffff0000u) * __builtin_amdgcn_rcpf(1.0f + __builtin_amdgcn_exp2f(-1.4426950408889634f * a[1]));
                        r[2] = x2[2] + __uint_as_float(pj.y << 16) * __builtin_amdgcn_rcpf(1.0f + __builtin_amdgcn_exp2f(-1.4426950408889634f * a[2]));
                        r[3] = x2[3] + __uint_as_float(pj.y & 0xffff0000u) * __builtin_amdgcn_rcpf(1.0f + __builtin_amdgcn_exp2f(-1.4426950408889634f * a[3]));
                        __builtin_nontemporal_store(r, (f32x4*)(outw + o2));
                    } }
    }
};
struct MoeOrder {
    int nM, nN, nwg, G, c, wid, mode; const PG8_LAS int* tile_e; const float* pf_bias; const float* pf_rstd; PG8_LAS unsigned char* pf_lds;
    const int* toklist; const PG8_LAS int* first_tile; PG8_LAS unsigned char* tokl;
    __device__ __forceinline__ const int* tok_src(const Unit& u) const { return toklist + (size_t)u.e * T + 256 * (u.pm - first_tile[u.e]); }
    __device__ __forceinline__ PG8_LAS unsigned char* tok_lds() const { return tokl; }
    __device__ void init(int nM_, int nN_, int G_, int c_, const PG8_LAS int* te, int wid_, int mode_, const float* pb, const float* pr, PG8_LAS unsigned char* pl) { nM = nM_; nN = nN_; nwg = nM * nN; G = G_; c = c_; tile_e = te; wid = wid_; mode = mode_; pf_bias = pb; pf_rstd = pr; pf_lds = pl; }
    __device__ bool next(int i, Unit& u) const {
        const long L = (long)i * G + c; if (L >= nwg) return false;
        int wgid = (int)L; { const int q = nwg / NXCD, r = nwg % NXCD, xcd = wgid % NXCD, off = wgid / NXCD; wgid = (xcd < r ? xcd * (q + 1) : r * (q + 1) + (xcd - r) * q) + off; }
        const int nig = WGM * nN, gid = wgid / nig, fm = gid * WGM, gsz = (nM - fm) < WGM ? (nM - fm) : WGM;
        u.pm = fm + ((wgid % nig) % gsz); u.pn = (wgid % nig) / gsz; u.e = __builtin_amdgcn_readfirstlane(tile_e[u.pm]); u.seq = i; return true;
    }
    __device__ __forceinline__ void a_ready(const Unit& u) const {
        const int lane = (int)__builtin_amdgcn_mbcnt_hi(~0u, __builtin_amdgcn_mbcnt_lo(~0u, 0u)), wr = wid >> 2, wc = wid & 3;
        PG8_LAS unsigned char* buf = pf_lds + (u.seq & 1) * PF_BUF_BYTES + wid * PF_WAVE_BYTES;
        if (mode == 1) {
            const float* bsrc = pf_bias + (size_t)u.e * 2048 + 128 * u.pn + 32 * wc + (lane & 31) + ((lane >> 5) ? 1024 : 0);
            __builtin_amdgcn_global_load_lds((const unsigned*)bsrc, (PG8_LAS unsigned*)buf, 4, 0, 0);
            const PG8_LAS int* tl = (const PG8_LAS int*)(tokl + 1024 * (u.seq & 1)) + wr * 64 + lane;
            __builtin_amdgcn_global_load_lds((const unsigned*)(pf_rstd + tl[0]), (PG8_LAS unsigned*)(buf + 256), 4, 0, 0);
            __builtin_amdgcn_global_load_lds((const unsigned*)(pf_rstd + tl[HALF]), (PG8_LAS unsigned*)(buf + 512), 4, 0, 0);
        } else if (mode == 2) {
            const float* bsrc = pf_bias + (size_t)u.e * 1024 + u.pn * BM + 32 * wc + (lane & 31) + ((lane >> 5) ? HALF : 0);
            __builtin_amdgcn_global_load_lds((const unsigned*)bsrc, (PG8_LAS unsigned*)buf, 4, 0, 0);
        }
    }
    __device__ __forceinline__ void done(const Unit&) const {}
};
struct EpiNull {
    static constexpr bool PERM = true, AFTER_DRAIN = false;
    __device__ __forceinline__ void operator()(const f32x4 (&acc)[2][2][4][2], const Unit& u, int wr, int wc, int fr, int fq) const {
#pragma unroll
        for (int ai = 0; ai < 2; ++ai)
#pragma unroll
            for (int bj = 0; bj < 2; ++bj)
#pragma unroll
                for (int m = 0; m < 4; ++m)
#pragma unroll
                    for (int n = 0; n < 2; ++n) asm volatile("" :: "v"(acc[ai][bj][m][n]));
    }
};
template <class Epi, class Sched, bool ALIGN_EPI = false, bool SP2 = false, bool F8 = false, bool GATHER = false>
__device__ __forceinline__ void gemm_phase(PG8_LAS unsigned char* lds, const Gemm g, const Sched& S, const Epi& E, const int wave_id) {
    int tid_ = wave_id * 64 + lane_id_hw(); asm volatile("" : "+v"(tid_));
    const int tid = tid_, wid = __builtin_amdgcn_readfirstlane(tid >> 6), lane = tid & 63, wr = wid >> 2, wc = wid & 3, fr = lane & 15, fq = lane >> 4;
    const int K = g.K, nt = K / BK;
    unsigned voffA[2], voffB[2];
#pragma unroll
    for (int i = 0; i < 2; ++i) { int R, C; stage_rc(tid * 16 + i * 8192, R, C); const int Rb = Epi::PERM ? ((R & ~31) + perm32(R & 31)) : R;
        voffA[i] = (unsigned)(R * K + C) * 2u; voffB[i] = (unsigned)(Rb * K + C) * 2u; }
    const size_t kstep = (size_t)(BK * 2);
    const size_t hstep = (size_t)HALF * K * 2;
    const size_t tstep = 2 * hstep;
    const size_t hstepA = GATHER ? 0 : hstep;
    unsigned gC[2][2];
#pragma unroll
    for (int h = 0; h < 2; ++h)
#pragma unroll
        for (int i = 0; i < 2; ++i) gC[h][i] = voffA[i];
#define PG8_TOK_DMA(U, par) do { if constexpr (GATHER) { if (wid < 4) __builtin_amdgcn_global_load_lds((const unsigned*)(S.tok_src(U) + 64 * wid + (int)__builtin_amdgcn_mbcnt_hi(~0u, __builtin_amdgcn_mbcnt_lo(~0u, 0u))), (PG8_LAS unsigned*)(S.tok_lds() + 1024 * (par) + 256 * wid), 4, 0, 0); } } while (0)
#define PG8_TOK_READ(dst, par) do { if constexpr (GATHER) { _Pragma("unroll") for (int i = 0; i < 2; ++i) { int R_, C_; stage_rc((wid * 64 + (int)__builtin_amdgcn_mbcnt_hi(~0u, __builtin_amdgcn_mbcnt_lo(~0u, 0u))) * 16 + i * 8192, R_, C_); _Pragma("unroll") for (int h = 0; h < 2; ++h) \
        dst[h][i] = (unsigned)(*(const PG8_LAS int*)(S.tok_lds() + 1024 * (par) + 4 * (h * HALF + R_))) * (unsigned)(K * 2) + (unsigned)C_ * 2u; } } } while (0)
    const unsigned ldsw = (unsigned)wid * 1024u;
    const int aoff = lds_byte(wr * 64 + fr, fq * 8), boff = lds_byte(wc * 32 + fr, fq * 8);
#define PG8_SA(b, h) (((b) * 2 + (h)) * HTB)
#define PG8_SB(b, h) ((4 + (b) * 2 + (h)) * HTB)
#define PG8_STAGE(bufoff, gbase, voff) do { _Pragma("unroll") for (int _i = 0; _i < 2; ++_i) \
        __builtin_amdgcn_global_load_lds((const unsigned*)((const char*)(gbase) + (voff)[_i]), (PG8_LAS unsigned*)(lds + (bufoff) + ldsw + _i * 8192), 16, 0, 0); } while (0)
#define PG8_LD16(off) (*(const PG8_LAS v4i32*)(lds + (off)))
#define PG8_LDA(dst, b, h) do { if constexpr (F8) { _Pragma("unroll") for (int m = 0; m < 4; ++m) dst##8[m] = __builtin_shufflevector(PG8_LD16(PG8_SA(b, h) + aoff + m * 2048), PG8_LD16(PG8_SA(b, h) + aoff + m * 2048 + 1024), 0, 1, 2, 3, 4, 5, 6, 7); } \
        else { _Pragma("unroll") for (int m = 0; m < 4; ++m) _Pragma("unroll") for (int k = 0; k < 2; ++k) dst[m][k] = *(const PG8_LAS bf16x8*)(lds + PG8_SA(b, h) + aoff + m * 2048 + k * 1024); } } while (0)
#define PG8_LDB(dst, b, h) do { if constexpr (F8) { _Pragma("unroll") for (int n = 0; n < 2; ++n) dst##8[n] = __builtin_shufflevector(PG8_LD16(PG8_SB(b, h) + boff + n * 2048), PG8_LD16(PG8_SB(b, h) + boff + n * 2048 + 1024), 0, 1, 2, 3, 4, 5, 6, 7); } \
        else { _Pragma("unroll") for (int n = 0; n < 2; ++n) _Pragma("unroll") for (int k = 0; k < 2; ++k) dst[n][k] = *(const PG8_LAS bf16x8*)(lds + PG8_SB(b, h) + boff + n * 2048 + k * 1024); } } while (0)
#define PG8_MMA(ai, bj, At, Bt) do { __builtin_amdgcn_s_setprio(1); \
        if constexpr (F8) { _Pragma("unroll") for (int m = 0; m < 4; ++m) _Pragma("unroll") for (int n = 0; n < 2; ++n) \
            asm volatile("v_mfma_scale_f32_16x16x128_f8f6f4 %0, %1, %2, %0, %3, %3 op_sel_hi:[0,0,0]" : "+v"(acc[ai][bj][m][n]) : "v"(Bt##8[n]), "v"(At##8[m]), "v"(f8scale)); } \
        else { _Pragma("unroll") for (int m = 0; m < 4; ++m) _Pragma("unroll") for (int n = 0; n < 2; ++n) _Pragma("unroll") for (int k = 0; k < 2; ++k) \
            acc[ai][bj][m][n] = __builtin_amdgcn_mfma_f32_16x16x32_bf16(Bt[n][k], At[m][k], acc[ai][bj][m][n], 0, 0, 0); } \
        __builtin_amdgcn_s_setprio(0); } while (0)
#define PG8_WAIT_V(n) asm volatile("s_waitcnt vmcnt(" #n ")" ::: "memory")
#define PG8_WAIT_L(n) asm volatile("s_waitcnt lgkmcnt(" #n ")" ::: "memory")
#define PG8_BAR __builtin_amdgcn_s_barrier()
#define PG8_SCHED __builtin_amdgcn_sched_barrier(0)
    Unit cur, nxt; int ui = 0;
    if (!S.next(0, cur)) return;
    f32x4 acc[2][2][4][2];
#pragma unroll
    for (int a = 0; a < 2; ++a)
#pragma unroll
        for (int b = 0; b < 2; ++b)
#pragma unroll
            for (int m = 0; m < 4; ++m)
#pragma unroll
                for (int n = 0; n < 2; ++n) acc[a][b][m][n] = (f32x4){0.f, 0.f, 0.f, 0.f};
    bf16x8 At[4][2], B0[2][2], B1[2][2];
    v8i32 At8[4], B08[2], B18[2]; const int f8scale = 0x7f7f7f7f;
    const char* cA = (const char*)g.A + (GATHER ? (size_t)0 : (size_t)cur.pm * tstep); const char* cB = (const char*)g.Bt + (size_t)cur.e * g.strideBe + (size_t)cur.pn * tstep;
    if constexpr (GATHER) { PG8_TOK_DMA(cur, 0); asm volatile("s_waitcnt vmcnt(0)" ::: "memory"); PG8_BAR; PG8_TOK_READ(gC, 0); }
    S.a_ready(cur);
    if constexpr (SP2) {
        PG8_STAGE(PG8_SB(0, 0), cB, voffB); PG8_STAGE(PG8_SB(0, 1), cB + hstep, voffB); PG8_STAGE(PG8_SA(0, 0), cA, gC[0]); PG8_STAGE(PG8_SA(0, 1), cA + hstepA, gC[1]);
        if (wr == 1) PG8_BAR;
        PG8_WAIT_V(2); PG8_BAR;
        PG8_STAGE(PG8_SB(1, 0), cB + kstep, voffB); PG8_STAGE(PG8_SA(1, 0), cA + kstep, gC[0]); PG8_STAGE(PG8_SB(1, 1), cB + hstep + kstep, voffB);
        PG8_WAIT_V(6); PG8_BAR;
    } else {
        PG8_STAGE(PG8_SB(0, 0), cB, voffB); PG8_STAGE(PG8_SA(0, 0), cA, voffA); PG8_STAGE(PG8_SB(0, 1), cB + hstep, voffB); PG8_STAGE(PG8_SA(0, 1), cA + hstep, voffA);
        if (wr == 1) PG8_BAR;
        PG8_WAIT_V(4); PG8_BAR;
        PG8_STAGE(PG8_SB(1, 0), cB + kstep, voffB); PG8_STAGE(PG8_SA(1, 0), cA + kstep, voffA); PG8_STAGE(PG8_SB(1, 1), cB + hstep + kstep, voffB);
        PG8_WAIT_V(6); PG8_BAR;
    }
    for (;;) {
        const bool has_next = S.next(ui + 1, nxt);
        const char* nA = (has_next && !GATHER) ? (const char*)g.A + (size_t)nxt.pm * tstep : cA;
        const char* nB = has_next ? (const char*)g.Bt + (size_t)nxt.e * g.strideBe + (size_t)nxt.pn * tstep : cB;
        if (has_next) PG8_TOK_DMA(nxt, (ui + 1) & 1);
#pragma unroll 1
        for (int t = 0; t < nt; t += 2) {
            const bool last = (t == nt - 2);
            const char* a1 = cA + (size_t)(t + 1) * kstep;
            const char* a2 = last ? nA : cA + (size_t)(t + 2) * kstep; const char* b2 = last ? nB : cB + (size_t)(t + 2) * kstep;
            const char* a3 = a2 + kstep; const char* b3 = b2 + kstep;
            if (last && has_next) S.a_ready(nxt);
            if constexpr (SP2) {
            PG8_LDB(B0, 0, 0); PG8_LDB(B1, 0, 1); PG8_SCHED; PG8_LDA(At, 0, 0); PG8_STAGE(PG8_SA(1, 1), a1 + hstepA, gC[1]);
            if constexpr (GATHER) { if (last && has_next) PG8_TOK_READ(gC, (ui + 1) & 1); }
            PG8_WAIT_V(8); PG8_WAIT_L(0); PG8_BAR; PG8_MMA(0, 0, At, B0); PG8_MMA(0, 1, At, B1); PG8_BAR; PG8_SCHED;
            PG8_LDA(At, 0, 1); PG8_STAGE(PG8_SB(0, 0), b2, voffB); PG8_STAGE(PG8_SB(0, 1), b2 + hstep, voffB); PG8_STAGE(PG8_SA(0, 0), a2, gC[0]);
            PG8_WAIT_V(8); PG8_WAIT_L(0); PG8_BAR; PG8_MMA(1, 0, At, B0); PG8_MMA(1, 1, At, B1); PG8_BAR; PG8_SCHED;
            PG8_LDB(B0, 1, 0); PG8_LDB(B1, 1, 1); PG8_SCHED; PG8_LDA(At, 1, 0); PG8_STAGE(PG8_SA(0, 1), a2 + hstepA, gC[1]);
            PG8_WAIT_V(8); PG8_WAIT_L(0); PG8_BAR; PG8_MMA(0, 0, At, B0); PG8_MMA(0, 1, At, B1); PG8_BAR; PG8_SCHED;
            PG8_LDA(At, 1, 1); PG8_STAGE(PG8_SB(1, 0), b3, voffB); PG8_STAGE(PG8_SB(1, 1), b3 + hstep, voffB); PG8_STAGE(PG8_SA(1, 0), a3, gC[0]);
            PG8_WAIT_V(8); PG8_WAIT_L(0); PG8_BAR; PG8_MMA(1, 0, At, B0); PG8_MMA(1, 1, At, B1); PG8_BAR; PG8_SCHED;
            } else {
            PG8_LDB(B0, 0, 0); PG8_SCHED; PG8_LDA(At, 0, 0); PG8_STAGE(PG8_SA(1, 1), a1 + hstep, voffA);
            PG8_WAIT_L(8); PG8_BAR; PG8_WAIT_L(0); PG8_MMA(0, 0, At, B0); PG8_BAR; PG8_SCHED;
            PG8_LDB(B1, 0, 1); PG8_STAGE(PG8_SB(0, 0), b2, voffB);
            PG8_BAR; PG8_WAIT_L(0); PG8_MMA(0, 1, At, B1); PG8_BAR;
            PG8_LDA(At, 0, 1); PG8_STAGE(PG8_SA(0, 0), a2, voffA);
            PG8_BAR; PG8_WAIT_L(0); PG8_MMA(1, 0, At, B0); PG8_BAR; PG8_SCHED;
            PG8_STAGE(PG8_SB(0, 1), b2 + hstep, voffB);
            PG8_WAIT_V(6); PG8_BAR; PG8_MMA(1, 1, At, B1); PG8_BAR;
            PG8_LDB(B0, 1, 0); PG8_SCHED; PG8_LDA(At, 1, 0); PG8_STAGE(PG8_SA(0, 1), a2 + hstep, voffA);
            PG8_WAIT_L(8); PG8_BAR; PG8_WAIT_L(0); PG8_MMA(0, 0, At, B0); PG8_BAR; PG8_SCHED;
            PG8_LDB(B1, 1, 1); PG8_STAGE(PG8_SB(1, 0), b3, voffB);
            PG8_BAR; PG8_WAIT_L(0); PG8_MMA(0, 1, At, B1); PG8_BAR;
            PG8_LDA(At, 1, 1); PG8_STAGE(PG8_SA(1, 0), a3, voffA);
            PG8_BAR; PG8_WAIT_L(0); PG8_MMA(1, 0, At, B0); PG8_BAR; PG8_SCHED;
            PG8_STAGE(PG8_SB(1, 1), b3 + hstep, voffB);
            PG8_WAIT_V(6); PG8_BAR; PG8_MMA(1, 1, At, B1); PG8_BAR;
            }
        }
        if constexpr (ALIGN_EPI) { if (wr == 0) PG8_BAR; }
        if constexpr (F8) asm volatile("s_nop 15\n\ts_nop 15\n\ts_nop 15" ::: "memory");
        if constexpr (!Epi::AFTER_DRAIN) { E(acc, cur, wr, wc, fr, fq); S.done(cur); }
        if (!has_next) break;
#pragma unroll
        for (int a = 0; a < 2; ++a)
#pragma unroll
            for (int b = 0; b < 2; ++b)
#pragma unroll
                for (int m = 0; m < 4; ++m)
#pragma unroll
                    for (int n = 0; n < 2; ++n) acc[a][b][m][n] = (f32x4){0.f, 0.f, 0.f, 0.f};
        cur = nxt; cA = nA; cB = nB; ++ui;
        if constexpr (ALIGN_EPI) { if (wr == 1) PG8_BAR; }
    }
    PG8_WAIT_V(0);
    if constexpr (!ALIGN_EPI) { if (wr == 0) PG8_BAR; }
    PG8_BAR;
    if constexpr (Epi::AFTER_DRAIN) { E.fused(acc, cur, wr, wc, fr, fq, lds, wid, lane); S.done(cur); }
#undef PG8_TOK_DMA
#undef PG8_TOK_READ
#undef PG8_SA
#undef PG8_SB
#undef PG8_STAGE
#undef PG8_LD16
#undef PG8_LDA
#undef PG8_LDB
#undef PG8_MMA
#undef PG8_WAIT_V
#undef PG8_WAIT_L
#undef PG8_BAR
#undef PG8_SCHED
}
}

constexpr int NWAVES = 8;
constexpr int T = pg8::T, SEQ = pg8::SEQ, DM = pg8::DM, DIN = pg8::DIN, NE = 32, PLE = 256;
constexpr float EPS = pg8::EPS;
constexpr size_t MiB = 1u << 20;
constexpr size_t WS_CTL = 0, CTL_ZERO_BYTES = 1 * MiB;
constexpr size_t WS_WT_IN = 2 * MiB, WS_WT_OUT = 9 * MiB, WS_WT_PG = 11 * MiB, WS_WT_PP = 13 * MiB;
constexpr size_t WS_GAINS = 13 * MiB + 512 * 1024;
constexpr size_t WS_WRT = 13 * MiB + 576 * 1024;
constexpr size_t WS_ROPEC = 14 * MiB, WS_ROPES = 16 * MiB, WS_PB = 18 * MiB, WS_ROUTE = 26 * MiB;
constexpr size_t WS_TOKLIST = 29 * MiB;
constexpr size_t WS_WT_UG = 32 * MiB, WS_WT_DN = 160 * MiB;
constexpr size_t WS_XN = 224 * MiB;
constexpr size_t WS_HM = 256 * MiB;
constexpr size_t WS_X1 = 256 * MiB;
constexpr size_t WS_RG = 352 * MiB;
constexpr size_t WS_Y = 368 * MiB;
constexpr size_t WS_PJ = 400 * MiB;
constexpr size_t WS_XS = 432 * MiB, WS_H = 576 * MiB, WS_YS = 720 * MiB;
constexpr size_t WS_END = 864 * MiB;
constexpr int CW_TMO = 0, CW_CODE = 1;
constexpr int CW_BAR = 4096;
constexpr int RING_OFF = 0, RING_BYTES = 131072;
constexpr int LDSCTL_OFF = RING_BYTES, MISC_OFF = LDSCTL_OFF + 320;
constexpr int PF_OFF = LDSCTL_OFF + 4096;
constexpr int TOKL_OFF = LDSCTL_OFF + 16384;
constexpr int LDS_BYTES = 151552;
#define GAS __attribute__((address_space(1)))
#define LAS __attribute__((address_space(3)))
typedef unsigned short bf16;
typedef unsigned v4u __attribute__((ext_vector_type(4)));
typedef float f32x4 __attribute__((ext_vector_type(4)));
typedef short bf16x8 __attribute__((ext_vector_type(8)));
typedef unsigned u32x4_t __attribute__((ext_vector_type(4)));
typedef unsigned u32x2_t __attribute__((ext_vector_type(2)));
typedef GAS unsigned gu32;
typedef GAS unsigned long long gu64;
#define RLX_AGENT __ATOMIC_RELAXED, __HIP_MEMORY_SCOPE_AGENT
#define LDS_WAIT() asm volatile("s_waitcnt lgkmcnt(0)" ::: "memory")
#define VM_WAIT() asm volatile("s_waitcnt vmcnt(0)" ::: "memory")
__device__ __forceinline__ unsigned long long rt() { return __builtin_amdgcn_s_memrealtime(); }
__device__ __forceinline__ unsigned f2bf(float f) { unsigned u = __builtin_bit_cast(unsigned, f); return (u + 0x7fffu + ((u >> 16) & 1u)) >> 16; }
__device__ __forceinline__ unsigned pk2(float lo, float hi) { return f2bf(lo) | (f2bf(hi) << 16); }

#define XB_TMO      128
#define XB_XCNT(j)  (256  + 64 * (j))
#define XB_XSUB(j)  (1280 + 64 * (j))
#define XB_XGEN(j)  (2304 + 64 * (j))
#define XB_TOP      3328
#define XB_TOPGEN   3392
#define XCD_BAR_WORDS 3456
#define XB_SPIN_CAP (1u << 18)

__device__ __forceinline__ unsigned xb_ld(unsigned* p)              { return __hip_atomic_load(p, __ATOMIC_RELAXED, __HIP_MEMORY_SCOPE_AGENT); }
__device__ __forceinline__ unsigned xb_add(unsigned* p, unsigned v) { return __hip_atomic_fetch_add(p, v, __ATOMIC_RELAXED, __HIP_MEMORY_SCOPE_AGENT); }
__device__ __forceinline__ unsigned xb_xcc_id() { return (unsigned)__builtin_amdgcn_s_getreg((3 << 11) | 20) & 0xFu; }
#define XB_SPIN(cond, bar) do { unsigned _sp = 0; while (cond) { __builtin_amdgcn_s_sleep(1); \
    if ((++_sp & 255u) == 0u) { if (xb_ld(&(bar)[XB_TMO])) break; if (_sp > XB_SPIN_CAP) { atomicAdd(&(bar)[XB_TMO], 1u); break; } } } } while (0)

struct XcdBarrier {
    unsigned* bar; unsigned x; int wave;
    volatile LAS unsigned* st;
};

__device__ __forceinline__ XcdBarrier xcd_barrier_post(unsigned* bar, volatile LAS unsigned* st) {
    XcdBarrier b; b.bar = bar; b.x = xb_xcc_id(); b.st = st;
    if (threadIdx.x == 0) (void)xb_add(&bar[XB_XCNT(b.x)], 1u);
    return b;
}
__device__ __forceinline__ void xcd_barrier_complete(unsigned* bar, unsigned x, unsigned& nloc, unsigned& nx) {
    const unsigned G = gridDim.x * gridDim.y * gridDim.z;
    unsigned sum, cnt, mine, sp = 0u;
    for (;;) {
        sum = 0u; cnt = 0u; mine = 0u;
#pragma unroll
        for (unsigned j = 0; j < 16; ++j) { const unsigned c = xb_ld(&bar[XB_XCNT(j)]); sum += c; cnt += (c > 0u) ? 1u : 0u; mine = (j == x) ? c : mine; }
        if (sum == G) break;
        __builtin_amdgcn_s_sleep(1);
        if ((++sp & 255u) == 0u) { if (xb_ld(&bar[XB_TMO])) break; if (sp > XB_SPIN_CAP) { atomicAdd(&bar[XB_TMO], 1u); break; } }
    }
    nloc = mine > 0u ? mine : 1u; nx = cnt > 0u ? cnt : 1u;
}

__device__ __forceinline__ void xcd_barrier(const XcdBarrier& b) {
    asm volatile("s_waitcnt vmcnt(0)" ::: "memory");
    __syncthreads();
    if (b.wave == 0 && lane_id_hw() == 0) {
        unsigned* bar = b.bar;
        __builtin_amdgcn_s_waitcnt(0);
        unsigned nloc = b.st[0], nx = b.st[1];
        if (nloc == 0u) { xcd_barrier_complete(bar, b.x, nloc, nx); b.st[0] = nloc; b.st[1] = nx; }
        const unsigned old = xb_add(&bar[XB_XSUB(b.x)], 1u);
        const unsigned gen = old / nloc;
        const unsigned tgen = gen;
        if (old + 1u == (gen + 1u) * nloc) {
            __builtin_amdgcn_fence(__ATOMIC_RELEASE, "agent");
            asm volatile("s_waitcnt vmcnt(0)" ::: "memory");
            const unsigned og = xb_add(&bar[XB_TOP], 1u);
            const unsigned tg = og / nx;
            if (og + 1u == (tg + 1u) * nx) xb_add(&bar[XB_TOPGEN], 1u);
            else XB_SPIN(xb_ld(&bar[XB_TOPGEN]) == tg, bar);
        } else {
            XB_SPIN(xb_ld(&bar[XB_TOPGEN]) == tgen, bar);
        }
        __builtin_amdgcn_fence(__ATOMIC_ACQUIRE, "agent");
        asm volatile("s_waitcnt vmcnt(0)" ::: "memory");
    }
    __syncthreads();
}

struct Args {
    const float* x; const float* p; const int* positions; const float* g_mix; const float* w_in;
    const float* sbq; const float* sbk; const float* rq; const float* rk; const float* gn_g; const float* gn_b; const float* w_out;
    const float* g_ffn; const float* w_r; const float* b_r; const float* w_ug; const float* b_ug; const float* w_dn; const float* b_dn;
    const float* g_ple; const float* w_pg; const float* w_pp;
    float* out; unsigned char* ws; int ph_lo, ph_hi;
};
struct Frame {
    LAS unsigned char* lds;
    volatile LAS unsigned* MISC;
    gu32* ctl;
    int wave;
    int vcu, G;
};
__device__ __forceinline__ int tid_now(int wave_id) { int t = wave_id * 64 + lane_id_hw(); asm volatile("" : "+v"(t)); return t; }
__device__ __forceinline__ float wave_sum(float v) {
#pragma unroll
    for (int o = 1; o < 64; o <<= 1) v += __shfl_xor(v, o);
    return v;
}
__device__ __forceinline__ unsigned cvtpk(float lo, float hi) { return pg8::cvt_pk_bf16(lo, hi); }

enum { MAP_NAT = 0, MAP_IN = 1, MAP_UG = 2 };
__device__ __forceinline__ void p0_item(const float* __restrict__ W, int N, int K, bf16* __restrict__ WT, int kb, int nb, int mapmode, LAS unsigned char* scr, int lane) {
    const int np = 64 * nb + 4 * (lane & 15);
    int src = np;
    if (mapmode == MAP_IN) { const int pn = np >> 8, L = np & 255, bj = L >> 7, wc = (L >> 5) & 3, e = L & 31; src = 256 * pn + 64 * wc + 32 * bj + e; }
    else if (mapmode == MAP_UG) { const int pn = np >> 8, L = np & 255, bj = L >> 7, i = L & 127; src = 1024 * bj + 128 * pn + i; }
    const float* gp = W + (size_t)(64 * kb + (lane >> 4)) * N + src;
    f32x4 v[16];
#pragma unroll
    for (int i = 0; i < 16; ++i) v[i] = *(const f32x4*)(gp + (size_t)(4 * i) * N);
#pragma unroll
    for (int i = 0; i < 16; ++i) {
        LAS unsigned* d = (LAS unsigned*)(scr + (4 * i + (lane >> 4)) * 132 + 8 * (lane & 15));
        d[0] = cvtpk(v[i][0], v[i][1]); d[1] = cvtpk(v[i][2], v[i][3]);
    }
    LDS_WAIT(); asm volatile("" ::: "memory");
    const int c = lane & 7;
#pragma unroll
    for (int it = 0; it < 4; ++it) {
        const int nl = 16 * it + 2 * (lane >> 3);
        unsigned d[8];
#pragma unroll
        for (int j = 0; j < 8; ++j) d[j] = *(const LAS unsigned*)(scr + (8 * c + j) * 132 + 2 * nl);
        v4u o0, o1;
        o0.x = (d[0] & 0xffffu) | (d[1] << 16); o0.y = (d[2] & 0xffffu) | (d[3] << 16); o0.z = (d[4] & 0xffffu) | (d[5] << 16); o0.w = (d[6] & 0xffffu) | (d[7] << 16);
        o1.x = (d[0] >> 16) | (d[1] & 0xffff0000u); o1.y = (d[2] >> 16) | (d[3] & 0xffff0000u); o1.z = (d[4] >> 16) | (d[5] & 0xffff0000u); o1.w = (d[6] >> 16) | (d[7] & 0xffff0000u);
        bf16* dst = WT + (size_t)(64 * nb + nl) * K + 64 * kb + 8 * c;
        *(v4u*)dst = o0; *(v4u*)(dst + K) = o1;
    }
    LDS_WAIT(); asm volatile("" ::: "memory");
}
__device__ __forceinline__ unsigned pk4_fp8(float a, float b, float c, float d) { int r = __builtin_amdgcn_cvt_pk_fp8_f32(a, b, 0, false); r = __builtin_amdgcn_cvt_pk_fp8_f32(c, d, r, true); return (unsigned)r; }
__device__ __forceinline__ void p0_item_f8(const float* __restrict__ W, int N, int K, unsigned char* __restrict__ WT, int kb, int nb, int mapmode, LAS unsigned char* scr, int lane) {
    const int np = 64 * nb + 4 * (lane & 15);
    int src = np;
    if (mapmode == MAP_UG) { const int pn = np >> 8, L = np & 255, bj = L >> 7, i = L & 127; src = 1024 * bj + 128 * pn + i; }
    const float* gp = W + (size_t)(64 * kb + (lane >> 4)) * N + src;
    f32x4 v[16];
#pragma unroll
    for (int i = 0; i < 16; ++i) v[i] = *(const f32x4*)(gp + (size_t)(4 * i) * N);
#pragma unroll
    for (int i = 0; i < 16; ++i) *(LAS unsigned*)(scr + (4 * i + (lane >> 4)) * 68 + 4 * (lane & 15)) = pk4_fp8(v[i][0] * 64.0f, v[i][1] * 64.0f, v[i][2] * 64.0f, v[i][3] * 64.0f);
    LDS_WAIT(); asm volatile("" ::: "memory");
    const int nq = lane & 15, kg = lane >> 4;
    unsigned d[16];
#pragma unroll
    for (int j = 0; j < 16; ++j) d[j] = *(const LAS unsigned*)(scr + (16 * kg + j) * 68 + 4 * nq);
#pragma unroll
    for (int t = 0; t < 4; ++t) {
        v4u o;
#pragma unroll
        for (int q = 0; q < 4; ++q) o[q] = ((d[4 * q] >> (8 * t)) & 0xffu) | (((d[4 * q + 1] >> (8 * t)) & 0xffu) << 8) | (((d[4 * q + 2] >> (8 * t)) & 0xffu) << 16) | (((d[4 * q + 3] >> (8 * t)) & 0xffu) << 24);
        *(v4u*)(WT + (size_t)(64 * nb + 4 * nq + t) * K + 64 * kb + 16 * kg) = o;
    }
    LDS_WAIT(); asm volatile("" ::: "memory");
}
struct P0D { const float* gp; int N, K, kb, nb; bf16* W16; unsigned char* W8; const float* rsc; };
__device__ __forceinline__ int p0_src_col(int np, int mapmode) {
    int src = np;
    if (mapmode == MAP_IN) { const int pn = np >> 8, L = np & 255, bj = L >> 7, wc = (L >> 5) & 3, e = L & 31; src = 256 * pn + 64 * wc + 32 * bj + e; }
    else if (mapmode == MAP_UG) { const int pn = np >> 8, L = np & 255, bj = L >> 7, i = L & 127; src = 1024 * bj + 128 * pn + i; }
    return src;
}
__device__ __forceinline__ P0D p0_mk(const float* W, int N, int K, bf16* W16, unsigned char* W8, int kb, int nb, int mapmode, int lane, const float* rsc = nullptr) {
    P0D d; d.N = N; d.K = K; d.kb = kb; d.nb = nb; d.W16 = W16; d.W8 = W8;
    if (W8) {
        d.rsc = rsc ? rsc + 128 * kb + (lane >> 3) : nullptr;
        d.gp = W + (size_t)(128 * kb + (lane >> 3)) * N + p0_src_col(32 * nb + 4 * (lane & 7), mapmode);
    } else {
        d.rsc = nullptr;
        d.gp = W + (size_t)(64 * kb + (lane >> 4)) * N + p0_src_col(64 * nb + 4 * (lane & 15), mapmode);
    }
    return d;
}
__device__ __forceinline__ void p0_load(const P0D& d, f32x4 (&v)[16]) {
#pragma unroll
    for (int i = 0; i < 16; ++i) v[i] = __builtin_nontemporal_load((const f32x4*)(d.gp + (size_t)((d.W8 ? 8 : 4) * i) * d.N));
}
__device__ __forceinline__ void p0_finish(const P0D& d, const f32x4 (&v)[16], LAS unsigned char* scr, int lane, const int pm = 0) {
    if (pm == 1) { _Pragma("unroll") for (int i = 0; i < 16; ++i) asm volatile("" :: "v"(v[i])); return; }
    if (d.W16) {
#pragma unroll
        for (int i = 0; i < 16; ++i) { LAS unsigned* q = (LAS unsigned*)(scr + (4 * i + (lane >> 4)) * 132 + 8 * (lane & 15)); q[0] = cvtpk(v[i][0], v[i][1]); q[1] = cvtpk(v[i][2], v[i][3]); }
        LDS_WAIT(); asm volatile("" ::: "memory");
        const int c = lane & 7;
#pragma unroll
        for (int it = 0; it < 4; ++it) {
            const int nl = 16 * it + 2 * (lane >> 3);
            unsigned x[8];
#pragma unroll
            for (int j = 0; j < 8; ++j) x[j] = *(const LAS unsigned*)(scr + (8 * c + j) * 132 + 2 * nl);
            v4u o0, o1;
            o0.x = (x[0] & 0xffffu) | (x[1] << 16); o0.y = (x[2] & 0xffffu) | (x[3] << 16); o0.z = (x[4] & 0xffffu) | (x[5] << 16); o0.w = (x[6] & 0xffffu) | (x[7] << 16);
            o1.x = (x[0] >> 16) | (x[1] & 0xffff0000u); o1.y = (x[2] >> 16) | (x[3] & 0xffff0000u); o1.z = (x[4] >> 16) | (x[5] & 0xffff0000u); o1.w = (x[6] >> 16) | (x[7] & 0xffff0000u);
            bf16* dst = d.W16 + (size_t)(64 * d.nb + nl) * d.K + 64 * d.kb + 8 * c;
            if (pm == 0 || pm == 3) { *(v4u*)dst = o0; *(v4u*)(dst + d.K) = o1; } else asm volatile("" :: "v"(o0), "v"(o1));
        }
    } else {
#pragma unroll
        for (int i = 0; i < 16; ++i) { const float sc = d.rsc ? d.rsc[8 * i] * 64.0f : 64.0f; *(LAS unsigned*)(scr + (8 * i + (lane >> 3)) * 36 + 4 * (lane & 7)) = pk4_fp8(v[i][0] * sc, v[i][1] * sc, v[i][2] * sc, v[i][3] * sc); }
        LDS_WAIT(); asm volatile("" ::: "memory");
        const int nq = lane & 7, kg = lane >> 3;
        unsigned x[16];
#pragma unroll
        for (int j = 0; j < 16; ++j) x[j] = *(const LAS unsigned*)(scr + (16 * kg + j) * 36 + 4 * nq);
#pragma unroll
        for (int t = 0; t < 4; ++t) {
            v4u o;
#pragma unroll
            for (int q = 0; q < 4; ++q) o[q] = ((x[4 * q] >> (8 * t)) & 0xffu) | (((x[4 * q + 1] >> (8 * t)) & 0xffu) << 8) | (((x[4 * q + 2] >> (8 * t)) & 0xffu) << 16) | (((x[4 * q + 3] >> (8 * t)) & 0xffu) << 24);
            if (pm == 0 || pm == 3) __builtin_nontemporal_store(o, (v4u*)(d.W8 + (size_t)(32 * d.nb + 4 * nq + t) * d.K + 128 * d.kb + 16 * kg)); else asm volatile("" :: "v"(o));
        }
    }
    LDS_WAIT(); asm volatile("" ::: "memory");
}
__device__ __forceinline__ P0D p0_decode(const Args& a, unsigned char* ws, int it, int lane) {
    constexpr int I_IN = 16 * 56, I_OUT = 256, I_PG = 256, I_PP = 4 * 16, I_UG = 16 * 32, I_DN = 256;
    int r = it;
    if (r < I_IN) return p0_mk(a.w_in, DIN, DM, (bf16*)(ws + WS_WT_IN), nullptr, r / 56, r % 56, MAP_IN, lane); r -= I_IN;
    if (r < I_OUT) return p0_mk(a.w_out, DM, DM, (bf16*)(ws + WS_WT_OUT), nullptr, r / 16, r % 16, MAP_NAT, lane); r -= I_OUT;
    if (r < I_PG) return p0_mk(a.w_pg, DM, DM, nullptr, (unsigned char*)(ws + WS_WT_PG), r / 32, r % 32, MAP_NAT, lane); r -= I_PG;
    if (r < I_PP) return p0_mk(a.w_pp, DM, PLE, (bf16*)(ws + WS_WT_PP), nullptr, r / 16, r % 16, MAP_NAT, lane); r -= I_PP;
    if (r < NE * I_UG) { const int e = r / I_UG, q = r % I_UG; return p0_mk(a.w_ug + (size_t)e * DM * 2048, 2048, DM, nullptr, (unsigned char*)(ws + WS_WT_UG) + (size_t)e * 2048 * DM, q / 64, q % 64, MAP_UG, lane, a.g_ffn); } r -= NE * I_UG;
    { const int e = r / I_DN, q = r % I_DN; return p0_mk(a.w_dn + (size_t)e * DM * DM, DM, DM, nullptr, (unsigned char*)(ws + WS_WT_DN) + (size_t)e * DM * DM, q / 32, q % 32, MAP_NAT, lane); }
}
__device__ __forceinline__ void rms_row_to_bf16(const float* xrow, const float* g, bf16* orow, int lane) {
    const f32x4* xr = (const f32x4*)xrow + lane;
    f32x4 v[4]; float s = 0.f;
#pragma unroll
    for (int j = 0; j < 4; ++j) { v[j] = xr[64 * j]; s += (v[j][0] * v[j][0] + v[j][1] * v[j][1]) + (v[j][2] * v[j][2] + v[j][3] * v[j][3]); }
    const float rstd = rsqrtf(wave_sum(s) * (1.f / DM) + EPS);
    unsigned long long* o8 = (unsigned long long*)orow + lane;
#pragma unroll
    for (int j = 0; j < 4; ++j) { const f32x4 gg = ((const f32x4*)g)[lane + 64 * j];
        o8[64 * j] = (unsigned long long)cvtpk(v[j][0] * rstd * gg[0], v[j][1] * rstd * gg[1]) | ((unsigned long long)cvtpk(v[j][2] * rstd * gg[2], v[j][3] * rstd * gg[3]) << 32); }
}
__device__ __forceinline__ void p0_prologue(Frame& F, const Args& a, const int pm = 0) {
    unsigned char* ws = a.ws; const int tid = tid_now(F.wave), lane = tid & 63;
    LAS unsigned char* scr = F.lds + RING_OFF + F.wave * 8448;
    const int gw = F.vcu * NWAVES + F.wave, NGW = F.G * NWAVES;
    constexpr int I_IN = 16 * 56, I_OUT = 256, I_PG = 256, I_PP = 4 * 16, I_UG = 16 * 32, I_DN = 256;
    constexpr int NITEMS = I_IN + I_OUT + I_PG + I_PP + NE * I_UG + NE * I_DN;
    if (gw < NITEMS) {
        int it = gw; P0D d0 = p0_decode(a, ws, it, lane), d1 = d0; f32x4 va[16], vb[16]; p0_load(d0, va);
        for (;;) {
            const int it1 = it + NGW; const bool h1 = it1 < NITEMS;
            if (h1) { d1 = p0_decode(a, ws, it1, lane); p0_load(d1, vb); }
            p0_finish(d0, va, scr, lane, pm);
            if (!h1) break;
            const int it2 = it1 + NGW; const bool h2 = it2 < NITEMS;
            if (h2) { d0 = p0_decode(a, ws, it2, lane); p0_load(d0, va); }
            p0_finish(d1, vb, scr, lane, pm);
            if (!h2) break;
            it = it2;
        }
    }
    if (pm != 0) return;
    if (blockIdx.x == 0 && tid < 256) { const int t = tid; const float* srcs = (t < 64) ? a.sbq : (t < 128) ? a.sbk : (t < 192) ? a.rq : a.rk; ((float*)(ws + WS_GAINS))[t] = srcs[t & 63]; }
    {
        f32x4 gg[4];
#pragma unroll
        for (int j = 0; j < 4; ++j) gg[j] = ((const f32x4*)a.g_mix)[lane + 64 * j];
        for (int m0 = 4 * gw; m0 < T; m0 += 4 * NGW) {
            f32x4 v[4][4];
#pragma unroll
            for (int r = 0; r < 4; ++r)
#pragma unroll
                for (int j = 0; j < 4; ++j) v[r][j] = __builtin_nontemporal_load((const f32x4*)(a.x + (size_t)(m0 + r) * DM) + lane + 64 * j);
#pragma unroll
            for (int r = 0; r < 4; ++r) {
                float ss = 0.f;
#pragma unroll
                for (int j = 0; j < 4; ++j) ss += (v[r][j][0] * v[r][j][0] + v[r][j][1] * v[r][j][1]) + (v[r][j][2] * v[r][j][2] + v[r][j][3] * v[r][j][3]);
                const float rstd = rsqrtf(wave_sum(ss) * (1.f / DM) + EPS);
                unsigned long long* o8 = (unsigned long long*)((bf16*)(ws + WS_XN) + (size_t)(m0 + r) * DM) + lane;
#pragma unroll
                for (int j = 0; j < 4; ++j) o8[64 * j] = (unsigned long long)cvtpk(v[r][j][0] * rstd * gg[j][0], v[r][j][1] * rstd * gg[j][1]) | ((unsigned long long)cvtpk(v[r][j][2] * rstd * gg[j][2], v[r][j][3] * rstd * gg[j][3]) << 32);
            }
        }
    }
    { const int gt = gw * 64 + lane, NGT = NGW * 64;
      for (int i0 = gt; i0 < T * PLE / 8; i0 += 4 * NGT) {
          f32x4 a0[4], a1[4];
#pragma unroll
          for (int q = 0; q < 4; ++q) { const int i = i0 + q * NGT; if (i < T * PLE / 8) { a0[q] = __builtin_nontemporal_load((const f32x4*)a.p + 2 * i); a1[q] = __builtin_nontemporal_load((const f32x4*)a.p + 2 * i + 1); } }
#pragma unroll
          for (int q = 0; q < 4; ++q) { const int i = i0 + q * NGT; if (i < T * PLE / 8) { v4u o; o.x = cvtpk(a0[q][0], a0[q][1]); o.y = cvtpk(a0[q][2], a0[q][3]); o.z = cvtpk(a1[q][0], a1[q][1]); o.w = cvtpk(a1[q][2], a1[q][3]); ((v4u*)(ws + WS_PB))[i] = o; } }
      }
      for (int i = gt; i < NE * DM; i += NGT) { const int e = i >> 10, k = i & (DM - 1); const float wv = a.w_r[(size_t)k * NE + e] * a.g_ffn[k];
          const unsigned hi = cvtpk(wv, 0.f) & 0xffffu; const unsigned lo = cvtpk(wv - __uint_as_float(hi << 16), 0.f) & 0xffffu;
          ((bf16*)(ws + WS_WRT))[i] = (bf16)hi; ((bf16*)(ws + WS_WRT))[NE * DM + i] = (bf16)lo; }
      float* rc = (float*)(ws + WS_ROPEC); float* rs = (float*)(ws + WS_ROPES);
      for (int i = gt; i < T * 32; i += NGT) { const int row = i >> 5, f = i & 31;
          const float inv_freq = exp2f(-(float)f * (13.287712379549449f / 32.0f));   const float ang = (float)a.positions[row] * inv_freq;
          float sn, cs; sincosf(ang, &sn, &cs); rc[i] = cs; rs[i] = sn; } }
}

namespace att {
typedef short bf16x8 __attribute__((ext_vector_type(8)));
typedef short s16x4 __attribute__((ext_vector_type(4)));
typedef float f32x16 __attribute__((ext_vector_type(16)));
typedef short v4i16_t __attribute__((ext_vector_type(4)));
constexpr int LK = 0, LV = 24576, LFLAG = 49152;
__device__ __forceinline__ s16x4 vtr(LAS const unsigned char* p) { return __builtin_bit_cast(s16x4, __builtin_amdgcn_ds_read_tr16_b64_v4i16((LAS v4i16_t*)p)); }
__device__ __forceinline__ int crow(int r, int hi) { return (r & 3) + 8 * (r >> 2) + 4 * hi; }
struct AttnArgs { const bf16* hm; const bf16* rg; bf16* Y; const float* gn_g; const float* gn_b; };

template <int MODE, int ABL = 0> __device__ __forceinline__ void attn_unit(LAS unsigned char* lds, const AttnArgs& A, int b, int h, int qb, const int wave_id) {
    int tid_ = wave_id * 64 + lane_id_hw(); asm volatile("" : "+v"(tid_));
    const int tid = tid_, lane = tid & 63, r32 = lane & 31, hh = lane >> 5;
    const int w = __builtin_amdgcn_readfirstlane(tid >> 6);
    const int q0 = qb * 256, qw = q0 + 32 * w;
    const size_t TS = (size_t)T * 512;
    const size_t hoff = (size_t)(b * 8 + h) * SEQ * 64;
    const bf16* Qp = A.hm + (MODE == 0 ? 0 : 3) * TS + hoff;
    const bf16* Kp = A.hm + (MODE == 0 ? 1 : 4) * TS + hoff;
    const bf16* Vp = A.hm + (MODE == 0 ? 2 : 5) * TS + hoff;
    bf16x8 qf[4];
#pragma unroll
    for (int ds = 0; ds < 4; ++ds) qf[ds] = *(const bf16x8*)(Qp + (size_t)(qw + r32) * 64 + 16 * ds + 8 * hh);
    f32x16 o[2];
#pragma unroll
    for (int r = 0; r < 16; ++r) { o[0][r] = 0.f; o[1][r] = 0.f; }
    float carry = 1.0f;
    const int jmax = (q0 + 255) >> 6, jd = (qw + 31) >> 6;
    const float lg2g = __log2f(1.0f - __builtin_amdgcn_exp2f(-5.0f - (float)h));
    const int krow = 8 * w + (lane >> 3);
    const bf16* Kt = Kp + (size_t)krow * 64 + (((lane & 7) ^ ((krow >> 1) & 7)) << 3); const bf16* Vt = Vp + (size_t)w * 512 + lane * 8;
    volatile LAS unsigned* flags = (volatile LAS unsigned*)(lds + LFLAG);
#define ATT_DMA(t, so) do { __builtin_amdgcn_global_load_lds((const unsigned*)(Kt + (size_t)(t) * 4096), (LAS unsigned*)(lds + LK + (so) + w * 1024), 16, 0, 0); \
                            __builtin_amdgcn_global_load_lds((const unsigned*)(Vt + (size_t)(t) * 4096), (LAS unsigned*)(lds + LV + (so) + w * 1024), 16, 0, 0); } while (0)
    ATT_DMA(jmax, 0);
    if (jmax >= 1) { ATT_DMA(jmax - 1, 8192); asm volatile("s_waitcnt vmcnt(2)\n\ts_barrier" ::: "memory"); }
    else asm volatile("s_waitcnt vmcnt(0)\n\ts_barrier" ::: "memory");
    bool finished = false;
    int so_cur = 0, so_new = 16384;
    for (int j = jmax; j >= 0; --j) {
        const int cur = j & 1;
        if (j >= 2 && ABL != 4) ATT_DMA(j - 2, so_new);
        if (j <= jd && !finished && ABL == 0) {
            LAS const unsigned char* Kb = lds + LK + so_cur;
            LAS const unsigned char* Vb = lds + LV + so_cur;
            f32x16 p[2];
#pragma unroll
            for (int r = 0; r < 16; ++r) { p[0][r] = 0.f; p[1][r] = 0.f; }
            bf16x8 kf[4][2];
            const int ksw = (r32 >> 1) & 7;
#pragma unroll
            for (int ds = 0; ds < 4; ++ds) { kf[ds][0] = *(LAS const bf16x8*)(Kb + r32 * 128 + (((2 * ds + hh) ^ ksw) << 4)); kf[ds][1] = *(LAS const bf16x8*)(Kb + 4096 + r32 * 128 + (((2 * ds + hh) ^ ksw) << 4)); }
#pragma unroll
            for (int ds = 0; ds < 4; ++ds) {
                p[0] = __builtin_amdgcn_mfma_f32_32x32x16_bf16(kf[ds][0], qf[ds], p[0], 0, 0, 0);
                p[1] = __builtin_amdgcn_mfma_f32_32x32x16_bf16(kf[ds][1], qf[ds], p[1], 0, 0, 0);
            }
            const bool diag = (j == jd);
            const int qg = qw + r32, kv0 = 64 * j + 4 * hh;
            if (MODE == 0) {
                float om[2][16];
#pragma unroll
                for (int hf = 0; hf < 2; ++hf)
#pragma unroll
                    for (int r = 0; r < 16; ++r) {
                        const float Z = p[hf][r];
                        const float a = __builtin_amdgcn_exp2f(-__builtin_fabsf(Z));
                        const float rc = __builtin_amdgcn_rcpf(1.0f + a), ar = a * rc;
                        const bool pos = Z >= 0.f;
                        p[hf][r] = pos ? rc : ar;
                        om[hf][r] = pos ? ar : rc;
                    }
                if (diag) {
#pragma unroll
                    for (int hf = 0; hf < 2; ++hf)
#pragma unroll
                        for (int r = 0; r < 16; ++r) { const bool valid = kv0 + 32 * hf + (r & 3) + 8 * (r >> 2) < qg; p[hf][r] = valid ? p[hf][r] : 0.f; om[hf][r] = valid ? om[hf][r] : 1.0f; }
                }
                float gs[8], ot[8];
#pragma unroll
                for (int m = 0; m < 8; ++m) { const int hf = m >> 2, g = m & 3; gs[m] = (om[hf][4 * g] * om[hf][4 * g + 1]) * (om[hf][4 * g + 2] * om[hf][4 * g + 3]); ot[m] = __shfl_xor(gs[m], 32); }
                float ps[8];
                ps[7] = 1.0f;
#pragma unroll
                for (int m = 6; m >= 0; --m) ps[m] = ps[m + 1] * (gs[m + 1] * ot[m + 1]);
                const float total = ps[0] * (gs[0] * ot[0]);
#pragma unroll
                for (int m = 0; m < 8; ++m) {
                    const int hf = m >> 2, g = m & 3;
                    float tail = carry * (hh ? ps[m] : ps[m] * ot[m]);
#pragma unroll
                    for (int i = 3; i >= 0; --i) { const int r = 4 * g + i; const float o1 = om[hf][r]; p[hf][r] *= tail; tail *= o1; }
                }
                carry *= total;
                finished = __all(carry < 1.0e-37f);
            } else {
                const float ct = __builtin_amdgcn_exp2f(lg2g * (float)(qw - 64 * j));
#pragma unroll
                for (int hf = 0; hf < 2; ++hf)
#pragma unroll
                    for (int r = 0; r < 16; ++r) p[hf][r] *= ct;
                if (diag) {
#pragma unroll
                    for (int hf = 0; hf < 2; ++hf)
#pragma unroll
                        for (int r = 0; r < 16; ++r) { const bool valid = kv0 + 32 * hf + (r & 3) + 8 * (r >> 2) <= qg; p[hf][r] = valid ? p[hf][r] : 0.f; }
                }
            }
            {
                const unsigned vbase = (unsigned)(uintptr_t)(Vb + (4 * hh + ((lane & 15) >> 2)) * 128 + (16 * ((lane >> 4) & 1) + 4 * (lane & 3)) * 2);
                s16x4 vl[2][2][2], vh[2][2][2];
#pragma unroll
                for (int hf = 0; hf < 2; ++hf)
#pragma unroll
                    for (int s = 0; s < 2; ++s)
#pragma unroll
                        for (int d0 = 0; d0 < 2; ++d0) {
                            asm volatile("ds_read_b64_tr_b16 %0, %1 offset:%c2" : "=&v"(vl[hf][s][d0]) : "v"(vbase), "i"(hf * 4096 + s * 2048 + d0 * 64) : "memory");
                            asm volatile("ds_read_b64_tr_b16 %0, %1 offset:%c2" : "=&v"(vh[hf][s][d0]) : "v"(vbase), "i"(hf * 4096 + s * 2048 + d0 * 64 + 1024) : "memory");
                        }
                bf16x8 wfr[2][2];
#pragma unroll
                for (int hf = 0; hf < 2; ++hf)
#pragma unroll
                    for (int s = 0; s < 2; ++s) {
                        u32x4_t wq;
                        wq.x = pg8::cvt_pk_bf16(p[hf][8 * s + 0], p[hf][8 * s + 1]); wq.y = pg8::cvt_pk_bf16(p[hf][8 * s + 2], p[hf][8 * s + 3]);
                        wq.z = pg8::cvt_pk_bf16(p[hf][8 * s + 4], p[hf][8 * s + 5]); wq.w = pg8::cvt_pk_bf16(p[hf][8 * s + 6], p[hf][8 * s + 7]);
                        wfr[hf][s] = __builtin_bit_cast(bf16x8, wq);
                    }
                asm volatile("s_waitcnt lgkmcnt(0)" ::: "memory"); __builtin_amdgcn_sched_barrier(0);
#pragma unroll
                for (int hf = 0; hf < 2; ++hf)
#pragma unroll
                    for (int s = 0; s < 2; ++s)
#pragma unroll
                        for (int d0 = 0; d0 < 2; ++d0) {
                            const s16x4 lo = vl[hf][s][d0], hi = vh[hf][s][d0];
                            const bf16x8 vf = (bf16x8){lo[0], lo[1], lo[2], lo[3], hi[0], hi[1], hi[2], hi[3]};
                            o[d0] = __builtin_amdgcn_mfma_f32_32x32x16_bf16(vf, wfr[hf][s], o[d0], 0, 0, 0);
                        }
            }
        }
        if (MODE == 0) { if (lane == 0) flags[cur * 8 + w] = finished ? 1u : 0u; }
        if (j >= 2) asm volatile("s_waitcnt vmcnt(2) lgkmcnt(0)\n\ts_barrier" ::: "memory"); else asm volatile("s_waitcnt vmcnt(0) lgkmcnt(0)\n\ts_barrier" ::: "memory");
        so_cur = (so_cur == 16384) ? 0 : so_cur + 8192; so_new = (so_new == 16384) ? 0 : so_new + 8192;
        if (MODE == 0) {
            unsigned all = 1u;
#pragma unroll
            for (int i = 0; i < 8; ++i) all &= flags[cur * 8 + i];
            if (all) break;
        }
    }
    asm volatile("s_waitcnt vmcnt(0)\n\ts_barrier" ::: "memory");
#undef ATT_DMA
    const int row = b * SEQ + qw + r32;
    if (MODE == 0) {
        bf16* yp = A.Y + (size_t)row * DM + h * 64 + 4 * hh;
#pragma unroll
        for (int d0 = 0; d0 < 2; ++d0)
#pragma unroll
            for (int g = 0; g < 4; ++g) { u32x2_t v; v.x = pg8::cvt_pk_bf16(o[d0][4 * g], o[d0][4 * g + 1]); v.y = pg8::cvt_pk_bf16(o[d0][4 * g + 2], o[d0][4 * g + 3]); *(u32x2_t*)(yp + 32 * d0 + 8 * g) = v; }
    } else {
        float s1 = 0.f;
#pragma unroll
        for (int r = 0; r < 16; ++r) s1 += o[0][r] + o[1][r];
        s1 += __shfl_xor(s1, 32);
        const float mu = s1 * (1.0f / 64.0f);
        float s2 = 0.f;
#pragma unroll
        for (int r = 0; r < 16; ++r) { const float a0 = o[0][r] - mu, a1 = o[1][r] - mu; s2 += a0 * a0 + a1 * a1; }
        s2 += __shfl_xor(s2, 32);
        const float rstd = rsqrtf(s2 * (1.0f / 64.0f) + EPS);
        bf16* yp = A.Y + (size_t)row * DM + 512 + h * 64 + 4 * hh;
        const bf16* gp = A.rg + (size_t)row * 512 + h * 64 + 4 * hh;
        const float* gg = A.gn_g + h * 64 + 4 * hh; const float* gb = A.gn_b + h * 64 + 4 * hh;
#pragma unroll
        for (int d0 = 0; d0 < 2; ++d0)
#pragma unroll
            for (int g = 0; g < 4; ++g) {
                const f32x4 gn = *(const f32x4*)(gg + 32 * d0 + 8 * g), bs = *(const f32x4*)(gb + 32 * d0 + 8 * g);
                const u32x2_t gr = *(const u32x2_t*)(gp + 32 * d0 + 8 * g);
                float gate[4] = {__uint_as_float(gr.x << 16), __uint_as_float(gr.x & 0xffff0000u), __uint_as_float(gr.y << 16), __uint_as_float(gr.y & 0xffff0000u)};
                float ov[4];
#pragma unroll
                for (int i = 0; i < 4; ++i) { const float yn = (o[d0][4 * g + i] - mu) * rstd * gn[i] + bs[i]; const float sg = gate[i] / (1.0f + __expf(-gate[i])); ov[i] = yn * sg; }
                u32x2_t v; v.x = pg8::cvt_pk_bf16(ov[0], ov[1]); v.y = pg8::cvt_pk_bf16(ov[2], ov[3]); *(u32x2_t*)(yp + 32 * d0 + 8 * g) = v;
            }
    }
}
__device__ __forceinline__ void attn_phase(LAS unsigned char* lds, const AttnArgs& A, int vcu, int dup, bf16* dummyY, const int wave_id) {
    const int g = vcu >> 5, local = vcu & 31;
    if (dup == 24 || dup == 25) { AttnArgs A2 = A; A2.Y = dummyY;
#pragma unroll 1
        for (int u = 0; u < 2; ++u) { const int bh = 8 * g + 4 * (u & 1) + (local >> 3), qb = (u & 1) ? 7 - (local & 7) : (local & 7); if (dup == 24) attn_unit<1, 3>(lds, A2, bh >> 3, bh & 7, qb, wave_id); else attn_unit<1, 4>(lds, A2, bh >> 3, bh & 7, qb, wave_id); } }
#pragma unroll 1
    for (int u = 0; u < ((dup == 20) ? 4 : 2); ++u) { const int bh = 8 * g + 4 * (u & 1) + (local >> 3), qb = (u & 1) ? 7 - (local & 7) : (local & 7); attn_unit<1>(lds, A, bh >> 3, bh & 7, qb, wave_id); }
#pragma unroll 1
    for (int u = 0; u < ((dup == 21) ? 4 : 2); ++u) { const int bh = 8 * g + 4 * (u & 1) + (local >> 3), qb = (u & 1) ? 7 - (local & 7) : (local & 7); attn_unit<0>(lds, A, bh >> 3, bh & 7, qb, wave_id); }
}
}

constexpr int CW_GCNT = 32768;
constexpr int LR_LCNT = LDSCTL_OFF + 1024, LR_GBASE = LDSCTL_OFF + 1152;
constexpr int LT_POFF = LDSCTL_OFF + 2048, LT_NT = LDSCTL_OFF + 2176, LT_TILE_E = LDSCTL_OFF + 2304, LT_FIRST = LDSCTL_OFF + 3712;
struct RouteBufs { int* tok_e; int* tok_slot; float* tok_gate; float* rstd; int* toklist; };
__device__ __forceinline__ RouteBufs route_bufs(unsigned char* ws) { RouteBufs r; r.tok_e = (int*)(ws + WS_ROUTE); r.tok_slot = r.tok_e + T * 4; r.tok_gate = (float*)(r.tok_slot + T * 4); r.rstd = (float*)(ws + WS_ROUTE + 1 * MiB); r.toklist = (int*)(ws + WS_TOKLIST); return r; }
typedef float f32x2v __attribute__((ext_vector_type(2)));
__device__ __forceinline__ unsigned opq_mask(bool c) { unsigned m = c ? 0xffffffffu : 0u; asm volatile("" : "+v"(m)); return m; }
__device__ __forceinline__ float blendf(unsigned m, float a, float b) { return __uint_as_float((__float_as_uint(a) & m) | (__float_as_uint(b) & ~m)); }
__device__ __forceinline__ int blendi(unsigned m, int a, int b) { return (int)(((unsigned)a & m) | ((unsigned)b & ~m)); }

#define SW2(c, a, b) { const float ta_ = (c) ? (b) : (a), tb_ = (c) ? (a) : (b); a = ta_; b = tb_; }
#define SW2I(c, a, b) { const int ta_ = (c) ? (b) : (a), tb_ = (c) ? (a) : (b); a = ta_; b = tb_; }
#define TOP4_INSERT(x, e) { const float x_ = (x); const int e_ = (e); const bool c3_ = (x_ > v3) || (x_ == v3 && e_ < i3); v3 = c3_ ? x_ : v3; i3 = c3_ ? e_ : i3; \
    const bool c2_ = (v3 > v2) || (v3 == v2 && i3 < i2); SW2(c2_, v2, v3) SW2I(c2_, i2, i3) const bool c1_ = (v2 > v1) || (v2 == v1 && i2 < i1); SW2(c1_, v1, v2) SW2I(c1_, i1, i2) \
    const bool c0_ = (v1 > v0) || (v1 == v0 && i1 < i0); SW2(c0_, v0, v1) SW2I(c0_, i0, i1) }
__device__ __forceinline__ void router_phase(Frame& F, const Args& a, const bool dry = false) {
    unsigned char* ws = a.ws; const int tid = tid_now(F.wave);
    LAS unsigned char* lds = F.lds;
    const int lane = tid & 63, r32 = lane & 31, hh = lane >> 5, w = F.wave, rg = w >> 2, kq = w & 3;
    volatile LAS unsigned* lcnt = (volatile LAS unsigned*)(lds + LR_LCNT);
    volatile LAS unsigned* gbase = (volatile LAS unsigned*)(lds + LR_GBASE);
    if (tid < 32) lcnt[tid] = 0u;
    const RouteBufs R = route_bufs(ws);
    const int row = F.vcu * 64 + 32 * rg + r32;
    const bf16* xr = (const bf16*)(ws + WS_X1) + (size_t)row * DM + 256 * kq + 8 * hh;
    const bf16* wt = (const bf16*)(ws + WS_WRT) + (size_t)r32 * DM + 256 * kq + 8 * hh;
    unsigned char* hp = (unsigned char*)(ws + (dry ? WS_H : WS_XN)) + (size_t)row * DM + 256 * kq + 8 * hh;
    att::f32x16 D;
#pragma unroll
    for (int r = 0; r < 16; ++r) D[r] = 0.f;
    float ss = 0.f;
#pragma unroll 8
    for (int ks = 0; ks < 16; ++ks) {
        const u32x4_t xh = *(const u32x4_t*)(xr + 16 * ks);
        const f32x4 v0 = (f32x4){__uint_as_float(xh.x << 16), __uint_as_float(xh.x & 0xffff0000u), __uint_as_float(xh.y << 16), __uint_as_float(xh.y & 0xffff0000u)};
        const f32x4 v1 = (f32x4){__uint_as_float(xh.z << 16), __uint_as_float(xh.z & 0xffff0000u), __uint_as_float(xh.w << 16), __uint_as_float(xh.w & 0xffff0000u)};
        ss += ((v0[0] * v0[0] + v0[1] * v0[1]) + (v0[2] * v0[2] + v0[3] * v0[3])) + ((v1[0] * v1[0] + v1[1] * v1[1]) + (v1[2] * v1[2] + v1[3] * v1[3]));
        u32x2_t h8; h8.x = pk4_fp8(v0[0], v0[1], v0[2], v0[3]); h8.y = pk4_fp8(v1[0], v1[1], v1[2], v1[3]); *(u32x2_t*)(hp + 16 * ks) = h8;
        const att::bf16x8 whi = *(const att::bf16x8*)(wt + 16 * ks), wlo = *(const att::bf16x8*)(wt + 32 * DM + 16 * ks);
        const att::bf16x8 bxh = __builtin_bit_cast(att::bf16x8, xh);
        D = __builtin_amdgcn_mfma_f32_32x32x16_bf16(whi, bxh, D, 0, 0, 0);
        D = __builtin_amdgcn_mfma_f32_32x32x16_bf16(wlo, bxh, D, 0, 0, 0);
    }
    { LAS f32x4* dp = (LAS f32x4*)(lds + (w * 64 + lane) * 64);
#pragma unroll
      for (int q = 0; q < 4; ++q) dp[q] = (f32x4){D[4 * q], D[4 * q + 1], D[4 * q + 2], D[4 * q + 3]};
      *(LAS float*)(lds + 32768 + (w * 64 + lane) * 4) = ss; }
    __syncthreads();
    int my_e0 = 0, my_e1 = 0, rk0 = 0, rk1 = 0; float my_g0 = 0.f, my_g1 = 0.f;
    if (kq == 0) {
#pragma unroll
        for (int o = 1; o < 4; ++o) { LAS const f32x4* dp = (LAS const f32x4*)(lds + ((w + o) * 64 + lane) * 64);
#pragma unroll
            for (int q = 0; q < 4; ++q) { const f32x4 t = dp[q]; D[4 * q] += t[0]; D[4 * q + 1] += t[1]; D[4 * q + 2] += t[2]; D[4 * q + 3] += t[3]; }
            ss += *(LAS const float*)(lds + 32768 + ((w + o) * 64 + lane) * 4); }
        ss += __shfl_xor(ss, 32);
        const float rstd = rsqrtf(ss * (1.f / DM) + EPS);
        if (hh == 0) R.rstd[row] = rstd;
        float l[16];
#pragma unroll
        for (int r = 0; r < 16; ++r) l[r] = D[r] * rstd + a.b_r[(r & 3) + 8 * (r >> 2) + 4 * hh];
        float c[8]; int ci[8];
#pragma unroll
        for (int k = 0; k < 4; ++k) {
            float bv = -INFINITY; int bi = 99;
#pragma unroll
            for (int r = 0; r < 16; ++r) { const int e = (r & 3) + 8 * (r >> 2) + 4 * hh; const bool bt = l[r] > bv; bv = bt ? l[r] : bv; bi = bt ? e : bi; }
            c[k] = bv; ci[k] = bi;
#pragma unroll
            for (int r = 0; r < 16; ++r) { const int e = (r & 3) + 8 * (r >> 2) + 4 * hh; l[r] = (e == bi) ? -INFINITY : l[r]; }
        }
#pragma unroll
        for (int k = 0; k < 4; ++k) { c[4 + k] = __shfl_xor(c[k], 32); ci[4 + k] = __shfl_xor(ci[k], 32); }
        float tv[4]; int ti[4];
#pragma unroll
        for (int k = 0; k < 4; ++k) {
            float bv = -INFINITY; int bi = 99;
#pragma unroll
            for (int j = 0; j < 8; ++j) { const bool bt = (c[j] > bv) || (c[j] == bv && ci[j] < bi); bv = bt ? c[j] : bv; bi = bt ? ci[j] : bi; }
            tv[k] = bv; ti[k] = bi;
#pragma unroll
            for (int j = 0; j < 8; ++j) c[j] = (ci[j] == bi) ? -INFINITY : c[j];
        }
        const float v0 = tv[0], v1 = tv[1], v2 = tv[2], v3 = tv[3]; const int i0 = ti[0], i1 = ti[1], i2 = ti[2], i3 = ti[3];
        const float e1 = __expf(v1 - v0), e2 = __expf(v2 - v0), e3 = __expf(v3 - v0), inv = 1.0f / (1.0f + e1 + e2 + e3);
        my_e0 = hh ? i2 : i0; my_e1 = hh ? i3 : i1; my_g0 = (hh ? e2 : 1.0f) * inv; my_g1 = (hh ? e3 : e1) * inv;
        rk0 = (int)__hip_atomic_fetch_add((LAS unsigned*)(lds + LR_LCNT) + my_e0, 1u, __ATOMIC_RELAXED, __HIP_MEMORY_SCOPE_WORKGROUP);
        rk1 = (int)__hip_atomic_fetch_add((LAS unsigned*)(lds + LR_LCNT) + my_e1, 1u, __ATOMIC_RELAXED, __HIP_MEMORY_SCOPE_WORKGROUP);
    }
    __syncthreads();
    if (tid < 32) gbase[tid] = __hip_atomic_fetch_add((unsigned*)(F.ctl + CW_GCNT + (dry ? 4096 : 0)) + 64 * tid, lcnt[tid], __ATOMIC_RELAXED, __HIP_MEMORY_SCOPE_AGENT);
    __syncthreads();
    if (kq == 0) {
        const int k0 = 2 * hh;
        const int s0 = (int)gbase[my_e0] + rk0, s1 = (int)gbase[my_e1] + rk1;
        R.tok_e[row * 4 + k0] = my_e0; R.tok_slot[row * 4 + k0] = s0; R.tok_gate[row * 4 + k0] = my_g0; R.toklist[(size_t)my_e0 * T + s0] = row;
        R.tok_e[row * 4 + k0 + 1] = my_e1; R.tok_slot[row * 4 + k0 + 1] = s1; R.tok_gate[row * 4 + k0 + 1] = my_g1; R.toklist[(size_t)my_e1 * T + s1] = row;
    }
}
#undef SW2
#undef SW2I
#undef TOP4_INSERT

__device__ __forceinline__ void build_tables(Frame& F) {
    LAS int* poff = (LAS int*)(F.lds + LT_POFF); LAS int* ntp = (LAS int*)(F.lds + LT_NT); LAS int* tile_e = (LAS int*)(F.lds + LT_TILE_E);
    LAS int* cnts = (LAS int*)(F.lds + LR_LCNT); const int tid = tid_now(F.wave);
    if (tid < NE) cnts[tid] = (int)__hip_atomic_load((unsigned*)(F.ctl + CW_GCNT) + 64 * tid, __ATOMIC_RELAXED, __HIP_MEMORY_SCOPE_AGENT);
    __syncthreads();
    if (tid == 0) {
        int t = 0;
        for (int e = 0; e < NE; ++e) { const int c = cnts[e]; const int nt = (c + 255) >> 8; poff[e] = t * 256; ((LAS int*)(F.lds + LT_FIRST))[e] = t; for (int i = 0; i < nt; ++i) tile_e[t + i] = e; t += nt; }
        *ntp = t;
    }
    __syncthreads();
}
__device__ __forceinline__ void combine_phase(Frame& F, const Args& a, const bool dry = false) {
    unsigned char* ws = a.ws; const RouteBufs R = route_bufs(ws);
    LAS const int* poff = (LAS const int*)(F.lds + LT_POFF);
    const int gw = F.vcu * NWAVES + F.wave, NGW = F.G * NWAVES, lane = tid_now(F.wave) & 63;
    for (int m0 = 2 * gw; m0 < T; m0 += 2 * NGW) {
        f32x4 v[2][2][2]; u32x2_t y[2][4][2]; float gt[2][4];
#pragma unroll
        for (int rr = 0; rr < 2; ++rr) { const int m = m0 + rr;
#pragma unroll
            for (int i = 0; i < 2; ++i) { { const v4u xq = __builtin_nontemporal_load((const v4u*)((const bf16*)(ws + WS_X1) + (size_t)m * DM + 8 * lane + 512 * i)); v[rr][i][0] = (f32x4){__uint_as_float(xq[0] << 16), __uint_as_float(xq[0] & 0xffff0000u), __uint_as_float(xq[1] << 16), __uint_as_float(xq[1] & 0xffff0000u)}; v[rr][i][1] = (f32x4){__uint_as_float(xq[2] << 16), __uint_as_float(xq[2] & 0xffff0000u), __uint_as_float(xq[3] << 16), __uint_as_float(xq[3] & 0xffff0000u)}; } }
#pragma unroll
            for (int k = 0; k < 4; ++k) { const int e = R.tok_e[m * 4 + k], slot = R.tok_slot[m * 4 + k]; gt[rr][k] = R.tok_gate[m * 4 + k];
                const unsigned char* yr = (const unsigned char*)(ws + WS_YS) + (size_t)(poff[e] + slot) * DM + 8 * lane;
                y[rr][k][0] = __builtin_nontemporal_load((const u32x2_t*)yr); y[rr][k][1] = __builtin_nontemporal_load((const u32x2_t*)(yr + 512)); } }
#pragma unroll
        for (int rr = 0; rr < 2; ++rr) { const int m = m0 + rr;
#pragma unroll
            for (int k = 0; k < 4; ++k)
#pragma unroll
                for (int i = 0; i < 2; ++i) { const u32x2_t yy = y[rr][k][i]; const float g = gt[rr][k];
                    const f32x2v a0 = __builtin_amdgcn_cvt_pk_f32_fp8((int)yy.x, false), a1 = __builtin_amdgcn_cvt_pk_f32_fp8((int)yy.x, true), a2 = __builtin_amdgcn_cvt_pk_f32_fp8((int)yy.y, false), a3 = __builtin_amdgcn_cvt_pk_f32_fp8((int)yy.y, true);
                    v[rr][i][0][0] += g * a0[0]; v[rr][i][0][1] += g * a0[1]; v[rr][i][0][2] += g * a1[0]; v[rr][i][0][3] += g * a1[1];
                    v[rr][i][1][0] += g * a2[0]; v[rr][i][1][1] += g * a2[1]; v[rr][i][1][2] += g * a3[0]; v[rr][i][1][3] += g * a3[1]; }
            float ss = 0.f;
#pragma unroll
            for (int i = 0; i < 2; ++i)
#pragma unroll
                for (int q = 0; q < 2; ++q) { const f32x4 t = v[rr][i][q]; ss += (t[0] * t[0] + t[1] * t[1]) + (t[2] * t[2] + t[3] * t[3]); }
            const float rstd = rsqrtf(wave_sum(ss) * (1.f / DM) + EPS);
            unsigned char* np = (unsigned char*)(ws + (dry ? WS_H : WS_XN)) + (size_t)m * DM + 8 * lane; bf16* ow = (bf16*)(ws + (dry ? WS_XS : WS_Y));
#pragma unroll
            for (int i = 0; i < 2; ++i) { { v4u xb; xb[0] = cvtpk(v[rr][i][0][0], v[rr][i][0][1]); xb[1] = cvtpk(v[rr][i][0][2], v[rr][i][0][3]); xb[2] = cvtpk(v[rr][i][1][0], v[rr][i][1][1]); xb[3] = cvtpk(v[rr][i][1][2], v[rr][i][1][3]); *(v4u*)(ow + (size_t)m * DM + 8 * lane + 512 * i) = xb; }
                const f32x4 g0 = *(const f32x4*)(a.g_ple + 8 * lane + 512 * i), g1 = *(const f32x4*)(a.g_ple + 8 * lane + 512 * i + 4);
                u32x2_t o; o.x = pk4_fp8(v[rr][i][0][0] * rstd * g0[0], v[rr][i][0][1] * rstd * g0[1], v[rr][i][0][2] * rstd * g0[2], v[rr][i][0][3] * rstd * g0[3]);
                o.y = pk4_fp8(v[rr][i][1][0] * rstd * g1[0], v[rr][i][1][1] * rstd * g1[1], v[rr][i][1][2] * rstd * g1[2], v[rr][i][1][3] * rstd * g1[3]);
                *(u32x2_t*)(np + 512 * i) = o; } }
    }
}

__global__ void __launch_bounds__(NWAVES * 64, 2) mega_fwd(Args args) {
    extern __shared__ __attribute__((aligned(16))) unsigned char lds[];
    Frame F;
    F.lds = (LAS unsigned char*)lds;
    F.MISC = (volatile LAS unsigned*)(F.lds + MISC_OFF);
    F.wave = __builtin_amdgcn_readfirstlane(threadIdx.x >> 6);
    F.G = gridDim.x; { const int bx = blockIdx.x; F.vcu = (F.G % 8 == 0) ? (bx % 8) * (F.G / 8) + bx / 8 : bx; }
    unsigned char* ws = args.ws;
    F.ctl = (gu32*)(ws + WS_CTL);
    for (int u = threadIdx.x; u < (LDS_BYTES - LDSCTL_OFF) / 4; u += NWAVES * 64) ((LAS unsigned*)(F.lds + LDSCTL_OFF))[u] = 0u;
    __syncthreads();
    XcdBarrier bar = xcd_barrier_post((unsigned*)(F.ctl + CW_BAR), F.MISC + 8); bar.wave = F.wave;
    const int lo = args.ph_lo, hi = args.ph_hi;
#define IN(k) (lo <= (k) && (k) < hi)
#define GRID_BAR() xcd_barrier(bar)
#ifndef DUP_PHASE
#define DUP_PHASE -1
#endif
#define REP(k) for (int rep_ = 0; rep_ < ((DUP_PHASE) == (k) ? 2 : 1); ++rep_)

    if (IN(0)) { if (DUP_PHASE == 40) { p0_prologue(F, args, 1); GRID_BAR(); } if (DUP_PHASE == 41) { p0_prologue(F, args, 2); GRID_BAR(); } if (DUP_PHASE == 42) { p0_prologue(F, args, 3); GRID_BAR(); } REP(0) { p0_prologue(F, args); GRID_BAR(); } }

    if (IN(1)) REP(1) {
        pg8::Gemm g{(const pg8::bf16_t*)(ws + WS_XN), (const pg8::bf16_t*)(ws + WS_WT_IN), DM, 0};
        pg8::StaticOrder S; S.init(T / 256, DIN / 256, F.G, (int)blockIdx.x);
        pg8::EpiProj E{(pg8::bf16_t*)(ws + WS_HM), (pg8::bf16_t*)(ws + WS_RG), (const float*)(ws + WS_GAINS), (const float*)(ws + WS_ROPEC), (const float*)(ws + WS_ROPES)};
        pg8::gemm_phase<pg8::EpiProj, pg8::StaticOrder, true, true>(F.lds + RING_OFF, g, S, E, F.wave);
        {
            const int G2 = (F.G == 256) ? 128 : F.G, c2 = (F.G == 256) ? (int)blockIdx.x - 128 : (int)blockIdx.x;
            if (c2 >= 0) {
                pg8::Gemm g2{(const pg8::bf16_t*)(ws + WS_PB), (const pg8::bf16_t*)(ws + WS_WT_PP), PLE, 0};
                pg8::StaticOrder S2; S2.init(T / 256, DM / 256, G2, c2);
                pg8::EpiBf16Plain E2{(pg8::bf16_t*)(ws + WS_PJ), DM};
                pg8::gemm_phase<pg8::EpiBf16Plain, pg8::StaticOrder, true, true>(F.lds + RING_OFF, g2, S2, E2, F.wave);
            }
        }
        GRID_BAR();
    }
    if (DUP_PHASE == 51 && IN(1)) {
        pg8::Gemm g{(const pg8::bf16_t*)(ws + WS_XN), (const pg8::bf16_t*)(ws + WS_WT_IN), DM, 0};
        pg8::StaticOrder S; S.init(T / 256, DIN / 256, F.G, (int)blockIdx.x);
        pg8::EpiNull E;
        pg8::gemm_phase<pg8::EpiNull, pg8::StaticOrder, true, true>(F.lds + RING_OFF, g, S, E, F.wave);
        GRID_BAR();
    }
    if (IN(2)) REP(2) {
        if (F.G == 256) {
            const att::AttnArgs AA{(const bf16*)(ws + WS_HM), (const bf16*)(ws + WS_RG), (bf16*)(ws + WS_Y), args.gn_g, args.gn_b};
            att::attn_phase(F.lds + RING_OFF, AA, F.vcu, DUP_PHASE, (bf16*)(ws + WS_XS), F.wave);
        }
        GRID_BAR();
    }
    if (IN(3)) REP(3) {
        pg8::Gemm g{(const pg8::bf16_t*)(ws + WS_Y), (const pg8::bf16_t*)(ws + WS_WT_OUT), DM, 0};
        pg8::StaticOrder S; S.init(T / 256, DM / 256, F.G, (int)blockIdx.x);
        pg8::EpiResid E{args.x, (pg8::bf16_t*)(ws + WS_X1)};
        pg8::gemm_phase<pg8::EpiResid, pg8::StaticOrder, true, true>(F.lds + RING_OFF, g, S, E, F.wave);
        GRID_BAR();
    }
    if (DUP_PHASE == 30 && IN(3)) { GRID_BAR(); GRID_BAR(); GRID_BAR(); GRID_BAR(); }
    if (IN(4)) { if (DUP_PHASE == 4) { if (F.G == 256) router_phase(F, args, true); GRID_BAR(); } if (F.G == 256) router_phase(F, args); GRID_BAR(); }
    if (IN(5) || (lo >= 6 && lo <= 8)) build_tables(F);
    if (IN(6)) REP(6) {
        const int NT = *(LAS const int*)(F.lds + LT_NT);
        pg8::Gemm g{(const pg8::bf16_t*)(ws + WS_XN), (const pg8::bf16_t*)(ws + WS_WT_UG), DM / 2, (size_t)2048 * DM};
        pg8::MoeOrder S; S.init(NT, 8, F.G, (int)blockIdx.x, (LAS const int*)(F.lds + LT_TILE_E), F.wave, 1, args.b_ug, route_bufs(ws).rstd, F.lds + PF_OFF);
        S.toklist = route_bufs(ws).toklist; S.first_tile = (LAS const int*)(F.lds + LT_FIRST); S.tokl = F.lds + TOKL_OFF;
        pg8::EpiMoeUp E{(unsigned char*)(ws + WS_H), F.lds + PF_OFF};
        pg8::gemm_phase<pg8::EpiMoeUp, pg8::MoeOrder, true, true, true, true>(F.lds + RING_OFF, g, S, E, F.wave);
        GRID_BAR();
    }
    if (IN(7)) REP(7) {
        const int NT = *(LAS const int*)(F.lds + LT_NT);
        pg8::Gemm g{(const pg8::bf16_t*)(ws + WS_H), (const pg8::bf16_t*)(ws + WS_WT_DN), DM / 2, (size_t)DM * DM};
        pg8::MoeOrder S; S.init(NT, 4, F.G, (int)blockIdx.x, (LAS const int*)(F.lds + LT_TILE_E), F.wave, 2, args.b_dn, nullptr, F.lds + PF_OFF);
        pg8::EpiMoeDown E{(unsigned char*)(ws + WS_YS), F.lds + PF_OFF};
        pg8::gemm_phase<pg8::EpiMoeDown, pg8::MoeOrder, true, true, true>(F.lds + RING_OFF, g, S, E, F.wave);
        GRID_BAR();
    }
    if (IN(8)) { if (DUP_PHASE == 8) { combine_phase(F, args, true); GRID_BAR(); } combine_phase(F, args); GRID_BAR(); }
    if (IN(9)) {
        pg8::Gemm g{(const pg8::bf16_t*)(ws + WS_XN), (const pg8::bf16_t*)(ws + WS_WT_PG), DM / 2, 0};
        pg8::StaticOrder S; S.init(T / 256, DM / 256, F.G, (int)blockIdx.x);
        if (DUP_PHASE == 9) { pg8::EpiPle E0{(const pg8::bf16_t*)(ws + WS_Y), (const pg8::bf16_t*)(ws + WS_PJ), (float*)(ws + WS_XS)}; pg8::gemm_phase<pg8::EpiPle, pg8::StaticOrder, true, true, true>(F.lds + RING_OFF, g, S, E0, F.wave); }
        pg8::EpiPle E{(const pg8::bf16_t*)(ws + WS_Y), (const pg8::bf16_t*)(ws + WS_PJ), args.out};
        pg8::gemm_phase<pg8::EpiPle, pg8::StaticOrder, true, true, true>(F.lds + RING_OFF, g, S, E, F.wave);
    }
#undef IN
}
extern "C" void kernel_launch(void* const* d_in, const int* in_sizes, int n_in, void* d_out, int out_size, void* d_ws, size_t ws_size, hipStream_t stream) {
    static int grid = 0;
    if (grid == 0) {
        if (n_in != 22 || ws_size < 1024 * MiB) { fprintf(stderr, "kernel_launch: unexpected n_in %d / ws %zu\n", n_in, ws_size); grid = -1; return; }
        int dev = 0, cus = 0, per_cu = 0;
        if (hipGetDevice(&dev) != hipSuccess || hipDeviceGetAttribute(&cus, hipDeviceAttributeMultiprocessorCount, dev) != hipSuccess) { grid = -1; return; }
        if (hipFuncSetAttribute((const void*)mega_fwd, hipFuncAttributeMaxDynamicSharedMemorySize, LDS_BYTES) != hipSuccess) { fprintf(stderr, "kernel_launch: hipFuncSetAttribute failed\n"); grid = -1; return; }
        if (hipOccupancyMaxActiveBlocksPerMultiprocessor(&per_cu, (const void*)mega_fwd, NWAVES * 64, LDS_BYTES) != hipSuccess || per_cu < 1) { fprintf(stderr, "kernel_launch: occupancy query says %d\n", per_cu); per_cu = 1; }
        (void)hipGetLastError();
        grid = cus;
    }
    if (grid < 0) return;
    (void)hipMemsetAsync((char*)d_ws + WS_CTL, 0, CTL_ZERO_BYTES, stream);
    (void)hipMemsetAsync((char*)d_ws + WS_TOKLIST, 0, (size_t)NE * T * 4, stream);
    Args a{};
    a.x = (const float*)d_in[0]; a.p = (const float*)d_in[1]; a.positions = (const int*)d_in[2]; a.g_mix = (const float*)d_in[3]; a.w_in = (const float*)d_in[4];
    a.sbq = (const float*)d_in[5]; a.sbk = (const float*)d_in[6]; a.rq = (const float*)d_in[7]; a.rk = (const float*)d_in[8]; a.gn_g = (const float*)d_in[9]; a.gn_b = (const float*)d_in[10];
    a.w_out = (const float*)d_in[11]; a.g_ffn = (const float*)d_in[12]; a.w_r = (const float*)d_in[13]; a.b_r = (const float*)d_in[14]; a.w_ug = (const float*)d_in[15]; a.b_ug = (const float*)d_in[16];
    a.w_dn = (const float*)d_in[17]; a.b_dn = (const float*)d_in[18]; a.g_ple = (const float*)d_in[19]; a.w_pg = (const float*)d_in[20]; a.w_pp = (const float*)d_in[21];
    a.out = (float*)d_out; a.ws = (unsigned char*)d_ws; a.ph_lo = 0; a.ph_hi = 10;
    hipLaunchKernelGGL(mega_fwd, dim3(grid), dim3(NWAVES * 64), LDS_BYTES, stream, a);

}
```

```cpp
#include <hip/hip_runtime.h>
#include <cstdint>
#include <cstdio>
#include <cmath>

__device__ __forceinline__ int lane_id_hw() { return (int)__builtin_amdgcn_mbcnt_hi(~0u, __builtin_amdgcn_mbcnt_lo(~0u, 0u)); }
namespace pg8 {
#define PG8_LAS __attribute__((address_space(3)))
typedef unsigned short bf16_t;
typedef short bf16x8 __attribute__((ext_vector_type(8)));
typedef float f32x4 __attribute__((ext_vector_type(4)));
typedef unsigned u32x4 __attribute__((ext_vector_type(4)));
typedef unsigned u32x2 __attribute__((ext_vector_type(2)));
typedef int v4i32 __attribute__((ext_vector_type(4)));
typedef int v8i32 __attribute__((ext_vector_type(8)));
constexpr int BM = 256, BK = 64, HALF = 128, HTB = HALF * BK * 2  , STAGE_BYTES = 8 * HTB, NXCD = 8, WGM = 8;

__host__ __device__ __forceinline__ int lds_byte(int r, int c) { const int st = (r >> 4) * 2 + (c >> 5), rr = r & 15, cc = c & 31, ob = rr * 64 + cc * 2; return st * 1024 + (ob ^ (((ob >> 9) & 1) << 5)); }
__host__ __device__ __forceinline__ void stage_rc(int b, int& R, int& C) { const int st = b / 1024, sb = b % 1024, swz = sb ^ (((sb >> 9) & 1) << 5); R = (st >> 1) * 16 + swz / 64; C = (st & 1) * 32 + (swz % 64) / 2; }
__host__ __device__ __forceinline__ int perm32(int rho) { const int n = rho >> 4, i = rho & 15; return 8 * (i >> 2) + 4 * n + (i & 3); }

struct Unit { int pm, pn, e, seq; };
struct Gemm { const bf16_t* A; const bf16_t* Bt; int K; size_t strideBe; };

struct StaticOrder {
    int nM, nN, nwg, G, c;
    __host__ __device__ void init(int nM_, int nN_, int G_, int c_) { nM = nM_; nN = nN_; nwg = nM * nN; G = G_; c = c_; }
    __host__ __device__ bool next(int i, Unit& u) const {
        const long L = (long)i * G + c; if (L >= nwg) return false;
        int wgid = (int)L; { const int q = nwg / NXCD, r = nwg % NXCD, xcd = wgid % NXCD, off = wgid / NXCD; wgid = (xcd < r ? xcd * (q + 1) : r * (q + 1) + (xcd - r) * q) + off; }
        const int nig = WGM * nN, gid = wgid / nig, fm = gid * WGM, gsz = (nM - fm) < WGM ? (nM - fm) : WGM;
        u.pm = fm + ((wgid % nig) % gsz); u.pn = (wgid % nig) / gsz; u.e = 0; u.seq = i; return true;
    }
    __device__ __forceinline__ void a_ready(const Unit&) const {}
    __device__ __forceinline__ void done(const Unit&) const {}
};

typedef float f32x2_t __attribute__((ext_vector_type(2))); typedef __bf16 bf16x2_t __attribute__((ext_vector_type(2)));
__device__ __forceinline__ unsigned cvt_pk_bf16(float lo, float hi) { f32x2_t v = {lo, hi}; bf16x2_t b = __builtin_convertvector(v, bf16x2_t); return __builtin_bit_cast(unsigned, b); }

constexpr int T = 16384, SEQ = 2048, DM = 1024, DIN = 3584;
constexpr float EPS = 1e-6f;
__device__ __forceinline__ u32x4 pack8(const f32x4 a, const f32x4 b) { u32x4 w; w.x = cvt_pk_bf16(a[0], a[1]); w.y = cvt_pk_bf16(a[2], a[3]); w.z = cvt_pk_bf16(b[0], b[1]); w.w = cvt_pk_bf16(b[2], b[3]); return w; }

struct EpiProj {
    static constexpr bool PERM = true, AFTER_DRAIN = false;
    bf16_t* hm;
    bf16_t* rg;
    const float* gains;
    const float *ropec, *ropes;
    __device__ __forceinline__ void operator()(const f32x4 (&acc)[2][2][4][2], const Unit& u, int wr, int wc, int fr, int fq) const {
        const int region = u.pn >> 1, hb = 4 * (u.pn & 1) + wc;
        const bool normed = (region == 0) || (region == 1) || (region == 3) || (region == 4);
        const bool rope = (region == 3) || (region == 4);
        const int gidx = region == 0 ? 0 : region == 1 ? 1 : region == 3 ? 2 : 3;
        const float* gp = gains + gidx * 64;
        f32x4 gv[2][2];
#pragma unroll
        for (int bj = 0; bj < 2; ++bj)
#pragma unroll
            for (int n = 0; n < 2; ++n) gv[bj][n] = normed ? *(const f32x4*)(gp + 32 * bj + 8 * fq + 4 * n) : (f32x4){1.f, 1.f, 1.f, 1.f};
        const float lg2g = __log2f(1.0f - __builtin_amdgcn_exp2f(-5.0f - (float)hb));
        const float scale = region == 0 ? 0.125f * 1.4426950408889634f : region == 4 ? 0.125f : 1.0f;
#pragma unroll
        for (int ai = 0; ai < 2; ++ai)
#pragma unroll
            for (int m = 0; m < 4; ++m) {
                const int row = u.pm * BM + ai * HALF + wr * 64 + m * 16 + fr;
                const int b = row >> 11, s = row & (SEQ - 1);
                f32x4 v[2][2];
#pragma unroll
                for (int bj = 0; bj < 2; ++bj)
#pragma unroll
                    for (int n = 0; n < 2; ++n) v[bj][n] = acc[ai][bj][m][n];
                if (normed) {
                    float ss = 0.f;
#pragma unroll
                    for (int bj = 0; bj < 2; ++bj)
#pragma unroll
                        for (int n = 0; n < 2; ++n) { const f32x4 x = v[bj][n]; ss += (x[0] * x[0] + x[1] * x[1]) + (x[2] * x[2] + x[3] * x[3]); }
                    ss += __shfl_xor(ss, 16); ss += __shfl_xor(ss, 32);
                    float rs = rsqrtf(ss * (1.0f / 64.0f) + EPS) * scale;
                    if (rope) rs *= (region == 3) ? __builtin_amdgcn_exp2f((float)(s & 31) * lg2g) : __builtin_amdgcn_exp2f(-(float)(s & 63) * lg2g);
#pragma unroll
                    for (int bj = 0; bj < 2; ++bj)
#pragma unroll
                        for (int n = 0; n < 2; ++n) v[bj][n] = v[bj][n] * rs * gv[bj][n];
                    if (rope) {
#pragma unroll
                        for (int n = 0; n < 2; ++n) {
                            const f32x4 c = *(const f32x4*)(ropec + (size_t)row * 32 + 8 * fq + 4 * n), sn = *(const f32x4*)(ropes + (size_t)row * 32 + 8 * fq + 4 * n);
                            const f32x4 lo = v[0][n], hi = v[1][n];
                            v[0][n] = lo * c - hi * sn; v[1][n] = hi * c + lo * sn;
                        }
                    }
                }
                bf16_t* dst = (region < 6) ? hm + (size_t)region * ((size_t)T * 512) + ((size_t)(b * 8 + hb) * SEQ + s) * 64 + 8 * fq
                                           : rg + (size_t)row * 512 + hb * 64 + 8 * fq;
#pragma unroll
                for (int bj = 0; bj < 2; ++bj) *(u32x4*)(dst + 32 * bj) = pack8(v[bj][0], v[bj][1]);
            }
    }
};

constexpr int PF_WAVE_BYTES = 768, PF_BUF_BYTES = 8 * PF_WAVE_BYTES;
struct EpiBf16Plain {
    static constexpr bool PERM = true, AFTER_DRAIN = false;
    bf16_t* O; int ldc;
    __device__ __forceinline__ void operator()(const f32x4 (&acc)[2][2][4][2], const Unit& u, int wr, int wc, int fr, int fq) const {
        const int row0 = u.pm * BM + wr * 64 + fr, col0 = u.pn * BM + wc * 32 + 8 * fq;
#pragma unroll
        for (int ai = 0; ai < 2; ++ai)
#pragma unroll
            for (int m = 0; m < 4; ++m) { bf16_t* rowp = O + (size_t)(row0 + ai * HALF + m * 16) * ldc + col0;
#pragma unroll
                for (int bj = 0; bj < 2; ++bj) *(u32x4*)(rowp + bj * HALF) = pack8(acc[ai][bj][m][0], acc[ai][bj][m][1]); }
    }
};
struct EpiResid {
    static constexpr bool PERM = true, AFTER_DRAIN = false;
    const float* base; bf16_t* X1;
    __device__ __forceinline__ void operator()(const f32x4 (&acc)[2][2][4][2], const Unit& u, int wr, int wc, int fr, int fq) const {
        const int col0 = u.pn * BM + wc * 32 + 8 * fq;
#pragma unroll
        for (int ai = 0; ai < 2; ++ai)
#pragma unroll
            for (int m = 0; m < 4; ++m) { const size_t off = (size_t)(u.pm * BM + ai * HALF + wr * 64 + m * 16 + fr) * DM + col0;
#pragma unroll
                for (int bj = 0; bj < 2; ++bj) { const f32x4 b0 = __builtin_nontemporal_load((const f32x4*)(base + off + bj * HALF)), b1 = __builtin_nontemporal_load((const f32x4*)(base + off + bj * HALF + 4));
                    *(u32x4*)(X1 + off + bj * HALF) = pack8(b0 + acc[ai][bj][m][0], b1 + acc[ai][bj][m][1]); } }
    }
};
struct EpiMoeUp {
    static constexpr bool PERM = true, AFTER_DRAIN = false;
    unsigned char* H; const PG8_LAS unsigned char* pf_lds;
    __device__ __forceinline__ void operator()(const f32x4 (&acc)[2][2][4][2], const Unit& u, int wr, int wc, int fr, int fq) const {
        const int cc = 128 * u.pn + 32 * wc + 8 * fq;
        f32x4 bg[2], bl[2]; float scs[2][4];
        const PG8_LAS unsigned char* buf = pf_lds + (u.seq & 1) * PF_BUF_BYTES + (wr * 4 + wc) * PF_WAVE_BYTES;
#pragma unroll
        for (int n = 0; n < 2; ++n) { bg[n] = *(const PG8_LAS f32x4*)(buf + (8 * fq + 4 * n) * 4); bl[n] = *(const PG8_LAS f32x4*)(buf + 128 + (8 * fq + 4 * n) * 4); }
#pragma unroll
        for (int ai = 0; ai < 2; ++ai)
#pragma unroll
            for (int m = 0; m < 4; ++m) scs[ai][m] = *(const PG8_LAS float*)(buf + 256 + ai * 256 + (m * 16 + fr) * 4);
#pragma unroll
        for (int n = 0; n < 2; ++n) bl[n] = bl[n] + 1.0f;
#pragma unroll
        for (int ai = 0; ai < 2; ++ai)
#pragma unroll
            for (int m = 0; m < 4; ++m) {
                const float sc = scs[ai][m] * 0.015625f;
                f32x4 hv[2];
#pragma unroll
                for (int n = 0; n < 2; ++n) {
                    const f32x4 g0 = acc[ai][0][m][n] * sc + bg[n], l1 = acc[ai][1][m][n] * sc + bl[n];
                    f32x4 glu, lin1;
#pragma unroll
                    for (int j = 0; j < 4; ++j) { glu[j] = __builtin_fminf(g0[j], 7.0f); lin1[j] = __builtin_amdgcn_fmed3f(l1[j], -6.0f, 8.0f); }
                    const f32x4 t = glu * (-1.702f * 1.4426950408889634f);
                    f32x4 e;
#pragma unroll
                    for (int j = 0; j < 4; ++j) e[j] = __builtin_amdgcn_exp2f(t[j]);
                    const f32x4 d = e + 1.0f;
                    f32x4 r;
#pragma unroll
                    for (int j = 0; j < 4; ++j) r[j] = __builtin_amdgcn_rcpf(d[j]);
                    hv[n] = (glu * r) * lin1;
                }
                u32x2 hq; hq.x = (unsigned)__builtin_amdgcn_cvt_pk_fp8_f32(hv[0][0], hv[0][1], 0, false); hq.x = (unsigned)__builtin_amdgcn_cvt_pk_fp8_f32(hv[0][2], hv[0][3], (int)hq.x, true);
                hq.y = (unsigned)__builtin_amdgcn_cvt_pk_fp8_f32(hv[1][0], hv[1][1], 0, false); hq.y = (unsigned)__builtin_amdgcn_cvt_pk_fp8_f32(hv[1][2], hv[1][3], (int)hq.y, true);
                *(u32x2*)(H + (size_t)(u.pm * BM + ai * HALF + wr * 64 + m * 16 + fr) * 1024 + cc) = hq;
            }
    }
};
struct EpiMoeDown {
    static constexpr bool PERM = true, AFTER_DRAIN = false;
    unsigned char* YS; const PG8_LAS unsigned char* pf_lds;
    __device__ __forceinline__ void operator()(const f32x4 (&acc)[2][2][4][2], const Unit& u, int wr, int wc, int fr, int fq) const {
        const int col0 = u.pn * BM + wc * 32 + 8 * fq;
        const PG8_LAS unsigned char* buf = pf_lds + (u.seq & 1) * PF_BUF_BYTES + (wr * 4 + wc) * PF_WAVE_BYTES;
        f32x4 bv[2][2];
#pragma unroll
        for (int bj = 0; bj < 2; ++bj)
#pragma unroll
            for (int n = 0; n < 2; ++n) bv[bj][n] = *(const PG8_LAS f32x4*)(buf + bj * 128 + (8 * fq + 4 * n) * 4);
#pragma unroll
        for (int ai = 0; ai < 2; ++ai)
#pragma unroll
            for (int m = 0; m < 4; ++m) { unsigned char* rowp = YS + (size_t)(u.pm * BM + ai * HALF + wr * 64 + m * 16 + fr) * 1024 + col0;
#pragma unroll
                for (int bj = 0; bj < 2; ++bj) { const f32x4 y0 = acc[ai][bj][m][0] * 0.015625f + bv[bj][0], y1 = acc[ai][bj][m][1] * 0.015625f + bv[bj][1];
                    u32x2 q; q.x = (unsigned)__builtin_amdgcn_cvt_pk_fp8_f32(y0[0], y0[1], 0, false); q.x = (unsigned)__builtin_amdgcn_cvt_pk_fp8_f32(y0[2], y0[3], (int)q.x, true);
                    q.y = (unsigned)__builtin_amdgcn_cvt_pk_fp8_f32(y1[0], y1[1], 0, false); q.y = (unsigned)__builtin_amdgcn_cvt_pk_fp8_f32(y1[2], y1[3], (int)q.y, true);
                    *(u32x2*)(rowp + bj * HALF) = q; } }
    }
};
struct EpiPle {
    static constexpr bool PERM = false, AFTER_DRAIN = false;
    const bf16_t* X2; const bf16_t* PJ; float* outw;
    __device__ __forceinline__ void operator()(const f32x4 (&acc)[2][2][4][2], const Unit& u, int wr, int wc, int fr, int fq) const {
        const int col0 = u.pn * BM + wc * 32 + 4 * fq;
#pragma unroll
        for (int ai = 0; ai < 2; ++ai)
#pragma unroll
            for (int m = 0; m < 4; ++m) { const size_t off = (size_t)(u.pm * BM + ai * HALF + wr * 64 + m * 16 + fr) * DM + col0;
#pragma unroll
                for (int bj = 0; bj < 2; ++bj)
#pragma unroll
                    for (int n = 0; n < 2; ++n) {
                        const size_t o2 = off + bj * HALF + n * 16;
                        const u32x2 xq = __builtin_nontemporal_load((const u32x2*)(X2 + o2)); const f32x4 x2 = (f32x4){__uint_as_float(xq.x << 16), __uint_as_float(xq.x & 0xffff0000u), __uint_as_float(xq.y << 16), __uint_as_float(xq.y & 0xffff0000u)}; const u32x2 pj = __builtin_nontemporal_load((const u32x2*)(PJ + o2)); const f32x4 a = acc[ai][bj][m][n] * 0.015625f;
                        f32x4 r;
                        r[0] = x2[0] + __uint_as_float(pj.x << 16) * __builtin_amdgcn_rcpf(1.0f + __builtin_amdgcn_exp2f(-1.4426950408889634f * a[0]));
                        r[1] = x2[1] + __uint_as_float(pj.x & 0xffff0000u) * __builtin_amdgcn_rcpf(1.0f + __builtin_amdgcn_exp2f(-1.4426950408889634f * a[1]));
                        r[2] = x2[2] + __uint_as_float(pj.y << 16) * __builtin_amdgcn_rcpf(1.0f + __builtin_amdgcn_exp2f(-1.4426950408889634f * a[2]));
                        r[3] = x2[3] + __uint_as_float(pj.y & 0xffff0000u) * __builtin_amdgcn_rcpf(1.0f + __builtin_amdgcn_exp2f(-1.4426950408889634f * a[3]));
                        __builtin_nontemporal_store(r, (f32x4*)(outw + o2));
                    } }
    }
};
struct MoeOrder {
    int nM, nN, nwg, G, c, wid, mode; const PG8_LAS int* tile_e; const float* pf_bias; const float* pf_rstd; PG8_LAS unsigned char* pf_lds;
    const int* toklist; const PG8_LAS int* first_tile; PG8_LAS unsigned char* tokl;
    __device__ __forceinline__ const int* tok_src(const Unit& u) const { return toklist + (size_t)u.e * T + 256 * (u.pm - first_tile[u.e]); }
    __device__ __forceinline__ PG8_LAS unsigned char* tok_lds() const { return tokl; }
    __device__ void init(int nM_, int nN_, int G_, int c_, const PG8_LAS int* te, int wid_, int mode_, const float* pb, const float* pr, PG8_LAS unsigned char* pl) { nM = nM_; nN = nN_; nwg = nM * nN; G = G_; c = c_; tile_e = te; wid = wid_; mode = mode_; pf_bias = pb; pf_rstd = pr; pf_lds = pl; }
    __device__ bool next(int i, Unit& u) const {
        const long L = (long)i * G + c; if (L >= nwg) return false;
        int wgid = (int)L; { const int q = nwg / NXCD, r = nwg % NXCD, xcd = wgid % NXCD, off = wgid / NXCD; wgid = (xcd < r ? xcd * (q + 1) : r * (q + 1) + (xcd - r) * q) + off; }
        const int nig = WGM * nN, gid = wgid / nig, fm = gid * WGM, gsz = (nM - fm) < WGM ? (nM - fm) : WGM;
        u.pm = fm + ((wgid % nig) % gsz); u.pn = (wgid % nig) / gsz; u.e = __builtin_amdgcn_readfirstlane(tile_e[u.pm]); u.seq = i; return true;
    }
    __device__ __forceinline__ void a_ready(const Unit& u) const {
        const int lane = (int)__builtin_amdgcn_mbcnt_hi(~0u, __builtin_amdgcn_mbcnt_lo(~0u, 0u)), wr = wid >> 2, wc = wid & 3;
        PG8_LAS unsigned char* buf = pf_lds + (u.seq & 1) * PF_BUF_BYTES + wid * PF_WAVE_BYTES;
        if (mode == 1) {
            const float* bsrc = pf_bias + (size_t)u.e * 2048 + 128 * u.pn + 32 * wc + (lane & 31) + ((lane >> 5) ? 1024 : 0);
            __builtin_amdgcn_global_load_lds((const unsigned*)bsrc, (PG8_LAS unsigned*)buf, 4, 0, 0);
            const PG8_LAS int* tl = (const PG8_LAS int*)(tokl + 1024 * (u.seq & 1)) + wr * 64 + lane;
            __builtin_amdgcn_global_load_lds((const unsigned*)(pf_rstd + tl[0]), (PG8_LAS unsigned*)(buf + 256), 4, 0, 0);
            __builtin_amdgcn_global_load_lds((const unsigned*)(pf_rstd + tl[HALF]), (PG8_LAS unsigned*)(buf + 512), 4, 0, 0);
        } else if (mode == 2) {
            const float* bsrc = pf_bias + (size_t)u.e * 1024 + u.pn * BM + 32 * wc + (lane & 31) + ((lane >> 5) ? HALF : 0);
            __builtin_amdgcn_global_load_lds((const unsigned*)bsrc, (PG8_LAS unsigned*)buf, 4, 0, 0);
        }
    }
    __device__ __forceinline__ void done(const Unit&) const {}
};
struct EpiNull {
    static constexpr bool PERM = true, AFTER_DRAIN = false;
    __device__ __forceinline__ void operator()(const f32x4 (&acc)[2][2][4][2], const Unit& u, int wr, int wc, int fr, int fq) const {
#pragma unroll
        for (int ai = 0; ai < 2; ++ai)
#pragma unroll
            for (int bj = 0; bj < 2; ++bj)
#pragma unroll
                for (int m = 0; m < 4; ++m)
#pragma unroll
                    for (int n = 0; n < 2; ++n) asm volatile("" :: "v"(acc[ai][bj][m][n]));
    }
};
template <class Epi, class Sched, bool ALIGN_EPI = false, bool SP2 = false, bool F8 = false, bool GATHER = false>
__device__ __forceinline__ void gemm_phase(PG8_LAS unsigned char* lds, const Gemm g, const Sched& S, const Epi& E, const int wave_id) {
    int tid_ = wave_id * 64 + lane_id_hw(); asm volatile("" : "+v"(tid_));
    const int tid = tid_, wid = __builtin_amdgcn_readfirstlane(tid >> 6), lane = tid & 63, wr = wid >> 2, wc = wid & 3, fr = lane & 15, fq = lane >> 4;
    const int K = g.K, nt = K / BK;
    unsigned voffA[2], voffB[2];
#pragma unroll
    for (int i = 0; i < 2; ++i) { int R, C; stage_rc(tid * 16 + i * 8192, R, C); const int Rb = Epi::PERM ? ((R & ~31) + perm32(R & 31)) : R;
        voffA[i] = (unsigned)(R * K + C) * 2u; voffB[i] = (unsigned)(Rb * K + C) * 2u; }
    const size_t kstep = (size_t)(BK * 2);
    const size_t hstep = (size_t)HALF * K * 2;
    const size_t tstep = 2 * hstep;
    const size_t hstepA = GATHER ? 0 : hstep;
    unsigned gC[2][2];
#pragma unroll
    for (int h = 0; h < 2; ++h)
#pragma unroll
        for (int i = 0; i < 2; ++i) gC[h][i] = voffA[i];
#define PG8_TOK_DMA(U, par) do { if constexpr (GATHER) { if (wid < 4) __builtin_amdgcn_global_load_lds((const unsigned*)(S.tok_src(U) + 64 * wid + (int)__builtin_amdgcn_mbcnt_hi(~0u, __builtin_amdgcn_mbcnt_lo(~0u, 0u))), (PG8_LAS unsigned*)(S.tok_lds() + 1024 * (par) + 256 * wid), 4, 0, 0); } } while (0)
#define PG8_TOK_READ(dst, par) do { if constexpr (GATHER) { _Pragma("unroll") for (int i = 0; i < 2; ++i) { int R_, C_; stage_rc((wid * 64 + (int)__builtin_amdgcn_mbcnt_hi(~0u, __builtin_amdgcn_mbcnt_lo(~0u, 0u))) * 16 + i * 8192, R_, C_); _Pragma("unroll") for (int h = 0; h < 2; ++h) \
        dst[h][i] = (unsigned)(*(const PG8_LAS int*)(S.tok_lds() + 1024 * (par) + 4 * (h * HALF + R_))) * (unsigned)(K * 2) + (unsigned)C_ * 2u; } } } while (0)
    const unsigned ldsw = (unsigned)wid * 1024u;
    const int aoff = lds_byte(wr * 64 + fr, fq * 8), boff = lds_byte(wc * 32 + fr, fq * 8);
#define PG8_SA(b, h) (((b) * 2 + (h)) * HTB)
#define PG8_SB(b, h) ((4 + (b) * 2 + (h)) * HTB)
#define PG8_STAGE(bufoff, gbase, voff) do { _Pragma("unroll") for (int _i = 0; _i < 2; ++_i) \
        __builtin_amdgcn_global_load_lds((const unsigned*)((const char*)(gbase) + (voff)[_i]), (PG8_LAS unsigned*)(lds + (bufoff) + ldsw + _i * 8192), 16, 0, 0); } while (0)
#define PG8_LD16(off) (*(const PG8_LAS v4i32*)(lds + (off)))
#define PG8_LDA(dst, b, h) do { if constexpr (F8) { _Pragma("unroll") for (int m = 0; m < 4; ++m) dst##8[m] = __builtin_shufflevector(PG8_LD16(PG8_SA(b, h) + aoff + m * 2048), PG8_LD16(PG8_SA(b, h) + aoff + m * 2048 + 1024), 0, 1, 2, 3, 4, 5, 6, 7); } \
        else { _Pragma("unroll") for (int m = 0; m < 4; ++m) _Pragma("unroll") for (int k = 0; k < 2; ++k) dst[m][k] = *(const PG8_LAS bf16x8*)(lds + PG8_SA(b, h) + aoff + m * 2048 + k * 1024); } } while (0)
#define PG8_LDB(dst, b, h) do { if constexpr (F8) { _Pragma("unroll") for (int n = 0; n < 2; ++n) dst##8[n] = __builtin_shufflevector(PG8_LD16(PG8_SB(b, h) + boff + n * 2048), PG8_LD16(PG8_SB(b, h) + boff + n * 2048 + 1024), 0, 1, 2, 3, 4, 5, 6, 7); } \
        else { _Pragma("unroll") for (int n = 0; n < 2; ++n) _Pragma("unroll") for (int k = 0; k < 2; ++k) dst[n][k] = *(const PG8_LAS bf16x8*)(lds + PG8_SB(b, h) + boff + n * 2048 + k * 1024); } } while (0)
#define PG8_MMA(ai, bj, At, Bt) do { __builtin_amdgcn_s_setprio(1); \
        if constexpr (F8) { _Pragma("unroll") for (int m = 0; m < 4; ++m) _Pragma("unroll") for (int n = 0; n < 2; ++n) \
            asm volatile("v_mfma_scale_f32_16x16x128_f8f6f4 %0, %1, %2, %0, %3, %3 op_sel_hi:[0,0,0]" : "+v"(acc[ai][bj][m][n]) : "v"(Bt##8[n]), "v"(At##8[m]), "v"(f8scale)); } \
        else { _Pragma("unroll") for (int m = 0; m < 4; ++m) _Pragma("unroll") for (int n = 0; n < 2; ++n) _Pragma("unroll") for (int k = 0; k < 2; ++k) \
            acc[ai][bj][m][n] = __builtin_amdgcn_mfma_f32_16x16x32_bf16(Bt[n][k], At[m][k], acc[ai][bj][m][n], 0, 0, 0); } \
        __builtin_amdgcn_s_setprio(0); } while (0)
#define PG8_WAIT_V(n) asm volatile("s_waitcnt vmcnt(" #n ")" ::: "memory")
#define PG8_WAIT_L(n) asm volatile("s_waitcnt lgkmcnt(" #n ")" ::: "memory")
#define PG8_BAR __builtin_amdgcn_s_barrier()
#define PG8_SCHED __builtin_amdgcn_sched_barrier(0)
    Unit cur, nxt; int ui = 0;
    if (!S.next(0, cur)) return;
    f32x4 acc[2][2][4][2];
#pragma unroll
    for (int a = 0; a < 2; ++a)
#pragma unroll
        for (int b = 0; b < 2; ++b)
#pragma unroll
            for (int m = 0; m < 4; ++m)
#pragma unroll
                for (int n = 0; n < 2; ++n) acc[a][b][m][n] = (f32x4){0.f, 0.f, 0.f, 0.f};
    bf16x8 At[4][2], B0[2][2], B1[2][2];
    v8i32 At8[4], B08[2], B18[2]; const int f8scale = 0x7f7f7f7f;
    const char* cA = (const char*)g.A + (GATHER ? (size_t)0 : (size_t)cur.pm * tstep); const char* cB = (const char*)g.Bt + (size_t)cur.e * g.strideBe + (size_t)cur.pn * tstep;
    if constexpr (GATHER) { PG8_TOK_DMA(cur, 0); asm volatile("s_waitcnt vmcnt(0)" ::: "memory"); PG8_BAR; PG8_TOK_READ(gC, 0); }
    S.a_ready(cur);
    if constexpr (SP2) {
        PG8_STAGE(PG8_SB(0, 0), cB, voffB); PG8_STAGE(PG8_SB(0, 1), cB + hstep, voffB); PG8_STAGE(PG8_SA(0, 0), cA, gC[0]); PG8_STAGE(PG8_SA(0, 1), cA + hstepA, gC[1]);
        if (wr == 1) PG8_BAR;
        PG8_WAIT_V(2); PG8_BAR;
        PG8_STAGE(PG8_SB(1, 0), cB + kstep, voffB); PG8_STAGE(PG8_SA(1, 0), cA + kstep, gC[0]); PG8_STAGE(PG8_SB(1, 1), cB + hstep + kstep, voffB);
        PG8_WAIT_V(6); PG8_BAR;
    } else {
        PG8_STAGE(PG8_SB(0, 0), cB, voffB); PG8_STAGE(PG8_SA(0, 0), cA, voffA); PG8_STAGE(PG8_SB(0, 1), cB + hstep, voffB); PG8_STAGE(PG8_SA(0, 1), cA + hstep, voffA);
        if (wr == 1) PG8_BAR;
        PG8_WAIT_V(4); PG8_BAR;
        PG8_STAGE(PG8_SB(1, 0), cB + kstep, voffB); PG8_STAGE(PG8_SA(1, 0), cA + kstep, voffA); PG8_STAGE(PG8_SB(1, 1), cB + hstep + kstep, voffB);
        PG8_WAIT_V(6); PG8_BAR;
    }
    for (;;) {
        const bool has_next = S.next(ui + 1, nxt);
        const char* nA = (has_next && !GATHER) ? (const char*)g.A + (size_t)nxt.pm * tstep : cA;
        const char* nB = has_next ? (const char*)g.Bt + (size_t)nxt.e * g.strideBe + (size_t)nxt.pn * tstep : cB;
        if (has_next) PG8_TOK_DMA(nxt, (ui + 1) & 1);
#pragma unroll 1
        for (int t = 0; t < nt; t += 2) {
            const bool last = (t == nt - 2);
            const char* a1 = cA + (size_t)(t + 1) * kstep;
            const char* a2 = last ? nA : cA + (size_t)(t + 2) * kstep; const char* b2 = last ? nB : cB + (size_t)(t + 2) * kstep;
            const char* a3 = a2 + kstep; const char* b3 = b2 + kstep;
            if (last && has_next) S.a_ready(nxt);
            if constexpr (SP2) {
            PG8_LDB(B0, 0, 0); PG8_LDB(B1, 0, 1); PG8_SCHED; PG8_LDA(At, 0, 0); PG8_STAGE(PG8_SA(1, 1), a1 + hstepA, gC[1]);
            if constexpr (GATHER) { if (last && has_next) PG8_TOK_READ(gC, (ui + 1) & 1); }
            PG8_WAIT_V(8); PG8_WAIT_L(0); PG8_BAR; PG8_MMA(0, 0, At, B0); PG8_MMA(0, 1, At, B1); PG8_BAR; PG8_SCHED;
            PG8_LDA(At, 0, 1); PG8_STAGE(PG8_SB(0, 0), b2, voffB); PG8_STAGE(PG8_SB(0, 1), b2 + hstep, voffB); PG8_STAGE(PG8_SA(0, 0), a2, gC[0]);
            PG8_WAIT_V(8); PG8_WAIT_L(0); PG8_BAR; PG8_MMA(1, 0, At, B0); PG8_MMA(1, 1, At, B1); PG8_BAR; PG8_SCHED;
            PG8_LDB(B0, 1, 0); PG8_LDB(B1, 1, 1); PG8_SCHED; PG8_LDA(At, 1, 0); PG8_STAGE(PG8_SA(0, 1), a2 + hstepA, gC[1]);
            PG8_WAIT_V(8); PG8_WAIT_L(0); PG8_BAR; PG8_MMA(0, 0, At, B0); PG8_MMA(0, 1, At, B1); PG8_BAR; PG8_SCHED;
            PG8_LDA(At, 1, 1); PG8_STAGE(PG8_SB(1, 0), b3, voffB); PG8_STAGE(PG8_SB(1, 1), b3 + hstep, voffB); PG8_STAGE(PG8_SA(1, 0), a3, gC[0]);
            PG8_WAIT_V(8); PG8_WAIT_L(0); PG8_BAR; PG8_MMA(1, 0, At, B0); PG8_MMA(1, 1, At, B1); PG8_BAR; PG8_SCHED;
            } else {
            PG8_LDB(B0, 0, 0); PG8_SCHED; PG8_LDA(At, 0, 0); PG8_STAGE(PG8_SA(1, 1), a1 + hstep, voffA);
            PG8_WAIT_L(8); PG8_BAR; PG8_WAIT_L(0); PG8_MMA(0, 0, At, B0); PG8_BAR; PG8_SCHED;
            PG8_LDB(B1, 0, 1); PG8_STAGE(PG8_SB(0, 0), b2, voffB);
            PG8_BAR; PG8_WAIT_L(0); PG8_MMA(0, 1, At, B1); PG8_BAR;
            PG8_LDA(At, 0, 1); PG8_STAGE(PG8_SA(0, 0), a2, voffA);
            PG8_BAR; PG8_WAIT_L(0); PG8_MMA(1, 0, At, B0); PG8_BAR; PG8_SCHED;
            PG8_STAGE(PG8_SB(0, 1), b2 + hstep, voffB);
            PG8_WAIT_V(6); PG8_BAR; PG8_MMA(1, 1, At, B1); PG8_BAR;
            PG8_LDB(B0, 1, 0); PG8_SCHED; PG8_LDA(At, 1, 0); PG8_STAGE(PG8_SA(0, 1), a2 + hstep, voffA);
            PG8_WAIT_L(8); PG8_BAR; PG8_WAIT_L(0); PG8_MMA(0, 0, At, B0); PG8_BAR; PG8_SCHED;
            PG8_LDB(B1, 1, 1); PG8_STAGE(PG8_SB(1, 0), b3, voffB);
            PG8_BAR; PG8_WAIT_L(0); PG8_MMA(0, 1, At, B1); PG8_BAR;
            PG8_LDA(At, 1, 1); PG8_STAGE(PG8_SA(1, 0), a3, voffA);
            PG8_BAR; PG8_WAIT_L(0); PG8_MMA(1, 0, At, B0); PG8_BAR; PG8_SCHED;
            PG8_STAGE(PG8_SB(1, 1), b3 + hstep, voffB);
            PG8_WAIT_V(6); PG8_BAR; PG8_MMA(1, 1, At, B1); PG8_BAR;
            }
        }
        if constexpr (ALIGN_EPI) { if (wr == 0) PG8_BAR; }
        if constexpr (F8) asm volatile("s_nop 15\n\ts_nop 15\n\ts_nop 15" ::: "memory");
        if constexpr (!Epi::AFTER_DRAIN) { E(acc, cur, wr, wc, fr, fq); S.done(cur); }
        if (!has_next) break;
#pragma unroll
        for (int a = 0; a < 2; ++a)
#pragma unroll
            for (int b = 0; b < 2; ++b)
#pragma unroll
                for (int m = 0; m < 4; ++m)
#pragma unroll
                    for (int n = 0; n < 2; ++n) acc[a][b][m][n] = (f32x4){0.f, 0.f, 0.f, 0.f};
        cur = nxt; cA = nA; cB = nB; ++ui;
        if constexpr (ALIGN_EPI) { if (wr == 1) PG8_BAR; }
    }
    PG8_WAIT_V(0);
    if constexpr (!ALIGN_EPI) { if (wr == 0) PG8_BAR; }
    PG8_BAR;
    if constexpr (Epi::AFTER_DRAIN) { E.fused(acc, cur, wr, wc, fr, fq, lds, wid, lane); S.done(cur); }
#undef PG8_TOK_DMA
#undef PG8_TOK_READ
#undef PG8_SA
#undef PG8_SB
#undef PG8_STAGE
#undef PG8_LD16
#undef PG8_LDA
#undef PG8_LDB
#undef PG8_MMA
#undef PG8_WAIT_V
#undef PG8_WAIT_L
#undef PG8_BAR
#undef PG8_SCHED
}
}

constexpr int NWAVES = 8;
constexpr int T = pg8::T, SEQ = pg8::SEQ, DM = pg8::DM, DIN = pg8::DIN, NE = 32, PLE = 256;
constexpr float EPS = pg8::EPS;
constexpr size_t MiB = 1u << 20;
constexpr size_t WS_CTL = 0, CTL_ZERO_BYTES = 256 * 1024;
constexpr size_t WS_WT_IN = 2 * MiB, WS_WT_OUT = 9 * MiB, WS_WT_PG = 11 * MiB, WS_WT_PP = 13 * MiB;
constexpr size_t WS_GAINS = 13 * MiB + 512 * 1024;
constexpr size_t WS_WRT = 13 * MiB + 576 * 1024;
constexpr size_t WS_ROPEC = 14 * MiB, WS_ROPES = 16 * MiB, WS_PB = 18 * MiB, WS_ROUTE = 26 * MiB;
constexpr size_t WS_TOKLIST = 29 * MiB;
constexpr size_t WS_WT_UG = 32 * MiB, WS_WT_DN = 160 * MiB;
constexpr size_t WS_XN = 224 * MiB;
constexpr size_t WS_HM = 256 * MiB;
constexpr size_t WS_X1 = 256 * MiB;
constexpr size_t WS_RG = 352 * MiB;
constexpr size_t WS_Y = 368 * MiB;
constexpr size_t WS_PJ = 400 * MiB;
constexpr size_t WS_XS = 432 * MiB, WS_H = 576 * MiB, WS_YS = 720 * MiB;
constexpr size_t WS_END = 864 * MiB;
constexpr int CW_TMO = 0, CW_CODE = 1;
constexpr int CW_BAR = 4096;
constexpr int RING_OFF = 0, RING_BYTES = 131072;
constexpr int LDSCTL_OFF = RING_BYTES, MISC_OFF = LDSCTL_OFF + 320;
constexpr int PF_OFF = LDSCTL_OFF + 4096;
constexpr int TOKL_OFF = LDSCTL_OFF + 16384;
constexpr int LDS_BYTES = 151552;
#define GAS __attribute__((address_space(1)))
#define LAS __attribute__((address_space(3)))
typedef unsigned short bf16;
typedef unsigned v4u __attribute__((ext_vector_type(4)));
typedef float f32x4 __attribute__((ext_vector_type(4)));
typedef short bf16x8 __attribute__((ext_vector_type(8)));
typedef unsigned u32x4_t __attribute__((ext_vector_type(4)));
typedef unsigned u32x2_t __attribute__((ext_vector_type(2)));
typedef GAS unsigned gu32;
typedef GAS unsigned long long gu64;
#define RLX_AGENT __ATOMIC_RELAXED, __HIP_MEMORY_SCOPE_AGENT
#define LDS_WAIT() asm volatile("s_waitcnt lgkmcnt(0)" ::: "memory")
#define VM_WAIT() asm volatile("s_waitcnt vmcnt(0)" ::: "memory")
__device__ __forceinline__ unsigned long long rt() { return __builtin_amdgcn_s_memrealtime(); }
__device__ __forceinline__ unsigned f2bf(float f) { unsigned u = __builtin_bit_cast(unsigned, f); return (u + 0x7fffu + ((u >> 16) & 1u)) >> 16; }
__device__ __forceinline__ unsigned pk2(float lo, float hi) { return f2bf(lo) | (f2bf(hi) << 16); }

#define XB_TMO      128
#define XB_XCNT(j)  (256  + 64 * (j))
#define XB_XSUB(j)  (1280 + 64 * (j))
#define XB_XGEN(j)  (2304 + 64 * (j))
#define XB_TOP      3328
#define XB_TOPGEN   3392
#define XCD_BAR_WORDS 3456
#define XB_SPIN_CAP (1u << 18)

__device__ __forceinline__ unsigned xb_ld(unsigned* p)              { return __hip_atomic_load(p, __ATOMIC_RELAXED, __HIP_MEMORY_SCOPE_AGENT); }
__device__ __forceinline__ unsigned xb_add(unsigned* p, unsigned v) { return __hip_atomic_fetch_add(p, v, __ATOMIC_RELAXED, __HIP_MEMORY_SCOPE_AGENT); }
__device__ __forceinline__ unsigned xb_xcc_id() { return (unsigned)__builtin_amdgcn_s_getreg((3 << 11) | 20) & 0xFu; }
#define XB_SPIN(cond, bar) do { unsigned _sp = 0; while (cond) { __builtin_amdgcn_s_sleep(1); \
    if ((++_sp & 255u) == 0u) { if (xb_ld(&(bar)[XB_TMO])) break; if (_sp > XB_SPIN_CAP) { atomicAdd(&(bar)[XB_TMO], 1u); break; } } } } while (0)

struct XcdBarrier {
    unsigned* bar; unsigned x; int wave;
    volatile LAS unsigned* st;
};

__device__ __forceinline__ XcdBarrier xcd_barrier_post(unsigned* bar, volatile LAS unsigned* st) {
    XcdBarrier b; b.bar = bar; b.x = xb_xcc_id(); b.st = st;
    if (threadIdx.x == 0) (void)xb_add(&bar[XB_XCNT(b.x)], 1u);
    return b;
}
__device__ __forceinline__ void xcd_barrier_complete(unsigned* bar, unsigned x, unsigned& nloc, unsigned& nx) {
    const unsigned G = gridDim.x * gridDim.y * gridDim.z;
    unsigned sum, cnt, mine, sp = 0u;
    for (;;) {
        sum = 0u; cnt = 0u; mine = 0u;
#pragma unroll
        for (unsigned j = 0; j < 16; ++j) { const unsigned c = xb_ld(&bar[XB_XCNT(j)]); sum += c; cnt += (c > 0u) ? 1u : 0u; mine = (j == x) ? c : mine; }
        if (sum == G) break;
        __builtin_amdgcn_s_sleep(1);
        if ((++sp & 255u) == 0u) { if (xb_ld(&bar[XB_TMO])) break; if (sp > XB_SPIN_CAP) { atomicAdd(&bar[XB_TMO], 1u); break; } }
    }
    nloc = mine > 0u ? mine : 1u; nx = cnt > 0u ? cnt : 1u;
}

__device__ __forceinline__ void xcd_barrier(const XcdBarrier& b) {
    asm volatile("s_waitcnt vmcnt(0)" ::: "memory");
    __syncthreads();
    if (b.wave == 0 && lane_id_hw() == 0) {
        unsigned* bar = b.bar;
        __builtin_amdgcn_s_waitcnt(0);
        unsigned nloc = b.st[0], nx = b.st[1];
        if (nloc == 0u) { xcd_barrier_complete(bar, b.x, nloc, nx); b.st[0] = nloc; b.st[1] = nx; }
        const unsigned old = xb_add(&bar[XB_XSUB(b.x)], 1u);
        const unsigned gen = old / nloc;
        const unsigned tgen = gen;
        if (old + 1u == (gen + 1u) * nloc) {
            __builtin_amdgcn_fence(__ATOMIC_RELEASE, "agent");
            asm volatile("s_waitcnt vmcnt(0)" ::: "memory");
            const unsigned og = xb_add(&bar[XB_TOP], 1u);
            const unsigned tg = og / nx;
            if (og + 1u == (tg + 1u) * nx) xb_add(&bar[XB_TOPGEN], 1u);
            else XB_SPIN(xb_ld(&bar[XB_TOPGEN]) == tg, bar);
        } else {
            XB_SPIN(xb_ld(&bar[XB_TOPGEN]) == tgen, bar);
        }
        __builtin_amdgcn_fence(__ATOMIC_ACQUIRE, "agent");
        asm volatile("s_waitcnt vmcnt(0)" ::: "memory");
    }
    __syncthreads();
}

struct Args {
    const float* x; const float* p; const int* positions; const float* g_mix; const float* w_in;
    const float* sbq; const float* sbk; const float* rq; const float* rk; const float* gn_g; const float* gn_b; const float* w_out;
    const float* g_ffn; const float* w_r; const float* b_r; const float* w_ug; const float* b_ug; const float* w_dn; const float* b_dn;
    const float* g_ple; const float* w_pg; const float* w_pp;
    float* out; unsigned char* ws; int ph_lo, ph_hi;
};
struct Frame {
    LAS unsigned char* lds;
    volatile LAS unsigned* MISC;
    gu32* ctl;
    int wave;
    int vcu, G;
};
__device__ __forceinline__ int tid_now(int wave_id) { int t = wave_id * 64 + lane_id_hw(); asm volatile("" : "+v"(t)); return t; }
__device__ __forceinline__ float wave_sum(float v) {
#pragma unroll
    for (int o = 1; o < 64; o <<= 1) v += __shfl_xor(v, o);
    return v;
}
__device__ __forceinline__ unsigned cvtpk(float lo, float hi) { return pg8::cvt_pk_bf16(lo, hi); }

enum { MAP_NAT = 0, MAP_IN = 1, MAP_UG = 2 };
__device__ __forceinline__ void p0_item(const float* __restrict__ W, int N, int K, bf16* __restrict__ WT, int kb, int nb, int mapmode, LAS unsigned char* scr, int lane) {
    const int np = 64 * nb + 4 * (lane & 15);
    int src = np;
    if (mapmode == MAP_IN) { const int pn = np >> 8, L = np & 255, bj = L >> 7, wc = (L >> 5) & 3, e = L & 31; src = 256 * pn + 64 * wc + 32 * bj + e; }
    else if (mapmode == MAP_UG) { const int pn = np >> 8, L = np & 255, bj = L >> 7, i = L & 127; src = 1024 * bj + 128 * pn + i; }
    const float* gp = W + (size_t)(64 * kb + (lane >> 4)) * N + src;
    f32x4 v[16];
#pragma unroll
    for (int i = 0; i < 16; ++i) v[i] = *(const f32x4*)(gp + (size_t)(4 * i) * N);
#pragma unroll
    for (int i = 0; i < 16; ++i) {
        LAS unsigned* d = (LAS unsigned*)(scr + (4 * i + (lane >> 4)) * 132 + 8 * (lane & 15));
        d[0] = cvtpk(v[i][0], v[i][1]); d[1] = cvtpk(v[i][2], v[i][3]);
    }
    LDS_WAIT(); asm volatile("" ::: "memory");
    const int c = lane & 7;
#pragma unroll
    for (int it = 0; it < 4; ++it) {
        const int nl = 16 * it + 2 * (lane >> 3);
        unsigned d[8];
#pragma unroll
        for (int j = 0; j < 8; ++j) d[j] = *(const LAS unsigned*)(scr + (8 * c + j) * 132 + 2 * nl);
        v4u o0, o1;
        o0.x = (d[0] & 0xffffu) | (d[1] << 16); o0.y = (d[2] & 0xffffu) | (d[3] << 16); o0.z = (d[4] & 0xffffu) | (d[5] << 16); o0.w = (d[6] & 0xffffu) | (d[7] << 16);
        o1.x = (d[0] >> 16) | (d[1] & 0xffff0000u); o1.y = (d[2] >> 16) | (d[3] & 0xffff0000u); o1.z = (d[4] >> 16) | (d[5] & 0xffff0000u); o1.w = (d[6] >> 16) | (d[7] & 0xffff0000u);
        bf16* dst = WT + (size_t)(64 * nb + nl) * K + 64 * kb + 8 * c;
        *(v4u*)dst = o0; *(v4u*)(dst + K) = o1;
    }
    LDS_WAIT(); asm volatile("" ::: "memory");
}
__device__ __forceinline__ unsigned pk4_fp8(float a, float b, float c, float d) { int r = __builtin_amdgcn_cvt_pk_fp8_f32(a, b, 0, false); r = __builtin_amdgcn_cvt_pk_fp8_f32(c, d, r, true); return (unsigned)r; }
__device__ __forceinline__ void p0_item_f8(const float* __restrict__ W, int N, int K, unsigned char* __restrict__ WT, int kb, int nb, int mapmode, LAS unsigned char* scr, int lane) {
    const int np = 64 * nb + 4 * (lane & 15);
    int src = np;
    if (mapmode == MAP_UG) { const int pn = np >> 8, L = np & 255, bj = L >> 7, i = L & 127; src = 1024 * bj + 128 * pn + i; }
    const float* gp = W + (size_t)(64 * kb + (lane >> 4)) * N + src;
    f32x4 v[16];
#pragma unroll
    for (int i = 0; i < 16; ++i) v[i] = *(const f32x4*)(gp + (size_t)(4 * i) * N);
#pragma unroll
    for (int i = 0; i < 16; ++i) *(LAS unsigned*)(scr + (4 * i + (lane >> 4)) * 68 + 4 * (lane & 15)) = pk4_fp8(v[i][0] * 64.0f, v[i][1] * 64.0f, v[i][2] * 64.0f, v[i][3] * 64.0f);
    LDS_WAIT(); asm volatile("" ::: "memory");
    const int nq = lane & 15, kg = lane >> 4;
    unsigned d[16];
#pragma unroll
    for (int j = 0; j < 16; ++j) d[j] = *(const LAS unsigned*)(scr + (16 * kg + j) * 68 + 4 * nq);
#pragma unroll
    for (int t = 0; t < 4; ++t) {
        v4u o;
#pragma unroll
        for (int q = 0; q < 4; ++q) o[q] = ((d[4 * q] >> (8 * t)) & 0xffu) | (((d[4 * q + 1] >> (8 * t)) & 0xffu) << 8) | (((d[4 * q + 2] >> (8 * t)) & 0xffu) << 16) | (((d[4 * q + 3] >> (8 * t)) & 0xffu) << 24);
        *(v4u*)(WT + (size_t)(64 * nb + 4 * nq + t) * K + 64 * kb + 16 * kg) = o;
    }
    LDS_WAIT(); asm volatile("" ::: "memory");
}
struct P0D { const float* gp; int N, K, kb, nb; bf16* W16; unsigned char* W8; const float* rsc; };
__device__ __forceinline__ int p0_src_col(int np, int mapmode) {
    int src = np;
    if (mapmode == MAP_IN) { const int pn = np >> 8, L = np & 255, bj = L >> 7, wc = (L >> 5) & 3, e = L & 31; src = 256 * pn + 64 * wc + 32 * bj + e; }
    else if (mapmode == MAP_UG) { const int pn = np >> 8, L = np & 255, bj = L >> 7, i = L & 127; src = 1024 * bj + 128 * pn + i; }
    return src;
}
__device__ __forceinline__ P0D p0_mk(const float* W, int N, int K, bf16* W16, unsigned char* W8, int kb, int nb, int mapmode, int lane, const float* rsc = nullptr) {
    P0D d; d.N = N; d.K = K; d.kb = kb; d.nb = nb; d.W16 = W16; d.W8 = W8;
    if (W8) {
        d.rsc = rsc ? rsc + 128 * kb + (lane >> 3) : nullptr;
        d.gp = W + (size_t)(128 * kb + (lane >> 3)) * N + p0_src_col(32 * nb + 4 * (lane & 7), mapmode);
    } else {
        d.rsc = nullptr;
        d.gp = W + (size_t)(64 * kb + (lane >> 4)) * N + p0_src_col(64 * nb + 4 * (lane & 15), mapmode);
    }
    return d;
}
__device__ __forceinline__ void p0_load(const P0D& d, f32x4 (&v)[16]) {
#pragma unroll
    for (int i = 0; i < 16; ++i) v[i] = __builtin_nontemporal_load((const f32x4*)(d.gp + (size_t)((d.W8 ? 8 : 4) * i) * d.N));
}
__device__ __forceinline__ void p0_finish(const P0D& d, const f32x4 (&v)[16], LAS unsigned char* scr, int lane, const int pm = 0) {
    if (pm == 1) { _Pragma("unroll") for (int i = 0; i < 16; ++i) asm volatile("" :: "v"(v[i])); return; }
    if (d.W16) {
#pragma unroll
        for (int i = 0; i < 16; ++i) { LAS unsigned* q = (LAS unsigned*)(scr + (4 * i + (lane >> 4)) * 132 + 8 * (lane & 15)); q[0] = cvtpk(v[i][0], v[i][1]); q[1] = cvtpk(v[i][2], v[i][3]); }
        LDS_WAIT(); asm volatile("" ::: "memory");
        const int c = lane & 7;
#pragma unroll
        for (int it = 0; it < 4; ++it) {
            const int nl = 16 * it + 2 * (lane >> 3);
            unsigned x[8];
#pragma unroll
            for (int j = 0; j < 8; ++j) x[j] = *(const LAS unsigned*)(scr + (8 * c + j) * 132 + 2 * nl);
            v4u o0, o1;
            o0.x = (x[0] & 0xffffu) | (x[1] << 16); o0.y = (x[2] & 0xffffu) | (x[3] << 16); o0.z = (x[4] & 0xffffu) | (x[5] << 16); o0.w = (x[6] & 0xffffu) | (x[7] << 16);
            o1.x = (x[0] >> 16) | (x[1] & 0xffff0000u); o1.y = (x[2] >> 16) | (x[3] & 0xffff0000u); o1.z = (x[4] >> 16) | (x[5] & 0xffff0000u); o1.w = (x[6] >> 16) | (x[7] & 0xffff0000u);
            bf16* dst = d.W16 + (size_t)(64 * d.nb + nl) * d.K + 64 * d.kb + 8 * c;
            if (pm == 0 || pm == 3) { *(v4u*)dst = o0; *(v4u*)(dst + d.K) = o1; } else asm volatile("" :: "v"(o0), "v"(o1));
        }
    } else {
#pragma unroll
        for (int i = 0; i < 16; ++i) { const float sc = d.rsc ? d.rsc[8 * i] * 64.0f : 64.0f; *(LAS unsigned*)(scr + (8 * i + (lane >> 3)) * 36 + 4 * (lane & 7)) = pk4_fp8(v[i][0] * sc, v[i][1] * sc, v[i][2] * sc, v[i][3] * sc); }
        LDS_WAIT(); asm volatile("" ::: "memory");
        const int nq = lane & 7, kg = lane >> 3;
        unsigned x[16];
#pragma unroll
        for (int j = 0; j < 16; ++j) x[j] = *(const LAS unsigned*)(scr + (16 * kg + j) * 36 + 4 * nq);
#pragma unroll
        for (int t = 0; t < 4; ++t) {
            v4u o;
#pragma unroll
            for (int q = 0; q < 4; ++q) o[q] = ((x[4 * q] >> (8 * t)) & 0xffu) | (((x[4 * q + 1] >> (8 * t)) & 0xffu) << 8) | (((x[4 * q + 2] >> (8 * t)) & 0xffu) << 16) | (((x[4 * q + 3] >> (8 * t)) & 0xffu) << 24);
            if (pm == 0 || pm == 3) __builtin_nontemporal_store(o, (v4u*)(d.W8 + (size_t)(32 * d.nb + 4 * nq + t) * d.K + 128 * d.kb + 16 * kg)); else asm volatile("" :: "v"(o));
        }
    }
    LDS_WAIT(); asm volatile("" ::: "memory");
}
__device__ __forceinline__ P0D p0_decode(const Args& a, unsigned char* ws, int it, int lane) {
    constexpr int I_IN = 16 * 56, I_OUT = 256, I_PG = 256, I_PP = 4 * 16, I_UG = 16 * 32, I_DN = 256;
    int r = it;
    if (r < I_IN) return p0_mk(a.w_in, DIN, DM, (bf16*)(ws + WS_WT_IN), nullptr, r / 56, r % 56, MAP_IN, lane); r -= I_IN;
    if (r < I_OUT) return p0_mk(a.w_out, DM, DM, (bf16*)(ws + WS_WT_OUT), nullptr, r / 16, r % 16, MAP_NAT, lane); r -= I_OUT;
    if (r < I_PG) return p0_mk(a.w_pg, DM, DM, nullptr, (unsigned char*)(ws + WS_WT_PG), r / 32, r % 32, MAP_NAT, lane); r -= I_PG;
    if (r < I_PP) return p0_mk(a.w_pp, DM, PLE, (bf16*)(ws + WS_WT_PP), nullptr, r / 16, r % 16, MAP_NAT, lane); r -= I_PP;
    if (r < NE * I_UG) { const int e = r / I_UG, q = r % I_UG; return p0_mk(a.w_ug + (size_t)e * DM * 2048, 2048, DM, nullptr, (unsigned char*)(ws + WS_WT_UG) + (size_t)e * 2048 * DM, q / 64, q % 64, MAP_UG, lane, a.g_ffn); } r -= NE * I_UG;
    { const int e = r / I_DN, q = r % I_DN; return p0_mk(a.w_dn + (size_t)e * DM * DM, DM, DM, nullptr, (unsigned char*)(ws + WS_WT_DN) + (size_t)e * DM * DM, q / 32, q % 32, MAP_NAT, lane); }
}
__device__ __forceinline__ void rms_row_to_bf16(const float* xrow, const float* g, bf16* orow, int lane) {
    const f32x4* xr = (const f32x4*)xrow + lane;
    f32x4 v[4]; float s = 0.f;
#pragma unroll
    for (int j = 0; j < 4; ++j) { v[j] = xr[64 * j]; s += (v[j][0] * v[j][0] + v[j][1] * v[j][1]) + (v[j][2] * v[j][2] + v[j][3] * v[j][3]); }
    const float rstd = rsqrtf(wave_sum(s) * (1.f / DM) + EPS);
    unsigned long long* o8 = (unsigned long long*)orow + lane;
#pragma unroll
    for (int j = 0; j < 4; ++j) { const f32x4 gg = ((const f32x4*)g)[lane + 64 * j];
        o8[64 * j] = (unsigned long long)cvtpk(v[j][0] * rstd * gg[0], v[j][1] * rstd * gg[1]) | ((unsigned long long)cvtpk(v[j][2] * rstd * gg[2], v[j][3] * rstd * gg[3]) << 32); }
}
__device__ __forceinline__ void p0_prologue(Frame& F, const Args& a, const int pm = 0) {
    unsigned char* ws = a.ws; const int tid = tid_now(F.wave), lane = tid & 63;
    LAS unsigned char* scr = F.lds + RING_OFF + F.wave * 8448;
    const int gw = F.vcu * NWAVES + F.wave, NGW = F.G * NWAVES;
    constexpr int I_IN = 16 * 56, I_OUT = 256, I_PG = 256, I_PP = 4 * 16, I_UG = 16 * 32, I_DN = 256;
    constexpr int NITEMS = I_IN + I_OUT + I_PG + I_PP + NE * I_UG + NE * I_DN;
    if (gw < NITEMS) {
        int it = gw; P0D d0 = p0_decode(a, ws, it, lane), d1 = d0; f32x4 va[16], vb[16]; p0_load(d0, va);
        for (;;) {
            const int it1 = it + NGW; const bool h1 = it1 < NITEMS;
            if (h1) { d1 = p0_decode(a, ws, it1, lane); p0_load(d1, vb); }
            p0_finish(d0, va, scr, lane, pm);
            if (!h1) break;
            const int it2 = it1 + NGW; const bool h2 = it2 < NITEMS;
            if (h2) { d0 = p0_decode(a, ws, it2, lane); p0_load(d0, va); }
            p0_finish(d1, vb, scr, lane, pm);
            if (!h2) break;
            it = it2;
        }
    }
    if (pm != 0) return;
    { v4u* tz = (v4u*)(ws + WS_TOKLIST); const v4u z4 = {0u, 0u, 0u, 0u}; for (int i = gw * 64 + lane; i < NE * T / 4; i += NGW * 64) tz[i] = z4; }
    if (blockIdx.x == 0 && tid < 256) { const int t = tid; const float* srcs = (t < 64) ? a.sbq : (t < 128) ? a.sbk : (t < 192) ? a.rq : a.rk; ((float*)(ws + WS_GAINS))[t] = srcs[t & 63]; }
    {
        f32x4 gg[4];
#pragma unroll
        for (int j = 0; j < 4; ++j) gg[j] = ((const f32x4*)a.g_mix)[lane + 64 * j];
        for (int m0 = 4 * gw; m0 < T; m0 += 4 * NGW) {
            f32x4 v[4][4];
#pragma unroll
            for (int r = 0; r < 4; ++r)
#pragma unroll
                for (int j = 0; j < 4; ++j) v[r][j] = __builtin_nontemporal_load((const f32x4*)(a.x + (size_t)(m0 + r) * DM) + lane + 64 * j);
#pragma unroll
            for (int r = 0; r < 4; ++r) {
                float ss = 0.f;
#pragma unroll
                for (int j = 0; j < 4; ++j) ss += (v[r][j][0] * v[r][j][0] + v[r][j][1] * v[r][j][1]) + (v[r][j][2] * v[r][j][2] + v[r][j][3] * v[r][j][3]);
                const float rstd = rsqrtf(wave_sum(ss) * (1.f / DM) + EPS);
                unsigned long long* o8 = (unsigned long long*)((bf16*)(ws + WS_XN) + (size_t)(m0 + r) * DM) + lane;
#pragma unroll
                for (int j = 0; j < 4; ++j) o8[64 * j] = (unsigned long long)cvtpk(v[r][j][0] * rstd * gg[j][0], v[r][j][1] * rstd * gg[j][1]) | ((unsigned long long)cvtpk(v[r][j][2] * rstd * gg[j][2], v[r][j][3] * rstd * gg[j][3]) << 32);
            }
        }
    }
    { const int gt = gw * 64 + lane, NGT = NGW * 64;
      for (int i0 = gt; i0 < T * PLE / 8; i0 += 4 * NGT) {
          f32x4 a0[4], a1[4];
#pragma unroll
          for (int q = 0; q < 4; ++q) { const int i = i0 + q * NGT; if (i < T * PLE / 8) { a0[q] = __builtin_nontemporal_load((const f32x4*)a.p + 2 * i); a1[q] = __builtin_nontemporal_load((const f32x4*)a.p + 2 * i + 1); } }
#pragma unroll
          for (int q = 0; q < 4; ++q) { const int i = i0 + q * NGT; if (i < T * PLE / 8) { v4u o; o.x = cvtpk(a0[q][0], a0[q][1]); o.y = cvtpk(a0[q][2], a0[q][3]); o.z = cvtpk(a1[q][0], a1[q][1]); o.w = cvtpk(a1[q][2], a1[q][3]); ((v4u*)(ws + WS_PB))[i] = o; } }
      }
      for (int i = gt; i < NE * DM; i += NGT) { const int e = i >> 10, k = i & (DM - 1); const float wv = a.w_r[(size_t)k * NE + e] * a.g_ffn[k];
          const unsigned hi = cvtpk(wv, 0.f) & 0xffffu; const unsigned lo = cvtpk(wv - __uint_as_float(hi << 16), 0.f) & 0xffffu;
          ((bf16*)(ws + WS_WRT))[i] = (bf16)hi; ((bf16*)(ws + WS_WRT))[NE * DM + i] = (bf16)lo; }
      float* rc = (float*)(ws + WS_ROPEC); float* rs = (float*)(ws + WS_ROPES);
      for (int i = gt; i < T * 32; i += NGT) { const int row = i >> 5, f = i & 31;
          const float inv_freq = exp2f(-(float)f * (13.287712379549449f / 32.0f));   const float ang = (float)a.positions[row] * inv_freq;
          float sn, cs; sincosf(ang, &sn, &cs); rc[i] = cs; rs[i] = sn; } }
}

namespace att {
typedef short bf16x8 __attribute__((ext_vector_type(8)));
typedef short s16x4 __attribute__((ext_vector_type(4)));
typedef float f32x16 __attribute__((ext_vector_type(16)));
typedef short v4i16_t __attribute__((ext_vector_type(4)));
constexpr int LK = 0, LV = 24576, LFLAG = 49152;
__device__ __forceinline__ s16x4 vtr(LAS const unsigned char* p) { return __builtin_bit_cast(s16x4, __builtin_amdgcn_ds_read_tr16_b64_v4i16((LAS v4i16_t*)p)); }
__device__ __forceinline__ int crow(int r, int hi) { return (r & 3) + 8 * (r >> 2) + 4 * hi; }
struct AttnArgs { const bf16* hm; const bf16* rg; bf16* Y; const float* gn_g; const float* gn_b; };

template <int MODE, int ABL = 0> __device__ __forceinline__ void attn_unit(LAS unsigned char* lds, const AttnArgs& A, int b, int h, int qb, const int wave_id) {
    int tid_ = wave_id * 64 + lane_id_hw(); asm volatile("" : "+v"(tid_));
    const int tid = tid_, lane = tid & 63, r32 = lane & 31, hh = lane >> 5;
    const int w = __builtin_amdgcn_readfirstlane(tid >> 6);
    const int q0 = qb * 256, qw = q0 + 32 * w;
    const size_t TS = (size_t)T * 512;
    const size_t hoff = (size_t)(b * 8 + h) * SEQ * 64;
    const bf16* Qp = A.hm + (MODE == 0 ? 0 : 3) * TS + hoff;
    const bf16* Kp = A.hm + (MODE == 0 ? 1 : 4) * TS + hoff;
    const bf16* Vp = A.hm + (MODE == 0 ? 2 : 5) * TS + hoff;
    bf16x8 qf[4];
#pragma unroll
    for (int ds = 0; ds < 4; ++ds) qf[ds] = *(const bf16x8*)(Qp + (size_t)(qw + r32) * 64 + 16 * ds + 8 * hh);
    f32x16 o[2];
#pragma unroll
    for (int r = 0; r < 16; ++r) { o[0][r] = 0.f; o[1][r] = 0.f; }
    float carry = 1.0f;
    const int jmax = (q0 + 255) >> 6, jd = (qw + 31) >> 6;
    const float lg2g = __log2f(1.0f - __builtin_amdgcn_exp2f(-5.0f - (float)h));
    const int krow = 8 * w + (lane >> 3);
    const bf16* Kt = Kp + (size_t)krow * 64 + (((lane & 7) ^ ((krow >> 1) & 7)) << 3); const bf16* Vt = Vp + (size_t)w * 512 + lane * 8;
    volatile LAS unsigned* flags = (volatile LAS unsigned*)(lds + LFLAG);
#define ATT_DMA(t, so) do { __builtin_amdgcn_global_load_lds((const unsigned*)(Kt + (size_t)(t) * 4096), (LAS unsigned*)(lds + LK + (so) + w * 1024), 16, 0, 0); \
                            __builtin_amdgcn_global_load_lds((const unsigned*)(Vt + (size_t)(t) * 4096), (LAS unsigned*)(lds + LV + (so) + w * 1024), 16, 0, 0); } while (0)
    ATT_DMA(jmax, 0);
    if (jmax >= 1) { ATT_DMA(jmax - 1, 8192); asm volatile("s_waitcnt vmcnt(2)\n\ts_barrier" ::: "memory"); }
    else asm volatile("s_waitcnt vmcnt(0)\n\ts_barrier" ::: "memory");
    bool finished = false;
    int so_cur = 0, so_new = 16384;
    for (int j = jmax; j >= 0; --j) {
        const int cur = j & 1;
        if (j >= 2 && ABL != 4) ATT_DMA(j - 2, so_new);
        if (j <= jd && !finished && ABL == 0) {
            LAS const unsigned char* Kb = lds + LK + so_cur;
            LAS const unsigned char* Vb = lds + LV + so_cur;
            f32x16 p[2];
#pragma unroll
            for (int r = 0; r < 16; ++r) { p[0][r] = 0.f; p[1][r] = 0.f; }
            bf16x8 kf[4][2];
            const int ksw = (r32 >> 1) & 7;
#pragma unroll
            for (int ds = 0; ds < 4; ++ds) { kf[ds][0] = *(LAS const bf16x8*)(Kb + r32 * 128 + (((2 * ds + hh) ^ ksw) << 4)); kf[ds][1] = *(LAS const bf16x8*)(Kb + 4096 + r32 * 128 + (((2 * ds + hh) ^ ksw) << 4)); }
#pragma unroll
            for (int ds = 0; ds < 4; ++ds) {
                p[0] = __builtin_amdgcn_mfma_f32_32x32x16_bf16(kf[ds][0], qf[ds], p[0], 0, 0, 0);
                p[1] = __builtin_amdgcn_mfma_f32_32x32x16_bf16(kf[ds][1], qf[ds], p[1], 0, 0, 0);
            }
            const bool diag = (j == jd);
            const int qg = qw + r32, kv0 = 64 * j + 4 * hh;
            if (MODE == 0) {
                float om[2][16];
#pragma unroll
                for (int hf = 0; hf < 2; ++hf)
#pragma unroll
                    for (int r = 0; r < 16; ++r) {
                        const float Z = p[hf][r];
                        const float a = __builtin_amdgcn_exp2f(-__builtin_fabsf(Z));
                        const float rc = __builtin_amdgcn_rcpf(1.0f + a), ar = a * rc;
                        const bool pos = Z >= 0.f;
                        p[hf][r] = pos ? rc : ar;
                        om[hf][r] = pos ? ar : rc;
                    }
                if (diag) {
#pragma unroll
                    for (int hf = 0; hf < 2; ++hf)
#pragma unroll
                        for (int r = 0; r < 16; ++r) { const bool valid = kv0 + 32 * hf + (r & 3) + 8 * (r >> 2) < qg; p[hf][r] = valid ? p[hf][r] : 0.f; om[hf][r] = valid ? om[hf][r] : 1.0f; }
                }
                float gs[8], ot[8];
#pragma unroll
                for (int m = 0; m < 8; ++m) { const int hf = m >> 2, g = m & 3; gs[m] = (om[hf][4 * g] * om[hf][4 * g + 1]) * (om[hf][4 * g + 2] * om[hf][4 * g + 3]); ot[m] = __shfl_xor(gs[m], 32); }
                float ps[8];
                ps[7] = 1.0f;
#pragma unroll
                for (int m = 6; m >= 0; --m) ps[m] = ps[m + 1] * (gs[m + 1] * ot[m + 1]);
                const float total = ps[0] * (gs[0] * ot[0]);
#pragma unroll
                for (int m = 0; m < 8; ++m) {
                    const int hf = m >> 2, g = m & 3;
                    float tail = carry * (hh ? ps[m] : ps[m] * ot[m]);
#pragma unroll
                    for (int i = 3; i >= 0; --i) { const int r = 4 * g + i; const float o1 = om[hf][r]; p[hf][r] *= tail; tail *= o1; }
                }
                carry *= total;
                finished = __all(carry < 1.0e-37f);
            } else {
                const float ct = __builtin_amdgcn_exp2f(lg2g * (float)(qw - 64 * j));
#pragma unroll
                for (int hf = 0; hf < 2; ++hf)
#pragma unroll
                    for (int r = 0; r < 16; ++r) p[hf][r] *= ct;
                if (diag) {
#pragma unroll
                    for (int hf = 0; hf < 2; ++hf)
#pragma unroll
                        for (int r = 0; r < 16; ++r) { const bool valid = kv0 + 32 * hf + (r & 3) + 8 * (r >> 2) <= qg; p[hf][r] = valid ? p[hf][r] : 0.f; }
                }
            }
            {
                const unsigned vbase = (unsigned)(uintptr_t)(Vb + (4 * hh + ((lane & 15) >> 2)) * 128 + (16 * ((lane >> 4) & 1) + 4 * (lane & 3)) * 2);
                s16x4 vl[2][2][2], vh[2][2][2];
#pragma unroll
                for (int hf = 0; hf < 2; ++hf)
#pragma unroll
                    for (int s = 0; s < 2; ++s)
#pragma unroll
                        for (int d0 = 0; d0 < 2; ++d0) {
                            asm volatile("ds_read_b64_tr_b16 %0, %1 offset:%c2" : "=&v"(vl[hf][s][d0]) : "v"(vbase), "i"(hf * 4096 + s * 2048 + d0 * 64) : "memory");
                            asm volatile("ds_read_b64_tr_b16 %0, %1 offset:%c2" : "=&v"(vh[hf][s][d0]) : "v"(vbase), "i"(hf * 4096 + s * 2048 + d0 * 64 + 1024) : "memory");
                        }
                bf16x8 wfr[2][2];
#pragma unroll
                for (int hf = 0; hf < 2; ++hf)
#pragma unroll
                    for (int s = 0; s < 2; ++s) {
                        u32x4_t wq;
                        wq.x = pg8::cvt_pk_bf16(p[hf][8 * s + 0], p[hf][8 * s + 1]); wq.y = pg8::cvt_pk_bf16(p[hf][8 * s + 2], p[hf][8 * s + 3]);
                        wq.z = pg8::cvt_pk_bf16(p[hf][8 * s + 4], p[hf][8 * s + 5]); wq.w = pg8::cvt_pk_bf16(p[hf][8 * s + 6], p[hf][8 * s + 7]);
                        wfr[hf][s] = __builtin_bit_cast(bf16x8, wq);
                    }
                asm volatile("s_waitcnt lgkmcnt(0)" ::: "memory"); __builtin_amdgcn_sched_barrier(0);
#pragma unroll
                for (int hf = 0; hf < 2; ++hf)
#pragma unroll
                    for (int s = 0; s < 2; ++s)
#pragma unroll
                        for (int d0 = 0; d0 < 2; ++d0) {
                            const s16x4 lo = vl[hf][s][d0], hi = vh[hf][s][d0];
                            const bf16x8 vf = (bf16x8){lo[0], lo[1], lo[2], lo[3], hi[0], hi[1], hi[2], hi[3]};
                            o[d0] = __builtin_amdgcn_mfma_f32_32x32x16_bf16(vf, wfr[hf][s], o[d0], 0, 0, 0);
                        }
            }
        }
        if (MODE == 0) { if (lane == 0) flags[cur * 8 + w] = finished ? 1u : 0u; }
        if (j >= 2) asm volatile("s_waitcnt vmcnt(2) lgkmcnt(0)\n\ts_barrier" ::: "memory"); else asm volatile("s_waitcnt vmcnt(0) lgkmcnt(0)\n\ts_barrier" ::: "memory");
        so_cur = (so_cur == 16384) ? 0 : so_cur + 8192; so_new = (so_new == 16384) ? 0 : so_new + 8192;
        if (MODE == 0) {
            unsigned all = 1u;
#pragma unroll
            for (int i = 0; i < 8; ++i) all &= flags[cur * 8 + i];
            if (all) break;
        }
    }
    asm volatile("s_waitcnt vmcnt(0)\n\ts_barrier" ::: "memory");
#undef ATT_DMA
    const int row = b * SEQ + qw + r32;
    if (MODE == 0) {
        bf16* yp = A.Y + (size_t)row * DM + h * 64 + 4 * hh;
#pragma unroll
        for (int d0 = 0; d0 < 2; ++d0)
#pragma unroll
            for (int g = 0; g < 4; ++g) { u32x2_t v; v.x = pg8::cvt_pk_bf16(o[d0][4 * g], o[d0][4 * g + 1]); v.y = pg8::cvt_pk_bf16(o[d0][4 * g + 2], o[d0][4 * g + 3]); *(u32x2_t*)(yp + 32 * d0 + 8 * g) = v; }
    } else {
        float s1 = 0.f;
#pragma unroll
        for (int r = 0; r < 16; ++r) s1 += o[0][r] + o[1][r];
        s1 += __shfl_xor(s1, 32);
        const float mu = s1 * (1.0f / 64.0f);
        float s2 = 0.f;
#pragma unroll
        for (int r = 0; r < 16; ++r) { const float a0 = o[0][r] - mu, a1 = o[1][r] - mu; s2 += a0 * a0 + a1 * a1; }
        s2 += __shfl_xor(s2, 32);
        const float rstd = rsqrtf(s2 * (1.0f / 64.0f) + EPS);
        bf16* yp = A.Y + (size_t)row * DM + 512 + h * 64 + 4 * hh;
        const bf16* gp = A.rg + (size_t)row * 512 + h * 64 + 4 * hh;
        const float* gg = A.gn_g + h * 64 + 4 * hh; const float* gb = A.gn_b + h * 64 + 4 * hh;
#pragma unroll
        for (int d0 = 0; d0 < 2; ++d0)
#pragma unroll
            for (int g = 0; g < 4; ++g) {
                const f32x4 gn = *(const f32x4*)(gg + 32 * d0 + 8 * g), bs = *(const f32x4*)(gb + 32 * d0 + 8 * g);
                const u32x2_t gr = *(const u32x2_t*)(gp + 32 * d0 + 8 * g);
                float gate[4] = {__uint_as_float(gr.x << 16), __uint_as_float(gr.x & 0xffff0000u), __uint_as_float(gr.y << 16), __uint_as_float(gr.y & 0xffff0000u)};
                float ov[4];
#pragma unroll
                for (int i = 0; i < 4; ++i) { const float yn = (o[d0][4 * g + i] - mu) * rstd * gn[i] + bs[i]; const float sg = gate[i] / (1.0f + __expf(-gate[i])); ov[i] = yn * sg; }
                u32x2_t v; v.x = pg8::cvt_pk_bf16(ov[0], ov[1]); v.y = pg8::cvt_pk_bf16(ov[2], ov[3]); *(u32x2_t*)(yp + 32 * d0 + 8 * g) = v;
            }
    }
}
__device__ __forceinline__ void attn_phase(LAS unsigned char* lds, const AttnArgs& A, int vcu, int dup, bf16* dummyY, const int wave_id) {
    const int g = vcu >> 5, local = vcu & 31;
    if (dup == 24 || dup == 25) { AttnArgs A2 = A; A2.Y = dummyY;
#pragma unroll 1
        for (int u = 0; u < 2; ++u) { const int bh = 8 * g + 4 * (u & 1) + (local >> 3), qb = (u & 1) ? 7 - (local & 7) : (local & 7); if (dup == 24) attn_unit<1, 3>(lds, A2, bh >> 3, bh & 7, qb, wave_id); else attn_unit<1, 4>(lds, A2, bh >> 3, bh & 7, qb, wave_id); } }
#pragma unroll 1
    for (int u = 0; u < ((dup == 20) ? 4 : 2); ++u) { const int bh = 8 * g + 4 * (u & 1) + (local >> 3), qb = (u & 1) ? 7 - (local & 7) : (local & 7); attn_unit<1>(lds, A, bh >> 3, bh & 7, qb, wave_id); }
#pragma unroll 1
    for (int u = 0; u < ((dup == 21) ? 4 : 2); ++u) { const int bh = 8 * g + 4 * (u & 1) + (local >> 3), qb = (u & 1) ? 7 - (local & 7) : (local & 7); attn_unit<0>(lds, A, bh >> 3, bh & 7, qb, wave_id); }
}
}

constexpr int CW_GCNT = 32768;
constexpr int LR_LCNT = LDSCTL_OFF + 1024, LR_GBASE = LDSCTL_OFF + 1152;
constexpr int LT_POFF = LDSCTL_OFF + 2048, LT_NT = LDSCTL_OFF + 2176, LT_TILE_E = LDSCTL_OFF + 2304, LT_FIRST = LDSCTL_OFF + 3712;
struct RouteBufs { int* tok_e; int* tok_slot; float* tok_gate; float* rstd; int* toklist; };
__device__ __forceinline__ RouteBufs route_bufs(unsigned char* ws) { RouteBufs r; r.tok_e = (int*)(ws + WS_ROUTE); r.tok_slot = r.tok_e + T * 4; r.tok_gate = (float*)(r.tok_slot + T * 4); r.rstd = (float*)(ws + WS_ROUTE + 1 * MiB); r.toklist = (int*)(ws + WS_TOKLIST); return r; }
typedef float f32x2v __attribute__((ext_vector_type(2)));
__device__ __forceinline__ unsigned opq_mask(bool c) { unsigned m = c ? 0xffffffffu : 0u; asm volatile("" : "+v"(m)); return m; }
__device__ __forceinline__ float blendf(unsigned m, float a, float b) { return __uint_as_float((__float_as_uint(a) & m) | (__float_as_uint(b) & ~m)); }
__device__ __forceinline__ int blendi(unsigned m, int a, int b) { return (int)(((unsigned)a & m) | ((unsigned)b & ~m)); }

#define SW2(c, a, b) { const float ta_ = (c) ? (b) : (a), tb_ = (c) ? (a) : (b); a = ta_; b = tb_; }
#define SW2I(c, a, b) { const int ta_ = (c) ? (b) : (a), tb_ = (c) ? (a) : (b); a = ta_; b = tb_; }
#define TOP4_INSERT(x, e) { const float x_ = (x); const int e_ = (e); const bool c3_ = (x_ > v3) || (x_ == v3 && e_ < i3); v3 = c3_ ? x_ : v3; i3 = c3_ ? e_ : i3; \
    const bool c2_ = (v3 > v2) || (v3 == v2 && i3 < i2); SW2(c2_, v2, v3) SW2I(c2_, i2, i3) const bool c1_ = (v2 > v1) || (v2 == v1 && i2 < i1); SW2(c1_, v1, v2) SW2I(c1_, i1, i2) \
    const bool c0_ = (v1 > v0) || (v1 == v0 && i1 < i0); SW2(c0_, v0, v1) SW2I(c0_, i0, i1) }
__device__ __forceinline__ void router_phase(Frame& F, const Args& a, const bool dry = false) {
    unsigned char* ws = a.ws; const int tid = tid_now(F.wave);
    LAS unsigned char* lds = F.lds;
    const int lane = tid & 63, r32 = lane & 31, hh = lane >> 5, w = F.wave, rg = w >> 2, kq = w & 3;
    volatile LAS unsigned* lcnt = (volatile LAS unsigned*)(lds + LR_LCNT);
    volatile LAS unsigned* gbase = (volatile LAS unsigned*)(lds + LR_GBASE);
    if (tid < 32) lcnt[tid] = 0u;
    const RouteBufs R = route_bufs(ws);
    const int row = F.vcu * 64 + 32 * rg + r32;
    const bf16* xr = (const bf16*)(ws + WS_X1) + (size_t)row * DM + 256 * kq + 8 * hh;
    const bf16* wt = (const bf16*)(ws + WS_WRT) + (size_t)r32 * DM + 256 * kq + 8 * hh;
    unsigned char* hp = (unsigned char*)(ws + (dry ? WS_H : WS_XN)) + (size_t)row * DM + 256 * kq + 8 * hh;
    att::f32x16 D;
#pragma unroll
    for (int r = 0; r < 16; ++r) D[r] = 0.f;
    float ss = 0.f;
#pragma unroll 8
    for (int ks = 0; ks < 16; ++ks) {
        const u32x4_t xh = *(const u32x4_t*)(xr + 16 * ks);
        const f32x4 v0 = (f32x4){__uint_as_float(xh.x << 16), __uint_as_float(xh.x & 0xffff0000u), __uint_as_float(xh.y << 16), __uint_as_float(xh.y & 0xffff0000u)};
        const f32x4 v1 = (f32x4){__uint_as_float(xh.z << 16), __uint_as_float(xh.z & 0xffff0000u), __uint_as_float(xh.w << 16), __uint_as_float(xh.w & 0xffff0000u)};
        ss += ((v0[0] * v0[0] + v0[1] * v0[1]) + (v0[2] * v0[2] + v0[3] * v0[3])) + ((v1[0] * v1[0] + v1[1] * v1[1]) + (v1[2] * v1[2] + v1[3] * v1[3]));
        u32x2_t h8; h8.x = pk4_fp8(v0[0], v0[1], v0[2], v0[3]); h8.y = pk4_fp8(v1[0], v1[1], v1[2], v1[3]); *(u32x2_t*)(hp + 16 * ks) = h8;
        const att::bf16x8 whi = *(const att::bf16x8*)(wt + 16 * ks), wlo = *(const att::bf16x8*)(wt + 32 * DM + 16 * ks);
        const att::bf16x8 bxh = __builtin_bit_cast(att::bf16x8, xh);
        D = __builtin_amdgcn_mfma_f32_32x32x16_bf16(whi, bxh, D, 0, 0, 0);
        D = __builtin_amdgcn_mfma_f32_32x32x16_bf16(wlo, bxh, D, 0, 0, 0);
    }
    { LAS f32x4* dp = (LAS f32x4*)(lds + (w * 64 + lane) * 64);
#pragma unroll
      for (int q = 0; q < 4; ++q) dp[q] = (f32x4){D[4 * q], D[4 * q + 1], D[4 * q + 2], D[4 * q + 3]};
      *(LAS float*)(lds + 32768 + (w * 64 + lane) * 4) = ss; }
    __syncthreads();
    int my_e0 = 0, my_e1 = 0, rk0 = 0, rk1 = 0; float my_g0 = 0.f, my_g1 = 0.f;
    if (kq == 0) {
#pragma unroll
        for (int o = 1; o < 4; ++o) { LAS const f32x4* dp = (LAS const f32x4*)(lds + ((w + o) * 64 + lane) * 64);
#pragma unroll
            for (int q = 0; q < 4; ++q) { const f32x4 t = dp[q]; D[4 * q] += t[0]; D[4 * q + 1] += t[1]; D[4 * q + 2] += t[2]; D[4 * q + 3] += t[3]; }
            ss += *(LAS const float*)(lds + 32768 + ((w + o) * 64 + lane) * 4); }
        ss += __shfl_xor(ss, 32);
        const float rstd = rsqrtf(ss * (1.f / DM) + EPS);
        if (hh == 0) R.rstd[row] = rstd;
        float l[16];
#pragma unroll
        for (int r = 0; r < 16; ++r) l[r] = D[r] * rstd + a.b_r[(r & 3) + 8 * (r >> 2) + 4 * hh];
        float c[8]; int ci[8];
#pragma unroll
        for (int k = 0; k < 4; ++k) {
            float bv = -INFINITY; int bi = 99;
#pragma unroll
            for (int r = 0; r < 16; ++r) { const int e = (r & 3) + 8 * (r >> 2) + 4 * hh; const bool bt = l[r] > bv; bv = bt ? l[r] : bv; bi = bt ? e : bi; }
            c[k] = bv; ci[k] = bi;
#pragma unroll
            for (int r = 0; r < 16; ++r) { const int e = (r & 3) + 8 * (r >> 2) + 4 * hh; l[r] = (e == bi) ? -INFINITY : l[r]; }
        }
#pragma unroll
        for (int k = 0; k < 4; ++k) { c[4 + k] = __shfl_xor(c[k], 32); ci[4 + k] = __shfl_xor(ci[k], 32); }
        float tv[4]; int ti[4];
#pragma unroll
        for (int k = 0; k < 4; ++k) {
            float bv = -INFINITY; int bi = 99;
#pragma unroll
            for (int j = 0; j < 8; ++j) { const bool bt = (c[j] > bv) || (c[j] == bv && ci[j] < bi); bv = bt ? c[j] : bv; bi = bt ? ci[j] : bi; }
            tv[k] = bv; ti[k] = bi;
#pragma unroll
            for (int j = 0; j < 8; ++j) c[j] = (ci[j] == bi) ? -INFINITY : c[j];
        }
        const float v0 = tv[0], v1 = tv[1], v2 = tv[2], v3 = tv[3]; const int i0 = ti[0], i1 = ti[1], i2 = ti[2], i3 = ti[3];
        const float e1 = __expf(v1 - v0), e2 = __expf(v2 - v0), e3 = __expf(v3 - v0), inv = 1.0f / (1.0f + e1 + e2 + e3);
        my_e0 = hh ? i2 : i0; my_e1 = hh ? i3 : i1; my_g0 = (hh ? e2 : 1.0f) * inv; my_g1 = (hh ? e3 : e1) * inv;
        rk0 = (int)__hip_atomic_fetch_add((LAS unsigned*)(lds + LR_LCNT) + my_e0, 1u, __ATOMIC_RELAXED, __HIP_MEMORY_SCOPE_WORKGROUP);
        rk1 = (int)__hip_atomic_fetch_add((LAS unsigned*)(lds + LR_LCNT) + my_e1, 1u, __ATOMIC_RELAXED, __HIP_MEMORY_SCOPE_WORKGROUP);
    }
    __syncthreads();
    if (tid < 32) gbase[tid] = __hip_atomic_fetch_add((unsigned*)(F.ctl + CW_GCNT + (dry ? 4096 : 0)) + 64 * tid, lcnt[tid], __ATOMIC_RELAXED, __HIP_MEMORY_SCOPE_AGENT);
    __syncthreads();
    if (kq == 0) {
        const int k0 = 2 * hh;
        const int s0 = (int)gbase[my_e0] + rk0, s1 = (int)gbase[my_e1] + rk1;
        R.tok_e[row * 4 + k0] = my_e0; R.tok_slot[row * 4 + k0] = s0; R.tok_gate[row * 4 + k0] = my_g0; R.toklist[(size_t)my_e0 * T + s0] = row;
        R.tok_e[row * 4 + k0 + 1] = my_e1; R.tok_slot[row * 4 + k0 + 1] = s1; R.tok_gate[row * 4 + k0 + 1] = my_g1; R.toklist[(size_t)my_e1 * T + s1] = row;
    }
}
#undef SW2
#undef SW2I
#undef TOP4_INSERT

__device__ __forceinline__ void build_tables(Frame& F) {
    LAS int* poff = (LAS int*)(F.lds + LT_POFF); LAS int* ntp = (LAS int*)(F.lds + LT_NT); LAS int* tile_e = (LAS int*)(F.lds + LT_TILE_E);
    LAS int* cnts = (LAS int*)(F.lds + LR_LCNT); const int tid = tid_now(F.wave);
    if (tid < NE) cnts[tid] = (int)__hip_atomic_load((unsigned*)(F.ctl + CW_GCNT) + 64 * tid, __ATOMIC_RELAXED, __HIP_MEMORY_SCOPE_AGENT);
    __syncthreads();
    if (tid == 0) {
        int t = 0;
        for (int e = 0; e < NE; ++e) { const int c = cnts[e]; const int nt = (c + 255) >> 8; poff[e] = t * 256; ((LAS int*)(F.lds + LT_FIRST))[e] = t; for (int i = 0; i < nt; ++i) tile_e[t + i] = e; t += nt; }
        *ntp = t;
    }
    __syncthreads();
}
__device__ __forceinline__ void combine_phase(Frame& F, const Args& a, const bool dry = false) {
    unsigned char* ws = a.ws; const RouteBufs R = route_bufs(ws);
    LAS const int* poff = (LAS const int*)(F.lds + LT_POFF);
    const int gw = F.vcu * NWAVES + F.wave, NGW = F.G * NWAVES, lane = tid_now(F.wave) & 63;
    for (int m0 = 2 * gw; m0 < T; m0 += 2 * NGW) {
        f32x4 v[2][2][2]; u32x2_t y[2][4][2]; float gt[2][4];
#pragma unroll
        for (int rr = 0; rr < 2; ++rr) { const int m = m0 + rr;
#pragma unroll
            for (int i = 0; i < 2; ++i) { { const v4u xq = __builtin_nontemporal_load((const v4u*)((const bf16*)(ws + WS_X1) + (size_t)m * DM + 8 * lane + 512 * i)); v[rr][i][0] = (f32x4){__uint_as_float(xq[0] << 16), __uint_as_float(xq[0] & 0xffff0000u), __uint_as_float(xq[1] << 16), __uint_as_float(xq[1] & 0xffff0000u)}; v[rr][i][1] = (f32x4){__uint_as_float(xq[2] << 16), __uint_as_float(xq[2] & 0xffff0000u), __uint_as_float(xq[3] << 16), __uint_as_float(xq[3] & 0xffff0000u)}; } }
#pragma unroll
            for (int k = 0; k < 4; ++k) { const int e = R.tok_e[m * 4 + k], slot = R.tok_slot[m * 4 + k]; gt[rr][k] = R.tok_gate[m * 4 + k];
                const unsigned char* yr = (const unsigned char*)(ws + WS_YS) + (size_t)(poff[e] + slot) * DM + 8 * lane;
                y[rr][k][0] = __builtin_nontemporal_load((const u32x2_t*)yr); y[rr][k][1] = __builtin_nontemporal_load((const u32x2_t*)(yr + 512)); } }
#pragma unroll
        for (int rr = 0; rr < 2; ++rr) { const int m = m0 + rr;
#pragma unroll
            for (int k = 0; k < 4; ++k)
#pragma unroll
                for (int i = 0; i < 2; ++i) { const u32x2_t yy = y[rr][k][i]; const float g = gt[rr][k];
                    const f32x2v a0 = __builtin_amdgcn_cvt_pk_f32_fp8((int)yy.x, false), a1 = __builtin_amdgcn_cvt_pk_f32_fp8((int)yy.x, true), a2 = __builtin_amdgcn_cvt_pk_f32_fp8((int)yy.y, false), a3 = __builtin_amdgcn_cvt_pk_f32_fp8((int)yy.y, true);
                    v[rr][i][0][0] += g * a0[0]; v[rr][i][0][1] += g * a0[1]; v[rr][i][0][2] += g * a1[0]; v[rr][i][0][3] += g * a1[1];
                    v[rr][i][1][0] += g * a2[0]; v[rr][i][1][1] += g * a2[1]; v[rr][i][1][2] += g * a3[0]; v[rr][i][1][3] += g * a3[1]; }
            float ss = 0.f;
#pragma unroll
            for (int i = 0; i < 2; ++i)
#pragma unroll
                for (int q = 0; q < 2; ++q) { const f32x4 t = v[rr][i][q]; ss += (t[0] * t[0] + t[1] * t[1]) + (t[2] * t[2] + t[3] * t[3]); }
            const float rstd = rsqrtf(wave_sum(ss) * (1.f / DM) + EPS);
            unsigned char* np = (unsigned char*)(ws + (dry ? WS_H : WS_XN)) + (size_t)m * DM + 8 * lane; bf16* ow = (bf16*)(ws + (dry ? WS_XS : WS_Y));
#pragma unroll
            for (int i = 0; i < 2; ++i) { { v4u xb; xb[0] = cvtpk(v[rr][i][0][0], v[rr][i][0][1]); xb[1] = cvtpk(v[rr][i][0][2], v[rr][i][0][3]); xb[2] = cvtpk(v[rr][i][1][0], v[rr][i][1][1]); xb[3] = cvtpk(v[rr][i][1][2], v[rr][i][1][3]); *(v4u*)(ow + (size_t)m * DM + 8 * lane + 512 * i) = xb; }
                const f32x4 g0 = *(const f32x4*)(a.g_ple + 8 * lane + 512 * i), g1 = *(const f32x4*)(a.g_ple + 8 * lane + 512 * i + 4);
                u32x2_t o; o.x = pk4_fp8(v[rr][i][0][0] * rstd * g0[0], v[rr][i][0][1] * rstd * g0[1], v[rr][i][0][2] * rstd * g0[2], v[rr][i][0][3] * rstd * g0[3]);
                o.y = pk4_fp8(v[rr][i][1][0] * rstd * g1[0], v[rr][i][1][1] * rstd * g1[1], v[rr][i][1][2] * rstd * g1[2], v[rr][i][1][3] * rstd * g1[3]);
                *(u32x2_t*)(np + 512 * i) = o; } }
    }
}

__global__ void __launch_bounds__(NWAVES * 64, 2) mega_fwd(Args args) {
    extern __shared__ __attribute__((aligned(16))) unsigned char lds[];
    Frame F;
    F.lds = (LAS unsigned char*)lds;
    F.MISC = (volatile LAS unsigned*)(F.lds + MISC_OFF);
    F.wave = __builtin_amdgcn_readfirstlane(threadIdx.x >> 6);
    F.G = gridDim.x; { const int bx = blockIdx.x; F.vcu = (F.G % 8 == 0) ? (bx % 8) * (F.G / 8) + bx / 8 : bx; }
    unsigned char* ws = args.ws;
    F.ctl = (gu32*)(ws + WS_CTL);
    for (int u = threadIdx.x; u < (LDS_BYTES - LDSCTL_OFF) / 4; u += NWAVES * 64) ((LAS unsigned*)(F.lds + LDSCTL_OFF))[u] = 0u;
    __syncthreads();
    XcdBarrier bar = xcd_barrier_post((unsigned*)(F.ctl + CW_BAR), F.MISC + 8); bar.wave = F.wave;
    const int lo = args.ph_lo, hi = args.ph_hi;
#define IN(k) (lo <= (k) && (k) < hi)
#define GRID_BAR() xcd_barrier(bar)
#ifndef DUP_PHASE
#define DUP_PHASE -1
#endif
#define REP(k) for (int rep_ = 0; rep_ < ((DUP_PHASE) == (k) ? 2 : 1); ++rep_)

    if (IN(0)) { if (DUP_PHASE == 40) { p0_prologue(F, args, 1); GRID_BAR(); } if (DUP_PHASE == 41) { p0_prologue(F, args, 2); GRID_BAR(); } if (DUP_PHASE == 42) { p0_prologue(F, args, 3); GRID_BAR(); } REP(0) { p0_prologue(F, args); GRID_BAR(); } }

    if (IN(1)) REP(1) {
        pg8::Gemm g{(const pg8::bf16_t*)(ws + WS_XN), (const pg8::bf16_t*)(ws + WS_WT_IN), DM, 0};
        pg8::StaticOrder S; S.init(T / 256, DIN / 256, F.G, (int)blockIdx.x);
        pg8::EpiProj E{(pg8::bf16_t*)(ws + WS_HM), (pg8::bf16_t*)(ws + WS_RG), (const float*)(ws + WS_GAINS), (const float*)(ws + WS_ROPEC), (const float*)(ws + WS_ROPES)};
        pg8::gemm_phase<pg8::EpiProj, pg8::StaticOrder, true, true>(F.lds + RING_OFF, g, S, E, F.wave);
        {
            const int G2 = (F.G == 256) ? 128 : F.G, c2 = (F.G == 256) ? (int)blockIdx.x - 128 : (int)blockIdx.x;
            if (c2 >= 0) {
                pg8::Gemm g2{(const pg8::bf16_t*)(ws + WS_PB), (const pg8::bf16_t*)(ws + WS_WT_PP), PLE, 0};
                pg8::StaticOrder S2; S2.init(T / 256, DM / 256, G2, c2);
                pg8::EpiBf16Plain E2{(pg8::bf16_t*)(ws + WS_PJ), DM};
                pg8::gemm_phase<pg8::EpiBf16Plain, pg8::StaticOrder, true, true>(F.lds + RING_OFF, g2, S2, E2, F.wave);
            }
        }
        GRID_BAR();
    }
    if (DUP_PHASE == 51 && IN(1)) {
        pg8::Gemm g{(const pg8::bf16_t*)(ws + WS_XN), (const pg8::bf16_t*)(ws + WS_WT_IN), DM, 0};
        pg8::StaticOrder S; S.init(T / 256, DIN / 256, F.G, (int)blockIdx.x);
        pg8::EpiNull E;
        pg8::gemm_phase<pg8::EpiNull, pg8::StaticOrder, true, true>(F.lds + RING_OFF, g, S, E, F.wave);
        GRID_BAR();
    }
    if (IN(2)) REP(2) {
        if (F.G == 256) {
            const att::AttnArgs AA{(const bf16*)(ws + WS_HM), (const bf16*)(ws + WS_RG), (bf16*)(ws + WS_Y), args.gn_g, args.gn_b};
            att::attn_phase(F.lds + RING_OFF, AA, F.vcu, DUP_PHASE, (bf16*)(ws + WS_XS), F.wave);
        }
        GRID_BAR();
    }
    if (IN(3)) REP(3) {
        pg8::Gemm g{(const pg8::bf16_t*)(ws + WS_Y), (const pg8::bf16_t*)(ws + WS_WT_OUT), DM, 0};
        pg8::StaticOrder S; S.init(T / 256, DM / 256, F.G, (int)blockIdx.x);
        pg8::EpiResid E{args.x, (pg8::bf16_t*)(ws + WS_X1)};
        pg8::gemm_phase<pg8::EpiResid, pg8::StaticOrder, true, true>(F.lds + RING_OFF, g, S, E, F.wave);
        GRID_BAR();
    }
    if (DUP_PHASE == 30 && IN(3)) { GRID_BAR(); GRID_BAR(); GRID_BAR(); GRID_BAR(); }
    if (IN(4)) { if (DUP_PHASE == 4) { if (F.G == 256) router_phase(F, args, true); GRID_BAR(); } if (F.G == 256) router_phase(F, args); GRID_BAR(); }
    if (IN(5) || (lo >= 6 && lo <= 8)) build_tables(F);
    if (IN(6)) REP(6) {
        const int NT = *(LAS const int*)(F.lds + LT_NT);
        pg8::Gemm g{(const pg8::bf16_t*)(ws + WS_XN), (const pg8::bf16_t*)(ws + WS_WT_UG), DM / 2, (size_t)2048 * DM};
        pg8::MoeOrder S; S.init(NT, 8, F.G, (int)blockIdx.x, (LAS const int*)(F.lds + LT_TILE_E), F.wave, 1, args.b_ug, route_bufs(ws).rstd, F.lds + PF_OFF);
        S.toklist = route_bufs(ws).toklist; S.first_tile = (LAS const int*)(F.lds + LT_FIRST); S.tokl = F.lds + TOKL_OFF;
        pg8::EpiMoeUp E{(unsigned char*)(ws + WS_H), F.lds + PF_OFF};
        pg8::gemm_phase<pg8::EpiMoeUp, pg8::MoeOrder, true, true, true, true>(F.lds + RING_OFF, g, S, E, F.wave);
        GRID_BAR();
    }
    if (IN(7)) REP(7) {
        const int NT = *(LAS const int*)(F.lds + LT_NT);
        pg8::Gemm g{(const pg8::bf16_t*)(ws + WS_H), (const pg8::bf16_t*)(ws + WS_WT_DN), DM / 2, (size_t)DM * DM};
        pg8::MoeOrder S; S.init(NT, 4, F.G, (int)blockIdx.x, (LAS const int*)(F.lds + LT_TILE_E), F.wave, 2, args.b_dn, nullptr, F.lds + PF_OFF);
        pg8::EpiMoeDown E{(unsigned char*)(ws + WS_YS), F.lds + PF_OFF};
        pg8::gemm_phase<pg8::EpiMoeDown, pg8::MoeOrder, true, true, true>(F.lds + RING_OFF, g, S, E, F.wave);
        GRID_BAR();
    }
    if (IN(8)) { if (DUP_PHASE == 8) { combine_phase(F, args, true); GRID_BAR(); } combine_phase(F, args); GRID_BAR(); }
    if (IN(9)) {
        pg8::Gemm g{(const pg8::bf16_t*)(ws + WS_XN), (const pg8::bf16_t*)(ws + WS_WT_PG), DM / 2, 0};
        pg8::StaticOrder S; S.init(T / 256, DM / 256, F.G, (int)blockIdx.x);
        if (DUP_PHASE == 9) { pg8::EpiPle E0{(const pg8::bf16_t*)(ws + WS_Y), (const pg8::bf16_t*)(ws + WS_PJ), (float*)(ws + WS_XS)}; pg8::gemm_phase<pg8::EpiPle, pg8::StaticOrder, true, true, true>(F.lds + RING_OFF, g, S, E0, F.wave); }
        pg8::EpiPle E{(const pg8::bf16_t*)(ws + WS_Y), (const pg8::bf16_t*)(ws + WS_PJ), args.out};
        pg8::gemm_phase<pg8::EpiPle, pg8::StaticOrder, true, true, true>(F.lds + RING_OFF, g, S, E, F.wave);
    }
#undef IN
}
extern "C" void kernel_launch(void* const* d_in, const int* in_sizes, int n_in, void* d_out, int out_size, void* d_ws, size_t ws_size, hipStream_t stream) {
    static int grid = 0;
    if (grid == 0) {
        if (n_in != 22 || ws_size < 1024 * MiB) { fprintf(stderr, "kernel_launch: unexpected n_in %d / ws %zu\n", n_in, ws_size); grid = -1; return; }
        int dev = 0, cus = 0, per_cu = 0;
        if (hipGetDevice(&dev) != hipSuccess || hipDeviceGetAttribute(&cus, hipDeviceAttributeMultiprocessorCount, dev) != hipSuccess) { grid = -1; return; }
        if (hipFuncSetAttribute((const void*)mega_fwd, hipFuncAttributeMaxDynamicSharedMemorySize, LDS_BYTES) != hipSuccess) { fprintf(stderr, "kernel_launch: hipFuncSetAttribute failed\n"); grid = -1; return; }
        if (hipOccupancyMaxActiveBlocksPerMultiprocessor(&per_cu, (const void*)mega_fwd, NWAVES * 64, LDS_BYTES) != hipSuccess || per_cu < 1) { fprintf(stderr, "kernel_launch: occupancy query says %d\n", per_cu); per_cu = 1; }
        (void)hipGetLastError();
        grid = cus;
    }
    if (grid < 0) return;
    (void)hipMemsetAsync((char*)d_ws + WS_CTL, 0, CTL_ZERO_BYTES, stream);
    Args a{};
    a.x = (const float*)d_in[0]; a.p = (const float*)d_in[1]; a.positions = (const int*)d_in[2]; a.g_mix = (const float*)d_in[3]; a.w_in = (const float*)d_in[4];
    a.sbq = (const float*)d_in[5]; a.sbk = (const float*)d_in[6]; a.rq = (const float*)d_in[7]; a.rk = (const float*)d_in[8]; a.gn_g = (const float*)d_in[9]; a.gn_b = (const float*)d_in[10];
    a.w_out = (const float*)d_in[11]; a.g_ffn = (const float*)d_in[12]; a.w_r = (const float*)d_in[13]; a.b_r = (const float*)d_in[14]; a.w_ug = (const float*)d_in[15]; a.b_ug = (const float*)d_in[16];
    a.w_dn = (const float*)d_in[17]; a.b_dn = (const float*)d_in[18]; a.g_ple = (const float*)d_in[19]; a.w_pg = (const float*)d_in[20]; a.w_pp = (const float*)d_in[21];
    a.out = (float*)d_out; a.ws = (unsigned char*)d_ws; a.ph_lo = 0; a.ph_hi = 10;
    hipLaunchKernelGGL(mega_fwd, dim3(grid), dim3(NWAVES * 64), LDS_BYTES, stream, a);

}
```

```cpp
#include <hip/hip_runtime.h>
#include <cstdint>
#include <cstdio>
#include <cmath>

__device__ __forceinline__ int lane_id_hw() { return (int)__builtin_amdgcn_mbcnt_hi(~0u, __builtin_amdgcn_mbcnt_lo(~0u, 0u)); }
namespace pg8 {
#define PG8_LAS __attribute__((address_space(3)))
typedef unsigned short bf16_t;
typedef short bf16x8 __attribute__((ext_vector_type(8)));
typedef float f32x4 __attribute__((ext_vector_type(4)));
typedef unsigned u32x4 __attribute__((ext_vector_type(4)));
typedef unsigned u32x2 __attribute__((ext_vector_type(2)));
typedef int v4i32 __attribute__((ext_vector_type(4)));
typedef int v8i32 __attribute__((ext_vector_type(8)));
constexpr int BM = 256, BK = 64, HALF = 128, HTB = HALF * BK * 2  , STAGE_BYTES = 8 * HTB, NXCD = 8, WGM = 8;

__host__ __device__ __forceinline__ int lds_byte(int r, int c) { const int st = (r >> 4) * 2 + (c >> 5), rr = r & 15, cc = c & 31, ob = rr * 64 + cc * 2; return st * 1024 + (ob ^ (((ob >> 9) & 1) << 5)); }
__host__ __device__ __forceinline__ void stage_rc(int b, int& R, int& C) { const int st = b / 1024, sb = b % 1024, swz = sb ^ (((sb >> 9) & 1) << 5); R = (st >> 1) * 16 + swz / 64; C = (st & 1) * 32 + (swz % 64) / 2; }
__host__ __device__ __forceinline__ int perm32(int rho) { const int n = rho >> 4, i = rho & 15; return 8 * (i >> 2) + 4 * n + (i & 3); }

struct Unit { int pm, pn, e, seq; };
struct Gemm { const bf16_t* A; const bf16_t* Bt; int K; size_t strideBe; };

struct StaticOrder {
    int nM, nN, nwg, G, c;
    __host__ __device__ void init(int nM_, int nN_, int G_, int c_) { nM = nM_; nN = nN_; nwg = nM * nN; G = G_; c = c_; }
    __host__ __device__ bool next(int i, Unit& u) const {
        const long L = (long)i * G + c; if (L >= nwg) return false;
        int wgid = (int)L; { const int q = nwg / NXCD, r = nwg % NXCD, xcd = wgid % NXCD, off = wgid / NXCD; wgid = (xcd < r ? xcd * (q + 1) : r * (q + 1) + (xcd - r) * q) + off; }
        const int nig = WGM * nN, gid = wgid / nig, fm = gid * WGM, gsz = (nM - fm) < WGM ? (nM - fm) : WGM;
        u.pm = fm + ((wgid % nig) % gsz); u.pn = (wgid % nig) / gsz; u.e = 0; u.seq = i; return true;
    }
    __device__ __forceinline__ void a_ready(const Unit&) const {}
    __device__ __forceinline__ void done(const Unit&) const {}
};

typedef float f32x2_t __attribute__((ext_vector_type(2))); typedef __bf16 bf16x2_t __attribute__((ext_vector_type(2)));
__device__ __forceinline__ unsigned cvt_pk_bf16(float lo, float hi) { f32x2_t v = {lo, hi}; bf16x2_t b = __builtin_convertvector(v, bf16x2_t); return __builtin_bit_cast(unsigned, b); }

constexpr int T = 16384, SEQ = 2048, DM = 1024, DIN = 3584;
constexpr float EPS = 1e-6f;
__device__ __forceinline__ u32x4 pack8(const f32x4 a, const f32x4 b) { u32x4 w; w.x = cvt_pk_bf16(a[0], a[1]); w.y = cvt_pk_bf16(a[2], a[3]); w.z = cvt_pk_bf16(b[0], b[1]); w.w = cvt_pk_bf16(b[2], b[3]); return w; }

struct EpiProj {
    static constexpr bool PERM = true, AFTER_DRAIN = false;
    bf16_t* hm;
    bf16_t* rg;
    const float* gains;
    const float *ropec, *ropes;
    __device__ __forceinline__ void operator()(const f32x4 (&acc)[2][2][4][2], const Unit& u, int wr, int wc, int fr, int fq) const {
        const int region = u.pn >> 1, hb = 4 * (u.pn & 1) + wc;
        const bool normed = (region == 0) || (region == 1) || (region == 3) || (region == 4);
        const bool rope = (region == 3) || (region == 4);
        const int gidx = region == 0 ? 0 : region == 1 ? 1 : region == 3 ? 2 : 3;
        const float* gp = gains + gidx * 64;
        f32x4 gv[2][2];
#pragma unroll
        for (int bj = 0; bj < 2; ++bj)
#pragma unroll
            for (int n = 0; n < 2; ++n) gv[bj][n] = normed ? *(const f32x4*)(gp + 32 * bj + 8 * fq + 4 * n) : (f32x4){1.f, 1.f, 1.f, 1.f};
        const float lg2g = __log2f(1.0f - __builtin_amdgcn_exp2f(-5.0f - (float)hb));
        const float scale = region == 0 ? 0.125f * 1.4426950408889634f : region == 4 ? 0.125f : 1.0f;
#pragma unroll
        for (int ai = 0; ai < 2; ++ai)
#pragma unroll
            for (int m = 0; m < 4; ++m) {
                const int row = u.pm * BM + ai * HALF + wr * 64 + m * 16 + fr;
                const int b = row >> 11, s = row & (SEQ - 1);
                f32x4 v[2][2];
#pragma unroll
                for (int bj = 0; bj < 2; ++bj)
#pragma unroll
                    for (int n = 0; n < 2; ++n) v[bj][n] = acc[ai][bj][m][n];
                if (normed) {
                    float ss = 0.f;
#pragma unroll
                    for (int bj = 0; bj < 2; ++bj)
#pragma unroll
                        for (int n = 0; n < 2; ++n) { const f32x4 x = v[bj][n]; ss += (x[0] * x[0] + x[1] * x[1]) + (x[2] * x[2] + x[3] * x[3]); }
                    ss += __shfl_xor(ss, 16); ss += __shfl_xor(ss, 32);
                    float rs = rsqrtf(ss * (1.0f / 64.0f) + EPS) * scale;
                    if (rope) rs *= (region == 3) ? __builtin_amdgcn_exp2f((float)(s & 31) * lg2g) : __builtin_amdgcn_exp2f(-(float)(s & 63) * lg2g);
#pragma unroll
                    for (int bj = 0; bj < 2; ++bj)
#pragma unroll
                        for (int n = 0; n < 2; ++n) v[bj][n] = v[bj][n] * rs * gv[bj][n];
                    if (rope) {
#pragma unroll
                        for (int n = 0; n < 2; ++n) {
                            const f32x4 c = *(const f32x4*)(ropec + (size_t)row * 32 + 8 * fq + 4 * n), sn = *(const f32x4*)(ropes + (size_t)row * 32 + 8 * fq + 4 * n);
                            const f32x4 lo = v[0][n], hi = v[1][n];
                            v[0][n] = lo * c - hi * sn; v[1][n] = hi * c + lo * sn;
                        }
                    }
                }
                bf16_t* dst = (region < 6) ? hm + (size_t)region * ((size_t)T * 512) + ((size_t)(b * 8 + hb) * SEQ + s) * 64 + 8 * fq
                                           : rg + (size_t)row * 512 + hb * 64 + 8 * fq;
#pragma unroll
                for (int bj = 0; bj < 2; ++bj) *(u32x4*)(dst + 32 * bj) = pack8(v[bj][0], v[bj][1]);
            }
    }
};

constexpr int PF_WAVE_BYTES = 768, PF_BUF_BYTES = 8 * PF_WAVE_BYTES;
struct EpiBf16Plain {
    static constexpr bool PERM = true, AFTER_DRAIN = false;
    bf16_t* O; int ldc;
    __device__ __forceinline__ void operator()(const f32x4 (&acc)[2][2][4][2], const Unit& u, int wr, int wc, int fr, int fq) const {
        const int row0 = u.pm * BM + wr * 64 + fr, col0 = u.pn * BM + wc * 32 + 8 * fq;
#pragma unroll
        for (int ai = 0; ai < 2; ++ai)
#pragma unroll
            for (int m = 0; m < 4; ++m) { bf16_t* rowp = O + (size_t)(row0 + ai * HALF + m * 16) * ldc + col0;
#pragma unroll
                for (int bj = 0; bj < 2; ++bj) *(u32x4*)(rowp + bj * HALF) = pack8(acc[ai][bj][m][0], acc[ai][bj][m][1]); }
    }
};
struct EpiResid {
    static constexpr bool PERM = true, AFTER_DRAIN = false;
    const float* base; bf16_t* X1;
    __device__ __forceinline__ void operator()(const f32x4 (&acc)[2][2][4][2], const Unit& u, int wr, int wc, int fr, int fq) const {
        const int col0 = u.pn * BM + wc * 32 + 8 * fq;
#pragma unroll
        for (int ai = 0; ai < 2; ++ai)
#pragma unroll
            for (int m = 0; m < 4; ++m) { const size_t off = (size_t)(u.pm * BM + ai * HALF + wr * 64 + m * 16 + fr) * DM + col0;
#pragma unroll
                for (int bj = 0; bj < 2; ++bj) { const f32x4 b0 = __builtin_nontemporal_load((const f32x4*)(base + off + bj * HALF)), b1 = __builtin_nontemporal_load((const f32x4*)(base + off + bj * HALF + 4));
                    *(u32x4*)(X1 + off + bj * HALF) = pack8(b0 + acc[ai][bj][m][0], b1 + acc[ai][bj][m][1]); } }
    }
};
struct EpiMoeUp {
    static constexpr bool PERM = true, AFTER_DRAIN = false;
    unsigned char* H; const PG8_LAS unsigned char* pf_lds;
    __device__ __forceinline__ void operator()(const f32x4 (&acc)[2][2][4][2], const Unit& u, int wr, int wc, int fr, int fq) const {
        const int cc = 128 * u.pn + 32 * wc + 8 * fq;
        f32x4 bg[2], bl[2]; float scs[2][4];
        const PG8_LAS unsigned char* buf = pf_lds + (u.seq & 1) * PF_BUF_BYTES + (wr * 4 + wc) * PF_WAVE_BYTES;
#pragma unroll
        for (int n = 0; n < 2; ++n) { bg[n] = *(const PG8_LAS f32x4*)(buf + (8 * fq + 4 * n) * 4); bl[n] = *(const PG8_LAS f32x4*)(buf + 128 + (8 * fq + 4 * n) * 4); }
#pragma unroll
        for (int ai = 0; ai < 2; ++ai)
#pragma unroll
            for (int m = 0; m < 4; ++m) scs[ai][m] = *(const PG8_LAS float*)(buf + 256 + ai * 256 + (m * 16 + fr) * 4);
#pragma unroll
        for (int n = 0; n < 2; ++n) bl[n] = bl[n] + 1.0f;
#pragma unroll
        for (int ai = 0; ai < 2; ++ai)
#pragma unroll
            for (int m = 0; m < 4; ++m) {
                const float sc = scs[ai][m] * 0.015625f;
                f32x4 hv[2];
#pragma unroll
                for (int n = 0; n < 2; ++n) {
                    const f32x4 g0 = acc[ai][0][m][n] * sc + bg[n], l1 = acc[ai][1][m][n] * sc + bl[n];
                    f32x4 glu, lin1;
#pragma unroll
                    for (int j = 0; j < 4; ++j) { glu[j] = __builtin_fminf(g0[j], 7.0f); lin1[j] = __builtin_amdgcn_fmed3f(l1[j], -6.0f, 8.0f); }
                    const f32x4 t = glu * (-1.702f * 1.4426950408889634f);
                    f32x4 e;
#pragma unroll
                    for (int j = 0; j < 4; ++j) e[j] = __builtin_amdgcn_exp2f(t[j]);
                    const f32x4 d = e + 1.0f;
                    f32x4 r;
#pragma unroll
                    for (int j = 0; j < 4; ++j) r[j] = __builtin_amdgcn_rcpf(d[j]);
                    hv[n] = (glu * r) * lin1;
                }
                u32x2 hq; hq.x = (unsigned)__builtin_amdgcn_cvt_pk_fp8_f32(hv[0][0], hv[0][1], 0, false); hq.x = (unsigned)__builtin_amdgcn_cvt_pk_fp8_f32(hv[0][2], hv[0][3], (int)hq.x, true);
                hq.y = (unsigned)__builtin_amdgcn_cvt_pk_fp8_f32(hv[1][0], hv[1][1], 0, false); hq.y = (unsigned)__builtin_amdgcn_cvt_pk_fp8_f32(hv[1][2], hv[1][3], (int)hq.y, true);
                *(u32x2*)(H + (size_t)(u.pm * BM + ai * HALF + wr * 64 + m * 16 + fr) * 1024 + cc) = hq;
            }
    }
};
struct EpiMoeDown {
    static constexpr bool PERM = true, AFTER_DRAIN = false;
    unsigned char* YS; const PG8_LAS unsigned char* pf_lds;
    __device__ __forceinline__ void operator()(const f32x4 (&acc)[2][2][4][2], const Unit& u, int wr, int wc, int fr, int fq) const {
        const int col0 = u.pn * BM + wc * 32 + 8 * fq;
        const PG8_LAS unsigned char* buf = pf_lds + (u.seq & 1) * PF_BUF_BYTES + (wr * 4 + wc) * PF_WAVE_BYTES;
        f32x4 bv[2][2];
#pragma unroll
        for (int bj = 0; bj < 2; ++bj)
#pragma unroll
            for (int n = 0; n < 2; ++n) bv[bj][n] = *(const PG8_LAS f32x4*)(buf + bj * 128 + (8 * fq + 4 * n) * 4);
#pragma unroll
        for (int ai = 0; ai < 2; ++ai)
#pragma unroll
            for (int m = 0; m < 4; ++m) { unsigned char* rowp = YS + (size_t)(u.pm * BM + ai * HALF + wr * 64 + m * 16 + fr) * 1024 + col0;
#pragma unroll
                for (int bj = 0; bj < 2; ++bj) { const f32x4 y0 = acc[ai][bj][m][0] * 0.015625f + bv[bj][0], y1 = acc[ai][bj][m][1] * 0.015625f + bv[bj][1];
                    u32x2 q; q.x = (unsigned)__builtin_amdgcn_cvt_pk_fp8_f32(y0[0], y0[1], 0, false); q.x = (unsigned)__builtin_amdgcn_cvt_pk_fp8_f32(y0[2], y0[3], (int)q.x, true);
                    q.y = (unsigned)__builtin_amdgcn_cvt_pk_fp8_f32(y1[0], y1[1], 0, false); q.y = (unsigned)__builtin_amdgcn_cvt_pk_fp8_f32(y1[2], y1[3], (int)q.y, true);
                    *(u32x2*)(rowp + bj * HALF) = q; } }
    }
};
struct EpiPle {
    static constexpr bool PERM = false, AFTER_DRAIN = false;
    const bf16_t* X2; const bf16_t* PJ; float* outw;
    __device__ __forceinline__ void operator()(const f32x4 (&acc)[2][2][4][2], const Unit& u, int wr, int wc, int fr, int fq) const {
        const int col0 = u.pn * BM + wc * 32 + 4 * fq;
#pragma unroll
        for (int ai = 0; ai < 2; ++ai)
#pragma unroll
            for (int m = 0; m < 4; ++m) { const size_t off = (size_t)(u.pm * BM + ai * HALF + wr * 64 + m * 16 + fr) * DM + col0;
#pragma unroll
                for (int bj = 0; bj < 2; ++bj)
#pragma unroll
                    for (int n = 0; n < 2; ++n) {
                        const size_t o2 = off + bj * HALF + n * 16;
                        const u32x2 xq = __builtin_nontemporal_load((const u32x2*)(X2 + o2)); const f32x4 x2 = (f32x4){__uint_as_float(xq.x << 16), __uint_as_float(xq.x & 0xffff0000u), __uint_as_float(xq.y << 16), __uint_as_float(xq.y & 0xffff0000u)}; const u32x2 pj = __builtin_nontemporal_load((const u32x2*)(PJ + o2)); const f32x4 a = acc[ai][bj][m][n] * 0.015625f;
                        f32x4 r;
                        r[0] = x2[0] + __uint_as_float(pj.x << 16) * __builtin_amdgcn_rcpf(1.0f + __builtin_amdgcn_exp2f(-1.4426950408889634f * a[0]));
                        r[1] = x2[1] + __uint_as_float(pj.x & 0xffff0000u) * __builtin_amdgcn_rcpf(1.0f + __builtin_amdgcn_exp2f(-1.4426950408889634f * a[1]));
                        r[2] = x2[2] + __uint_as_float(pj.y << 16) * __builtin_amdgcn_rcpf(1.0f + __builtin_amdgcn_exp2f(-1.4426950408889634f * a[2]));
                        r[3] = x2[3] + __uint_as_float(pj.y & 0xffff0000u) * __builtin_amdgcn_rcpf(1.0f + __builtin_amdgcn_exp2f(-1.4426950408889634f * a[3]));
                        __builtin_nontemporal_store(r, (f32x4*)(outw + o2));
                    } }
    }
};
struct MoeOrder {
    int nM, nN, nwg, G, c, wid, mode; const PG8_LAS int* tile_e; const float* pf_bias; const float* pf_rstd; PG8_LAS unsigned char* pf_lds;
    const int* toklist; const PG8_LAS int* first_tile; PG8_LAS unsigned char* tokl;
    __device__ __forceinline__ const int* tok_src(const Unit& u) const { return toklist + (size_t)u.e * T + 256 * (u.pm - first_tile[u.e]); }
    __device__ __forceinline__ PG8_LAS unsigned char* tok_lds() const { return tokl; }
    __device__ void init(int nM_, int nN_, int G_, int c_, const PG8_LAS int* te, int wid_, int mode_, const float* pb, const float* pr, PG8_LAS unsigned char* pl) { nM = nM_; nN = nN_; nwg = nM * nN; G = G_; c = c_; tile_e = te; wid = wid_; mode = mode_; pf_bias = pb; pf_rstd = pr; pf_lds = pl; }
    __device__ bool next(int i, Unit& u) const {
        const long L = (long)i * G + c; if (L >= nwg) return false;
        int wgid = (int)L; { const int q = nwg / NXCD, r = nwg % NXCD, xcd = wgid % NXCD, off = wgid / NXCD; wgid = (xcd < r ? xcd * (q + 1) : r * (q + 1) + (xcd - r) * q) + off; }
        const int nig = WGM * nN, gid = wgid / nig, fm = gid * WGM, gsz = (nM - fm) < WGM ? (nM - fm) : WGM;
        u.pm = fm + ((wgid % nig) % gsz); u.pn = (wgid % nig) / gsz; u.e = __builtin_amdgcn_readfirstlane(tile_e[u.pm]); u.seq = i; return true;
    }
    __device__ __forceinline__ void a_ready(const Unit& u) const {
        const int lane = (int)__builtin_amdgcn_mbcnt_hi(~0u, __builtin_amdgcn_mbcnt_lo(~0u, 0u)), wr = wid >> 2, wc = wid & 3;
        PG8_LAS unsigned char* buf = pf_lds + (u.seq & 1) * PF_BUF_BYTES + wid * PF_WAVE_BYTES;
        if (mode == 1) {
            const float* bsrc = pf_bias + (size_t)u.e * 2048 + 128 * u.pn + 32 * wc + (lane & 31) + ((lane >> 5) ? 1024 : 0);
            __builtin_amdgcn_global_load_lds((const unsigned*)bsrc, (PG8_LAS unsigned*)buf, 4, 0, 0);
            const PG8_LAS int* tl = (const PG8_LAS int*)(tokl + 1024 * (u.seq & 1)) + wr * 64 + lane;
            __builtin_amdgcn_global_load_lds((const unsigned*)(pf_rstd + tl[0]), (PG8_LAS unsigned*)(buf + 256), 4, 0, 0);
            __builtin_amdgcn_global_load_lds((const unsigned*)(pf_rstd + tl[HALF]), (PG8_LAS unsigned*)(buf + 512), 4, 0, 0);
        } else if (mode == 2) {
            const float* bsrc = pf_bias + (size_t)u.e * 1024 + u.pn * BM + 32 * wc + (lane & 31) + ((lane >> 5) ? HALF : 0);
            __builtin_amdgcn_global_load_lds((const unsigned*)bsrc, (PG8_LAS unsigned*)buf, 4, 0, 0);
        }
    }
    __device__ __forceinline__ void done(const Unit&) const {}
};
struct EpiNull {
    static constexpr bool PERM = true, AFTER_DRAIN = false;
    __device__ __forceinline__ void operator()(const f32x4 (&acc)[2][2][4][2], const Unit& u, int wr, int wc, int fr, int fq) const {
#pragma unroll
        for (int ai = 0; ai < 2; ++ai)
#pragma unroll
            for (int bj = 0; bj < 2; ++bj)
#pragma unroll
                for (int m = 0; m < 4; ++m)
#pragma unroll
                    for (int n = 0; n < 2; ++n) asm volatile("" :: "v"(acc[ai][bj][m][n]));
    }
};
template <class Epi, class Sched, bool ALIGN_EPI = false, bool SP2 = false, bool F8 = false, bool GATHER = false>
__device__ __forceinline__ void gemm_phase(PG8_LAS unsigned char* lds, const Gemm g, const Sched& S, const Epi& E, const int wave_id) {
    int tid_ = wave_id * 64 + lane_id_hw(); asm volatile("" : "+v"(tid_));
    const int tid = tid_, wid = __builtin_amdgcn_readfirstlane(tid >> 6), lane = tid & 63, wr = wid >> 2, wc = wid & 3, fr = lane & 15, fq = lane >> 4;
    const int K = g.K, nt = K / BK;
    unsigned voffA[2], voffB[2];
#pragma unroll
    for (int i = 0; i < 2; ++i) { int R, C; stage_rc(tid * 16 + i * 8192, R, C); const int Rb = Epi::PERM ? ((R & ~31) + perm32(R & 31)) : R;
        voffA[i] = (unsigned)(R * K + C) * 2u; voffB[i] = (unsigned)(Rb * K + C) * 2u; }
    const size_t kstep = (size_t)(BK * 2);
    const size_t hstep = (size_t)HALF * K * 2;
    const size_t tstep = 2 * hstep;
    const size_t hstepA = GATHER ? 0 : hstep;
    unsigned gC[2][2];
#pragma unroll
    for (int h = 0; h < 2; ++h)
#pragma unroll
        for (int i = 0; i < 2; ++i) gC[h][i] = voffA[i];
#define PG8_TOK_DMA(U, par) do { if constexpr (GATHER) { if (wid < 4) __builtin_amdgcn_global_load_lds((const unsigned*)(S.tok_src(U) + 64 * wid + (int)__builtin_amdgcn_mbcnt_hi(~0u, __builtin_amdgcn_mbcnt_lo(~0u, 0u))), (PG8_LAS unsigned*)(S.tok_lds() + 1024 * (par) + 256 * wid), 4, 0, 0); } } while (0)
#define PG8_TOK_READ(dst, par) do { if constexpr (GATHER) { _Pragma("unroll") for (int i = 0; i < 2; ++i) { int R_, C_; stage_rc((wid * 64 + (int)__builtin_amdgcn_mbcnt_hi(~0u, __builtin_amdgcn_mbcnt_lo(~0u, 0u))) * 16 + i * 8192, R_, C_); _Pragma("unroll") for (int h = 0; h < 2; ++h) \
        dst[h][i] = (unsigned)(*(const PG8_LAS int*)(S.tok_lds() + 1024 * (par) + 4 * (h * HALF + R_))) * (unsigned)(K * 2) + (unsigned)C_ * 2u; } } } while (0)
    const unsigned ldsw = (unsigned)wid * 1024u;
    const int aoff = lds_byte(wr * 64 + fr, fq * 8), boff = lds_byte(wc * 32 + fr, fq * 8);
#define PG8_SA(b, h) (((b) * 2 + (h)) * HTB)
#define PG8_SB(b, h) ((4 + (b) * 2 + (h)) * HTB)
#define PG8_STAGE(bufoff, gbase, voff) do { _Pragma("unroll") for (int _i = 0; _i < 2; ++_i) \
        __builtin_amdgcn_global_load_lds((const unsigned*)((const char*)(gbase) + (voff)[_i]), (PG8_LAS unsigned*)(lds + (bufoff) + ldsw + _i * 8192), 16, 0, 0); } while (0)
#define PG8_LD16(off) (*(const PG8_LAS v4i32*)(lds + (off)))
#define PG8_LDA(dst, b, h) do { if constexpr (F8) { _Pragma("unroll") for (int m = 0; m < 4; ++m) dst##8[m] = __builtin_shufflevector(PG8_LD16(PG8_SA(b, h) + aoff + m * 2048), PG8_LD16(PG8_SA(b, h) + aoff + m * 2048 + 1024), 0, 1, 2, 3, 4, 5, 6, 7); } \
        else { _Pragma("unroll") for (int m = 0; m < 4; ++m) _Pragma("unroll") for (int k = 0; k < 2; ++k) dst[m][k] = *(const PG8_LAS bf16x8*)(lds + PG8_SA(b, h) + aoff + m * 2048 + k * 1024); } } while (0)
#define PG8_LDB(dst, b, h) do { if constexpr (F8) { _Pragma("unroll") for (int n = 0; n < 2; ++n) dst##8[n] = __builtin_shufflevector(PG8_LD16(PG8_SB(b, h) + boff + n * 2048), PG8_LD16(PG8_SB(b, h) + boff + n * 2048 + 1024), 0, 1, 2, 3, 4, 5, 6, 7); } \
        else { _Pragma("unroll") for (int n = 0; n < 2; ++n) _Pragma("unroll") for (int k = 0; k < 2; ++k) dst[n][k] = *(const PG8_LAS bf16x8*)(lds + PG8_SB(b, h) + boff + n * 2048 + k * 1024); } } while (0)
#define PG8_MMA(ai, bj, At, Bt) do { __builtin_amdgcn_s_setprio(1); \
        if constexpr (F8) { _Pragma("unroll") for (int m = 0; m < 4; ++m) _Pragma("unroll") for (int n = 0; n < 2; ++n) \
            asm volatile("v_mfma_scale_f32_16x16x128_f8f6f4 %0, %1, %2, %0, %3, %3 op_sel_hi:[0,0,0]" : "+v"(acc[ai][bj][m][n]) : "v"(Bt##8[n]), "v"(At##8[m]), "v"(f8scale)); } \
        else { _Pragma("unroll") for (int m = 0; m < 4; ++m) _Pragma("unroll") for (int n = 0; n < 2; ++n) _Pragma("unroll") for (int k = 0; k < 2; ++k) \
            acc[ai][bj][m][n] = __builtin_amdgcn_mfma_f32_16x16x32_bf16(Bt[n][k], At[m][k], acc[ai][bj][m][n], 0, 0, 0); } \
        __builtin_amdgcn_s_setprio(0); } while (0)
#define PG8_WAIT_V(n) asm volatile("s_waitcnt vmcnt(" #n ")" ::: "memory")
#define PG8_WAIT_L(n) asm volatile("s_waitcnt lgkmcnt(" #n ")" ::: "memory")
#define PG8_BAR __builtin_amdgcn_s_barrier()
#define PG8_SCHED __builtin_amdgcn_sched_barrier(0)
    Unit cur, nxt; int ui = 0;
    if (!S.next(0, cur)) return;
    f32x4 acc[2][2][4][2];
#pragma unroll
    for (int a = 0; a < 2; ++a)
#pragma unroll
        for (int b = 0; b < 2; ++b)
#pragma unroll
            for (int m = 0; m < 4; ++m)
#pragma unroll
                for (int n = 0; n < 2; ++n) acc[a][b][m][n] = (f32x4){0.f, 0.f, 0.f, 0.f};
    bf16x8 At[4][2], B0[2][2], B1[2][2];
    v8i32 At8[4], B08[2], B18[2]; const int f8scale = 0x7f7f7f7f;
    const char* cA = (const char*)g.A + (GATHER ? (size_t)0 : (size_t)cur.pm * tstep); const char* cB = (const char*)g.Bt + (size_t)cur.e * g.strideBe + (size_t)cur.pn * tstep;
    if constexpr (GATHER) { PG8_TOK_DMA(cur, 0); asm volatile("s_waitcnt vmcnt(0)" ::: "memory"); PG8_BAR; PG8_TOK_READ(gC, 0); }
    S.a_ready(cur);
    if constexpr (SP2) {
        PG8_STAGE(PG8_SB(0, 0), cB, voffB); PG8_STAGE(PG8_SB(0, 1), cB + hstep, voffB); PG8_STAGE(PG8_SA(0, 0), cA, gC[0]); PG8_STAGE(PG8_SA(0, 1), cA + hstepA, gC[1]);
        if (wr == 1) PG8_BAR;
        PG8_WAIT_V(2); PG8_BAR;
        PG8_STAGE(PG8_SB(1, 0), cB + kstep, voffB); PG8_STAGE(PG8_SA(1, 0), cA + kstep, gC[0]); PG8_STAGE(PG8_SB(1, 1), cB + hstep + kstep, voffB);
        PG8_WAIT_V(6); PG8_BAR;
    } else {
        PG8_STAGE(PG8_SB(0, 0), cB, voffB); PG8_STAGE(PG8_SA(0, 0), cA, voffA); PG8_STAGE(PG8_SB(0, 1), cB + hstep, voffB); PG8_STAGE(PG8_SA(0, 1), cA + hstep, voffA);
        if (wr == 1) PG8_BAR;
        PG8_WAIT_V(4); PG8_BAR;
        PG8_STAGE(PG8_SB(1, 0), cB + kstep, voffB); PG8_STAGE(PG8_SA(1, 0), cA + kstep, voffA); PG8_STAGE(PG8_SB(1, 1), cB + hstep + kstep, voffB);
        PG8_WAIT_V(6); PG8_BAR;
    }
    for (;;) {
        const bool has_next = S.next(ui + 1, nxt);
        const char* nA = (has_next && !GATHER) ? (const char*)g.A + (size_t)nxt.pm * tstep : cA;
        const char* nB = has_next ? (const char*)g.Bt + (size_t)nxt.e * g.strideBe + (size_t)nxt.pn * tstep : cB;
        if (has_next) PG8_TOK_DMA(nxt, (ui + 1) & 1);
#pragma unroll 1
        for (int t = 0; t < nt; t += 2) {
            const bool last = (t == nt - 2);
            const char* a1 = cA + (size_t)(t + 1) * kstep;
            const char* a2 = last ? nA : cA + (size_t)(t + 2) * kstep; const char* b2 = last ? nB : cB + (size_t)(t + 2) * kstep;
            const char* a3 = a2 + kstep; const char* b3 = b2 + kstep;
            if (last && has_next) S.a_ready(nxt);
            if constexpr (SP2) {
            PG8_LDB(B0, 0, 0); PG8_LDB(B1, 0, 1); PG8_SCHED; PG8_LDA(At, 0, 0); PG8_STAGE(PG8_SA(1, 1), a1 + hstepA, gC[1]);
            if constexpr (GATHER) { if (last && has_next) PG8_TOK_READ(gC, (ui + 1) & 1); }
            PG8_WAIT_V(8); PG8_WAIT_L(0); PG8_BAR; PG8_MMA(0, 0, At, B0); PG8_MMA(0, 1, At, B1); PG8_BAR; PG8_SCHED;
            PG8_LDA(At, 0, 1); PG8_STAGE(PG8_SB(0, 0), b2, voffB); PG8_STAGE(PG8_SB(0, 1), b2 + hstep, voffB); PG8_STAGE(PG8_SA(0, 0), a2, gC[0]);
            PG8_WAIT_V(8); PG8_WAIT_L(0); PG8_BAR; PG8_MMA(1, 0, At, B0); PG8_MMA(1, 1, At, B1); PG8_BAR; PG8_SCHED;
            PG8_LDB(B0, 1, 0); PG8_LDB(B1, 1, 1); PG8_SCHED; PG8_LDA(At, 1, 0); PG8_STAGE(PG8_SA(0, 1), a2 + hstepA, gC[1]);
            PG8_WAIT_V(8); PG8_WAIT_L(0); PG8_BAR; PG8_MMA(0, 0, At, B0); PG8_MMA(0, 1, At, B1); PG8_BAR; PG8_SCHED;
            PG8_LDA(At, 1, 1); PG8_STAGE(PG8_SB(1, 0), b3, voffB); PG8_STAGE(PG8_SB(1, 1), b3 + hstep, voffB); PG8_STAGE(PG8_SA(1, 0), a3, gC[0]);
            PG8_WAIT_V(8); PG8_WAIT_L(0); PG8_BAR; PG8_MMA(1, 0, At, B0); PG8_MMA(1, 1, At, B1); PG8_BAR; PG8_SCHED;
            } else {
            PG8_LDB(B0, 0, 0); PG8_SCHED; PG8_LDA(At, 0, 0); PG8_STAGE(PG8_SA(1, 1), a1 + hstep, voffA);
            PG8_WAIT_L(8); PG8_BAR; PG8_WAIT_L(0); PG8_MMA(0, 0, At, B0); PG8_BAR; PG8_SCHED;
            PG8_LDB(B1, 0, 1); PG8_STAGE(PG8_SB(0, 0), b2, voffB);
            PG8_BAR; PG8_WAIT_L(0); PG8_MMA(0, 1, At, B1); PG8_BAR;
            PG8_LDA(At, 0, 1); PG8_STAGE(PG8_SA(0, 0), a2, voffA);
            PG8_BAR; PG8_WAIT_L(0); PG8_MMA(1, 0, At, B0); PG8_BAR; PG8_SCHED;
            PG8_STAGE(PG8_SB(0, 1), b2 + hstep, voffB);
            PG8_WAIT_V(6); PG8_BAR; PG8_MMA(1, 1, At, B1); PG8_BAR;
            PG8_LDB(B0, 1, 0); PG8_SCHED; PG8_LDA(At, 1, 0); PG8_STAGE(PG8_SA(0, 1), a2 + hstep, voffA);
            PG8_WAIT_L(8); PG8_BAR; PG8_WAIT_L(0); PG8_MMA(0, 0, At, B0); PG8_BAR; PG8_SCHED;
            PG8_LDB(B1, 1, 1); PG8_STAGE(PG8_SB(1, 0), b3, voffB);
            PG8_BAR; PG8_WAIT_L(0); PG8_MMA(0, 1, At, B1); PG8_BAR;
            PG8_LDA(At, 1, 1); PG8_STAGE(PG8_SA(1, 0), a3, voffA);
            PG8_BAR; PG8_WAIT_L(0); PG8_MMA(1, 0, At, B0); PG8_BAR; PG8_SCHED;
            PG8_STAGE(PG8_SB(1, 1), b3 + hstep, voffB);
            PG8_WAIT_V(6); PG8_BAR; PG8_MMA(1, 1, At, B1); PG8_BAR;
            }
        }
        if constexpr (ALIGN_EPI) { if (wr == 0) PG8_BAR; }
        if constexpr (F8) asm volatile("s_nop 15\n\ts_nop 15\n\ts_nop 15" ::: "memory");
        if constexpr (!Epi::AFTER_DRAIN) { E(acc, cur, wr, wc, fr, fq); S.done(cur); }
        if (!has_next) break;
#pragma unroll
        for (int a = 0; a < 2; ++a)
#pragma unroll
            for (int b = 0; b < 2; ++b)
#pragma unroll
                for (int m = 0; m < 4; ++m)
#pragma unroll
                    for (int n = 0; n < 2; ++n) acc[a][b][m][n] = (f32x4){0.f, 0.f, 0.f, 0.f};
        cur = nxt; cA = nA; cB = nB; ++ui;
        if constexpr (ALIGN_EPI) { if (wr == 1) PG8_BAR; }
    }
    PG8_WAIT_V(0);
    if constexpr (!ALIGN_EPI) { if (wr == 0) PG8_BAR; }
    PG8_BAR;
    if constexpr (Epi::AFTER_DRAIN) { E.fused(acc, cur, wr, wc, fr, fq, lds, wid, lane); S.done(cur); }
#undef PG8_TOK_DMA
#undef PG8_TOK_READ
#undef PG8_SA
#undef PG8_SB
#undef PG8_STAGE
#undef PG8_LD16
#undef PG8_LDA
#undef PG8_LDB
#undef PG8_MMA
#undef PG8_WAIT_V
#undef PG8_WAIT_L
#undef PG8_BAR
#undef PG8_SCHED
}
}

constexpr int NWAVES = 8;
constexpr int T = pg8::T, SEQ = pg8::SEQ, DM = pg8::DM, DIN = pg8::DIN, NE = 32, PLE = 256;
constexpr float EPS = pg8::EPS;
constexpr size_t MiB = 1u << 20;
constexpr size_t WS_CTL = 0, CTL_ZERO_BYTES = 256 * 1024;
constexpr size_t WS_WT_IN = 2 * MiB, WS_WT_OUT = 9 * MiB, WS_WT_PG = 11 * MiB, WS_WT_PP = 13 * MiB;
constexpr size_t WS_GAINS = 13 * MiB + 512 * 1024;
constexpr size_t WS_WRT = 13 * MiB + 576 * 1024;
constexpr size_t WS_ROPEC = 14 * MiB, WS_ROPES = 16 * MiB, WS_PB = 18 * MiB, WS_ROUTE = 26 * MiB;
constexpr size_t WS_TOKLIST = 29 * MiB;
constexpr size_t WS_WT_UG = 32 * MiB, WS_WT_DN = 160 * MiB;
constexpr size_t WS_XN = 224 * MiB;
constexpr size_t WS_HM = 256 * MiB;
constexpr size_t WS_X1 = 256 * MiB;
constexpr size_t WS_RG = 352 * MiB;
constexpr size_t WS_Y = 368 * MiB;
constexpr size_t WS_PJ = 400 * MiB;
constexpr size_t WS_XS = 432 * MiB, WS_H = 576 * MiB, WS_YS = 720 * MiB;
constexpr size_t WS_END = 864 * MiB;
constexpr int CW_TMO = 0, CW_CODE = 1;
constexpr int CW_BAR = 4096;
constexpr int RING_OFF = 0, RING_BYTES = 131072;
constexpr int LDSCTL_OFF = RING_BYTES, MISC_OFF = LDSCTL_OFF + 320;
constexpr int PF_OFF = LDSCTL_OFF + 4096;
constexpr int TOKL_OFF = LDSCTL_OFF + 16384;
constexpr int LDS_BYTES = 151552;
#define GAS __attribute__((address_space(1)))
#define LAS __attribute__((address_space(3)))
typedef unsigned short bf16;
typedef unsigned v4u __attribute__((ext_vector_type(4)));
typedef float f32x4 __attribute__((ext_vector_type(4)));
typedef short bf16x8 __attribute__((ext_vector_type(8)));
typedef unsigned u32x4_t __attribute__((ext_vector_type(4)));
typedef unsigned u32x2_t __attribute__((ext_vector_type(2)));
typedef GAS unsigned gu32;
typedef GAS unsigned long long gu64;
#define RLX_AGENT __ATOMIC_RELAXED, __HIP_MEMORY_SCOPE_AGENT
#define LDS_WAIT() asm volatile("s_waitcnt lgkmcnt(0)" ::: "memory")
#define VM_WAIT() asm volatile("s_waitcnt vmcnt(0)" ::: "memory")
__device__ __forceinline__ unsigned long long rt() { return __builtin_amdgcn_s_memrealtime(); }
__device__ __forceinline__ unsigned f2bf(float f) { unsigned u = __builtin_bit_cast(unsigned, f); return (u + 0x7fffu + ((u >> 16) & 1u)) >> 16; }
__device__ __forceinline__ unsigned pk2(float lo, float hi) { return f2bf(lo) | (f2bf(hi) << 16); }

#define XB_TMO      128
#define XB_XCNT(j)  (256  + 64 * (j))
#define XB_XSUB(j)  (1280 + 64 * (j))
#define XB_XGEN(j)  (2304 + 64 * (j))
#define XB_TOP      3328
#define XB_TOPGEN   3392
#define XCD_BAR_WORDS 3456
#define XB_SPIN_CAP (1u << 18)

__device__ __forceinline__ unsigned xb_ld(unsigned* p)              { return __hip_atomic_load(p, __ATOMIC_RELAXED, __HIP_MEMORY_SCOPE_AGENT); }
__device__ __forceinline__ unsigned xb_add(unsigned* p, unsigned v) { return __hip_atomic_fetch_add(p, v, __ATOMIC_RELAXED, __HIP_MEMORY_SCOPE_AGENT); }
__device__ __forceinline__ unsigned xb_xcc_id() { return (unsigned)__builtin_amdgcn_s_getreg((3 << 11) | 20) & 0xFu; }
#define XB_SPIN(cond, bar) do { unsigned _sp = 0; while (cond) { __builtin_amdgcn_s_sleep(1); \
    if ((++_sp & 255u) == 0u) { if (xb_ld(&(bar)[XB_TMO])) break; if (_sp > XB_SPIN_CAP) { atomicAdd(&(bar)[XB_TMO], 1u); break; } } } } while (0)

struct XcdBarrier {
    unsigned* bar; unsigned x; int wave;
    volatile LAS unsigned* st;
};

__device__ __forceinline__ XcdBarrier xcd_barrier_post(unsigned* bar, volatile LAS unsigned* st) {
    XcdBarrier b; b.bar = bar; b.x = xb_xcc_id(); b.st = st;
    if (threadIdx.x == 0) (void)xb_add(&bar[XB_XCNT(b.x)], 1u);
    return b;
}
__device__ __forceinline__ void xcd_barrier_complete(unsigned* bar, unsigned x, unsigned& nloc, unsigned& nx) {
    const unsigned G = gridDim.x * gridDim.y * gridDim.z;
    unsigned sum, cnt, mine, sp = 0u;
    for (;;) {
        sum = 0u; cnt = 0u; mine = 0u;
#pragma unroll
        for (unsigned j = 0; j < 16; ++j) { const unsigned c = xb_ld(&bar[XB_XCNT(j)]); sum += c; cnt += (c > 0u) ? 1u : 0u; mine = (j == x) ? c : mine; }
        if (sum == G) break;
        __builtin_amdgcn_s_sleep(1);
        if ((++sp & 255u) == 0u) { if (xb_ld(&bar[XB_TMO])) break; if (sp > XB_SPIN_CAP) { atomicAdd(&bar[XB_TMO], 1u); break; } }
    }
    nloc = mine > 0u ? mine : 1u; nx = cnt > 0u ? cnt : 1u;
}

__device__ __forceinline__ void xcd_barrier(const XcdBarrier& b) {
    asm volatile("s_waitcnt vmcnt(0)" ::: "memory");
    __syncthreads();
    if (b.wave == 0 && lane_id_hw() == 0) {
        unsigned* bar = b.bar;
        __builtin_amdgcn_s_waitcnt(0);
        unsigned nloc = b.st[0], nx = b.st[1];
        if (nloc == 0u) { xcd_barrier_complete(bar, b.x, nloc, nx); b.st[0] = nloc; b.st[1] = nx; }
        const unsigned old = xb_add(&bar[XB_XSUB(b.x)], 1u);
        const unsigned gen = old / nloc;
        const unsigned tgen = gen;
        if (old + 1u == (gen + 1u) * nloc) {
            __builtin_amdgcn_fence(__ATOMIC_RELEASE, "agent");
            asm volatile("s_waitcnt vmcnt(0)" ::: "memory");
            const unsigned og = xb_add(&bar[XB_TOP], 1u);
            const unsigned tg = og / nx;
            if (og + 1u == (tg + 1u) * nx) xb_add(&bar[XB_TOPGEN], 1u);
            else XB_SPIN(xb_ld(&bar[XB_TOPGEN]) == tg, bar);
        } else {
            XB_SPIN(xb_ld(&bar[XB_TOPGEN]) == tgen, bar);
        }
        __builtin_amdgcn_fence(__ATOMIC_ACQUIRE, "agent");
        asm volatile("s_waitcnt vmcnt(0)" ::: "memory");
    }
    __syncthreads();
}

struct Args {
    const float* x; const float* p; const int* positions; const float* g_mix; const float* w_in;
    const float* sbq; const float* sbk; const float* rq; const float* rk; const float* gn_g; const float* gn_b; const float* w_out;
    const float* g_ffn; const float* w_r; const float* b_r; const float* w_ug; const float* b_ug; const float* w_dn; const float* b_dn;
    const float* g_ple; const float* w_pg; const float* w_pp;
    float* out; unsigned char* ws; int ph_lo, ph_hi;
};
struct Frame {
    LAS unsigned char* lds;
    volatile LAS unsigned* MISC;
    gu32* ctl;
    int wave;
    int vcu, G;
};
__device__ __forceinline__ int tid_now(int wave_id) { int t = wave_id * 64 + lane_id_hw(); asm volatile("" : "+v"(t)); return t; }
__device__ __forceinline__ float wave_sum(float v) {
#pragma unroll
    for (int o = 1; o < 64; o <<= 1) v += __shfl_xor(v, o);
    return v;
}
__device__ __forceinline__ unsigned cvtpk(float lo, float hi) { return pg8::cvt_pk_bf16(lo, hi); }

enum { MAP_NAT = 0, MAP_IN = 1, MAP_UG = 2 };
__device__ __forceinline__ void p0_item(const float* __restrict__ W, int N, int K, bf16* __restrict__ WT, int kb, int nb, int mapmode, LAS unsigned char* scr, int lane) {
    const int np = 64 * nb + 4 * (lane & 15);
    int src = np;
    if (mapmode == MAP_IN) { const int pn = np >> 8, L = np & 255, bj = L >> 7, wc = (L >> 5) & 3, e = L & 31; src = 256 * pn + 64 * wc + 32 * bj + e; }
    else if (mapmode == MAP_UG) { const int pn = np >> 8, L = np & 255, bj = L >> 7, i = L & 127; src = 1024 * bj + 128 * pn + i; }
    const float* gp = W + (size_t)(64 * kb + (lane >> 4)) * N + src;
    f32x4 v[16];
#pragma unroll
    for (int i = 0; i < 16; ++i) v[i] = *(const f32x4*)(gp + (size_t)(4 * i) * N);
#pragma unroll
    for (int i = 0; i < 16; ++i) {
        LAS unsigned* d = (LAS unsigned*)(scr + (4 * i + (lane >> 4)) * 132 + 8 * (lane & 15));
        d[0] = cvtpk(v[i][0], v[i][1]); d[1] = cvtpk(v[i][2], v[i][3]);
    }
    LDS_WAIT(); asm volatile("" ::: "memory");
    const int c = lane & 7;
#pragma unroll
    for (int it = 0; it < 4; ++it) {
        const int nl = 16 * it + 2 * (lane >> 3);
        unsigned d[8];
#pragma unroll
        for (int j = 0; j < 8; ++j) d[j] = *(const LAS unsigned*)(scr + (8 * c + j) * 132 + 2 * nl);
        v4u o0, o1;
        o0.x = (d[0] & 0xffffu) | (d[1] << 16); o0.y = (d[2] & 0xffffu) | (d[3] << 16); o0.z = (d[4] & 0xffffu) | (d[5] << 16); o0.w = (d[6] & 0xffffu) | (d[7] << 16);
        o1.x = (d[0] >> 16) | (d[1] & 0xffff0000u); o1.y = (d[2] >> 16) | (d[3] & 0xffff0000u); o1.z = (d[4] >> 16) | (d[5] & 0xffff0000u); o1.w = (d[6] >> 16) | (d[7] & 0xffff0000u);
        bf16* dst = WT + (size_t)(64 * nb + nl) * K + 64 * kb + 8 * c;
        *(v4u*)dst = o0; *(v4u*)(dst + K) = o1;
    }
    LDS_WAIT(); asm volatile("" ::: "memory");
}
__device__ __forceinline__ unsigned pk4_fp8(float a, float b, float c, float d) { int r = __builtin_amdgcn_cvt_pk_fp8_f32(a, b, 0, false); r = __builtin_amdgcn_cvt_pk_fp8_f32(c, d, r, true); return (unsigned)r; }
__device__ __forceinline__ void p0_item_f8(const float* __restrict__ W, int N, int K, unsigned char* __restrict__ WT, int kb, int nb, int mapmode, LAS unsigned char* scr, int lane) {
    const int np = 64 * nb + 4 * (lane & 15);
    int src = np;
    if (mapmode == MAP_UG) { const int pn = np >> 8, L = np & 255, bj = L >> 7, i = L & 127; src = 1024 * bj + 128 * pn + i; }
    const float* gp = W + (size_t)(64 * kb + (lane >> 4)) * N + src;
    f32x4 v[16];
#pragma unroll
    for (int i = 0; i < 16; ++i) v[i] = *(const f32x4*)(gp + (size_t)(4 * i) * N);
#pragma unroll
    for (int i = 0; i < 16; ++i) *(LAS unsigned*)(scr + (4 * i + (lane >> 4)) * 68 + 4 * (lane & 15)) = pk4_fp8(v[i][0] * 64.0f, v[i][1] * 64.0f, v[i][2] * 64.0f, v[i][3] * 64.0f);
    LDS_WAIT(); asm volatile("" ::: "memory");
    const int nq = lane & 15, kg = lane >> 4;
    unsigned d[16];
#pragma unroll
    for (int j = 0; j < 16; ++j) d[j] = *(const LAS unsigned*)(scr + (16 * kg + j) * 68 + 4 * nq);
#pragma unroll
    for (int t = 0; t < 4; ++t) {
        v4u o;
#pragma unroll
        for (int q = 0; q < 4; ++q) o[q] = ((d[4 * q] >> (8 * t)) & 0xffu) | (((d[4 * q + 1] >> (8 * t)) & 0xffu) << 8) | (((d[4 * q + 2] >> (8 * t)) & 0xffu) << 16) | (((d[4 * q + 3] >> (8 * t)) & 0xffu) << 24);
        *(v4u*)(WT + (size_t)(64 * nb + 4 * nq + t) * K + 64 * kb + 16 * kg) = o;
    }
    LDS_WAIT(); asm volatile("" ::: "memory");
}
struct P0D { const float* gp; int N, K, kb, nb; bf16* W16; unsigned char* W8; const float* rsc; };
__device__ __forceinline__ int p0_src_col(int np, int mapmode) {
    int src = np;
    if (mapmode == MAP_IN) { const int pn = np >> 8, L = np & 255, bj = L >> 7, wc = (L >> 5) & 3, e = L & 31; src = 256 * pn + 64 * wc + 32 * bj + e; }
    else if (mapmode == MAP_UG) { const int pn = np >> 8, L = np & 255, bj = L >> 7, i = L & 127; src = 1024 * bj + 128 * pn + i; }
    return src;
}
__device__ __forceinline__ P0D p0_mk(const float* W, int N, int K, bf16* W16, unsigned char* W8, int kb, int nb, int mapmode, int lane, const float* rsc = nullptr) {
    P0D d; d.N = N; d.K = K; d.kb = kb; d.nb = nb; d.W16 = W16; d.W8 = W8;
    if (W8) {
        d.rsc = rsc ? rsc + 128 * kb + (lane >> 3) : nullptr;
        d.gp = W + (size_t)(128 * kb + (lane >> 3)) * N + p0_src_col(32 * nb + 4 * (lane & 7), mapmode);
    } else {
        d.rsc = nullptr;
        d.gp = W + (size_t)(64 * kb + (lane >> 4)) * N + p0_src_col(64 * nb + 4 * (lane & 15), mapmode);
    }
    return d;
}
__device__ __forceinline__ void p0_load(const P0D& d, f32x4 (&v)[16]) {
#pragma unroll
    for (int i = 0; i < 16; ++i) v[i] = __builtin_nontemporal_load((const f32x4*)(d.gp + (size_t)((d.W8 ? 8 : 4) * i) * d.N));
}
__device__ __forceinline__ void p0_finish(const P0D& d, const f32x4 (&v)[16], LAS unsigned char* scr, int lane, const int pm = 0) {
    if (pm == 1) { _Pragma("unroll") for (int i = 0; i < 16; ++i) asm volatile("" :: "v"(v[i])); return; }
    if (d.W16) {
#pragma unroll
        for (int i = 0; i < 16; ++i) { LAS unsigned* q = (LAS unsigned*)(scr + (4 * i + (lane >> 4)) * 132 + 8 * (lane & 15)); q[0] = cvtpk(v[i][0], v[i][1]); q[1] = cvtpk(v[i][2], v[i][3]); }
        LDS_WAIT(); asm volatile("" ::: "memory");
        const int c = lane & 7;
#pragma unroll
        for (int it = 0; it < 4; ++it) {
            const int nl = 16 * it + 2 * (lane >> 3);
            unsigned x[8];
#pragma unroll
            for (int j = 0; j < 8; ++j) x[j] = *(const LAS unsigned*)(scr + (8 * c + j) * 132 + 2 * nl);
            v4u o0, o1;
            o0.x = (x[0] & 0xffffu) | (x[1] << 16); o0.y = (x[2] & 0xffffu) | (x[3] << 16); o0.z = (x[4] & 0xffffu) | (x[5] << 16); o0.w = (x[6] & 0xffffu) | (x[7] << 16);
            o1.x = (x[0] >> 16) | (x[1] & 0xffff0000u); o1.y = (x[2] >> 16) | (x[3] & 0xffff0000u); o1.z = (x[4] >> 16) | (x[5] & 0xffff0000u); o1.w = (x[6] >> 16) | (x[7] & 0xffff0000u);
            bf16* dst = d.W16 + (size_t)(64 * d.nb + nl) * d.K + 64 * d.kb + 8 * c;
            if (pm == 0 || pm == 3) { *(v4u*)dst = o0; *(v4u*)(dst + d.K) = o1; } else asm volatile("" :: "v"(o0), "v"(o1));
        }
    } else {
#pragma unroll
        for (int i = 0; i < 16; ++i) { const float sc = d.rsc ? d.rsc[8 * i] * 64.0f : 64.0f; *(LAS unsigned*)(scr + (8 * i + (lane >> 3)) * 36 + 4 * (lane & 7)) = pk4_fp8(v[i][0] * sc, v[i][1] * sc, v[i][2] * sc, v[i][3] * sc); }
        LDS_WAIT(); asm volatile("" ::: "memory");
        const int nq = lane & 7, kg = lane >> 3;
        unsigned x[16];
#pragma unroll
        for (int j = 0; j < 16; ++j) x[j] = *(const LAS unsigned*)(scr + (16 * kg + j) * 36 + 4 * nq);
#pragma unroll
        for (int t = 0; t < 4; ++t) {
            v4u o;
#pragma unroll
            for (int q = 0; q < 4; ++q) o[q] = ((x[4 * q] >> (8 * t)) & 0xffu) | (((x[4 * q + 1] >> (8 * t)) & 0xffu) << 8) | (((x[4 * q + 2] >> (8 * t)) & 0xffu) << 16) | (((x[4 * q + 3] >> (8 * t)) & 0xffu) << 24);
            if (pm == 0 || pm == 3) __builtin_nontemporal_store(o, (v4u*)(d.W8 + (size_t)(32 * d.nb + 4 * nq + t) * d.K + 128 * d.kb + 16 * kg)); else asm volatile("" :: "v"(o));
        }
    }
    LDS_WAIT(); asm volatile("" ::: "memory");
}
__device__ __forceinline__ P0D p0_decode(const Args& a, unsigned char* ws, int it, int lane) {
    constexpr int I_IN = 16 * 56, I_OUT = 256, I_PG = 256, I_PP = 4 * 16, I_UG = 16 * 32, I_DN = 256;
    int r = it;
    if (r < I_IN) return p0_mk(a.w_in, DIN, DM, (bf16*)(ws + WS_WT_IN), nullptr, r / 56, r % 56, MAP_IN, lane); r -= I_IN;
    if (r < I_OUT) return p0_mk(a.w_out, DM, DM, (bf16*)(ws + WS_WT_OUT), nullptr, r / 16, r % 16, MAP_NAT, lane); r -= I_OUT;
    if (r < I_PG) return p0_mk(a.w_pg, DM, DM, nullptr, (unsigned char*)(ws + WS_WT_PG), r / 32, r % 32, MAP_NAT, lane); r -= I_PG;
    if (r < I_PP) return p0_mk(a.w_pp, DM, PLE, (bf16*)(ws + WS_WT_PP), nullptr, r / 16, r % 16, MAP_NAT, lane); r -= I_PP;
    if (r < NE * I_UG) { const int e = r / I_UG, q = r % I_UG; return p0_mk(a.w_ug + (size_t)e * DM * 2048, 2048, DM, nullptr, (unsigned char*)(ws + WS_WT_UG) + (size_t)e * 2048 * DM, q / 64, q % 64, MAP_UG, lane, a.g_ffn); } r -= NE * I_UG;
    { const int e = r / I_DN, q = r % I_DN; return p0_mk(a.w_dn + (size_t)e * DM * DM, DM, DM, nullptr, (unsigned char*)(ws + WS_WT_DN) + (size_t)e * DM * DM, q / 32, q % 32, MAP_NAT, lane); }
}
__device__ __forceinline__ void rms_row_to_bf16(const float* xrow, const float* g, bf16* orow, int lane) {
    const f32x4* xr = (const f32x4*)xrow + lane;
    f32x4 v[4]; float s = 0.f;
#pragma unroll
    for (int j = 0; j < 4; ++j) { v[j] = xr[64 * j]; s += (v[j][0] * v[j][0] + v[j][1] * v[j][1]) + (v[j][2] * v[j][2] + v[j][3] * v[j][3]); }
    const float rstd = rsqrtf(wave_sum(s) * (1.f / DM) + EPS);
    unsigned long long* o8 = (unsigned long long*)orow + lane;
#pragma unroll
    for (int j = 0; j < 4; ++j) { const f32x4 gg = ((const f32x4*)g)[lane + 64 * j];
        o8[64 * j] = (unsigned long long)cvtpk(v[j][0] * rstd * gg[0], v[j][1] * rstd * gg[1]) | ((unsigned long long)cvtpk(v[j][2] * rstd * gg[2], v[j][3] * rstd * gg[3]) << 32); }
}
__device__ __forceinline__ void p0_prologue(Frame& F, const Args& a, const int pm = 0) {
    unsigned char* ws = a.ws; const int tid = tid_now(F.wave), lane = tid & 63;
    LAS unsigned char* scr = F.lds + RING_OFF + F.wave * 8448;
    const int gw = F.vcu * NWAVES + F.wave, NGW = F.G * NWAVES;
    constexpr int I_IN = 16 * 56, I_OUT = 256, I_PG = 256, I_PP = 4 * 16, I_UG = 16 * 32, I_DN = 256;
    constexpr int NITEMS = I_IN + I_OUT + I_PG + I_PP + NE * I_UG + NE * I_DN;
    if (gw < NITEMS) {
        int it = gw; P0D d0 = p0_decode(a, ws, it, lane), d1 = d0; f32x4 va[16], vb[16]; p0_load(d0, va);
        for (;;) {
            const int it1 = it + NGW; const bool h1 = it1 < NITEMS;
            if (h1) { d1 = p0_decode(a, ws, it1, lane); p0_load(d1, vb); }
            p0_finish(d0, va, scr, lane, pm);
            if (!h1) break;
            const int it2 = it1 + NGW; const bool h2 = it2 < NITEMS;
            if (h2) { d0 = p0_decode(a, ws, it2, lane); p0_load(d0, va); }
            p0_finish(d1, vb, scr, lane, pm);
            if (!h2) break;
            it = it2;
        }
    }
    if (pm != 0) return;
    { v4u* tz = (v4u*)(ws + WS_TOKLIST); const v4u z4 = {0u, 0u, 0u, 0u}; for (int i = gw * 64 + lane; i < NE * T / 4; i += NGW * 64) tz[i] = z4; }
    if (blockIdx.x == 0 && tid < 256) { const int t = tid; const float* srcs = (t < 64) ? a.sbq : (t < 128) ? a.sbk : (t < 192) ? a.rq : a.rk; ((float*)(ws + WS_GAINS))[t] = srcs[t & 63]; }
    {
        f32x4 gg[4];
#pragma unroll
        for (int j = 0; j < 4; ++j) gg[j] = ((const f32x4*)a.g_mix)[lane + 64 * j];
        for (int m0 = 4 * gw; m0 < T; m0 += 4 * NGW) {
            f32x4 v[4][4];
#pragma unroll
            for (int r = 0; r < 4; ++r)
#pragma unroll
                for (int j = 0; j < 4; ++j) v[r][j] = __builtin_nontemporal_load((const f32x4*)(a.x + (size_t)(m0 + r) * DM) + lane + 64 * j);
#pragma unroll
            for (int r = 0; r < 4; ++r) {
                float ss = 0.f;
#pragma unroll
                for (int j = 0; j < 4; ++j) ss += (v[r][j][0] * v[r][j][0] + v[r][j][1] * v[r][j][1]) + (v[r][j][2] * v[r][j][2] + v[r][j][3] * v[r][j][3]);
                const float rstd = rsqrtf(wave_sum(ss) * (1.f / DM) + EPS);
                unsigned long long* o8 = (unsigned long long*)((bf16*)(ws + WS_XN) + (size_t)(m0 + r) * DM) + lane;
#pragma unroll
                for (int j = 0; j < 4; ++j) o8[64 * j] = (unsigned long long)cvtpk(v[r][j][0] * rstd * gg[j][0], v[r][j][1] * rstd * gg[j][1]) | ((unsigned long long)cvtpk(v[r][j][2] * rstd * gg[j][2], v[r][j][3] * rstd * gg[j][3]) << 32);
            }
        }
    }
    { const int gt = gw * 64 + lane, NGT = NGW * 64;
      for (int i0 = gt; i0 < T * PLE / 8; i0 += 4 * NGT) {
          f32x4 a0[4], a1[4];
#pragma unroll
          for (int q = 0; q < 4; ++q) { const int i = i0 + q * NGT; if (i < T * PLE / 8) { a0[q] = __builtin_nontemporal_load((const f32x4*)a.p + 2 * i); a1[q] = __builtin_nontemporal_load((const f32x4*)a.p + 2 * i + 1); } }
#pragma unroll
          for (int q = 0; q < 4; ++q) { const int i = i0 + q * NGT; if (i < T * PLE / 8) { v4u o; o.x = cvtpk(a0[q][0], a0[q][1]); o.y = cvtpk(a0[q][2], a0[q][3]); o.z = cvtpk(a1[q][0], a1[q][1]); o.w = cvtpk(a1[q][2], a1[q][3]); ((v4u*)(ws + WS_PB))[i] = o; } }
      }
      for (int i = gt; i < NE * DM; i += NGT) { const int e = i >> 10, k = i & (DM - 1); const float wv = a.w_r[(size_t)k * NE + e] * a.g_ffn[k];
          const unsigned hi = cvtpk(wv, 0.f) & 0xffffu; const unsigned lo = cvtpk(wv - __uint_as_float(hi << 16), 0.f) & 0xffffu;
          ((bf16*)(ws + WS_WRT))[i] = (bf16)hi; ((bf16*)(ws + WS_WRT))[NE * DM + i] = (bf16)lo; }
      float* rc = (float*)(ws + WS_ROPEC); float* rs = (float*)(ws + WS_ROPES);
      for (int i = gt; i < T * 32; i += NGT) { const int row = i >> 5, f = i & 31;
          const float inv_freq = exp2f(-(float)f * (13.287712379549449f / 32.0f));   const float ang = (float)a.positions[row] * inv_freq;
          float sn, cs; sincosf(ang, &sn, &cs); rc[i] = cs; rs[i] = sn; } }
}

namespace att {
typedef short bf16x8 __attribute__((ext_vector_type(8)));
typedef short s16x4 __attribute__((ext_vector_type(4)));
typedef float f32x16 __attribute__((ext_vector_type(16)));
typedef short v4i16_t __attribute__((ext_vector_type(4)));
constexpr int LK = 0, LV = 24576, LFLAG = 49152;
__device__ __forceinline__ s16x4 vtr(LAS const unsigned char* p) { return __builtin_bit_cast(s16x4, __builtin_amdgcn_ds_read_tr16_b64_v4i16((LAS v4i16_t*)p)); }
__device__ __forceinline__ int crow(int r, int hi) { return (r & 3) + 8 * (r >> 2) + 4 * hi; }
struct AttnArgs { const bf16* hm; const bf16* rg; bf16* Y; const float* gn_g; const float* gn_b; };

template <int MODE, int ABL = 0> __device__ __forceinline__ void attn_unit(LAS unsigned char* lds, const AttnArgs& A, int b, int h, int qb, const int wave_id) {
    int tid_ = wave_id * 64 + lane_id_hw(); asm volatile("" : "+v"(tid_));
    const int tid = tid_, lane = tid & 63, r32 = lane & 31, hh = lane >> 5;
    const int w = __builtin_amdgcn_readfirstlane(tid >> 6);
    const int q0 = qb * 256, qw = q0 + 32 * w;
    const size_t TS = (size_t)T * 512;
    const size_t hoff = (size_t)(b * 8 + h) * SEQ * 64;
    const bf16* Qp = A.hm + (MODE == 0 ? 0 : 3) * TS + hoff;
    const bf16* Kp = A.hm + (MODE == 0 ? 1 : 4) * TS + hoff;
    const bf16* Vp = A.hm + (MODE == 0 ? 2 : 5) * TS + hoff;
    bf16x8 qf[4];
#pragma unroll
    for (int ds = 0; ds < 4; ++ds) qf[ds] = *(const bf16x8*)(Qp + (size_t)(qw + r32) * 64 + 16 * ds + 8 * hh);
    f32x16 o[2];
#pragma unroll
    for (int r = 0; r < 16; ++r) { o[0][r] = 0.f; o[1][r] = 0.f; }
    float carry = 1.0f;
    const int jmax = (q0 + 255) >> 6, jd = (qw + 31) >> 6;
    const float lg2g = __log2f(1.0f - __builtin_amdgcn_exp2f(-5.0f - (float)h));
    const int krow = 8 * w + (lane >> 3);
    const bf16* Kt = Kp + (size_t)krow * 64 + (((lane & 7) ^ ((krow >> 1) & 7)) << 3); const bf16* Vt = Vp + (size_t)w * 512 + lane * 8;
    volatile LAS unsigned* flags = (volatile LAS unsigned*)(lds + LFLAG);
#define ATT_DMA(t, so) do { __builtin_amdgcn_global_load_lds((const unsigned*)(Kt + (size_t)(t) * 4096), (LAS unsigned*)(lds + LK + (so) + w * 1024), 16, 0, 0); \
                            __builtin_amdgcn_global_load_lds((const unsigned*)(Vt + (size_t)(t) * 4096), (LAS unsigned*)(lds + LV + (so) + w * 1024), 16, 0, 0); } while (0)
    ATT_DMA(jmax, 0);
    if (jmax >= 1) { ATT_DMA(jmax - 1, 8192); asm volatile("s_waitcnt vmcnt(2)\n\ts_barrier" ::: "memory"); }
    else asm volatile("s_waitcnt vmcnt(0)\n\ts_barrier" ::: "memory");
    bool finished = false;
    int so_cur = 0, so_new = 16384;
    for (int j = jmax; j >= 0; --j) {
        const int cur = j & 1;
        if (j >= 2 && ABL != 4) ATT_DMA(j - 2, so_new);
        if (j <= jd && !finished && ABL == 0) {
            LAS const unsigned char* Kb = lds + LK + so_cur;
            LAS const unsigned char* Vb = lds + LV + so_cur;
            f32x16 p[2];
#pragma unroll
            for (int r = 0; r < 16; ++r) { p[0][r] = 0.f; p[1][r] = 0.f; }
            bf16x8 kf[4][2];
            const int ksw = (r32 >> 1) & 7;
#pragma unroll
            for (int ds = 0; ds < 4; ++ds) { kf[ds][0] = *(LAS const bf16x8*)(Kb + r32 * 128 + (((2 * ds + hh) ^ ksw) << 4)); kf[ds][1] = *(LAS const bf16x8*)(Kb + 4096 + r32 * 128 + (((2 * ds + hh) ^ ksw) << 4)); }
#pragma unroll
            for (int ds = 0; ds < 4; ++ds) {
                p[0] = __builtin_amdgcn_mfma_f32_32x32x16_bf16(kf[ds][0], qf[ds], p[0], 0, 0, 0);
                p[1] = __builtin_amdgcn_mfma_f32_32x32x16_bf16(kf[ds][1], qf[ds], p[1], 0, 0, 0);
            }
            const bool diag = (j == jd);
            const int qg = qw + r32, kv0 = 64 * j + 4 * hh;
            if (MODE == 0) {
                float om[2][16];
#pragma unroll
                for (int hf = 0; hf < 2; ++hf)
#pragma unroll
                    for (int r = 0; r < 16; ++r) {
                        const float a = __builtin_amdgcn_exp2f(__builtin_fminf(-p[hf][r], 120.0f));
                        const float rc = __builtin_amdgcn_rcpf(1.0f + a);
                        p[hf][r] = rc;
                        om[hf][r] = a * rc;
                    }
                if (diag) {
#pragma unroll
                    for (int hf = 0; hf < 2; ++hf)
#pragma unroll
                        for (int r = 0; r < 16; ++r) { const bool valid = kv0 + 32 * hf + (r & 3) + 8 * (r >> 2) < qg; p[hf][r] = valid ? p[hf][r] : 0.f; om[hf][r] = valid ? om[hf][r] : 1.0f; }
                }
                float gs[8], ot[8];
#pragma unroll
                for (int m = 0; m < 8; ++m) { const int hf = m >> 2, g = m & 3; gs[m] = (om[hf][4 * g] * om[hf][4 * g + 1]) * (om[hf][4 * g + 2] * om[hf][4 * g + 3]); ot[m] = __shfl_xor(gs[m], 32); }
                float ps[8];
                ps[7] = 1.0f;
#pragma unroll
                for (int m = 6; m >= 0; --m) ps[m] = ps[m + 1] * (gs[m + 1] * ot[m + 1]);
                const float total = ps[0] * (gs[0] * ot[0]);
#pragma unroll
                for (int m = 0; m < 8; ++m) {
                    const int hf = m >> 2, g = m & 3;
                    float tail = carry * (hh ? ps[m] : ps[m] * ot[m]);
#pragma unroll
                    for (int i = 3; i >= 0; --i) { const int r = 4 * g + i; const float o1 = om[hf][r]; p[hf][r] *= tail; tail *= o1; }
                }
                carry *= total;
                finished = __all(carry < 1.0e-37f);
            } else {
                const float ct = __builtin_amdgcn_exp2f(lg2g * (float)(qw - 64 * j));
#pragma unroll
                for (int hf = 0; hf < 2; ++hf)
#pragma unroll
                    for (int r = 0; r < 16; ++r) p[hf][r] *= ct;
                if (diag) {
#pragma unroll
                    for (int hf = 0; hf < 2; ++hf)
#pragma unroll
                        for (int r = 0; r < 16; ++r) { const bool valid = kv0 + 32 * hf + (r & 3) + 8 * (r >> 2) <= qg; p[hf][r] = valid ? p[hf][r] : 0.f; }
                }
            }
            {
                const unsigned vbase = (unsigned)(uintptr_t)(Vb + (4 * hh + ((lane & 15) >> 2)) * 128 + (16 * ((lane >> 4) & 1) + 4 * (lane & 3)) * 2);
                s16x4 vl[2][2][2], vh[2][2][2];
#pragma unroll
                for (int hf = 0; hf < 2; ++hf)
#pragma unroll
                    for (int s = 0; s < 2; ++s)
#pragma unroll
                        for (int d0 = 0; d0 < 2; ++d0) {
                            asm volatile("ds_read_b64_tr_b16 %0, %1 offset:%c2" : "=&v"(vl[hf][s][d0]) : "v"(vbase), "i"(hf * 4096 + s * 2048 + d0 * 64) : "memory");
                            asm volatile("ds_read_b64_tr_b16 %0, %1 offset:%c2" : "=&v"(vh[hf][s][d0]) : "v"(vbase), "i"(hf * 4096 + s * 2048 + d0 * 64 + 1024) : "memory");
                        }
                bf16x8 wfr[2][2];
#pragma unroll
                for (int hf = 0; hf < 2; ++hf)
#pragma unroll
                    for (int s = 0; s < 2; ++s) {
                        u32x4_t wq;
                        wq.x = pg8::cvt_pk_bf16(p[hf][8 * s + 0], p[hf][8 * s + 1]); wq.y = pg8::cvt_pk_bf16(p[hf][8 * s + 2], p[hf][8 * s + 3]);
                        wq.z = pg8::cvt_pk_bf16(p[hf][8 * s + 4], p[hf][8 * s + 5]); wq.w = pg8::cvt_pk_bf16(p[hf][8 * s + 6], p[hf][8 * s + 7]);
                        wfr[hf][s] = __builtin_bit_cast(bf16x8, wq);
                    }
                asm volatile("s_waitcnt lgkmcnt(0)" ::: "memory"); __builtin_amdgcn_sched_barrier(0);
#pragma unroll
                for (int hf = 0; hf < 2; ++hf)
#pragma unroll
                    for (int s = 0; s < 2; ++s)
#pragma unroll
                        for (int d0 = 0; d0 < 2; ++d0) {
                            const s16x4 lo = vl[hf][s][d0], hi = vh[hf][s][d0];
                            const bf16x8 vf = (bf16x8){lo[0], lo[1], lo[2], lo[3], hi[0], hi[1], hi[2], hi[3]};
                            o[d0] = __builtin_amdgcn_mfma_f32_32x32x16_bf16(vf, wfr[hf][s], o[d0], 0, 0, 0);
                        }
            }
        }
        if (MODE == 0) { if (lane == 0) flags[cur * 8 + w] = finished ? 1u : 0u; }
        if (j >= 2) asm volatile("s_waitcnt vmcnt(2) lgkmcnt(0)\n\ts_barrier" ::: "memory"); else asm volatile("s_waitcnt vmcnt(0) lgkmcnt(0)\n\ts_barrier" ::: "memory");
        so_cur = (so_cur == 16384) ? 0 : so_cur + 8192; so_new = (so_new == 16384) ? 0 : so_new + 8192;
        if (MODE == 0) {
            unsigned all = 1u;
#pragma unroll
            for (int i = 0; i < 8; ++i) all &= flags[cur * 8 + i];
            if (all) break;
        }
    }
    asm volatile("s_waitcnt vmcnt(0)\n\ts_barrier" ::: "memory");
#undef ATT_DMA
    const int row = b * SEQ + qw + r32;
    if (MODE == 0) {
        bf16* yp = A.Y + (size_t)row * DM + h * 64 + 4 * hh;
#pragma unroll
        for (int d0 = 0; d0 < 2; ++d0)
#pragma unroll
            for (int g = 0; g < 4; ++g) { u32x2_t v; v.x = pg8::cvt_pk_bf16(o[d0][4 * g], o[d0][4 * g + 1]); v.y = pg8::cvt_pk_bf16(o[d0][4 * g + 2], o[d0][4 * g + 3]); *(u32x2_t*)(yp + 32 * d0 + 8 * g) = v; }
    } else {
        float s1 = 0.f;
#pragma unroll
        for (int r = 0; r < 16; ++r) s1 += o[0][r] + o[1][r];
        s1 += __shfl_xor(s1, 32);
        const float mu = s1 * (1.0f / 64.0f);
        float s2 = 0.f;
#pragma unroll
        for (int r = 0; r < 16; ++r) { const float a0 = o[0][r] - mu, a1 = o[1][r] - mu; s2 += a0 * a0 + a1 * a1; }
        s2 += __shfl_xor(s2, 32);
        const float rstd = rsqrtf(s2 * (1.0f / 64.0f) + EPS);
        bf16* yp = A.Y + (size_t)row * DM + 512 + h * 64 + 4 * hh;
        const bf16* gp = A.rg + (size_t)row * 512 + h * 64 + 4 * hh;
        const float* gg = A.gn_g + h * 64 + 4 * hh; const float* gb = A.gn_b + h * 64 + 4 * hh;
#pragma unroll
        for (int d0 = 0; d0 < 2; ++d0)
#pragma unroll
            for (int g = 0; g < 4; ++g) {
                const f32x4 gn = *(const f32x4*)(gg + 32 * d0 + 8 * g), bs = *(const f32x4*)(gb + 32 * d0 + 8 * g);
                const u32x2_t gr = *(const u32x2_t*)(gp + 32 * d0 + 8 * g);
                float gate[4] = {__uint_as_float(gr.x << 16), __uint_as_float(gr.x & 0xffff0000u), __uint_as_float(gr.y << 16), __uint_as_float(gr.y & 0xffff0000u)};
                float ov[4];
#pragma unroll
                for (int i = 0; i < 4; ++i) { const float yn = (o[d0][4 * g + i] - mu) * rstd * gn[i] + bs[i]; const float sg = gate[i] / (1.0f + __expf(-gate[i])); ov[i] = yn * sg; }
                u32x2_t v; v.x = pg8::cvt_pk_bf16(ov[0], ov[1]); v.y = pg8::cvt_pk_bf16(ov[2], ov[3]); *(u32x2_t*)(yp + 32 * d0 + 8 * g) = v;
            }
    }
}
__device__ __forceinline__ void attn_phase(LAS unsigned char* lds, const AttnArgs& A, int vcu, int dup, bf16* dummyY, const int wave_id) {
    const int g = vcu >> 5, local = vcu & 31;
    if (dup == 24 || dup == 25) { AttnArgs A2 = A; A2.Y = dummyY;
#pragma unroll 1
        for (int u = 0; u < 2; ++u) { const int bh = 8 * g + 4 * (u & 1) + (local >> 3), qb = (u & 1) ? 7 - (local & 7) : (local & 7); if (dup == 24) attn_unit<1, 3>(lds, A2, bh >> 3, bh & 7, qb, wave_id); else attn_unit<1, 4>(lds, A2, bh >> 3, bh & 7, qb, wave_id); } }
#pragma unroll 1
    for (int u = 0; u < ((dup == 20) ? 4 : 2); ++u) { const int bh = 8 * g + 4 * (u & 1) + (local >> 3), qb = (u & 1) ? 7 - (local & 7) : (local & 7); attn_unit<1>(lds, A, bh >> 3, bh & 7, qb, wave_id); }
#pragma unroll 1
    for (int u = 0; u < ((dup == 21) ? 4 : 2); ++u) { const int bh = 8 * g + 4 * (u & 1) + (local >> 3), qb = (u & 1) ? 7 - (local & 7) : (local & 7); attn_unit<0>(lds, A, bh >> 3, bh & 7, qb, wave_id); }
}
}

constexpr int CW_GCNT = 32768;
constexpr int LR_LCNT = LDSCTL_OFF + 1024, LR_GBASE = LDSCTL_OFF + 1152;
constexpr int LT_POFF = LDSCTL_OFF + 2048, LT_NT = LDSCTL_OFF + 2176, LT_TILE_E = LDSCTL_OFF + 2304, LT_FIRST = LDSCTL_OFF + 3712;
struct RouteBufs { int* tok_e; int* tok_slot; float* tok_gate; float* rstd; int* toklist; };
__device__ __forceinline__ RouteBufs route_bufs(unsigned char* ws) { RouteBufs r; r.tok_e = (int*)(ws + WS_ROUTE); r.tok_slot = r.tok_e + T * 4; r.tok_gate = (float*)(r.tok_slot + T * 4); r.rstd = (float*)(ws + WS_ROUTE + 1 * MiB); r.toklist = (int*)(ws + WS_TOKLIST); return r; }
typedef float f32x2v __attribute__((ext_vector_type(2)));
__device__ __forceinline__ unsigned opq_mask(bool c) { unsigned m = c ? 0xffffffffu : 0u; asm volatile("" : "+v"(m)); return m; }
__device__ __forceinline__ float blendf(unsigned m, float a, float b) { return __uint_as_float((__float_as_uint(a) & m) | (__float_as_uint(b) & ~m)); }
__device__ __forceinline__ int blendi(unsigned m, int a, int b) { return (int)(((unsigned)a & m) | ((unsigned)b & ~m)); }

#define SW2(c, a, b) { const float ta_ = (c) ? (b) : (a), tb_ = (c) ? (a) : (b); a = ta_; b = tb_; }
#define SW2I(c, a, b) { const int ta_ = (c) ? (b) : (a), tb_ = (c) ? (a) : (b); a = ta_; b = tb_; }
#define TOP4_INSERT(x, e) { const float x_ = (x); const int e_ = (e); const bool c3_ = (x_ > v3) || (x_ == v3 && e_ < i3); v3 = c3_ ? x_ : v3; i3 = c3_ ? e_ : i3; \
    const bool c2_ = (v3 > v2) || (v3 == v2 && i3 < i2); SW2(c2_, v2, v3) SW2I(c2_, i2, i3) const bool c1_ = (v2 > v1) || (v2 == v1 && i2 < i1); SW2(c1_, v1, v2) SW2I(c1_, i1, i2) \
    const bool c0_ = (v1 > v0) || (v1 == v0 && i1 < i0); SW2(c0_, v0, v1) SW2I(c0_, i0, i1) }
__device__ __forceinline__ void router_phase(Frame& F, const Args& a, const bool dry = false) {
    unsigned char* ws = a.ws; const int tid = tid_now(F.wave);
    LAS unsigned char* lds = F.lds;
    const int lane = tid & 63, r32 = lane & 31, hh = lane >> 5, w = F.wave, rg = w >> 2, kq = w & 3;
    volatile LAS unsigned* lcnt = (volatile LAS unsigned*)(lds + LR_LCNT);
    volatile LAS unsigned* gbase = (volatile LAS unsigned*)(lds + LR_GBASE);
    if (tid < 32) lcnt[tid] = 0u;
    const RouteBufs R = route_bufs(ws);
    const int row = F.vcu * 64 + 32 * rg + r32;
    const bf16* xr = (const bf16*)(ws + WS_X1) + (size_t)row * DM + 256 * kq + 8 * hh;
    const bf16* wt = (const bf16*)(ws + WS_WRT) + (size_t)r32 * DM + 256 * kq + 8 * hh;
    unsigned char* hp = (unsigned char*)(ws + (dry ? WS_H : WS_XN)) + (size_t)row * DM + 256 * kq + 8 * hh;
    att::f32x16 D;
#pragma unroll
    for (int r = 0; r < 16; ++r) D[r] = 0.f;
    float ss = 0.f;
#pragma unroll 8
    for (int ks = 0; ks < 16; ++ks) {
        const u32x4_t xh = *(const u32x4_t*)(xr + 16 * ks);
        const f32x4 v0 = (f32x4){__uint_as_float(xh.x << 16), __uint_as_float(xh.x & 0xffff0000u), __uint_as_float(xh.y << 16), __uint_as_float(xh.y & 0xffff0000u)};
        const f32x4 v1 = (f32x4){__uint_as_float(xh.z << 16), __uint_as_float(xh.z & 0xffff0000u), __uint_as_float(xh.w << 16), __uint_as_float(xh.w & 0xffff0000u)};
        ss += ((v0[0] * v0[0] + v0[1] * v0[1]) + (v0[2] * v0[2] + v0[3] * v0[3])) + ((v1[0] * v1[0] + v1[1] * v1[1]) + (v1[2] * v1[2] + v1[3] * v1[3]));
        u32x2_t h8; h8.x = pk4_fp8(v0[0], v0[1], v0[2], v0[3]); h8.y = pk4_fp8(v1[0], v1[1], v1[2], v1[3]); *(u32x2_t*)(hp + 16 * ks) = h8;
        const att::bf16x8 whi = *(const att::bf16x8*)(wt + 16 * ks), wlo = *(const att::bf16x8*)(wt + 32 * DM + 16 * ks);
        const att::bf16x8 bxh = __builtin_bit_cast(att::bf16x8, xh);
        D = __builtin_amdgcn_mfma_f32_32x32x16_bf16(whi, bxh, D, 0, 0, 0);
        D = __builtin_amdgcn_mfma_f32_32x32x16_bf16(wlo, bxh, D, 0, 0, 0);
    }
    { LAS f32x4* dp = (LAS f32x4*)(lds + (w * 64 + lane) * 64);
#pragma unroll
      for (int q = 0; q < 4; ++q) dp[q] = (f32x4){D[4 * q], D[4 * q + 1], D[4 * q + 2], D[4 * q + 3]};
      *(LAS float*)(lds + 32768 + (w * 64 + lane) * 4) = ss; }
    __syncthreads();
    int my_e0 = 0, my_e1 = 0, rk0 = 0, rk1 = 0; float my_g0 = 0.f, my_g1 = 0.f;
    if (kq == 0) {
#pragma unroll
        for (int o = 1; o < 4; ++o) { LAS const f32x4* dp = (LAS const f32x4*)(lds + ((w + o) * 64 + lane) * 64);
#pragma unroll
            for (int q = 0; q < 4; ++q) { const f32x4 t = dp[q]; D[4 * q] += t[0]; D[4 * q + 1] += t[1]; D[4 * q + 2] += t[2]; D[4 * q + 3] += t[3]; }
            ss += *(LAS const float*)(lds + 32768 + ((w + o) * 64 + lane) * 4); }
        ss += __shfl_xor(ss, 32);
        const float rstd = rsqrtf(ss * (1.f / DM) + EPS);
        if (hh == 0) R.rstd[row] = rstd;
        float l[16];
#pragma unroll
        for (int r = 0; r < 16; ++r) l[r] = D[r] * rstd + a.b_r[(r & 3) + 8 * (r >> 2) + 4 * hh];
        float c[8]; int ci[8];
#pragma unroll
        for (int k = 0; k < 4; ++k) {
            float bv = -INFINITY; int bi = 99;
#pragma unroll
            for (int r = 0; r < 16; ++r) { const int e = (r & 3) + 8 * (r >> 2) + 4 * hh; const bool bt = l[r] > bv; bv = bt ? l[r] : bv; bi = bt ? e : bi; }
            c[k] = bv; ci[k] = bi;
#pragma unroll
            for (int r = 0; r < 16; ++r) { const int e = (r & 3) + 8 * (r >> 2) + 4 * hh; l[r] = (e == bi) ? -INFINITY : l[r]; }
        }
#pragma unroll
        for (int k = 0; k < 4; ++k) { c[4 + k] = __shfl_xor(c[k], 32); ci[4 + k] = __shfl_xor(ci[k], 32); }
        float tv[4]; int ti[4];
#pragma unroll
        for (int k = 0; k < 4; ++k) {
            float bv = -INFINITY; int bi = 99;
#pragma unroll
            for (int j = 0; j < 8; ++j) { const bool bt = (c[j] > bv) || (c[j] == bv && ci[j] < bi); bv = bt ? c[j] : bv; bi = bt ? ci[j] : bi; }
            tv[k] = bv; ti[k] = bi;
#pragma unroll
            for (int j = 0; j < 8; ++j) c[j] = (ci[j] == bi) ? -INFINITY : c[j];
        }
        const float v0 = tv[0], v1 = tv[1], v2 = tv[2], v3 = tv[3]; const int i0 = ti[0], i1 = ti[1], i2 = ti[2], i3 = ti[3];
        const float e1 = __expf(v1 - v0), e2 = __expf(v2 - v0), e3 = __expf(v3 - v0), inv = 1.0f / (1.0f + e1 + e2 + e3);
        my_e0 = hh ? i2 : i0; my_e1 = hh ? i3 : i1; my_g0 = (hh ? e2 : 1.0f) * inv; my_g1 = (hh ? e3 : e1) * inv;
        rk0 = (int)__hip_atomic_fetch_add((LAS unsigned*)(lds + LR_LCNT) + my_e0, 1u, __ATOMIC_RELAXED, __HIP_MEMORY_SCOPE_WORKGROUP);
        rk1 = (int)__hip_atomic_fetch_add((LAS unsigned*)(lds + LR_LCNT) + my_e1, 1u, __ATOMIC_RELAXED, __HIP_MEMORY_SCOPE_WORKGROUP);
    }
    __syncthreads();
    if (tid < 32) gbase[tid] = __hip_atomic_fetch_add((unsigned*)(F.ctl + CW_GCNT + (dry ? 4096 : 0)) + 64 * tid, lcnt[tid], __ATOMIC_RELAXED, __HIP_MEMORY_SCOPE_AGENT);
    __syncthreads();
    if (kq == 0) {
        const int k0 = 2 * hh;
        const int s0 = (int)gbase[my_e0] + rk0, s1 = (int)gbase[my_e1] + rk1;
        R.tok_e[row * 4 + k0] = my_e0; R.tok_slot[row * 4 + k0] = s0; R.tok_gate[row * 4 + k0] = my_g0; R.toklist[(size_t)my_e0 * T + s0] = row;
        R.tok_e[row * 4 + k0 + 1] = my_e1; R.tok_slot[row * 4 + k0 + 1] = s1; R.tok_gate[row * 4 + k0 + 1] = my_g1; R.toklist[(size_t)my_e1 * T + s1] = row;
    }
}
#undef SW2
#undef SW2I
#undef TOP4_INSERT

__device__ __forceinline__ void build_tables(Frame& F) {
    LAS int* poff = (LAS int*)(F.lds + LT_POFF); LAS int* ntp = (LAS int*)(F.lds + LT_NT); LAS int* tile_e = (LAS int*)(F.lds + LT_TILE_E);
    LAS int* cnts = (LAS int*)(F.lds + LR_LCNT); const int tid = tid_now(F.wave);
    if (tid < NE) cnts[tid] = (int)__hip_atomic_load((unsigned*)(F.ctl + CW_GCNT) + 64 * tid, __ATOMIC_RELAXED, __HIP_MEMORY_SCOPE_AGENT);
    __syncthreads();
    if (tid == 0) {
        int t = 0;
        for (int e = 0; e < NE; ++e) { const int c = cnts[e]; const int nt = (c + 255) >> 8; poff[e] = t * 256; ((LAS int*)(F.lds + LT_FIRST))[e] = t; for (int i = 0; i < nt; ++i) tile_e[t + i] = e; t += nt; }
        *ntp = t;
    }
    __syncthreads();
}
__device__ __forceinline__ void combine_phase(Frame& F, const Args& a, const bool dry = false) {
    unsigned char* ws = a.ws; const RouteBufs R = route_bufs(ws);
    LAS const int* poff = (LAS const int*)(F.lds + LT_POFF);
    const int gw = F.vcu * NWAVES + F.wave, NGW = F.G * NWAVES, lane = tid_now(F.wave) & 63;
    for (int m0 = 2 * gw; m0 < T; m0 += 2 * NGW) {
        f32x4 v[2][2][2]; u32x2_t y[2][4][2]; float gt[2][4];
#pragma unroll
        for (int rr = 0; rr < 2; ++rr) { const int m = m0 + rr;
#pragma unroll
            for (int i = 0; i < 2; ++i) { { const v4u xq = __builtin_nontemporal_load((const v4u*)((const bf16*)(ws + WS_X1) + (size_t)m * DM + 8 * lane + 512 * i)); v[rr][i][0] = (f32x4){__uint_as_float(xq[0] << 16), __uint_as_float(xq[0] & 0xffff0000u), __uint_as_float(xq[1] << 16), __uint_as_float(xq[1] & 0xffff0000u)}; v[rr][i][1] = (f32x4){__uint_as_float(xq[2] << 16), __uint_as_float(xq[2] & 0xffff0000u), __uint_as_float(xq[3] << 16), __uint_as_float(xq[3] & 0xffff0000u)}; } }
#pragma unroll
            for (int k = 0; k < 4; ++k) { const int e = R.tok_e[m * 4 + k], slot = R.tok_slot[m * 4 + k]; gt[rr][k] = R.tok_gate[m * 4 + k];
                const unsigned char* yr = (const unsigned char*)(ws + WS_YS) + (size_t)(poff[e] + slot) * DM + 8 * lane;
                y[rr][k][0] = __builtin_nontemporal_load((const u32x2_t*)yr); y[rr][k][1] = __builtin_nontemporal_load((const u32x2_t*)(yr + 512)); } }
#pragma unroll
        for (int rr = 0; rr < 2; ++rr) { const int m = m0 + rr;
#pragma unroll
            for (int k = 0; k < 4; ++k)
#pragma unroll
                for (int i = 0; i < 2; ++i) { const u32x2_t yy = y[rr][k][i]; const float g = gt[rr][k];
                    const f32x2v a0 = __builtin_amdgcn_cvt_pk_f32_fp8((int)yy.x, false), a1 = __builtin_amdgcn_cvt_pk_f32_fp8((int)yy.x, true), a2 = __builtin_amdgcn_cvt_pk_f32_fp8((int)yy.y, false), a3 = __builtin_amdgcn_cvt_pk_f32_fp8((int)yy.y, true);
                    v[rr][i][0][0] += g * a0[0]; v[rr][i][0][1] += g * a0[1]; v[rr][i][0][2] += g * a1[0]; v[rr][i][0][3] += g * a1[1];
                    v[rr][i][1][0] += g * a2[0]; v[rr][i][1][1] += g * a2[1]; v[rr][i][1][2] += g * a3[0]; v[rr][i][1][3] += g * a3[1]; }
            float ss = 0.f;
#pragma unroll
            for (int i = 0; i < 2; ++i)
#pragma unroll
                for (int q = 0; q < 2; ++q) { const f32x4 t = v[rr][i][q]; ss += (t[0] * t[0] + t[1] * t[1]) + (t[2] * t[2] + t[3] * t[3]); }
            const float rstd = rsqrtf(wave_sum(ss) * (1.f / DM) + EPS);
            unsigned char* np = (unsigned char*)(ws + (dry ? WS_H : WS_XN)) + (size_t)m * DM + 8 * lane; bf16* ow = (bf16*)(ws + (dry ? WS_XS : WS_Y));
#pragma unroll
            for (int i = 0; i < 2; ++i) { { v4u xb; xb[0] = cvtpk(v[rr][i][0][0], v[rr][i][0][1]); xb[1] = cvtpk(v[rr][i][0][2], v[rr][i][0][3]); xb[2] = cvtpk(v[rr][i][1][0], v[rr][i][1][1]); xb[3] = cvtpk(v[rr][i][1][2], v[rr][i][1][3]); *(v4u*)(ow + (size_t)m * DM + 8 * lane + 512 * i) = xb; }
                const f32x4 g0 = *(const f32x4*)(a.g_ple + 8 * lane + 512 * i), g1 = *(const f32x4*)(a.g_ple + 8 * lane + 512 * i + 4);
                u32x2_t o; o.x = pk4_fp8(v[rr][i][0][0] * rstd * g0[0], v[rr][i][0][1] * rstd * g0[1], v[rr][i][0][2] * rstd * g0[2], v[rr][i][0][3] * rstd * g0[3]);
                o.y = pk4_fp8(v[rr][i][1][0] * rstd * g1[0], v[rr][i][1][1] * rstd * g1[1], v[rr][i][1][2] * rstd * g1[2], v[rr][i][1][3] * rstd * g1[3]);
                *(u32x2_t*)(np + 512 * i) = o; } }
    }
}

__global__ void __launch_bounds__(NWAVES * 64, 2) mega_fwd(Args args) {
    extern __shared__ __attribute__((aligned(16))) unsigned char lds[];
    Frame F;
    F.lds = (LAS unsigned char*)lds;
    F.MISC = (volatile LAS unsigned*)(F.lds + MISC_OFF);
    F.wave = __builtin_amdgcn_readfirstlane(threadIdx.x >> 6);
    F.G = gridDim.x; { const int bx = blockIdx.x; F.vcu = (F.G % 8 == 0) ? (bx % 8) * (F.G / 8) + bx / 8 : bx; }
    unsigned char* ws = args.ws;
    F.ctl = (gu32*)(ws + WS_CTL);
    for (int u = threadIdx.x; u < (LDS_BYTES - LDSCTL_OFF) / 4; u += NWAVES * 64) ((LAS unsigned*)(F.lds + LDSCTL_OFF))[u] = 0u;
    __syncthreads();
    XcdBarrier bar = xcd_barrier_post((unsigned*)(F.ctl + CW_BAR), F.MISC + 8); bar.wave = F.wave;
    const int lo = args.ph_lo, hi = args.ph_hi;
#define IN(k) (lo <= (k) && (k) < hi)
#define GRID_BAR() xcd_barrier(bar)
#ifndef DUP_PHASE
#define DUP_PHASE -1
#endif
#define REP(k) for (int rep_ = 0; rep_ < ((DUP_PHASE) == (k) ? 2 : 1); ++rep_)

    if (IN(0)) { if (DUP_PHASE == 40) { p0_prologue(F, args, 1); GRID_BAR(); } if (DUP_PHASE == 41) { p0_prologue(F, args, 2); GRID_BAR(); } if (DUP_PHASE == 42) { p0_prologue(F, args, 3); GRID_BAR(); } REP(0) { p0_prologue(F, args); GRID_BAR(); } }

    if (IN(1)) REP(1) {
        pg8::Gemm g{(const pg8::bf16_t*)(ws + WS_XN), (const pg8::bf16_t*)(ws + WS_WT_IN), DM, 0};
        pg8::StaticOrder S; S.init(T / 256, DIN / 256, F.G, (int)blockIdx.x);
        pg8::EpiProj E{(pg8::bf16_t*)(ws + WS_HM), (pg8::bf16_t*)(ws + WS_RG), (const float*)(ws + WS_GAINS), (const float*)(ws + WS_ROPEC), (const float*)(ws + WS_ROPES)};
        pg8::gemm_phase<pg8::EpiProj, pg8::StaticOrder, true, true>(F.lds + RING_OFF, g, S, E, F.wave);
        {
            const int G2 = (F.G == 256) ? 128 : F.G, c2 = (F.G == 256) ? (int)blockIdx.x - 128 : (int)blockIdx.x;
            if (c2 >= 0) {
                pg8::Gemm g2{(const pg8::bf16_t*)(ws + WS_PB), (const pg8::bf16_t*)(ws + WS_WT_PP), PLE, 0};
                pg8::StaticOrder S2; S2.init(T / 256, DM / 256, G2, c2);
                pg8::EpiBf16Plain E2{(pg8::bf16_t*)(ws + WS_PJ), DM};
                pg8::gemm_phase<pg8::EpiBf16Plain, pg8::StaticOrder, true, true>(F.lds + RING_OFF, g2, S2, E2, F.wave);
            }
        }
        GRID_BAR();
    }
    if (DUP_PHASE == 51 && IN(1)) {
        pg8::Gemm g{(const pg8::bf16_t*)(ws + WS_XN), (const pg8::bf16_t*)(ws + WS_WT_IN), DM, 0};
        pg8::StaticOrder S; S.init(T / 256, DIN / 256, F.G, (int)blockIdx.x);
        pg8::EpiNull E;
        pg8::gemm_phase<pg8::EpiNull, pg8::StaticOrder, true, true>(F.lds + RING_OFF, g, S, E, F.wave);
        GRID_BAR();
    }
    if (IN(2)) REP(2) {
        if (F.G == 256) {
            const att::AttnArgs AA{(const bf16*)(ws + WS_HM), (const bf16*)(ws + WS_RG), (bf16*)(ws + WS_Y), args.gn_g, args.gn_b};
            att::attn_phase(F.lds + RING_OFF, AA, F.vcu, DUP_PHASE, (bf16*)(ws + WS_XS), F.wave);
        }
        GRID_BAR();
    }
    if (IN(3)) REP(3) {
        pg8::Gemm g{(const pg8::bf16_t*)(ws + WS_Y), (const pg8::bf16_t*)(ws + WS_WT_OUT), DM, 0};
        pg8::StaticOrder S; S.init(T / 256, DM / 256, F.G, (int)blockIdx.x);
        pg8::EpiResid E{args.x, (pg8::bf16_t*)(ws + WS_X1)};
        pg8::gemm_phase<pg8::EpiResid, pg8::StaticOrder, true, true>(F.lds + RING_OFF, g, S, E, F.wave);
        GRID_BAR();
    }
    if (DUP_PHASE == 30 && IN(3)) { GRID_BAR(); GRID_BAR(); GRID_BAR(); GRID_BAR(); }
    if (IN(4)) { if (DUP_PHASE == 4) { if (F.G == 256) router_phase(F, args, true); GRID_BAR(); } if (F.G == 256) router_phase(F, args); GRID_BAR(); }
    if (IN(5) || (lo >= 6 && lo <= 8)) build_tables(F);
    if (IN(6)) REP(6) {
        const int NT = *(LAS const int*)(F.lds + LT_NT);
        pg8::Gemm g{(const pg8::bf16_t*)(ws + WS_XN), (const pg8::bf16_t*)(ws + WS_WT_UG), DM / 2, (size_t)2048 * DM};
        pg8::MoeOrder S; S.init(NT, 8, F.G, (int)blockIdx.x, (LAS const int*)(F.lds + LT_TILE_E), F.wave, 1, args.b_ug, route_bufs(ws).rstd, F.lds + PF_OFF);
        S.toklist = route_bufs(ws).toklist; S.first_tile = (LAS const int*)(F.lds + LT_FIRST); S.tokl = F.lds + TOKL_OFF;
        pg8::EpiMoeUp E{(unsigned char*)(ws + WS_H), F.lds + PF_OFF};
        pg8::gemm_phase<pg8::EpiMoeUp, pg8::MoeOrder, true, true, true, true>(F.lds + RING_OFF, g, S, E, F.wave);
        GRID_BAR();
    }
    if (IN(7)) REP(7) {
        const int NT = *(LAS const int*)(F.lds + LT_NT);
        pg8::Gemm g{(const pg8::bf16_t*)(ws + WS_H), (const pg8::bf16_t*)(ws + WS_WT_DN), DM / 2, (size_t)DM * DM};
        pg8::MoeOrder S; S.init(NT, 4, F.G, (int)blockIdx.x, (LAS const int*)(F.lds + LT_TILE_E), F.wave, 2, args.b_dn, nullptr, F.lds + PF_OFF);
        pg8::EpiMoeDown E{(unsigned char*)(ws + WS_YS), F.lds + PF_OFF};
        pg8::gemm_phase<pg8::EpiMoeDown, pg8::MoeOrder, true, true, true>(F.lds + RING_OFF, g, S, E, F.wave);
        GRID_BAR();
    }
    if (IN(8)) { if (DUP_PHASE == 8) { combine_phase(F, args, true); GRID_BAR(); } combine_phase(F, args); GRID_BAR(); }
    if (IN(9)) {
        pg8::Gemm g{(const pg8::bf16_t*)(ws + WS_XN), (const pg8::bf16_t*)(ws + WS_WT_PG), DM / 2, 0};
        pg8::StaticOrder S; S.init(T / 256, DM / 256, F.G, (int)blockIdx.x);
        if (DUP_PHASE == 9) { pg8::EpiPle E0{(const pg8::bf16_t*)(ws + WS_Y), (const pg8::bf16_t*)(ws + WS_PJ), (float*)(ws + WS_XS)}; pg8::gemm_phase<pg8::EpiPle, pg8::StaticOrder, true, true, true>(F.lds + RING_OFF, g, S, E0, F.wave); }
        pg8::EpiPle E{(const pg8::bf16_t*)(ws + WS_Y), (const pg8::bf16_t*)(ws + WS_PJ), args.out};
        pg8::gemm_phase<pg8::EpiPle, pg8::StaticOrder, true, true, true>(F.lds + RING_OFF, g, S, E, F.wave);
    }
#undef IN
}
extern "C" void kernel_launch(void* const* d_in, const int* in_sizes, int n_in, void* d_out, int out_size, void* d_ws, size_t ws_size, hipStream_t stream) {
    static int grid = 0;
    if (grid == 0) {
        if (n_in != 22 || ws_size < 1024 * MiB) { fprintf(stderr, "kernel_launch: unexpected n_in %d / ws %zu\n", n_in, ws_size); grid = -1; return; }
        int dev = 0, cus = 0, per_cu = 0;
        if (hipGetDevice(&dev) != hipSuccess || hipDeviceGetAttribute(&cus, hipDeviceAttributeMultiprocessorCount, dev) != hipSuccess) { grid = -1; return; }
        if (hipFuncSetAttribute((const void*)mega_fwd, hipFuncAttributeMaxDynamicSharedMemorySize, LDS_BYTES) != hipSuccess) { fprintf(stderr, "kernel_launch: hipFuncSetAttribute failed\n"); grid = -1; return; }
        if (hipOccupancyMaxActiveBlocksPerMultiprocessor(&per_cu, (const void*)mega_fwd, NWAVES * 64, LDS_BYTES) != hipSuccess || per_cu < 1) { fprintf(stderr, "kernel_launch: occupancy query says %d\n", per_cu); per_cu = 1; }
        (void)hipGetLastError();
        grid = cus;
    }
    if (grid < 0) return;
    (void)hipMemsetAsync((char*)d_ws + WS_CTL, 0, CTL_ZERO_BYTES, stream);
    Args a{};
    a.x = (const float*)d_in[0]; a.p = (const float*)d_in[1]; a.positions = (const int*)d_in[2]; a.g_mix = (const float*)d_in[3]; a.w_in = (const float*)d_in[4];
    a.sbq = (const float*)d_in[5]; a.sbk = (const float*)d_in[6]; a.rq = (const float*)d_in[7]; a.rk = (const float*)d_in[8]; a.gn_g = (const float*)d_in[9]; a.gn_b = (const float*)d_in[10];
    a.w_out = (const float*)d_in[11]; a.g_ffn = (const float*)d_in[12]; a.w_r = (const float*)d_in[13]; a.b_r = (const float*)d_in[14]; a.w_ug = (const float*)d_in[15]; a.b_ug = (const float*)d_in[16];
    a.w_dn = (const float*)d_in[17]; a.b_dn = (const float*)d_in[18]; a.g_ple = (const float*)d_in[19]; a.w_pg = (const float*)d_in[20]; a.w_pp = (const float*)d_in[21];
    a.out = (float*)d_out; a.ws = (unsigned char*)d_ws; a.ph_lo = 0; a.ph_hi = 10;
    hipLaunchKernelGGL(mega_fwd, dim3(grid), dim3(NWAVES * 64), LDS_BYTES, stream, a);

}
```

```cpp
#include <hip/hip_runtime.h>
#include <cstdint>
#include <cstdio>
#include <cmath>

__device__ __forceinline__ int lane_id_hw() { return (int)__builtin_amdgcn_mbcnt_hi(~0u, __builtin_amdgcn_mbcnt_lo(~0u, 0u)); }
namespace pg8 {
#define PG8_LAS __attribute__((address_space(3)))
typedef unsigned short bf16_t;
typedef short bf16x8 __attribute__((ext_vector_type(8)));
typedef float f32x4 __attribute__((ext_vector_type(4)));
typedef unsigned u32x4 __attribute__((ext_vector_type(4)));
typedef unsigned u32x2 __attribute__((ext_vector_type(2)));
typedef int v4i32 __attribute__((ext_vector_type(4)));
typedef int v8i32 __attribute__((ext_vector_type(8)));
constexpr int BM = 256, BK = 64, HALF = 128, HTB = HALF * BK * 2  , STAGE_BYTES = 8 * HTB, NXCD = 8, WGM = 8;

__host__ __device__ __forceinline__ int lds_byte(int r, int c) { const int st = (r >> 4) * 2 + (c >> 5), rr = r & 15, cc = c & 31, ob = rr * 64 + cc * 2; return st * 1024 + (ob ^ (((ob >> 9) & 1) << 5)); }
__host__ __device__ __forceinline__ void stage_rc(int b, int& R, int& C) { const int st = b / 1024, sb = b % 1024, swz = sb ^ (((sb >> 9) & 1) << 5); R = (st >> 1) * 16 + swz / 64; C = (st & 1) * 32 + (swz % 64) / 2; }
__host__ __device__ __forceinline__ int perm32(int rho) { const int n = rho >> 4, i = rho & 15; return 8 * (i >> 2) + 4 * n + (i & 3); }

struct Unit { int pm, pn, e, seq; };
struct Gemm { const bf16_t* A; const bf16_t* Bt; int K; size_t strideBe; };

struct StaticOrder {
    int nM, nN, nwg, G, c;
    __host__ __device__ void init(int nM_, int nN_, int G_, int c_) { nM = nM_; nN = nN_; nwg = nM * nN; G = G_; c = c_; }
    __host__ __device__ bool next(int i, Unit& u) const {
        const long L = (long)i * G + c; if (L >= nwg) return false;
        int wgid = (int)L; { const int q = nwg / NXCD, r = nwg % NXCD, xcd = wgid % NXCD, off = wgid / NXCD; wgid = (xcd < r ? xcd * (q + 1) : r * (q + 1) + (xcd - r) * q) + off; }
        const int nig = WGM * nN, gid = wgid / nig, fm = gid * WGM, gsz = (nM - fm) < WGM ? (nM - fm) : WGM;
        u.pm = fm + ((wgid % nig) % gsz); u.pn = (wgid % nig) / gsz; u.e = 0; u.seq = i; return true;
    }
    __device__ __forceinline__ void a_ready(const Unit&) const {}
    __device__ __forceinline__ void done(const Unit&) const {}
};

typedef float f32x2_t __attribute__((ext_vector_type(2))); typedef __bf16 bf16x2_t __attribute__((ext_vector_type(2)));
__device__ __forceinline__ unsigned cvt_pk_bf16(float lo, float hi) { f32x2_t v = {lo, hi}; bf16x2_t b = __builtin_convertvector(v, bf16x2_t); return __builtin_bit_cast(unsigned, b); }

constexpr int T = 16384, SEQ = 2048, DM = 1024, DIN = 3584;
constexpr float EPS = 1e-6f;
__device__ __forceinline__ u32x4 pack8(const f32x4 a, const f32x4 b) { u32x4 w; w.x = cvt_pk_bf16(a[0], a[1]); w.y = cvt_pk_bf16(a[2], a[3]); w.z = cvt_pk_bf16(b[0], b[1]); w.w = cvt_pk_bf16(b[2], b[3]); return w; }

struct EpiProj {
    static constexpr bool PERM = true, AFTER_DRAIN = false;
    bf16_t* hm;
    bf16_t* rg;
    const float* gains;
    const float *ropec, *ropes;
    __device__ __forceinline__ void operator()(const f32x4 (&acc)[2][2][4][2], const Unit& u, int wr, int wc, int fr, int fq) const {
        const int region = u.pn >> 1, hb = 4 * (u.pn & 1) + wc;
        const bool normed = (region == 0) || (region == 1) || (region == 3) || (region == 4);
        const bool rope = (region == 3) || (region == 4);
        const int gidx = region == 0 ? 0 : region == 1 ? 1 : region == 3 ? 2 : 3;
        const float* gp = gains + gidx * 64;
        f32x4 gv[2][2];
#pragma unroll
        for (int bj = 0; bj < 2; ++bj)
#pragma unroll
            for (int n = 0; n < 2; ++n) gv[bj][n] = normed ? *(const f32x4*)(gp + 32 * bj + 8 * fq + 4 * n) : (f32x4){1.f, 1.f, 1.f, 1.f};
        const float lg2g = __log2f(1.0f - __builtin_amdgcn_exp2f(-5.0f - (float)hb));
        const float scale = region == 0 ? 0.125f * 1.4426950408889634f : region == 4 ? 0.125f : 1.0f;
#pragma unroll
        for (int ai = 0; ai < 2; ++ai)
#pragma unroll
            for (int m = 0; m < 4; ++m) {
                const int row = u.pm * BM + ai * HALF + wr * 64 + m * 16 + fr;
                const int b = row >> 11, s = row & (SEQ - 1);
                f32x4 v[2][2];
#pragma unroll
                for (int bj = 0; bj < 2; ++bj)
#pragma unroll
                    for (int n = 0; n < 2; ++n) v[bj][n] = acc[ai][bj][m][n];
                if (normed) {
                    float ss = 0.f;
#pragma unroll
                    for (int bj = 0; bj < 2; ++bj)
#pragma unroll
                        for (int n = 0; n < 2; ++n) { const f32x4 x = v[bj][n]; ss += (x[0] * x[0] + x[1] * x[1]) + (x[2] * x[2] + x[3] * x[3]); }
                    ss += __shfl_xor(ss, 16); ss += __shfl_xor(ss, 32);
                    float rs = rsqrtf(ss * (1.0f / 64.0f) + EPS) * scale;
                    if (rope) rs *= (region == 3) ? __builtin_amdgcn_exp2f((float)(s & 31) * lg2g) : __builtin_amdgcn_exp2f(-(float)(s & 63) * lg2g);
#pragma unroll
                    for (int bj = 0; bj < 2; ++bj)
#pragma unroll
                        for (int n = 0; n < 2; ++n) v[bj][n] = v[bj][n] * rs * gv[bj][n];
                    if (rope) {
#pragma unroll
                        for (int n = 0; n < 2; ++n) {
                            const f32x4 c = *(const f32x4*)(ropec + (size_t)row * 32 + 8 * fq + 4 * n), sn = *(const f32x4*)(ropes + (size_t)row * 32 + 8 * fq + 4 * n);
                            const f32x4 lo = v[0][n], hi = v[1][n];
                            v[0][n] = lo * c - hi * sn; v[1][n] = hi * c + lo * sn;
                        }
                    }
                }
                bf16_t* dst = (region < 6) ? hm + (size_t)region * ((size_t)T * 512) + ((size_t)(b * 8 + hb) * SEQ + s) * 64 + 8 * fq
                                           : rg + (size_t)row * 512 + hb * 64 + 8 * fq;
#pragma unroll
                for (int bj = 0; bj < 2; ++bj) *(u32x4*)(dst + 32 * bj) = pack8(v[bj][0], v[bj][1]);
            }
    }
};

constexpr int PF_WAVE_BYTES = 768, PF_BUF_BYTES = 8 * PF_WAVE_BYTES;
struct EpiBf16Plain {
    static constexpr bool PERM = true, AFTER_DRAIN = false;
    bf16_t* O; int ldc;
    __device__ __forceinline__ void operator()(const f32x4 (&acc)[2][2][4][2], const Unit& u, int wr, int wc, int fr, int fq) const {
        const int row0 = u.pm * BM + wr * 64 + fr, col0 = u.pn * BM + wc * 32 + 8 * fq;
#pragma unroll
        for (int ai = 0; ai < 2; ++ai)
#pragma unroll
            for (int m = 0; m < 4; ++m) { bf16_t* rowp = O + (size_t)(row0 + ai * HALF + m * 16) * ldc + col0;
#pragma unroll
                for (int bj = 0; bj < 2; ++bj) *(u32x4*)(rowp + bj * HALF) = pack8(acc[ai][bj][m][0], acc[ai][bj][m][1]); }
    }
};
struct EpiResid {
    static constexpr bool PERM = true, AFTER_DRAIN = false;
    const float* base; bf16_t* X1;
    __device__ __forceinline__ void operator()(const f32x4 (&acc)[2][2][4][2], const Unit& u, int wr, int wc, int fr, int fq) const {
        const int col0 = u.pn * BM + wc * 32 + 8 * fq;
#pragma unroll
        for (int ai = 0; ai < 2; ++ai)
#pragma unroll
            for (int m = 0; m < 4; ++m) { const size_t off = (size_t)(u.pm * BM + ai * HALF + wr * 64 + m * 16 + fr) * DM + col0;
#pragma unroll
                for (int bj = 0; bj < 2; ++bj) { const f32x4 b0 = __builtin_nontemporal_load((const f32x4*)(base + off + bj * HALF)), b1 = __builtin_nontemporal_load((const f32x4*)(base + off + bj * HALF + 4));
                    *(u32x4*)(X1 + off + bj * HALF) = pack8(b0 + acc[ai][bj][m][0], b1 + acc[ai][bj][m][1]); } }
    }
};
struct EpiMoeUp {
    static constexpr bool PERM = true, AFTER_DRAIN = false;
    unsigned char* H; const PG8_LAS unsigned char* pf_lds;
    __device__ __forceinline__ void operator()(const f32x4 (&acc)[2][2][4][2], const Unit& u, int wr, int wc, int fr, int fq) const {
        const int cc = 128 * u.pn + 32 * wc + 8 * fq;
        f32x4 bg[2], bl[2]; float scs[2][4];
        const PG8_LAS unsigned char* buf = pf_lds + (u.seq & 1) * PF_BUF_BYTES + (wr * 4 + wc) * PF_WAVE_BYTES;
#pragma unroll
        for (int n = 0; n < 2; ++n) { bg[n] = *(const PG8_LAS f32x4*)(buf + (8 * fq + 4 * n) * 4); bl[n] = *(const PG8_LAS f32x4*)(buf + 128 + (8 * fq + 4 * n) * 4); }
#pragma unroll
        for (int ai = 0; ai < 2; ++ai)
#pragma unroll
            for (int m = 0; m < 4; ++m) scs[ai][m] = *(const PG8_LAS float*)(buf + 256 + ai * 256 + (m * 16 + fr) * 4);
#pragma unroll
        for (int n = 0; n < 2; ++n) bl[n] = bl[n] + 1.0f;
#pragma unroll
        for (int ai = 0; ai < 2; ++ai)
#pragma unroll
            for (int m = 0; m < 4; ++m) {
                const float sc = scs[ai][m] * 0.015625f;
                f32x4 hv[2];
#pragma unroll
                for (int n = 0; n < 2; ++n) {
                    const f32x4 g0 = acc[ai][0][m][n] * sc + bg[n], l1 = acc[ai][1][m][n] * sc + bl[n];
                    f32x4 glu, lin1;
#pragma unroll
                    for (int j = 0; j < 4; ++j) { glu[j] = __builtin_fminf(g0[j], 7.0f); lin1[j] = __builtin_amdgcn_fmed3f(l1[j], -6.0f, 8.0f); }
                    const f32x4 t = glu * (-1.702f * 1.4426950408889634f);
                    f32x4 e;
#pragma unroll
                    for (int j = 0; j < 4; ++j) e[j] = __builtin_amdgcn_exp2f(t[j]);
                    const f32x4 d = e + 1.0f;
                    f32x4 r;
#pragma unroll
                    for (int j = 0; j < 4; ++j) r[j] = __builtin_amdgcn_rcpf(d[j]);
                    hv[n] = (glu * r) * lin1;
                }
                u32x2 hq; hq.x = (unsigned)__builtin_amdgcn_cvt_pk_fp8_f32(hv[0][0], hv[0][1], 0, false); hq.x = (unsigned)__builtin_amdgcn_cvt_pk_fp8_f32(hv[0][2], hv[0][3], (int)hq.x, true);
                hq.y = (unsigned)__builtin_amdgcn_cvt_pk_fp8_f32(hv[1][0], hv[1][1], 0, false); hq.y = (unsigned)__builtin_amdgcn_cvt_pk_fp8_f32(hv[1][2], hv[1][3], (int)hq.y, true);
                *(u32x2*)(H + (size_t)(u.pm * BM + ai * HALF + wr * 64 + m * 16 + fr) * 1024 + cc) = hq;
            }
    }
};
struct EpiMoeDown {
    static constexpr bool PERM = true, AFTER_DRAIN = false;
    unsigned char* YS; const PG8_LAS unsigned char* pf_lds;
    __device__ __forceinline__ void operator()(const f32x4 (&acc)[2][2][4][2], const Unit& u, int wr, int wc, int fr, int fq) const {
        const int col0 = u.pn * BM + wc * 32 + 8 * fq;
        const PG8_LAS unsigned char* buf = pf_lds + (u.seq & 1) * PF_BUF_BYTES + (wr * 4 + wc) * PF_WAVE_BYTES;
        f32x4 bv[2][2];
#pragma unroll
        for (int bj = 0; bj < 2; ++bj)
#pragma unroll
            for (int n = 0; n < 2; ++n) bv[bj][n] = *(const PG8_LAS f32x4*)(buf + bj * 128 + (8 * fq + 4 * n) * 4);
#pragma unroll
        for (int ai = 0; ai < 2; ++ai)
#pragma unroll
            for (int m = 0; m < 4; ++m) { unsigned char* rowp = YS + (size_t)(u.pm * BM + ai * HALF + wr * 64 + m * 16 + fr) * 1024 + col0;
#pragma unroll
                for (int bj = 0; bj < 2; ++bj) { const f32x4 y0 = acc[ai][bj][m][0] * 0.015625f + bv[bj][0], y1 = acc[ai][bj][m][1] * 0.015625f + bv[bj][1];
                    u32x2 q; q.x = (unsigned)__builtin_amdgcn_cvt_pk_fp8_f32(y0[0], y0[1], 0, false); q.x = (unsigned)__builtin_amdgcn_cvt_pk_fp8_f32(y0[2], y0[3], (int)q.x, true);
                    q.y = (unsigned)__builtin_amdgcn_cvt_pk_fp8_f32(y1[0], y1[1], 0, false); q.y = (unsigned)__builtin_amdgcn_cvt_pk_fp8_f32(y1[2], y1[3], (int)q.y, true);
                    *(u32x2*)(rowp + bj * HALF) = q; } }
    }
};
struct EpiPle {
    static constexpr bool PERM = false, AFTER_DRAIN = false;
    const bf16_t* X2; const bf16_t* PJ; float* outw;
    __device__ __forceinline__ void operator()(const f32x4 (&acc)[2][2][4][2], const Unit& u, int wr, int wc, int fr, int fq) const {
        const int col0 = u.pn * BM + wc * 32 + 4 * fq;
#pragma unroll
        for (int ai = 0; ai < 2; ++ai)
#pragma unroll
            for (int m = 0; m < 4; ++m) { const size_t off = (size_t)(u.pm * BM + ai * HALF + wr * 64 + m * 16 + fr) * DM + col0;
#pragma unroll
                for (int bj = 0; bj < 2; ++bj)
#pragma unroll
                    for (int n = 0; n < 2; ++n) {
                        const size_t o2 = off + bj * HALF + n * 16;
                        const u32x2 xq = __builtin_nontemporal_load((const u32x2*)(X2 + o2)); const f32x4 x2 = (f32x4){__uint_as_float(xq.x << 16), __uint_as_float(xq.x & 0xffff0000u), __uint_as_float(xq.y << 16), __uint_as_float(xq.y & 0xffff0000u)}; const u32x2 pj = __builtin_nontemporal_load((const u32x2*)(PJ + o2)); const f32x4 a = acc[ai][bj][m][n] * 0.015625f;
                        f32x4 r;
                        r[0] = x2[0] + __uint_as_float(pj.x << 16) * __builtin_amdgcn_rcpf(1.0f + __builtin_amdgcn_exp2f(-1.4426950408889634f * a[0]));
                        r[1] = x2[1] + __uint_as_float(pj.x & 0xffff0000u) * __builtin_amdgcn_rcpf(1.0f + __builtin_amdgcn_exp2f(-1.4426950408889634f * a[1]));
                        r[2] = x2[2] + __uint_as_float(pj.y << 16) * __builtin_amdgcn_rcpf(1.0f + __builtin_amdgcn_exp2f(-1.4426950408889634f * a[2]));
                        r[3] = x2[3] + __uint_as_float(pj.y & 0xffff0000u) * __builtin_amdgcn_rcpf(1.0f + __builtin_amdgcn_exp2f(-1.4426950408889634f * a[3]));
                        __builtin_nontemporal_store(r, (f32x4*)(outw + o2));
                    } }
    }
};
struct MoeOrder {
    int nM, nN, nwg, G, c, wid, mode; const PG8_LAS int* tile_e; const float* pf_bias; const float* pf_rstd; PG8_LAS unsigned char* pf_lds;
    const int* toklist; const PG8_LAS int* first_tile; PG8_LAS unsigned char* tokl;
    __device__ __forceinline__ const int* tok_src(const Unit& u) const { return toklist + (size_t)u.e * T + 256 * (u.pm - first_tile[u.e]); }
    __device__ __forceinline__ PG8_LAS unsigned char* tok_lds() const { return tokl; }
    __device__ void init(int nM_, int nN_, int G_, int c_, const PG8_LAS int* te, int wid_, int mode_, const float* pb, const float* pr, PG8_LAS unsigned char* pl) { nM = nM_; nN = nN_; nwg = nM * nN; G = G_; c = c_; tile_e = te; wid = wid_; mode = mode_; pf_bias = pb; pf_rstd = pr; pf_lds = pl; }
    __device__ bool next(int i, Unit& u) const {
        const long L = (long)i * G + c; if (L >= nwg) return false;
        int wgid = (int)L; { const int q = nwg / NXCD, r = nwg % NXCD, xcd = wgid % NXCD, off = wgid / NXCD; wgid = (xcd < r ? xcd * (q + 1) : r * (q + 1) + (xcd - r) * q) + off; }
        const int nig = WGM * nN, gid = wgid / nig, fm = gid * WGM, gsz = (nM - fm) < WGM ? (nM - fm) : WGM;
        u.pm = fm + ((wgid % nig) % gsz); u.pn = (wgid % nig) / gsz; u.e = __builtin_amdgcn_readfirstlane(tile_e[u.pm]); u.seq = i; return true;
    }
    __device__ __forceinline__ void a_ready(const Unit& u) const {
        const int lane = (int)__builtin_amdgcn_mbcnt_hi(~0u, __builtin_amdgcn_mbcnt_lo(~0u, 0u)), wr = wid >> 2, wc = wid & 3;
        PG8_LAS unsigned char* buf = pf_lds + (u.seq & 1) * PF_BUF_BYTES + wid * PF_WAVE_BYTES;
        if (mode == 1) {
            const float* bsrc = pf_bias + (size_t)u.e * 2048 + 128 * u.pn + 32 * wc + (lane & 31) + ((lane >> 5) ? 1024 : 0);
            __builtin_amdgcn_global_load_lds((const unsigned*)bsrc, (PG8_LAS unsigned*)buf, 4, 0, 0);
            const PG8_LAS int* tl = (const PG8_LAS int*)(tokl + 1024 * (u.seq & 1)) + wr * 64 + lane;
            __builtin_amdgcn_global_load_lds((const unsigned*)(pf_rstd + tl[0]), (PG8_LAS unsigned*)(buf + 256), 4, 0, 0);
            __builtin_amdgcn_global_load_lds((const unsigned*)(pf_rstd + tl[HALF]), (PG8_LAS unsigned*)(buf + 512), 4, 0, 0);
        } else if (mode == 2) {
            const float* bsrc = pf_bias + (size_t)u.e * 1024 + u.pn * BM + 32 * wc + (lane & 31) + ((lane >> 5) ? HALF : 0);
            __builtin_amdgcn_global_load_lds((const unsigned*)bsrc, (PG8_LAS unsigned*)buf, 4, 0, 0);
        }
    }
    __device__ __forceinline__ void done(const Unit&) const {}
};
struct EpiNull {
    static constexpr bool PERM = true, AFTER_DRAIN = false;
    __device__ __forceinline__ void operator()(const f32x4 (&acc)[2][2][4][2], const Unit& u, int wr, int wc, int fr, int fq) const {
#pragma unroll
        for (int ai = 0; ai < 2; ++ai)
#pragma unroll
            for (int bj = 0; bj < 2; ++bj)
#pragma unroll
                for (int m = 0; m < 4; ++m)
#pragma unroll
                    for (int n = 0; n < 2; ++n) asm volatile("" :: "v"(acc[ai][bj][m][n]));
    }
};
template <class Epi, class Sched, bool ALIGN_EPI = false, bool SP2 = false, bool F8 = false, bool GATHER = false>
__device__ __forceinline__ void gemm_phase(PG8_LAS unsigned char* lds, const Gemm g, const Sched& S, const Epi& E, const int wave_id) {
    int tid_ = wave_id * 64 + lane_id_hw(); asm volatile("" : "+v"(tid_));
    const int tid = tid_, wid = __builtin_amdgcn_readfirstlane(tid >> 6), lane = tid & 63, wr = wid >> 2, wc = wid & 3, fr = lane & 15, fq = lane >> 4;
    const int K = g.K, nt = K / BK;
    unsigned voffA[2], voffB[2];
#pragma unroll
    for (int i = 0; i < 2; ++i) { int R, C; stage_rc(tid * 16 + i * 8192, R, C); const int Rb = Epi::PERM ? ((R & ~31) + perm32(R & 31)) : R;
        voffA[i] = (unsigned)(R * K + C) * 2u; voffB[i] = (unsigned)(Rb * K + C) * 2u; }
    const size_t kstep = (size_t)(BK * 2);
    const size_t hstep = (size_t)HALF * K * 2;
    const size_t tstep = 2 * hstep;
    const size_t hstepA = GATHER ? 0 : hstep;
    unsigned gC[2][2];
#pragma unroll
    for (int h = 0; h < 2; ++h)
#pragma unroll
        for (int i = 0; i < 2; ++i) gC[h][i] = voffA[i];
#define PG8_TOK_DMA(U, par) do { if constexpr (GATHER) { if (wid < 4) __builtin_amdgcn_global_load_lds((const unsigned*)(S.tok_src(U) + 64 * wid + (int)__builtin_amdgcn_mbcnt_hi(~0u, __builtin_amdgcn_mbcnt_lo(~0u, 0u))), (PG8_LAS unsigned*)(S.tok_lds() + 1024 * (par) + 256 * wid), 4, 0, 0); } } while (0)
#define PG8_TOK_READ(dst, par) do { if constexpr (GATHER) { _Pragma("unroll") for (int i = 0; i < 2; ++i) { int R_, C_; stage_rc((wid * 64 + (int)__builtin_amdgcn_mbcnt_hi(~0u, __builtin_amdgcn_mbcnt_lo(~0u, 0u))) * 16 + i * 8192, R_, C_); _Pragma("unroll") for (int h = 0; h < 2; ++h) \
        dst[h][i] = (unsigned)(*(const PG8_LAS int*)(S.tok_lds() + 1024 * (par) + 4 * (h * HALF + R_))) * (unsigned)(K * 2) + (unsigned)C_ * 2u; } } } while (0)
    const unsigned ldsw = (unsigned)wid * 1024u;
    const int aoff = lds_byte(wr * 64 + fr, fq * 8), boff = lds_byte(wc * 32 + fr, fq * 8);
#define PG8_SA(b, h) (((b) * 2 + (h)) * HTB)
#define PG8_SB(b, h) ((4 + (b) * 2 + (h)) * HTB)
#define PG8_STAGE(bufoff, gbase, voff) do { _Pragma("unroll") for (int _i = 0; _i < 2; ++_i) \
        __builtin_amdgcn_global_load_lds((const unsigned*)((const char*)(gbase) + (voff)[_i]), (PG8_LAS unsigned*)(lds + (bufoff) + ldsw + _i * 8192), 16, 0, 0); } while (0)
#define PG8_LD16(off) (*(const PG8_LAS v4i32*)(lds + (off)))
#define PG8_LDA(dst, b, h) do { if constexpr (F8) { _Pragma("unroll") for (int m = 0; m < 4; ++m) dst##8[m] = __builtin_shufflevector(PG8_LD16(PG8_SA(b, h) + aoff + m * 2048), PG8_LD16(PG8_SA(b, h) + aoff + m * 2048 + 1024), 0, 1, 2, 3, 4, 5, 6, 7); } \
        else { _Pragma("unroll") for (int m = 0; m < 4; ++m) _Pragma("unroll") for (int k = 0; k < 2; ++k) dst[m][k] = *(const PG8_LAS bf16x8*)(lds + PG8_SA(b, h) + aoff + m * 2048 + k * 1024); } } while (0)
#define PG8_LDB(dst, b, h) do { if constexpr (F8) { _Pragma("unroll") for (int n = 0; n < 2; ++n) dst##8[n] = __builtin_shufflevector(PG8_LD16(PG8_SB(b, h) + boff + n * 2048), PG8_LD16(PG8_SB(b, h) + boff + n * 2048 + 1024), 0, 1, 2, 3, 4, 5, 6, 7); } \
        else { _Pragma("unroll") for (int n = 0; n < 2; ++n) _Pragma("unroll") for (int k = 0; k < 2; ++k) dst[n][k] = *(const PG8_LAS bf16x8*)(lds + PG8_SB(b, h) + boff + n * 2048 + k * 1024); } } while (0)
#define PG8_MMA(ai, bj, At, Bt) do { __builtin_amdgcn_s_setprio(1); \
        if constexpr (F8) { _Pragma("unroll") for (int m = 0; m < 4; ++m) _Pragma("unroll") for (int n = 0; n < 2; ++n) \
            asm volatile("v_mfma_scale_f32_16x16x128_f8f6f4 %0, %1, %2, %0, %3, %3 op_sel_hi:[0,0,0]" : "+v"(acc[ai][bj][m][n]) : "v"(Bt##8[n]), "v"(At##8[m]), "v"(f8scale)); } \
        else { _Pragma("unroll") for (int m = 0; m < 4; ++m) _Pragma("unroll") for (int n = 0; n < 2; ++n) _Pragma("unroll") for (int k = 0; k < 2; ++k) \
            acc[ai][bj][m][n] = __builtin_amdgcn_mfma_f32_16x16x32_bf16(Bt[n][k], At[m][k], acc[ai][bj][m][n], 0, 0, 0); } \
        __builtin_amdgcn_s_setprio(0); } while (0)
#define PG8_WAIT_V(n) asm volatile("s_waitcnt vmcnt(" #n ")" ::: "memory")
#define PG8_WAIT_L(n) asm volatile("s_waitcnt lgkmcnt(" #n ")" ::: "memory")
#define PG8_BAR __builtin_amdgcn_s_barrier()
#define PG8_SCHED __builtin_amdgcn_sched_barrier(0)
    Unit cur, nxt; int ui = 0;
    if (!S.next(0, cur)) return;
    f32x4 acc[2][2][4][2];
#pragma unroll
    for (int a = 0; a < 2; ++a)
#pragma unroll
        for (int b = 0; b < 2; ++b)
#pragma unroll
            for (int m = 0; m < 4; ++m)
#pragma unroll
                for (int n = 0; n < 2; ++n) acc[a][b][m][n] = (f32x4){0.f, 0.f, 0.f, 0.f};
    bf16x8 At[4][2], B0[2][2], B1[2][2];
    v8i32 At8[4], B08[2], B18[2]; const int f8scale = 0x7f7f7f7f;
    const char* cA = (const char*)g.A + (GATHER ? (size_t)0 : (size_t)cur.pm * tstep); const char* cB = (const char*)g.Bt + (size_t)cur.e * g.strideBe + (size_t)cur.pn * tstep;
    if constexpr (GATHER) { PG8_TOK_DMA(cur, 0); asm volatile("s_waitcnt vmcnt(0)" ::: "memory"); PG8_BAR; PG8_TOK_READ(gC, 0); }
    S.a_ready(cur);
    if constexpr (SP2) {
        PG8_STAGE(PG8_SB(0, 0), cB, voffB); PG8_STAGE(PG8_SB(0, 1), cB + hstep, voffB); PG8_STAGE(PG8_SA(0, 0), cA, gC[0]); PG8_STAGE(PG8_SA(0, 1), cA + hstepA, gC[1]);
        if (wr == 1) PG8_BAR;
        PG8_WAIT_V(2); PG8_BAR;
        PG8_STAGE(PG8_SB(1, 0), cB + kstep, voffB); PG8_STAGE(PG8_SA(1, 0), cA + kstep, gC[0]); PG8_STAGE(PG8_SB(1, 1), cB + hstep + kstep, voffB);
        PG8_WAIT_V(6); PG8_BAR;
    } else {
        PG8_STAGE(PG8_SB(0, 0), cB, voffB); PG8_STAGE(PG8_SA(0, 0), cA, voffA); PG8_STAGE(PG8_SB(0, 1), cB + hstep, voffB); PG8_STAGE(PG8_SA(0, 1), cA + hstep, voffA);
        if (wr == 1) PG8_BAR;
        PG8_WAIT_V(4); PG8_BAR;
        PG8_STAGE(PG8_SB(1, 0), cB + kstep, voffB); PG8_STAGE(PG8_SA(1, 0), cA + kstep, voffA); PG8_STAGE(PG8_SB(1, 1), cB + hstep + kstep, voffB);
        PG8_WAIT_V(6); PG8_BAR;
    }
    for (;;) {
        const bool has_next = S.next(ui + 1, nxt);
        const char* nA = (has_next && !GATHER) ? (const char*)g.A + (size_t)nxt.pm * tstep : cA;
        const char* nB = has_next ? (const char*)g.Bt + (size_t)nxt.e * g.strideBe + (size_t)nxt.pn * tstep : cB;
        if (has_next) PG8_TOK_DMA(nxt, (ui + 1) & 1);
#pragma unroll 1
        for (int t = 0; t < nt; t += 2) {
            const bool last = (t == nt - 2);
            const char* a1 = cA + (size_t)(t + 1) * kstep;
            const char* a2 = last ? nA : cA + (size_t)(t + 2) * kstep; const char* b2 = last ? nB : cB + (size_t)(t + 2) * kstep;
            const char* a3 = a2 + kstep; const char* b3 = b2 + kstep;
            if (last && has_next) S.a_ready(nxt);
            if constexpr (SP2) {
            PG8_LDB(B0, 0, 0); PG8_LDB(B1, 0, 1); PG8_SCHED; PG8_LDA(At, 0, 0); PG8_STAGE(PG8_SA(1, 1), a1 + hstepA, gC[1]);
            if constexpr (GATHER) { if (last && has_next) PG8_TOK_READ(gC, (ui + 1) & 1); }
            PG8_WAIT_V(8); PG8_WAIT_L(0); PG8_BAR; PG8_MMA(0, 0, At, B0); PG8_MMA(0, 1, At, B1); PG8_BAR; PG8_SCHED;
            PG8_LDA(At, 0, 1); PG8_STAGE(PG8_SB(0, 0), b2, voffB); PG8_STAGE(PG8_SB(0, 1), b2 + hstep, voffB); PG8_STAGE(PG8_SA(0, 0), a2, gC[0]);
            PG8_WAIT_V(8); PG8_WAIT_L(0); PG8_BAR; PG8_MMA(1, 0, At, B0); PG8_MMA(1, 1, At, B1); PG8_BAR; PG8_SCHED;
            PG8_LDB(B0, 1, 0); PG8_LDB(B1, 1, 1); PG8_SCHED; PG8_LDA(At, 1, 0); PG8_STAGE(PG8_SA(0, 1), a2 + hstepA, gC[1]);
            PG8_WAIT_V(8); PG8_WAIT_L(0); PG8_BAR; PG8_MMA(0, 0, At, B0); PG8_MMA(0, 1, At, B1); PG8_BAR; PG8_SCHED;
            PG8_LDA(At, 1, 1); PG8_STAGE(PG8_SB(1, 0), b3, voffB); PG8_STAGE(PG8_SB(1, 1), b3 + hstep, voffB); PG8_STAGE(PG8_SA(1, 0), a3, gC[0]);
            PG8_WAIT_V(8); PG8_WAIT_L(0); PG8_BAR; PG8_MMA(1, 0, At, B0); PG8_MMA(1, 1, At, B1); PG8_BAR; PG8_SCHED;
            } else {
            PG8_LDB(B0, 0, 0); PG8_SCHED; PG8_LDA(At, 0, 0); PG8_STAGE(PG8_SA(1, 1), a1 + hstep, voffA);
            PG8_WAIT_L(8); PG8_BAR; PG8_WAIT_L(0); PG8_MMA(0, 0, At, B0); PG8_BAR; PG8_SCHED;
            PG8_LDB(B1, 0, 1); PG8_STAGE(PG8_SB(0, 0), b2, voffB);
            PG8_BAR; PG8_WAIT_L(0); PG8_MMA(0, 1, At, B1); PG8_BAR;
            PG8_LDA(At, 0, 1); PG8_STAGE(PG8_SA(0, 0), a2, voffA);
            PG8_BAR; PG8_WAIT_L(0); PG8_MMA(1, 0, At, B0); PG8_BAR; PG8_SCHED;
            PG8_STAGE(PG8_SB(0, 1), b2 + hstep, voffB);
            PG8_WAIT_V(6); PG8_BAR; PG8_MMA(1, 1, At, B1); PG8_BAR;
            PG8_LDB(B0, 1, 0); PG8_SCHED; PG8_LDA(At, 1, 0); PG8_STAGE(PG8_SA(0, 1), a2 + hstep, voffA);
            PG8_WAIT_L(8); PG8_BAR; PG8_WAIT_L(0); PG8_MMA(0, 0, At, B0); PG8_BAR; PG8_SCHED;
            PG8_LDB(B1, 1, 1); PG8_STAGE(PG8_SB(1, 0), b3, voffB);
            PG8_BAR; PG8_WAIT_L(0); PG8_MMA(0, 1, At, B1); PG8_BAR;
            PG8_LDA(At, 1, 1); PG8_STAGE(PG8_SA(1, 0), a3, voffA);
            PG8_BAR; PG8_WAIT_L(0); PG8_MMA(1, 0, At, B0); PG8_BAR; PG8_SCHED;
            PG8_STAGE(PG8_SB(1, 1), b3 + hstep, voffB);
            PG8_WAIT_V(6); PG8_BAR; PG8_MMA(1, 1, At, B1); PG8_BAR;
            }
        }
        if constexpr (ALIGN_EPI) { if (wr == 0) PG8_BAR; }
        if constexpr (F8) asm volatile("s_nop 15\n\ts_nop 15\n\ts_nop 15" ::: "memory");
        if constexpr (!Epi::AFTER_DRAIN) { E(acc, cur, wr, wc, fr, fq); S.done(cur); }
        if (!has_next) break;
#pragma unroll
        for (int a = 0; a < 2; ++a)
#pragma unroll
            for (int b = 0; b < 2; ++b)
#pragma unroll
                for (int m = 0; m < 4; ++m)
#pragma unroll
                    for (int n = 0; n < 2; ++n) acc[a][b][m][n] = (f32x4){0.f, 0.f, 0.f, 0.f};
        cur = nxt; cA = nA; cB = nB; ++ui;
        if constexpr (ALIGN_EPI) { if (wr == 1) PG8_BAR; }
    }
    PG8_WAIT_V(0);
    if constexpr (!ALIGN_EPI) { if (wr == 0) PG8_BAR; }
    PG8_BAR;
    if constexpr (Epi::AFTER_DRAIN) { E.fused(acc, cur, wr, wc, fr, fq, lds, wid, lane); S.done(cur); }
#undef PG8_TOK_DMA
#undef PG8_TOK_READ
#undef PG8_SA
#undef PG8_SB
#undef PG8_STAGE
#undef PG8_LD16
#undef PG8_LDA
#undef PG8_LDB
#undef PG8_MMA
#undef PG8_WAIT_V
#undef PG8_WAIT_L
#undef PG8_BAR
#undef PG8_SCHED
}
}

constexpr int NWAVES = 8;
constexpr int T = pg8::T, SEQ = pg8::SEQ, DM = pg8::DM, DIN = pg8::DIN, NE = 32, PLE = 256;
constexpr float EPS = pg8::EPS;
constexpr size_t MiB = 1u << 20;
constexpr size_t WS_CTL = 0, CTL_ZERO_BYTES = 256 * 1024;
constexpr size_t WS_WT_IN = 2 * MiB, WS_WT_OUT = 9 * MiB, WS_WT_PG = 11 * MiB, WS_WT_PP = 13 * MiB;
constexpr size_t WS_GAINS = 13 * MiB + 512 * 1024;
constexpr size_t WS_WRT = 13 * MiB + 576 * 1024;
constexpr size_t WS_ROPEC = 14 * MiB, WS_ROPES = 16 * MiB, WS_PB = 18 * MiB, WS_ROUTE = 26 * MiB;
constexpr size_t WS_TOKLIST = 29 * MiB;
constexpr size_t WS_WT_UG = 32 * MiB, WS_WT_DN = 160 * MiB;
constexpr size_t WS_XN = 224 * MiB;
constexpr size_t WS_HM = 256 * MiB;
constexpr size_t WS_X1 = 256 * MiB;
constexpr size_t WS_RG = 352 * MiB;
constexpr size_t WS_Y = 368 * MiB;
constexpr size_t WS_PJ = 400 * MiB;
constexpr size_t WS_XS = 432 * MiB, WS_H = 576 * MiB, WS_YS = 720 * MiB;
constexpr size_t WS_END = 864 * MiB;
constexpr int CW_TMO = 0, CW_CODE = 1;
constexpr int CW_BAR = 4096;
constexpr int RING_OFF = 0, RING_BYTES = 131072;
constexpr int LDSCTL_OFF = RING_BYTES, MISC_OFF = LDSCTL_OFF + 320;
constexpr int PF_OFF = LDSCTL_OFF + 4096;
constexpr int TOKL_OFF = LDSCTL_OFF + 16384;
constexpr int LDS_BYTES = 151552;
#define GAS __attribute__((address_space(1)))
#define LAS __attribute__((address_space(3)))
typedef unsigned short bf16;
typedef unsigned v4u __attribute__((ext_vector_type(4)));
typedef float f32x4 __attribute__((ext_vector_type(4)));
typedef short bf16x8 __attribute__((ext_vector_type(8)));
typedef unsigned u32x4_t __attribute__((ext_vector_type(4)));
typedef unsigned u32x2_t __attribute__((ext_vector_type(2)));
typedef GAS unsigned gu32;
typedef GAS unsigned long long gu64;
#define RLX_AGENT __ATOMIC_RELAXED, __HIP_MEMORY_SCOPE_AGENT
#define LDS_WAIT() asm volatile("s_waitcnt lgkmcnt(0)" ::: "memory")
#define VM_WAIT() asm volatile("s_waitcnt vmcnt(0)" ::: "memory")
__device__ __forceinline__ unsigned long long rt() { return __builtin_amdgcn_s_memrealtime(); }
__device__ __forceinline__ unsigned f2bf(float f) { unsigned u = __builtin_bit_cast(unsigned, f); return (u + 0x7fffu + ((u >> 16) & 1u)) >> 16; }
__device__ __forceinline__ unsigned pk2(float lo, float hi) { return f2bf(lo) | (f2bf(hi) << 16); }

#define XB_TMO      128
#define XB_XCNT(j)  (256  + 64 * (j))
#define XB_XSUB(j)  (1280 + 64 * (j))
#define XB_XGEN(j)  (2304 + 64 * (j))
#define XB_TOP      3328
#define XB_TOPGEN   3392
#define XCD_BAR_WORDS 3456
#define XB_SPIN_CAP (1u << 18)

__device__ __forceinline__ unsigned xb_ld(unsigned* p)              { return __hip_atomic_load(p, __ATOMIC_RELAXED, __HIP_MEMORY_SCOPE_AGENT); }
__device__ __forceinline__ unsigned xb_add(unsigned* p, unsigned v) { return __hip_atomic_fetch_add(p, v, __ATOMIC_RELAXED, __HIP_MEMORY_SCOPE_AGENT); }
__device__ __forceinline__ unsigned xb_xcc_id() { return (unsigned)__builtin_amdgcn_s_getreg((3 << 11) | 20) & 0xFu; }
#define XB_SPIN(cond, bar) do { unsigned _sp = 0; while (cond) { __builtin_amdgcn_s_sleep(1); \
    if ((++_sp & 255u) == 0u) { if (xb_ld(&(bar)[XB_TMO])) break; if (_sp > XB_SPIN_CAP) { atomicAdd(&(bar)[XB_TMO], 1u); break; } } } } while (0)

struct XcdBarrier {
    unsigned* bar; unsigned x; int wave;
    volatile LAS unsigned* st;
};

__device__ __forceinline__ XcdBarrier xcd_barrier_post(unsigned* bar, volatile LAS unsigned* st) {
    XcdBarrier b; b.bar = bar; b.x = xb_xcc_id(); b.st = st;
    if (threadIdx.x == 0) (void)xb_add(&bar[XB_XCNT(b.x)], 1u);
    return b;
}
__device__ __forceinline__ void xcd_barrier_complete(unsigned* bar, unsigned x, unsigned& nloc, unsigned& nx) {
    const unsigned G = gridDim.x * gridDim.y * gridDim.z;
    unsigned sum, cnt, mine, sp = 0u;
    for (;;) {
        sum = 0u; cnt = 0u; mine = 0u;
#pragma unroll
        for (unsigned j = 0; j < 16; ++j) { const unsigned c = xb_ld(&bar[XB_XCNT(j)]); sum += c; cnt += (c > 0u) ? 1u : 0u; mine = (j == x) ? c : mine; }
        if (sum == G) break;
        __builtin_amdgcn_s_sleep(1);
        if ((++sp & 255u) == 0u) { if (xb_ld(&bar[XB_TMO])) break; if (sp > XB_SPIN_CAP) { atomicAdd(&bar[XB_TMO], 1u); break; } }
    }
    nloc = mine > 0u ? mine : 1u; nx = cnt > 0u ? cnt : 1u;
}

__device__ __forceinline__ void xcd_barrier(const XcdBarrier& b) {
    asm volatile("s_waitcnt vmcnt(0)" ::: "memory");
    __syncthreads();
    if (b.wave == 0 && lane_id_hw() == 0) {
        unsigned* bar = b.bar;
        __builtin_amdgcn_s_waitcnt(0);
        unsigned nloc = b.st[0], nx = b.st[1];
        if (nloc == 0u) { xcd_barrier_complete(bar, b.x, nloc, nx); b.st[0] = nloc; b.st[1] = nx; }
        const unsigned old = xb_add(&bar[XB_XSUB(b.x)], 1u);
        const unsigned gen = old / nloc;
        const unsigned tgen = gen;
        if (old + 1u == (gen + 1u) * nloc) {
            __builtin_amdgcn_fence(__ATOMIC_RELEASE, "agent");
            asm volatile("s_waitcnt vmcnt(0)" ::: "memory");
            const unsigned og = xb_add(&bar[XB_TOP], 1u);
            const unsigned tg = og / nx;
            if (og + 1u == (tg + 1u) * nx) xb_add(&bar[XB_TOPGEN], 1u);
            else XB_SPIN(xb_ld(&bar[XB_TOPGEN]) == tg, bar);
        } else {
            XB_SPIN(xb_ld(&bar[XB_TOPGEN]) == tgen, bar);
        }
        __builtin_amdgcn_fence(__ATOMIC_ACQUIRE, "agent");
        asm volatile("s_waitcnt vmcnt(0)" ::: "memory");
    }
    __syncthreads();
}

struct Args {
    const float* x; const float* p; const int* positions; const float* g_mix; const float* w_in;
    const float* sbq; const float* sbk; const float* rq; const float* rk; const float* gn_g; const float* gn_b; const float* w_out;
    const float* g_ffn; const float* w_r; const float* b_r; const float* w_ug; const float* b_ug; const float* w_dn; const float* b_dn;
    const float* g_ple; const float* w_pg; const float* w_pp;
    float* out; unsigned char* ws; int ph_lo, ph_hi;
};
struct Frame {
    LAS unsigned char* lds;
    volatile LAS unsigned* MISC;
    gu32* ctl;
    int wave;
    int vcu, G;
};
__device__ __forceinline__ int tid_now(int wave_id) { int t = wave_id * 64 + lane_id_hw(); asm volatile("" : "+v"(t)); return t; }
__device__ __forceinline__ float wave_sum(float v) {
#pragma unroll
    for (int o = 1; o < 64; o <<= 1) v += __shfl_xor(v, o);
    return v;
}
__device__ __forceinline__ unsigned cvtpk(float lo, float hi) { return pg8::cvt_pk_bf16(lo, hi); }

enum { MAP_NAT = 0, MAP_IN = 1, MAP_UG = 2 };
constexpr int P0_E_P2 = 32;
__device__ __forceinline__ void p0_item(const float* __restrict__ W, int N, int K, bf16* __restrict__ WT, int kb, int nb, int mapmode, LAS unsigned char* scr, int lane) {
    const int np = 64 * nb + 4 * (lane & 15);
    int src = np;
    if (mapmode == MAP_IN) { const int pn = np >> 8, L = np & 255, bj = L >> 7, wc = (L >> 5) & 3, e = L & 31; src = 256 * pn + 64 * wc + 32 * bj + e; }
    else if (mapmode == MAP_UG) { const int pn = np >> 8, L = np & 255, bj = L >> 7, i = L & 127; src = 1024 * bj + 128 * pn + i; }
    const float* gp = W + (size_t)(64 * kb + (lane >> 4)) * N + src;
    f32x4 v[16];
#pragma unroll
    for (int i = 0; i < 16; ++i) v[i] = *(const f32x4*)(gp + (size_t)(4 * i) * N);
#pragma unroll
    for (int i = 0; i < 16; ++i) {
        LAS unsigned* d = (LAS unsigned*)(scr + (4 * i + (lane >> 4)) * 132 + 8 * (lane & 15));
        d[0] = cvtpk(v[i][0], v[i][1]); d[1] = cvtpk(v[i][2], v[i][3]);
    }
    LDS_WAIT(); asm volatile("" ::: "memory");
    const int c = lane & 7;
#pragma unroll
    for (int it = 0; it < 4; ++it) {
        const int nl = 16 * it + 2 * (lane >> 3);
        unsigned d[8];
#pragma unroll
        for (int j = 0; j < 8; ++j) d[j] = *(const LAS unsigned*)(scr + (8 * c + j) * 132 + 2 * nl);
        v4u o0, o1;
        o0.x = (d[0] & 0xffffu) | (d[1] << 16); o0.y = (d[2] & 0xffffu) | (d[3] << 16); o0.z = (d[4] & 0xffffu) | (d[5] << 16); o0.w = (d[6] & 0xffffu) | (d[7] << 16);
        o1.x = (d[0] >> 16) | (d[1] & 0xffff0000u); o1.y = (d[2] >> 16) | (d[3] & 0xffff0000u); o1.z = (d[4] >> 16) | (d[5] & 0xffff0000u); o1.w = (d[6] >> 16) | (d[7] & 0xffff0000u);
        bf16* dst = WT + (size_t)(64 * nb + nl) * K + 64 * kb + 8 * c;
        *(v4u*)dst = o0; *(v4u*)(dst + K) = o1;
    }
    LDS_WAIT(); asm volatile("" ::: "memory");
}
__device__ __forceinline__ unsigned pk4_fp8(float a, float b, float c, float d) { int r = __builtin_amdgcn_cvt_pk_fp8_f32(a, b, 0, false); r = __builtin_amdgcn_cvt_pk_fp8_f32(c, d, r, true); return (unsigned)r; }
__device__ __forceinline__ void p0_item_f8(const float* __restrict__ W, int N, int K, unsigned char* __restrict__ WT, int kb, int nb, int mapmode, LAS unsigned char* scr, int lane) {
    const int np = 64 * nb + 4 * (lane & 15);
    int src = np;
    if (mapmode == MAP_UG) { const int pn = np >> 8, L = np & 255, bj = L >> 7, i = L & 127; src = 1024 * bj + 128 * pn + i; }
    const float* gp = W + (size_t)(64 * kb + (lane >> 4)) * N + src;
    f32x4 v[16];
#pragma unroll
    for (int i = 0; i < 16; ++i) v[i] = *(const f32x4*)(gp + (size_t)(4 * i) * N);
#pragma unroll
    for (int i = 0; i < 16; ++i) *(LAS unsigned*)(scr + (4 * i + (lane >> 4)) * 68 + 4 * (lane & 15)) = pk4_fp8(v[i][0] * 64.0f, v[i][1] * 64.0f, v[i][2] * 64.0f, v[i][3] * 64.0f);
    LDS_WAIT(); asm volatile("" ::: "memory");
    const int nq = lane & 15, kg = lane >> 4;
    unsigned d[16];
#pragma unroll
    for (int j = 0; j < 16; ++j) d[j] = *(const LAS unsigned*)(scr + (16 * kg + j) * 68 + 4 * nq);
#pragma unroll
    for (int t = 0; t < 4; ++t) {
        v4u o;
#pragma unroll
        for (int q = 0; q < 4; ++q) o[q] = ((d[4 * q] >> (8 * t)) & 0xffu) | (((d[4 * q + 1] >> (8 * t)) & 0xffu) << 8) | (((d[4 * q + 2] >> (8 * t)) & 0xffu) << 16) | (((d[4 * q + 3] >> (8 * t)) & 0xffu) << 24);
        *(v4u*)(WT + (size_t)(64 * nb + 4 * nq + t) * K + 64 * kb + 16 * kg) = o;
    }
    LDS_WAIT(); asm volatile("" ::: "memory");
}
struct P0D { const float* gp; int N, K, kb, nb; bf16* W16; unsigned char* W8; const float* rsc; };
__device__ __forceinline__ int p0_src_col(int np, int mapmode) {
    int src = np;
    if (mapmode == MAP_IN) { const int pn = np >> 8, L = np & 255, bj = L >> 7, wc = (L >> 5) & 3, e = L & 31; src = 256 * pn + 64 * wc + 32 * bj + e; }
    else if (mapmode == MAP_UG) { const int pn = np >> 8, L = np & 255, bj = L >> 7, i = L & 127; src = 1024 * bj + 128 * pn + i; }
    return src;
}
__device__ __forceinline__ P0D p0_mk(const float* W, int N, int K, bf16* W16, unsigned char* W8, int kb, int nb, int mapmode, int lane, const float* rsc = nullptr) {
    P0D d; d.N = N; d.K = K; d.kb = kb; d.nb = nb; d.W16 = W16; d.W8 = W8;
    if (W8) {
        d.rsc = rsc ? rsc + 128 * kb + (lane >> 3) : nullptr;
        d.gp = W + (size_t)(128 * kb + (lane >> 3)) * N + p0_src_col(32 * nb + 4 * (lane & 7), mapmode);
    } else {
        d.rsc = nullptr;
        d.gp = W + (size_t)(64 * kb + (lane >> 4)) * N + p0_src_col(64 * nb + 4 * (lane & 15), mapmode);
    }
    return d;
}
__device__ __forceinline__ void p0_load(const P0D& d, f32x4 (&v)[16]) {
#pragma unroll
    for (int i = 0; i < 16; ++i) v[i] = __builtin_nontemporal_load((const f32x4*)(d.gp + (size_t)((d.W8 ? 8 : 4) * i) * d.N));
}
__device__ __forceinline__ void p0_finish(const P0D& d, const f32x4 (&v)[16], LAS unsigned char* scr, int lane, const int pm = 0) {
    if (pm == 1) { _Pragma("unroll") for (int i = 0; i < 16; ++i) asm volatile("" :: "v"(v[i])); return; }
    if (d.W16) {
#pragma unroll
        for (int i = 0; i < 16; ++i) { LAS unsigned* q = (LAS unsigned*)(scr + (4 * i + (lane >> 4)) * 132 + 8 * (lane & 15)); q[0] = cvtpk(v[i][0], v[i][1]); q[1] = cvtpk(v[i][2], v[i][3]); }
        LDS_WAIT(); asm volatile("" ::: "memory");
        const int c = lane & 7;
#pragma unroll
        for (int it = 0; it < 4; ++it) {
            const int nl = 16 * it + 2 * (lane >> 3);
            unsigned x[8];
#pragma unroll
            for (int j = 0; j < 8; ++j) x[j] = *(const LAS unsigned*)(scr + (8 * c + j) * 132 + 2 * nl);
            v4u o0, o1;
            o0.x = (x[0] & 0xffffu) | (x[1] << 16); o0.y = (x[2] & 0xffffu) | (x[3] << 16); o0.z = (x[4] & 0xffffu) | (x[5] << 16); o0.w = (x[6] & 0xffffu) | (x[7] << 16);
            o1.x = (x[0] >> 16) | (x[1] & 0xffff0000u); o1.y = (x[2] >> 16) | (x[3] & 0xffff0000u); o1.z = (x[4] >> 16) | (x[5] & 0xffff0000u); o1.w = (x[6] >> 16) | (x[7] & 0xffff0000u);
            bf16* dst = d.W16 + (size_t)(64 * d.nb + nl) * d.K + 64 * d.kb + 8 * c;
            if (pm == 0 || pm == 3) { *(v4u*)dst = o0; *(v4u*)(dst + d.K) = o1; } else asm volatile("" :: "v"(o0), "v"(o1));
        }
    } else {
#pragma unroll
        for (int i = 0; i < 16; ++i) { const float sc = d.rsc ? d.rsc[8 * i] * 64.0f : 64.0f; *(LAS unsigned*)(scr + (8 * i + (lane >> 3)) * 36 + 4 * (lane & 7)) = pk4_fp8(v[i][0] * sc, v[i][1] * sc, v[i][2] * sc, v[i][3] * sc); }
        LDS_WAIT(); asm volatile("" ::: "memory");
        const int nq = lane & 7, kg = lane >> 3;
        unsigned x[16];
#pragma unroll
        for (int j = 0; j < 16; ++j) x[j] = *(const LAS unsigned*)(scr + (16 * kg + j) * 36 + 4 * nq);
#pragma unroll
        for (int t = 0; t < 4; ++t) {
            v4u o;
#pragma unroll
            for (int q = 0; q < 4; ++q) { const unsigned lo = __builtin_amdgcn_perm(x[4 * q + 1], x[4 * q], 0x0c0c0000u | ((4u + t) << 8) | (unsigned)t), hi = __builtin_amdgcn_perm(x[4 * q + 3], x[4 * q + 2], 0x0c0c0000u | ((4u + t) << 8) | (unsigned)t); o[q] = lo | (hi << 16); }
            if (pm == 0 || pm == 3) __builtin_nontemporal_store(o, (v4u*)(d.W8 + (size_t)(32 * d.nb + 4 * nq + t) * d.K + 128 * d.kb + 16 * kg)); else asm volatile("" :: "v"(o));
        }
    }
    LDS_WAIT(); asm volatile("" ::: "memory");
}
constexpr int P0_I_IN = 16 * 56, P0_I_OUT = 256, P0_I_PG = 256, P0_I_PP = 4 * 16, P0_I_UG = 16 * 32, P0_I_DN = 256, P0_I_SMALL = P0_I_IN + P0_I_OUT + P0_I_PG + P0_I_PP;
__device__ __forceinline__ P0D p0_decode(const Args& a, unsigned char* ws, int it, int lane, bool small, int e0, int ne) {
    int r = it;
    if (small) {
        if (r < P0_I_IN) return p0_mk(a.w_in, DIN, DM, (bf16*)(ws + WS_WT_IN), nullptr, r / 56, r % 56, MAP_IN, lane); r -= P0_I_IN;
        if (r < P0_I_OUT) return p0_mk(a.w_out, DM, DM, (bf16*)(ws + WS_WT_OUT), nullptr, r / 16, r % 16, MAP_NAT, lane); r -= P0_I_OUT;
        if (r < P0_I_PG) return p0_mk(a.w_pg, DM, DM, nullptr, (unsigned char*)(ws + WS_WT_PG), r / 32, r % 32, MAP_NAT, lane); r -= P0_I_PG;
        if (r < P0_I_PP) return p0_mk(a.w_pp, DM, PLE, (bf16*)(ws + WS_WT_PP), nullptr, r / 16, r % 16, MAP_NAT, lane); r -= P0_I_PP;
    }
    if (r < ne * P0_I_UG) { const int e = e0 + r / P0_I_UG, q = r % P0_I_UG; return p0_mk(a.w_ug + (size_t)e * DM * 2048, 2048, DM, nullptr, (unsigned char*)(ws + WS_WT_UG) + (size_t)e * 2048 * DM, q / 64, q % 64, MAP_UG, lane, a.g_ffn); } r -= ne * P0_I_UG;
    { const int e = e0 + r / P0_I_DN, q = r % P0_I_DN; return p0_mk(a.w_dn + (size_t)e * DM * DM, DM, DM, nullptr, (unsigned char*)(ws + WS_WT_DN) + (size_t)e * DM * DM, q / 32, q % 32, MAP_NAT, lane); }
}
__device__ __forceinline__ void p0_items(const Args& a, unsigned char* ws, LAS unsigned char* scr, int lane, int gw, int NGW, bool small, int e0, int ne, const int pm) {
    const int NITEMS = (small ? P0_I_SMALL : 0) + ne * (P0_I_UG + P0_I_DN);
    if (gw < NITEMS) {
        int it = gw; P0D d0 = p0_decode(a, ws, it, lane, small, e0, ne), d1 = d0; f32x4 va[16], vb[16]; p0_load(d0, va);
        for (;;) {
            const int it1 = it + NGW; const bool h1 = it1 < NITEMS;
            if (h1) { d1 = p0_decode(a, ws, it1, lane, small, e0, ne); p0_load(d1, vb); }
            p0_finish(d0, va, scr, lane, pm);
            if (!h1) break;
            const int it2 = it1 + NGW; const bool h2 = it2 < NITEMS;
            if (h2) { d0 = p0_decode(a, ws, it2, lane, small, e0, ne); p0_load(d0, va); }
            p0_finish(d1, vb, scr, lane, pm);
            if (!h2) break;
            it = it2;
        }
    }
}
__device__ __forceinline__ void p0_items_from(const Args& a, unsigned char* ws, LAS unsigned char* scr, int lane, int first, int step, int ne) { p0_items(a, ws, scr, lane, first, step, false, 0, ne, 0); }
__device__ __forceinline__ void rms_row_to_bf16(const float* xrow, const float* g, bf16* orow, int lane) {
    const f32x4* xr = (const f32x4*)xrow + lane;
    f32x4 v[4]; float s = 0.f;
#pragma unroll
    for (int j = 0; j < 4; ++j) { v[j] = xr[64 * j]; s += (v[j][0] * v[j][0] + v[j][1] * v[j][1]) + (v[j][2] * v[j][2] + v[j][3] * v[j][3]); }
    const float rstd = rsqrtf(wave_sum(s) * (1.f / DM) + EPS);
    unsigned long long* o8 = (unsigned long long*)orow + lane;
#pragma unroll
    for (int j = 0; j < 4; ++j) { const f32x4 gg = ((const f32x4*)g)[lane + 64 * j];
        o8[64 * j] = (unsigned long long)cvtpk(v[j][0] * rstd * gg[0], v[j][1] * rstd * gg[1]) | ((unsigned long long)cvtpk(v[j][2] * rstd * gg[2], v[j][3] * rstd * gg[3]) << 32); }
}
__device__ __forceinline__ void p0_prologue(Frame& F, const Args& a, const int pm = 0) {
    unsigned char* ws = a.ws; const int tid = tid_now(F.wave), lane = tid & 63;
    LAS unsigned char* scr = F.lds + RING_OFF + F.wave * 8448;
    const int gw = F.vcu * NWAVES + F.wave, NGW = F.G * NWAVES;
    { const int e0 = (F.G == 256) ? P0_E_P2 : 0; p0_items(a, ws, scr, lane, gw, NGW, true, e0, NE - e0, pm); }
    if (pm != 0) return;
    { v4u* tz = (v4u*)(ws + WS_TOKLIST); const v4u z4 = {0u, 0u, 0u, 0u}; for (int i = gw * 64 + lane; i < NE * T / 4; i += NGW * 64) tz[i] = z4; }
    if (blockIdx.x == 0 && tid < 256) { const int t = tid; const float* srcs = (t < 64) ? a.sbq : (t < 128) ? a.sbk : (t < 192) ? a.rq : a.rk; ((float*)(ws + WS_GAINS))[t] = srcs[t & 63]; }
    {
        f32x4 gg[4];
#pragma unroll
        for (int j = 0; j < 4; ++j) gg[j] = ((const f32x4*)a.g_mix)[lane + 64 * j];
        for (int m0 = 4 * gw; m0 < T; m0 += 4 * NGW) {
            f32x4 v[4][4];
#pragma unroll
            for (int r = 0; r < 4; ++r)
#pragma unroll
                for (int j = 0; j < 4; ++j) v[r][j] = __builtin_nontemporal_load((const f32x4*)(a.x + (size_t)(m0 + r) * DM) + lane + 64 * j);
#pragma unroll
            for (int r = 0; r < 4; ++r) {
                float ss = 0.f;
#pragma unroll
                for (int j = 0; j < 4; ++j) ss += (v[r][j][0] * v[r][j][0] + v[r][j][1] * v[r][j][1]) + (v[r][j][2] * v[r][j][2] + v[r][j][3] * v[r][j][3]);
                const float rstd = rsqrtf(wave_sum(ss) * (1.f / DM) + EPS);
                unsigned long long* o8 = (unsigned long long*)((bf16*)(ws + WS_XN) + (size_t)(m0 + r) * DM) + lane;
#pragma unroll
                for (int j = 0; j < 4; ++j) o8[64 * j] = (unsigned long long)cvtpk(v[r][j][0] * rstd * gg[j][0], v[r][j][1] * rstd * gg[j][1]) | ((unsigned long long)cvtpk(v[r][j][2] * rstd * gg[j][2], v[r][j][3] * rstd * gg[j][3]) << 32);
            }
        }
    }
    { const int gt = gw * 64 + lane, NGT = NGW * 64;
      for (int i0 = gt; i0 < T * PLE / 8; i0 += 4 * NGT) {
          f32x4 a0[4], a1[4];
#pragma unroll
          for (int q = 0; q < 4; ++q) { const int i = i0 + q * NGT; if (i < T * PLE / 8) { a0[q] = __builtin_nontemporal_load((const f32x4*)a.p + 2 * i); a1[q] = __builtin_nontemporal_load((const f32x4*)a.p + 2 * i + 1); } }
#pragma unroll
          for (int q = 0; q < 4; ++q) { const int i = i0 + q * NGT; if (i < T * PLE / 8) { v4u o; o.x = cvtpk(a0[q][0], a0[q][1]); o.y = cvtpk(a0[q][2], a0[q][3]); o.z = cvtpk(a1[q][0], a1[q][1]); o.w = cvtpk(a1[q][2], a1[q][3]); ((v4u*)(ws + WS_PB))[i] = o; } }
      }
      for (int i = gt; i < NE * DM; i += NGT) { const int e = i >> 10, k = i & (DM - 1); const float wv = a.w_r[(size_t)k * NE + e] * a.g_ffn[k];
          const unsigned hi = cvtpk(wv, 0.f) & 0xffffu; const unsigned lo = cvtpk(wv - __uint_as_float(hi << 16), 0.f) & 0xffffu;
          ((bf16*)(ws + WS_WRT))[i] = (bf16)hi; ((bf16*)(ws + WS_WRT))[NE * DM + i] = (bf16)lo; }
      float* rc = (float*)(ws + WS_ROPEC); float* rs = (float*)(ws + WS_ROPES);
      for (int i = gt; i < T * 32; i += NGT) { const int row = i >> 5, f = i & 31;
          const float inv_freq = exp2f(-(float)f * (13.287712379549449f / 32.0f));   const float ang = (float)a.positions[row] * inv_freq;
          float sn, cs; sincosf(ang, &sn, &cs); rc[i] = cs; rs[i] = sn; } }
}

namespace att {
typedef short bf16x8 __attribute__((ext_vector_type(8)));
typedef short s16x4 __attribute__((ext_vector_type(4)));
typedef float f32x16 __attribute__((ext_vector_type(16)));
typedef short v4i16_t __attribute__((ext_vector_type(4)));
constexpr int LK = 0, LV = 24576, LFLAG = 49152;
__device__ __forceinline__ s16x4 vtr(LAS const unsigned char* p) { return __builtin_bit_cast(s16x4, __builtin_amdgcn_ds_read_tr16_b64_v4i16((LAS v4i16_t*)p)); }
__device__ __forceinline__ int crow(int r, int hi) { return (r & 3) + 8 * (r >> 2) + 4 * hi; }
struct AttnArgs { const bf16* hm; const bf16* rg; bf16* Y; const float* gn_g; const float* gn_b; };
struct ConvStream { const Args* a; unsigned char* ws; LAS unsigned char* scr; int it, step, nitems, ne, gap; };

template <int MODE, int ABL = 0> __device__ __forceinline__ void attn_unit(LAS unsigned char* lds, const AttnArgs& A, int b, int h, int qb, const int wave_id, ConvStream& cs) {
    int tid_ = wave_id * 64 + lane_id_hw(); asm volatile("" : "+v"(tid_));
    const int tid = tid_, lane = tid & 63, r32 = lane & 31, hh = lane >> 5;
    const int w = __builtin_amdgcn_readfirstlane(tid >> 6);
    const int q0 = qb * 256, qw = q0 + 32 * w;
    const size_t TS = (size_t)T * 512;
    const size_t hoff = (size_t)(b * 8 + h) * SEQ * 64;
    const bf16* Qp = A.hm + (MODE == 0 ? 0 : 3) * TS + hoff;
    const bf16* Kp = A.hm + (MODE == 0 ? 1 : 4) * TS + hoff;
    const bf16* Vp = A.hm + (MODE == 0 ? 2 : 5) * TS + hoff;
    bf16x8 qf[4];
#pragma unroll
    for (int ds = 0; ds < 4; ++ds) qf[ds] = *(const bf16x8*)(Qp + (size_t)(qw + r32) * 64 + 16 * ds + 8 * hh);
    f32x16 o[2];
#pragma unroll
    for (int r = 0; r < 16; ++r) { o[0][r] = 0.f; o[1][r] = 0.f; }
    float carry = 1.0f;
    const int jmax = (q0 + 255) >> 6, jd = (qw + 31) >> 6;
    const float lg2g = __log2f(1.0f - __builtin_amdgcn_exp2f(-5.0f - (float)h));
    const int krow = 8 * w + (lane >> 3);
    const bf16* Kt = Kp + (size_t)krow * 64 + (((lane & 7) ^ ((krow >> 1) & 7)) << 3); const bf16* Vt = Vp + (size_t)w * 512 + lane * 8;
    volatile LAS unsigned* flags = (volatile LAS unsigned*)(lds + LFLAG);
#define ATT_DMA(t, so) do { __builtin_amdgcn_global_load_lds((const unsigned*)(Kt + (size_t)(t) * 4096), (LAS unsigned*)(lds + LK + (so) + w * 1024), 16, 0, 0); \
                            __builtin_amdgcn_global_load_lds((const unsigned*)(Vt + (size_t)(t) * 4096), (LAS unsigned*)(lds + LV + (so) + w * 1024), 16, 0, 0); } while (0)
    ATT_DMA(jmax, 0);
    if (jmax >= 1) { ATT_DMA(jmax - 1, 8192); asm volatile("s_waitcnt vmcnt(2)\n\ts_barrier" ::: "memory"); }
    else asm volatile("s_waitcnt vmcnt(0)\n\ts_barrier" ::: "memory");
    bool finished = false;
    int so_cur = 0, so_new = 16384;
    P0D cd = P0D{}; f32x4 cv[16]; bool chave = false; int cgap = 0;
    for (int j = jmax; j >= 0; --j) {
        const int cur = j & 1;
        bool cnew = false;
        if (MODE == 1 && ABL == 0) {
            if (chave) { p0_finish(cd, cv, cs.scr, lane, 0); chave = false; }
            if (cs.it < cs.nitems && cgap == 0) { cd = p0_decode(*cs.a, cs.ws, cs.it, lane, false, 0, cs.ne); p0_load(cd, cv); cs.it += cs.step; chave = true; cnew = true; cgap = cs.gap; }
            else if (cgap > 0) --cgap;
        }
        if (j >= 2 && ABL != 4) ATT_DMA(j - 2, so_new);
        if (j <= jd && !finished && ABL == 0) {
            LAS const unsigned char* Kb = lds + LK + so_cur;
            LAS const unsigned char* Vb = lds + LV + so_cur;
            f32x16 p[2];
#pragma unroll
            for (int r = 0; r < 16; ++r) { p[0][r] = 0.f; p[1][r] = 0.f; }
            bf16x8 kf[4][2];
            const int ksw = (r32 >> 1) & 7;
#pragma unroll
            for (int ds = 0; ds < 4; ++ds) { kf[ds][0] = *(LAS const bf16x8*)(Kb + r32 * 128 + (((2 * ds + hh) ^ ksw) << 4)); kf[ds][1] = *(LAS const bf16x8*)(Kb + 4096 + r32 * 128 + (((2 * ds + hh) ^ ksw) << 4)); }
#pragma unroll
            for (int ds = 0; ds < 4; ++ds) {
                p[0] = __builtin_amdgcn_mfma_f32_32x32x16_bf16(kf[ds][0], qf[ds], p[0], 0, 0, 0);
                p[1] = __builtin_amdgcn_mfma_f32_32x32x16_bf16(kf[ds][1], qf[ds], p[1], 0, 0, 0);
            }
            const bool diag = (j == jd);
            const int qg = qw + r32, kv0 = 64 * j + 4 * hh;
            if (MODE == 0) {
                float om[2][16];
#pragma unroll
                for (int hf = 0; hf < 2; ++hf)
#pragma unroll
                    for (int r = 0; r < 16; ++r) {
                        const float a = __builtin_amdgcn_exp2f(__builtin_fminf(-p[hf][r], 120.0f));
                        const float rc = __builtin_amdgcn_rcpf(1.0f + a);
                        p[hf][r] = rc;
                        om[hf][r] = a * rc;
                    }
                if (diag) {
#pragma unroll
                    for (int hf = 0; hf < 2; ++hf)
#pragma unroll
                        for (int r = 0; r < 16; ++r) { const bool valid = kv0 + 32 * hf + (r & 3) + 8 * (r >> 2) < qg; p[hf][r] = valid ? p[hf][r] : 0.f; om[hf][r] = valid ? om[hf][r] : 1.0f; }
                }
                float gs[8], ot[8];
#pragma unroll
                for (int m = 0; m < 8; ++m) { const int hf = m >> 2, g = m & 3; gs[m] = (om[hf][4 * g] * om[hf][4 * g + 1]) * (om[hf][4 * g + 2] * om[hf][4 * g + 3]); ot[m] = __shfl_xor(gs[m], 32); }
                float ps[8];
                ps[7] = 1.0f;
#pragma unroll
                for (int m = 6; m >= 0; --m) ps[m] = ps[m + 1] * (gs[m + 1] * ot[m + 1]);
                const float total = ps[0] * (gs[0] * ot[0]);
#pragma unroll
                for (int m = 0; m < 8; ++m) {
                    const int hf = m >> 2, g = m & 3;
                    float tail = carry * (hh ? ps[m] : ps[m] * ot[m]);
#pragma unroll
                    for (int i = 3; i >= 0; --i) { const int r = 4 * g + i; const float o1 = om[hf][r]; p[hf][r] *= tail; tail *= o1; }
                }
                carry *= total;
                finished = __all(carry < 1.0e-37f);
            } else {
                const float ct = __builtin_amdgcn_exp2f(lg2g * (float)(qw - 64 * j));
#pragma unroll
                for (int hf = 0; hf < 2; ++hf)
#pragma unroll
                    for (int r = 0; r < 16; ++r) p[hf][r] *= ct;
                if (diag) {
#pragma unroll
                    for (int hf = 0; hf < 2; ++hf)
#pragma unroll
                        for (int r = 0; r < 16; ++r) { const bool valid = kv0 + 32 * hf + (r & 3) + 8 * (r >> 2) <= qg; p[hf][r] = valid ? p[hf][r] : 0.f; }
                }
            }
            {
                const unsigned vbase = (unsigned)(uintptr_t)(Vb + (4 * hh + ((lane & 15) >> 2)) * 128 + (16 * ((lane >> 4) & 1) + 4 * (lane & 3)) * 2);
                s16x4 vl[2][2][2], vh[2][2][2];
#pragma unroll
                for (int hf = 0; hf < 2; ++hf)
#pragma unroll
                    for (int s = 0; s < 2; ++s)
#pragma unroll
                        for (int d0 = 0; d0 < 2; ++d0) {
                            asm volatile("ds_read_b64_tr_b16 %0, %1 offset:%c2" : "=&v"(vl[hf][s][d0]) : "v"(vbase), "i"(hf * 4096 + s * 2048 + d0 * 64) : "memory");
                            asm volatile("ds_read_b64_tr_b16 %0, %1 offset:%c2" : "=&v"(vh[hf][s][d0]) : "v"(vbase), "i"(hf * 4096 + s * 2048 + d0 * 64 + 1024) : "memory");
                        }
                bf16x8 wfr[2][2];
#pragma unroll
                for (int hf = 0; hf < 2; ++hf)
#pragma unroll
                    for (int s = 0; s < 2; ++s) {
                        u32x4_t wq;
                        wq.x = pg8::cvt_pk_bf16(p[hf][8 * s + 0], p[hf][8 * s + 1]); wq.y = pg8::cvt_pk_bf16(p[hf][8 * s + 2], p[hf][8 * s + 3]);
                        wq.z = pg8::cvt_pk_bf16(p[hf][8 * s + 4], p[hf][8 * s + 5]); wq.w = pg8::cvt_pk_bf16(p[hf][8 * s + 6], p[hf][8 * s + 7]);
                        wfr[hf][s] = __builtin_bit_cast(bf16x8, wq);
                    }
                asm volatile("s_waitcnt lgkmcnt(0)" ::: "memory"); __builtin_amdgcn_sched_barrier(0);
#pragma unroll
                for (int hf = 0; hf < 2; ++hf)
#pragma unroll
                    for (int s = 0; s < 2; ++s)
#pragma unroll
                        for (int d0 = 0; d0 < 2; ++d0) {
                            const s16x4 lo = vl[hf][s][d0], hi = vh[hf][s][d0];
                            const bf16x8 vf = (bf16x8){lo[0], lo[1], lo[2], lo[3], hi[0], hi[1], hi[2], hi[3]};
                            o[d0] = __builtin_amdgcn_mfma_f32_32x32x16_bf16(vf, wfr[hf][s], o[d0], 0, 0, 0);
                        }
            }
        }
        if (MODE == 0) { if (lane == 0) flags[cur * 8 + w] = finished ? 1u : 0u; }
        if (cnew) { if (j >= 2) asm volatile("s_waitcnt vmcnt(18) lgkmcnt(0)\n\ts_barrier" ::: "memory"); else asm volatile("s_waitcnt vmcnt(16) lgkmcnt(0)\n\ts_barrier" ::: "memory"); }
        else { if (j >= 2) asm volatile("s_waitcnt vmcnt(2) lgkmcnt(0)\n\ts_barrier" ::: "memory"); else asm volatile("s_waitcnt vmcnt(0) lgkmcnt(0)\n\ts_barrier" ::: "memory"); }
        so_cur = (so_cur == 16384) ? 0 : so_cur + 8192; so_new = (so_new == 16384) ? 0 : so_new + 8192;
        if (MODE == 0) {
            unsigned all = 1u;
#pragma unroll
            for (int i = 0; i < 8; ++i) all &= flags[cur * 8 + i];
            if (all) break;
        }
    }
    if (MODE == 1 && ABL == 0) { if (chave) p0_finish(cd, cv, cs.scr, lane, 0); }
    asm volatile("s_waitcnt vmcnt(0)\n\ts_barrier" ::: "memory");
#undef ATT_DMA
    const int row = b * SEQ + qw + r32;
    if (MODE == 0) {
        bf16* yp = A.Y + (size_t)row * DM + h * 64 + 4 * hh;
#pragma unroll
        for (int d0 = 0; d0 < 2; ++d0)
#pragma unroll
            for (int g = 0; g < 4; ++g) { u32x2_t v; v.x = pg8::cvt_pk_bf16(o[d0][4 * g], o[d0][4 * g + 1]); v.y = pg8::cvt_pk_bf16(o[d0][4 * g + 2], o[d0][4 * g + 3]); *(u32x2_t*)(yp + 32 * d0 + 8 * g) = v; }
    } else {
        float s1 = 0.f;
#pragma unroll
        for (int r = 0; r < 16; ++r) s1 += o[0][r] + o[1][r];
        s1 += __shfl_xor(s1, 32);
        const float mu = s1 * (1.0f / 64.0f);
        float s2 = 0.f;
#pragma unroll
        for (int r = 0; r < 16; ++r) { const float a0 = o[0][r] - mu, a1 = o[1][r] - mu; s2 += a0 * a0 + a1 * a1; }
        s2 += __shfl_xor(s2, 32);
        const float rstd = rsqrtf(s2 * (1.0f / 64.0f) + EPS);
        bf16* yp = A.Y + (size_t)row * DM + 512 + h * 64 + 4 * hh;
        const bf16* gp = A.rg + (size_t)row * 512 + h * 64 + 4 * hh;
        const float* gg = A.gn_g + h * 64 + 4 * hh; const float* gb = A.gn_b + h * 64 + 4 * hh;
#pragma unroll
        for (int d0 = 0; d0 < 2; ++d0)
#pragma unroll
            for (int g = 0; g < 4; ++g) {
                const f32x4 gn = *(const f32x4*)(gg + 32 * d0 + 8 * g), bs = *(const f32x4*)(gb + 32 * d0 + 8 * g);
                const u32x2_t gr = *(const u32x2_t*)(gp + 32 * d0 + 8 * g);
                float gate[4] = {__uint_as_float(gr.x << 16), __uint_as_float(gr.x & 0xffff0000u), __uint_as_float(gr.y << 16), __uint_as_float(gr.y & 0xffff0000u)};
                float ov[4];
#pragma unroll
                for (int i = 0; i < 4; ++i) { const float yn = (o[d0][4 * g + i] - mu) * rstd * gn[i] + bs[i]; const float sg = gate[i] / (1.0f + __expf(-gate[i])); ov[i] = yn * sg; }
                u32x2_t v; v.x = pg8::cvt_pk_bf16(ov[0], ov[1]); v.y = pg8::cvt_pk_bf16(ov[2], ov[3]); *(u32x2_t*)(yp + 32 * d0 + 8 * g) = v;
            }
    }
}
__device__ __forceinline__ void attn_phase(LAS unsigned char* lds, const AttnArgs& A, int vcu, int dup, bf16* dummyY, const int wave_id, const Args& args, int G) {
    const int g = vcu >> 5, local = vcu & 31;
    ConvStream cs; cs.a = &args; cs.ws = args.ws; cs.scr = lds + 57344 + wave_id * 4608; cs.it = vcu * 8 + wave_id; cs.step = G * 8; cs.ne = P0_E_P2; cs.nitems = P0_E_P2 * (P0_I_UG + P0_I_DN); cs.gap = 2;
#pragma unroll 1
    for (int u = 0; u < 2; ++u) { const int bh = 8 * g + 4 * (u & 1) + (local >> 3), qb = (u & 1) ? 7 - (local & 7) : (local & 7); attn_unit<1>(lds, A, bh >> 3, bh & 7, qb, wave_id, cs); }
#pragma unroll 1
    for (int u = 0; u < 2; ++u) { const int bh = 8 * g + 4 * (u & 1) + (local >> 3), qb = (u & 1) ? 7 - (local & 7) : (local & 7); attn_unit<0>(lds, A, bh >> 3, bh & 7, qb, wave_id, cs); }
    { const int lane = lane_id_hw(); if (cs.it < cs.nitems) p0_items_from(args, args.ws, cs.scr, lane, cs.it, cs.step, cs.ne); }
}
}

constexpr int CW_GCNT = 32768;
constexpr int LR_LCNT = LDSCTL_OFF + 1024, LR_GBASE = LDSCTL_OFF + 1152;
constexpr int LT_POFF = LDSCTL_OFF + 2048, LT_NT = LDSCTL_OFF + 2176, LT_TILE_E = LDSCTL_OFF + 2304, LT_FIRST = LDSCTL_OFF + 3712;
struct RouteBufs { int* tok_e; int* tok_slot; float* tok_gate; float* rstd; int* toklist; };
__device__ __forceinline__ RouteBufs route_bufs(unsigned char* ws) { RouteBufs r; r.tok_e = (int*)(ws + WS_ROUTE); r.tok_slot = r.tok_e + T * 4; r.tok_gate = (float*)(r.tok_slot + T * 4); r.rstd = (float*)(ws + WS_ROUTE + 1 * MiB); r.toklist = (int*)(ws + WS_TOKLIST); return r; }
typedef float f32x2v __attribute__((ext_vector_type(2)));
__device__ __forceinline__ unsigned opq_mask(bool c) { unsigned m = c ? 0xffffffffu : 0u; asm volatile("" : "+v"(m)); return m; }
__device__ __forceinline__ float blendf(unsigned m, float a, float b) { return __uint_as_float((__float_as_uint(a) & m) | (__float_as_uint(b) & ~m)); }
__device__ __forceinline__ int blendi(unsigned m, int a, int b) { return (int)(((unsigned)a & m) | ((unsigned)b & ~m)); }

#define SW2(c, a, b) { const float ta_ = (c) ? (b) : (a), tb_ = (c) ? (a) : (b); a = ta_; b = tb_; }
#define SW2I(c, a, b) { const int ta_ = (c) ? (b) : (a), tb_ = (c) ? (a) : (b); a = ta_; b = tb_; }
#define TOP4_INSERT(x, e) { const float x_ = (x); const int e_ = (e); const bool c3_ = (x_ > v3) || (x_ == v3 && e_ < i3); v3 = c3_ ? x_ : v3; i3 = c3_ ? e_ : i3; \
    const bool c2_ = (v3 > v2) || (v3 == v2 && i3 < i2); SW2(c2_, v2, v3) SW2I(c2_, i2, i3) const bool c1_ = (v2 > v1) || (v2 == v1 && i2 < i1); SW2(c1_, v1, v2) SW2I(c1_, i1, i2) \
    const bool c0_ = (v1 > v0) || (v1 == v0 && i1 < i0); SW2(c0_, v0, v1) SW2I(c0_, i0, i1) }
__device__ __forceinline__ void router_phase(Frame& F, const Args& a, const bool dry = false) {
    unsigned char* ws = a.ws; const int tid = tid_now(F.wave);
    LAS unsigned char* lds = F.lds;
    const int lane = tid & 63, r32 = lane & 31, hh = lane >> 5, w = F.wave, rg = w >> 2, kq = w & 3;
    volatile LAS unsigned* lcnt = (volatile LAS unsigned*)(lds + LR_LCNT);
    volatile LAS unsigned* gbase = (volatile LAS unsigned*)(lds + LR_GBASE);
    if (tid < 32) lcnt[tid] = 0u;
    const RouteBufs R = route_bufs(ws);
    const int row = F.vcu * 64 + 32 * rg + r32;
    const bf16* xr = (const bf16*)(ws + WS_X1) + (size_t)row * DM + 256 * kq + 8 * hh;
    const bf16* wt = (const bf16*)(ws + WS_WRT) + (size_t)r32 * DM + 256 * kq + 8 * hh;
    unsigned char* hp = (unsigned char*)(ws + (dry ? WS_H : WS_XN)) + (size_t)row * DM + 256 * kq + 8 * hh;
    att::f32x16 D;
#pragma unroll
    for (int r = 0; r < 16; ++r) D[r] = 0.f;
    float ss = 0.f;
#pragma unroll 8
    for (int ks = 0; ks < 16; ++ks) {
        const u32x4_t xh = *(const u32x4_t*)(xr + 16 * ks);
        const f32x4 v0 = (f32x4){__uint_as_float(xh.x << 16), __uint_as_float(xh.x & 0xffff0000u), __uint_as_float(xh.y << 16), __uint_as_float(xh.y & 0xffff0000u)};
        const f32x4 v1 = (f32x4){__uint_as_float(xh.z << 16), __uint_as_float(xh.z & 0xffff0000u), __uint_as_float(xh.w << 16), __uint_as_float(xh.w & 0xffff0000u)};
        ss += ((v0[0] * v0[0] + v0[1] * v0[1]) + (v0[2] * v0[2] + v0[3] * v0[3])) + ((v1[0] * v1[0] + v1[1] * v1[1]) + (v1[2] * v1[2] + v1[3] * v1[3]));
        u32x2_t h8; h8.x = pk4_fp8(v0[0], v0[1], v0[2], v0[3]); h8.y = pk4_fp8(v1[0], v1[1], v1[2], v1[3]); *(u32x2_t*)(hp + 16 * ks) = h8;
        const att::bf16x8 whi = *(const att::bf16x8*)(wt + 16 * ks), wlo = *(const att::bf16x8*)(wt + 32 * DM + 16 * ks);
        const att::bf16x8 bxh = __builtin_bit_cast(att::bf16x8, xh);
        D = __builtin_amdgcn_mfma_f32_32x32x16_bf16(whi, bxh, D, 0, 0, 0);
        D = __builtin_amdgcn_mfma_f32_32x32x16_bf16(wlo, bxh, D, 0, 0, 0);
    }
    { LAS f32x4* dp = (LAS f32x4*)(lds + (w * 64 + lane) * 64);
#pragma unroll
      for (int q = 0; q < 4; ++q) dp[q] = (f32x4){D[4 * q], D[4 * q + 1], D[4 * q + 2], D[4 * q + 3]};
      *(LAS float*)(lds + 32768 + (w * 64 + lane) * 4) = ss; }
    __syncthreads();
    int my_e0 = 0, my_e1 = 0, rk0 = 0, rk1 = 0; float my_g0 = 0.f, my_g1 = 0.f;
    if (kq == 0) {
#pragma unroll
        for (int o = 1; o < 4; ++o) { LAS const f32x4* dp = (LAS const f32x4*)(lds + ((w + o) * 64 + lane) * 64);
#pragma unroll
            for (int q = 0; q < 4; ++q) { const f32x4 t = dp[q]; D[4 * q] += t[0]; D[4 * q + 1] += t[1]; D[4 * q + 2] += t[2]; D[4 * q + 3] += t[3]; }
            ss += *(LAS const float*)(lds + 32768 + ((w + o) * 64 + lane) * 4); }
        ss += __shfl_xor(ss, 32);
        const float rstd = rsqrtf(ss * (1.f / DM) + EPS);
        if (hh == 0) R.rstd[row] = rstd;
        float l[16];
#pragma unroll
        for (int r = 0; r < 16; ++r) l[r] = D[r] * rstd + a.b_r[(r & 3) + 8 * (r >> 2) + 4 * hh];
        float c[8]; int ci[8];
#pragma unroll
        for (int k = 0; k < 4; ++k) {
            float bv = -INFINITY; int bi = 99;
#pragma unroll
            for (int r = 0; r < 16; ++r) { const int e = (r & 3) + 8 * (r >> 2) + 4 * hh; const bool bt = l[r] > bv; bv = bt ? l[r] : bv; bi = bt ? e : bi; }
            c[k] = bv; ci[k] = bi;
#pragma unroll
            for (int r = 0; r < 16; ++r) { const int e = (r & 3) + 8 * (r >> 2) + 4 * hh; l[r] = (e == bi) ? -INFINITY : l[r]; }
        }
#pragma unroll
        for (int k = 0; k < 4; ++k) { c[4 + k] = __shfl_xor(c[k], 32); ci[4 + k] = __shfl_xor(ci[k], 32); }
        float tv[4]; int ti[4];
#pragma unroll
        for (int k = 0; k < 4; ++k) {
            float bv = -INFINITY; int bi = 99;
#pragma unroll
            for (int j = 0; j < 8; ++j) { const bool bt = (c[j] > bv) || (c[j] == bv && ci[j] < bi); bv = bt ? c[j] : bv; bi = bt ? ci[j] : bi; }
            tv[k] = bv; ti[k] = bi;
#pragma unroll
            for (int j = 0; j < 8; ++j) c[j] = (ci[j] == bi) ? -INFINITY : c[j];
        }
        const float v0 = tv[0], v1 = tv[1], v2 = tv[2], v3 = tv[3]; const int i0 = ti[0], i1 = ti[1], i2 = ti[2], i3 = ti[3];
        const float e1 = __expf(v1 - v0), e2 = __expf(v2 - v0), e3 = __expf(v3 - v0), inv = 1.0f / (1.0f + e1 + e2 + e3);
        my_e0 = hh ? i2 : i0; my_e1 = hh ? i3 : i1; my_g0 = (hh ? e2 : 1.0f) * inv; my_g1 = (hh ? e3 : e1) * inv;
        rk0 = (int)__hip_atomic_fetch_add((LAS unsigned*)(lds + LR_LCNT) + my_e0, 1u, __ATOMIC_RELAXED, __HIP_MEMORY_SCOPE_WORKGROUP);
        rk1 = (int)__hip_atomic_fetch_add((LAS unsigned*)(lds + LR_LCNT) + my_e1, 1u, __ATOMIC_RELAXED, __HIP_MEMORY_SCOPE_WORKGROUP);
    }
    __syncthreads();
    if (tid < 32) gbase[tid] = __hip_atomic_fetch_add((unsigned*)(F.ctl + CW_GCNT + (dry ? 4096 : 0)) + 64 * tid, lcnt[tid], __ATOMIC_RELAXED, __HIP_MEMORY_SCOPE_AGENT);
    __syncthreads();
    if (kq == 0) {
        const int k0 = 2 * hh;
        const int s0 = (int)gbase[my_e0] + rk0, s1 = (int)gbase[my_e1] + rk1;
        R.tok_e[row * 4 + k0] = my_e0; R.tok_slot[row * 4 + k0] = s0; R.tok_gate[row * 4 + k0] = my_g0; R.toklist[(size_t)my_e0 * T + s0] = row;
        R.tok_e[row * 4 + k0 + 1] = my_e1; R.tok_slot[row * 4 + k0 + 1] = s1; R.tok_gate[row * 4 + k0 + 1] = my_g1; R.toklist[(size_t)my_e1 * T + s1] = row;
    }
}
#undef SW2
#undef SW2I
#undef TOP4_INSERT

__device__ __forceinline__ void build_tables(Frame& F) {
    LAS int* poff = (LAS int*)(F.lds + LT_POFF); LAS int* ntp = (LAS int*)(F.lds + LT_NT); LAS int* tile_e = (LAS int*)(F.lds + LT_TILE_E);
    LAS int* cnts = (LAS int*)(F.lds + LR_LCNT); const int tid = tid_now(F.wave);
    if (tid < NE) cnts[tid] = (int)__hip_atomic_load((unsigned*)(F.ctl + CW_GCNT) + 64 * tid, __ATOMIC_RELAXED, __HIP_MEMORY_SCOPE_AGENT);
    __syncthreads();
    if (tid == 0) {
        int t = 0;
        for (int e = 0; e < NE; ++e) { const int c = cnts[e]; const int nt = (c + 255) >> 8; poff[e] = t * 256; ((LAS int*)(F.lds + LT_FIRST))[e] = t; for (int i = 0; i < nt; ++i) tile_e[t + i] = e; t += nt; }
        *ntp = t;
    }
    __syncthreads();
}
__device__ __forceinline__ void combine_phase(Frame& F, const Args& a, const bool dry = false) {
    unsigned char* ws = a.ws; const RouteBufs R = route_bufs(ws);
    LAS const int* poff = (LAS const int*)(F.lds + LT_POFF);
    const int gw = F.vcu * NWAVES + F.wave, NGW = F.G * NWAVES, lane = tid_now(F.wave) & 63;
    for (int m0 = 2 * gw; m0 < T; m0 += 2 * NGW) {
        f32x4 v[2][2][2]; u32x2_t y[2][4][2]; float gt[2][4];
#pragma unroll
        for (int rr = 0; rr < 2; ++rr) { const int m = m0 + rr;
#pragma unroll
            for (int i = 0; i < 2; ++i) { { const v4u xq = __builtin_nontemporal_load((const v4u*)((const bf16*)(ws + WS_X1) + (size_t)m * DM + 8 * lane + 512 * i)); v[rr][i][0] = (f32x4){__uint_as_float(xq[0] << 16), __uint_as_float(xq[0] & 0xffff0000u), __uint_as_float(xq[1] << 16), __uint_as_float(xq[1] & 0xffff0000u)}; v[rr][i][1] = (f32x4){__uint_as_float(xq[2] << 16), __uint_as_float(xq[2] & 0xffff0000u), __uint_as_float(xq[3] << 16), __uint_as_float(xq[3] & 0xffff0000u)}; } }
#pragma unroll
            for (int k = 0; k < 4; ++k) { const int e = R.tok_e[m * 4 + k], slot = R.tok_slot[m * 4 + k]; gt[rr][k] = R.tok_gate[m * 4 + k];
                const unsigned char* yr = (const unsigned char*)(ws + WS_YS) + (size_t)(poff[e] + slot) * DM + 8 * lane;
                y[rr][k][0] = __builtin_nontemporal_load((const u32x2_t*)yr); y[rr][k][1] = __builtin_nontemporal_load((const u32x2_t*)(yr + 512)); } }
#pragma unroll
        for (int rr = 0; rr < 2; ++rr) { const int m = m0 + rr;
#pragma unroll
            for (int k = 0; k < 4; ++k)
#pragma unroll
                for (int i = 0; i < 2; ++i) { const u32x2_t yy = y[rr][k][i]; const float g = gt[rr][k];
                    const f32x2v a0 = __builtin_amdgcn_cvt_pk_f32_fp8((int)yy.x, false), a1 = __builtin_amdgcn_cvt_pk_f32_fp8((int)yy.x, true), a2 = __builtin_amdgcn_cvt_pk_f32_fp8((int)yy.y, false), a3 = __builtin_amdgcn_cvt_pk_f32_fp8((int)yy.y, true);
                    v[rr][i][0][0] += g * a0[0]; v[rr][i][0][1] += g * a0[1]; v[rr][i][0][2] += g * a1[0]; v[rr][i][0][3] += g * a1[1];
                    v[rr][i][1][0] += g * a2[0]; v[rr][i][1][1] += g * a2[1]; v[rr][i][1][2] += g * a3[0]; v[rr][i][1][3] += g * a3[1]; }
            float ss = 0.f;
#pragma unroll
            for (int i = 0; i < 2; ++i)
#pragma unroll
                for (int q = 0; q < 2; ++q) { const f32x4 t = v[rr][i][q]; ss += (t[0] * t[0] + t[1] * t[1]) + (t[2] * t[2] + t[3] * t[3]); }
            const float rstd = rsqrtf(wave_sum(ss) * (1.f / DM) + EPS);
            unsigned char* np = (unsigned char*)(ws + (dry ? WS_H : WS_XN)) + (size_t)m * DM + 8 * lane; bf16* ow = (bf16*)(ws + (dry ? WS_XS : WS_Y));
#pragma unroll
            for (int i = 0; i < 2; ++i) { { v4u xb; xb[0] = cvtpk(v[rr][i][0][0], v[rr][i][0][1]); xb[1] = cvtpk(v[rr][i][0][2], v[rr][i][0][3]); xb[2] = cvtpk(v[rr][i][1][0], v[rr][i][1][1]); xb[3] = cvtpk(v[rr][i][1][2], v[rr][i][1][3]); *(v4u*)(ow + (size_t)m * DM + 8 * lane + 512 * i) = xb; }
                const f32x4 g0 = *(const f32x4*)(a.g_ple + 8 * lane + 512 * i), g1 = *(const f32x4*)(a.g_ple + 8 * lane + 512 * i + 4);
                u32x2_t o; o.x = pk4_fp8(v[rr][i][0][0] * rstd * g0[0], v[rr][i][0][1] * rstd * g0[1], v[rr][i][0][2] * rstd * g0[2], v[rr][i][0][3] * rstd * g0[3]);
                o.y = pk4_fp8(v[rr][i][1][0] * rstd * g1[0], v[rr][i][1][1] * rstd * g1[1], v[rr][i][1][2] * rstd * g1[2], v[rr][i][1][3] * rstd * g1[3]);
                *(u32x2_t*)(np + 512 * i) = o; } }
    }
}

__global__ void __launch_bounds__(NWAVES * 64, 2) mega_fwd(Args args) {
    extern __shared__ __attribute__((aligned(16))) unsigned char lds[];
    Frame F;
    F.lds = (LAS unsigned char*)lds;
    F.MISC = (volatile LAS unsigned*)(F.lds + MISC_OFF);
    F.wave = __builtin_amdgcn_readfirstlane(threadIdx.x >> 6);
    F.G = gridDim.x; { const int bx = blockIdx.x; F.vcu = (F.G % 8 == 0) ? (bx % 8) * (F.G / 8) + bx / 8 : bx; }
    unsigned char* ws = args.ws;
    F.ctl = (gu32*)(ws + WS_CTL);
    for (int u = threadIdx.x; u < (LDS_BYTES - LDSCTL_OFF) / 4; u += NWAVES * 64) ((LAS unsigned*)(F.lds + LDSCTL_OFF))[u] = 0u;
    __syncthreads();
    XcdBarrier bar = xcd_barrier_post((unsigned*)(F.ctl + CW_BAR), F.MISC + 8); bar.wave = F.wave;
    const int lo = args.ph_lo, hi = args.ph_hi;
#define IN(k) (lo <= (k) && (k) < hi)
#define GRID_BAR() xcd_barrier(bar)
#ifndef DUP_PHASE
#define DUP_PHASE -1
#endif
#define REP(k) for (int rep_ = 0; rep_ < ((DUP_PHASE) == (k) ? 2 : 1); ++rep_)

    if (IN(0)) { if (DUP_PHASE == 40) { p0_prologue(F, args, 1); GRID_BAR(); } if (DUP_PHASE == 41) { p0_prologue(F, args, 2); GRID_BAR(); } if (DUP_PHASE == 42) { p0_prologue(F, args, 3); GRID_BAR(); } REP(0) { p0_prologue(F, args); GRID_BAR(); } }

    if (IN(1)) REP(1) {
        pg8::Gemm g{(const pg8::bf16_t*)(ws + WS_XN), (const pg8::bf16_t*)(ws + WS_WT_IN), DM, 0};
        pg8::StaticOrder S; S.init(T / 256, DIN / 256, F.G, (int)blockIdx.x);
        pg8::EpiProj E{(pg8::bf16_t*)(ws + WS_HM), (pg8::bf16_t*)(ws + WS_RG), (const float*)(ws + WS_GAINS), (const float*)(ws + WS_ROPEC), (const float*)(ws + WS_ROPES)};
        pg8::gemm_phase<pg8::EpiProj, pg8::StaticOrder, true, true>(F.lds + RING_OFF, g, S, E, F.wave);
        {
            const int G2 = (F.G == 256) ? 128 : F.G, c2 = (F.G == 256) ? (int)blockIdx.x - 128 : (int)blockIdx.x;
            if (c2 >= 0) {
                pg8::Gemm g2{(const pg8::bf16_t*)(ws + WS_PB), (const pg8::bf16_t*)(ws + WS_WT_PP), PLE, 0};
                pg8::StaticOrder S2; S2.init(T / 256, DM / 256, G2, c2);
                pg8::EpiBf16Plain E2{(pg8::bf16_t*)(ws + WS_PJ), DM};
                pg8::gemm_phase<pg8::EpiBf16Plain, pg8::StaticOrder, true, true>(F.lds + RING_OFF, g2, S2, E2, F.wave);
            }
        }
        GRID_BAR();
    }
    if (DUP_PHASE == 51 && IN(1)) {
        pg8::Gemm g{(const pg8::bf16_t*)(ws + WS_XN), (const pg8::bf16_t*)(ws + WS_WT_IN), DM, 0};
        pg8::StaticOrder S; S.init(T / 256, DIN / 256, F.G, (int)blockIdx.x);
        pg8::EpiNull E;
        pg8::gemm_phase<pg8::EpiNull, pg8::StaticOrder, true, true>(F.lds + RING_OFF, g, S, E, F.wave);
        GRID_BAR();
    }
    if (IN(2)) REP(2) {
        if (F.G == 256) {
            const att::AttnArgs AA{(const bf16*)(ws + WS_HM), (const bf16*)(ws + WS_RG), (bf16*)(ws + WS_Y), args.gn_g, args.gn_b};
            att::attn_phase(F.lds + RING_OFF, AA, F.vcu, DUP_PHASE, (bf16*)(ws + WS_XS), F.wave, args, F.G);
        }
        GRID_BAR();
    }
    if (IN(3)) REP(3) {
        pg8::Gemm g{(const pg8::bf16_t*)(ws + WS_Y), (const pg8::bf16_t*)(ws + WS_WT_OUT), DM, 0};
        pg8::StaticOrder S; S.init(T / 256, DM / 256, F.G, (int)blockIdx.x);
        pg8::EpiResid E{args.x, (pg8::bf16_t*)(ws + WS_X1)};
        pg8::gemm_phase<pg8::EpiResid, pg8::StaticOrder, true, true>(F.lds + RING_OFF, g, S, E, F.wave);
        GRID_BAR();
    }
    if (DUP_PHASE == 30 && IN(3)) { GRID_BAR(); GRID_BAR(); GRID_BAR(); GRID_BAR(); }
    if (IN(4)) { if (DUP_PHASE == 4) { if (F.G == 256) router_phase(F, args, true); GRID_BAR(); } if (F.G == 256) router_phase(F, args); GRID_BAR(); }
    if (IN(5) || (lo >= 6 && lo <= 8)) build_tables(F);
    if (IN(6)) REP(6) {
        const int NT = *(LAS const int*)(F.lds + LT_NT);
        pg8::Gemm g{(const pg8::bf16_t*)(ws + WS_XN), (const pg8::bf16_t*)(ws + WS_WT_UG), DM / 2, (size_t)2048 * DM};
        pg8::MoeOrder S; S.init(NT, 8, F.G, (int)blockIdx.x, (LAS const int*)(F.lds + LT_TILE_E), F.wave, 1, args.b_ug, route_bufs(ws).rstd, F.lds + PF_OFF);
        S.toklist = route_bufs(ws).toklist; S.first_tile = (LAS const int*)(F.lds + LT_FIRST); S.tokl = F.lds + TOKL_OFF;
        pg8::EpiMoeUp E{(unsigned char*)(ws + WS_H), F.lds + PF_OFF};
        pg8::gemm_phase<pg8::EpiMoeUp, pg8::MoeOrder, true, true, true, true>(F.lds + RING_OFF, g, S, E, F.wave);
        GRID_BAR();
    }
    if (IN(7)) REP(7) {
        const int NT = *(LAS const int*)(F.lds + LT_NT);
        pg8::Gemm g{(const pg8::bf16_t*)(ws + WS_H), (const pg8::bf16_t*)(ws + WS_WT_DN), DM / 2, (size_t)DM * DM};
        pg8::MoeOrder S; S.init(NT, 4, F.G, (int)blockIdx.x, (LAS const int*)(F.lds + LT_TILE_E), F.wave, 2, args.b_dn, nullptr, F.lds + PF_OFF);
        pg8::EpiMoeDown E{(unsigned char*)(ws + WS_YS), F.lds + PF_OFF};
        pg8::gemm_phase<pg8::EpiMoeDown, pg8::MoeOrder, true, true, true>(F.lds + RING_OFF, g, S, E, F.wave);
        GRID_BAR();
    }
    if (IN(8)) { if (DUP_PHASE == 8) { combine_phase(F, args, true); GRID_BAR(); } combine_phase(F, args); GRID_BAR(); }
    if (IN(9)) {
        pg8::Gemm g{(const pg8::bf16_t*)(ws + WS_XN), (const pg8::bf16_t*)(ws + WS_WT_PG), DM / 2, 0};
        pg8::StaticOrder S; S.init(T / 256, DM / 256, F.G, (int)blockIdx.x);
        if (DUP_PHASE == 9) { pg8::EpiPle E0{(const pg8::bf16_t*)(ws + WS_Y), (const pg8::bf16_t*)(ws + WS_PJ), (float*)(ws + WS_XS)}; pg8::gemm_phase<pg8::EpiPle, pg8::StaticOrder, true, true, true>(F.lds + RING_OFF, g, S, E0, F.wave); }
        pg8::EpiPle E{(const pg8::bf16_t*)(ws + WS_Y), (const pg8::bf16_t*)(ws + WS_PJ), args.out};
        pg8::gemm_phase<pg8::EpiPle, pg8::StaticOrder, true, true, true>(F.lds + RING_OFF, g, S, E, F.wave);
    }
#undef IN
}
extern "C" void kernel_launch(void* const* d_in, const int* in_sizes, int n_in, void* d_out, int out_size, void* d_ws, size_t ws_size, hipStream_t stream) {
    static int grid = 0;
    if (grid == 0) {
        if (n_in != 22 || ws_size < 1024 * MiB) { fprintf(stderr, "kernel_launch: unexpected n_in %d / ws %zu\n", n_in, ws_size); grid = -1; return; }
        int dev = 0, cus = 0, per_cu = 0;
        if (hipGetDevice(&dev) != hipSuccess || hipDeviceGetAttribute(&cus, hipDeviceAttributeMultiprocessorCount, dev) != hipSuccess) { grid = -1; return; }
        if (hipFuncSetAttribute((const void*)mega_fwd, hipFuncAttributeMaxDynamicSharedMemorySize, LDS_BYTES) != hipSuccess) { fprintf(stderr, "kernel_launch: hipFuncSetAttribute failed\n"); grid = -1; return; }
        if (hipOccupancyMaxActiveBlocksPerMultiprocessor(&per_cu, (const void*)mega_fwd, NWAVES * 64, LDS_BYTES) != hipSuccess || per_cu < 1) { fprintf(stderr, "kernel_launch: occupancy query says %d\n", per_cu); per_cu = 1; }
        (void)hipGetLastError();
        grid = cus;
    }
    if (grid < 0) return;
    (void)hipMemsetAsync((char*)d_ws + WS_CTL, 0, CTL_ZERO_BYTES, stream);
    Args a{};
    a.x = (const float*)d_in[0]; a.p = (const float*)d_in[1]; a.positions = (const int*)d_in[2]; a.g_mix = (const float*)d_in[3]; a.w_in = (const float*)d_in[4];
    a.sbq = (const float*)d_in[5]; a.sbk = (const float*)d_in[6]; a.rq = (const float*)d_in[7]; a.rk = (const float*)d_in[8]; a.gn_g = (const float*)d_in[9]; a.gn_b = (const float*)d_in[10];
    a.w_out = (const float*)d_in[11]; a.g_ffn = (const float*)d_in[12]; a.w_r = (const float*)d_in[13]; a.b_r = (const float*)d_in[14]; a.w_ug = (const float*)d_in[15]; a.b_ug = (const float*)d_in[16];
    a.w_dn = (const float*)d_in[17]; a.b_dn = (const float*)d_in[18]; a.g_ple = (const float*)d_in[19]; a.w_pg = (const float*)d_in[20]; a.w_pp = (const float*)d_in[21];
    a.out = (float*)d_out; a.ws = (unsigned char*)d_ws; a.ph_lo = 0; a.ph_hi = 10;
    hipLaunchKernelGGL(mega_fwd, dim3(grid), dim3(NWAVES * 64), LDS_BYTES, stream, a);

}
```

```cpp
#include <hip/hip_runtime.h>
#include <cstdint>
#include <cstdio>
#include <cmath>

__device__ __forceinline__ int lane_id_hw() { return (int)__builtin_amdgcn_mbcnt_hi(~0u, __builtin_amdgcn_mbcnt_lo(~0u, 0u)); }
namespace pg8 {
#define PG8_LAS __attribute__((address_space(3)))
typedef unsigned short bf16_t;
typedef short bf16x8 __attribute__((ext_vector_type(8)));
typedef float f32x4 __attribute__((ext_vector_type(4)));
typedef unsigned u32x4 __attribute__((ext_vector_type(4)));
typedef unsigned u32x2 __attribute__((ext_vector_type(2)));
typedef int v4i32 __attribute__((ext_vector_type(4)));
typedef int v8i32 __attribute__((ext_vector_type(8)));
constexpr int BM = 256, BK = 64, HALF = 128, HTB = HALF * BK * 2  , STAGE_BYTES = 8 * HTB, NXCD = 8, WGM = 8;

__host__ __device__ __forceinline__ int lds_byte(int r, int c) { const int st = (r >> 4) * 2 + (c >> 5), rr = r & 15, cc = c & 31, ob = rr * 64 + cc * 2; return st * 1024 + (ob ^ (((ob >> 9) & 1) << 5)); }
__host__ __device__ __forceinline__ void stage_rc(int b, int& R, int& C) { const int st = b / 1024, sb = b % 1024, swz = sb ^ (((sb >> 9) & 1) << 5); R = (st >> 1) * 16 + swz / 64; C = (st & 1) * 32 + (swz % 64) / 2; }
__host__ __device__ __forceinline__ int perm32(int rho) { const int n = rho >> 4, i = rho & 15; return 8 * (i >> 2) + 4 * n + (i & 3); }

struct Unit { int pm, pn, e, seq; };
#ifdef PROBE_LO
struct Gemm { const bf16_t* A; const bf16_t* Bt; int K; size_t strideBe; int nostage = 0; };
#define PG8_NOSTAGE (g.nostage != 0)
#else
struct Gemm { const bf16_t* A; const bf16_t* Bt; int K; size_t strideBe; };
#define PG8_NOSTAGE false
#endif

struct StaticOrder {
    int nM, nN, nwg, G, c;
    __host__ __device__ void init(int nM_, int nN_, int G_, int c_) { nM = nM_; nN = nN_; nwg = nM * nN; G = G_; c = c_; }
    __host__ __device__ bool next(int i, Unit& u) const {
        const long L = (long)i * G + c; if (L >= nwg) return false;
        int wgid = (int)L; { const int q = nwg / NXCD, r = nwg % NXCD, xcd = wgid % NXCD, off = wgid / NXCD; wgid = (xcd < r ? xcd * (q + 1) : r * (q + 1) + (xcd - r) * q) + off; }
        const int nig = WGM * nN, gid = wgid / nig, fm = gid * WGM, gsz = (nM - fm) < WGM ? (nM - fm) : WGM;
        u.pm = fm + ((wgid % nig) % gsz); u.pn = (wgid % nig) / gsz; u.e = 0; u.seq = i; return true;
    }
    __device__ __forceinline__ void a_ready(const Unit&) const {}
    __device__ __forceinline__ void done(const Unit&) const {}
};

typedef float f32x2_t __attribute__((ext_vector_type(2))); typedef __bf16 bf16x2_t __attribute__((ext_vector_type(2)));
__device__ __forceinline__ unsigned cvt_pk_bf16(float lo, float hi) { f32x2_t v = {lo, hi}; bf16x2_t b = __builtin_convertvector(v, bf16x2_t); return __builtin_bit_cast(unsigned, b); }

constexpr int T = 16384, SEQ = 2048, DM = 1024, DIN = 3584;
constexpr float EPS = 1e-6f;
__device__ __forceinline__ u32x4 pack8(const f32x4 a, const f32x4 b) { u32x4 w; w.x = cvt_pk_bf16(a[0], a[1]); w.y = cvt_pk_bf16(a[2], a[3]); w.z = cvt_pk_bf16(b[0], b[1]); w.w = cvt_pk_bf16(b[2], b[3]); return w; }

struct EpiProj {
    static constexpr bool PERM = true, AFTER_DRAIN = false;
    bf16_t* hm;
    bf16_t* rg;
    const float* gains;
    const float *ropec, *ropes;
    __device__ __forceinline__ void operator()(const f32x4 (&acc)[2][2][4][2], const Unit& u, int wr, int wc, int fr, int fq) const {
        const int region = u.pn >> 1, hb = 4 * (u.pn & 1) + wc;
        const bool normed = (region == 0) || (region == 1) || (region == 3) || (region == 4);
        const bool rope = (region == 3) || (region == 4);
        const int gidx = region == 0 ? 0 : region == 1 ? 1 : region == 3 ? 2 : 3;
        const float* gp = gains + gidx * 64;
        f32x4 gv[2][2];
#pragma unroll
        for (int bj = 0; bj < 2; ++bj)
#pragma unroll
            for (int n = 0; n < 2; ++n) gv[bj][n] = normed ? *(const f32x4*)(gp + 32 * bj + 8 * fq + 4 * n) : (f32x4){1.f, 1.f, 1.f, 1.f};
        const float lg2g = __log2f(1.0f - __builtin_amdgcn_exp2f(-5.0f - (float)hb));
        const float scale = region == 0 ? 0.125f * 1.4426950408889634f : region == 4 ? 0.125f : 1.0f;
#pragma unroll
        for (int ai = 0; ai < 2; ++ai)
#pragma unroll
            for (int m = 0; m < 4; ++m) {
                const int row = u.pm * BM + ai * HALF + wr * 64 + m * 16 + fr;
                const int b = row >> 11, s = row & (SEQ - 1);
                f32x4 v[2][2];
#pragma unroll
                for (int bj = 0; bj < 2; ++bj)
#pragma unroll
                    for (int n = 0; n < 2; ++n) v[bj][n] = acc[ai][bj][m][n];
                if (normed) {
                    float ss = 0.f;
#pragma unroll
                    for (int bj = 0; bj < 2; ++bj)
#pragma unroll
                        for (int n = 0; n < 2; ++n) { const f32x4 x = v[bj][n]; ss += (x[0] * x[0] + x[1] * x[1]) + (x[2] * x[2] + x[3] * x[3]); }
                    ss += __shfl_xor(ss, 16); ss += __shfl_xor(ss, 32);
                    float rs = rsqrtf(ss * (1.0f / 64.0f) + EPS) * scale;
                    if (rope) rs *= (region == 3) ? __builtin_amdgcn_exp2f((float)(s & 31) * lg2g) : __builtin_amdgcn_exp2f(-(float)(s & 63) * lg2g);
#pragma unroll
                    for (int bj = 0; bj < 2; ++bj)
#pragma unroll
                        for (int n = 0; n < 2; ++n) v[bj][n] = v[bj][n] * rs * gv[bj][n];
                    if (rope) {
#pragma unroll
                        for (int n = 0; n < 2; ++n) {
                            const f32x4 c = *(const f32x4*)(ropec + (size_t)row * 32 + 8 * fq + 4 * n), sn = *(const f32x4*)(ropes + (size_t)row * 32 + 8 * fq + 4 * n);
                            const f32x4 lo = v[0][n], hi = v[1][n];
                            v[0][n] = lo * c - hi * sn; v[1][n] = hi * c + lo * sn;
                        }
                    }
                }
                bf16_t* dst = (region < 6) ? hm + (size_t)region * ((size_t)T * 512) + ((size_t)(b * 8 + hb) * SEQ + s) * 64 + 8 * fq
                                           : rg + (size_t)row * 512 + hb * 64 + 8 * fq;
#pragma unroll
                for (int bj = 0; bj < 2; ++bj) *(u32x4*)(dst + 32 * bj) = pack8(v[bj][0], v[bj][1]);
            }
    }
};

constexpr int PF_WAVE_BYTES = 768, PF_BUF_BYTES = 8 * PF_WAVE_BYTES;
struct EpiBf16Plain {
    static constexpr bool PERM = true, AFTER_DRAIN = false;
    bf16_t* O; int ldc;
    __device__ __forceinline__ void operator()(const f32x4 (&acc)[2][2][4][2], const Unit& u, int wr, int wc, int fr, int fq) const {
        const int row0 = u.pm * BM + wr * 64 + fr, col0 = u.pn * BM + wc * 32 + 8 * fq;
#pragma unroll
        for (int ai = 0; ai < 2; ++ai)
#pragma unroll
            for (int m = 0; m < 4; ++m) { bf16_t* rowp = O + (size_t)(row0 + ai * HALF + m * 16) * ldc + col0;
#pragma unroll
                for (int bj = 0; bj < 2; ++bj) *(u32x4*)(rowp + bj * HALF) = pack8(acc[ai][bj][m][0], acc[ai][bj][m][1]); }
    }
};
struct EpiResid {
    static constexpr bool PERM = true, AFTER_DRAIN = false;
    const float* base; bf16_t* X1;
    __device__ __forceinline__ void operator()(const f32x4 (&acc)[2][2][4][2], const Unit& u, int wr, int wc, int fr, int fq) const {
        const int col0 = u.pn * BM + wc * 32 + 8 * fq;
#pragma unroll
        for (int ai = 0; ai < 2; ++ai)
#pragma unroll
            for (int m = 0; m < 4; ++m) { const size_t off = (size_t)(u.pm * BM + ai * HALF + wr * 64 + m * 16 + fr) * DM + col0;
#pragma unroll
                for (int bj = 0; bj < 2; ++bj) { const f32x4 b0 = __builtin_nontemporal_load((const f32x4*)(base + off + bj * HALF)), b1 = __builtin_nontemporal_load((const f32x4*)(base + off + bj * HALF + 4));
                    *(u32x4*)(X1 + off + bj * HALF) = pack8(b0 + acc[ai][bj][m][0], b1 + acc[ai][bj][m][1]); } }
    }
};
struct EpiMoeUp {
    static constexpr bool PERM = true, AFTER_DRAIN = false;
    unsigned char* H; const PG8_LAS unsigned char* pf_lds;
    __device__ __forceinline__ void operator()(const f32x4 (&acc)[2][2][4][2], const Unit& u, int wr, int wc, int fr, int fq) const {
#ifdef PROBE_LO
        if (H == nullptr) return;
#endif
        const int cc = 128 * u.pn + 32 * wc + 8 * fq;
        f32x4 bg[2], bl[2]; float scs[2][4];
        const PG8_LAS unsigned char* buf = pf_lds + (u.seq & 1) * PF_BUF_BYTES + (wr * 4 + wc) * PF_WAVE_BYTES;
#pragma unroll
        for (int n = 0; n < 2; ++n) { bg[n] = *(const PG8_LAS f32x4*)(buf + (8 * fq + 4 * n) * 4); bl[n] = *(const PG8_LAS f32x4*)(buf + 128 + (8 * fq + 4 * n) * 4); }
#pragma unroll
        for (int ai = 0; ai < 2; ++ai)
#pragma unroll
            for (int m = 0; m < 4; ++m) scs[ai][m] = *(const PG8_LAS float*)(buf + 256 + ai * 256 + (m * 16 + fr) * 4);
#pragma unroll
        for (int n = 0; n < 2; ++n) bl[n] = bl[n] + 1.0f;
#pragma unroll
        for (int ai = 0; ai < 2; ++ai)
#pragma unroll
            for (int m = 0; m < 4; ++m) {
                const float sc = scs[ai][m] * 0.015625f;
                f32x4 hv[2];
#pragma unroll
                for (int n = 0; n < 2; ++n) {
                    const f32x4 g0 = acc[ai][0][m][n] * sc + bg[n], l1 = acc[ai][1][m][n] * sc + bl[n];
                    f32x4 glu, lin1;
#pragma unroll
                    for (int j = 0; j < 4; ++j) { glu[j] = __builtin_fminf(g0[j], 7.0f); lin1[j] = __builtin_amdgcn_fmed3f(l1[j], -6.0f, 8.0f); }
                    const f32x4 t = glu * (-1.702f * 1.4426950408889634f);
                    f32x4 e;
#pragma unroll
                    for (int j = 0; j < 4; ++j) e[j] = __builtin_amdgcn_exp2f(t[j]);
                    const f32x4 d = e + 1.0f;
                    f32x4 r;
#pragma unroll
                    for (int j = 0; j < 4; ++j) r[j] = __builtin_amdgcn_rcpf(d[j]);
                    hv[n] = (glu * r) * lin1;
                }
                u32x2 hq; hq.x = (unsigned)__builtin_amdgcn_cvt_pk_fp8_f32(hv[0][0], hv[0][1], 0, false); hq.x = (unsigned)__builtin_amdgcn_cvt_pk_fp8_f32(hv[0][2], hv[0][3], (int)hq.x, true);
                hq.y = (unsigned)__builtin_amdgcn_cvt_pk_fp8_f32(hv[1][0], hv[1][1], 0, false); hq.y = (unsigned)__builtin_amdgcn_cvt_pk_fp8_f32(hv[1][2], hv[1][3], (int)hq.y, true);
                *(u32x2*)(H + (size_t)(u.pm * BM + ai * HALF + wr * 64 + m * 16 + fr) * 1024 + cc) = hq;
            }
    }
};
struct EpiMoeDown {
    static constexpr bool PERM = true, AFTER_DRAIN = false;
    unsigned char* YS; const PG8_LAS unsigned char* pf_lds;
    __device__ __forceinline__ void operator()(const f32x4 (&acc)[2][2][4][2], const Unit& u, int wr, int wc, int fr, int fq) const {
#ifdef PROBE_LO
        if (YS == nullptr) return;
#endif
        const int col0 = u.pn * BM + wc * 32 + 8 * fq;
        const PG8_LAS unsigned char* buf = pf_lds + (u.seq & 1) * PF_BUF_BYTES + (wr * 4 + wc) * PF_WAVE_BYTES;
        f32x4 bv[2][2];
#pragma unroll
        for (int bj = 0; bj < 2; ++bj)
#pragma unroll
            for (int n = 0; n < 2; ++n) bv[bj][n] = *(const PG8_LAS f32x4*)(buf + bj * 128 + (8 * fq + 4 * n) * 4);
#pragma unroll
        for (int ai = 0; ai < 2; ++ai)
#pragma unroll
            for (int m = 0; m < 4; ++m) { unsigned char* rowp = YS + (size_t)(u.pm * BM + ai * HALF + wr * 64 + m * 16 + fr) * 1024 + col0;
#pragma unroll
                for (int bj = 0; bj < 2; ++bj) { const f32x4 y0 = acc[ai][bj][m][0] * 0.015625f + bv[bj][0], y1 = acc[ai][bj][m][1] * 0.015625f + bv[bj][1];
                    u32x2 q; q.x = (unsigned)__builtin_amdgcn_cvt_pk_fp8_f32(y0[0], y0[1], 0, false); q.x = (unsigned)__builtin_amdgcn_cvt_pk_fp8_f32(y0[2], y0[3], (int)q.x, true);
                    q.y = (unsigned)__builtin_amdgcn_cvt_pk_fp8_f32(y1[0], y1[1], 0, false); q.y = (unsigned)__builtin_amdgcn_cvt_pk_fp8_f32(y1[2], y1[3], (int)q.y, true);
                    *(u32x2*)(rowp + bj * HALF) = q; } }
    }
};
struct EpiPle {
    static constexpr bool PERM = false, AFTER_DRAIN = false;
    const bf16_t* X2; const bf16_t* PJ; float* outw;
    __device__ __forceinline__ void operator()(const f32x4 (&acc)[2][2][4][2], const Unit& u, int wr, int wc, int fr, int fq) const {
        const int col0 = u.pn * BM + wc * 32 + 4 * fq;
#pragma unroll
        for (int ai = 0; ai < 2; ++ai)
#pragma unroll
            for (int m = 0; m < 4; ++m) { const size_t off = (size_t)(u.pm * BM + ai * HALF + wr * 64 + m * 16 + fr) * DM + col0;
#pragma unroll
                for (int bj = 0; bj < 2; ++bj)
#pragma unroll
                    for (int n = 0; n < 2; ++n) {
                        const size_t o2 = off + bj * HALF + n * 16;
                        const u32x2 xq = __builtin_nontemporal_load((const u32x2*)(X2 + o2)); const f32x4 x2 = (f32x4){__uint_as_float(xq.x << 16), __uint_as_float(xq.x & 0xffff0000u), __uint_as_float(xq.y << 16), __uint_as_float(xq.y & 0xffff0000u)}; const u32x2 pj = __builtin_nontemporal_load((const u32x2*)(PJ + o2)); const f32x4 a = acc[ai][bj][m][n] * 0.015625f;
                        f32x4 r;
                        r[0] = x2[0] + __uint_as_float(pj.x << 16) * __builtin_amdgcn_rcpf(1.0f + __builtin_amdgcn_exp2f(-1.4426950408889634f * a[0]));
                        r[1] = x2[1] + __uint_as_float(pj.x & 0xffff0000u) * __builtin_amdgcn_rcpf(1.0f + __builtin_amdgcn_exp2f(-1.4426950408889634f * a[1]));
                        r[2] = x2[2] + __uint_as_float(pj.y << 16) * __builtin_amdgcn_rcpf(1.0f + __builtin_amdgcn_exp2f(-1.4426950408889634f * a[2]));
                        r[3] = x2[3] + __uint_as_float(pj.y & 0xffff0000u) * __builtin_amdgcn_rcpf(1.0f + __builtin_amdgcn_exp2f(-1.4426950408889634f * a[3]));
                        __builtin_nontemporal_store(r, (f32x4*)(outw + o2));
                    } }
    }
};
struct MoeOrder {
    int nM, nN, nwg, G, c, wid, mode; const PG8_LAS int* tile_e; const float* pf_bias; const float* pf_rstd; PG8_LAS unsigned char* pf_lds;
    const int* toklist; const PG8_LAS int* first_tile; PG8_LAS unsigned char* tokl;
    __device__ __forceinline__ const int* tok_src(const Unit& u) const { return toklist + (size_t)u.e * T + 256 * (u.pm - first_tile[u.e]); }
    __device__ __forceinline__ PG8_LAS unsigned char* tok_lds() const { return tokl; }
    __device__ void init(int nM_, int nN_, int G_, int c_, const PG8_LAS int* te, int wid_, int mode_, const float* pb, const float* pr, PG8_LAS unsigned char* pl) { nM = nM_; nN = nN_; nwg = nM * nN; G = G_; c = c_; tile_e = te; wid = wid_; mode = mode_; pf_bias = pb; pf_rstd = pr; pf_lds = pl; }
    __device__ bool next(int i, Unit& u) const {
        const long L = (long)i * G + c; if (L >= nwg) return false;
        int wgid = (int)L; { const int q = nwg / NXCD, r = nwg % NXCD, xcd = wgid % NXCD, off = wgid / NXCD; wgid = (xcd < r ? xcd * (q + 1) : r * (q + 1) + (xcd - r) * q) + off; }
        const int nig = WGM * nN, gid = wgid / nig, fm = gid * WGM, gsz = (nM - fm) < WGM ? (nM - fm) : WGM;
        u.pm = fm + ((wgid % nig) % gsz); u.pn = (wgid % nig) / gsz; u.e = __builtin_amdgcn_readfirstlane(tile_e[u.pm]); u.seq = i; return true;
    }
    __device__ __forceinline__ void a_ready(const Unit& u) const {
        const int lane = (int)__builtin_amdgcn_mbcnt_hi(~0u, __builtin_amdgcn_mbcnt_lo(~0u, 0u)), wr = wid >> 2, wc = wid & 3;
        PG8_LAS unsigned char* buf = pf_lds + (u.seq & 1) * PF_BUF_BYTES + wid * PF_WAVE_BYTES;
        if (mode == 1) {
            const float* bsrc = pf_bias + (size_t)u.e * 2048 + 128 * u.pn + 32 * wc + (lane & 31) + ((lane >> 5) ? 1024 : 0);
            __builtin_amdgcn_global_load_lds((const unsigned*)bsrc, (PG8_LAS unsigned*)buf, 4, 0, 0);
            const PG8_LAS int* tl = (const PG8_LAS int*)(tokl + 1024 * (u.seq & 1)) + wr * 64 + lane;
            __builtin_amdgcn_global_load_lds((const unsigned*)(pf_rstd + tl[0]), (PG8_LAS unsigned*)(buf + 256), 4, 0, 0);
            __builtin_amdgcn_global_load_lds((const unsigned*)(pf_rstd + tl[HALF]), (PG8_LAS unsigned*)(buf + 512), 4, 0, 0);
        } else if (mode == 2) {
            const float* bsrc = pf_bias + (size_t)u.e * 1024 + u.pn * BM + 32 * wc + (lane & 31) + ((lane >> 5) ? HALF : 0);
            __builtin_amdgcn_global_load_lds((const unsigned*)bsrc, (PG8_LAS unsigned*)buf, 4, 0, 0);
        }
    }
    __device__ __forceinline__ void done(const Unit&) const {}
};
struct EpiNull {
    static constexpr bool PERM = true, AFTER_DRAIN = false;
    __device__ __forceinline__ void operator()(const f32x4 (&acc)[2][2][4][2], const Unit& u, int wr, int wc, int fr, int fq) const {
#pragma unroll
        for (int ai = 0; ai < 2; ++ai)
#pragma unroll
            for (int bj = 0; bj < 2; ++bj)
#pragma unroll
                for (int m = 0; m < 4; ++m)
#pragma unroll
                    for (int n = 0; n < 2; ++n) asm volatile("" :: "v"(acc[ai][bj][m][n]));
    }
};
template <class Epi, class Sched, bool ALIGN_EPI = false, bool SP2 = false, bool F8 = false, bool GATHER = false>
__device__ __forceinline__ void gemm_phase(PG8_LAS unsigned char* lds, const Gemm g, const Sched& S, const Epi& E, const int wave_id) {
    int tid_ = wave_id * 64 + lane_id_hw(); asm volatile("" : "+v"(tid_));
    const int tid = tid_, wid = __builtin_amdgcn_readfirstlane(tid >> 6), lane = tid & 63, wr = wid >> 2, wc = wid & 3, fr = lane & 15, fq = lane >> 4;
    const int K = g.K, nt = K / BK;
    unsigned voffA[2], voffB[2];
#pragma unroll
    for (int i = 0; i < 2; ++i) { int R, C; stage_rc(tid * 16 + i * 8192, R, C); const int Rb = Epi::PERM ? ((R & ~31) + perm32(R & 31)) : R;
        voffA[i] = (unsigned)(R * K + C) * 2u; voffB[i] = (unsigned)(Rb * K + C) * 2u; }
    const size_t kstep = (size_t)(BK * 2);
    const size_t hstep = (size_t)HALF * K * 2;
    const size_t tstep = 2 * hstep;
    const size_t hstepA = GATHER ? 0 : hstep;
    unsigned gC[2][2];
#pragma unroll
    for (int h = 0; h < 2; ++h)
#pragma unroll
        for (int i = 0; i < 2; ++i) gC[h][i] = voffA[i];
#define PG8_TOK_DMA(U, par) do { if constexpr (GATHER) { if (wid < 4) __builtin_amdgcn_global_load_lds((const unsigned*)(S.tok_src(U) + 64 * wid + (int)__builtin_amdgcn_mbcnt_hi(~0u, __builtin_amdgcn_mbcnt_lo(~0u, 0u))), (PG8_LAS unsigned*)(S.tok_lds() + 1024 * (par) + 256 * wid), 4, 0, 0); } } while (0)
#define PG8_TOK_READ(dst, par) do { if constexpr (GATHER) { _Pragma("unroll") for (int i = 0; i < 2; ++i) { int R_, C_; stage_rc((wid * 64 + (int)__builtin_amdgcn_mbcnt_hi(~0u, __builtin_amdgcn_mbcnt_lo(~0u, 0u))) * 16 + i * 8192, R_, C_); _Pragma("unroll") for (int h = 0; h < 2; ++h) \
        dst[h][i] = (unsigned)(*(const PG8_LAS int*)(S.tok_lds() + 1024 * (par) + 4 * (h * HALF + R_))) * (unsigned)(K * 2) + (unsigned)C_ * 2u; } } } while (0)
    const unsigned ldsw = (unsigned)wid * 1024u;
    const int aoff = lds_byte(wr * 64 + fr, fq * 8), boff = lds_byte(wc * 32 + fr, fq * 8);
#define PG8_SA(b, h) (((b) * 2 + (h)) * HTB)
#define PG8_SB(b, h) ((4 + (b) * 2 + (h)) * HTB)
#define PG8_STAGE(bufoff, gbase, voff) do { if (!PG8_NOSTAGE) _Pragma("unroll") for (int _i = 0; _i < 2; ++_i) \
        __builtin_amdgcn_global_load_lds((const unsigned*)((const char*)(gbase) + (voff)[_i]), (PG8_LAS unsigned*)(lds + (bufoff) + ldsw + _i * 8192), 16, 0, 0); } while (0)
#define PG8_LD16(off) (*(const PG8_LAS v4i32*)(lds + (off)))
#define PG8_LDA(dst, b, h) do { if constexpr (F8) { _Pragma("unroll") for (int m = 0; m < 4; ++m) dst##8[m] = __builtin_shufflevector(PG8_LD16(PG8_SA(b, h) + aoff + m * 2048), PG8_LD16(PG8_SA(b, h) + aoff + m * 2048 + 1024), 0, 1, 2, 3, 4, 5, 6, 7); } \
        else { _Pragma("unroll") for (int m = 0; m < 4; ++m) _Pragma("unroll") for (int k = 0; k < 2; ++k) dst[m][k] = *(const PG8_LAS bf16x8*)(lds + PG8_SA(b, h) + aoff + m * 2048 + k * 1024); } } while (0)
#define PG8_LDB(dst, b, h) do { if constexpr (F8) { _Pragma("unroll") for (int n = 0; n < 2; ++n) dst##8[n] = __builtin_shufflevector(PG8_LD16(PG8_SB(b, h) + boff + n * 2048), PG8_LD16(PG8_SB(b, h) + boff + n * 2048 + 1024), 0, 1, 2, 3, 4, 5, 6, 7); } \
        else { _Pragma("unroll") for (int n = 0; n < 2; ++n) _Pragma("unroll") for (int k = 0; k < 2; ++k) dst[n][k] = *(const PG8_LAS bf16x8*)(lds + PG8_SB(b, h) + boff + n * 2048 + k * 1024); } } while (0)
#define PG8_MMA(ai, bj, At, Bt) do { __builtin_amdgcn_s_setprio(1); \
        if constexpr (F8) { _Pragma("unroll") for (int m = 0; m < 4; ++m) _Pragma("unroll") for (int n = 0; n < 2; ++n) \
            asm volatile("v_mfma_scale_f32_16x16x128_f8f6f4 %0, %1, %2, %0, %3, %3 op_sel_hi:[0,0,0]" : "+v"(acc[ai][bj][m][n]) : "v"(Bt##8[n]), "v"(At##8[m]), "v"(f8scale)); } \
        else { _Pragma("unroll") for (int m = 0; m < 4; ++m) _Pragma("unroll") for (int n = 0; n < 2; ++n) _Pragma("unroll") for (int k = 0; k < 2; ++k) \
            acc[ai][bj][m][n] = __builtin_amdgcn_mfma_f32_16x16x32_bf16(Bt[n][k], At[m][k], acc[ai][bj][m][n], 0, 0, 0); } \
        __builtin_amdgcn_s_setprio(0); } while (0)
#define PG8_WAIT_V(n) asm volatile("s_waitcnt vmcnt(" #n ")" ::: "memory")
#define PG8_WAIT_L(n) asm volatile("s_waitcnt lgkmcnt(" #n ")" ::: "memory")
#define PG8_BAR __builtin_amdgcn_s_barrier()
#define PG8_SCHED __builtin_amdgcn_sched_barrier(0)
    Unit cur, nxt; int ui = 0;
    if (!S.next(0, cur)) return;
    f32x4 acc[2][2][4][2];
#pragma unroll
    for (int a = 0; a < 2; ++a)
#pragma unroll
        for (int b = 0; b < 2; ++b)
#pragma unroll
            for (int m = 0; m < 4; ++m)
#pragma unroll
                for (int n = 0; n < 2; ++n) acc[a][b][m][n] = (f32x4){0.f, 0.f, 0.f, 0.f};
    bf16x8 At[4][2], B0[2][2], B1[2][2];
    v8i32 At8[4], B08[2], B18[2]; const int f8scale = 0x7f7f7f7f;
    const char* cA = (const char*)g.A + (GATHER ? (size_t)0 : (size_t)cur.pm * tstep); const char* cB = (const char*)g.Bt + (size_t)cur.e * g.strideBe + (size_t)cur.pn * tstep;
    if constexpr (GATHER) { PG8_TOK_DMA(cur, 0); asm volatile("s_waitcnt vmcnt(0)" ::: "memory"); PG8_BAR; PG8_TOK_READ(gC, 0); }
    S.a_ready(cur);
    if constexpr (SP2) {
        PG8_STAGE(PG8_SB(0, 0), cB, voffB); PG8_STAGE(PG8_SB(0, 1), cB + hstep, voffB); PG8_STAGE(PG8_SA(0, 0), cA, gC[0]); PG8_STAGE(PG8_SA(0, 1), cA + hstepA, gC[1]);
        if (wr == 1) PG8_BAR;
        PG8_WAIT_V(2); PG8_BAR;
        PG8_STAGE(PG8_SB(1, 0), cB + kstep, voffB); PG8_STAGE(PG8_SA(1, 0), cA + kstep, gC[0]); PG8_STAGE(PG8_SB(1, 1), cB + hstep + kstep, voffB);
        PG8_WAIT_V(6); PG8_BAR;
    } else {
        PG8_STAGE(PG8_SB(0, 0), cB, voffB); PG8_STAGE(PG8_SA(0, 0), cA, voffA); PG8_STAGE(PG8_SB(0, 1), cB + hstep, voffB); PG8_STAGE(PG8_SA(0, 1), cA + hstep, voffA);
        if (wr == 1) PG8_BAR;
        PG8_WAIT_V(4); PG8_BAR;
        PG8_STAGE(PG8_SB(1, 0), cB + kstep, voffB); PG8_STAGE(PG8_SA(1, 0), cA + kstep, voffA); PG8_STAGE(PG8_SB(1, 1), cB + hstep + kstep, voffB);
        PG8_WAIT_V(6); PG8_BAR;
    }
    for (;;) {
        const bool has_next = S.next(ui + 1, nxt);
        const char* nA = (has_next && !GATHER) ? (const char*)g.A + (size_t)nxt.pm * tstep : cA;
        const char* nB = has_next ? (const char*)g.Bt + (size_t)nxt.e * g.strideBe + (size_t)nxt.pn * tstep : cB;
        if (has_next) PG8_TOK_DMA(nxt, (ui + 1) & 1);
#pragma unroll 1
        for (int t = 0; t < nt; t += 2) {
            const bool last = (t == nt - 2);
            const char* a1 = cA + (size_t)(t + 1) * kstep;
            const char* a2 = last ? nA : cA + (size_t)(t + 2) * kstep; const char* b2 = last ? nB : cB + (size_t)(t + 2) * kstep;
            const char* a3 = a2 + kstep; const char* b3 = b2 + kstep;
            if (last && has_next) S.a_ready(nxt);
            if constexpr (SP2) {
            PG8_LDB(B0, 0, 0); PG8_LDB(B1, 0, 1); PG8_SCHED; PG8_LDA(At, 0, 0); PG8_STAGE(PG8_SA(1, 1), a1 + hstepA, gC[1]);
            if constexpr (GATHER) { if (last && has_next) PG8_TOK_READ(gC, (ui + 1) & 1); }
            PG8_WAIT_V(8); PG8_WAIT_L(0); PG8_BAR; PG8_MMA(0, 0, At, B0); PG8_MMA(0, 1, At, B1); PG8_BAR; PG8_SCHED;
            PG8_LDA(At, 0, 1); PG8_STAGE(PG8_SB(0, 0), b2, voffB); PG8_STAGE(PG8_SB(0, 1), b2 + hstep, voffB); PG8_STAGE(PG8_SA(0, 0), a2, gC[0]);
            PG8_WAIT_V(8); PG8_WAIT_L(0); PG8_BAR; PG8_MMA(1, 0, At, B0); PG8_MMA(1, 1, At, B1); PG8_BAR; PG8_SCHED;
            PG8_LDB(B0, 1, 0); PG8_LDB(B1, 1, 1); PG8_SCHED; PG8_LDA(At, 1, 0); PG8_STAGE(PG8_SA(0, 1), a2 + hstepA, gC[1]);
            PG8_WAIT_V(8); PG8_WAIT_L(0); PG8_BAR; PG8_MMA(0, 0, At, B0); PG8_MMA(0, 1, At, B1); PG8_BAR; PG8_SCHED;
            PG8_LDA(At, 1, 1); PG8_STAGE(PG8_SB(1, 0), b3, voffB); PG8_STAGE(PG8_SB(1, 1), b3 + hstep, voffB); PG8_STAGE(PG8_SA(1, 0), a3, gC[0]);
            PG8_WAIT_V(8); PG8_WAIT_L(0); PG8_BAR; PG8_MMA(1, 0, At, B0); PG8_MMA(1, 1, At, B1); PG8_BAR; PG8_SCHED;
            } else {
            PG8_LDB(B0, 0, 0); PG8_SCHED; PG8_LDA(At, 0, 0); PG8_STAGE(PG8_SA(1, 1), a1 + hstep, voffA);
            PG8_WAIT_L(8); PG8_BAR; PG8_WAIT_L(0); PG8_MMA(0, 0, At, B0); PG8_BAR; PG8_SCHED;
            PG8_LDB(B1, 0, 1); PG8_STAGE(PG8_SB(0, 0), b2, voffB);
            PG8_BAR; PG8_WAIT_L(0); PG8_MMA(0, 1, At, B1); PG8_BAR;
            PG8_LDA(At, 0, 1); PG8_STAGE(PG8_SA(0, 0), a2, voffA);
            PG8_BAR; PG8_WAIT_L(0); PG8_MMA(1, 0, At, B0); PG8_BAR; PG8_SCHED;
            PG8_STAGE(PG8_SB(0, 1), b2 + hstep, voffB);
            PG8_WAIT_V(6); PG8_BAR; PG8_MMA(1, 1, At, B1); PG8_BAR;
            PG8_LDB(B0, 1, 0); PG8_SCHED; PG8_LDA(At, 1, 0); PG8_STAGE(PG8_SA(0, 1), a2 + hstep, voffA);
            PG8_WAIT_L(8); PG8_BAR; PG8_WAIT_L(0); PG8_MMA(0, 0, At, B0); PG8_BAR; PG8_SCHED;
            PG8_LDB(B1, 1, 1); PG8_STAGE(PG8_SB(1, 0), b3, voffB);
            PG8_BAR; PG8_WAIT_L(0); PG8_MMA(0, 1, At, B1); PG8_BAR;
            PG8_LDA(At, 1, 1); PG8_STAGE(PG8_SA(1, 0), a3, voffA);
            PG8_BAR; PG8_WAIT_L(0); PG8_MMA(1, 0, At, B0); PG8_BAR; PG8_SCHED;
            PG8_STAGE(PG8_SB(1, 1), b3 + hstep, voffB);
            PG8_WAIT_V(6); PG8_BAR; PG8_MMA(1, 1, At, B1); PG8_BAR;
            }
        }
        if constexpr (ALIGN_EPI) { if (wr == 0) PG8_BAR; }
        if constexpr (F8) asm volatile("s_nop 15\n\ts_nop 15\n\ts_nop 15" ::: "memory");
        if constexpr (!Epi::AFTER_DRAIN) { E(acc, cur, wr, wc, fr, fq); S.done(cur); }
        if (!has_next) break;
#pragma unroll
        for (int a = 0; a < 2; ++a)
#pragma unroll
            for (int b = 0; b < 2; ++b)
#pragma unroll
                for (int m = 0; m < 4; ++m)
#pragma unroll
                    for (int n = 0; n < 2; ++n) acc[a][b][m][n] = (f32x4){0.f, 0.f, 0.f, 0.f};
        cur = nxt; cA = nA; cB = nB; ++ui;
        if constexpr (ALIGN_EPI) { if (wr == 1) PG8_BAR; }
    }
    PG8_WAIT_V(0);
    if constexpr (!ALIGN_EPI) { if (wr == 0) PG8_BAR; }
    PG8_BAR;
    if constexpr (Epi::AFTER_DRAIN) { E.fused(acc, cur, wr, wc, fr, fq, lds, wid, lane); S.done(cur); }
#undef PG8_TOK_DMA
#undef PG8_TOK_READ
#undef PG8_SA
#undef PG8_SB
#undef PG8_STAGE
#undef PG8_LD16
#undef PG8_LDA
#undef PG8_LDB
#undef PG8_MMA
#undef PG8_WAIT_V
#undef PG8_WAIT_L
#undef PG8_BAR
#undef PG8_SCHED
}
}

constexpr int NWAVES = 8;
constexpr int T = pg8::T, SEQ = pg8::SEQ, DM = pg8::DM, DIN = pg8::DIN, NE = 32, PLE = 256;
constexpr float EPS = pg8::EPS;
constexpr size_t MiB = 1u << 20;
constexpr size_t WS_CTL = 0, CTL_ZERO_BYTES = 256 * 1024;
constexpr size_t WS_WT_IN = 2 * MiB, WS_WT_OUT = 9 * MiB, WS_WT_PG = 11 * MiB, WS_WT_PP = 13 * MiB;
constexpr size_t WS_GAINS = 13 * MiB + 512 * 1024;
constexpr size_t WS_WRT = 13 * MiB + 576 * 1024;
constexpr size_t WS_ROPEC = 14 * MiB, WS_ROPES = 16 * MiB, WS_PB = 18 * MiB, WS_ROUTE = 26 * MiB;
constexpr size_t WS_TOKLIST = 29 * MiB;
constexpr size_t WS_WT_UG = 32 * MiB, WS_WT_DN = 160 * MiB;
constexpr size_t WS_XN = 224 * MiB;
constexpr size_t WS_HM = 256 * MiB;
constexpr size_t WS_X1 = 256 * MiB;
constexpr size_t WS_RG = 352 * MiB;
constexpr size_t WS_Y = 368 * MiB;
constexpr size_t WS_PJ = 400 * MiB;
constexpr size_t WS_XS = 432 * MiB, WS_H = 576 * MiB, WS_YS = 720 * MiB;
constexpr size_t WS_END = 864 * MiB;
constexpr int CW_TMO = 0, CW_CODE = 1;
constexpr int CW_BAR = 4096;
constexpr int RING_OFF = 0, RING_BYTES = 131072;
constexpr int LDSCTL_OFF = RING_BYTES, MISC_OFF = LDSCTL_OFF + 320;
constexpr int PF_OFF = LDSCTL_OFF + 4096;
constexpr int TOKL_OFF = LDSCTL_OFF + 16384;
constexpr int LDS_BYTES = 151552;
#define GAS __attribute__((address_space(1)))
#define LAS __attribute__((address_space(3)))
typedef unsigned short bf16;
typedef unsigned v4u __attribute__((ext_vector_type(4)));
typedef float f32x4 __attribute__((ext_vector_type(4)));
typedef short bf16x8 __attribute__((ext_vector_type(8)));
typedef unsigned u32x4_t __attribute__((ext_vector_type(4)));
typedef unsigned u32x2_t __attribute__((ext_vector_type(2)));
typedef GAS unsigned gu32;
typedef GAS unsigned long long gu64;
#define RLX_AGENT __ATOMIC_RELAXED, __HIP_MEMORY_SCOPE_AGENT
#define LDS_WAIT() asm volatile("s_waitcnt lgkmcnt(0)" ::: "memory")
#define VM_WAIT() asm volatile("s_waitcnt vmcnt(0)" ::: "memory")
__device__ __forceinline__ unsigned long long rt() { return __builtin_amdgcn_s_memrealtime(); }
__device__ __forceinline__ unsigned f2bf(float f) { unsigned u = __builtin_bit_cast(unsigned, f); return (u + 0x7fffu + ((u >> 16) & 1u)) >> 16; }
__device__ __forceinline__ unsigned pk2(float lo, float hi) { return f2bf(lo) | (f2bf(hi) << 16); }

#define XB_TMO      128
#define XB_XCNT(j)  (256  + 64 * (j))
#define XB_XSUB(j)  (1280 + 64 * (j))
#define XB_XGEN(j)  (2304 + 64 * (j))
#define XB_TOP      3328
#define XB_TOPGEN   3392
#define XCD_BAR_WORDS 3456
#define XB_SPIN_CAP (1u << 18)

__device__ __forceinline__ unsigned xb_ld(unsigned* p)              { return __hip_atomic_load(p, __ATOMIC_RELAXED, __HIP_MEMORY_SCOPE_AGENT); }
__device__ __forceinline__ unsigned xb_add(unsigned* p, unsigned v) { return __hip_atomic_fetch_add(p, v, __ATOMIC_RELAXED, __HIP_MEMORY_SCOPE_AGENT); }
__device__ __forceinline__ unsigned xb_xcc_id() { return (unsigned)__builtin_amdgcn_s_getreg((3 << 11) | 20) & 0xFu; }
#define XB_SPIN(cond, bar) do { unsigned _sp = 0; while (cond) { __builtin_amdgcn_s_sleep(1); \
    if ((++_sp & 255u) == 0u) { if (xb_ld(&(bar)[XB_TMO])) break; if (_sp > XB_SPIN_CAP) { atomicAdd(&(bar)[XB_TMO], 1u); break; } } } } while (0)

struct XcdBarrier {
    unsigned* bar; unsigned x; int wave;
    volatile LAS unsigned* st;
};

__device__ __forceinline__ XcdBarrier xcd_barrier_post(unsigned* bar, volatile LAS unsigned* st) {
    XcdBarrier b; b.bar = bar; b.x = xb_xcc_id(); b.st = st;
    if (threadIdx.x == 0) (void)xb_add(&bar[XB_XCNT(b.x)], 1u);
    return b;
}
__device__ __forceinline__ void xcd_barrier_complete(unsigned* bar, unsigned x, unsigned& nloc, unsigned& nx) {
    const unsigned G = gridDim.x * gridDim.y * gridDim.z;
    unsigned sum, cnt, mine, sp = 0u;
    for (;;) {
        sum = 0u; cnt = 0u; mine = 0u;
#pragma unroll
        for (unsigned j = 0; j < 16; ++j) { const unsigned c = xb_ld(&bar[XB_XCNT(j)]); sum += c; cnt += (c > 0u) ? 1u : 0u; mine = (j == x) ? c : mine; }
        if (sum == G) break;
        __builtin_amdgcn_s_sleep(1);
        if ((++sp & 255u) == 0u) { if (xb_ld(&bar[XB_TMO])) break; if (sp > XB_SPIN_CAP) { atomicAdd(&bar[XB_TMO], 1u); break; } }
    }
    nloc = mine > 0u ? mine : 1u; nx = cnt > 0u ? cnt : 1u;
}

__device__ __forceinline__ void xcd_barrier(const XcdBarrier& b) {
    asm volatile("s_waitcnt vmcnt(0)" ::: "memory");
    __syncthreads();
    if (b.wave == 0 && lane_id_hw() == 0) {
        unsigned* bar = b.bar;
        __builtin_amdgcn_s_waitcnt(0);
        unsigned nloc = b.st[0], nx = b.st[1];
        if (nloc == 0u) { xcd_barrier_complete(bar, b.x, nloc, nx); b.st[0] = nloc; b.st[1] = nx; }
        const unsigned old = xb_add(&bar[XB_XSUB(b.x)], 1u);
        const unsigned gen = old / nloc;
        const unsigned tgen = gen;
        if (old + 1u == (gen + 1u) * nloc) {
            __builtin_amdgcn_fence(__ATOMIC_RELEASE, "agent");
            asm volatile("s_waitcnt vmcnt(0)" ::: "memory");
            const unsigned og = xb_add(&bar[XB_TOP], 1u);
            const unsigned tg = og / nx;
            if (og + 1u == (tg + 1u) * nx) xb_add(&bar[XB_TOPGEN], 1u);
            else XB_SPIN(xb_ld(&bar[XB_TOPGEN]) == tg, bar);
        } else {
            XB_SPIN(xb_ld(&bar[XB_TOPGEN]) == tgen, bar);
        }
        __builtin_amdgcn_fence(__ATOMIC_ACQUIRE, "agent");
        asm volatile("s_waitcnt vmcnt(0)" ::: "memory");
    }
    __syncthreads();
}

struct Args {
    const float* x; const float* p; const int* positions; const float* g_mix; const float* w_in;
    const float* sbq; const float* sbk; const float* rq; const float* rk; const float* gn_g; const float* gn_b; const float* w_out;
    const float* g_ffn; const float* w_r; const float* b_r; const float* w_ug; const float* b_ug; const float* w_dn; const float* b_dn;
    const float* g_ple; const float* w_pg; const float* w_pp;
    float* out; unsigned char* ws; int ph_lo, ph_hi;
};
struct Frame {
    LAS unsigned char* lds;
    volatile LAS unsigned* MISC;
    gu32* ctl;
    int wave;
    int vcu, G;
};
__device__ __forceinline__ int tid_now(int wave_id) { int t = wave_id * 64 + lane_id_hw(); asm volatile("" : "+v"(t)); return t; }
__device__ __forceinline__ float wave_sum(float v) {
#pragma unroll
    for (int o = 1; o < 64; o <<= 1) v += __shfl_xor(v, o);
    return v;
}
__device__ __forceinline__ unsigned cvtpk(float lo, float hi) { return pg8::cvt_pk_bf16(lo, hi); }

enum { MAP_NAT = 0, MAP_IN = 1, MAP_UG = 2 };
constexpr int P0_E_P2 = 32;
__device__ __forceinline__ void p0_item(const float* __restrict__ W, int N, int K, bf16* __restrict__ WT, int kb, int nb, int mapmode, LAS unsigned char* scr, int lane) {
    const int np = 64 * nb + 4 * (lane & 15);
    int src = np;
    if (mapmode == MAP_IN) { const int pn = np >> 8, L = np & 255, bj = L >> 7, wc = (L >> 5) & 3, e = L & 31; src = 256 * pn + 64 * wc + 32 * bj + e; }
    else if (mapmode == MAP_UG) { const int pn = np >> 8, L = np & 255, bj = L >> 7, i = L & 127; src = 1024 * bj + 128 * pn + i; }
    const float* gp = W + (size_t)(64 * kb + (lane >> 4)) * N + src;
    f32x4 v[16];
#pragma unroll
    for (int i = 0; i < 16; ++i) v[i] = *(const f32x4*)(gp + (size_t)(4 * i) * N);
#pragma unroll
    for (int i = 0; i < 16; ++i) {
        LAS unsigned* d = (LAS unsigned*)(scr + (4 * i + (lane >> 4)) * 132 + 8 * (lane & 15));
        d[0] = cvtpk(v[i][0], v[i][1]); d[1] = cvtpk(v[i][2], v[i][3]);
    }
    LDS_WAIT(); asm volatile("" ::: "memory");
    const int c = lane & 7;
#pragma unroll
    for (int it = 0; it < 4; ++it) {
        const int nl = 16 * it + 2 * (lane >> 3);
        unsigned d[8];
#pragma unroll
        for (int j = 0; j < 8; ++j) d[j] = *(const LAS unsigned*)(scr + (8 * c + j) * 132 + 2 * nl);
        v4u o0, o1;
        o0.x = (d[0] & 0xffffu) | (d[1] << 16); o0.y = (d[2] & 0xffffu) | (d[3] << 16); o0.z = (d[4] & 0xffffu) | (d[5] << 16); o0.w = (d[6] & 0xffffu) | (d[7] << 16);
        o1.x = (d[0] >> 16) | (d[1] & 0xffff0000u); o1.y = (d[2] >> 16) | (d[3] & 0xffff0000u); o1.z = (d[4] >> 16) | (d[5] & 0xffff0000u); o1.w = (d[6] >> 16) | (d[7] & 0xffff0000u);
        bf16* dst = WT + (size_t)(64 * nb + nl) * K + 64 * kb + 8 * c;
        *(v4u*)dst = o0; *(v4u*)(dst + K) = o1;
    }
    LDS_WAIT(); asm volatile("" ::: "memory");
}
__device__ __forceinline__ unsigned pk4_fp8(float a, float b, float c, float d) { int r = __builtin_amdgcn_cvt_pk_fp8_f32(a, b, 0, false); r = __builtin_amdgcn_cvt_pk_fp8_f32(c, d, r, true); return (unsigned)r; }
__device__ __forceinline__ void p0_item_f8(const float* __restrict__ W, int N, int K, unsigned char* __restrict__ WT, int kb, int nb, int mapmode, LAS unsigned char* scr, int lane) {
    const int np = 64 * nb + 4 * (lane & 15);
    int src = np;
    if (mapmode == MAP_UG) { const int pn = np >> 8, L = np & 255, bj = L >> 7, i = L & 127; src = 1024 * bj + 128 * pn + i; }
    const float* gp = W + (size_t)(64 * kb + (lane >> 4)) * N + src;
    f32x4 v[16];
#pragma unroll
    for (int i = 0; i < 16; ++i) v[i] = *(const f32x4*)(gp + (size_t)(4 * i) * N);
#pragma unroll
    for (int i = 0; i < 16; ++i) *(LAS unsigned*)(scr + (4 * i + (lane >> 4)) * 68 + 4 * (lane & 15)) = pk4_fp8(v[i][0] * 64.0f, v[i][1] * 64.0f, v[i][2] * 64.0f, v[i][3] * 64.0f);
    LDS_WAIT(); asm volatile("" ::: "memory");
    const int nq = lane & 15, kg = lane >> 4;
    unsigned d[16];
#pragma unroll
    for (int j = 0; j < 16; ++j) d[j] = *(const LAS unsigned*)(scr + (16 * kg + j) * 68 + 4 * nq);
#pragma unroll
    for (int t = 0; t < 4; ++t) {
        v4u o;
#pragma unroll
        for (int q = 0; q < 4; ++q) o[q] = ((d[4 * q] >> (8 * t)) & 0xffu) | (((d[4 * q + 1] >> (8 * t)) & 0xffu) << 8) | (((d[4 * q + 2] >> (8 * t)) & 0xffu) << 16) | (((d[4 * q + 3] >> (8 * t)) & 0xffu) << 24);
        *(v4u*)(WT + (size_t)(64 * nb + 4 * nq + t) * K + 64 * kb + 16 * kg) = o;
    }
    LDS_WAIT(); asm volatile("" ::: "memory");
}
struct P0D { const float* gp; int N, K, kb, nb; bf16* W16; unsigned char* W8; const float* rsc; };
__device__ __forceinline__ int p0_src_col(int np, int mapmode) {
    int src = np;
    if (mapmode == MAP_IN) { const int pn = np >> 8, L = np & 255, bj = L >> 7, wc = (L >> 5) & 3, e = L & 31; src = 256 * pn + 64 * wc + 32 * bj + e; }
    else if (mapmode == MAP_UG) { const int pn = np >> 8, L = np & 255, bj = L >> 7, i = L & 127; src = 1024 * bj + 128 * pn + i; }
    return src;
}
__device__ __forceinline__ P0D p0_mk(const float* W, int N, int K, bf16* W16, unsigned char* W8, int kb, int nb, int mapmode, int lane, const float* rsc = nullptr) {
    P0D d; d.N = N; d.K = K; d.kb = kb; d.nb = nb; d.W16 = W16; d.W8 = W8;
    if (W8) {
        d.rsc = rsc ? rsc + 128 * kb + (lane >> 3) : nullptr;
        d.gp = W + (size_t)(128 * kb + (lane >> 3)) * N + p0_src_col(32 * nb + 4 * (lane & 7), mapmode);
    } else {
        d.rsc = nullptr;
        d.gp = W + (size_t)(64 * kb + (lane >> 4)) * N + p0_src_col(64 * nb + 4 * (lane & 15), mapmode);
    }
    return d;
}
__device__ __forceinline__ void p0_load(const P0D& d, f32x4 (&v)[16]) {
#pragma unroll
    for (int i = 0; i < 16; ++i) v[i] = __builtin_nontemporal_load((const f32x4*)(d.gp + (size_t)((d.W8 ? 8 : 4) * i) * d.N));
}
__device__ __forceinline__ void p0_finish(const P0D& d, const f32x4 (&v)[16], LAS unsigned char* scr, int lane, const int pm = 0) {
    if (pm == 1) { _Pragma("unroll") for (int i = 0; i < 16; ++i) asm volatile("" :: "v"(v[i])); return; }
    if (d.W16) {
#pragma unroll
        for (int i = 0; i < 16; ++i) { LAS unsigned* q = (LAS unsigned*)(scr + (4 * i + (lane >> 4)) * 132 + 8 * (lane & 15)); q[0] = cvtpk(v[i][0], v[i][1]); q[1] = cvtpk(v[i][2], v[i][3]); }
        LDS_WAIT(); asm volatile("" ::: "memory");
        const int c = lane & 7;
#pragma unroll
        for (int it = 0; it < 4; ++it) {
            const int nl = 16 * it + 2 * (lane >> 3);
            unsigned x[8];
#pragma unroll
            for (int j = 0; j < 8; ++j) x[j] = *(const LAS unsigned*)(scr + (8 * c + j) * 132 + 2 * nl);
            v4u o0, o1;
            o0.x = (x[0] & 0xffffu) | (x[1] << 16); o0.y = (x[2] & 0xffffu) | (x[3] << 16); o0.z = (x[4] & 0xffffu) | (x[5] << 16); o0.w = (x[6] & 0xffffu) | (x[7] << 16);
            o1.x = (x[0] >> 16) | (x[1] & 0xffff0000u); o1.y = (x[2] >> 16) | (x[3] & 0xffff0000u); o1.z = (x[4] >> 16) | (x[5] & 0xffff0000u); o1.w = (x[6] >> 16) | (x[7] & 0xffff0000u);
            bf16* dst = d.W16 + (size_t)(64 * d.nb + nl) * d.K + 64 * d.kb + 8 * c;
            if (pm == 0 || pm == 3) { *(v4u*)dst = o0; *(v4u*)(dst + d.K) = o1; } else asm volatile("" :: "v"(o0), "v"(o1));
        }
    } else {
#pragma unroll
        for (int i = 0; i < 16; ++i) { const float sc = d.rsc ? d.rsc[8 * i] * 64.0f : 64.0f; *(LAS unsigned*)(scr + (8 * i + (lane >> 3)) * 36 + 4 * (lane & 7)) = pk4_fp8(v[i][0] * sc, v[i][1] * sc, v[i][2] * sc, v[i][3] * sc); }
        LDS_WAIT(); asm volatile("" ::: "memory");
        const int nq = lane & 7, kg = lane >> 3;
        unsigned x[16];
#pragma unroll
        for (int j = 0; j < 16; ++j) x[j] = *(const LAS unsigned*)(scr + (16 * kg + j) * 36 + 4 * nq);
#pragma unroll
        for (int t = 0; t < 4; ++t) {
            v4u o;
#pragma unroll
            for (int q = 0; q < 4; ++q) { const unsigned lo = __builtin_amdgcn_perm(x[4 * q + 1], x[4 * q], 0x0c0c0000u | ((4u + t) << 8) | (unsigned)t), hi = __builtin_amdgcn_perm(x[4 * q + 3], x[4 * q + 2], 0x0c0c0000u | ((4u + t) << 8) | (unsigned)t); o[q] = lo | (hi << 16); }
            if (pm == 0 || pm == 3) __builtin_nontemporal_store(o, (v4u*)(d.W8 + (size_t)(32 * d.nb + 4 * nq + t) * d.K + 128 * d.kb + 16 * kg)); else asm volatile("" :: "v"(o));
        }
    }
    LDS_WAIT(); asm volatile("" ::: "memory");
}
constexpr int P0_I_IN = 16 * 56, P0_I_OUT = 256, P0_I_PG = 256, P0_I_PP = 4 * 16, P0_I_UG = 16 * 32, P0_I_DN = 256, P0_I_SMALL = P0_I_IN + P0_I_OUT + P0_I_PG + P0_I_PP;
__device__ __forceinline__ P0D p0_decode(const Args& a, unsigned char* ws, int it, int lane, bool small, int e0, int ne) {
    int r = it;
    if (small) {
        if (r < P0_I_IN) return p0_mk(a.w_in, DIN, DM, (bf16*)(ws + WS_WT_IN), nullptr, r / 56, r % 56, MAP_IN, lane); r -= P0_I_IN;
        if (r < P0_I_OUT) return p0_mk(a.w_out, DM, DM, (bf16*)(ws + WS_WT_OUT), nullptr, r / 16, r % 16, MAP_NAT, lane); r -= P0_I_OUT;
        if (r < P0_I_PG) return p0_mk(a.w_pg, DM, DM, nullptr, (unsigned char*)(ws + WS_WT_PG), r / 32, r % 32, MAP_NAT, lane); r -= P0_I_PG;
        if (r < P0_I_PP) return p0_mk(a.w_pp, DM, PLE, (bf16*)(ws + WS_WT_PP), nullptr, r / 16, r % 16, MAP_NAT, lane); r -= P0_I_PP;
    }
    if (r < ne * P0_I_UG) { const int e = e0 + r / P0_I_UG, q = r % P0_I_UG; return p0_mk(a.w_ug + (size_t)e * DM * 2048, 2048, DM, nullptr, (unsigned char*)(ws + WS_WT_UG) + (size_t)e * 2048 * DM, q / 64, q % 64, MAP_UG, lane, a.g_ffn); } r -= ne * P0_I_UG;
    { const int e = e0 + r / P0_I_DN, q = r % P0_I_DN; return p0_mk(a.w_dn + (size_t)e * DM * DM, DM, DM, nullptr, (unsigned char*)(ws + WS_WT_DN) + (size_t)e * DM * DM, q / 32, q % 32, MAP_NAT, lane); }
}
__device__ __forceinline__ void p0_items(const Args& a, unsigned char* ws, LAS unsigned char* scr, int lane, int gw, int NGW, bool small, int e0, int ne, const int pm) {
    const int NITEMS = (small ? P0_I_SMALL : 0) + ne * (P0_I_UG + P0_I_DN);
    if (gw < NITEMS) {
        int it = gw; P0D d0 = p0_decode(a, ws, it, lane, small, e0, ne), d1 = d0; f32x4 va[16], vb[16]; p0_load(d0, va);
        for (;;) {
            const int it1 = it + NGW; const bool h1 = it1 < NITEMS;
            if (h1) { d1 = p0_decode(a, ws, it1, lane, small, e0, ne); p0_load(d1, vb); }
            p0_finish(d0, va, scr, lane, pm);
            if (!h1) break;
            const int it2 = it1 + NGW; const bool h2 = it2 < NITEMS;
            if (h2) { d0 = p0_decode(a, ws, it2, lane, small, e0, ne); p0_load(d0, va); }
            p0_finish(d1, vb, scr, lane, pm);
            if (!h2) break;
            it = it2;
        }
    }
}
__device__ __forceinline__ void p0_items_from(const Args& a, unsigned char* ws, LAS unsigned char* scr, int lane, int first, int step, int ne) { p0_items(a, ws, scr, lane, first, step, false, 0, ne, 0); }
__device__ __forceinline__ void rms_row_to_bf16(const float* xrow, const float* g, bf16* orow, int lane) {
    const f32x4* xr = (const f32x4*)xrow + lane;
    f32x4 v[4]; float s = 0.f;
#pragma unroll
    for (int j = 0; j < 4; ++j) { v[j] = xr[64 * j]; s += (v[j][0] * v[j][0] + v[j][1] * v[j][1]) + (v[j][2] * v[j][2] + v[j][3] * v[j][3]); }
    const float rstd = rsqrtf(wave_sum(s) * (1.f / DM) + EPS);
    unsigned long long* o8 = (unsigned long long*)orow + lane;
#pragma unroll
    for (int j = 0; j < 4; ++j) { const f32x4 gg = ((const f32x4*)g)[lane + 64 * j];
        o8[64 * j] = (unsigned long long)cvtpk(v[j][0] * rstd * gg[0], v[j][1] * rstd * gg[1]) | ((unsigned long long)cvtpk(v[j][2] * rstd * gg[2], v[j][3] * rstd * gg[3]) << 32); }
}
__device__ __forceinline__ void p0_prologue(Frame& F, const Args& a, const int pm = 0) {
    unsigned char* ws = a.ws; const int tid = tid_now(F.wave), lane = tid & 63;
    LAS unsigned char* scr = F.lds + RING_OFF + F.wave * 8448;
    const int gw = F.vcu * NWAVES + F.wave, NGW = F.G * NWAVES;
    { const int e0 = (F.G == 256) ? P0_E_P2 : 0; p0_items(a, ws, scr, lane, gw, NGW, true, e0, NE - e0, pm); }
    if (pm != 0) return;
    { v4u* tz = (v4u*)(ws + WS_TOKLIST); const v4u z4 = {0u, 0u, 0u, 0u}; for (int i = gw * 64 + lane; i < NE * T / 4; i += NGW * 64) tz[i] = z4; }
    if (blockIdx.x == 0 && tid < 256) { const int t = tid; const float* srcs = (t < 64) ? a.sbq : (t < 128) ? a.sbk : (t < 192) ? a.rq : a.rk; ((float*)(ws + WS_GAINS))[t] = srcs[t & 63]; }
    {
        f32x4 gg[4];
#pragma unroll
        for (int j = 0; j < 4; ++j) gg[j] = ((const f32x4*)a.g_mix)[lane + 64 * j];
        for (int m0 = 4 * gw; m0 < T; m0 += 4 * NGW) {
            f32x4 v[4][4];
#pragma unroll
            for (int r = 0; r < 4; ++r)
#pragma unroll
                for (int j = 0; j < 4; ++j) v[r][j] = __builtin_nontemporal_load((const f32x4*)(a.x + (size_t)(m0 + r) * DM) + lane + 64 * j);
#pragma unroll
            for (int r = 0; r < 4; ++r) {
                float ss = 0.f;
#pragma unroll
                for (int j = 0; j < 4; ++j) ss += (v[r][j][0] * v[r][j][0] + v[r][j][1] * v[r][j][1]) + (v[r][j][2] * v[r][j][2] + v[r][j][3] * v[r][j][3]);
                const float rstd = rsqrtf(wave_sum(ss) * (1.f / DM) + EPS);
                unsigned long long* o8 = (unsigned long long*)((bf16*)(ws + WS_XN) + (size_t)(m0 + r) * DM) + lane;
#pragma unroll
                for (int j = 0; j < 4; ++j) o8[64 * j] = (unsigned long long)cvtpk(v[r][j][0] * rstd * gg[j][0], v[r][j][1] * rstd * gg[j][1]) | ((unsigned long long)cvtpk(v[r][j][2] * rstd * gg[j][2], v[r][j][3] * rstd * gg[j][3]) << 32);
            }
        }
    }
    { const int gt = gw * 64 + lane, NGT = NGW * 64;
      for (int i0 = gt; i0 < T * PLE / 8; i0 += 4 * NGT) {
          f32x4 a0[4], a1[4];
#pragma unroll
          for (int q = 0; q < 4; ++q) { const int i = i0 + q * NGT; if (i < T * PLE / 8) { a0[q] = __builtin_nontemporal_load((const f32x4*)a.p + 2 * i); a1[q] = __builtin_nontemporal_load((const f32x4*)a.p + 2 * i + 1); } }
#pragma unroll
          for (int q = 0; q < 4; ++q) { const int i = i0 + q * NGT; if (i < T * PLE / 8) { v4u o; o.x = cvtpk(a0[q][0], a0[q][1]); o.y = cvtpk(a0[q][2], a0[q][3]); o.z = cvtpk(a1[q][0], a1[q][1]); o.w = cvtpk(a1[q][2], a1[q][3]); ((v4u*)(ws + WS_PB))[i] = o; } }
      }
      for (int i = gt; i < NE * DM; i += NGT) { const int e = i >> 10, k = i & (DM - 1); const float wv = a.w_r[(size_t)k * NE + e] * a.g_ffn[k];
          const unsigned hi = cvtpk(wv, 0.f) & 0xffffu; const unsigned lo = cvtpk(wv - __uint_as_float(hi << 16), 0.f) & 0xffffu;
          ((bf16*)(ws + WS_WRT))[i] = (bf16)hi; ((bf16*)(ws + WS_WRT))[NE * DM + i] = (bf16)lo; }
      float* rc = (float*)(ws + WS_ROPEC); float* rs = (float*)(ws + WS_ROPES);
      for (int i = gt; i < T * 32; i += NGT) { const int row = i >> 5, f = i & 31;
          const float inv_freq = exp2f(-(float)f * (13.287712379549449f / 32.0f));   const float ang = (float)a.positions[row] * inv_freq;
          float sn, cs; sincosf(ang, &sn, &cs); rc[i] = cs; rs[i] = sn; } }
}

namespace att {
typedef short bf16x8 __attribute__((ext_vector_type(8)));
typedef short s16x4 __attribute__((ext_vector_type(4)));
typedef float f32x16 __attribute__((ext_vector_type(16)));
typedef short v4i16_t __attribute__((ext_vector_type(4)));
constexpr int LK = 0, LV = 24576, LFLAG = 49152;
__device__ __forceinline__ s16x4 vtr(LAS const unsigned char* p) { return __builtin_bit_cast(s16x4, __builtin_amdgcn_ds_read_tr16_b64_v4i16((LAS v4i16_t*)p)); }
__device__ __forceinline__ int crow(int r, int hi) { return (r & 3) + 8 * (r >> 2) + 4 * hi; }
struct AttnArgs { const bf16* hm; const bf16* rg; bf16* Y; const float* gn_g; const float* gn_b; };
struct ConvStream { const Args* a; unsigned char* ws; LAS unsigned char* scr; int it, step, nitems, ne, gap; };

template <int MODE, int ABL = 0> __device__ __forceinline__ void attn_unit(LAS unsigned char* lds, const AttnArgs& A, int b, int h, int qb, const int wave_id, ConvStream& cs) {
    int tid_ = wave_id * 64 + lane_id_hw(); asm volatile("" : "+v"(tid_));
    const int tid = tid_, lane = tid & 63, r32 = lane & 31, hh = lane >> 5;
    const int w = __builtin_amdgcn_readfirstlane(tid >> 6);
    const int q0 = qb * 256, qw = q0 + 32 * w;
    const size_t TS = (size_t)T * 512;
    const size_t hoff = (size_t)(b * 8 + h) * SEQ * 64;
    const bf16* Qp = A.hm + (MODE == 0 ? 0 : 3) * TS + hoff;
    const bf16* Kp = A.hm + (MODE == 0 ? 1 : 4) * TS + hoff;
    const bf16* Vp = A.hm + (MODE == 0 ? 2 : 5) * TS + hoff;
    bf16x8 qf[4];
#pragma unroll
    for (int ds = 0; ds < 4; ++ds) qf[ds] = *(const bf16x8*)(Qp + (size_t)(qw + r32) * 64 + 16 * ds + 8 * hh);
    f32x16 o[2];
#pragma unroll
    for (int r = 0; r < 16; ++r) { o[0][r] = 0.f; o[1][r] = 0.f; }
    float carry = 1.0f;
    const int jmax = (q0 + 255) >> 6, jd = (qw + 31) >> 6;
    const float lg2g = __log2f(1.0f - __builtin_amdgcn_exp2f(-5.0f - (float)h));
    const int krow = 8 * w + (lane >> 3);
    const bf16* Kt = Kp + (size_t)krow * 64 + (((lane & 7) ^ ((krow >> 1) & 7)) << 3); const bf16* Vt = Vp + (size_t)w * 512 + lane * 8;
    volatile LAS unsigned* flags = (volatile LAS unsigned*)(lds + LFLAG);
#define ATT_DMA(t, so) do { __builtin_amdgcn_global_load_lds((const unsigned*)(Kt + (size_t)(t) * 4096), (LAS unsigned*)(lds + LK + (so) + w * 1024), 16, 0, 0); \
                            __builtin_amdgcn_global_load_lds((const unsigned*)(Vt + (size_t)(t) * 4096), (LAS unsigned*)(lds + LV + (so) + w * 1024), 16, 0, 0); } while (0)
    ATT_DMA(jmax, 0);
    if (jmax >= 1) { ATT_DMA(jmax - 1, 8192); asm volatile("s_waitcnt vmcnt(2)\n\ts_barrier" ::: "memory"); }
    else asm volatile("s_waitcnt vmcnt(0)\n\ts_barrier" ::: "memory");
    bool finished = false;
    int so_cur = 0, so_new = 16384;
    P0D cd = P0D{}; f32x4 cv[16]; bool chave = false; int cgap = 0;
    for (int j = jmax; j >= 0; --j) {
        const int cur = j & 1;
        bool cnew = false;
        if (MODE == 1 && ABL == 0) {
            if (chave) { p0_finish(cd, cv, cs.scr, lane, 0); chave = false; }
            if (cs.it < cs.nitems && cgap == 0) { cd = p0_decode(*cs.a, cs.ws, cs.it, lane, false, 0, cs.ne); p0_load(cd, cv); cs.it += cs.step; chave = true; cnew = true; cgap = cs.gap; }
            else if (cgap > 0) --cgap;
        }
        if (j >= 2 && ABL != 4) ATT_DMA(j - 2, so_new);
        if (j <= jd && !finished && ABL == 0) {
            LAS const unsigned char* Kb = lds + LK + so_cur;
            LAS const unsigned char* Vb = lds + LV + so_cur;
            f32x16 p[2];
#pragma unroll
            for (int r = 0; r < 16; ++r) { p[0][r] = 0.f; p[1][r] = 0.f; }
            bf16x8 kf[4][2];
            const int ksw = (r32 >> 1) & 7;
#pragma unroll
            for (int ds = 0; ds < 4; ++ds) { kf[ds][0] = *(LAS const bf16x8*)(Kb + r32 * 128 + (((2 * ds + hh) ^ ksw) << 4)); kf[ds][1] = *(LAS const bf16x8*)(Kb + 4096 + r32 * 128 + (((2 * ds + hh) ^ ksw) << 4)); }
#pragma unroll
            for (int ds = 0; ds < 4; ++ds) {
                p[0] = __builtin_amdgcn_mfma_f32_32x32x16_bf16(kf[ds][0], qf[ds], p[0], 0, 0, 0);
                p[1] = __builtin_amdgcn_mfma_f32_32x32x16_bf16(kf[ds][1], qf[ds], p[1], 0, 0, 0);
            }
            const bool diag = (j == jd);
            const int qg = qw + r32, kv0 = 64 * j + 4 * hh;
            if (MODE == 0) {
                float om[2][16];
#pragma unroll
                for (int hf = 0; hf < 2; ++hf)
#pragma unroll
                    for (int r = 0; r < 16; ++r) {
                        const float a = __builtin_amdgcn_exp2f(__builtin_fminf(-p[hf][r], 120.0f));
                        const float rc = __builtin_amdgcn_rcpf(1.0f + a);
                        p[hf][r] = rc;
                        om[hf][r] = a * rc;
                    }
                if (diag) {
#pragma unroll
                    for (int hf = 0; hf < 2; ++hf)
#pragma unroll
                        for (int r = 0; r < 16; ++r) { const bool valid = kv0 + 32 * hf + (r & 3) + 8 * (r >> 2) < qg; p[hf][r] = valid ? p[hf][r] : 0.f; om[hf][r] = valid ? om[hf][r] : 1.0f; }
                }
                float gs[8], ot[8];
#pragma unroll
                for (int m = 0; m < 8; ++m) { const int hf = m >> 2, g = m & 3; gs[m] = (om[hf][4 * g] * om[hf][4 * g + 1]) * (om[hf][4 * g + 2] * om[hf][4 * g + 3]); ot[m] = __shfl_xor(gs[m], 32); }
                float ps[8];
                ps[7] = 1.0f;
#pragma unroll
                for (int m = 6; m >= 0; --m) ps[m] = ps[m + 1] * (gs[m + 1] * ot[m + 1]);
                const float total = ps[0] * (gs[0] * ot[0]);
#pragma unroll
                for (int m = 0; m < 8; ++m) {
                    const int hf = m >> 2, g = m & 3;
                    float tail = carry * (hh ? ps[m] : ps[m] * ot[m]);
#pragma unroll
                    for (int i = 3; i >= 0; --i) { const int r = 4 * g + i; const float o1 = om[hf][r]; p[hf][r] *= tail; tail *= o1; }
                }
                carry *= total;
                finished = __all(carry < 1.0e-37f);
            } else {
                const float ct = __builtin_amdgcn_exp2f(lg2g * (float)(qw - 64 * j));
#pragma unroll
                for (int hf = 0; hf < 2; ++hf)
#pragma unroll
                    for (int r = 0; r < 16; ++r) p[hf][r] *= ct;
                if (diag) {
#pragma unroll
                    for (int hf = 0; hf < 2; ++hf)
#pragma unroll
                        for (int r = 0; r < 16; ++r) { const bool valid = kv0 + 32 * hf + (r & 3) + 8 * (r >> 2) <= qg; p[hf][r] = valid ? p[hf][r] : 0.f; }
                }
            }
            {
                const unsigned vbase = (unsigned)(uintptr_t)(Vb + (4 * hh + ((lane & 15) >> 2)) * 128 + (16 * ((lane >> 4) & 1) + 4 * (lane & 3)) * 2);
                s16x4 vl[2][2][2], vh[2][2][2];
#pragma unroll
                for (int hf = 0; hf < 2; ++hf)
#pragma unroll
                    for (int s = 0; s < 2; ++s)
#pragma unroll
                        for (int d0 = 0; d0 < 2; ++d0) {
                            asm volatile("ds_read_b64_tr_b16 %0, %1 offset:%c2" : "=&v"(vl[hf][s][d0]) : "v"(vbase), "i"(hf * 4096 + s * 2048 + d0 * 64) : "memory");
                            asm volatile("ds_read_b64_tr_b16 %0, %1 offset:%c2" : "=&v"(vh[hf][s][d0]) : "v"(vbase), "i"(hf * 4096 + s * 2048 + d0 * 64 + 1024) : "memory");
                        }
                bf16x8 wfr[2][2];
#pragma unroll
                for (int hf = 0; hf < 2; ++hf)
#pragma unroll
                    for (int s = 0; s < 2; ++s) {
                        u32x4_t wq;
                        wq.x = pg8::cvt_pk_bf16(p[hf][8 * s + 0], p[hf][8 * s + 1]); wq.y = pg8::cvt_pk_bf16(p[hf][8 * s + 2], p[hf][8 * s + 3]);
                        wq.z = pg8::cvt_pk_bf16(p[hf][8 * s + 4], p[hf][8 * s + 5]); wq.w = pg8::cvt_pk_bf16(p[hf][8 * s + 6], p[hf][8 * s + 7]);
                        wfr[hf][s] = __builtin_bit_cast(bf16x8, wq);
                    }
                asm volatile("s_waitcnt lgkmcnt(0)" ::: "memory"); __builtin_amdgcn_sched_barrier(0);
#pragma unroll
                for (int hf = 0; hf < 2; ++hf)
#pragma unroll
                    for (int s = 0; s < 2; ++s)
#pragma unroll
                        for (int d0 = 0; d0 < 2; ++d0) {
                            const s16x4 lo = vl[hf][s][d0], hi = vh[hf][s][d0];
                            const bf16x8 vf = (bf16x8){lo[0], lo[1], lo[2], lo[3], hi[0], hi[1], hi[2], hi[3]};
                            o[d0] = __builtin_amdgcn_mfma_f32_32x32x16_bf16(vf, wfr[hf][s], o[d0], 0, 0, 0);
                        }
            }
        }
        if (MODE == 0) { if (lane == 0) flags[cur * 8 + w] = finished ? 1u : 0u; }
        if (cnew) { if (j >= 2) asm volatile("s_waitcnt vmcnt(18) lgkmcnt(0)\n\ts_barrier" ::: "memory"); else asm volatile("s_waitcnt vmcnt(16) lgkmcnt(0)\n\ts_barrier" ::: "memory"); }
        else { if (j >= 2) asm volatile("s_waitcnt vmcnt(2) lgkmcnt(0)\n\ts_barrier" ::: "memory"); else asm volatile("s_waitcnt vmcnt(0) lgkmcnt(0)\n\ts_barrier" ::: "memory"); }
        so_cur = (so_cur == 16384) ? 0 : so_cur + 8192; so_new = (so_new == 16384) ? 0 : so_new + 8192;
        if (MODE == 0) {
            unsigned all = 1u;
#pragma unroll
            for (int i = 0; i < 8; ++i) all &= flags[cur * 8 + i];
            if (all) break;
        }
    }
    if (MODE == 1 && ABL == 0) { if (chave) p0_finish(cd, cv, cs.scr, lane, 0); }
    asm volatile("s_waitcnt vmcnt(0)\n\ts_barrier" ::: "memory");
#undef ATT_DMA
    const int row = b * SEQ + qw + r32;
    if (MODE == 0) {
        bf16* yp = A.Y + (size_t)row * DM + h * 64 + 4 * hh;
#pragma unroll
        for (int d0 = 0; d0 < 2; ++d0)
#pragma unroll
            for (int g = 0; g < 4; ++g) { u32x2_t v; v.x = pg8::cvt_pk_bf16(o[d0][4 * g], o[d0][4 * g + 1]); v.y = pg8::cvt_pk_bf16(o[d0][4 * g + 2], o[d0][4 * g + 3]); *(u32x2_t*)(yp + 32 * d0 + 8 * g) = v; }
    } else {
        float s1 = 0.f;
#pragma unroll
        for (int r = 0; r < 16; ++r) s1 += o[0][r] + o[1][r];
        s1 += __shfl_xor(s1, 32);
        const float mu = s1 * (1.0f / 64.0f);
        float s2 = 0.f;
#pragma unroll
        for (int r = 0; r < 16; ++r) { const float a0 = o[0][r] - mu, a1 = o[1][r] - mu; s2 += a0 * a0 + a1 * a1; }
        s2 += __shfl_xor(s2, 32);
        const float rstd = rsqrtf(s2 * (1.0f / 64.0f) + EPS);
        bf16* yp = A.Y + (size_t)row * DM + 512 + h * 64 + 4 * hh;
        const bf16* gp = A.rg + (size_t)row * 512 + h * 64 + 4 * hh;
        const float* gg = A.gn_g + h * 64 + 4 * hh; const float* gb = A.gn_b + h * 64 + 4 * hh;
#pragma unroll
        for (int d0 = 0; d0 < 2; ++d0)
#pragma unroll
            for (int g = 0; g < 4; ++g) {
                const f32x4 gn = *(const f32x4*)(gg + 32 * d0 + 8 * g), bs = *(const f32x4*)(gb + 32 * d0 + 8 * g);
                const u32x2_t gr = *(const u32x2_t*)(gp + 32 * d0 + 8 * g);
                float gate[4] = {__uint_as_float(gr.x << 16), __uint_as_float(gr.x & 0xffff0000u), __uint_as_float(gr.y << 16), __uint_as_float(gr.y & 0xffff0000u)};
                float ov[4];
#pragma unroll
                for (int i = 0; i < 4; ++i) { const float yn = (o[d0][4 * g + i] - mu) * rstd * gn[i] + bs[i]; const float sg = gate[i] / (1.0f + __expf(-gate[i])); ov[i] = yn * sg; }
                u32x2_t v; v.x = pg8::cvt_pk_bf16(ov[0], ov[1]); v.y = pg8::cvt_pk_bf16(ov[2], ov[3]); *(u32x2_t*)(yp + 32 * d0 + 8 * g) = v;
            }
    }
}
__device__ __forceinline__ void attn_phase(LAS unsigned char* lds, const AttnArgs& A, int vcu, int dup, bf16* dummyY, const int wave_id, const Args& args, int G) {
    const int g = vcu >> 5, local = vcu & 31;
    ConvStream cs; cs.a = &args; cs.ws = args.ws; cs.scr = lds + 57344 + wave_id * 4608; cs.it = vcu * 8 + wave_id; cs.step = G * 8; cs.ne = P0_E_P2; cs.nitems = P0_E_P2 * (P0_I_UG + P0_I_DN); cs.gap = 2;
#pragma unroll 1
    for (int u = 0; u < 2; ++u) { const int bh = 8 * g + 4 * (u & 1) + (local >> 3), qb = (u & 1) ? 7 - (local & 7) : (local & 7); attn_unit<1>(lds, A, bh >> 3, bh & 7, qb, wave_id, cs); }
#pragma unroll 1
    for (int u = 0; u < 2; ++u) { const int bh = 8 * g + 4 * (u & 1) + (local >> 3), qb = (u & 1) ? 7 - (local & 7) : (local & 7); attn_unit<0>(lds, A, bh >> 3, bh & 7, qb, wave_id, cs); }
    { const int lane = lane_id_hw(); if (cs.it < cs.nitems) p0_items_from(args, args.ws, cs.scr, lane, cs.it, cs.step, cs.ne); }
}
}

constexpr int CW_GCNT = 32768;
constexpr int LR_LCNT = LDSCTL_OFF + 1024, LR_GBASE = LDSCTL_OFF + 1152;
constexpr int LT_POFF = LDSCTL_OFF + 2048, LT_NT = LDSCTL_OFF + 2176, LT_TILE_E = LDSCTL_OFF + 2304, LT_FIRST = LDSCTL_OFF + 3712;
struct RouteBufs { int* tok_e; int* tok_slot; float* tok_gate; float* rstd; int* toklist; };
__device__ __forceinline__ RouteBufs route_bufs(unsigned char* ws) { RouteBufs r; r.tok_e = (int*)(ws + WS_ROUTE); r.tok_slot = r.tok_e + T * 4; r.tok_gate = (float*)(r.tok_slot + T * 4); r.rstd = (float*)(ws + WS_ROUTE + 1 * MiB); r.toklist = (int*)(ws + WS_TOKLIST); return r; }
typedef float f32x2v __attribute__((ext_vector_type(2)));
__device__ __forceinline__ unsigned opq_mask(bool c) { unsigned m = c ? 0xffffffffu : 0u; asm volatile("" : "+v"(m)); return m; }
__device__ __forceinline__ float blendf(unsigned m, float a, float b) { return __uint_as_float((__float_as_uint(a) & m) | (__float_as_uint(b) & ~m)); }
__device__ __forceinline__ int blendi(unsigned m, int a, int b) { return (int)(((unsigned)a & m) | ((unsigned)b & ~m)); }

#define SW2(c, a, b) { const float ta_ = (c) ? (b) : (a), tb_ = (c) ? (a) : (b); a = ta_; b = tb_; }
#define SW2I(c, a, b) { const int ta_ = (c) ? (b) : (a), tb_ = (c) ? (a) : (b); a = ta_; b = tb_; }
#define TOP4_INSERT(x, e) { const float x_ = (x); const int e_ = (e); const bool c3_ = (x_ > v3) || (x_ == v3 && e_ < i3); v3 = c3_ ? x_ : v3; i3 = c3_ ? e_ : i3; \
    const bool c2_ = (v3 > v2) || (v3 == v2 && i3 < i2); SW2(c2_, v2, v3) SW2I(c2_, i2, i3) const bool c1_ = (v2 > v1) || (v2 == v1 && i2 < i1); SW2(c1_, v1, v2) SW2I(c1_, i1, i2) \
    const bool c0_ = (v1 > v0) || (v1 == v0 && i1 < i0); SW2(c0_, v0, v1) SW2I(c0_, i0, i1) }
__device__ __forceinline__ void router_phase(Frame& F, const Args& a, const bool dry = false) {
    unsigned char* ws = a.ws; const int tid = tid_now(F.wave);
    LAS unsigned char* lds = F.lds;
    const int lane = tid & 63, r32 = lane & 31, hh = lane >> 5, w = F.wave, rg = w >> 2, kq = w & 3;
    volatile LAS unsigned* lcnt = (volatile LAS unsigned*)(lds + LR_LCNT);
    volatile LAS unsigned* gbase = (volatile LAS unsigned*)(lds + LR_GBASE);
    if (tid < 32) lcnt[tid] = 0u;
    const RouteBufs R = route_bufs(ws);
    const int row = F.vcu * 64 + 32 * rg + r32;
    const bf16* xr = (const bf16*)(ws + WS_X1) + (size_t)row * DM + 256 * kq + 8 * hh;
    const bf16* wt = (const bf16*)(ws + WS_WRT) + (size_t)r32 * DM + 256 * kq + 8 * hh;
    unsigned char* hp = (unsigned char*)(ws + (dry ? WS_H : WS_XN)) + (size_t)row * DM + 256 * kq + 8 * hh;
    att::f32x16 D;
#pragma unroll
    for (int r = 0; r < 16; ++r) D[r] = 0.f;
    float ss = 0.f;
#pragma unroll 8
    for (int ks = 0; ks < 16; ++ks) {
        const u32x4_t xh = *(const u32x4_t*)(xr + 16 * ks);
        const f32x4 v0 = (f32x4){__uint_as_float(xh.x << 16), __uint_as_float(xh.x & 0xffff0000u), __uint_as_float(xh.y << 16), __uint_as_float(xh.y & 0xffff0000u)};
        const f32x4 v1 = (f32x4){__uint_as_float(xh.z << 16), __uint_as_float(xh.z & 0xffff0000u), __uint_as_float(xh.w << 16), __uint_as_float(xh.w & 0xffff0000u)};
        ss += ((v0[0] * v0[0] + v0[1] * v0[1]) + (v0[2] * v0[2] + v0[3] * v0[3])) + ((v1[0] * v1[0] + v1[1] * v1[1]) + (v1[2] * v1[2] + v1[3] * v1[3]));
        u32x2_t h8; h8.x = pk4_fp8(v0[0], v0[1], v0[2], v0[3]); h8.y = pk4_fp8(v1[0], v1[1], v1[2], v1[3]); *(u32x2_t*)(hp + 16 * ks) = h8;
        const att::bf16x8 whi = *(const att::bf16x8*)(wt + 16 * ks), wlo = *(const att::bf16x8*)(wt + 32 * DM + 16 * ks);
        const att::bf16x8 bxh = __builtin_bit_cast(att::bf16x8, xh);
        D = __builtin_amdgcn_mfma_f32_32x32x16_bf16(whi, bxh, D, 0, 0, 0);
        D = __builtin_amdgcn_mfma_f32_32x32x16_bf16(wlo, bxh, D, 0, 0, 0);
    }
    { LAS f32x4* dp = (LAS f32x4*)(lds + (w * 64 + lane) * 64);
#pragma unroll
      for (int q = 0; q < 4; ++q) dp[q] = (f32x4){D[4 * q], D[4 * q + 1], D[4 * q + 2], D[4 * q + 3]};
      *(LAS float*)(lds + 32768 + (w * 64 + lane) * 4) = ss; }
    __syncthreads();
    int my_e0 = 0, my_e1 = 0, rk0 = 0, rk1 = 0; float my_g0 = 0.f, my_g1 = 0.f;
    if (kq == 0) {
#pragma unroll
        for (int o = 1; o < 4; ++o) { LAS const f32x4* dp = (LAS const f32x4*)(lds + ((w + o) * 64 + lane) * 64);
#pragma unroll
            for (int q = 0; q < 4; ++q) { const f32x4 t = dp[q]; D[4 * q] += t[0]; D[4 * q + 1] += t[1]; D[4 * q + 2] += t[2]; D[4 * q + 3] += t[3]; }
            ss += *(LAS const float*)(lds + 32768 + ((w + o) * 64 + lane) * 4); }
        ss += __shfl_xor(ss, 32);
        const float rstd = rsqrtf(ss * (1.f / DM) + EPS);
        if (hh == 0) R.rstd[row] = rstd;
        float l[16];
#pragma unroll
        for (int r = 0; r < 16; ++r) l[r] = D[r] * rstd + a.b_r[(r & 3) + 8 * (r >> 2) + 4 * hh];
        float c[8]; int ci[8];
#pragma unroll
        for (int k = 0; k < 4; ++k) {
            float bv = -INFINITY; int bi = 99;
#pragma unroll
            for (int r = 0; r < 16; ++r) { const int e = (r & 3) + 8 * (r >> 2) + 4 * hh; const bool bt = l[r] > bv; bv = bt ? l[r] : bv; bi = bt ? e : bi; }
            c[k] = bv; ci[k] = bi;
#pragma unroll
            for (int r = 0; r < 16; ++r) { const int e = (r & 3) + 8 * (r >> 2) + 4 * hh; l[r] = (e == bi) ? -INFINITY : l[r]; }
        }
#pragma unroll
        for (int k = 0; k < 4; ++k) { c[4 + k] = __shfl_xor(c[k], 32); ci[4 + k] = __shfl_xor(ci[k], 32); }
        float tv[4]; int ti[4];
#pragma unroll
        for (int k = 0; k < 4; ++k) {
            float bv = -INFINITY; int bi = 99;
#pragma unroll
            for (int j = 0; j < 8; ++j) { const bool bt = (c[j] > bv) || (c[j] == bv && ci[j] < bi); bv = bt ? c[j] : bv; bi = bt ? ci[j] : bi; }
            tv[k] = bv; ti[k] = bi;
#pragma unroll
            for (int j = 0; j < 8; ++j) c[j] = (ci[j] == bi) ? -INFINITY : c[j];
        }
        const float v0 = tv[0], v1 = tv[1], v2 = tv[2], v3 = tv[3]; const int i0 = ti[0], i1 = ti[1], i2 = ti[2], i3 = ti[3];
        const float e1 = __expf(v1 - v0), e2 = __expf(v2 - v0), e3 = __expf(v3 - v0), inv = 1.0f / (1.0f + e1 + e2 + e3);
        my_e0 = hh ? i2 : i0; my_e1 = hh ? i3 : i1; my_g0 = (hh ? e2 : 1.0f) * inv; my_g1 = (hh ? e3 : e1) * inv;
        rk0 = (int)__hip_atomic_fetch_add((LAS unsigned*)(lds + LR_LCNT) + my_e0, 1u, __ATOMIC_RELAXED, __HIP_MEMORY_SCOPE_WORKGROUP);
        rk1 = (int)__hip_atomic_fetch_add((LAS unsigned*)(lds + LR_LCNT) + my_e1, 1u, __ATOMIC_RELAXED, __HIP_MEMORY_SCOPE_WORKGROUP);
    }
    __syncthreads();
    if (tid < 32) gbase[tid] = __hip_atomic_fetch_add((unsigned*)(F.ctl + CW_GCNT + (dry ? 4096 : 0)) + 64 * tid, lcnt[tid], __ATOMIC_RELAXED, __HIP_MEMORY_SCOPE_AGENT);
    __syncthreads();
    if (kq == 0) {
        const int k0 = 2 * hh;
        const int s0 = (int)gbase[my_e0] + rk0, s1 = (int)gbase[my_e1] + rk1;
        R.tok_e[row * 4 + k0] = my_e0; R.tok_slot[row * 4 + k0] = s0; R.tok_gate[row * 4 + k0] = my_g0; R.toklist[(size_t)my_e0 * T + s0] = row;
        R.tok_e[row * 4 + k0 + 1] = my_e1; R.tok_slot[row * 4 + k0 + 1] = s1; R.tok_gate[row * 4 + k0 + 1] = my_g1; R.toklist[(size_t)my_e1 * T + s1] = row;
    }
}
#undef SW2
#undef SW2I
#undef TOP4_INSERT

__device__ __forceinline__ void build_tables(Frame& F) {
    LAS int* poff = (LAS int*)(F.lds + LT_POFF); LAS int* ntp = (LAS int*)(F.lds + LT_NT); LAS int* tile_e = (LAS int*)(F.lds + LT_TILE_E);
    LAS int* cnts = (LAS int*)(F.lds + LR_LCNT); const int tid = tid_now(F.wave);
    if (tid < NE) cnts[tid] = (int)__hip_atomic_load((unsigned*)(F.ctl + CW_GCNT) + 64 * tid, __ATOMIC_RELAXED, __HIP_MEMORY_SCOPE_AGENT);
    __syncthreads();
    if (tid == 0) {
        int t = 0;
        for (int e = 0; e < NE; ++e) { const int c = cnts[e]; const int nt = (c + 255) >> 8; poff[e] = t * 256; ((LAS int*)(F.lds + LT_FIRST))[e] = t; for (int i = 0; i < nt; ++i) tile_e[t + i] = e; t += nt; }
        *ntp = t;
    }
    __syncthreads();
}
constexpr int CRPT = 4;
__device__ __forceinline__ void combine_phase(Frame& F, const Args& a, const bool dry = false) {
    unsigned char* ws = a.ws; const RouteBufs R = route_bufs(ws);
    LAS const int* poff = (LAS const int*)(F.lds + LT_POFF);
    const int gw = F.vcu * NWAVES + F.wave, NGW = F.G * NWAVES, lane = tid_now(F.wave) & 63;
    for (int m0 = CRPT * gw; m0 < T; m0 += CRPT * NGW) {
        f32x4 v[CRPT][2][2]; u32x2_t y[CRPT][4][2]; float gt[CRPT][4];
#pragma unroll
        for (int rr = 0; rr < CRPT; ++rr) { const int m = m0 + rr;
#pragma unroll
            for (int i = 0; i < 2; ++i) { { const v4u xq = __builtin_nontemporal_load((const v4u*)((const bf16*)(ws + WS_X1) + (size_t)m * DM + 8 * lane + 512 * i)); v[rr][i][0] = (f32x4){__uint_as_float(xq[0] << 16), __uint_as_float(xq[0] & 0xffff0000u), __uint_as_float(xq[1] << 16), __uint_as_float(xq[1] & 0xffff0000u)}; v[rr][i][1] = (f32x4){__uint_as_float(xq[2] << 16), __uint_as_float(xq[2] & 0xffff0000u), __uint_as_float(xq[3] << 16), __uint_as_float(xq[3] & 0xffff0000u)}; } }
#pragma unroll
            for (int k = 0; k < 4; ++k) { const int e = R.tok_e[m * 4 + k], slot = R.tok_slot[m * 4 + k]; gt[rr][k] = R.tok_gate[m * 4 + k];
                const unsigned char* yr = (const unsigned char*)(ws + WS_YS) + (size_t)(poff[e] + slot) * DM + 8 * lane;
                y[rr][k][0] = __builtin_nontemporal_load((const u32x2_t*)yr); y[rr][k][1] = __builtin_nontemporal_load((const u32x2_t*)(yr + 512)); } }
#pragma unroll
        for (int rr = 0; rr < CRPT; ++rr) { const int m = m0 + rr;
#pragma unroll
            for (int k = 0; k < 4; ++k)
#pragma unroll
                for (int i = 0; i < 2; ++i) { const u32x2_t yy = y[rr][k][i]; const float g = gt[rr][k];
                    const f32x2v a0 = __builtin_amdgcn_cvt_pk_f32_fp8((int)yy.x, false), a1 = __builtin_amdgcn_cvt_pk_f32_fp8((int)yy.x, true), a2 = __builtin_amdgcn_cvt_pk_f32_fp8((int)yy.y, false), a3 = __builtin_amdgcn_cvt_pk_f32_fp8((int)yy.y, true);
                    v[rr][i][0][0] += g * a0[0]; v[rr][i][0][1] += g * a0[1]; v[rr][i][0][2] += g * a1[0]; v[rr][i][0][3] += g * a1[1];
                    v[rr][i][1][0] += g * a2[0]; v[rr][i][1][1] += g * a2[1]; v[rr][i][1][2] += g * a3[0]; v[rr][i][1][3] += g * a3[1]; }
            float ss = 0.f;
#pragma unroll
            for (int i = 0; i < 2; ++i)
#pragma unroll
                for (int q = 0; q < 2; ++q) { const f32x4 t = v[rr][i][q]; ss += (t[0] * t[0] + t[1] * t[1]) + (t[2] * t[2] + t[3] * t[3]); }
            const float rstd = rsqrtf(wave_sum(ss) * (1.f / DM) + EPS);
            unsigned char* np = (unsigned char*)(ws + (dry ? WS_H : WS_XN)) + (size_t)m * DM + 8 * lane; bf16* ow = (bf16*)(ws + (dry ? WS_XS : WS_Y));
#pragma unroll
            for (int i = 0; i < 2; ++i) { { v4u xb; xb[0] = cvtpk(v[rr][i][0][0], v[rr][i][0][1]); xb[1] = cvtpk(v[rr][i][0][2], v[rr][i][0][3]); xb[2] = cvtpk(v[rr][i][1][0], v[rr][i][1][1]); xb[3] = cvtpk(v[rr][i][1][2], v[rr][i][1][3]); *(v4u*)(ow + (size_t)m * DM + 8 * lane + 512 * i) = xb; }
                const f32x4 g0 = *(const f32x4*)(a.g_ple + 8 * lane + 512 * i), g1 = *(const f32x4*)(a.g_ple + 8 * lane + 512 * i + 4);
                u32x2_t o; o.x = pk4_fp8(v[rr][i][0][0] * rstd * g0[0], v[rr][i][0][1] * rstd * g0[1], v[rr][i][0][2] * rstd * g0[2], v[rr][i][0][3] * rstd * g0[3]);
                o.y = pk4_fp8(v[rr][i][1][0] * rstd * g1[0], v[rr][i][1][1] * rstd * g1[1], v[rr][i][1][2] * rstd * g1[2], v[rr][i][1][3] * rstd * g1[3]);
                *(u32x2_t*)(np + 512 * i) = o; } }
    }
}

__global__ void __launch_bounds__(NWAVES * 64, 2) mega_fwd(Args args) {
    extern __shared__ __attribute__((aligned(16))) unsigned char lds[];
    Frame F;
    F.lds = (LAS unsigned char*)lds;
    F.MISC = (volatile LAS unsigned*)(F.lds + MISC_OFF);
    F.wave = __builtin_amdgcn_readfirstlane(threadIdx.x >> 6);
    F.G = gridDim.x; { const int bx = blockIdx.x; F.vcu = (F.G % 8 == 0) ? (bx % 8) * (F.G / 8) + bx / 8 : bx; }
    unsigned char* ws = args.ws;
    F.ctl = (gu32*)(ws + WS_CTL);
    for (int u = threadIdx.x; u < (LDS_BYTES - LDSCTL_OFF) / 4; u += NWAVES * 64) ((LAS unsigned*)(F.lds + LDSCTL_OFF))[u] = 0u;
    __syncthreads();
    XcdBarrier bar = xcd_barrier_post((unsigned*)(F.ctl + CW_BAR), F.MISC + 8); bar.wave = F.wave;
#ifdef PROBE_LO
    const int lo = args.ph_lo, hi = args.ph_hi & 0xff; const bool PROBE_NULL = (args.ph_hi >> 8) != 0;
#else
    const int lo = args.ph_lo, hi = args.ph_hi; constexpr bool PROBE_NULL = false;
#endif
#define IN(k) (lo <= (k) && (k) < hi)
#define GRID_BAR() xcd_barrier(bar)
#ifndef DUP_PHASE
#define DUP_PHASE -1
#endif
#define REP(k) for (int rep_ = 0; rep_ < ((DUP_PHASE) == (k) ? 2 : 1); ++rep_)

    if (IN(0)) { if (DUP_PHASE == 40) { p0_prologue(F, args, 1); GRID_BAR(); } if (DUP_PHASE == 41) { p0_prologue(F, args, 2); GRID_BAR(); } if (DUP_PHASE == 42) { p0_prologue(F, args, 3); GRID_BAR(); } REP(0) { p0_prologue(F, args); GRID_BAR(); } }

    if (IN(1)) REP(1) {
        pg8::Gemm g{(const pg8::bf16_t*)(ws + WS_XN), (const pg8::bf16_t*)(ws + WS_WT_IN), DM, 0};
        pg8::StaticOrder S; S.init(T / 256, DIN / 256, F.G, (int)blockIdx.x);
        pg8::EpiProj E{(pg8::bf16_t*)(ws + WS_HM), (pg8::bf16_t*)(ws + WS_RG), (const float*)(ws + WS_GAINS), (const float*)(ws + WS_ROPEC), (const float*)(ws + WS_ROPES)};
        pg8::gemm_phase<pg8::EpiProj, pg8::StaticOrder, true, true>(F.lds + RING_OFF, g, S, E, F.wave);
        {
            const int G2 = (F.G == 256) ? 128 : F.G, c2 = (F.G == 256) ? (int)blockIdx.x - 128 : (int)blockIdx.x;
            if (c2 >= 0) {
                pg8::Gemm g2{(const pg8::bf16_t*)(ws + WS_PB), (const pg8::bf16_t*)(ws + WS_WT_PP), PLE, 0};
                pg8::StaticOrder S2; S2.init(T / 256, DM / 256, G2, c2);
                pg8::EpiBf16Plain E2{(pg8::bf16_t*)(ws + WS_PJ), DM};
                pg8::gemm_phase<pg8::EpiBf16Plain, pg8::StaticOrder, true, true>(F.lds + RING_OFF, g2, S2, E2, F.wave);
            }
        }
        GRID_BAR();
    }
    if (DUP_PHASE == 51 && IN(1)) {
        pg8::Gemm g{(const pg8::bf16_t*)(ws + WS_XN), (const pg8::bf16_t*)(ws + WS_WT_IN), DM, 0};
        pg8::StaticOrder S; S.init(T / 256, DIN / 256, F.G, (int)blockIdx.x);
        pg8::EpiNull E;
        pg8::gemm_phase<pg8::EpiNull, pg8::StaticOrder, true, true>(F.lds + RING_OFF, g, S, E, F.wave);
        GRID_BAR();
    }
    if (IN(2)) REP(2) {
        if (F.G == 256) {
            const att::AttnArgs AA{(const bf16*)(ws + WS_HM), (const bf16*)(ws + WS_RG), (bf16*)(ws + WS_Y), args.gn_g, args.gn_b};
            att::attn_phase(F.lds + RING_OFF, AA, F.vcu, DUP_PHASE, (bf16*)(ws + WS_XS), F.wave, args, F.G);
        }
        GRID_BAR();
    }
    if (IN(3)) REP(3) {
        pg8::Gemm g{(const pg8::bf16_t*)(ws + WS_Y), (const pg8::bf16_t*)(ws + WS_WT_OUT), DM, 0};
        pg8::StaticOrder S; S.init(T / 256, DM / 256, F.G, (int)blockIdx.x);
        pg8::EpiResid E{args.x, (pg8::bf16_t*)(ws + WS_X1)};
        pg8::gemm_phase<pg8::EpiResid, pg8::StaticOrder, true, true>(F.lds + RING_OFF, g, S, E, F.wave);
        GRID_BAR();
    }
    if (DUP_PHASE == 30 && IN(3)) { GRID_BAR(); GRID_BAR(); GRID_BAR(); GRID_BAR(); }
    if (IN(4)) { if (DUP_PHASE == 4) { if (F.G == 256) router_phase(F, args, true); GRID_BAR(); } if (F.G == 256) router_phase(F, args); GRID_BAR(); }
    if (IN(5) || (lo >= 6 && lo <= 8)) build_tables(F);
    if (IN(6)) REP(6) {
        const int NT = *(LAS const int*)(F.lds + LT_NT);
        pg8::Gemm g{(const pg8::bf16_t*)(ws + WS_XN), (const pg8::bf16_t*)(ws + WS_WT_UG), DM / 2, (size_t)2048 * DM};
#ifdef PROBE_LO
        g.nostage = ((args.ph_hi >> 8) == 2);
#endif
        pg8::MoeOrder S; S.init(NT, 8, F.G, (int)blockIdx.x, (LAS const int*)(F.lds + LT_TILE_E), F.wave, 1, args.b_ug, route_bufs(ws).rstd, F.lds + PF_OFF);
        S.toklist = route_bufs(ws).toklist; S.first_tile = (LAS const int*)(F.lds + LT_FIRST); S.tokl = F.lds + TOKL_OFF;
        pg8::EpiMoeUp E{PROBE_NULL ? (unsigned char*)nullptr : (unsigned char*)(ws + WS_H), F.lds + PF_OFF};
        pg8::gemm_phase<pg8::EpiMoeUp, pg8::MoeOrder, true, true, true, true>(F.lds + RING_OFF, g, S, E, F.wave);
        GRID_BAR();
    }
    if (IN(7)) REP(7) {
        const int NT = *(LAS const int*)(F.lds + LT_NT);
        pg8::Gemm g{(const pg8::bf16_t*)(ws + WS_H), (const pg8::bf16_t*)(ws + WS_WT_DN), DM / 2, (size_t)DM * DM};
        pg8::MoeOrder S; S.init(NT, 4, F.G, (int)blockIdx.x, (LAS const int*)(F.lds + LT_TILE_E), F.wave, 2, args.b_dn, nullptr, F.lds + PF_OFF);
        pg8::EpiMoeDown E{PROBE_NULL ? (unsigned char*)nullptr : (unsigned char*)(ws + WS_YS), F.lds + PF_OFF};
        pg8::gemm_phase<pg8::EpiMoeDown, pg8::MoeOrder, true, true, true>(F.lds + RING_OFF, g, S, E, F.wave);
        GRID_BAR();
    }
    if (IN(8)) { if (DUP_PHASE == 8) { combine_phase(F, args, true); GRID_BAR(); } combine_phase(F, args); GRID_BAR(); }
    if (IN(9)) {
        pg8::Gemm g{(const pg8::bf16_t*)(ws + WS_XN), (const pg8::bf16_t*)(ws + WS_WT_PG), DM / 2, 0};
        pg8::StaticOrder S; S.init(T / 256, DM / 256, F.G, (int)blockIdx.x);
        if (DUP_PHASE == 9) { pg8::EpiPle E0{(const pg8::bf16_t*)(ws + WS_Y), (const pg8::bf16_t*)(ws + WS_PJ), (float*)(ws + WS_XS)}; pg8::gemm_phase<pg8::EpiPle, pg8::StaticOrder, true, true, true>(F.lds + RING_OFF, g, S, E0, F.wave); }
        pg8::EpiPle E{(const pg8::bf16_t*)(ws + WS_Y), (const pg8::bf16_t*)(ws + WS_PJ), args.out};
        pg8::gemm_phase<pg8::EpiPle, pg8::StaticOrder, true, true, true>(F.lds + RING_OFF, g, S, E, F.wave);
    }
#undef IN
}
extern "C" void kernel_launch(void* const* d_in, const int* in_sizes, int n_in, void* d_out, int out_size, void* d_ws, size_t ws_size, hipStream_t stream) {
    static int grid = 0;
    if (grid == 0) {
        if (n_in != 22 || ws_size < 1024 * MiB) { fprintf(stderr, "kernel_launch: unexpected n_in %d / ws %zu\n", n_in, ws_size); grid = -1; return; }
        int dev = 0, cus = 0, per_cu = 0;
        if (hipGetDevice(&dev) != hipSuccess || hipDeviceGetAttribute(&cus, hipDeviceAttributeMultiprocessorCount, dev) != hipSuccess) { grid = -1; return; }
        if (hipFuncSetAttribute((const void*)mega_fwd, hipFuncAttributeMaxDynamicSharedMemorySize, LDS_BYTES) != hipSuccess) { fprintf(stderr, "kernel_launch: hipFuncSetAttribute failed\n"); grid = -1; return; }
        if (hipOccupancyMaxActiveBlocksPerMultiprocessor(&per_cu, (const void*)mega_fwd, NWAVES * 64, LDS_BYTES) != hipSuccess || per_cu < 1) { fprintf(stderr, "kernel_launch: occupancy query says %d\n", per_cu); per_cu = 1; }
        (void)hipGetLastError();
        grid = cus;
    }
    if (grid < 0) return;
    (void)hipMemsetAsync((char*)d_ws + WS_CTL, 0, CTL_ZERO_BYTES, stream);
    Args a{};
    a.x = (const float*)d_in[0]; a.p = (const float*)d_in[1]; a.positions = (const int*)d_in[2]; a.g_mix = (const float*)d_in[3]; a.w_in = (const float*)d_in[4];
    a.sbq = (const float*)d_in[5]; a.sbk = (const float*)d_in[6]; a.rq = (const float*)d_in[7]; a.rk = (const float*)d_in[8]; a.gn_g = (const float*)d_in[9]; a.gn_b = (const float*)d_in[10];
    a.w_out = (const float*)d_in[11]; a.g_ffn = (const float*)d_in[12]; a.w_r = (const float*)d_in[13]; a.b_r = (const float*)d_in[14]; a.w_ug = (const float*)d_in[15]; a.b_ug = (const float*)d_in[16];
    a.w_dn = (const float*)d_in[17]; a.b_dn = (const float*)d_in[18]; a.g_ple = (const float*)d_in[19]; a.w_pg = (const float*)d_in[20]; a.w_pp = (const float*)d_in[21];
    a.out = (float*)d_out; a.ws = (unsigned char*)d_ws; a.ph_lo = 0; a.ph_hi = 10;
    hipLaunchKernelGGL(mega_fwd, dim3(grid), dim3(NWAVES * 64), LDS_BYTES, stream, a);
#ifdef PROBE_LO
    (void)hipMemsetAsync((char*)d_ws + WS_CTL + CW_BAR * 4, 0, 16384, stream);
    a.ph_lo = PROBE_LO; a.ph_hi = PROBE_HI | (PROBE_FLAG << 8);
    hipLaunchKernelGGL(mega_fwd, dim3(grid), dim3(NWAVES * 64), LDS_BYTES, stream, a);
#endif

}
```

```cpp
#include <hip/hip_runtime.h>
#include <cstdint>
#include <cstdio>
#include <cmath>

__device__ __forceinline__ int lane_id_hw() { return (int)__builtin_amdgcn_mbcnt_hi(~0u, __builtin_amdgcn_mbcnt_lo(~0u, 0u)); }
namespace pg8 {
#define PG8_LAS __attribute__((address_space(3)))
typedef unsigned short bf16_t;
typedef short bf16x8 __attribute__((ext_vector_type(8)));
typedef float f32x4 __attribute__((ext_vector_type(4)));
typedef unsigned u32x4 __attribute__((ext_vector_type(4)));
typedef unsigned u32x2 __attribute__((ext_vector_type(2)));
typedef int v4i32 __attribute__((ext_vector_type(4)));
typedef int v8i32 __attribute__((ext_vector_type(8)));
constexpr int BM = 256, BK = 64, HALF = 128, HTB = HALF * BK * 2  , STAGE_BYTES = 8 * HTB, NXCD = 8, WGM = 8;

__host__ __device__ __forceinline__ int lds_byte(int r, int c) { const int st = (r >> 4) * 2 + (c >> 5), rr = r & 15, cc = c & 31, ob = rr * 64 + cc * 2; return st * 1024 + (ob ^ (((ob >> 9) & 1) << 5)); }
__host__ __device__ __forceinline__ void stage_rc(int b, int& R, int& C) { const int st = b / 1024, sb = b % 1024, swz = sb ^ (((sb >> 9) & 1) << 5); R = (st >> 1) * 16 + swz / 64; C = (st & 1) * 32 + (swz % 64) / 2; }
__host__ __device__ __forceinline__ int perm32(int rho) { const int n = rho >> 4, i = rho & 15; return 8 * (i >> 2) + 4 * n + (i & 3); }

struct Unit { int pm, pn, e, seq; };
#ifdef PROBE_LO
struct Gemm { const bf16_t* A; const bf16_t* Bt; int K; size_t strideBe; int nostage = 0; };
#define PG8_NOSTAGE (g.nostage != 0)
#else
struct Gemm { const bf16_t* A; const bf16_t* Bt; int K; size_t strideBe; };
#define PG8_NOSTAGE false
#endif

struct StaticOrder {
    int nM, nN, nwg, G, c;
    __host__ __device__ void init(int nM_, int nN_, int G_, int c_) { nM = nM_; nN = nN_; nwg = nM * nN; G = G_; c = c_; }
    __host__ __device__ bool next(int i, Unit& u) const {
        const long L = (long)i * G + c; if (L >= nwg) return false;
        int wgid = (int)L; { const int q = nwg / NXCD, r = nwg % NXCD, xcd = wgid % NXCD, off = wgid / NXCD; wgid = (xcd < r ? xcd * (q + 1) : r * (q + 1) + (xcd - r) * q) + off; }
        const int nig = WGM * nN, gid = wgid / nig, fm = gid * WGM, gsz = (nM - fm) < WGM ? (nM - fm) : WGM;
        u.pm = fm + ((wgid % nig) % gsz); u.pn = (wgid % nig) / gsz; u.e = 0; u.seq = i; return true;
    }
    __device__ __forceinline__ void a_ready(const Unit&) const {}
    __device__ __forceinline__ void done(const Unit&) const {}
};

typedef float f32x2_t __attribute__((ext_vector_type(2))); typedef __bf16 bf16x2_t __attribute__((ext_vector_type(2)));
__device__ __forceinline__ unsigned cvt_pk_bf16(float lo, float hi) { f32x2_t v = {lo, hi}; bf16x2_t b = __builtin_convertvector(v, bf16x2_t); return __builtin_bit_cast(unsigned, b); }

constexpr int T = 16384, SEQ = 2048, DM = 1024, DIN = 3584;
constexpr float EPS = 1e-6f;
__device__ __forceinline__ u32x4 pack8(const f32x4 a, const f32x4 b) { u32x4 w; w.x = cvt_pk_bf16(a[0], a[1]); w.y = cvt_pk_bf16(a[2], a[3]); w.z = cvt_pk_bf16(b[0], b[1]); w.w = cvt_pk_bf16(b[2], b[3]); return w; }

struct EpiProj {
    static constexpr bool PERM = true, AFTER_DRAIN = false;
    bf16_t* hm;
    bf16_t* rg;
    const float* gains;
    const float *ropec, *ropes;
    __device__ __forceinline__ void operator()(const f32x4 (&acc)[2][2][4][2], const Unit& u, int wr, int wc, int fr, int fq) const {
        const int region = u.pn >> 1, hb = 4 * (u.pn & 1) + wc;
        const bool normed = (region == 0) || (region == 1) || (region == 3) || (region == 4);
        const bool rope = (region == 3) || (region == 4);
        const int gidx = region == 0 ? 0 : region == 1 ? 1 : region == 3 ? 2 : 3;
        const float* gp = gains + gidx * 64;
        f32x4 gv[2][2];
#pragma unroll
        for (int bj = 0; bj < 2; ++bj)
#pragma unroll
            for (int n = 0; n < 2; ++n) gv[bj][n] = normed ? *(const f32x4*)(gp + 32 * bj + 8 * fq + 4 * n) : (f32x4){1.f, 1.f, 1.f, 1.f};
        const float lg2g = __log2f(1.0f - __builtin_amdgcn_exp2f(-5.0f - (float)hb));
        const float scale = region == 0 ? 0.125f * 1.4426950408889634f : region == 4 ? 0.125f : 1.0f;
#pragma unroll
        for (int ai = 0; ai < 2; ++ai)
#pragma unroll
            for (int m = 0; m < 4; ++m) {
                const int row = u.pm * BM + ai * HALF + wr * 64 + m * 16 + fr;
                const int b = row >> 11, s = row & (SEQ - 1);
                f32x4 v[2][2];
#pragma unroll
                for (int bj = 0; bj < 2; ++bj)
#pragma unroll
                    for (int n = 0; n < 2; ++n) v[bj][n] = acc[ai][bj][m][n];
                if (normed) {
                    float ss = 0.f;
#pragma unroll
                    for (int bj = 0; bj < 2; ++bj)
#pragma unroll
                        for (int n = 0; n < 2; ++n) { const f32x4 x = v[bj][n]; ss += (x[0] * x[0] + x[1] * x[1]) + (x[2] * x[2] + x[3] * x[3]); }
                    ss += __shfl_xor(ss, 16); ss += __shfl_xor(ss, 32);
                    float rs = rsqrtf(ss * (1.0f / 64.0f) + EPS) * scale;
                    if (rope) rs *= (region == 3) ? __builtin_amdgcn_exp2f((float)(s & 31) * lg2g) : __builtin_amdgcn_exp2f(-(float)(s & 63) * lg2g);
#pragma unroll
                    for (int bj = 0; bj < 2; ++bj)
#pragma unroll
                        for (int n = 0; n < 2; ++n) v[bj][n] = v[bj][n] * rs * gv[bj][n];
                    if (rope) {
#pragma unroll
                        for (int n = 0; n < 2; ++n) {
                            const f32x4 c = *(const f32x4*)(ropec + (size_t)row * 32 + 8 * fq + 4 * n), sn = *(const f32x4*)(ropes + (size_t)row * 32 + 8 * fq + 4 * n);
                            const f32x4 lo = v[0][n], hi = v[1][n];
                            v[0][n] = lo * c - hi * sn; v[1][n] = hi * c + lo * sn;
                        }
                    }
                }
                bf16_t* dst = (region < 6) ? hm + (size_t)region * ((size_t)T * 512) + ((size_t)(b * 8 + hb) * SEQ + s) * 64 + 8 * fq
                                           : rg + (size_t)row * 512 + hb * 64 + 8 * fq;
#pragma unroll
                for (int bj = 0; bj < 2; ++bj) *(u32x4*)(dst + 32 * bj) = pack8(v[bj][0], v[bj][1]);
            }
    }
};

constexpr int PF_WAVE_BYTES = 768, PF_BUF_BYTES = 8 * PF_WAVE_BYTES;
struct EpiBf16Plain {
    static constexpr bool PERM = true, AFTER_DRAIN = false;
    bf16_t* O; int ldc;
    __device__ __forceinline__ void operator()(const f32x4 (&acc)[2][2][4][2], const Unit& u, int wr, int wc, int fr, int fq) const {
        const int row0 = u.pm * BM + wr * 64 + fr, col0 = u.pn * BM + wc * 32 + 8 * fq;
#pragma unroll
        for (int ai = 0; ai < 2; ++ai)
#pragma unroll
            for (int m = 0; m < 4; ++m) { bf16_t* rowp = O + (size_t)(row0 + ai * HALF + m * 16) * ldc + col0;
#pragma unroll
                for (int bj = 0; bj < 2; ++bj) *(u32x4*)(rowp + bj * HALF) = pack8(acc[ai][bj][m][0], acc[ai][bj][m][1]); }
    }
};
struct EpiResid {
    static constexpr bool PERM = true, AFTER_DRAIN = false;
    const float* base; bf16_t* X1;
    __device__ __forceinline__ void operator()(const f32x4 (&acc)[2][2][4][2], const Unit& u, int wr, int wc, int fr, int fq) const {
        const int col0 = u.pn * BM + wc * 32 + 8 * fq;
#pragma unroll
        for (int ai = 0; ai < 2; ++ai)
#pragma unroll
            for (int m = 0; m < 4; ++m) { const size_t off = (size_t)(u.pm * BM + ai * HALF + wr * 64 + m * 16 + fr) * DM + col0;
#pragma unroll
                for (int bj = 0; bj < 2; ++bj) { const f32x4 b0 = __builtin_nontemporal_load((const f32x4*)(base + off + bj * HALF)), b1 = __builtin_nontemporal_load((const f32x4*)(base + off + bj * HALF + 4));
                    *(u32x4*)(X1 + off + bj * HALF) = pack8(b0 + acc[ai][bj][m][0], b1 + acc[ai][bj][m][1]); } }
    }
};
struct EpiMoeUp {
    static constexpr bool PERM = true, AFTER_DRAIN = false;
    unsigned char* H; const PG8_LAS unsigned char* pf_lds;
    __device__ __forceinline__ void operator()(const f32x4 (&acc)[2][2][4][2], const Unit& u, int wr, int wc, int fr, int fq) const {
#ifdef PROBE_LO
        if (H == nullptr) return;
#endif
        const int cc = 128 * u.pn + 32 * wc + 8 * fq;
        f32x4 bg[2], bl[2]; float scs[2][4];
        const PG8_LAS unsigned char* buf = pf_lds + (u.seq & 1) * PF_BUF_BYTES + (wr * 4 + wc) * PF_WAVE_BYTES;
#pragma unroll
        for (int n = 0; n < 2; ++n) { bg[n] = *(const PG8_LAS f32x4*)(buf + (8 * fq + 4 * n) * 4); bl[n] = *(const PG8_LAS f32x4*)(buf + 128 + (8 * fq + 4 * n) * 4); }
#pragma unroll
        for (int ai = 0; ai < 2; ++ai)
#pragma unroll
            for (int m = 0; m < 4; ++m) scs[ai][m] = *(const PG8_LAS float*)(buf + 256 + ai * 256 + (m * 16 + fr) * 4);
#pragma unroll
        for (int n = 0; n < 2; ++n) bl[n] = bl[n] + 1.0f;
#pragma unroll
        for (int ai = 0; ai < 2; ++ai)
#pragma unroll
            for (int m = 0; m < 4; ++m) {
                const float sc = scs[ai][m] * 0.015625f;
                f32x4 hv[2];
#pragma unroll
                for (int n = 0; n < 2; ++n) {
                    const f32x4 g0 = acc[ai][0][m][n] * sc + bg[n], l1 = acc[ai][1][m][n] * sc + bl[n];
                    f32x4 glu, lin1;
#pragma unroll
                    for (int j = 0; j < 4; ++j) { glu[j] = __builtin_fminf(g0[j], 7.0f); lin1[j] = __builtin_amdgcn_fmed3f(l1[j], -6.0f, 8.0f); }
                    const f32x4 t = glu * (-1.702f * 1.4426950408889634f);
                    f32x4 e;
#pragma unroll
                    for (int j = 0; j < 4; ++j) e[j] = __builtin_amdgcn_exp2f(t[j]);
                    const f32x4 d = e + 1.0f;
                    f32x4 r;
#pragma unroll
                    for (int j = 0; j < 4; ++j) r[j] = __builtin_amdgcn_rcpf(d[j]);
                    hv[n] = (glu * r) * lin1;
                }
                u32x2 hq; hq.x = (unsigned)__builtin_amdgcn_cvt_pk_fp8_f32(hv[0][0], hv[0][1], 0, false); hq.x = (unsigned)__builtin_amdgcn_cvt_pk_fp8_f32(hv[0][2], hv[0][3], (int)hq.x, true);
                hq.y = (unsigned)__builtin_amdgcn_cvt_pk_fp8_f32(hv[1][0], hv[1][1], 0, false); hq.y = (unsigned)__builtin_amdgcn_cvt_pk_fp8_f32(hv[1][2], hv[1][3], (int)hq.y, true);
                *(u32x2*)(H + (size_t)(u.pm * BM + ai * HALF + wr * 64 + m * 16 + fr) * 1024 + cc) = hq;
            }
    }
};
struct EpiMoeDown {
    static constexpr bool PERM = true, AFTER_DRAIN = false;
    unsigned char* YS; const PG8_LAS unsigned char* pf_lds;
    __device__ __forceinline__ void operator()(const f32x4 (&acc)[2][2][4][2], const Unit& u, int wr, int wc, int fr, int fq) const {
#ifdef PROBE_LO
        if (YS == nullptr) return;
#endif
        const int col0 = u.pn * BM + wc * 32 + 8 * fq;
        const PG8_LAS unsigned char* buf = pf_lds + (u.seq & 1) * PF_BUF_BYTES + (wr * 4 + wc) * PF_WAVE_BYTES;
        f32x4 bv[2][2];
#pragma unroll
        for (int bj = 0; bj < 2; ++bj)
#pragma unroll
            for (int n = 0; n < 2; ++n) bv[bj][n] = *(const PG8_LAS f32x4*)(buf + bj * 128 + (8 * fq + 4 * n) * 4);
#pragma unroll
        for (int ai = 0; ai < 2; ++ai)
#pragma unroll
            for (int m = 0; m < 4; ++m) { unsigned char* rowp = YS + (size_t)(u.pm * BM + ai * HALF + wr * 64 + m * 16 + fr) * 1024 + col0;
#pragma unroll
                for (int bj = 0; bj < 2; ++bj) { const f32x4 y0 = acc[ai][bj][m][0] * 0.015625f + bv[bj][0], y1 = acc[ai][bj][m][1] * 0.015625f + bv[bj][1];
                    u32x2 q; q.x = (unsigned)__builtin_amdgcn_cvt_pk_fp8_f32(y0[0], y0[1], 0, false); q.x = (unsigned)__builtin_amdgcn_cvt_pk_fp8_f32(y0[2], y0[3], (int)q.x, true);
                    q.y = (unsigned)__builtin_amdgcn_cvt_pk_fp8_f32(y1[0], y1[1], 0, false); q.y = (unsigned)__builtin_amdgcn_cvt_pk_fp8_f32(y1[2], y1[3], (int)q.y, true);
                    *(u32x2*)(rowp + bj * HALF) = q; } }
    }
};
struct EpiPle {
    static constexpr bool PERM = true, AFTER_DRAIN = false;
    const bf16_t* X2; const bf16_t* PJ; float* outw;
    __device__ __forceinline__ void operator()(const f32x4 (&acc)[2][2][4][2], const Unit& u, int wr, int wc, int fr, int fq) const {
        const int col0 = u.pn * BM + wc * 32 + 8 * fq;
#pragma unroll
        for (int ai = 0; ai < 2; ++ai)
#pragma unroll
            for (int m = 0; m < 4; ++m) { const size_t off = (size_t)(u.pm * BM + ai * HALF + wr * 64 + m * 16 + fr) * DM + col0;
#pragma unroll
                for (int bj = 0; bj < 2; ++bj) {
                    const size_t o2 = off + bj * HALF;
                    const u32x4 xq = __builtin_nontemporal_load((const u32x4*)(X2 + o2)), pq = __builtin_nontemporal_load((const u32x4*)(PJ + o2));
#pragma unroll
                    for (int n = 0; n < 2; ++n) {
                        const f32x4 a = acc[ai][bj][m][n] * 0.015625f;
                        const unsigned x0 = xq[2 * n], x1 = xq[2 * n + 1], p0 = pq[2 * n], p1 = pq[2 * n + 1];
                        f32x4 r;
                        r[0] = __uint_as_float(x0 << 16) + __uint_as_float(p0 << 16) * __builtin_amdgcn_rcpf(1.0f + __builtin_amdgcn_exp2f(-1.4426950408889634f * a[0]));
                        r[1] = __uint_as_float(x0 & 0xffff0000u) + __uint_as_float(p0 & 0xffff0000u) * __builtin_amdgcn_rcpf(1.0f + __builtin_amdgcn_exp2f(-1.4426950408889634f * a[1]));
                        r[2] = __uint_as_float(x1 << 16) + __uint_as_float(p1 << 16) * __builtin_amdgcn_rcpf(1.0f + __builtin_amdgcn_exp2f(-1.4426950408889634f * a[2]));
                        r[3] = __uint_as_float(x1 & 0xffff0000u) + __uint_as_float(p1 & 0xffff0000u) * __builtin_amdgcn_rcpf(1.0f + __builtin_amdgcn_exp2f(-1.4426950408889634f * a[3]));
                        __builtin_nontemporal_store(r, (f32x4*)(outw + o2 + 4 * n));
                    } } }
    }
};
struct MoeOrder {
    int nM, nN, nwg, G, c, wid, mode; const PG8_LAS int* tile_e; const float* pf_bias; const float* pf_rstd; PG8_LAS unsigned char* pf_lds;
    const int* toklist; const PG8_LAS int* first_tile; PG8_LAS unsigned char* tokl;
    __device__ __forceinline__ const int* tok_src(const Unit& u) const { return toklist + (size_t)u.e * T + 256 * (u.pm - first_tile[u.e]); }
    __device__ __forceinline__ PG8_LAS unsigned char* tok_lds() const { return tokl; }
    __device__ void init(int nM_, int nN_, int G_, int c_, const PG8_LAS int* te, int wid_, int mode_, const float* pb, const float* pr, PG8_LAS unsigned char* pl) { nM = nM_; nN = nN_; nwg = nM * nN; G = G_; c = c_; tile_e = te; wid = wid_; mode = mode_; pf_bias = pb; pf_rstd = pr; pf_lds = pl; }
    __device__ bool next(int i, Unit& u) const {
        const long L = (long)i * G + c; if (L >= nwg) return false;
        int wgid = (int)L; { const int q = nwg / NXCD, r = nwg % NXCD, xcd = wgid % NXCD, off = wgid / NXCD; wgid = (xcd < r ? xcd * (q + 1) : r * (q + 1) + (xcd - r) * q) + off; }
        const int nig = WGM * nN, gid = wgid / nig, fm = gid * WGM, gsz = (nM - fm) < WGM ? (nM - fm) : WGM;
        u.pm = fm + ((wgid % nig) % gsz); u.pn = (wgid % nig) / gsz; u.e = __builtin_amdgcn_readfirstlane(tile_e[u.pm]); u.seq = i; return true;
    }
    __device__ __forceinline__ void a_ready(const Unit& u) const {
        const int lane = (int)__builtin_amdgcn_mbcnt_hi(~0u, __builtin_amdgcn_mbcnt_lo(~0u, 0u)), wr = wid >> 2, wc = wid & 3;
        PG8_LAS unsigned char* buf = pf_lds + (u.seq & 1) * PF_BUF_BYTES + wid * PF_WAVE_BYTES;
        if (mode == 1) {
            const float* bsrc = pf_bias + (size_t)u.e * 2048 + 128 * u.pn + 32 * wc + (lane & 31) + ((lane >> 5) ? 1024 : 0);
            __builtin_amdgcn_global_load_lds((const unsigned*)bsrc, (PG8_LAS unsigned*)buf, 4, 0, 0);
            const PG8_LAS int* tl = (const PG8_LAS int*)(tokl + 1024 * (u.seq & 1)) + wr * 64 + lane;
            __builtin_amdgcn_global_load_lds((const unsigned*)(pf_rstd + tl[0]), (PG8_LAS unsigned*)(buf + 256), 4, 0, 0);
            __builtin_amdgcn_global_load_lds((const unsigned*)(pf_rstd + tl[HALF]), (PG8_LAS unsigned*)(buf + 512), 4, 0, 0);
        } else if (mode == 2) {
            const float* bsrc = pf_bias + (size_t)u.e * 1024 + u.pn * BM + 32 * wc + (lane & 31) + ((lane >> 5) ? HALF : 0);
            __builtin_amdgcn_global_load_lds((const unsigned*)bsrc, (PG8_LAS unsigned*)buf, 4, 0, 0);
        }
    }
    __device__ __forceinline__ void done(const Unit&) const {}
};
struct EpiNull {
    static constexpr bool PERM = true, AFTER_DRAIN = false;
    __device__ __forceinline__ void operator()(const f32x4 (&acc)[2][2][4][2], const Unit& u, int wr, int wc, int fr, int fq) const {
#pragma unroll
        for (int ai = 0; ai < 2; ++ai)
#pragma unroll
            for (int bj = 0; bj < 2; ++bj)
#pragma unroll
                for (int m = 0; m < 4; ++m)
#pragma unroll
                    for (int n = 0; n < 2; ++n) asm volatile("" :: "v"(acc[ai][bj][m][n]));
    }
};
template <class Epi, class Sched, bool ALIGN_EPI = false, bool SP2 = false, bool F8 = false, bool GATHER = false>
__device__ __forceinline__ void gemm_phase(PG8_LAS unsigned char* lds, const Gemm g, const Sched& S, const Epi& E, const int wave_id) {
    int tid_ = wave_id * 64 + lane_id_hw(); asm volatile("" : "+v"(tid_));
    const int tid = tid_, wid = __builtin_amdgcn_readfirstlane(tid >> 6), lane = tid & 63, wr = wid >> 2, wc = wid & 3, fr = lane & 15, fq = lane >> 4;
    const int K = g.K, nt = K / BK;
    unsigned voffA[2], voffB[2];
#pragma unroll
    for (int i = 0; i < 2; ++i) { int R, C; stage_rc(tid * 16 + i * 8192, R, C); const int Rb = Epi::PERM ? ((R & ~31) + perm32(R & 31)) : R;
        voffA[i] = (unsigned)(R * K + C) * 2u; voffB[i] = (unsigned)(Rb * K + C) * 2u; }
    const size_t kstep = (size_t)(BK * 2);
    const size_t hstep = (size_t)HALF * K * 2;
    const size_t tstep = 2 * hstep;
    const size_t hstepA = GATHER ? 0 : hstep;
    unsigned gC[2][2];
#pragma unroll
    for (int h = 0; h < 2; ++h)
#pragma unroll
        for (int i = 0; i < 2; ++i) gC[h][i] = voffA[i];
#define PG8_TOK_DMA(U, par) do { if constexpr (GATHER) { if (wid < 4) __builtin_amdgcn_global_load_lds((const unsigned*)(S.tok_src(U) + 64 * wid + (int)__builtin_amdgcn_mbcnt_hi(~0u, __builtin_amdgcn_mbcnt_lo(~0u, 0u))), (PG8_LAS unsigned*)(S.tok_lds() + 1024 * (par) + 256 * wid), 4, 0, 0); } } while (0)
#define PG8_TOK_READ(dst, par) do { if constexpr (GATHER) { _Pragma("unroll") for (int i = 0; i < 2; ++i) { int R_, C_; stage_rc((wid * 64 + (int)__builtin_amdgcn_mbcnt_hi(~0u, __builtin_amdgcn_mbcnt_lo(~0u, 0u))) * 16 + i * 8192, R_, C_); _Pragma("unroll") for (int h = 0; h < 2; ++h) \
        dst[h][i] = (unsigned)(*(const PG8_LAS int*)(S.tok_lds() + 1024 * (par) + 4 * (h * HALF + R_))) * (unsigned)(K * 2) + (unsigned)C_ * 2u; } } } while (0)
    const unsigned ldsw = (unsigned)wid * 1024u;
    const int aoff = lds_byte(wr * 64 + fr, fq * 8), boff = lds_byte(wc * 32 + fr, fq * 8);
#define PG8_SA(b, h) (((b) * 2 + (h)) * HTB)
#define PG8_SB(b, h) ((4 + (b) * 2 + (h)) * HTB)
#define PG8_STAGE(bufoff, gbase, voff) do { if (!PG8_NOSTAGE) _Pragma("unroll") for (int _i = 0; _i < 2; ++_i) \
        __builtin_amdgcn_global_load_lds((const unsigned*)((const char*)(gbase) + (voff)[_i]), (PG8_LAS unsigned*)(lds + (bufoff) + ldsw + _i * 8192), 16, 0, 0); } while (0)
#define PG8_LD16(off) (*(const PG8_LAS v4i32*)(lds + (off)))
#define PG8_LDA(dst, b, h) do { if constexpr (F8) { _Pragma("unroll") for (int m = 0; m < 4; ++m) dst##8[m] = __builtin_shufflevector(PG8_LD16(PG8_SA(b, h) + aoff + m * 2048), PG8_LD16(PG8_SA(b, h) + aoff + m * 2048 + 1024), 0, 1, 2, 3, 4, 5, 6, 7); } \
        else { _Pragma("unroll") for (int m = 0; m < 4; ++m) _Pragma("unroll") for (int k = 0; k < 2; ++k) dst[m][k] = *(const PG8_LAS bf16x8*)(lds + PG8_SA(b, h) + aoff + m * 2048 + k * 1024); } } while (0)
#define PG8_LDB(dst, b, h) do { if constexpr (F8) { _Pragma("unroll") for (int n = 0; n < 2; ++n) dst##8[n] = __builtin_shufflevector(PG8_LD16(PG8_SB(b, h) + boff + n * 2048), PG8_LD16(PG8_SB(b, h) + boff + n * 2048 + 1024), 0, 1, 2, 3, 4, 5, 6, 7); } \
        else { _Pragma("unroll") for (int n = 0; n < 2; ++n) _Pragma("unroll") for (int k = 0; k < 2; ++k) dst[n][k] = *(const PG8_LAS bf16x8*)(lds + PG8_SB(b, h) + boff + n * 2048 + k * 1024); } } while (0)
#define PG8_MMA(ai, bj, At, Bt) do { __builtin_amdgcn_s_setprio(1); \
        if constexpr (F8) { _Pragma("unroll") for (int m = 0; m < 4; ++m) _Pragma("unroll") for (int n = 0; n < 2; ++n) \
            asm volatile("v_mfma_scale_f32_16x16x128_f8f6f4 %0, %1, %2, %0, %3, %3 op_sel_hi:[0,0,0]" : "+v"(acc[ai][bj][m][n]) : "v"(Bt##8[n]), "v"(At##8[m]), "v"(f8scale)); } \
        else { _Pragma("unroll") for (int m = 0; m < 4; ++m) _Pragma("unroll") for (int n = 0; n < 2; ++n) _Pragma("unroll") for (int k = 0; k < 2; ++k) \
            acc[ai][bj][m][n] = __builtin_amdgcn_mfma_f32_16x16x32_bf16(Bt[n][k], At[m][k], acc[ai][bj][m][n], 0, 0, 0); } \
        __builtin_amdgcn_s_setprio(0); } while (0)
#define PG8_WAIT_V(n) asm volatile("s_waitcnt vmcnt(" #n ")" ::: "memory")
#define PG8_WAIT_L(n) asm volatile("s_waitcnt lgkmcnt(" #n ")" ::: "memory")
#define PG8_BAR __builtin_amdgcn_s_barrier()
#define PG8_SCHED __builtin_amdgcn_sched_barrier(0)
    Unit cur, nxt; int ui = 0;
    if (!S.next(0, cur)) return;
    f32x4 acc[2][2][4][2];
#pragma unroll
    for (int a = 0; a < 2; ++a)
#pragma unroll
        for (int b = 0; b < 2; ++b)
#pragma unroll
            for (int m = 0; m < 4; ++m)
#pragma unroll
                for (int n = 0; n < 2; ++n) acc[a][b][m][n] = (f32x4){0.f, 0.f, 0.f, 0.f};
    bf16x8 At[4][2], B0[2][2], B1[2][2];
    v8i32 At8[4], B08[2], B18[2]; const int f8scale = 0x7f7f7f7f;
    const char* cA = (const char*)g.A + (GATHER ? (size_t)0 : (size_t)cur.pm * tstep); const char* cB = (const char*)g.Bt + (size_t)cur.e * g.strideBe + (size_t)cur.pn * tstep;
    if constexpr (GATHER) { PG8_TOK_DMA(cur, 0); asm volatile("s_waitcnt vmcnt(0)" ::: "memory"); PG8_BAR; PG8_TOK_READ(gC, 0); }
    S.a_ready(cur);
    if constexpr (SP2) {
        PG8_STAGE(PG8_SB(0, 0), cB, voffB); PG8_STAGE(PG8_SB(0, 1), cB + hstep, voffB); PG8_STAGE(PG8_SA(0, 0), cA, gC[0]); PG8_STAGE(PG8_SA(0, 1), cA + hstepA, gC[1]);
        if (wr == 1) PG8_BAR;
        PG8_WAIT_V(2); PG8_BAR;
        PG8_STAGE(PG8_SB(1, 0), cB + kstep, voffB); PG8_STAGE(PG8_SA(1, 0), cA + kstep, gC[0]); PG8_STAGE(PG8_SB(1, 1), cB + hstep + kstep, voffB);
        PG8_WAIT_V(6); PG8_BAR;
    } else {
        PG8_STAGE(PG8_SB(0, 0), cB, voffB); PG8_STAGE(PG8_SA(0, 0), cA, voffA); PG8_STAGE(PG8_SB(0, 1), cB + hstep, voffB); PG8_STAGE(PG8_SA(0, 1), cA + hstep, voffA);
        if (wr == 1) PG8_BAR;
        PG8_WAIT_V(4); PG8_BAR;
        PG8_STAGE(PG8_SB(1, 0), cB + kstep, voffB); PG8_STAGE(PG8_SA(1, 0), cA + kstep, voffA); PG8_STAGE(PG8_SB(1, 1), cB + hstep + kstep, voffB);
        PG8_WAIT_V(6); PG8_BAR;
    }
    for (;;) {
        const bool has_next = S.next(ui + 1, nxt);
        const char* nA = (has_next && !GATHER) ? (const char*)g.A + (size_t)nxt.pm * tstep : cA;
        const char* nB = has_next ? (const char*)g.Bt + (size_t)nxt.e * g.strideBe + (size_t)nxt.pn * tstep : cB;
        if (has_next) PG8_TOK_DMA(nxt, (ui + 1) & 1);
#pragma unroll 1
        for (int t = 0; t < nt; t += 2) {
            const bool last = (t == nt - 2);
            const char* a1 = cA + (size_t)(t + 1) * kstep;
            const char* a2 = last ? nA : cA + (size_t)(t + 2) * kstep; const char* b2 = last ? nB : cB + (size_t)(t + 2) * kstep;
            const char* a3 = a2 + kstep; const char* b3 = b2 + kstep;
            if (last && has_next) S.a_ready(nxt);
            if constexpr (SP2) {
            PG8_LDB(B0, 0, 0); PG8_LDB(B1, 0, 1); PG8_SCHED; PG8_LDA(At, 0, 0); PG8_STAGE(PG8_SA(1, 1), a1 + hstepA, gC[1]);
            if constexpr (GATHER) { if (last && has_next) PG8_TOK_READ(gC, (ui + 1) & 1); }
            PG8_WAIT_V(8); PG8_WAIT_L(0); PG8_BAR; PG8_MMA(0, 0, At, B0); PG8_MMA(0, 1, At, B1); PG8_BAR; PG8_SCHED;
            PG8_LDA(At, 0, 1); PG8_STAGE(PG8_SB(0, 0), b2, voffB); PG8_STAGE(PG8_SB(0, 1), b2 + hstep, voffB); PG8_STAGE(PG8_SA(0, 0), a2, gC[0]);
            PG8_WAIT_V(8); PG8_WAIT_L(0); PG8_BAR; PG8_MMA(1, 0, At, B0); PG8_MMA(1, 1, At, B1); PG8_BAR; PG8_SCHED;
            PG8_LDB(B0, 1, 0); PG8_LDB(B1, 1, 1); PG8_SCHED; PG8_LDA(At, 1, 0); PG8_STAGE(PG8_SA(0, 1), a2 + hstepA, gC[1]);
            PG8_WAIT_V(8); PG8_WAIT_L(0); PG8_BAR; PG8_MMA(0, 0, At, B0); PG8_MMA(0, 1, At, B1); PG8_BAR; PG8_SCHED;
            PG8_LDA(At, 1, 1); PG8_STAGE(PG8_SB(1, 0), b3, voffB); PG8_STAGE(PG8_SB(1, 1), b3 + hstep, voffB); PG8_STAGE(PG8_SA(1, 0), a3, gC[0]);
            PG8_WAIT_V(8); PG8_WAIT_L(0); PG8_BAR; PG8_MMA(1, 0, At, B0); PG8_MMA(1, 1, At, B1); PG8_BAR; PG8_SCHED;
            } else {
            PG8_LDB(B0, 0, 0); PG8_SCHED; PG8_LDA(At, 0, 0); PG8_STAGE(PG8_SA(1, 1), a1 + hstep, voffA);
            PG8_WAIT_L(8); PG8_BAR; PG8_WAIT_L(0); PG8_MMA(0, 0, At, B0); PG8_BAR; PG8_SCHED;
            PG8_LDB(B1, 0, 1); PG8_STAGE(PG8_SB(0, 0), b2, voffB);
            PG8_BAR; PG8_WAIT_L(0); PG8_MMA(0, 1, At, B1); PG8_BAR;
            PG8_LDA(At, 0, 1); PG8_STAGE(PG8_SA(0, 0), a2, voffA);
            PG8_BAR; PG8_WAIT_L(0); PG8_MMA(1, 0, At, B0); PG8_BAR; PG8_SCHED;
            PG8_STAGE(PG8_SB(0, 1), b2 + hstep, voffB);
            PG8_WAIT_V(6); PG8_BAR; PG8_MMA(1, 1, At, B1); PG8_BAR;
            PG8_LDB(B0, 1, 0); PG8_SCHED; PG8_LDA(At, 1, 0); PG8_STAGE(PG8_SA(0, 1), a2 + hstep, voffA);
            PG8_WAIT_L(8); PG8_BAR; PG8_WAIT_L(0); PG8_MMA(0, 0, At, B0); PG8_BAR; PG8_SCHED;
            PG8_LDB(B1, 1, 1); PG8_STAGE(PG8_SB(1, 0), b3, voffB);
            PG8_BAR; PG8_WAIT_L(0); PG8_MMA(0, 1, At, B1); PG8_BAR;
            PG8_LDA(At, 1, 1); PG8_STAGE(PG8_SA(1, 0), a3, voffA);
            PG8_BAR; PG8_WAIT_L(0); PG8_MMA(1, 0, At, B0); PG8_BAR; PG8_SCHED;
            PG8_STAGE(PG8_SB(1, 1), b3 + hstep, voffB);
            PG8_WAIT_V(6); PG8_BAR; PG8_MMA(1, 1, At, B1); PG8_BAR;
            }
        }
        if constexpr (ALIGN_EPI) { if (wr == 0) PG8_BAR; }
        if constexpr (F8) asm volatile("s_nop 15\n\ts_nop 15\n\ts_nop 15" ::: "memory");
        if constexpr (!Epi::AFTER_DRAIN) { E(acc, cur, wr, wc, fr, fq); S.done(cur); }
        if (!has_next) break;
#pragma unroll
        for (int a = 0; a < 2; ++a)
#pragma unroll
            for (int b = 0; b < 2; ++b)
#pragma unroll
                for (int m = 0; m < 4; ++m)
#pragma unroll
                    for (int n = 0; n < 2; ++n) acc[a][b][m][n] = (f32x4){0.f, 0.f, 0.f, 0.f};
        cur = nxt; cA = nA; cB = nB; ++ui;
        if constexpr (ALIGN_EPI) { if (wr == 1) PG8_BAR; }
    }
    PG8_WAIT_V(0);
    if constexpr (!ALIGN_EPI) { if (wr == 0) PG8_BAR; }
    PG8_BAR;
    if constexpr (Epi::AFTER_DRAIN) { E.fused(acc, cur, wr, wc, fr, fq, lds, wid, lane); S.done(cur); }
#undef PG8_TOK_DMA
#undef PG8_TOK_READ
#undef PG8_SA
#undef PG8_SB
#undef PG8_STAGE
#undef PG8_LD16
#undef PG8_LDA
#undef PG8_LDB
#undef PG8_MMA
#undef PG8_WAIT_V
#undef PG8_WAIT_L
#undef PG8_BAR
#undef PG8_SCHED
}
}

constexpr int NWAVES = 8;
constexpr int T = pg8::T, SEQ = pg8::SEQ, DM = pg8::DM, DIN = pg8::DIN, NE = 32, PLE = 256;
constexpr float EPS = pg8::EPS;
constexpr size_t MiB = 1u << 20;
constexpr size_t WS_CTL = 0, CTL_ZERO_BYTES = 256 * 1024;
constexpr size_t WS_WT_IN = 2 * MiB, WS_WT_OUT = 9 * MiB, WS_WT_PG = 11 * MiB, WS_WT_PP = 13 * MiB;
constexpr size_t WS_GAINS = 13 * MiB + 512 * 1024;
constexpr size_t WS_WRT = 13 * MiB + 576 * 1024;
constexpr size_t WS_ROPEC = 14 * MiB, WS_ROPES = 16 * MiB, WS_PB = 18 * MiB, WS_ROUTE = 26 * MiB;
constexpr size_t WS_TOKLIST = 29 * MiB;
constexpr size_t WS_WT_UG = 32 * MiB, WS_WT_DN = 160 * MiB;
constexpr size_t WS_XN = 224 * MiB;
constexpr size_t WS_HM = 256 * MiB;
constexpr size_t WS_X1 = 256 * MiB;
constexpr size_t WS_RG = 352 * MiB;
constexpr size_t WS_Y = 368 * MiB;
constexpr size_t WS_PJ = 400 * MiB;
constexpr size_t WS_XS = 432 * MiB, WS_H = 576 * MiB, WS_YS = 720 * MiB;
constexpr size_t WS_END = 864 * MiB;
constexpr int CW_TMO = 0, CW_CODE = 1;
constexpr int CW_BAR = 4096;
constexpr int RING_OFF = 0, RING_BYTES = 131072;
constexpr int LDSCTL_OFF = RING_BYTES, MISC_OFF = LDSCTL_OFF + 320;
constexpr int PF_OFF = LDSCTL_OFF + 4096;
constexpr int TOKL_OFF = LDSCTL_OFF + 16384;
constexpr int LDS_BYTES = 151552;
#define GAS __attribute__((address_space(1)))
#define LAS __attribute__((address_space(3)))
typedef unsigned short bf16;
typedef unsigned v4u __attribute__((ext_vector_type(4)));
typedef float f32x4 __attribute__((ext_vector_type(4)));
typedef short bf16x8 __attribute__((ext_vector_type(8)));
typedef unsigned u32x4_t __attribute__((ext_vector_type(4)));
typedef unsigned u32x2_t __attribute__((ext_vector_type(2)));
typedef GAS unsigned gu32;
typedef GAS unsigned long long gu64;
#define RLX_AGENT __ATOMIC_RELAXED, __HIP_MEMORY_SCOPE_AGENT
#define LDS_WAIT() asm volatile("s_waitcnt lgkmcnt(0)" ::: "memory")
#define VM_WAIT() asm volatile("s_waitcnt vmcnt(0)" ::: "memory")
__device__ __forceinline__ unsigned long long rt() { return __builtin_amdgcn_s_memrealtime(); }
__device__ __forceinline__ unsigned f2bf(float f) { unsigned u = __builtin_bit_cast(unsigned, f); return (u + 0x7fffu + ((u >> 16) & 1u)) >> 16; }
__device__ __forceinline__ unsigned pk2(float lo, float hi) { return f2bf(lo) | (f2bf(hi) << 16); }

#define XB_TMO      128
#define XB_XCNT(j)  (256  + 64 * (j))
#define XB_XSUB(j)  (1280 + 64 * (j))
#define XB_XGEN(j)  (2304 + 64 * (j))
#define XB_TOP      3328
#define XB_TOPGEN   3392
#define XCD_BAR_WORDS 3456
#define XB_SPIN_CAP (1u << 18)

__device__ __forceinline__ unsigned xb_ld(unsigned* p)              { return __hip_atomic_load(p, __ATOMIC_RELAXED, __HIP_MEMORY_SCOPE_AGENT); }
__device__ __forceinline__ unsigned xb_add(unsigned* p, unsigned v) { return __hip_atomic_fetch_add(p, v, __ATOMIC_RELAXED, __HIP_MEMORY_SCOPE_AGENT); }
__device__ __forceinline__ unsigned xb_xcc_id() { return (unsigned)__builtin_amdgcn_s_getreg((3 << 11) | 20) & 0xFu; }
#define XB_SPIN(cond, bar) do { unsigned _sp = 0; while (cond) { __builtin_amdgcn_s_sleep(1); \
    if ((++_sp & 255u) == 0u) { if (xb_ld(&(bar)[XB_TMO])) break; if (_sp > XB_SPIN_CAP) { atomicAdd(&(bar)[XB_TMO], 1u); break; } } } } while (0)

struct XcdBarrier {
    unsigned* bar; unsigned x; int wave;
    volatile LAS unsigned* st;
};

__device__ __forceinline__ XcdBarrier xcd_barrier_post(unsigned* bar, volatile LAS unsigned* st) {
    XcdBarrier b; b.bar = bar; b.x = xb_xcc_id(); b.st = st;
    if (threadIdx.x == 0) (void)xb_add(&bar[XB_XCNT(b.x)], 1u);
    return b;
}
__device__ __forceinline__ void xcd_barrier_complete(unsigned* bar, unsigned x, unsigned& nloc, unsigned& nx) {
    const unsigned G = gridDim.x * gridDim.y * gridDim.z;
    unsigned sum, cnt, mine, sp = 0u;
    for (;;) {
        sum = 0u; cnt = 0u; mine = 0u;
#pragma unroll
        for (unsigned j = 0; j < 16; ++j) { const unsigned c = xb_ld(&bar[XB_XCNT(j)]); sum += c; cnt += (c > 0u) ? 1u : 0u; mine = (j == x) ? c : mine; }
        if (sum == G) break;
        __builtin_amdgcn_s_sleep(1);
        if ((++sp & 255u) == 0u) { if (xb_ld(&bar[XB_TMO])) break; if (sp > XB_SPIN_CAP) { atomicAdd(&bar[XB_TMO], 1u); break; } }
    }
    nloc = mine > 0u ? mine : 1u; nx = cnt > 0u ? cnt : 1u;
}

__device__ __forceinline__ void xcd_barrier(const XcdBarrier& b) {
    asm volatile("s_waitcnt vmcnt(0)" ::: "memory");
    __syncthreads();
    if (b.wave == 0 && lane_id_hw() == 0) {
        unsigned* bar = b.bar;
        __builtin_amdgcn_s_waitcnt(0);
        unsigned nloc = b.st[0], nx = b.st[1];
        if (nloc == 0u) { xcd_barrier_complete(bar, b.x, nloc, nx); b.st[0] = nloc; b.st[1] = nx; }
        const unsigned old = xb_add(&bar[XB_XSUB(b.x)], 1u);
        const unsigned gen = old / nloc;
        const unsigned tgen = gen;
        if (old + 1u == (gen + 1u) * nloc) {
            __builtin_amdgcn_fence(__ATOMIC_RELEASE, "agent");
            asm volatile("s_waitcnt vmcnt(0)" ::: "memory");
            const unsigned og = xb_add(&bar[XB_TOP], 1u);
            const unsigned tg = og / nx;
            if (og + 1u == (tg + 1u) * nx) xb_add(&bar[XB_TOPGEN], 1u);
            else XB_SPIN(xb_ld(&bar[XB_TOPGEN]) == tg, bar);
        } else {
            XB_SPIN(xb_ld(&bar[XB_TOPGEN]) == tgen, bar);
        }
        __builtin_amdgcn_fence(__ATOMIC_ACQUIRE, "agent");
        asm volatile("s_waitcnt vmcnt(0)" ::: "memory");
    }
    __syncthreads();
}

struct Args {
    const float* x; const float* p; const int* positions; const float* g_mix; const float* w_in;
    const float* sbq; const float* sbk; const float* rq; const float* rk; const float* gn_g; const float* gn_b; const float* w_out;
    const float* g_ffn; const float* w_r; const float* b_r; const float* w_ug; const float* b_ug; const float* w_dn; const float* b_dn;
    const float* g_ple; const float* w_pg; const float* w_pp;
    float* out; unsigned char* ws; int ph_lo, ph_hi;
};
struct Frame {
    LAS unsigned char* lds;
    volatile LAS unsigned* MISC;
    gu32* ctl;
    int wave;
    int vcu, G;
};
__device__ __forceinline__ int tid_now(int wave_id) { int t = wave_id * 64 + lane_id_hw(); asm volatile("" : "+v"(t)); return t; }
__device__ __forceinline__ float wave_sum(float v) {
#pragma unroll
    for (int o = 1; o < 64; o <<= 1) v += __shfl_xor(v, o);
    return v;
}
__device__ __forceinline__ unsigned cvtpk(float lo, float hi) { return pg8::cvt_pk_bf16(lo, hi); }

enum { MAP_NAT = 0, MAP_IN = 1, MAP_UG = 2 };
constexpr int P0_E_P2 = 32;
__device__ __forceinline__ void p0_item(const float* __restrict__ W, int N, int K, bf16* __restrict__ WT, int kb, int nb, int mapmode, LAS unsigned char* scr, int lane) {
    const int np = 64 * nb + 4 * (lane & 15);
    int src = np;
    if (mapmode == MAP_IN) { const int pn = np >> 8, L = np & 255, bj = L >> 7, wc = (L >> 5) & 3, e = L & 31; src = 256 * pn + 64 * wc + 32 * bj + e; }
    else if (mapmode == MAP_UG) { const int pn = np >> 8, L = np & 255, bj = L >> 7, i = L & 127; src = 1024 * bj + 128 * pn + i; }
    const float* gp = W + (size_t)(64 * kb + (lane >> 4)) * N + src;
    f32x4 v[16];
#pragma unroll
    for (int i = 0; i < 16; ++i) v[i] = *(const f32x4*)(gp + (size_t)(4 * i) * N);
#pragma unroll
    for (int i = 0; i < 16; ++i) {
        LAS unsigned* d = (LAS unsigned*)(scr + (4 * i + (lane >> 4)) * 132 + 8 * (lane & 15));
        d[0] = cvtpk(v[i][0], v[i][1]); d[1] = cvtpk(v[i][2], v[i][3]);
    }
    LDS_WAIT(); asm volatile("" ::: "memory");
    const int c = lane & 7;
#pragma unroll
    for (int it = 0; it < 4; ++it) {
        const int nl = 16 * it + 2 * (lane >> 3);
        unsigned d[8];
#pragma unroll
        for (int j = 0; j < 8; ++j) d[j] = *(const LAS unsigned*)(scr + (8 * c + j) * 132 + 2 * nl);
        v4u o0, o1;
        o0.x = (d[0] & 0xffffu) | (d[1] << 16); o0.y = (d[2] & 0xffffu) | (d[3] << 16); o0.z = (d[4] & 0xffffu) | (d[5] << 16); o0.w = (d[6] & 0xffffu) | (d[7] << 16);
        o1.x = (d[0] >> 16) | (d[1] & 0xffff0000u); o1.y = (d[2] >> 16) | (d[3] & 0xffff0000u); o1.z = (d[4] >> 16) | (d[5] & 0xffff0000u); o1.w = (d[6] >> 16) | (d[7] & 0xffff0000u);
        bf16* dst = WT + (size_t)(64 * nb + nl) * K + 64 * kb + 8 * c;
        *(v4u*)dst = o0; *(v4u*)(dst + K) = o1;
    }
    LDS_WAIT(); asm volatile("" ::: "memory");
}
__device__ __forceinline__ unsigned pk4_fp8(float a, float b, float c, float d) { int r = __builtin_amdgcn_cvt_pk_fp8_f32(a, b, 0, false); r = __builtin_amdgcn_cvt_pk_fp8_f32(c, d, r, true); return (unsigned)r; }
__device__ __forceinline__ void p0_item_f8(const float* __restrict__ W, int N, int K, unsigned char* __restrict__ WT, int kb, int nb, int mapmode, LAS unsigned char* scr, int lane) {
    const int np = 64 * nb + 4 * (lane & 15);
    int src = np;
    if (mapmode == MAP_UG) { const int pn = np >> 8, L = np & 255, bj = L >> 7, i = L & 127; src = 1024 * bj + 128 * pn + i; }
    const float* gp = W + (size_t)(64 * kb + (lane >> 4)) * N + src;
    f32x4 v[16];
#pragma unroll
    for (int i = 0; i < 16; ++i) v[i] = *(const f32x4*)(gp + (size_t)(4 * i) * N);
#pragma unroll
    for (int i = 0; i < 16; ++i) *(LAS unsigned*)(scr + (4 * i + (lane >> 4)) * 68 + 4 * (lane & 15)) = pk4_fp8(v[i][0] * 64.0f, v[i][1] * 64.0f, v[i][2] * 64.0f, v[i][3] * 64.0f);
    LDS_WAIT(); asm volatile("" ::: "memory");
    const int nq = lane & 15, kg = lane >> 4;
    unsigned d[16];
#pragma unroll
    for (int j = 0; j < 16; ++j) d[j] = *(const LAS unsigned*)(scr + (16 * kg + j) * 68 + 4 * nq);
#pragma unroll
    for (int t = 0; t < 4; ++t) {
        v4u o;
#pragma unroll
        for (int q = 0; q < 4; ++q) o[q] = ((d[4 * q] >> (8 * t)) & 0xffu) | (((d[4 * q + 1] >> (8 * t)) & 0xffu) << 8) | (((d[4 * q + 2] >> (8 * t)) & 0xffu) << 16) | (((d[4 * q + 3] >> (8 * t)) & 0xffu) << 24);
        *(v4u*)(WT + (size_t)(64 * nb + 4 * nq + t) * K + 64 * kb + 16 * kg) = o;
    }
    LDS_WAIT(); asm volatile("" ::: "memory");
}
struct P0D { const float* gp; int N, K, kb, nb; bf16* W16; unsigned char* W8; const float* rsc; };
__device__ __forceinline__ int p0_src_col(int np, int mapmode) {
    int src = np;
    if (mapmode == MAP_IN) { const int pn = np >> 8, L = np & 255, bj = L >> 7, wc = (L >> 5) & 3, e = L & 31; src = 256 * pn + 64 * wc + 32 * bj + e; }
    else if (mapmode == MAP_UG) { const int pn = np >> 8, L = np & 255, bj = L >> 7, i = L & 127; src = 1024 * bj + 128 * pn + i; }
    return src;
}
__device__ __forceinline__ P0D p0_mk(const float* W, int N, int K, bf16* W16, unsigned char* W8, int kb, int nb, int mapmode, int lane, const float* rsc = nullptr) {
    P0D d; d.N = N; d.K = K; d.kb = kb; d.nb = nb; d.W16 = W16; d.W8 = W8;
    if (W8) {
        d.rsc = rsc ? rsc + 128 * kb + (lane >> 3) : nullptr;
        d.gp = W + (size_t)(128 * kb + (lane >> 3)) * N + p0_src_col(32 * nb + 4 * (lane & 7), mapmode);
    } else {
        d.rsc = nullptr;
        d.gp = W + (size_t)(64 * kb + (lane >> 4)) * N + p0_src_col(64 * nb + 4 * (lane & 15), mapmode);
    }
    return d;
}
__device__ __forceinline__ void p0_load(const P0D& d, f32x4 (&v)[16]) {
#pragma unroll
    for (int i = 0; i < 16; ++i) v[i] = __builtin_nontemporal_load((const f32x4*)(d.gp + (size_t)((d.W8 ? 8 : 4) * i) * d.N));
}
__device__ __forceinline__ void p0_finish(const P0D& d, const f32x4 (&v)[16], LAS unsigned char* scr, int lane, const int pm = 0) {
    if (pm == 1) { _Pragma("unroll") for (int i = 0; i < 16; ++i) asm volatile("" :: "v"(v[i])); return; }
    if (d.W16) {
#pragma unroll
        for (int i = 0; i < 16; ++i) { LAS unsigned* q = (LAS unsigned*)(scr + (4 * i + (lane >> 4)) * 132 + 8 * (lane & 15)); q[0] = cvtpk(v[i][0], v[i][1]); q[1] = cvtpk(v[i][2], v[i][3]); }
        LDS_WAIT(); asm volatile("" ::: "memory");
        const int c = lane & 7;
#pragma unroll
        for (int it = 0; it < 4; ++it) {
            const int nl = 16 * it + 2 * (lane >> 3);
            unsigned x[8];
#pragma unroll
            for (int j = 0; j < 8; ++j) x[j] = *(const LAS unsigned*)(scr + (8 * c + j) * 132 + 2 * nl);
            v4u o0, o1;
            o0.x = (x[0] & 0xffffu) | (x[1] << 16); o0.y = (x[2] & 0xffffu) | (x[3] << 16); o0.z = (x[4] & 0xffffu) | (x[5] << 16); o0.w = (x[6] & 0xffffu) | (x[7] << 16);
            o1.x = (x[0] >> 16) | (x[1] & 0xffff0000u); o1.y = (x[2] >> 16) | (x[3] & 0xffff0000u); o1.z = (x[4] >> 16) | (x[5] & 0xffff0000u); o1.w = (x[6] >> 16) | (x[7] & 0xffff0000u);
            bf16* dst = d.W16 + (size_t)(64 * d.nb + nl) * d.K + 64 * d.kb + 8 * c;
            if (pm == 0 || pm == 3) { *(v4u*)dst = o0; *(v4u*)(dst + d.K) = o1; } else asm volatile("" :: "v"(o0), "v"(o1));
        }
    } else {
#pragma unroll
        for (int i = 0; i < 16; ++i) { const float sc = d.rsc ? d.rsc[8 * i] * 64.0f : 64.0f; *(LAS unsigned*)(scr + (8 * i + (lane >> 3)) * 36 + 4 * (lane & 7)) = pk4_fp8(v[i][0] * sc, v[i][1] * sc, v[i][2] * sc, v[i][3] * sc); }
        LDS_WAIT(); asm volatile("" ::: "memory");
        const int nq = lane & 7, kg = lane >> 3;
        unsigned x[16];
#pragma unroll
        for (int j = 0; j < 16; ++j) x[j] = *(const LAS unsigned*)(scr + (16 * kg + j) * 36 + 4 * nq);
#pragma unroll
        for (int t = 0; t < 4; ++t) {
            v4u o;
#pragma unroll
            for (int q = 0; q < 4; ++q) { const unsigned lo = __builtin_amdgcn_perm(x[4 * q + 1], x[4 * q], 0x0c0c0000u | ((4u + t) << 8) | (unsigned)t), hi = __builtin_amdgcn_perm(x[4 * q + 3], x[4 * q + 2], 0x0c0c0000u | ((4u + t) << 8) | (unsigned)t); o[q] = lo | (hi << 16); }
            if (pm == 0 || pm == 3) __builtin_nontemporal_store(o, (v4u*)(d.W8 + (size_t)(32 * d.nb + 4 * nq + t) * d.K + 128 * d.kb + 16 * kg)); else asm volatile("" :: "v"(o));
        }
    }
    LDS_WAIT(); asm volatile("" ::: "memory");
}
constexpr int P0_I_IN = 16 * 56, P0_I_OUT = 256, P0_I_PG = 256, P0_I_PP = 4 * 16, P0_I_UG = 16 * 32, P0_I_DN = 256, P0_I_SMALL = P0_I_IN + P0_I_OUT + P0_I_PG + P0_I_PP;
__device__ __forceinline__ P0D p0_decode(const Args& a, unsigned char* ws, int it, int lane, bool small, int e0, int ne) {
    int r = it;
    if (small) {
        if (r < P0_I_IN) return p0_mk(a.w_in, DIN, DM, (bf16*)(ws + WS_WT_IN), nullptr, r / 56, r % 56, MAP_IN, lane); r -= P0_I_IN;
        if (r < P0_I_OUT) return p0_mk(a.w_out, DM, DM, (bf16*)(ws + WS_WT_OUT), nullptr, r / 16, r % 16, MAP_NAT, lane); r -= P0_I_OUT;
        if (r < P0_I_PG) return p0_mk(a.w_pg, DM, DM, nullptr, (unsigned char*)(ws + WS_WT_PG), r / 32, r % 32, MAP_NAT, lane); r -= P0_I_PG;
        if (r < P0_I_PP) return p0_mk(a.w_pp, DM, PLE, (bf16*)(ws + WS_WT_PP), nullptr, r / 16, r % 16, MAP_NAT, lane); r -= P0_I_PP;
    }
    if (r < ne * P0_I_UG) { const int e = e0 + r / P0_I_UG, q = r % P0_I_UG; return p0_mk(a.w_ug + (size_t)e * DM * 2048, 2048, DM, nullptr, (unsigned char*)(ws + WS_WT_UG) + (size_t)e * 2048 * DM, q / 64, q % 64, MAP_UG, lane, a.g_ffn); } r -= ne * P0_I_UG;
    { const int e = e0 + r / P0_I_DN, q = r % P0_I_DN; return p0_mk(a.w_dn + (size_t)e * DM * DM, DM, DM, nullptr, (unsigned char*)(ws + WS_WT_DN) + (size_t)e * DM * DM, q / 32, q % 32, MAP_NAT, lane); }
}
__device__ __forceinline__ void p0_items(const Args& a, unsigned char* ws, LAS unsigned char* scr, int lane, int gw, int NGW, bool small, int e0, int ne, const int pm) {
    const int NITEMS = (small ? P0_I_SMALL : 0) + ne * (P0_I_UG + P0_I_DN);
    if (gw < NITEMS) {
        int it = gw; P0D d0 = p0_decode(a, ws, it, lane, small, e0, ne), d1 = d0; f32x4 va[16], vb[16]; p0_load(d0, va);
        for (;;) {
            const int it1 = it + NGW; const bool h1 = it1 < NITEMS;
            if (h1) { d1 = p0_decode(a, ws, it1, lane, small, e0, ne); p0_load(d1, vb); }
            p0_finish(d0, va, scr, lane, pm);
            if (!h1) break;
            const int it2 = it1 + NGW; const bool h2 = it2 < NITEMS;
            if (h2) { d0 = p0_decode(a, ws, it2, lane, small, e0, ne); p0_load(d0, va); }
            p0_finish(d1, vb, scr, lane, pm);
            if (!h2) break;
            it = it2;
        }
    }
}
__device__ __forceinline__ void p0_items_from(const Args& a, unsigned char* ws, LAS unsigned char* scr, int lane, int first, int step, int ne) { p0_items(a, ws, scr, lane, first, step, false, 0, ne, 0); }
__device__ __forceinline__ void rms_row_to_bf16(const float* xrow, const float* g, bf16* orow, int lane) {
    const f32x4* xr = (const f32x4*)xrow + lane;
    f32x4 v[4]; float s = 0.f;
#pragma unroll
    for (int j = 0; j < 4; ++j) { v[j] = xr[64 * j]; s += (v[j][0] * v[j][0] + v[j][1] * v[j][1]) + (v[j][2] * v[j][2] + v[j][3] * v[j][3]); }
    const float rstd = rsqrtf(wave_sum(s) * (1.f / DM) + EPS);
    unsigned long long* o8 = (unsigned long long*)orow + lane;
#pragma unroll
    for (int j = 0; j < 4; ++j) { const f32x4 gg = ((const f32x4*)g)[lane + 64 * j];
        o8[64 * j] = (unsigned long long)cvtpk(v[j][0] * rstd * gg[0], v[j][1] * rstd * gg[1]) | ((unsigned long long)cvtpk(v[j][2] * rstd * gg[2], v[j][3] * rstd * gg[3]) << 32); }
}
__device__ __forceinline__ void p0_prologue(Frame& F, const Args& a, const int pm = 0) {
    unsigned char* ws = a.ws; const int tid = tid_now(F.wave), lane = tid & 63;
    LAS unsigned char* scr = F.lds + RING_OFF + F.wave * 8448;
    const int gw = F.vcu * NWAVES + F.wave, NGW = F.G * NWAVES;
    { const int e0 = (F.G == 256) ? P0_E_P2 : 0; p0_items(a, ws, scr, lane, gw, NGW, true, e0, NE - e0, pm); }
    if (pm != 0) return;
    { v4u* tz = (v4u*)(ws + WS_TOKLIST); const v4u z4 = {0u, 0u, 0u, 0u}; for (int i = gw * 64 + lane; i < NE * T / 4; i += NGW * 64) tz[i] = z4; }
    if (blockIdx.x == 0 && tid < 256) { const int t = tid; const float* srcs = (t < 64) ? a.sbq : (t < 128) ? a.sbk : (t < 192) ? a.rq : a.rk; ((float*)(ws + WS_GAINS))[t] = srcs[t & 63]; }
    {
        f32x4 gg[4];
#pragma unroll
        for (int j = 0; j < 4; ++j) gg[j] = ((const f32x4*)a.g_mix)[lane + 64 * j];
        for (int m0 = 4 * gw; m0 < T; m0 += 4 * NGW) {
            f32x4 v[4][4];
#pragma unroll
            for (int r = 0; r < 4; ++r)
#pragma unroll
                for (int j = 0; j < 4; ++j) v[r][j] = __builtin_nontemporal_load((const f32x4*)(a.x + (size_t)(m0 + r) * DM) + lane + 64 * j);
#pragma unroll
            for (int r = 0; r < 4; ++r) {
                float ss = 0.f;
#pragma unroll
                for (int j = 0; j < 4; ++j) ss += (v[r][j][0] * v[r][j][0] + v[r][j][1] * v[r][j][1]) + (v[r][j][2] * v[r][j][2] + v[r][j][3] * v[r][j][3]);
                const float rstd = rsqrtf(wave_sum(ss) * (1.f / DM) + EPS);
                unsigned long long* o8 = (unsigned long long*)((bf16*)(ws + WS_XN) + (size_t)(m0 + r) * DM) + lane;
#pragma unroll
                for (int j = 0; j < 4; ++j) o8[64 * j] = (unsigned long long)cvtpk(v[r][j][0] * rstd * gg[j][0], v[r][j][1] * rstd * gg[j][1]) | ((unsigned long long)cvtpk(v[r][j][2] * rstd * gg[j][2], v[r][j][3] * rstd * gg[j][3]) << 32);
            }
        }
    }
    { const int gt = gw * 64 + lane, NGT = NGW * 64;
      for (int i0 = gt; i0 < T * PLE / 8; i0 += 4 * NGT) {
          f32x4 a0[4], a1[4];
#pragma unroll
          for (int q = 0; q < 4; ++q) { const int i = i0 + q * NGT; if (i < T * PLE / 8) { a0[q] = __builtin_nontemporal_load((const f32x4*)a.p + 2 * i); a1[q] = __builtin_nontemporal_load((const f32x4*)a.p + 2 * i + 1); } }
#pragma unroll
          for (int q = 0; q < 4; ++q) { const int i = i0 + q * NGT; if (i < T * PLE / 8) { v4u o; o.x = cvtpk(a0[q][0], a0[q][1]); o.y = cvtpk(a0[q][2], a0[q][3]); o.z = cvtpk(a1[q][0], a1[q][1]); o.w = cvtpk(a1[q][2], a1[q][3]); ((v4u*)(ws + WS_PB))[i] = o; } }
      }
      for (int i = gt; i < NE * DM; i += NGT) { const int e = i >> 10, k = i & (DM - 1); const float wv = a.w_r[(size_t)k * NE + e] * a.g_ffn[k];
          const unsigned hi = cvtpk(wv, 0.f) & 0xffffu; const unsigned lo = cvtpk(wv - __uint_as_float(hi << 16), 0.f) & 0xffffu;
          ((bf16*)(ws + WS_WRT))[i] = (bf16)hi; ((bf16*)(ws + WS_WRT))[NE * DM + i] = (bf16)lo; }
      float* rc = (float*)(ws + WS_ROPEC); float* rs = (float*)(ws + WS_ROPES);
      for (int i = gt; i < T * 32; i += NGT) { const int row = i >> 5, f = i & 31;
          const float inv_freq = exp2f(-(float)f * (13.287712379549449f / 32.0f));   const float ang = (float)a.positions[row] * inv_freq;
          float sn, cs; sincosf(ang, &sn, &cs); rc[i] = cs; rs[i] = sn; } }
}

namespace att {
typedef short bf16x8 __attribute__((ext_vector_type(8)));
typedef short s16x4 __attribute__((ext_vector_type(4)));
typedef float f32x16 __attribute__((ext_vector_type(16)));
typedef short v4i16_t __attribute__((ext_vector_type(4)));
constexpr int LK = 0, LV = 24576, LFLAG = 49152;
__device__ __forceinline__ s16x4 vtr(LAS const unsigned char* p) { return __builtin_bit_cast(s16x4, __builtin_amdgcn_ds_read_tr16_b64_v4i16((LAS v4i16_t*)p)); }
__device__ __forceinline__ int crow(int r, int hi) { return (r & 3) + 8 * (r >> 2) + 4 * hi; }
struct AttnArgs { const bf16* hm; const bf16* rg; bf16* Y; const float* gn_g; const float* gn_b; };
struct ConvStream { const Args* a; unsigned char* ws; LAS unsigned char* scr; int it, step, nitems, ne, gap; };

template <int MODE, int ABL = 0> __device__ __forceinline__ void attn_unit(LAS unsigned char* lds, const AttnArgs& A, int b, int h, int qb, const int wave_id, ConvStream& cs) {
    int tid_ = wave_id * 64 + lane_id_hw(); asm volatile("" : "+v"(tid_));
    const int tid = tid_, lane = tid & 63, r32 = lane & 31, hh = lane >> 5;
    const int w = __builtin_amdgcn_readfirstlane(tid >> 6);
    const int q0 = qb * 256, qw = q0 + 32 * w;
    const size_t TS = (size_t)T * 512;
    const size_t hoff = (size_t)(b * 8 + h) * SEQ * 64;
    const bf16* Qp = A.hm + (MODE == 0 ? 0 : 3) * TS + hoff;
    const bf16* Kp = A.hm + (MODE == 0 ? 1 : 4) * TS + hoff;
    const bf16* Vp = A.hm + (MODE == 0 ? 2 : 5) * TS + hoff;
    bf16x8 qf[4];
#pragma unroll
    for (int ds = 0; ds < 4; ++ds) qf[ds] = *(const bf16x8*)(Qp + (size_t)(qw + r32) * 64 + 16 * ds + 8 * hh);
    f32x16 o[2];
#pragma unroll
    for (int r = 0; r < 16; ++r) { o[0][r] = 0.f; o[1][r] = 0.f; }
    float carry = 1.0f;
    const int jmax = (q0 + 255) >> 6, jd = (qw + 31) >> 6;
    const float lg2g = __log2f(1.0f - __builtin_amdgcn_exp2f(-5.0f - (float)h));
    const int krow = 8 * w + (lane >> 3);
    const bf16* Kt = Kp + (size_t)krow * 64 + (((lane & 7) ^ ((krow >> 1) & 7)) << 3); const bf16* Vt = Vp + (size_t)w * 512 + lane * 8;
    volatile LAS unsigned* flags = (volatile LAS unsigned*)(lds + LFLAG);
#define ATT_DMA(t, so) do { __builtin_amdgcn_global_load_lds((const unsigned*)(Kt + (size_t)(t) * 4096), (LAS unsigned*)(lds + LK + (so) + w * 1024), 16, 0, 0); \
                            __builtin_amdgcn_global_load_lds((const unsigned*)(Vt + (size_t)(t) * 4096), (LAS unsigned*)(lds + LV + (so) + w * 1024), 16, 0, 0); } while (0)
    ATT_DMA(jmax, 0);
    if (jmax >= 1) { ATT_DMA(jmax - 1, 8192); asm volatile("s_waitcnt vmcnt(2)\n\ts_barrier" ::: "memory"); }
    else asm volatile("s_waitcnt vmcnt(0)\n\ts_barrier" ::: "memory");
    bool finished = false;
    int so_cur = 0, so_new = 16384;
    P0D cd = P0D{}; f32x4 cv[16]; bool chave = false; int cgap = 0;
    for (int j = jmax; j >= 0; --j) {
        const int cur = j & 1;
        bool cnew = false;
        if (MODE == 1 && ABL == 0) {
            if (chave) { p0_finish(cd, cv, cs.scr, lane, 0); chave = false; }
            if (cs.it < cs.nitems && cgap == 0) { cd = p0_decode(*cs.a, cs.ws, cs.it, lane, false, 0, cs.ne); p0_load(cd, cv); cs.it += cs.step; chave = true; cnew = true; cgap = cs.gap; }
            else if (cgap > 0) --cgap;
        }
        if (j >= 2 && ABL != 4) ATT_DMA(j - 2, so_new);
        if (j <= jd && !finished && ABL == 0) {
            LAS const unsigned char* Kb = lds + LK + so_cur;
            LAS const unsigned char* Vb = lds + LV + so_cur;
            f32x16 p[2];
#pragma unroll
            for (int r = 0; r < 16; ++r) { p[0][r] = 0.f; p[1][r] = 0.f; }
            bf16x8 kf[4][2];
            const int ksw = (r32 >> 1) & 7;
#pragma unroll
            for (int ds = 0; ds < 4; ++ds) { kf[ds][0] = *(LAS const bf16x8*)(Kb + r32 * 128 + (((2 * ds + hh) ^ ksw) << 4)); kf[ds][1] = *(LAS const bf16x8*)(Kb + 4096 + r32 * 128 + (((2 * ds + hh) ^ ksw) << 4)); }
#pragma unroll
            for (int ds = 0; ds < 4; ++ds) {
                p[0] = __builtin_amdgcn_mfma_f32_32x32x16_bf16(kf[ds][0], qf[ds], p[0], 0, 0, 0);
                p[1] = __builtin_amdgcn_mfma_f32_32x32x16_bf16(kf[ds][1], qf[ds], p[1], 0, 0, 0);
            }
            const bool diag = (j == jd);
            const int qg = qw + r32, kv0 = 64 * j + 4 * hh;
            if (MODE == 0) {
                float om[2][16];
#pragma unroll
                for (int hf = 0; hf < 2; ++hf)
#pragma unroll
                    for (int r = 0; r < 16; ++r) {
                        const float a = __builtin_amdgcn_exp2f(__builtin_fminf(-p[hf][r], 120.0f));
                        const float rc = __builtin_amdgcn_rcpf(1.0f + a);
                        p[hf][r] = rc;
                        om[hf][r] = a * rc;
                    }
                if (diag) {
#pragma unroll
                    for (int hf = 0; hf < 2; ++hf)
#pragma unroll
                        for (int r = 0; r < 16; ++r) { const bool valid = kv0 + 32 * hf + (r & 3) + 8 * (r >> 2) < qg; p[hf][r] = valid ? p[hf][r] : 0.f; om[hf][r] = valid ? om[hf][r] : 1.0f; }
                }
                float gs[8], ot[8];
#pragma unroll
                for (int m = 0; m < 8; ++m) { const int hf = m >> 2, g = m & 3; gs[m] = (om[hf][4 * g] * om[hf][4 * g + 1]) * (om[hf][4 * g + 2] * om[hf][4 * g + 3]); ot[m] = __shfl_xor(gs[m], 32); }
                float ps[8];
                ps[7] = 1.0f;
#pragma unroll
                for (int m = 6; m >= 0; --m) ps[m] = ps[m + 1] * (gs[m + 1] * ot[m + 1]);
                const float total = ps[0] * (gs[0] * ot[0]);
#pragma unroll
                for (int m = 0; m < 8; ++m) {
                    const int hf = m >> 2, g = m & 3;
                    float tail = carry * (hh ? ps[m] : ps[m] * ot[m]);
#pragma unroll
                    for (int i = 3; i >= 0; --i) { const int r = 4 * g + i; const float o1 = om[hf][r]; p[hf][r] *= tail; tail *= o1; }
                }
                carry *= total;
                finished = __all(carry < 1.0e-37f);
            } else {
                const float ct = __builtin_amdgcn_exp2f(lg2g * (float)(qw - 64 * j));
#pragma unroll
                for (int hf = 0; hf < 2; ++hf)
#pragma unroll
                    for (int r = 0; r < 16; ++r) p[hf][r] *= ct;
                if (diag) {
#pragma unroll
                    for (int hf = 0; hf < 2; ++hf)
#pragma unroll
                        for (int r = 0; r < 16; ++r) { const bool valid = kv0 + 32 * hf + (r & 3) + 8 * (r >> 2) <= qg; p[hf][r] = valid ? p[hf][r] : 0.f; }
                }
            }
            {
                const unsigned vbase = (unsigned)(uintptr_t)(Vb + (4 * hh + ((lane & 15) >> 2)) * 128 + (16 * ((lane >> 4) & 1) + 4 * (lane & 3)) * 2);
                s16x4 vl[2][2][2], vh[2][2][2];
#pragma unroll
                for (int hf = 0; hf < 2; ++hf)
#pragma unroll
                    for (int s = 0; s < 2; ++s)
#pragma unroll
                        for (int d0 = 0; d0 < 2; ++d0) {
                            asm volatile("ds_read_b64_tr_b16 %0, %1 offset:%c2" : "=&v"(vl[hf][s][d0]) : "v"(vbase), "i"(hf * 4096 + s * 2048 + d0 * 64) : "memory");
                            asm volatile("ds_read_b64_tr_b16 %0, %1 offset:%c2" : "=&v"(vh[hf][s][d0]) : "v"(vbase), "i"(hf * 4096 + s * 2048 + d0 * 64 + 1024) : "memory");
                        }
                bf16x8 wfr[2][2];
#pragma unroll
                for (int hf = 0; hf < 2; ++hf)
#pragma unroll
                    for (int s = 0; s < 2; ++s) {
                        u32x4_t wq;
                        wq.x = pg8::cvt_pk_bf16(p[hf][8 * s + 0], p[hf][8 * s + 1]); wq.y = pg8::cvt_pk_bf16(p[hf][8 * s + 2], p[hf][8 * s + 3]);
                        wq.z = pg8::cvt_pk_bf16(p[hf][8 * s + 4], p[hf][8 * s + 5]); wq.w = pg8::cvt_pk_bf16(p[hf][8 * s + 6], p[hf][8 * s + 7]);
                        wfr[hf][s] = __builtin_bit_cast(bf16x8, wq);
                    }
                asm volatile("s_waitcnt lgkmcnt(0)" ::: "memory"); __builtin_amdgcn_sched_barrier(0);
#pragma unroll
                for (int hf = 0; hf < 2; ++hf)
#pragma unroll
                    for (int s = 0; s < 2; ++s)
#pragma unroll
                        for (int d0 = 0; d0 < 2; ++d0) {
                            const s16x4 lo = vl[hf][s][d0], hi = vh[hf][s][d0];
                            const bf16x8 vf = (bf16x8){lo[0], lo[1], lo[2], lo[3], hi[0], hi[1], hi[2], hi[3]};
                            o[d0] = __builtin_amdgcn_mfma_f32_32x32x16_bf16(vf, wfr[hf][s], o[d0], 0, 0, 0);
                        }
            }
        }
        if (MODE == 0) { if (lane == 0) flags[cur * 8 + w] = finished ? 1u : 0u; }
        if (cnew) { if (j >= 2) asm volatile("s_waitcnt vmcnt(18) lgkmcnt(0)\n\ts_barrier" ::: "memory"); else asm volatile("s_waitcnt vmcnt(16) lgkmcnt(0)\n\ts_barrier" ::: "memory"); }
        else { if (j >= 2) asm volatile("s_waitcnt vmcnt(2) lgkmcnt(0)\n\ts_barrier" ::: "memory"); else asm volatile("s_waitcnt vmcnt(0) lgkmcnt(0)\n\ts_barrier" ::: "memory"); }
        so_cur = (so_cur == 16384) ? 0 : so_cur + 8192; so_new = (so_new == 16384) ? 0 : so_new + 8192;
        if (MODE == 0) {
            unsigned all = 1u;
#pragma unroll
            for (int i = 0; i < 8; ++i) all &= flags[cur * 8 + i];
            if (all) break;
        }
    }
    if (MODE == 1 && ABL == 0) { if (chave) p0_finish(cd, cv, cs.scr, lane, 0); }
    asm volatile("s_waitcnt vmcnt(0)\n\ts_barrier" ::: "memory");
#undef ATT_DMA
    const int row = b * SEQ + qw + r32;
    if (MODE == 0) {
        bf16* yp = A.Y + (size_t)row * DM + h * 64 + 4 * hh;
#pragma unroll
        for (int d0 = 0; d0 < 2; ++d0)
#pragma unroll
            for (int g = 0; g < 4; ++g) { u32x2_t v; v.x = pg8::cvt_pk_bf16(o[d0][4 * g], o[d0][4 * g + 1]); v.y = pg8::cvt_pk_bf16(o[d0][4 * g + 2], o[d0][4 * g + 3]); *(u32x2_t*)(yp + 32 * d0 + 8 * g) = v; }
    } else {
        float s1 = 0.f;
#pragma unroll
        for (int r = 0; r < 16; ++r) s1 += o[0][r] + o[1][r];
        s1 += __shfl_xor(s1, 32);
        const float mu = s1 * (1.0f / 64.0f);
        float s2 = 0.f;
#pragma unroll
        for (int r = 0; r < 16; ++r) { const float a0 = o[0][r] - mu, a1 = o[1][r] - mu; s2 += a0 * a0 + a1 * a1; }
        s2 += __shfl_xor(s2, 32);
        const float rstd = rsqrtf(s2 * (1.0f / 64.0f) + EPS);
        bf16* yp = A.Y + (size_t)row * DM + 512 + h * 64 + 4 * hh;
        const bf16* gp = A.rg + (size_t)row * 512 + h * 64 + 4 * hh;
        const float* gg = A.gn_g + h * 64 + 4 * hh; const float* gb = A.gn_b + h * 64 + 4 * hh;
#pragma unroll
        for (int d0 = 0; d0 < 2; ++d0)
#pragma unroll
            for (int g = 0; g < 4; ++g) {
                const f32x4 gn = *(const f32x4*)(gg + 32 * d0 + 8 * g), bs = *(const f32x4*)(gb + 32 * d0 + 8 * g);
                const u32x2_t gr = *(const u32x2_t*)(gp + 32 * d0 + 8 * g);
                float gate[4] = {__uint_as_float(gr.x << 16), __uint_as_float(gr.x & 0xffff0000u), __uint_as_float(gr.y << 16), __uint_as_float(gr.y & 0xffff0000u)};
                float ov[4];
#pragma unroll
                for (int i = 0; i < 4; ++i) { const float yn = (o[d0][4 * g + i] - mu) * rstd * gn[i] + bs[i]; const float sg = gate[i] / (1.0f + __expf(-gate[i])); ov[i] = yn * sg; }
                u32x2_t v; v.x = pg8::cvt_pk_bf16(ov[0], ov[1]); v.y = pg8::cvt_pk_bf16(ov[2], ov[3]); *(u32x2_t*)(yp + 32 * d0 + 8 * g) = v;
            }
    }
}
__device__ __forceinline__ void attn_phase(LAS unsigned char* lds, const AttnArgs& A, int vcu, int dup, bf16* dummyY, const int wave_id, const Args& args, int G) {
    const int g = vcu >> 5, local = vcu & 31;
    ConvStream cs; cs.a = &args; cs.ws = args.ws; cs.scr = lds + 57344 + wave_id * 4608; cs.it = vcu * 8 + wave_id; cs.step = G * 8; cs.ne = P0_E_P2; cs.nitems = P0_E_P2 * (P0_I_UG + P0_I_DN); cs.gap = 2;
#pragma unroll 1
    for (int u = 0; u < 2; ++u) { const int bh = 8 * g + 4 * (u & 1) + (local >> 3), qb = (u & 1) ? 7 - (local & 7) : (local & 7); attn_unit<1>(lds, A, bh >> 3, bh & 7, qb, wave_id, cs); }
#pragma unroll 1
    for (int u = 0; u < 2; ++u) { const int bh = 8 * g + 4 * (u & 1) + (local >> 3), qb = (u & 1) ? 7 - (local & 7) : (local & 7); attn_unit<0>(lds, A, bh >> 3, bh & 7, qb, wave_id, cs); }
    { const int lane = lane_id_hw(); if (cs.it < cs.nitems) p0_items_from(args, args.ws, cs.scr, lane, cs.it, cs.step, cs.ne); }
}
}

constexpr int CW_GCNT = 32768;
constexpr int LR_LCNT = LDSCTL_OFF + 1024, LR_GBASE = LDSCTL_OFF + 1152;
constexpr int LT_POFF = LDSCTL_OFF + 2048, LT_NT = LDSCTL_OFF + 2176, LT_TILE_E = LDSCTL_OFF + 2304, LT_FIRST = LDSCTL_OFF + 3712;
struct RouteBufs { int* tok_e; int* tok_slot; float* tok_gate; float* rstd; int* toklist; };
__device__ __forceinline__ RouteBufs route_bufs(unsigned char* ws) { RouteBufs r; r.tok_e = (int*)(ws + WS_ROUTE); r.tok_slot = r.tok_e + T * 4; r.tok_gate = (float*)(r.tok_slot + T * 4); r.rstd = (float*)(ws + WS_ROUTE + 1 * MiB); r.toklist = (int*)(ws + WS_TOKLIST); return r; }
typedef float f32x2v __attribute__((ext_vector_type(2)));
__device__ __forceinline__ unsigned opq_mask(bool c) { unsigned m = c ? 0xffffffffu : 0u; asm volatile("" : "+v"(m)); return m; }
__device__ __forceinline__ float blendf(unsigned m, float a, float b) { return __uint_as_float((__float_as_uint(a) & m) | (__float_as_uint(b) & ~m)); }
__device__ __forceinline__ int blendi(unsigned m, int a, int b) { return (int)(((unsigned)a & m) | ((unsigned)b & ~m)); }

#define SW2(c, a, b) { const float ta_ = (c) ? (b) : (a), tb_ = (c) ? (a) : (b); a = ta_; b = tb_; }
#define SW2I(c, a, b) { const int ta_ = (c) ? (b) : (a), tb_ = (c) ? (a) : (b); a = ta_; b = tb_; }
#define TOP4_INSERT(x, e) { const float x_ = (x); const int e_ = (e); const bool c3_ = (x_ > v3) || (x_ == v3 && e_ < i3); v3 = c3_ ? x_ : v3; i3 = c3_ ? e_ : i3; \
    const bool c2_ = (v3 > v2) || (v3 == v2 && i3 < i2); SW2(c2_, v2, v3) SW2I(c2_, i2, i3) const bool c1_ = (v2 > v1) || (v2 == v1 && i2 < i1); SW2(c1_, v1, v2) SW2I(c1_, i1, i2) \
    const bool c0_ = (v1 > v0) || (v1 == v0 && i1 < i0); SW2(c0_, v0, v1) SW2I(c0_, i0, i1) }
__device__ __forceinline__ void router_phase(Frame& F, const Args& a, const bool dry = false) {
    unsigned char* ws = a.ws; const int tid = tid_now(F.wave);
    LAS unsigned char* lds = F.lds;
    const int lane = tid & 63, r32 = lane & 31, hh = lane >> 5, w = F.wave, rg = w >> 2, kq = w & 3;
    volatile LAS unsigned* lcnt = (volatile LAS unsigned*)(lds + LR_LCNT);
    volatile LAS unsigned* gbase = (volatile LAS unsigned*)(lds + LR_GBASE);
    if (tid < 32) lcnt[tid] = 0u;
    const RouteBufs R = route_bufs(ws);
    const int row = F.vcu * 64 + 32 * rg + r32;
    const bf16* xr = (const bf16*)(ws + WS_X1) + (size_t)row * DM + 256 * kq + 8 * hh;
    const bf16* wt = (const bf16*)(ws + WS_WRT) + (size_t)r32 * DM + 256 * kq + 8 * hh;
    unsigned char* hp = (unsigned char*)(ws + (dry ? WS_H : WS_XN)) + (size_t)row * DM + 256 * kq + 8 * hh;
    att::f32x16 D;
#pragma unroll
    for (int r = 0; r < 16; ++r) D[r] = 0.f;
    float ss = 0.f;
#pragma unroll 8
    for (int ks = 0; ks < 16; ++ks) {
        const u32x4_t xh = *(const u32x4_t*)(xr + 16 * ks);
        const f32x4 v0 = (f32x4){__uint_as_float(xh.x << 16), __uint_as_float(xh.x & 0xffff0000u), __uint_as_float(xh.y << 16), __uint_as_float(xh.y & 0xffff0000u)};
        const f32x4 v1 = (f32x4){__uint_as_float(xh.z << 16), __uint_as_float(xh.z & 0xffff0000u), __uint_as_float(xh.w << 16), __uint_as_float(xh.w & 0xffff0000u)};
        ss += ((v0[0] * v0[0] + v0[1] * v0[1]) + (v0[2] * v0[2] + v0[3] * v0[3])) + ((v1[0] * v1[0] + v1[1] * v1[1]) + (v1[2] * v1[2] + v1[3] * v1[3]));
        u32x2_t h8; h8.x = pk4_fp8(v0[0], v0[1], v0[2], v0[3]); h8.y = pk4_fp8(v1[0], v1[1], v1[2], v1[3]); *(u32x2_t*)(hp + 16 * ks) = h8;
        const att::bf16x8 whi = *(const att::bf16x8*)(wt + 16 * ks), wlo = *(const att::bf16x8*)(wt + 32 * DM + 16 * ks);
        const att::bf16x8 bxh = __builtin_bit_cast(att::bf16x8, xh);
        D = __builtin_amdgcn_mfma_f32_32x32x16_bf16(whi, bxh, D, 0, 0, 0);
        D = __builtin_amdgcn_mfma_f32_32x32x16_bf16(wlo, bxh, D, 0, 0, 0);
    }
    { LAS f32x4* dp = (LAS f32x4*)(lds + (w * 64 + lane) * 64);
#pragma unroll
      for (int q = 0; q < 4; ++q) dp[q] = (f32x4){D[4 * q], D[4 * q + 1], D[4 * q + 2], D[4 * q + 3]};
      *(LAS float*)(lds + 32768 + (w * 64 + lane) * 4) = ss; }
    __syncthreads();
    int my_e0 = 0, my_e1 = 0, rk0 = 0, rk1 = 0; float my_g0 = 0.f, my_g1 = 0.f;
    if (kq == 0) {
#pragma unroll
        for (int o = 1; o < 4; ++o) { LAS const f32x4* dp = (LAS const f32x4*)(lds + ((w + o) * 64 + lane) * 64);
#pragma unroll
            for (int q = 0; q < 4; ++q) { const f32x4 t = dp[q]; D[4 * q] += t[0]; D[4 * q + 1] += t[1]; D[4 * q + 2] += t[2]; D[4 * q + 3] += t[3]; }
            ss += *(LAS const float*)(lds + 32768 + ((w + o) * 64 + lane) * 4); }
        ss += __shfl_xor(ss, 32);
        const float rstd = rsqrtf(ss * (1.f / DM) + EPS);
        if (hh == 0) R.rstd[row] = rstd;
        float l[16];
#pragma unroll
        for (int r = 0; r < 16; ++r) l[r] = D[r] * rstd + a.b_r[(r & 3) + 8 * (r >> 2) + 4 * hh];
        float c[8]; int ci[8];
#pragma unroll
        for (int k = 0; k < 4; ++k) {
            float bv = -INFINITY; int bi = 99;
#pragma unroll
            for (int r = 0; r < 16; ++r) { const int e = (r & 3) + 8 * (r >> 2) + 4 * hh; const bool bt = l[r] > bv; bv = bt ? l[r] : bv; bi = bt ? e : bi; }
            c[k] = bv; ci[k] = bi;
#pragma unroll
            for (int r = 0; r < 16; ++r) { const int e = (r & 3) + 8 * (r >> 2) + 4 * hh; l[r] = (e == bi) ? -INFINITY : l[r]; }
        }
#pragma unroll
        for (int k = 0; k < 4; ++k) { c[4 + k] = __shfl_xor(c[k], 32); ci[4 + k] = __shfl_xor(ci[k], 32); }
        float tv[4]; int ti[4];
#pragma unroll
        for (int k = 0; k < 4; ++k) {
            float bv = -INFINITY; int bi = 99;
#pragma unroll
            for (int j = 0; j < 8; ++j) { const bool bt = (c[j] > bv) || (c[j] == bv && ci[j] < bi); bv = bt ? c[j] : bv; bi = bt ? ci[j] : bi; }
            tv[k] = bv; ti[k] = bi;
#pragma unroll
            for (int j = 0; j < 8; ++j) c[j] = (ci[j] == bi) ? -INFINITY : c[j];
        }
        const float v0 = tv[0], v1 = tv[1], v2 = tv[2], v3 = tv[3]; const int i0 = ti[0], i1 = ti[1], i2 = ti[2], i3 = ti[3];
        const float e1 = __expf(v1 - v0), e2 = __expf(v2 - v0), e3 = __expf(v3 - v0), inv = 1.0f / (1.0f + e1 + e2 + e3);
        my_e0 = hh ? i2 : i0; my_e1 = hh ? i3 : i1; my_g0 = (hh ? e2 : 1.0f) * inv; my_g1 = (hh ? e3 : e1) * inv;
        rk0 = (int)__hip_atomic_fetch_add((LAS unsigned*)(lds + LR_LCNT) + my_e0, 1u, __ATOMIC_RELAXED, __HIP_MEMORY_SCOPE_WORKGROUP);
        rk1 = (int)__hip_atomic_fetch_add((LAS unsigned*)(lds + LR_LCNT) + my_e1, 1u, __ATOMIC_RELAXED, __HIP_MEMORY_SCOPE_WORKGROUP);
    }
    __syncthreads();
    if (tid < 32) gbase[tid] = __hip_atomic_fetch_add((unsigned*)(F.ctl + CW_GCNT + (dry ? 4096 : 0)) + 64 * tid, lcnt[tid], __ATOMIC_RELAXED, __HIP_MEMORY_SCOPE_AGENT);
    __syncthreads();
    if (kq == 0) {
        const int k0 = 2 * hh;
        const int s0 = (int)gbase[my_e0] + rk0, s1 = (int)gbase[my_e1] + rk1;
        R.tok_e[row * 4 + k0] = my_e0; R.tok_slot[row * 4 + k0] = s0; R.tok_gate[row * 4 + k0] = my_g0; R.toklist[(size_t)my_e0 * T + s0] = row;
        R.tok_e[row * 4 + k0 + 1] = my_e1; R.tok_slot[row * 4 + k0 + 1] = s1; R.tok_gate[row * 4 + k0 + 1] = my_g1; R.toklist[(size_t)my_e1 * T + s1] = row;
    }
}
#undef SW2
#undef SW2I
#undef TOP4_INSERT

__device__ __forceinline__ void build_tables(Frame& F) {
    LAS int* poff = (LAS int*)(F.lds + LT_POFF); LAS int* ntp = (LAS int*)(F.lds + LT_NT); LAS int* tile_e = (LAS int*)(F.lds + LT_TILE_E);
    LAS int* cnts = (LAS int*)(F.lds + LR_LCNT); const int tid = tid_now(F.wave);
    if (tid < NE) cnts[tid] = (int)__hip_atomic_load((unsigned*)(F.ctl + CW_GCNT) + 64 * tid, __ATOMIC_RELAXED, __HIP_MEMORY_SCOPE_AGENT);
    __syncthreads();
    if (tid == 0) {
        int t = 0;
        for (int e = 0; e < NE; ++e) { const int c = cnts[e]; const int nt = (c + 255) >> 8; poff[e] = t * 256; ((LAS int*)(F.lds + LT_FIRST))[e] = t; for (int i = 0; i < nt; ++i) tile_e[t + i] = e; t += nt; }
        *ntp = t;
    }
    __syncthreads();
}
constexpr int CRPT = 4;
__device__ __forceinline__ void combine_phase(Frame& F, const Args& a, const bool dry = false) {
    unsigned char* ws = a.ws; const RouteBufs R = route_bufs(ws);
    LAS const int* poff = (LAS const int*)(F.lds + LT_POFF);
    const int gw = F.vcu * NWAVES + F.wave, NGW = F.G * NWAVES, lane = tid_now(F.wave) & 63;
    for (int m0 = CRPT * gw; m0 < T; m0 += CRPT * NGW) {
        f32x4 v[CRPT][2][2]; u32x2_t y[CRPT][4][2]; float gt[CRPT][4];
#pragma unroll
        for (int rr = 0; rr < CRPT; ++rr) { const int m = m0 + rr;
#pragma unroll
            for (int i = 0; i < 2; ++i) { { const v4u xq = __builtin_nontemporal_load((const v4u*)((const bf16*)(ws + WS_X1) + (size_t)m * DM + 8 * lane + 512 * i)); v[rr][i][0] = (f32x4){__uint_as_float(xq[0] << 16), __uint_as_float(xq[0] & 0xffff0000u), __uint_as_float(xq[1] << 16), __uint_as_float(xq[1] & 0xffff0000u)}; v[rr][i][1] = (f32x4){__uint_as_float(xq[2] << 16), __uint_as_float(xq[2] & 0xffff0000u), __uint_as_float(xq[3] << 16), __uint_as_float(xq[3] & 0xffff0000u)}; } }
#pragma unroll
            for (int k = 0; k < 4; ++k) { const int e = R.tok_e[m * 4 + k], slot = R.tok_slot[m * 4 + k]; gt[rr][k] = R.tok_gate[m * 4 + k];
                const unsigned char* yr = (const unsigned char*)(ws + WS_YS) + (size_t)(poff[e] + slot) * DM + 8 * lane;
                y[rr][k][0] = __builtin_nontemporal_load((const u32x2_t*)yr); y[rr][k][1] = __builtin_nontemporal_load((const u32x2_t*)(yr + 512)); } }
#pragma unroll
        for (int rr = 0; rr < CRPT; ++rr) { const int m = m0 + rr;
#pragma unroll
            for (int k = 0; k < 4; ++k)
#pragma unroll
                for (int i = 0; i < 2; ++i) { const u32x2_t yy = y[rr][k][i]; const float g = gt[rr][k];
                    const f32x2v a0 = __builtin_amdgcn_cvt_pk_f32_fp8((int)yy.x, false), a1 = __builtin_amdgcn_cvt_pk_f32_fp8((int)yy.x, true), a2 = __builtin_amdgcn_cvt_pk_f32_fp8((int)yy.y, false), a3 = __builtin_amdgcn_cvt_pk_f32_fp8((int)yy.y, true);
                    v[rr][i][0][0] += g * a0[0]; v[rr][i][0][1] += g * a0[1]; v[rr][i][0][2] += g * a1[0]; v[rr][i][0][3] += g * a1[1];
                    v[rr][i][1][0] += g * a2[0]; v[rr][i][1][1] += g * a2[1]; v[rr][i][1][2] += g * a3[0]; v[rr][i][1][3] += g * a3[1]; }
            float ss = 0.f;
#pragma unroll
            for (int i = 0; i < 2; ++i)
#pragma unroll
                for (int q = 0; q < 2; ++q) { const f32x4 t = v[rr][i][q]; ss += (t[0] * t[0] + t[1] * t[1]) + (t[2] * t[2] + t[3] * t[3]); }
            const float rstd = rsqrtf(wave_sum(ss) * (1.f / DM) + EPS);
            unsigned char* np = (unsigned char*)(ws + (dry ? WS_H : WS_XN)) + (size_t)m * DM + 8 * lane; bf16* ow = (bf16*)(ws + (dry ? WS_XS : WS_Y));
#pragma unroll
            for (int i = 0; i < 2; ++i) { { v4u xb; xb[0] = cvtpk(v[rr][i][0][0], v[rr][i][0][1]); xb[1] = cvtpk(v[rr][i][0][2], v[rr][i][0][3]); xb[2] = cvtpk(v[rr][i][1][0], v[rr][i][1][1]); xb[3] = cvtpk(v[rr][i][1][2], v[rr][i][1][3]); *(v4u*)(ow + (size_t)m * DM + 8 * lane + 512 * i) = xb; }
                const f32x4 g0 = *(const f32x4*)(a.g_ple + 8 * lane + 512 * i), g1 = *(const f32x4*)(a.g_ple + 8 * lane + 512 * i + 4);
                u32x2_t o; o.x = pk4_fp8(v[rr][i][0][0] * rstd * g0[0], v[rr][i][0][1] * rstd * g0[1], v[rr][i][0][2] * rstd * g0[2], v[rr][i][0][3] * rstd * g0[3]);
                o.y = pk4_fp8(v[rr][i][1][0] * rstd * g1[0], v[rr][i][1][1] * rstd * g1[1], v[rr][i][1][2] * rstd * g1[2], v[rr][i][1][3] * rstd * g1[3]);
                *(u32x2_t*)(np + 512 * i) = o; } }
    }
}

__global__ void __launch_bounds__(NWAVES * 64, 2) mega_fwd(Args args) {
    extern __shared__ __attribute__((aligned(16))) unsigned char lds[];
    Frame F;
    F.lds = (LAS unsigned char*)lds;
    F.MISC = (volatile LAS unsigned*)(F.lds + MISC_OFF);
    F.wave = __builtin_amdgcn_readfirstlane(threadIdx.x >> 6);
    F.G = gridDim.x; { const int bx = blockIdx.x; F.vcu = (F.G % 8 == 0) ? (bx % 8) * (F.G / 8) + bx / 8 : bx; }
    unsigned char* ws = args.ws;
    F.ctl = (gu32*)(ws + WS_CTL);
    for (int u = threadIdx.x; u < (LDS_BYTES - LDSCTL_OFF) / 4; u += NWAVES * 64) ((LAS unsigned*)(F.lds + LDSCTL_OFF))[u] = 0u;
    __syncthreads();
    XcdBarrier bar = xcd_barrier_post((unsigned*)(F.ctl + CW_BAR), F.MISC + 8); bar.wave = F.wave;
#ifdef PROBE_LO
    const int lo = args.ph_lo, hi = args.ph_hi & 0xff; const bool PROBE_NULL = (args.ph_hi >> 8) != 0;
#else
    const int lo = args.ph_lo, hi = args.ph_hi; constexpr bool PROBE_NULL = false;
#endif
#define IN(k) (lo <= (k) && (k) < hi)
#define GRID_BAR() xcd_barrier(bar)
#ifndef DUP_PHASE
#define DUP_PHASE -1
#endif
#define REP(k) for (int rep_ = 0; rep_ < ((DUP_PHASE) == (k) ? 2 : 1); ++rep_)

    if (IN(0)) { if (DUP_PHASE == 40) { p0_prologue(F, args, 1); GRID_BAR(); } if (DUP_PHASE == 41) { p0_prologue(F, args, 2); GRID_BAR(); } if (DUP_PHASE == 42) { p0_prologue(F, args, 3); GRID_BAR(); } REP(0) { p0_prologue(F, args); GRID_BAR(); } }

    if (IN(1)) REP(1) {
        pg8::Gemm g{(const pg8::bf16_t*)(ws + WS_XN), (const pg8::bf16_t*)(ws + WS_WT_IN), DM, 0};
        pg8::StaticOrder S; S.init(T / 256, DIN / 256, F.G, (int)blockIdx.x);
        pg8::EpiProj E{(pg8::bf16_t*)(ws + WS_HM), (pg8::bf16_t*)(ws + WS_RG), (const float*)(ws + WS_GAINS), (const float*)(ws + WS_ROPEC), (const float*)(ws + WS_ROPES)};
        pg8::gemm_phase<pg8::EpiProj, pg8::StaticOrder, true, true>(F.lds + RING_OFF, g, S, E, F.wave);
        {
            const int G2 = (F.G == 256) ? 128 : F.G, c2 = (F.G == 256) ? (int)blockIdx.x - 128 : (int)blockIdx.x;
            if (c2 >= 0) {
                pg8::Gemm g2{(const pg8::bf16_t*)(ws + WS_PB), (const pg8::bf16_t*)(ws + WS_WT_PP), PLE, 0};
                pg8::StaticOrder S2; S2.init(T / 256, DM / 256, G2, c2);
                pg8::EpiBf16Plain E2{(pg8::bf16_t*)(ws + WS_PJ), DM};
                pg8::gemm_phase<pg8::EpiBf16Plain, pg8::StaticOrder, true, true>(F.lds + RING_OFF, g2, S2, E2, F.wave);
            }
        }
        GRID_BAR();
    }
    if (DUP_PHASE == 51 && IN(1)) {
        pg8::Gemm g{(const pg8::bf16_t*)(ws + WS_XN), (const pg8::bf16_t*)(ws + WS_WT_IN), DM, 0};
        pg8::StaticOrder S; S.init(T / 256, DIN / 256, F.G, (int)blockIdx.x);
        pg8::EpiNull E;
        pg8::gemm_phase<pg8::EpiNull, pg8::StaticOrder, true, true>(F.lds + RING_OFF, g, S, E, F.wave);
        GRID_BAR();
    }
    if (IN(2)) REP(2) {
        if (F.G == 256) {
            const att::AttnArgs AA{(const bf16*)(ws + WS_HM), (const bf16*)(ws + WS_RG), (bf16*)(ws + WS_Y), args.gn_g, args.gn_b};
            att::attn_phase(F.lds + RING_OFF, AA, F.vcu, DUP_PHASE, (bf16*)(ws + WS_XS), F.wave, args, F.G);
        }
        GRID_BAR();
    }
    if (IN(3)) REP(3) {
        pg8::Gemm g{(const pg8::bf16_t*)(ws + WS_Y), (const pg8::bf16_t*)(ws + WS_WT_OUT), DM, 0};
        pg8::StaticOrder S; S.init(T / 256, DM / 256, F.G, (int)blockIdx.x);
        pg8::EpiResid E{args.x, (pg8::bf16_t*)(ws + WS_X1)};
        pg8::gemm_phase<pg8::EpiResid, pg8::StaticOrder, true, true>(F.lds + RING_OFF, g, S, E, F.wave);
        GRID_BAR();
    }
    if (DUP_PHASE == 30 && IN(3)) { GRID_BAR(); GRID_BAR(); GRID_BAR(); GRID_BAR(); }
    if (IN(4)) { if (DUP_PHASE == 4) { if (F.G == 256) router_phase(F, args, true); GRID_BAR(); } if (F.G == 256) router_phase(F, args); GRID_BAR(); }
    if (IN(5) || (lo >= 6 && lo <= 8)) build_tables(F);
    if (IN(6)) REP(6) {
        const int NT = *(LAS const int*)(F.lds + LT_NT);
        pg8::Gemm g{(const pg8::bf16_t*)(ws + WS_XN), (const pg8::bf16_t*)(ws + WS_WT_UG), DM / 2, (size_t)2048 * DM};
#ifdef PROBE_LO
        g.nostage = ((args.ph_hi >> 8) == 2);
#endif
        pg8::MoeOrder S; S.init(NT, 8, F.G, (int)blockIdx.x, (LAS const int*)(F.lds + LT_TILE_E), F.wave, 1, args.b_ug, route_bufs(ws).rstd, F.lds + PF_OFF);
        S.toklist = route_bufs(ws).toklist; S.first_tile = (LAS const int*)(F.lds + LT_FIRST); S.tokl = F.lds + TOKL_OFF;
        pg8::EpiMoeUp E{PROBE_NULL ? (unsigned char*)nullptr : (unsigned char*)(ws + WS_H), F.lds + PF_OFF};
        pg8::gemm_phase<pg8::EpiMoeUp, pg8::MoeOrder, true, true, true, true>(F.lds + RING_OFF, g, S, E, F.wave);
        GRID_BAR();
    }
    if (IN(7)) REP(7) {
        const int NT = *(LAS const int*)(F.lds + LT_NT);
        pg8::Gemm g{(const pg8::bf16_t*)(ws + WS_H), (const pg8::bf16_t*)(ws + WS_WT_DN), DM / 2, (size_t)DM * DM};
        pg8::MoeOrder S; S.init(NT, 4, F.G, (int)blockIdx.x, (LAS const int*)(F.lds + LT_TILE_E), F.wave, 2, args.b_dn, nullptr, F.lds + PF_OFF);
        pg8::EpiMoeDown E{PROBE_NULL ? (unsigned char*)nullptr : (unsigned char*)(ws + WS_YS), F.lds + PF_OFF};
        pg8::gemm_phase<pg8::EpiMoeDown, pg8::MoeOrder, true, true, true>(F.lds + RING_OFF, g, S, E, F.wave);
        GRID_BAR();
    }
    if (IN(8)) { if (DUP_PHASE == 8) { combine_phase(F, args, true); GRID_BAR(); } combine_phase(F, args); GRID_BAR(); }
    if (IN(9)) {
        pg8::Gemm g{(const pg8::bf16_t*)(ws + WS_XN), (const pg8::bf16_t*)(ws + WS_WT_PG), DM / 2, 0};
        pg8::StaticOrder S; S.init(T / 256, DM / 256, F.G, (int)blockIdx.x);
        if (DUP_PHASE == 9) { pg8::EpiPle E0{(const pg8::bf16_t*)(ws + WS_Y), (const pg8::bf16_t*)(ws + WS_PJ), (float*)(ws + WS_XS)}; pg8::gemm_phase<pg8::EpiPle, pg8::StaticOrder, true, true, true>(F.lds + RING_OFF, g, S, E0, F.wave); }
        pg8::EpiPle E{(const pg8::bf16_t*)(ws + WS_Y), (const pg8::bf16_t*)(ws + WS_PJ), args.out};
        pg8::gemm_phase<pg8::EpiPle, pg8::StaticOrder, true, true, true>(F.lds + RING_OFF, g, S, E, F.wave);
    }
#undef IN
}
extern "C" void kernel_launch(void* const* d_in, const int* in_sizes, int n_in, void* d_out, int out_size, void* d_ws, size_t ws_size, hipStream_t stream) {
    static int grid = 0;
    if (grid == 0) {
        if (n_in != 22 || ws_size < 1024 * MiB) { fprintf(stderr, "kernel_launch: unexpected n_in %d / ws %zu\n", n_in, ws_size); grid = -1; return; }
        int dev = 0, cus = 0, per_cu = 0;
        if (hipGetDevice(&dev) != hipSuccess || hipDeviceGetAttribute(&cus, hipDeviceAttributeMultiprocessorCount, dev) != hipSuccess) { grid = -1; return; }
        if (hipFuncSetAttribute((const void*)mega_fwd, hipFuncAttributeMaxDynamicSharedMemorySize, LDS_BYTES) != hipSuccess) { fprintf(stderr, "kernel_launch: hipFuncSetAttribute failed\n"); grid = -1; return; }
        if (hipOccupancyMaxActiveBlocksPerMultiprocessor(&per_cu, (const void*)mega_fwd, NWAVES * 64, LDS_BYTES) != hipSuccess || per_cu < 1) { fprintf(stderr, "kernel_launch: occupancy query says %d\n", per_cu); per_cu = 1; }
        (void)hipGetLastError();
        grid = cus;
    }
    if (grid < 0) return;
    (void)hipMemsetAsync((char*)d_ws + WS_CTL, 0, CTL_ZERO_BYTES, stream);
    Args a{};
    a.x = (const float*)d_in[0]; a.p = (const float*)d_in[1]; a.positions = (const int*)d_in[2]; a.g_mix = (const float*)d_in[3]; a.w_in = (const float*)d_in[4];
    a.sbq = (const float*)d_in[5]; a.sbk = (const float*)d_in[6]; a.rq = (const float*)d_in[7]; a.rk = (const float*)d_in[8]; a.gn_g = (const float*)d_in[9]; a.gn_b = (const float*)d_in[10];
    a.w_out = (const float*)d_in[11]; a.g_ffn = (const float*)d_in[12]; a.w_r = (const float*)d_in[13]; a.b_r = (const float*)d_in[14]; a.w_ug = (const float*)d_in[15]; a.b_ug = (const float*)d_in[16];
    a.w_dn = (const float*)d_in[17]; a.b_dn = (const float*)d_in[18]; a.g_ple = (const float*)d_in[19]; a.w_pg = (const float*)d_in[20]; a.w_pp = (const float*)d_in[21];
    a.out = (float*)d_out; a.ws = (unsigned char*)d_ws; a.ph_lo = 0; a.ph_hi = 10;
    hipLaunchKernelGGL(mega_fwd, dim3(grid), dim3(NWAVES * 64), LDS_BYTES, stream, a);
#ifdef PROBE_LO
    (void)hipMemsetAsync((char*)d_ws + WS_CTL + CW_BAR * 4, 0, 16384, stream);
    a.ph_lo = PROBE_LO; a.ph_hi = PROBE_HI | (PROBE_FLAG << 8);
    hipLaunchKernelGGL(mega_fwd, dim3(grid), dim3(NWAVES * 64), LDS_BYTES, stream, a);
#endif

}
```
